# Optimizing an MI355X kernel written in HIP

```python
import math
import jax
import jax.numpy as jnp
from jax import lax
import numpy as np

D_MODEL = 1024
BATCH = 32
SEQ = 2048
DEPTH = 2

GRID_W = 64
CTX_LEN = 256
EPS = 1e-6

D_MIX = D_MODEL
W_CONV = D_MIX // 4
W_POOL = D_MIX // 4
W_SSM = D_MIX // 4
W_MLA = D_MIX - W_CONV - W_POOL - W_SSM

CONV_K = 31

POOL_WINDOWS = (2, 4, 8, 16)
POOL_CH = W_POOL // len(POOL_WINDOWS)

SSM_CH = 16
SSM_GROUPS = W_SSM // SSM_CH
SSM_STATE = 64

MLA_V = 64
MLA_HEADS = W_MLA // MLA_V
MLA_NOPE = 64
MLA_ROPE = 32
MLA_QK = MLA_NOPE + MLA_ROPE
MLA_Q_RANK = 192
MLA_KV_RANK = 128
ROPE_AXIS = MLA_ROPE // 2
ROPE_BASE = 10000.0
Q_BLOCK = 128

N_EXPERTS = 32
TOP_K = 4
D_EXPERT = D_MODEL
SWIGLU_LIMIT = 7.0
SWIGLU_ALPHA = 1.702
MOE_BLOCK = 512

OFF_POOL = 2 * W_CONV
OFF_Q = OFF_POOL + W_POOL
OFF_SSM = OFF_Q + MLA_Q_RANK
OFF_KV = OFF_SSM + W_SSM
OFF_KPE = OFF_KV + MLA_KV_RANK
N_IN = OFF_KPE + MLA_ROPE
SPLIT_AT = (OFF_POOL, OFF_Q, OFF_SSM, OFF_KV, OFF_KPE)

kernel_name = 'hybrid_dit_conv_pool_s5_mla_moe'


def rmsnorm(x, g):
    xf = x.astype(jnp.float32)
    y = xf * lax.rsqrt(jnp.mean(xf * xf, axis=-1, keepdims=True) + EPS)
    return y.astype(x.dtype) * g


def layernorm(x, g, b):
    xf = x.astype(jnp.float32)
    mu = jnp.mean(xf, axis=-1, keepdims=True)
    var = jnp.mean(jnp.square(xf - mu), axis=-1, keepdims=True)
    return ((xf - mu) * lax.rsqrt(var + EPS)).astype(x.dtype) * g + b


def conv_module(p, dw, dw_b, ln_g, ln_b, pw):
    val, gate = jnp.split(p, 2, axis=-1)
    u = val * jax.nn.sigmoid(gate)
    u = lax.conv_general_dilated(
        u, dw[:, None, :], window_strides=(1,),
        padding=[(CONV_K // 2, CONV_K // 2)],
        dimension_numbers=('NWC', 'WIO', 'NWC'),
        feature_group_count=u.shape[-1]) + dw_b
    u = jax.nn.silu(layernorm(u, ln_g, ln_b))
    return u @ pw


def multiscale_pool(u, w, scale):
    bsz, length, _ = u.shape
    n_g = len(POOL_WINDOWS)
    ug = u.reshape(bsz, length, n_g, POOL_CH)
    cs = jnp.concatenate([jnp.zeros((bsz, 1, n_g, POOL_CH), jnp.float32),
                          jnp.cumsum(ug.astype(jnp.float32), axis=1)], axis=1)
    t = jnp.arange(length)
    groups = []
    for g, win in enumerate(POOL_WINDOWS):
        lo = jnp.maximum(t - win // 2, 0)
        hi = jnp.minimum(t + win - 1 - win // 2, length - 1)
        csg = cs[:, :, g]
        cnt = (hi - lo + 1).astype(jnp.float32)[None, :, None]
        mean = (csg[:, hi + 1] - csg[:, lo]) / cnt
        groups.append(mean.astype(u.dtype) - ug[:, :, g])
    pooled = jnp.stack(groups, axis=2)
    y = jnp.einsum('blgc,gcd->blgd', pooled, w)
    return y.reshape(bsz, length, W_POOL) * scale


def s5_discretise(a_re, a_im, log_dt, b_re, b_im):
    a_re = jnp.minimum(a_re.astype(jnp.float32), -1e-4)
    a_im = a_im.astype(jnp.float32)
    dt = jnp.exp(log_dt.astype(jnp.float32))[:, None]
    mag = jnp.exp(a_re * dt)
    ab_re = mag * jnp.cos(a_im * dt)
    ab_im = mag * jnp.sin(a_im * dt)
    den = a_re * a_re + a_im * a_im
    f_re = ((ab_re - 1.0) * a_re + ab_im * a_im) / den
    f_im = (ab_im * a_re - (ab_re - 1.0) * a_im) / den
    b_re = b_re.astype(jnp.float32)
    b_im = b_im.astype(jnp.float32)
    bb_re = f_re[..., None] * b_re - f_im[..., None] * b_im
    bb_im = f_re[..., None] * b_im + f_im[..., None] * b_re
    return ab_re, ab_im, bb_re, bb_im


def _complex_affine_combine(e1, e2):
    a1r, a1i, b1r, b1i = e1
    a2r, a2i, b2r, b2i = e2
    return (a1r * a2r - a1i * a2i, a1r * a2i + a1i * a2r,
            a2r * b1r - a2i * b1i + b2r, a2r * b1i + a2i * b1r + b2i)


def diag_scan(ab_re, ab_im, bb_re, bb_im, u, h0_re, h0_im, reverse):
    bu_re = jnp.einsum('blgc,gpc->blgp', u, bb_re)
    bu_im = jnp.einsum('blgc,gpc->blgp', u, bb_im)
    first = u.shape[1] - 1 if reverse else 0
    bu_re = bu_re.at[:, first].add(ab_re * h0_re - ab_im * h0_im)
    bu_im = bu_im.at[:, first].add(ab_re * h0_im + ab_im * h0_re)
    a_re = jnp.broadcast_to(ab_re, bu_re.shape)
    a_im = jnp.broadcast_to(ab_im, bu_im.shape)
    _, _, h_re, h_im = lax.associative_scan(
        _complex_affine_combine, (a_re, a_im, bu_re, bu_im), reverse=reverse, axis=1)
    return h_re, h_im


def s5_readout(h_re, h_im, c_re, c_im):
    return (jnp.einsum('blgp,gcp->blgc', h_re, c_re.astype(jnp.float32))
            - jnp.einsum('blgp,gcp->blgc', h_im, c_im.astype(jnp.float32)))


def s5_mixer(ux, uc, a_re, a_im, log_dt, b_re, b_im, c_re, c_im, d, glu_w, glu_b, need_ctx):
    def grouped(u):
        return u.astype(jnp.float32).reshape(u.shape[0], u.shape[1], SSM_GROUPS, SSM_CH)
    gx, gc = grouped(ux), grouped(uc)
    zero = jnp.zeros((ux.shape[0], SSM_GROUPS, SSM_STATE), jnp.float32)
    d_g = d.astype(jnp.float32).reshape(SSM_GROUPS, SSM_CH)
    yx = d_g * gx
    yc = d_g * gc if need_ctx else None
    for direction in range(2):
        reverse = direction == 1
        ab_re, ab_im, bb_re, bb_im = s5_discretise(
            a_re[direction], a_im[direction], log_dt[direction], b_re[direction], b_im[direction])
        hc_re, hc_im = diag_scan(ab_re, ab_im, bb_re, bb_im, gc, zero, zero, reverse)
        end = 0 if reverse else -1
        hx_re, hx_im = diag_scan(ab_re, ab_im, bb_re, bb_im, gx,
                                 hc_re[:, end], hc_im[:, end], reverse)
        yx = yx + s5_readout(hx_re, hx_im, c_re[direction], c_im[direction])
        if need_ctx:
            yc = yc + s5_readout(hc_re, hc_im, c_re[direction], c_im[direction])

    def glu(y, like):
        z = jax.nn.gelu(y.reshape(like.shape)).astype(like.dtype)
        return z * jax.nn.sigmoid(z @ glu_w + glu_b)
    return glu(yx, ux), (glu(yc, uc) if need_ctx else None)


def axial_rope_tables(rows, dtype):
    row = jnp.repeat(jnp.arange(rows), GRID_W).astype(jnp.float32)
    col = jnp.tile(jnp.arange(GRID_W), rows).astype(jnp.float32)
    inv = ROPE_BASE ** (-jnp.arange(0, ROPE_AXIS, 2, dtype=jnp.float32) / ROPE_AXIS)
    ang_r = row[:, None] * inv
    ang_c = col[:, None] * inv
    return tuple(t.astype(dtype)[:, None, :] for t in
                 (jnp.cos(ang_r), jnp.sin(ang_r), jnp.cos(ang_c), jnp.sin(ang_c)))


def _rotate_half(x, cos, sin):
    x1, x2 = jnp.split(x, 2, axis=-1)
    return jnp.concatenate([x1 * cos - x2 * sin, x2 * cos + x1 * sin], axis=-1)


def apply_axial_rope(t, tables):
    cos_r, sin_r, cos_c, sin_c = tables
    return jnp.concatenate([
        t[..., :MLA_NOPE],
        _rotate_half(t[..., MLA_NOPE:MLA_NOPE + ROPE_AXIS], cos_r, sin_r),
        _rotate_half(t[..., MLA_NOPE + ROPE_AXIS:], cos_c, sin_c)], axis=-1)


def mla_query(cq, q_a_g, wq_b, q_g):
    q = rmsnorm(cq, q_a_g) @ wq_b
    return rmsnorm(q.reshape(*cq.shape[:-1], MLA_HEADS, MLA_QK), q_g)


def mla_key_value(ckv, kpe, kv_a_g, wkv_b, k_g):
    lead = ckv.shape[:-1]
    kv = (rmsnorm(ckv, kv_a_g) @ wkv_b).reshape(*lead, MLA_HEADS, MLA_NOPE + MLA_V)
    k_pe = jnp.broadcast_to(kpe[..., None, :], (*lead, MLA_HEADS, MLA_ROPE))
    k = rmsnorm(jnp.concatenate([kv[..., :MLA_NOPE], k_pe], axis=-1), k_g)
    return k, kv[..., MLA_NOPE:]


def attend(q, k, v):
    s = jnp.einsum('bqhd,bkhd->bhqk', q, k).astype(jnp.float32) * (MLA_QK ** -0.5)
    p = jax.nn.softmax(s, axis=-1).astype(v.dtype)
    return jnp.einsum('bhqk,bkhv->bqhv', p, v)


def blocked_attention(q, k, v):
    bsz, length = q.shape[:2]
    qb = q.reshape(bsz, length // Q_BLOCK, Q_BLOCK, MLA_HEADS, MLA_QK).swapaxes(0, 1)
    o = lax.map(lambda qi: attend(qi, k, v), qb)
    return o.swapaxes(0, 1).reshape(bsz, length, MLA_HEADS * MLA_V)


def moe(h, router_w, router_b, w_in, b_in, w_out, b_out):
    n_tok, dim = h.shape
    logits = (h @ router_w + router_b).astype(jnp.float32)
    top_v, top_i = lax.top_k(logits, TOP_K)
    top_w = jax.nn.softmax(top_v, axis=-1)
    flat_e = top_i.reshape(-1)
    flat_t = jnp.arange(n_tok * TOP_K, dtype=jnp.int32) // TOP_K
    flat_w = top_w.reshape(-1)
    order = jnp.argsort(flat_e)
    sorted_e = flat_e[order]
    counts = jnp.bincount(flat_e, length=N_EXPERTS)
    padded = (counts + MOE_BLOCK - 1) // MOE_BLOCK * MOE_BLOCK
    pad_end = jnp.cumsum(padded)
    pad_start = pad_end - padded
    start = jnp.cumsum(counts) - counts
    dest = pad_start[sorted_e] + (jnp.arange(n_tok * TOP_K) - start[sorted_e])
    n_blocks = -(-(n_tok * TOP_K) // MOE_BLOCK) + N_EXPERTS
    n_pad = n_blocks * MOE_BLOCK
    tok_pad = jnp.full((n_pad,), n_tok, jnp.int32).at[dest].set(flat_t[order])
    w_pad = jnp.zeros((n_pad,), jnp.float32).at[dest].set(flat_w[order])
    block_e = jnp.minimum(jnp.searchsorted(pad_end, jnp.arange(n_blocks) * MOE_BLOCK, side='right'),
                          N_EXPERTS - 1)
    h_ext = jnp.concatenate([h, jnp.zeros((1, dim), h.dtype)], axis=0)

    def expert_block(args):
        idx, e = args
        xb = h_ext[idx]
        gu = xb @ w_in[e] + b_in[e]
        gate, up = jnp.split(gu, 2, axis=-1)
        gate = jnp.minimum(gate, SWIGLU_LIMIT)
        up = jnp.clip(up, -SWIGLU_LIMIT, SWIGLU_LIMIT)
        act = (up + 1.0) * gate * jax.nn.sigmoid(SWIGLU_ALPHA * gate)
        return act @ w_out[e] + b_out[e]

    y = lax.map(expert_block, (tok_pad.reshape(n_blocks, MOE_BLOCK), block_e)).reshape(n_pad, dim)
    y = y * w_pad.astype(y.dtype)[:, None]
    return jnp.zeros((n_tok + 1, dim), y.dtype).at[tok_pad].add(y)[:n_tok]


def setup_inputs(seed: int = 0) -> dict:
    key = jax.random.key(seed)
    keys = iter(jax.random.split(key, 48))

    def nrm(shape, std):
        return std * jax.random.normal(next(keys), shape, jnp.float32)

    def gain(shape):
        return 1.0 + nrm(shape, 0.02)

    L = DEPTH
    G, P = SSM_GROUPS, SSM_STATE
    state_idx = jnp.arange(P, dtype=jnp.float32)
    return {
        'x': nrm((BATCH, SEQ, D_MODEL), 1.0),
        'c': nrm((BATCH, D_MODEL), 1.0),
        'ctx': nrm((BATCH, CTX_LEN, D_MODEL), 1.0),
        'c_ctx': nrm((D_MODEL,), 1.0),
        'ada_w': nrm((L, D_MODEL, 6 * D_MODEL), 0.5 * D_MODEL ** -0.5),
        'ada_b': nrm((L, 6 * D_MODEL), 0.02),
        'norm1_g': gain((L, D_MODEL)),
        'norm2_g': gain((L, D_MODEL)),
        'w_mix_in': nrm((L, D_MODEL, N_IN), D_MODEL ** -0.5),
        'w_mix_out': nrm((L, D_MIX, D_MODEL), D_MIX ** -0.5),
        'conv_dw': nrm((L, CONV_K, W_CONV), CONV_K ** -0.5),
        'conv_dw_b': nrm((L, W_CONV), 0.02),
        'conv_ln_g': gain((L, W_CONV)),
        'conv_ln_b': nrm((L, W_CONV), 0.02),
        'conv_pw': nrm((L, W_CONV, W_CONV), W_CONV ** -0.5),
        'pool_w': nrm((L, len(POOL_WINDOWS), POOL_CH, POOL_CH), POOL_CH ** -0.5),
        'pool_scale': gain((L, W_POOL)),
        'ssm_a_re': -0.5 + nrm((L, 2, G, P), 0.01),
        'ssm_a_im': math.pi * state_idx + nrm((L, 2, G, P), 0.01),
        'ssm_log_dt': jax.random.uniform(next(keys), (L, 2, G), jnp.float32,
                                         math.log(1e-3), math.log(1e-1)),
        'ssm_b_re': nrm((L, 2, G, P, SSM_CH), (2 * SSM_CH) ** -0.5),
        'ssm_b_im': nrm((L, 2, G, P, SSM_CH), (2 * SSM_CH) ** -0.5),
        'ssm_c_re': nrm((L, 2, G, SSM_CH, P), P ** -0.5),
        'ssm_c_im': nrm((L, 2, G, SSM_CH, P), P ** -0.5),
        'ssm_d': nrm((L, W_SSM), 0.5),
        'ssm_glu_w': nrm((L, W_SSM, W_SSM), W_SSM ** -0.5),
        'ssm_glu_b': nrm((L, W_SSM), 0.02),
        'mla_q_a_g': gain((L, MLA_Q_RANK)),
        'mla_wq_b': nrm((L, MLA_Q_RANK, MLA_HEADS * MLA_QK), MLA_Q_RANK ** -0.5),
        'mla_kv_a_g': gain((L, MLA_KV_RANK)),
        'mla_wkv_b': nrm((L, MLA_KV_RANK, MLA_HEADS * (MLA_NOPE + MLA_V)), MLA_KV_RANK ** -0.5),
        'mla_q_g': gain((L, MLA_QK)),
        'mla_k_g': gain((L, MLA_QK)),
        'router_w': nrm((L, D_MODEL, N_EXPERTS), D_MODEL ** -0.5),
        'router_b': nrm((L, N_EXPERTS), 0.01),
        'exp_w_in': nrm((L, N_EXPERTS, D_MODEL, 2 * D_EXPERT), D_MODEL ** -0.5),
        'exp_b_in': nrm((L, N_EXPERTS, 2 * D_EXPERT), 0.01),
        'exp_w_out': nrm((L, N_EXPERTS, D_EXPERT, D_MODEL), D_EXPERT ** -0.5),
        'exp_b_out': nrm((L, N_EXPERTS, D_MODEL), 0.01),
    }


def reference(x, c, ctx, c_ctx, ada_w, ada_b, norm1_g, norm2_g, w_mix_in, w_mix_out,
              conv_dw, conv_dw_b, conv_ln_g, conv_ln_b, conv_pw, pool_w, pool_scale,
              ssm_a_re, ssm_a_im, ssm_log_dt, ssm_b_re, ssm_b_im, ssm_c_re, ssm_c_im,
              ssm_d, ssm_glu_w, ssm_glu_b,
              mla_q_a_g, mla_wq_b, mla_kv_a_g, mla_wkv_b, mla_q_g, mla_k_g,
              router_w, router_b, exp_w_in, exp_b_in, exp_w_out, exp_b_out):
    bsz, n_lat, dim = x.shape
    n_ctx = ctx.shape[1]
    rows = n_lat // GRID_W
    rope = axial_rope_tables(rows, x.dtype)
    silu_c = jax.nn.silu(c)
    silu_cc = jax.nn.silu(c_ctx)
    for l in range(DEPTH):
        last = l == DEPTH - 1
        mod = (silu_c @ ada_w[l] + ada_b[l])[:, None, :]
        mod_c = silu_cc @ ada_w[l] + ada_b[l]
        sh1, sc1, g1, sh2, sc2, g2 = jnp.split(mod, 6, axis=-1)
        sh1c, sc1c, g1c, sh2c, sc2c, g2c = jnp.split(mod_c, 6, axis=-1)

        hx = rmsnorm(x, norm1_g[l]) * (1.0 + sc1) + sh1
        hc = rmsnorm(ctx, norm1_g[l]) * (1.0 + sc1c) + sh1c
        x_conv, x_pool, x_q, x_ssm, x_kv, x_kpe = jnp.split(hx @ w_mix_in[l], SPLIT_AT, axis=-1)
        if last:
            c_ssm, c_kv, c_kpe = jnp.split(hc @ w_mix_in[l][:, OFF_SSM:],
                                           (W_SSM, W_SSM + MLA_KV_RANK), axis=-1)
        else:
            c_conv, c_pool, c_q, c_ssm, c_kv, c_kpe = jnp.split(hc @ w_mix_in[l], SPLIT_AT, axis=-1)

        conv_p = (conv_dw[l], conv_dw_b[l], conv_ln_g[l], conv_ln_b[l], conv_pw[l])
        ya_x = conv_module(x_conv, *conv_p)
        yp_x = multiscale_pool(x_pool, pool_w[l], pool_scale[l])
        ys_x, ys_c = s5_mixer(x_ssm, c_ssm, ssm_a_re[l], ssm_a_im[l], ssm_log_dt[l],
                              ssm_b_re[l], ssm_b_im[l], ssm_c_re[l], ssm_c_im[l],
                              ssm_d[l], ssm_glu_w[l], ssm_glu_b[l], not last)
        qx = apply_axial_rope(mla_query(x_q, mla_q_a_g[l], mla_wq_b[l], mla_q_g[l]), rope)
        kx, vx = mla_key_value(x_kv, x_kpe, mla_kv_a_g[l], mla_wkv_b[l], mla_k_g[l])
        kx = apply_axial_rope(kx, rope)
        kc, vc = mla_key_value(c_kv, c_kpe, mla_kv_a_g[l], mla_wkv_b[l], mla_k_g[l])
        ym_x = blocked_attention(qx, jnp.concatenate([kx, kc], axis=1),
                                 jnp.concatenate([vx, vc], axis=1))
        x = x + g1 * (jnp.concatenate([ya_x, yp_x, ys_x, ym_x], axis=-1) @ w_mix_out[l])
        if not last:
            ya_c = conv_module(c_conv, *conv_p)
            yp_c = multiscale_pool(c_pool, pool_w[l], pool_scale[l])
            qc = mla_query(c_q, mla_q_a_g[l], mla_wq_b[l], mla_q_g[l])
            ym_c = attend(qc, kc, vc).reshape(bsz, n_ctx, W_MLA)
            ctx = ctx + g1c * (jnp.concatenate([ya_c, yp_c, ys_c, ym_c], axis=-1) @ w_mix_out[l])

        moe_p = (router_w[l], router_b[l], exp_w_in[l], exp_b_in[l], exp_w_out[l], exp_b_out[l])
        h2x = (rmsnorm(x, norm2_g[l]) * (1.0 + sc2) + sh2).reshape(bsz * n_lat, dim)
        if last:
            x = x + g2 * moe(h2x, *moe_p).reshape(bsz, n_lat, dim)
        else:
            h2c = (rmsnorm(ctx, norm2_g[l]) * (1.0 + sc2c) + sh2c).reshape(bsz * n_ctx, dim)
            m = moe(jnp.concatenate([h2x, h2c], axis=0), *moe_p)
            x = x + g2 * m[:bsz * n_lat].reshape(bsz, n_lat, dim)
            ctx = ctx + g2c * m[bsz * n_lat:].reshape(bsz, n_ctx, dim)
    return x
```

```cpp
#include <hip/hip_runtime.h>
#include <stdint.h>
#include <stdio.h>

#ifndef MK_ONE_LAUNCH
#define MK_ONE_LAUNCH 0
#endif

#define DI __device__ __forceinline__
#define LAS __attribute__((address_space(3)))
typedef unsigned short bf16_t;
typedef short bf16x8 __attribute__((ext_vector_type(8)));
typedef short s16x4 __attribute__((ext_vector_type(4)));
typedef float f32x4 __attribute__((ext_vector_type(4)));
typedef float f32x16 __attribute__((ext_vector_type(16)));
typedef unsigned u32x2 __attribute__((ext_vector_type(2)));
typedef unsigned u32x4 __attribute__((ext_vector_type(4)));

constexpr int D = 1024, NB = 32, SEQ = 2048, CTXL = 256;
constexpr int TX = NB * SEQ, TC = NB * CTXL, TT = TX + TC;
constexpr int NINP = 1536;
constexpr int OFF_POOL = 512, OFF_Q = 768, OFF_SSM = 960, OFF_KV = 1216, OFF_KPE = 1344, N_IN = 1376;
constexpr int NE = 32;
constexpr int NCH = 36;
constexpr int NCROW = NB * NCH;
constexpr float EPS = 1e-6f;

constexpr size_t WS_BAR = 0;
constexpr size_t WS_CNT = 16384;
constexpr size_t WS_MOD = WS_CNT + 1024;
constexpr size_t WS_A64 = WS_MOD + (size_t)2 * 33 * 6144 * 4;
constexpr size_t WS_WMI = WS_A64 + (size_t)2 * 2 * 16 * 64 * 2 * 4;
constexpr size_t WS_WMO = WS_WMI + (size_t)2 * 1536 * 1024 * 2;
constexpr size_t WS_WPW = WS_WMO + (size_t)2 * 1024 * 1024 * 2;
constexpr size_t WS_WGLU = WS_WPW + (size_t)2 * 256 * 256 * 2;
constexpr size_t WS_WPOOL = WS_WGLU + (size_t)2 * 256 * 256 * 2;
constexpr size_t WS_WQ = WS_WPOOL + (size_t)2 * 256 * 256 * 2;
constexpr size_t WS_WKV = WS_WQ + (size_t)2 * 512 * 256 * 2;
constexpr size_t WS_TS5 = WS_WKV + (size_t)2 * 512 * 256 * 2;
constexpr size_t WS_WS5 = WS_TS5 + (size_t)2 * 16 * 1024 * 1280 * 2;
constexpr size_t WS_W1 = WS_WS5 + (size_t)2 * 16 * 256 * 1024 * 2;
constexpr size_t WS_W2 = WS_W1 + (size_t)32 * 2048 * 1024 * 2;
constexpr size_t WS_X = WS_W2 + (size_t)32 * 1024 * 1024 * 2;
constexpr size_t WS_H = WS_X + (size_t)TT * 1024 * 4;
constexpr size_t WS_LIST = WS_H + (size_t)TT * 1024 * 2;
constexpr size_t WS_TOPW = WS_LIST + (size_t)32 * TT * 4;
constexpr size_t WS_RA = WS_TOPW + (size_t)TT * 4 * 4;
constexpr size_t WS_RY = WS_RA + (size_t)TT * 4 * 1024 * 2;
constexpr size_t WS_END = WS_RY + (size_t)TT * 4 * 1024 * 2;
constexpr size_t WS_P = WS_RA;
constexpr size_t WS_ACONV = WS_P + (size_t)TT * NINP * 2;
constexpr size_t WS_APOOL = WS_ACONV + (size_t)TT * 256 * 2;
constexpr size_t WS_RAWQ = WS_APOOL + (size_t)TT * 256 * 2;
constexpr size_t WS_RAWKV = WS_RAWQ + (size_t)TT * 512 * 4;
constexpr size_t WS_Q = WS_RAWKV + (size_t)TT * 512 * 4;
constexpr size_t WS_KB = WS_Q + (size_t)TT * 384 * 2;
constexpr size_t WS_VT = WS_KB + (size_t)128 * 2304 * 96 * 2;
constexpr size_t WS_SST = WS_VT + (size_t)128 * 64 * 2304 * 2;
constexpr size_t WS_HIN = WS_SST + (size_t)NCROW * 16 * 256 * 4;
constexpr size_t WS_Z = WS_HIN + (size_t)NCROW * 16 * 256 * 2;
constexpr size_t WS_CAT = WS_Z + (size_t)TT * 256 * 2;
constexpr size_t WS_MIX_END = WS_CAT + (size_t)TT * 1024 * 2;
static_assert(WS_MIX_END <= WS_END, "mixer buffers must fit in the ACT/Y regions");
static_assert(WS_END <= (size_t)2147483648ull, "workspace budget");

constexpr int LDS_BYTES = 147456;
constexpr int LDS_MISC = 146432;

struct Params {
    const float *x, *c, *ctx, *c_ctx, *ada_w, *ada_b, *norm1_g, *norm2_g, *w_mix_in, *w_mix_out,
        *conv_dw, *conv_dw_b, *conv_ln_g, *conv_ln_b, *conv_pw, *pool_w, *pool_scale,
        *ssm_a_re, *ssm_a_im, *ssm_log_dt, *ssm_b_re, *ssm_b_im, *ssm_c_re, *ssm_c_im, *ssm_d, *ssm_glu_w, *ssm_glu_b,
        *mla_q_a_g, *mla_wq_b, *mla_kv_a_g, *mla_wkv_b, *mla_q_g, *mla_k_g,
        *router_w, *router_b, *exp_w_in, *exp_b_in, *exp_w_out, *exp_b_out;
    float* out;
    char* ws;
    long long ph_lo, ph_hi;
};

typedef const __attribute__((address_space(4))) char* kaptr_t;
template <int OFF> DI unsigned long long kld64(kaptr_t ka, int tok) {
    unsigned long long v;
    asm("s_load_dwordx2 %0, %1, %3\n\ts_waitcnt lgkmcnt(0)" : "=&s"(v) : "s"(ka), "s"(tok), "n"(OFF));
    return v;
}
DI int ptoken() { int t; asm volatile("s_mov_b32 %0, 0" : "=s"(t)); return t; }
DI Params kparams(kaptr_t ka, int tok) {
    Params p;
#define KL_(f) p.f = (decltype(p.f))((__attribute__((address_space(1))) char*)kld64<__builtin_offsetof(Params, f)>(ka, tok))
    KL_(x); KL_(c); KL_(ctx); KL_(c_ctx); KL_(ada_w); KL_(ada_b); KL_(norm1_g); KL_(norm2_g); KL_(w_mix_in); KL_(w_mix_out); KL_(conv_dw); KL_(conv_dw_b); KL_(conv_ln_g); KL_(conv_ln_b); KL_(conv_pw); KL_(pool_w); KL_(pool_scale); KL_(ssm_a_re); KL_(ssm_a_im); KL_(ssm_log_dt); KL_(ssm_b_re); KL_(ssm_b_im); KL_(ssm_c_re); KL_(ssm_c_im); KL_(ssm_d); KL_(ssm_glu_w); KL_(ssm_glu_b); KL_(mla_q_a_g); KL_(mla_wq_b); KL_(mla_kv_a_g); KL_(mla_wkv_b); KL_(mla_q_g); KL_(mla_k_g); KL_(router_w); KL_(router_b); KL_(exp_w_in); KL_(exp_b_in); KL_(exp_w_out); KL_(exp_b_out); KL_(out); KL_(ws);
#undef KL_
    p.ph_lo = 0; p.ph_hi = 0;
    return p;
}

typedef __bf16 bf16v2_t __attribute__((ext_vector_type(2)));
typedef float f32v2_t __attribute__((ext_vector_type(2)));
DI unsigned pk_bf16(float lo, float hi) { const f32v2_t f = {lo, hi}; const bf16v2_t b = __builtin_convertvector(f, bf16v2_t); return __builtin_bit_cast(unsigned, b); }
DI bf16_t f2bf(float x) { return (bf16_t)(pk_bf16(x, 0.f) & 0xffffu); }
DI float bf2f(bf16_t v) { return __uint_as_float(((unsigned)v) << 16); }
DI float bflo(unsigned u) { return __uint_as_float(u << 16); }
DI float bfhi(unsigned u) { return __uint_as_float(u & 0xffff0000u); }
DI int olane() { int l = (int)__builtin_amdgcn_mbcnt_hi(~0u, __builtin_amdgcn_mbcnt_lo(~0u, 0u)); asm volatile("" : "+v"(l)); return l; }
DI float shx(float v, int o) { const int l = olane(); return __int_as_float(__builtin_amdgcn_ds_bpermute((l ^ o) << 2, __float_as_int(v))); }
DI float shi(float v, int src) { return __int_as_float(__builtin_amdgcn_ds_bpermute(src << 2, __float_as_int(v))); }
#define otid() otid_(wv_)
DI int otid_(int wv) { int t = (wv << 6) | olane(); asm volatile("" : "+v"(t)); return t; }
DI float wave_sum(float v) {
#pragma unroll
    for (int o = 32; o > 0; o >>= 1) v += shx(v, o);
    return v;
}
DI float wave_max(float v) {
#pragma unroll
    for (int o = 32; o > 0; o >>= 1) v = fmaxf(v, shx(v, o));
    return v;
}
DI float sigmoidf_(float x) { return 1.f / (1.f + __expf(-x)); }
DI float siluf_(float x) { return x * sigmoidf_(x); }
DI float gelu_tanh(float x) {
    const float u = 0.7978845608028654f * (x + 0.044715f * x * x * x);
    const float e = __expf(2.f * u);
    const float th = 1.f - 2.f / (e + 1.f);
    return 0.5f * x * (1.f + th);
}
DI void glds16(const void* src, LAS char* dst) {
    __builtin_amdgcn_global_load_lds((const __attribute__((address_space(1))) void*)src, (LAS void*)dst, 16, 0, 0);
}

#define XB_TMO      128
#define XB_XCNT(j)  (256  + 64 * (j))
#define XB_XSUB(j)  (1280 + 64 * (j))
#define XB_XGEN(j)  (2304 + 64 * (j))
#define XB_TOP      3328
#define XB_TOPGEN   3392
#define XCD_BAR_WORDS 3456
#define XB_SPIN_CAP (1u << 18)
__device__ __forceinline__ unsigned xb_ld(unsigned* p)              { return __hip_atomic_load(p, __ATOMIC_RELAXED, __HIP_MEMORY_SCOPE_AGENT); }
__device__ __forceinline__ unsigned xb_add(unsigned* p, unsigned v) { return __hip_atomic_fetch_add(p, v, __ATOMIC_RELAXED, __HIP_MEMORY_SCOPE_AGENT); }
__device__ __forceinline__ unsigned xb_xcc_id() { return (unsigned)__builtin_amdgcn_s_getreg((3 << 11) | 20) & 0xFu; }
#define XB_SPIN(cond, bar) do { unsigned _sp = 0; while (cond) { __builtin_amdgcn_s_sleep(1); \
    if ((++_sp & 255u) == 0u) { if (xb_ld(&(bar)[XB_TMO])) break; if (_sp > XB_SPIN_CAP) { atomicAdd(&(bar)[XB_TMO], 1u); break; } } } } while (0)
struct XcdBarrier { unsigned* bar; unsigned x; volatile LAS unsigned* st; };
__device__ __forceinline__ XcdBarrier xcd_barrier_post(unsigned* bar, volatile LAS unsigned* st, const int wv_) {
    XcdBarrier b; b.bar = bar; b.x = xb_xcc_id(); b.st = st;
    if (otid() == 0) (void)xb_add(&bar[XB_XCNT(b.x)], 1u);
    return b;
}
__device__ __forceinline__ void xcd_barrier_complete(unsigned* bar, unsigned x, unsigned& nloc, unsigned& nx) {
    const unsigned G = gridDim.x * gridDim.y * gridDim.z;
    unsigned sum, cnt, mine, sp = 0u;
    for (;;) {
        sum = 0u; cnt = 0u; mine = 0u;
#pragma unroll
        for (unsigned j = 0; j < 16; ++j) { const unsigned c = xb_ld(&bar[XB_XCNT(j)]); sum += c; cnt += (c > 0u) ? 1u : 0u; mine = (j == x) ? c : mine; }
        if (sum == G) break;
        __builtin_amdgcn_s_sleep(1);
        if ((++sp & 255u) == 0u) { if (xb_ld(&bar[XB_TMO])) break; if (sp > XB_SPIN_CAP) { atomicAdd(&bar[XB_TMO], 1u); break; } }
    }
    nloc = mine > 0u ? mine : 1u; nx = cnt > 0u ? cnt : 1u;
}
__device__ __forceinline__ void xcd_barrier(const XcdBarrier& b, const int wv_) {
    asm volatile("s_waitcnt vmcnt(0)" ::: "memory");
    __syncthreads();
    if (otid() == 0) {
        unsigned* bar = b.bar;
        __builtin_amdgcn_s_waitcnt(0);
        unsigned nloc = b.st[0], nx = b.st[1];
        if (nloc == 0u) { xcd_barrier_complete(bar, b.x, nloc, nx); b.st[0] = nloc; b.st[1] = nx; }
        const unsigned old = xb_add(&bar[XB_XSUB(b.x)], 1u);
        const unsigned gen = old / nloc;
        if (old + 1u == (gen + 1u) * nloc) {
            __builtin_amdgcn_fence(__ATOMIC_RELEASE, "agent");
            asm volatile("s_waitcnt vmcnt(0)" ::: "memory");
            const unsigned og = xb_add(&bar[XB_TOP], 1u);
            const unsigned tg = og / nx;
            if (og + 1u == (tg + 1u) * nx) xb_add(&bar[XB_TOPGEN], 1u);
            else XB_SPIN(xb_ld(&bar[XB_TOPGEN]) == tg, bar);
            __builtin_amdgcn_fence(__ATOMIC_ACQUIRE, "agent");
            xb_add(&bar[XB_XGEN(b.x)], 1u);
            asm volatile("s_waitcnt vmcnt(0)" ::: "memory");
        } else {
            XB_SPIN(xb_ld(&bar[XB_XGEN(b.x)]) == gen, bar);
            __builtin_amdgcn_fence(__ATOMIC_ACQUIRE, "agent");
            asm volatile("s_waitcnt vmcnt(0)" ::: "memory");
        }
    }
    __syncthreads();
}

constexpr int HTB = 128 * 64 * 2;
DI int lds_byte(int r, int c) { const int st = (r >> 4) * 2 + (c >> 5), rr = r & 15, cc = c & 31, ob = rr * 64 + cc * 2; return st * 1024 + (ob ^ (((ob >> 9) & 1) << 5)); }
DI void stage_rc(int b, int& R, int& C) { const int st = b / 1024, sb = b % 1024, swz = sb ^ (((sb >> 9) & 1) << 5); R = (st >> 1) * 16 + swz / 64; C = (st & 1) * 32 + (swz % 64) / 2; }

DI void stage_rc_t(int tz, int i, int& R, int& C) { stage_rc(tz * 16 + i * 8192, R, C); }
struct APlain {
    const char* base; int lda2;
    DI const char* ptr(int tz, int h, int i, int kt) const { int R, C; stage_rc_t(tz, i, R, C); return base + (unsigned)((h * 128 + R) * lda2 + C * 2 + kt * 128); }
};
struct ASimple {
    const char* base; unsigned off[2][2]; unsigned kstride;
    DI const char* ptr(int tz, int h, int i, int kt) const { return base + (unsigned)(off[h][i] + (unsigned)kt * kstride); }
};
struct ASeg2 {
    const char* base0; const char* base1; unsigned off0[2][2]; unsigned off1[2][2]; unsigned ks0; int nt0;
    DI const char* ptr(int tz, int h, int i, int kt) const { return kt < nt0 ? base0 + (unsigned)(off0[h][i] + (unsigned)kt * ks0) : base1 + (unsigned)(off1[h][i] + (unsigned)(kt - nt0) * 128u); }
};
struct BSimple {
    const char* base[2]; int ldb2;
    DI const char* ptr(int tz, int h, int i, int kt) const { int R, C; stage_rc_t(tz, i, R, C); return base[h] + (unsigned)(R * ldb2 + C * 2 + kt * 128); }
};

#define WAIT_V(n) asm volatile("s_waitcnt vmcnt(" #n ")" ::: "memory")
#define WAIT_L(n) asm volatile("s_waitcnt lgkmcnt(" #n ")" ::: "memory")
#define BAR_ __builtin_amdgcn_s_barrier()
#define SCHED_ __builtin_amdgcn_sched_barrier(0)

template <class AS, class BS>
DI void gemm_core(LAS char* shm, const AS& as, const BS& bs, const int nt, f32x4 (&acc)[2][2][4][2], const int wv_) {
    int tz = otid();
    int wid = tz >> 6, lane = tz & 63, wr = wid >> 2, wc = wid & 3, fr = lane & 15, fq = lane >> 4;
    bf16x8 At[4][2], B0[2][2], B1[2][2];
#define SA_(b, h) (shm + ((b) * 2 + (h)) * HTB)
#define SB_(b, h) (shm + (4 + (b) * 2 + (h)) * HTB)
#define STG_A(b, h, kt) do { _Pragma("unroll") for (int i_ = 0; i_ < 2; ++i_) glds16(as.ptr(tz, h, i_, kt), SA_(b, h) + tz * 16 + i_ * 8192); } while (0)
#define STG_B(b, h, kt) do { _Pragma("unroll") for (int i_ = 0; i_ < 2; ++i_) glds16(bs.ptr(tz, h, i_, kt), SB_(b, h) + tz * 16 + i_ * 8192); } while (0)
#define LDA_(dst, b, h) do { _Pragma("unroll") for (int m = 0; m < 4; ++m) _Pragma("unroll") for (int k = 0; k < 2; ++k) \
        dst[m][k] = *(const LAS bf16x8*)(SA_(b, h) + lds_byte(wr * 64 + m * 16 + fr, k * 32 + fq * 8)); } while (0)
#define LDB_(dst, b, h) do { _Pragma("unroll") for (int n = 0; n < 2; ++n) _Pragma("unroll") for (int k = 0; k < 2; ++k) \
        dst[n][k] = *(const LAS bf16x8*)(SB_(b, h) + lds_byte(wc * 32 + n * 16 + fr, k * 32 + fq * 8)); } while (0)
#define MMA_(ai, bj, A_, B_) do { __builtin_amdgcn_s_setprio(1); \
        _Pragma("unroll") for (int m = 0; m < 4; ++m) _Pragma("unroll") for (int n = 0; n < 2; ++n) _Pragma("unroll") for (int k = 0; k < 2; ++k) \
            acc[ai][bj][m][n] = __builtin_amdgcn_mfma_f32_16x16x32_bf16(B_[n][k], A_[m][k], acc[ai][bj][m][n], 0, 0, 0); \
        __builtin_amdgcn_s_setprio(0); } while (0)

    STG_B(0, 0, 0); STG_A(0, 0, 0); STG_B(0, 1, 0); STG_A(0, 1, 0);
    if (wr == 1) BAR_;
    WAIT_V(4); BAR_;
    STG_B(1, 0, 1); STG_A(1, 0, 1); STG_B(1, 1, 1);
    WAIT_V(6); BAR_;
    for (int t = 0; t < nt - 2; t += 2) {
        LDB_(B0, 0, 0); SCHED_; LDA_(At, 0, 0); STG_A(1, 1, t + 1);
        WAIT_L(8); BAR_; WAIT_L(0); MMA_(0, 0, At, B0); BAR_; SCHED_;
        LDB_(B1, 0, 1); STG_B(0, 0, t + 2);
        BAR_; WAIT_L(0); MMA_(0, 1, At, B1); BAR_;
        LDA_(At, 0, 1); STG_A(0, 0, t + 2);
        BAR_; WAIT_L(0); MMA_(1, 0, At, B0); BAR_; SCHED_;
        STG_B(0, 1, t + 2);
        WAIT_V(6); BAR_; MMA_(1, 1, At, B1); BAR_;
        LDB_(B0, 1, 0); SCHED_; LDA_(At, 1, 0); STG_A(0, 1, t + 2);
        WAIT_L(8); BAR_; WAIT_L(0); MMA_(0, 0, At, B0); BAR_; SCHED_;
        LDB_(B1, 1, 1); STG_B(1, 0, t + 3);
        BAR_; WAIT_L(0); MMA_(0, 1, At, B1); BAR_;
        LDA_(At, 1, 1); STG_A(1, 0, t + 3);
        BAR_; WAIT_L(0); MMA_(1, 0, At, B0); BAR_; SCHED_;
        STG_B(1, 1, t + 3);
        WAIT_V(6); BAR_; MMA_(1, 1, At, B1); BAR_;
    }
    asm volatile("" : "+v"(tz)); wid = tz >> 6; lane = tz & 63; wr = wid >> 2; wc = wid & 3; fr = lane & 15; fq = lane >> 4;
    { LDB_(B0, 0, 0); WAIT_V(0); LDA_(At, 0, 0); STG_A(1, 1, nt - 1);
      BAR_; WAIT_L(0); MMA_(0, 0, At, B0); BAR_;
      LDB_(B1, 0, 1); BAR_; WAIT_L(0); MMA_(0, 1, At, B1); BAR_;
      LDA_(At, 0, 1); WAIT_V(4); BAR_; WAIT_L(0); MMA_(1, 0, At, B0); MMA_(1, 1, At, B1); BAR_; }
    { LDB_(B0, 1, 0); LDA_(At, 1, 0); WAIT_V(2); BAR_; WAIT_L(0); MMA_(0, 0, At, B0); BAR_;
      LDB_(B1, 1, 1); WAIT_V(0); BAR_; WAIT_L(0); MMA_(0, 1, At, B1); BAR_;
      LDA_(At, 1, 1); BAR_; WAIT_L(0); MMA_(1, 0, At, B0); MMA_(1, 1, At, B1); BAR_; }
    if (wr == 0) BAR_;
#undef SA_
#undef SB_
#undef STG_A
#undef STG_B
#undef LDA_
#undef LDB_
#undef MMA_
}

DI void stage_coords(int (&R)[2], int (&C)[2], const int wv_) {
    const int t_ = otid();
#pragma unroll
    for (int i = 0; i < 2; ++i) stage_rc(t_ * 16 + i * 8192, R[i], C[i]);
}
DI void zero_acc(f32x4 (&acc)[2][2][4][2]) {
#pragma unroll
    for (int a = 0; a < 2; ++a)
#pragma unroll
        for (int b = 0; b < 2; ++b)
#pragma unroll
            for (int m = 0; m < 4; ++m)
#pragma unroll
                for (int n = 0; n < 2; ++n) acc[a][b][m][n] = (f32x4){0.f, 0.f, 0.f, 0.f};
}
DI APlain make_a_plain(const bf16_t* A, size_t row0, int lda, int col0) {
    APlain a; a.base = (const char*)(A + row0 * (size_t)lda + col0); a.lda2 = lda * 2; return a;
}
DI BSimple make_b(const bf16_t* Bt0, const bf16_t* Bt1, int ldb) {
    BSimple b; b.base[0] = (const char*)Bt0; b.base[1] = (const char*)Bt1; b.ldb2 = ldb * 2; return b;
}
#define EPI_FOR(acc, ...) do { const int _tz = otid(), _w = _tz >> 6, _l = _tz & 63, _wr = _w >> 2, _wc = _w & 3, _fr = _l & 15, _fq = _l >> 4; \
    _Pragma("unroll") for (int ai = 0; ai < 2; ++ai) _Pragma("unroll") for (int m = 0; m < 4; ++m) { const int lr = ai * 128 + _wr * 64 + m * 16 + _fr; \
    _Pragma("unroll") for (int bj = 0; bj < 2; ++bj) _Pragma("unroll") for (int n = 0; n < 2; ++n) { const int lc = bj * 128 + _wc * 32 + n * 16 + _fq * 4; const f32x4 v = acc[ai][bj][m][n]; __VA_ARGS__ } } } while (0)

DI void store_bf16x4(bf16_t* p, float a, float b, float c, float d) { u32x2 v; v.x = pk_bf16(a, b); v.y = pk_bf16(c, d); *(u32x2*)p = v; }

DI int mod_row(int r) { return r < TX ? (r >> 11) : 32; }
DI int crow_tok(int cr) { const int b = cr / NCH, j = cr - b * NCH; return j < 4 ? TX + b * CTXL + j * 64 : b * SEQ + (j - 4) * 64; }

DI void cvt_tile(LAS char* wl  , const float* src, int ld_src, int kvalid, int nvalid, const float* scale, bf16_t* dst, int ld_dst, const int wv_) {
    const int lane = otid() & 63;
    const int lr = lane >> 4, lc = (lane & 15) * 4;
    f32x4 v[16];
#pragma unroll
    for (int it = 0; it < 16; ++it) {
        const int k = it * 4 + lr;
        v[it] = (f32x4){0.f, 0.f, 0.f, 0.f};
        if (src != nullptr && k < kvalid && lc < nvalid) { v[it] = *(const f32x4*)(src + (size_t)k * ld_src + lc); if (scale) { const float s = scale[k]; v[it] *= s; } }
    }
#pragma unroll
    for (int it = 0; it < 16; ++it) {
        const int k = it * 4 + lr;
#pragma unroll
        for (int j = 0; j < 4; ++j) *(LAS bf16_t*)(wl + (lc + j) * 144 + k * 2) = f2bf(v[it][j]);
    }
    asm volatile("s_waitcnt lgkmcnt(0)" ::: "memory");
#pragma unroll
    for (int i = 0; i < 8; ++i) {
        const int q = i * 64 + lane, n = q >> 3, c = q & 7;
        const u32x4 w = *(const LAS u32x4*)(wl + n * 144 + c * 16);
        *(u32x4*)(dst + (size_t)n * ld_dst + c * 8) = w;
    }
    asm volatile("s_waitcnt lgkmcnt(0)" ::: "memory");
}
constexpr int CVT_SMALL_TILES = 768 + 512 + 32 + 32 + 64 + 64 + 32;
constexpr int CVT_EXP_TILES = 32 * (32 * 16 + 16 * 16);
DI void cvt_small(const Params& p, LAS char* wl, int t, const int wv_) {
    char* ws = p.ws;
    if (t < 768) { const int l = t / 384, r = t % 384, nt = r / 16, kt = r % 16;
        cvt_tile(wl, p.w_mix_in + (size_t)l * 1024 * N_IN + (size_t)kt * 64 * N_IN + nt * 64, N_IN, 64, N_IN - nt * 64, nullptr,
                 (bf16_t*)(ws + WS_WMI) + ((size_t)l * 1536 + nt * 64) * 1024 + kt * 64, 1024, wv_); return; }
    t -= 768;
    if (t < 512) { const int l = t / 256, r = t % 256, nt = r / 16, kt = r % 16;
        cvt_tile(wl, p.w_mix_out + (size_t)l * 1024 * 1024 + (size_t)kt * 64 * 1024 + nt * 64, 1024, 64, 64, nullptr,
                 (bf16_t*)(ws + WS_WMO) + ((size_t)l * 1024 + nt * 64) * 1024 + kt * 64, 1024, wv_); return; }
    t -= 512;
    if (t < 32) { const int l = t / 16, r = t % 16, nt = r / 4, kt = r % 4;
        cvt_tile(wl, p.conv_pw + (size_t)l * 65536 + (size_t)kt * 64 * 256 + nt * 64, 256, 64, 64, nullptr,
                 (bf16_t*)(ws + WS_WPW) + ((size_t)l * 256 + nt * 64) * 256 + kt * 64, 256, wv_); return; }
    t -= 32;
    if (t < 32) { const int l = t / 16, r = t % 16, nt = r / 4, kt = r % 4;
        cvt_tile(wl, p.ssm_glu_w + (size_t)l * 65536 + (size_t)kt * 64 * 256 + nt * 64, 256, 64, 64, nullptr,
                 (bf16_t*)(ws + WS_WGLU) + ((size_t)l * 256 + nt * 64) * 256 + kt * 64, 256, wv_); return; }
    t -= 32;
    if (t < 64) { const int l = t / 32, r = t % 32, nt = r / 4, kt = r % 4;
        const bool any = (kt < 3) && (nt < 6);
        cvt_tile(wl, any ? p.mla_wq_b + (size_t)l * 192 * 384 + (size_t)kt * 64 * 384 + nt * 64 : nullptr, 384, 64, 64, p.mla_q_a_g + l * 192 + kt * 64,
                 (bf16_t*)(ws + WS_WQ) + ((size_t)l * 512 + nt * 64) * 256 + kt * 64, 256, wv_); return; }
    t -= 64;
    if (t < 64) { const int l = t / 32, r = t % 32, nt = r / 4, kt = r % 4;
        const bool any = (kt < 2);
        cvt_tile(wl, any ? p.mla_wkv_b + (size_t)l * 128 * 512 + (size_t)kt * 64 * 512 + nt * 64 : nullptr, 512, 64, 64, p.mla_kv_a_g + l * 128 + kt * 64,
                 (bf16_t*)(ws + WS_WKV) + ((size_t)l * 512 + nt * 64) * 256 + kt * 64, 256, wv_); return; }
    t -= 64;
    { const int l = t / 16, r = t % 16, nt = r / 4, kt = r % 4;
        cvt_tile(wl, nt == kt ? p.pool_w + ((size_t)l * 4 + nt) * 4096 : nullptr, 64, 64, 64, nullptr,
                 (bf16_t*)(ws + WS_WPOOL) + ((size_t)l * 256 + nt * 64) * 256 + kt * 64, 256, wv_); }
}
DI void cvt_expert(const Params& p, LAS char* wl, int l, int t, const int wv_) {
    char* ws = p.ws;
    const int e = t / 768, r = t % 768;
    if (r < 512) { const int nt = r / 16, kt = r % 16;
        cvt_tile(wl, p.exp_w_in + ((size_t)(l * NE + e) * 1024 + kt * 64) * 2048 + nt * 64, 2048, 64, 64, nullptr,
                 (bf16_t*)(ws + WS_W1) + ((size_t)e * 2048 + nt * 64) * 1024 + kt * 64, 1024, wv_);
    } else { const int q = r - 512, nt = q / 16, kt = q % 16;
        cvt_tile(wl, p.exp_w_out + ((size_t)(l * NE + e) * 1024 + kt * 64) * 1024 + nt * 64, 1024, 64, 64, nullptr,
                 (bf16_t*)(ws + WS_W2) + ((size_t)e * 1024 + nt * 64) * 1024 + kt * 64, 1024, wv_);
    }
}

DI void ada_unit(const Params& p, LAS char* shm, int u, const int wv_) {
    const int tid = otid();
    const int l = u / 48, jc = u % 48;
    LAS float* sc = (LAS float*)shm;
    for (int i = tid; i < 33 * 1024; i += 512) { const int r = i >> 10, k = i & 1023; const float v = r < 32 ? p.c[r * 1024 + k] : p.c_ctx[k]; sc[i] = siluf_(v); }
    __syncthreads();
    const int col = tid & 127, kq = tid >> 7;
    float acc[33];
#pragma unroll
    for (int r = 0; r < 33; ++r) acc[r] = 0.f;
    const float* wp = p.ada_w + ((size_t)l * 1024 + kq * 256) * 6144 + jc * 128 + col;
    for (int k4 = 0; k4 < 256; k4 += 4) {
        float w[4];
#pragma unroll
        for (int i = 0; i < 4; ++i) w[i] = wp[(size_t)(k4 + i) * 6144];
#pragma unroll
        for (int r = 0; r < 33; ++r) { const f32x4 s = *(const LAS f32x4*)(sc + r * 1024 + kq * 256 + k4); acc[r] += s[0] * w[0] + s[1] * w[1] + s[2] * w[2] + s[3] * w[3]; }
    }
    __syncthreads();
    LAS float* red = (LAS float*)shm;
#pragma unroll
    for (int r = 0; r < 33; ++r) red[(kq * 33 + r) * 128 + col] = acc[r];
    __syncthreads();
    for (int i = tid; i < 33 * 128; i += 512) { const int r = i >> 7, cc = i & 127;
        const float s = red[(0 * 33 + r) * 128 + cc] + red[(1 * 33 + r) * 128 + cc] + red[(2 * 33 + r) * 128 + cc] + red[(3 * 33 + r) * 128 + cc];
        ((float*)(p.ws + WS_MOD))[((size_t)l * 33 + r) * 6144 + jc * 128 + cc] = s + p.ada_b[l * 6144 + jc * 128 + cc]; }
    __syncthreads();
}

DI void s5pre_unit(const Params& p, LAS char* shm, int u, const int wv_) {
    const int tid = otid();
    const int l = u >> 4, g = u & 15;
    LAS float* pw = (LAS float*)shm;
    LAS float* bb = pw + 65 * 64 * 2;
    LAS float* cc = bb + 64 * 16 * 2;
    LAS float* kk = cc + 16 * 64 * 2;
    LAS float* k0f = kk + 64 * 256;
    bf16_t* TS = (bf16_t*)(p.ws + WS_TS5) + (size_t)(l * 16 + g) * 1024 * 1280;
    bf16_t* WS = (bf16_t*)(p.ws + WS_WS5) + (size_t)(l * 16 + g) * 256 * 1024;
    for (int dir = 0; dir < 2; ++dir) {
        const int pbase = ((l * 2 + dir) * 16 + g) * 64;
        const double dt = exp((double)p.ssm_log_dt[(l * 2 + dir) * 16 + g]);
        for (int i = tid; i < 65 * 64; i += 512) { const int tau = i >> 6, q = i & 63;
            const double are = fmin((double)p.ssm_a_re[pbase + q], -1e-4), aim = (double)p.ssm_a_im[pbase + q];
            const double mg = exp(are * dt * tau), an = aim * dt * tau;
            pw[i * 2] = (float)(mg * cos(an)); pw[i * 2 + 1] = (float)(mg * sin(an)); }
        for (int i = tid; i < 64 * 16; i += 512) { const int q = i >> 4, ci = i & 15;
            const double are = fmin((double)p.ssm_a_re[pbase + q], -1e-4), aim = (double)p.ssm_a_im[pbase + q];
            const double mg = exp(are * dt), abr = mg * cos(aim * dt), abi = mg * sin(aim * dt), den = are * are + aim * aim;
            const double fre = ((abr - 1.0) * are + abi * aim) / den, fim = (abi * are - (abr - 1.0) * aim) / den;
            const double br = (double)p.ssm_b_re[(size_t)(pbase + q) * 16 + ci], bi = (double)p.ssm_b_im[(size_t)(pbase + q) * 16 + ci];
            bb[i * 2] = (float)(fre * br - fim * bi); bb[i * 2 + 1] = (float)(fre * bi + fim * br); }
        for (int i = tid; i < 16 * 64; i += 512) { const int co = i >> 6, q = i & 63;
            const size_t ix = ((size_t)((l * 2 + dir) * 16 + g) * 16 + co) * 64 + q;
            cc[i * 2] = p.ssm_c_re[ix]; cc[i * 2 + 1] = p.ssm_c_im[ix]; }
        __syncthreads();
        if (tid < 64) { float* a64 = (float*)(p.ws + WS_A64) + (size_t)(((l * 2 + dir) * 16 + g) * 64 + tid) * 2; a64[0] = pw[(64 * 64 + tid) * 2]; a64[1] = pw[(64 * 64 + tid) * 2 + 1]; }
        { const int cocip = tid & 255, co = cocip >> 4, ci = cocip & 15;
          for (int tau = (tid >> 8); tau < 64; tau += 2) {
              float s = 0.f;
              for (int q = 0; q < 64; ++q) {
                  const float pr = pw[(tau * 64 + q) * 2], pi = pw[(tau * 64 + q) * 2 + 1];
                  const float br = bb[(q * 16 + ci) * 2], bi = bb[(q * 16 + ci) * 2 + 1];
                  const float er = pr * br - pi * bi, ei = pr * bi + pi * br;
                  s += cc[(co * 64 + q) * 2] * er - cc[(co * 64 + q) * 2 + 1] * ei;
              }
              kk[tau * 256 + cocip] = s;
          } }
        for (int i = tid; i < 128 * 512; i += 512) { const int row = i >> 9, kp = (i & 511) * 2, ri = row >> 6, q = row & 63, s = kp >> 4, ci = kp & 15;
            const int e = dir == 0 ? 63 - s : s;
            const float pr = pw[(e * 64 + q) * 2], pi = pw[(e * 64 + q) * 2 + 1];
            float o[2];
#pragma unroll
            for (int j = 0; j < 2; ++j) { const float br = bb[(q * 16 + ci + j) * 2], bi = bb[(q * 16 + ci + j) * 2 + 1]; o[j] = ri == 0 ? pr * br - pi * bi : pr * bi + pi * br; }
            *(unsigned*)(WS + (size_t)(dir * 128 + row) * 1024 + kp) = pk_bf16(o[0], o[1]); }
        for (int i = tid; i < 1024 * 64; i += 512) { const int row = i >> 6, kp = (i & 63) * 2, t = row >> 4, co = row & 15, ri = kp >> 6, q = kp & 63;
            const int e = dir == 0 ? t + 1 : 64 - t;
            float o[2];
#pragma unroll
            for (int j = 0; j < 2; ++j) { const float pr = pw[(e * 64 + q + j) * 2], pi = pw[(e * 64 + q + j) * 2 + 1];
                const float cr = cc[(co * 64 + q + j) * 2], ci_ = cc[(co * 64 + q + j) * 2 + 1];
                o[j] = ri == 0 ? (cr * pr - ci_ * pi) : -(cr * pi + ci_ * pr); }
            *(unsigned*)(TS + (size_t)row * 1280 + 1024 + dir * 128 + kp) = pk_bf16(o[0], o[1]); }
        __syncthreads();
        for (int rr = tid; rr < 1024; rr += 512) { const int t = rr >> 4, co = rr & 15;
            const float dco = p.ssm_d[l * 256 + g * 16 + co];
            bf16_t* rowp = TS + (size_t)rr * 1280;
            if (dir == 0) {
                for (int s = 0; s <= t; ++s) { const int tau = t - s;
                    unsigned w[8];
#pragma unroll
                    for (int j = 0; j < 8; ++j) { float a = kk[tau * 256 + co * 16 + 2 * j], b = kk[tau * 256 + co * 16 + 2 * j + 1];
                        if (s == t) { if (2 * j == co) a += dco; if (2 * j + 1 == co) b += dco; }
                        w[j] = pk_bf16(a, b); }
                    *(u32x4*)(rowp + s * 16) = (u32x4){w[0], w[1], w[2], w[3]}; *(u32x4*)(rowp + s * 16 + 8) = (u32x4){w[4], w[5], w[6], w[7]}; }
            } else {
                for (int s = t; s < 64; ++s) { const int tau = s - t;
                    unsigned w[8];
#pragma unroll
                    for (int j = 0; j < 8; ++j) { float a = kk[tau * 256 + co * 16 + 2 * j], b = kk[tau * 256 + co * 16 + 2 * j + 1];
                        if (s == t) { a += k0f[co * 16 + 2 * j]; b += k0f[co * 16 + 2 * j + 1]; if (2 * j == co) a += dco; if (2 * j + 1 == co) b += dco; }
                        w[j] = pk_bf16(a, b); }
                    *(u32x4*)(rowp + s * 16) = (u32x4){w[0], w[1], w[2], w[3]}; *(u32x4*)(rowp + s * 16 + 8) = (u32x4){w[4], w[5], w[6], w[7]}; }
            }
        }
        __syncthreads();
        if (dir == 0) { if (tid < 256) k0f[tid] = kk[tid]; }
        __syncthreads();
    }
}

DI void phase_prologue(const Params& p, LAS char* shm, const int wv_) {
    const int tid = otid();
    if (blockIdx.x == 0 && tid < 64) ((int*)(p.ws + WS_CNT))[tid] = 0;
    const int n_cvt = (CVT_SMALL_TILES + CVT_EXP_TILES + 7) / 8;
    const int n_units = 32 + 96 + n_cvt;
    for (int u = blockIdx.x; u < n_units; u += gridDim.x) {
        if (u < 32) s5pre_unit(p, shm, u, wv_);
        else if (u < 128) ada_unit(p, shm, u - 32, wv_);
        else {
            const int t = (u - 128) * 8 + (tid >> 6);
            LAS char* wl = shm + (tid >> 6) * (64 * 144);
            if (t < CVT_SMALL_TILES) cvt_small(p, wl, t, wv_);
            else if (t < CVT_SMALL_TILES + CVT_EXP_TILES) cvt_expert(p, wl, 0, t - CVT_SMALL_TILES, wv_);
        }
    }
}

DI void norm_mod_store(const float (&v)[16], const float* g, const float* modrow  , bf16_t* hrow, const int wv_) {
    const int lane = otid() & 63;
    float ss = 0.f;
#pragma unroll
    for (int i = 0; i < 16; ++i) ss += v[i] * v[i];
    ss = wave_sum(ss);
    const float rn = rsqrtf(ss * (1.f / 1024.f) + EPS);
#pragma unroll
    for (int j = 0; j < 4; ++j) {
        const int col = j * 256 + lane * 4;
        const f32x4 gg = *(const f32x4*)(g + col), sh = *(const f32x4*)(modrow + col), sc = *(const f32x4*)(modrow + 1024 + col);
        float o[4];
#pragma unroll
        for (int i = 0; i < 4; ++i) o[i] = v[j * 4 + i] * rn * gg[i] * (1.f + sc[i]) + sh[i];
        store_bf16x4(hrow + col, o[0], o[1], o[2], o[3]);
    }
}
DI void phase_norm1_l0(const Params& p, const int wv_) {
    const int tid_ = otid(); const int wid = tid_ >> 6, lane = tid_ & 63;
    const float* MOD = (const float*)(p.ws + WS_MOD);
    bf16_t* H = (bf16_t*)(p.ws + WS_H);
    for (int r = blockIdx.x * 8 + wid; r < TT; r += gridDim.x * 8) {
        const float* src = r < TX ? p.x + (size_t)r * 1024 : p.ctx + (size_t)(r - TX) * 1024;
        float v[16];
#pragma unroll
        for (int j = 0; j < 4; ++j) { const f32x4 t = *(const f32x4*)(src + j * 256 + lane * 4); v[j * 4] = t[0]; v[j * 4 + 1] = t[1]; v[j * 4 + 2] = t[2]; v[j * 4 + 3] = t[3]; }
        norm_mod_store(v, p.norm1_g, MOD + (size_t)(0 * 33 + mod_row(r)) * 6144, H + (size_t)r * 1024, wv_);
    }
}

DI void phase_inproj(const Params& p, LAS char* shm, int l, const int wv_) {
    const bf16_t* H = (const bf16_t*)(p.ws + WS_H);
    const bf16_t* W = (const bf16_t*)(p.ws + WS_WMI) + (size_t)l * 1536 * 1024;
    bf16_t* P = (bf16_t*)(p.ws + WS_P);
    const int n_units = (TT / 256) * 6;
    for (int u = blockIdx.x; u < n_units; u += gridDim.x) {
        const int mt = u / 6, nt = u % 6;
        APlain as = make_a_plain(H, (size_t)mt * 256, 1024, 0);
        BSimple bs = make_b(W + (size_t)(nt * 256) * 1024, W + (size_t)(nt * 256 + 128) * 1024, 1024);
        f32x4 acc[2][2][4][2]; zero_acc(acc);
        gemm_core(shm, as, bs, 16, acc, wv_);
        EPI_FOR(acc, { store_bf16x4(P + (size_t)(mt * 256 + lr) * NINP + nt * 256 + lc, v[0], v[1], v[2], v[3]); });
    }
}

DI void pre_unit(const Params& p, LAS char* shm, int l, int tile, const int wv_) {
    const int tid = otid();
    const bf16_t* P = (const bf16_t*)(p.ws + WS_P);
    int row0, ts0, L;
    if (tile < 512) { row0 = tile * 128; ts0 = row0 & 2047; L = SEQ; } else { row0 = TX + (tile - 512) * 128; ts0 = (row0 - TX) & 255; L = CTXL; }
    const int c = tid & 255, half = tid >> 8;
    LAS float* cv = (LAS float*)shm;
    {
        float w[31];
#pragma unroll
        for (int j = 0; j < 31; ++j) w[j] = p.conv_dw[((size_t)l * 31 + j) * 256 + c];
        const float bias = p.conv_dw_b[l * 256 + c];
        for (int blk = 0; blk < 4; ++blk) {
            const int t0 = half * 64 + blk * 16;
            float in[46];
#pragma unroll
            for (int i = 0; i < 46; ++i) {
                const int ts = ts0 + t0 - 15 + i;
                float u = 0.f;
                if (ts >= 0 && ts < L) { const bf16_t* pr = P + (size_t)(row0 + t0 - 15 + i) * NINP; const float val = bf2f(pr[c]), gate = bf2f(pr[256 + c]); u = val * sigmoidf_(gate); }
                in[i] = u;
            }
#pragma unroll
            for (int o = 0; o < 16; ++o) { float s = bias;
#pragma unroll
                for (int j = 0; j < 31; ++j) s += w[j] * in[o + j];
                cv[(t0 + o) * 257 + c] = s; }
        }
    }
    __syncthreads();
    {
        const int wid = tid >> 6, lane = tid & 63;
        bf16_t* AC = (bf16_t*)(p.ws + WS_ACONV);
        for (int t = wid; t < 128; t += 8) {
            float x[4]; float s = 0.f;
#pragma unroll
            for (int j = 0; j < 4; ++j) { x[j] = cv[t * 257 + lane + 64 * j]; s += x[j]; }
            const float mu = wave_sum(s) * (1.f / 256.f);
            float q = 0.f;
#pragma unroll
            for (int j = 0; j < 4; ++j) { x[j] -= mu; q += x[j] * x[j]; }
            const float rs = rsqrtf(wave_sum(q) * (1.f / 256.f) + EPS);
#pragma unroll
            for (int j = 0; j < 4; ++j) { const int ch = lane + 64 * j; const float y = x[j] * rs * p.conv_ln_g[l * 256 + ch] + p.conv_ln_b[l * 256 + ch];
                AC[(size_t)(row0 + t) * 256 + ch] = f2bf(siluf_(y)); }
        }
    }
    {
        bf16_t* AP = (bf16_t*)(p.ws + WS_APOOL);
        const int g = c >> 6, win = 2 << g;
        for (int t = half * 64; t < half * 64 + 64; ++t) {
            const int ts = ts0 + t;
            const int lo = max(ts - win / 2, 0), hi = min(ts + win - 1 - win / 2, L - 1);
            float s = 0.f;
            for (int q = lo; q <= hi; ++q) s += bf2f(P[(size_t)(row0 + t + (q - ts)) * NINP + OFF_POOL + c]);
            const float self = bf2f(P[(size_t)(row0 + t) * NINP + OFF_POOL + c]);
            AP[(size_t)(row0 + t) * 256 + c] = f2bf(s / (float)(hi - lo + 1) - self);
        }
    }
    __syncthreads();
}
DI void phase_A(const Params& p, LAS char* shm, int l, const int wv_) {
    const bf16_t* P = (const bf16_t*)(p.ws + WS_P);
    const int n_s5 = 16 * 5, n_q = 288 * 2, n_kv = 288 * 2, n_pre = 576;
    const int n_units = n_s5 + n_q + n_kv + n_pre;
    for (int u = blockIdx.x; u < n_units; u += gridDim.x) {
        if (u < n_s5) {
            const int g = u / 5, mt = u % 5;
            int R[2], C[2]; stage_coords(R, C, wv_);
            ASimple as; as.base = (const char*)P; as.kstride = 4 * NINP * 2;
#pragma unroll
            for (int h = 0; h < 2; ++h)
#pragma unroll
                for (int i = 0; i < 2; ++i) { const int cr = min(mt * 256 + h * 128 + R[i], NCROW - 1);
                    as.off[h][i] = (unsigned)(((size_t)(crow_tok(cr) + (C[i] >> 4)) * NINP + OFF_SSM + g * 16 + (C[i] & 15)) * 2); }
            const bf16_t* W = (const bf16_t*)(p.ws + WS_WS5) + (size_t)(l * 16 + g) * 256 * 1024;
            BSimple bs = make_b(W, W + (size_t)128 * 1024, 1024);
            f32x4 acc[2][2][4][2]; zero_acc(acc);
            gemm_core(shm, as, bs, 16, acc, wv_);
            float* SST = (float*)(p.ws + WS_SST);
            EPI_FOR(acc, { const int cr = mt * 256 + lr; if (cr < NCROW) *(f32x4*)(SST + ((size_t)cr * 16 + g) * 256 + lc) = v; });
        } else if (u < n_s5 + n_q + n_kv) {
            const int v_ = u - n_s5; const bool isq = v_ < n_q; const int w_ = isq ? v_ : v_ - n_q;
            const int mt = w_ >> 1, nt = w_ & 1;
            APlain as = make_a_plain(P, (size_t)mt * 256, NINP, isq ? OFF_Q : OFF_KV);
            const bf16_t* W = (const bf16_t*)(p.ws + (isq ? WS_WQ : WS_WKV)) + (size_t)l * 512 * 256 + (size_t)nt * 256 * 256;
            BSimple bs = make_b(W, W + (size_t)128 * 256, 256);
            f32x4 acc[2][2][4][2]; zero_acc(acc);
            gemm_core(shm, as, bs, 4, acc, wv_);
            float* RAW = (float*)(p.ws + (isq ? WS_RAWQ : WS_RAWKV));
            EPI_FOR(acc, { *(f32x4*)(RAW + (size_t)(mt * 256 + lr) * 512 + nt * 256 + lc) = v; });
        } else {
            pre_unit(p, shm, l, u - (n_s5 + n_q + n_kv), wv_);
        }
    }
}

DI void qkvpost_unit(const Params& p, LAS char* shm, int l, int unit, const int wv_) {
    const int tid = otid(), wid = tid >> 6, lane = tid & 63;
    const bf16_t* P = (const bf16_t*)(p.ws + WS_P);
    const float* RAWQ = (const float*)(p.ws + WS_RAWQ);
    const float* RAWKV = (const float*)(p.ws + WS_RAWKV);
    bf16_t* Q = (bf16_t*)(p.ws + WS_Q);
    bf16_t* KB = (bf16_t*)(p.ws + WS_KB);
    bf16_t* VT = (bf16_t*)(p.ws + WS_VT);
    LAS bf16_t* vt = (LAS bf16_t*)shm;
    const int row0 = unit * 64;
    const bool lat = row0 < TX;
    const int b = lat ? (row0 >> 11) : ((row0 - TX) >> 8);
    const int key0 = lat ? (row0 & 2047) : 2048 + ((row0 - TX) & 255);
    const int head = lane >> 4, sub = lane & 15;
    const float lninv = -9.210340371976184f / 8.f;
    for (int tk = wid * 8; tk < wid * 8 + 8; ++tk) {
        const int r = row0 + tk;
        const bf16_t* pr = P + (size_t)r * NINP;
        float sq = 0.f, skv = 0.f;
#pragma unroll
        for (int j = 0; j < 3; ++j) { const float a = bf2f(pr[OFF_Q + lane + 64 * j]); sq += a * a; }
#pragma unroll
        for (int j = 0; j < 2; ++j) { const float a = bf2f(pr[OFF_KV + lane + 64 * j]); skv += a * a; }
        sq = wave_sum(sq); skv = wave_sum(skv);
        const float rq = rsqrtf(sq * (1.f / 192.f) + EPS), rkv = rsqrtf(skv * (1.f / 128.f) + EPS);
        float cs[2], sn[2];
        { const int tseq = r & 2047; const float fr_ = __expf(lninv * (float)(sub & 7));
          const float a0 = (float)(tseq >> 6) * fr_, a1 = (float)(tseq & 63) * fr_;
          cs[0] = cosf(a0); sn[0] = sinf(a0); cs[1] = cosf(a1); sn[1] = sinf(a1); }
        {
            float q[6]; float ss = 0.f;
#pragma unroll
            for (int j = 0; j < 6; ++j) { q[j] = RAWQ[(size_t)r * 512 + head * 96 + sub + 16 * j] * rq; ss += q[j] * q[j]; }
#pragma unroll
            for (int o = 8; o > 0; o >>= 1) ss += shx(ss, o);
            const float rn = rsqrtf(ss * (1.f / 96.f) + EPS);
#pragma unroll
            for (int j = 0; j < 6; ++j) q[j] = q[j] * rn * p.mla_q_g[l * 96 + sub + 16 * j];
            if (lat) {
#pragma unroll
                for (int j = 4; j < 6; ++j) { const float other = shx(q[j], 8);
                    q[j] = (sub < 8) ? q[j] * cs[j - 4] - other * sn[j - 4] : q[j] * cs[j - 4] + other * sn[j - 4]; }
            }
#pragma unroll
            for (int j = 0; j < 6; ++j) Q[(size_t)r * 384 + head * 96 + sub + 16 * j] = f2bf(q[j]);
        }
        {
            float k[6]; float ss = 0.f;
#pragma unroll
            for (int j = 0; j < 4; ++j) { k[j] = RAWKV[(size_t)r * 512 + head * 128 + sub + 16 * j] * rkv; ss += k[j] * k[j]; }
#pragma unroll
            for (int j = 4; j < 6; ++j) { k[j] = bf2f(pr[OFF_KPE + sub + 16 * (j - 4)]); ss += k[j] * k[j]; }
#pragma unroll
            for (int o = 8; o > 0; o >>= 1) ss += shx(ss, o);
            const float rn = rsqrtf(ss * (1.f / 96.f) + EPS);
#pragma unroll
            for (int j = 0; j < 6; ++j) k[j] = k[j] * rn * p.mla_k_g[l * 96 + sub + 16 * j];
            if (lat) {
#pragma unroll
                for (int j = 4; j < 6; ++j) { const float other = shx(k[j], 8);
                    k[j] = (sub < 8) ? k[j] * cs[j - 4] - other * sn[j - 4] : k[j] * cs[j - 4] + other * sn[j - 4]; }
            }
            bf16_t* kr = KB + ((size_t)(b * 4 + head) * 2304 + key0 + tk) * 96;
#pragma unroll
            for (int j = 0; j < 6; ++j) kr[sub + 16 * j] = f2bf(k[j]);
        }
#pragma unroll
        for (int j = 0; j < 4; ++j) { const float v = RAWKV[(size_t)r * 512 + head * 128 + 64 + sub + 16 * j] * rkv; vt[(head * 64 + sub + 16 * j) * 72 + tk] = f2bf(v); }
    }
    __syncthreads();
    { const int hv = tid >> 1, hf = tid & 1;
      bf16_t* dst = VT + ((size_t)(b * 4 + (hv >> 6)) * 64 + (hv & 63)) * 2304 + key0 + hf * 32;
#pragma unroll
      for (int i = 0; i < 4; ++i) *(u32x4*)(dst + i * 8) = *(const LAS u32x4*)(vt + hv * 72 + hf * 32 + i * 8); }
    __syncthreads();
}
DI void s5carry_unit(const Params& p, int l, int unit, const int wv_) {
    const int gid = unit * 512 + otid();
    const int q = gid & 63, dir = (gid >> 6) & 1, g = (gid >> 7) & 15, b = gid >> 11;
    const float* A64 = (const float*)(p.ws + WS_A64) + (size_t)(((l * 2 + dir) * 16 + g) * 64 + q) * 2;
    const float ar = A64[0], ai = A64[1];
    const float* SST = (const float*)(p.ws + WS_SST);
    bf16_t* HIN = (bf16_t*)(p.ws + WS_HIN);
    float hr = 0.f, hi = 0.f;
    for (int s = 0; s < NCH; ++s) {
        const int j = dir == 0 ? s : (s < 4 ? 3 - s : 39 - s);
        const size_t base = ((size_t)(b * NCH + j) * 16 + g) * 256 + dir * 128 + q;
        HIN[base] = f2bf(hr); HIN[base + 64] = f2bf(hi);
        const float sr = SST[base], si = SST[base + 64];
        const float nr = ar * hr - ai * hi + sr, ni = ar * hi + ai * hr + si;
        hr = nr; hi = ni;
    }
}
DI void phase_B(const Params& p, LAS char* shm, int l, const int wv_) {
    const int n_g = 288 * 2, n_post = TT / 64, n_carry = 128;
    const int n_units = n_g + n_post + n_carry;
    for (int u = blockIdx.x; u < n_units; u += gridDim.x) {
        if (u < n_g) {
            const bool isconv = u < 288; const int mt = isconv ? u : u - 288;
            const bf16_t* A = (const bf16_t*)(p.ws + (isconv ? WS_ACONV : WS_APOOL));
            const bf16_t* W = (const bf16_t*)(p.ws + (isconv ? WS_WPW : WS_WPOOL)) + (size_t)l * 65536;
            APlain as = make_a_plain(A, (size_t)mt * 256, 256, 0);
            BSimple bs = make_b(W, W + (size_t)128 * 256, 256);
            f32x4 acc[2][2][4][2]; zero_acc(acc);
            gemm_core(shm, as, bs, 4, acc, wv_);
            bf16_t* CAT = (bf16_t*)(p.ws + WS_CAT);
            if (isconv) { EPI_FOR(acc, { store_bf16x4(CAT + (size_t)(mt * 256 + lr) * 1024 + lc, v[0], v[1], v[2], v[3]); }); }
            else { EPI_FOR(acc, { const f32x4 s = *(const f32x4*)(p.pool_scale + l * 256 + lc);
                                  store_bf16x4(CAT + (size_t)(mt * 256 + lr) * 1024 + 256 + lc, v[0] * s[0], v[1] * s[1], v[2] * s[2], v[3] * s[3]); }); }
        } else if (u < n_g + n_post) qkvpost_unit(p, shm, l, u - n_g, wv_);
        else s5carry_unit(p, l, u - n_g - n_post, wv_);
    }
}

DI void attn_unit(const Params& p, LAS char* shm, int l, int b, int h, int qrow0, int nq, int key_lo, int nkeys, const int wv_) {
    const int tid = otid(), wid = tid >> 6, lane = tid & 63, l31 = lane & 31, hh = lane >> 5;
    const bf16_t* Q = (const bf16_t*)(p.ws + WS_Q);
    const bf16_t* KBp = (const bf16_t*)(p.ws + WS_KB) + (size_t)(b * 4 + h) * 2304 * 96;
    const bf16_t* VTp = (const bf16_t*)(p.ws + WS_VT) + (size_t)(b * 4 + h) * 64 * 2304;
    bf16_t* CAT = (bf16_t*)(p.ws + WS_CAT);
    LAS char* kl = shm;
    LAS char* vl = shm + 13312;
    const bool active = wid * 64 < nq;
    float gq = 0.f, gk = 0.f;
    for (int i = lane; i < 96; i += 64) { gq = fmaxf(gq, fabsf(p.mla_q_g[l * 96 + i])); gk = fmaxf(gk, fabsf(p.mla_k_g[l * 96 + i])); }
    gq = wave_max(gq); gk = wave_max(gk);
    const float LOG2E = 1.4426950408889634f;
    const float sc2 = 0.10206207261596575f * LOG2E;
    const float c2 = 9.797958971132712f * gq * gk * LOG2E;
    bf16x8 qf[2][6];
    if (active) {
#pragma unroll
        for (int qb = 0; qb < 2; ++qb)
#pragma unroll
            for (int ks = 0; ks < 6; ++ks) qf[qb][ks] = *(const bf16x8*)(Q + (size_t)(qrow0 + wid * 64 + qb * 32 + l31) * 384 + h * 96 + ks * 16 + hh * 8);
    }
    f32x16 O[2][2];
#pragma unroll
    for (int a = 0; a < 2; ++a)
#pragma unroll
        for (int c = 0; c < 2; ++c)
#pragma unroll
            for (int i = 0; i < 16; ++i) O[a][c][i] = 0.f;
    float lsum[2] = {0.f, 0.f};
    const int ntile = nkeys / 64;
    u32x4 kreg0, kreg1, vreg;
    auto load_tile = [&](int t) {
        const int key = key_lo + t * 64;
        { const int id = tid, kr = id / 12, part = id % 12; kreg0 = *(const u32x4*)(KBp + (size_t)(key + kr) * 96 + part * 8); }
        if (tid < 256) { const int id = tid + 512, kr = id / 12, part = id % 12; kreg1 = *(const u32x4*)(KBp + (size_t)(key + kr) * 96 + part * 8); }
        { const int vd = tid >> 3, part = tid & 7; vreg = *(const u32x4*)(VTp + (size_t)vd * 2304 + key + part * 8); }
    };
    auto write_tile = [&]() {
        { const int id = tid, kr = id / 12, part = id % 12; *(LAS u32x4*)(kl + kr * 208 + part * 16) = kreg0; }
        if (tid < 256) { const int id = tid + 512, kr = id / 12, part = id % 12; *(LAS u32x4*)(kl + kr * 208 + part * 16) = kreg1; }
        { const int vd = tid >> 3, part = tid & 7; *(LAS u32x4*)(vl + vd * 144 + part * 16) = vreg; }
    };
    load_tile(0);
    for (int t = 0; t < ntile; ++t) {
        __syncthreads();
        write_tile();
        __syncthreads();
        if (t + 1 < ntile) load_tile(t + 1);
        if (active) {
#pragma unroll
            for (int kb = 0; kb < 2; ++kb) {
                f32x16 S[2];
#pragma unroll
                for (int qb = 0; qb < 2; ++qb)
#pragma unroll
                    for (int i = 0; i < 16; ++i) S[qb][i] = 0.f;
#pragma unroll
                for (int ks = 0; ks < 6; ++ks) {
                    const bf16x8 a = *(const LAS bf16x8*)(kl + (kb * 32 + l31) * 208 + ks * 32 + hh * 16);
#pragma unroll
                    for (int qb = 0; qb < 2; ++qb) S[qb] = __builtin_amdgcn_mfma_f32_32x32x16_bf16(a, qf[qb][ks], S[qb], 0, 0, 0);
                }
                bf16x8 pf[2][2];
#pragma unroll
                for (int qb = 0; qb < 2; ++qb) {
                    float e[16];
#pragma unroll
                    for (int i = 0; i < 16; ++i) { e[i] = exp2f(S[qb][i] * sc2 - c2); lsum[qb] += e[i]; }
#pragma unroll
                    for (int s = 0; s < 2; ++s) { u32x4 w; w.x = pk_bf16(e[8 * s], e[8 * s + 1]); w.y = pk_bf16(e[8 * s + 2], e[8 * s + 3]); w.z = pk_bf16(e[8 * s + 4], e[8 * s + 5]); w.w = pk_bf16(e[8 * s + 6], e[8 * s + 7]);
                        pf[qb][s] = __builtin_bit_cast(bf16x8, w); }
                }
#pragma unroll
                for (int s = 0; s < 2; ++s) {
                    const int kk = kb * 2 + s;
#pragma unroll
                    for (int vb = 0; vb < 2; ++vb) {
                        const s16x4 lo = *(const LAS s16x4*)(vl + (vb * 32 + l31) * 144 + (16 * kk + 4 * hh) * 2);
                        const s16x4 hi = *(const LAS s16x4*)(vl + (vb * 32 + l31) * 144 + (16 * kk + 8 + 4 * hh) * 2);
                        const bf16x8 va = __builtin_shufflevector(lo, hi, 0, 1, 2, 3, 4, 5, 6, 7);
#pragma unroll
                        for (int qb = 0; qb < 2; ++qb) O[vb][qb] = __builtin_amdgcn_mfma_f32_32x32x16_bf16(va, pf[qb][s], O[vb][qb], 0, 0, 0);
                    }
                }
            }
        }
    }
    if (active) {
#pragma unroll
        for (int qb = 0; qb < 2; ++qb) {
            const float tot = lsum[qb] + shx(lsum[qb], 32);
            const float inv = 1.f / tot;
            bf16_t* orow = CAT + (size_t)(qrow0 + wid * 64 + qb * 32 + l31) * 1024 + 768 + h * 64;
#pragma unroll
            for (int vb = 0; vb < 2; ++vb)
#pragma unroll
                for (int i4 = 0; i4 < 4; ++i4)
                    store_bf16x4(orow + vb * 32 + 8 * i4 + 4 * hh, O[vb][qb][4 * i4] * inv, O[vb][qb][4 * i4 + 1] * inv, O[vb][qb][4 * i4 + 2] * inv, O[vb][qb][4 * i4 + 3] * inv);
        }
    }
    __syncthreads();
}
DI void phase_C(const Params& p, LAS char* shm, int l, const int wv_) {
    const int n_ax = 512, n_s5 = 16 * 5 * 4, n_ac = (l == 0) ? 128 : 0;
    const int n_units = n_ax + n_s5 + n_ac;
    for (int u = blockIdx.x; u < n_units; u += gridDim.x) {
        if (u < n_ax) { const int qb = u & 3, h = (u >> 2) & 3, b = u >> 4;
            attn_unit(p, shm, l, b, h, b * SEQ + qb * 512, 512, 0, 2304, wv_);
        } else if (u < n_ax + n_s5) {
            const int v_ = u - n_ax; const int ntile = v_ & 3, mt = (v_ >> 2) % 5, g = v_ / 20;
            int R[2], C[2]; stage_coords(R, C, wv_);
            ASeg2 as; as.base0 = (const char*)(p.ws + WS_P); as.base1 = (const char*)(p.ws + WS_HIN); as.ks0 = 4 * NINP * 2; as.nt0 = 16;
#pragma unroll
            for (int h = 0; h < 2; ++h)
#pragma unroll
                for (int i = 0; i < 2; ++i) { const int cr = min(mt * 256 + h * 128 + R[i], NCROW - 1);
                    as.off0[h][i] = (unsigned)(((size_t)(crow_tok(cr) + (C[i] >> 4)) * NINP + OFF_SSM + g * 16 + (C[i] & 15)) * 2);
                    as.off1[h][i] = (unsigned)((((size_t)cr * 16 + g) * 256 + C[i]) * 2); }
            const bf16_t* W = (const bf16_t*)(p.ws + WS_TS5) + ((size_t)(l * 16 + g) * 1024 + ntile * 256) * 1280;
            BSimple bs = make_b(W, W + (size_t)128 * 1280, 1280);
            f32x4 acc[2][2][4][2]; zero_acc(acc);
            gemm_core(shm, as, bs, 20, acc, wv_);
            bf16_t* Z = (bf16_t*)(p.ws + WS_Z);
            EPI_FOR(acc, { const int cr = mt * 256 + lr; if (cr < NCROW) { const int col = ntile * 256 + lc, t = col >> 4, co = col & 15;
                store_bf16x4(Z + (size_t)(crow_tok(cr) + t) * 256 + g * 16 + co, gelu_tanh(v[0]), gelu_tanh(v[1]), gelu_tanh(v[2]), gelu_tanh(v[3])); } });
        } else { const int v_ = u - n_ax - n_s5; const int h = v_ & 3, b = v_ >> 2;
            attn_unit(p, shm, l, b, h, TX + b * CTXL, 256, 2048, 256, wv_);
        }
    }
}

DI void phase_D(const Params& p, LAS char* shm, int l, const int wv_) {
    const bf16_t* Z = (const bf16_t*)(p.ws + WS_Z);
    const bf16_t* W = (const bf16_t*)(p.ws + WS_WGLU) + (size_t)l * 65536;
    bf16_t* CAT = (bf16_t*)(p.ws + WS_CAT);
    for (int u = blockIdx.x; u < 288; u += gridDim.x) {
        APlain as = make_a_plain(Z, (size_t)u * 256, 256, 0);
        BSimple bs = make_b(W, W + (size_t)128 * 256, 256);
        f32x4 acc[2][2][4][2]; zero_acc(acc);
        gemm_core(shm, as, bs, 4, acc, wv_);
        EPI_FOR(acc, { const size_t r = (size_t)(u * 256 + lr); const f32x4 bsv = *(const f32x4*)(p.ssm_glu_b + l * 256 + lc);
            const u32x2 zz = *(const u32x2*)(Z + r * 256 + lc);
            const float z0 = bflo(zz.x), z1 = bfhi(zz.x), z2 = bflo(zz.y), z3 = bfhi(zz.y);
            store_bf16x4(CAT + r * 1024 + 512 + lc, z0 * sigmoidf_(v[0] + bsv[0]), z1 * sigmoidf_(v[1] + bsv[1]), z2 * sigmoidf_(v[2] + bsv[2]), z3 * sigmoidf_(v[3] + bsv[3])); });
    }
}

DI void phase_E(const Params& p, LAS char* shm, int l, const int wv_) {
    const bf16_t* CAT = (const bf16_t*)(p.ws + WS_CAT);
    const bf16_t* W = (const bf16_t*)(p.ws + WS_WMO) + (size_t)l * 1024 * 1024;
    float* X = (float*)(p.ws + WS_X);
    const float* MOD = (const float*)(p.ws + WS_MOD) + (size_t)l * 33 * 6144;
    const int rows = (l == 1) ? TX : TT;
    const int n_units = (rows / 256) * 4;
    for (int u = blockIdx.x; u < n_units; u += gridDim.x) {
        const int mt = u >> 2, nt = u & 3;
        APlain as = make_a_plain(CAT, (size_t)mt * 256, 1024, 0);
        BSimple bs = make_b(W + (size_t)(nt * 256) * 1024, W + (size_t)(nt * 256 + 128) * 1024, 1024);
        f32x4 acc[2][2][4][2]; zero_acc(acc);
        gemm_core(shm, as, bs, 16, acc, wv_);
        EPI_FOR(acc, { const int r = mt * 256 + lr; const int col = nt * 256 + lc;
            const float* xo = (l == 0) ? (r < TX ? p.x + (size_t)r * 1024 : p.ctx + (size_t)(r - TX) * 1024) : X + (size_t)r * 1024;
            const f32x4 xv = *(const f32x4*)(xo + col); const f32x4 g1 = *(const f32x4*)(MOD + (size_t)mod_row(r) * 6144 + 2048 + col);
            *(f32x4*)(X + (size_t)r * 1024 + col) = xv + g1 * v; });
    }
}

DI void phase_router(const Params& p, LAS char* shm, int l, const int wv_) {
    const int tid = otid(), wid = tid >> 6, lane = tid & 63;
    const int Tm = (l == 1) ? TX : TT;
    const float* X = (const float*)(p.ws + WS_X);
    const float* MOD = (const float*)(p.ws + WS_MOD) + (size_t)l * 33 * 6144;
    bf16_t* H = (bf16_t*)(p.ws + WS_H);
    int* CNT = (int*)(p.ws + WS_CNT) + l * 32;
    int* LIST = (int*)(p.ws + WS_LIST);
    float* TOPW = (float*)(p.ws + WS_TOPW);
    LAS float* wl = (LAS float*)shm;
    LAS int* lcnt = (LAS int*)(shm + 131072);
    LAS int* lbase = lcnt + 32;
    LAS unsigned* lrec = (LAS unsigned*)(lbase + 32);
    for (int i = tid; i < 1024 * 8; i += 512) { const int k = i >> 3, gq = i & 7;
        *(LAS f32x4*)(wl + k * 32 + ((gq ^ ((k >> 1) & 7)) << 2)) = *(const f32x4*)(p.router_w + (size_t)l * 32768 + k * 32 + gq * 4); }
    const int tpw = (Tm + gridDim.x - 1) / gridDim.x;
    const int tbeg = blockIdx.x * tpw, tend = min(tbeg + tpw, Tm);
    for (int c0 = tbeg; c0 < tend; c0 += 256) {
        const int c1 = min(c0 + 256, tend);
        if (tid < 32) lcnt[tid] = 0;
        __syncthreads();
        for (int t = c0 + wid; t < c1; t += 8) {
            float v[16]; float ss = 0.f;
#pragma unroll
            for (int j = 0; j < 16; ++j) { v[j] = X[(size_t)t * 1024 + lane + 64 * j]; ss += v[j] * v[j]; }
            ss = wave_sum(ss);
            const float rn = rsqrtf(ss * (1.f / 1024.f) + EPS);
            const float* mr = MOD + (size_t)mod_row(t) * 6144;
#pragma unroll
            for (int j = 0; j < 16; ++j) { const int k = lane + 64 * j; v[j] = v[j] * rn * p.norm2_g[l * 1024 + k] * (1.f + mr[4096 + k]) + mr[3072 + k]; H[(size_t)t * 1024 + k] = f2bf(v[j]); }
            float lg[32];
#pragma unroll
            for (int e = 0; e < 32; ++e) lg[e] = 0.f;
#pragma unroll
            for (int j = 0; j < 16; ++j) { const int k = lane + 64 * j; const int sw = (k >> 1) & 7;
#pragma unroll
                for (int gq = 0; gq < 8; ++gq) { const f32x4 w = *(const LAS f32x4*)(wl + k * 32 + ((gq ^ sw) << 2));
                    lg[gq * 4] += v[j] * w[0]; lg[gq * 4 + 1] += v[j] * w[1]; lg[gq * 4 + 2] += v[j] * w[2]; lg[gq * 4 + 3] += v[j] * w[3]; } }
            float r16[16];
            { const bool up = (lane & 32) != 0;
#pragma unroll
              for (int i = 0; i < 16; ++i) { const float send = up ? lg[i] : lg[i + 16]; const float keep = up ? lg[i + 16] : lg[i]; r16[i] = keep + shx(send, 32); } }
            float r8[8];
            { const bool up = (lane & 16) != 0;
#pragma unroll
              for (int i = 0; i < 8; ++i) { const float send = up ? r16[i] : r16[i + 8]; const float keep = up ? r16[i + 8] : r16[i]; r8[i] = keep + shx(send, 16); } }
            float r4[4];
            { const bool up = (lane & 8) != 0;
#pragma unroll
              for (int i = 0; i < 4; ++i) { const float send = up ? r8[i] : r8[i + 4]; const float keep = up ? r8[i + 4] : r8[i]; r4[i] = keep + shx(send, 8); } }
            float r2[2];
            { const bool up = (lane & 4) != 0;
#pragma unroll
              for (int i = 0; i < 2; ++i) { const float send = up ? r4[i] : r4[i + 2]; const float keep = up ? r4[i + 2] : r4[i]; r2[i] = keep + shx(send, 4); } }
            float r1;
            { const bool up = (lane & 2) != 0; const float send = up ? r2[0] : r2[1]; const float keep = up ? r2[1] : r2[0]; r1 = keep + shx(send, 2); }
            r1 += shx(r1, 1);
            int e = lane >> 1; asm volatile("" : "+v"(e));
            float logit = r1 + p.router_b[l * 32 + e];
            logit = fminf(fmaxf(logit, -1e30f), 1e30f);
            int rank = 0;
#pragma unroll
            for (int j = 0; j < 32; ++j) { const float o = shi(logit, 2 * j); rank += (o > logit || (o == logit && j < e)) ? 1 : 0; }
            const float mx = wave_max(logit);
            const bool sel = rank < 4;
            const float ex = sel ? __expf(logit - mx) : 0.f;
            const float den = wave_sum(ex) * 0.5f;
            if (sel && (lane & 1) == 0) {
                const int slot = t * 4 + rank;
                TOPW[slot] = ex / den;
                const int pos = atomicAdd((int*)&lcnt[e], 1);
                lrec[(t - c0) * 4 + rank] = (unsigned)e | ((unsigned)pos << 8);
            }
        }
        __syncthreads();
        if (tid < 32) lbase[tid] = atomicAdd(&CNT[tid], lcnt[tid]);
        __syncthreads();
        for (int i = tid; i < (c1 - c0) * 4; i += 512) { const unsigned rec = lrec[i]; const int e = rec & 255, pos = rec >> 8;
            LIST[(size_t)e * TT + lbase[e] + pos] = (c0 * 4) + i; }
        __syncthreads();
    }
}

DI void moe_tiles(const Params& p, LAS int* tstart, int l, const int wv_) {
    const int* CNT = (const int*)(p.ws + WS_CNT) + l * 32;
    if (otid() == 0) { int s = 0; for (int e = 0; e < 32; ++e) { tstart[e] = s; s += (CNT[e] + 255) >> 8; } tstart[32] = s; }
    __syncthreads();
}
DI int moe_find(const LAS int* tstart, int mt) { int e = 0;
#pragma unroll
    for (int i = 1; i < 32; ++i) e += (mt >= tstart[i]) ? 1 : 0;
    return e; }
DI void phase_moe1(const Params& p, LAS char* shm, int l, const int wv_) {
    LAS int* tstart = (LAS int*)(shm + LDS_MISC + 64);
    moe_tiles(p, tstart, l, wv_);
    const int* CNT = (const int*)(p.ws + WS_CNT) + l * 32;
    const int* LIST = (const int*)(p.ws + WS_LIST);
    const bf16_t* H = (const bf16_t*)(p.ws + WS_H);
    bf16_t* ACT = (bf16_t*)(p.ws + WS_RA);
    const int n_units = tstart[32] * 8;
    for (int u = blockIdx.x; u < n_units; u += gridDim.x) {
        const int mt = u >> 3, n8 = u & 7;
        const int e = moe_find(tstart, mt);
        const int r0 = (mt - tstart[e]) * 256, cnt = CNT[e];
        const int* lst = LIST + (size_t)e * TT;
        int R[2], C[2]; stage_coords(R, C, wv_);
        ASimple as; as.base = (const char*)H; as.kstride = 128;
#pragma unroll
        for (int h = 0; h < 2; ++h)
#pragma unroll
            for (int i = 0; i < 2; ++i) { const int slot = lst[min(r0 + h * 128 + R[i], cnt - 1)]; as.off[h][i] = (unsigned)(((size_t)(slot >> 2) * 1024 + C[i]) * 2); }
        const bf16_t* W = (const bf16_t*)(p.ws + WS_W1) + (size_t)e * 2048 * 1024;
        BSimple bs = make_b(W + (size_t)(n8 * 128) * 1024, W + (size_t)(1024 + n8 * 128) * 1024, 1024);
        f32x4 acc[2][2][4][2]; zero_acc(acc);
        gemm_core(shm, as, bs, 16, acc, wv_);
        { const int _tz = otid(), _w = _tz >> 6, _l = _tz & 63, _wr = _w >> 2, _wc = _w & 3, _fr = _l & 15, _fq = _l >> 4;
          const float* bin = p.exp_b_in + (size_t)(l * NE + e) * 2048;
#pragma unroll
          for (int ai = 0; ai < 2; ++ai)
#pragma unroll
              for (int m = 0; m < 4; ++m) { const int lr = r0 + ai * 128 + _wr * 64 + m * 16 + _fr;
                  if (lr < cnt) { const int slot = lst[lr]; bf16_t* orow = ACT + (size_t)slot * 1024 + n8 * 128;
#pragma unroll
                      for (int n = 0; n < 2; ++n) { const int lc = _wc * 32 + n * 16 + _fq * 4;
                          const f32x4 bg = *(const f32x4*)(bin + n8 * 128 + lc), bu = *(const f32x4*)(bin + 1024 + n8 * 128 + lc);
                          float o[4];
#pragma unroll
                          for (int r = 0; r < 4; ++r) { const float gate = fminf(acc[ai][0][m][n][r] + bg[r], 7.f); const float up = fminf(fmaxf(acc[ai][1][m][n][r] + bu[r], -7.f), 7.f);
                              o[r] = (up + 1.f) * gate * sigmoidf_(1.702f * gate); }
                          store_bf16x4(orow + lc, o[0], o[1], o[2], o[3]); } } } }
    }
}
DI void phase_moe2(const Params& p, LAS char* shm, int l, const int wv_) {
    LAS int* tstart = (LAS int*)(shm + LDS_MISC + 64);
    moe_tiles(p, tstart, l, wv_);
    const int* CNT = (const int*)(p.ws + WS_CNT) + l * 32;
    const int* LIST = (const int*)(p.ws + WS_LIST);
    const float* TOPW = (const float*)(p.ws + WS_TOPW);
    const bf16_t* ACT = (const bf16_t*)(p.ws + WS_RA);
    bf16_t* Y = (bf16_t*)(p.ws + WS_RY);
    const int n_units = tstart[32] * 4;
    for (int u = blockIdx.x; u < n_units; u += gridDim.x) {
        const int mt = u >> 2, n4 = u & 3;
        const int e = moe_find(tstart, mt);
        const int r0 = (mt - tstart[e]) * 256, cnt = CNT[e];
        const int* lst = LIST + (size_t)e * TT;
        int R[2], C[2]; stage_coords(R, C, wv_);
        ASimple as; as.base = (const char*)ACT; as.kstride = 128;
#pragma unroll
        for (int h = 0; h < 2; ++h)
#pragma unroll
            for (int i = 0; i < 2; ++i) { const int slot = lst[min(r0 + h * 128 + R[i], cnt - 1)]; as.off[h][i] = (unsigned)(((size_t)slot * 1024 + C[i]) * 2); }
        const bf16_t* W = (const bf16_t*)(p.ws + WS_W2) + (size_t)e * 1024 * 1024;
        BSimple bs = make_b(W + (size_t)(n4 * 256) * 1024, W + (size_t)(n4 * 256 + 128) * 1024, 1024);
        f32x4 acc[2][2][4][2]; zero_acc(acc);
        gemm_core(shm, as, bs, 16, acc, wv_);
        { const int _tz = otid(), _w = _tz >> 6, _l = _tz & 63, _wr = _w >> 2, _wc = _w & 3, _fr = _l & 15, _fq = _l >> 4;
          const float* bo = p.exp_b_out + (size_t)(l * NE + e) * 1024 + n4 * 256;
#pragma unroll
          for (int ai = 0; ai < 2; ++ai)
#pragma unroll
              for (int m = 0; m < 4; ++m) { const int lr = r0 + ai * 128 + _wr * 64 + m * 16 + _fr;
                  if (lr < cnt) { const int slot = lst[lr]; const float w = TOPW[slot]; bf16_t* orow = Y + (size_t)slot * 1024 + n4 * 256;
#pragma unroll
                      for (int bj = 0; bj < 2; ++bj)
#pragma unroll
                          for (int n = 0; n < 2; ++n) { const int lc = bj * 128 + _wc * 32 + n * 16 + _fq * 4; const f32x4 bv = *(const f32x4*)(bo + lc); const f32x4 v = acc[ai][bj][m][n];
                              store_bf16x4(orow + lc, (v[0] + bv[0]) * w, (v[1] + bv[1]) * w, (v[2] + bv[2]) * w, (v[3] + bv[3]) * w); } } } }
    }
}

DI void phase_combine(const Params& p, LAS char* shm, int l, const int wv_) {
    const int tid = otid(), wid = tid >> 6, lane = tid & 63;
    float* X = (float*)(p.ws + WS_X);
    const bf16_t* Y = (const bf16_t*)(p.ws + WS_RY);
    const float* MOD = (const float*)(p.ws + WS_MOD);
    bf16_t* H = (bf16_t*)(p.ws + WS_H);
    const int Tm = (l == 1) ? TX : TT;
    for (int r = blockIdx.x * 8 + wid; r < Tm; r += gridDim.x * 8) {
        const float* g2 = MOD + (size_t)(l * 33 + mod_row(r)) * 6144 + 5120;
        float v[16];
#pragma unroll
        for (int j = 0; j < 4; ++j) {
            const int col = j * 256 + lane * 4;
            f32x4 s = (f32x4){0.f, 0.f, 0.f, 0.f};
#pragma unroll
            for (int k = 0; k < 4; ++k) { const u32x2 yy = *(const u32x2*)(Y + ((size_t)r * 4 + k) * 1024 + col); s[0] += bflo(yy.x); s[1] += bfhi(yy.x); s[2] += bflo(yy.y); s[3] += bfhi(yy.y); }
            const f32x4 xv = *(const f32x4*)(X + (size_t)r * 1024 + col), gg = *(const f32x4*)(g2 + col);
            const f32x4 o = xv + gg * s;
            if (l == 1) *(f32x4*)(p.out + (size_t)r * 1024 + col) = o; else *(f32x4*)(X + (size_t)r * 1024 + col) = o;
            v[j * 4] = o[0]; v[j * 4 + 1] = o[1]; v[j * 4 + 2] = o[2]; v[j * 4 + 3] = o[3];
        }
        if (l == 0) norm_mod_store(v, p.norm1_g + 1024, MOD + (size_t)(1 * 33 + mod_row(r)) * 6144, H + (size_t)r * 1024, wv_);
    }
    if (l == 0) {
        __syncthreads();
        const int n_cvt = CVT_EXP_TILES / 8;
        for (int u = blockIdx.x; u < n_cvt; u += gridDim.x) cvt_expert(p, shm + wid * (64 * 144), 1, u * 8 + wid, wv_);
    }
}

constexpr int NPH_LAYER = 10;
constexpr int NPH = 2 + 2 * NPH_LAYER;

__global__ void __launch_bounds__(512, 2) mk_forward(Params p_unused) {
    extern __shared__ __attribute__((aligned(16))) char smem_raw[];
    LAS char* shm = (LAS char*)smem_raw;
    volatile LAS unsigned* xb_words = (volatile LAS unsigned*)(shm + LDS_MISC);
    const int wv_ = __builtin_amdgcn_readfirstlane((int)(threadIdx.x >> 6));
    if (wv_ == 0 && olane() < 4) xb_words[olane()] = 0u;
    __syncthreads();
    kaptr_t ka = (kaptr_t)__builtin_amdgcn_kernarg_segment_ptr();
    const int tok0 = ptoken();
    const int lo = (int)kld64<__builtin_offsetof(Params, ph_lo)>(ka, tok0), hi = (int)kld64<__builtin_offsetof(Params, ph_hi)>(ka, tok0);
    const bool multi = (hi - lo) > 1;
    unsigned* barw = (unsigned*)((__attribute__((address_space(1))) char*)kld64<__builtin_offsetof(Params, ws)>(ka, tok0) + WS_BAR);
    XcdBarrier bar; bar.bar = barw; bar.x = 0; bar.st = xb_words;
    if (multi) bar = xcd_barrier_post(barw, xb_words, wv_);
#ifndef ONLY_KIND
#define ONLY_KIND (-1)
#endif
#define PHASE(idx, kind, FN, ...) do { if ((ONLY_KIND < 0 || ONLY_KIND == (kind)) && (idx) >= lo && (idx) < hi) { const Params p = kparams(ka, ptoken()); FN(p, ##__VA_ARGS__, wv_); if ((idx) + 1 < hi) xcd_barrier(bar, wv_); } } while (0)
    PHASE(0, 0, phase_prologue, shm);
    PHASE(1, 1, phase_norm1_l0);
    for (int l = 0; l < 2; ++l) {
        const int b0 = 2 + l * NPH_LAYER;
        PHASE(b0 + 0, 2, phase_inproj, shm, l);
        PHASE(b0 + 1, 3, phase_A, shm, l);
        PHASE(b0 + 2, 4, phase_B, shm, l);
        PHASE(b0 + 3, 5, phase_C, shm, l);
        PHASE(b0 + 4, 6, phase_D, shm, l);
        PHASE(b0 + 5, 7, phase_E, shm, l);
        PHASE(b0 + 6, 8, phase_router, shm, l);
        PHASE(b0 + 7, 9, phase_moe1, shm, l);
        PHASE(b0 + 8, 10, phase_moe2, shm, l);
        PHASE(b0 + 9, 11, phase_combine, shm, l);
    }
#undef PHASE
}


extern "C" void kernel_launch(void* const* d_in, const int* in_sizes, int n_in, void* d_out, int out_size, void* d_ws, size_t ws_size, hipStream_t stream) {
    static int grid = 0;
    if (grid == 0) {
        if (n_in != 39 || ws_size < WS_END) { fprintf(stderr, "kernel_launch: unexpected n_in %d or ws_size %zu (< %zu)\n", n_in, ws_size, (size_t)WS_END); grid = -1; return; }
        int dev = 0, cus = 0;
        if (hipGetDevice(&dev) != hipSuccess || hipDeviceGetAttribute(&cus, hipDeviceAttributeMultiprocessorCount, dev) != hipSuccess) { grid = -1; return; }
        if (hipFuncSetAttribute((const void*)mk_forward, hipFuncAttributeMaxDynamicSharedMemorySize, LDS_BYTES) != hipSuccess) { fprintf(stderr, "kernel_launch: hipFuncSetAttribute failed\n"); grid = -1; return; }
        int per_cu = 0;
        if (hipOccupancyMaxActiveBlocksPerMultiprocessor(&per_cu, (const void*)mk_forward, 512, LDS_BYTES) != hipSuccess || per_cu < 1) fprintf(stderr, "kernel_launch: occupancy query says %d\n", per_cu);
        (void)hipGetLastError();
        grid = cus;
    }
    if (grid < 0) return;
    (void)hipMemsetAsync((char*)d_ws + WS_BAR, 0, 16384 + 1024, stream);
    Params p{};
    const float** pf = (const float**)&p;
    for (int i = 0; i < 39; ++i) pf[i] = (const float*)d_in[i];
    p.out = (float*)d_out; p.ws = (char*)d_ws;
#if MK_ONE_LAUNCH
    p.ph_lo = 0; p.ph_hi = NPH;
    hipLaunchKernelGGL(mk_forward, dim3(grid), dim3(512), LDS_BYTES, stream, p);
#else
#ifndef MK_LAST_PHASE
#define MK_LAST_PHASE NPH
#endif
    for (int ph = 0; ph < MK_LAST_PHASE; ++ph) { p.ph_lo = ph; p.ph_hi = ph + 1; hipLaunchKernelGGL(mk_forward, dim3(grid), dim3(512), LDS_BYTES, stream, p); }
#endif
}
```

```cpp
#include <hip/hip_runtime.h>
#include <stdint.h>
#include <stdio.h>

#ifndef MK_REPEAT_MASK
#define MK_REPEAT_MASK 0x0
#endif
#ifndef MK_ONE_LAUNCH
#define MK_ONE_LAUNCH 1
#endif

#define DI __device__ __forceinline__
#define LAS __attribute__((address_space(3)))
typedef unsigned short bf16_t;
typedef short bf16x8 __attribute__((ext_vector_type(8)));
typedef short s16x4 __attribute__((ext_vector_type(4)));
typedef float f32x4 __attribute__((ext_vector_type(4)));
typedef float f32x16 __attribute__((ext_vector_type(16)));
typedef unsigned u32x2 __attribute__((ext_vector_type(2)));
typedef unsigned u32x4 __attribute__((ext_vector_type(4)));
typedef int i32x4 __attribute__((ext_vector_type(4)));
typedef int i32x8 __attribute__((ext_vector_type(8)));

constexpr int D = 1024, NB = 32, SEQ = 2048, CTXL = 256;
constexpr int TX = NB * SEQ, TC = NB * CTXL, TT = TX + TC;
constexpr int NINP = 1536;
constexpr int OFF_POOL = 512, OFF_Q = 768, OFF_SSM = 960, OFF_KV = 1216, OFF_KPE = 1344, N_IN = 1376;
constexpr int NE = 32;
constexpr int NCH = 36;
constexpr int NCROW = NB * NCH;
constexpr float EPS = 1e-6f;

constexpr size_t WS_BAR = 0;
constexpr size_t WS_CNT = 16384;
constexpr size_t WS_MOD = WS_CNT + 1024;
constexpr size_t WS_A64 = WS_MOD + (size_t)2 * 33 * 6144 * 4;
constexpr size_t WS_WMI = WS_A64 + (size_t)2 * 2 * 16 * 64 * 2 * 4;
constexpr size_t WS_WMO = WS_WMI + (size_t)2 * 1536 * 1024 * 2;
constexpr size_t WS_WPW = WS_WMO + (size_t)2 * 1024 * 1024 * 2;
constexpr size_t WS_WGLU = WS_WPW + (size_t)2 * 256 * 256 * 2;
constexpr size_t WS_WPOOL = WS_WGLU + (size_t)2 * 256 * 256 * 2;
constexpr size_t WS_WQ = WS_WPOOL + (size_t)2 * 256 * 256 * 2;
constexpr size_t WS_WKV = WS_WQ + (size_t)2 * 512 * 256 * 2;
constexpr size_t WS_TS5 = WS_WKV + (size_t)2 * 512 * 256 * 2;
constexpr size_t WS_WS5 = WS_TS5 + (size_t)2 * 16 * 1024 * 1280 * 2;
constexpr size_t WS_W1 = WS_WS5 + (size_t)2 * 16 * 256 * 1024 * 2;
constexpr size_t WS_W2 = WS_W1 + (size_t)32 * 2048 * 1024 * 2;
constexpr size_t WS_X = WS_W2 + (size_t)32 * 1024 * 1024 * 2;
constexpr size_t WS_H = WS_X + (size_t)TT * 1024 * 4;
constexpr size_t WS_LIST = WS_H + (size_t)TT * 1024 * 2;
constexpr size_t WS_TOPW = WS_LIST + (size_t)32 * TT * 8;
constexpr size_t WS_RA = WS_TOPW + (size_t)TT * 4 * 4;
constexpr size_t WS_RY = WS_RA + (size_t)TT * 4 * 1024 * 2;
constexpr size_t WS_END = WS_RY + (size_t)TT * 4 * 1024 * 2;
constexpr size_t WS_P = WS_RA;
constexpr size_t WS_ACONV = WS_P + (size_t)TT * NINP * 2;
constexpr size_t WS_APOOL = WS_ACONV + (size_t)TT * 256 * 2;
constexpr size_t WS_RAWQ = WS_APOOL + (size_t)TT * 256 * 2;
constexpr size_t WS_RAWKV = WS_RAWQ + (size_t)TT * 512 * 4;
constexpr size_t WS_Q = WS_RAWKV + (size_t)TT * 512 * 4;
constexpr size_t WS_KB = WS_Q + (size_t)TT * 384 * 2;
constexpr size_t WS_VT = WS_KB + (size_t)128 * 2304 * 96 * 2;
constexpr size_t WS_SST = WS_VT + (size_t)128 * 64 * 2304 * 2;
constexpr size_t WS_HIN = WS_SST + (size_t)NCROW * 16 * 256 * 4;
constexpr size_t WS_Z = WS_HIN + (size_t)NCROW * 16 * 256 * 2;
constexpr size_t WS_CAT = WS_Z + (size_t)TT * 256 * 2;
constexpr size_t WS_MIX_END = WS_CAT + (size_t)TT * 1024 * 2;
static_assert(WS_MIX_END <= WS_END, "mixer buffers must fit in the ACT/Y regions");
static_assert(WS_END <= (size_t)2147483648ull, "workspace budget");

constexpr int LDS_BYTES = 147456;
constexpr int LDS_MISC = 146432;

struct Params {
    const float *x, *c, *ctx, *c_ctx, *ada_w, *ada_b, *norm1_g, *norm2_g, *w_mix_in, *w_mix_out,
        *conv_dw, *conv_dw_b, *conv_ln_g, *conv_ln_b, *conv_pw, *pool_w, *pool_scale,
        *ssm_a_re, *ssm_a_im, *ssm_log_dt, *ssm_b_re, *ssm_b_im, *ssm_c_re, *ssm_c_im, *ssm_d, *ssm_glu_w, *ssm_glu_b,
        *mla_q_a_g, *mla_wq_b, *mla_kv_a_g, *mla_wkv_b, *mla_q_g, *mla_k_g,
        *router_w, *router_b, *exp_w_in, *exp_b_in, *exp_w_out, *exp_b_out;
    float* out;
    char* ws;
    long long ph_lo, ph_hi;
};

typedef const __attribute__((address_space(4))) char* kaptr_t;
template <int OFF> DI unsigned long long kld64(kaptr_t ka, int tok) {
    unsigned long long v;
    asm("s_load_dwordx2 %0, %1, %3\n\ts_waitcnt lgkmcnt(0)" : "=&s"(v) : "s"(ka), "s"(tok), "n"(OFF));
    return v;
}
DI int ptoken() { int t; asm volatile("s_mov_b32 %0, 0" : "=s"(t)); return t; }
DI Params kparams(kaptr_t ka, int tok) {
    Params p;
#define KL_(f) p.f = (decltype(p.f))((__attribute__((address_space(1))) char*)kld64<__builtin_offsetof(Params, f)>(ka, tok))
    KL_(x); KL_(c); KL_(ctx); KL_(c_ctx); KL_(ada_w); KL_(ada_b); KL_(norm1_g); KL_(norm2_g); KL_(w_mix_in); KL_(w_mix_out); KL_(conv_dw); KL_(conv_dw_b); KL_(conv_ln_g); KL_(conv_ln_b); KL_(conv_pw); KL_(pool_w); KL_(pool_scale); KL_(ssm_a_re); KL_(ssm_a_im); KL_(ssm_log_dt); KL_(ssm_b_re); KL_(ssm_b_im); KL_(ssm_c_re); KL_(ssm_c_im); KL_(ssm_d); KL_(ssm_glu_w); KL_(ssm_glu_b); KL_(mla_q_a_g); KL_(mla_wq_b); KL_(mla_kv_a_g); KL_(mla_wkv_b); KL_(mla_q_g); KL_(mla_k_g); KL_(router_w); KL_(router_b); KL_(exp_w_in); KL_(exp_b_in); KL_(exp_w_out); KL_(exp_b_out); KL_(out); KL_(ws);
#undef KL_
    p.ph_lo = 0; p.ph_hi = 0;
    return p;
}

typedef __bf16 bf16v2_t __attribute__((ext_vector_type(2)));
typedef float f32v2_t __attribute__((ext_vector_type(2)));
DI unsigned pk_bf16(float lo, float hi) { const f32v2_t f = {lo, hi}; const bf16v2_t b = __builtin_convertvector(f, bf16v2_t); return __builtin_bit_cast(unsigned, b); }
DI bf16_t f2bf(float x) { return (bf16_t)(pk_bf16(x, 0.f) & 0xffffu); }
DI float bf2f(bf16_t v) { return __uint_as_float(((unsigned)v) << 16); }
DI unsigned f2fp8(float x) { x = fminf(fmaxf(x, -448.f), 448.f); return (unsigned)__builtin_amdgcn_cvt_pk_fp8_f32(x, x, 0, false) & 0xffu; }
DI unsigned pk_fp8x4(float a, float b, float c, float d) { return f2fp8(a) | (f2fp8(b) << 8) | (f2fp8(c) << 16) | (f2fp8(d) << 24); }
DI float bflo(unsigned u) { return __uint_as_float(u << 16); }
DI float bfhi(unsigned u) { return __uint_as_float(u & 0xffff0000u); }
DI int olane() { int l = (int)__builtin_amdgcn_mbcnt_hi(~0u, __builtin_amdgcn_mbcnt_lo(~0u, 0u)); asm volatile("" : "+v"(l)); return l; }
DI float shx(float v, int o) { const int l = olane(); return __int_as_float(__builtin_amdgcn_ds_bpermute((l ^ o) << 2, __float_as_int(v))); }
DI float shi(float v, int src) { return __int_as_float(__builtin_amdgcn_ds_bpermute(src << 2, __float_as_int(v))); }
#define otid() otid_(wv_)
DI int otid_(int wv) { int t = (wv << 6) | olane(); asm volatile("" : "+v"(t)); return t; }
DI float wave_sum(float v) {
#pragma unroll
    for (int o = 32; o > 0; o >>= 1) v += shx(v, o);
    return v;
}
DI float wave_max(float v) {
#pragma unroll
    for (int o = 32; o > 0; o >>= 1) v = fmaxf(v, shx(v, o));
    return v;
}
DI float sigmoidf_(float x) { return 1.f / (1.f + __expf(-x)); }
DI float siluf_(float x) { return x * sigmoidf_(x); }
DI float gelu_tanh(float x) {
    const float u = 0.7978845608028654f * (x + 0.044715f * x * x * x);
    const float e = __expf(2.f * u);
    const float th = 1.f - 2.f / (e + 1.f);
    return 0.5f * x * (1.f + th);
}
DI void glds16(const void* src, LAS char* dst) {
    __builtin_amdgcn_global_load_lds((const __attribute__((address_space(1))) void*)src, (LAS void*)dst, 16, 0, 0);
}

#define XB_TMO      128
#define XB_XCNT(j)  (256  + 64 * (j))
#define XB_XSUB(j)  (1280 + 64 * (j))
#define XB_XGEN(j)  (2304 + 64 * (j))
#define XB_TOP      3328
#define XB_TOPGEN   3392
#define XCD_BAR_WORDS 3456
#define XB_SPIN_CAP (1u << 18)
__device__ __forceinline__ unsigned xb_ld(unsigned* p)              { return __hip_atomic_load(p, __ATOMIC_RELAXED, __HIP_MEMORY_SCOPE_AGENT); }
__device__ __forceinline__ unsigned xb_add(unsigned* p, unsigned v) { return __hip_atomic_fetch_add(p, v, __ATOMIC_RELAXED, __HIP_MEMORY_SCOPE_AGENT); }
__device__ __forceinline__ unsigned xb_xcc_id() { return (unsigned)__builtin_amdgcn_s_getreg((3 << 11) | 20) & 0xFu; }
#define XB_SPIN(cond, bar) do { unsigned _sp = 0; while (cond) { __builtin_amdgcn_s_sleep(1); \
    if ((++_sp & 255u) == 0u) { if (xb_ld(&(bar)[XB_TMO])) break; if (_sp > XB_SPIN_CAP) { atomicAdd(&(bar)[XB_TMO], 1u); break; } } } } while (0)
struct XcdBarrier { unsigned* bar; unsigned x; volatile LAS unsigned* st; };
__device__ __forceinline__ XcdBarrier xcd_barrier_post(unsigned* bar, volatile LAS unsigned* st, const int wv_) {
    XcdBarrier b; b.bar = bar; b.x = xb_xcc_id(); b.st = st;
    if (otid() == 0) (void)xb_add(&bar[XB_XCNT(b.x)], 1u);
    return b;
}
__device__ __forceinline__ void xcd_barrier_complete(unsigned* bar, unsigned x, unsigned& nloc, unsigned& nx) {
    const unsigned G = gridDim.x * gridDim.y * gridDim.z;
    unsigned sum, cnt, mine, sp = 0u;
    for (;;) {
        sum = 0u; cnt = 0u; mine = 0u;
#pragma unroll
        for (unsigned j = 0; j < 16; ++j) { const unsigned c = xb_ld(&bar[XB_XCNT(j)]); sum += c; cnt += (c > 0u) ? 1u : 0u; mine = (j == x) ? c : mine; }
        if (sum == G) break;
        __builtin_amdgcn_s_sleep(1);
        if ((++sp & 255u) == 0u) { if (xb_ld(&bar[XB_TMO])) break; if (sp > XB_SPIN_CAP) { atomicAdd(&bar[XB_TMO], 1u); break; } }
    }
    nloc = mine > 0u ? mine : 1u; nx = cnt > 0u ? cnt : 1u;
}
__device__ __forceinline__ void xcd_barrier(const XcdBarrier& b, const int wv_) {
    asm volatile("s_waitcnt vmcnt(0)" ::: "memory");
    __syncthreads();
    if (otid() == 0) {
        unsigned* bar = b.bar;
        __builtin_amdgcn_s_waitcnt(0);
        unsigned nloc = b.st[0], nx = b.st[1];
        if (nloc == 0u) { xcd_barrier_complete(bar, b.x, nloc, nx); b.st[0] = nloc; b.st[1] = nx; }
        const unsigned old = xb_add(&bar[XB_XSUB(b.x)], 1u);
        const unsigned gen = old / nloc;
        if (old + 1u == (gen + 1u) * nloc) {
            __builtin_amdgcn_fence(__ATOMIC_RELEASE, "agent");
            asm volatile("s_waitcnt vmcnt(0)" ::: "memory");
            const unsigned og = xb_add(&bar[XB_TOP], 1u);
            const unsigned tg = og / nx;
            if (og + 1u == (tg + 1u) * nx) xb_add(&bar[XB_TOPGEN], 1u);
            else XB_SPIN(xb_ld(&bar[XB_TOPGEN]) == tg, bar);
            __builtin_amdgcn_fence(__ATOMIC_ACQUIRE, "agent");
            xb_add(&bar[XB_XGEN(b.x)], 1u);
            asm volatile("s_waitcnt vmcnt(0)" ::: "memory");
        } else {
            XB_SPIN(xb_ld(&bar[XB_XGEN(b.x)]) == gen, bar);
            __builtin_amdgcn_fence(__ATOMIC_ACQUIRE, "agent");
            asm volatile("s_waitcnt vmcnt(0)" ::: "memory");
        }
    }
    __syncthreads();
}

constexpr int HTB = 128 * 64 * 2;
DI int lds_byte(int r, int c) { const int st = (r >> 4) * 2 + (c >> 5), rr = r & 15, cc = c & 31, ob = rr * 64 + cc * 2; return st * 1024 + (ob ^ (((ob >> 9) & 1) << 5)); }
DI void stage_rc(int b, int& R, int& C) { const int st = b / 1024, sb = b % 1024, swz = sb ^ (((sb >> 9) & 1) << 5); R = (st >> 1) * 16 + swz / 64; C = (st & 1) * 32 + (swz % 64) / 2; }

DI void stage_rc_t(int tz, int i, int& R, int& C) { stage_rc(tz * 16 + i * 8192, R, C); }
struct APlain {
    const char* base; int lda2;
    DI void park(LAS unsigned*) const {} DI void unpark(const LAS unsigned*) {} DI void take_uniform(const APlain&) {}
    DI const char* ptr(int tz, int h, int i, int kt) const { int R, C; stage_rc_t(tz, i, R, C); return base + (unsigned)((h * 128 + R) * lda2 + C * 2 + kt * 128); }
};
struct ASimple {
    const char* base; unsigned off[2][2]; unsigned kstride;
    DI void park(LAS unsigned* q) const { *(LAS u32x4*)q = (u32x4){off[0][0], off[0][1], off[1][0], off[1][1]}; }
    DI void unpark(const LAS unsigned* q) { const u32x4 v = *(const LAS u32x4*)q; off[0][0] = v.x; off[0][1] = v.y; off[1][0] = v.z; off[1][1] = v.w; }
    DI void take_uniform(const ASimple& o) { base = o.base; kstride = o.kstride; }
    DI const char* ptr(int tz, int h, int i, int kt) const { return base + (unsigned)(off[h][i] + (unsigned)kt * kstride); }
};
struct ASeg2 {
    const char* base0; const char* base1; unsigned off0[2][2]; unsigned off1[2][2]; unsigned ks0; int nt0;
    DI void park(LAS unsigned*) const {} DI void unpark(const LAS unsigned*) {} DI void take_uniform(const ASeg2&) {}
    DI const char* ptr(int tz, int h, int i, int kt) const { return kt < nt0 ? base0 + (unsigned)(off0[h][i] + (unsigned)kt * ks0) : base1 + (unsigned)(off1[h][i] + (unsigned)(kt - nt0) * 128u); }
};
struct BSimple {
    const char* base[2]; int ldb2;
    DI const char* ptr(int tz, int h, int i, int kt) const { int R, C; stage_rc_t(tz, i, R, C); return base[h] + (unsigned)(R * ldb2 + C * 2 + kt * 128); }
};

#define WAIT_V(n) asm volatile("s_waitcnt vmcnt(" #n ")" ::: "memory")
#define WAIT_L(n) asm volatile("s_waitcnt lgkmcnt(" #n ")" ::: "memory")
#define BAR_ __builtin_amdgcn_s_barrier()
#define SCHED_ __builtin_amdgcn_sched_barrier(0)

DI void zero_acc(f32x4 (&acc)[2][2][4][2]) {
#pragma unroll
    for (int a = 0; a < 2; ++a)
#pragma unroll
        for (int b = 0; b < 2; ++b)
#pragma unroll
            for (int m = 0; m < 4; ++m)
#pragma unroll
                for (int n = 0; n < 2; ++n) acc[a][b][m][n] = (f32x4){0.f, 0.f, 0.f, 0.f};
}
template <int MODE> struct FragT;
template <> struct FragT<0> {
    i32x4 lo, hi;
    DI void load(const LAS char* p0, const LAS char* p1) { lo = *(const LAS i32x4*)p0; hi = *(const LAS i32x4*)p1; }
    static DI f32x4 mma(const FragT& b, const FragT& a, f32x4 c) {
        c = __builtin_amdgcn_mfma_f32_16x16x32_bf16(__builtin_bit_cast(bf16x8, b.lo), __builtin_bit_cast(bf16x8, a.lo), c, 0, 0, 0);
        return __builtin_amdgcn_mfma_f32_16x16x32_bf16(__builtin_bit_cast(bf16x8, b.hi), __builtin_bit_cast(bf16x8, a.hi), c, 0, 0, 0); }
};
template <> struct FragT<1> {
    i32x4 lo, hi;
    DI void load(const LAS char* p0, const LAS char* p1) { lo = *(const LAS i32x4*)p0; hi = *(const LAS i32x4*)p1; }
    static DI long pk(int x, int y) { return (long)(((unsigned long long)(unsigned)y << 32) | (unsigned)x); }
    static DI f32x4 mma(const FragT& b, const FragT& a, f32x4 c) {
        c = __builtin_amdgcn_mfma_f32_16x16x32_fp8_fp8(pk(b.lo.x, b.lo.y), pk(a.lo.x, a.lo.y), c, 0, 0, 0);
        c = __builtin_amdgcn_mfma_f32_16x16x32_fp8_fp8(pk(b.lo.z, b.lo.w), pk(a.lo.z, a.lo.w), c, 0, 0, 0);
        c = __builtin_amdgcn_mfma_f32_16x16x32_fp8_fp8(pk(b.hi.x, b.hi.y), pk(a.hi.x, a.hi.y), c, 0, 0, 0);
        return __builtin_amdgcn_mfma_f32_16x16x32_fp8_fp8(pk(b.hi.z, b.hi.w), pk(a.hi.z, a.hi.w), c, 0, 0, 0); }
};
template <> struct FragT<2> {
    i32x8 v;
    DI void load(const LAS char* p0, const LAS char* p1) { const i32x4 lo = *(const LAS i32x4*)p0, hi = *(const LAS i32x4*)p1; v = __builtin_shufflevector(lo, hi, 0, 1, 2, 3, 4, 5, 6, 7); }
    static DI f32x4 mma(const FragT& b, const FragT& a, f32x4 c) {
        const int one = 0x7f7f7f7f;
        asm volatile("v_mfma_scale_f32_16x16x128_f8f6f4 %0, %1, %2, %0, %3, %3 op_sel_hi:[0,0,0]" : "+v"(c) : "v"(b.v), "v"(a.v), "v"(one));
        return c; }
};
template <class PV>
DI void gemm_stream(LAS char* shm, const PV& pv, const int wv_) {
    typedef typename PV::AS AS; typedef typename PV::BS BS;
    constexpr int nt = PV::NT;
    int u = pv.first();
    if (u < 0) return;
    const int tz = otid();
    const int wr = wv_ >> 2, wc = wv_ & 3, lane = tz & 63, fr = lane & 15, fq = lane >> 4;
    const int aoff = lds_byte(wr * 64 + fr, fq * 8), boff = lds_byte(wc * 32 + fr, fq * 8);
    const unsigned ldsw = (unsigned)wv_ * 1024u;
    f32x4 acc[2][2][4][2]; zero_acc(acc);
    typedef FragT<PV::FP8> Frag;
    Frag At[4], B0[2], B1[2];
    AS ca, na; BS cb, nb;
    pv.src(u, ca, cb, wv_);
    constexpr bool F8 = PV::FP8 != 0;
    LAS unsigned* park = (LAS unsigned*)(shm + 131072) + tz * 4;
    const int aoff0 = F8 ? lds_byte(wr * 64 + fr, fq * 16) : aoff, aoff1 = F8 ? aoff0 + 16 : aoff + 1024;
    const int boff0 = F8 ? lds_byte(wc * 32 + fr, fq * 16) : boff, boff1 = F8 ? boff0 + 16 : boff + 1024;
#define SA_(b, h) (((b) * 2 + (h)) * HTB)
#define SB_(b, h) ((4 + (b) * 2 + (h)) * HTB)
#define STG_(bufoff, S, h, kt) do { _Pragma("unroll") for (int i_ = 0; i_ < 2; ++i_) glds16((S).ptr(tz, h, i_, kt), shm + (bufoff) + ldsw + i_ * 8192); } while (0)
#define LDA_(dst, b, h) do { _Pragma("unroll") for (int m = 0; m < 4; ++m) dst[m].load(shm + SA_(b, h) + aoff0 + m * 2048, shm + SA_(b, h) + aoff1 + m * 2048); } while (0)
#define LDB_(dst, b, h) do { _Pragma("unroll") for (int n = 0; n < 2; ++n) dst[n].load(shm + SB_(b, h) + boff0 + n * 2048, shm + SB_(b, h) + boff1 + n * 2048); } while (0)
#define MMA_(ai, bj, A_, B_) do { __builtin_amdgcn_s_setprio(1); \
        _Pragma("unroll") for (int m = 0; m < 4; ++m) _Pragma("unroll") for (int n = 0; n < 2; ++n) { \
            acc[ai][bj][m][n] = Frag::mma(B_[n], A_[m], acc[ai][bj][m][n]); } \
        __builtin_amdgcn_s_setprio(0); } while (0)
    STG_(SB_(0, 0), cb, 0, 0); STG_(SA_(0, 0), ca, 0, 0); STG_(SB_(0, 1), cb, 1, 0); STG_(SA_(0, 1), ca, 1, 0);
    if (wr == 1) BAR_;
    WAIT_V(4); BAR_;
    STG_(SB_(1, 0), cb, 0, 1); STG_(SA_(1, 0), ca, 0, 1); STG_(SB_(1, 1), cb, 1, 1);
    WAIT_V(6); BAR_;
    for (;;) {
        const int un = pv.next(u); const bool has_next = un >= 0;
        if (has_next) pv.src(un, na, nb, wv_); else { na = ca; nb = cb; }
        if (PV::PARK) { na.park(park); asm volatile("s_waitcnt lgkmcnt(0)" ::: "memory"); }
#pragma clang loop unroll(disable)
        for (int t = 0; t < nt; t += 2) {
            const bool last = (t == nt - 2);
            AS a2 = last ? na : ca; const BS b2 = last ? nb : cb; const int k2 = last ? 0 : t + 2;
            if (PV::PARK) { if (last) a2.unpark(park); }
            LDB_(B0, 0, 0); SCHED_; LDA_(At, 0, 0); STG_(SA_(1, 1), ca, 1, t + 1);
            WAIT_L(8); BAR_; WAIT_L(0); MMA_(0, 0, At, B0); BAR_; SCHED_;
            LDB_(B1, 0, 1); STG_(SB_(0, 0), b2, 0, k2);
            BAR_; WAIT_L(0); MMA_(0, 1, At, B1); BAR_;
            LDA_(At, 0, 1); STG_(SA_(0, 0), a2, 0, k2);
            BAR_; WAIT_L(0); MMA_(1, 0, At, B0); BAR_; SCHED_;
            STG_(SB_(0, 1), b2, 1, k2);
            WAIT_V(6); BAR_; MMA_(1, 1, At, B1); BAR_;
            LDB_(B0, 1, 0); SCHED_; LDA_(At, 1, 0); STG_(SA_(0, 1), a2, 1, k2);
            WAIT_L(8); BAR_; WAIT_L(0); MMA_(0, 0, At, B0); BAR_; SCHED_;
            LDB_(B1, 1, 1); STG_(SB_(1, 0), b2, 0, k2 + 1);
            BAR_; WAIT_L(0); MMA_(0, 1, At, B1); BAR_;
            LDA_(At, 1, 1); STG_(SA_(1, 0), a2, 0, k2 + 1);
            BAR_; WAIT_L(0); MMA_(1, 0, At, B0); BAR_; SCHED_;
            STG_(SB_(1, 1), b2, 1, k2 + 1);
            WAIT_V(6); BAR_; MMA_(1, 1, At, B1); BAR_;
            if (PV::PARK) { if (last) ca = a2; }
        }
        if (PV::FP8 == 2) asm volatile("s_nop 15\n\ts_nop 15" ::: "memory");
        pv.epi(acc, u, wv_);
        if (!has_next) break;
        zero_acc(acc);
        u = un; if (!PV::PARK) ca = na; cb = nb;
        if (PV::PARK) ca.take_uniform(na);
    }
    WAIT_V(0);
    if (wr == 0) BAR_;
    BAR_;
#undef SA_
#undef SB_
#undef STG_
#undef LDA_
#undef LDB_
#undef MMA_
}
DI int lin_first(int shift, int count) { const int G = gridDim.x; const int u = (int)((blockIdx.x + G - (shift % G)) % G); return u < count ? u : -1; }
DI int lin_next(int u, int count) { const int un = u + (int)gridDim.x; return un < count ? un : -1; }
template <int MG, int NTL> struct XcdDeal {
    int MT;
    DI bool decode(int J, int& mt, int& nt) const { const int x = blockIdx.x & 7; const int grp = (J / (MG * NTL)) * 8 + x, w = J % (MG * NTL); mt = grp * MG + w / NTL; nt = w % NTL; return mt < MT; }
    DI int jmax() const { return ((MT + 8 * MG - 1) / (8 * MG)) * (MG * NTL); }
    DI int first() const { int J = blockIdx.x >> 3; const int per = gridDim.x >> 3, jm = jmax(); int mt, nt;
        while (J < jm && !decode(J, mt, nt)) J += per;
        return J < jm ? J : -1; }
    DI int next(int J) const { const int per = gridDim.x >> 3, jm = jmax(); int mt, nt; J += per;
        while (J < jm && !decode(J, mt, nt)) J += per;
        return J < jm ? J : -1; }
};
DI int first_unit(int shift) { const int G = gridDim.x; return (int)((blockIdx.x + G - (shift % G)) % G); }

DI void stage_coords(int (&R)[2], int (&C)[2], const int wv_) {
    const int t_ = otid();
#pragma unroll
    for (int i = 0; i < 2; ++i) stage_rc(t_ * 16 + i * 8192, R[i], C[i]);
}
DI APlain make_a_plain(const bf16_t* A, size_t row0, int lda, int col0) {
    APlain a; a.base = (const char*)(A + row0 * (size_t)lda + col0); a.lda2 = lda * 2; return a;
}
DI BSimple make_b(const bf16_t* Bt0, const bf16_t* Bt1, int ldb) {
    BSimple b; b.base[0] = (const char*)Bt0; b.base[1] = (const char*)Bt1; b.ldb2 = ldb * 2; return b;
}
#define EPI_FOR(acc, ...) do { const int _tz = otid(), _w = _tz >> 6, _l = _tz & 63, _wr = _w >> 2, _wc = _w & 3, _fr = _l & 15, _fq = _l >> 4; \
    _Pragma("unroll") for (int ai = 0; ai < 2; ++ai) _Pragma("unroll") for (int m = 0; m < 4; ++m) { const int lr = ai * 128 + _wr * 64 + m * 16 + _fr; \
    _Pragma("unroll") for (int bj = 0; bj < 2; ++bj) _Pragma("unroll") for (int n = 0; n < 2; ++n) { const int lc = bj * 128 + _wc * 32 + n * 16 + _fq * 4; const f32x4 v = acc[ai][bj][m][n]; __VA_ARGS__ } } } while (0)

DI void store_bf16x4(bf16_t* p, float a, float b, float c, float d) { u32x2 v; v.x = pk_bf16(a, b); v.y = pk_bf16(c, d); *(u32x2*)p = v; }

DI int mod_row(int r) { return r < TX ? (r >> 11) : 32; }
DI int crow_tok(int cr) { const int b = cr / NCH, j = cr - b * NCH; return j < 4 ? TX + b * CTXL + j * 64 : b * SEQ + (j - 4) * 64; }

DI void cvt_tile(LAS char* wl  , const float* src, int ld_src, int kvalid, int nvalid, const float* scale, bf16_t* dst, int ld_dst, const int wv_) {
    const int lane = otid() & 63;
    const int lr = lane >> 4, lc = (lane & 15) * 4;
    f32x4 v[16];
#pragma unroll
    for (int it = 0; it < 16; ++it) {
        const int k = it * 4 + lr;
        v[it] = (f32x4){0.f, 0.f, 0.f, 0.f};
        if (src != nullptr && k < kvalid && lc < nvalid) { v[it] = *(const f32x4*)(src + (size_t)k * ld_src + lc); if (scale) { const float s = scale[k]; v[it] *= s; } }
    }
#pragma unroll
    for (int it = 0; it < 16; ++it) {
        const int k = it * 4 + lr;
#pragma unroll
        for (int j = 0; j < 4; ++j) *(LAS bf16_t*)(wl + (lc + j) * 144 + k * 2) = f2bf(v[it][j]);
    }
    asm volatile("s_waitcnt lgkmcnt(0)" ::: "memory");
#pragma unroll
    for (int i = 0; i < 8; ++i) {
        const int q = i * 64 + lane, n = q >> 3, c = q & 7;
        const u32x4 w = *(const LAS u32x4*)(wl + n * 144 + c * 16);
        *(u32x4*)(dst + (size_t)n * ld_dst + c * 8) = w;
    }
    asm volatile("s_waitcnt lgkmcnt(0)" ::: "memory");
}
DI void cvt_tile8(LAS char* wl  , const float* src, int ld_src, unsigned char* dst, int ld_dst, const int wv_) {
    const int lane = otid() & 63;
    const int lr = lane >> 4, lc = (lane & 15) * 4;
    f32x4 v[16];
#pragma unroll
    for (int it = 0; it < 16; ++it) v[it] = *(const f32x4*)(src + (size_t)(it * 4 + lr) * ld_src + lc);
#pragma unroll
    for (int it = 0; it < 16; ++it) {
        const int k = it * 4 + lr;
#pragma unroll
        for (int j = 0; j < 4; ++j) *(LAS unsigned char*)(wl + (lc + j) * 80 + k) = (unsigned char)f2fp8(v[it][j] * 256.f);
    }
    asm volatile("s_waitcnt lgkmcnt(0)" ::: "memory");
#pragma unroll
    for (int i = 0; i < 4; ++i) {
        const int q = i * 64 + lane, n = q >> 2, c = q & 3;
        const u32x4 w = *(const LAS u32x4*)(wl + n * 80 + c * 16);
        *(u32x4*)(dst + (size_t)n * ld_dst + c * 16) = w;
    }
    asm volatile("s_waitcnt lgkmcnt(0)" ::: "memory");
}
constexpr int CVT_SMALL_TILES = 768 + 512 + 32 + 32 + 64 + 64 + 32;
constexpr int CVT_EXP_TILES = 32 * (32 * 16 + 16 * 16);
DI void cvt_small(const Params& p, LAS char* wl, int t, const int wv_) {
    char* ws = p.ws;
    if (t < 768) { const int l = t / 384, r = t % 384, nt = r / 16, kt = r % 16;
        cvt_tile(wl, p.w_mix_in + (size_t)l * 1024 * N_IN + (size_t)kt * 64 * N_IN + nt * 64, N_IN, 64, N_IN - nt * 64, nullptr,
                 (bf16_t*)(ws + WS_WMI) + ((size_t)l * 1536 + nt * 64) * 1024 + kt * 64, 1024, wv_); return; }
    t -= 768;
    if (t < 512) { const int l = t / 256, r = t % 256, nt = r / 16, kt = r % 16;
        cvt_tile(wl, p.w_mix_out + (size_t)l * 1024 * 1024 + (size_t)kt * 64 * 1024 + nt * 64, 1024, 64, 64, nullptr,
                 (bf16_t*)(ws + WS_WMO) + ((size_t)l * 1024 + nt * 64) * 1024 + kt * 64, 1024, wv_); return; }
    t -= 512;
    if (t < 32) { const int l = t / 16, r = t % 16, nt = r / 4, kt = r % 4;
        cvt_tile(wl, p.conv_pw + (size_t)l * 65536 + (size_t)kt * 64 * 256 + nt * 64, 256, 64, 64, nullptr,
                 (bf16_t*)(ws + WS_WPW) + ((size_t)l * 256 + nt * 64) * 256 + kt * 64, 256, wv_); return; }
    t -= 32;
    if (t < 32) { const int l = t / 16, r = t % 16, nt = r / 4, kt = r % 4;
        cvt_tile(wl, p.ssm_glu_w + (size_t)l * 65536 + (size_t)kt * 64 * 256 + nt * 64, 256, 64, 64, nullptr,
                 (bf16_t*)(ws + WS_WGLU) + ((size_t)l * 256 + nt * 64) * 256 + kt * 64, 256, wv_); return; }
    t -= 32;
    if (t < 64) { const int l = t / 32, r = t % 32, nt = r / 4, kt = r % 4;
        const bool any = (kt < 3) && (nt < 6);
        cvt_tile(wl, any ? p.mla_wq_b + (size_t)l * 192 * 384 + (size_t)kt * 64 * 384 + nt * 64 : nullptr, 384, 64, 64, p.mla_q_a_g + l * 192 + kt * 64,
                 (bf16_t*)(ws + WS_WQ) + ((size_t)l * 512 + nt * 64) * 256 + kt * 64, 256, wv_); return; }
    t -= 64;
    if (t < 64) { const int l = t / 32, r = t % 32, nt = r / 4, kt = r % 4;
        const bool any = (kt < 2);
        cvt_tile(wl, any ? p.mla_wkv_b + (size_t)l * 128 * 512 + (size_t)kt * 64 * 512 + nt * 64 : nullptr, 512, 64, 64, p.mla_kv_a_g + l * 128 + kt * 64,
                 (bf16_t*)(ws + WS_WKV) + ((size_t)l * 512 + nt * 64) * 256 + kt * 64, 256, wv_); return; }
    t -= 64;
    { const int l = t / 16, r = t % 16, nt = r / 4, kt = r % 4;
        cvt_tile(wl, nt == kt ? p.pool_w + ((size_t)l * 4 + nt) * 4096 : nullptr, 64, 64, 64, nullptr,
                 (bf16_t*)(ws + WS_WPOOL) + ((size_t)l * 256 + nt * 64) * 256 + kt * 64, 256, wv_); }
}
DI void cvt_expert(const Params& p, LAS char* wl, int l, int t, const int wv_) {
    char* ws = p.ws;
    const int e = t / 768, r = t % 768;
    if (r < 512) { const int nt = r / 16, kt = r % 16;
        cvt_tile8(wl, p.exp_w_in + ((size_t)(l * NE + e) * 1024 + kt * 64) * 2048 + nt * 64, 2048,
                  (unsigned char*)(ws + WS_W1) + ((size_t)(l * NE + e) * 2048 + nt * 64) * 1024 + kt * 64, 1024, wv_);
    } else { const int q = r - 512, nt = q / 16, kt = q % 16;
        cvt_tile8(wl, p.exp_w_out + ((size_t)(l * NE + e) * 1024 + kt * 64) * 1024 + nt * 64, 1024,
                  (unsigned char*)(ws + WS_W2) + ((size_t)(l * NE + e) * 1024 + nt * 64) * 1024 + kt * 64, 1024, wv_);
    }
}

DI void ada_unit(const Params& p, LAS char* shm, int u, const int wv_) {
    const int tid = otid();
    const int l = u / 48, jc = u % 48;
    LAS float* sc = (LAS float*)shm;
    for (int i = tid; i < 33 * 1024; i += 512) { const int r = i >> 10, k = i & 1023; const float v = r < 32 ? p.c[r * 1024 + k] : p.c_ctx[k]; sc[i] = siluf_(v); }
    __syncthreads();
    const int col = tid & 127, kq = tid >> 7;
    float acc[33];
#pragma unroll
    for (int r = 0; r < 33; ++r) acc[r] = 0.f;
    const float* wp = p.ada_w + ((size_t)l * 1024 + kq * 256) * 6144 + jc * 128 + col;
    for (int k4 = 0; k4 < 256; k4 += 4) {
        float w[4];
#pragma unroll
        for (int i = 0; i < 4; ++i) w[i] = wp[(size_t)(k4 + i) * 6144];
#pragma unroll
        for (int r = 0; r < 33; ++r) { const f32x4 s = *(const LAS f32x4*)(sc + r * 1024 + kq * 256 + k4); acc[r] += s[0] * w[0] + s[1] * w[1] + s[2] * w[2] + s[3] * w[3]; }
    }
    __syncthreads();
    LAS float* red = (LAS float*)shm;
#pragma unroll
    for (int r = 0; r < 33; ++r) red[(kq * 33 + r) * 128 + col] = acc[r];
    __syncthreads();
    for (int i = tid; i < 33 * 128; i += 512) { const int r = i >> 7, cc = i & 127;
        const float s = red[(0 * 33 + r) * 128 + cc] + red[(1 * 33 + r) * 128 + cc] + red[(2 * 33 + r) * 128 + cc] + red[(3 * 33 + r) * 128 + cc];
        ((float*)(p.ws + WS_MOD))[((size_t)l * 33 + r) * 6144 + jc * 128 + cc] = s + p.ada_b[l * 6144 + jc * 128 + cc]; }
    __syncthreads();
}

DI void s5_load_bc(const Params& p, LAS float* bb, LAS float* cc, int l, int dir, int g, int tid) {
    const int pbase = ((l * 2 + dir) * 16 + g) * 64;
    const double dt = exp((double)p.ssm_log_dt[(l * 2 + dir) * 16 + g]);
    for (int i = tid; i < 64 * 16; i += 512) { const int q = i >> 4, ci = i & 15;
        const double are = fmin((double)p.ssm_a_re[pbase + q], -1e-4), aim = (double)p.ssm_a_im[pbase + q];
        const double mg = exp(are * dt), abr = mg * cos(aim * dt), abi = mg * sin(aim * dt), den = are * are + aim * aim;
        const double fre = ((abr - 1.0) * are + abi * aim) / den, fim = (abi * are - (abr - 1.0) * aim) / den;
        const double br = (double)p.ssm_b_re[(size_t)(pbase + q) * 16 + ci], bi = (double)p.ssm_b_im[(size_t)(pbase + q) * 16 + ci];
        bb[i * 2] = (float)(fre * br - fim * bi); bb[i * 2 + 1] = (float)(fre * bi + fim * br); }
    for (int i = tid; i < 16 * 64; i += 512) { const int co = i >> 6, q = i & 63;
        const size_t ix = ((size_t)((l * 2 + dir) * 16 + g) * 16 + co) * 64 + q;
        cc[i * 2] = p.ssm_c_re[ix]; cc[i * 2 + 1] = p.ssm_c_im[ix]; }
}
DI void s5pre_unit(const Params& p, LAS char* shm, int u, const int wv_) {
    const int tid = otid();
    const int l = u >> 5, g = (u >> 1) & 15, dir = u & 1;
    LAS float* pw = (LAS float*)shm;
    LAS float* bb = pw + 65 * 64 * 2;
    LAS float* cc = bb + 64 * 16 * 2;
    LAS float* kk = cc + 16 * 64 * 2;
    LAS float* k0o = kk + 64 * 256;
    bf16_t* TS = (bf16_t*)(p.ws + WS_TS5) + (size_t)(l * 16 + g) * 1024 * 1280;
    bf16_t* WS = (bf16_t*)(p.ws + WS_WS5) + (size_t)(l * 16 + g) * 256 * 1024;
    const int cocip = tid & 255, co_ = cocip >> 4, ci_ = cocip & 15;
    if (dir == 0) {
        s5_load_bc(p, bb, cc, l, 1, g, tid);
        __syncthreads();
        if (tid < 256) { float s_ = 0.f;
            for (int q = 0; q < 64; ++q) s_ += cc[(co_ * 64 + q) * 2] * bb[(q * 16 + ci_) * 2] - cc[(co_ * 64 + q) * 2 + 1] * bb[(q * 16 + ci_) * 2 + 1];
            k0o[tid] = s_; }
        __syncthreads();
    }
    {
        const int pbase = ((l * 2 + dir) * 16 + g) * 64;
        const double dt = exp((double)p.ssm_log_dt[(l * 2 + dir) * 16 + g]);
        for (int i = tid; i < 65 * 64; i += 512) { const int tau = i >> 6, q = i & 63;
            const double are = fmin((double)p.ssm_a_re[pbase + q], -1e-4), aim = (double)p.ssm_a_im[pbase + q];
            const double mg = exp(are * dt * tau), an = aim * dt * tau;
            pw[i * 2] = (float)(mg * cos(an)); pw[i * 2 + 1] = (float)(mg * sin(an)); }
        s5_load_bc(p, bb, cc, l, dir, g, tid);
        __syncthreads();
        if (tid < 64) { float* a64 = (float*)(p.ws + WS_A64) + (size_t)(((l * 2 + dir) * 16 + g) * 64 + tid) * 2; a64[0] = pw[(64 * 64 + tid) * 2]; a64[1] = pw[(64 * 64 + tid) * 2 + 1]; }
        { float gr[64], gi[64];
#pragma unroll
          for (int q = 0; q < 64; ++q) { const float cr = cc[(co_ * 64 + q) * 2], cim = cc[(co_ * 64 + q) * 2 + 1], br = bb[(q * 16 + ci_) * 2], bi = bb[(q * 16 + ci_) * 2 + 1];
              gr[q] = cr * br - cim * bi; gi[q] = cr * bi + cim * br; }
          for (int tau = (tid >> 8); tau < 64; tau += 2) {
              float s_ = 0.f;
#pragma unroll
              for (int q = 0; q < 64; ++q) s_ += gr[q] * pw[(tau * 64 + q) * 2] - gi[q] * pw[(tau * 64 + q) * 2 + 1];
              kk[tau * 256 + cocip] = s_;
          } }
        for (int i = tid; i < 128 * 512; i += 512) { const int row = i >> 9, kp = (i & 511) * 2, ri = row >> 6, q = row & 63, s_ = kp >> 4, ci = kp & 15;
            const int e = dir == 0 ? 63 - s_ : s_;
            const float pr = pw[(e * 64 + q) * 2], pi = pw[(e * 64 + q) * 2 + 1];
            float o[2];
#pragma unroll
            for (int j = 0; j < 2; ++j) { const float br = bb[(q * 16 + ci + j) * 2], bi = bb[(q * 16 + ci + j) * 2 + 1]; o[j] = ri == 0 ? pr * br - pi * bi : pr * bi + pi * br; }
            *(unsigned*)(WS + (size_t)(dir * 128 + row) * 1024 + kp) = pk_bf16(o[0], o[1]); }
        for (int i = tid; i < 1024 * 64; i += 512) { const int row = i >> 6, kp = (i & 63) * 2, t = row >> 4, co = row & 15, ri = kp >> 6, q = kp & 63;
            const int e = dir == 0 ? t + 1 : 64 - t;
            float o[2];
#pragma unroll
            for (int j = 0; j < 2; ++j) { const float pr = pw[(e * 64 + q + j) * 2], pi = pw[(e * 64 + q + j) * 2 + 1];
                const float cr = cc[(co * 64 + q + j) * 2], cim = cc[(co * 64 + q + j) * 2 + 1];
                o[j] = ri == 0 ? (cr * pr - cim * pi) : -(cr * pi + cim * pr); }
            *(unsigned*)(TS + (size_t)row * 1280 + 1024 + dir * 128 + kp) = pk_bf16(o[0], o[1]); }
        __syncthreads();
        for (int rr = tid; rr < 1024; rr += 512) { const int t = rr >> 4, co = rr & 15;
            const float dco = p.ssm_d[l * 256 + g * 16 + co];
            bf16_t* rowp = TS + (size_t)rr * 1280;
            const int s_lo = dir == 0 ? 0 : t + 1, s_hi = dir == 0 ? t : 63;
            for (int s_ = s_lo; s_ <= s_hi; ++s_) { const int tau = dir == 0 ? t - s_ : s_ - t;
                unsigned w[8];
#pragma unroll
                for (int j = 0; j < 8; ++j) { float a = kk[tau * 256 + co * 16 + 2 * j], b2 = kk[tau * 256 + co * 16 + 2 * j + 1];
                    if (s_ == t) { a += k0o[co * 16 + 2 * j]; b2 += k0o[co * 16 + 2 * j + 1]; if (2 * j == co) a += dco; if (2 * j + 1 == co) b2 += dco; }
                    w[j] = pk_bf16(a, b2); }
                *(u32x4*)(rowp + s_ * 16) = (u32x4){w[0], w[1], w[2], w[3]}; *(u32x4*)(rowp + s_ * 16 + 8) = (u32x4){w[4], w[5], w[6], w[7]}; }
        }
        __syncthreads();
    }
}

DI void phase_prologue(const Params& p, LAS char* shm, const int wv_) {
    const int tid = otid();
    if (blockIdx.x == 0 && tid < 64) ((int*)(p.ws + WS_CNT))[tid] = 0;
    const int n_cvt = (CVT_SMALL_TILES + 2 * CVT_EXP_TILES + 7) / 8;
    const int n_units = 64 + 96 + n_cvt;
    for (int u = blockIdx.x; u < n_units; u += gridDim.x) {
        if (u < 64) s5pre_unit(p, shm, u, wv_);
        else if (u < 160) ada_unit(p, shm, u - 64, wv_);
        else {
            const int t = (u - 160) * 8 + (tid >> 6);
            LAS char* wl = shm + (tid >> 6) * (64 * 144);
            if (t < CVT_SMALL_TILES) cvt_small(p, wl, t, wv_);
            else if (t < CVT_SMALL_TILES + 2 * CVT_EXP_TILES) { const int te = t - CVT_SMALL_TILES; cvt_expert(p, wl, te / CVT_EXP_TILES, te % CVT_EXP_TILES, wv_); }
        }
    }
}

DI void norm_mod_store(const float (&v)[16], const float* g, const float* modrow  , bf16_t* hrow, const int wv_) {
    const int lane = otid() & 63;
    float ss = 0.f;
#pragma unroll
    for (int i = 0; i < 16; ++i) ss += v[i] * v[i];
    ss = wave_sum(ss);
    const float rn = rsqrtf(ss * (1.f / 1024.f) + EPS);
#pragma unroll
    for (int j = 0; j < 4; ++j) {
        const int col = j * 256 + lane * 4;
        const f32x4 gg = *(const f32x4*)(g + col), sh = *(const f32x4*)(modrow + col), sc = *(const f32x4*)(modrow + 1024 + col);
        float o[4];
#pragma unroll
        for (int i = 0; i < 4; ++i) o[i] = v[j * 4 + i] * rn * gg[i] * (1.f + sc[i]) + sh[i];
        store_bf16x4(hrow + col, o[0], o[1], o[2], o[3]);
    }
}
DI void phase_norm1_l0(const Params& p, const int wv_) {
    const int tid_ = otid(); const int wid = tid_ >> 6, lane = tid_ & 63;
    const float* MOD = (const float*)(p.ws + WS_MOD);
    bf16_t* H = (bf16_t*)(p.ws + WS_H);
    for (int r = blockIdx.x * 8 + wid; r < TT; r += gridDim.x * 8) {
        const float* src = r < TX ? p.x + (size_t)r * 1024 : p.ctx + (size_t)(r - TX) * 1024;
        float v[16];
#pragma unroll
        for (int j = 0; j < 4; ++j) { const f32x4 t = *(const f32x4*)(src + j * 256 + lane * 4); v[j * 4] = t[0]; v[j * 4 + 1] = t[1]; v[j * 4 + 2] = t[2]; v[j * 4 + 3] = t[3]; }
        norm_mod_store(v, p.norm1_g, MOD + (size_t)(0 * 33 + mod_row(r)) * 6144, H + (size_t)r * 1024, wv_);
    }
}

struct PvInproj {
    const Params& p; int l;
    static constexpr int NT = 16; static constexpr int FP8 = 0; static constexpr bool PARK = false; typedef APlain AS; typedef BSimple BS;
    XcdDeal<4, 6> deal;
    DI int first() const { return deal.first(); }
    DI int next(int u) const { return deal.next(u); }
    DI void src(int u, AS& a, BS& b, const int wv_) const {
        int mt, nt; deal.decode(u, mt, nt);
        const bf16_t* W = (const bf16_t*)(p.ws + WS_WMI) + (size_t)l * 1536 * 1024;
        a = make_a_plain((const bf16_t*)(p.ws + WS_H), (size_t)mt * 256, 1024, 0);
        b = nt < 2 ? make_b(W + (size_t)(nt * 128) * 1024, W + (size_t)(256 + nt * 128) * 1024, 1024)
                   : make_b(W + (size_t)(nt * 256) * 1024, W + (size_t)(nt * 256 + 128) * 1024, 1024);
    }
    DI void epi(f32x4 (&acc)[2][2][4][2], int u, const int wv_) const {
        int mt, nt; deal.decode(u, mt, nt);
        bf16_t* P = (bf16_t*)(p.ws + WS_P);
        if (nt < 2) {
            const int _tz = otid(), _w = _tz >> 6, _l = _tz & 63, _wr = _w >> 2, _wc = _w & 3, _fr = _l & 15, _fq = _l >> 4;
#pragma unroll
            for (int ai = 0; ai < 2; ++ai)
#pragma unroll
                for (int m = 0; m < 4; ++m) { const int lr = ai * 128 + _wr * 64 + m * 16 + _fr;
#pragma unroll
                    for (int n = 0; n < 2; ++n) { const int lc = _wc * 32 + n * 16 + _fq * 4; const f32x4 va = acc[ai][0][m][n], ga = acc[ai][1][m][n];
                        store_bf16x4(P + (size_t)(mt * 256 + lr) * NINP + nt * 128 + lc, va[0] * sigmoidf_(ga[0]), va[1] * sigmoidf_(ga[1]), va[2] * sigmoidf_(ga[2]), va[3] * sigmoidf_(ga[3])); } }
        } else {
            EPI_FOR(acc, { store_bf16x4(P + (size_t)(mt * 256 + lr) * NINP + nt * 256 + lc, v[0], v[1], v[2], v[3]); });
        }
    }
};
DI void phase_inproj(const Params& p, LAS char* shm, int l, const int wv_) {
    PvInproj pv{p, l, {TT / 256}};
    gemm_stream(shm, pv, wv_);
}

template <int WIN>
DI void pool_run(const bf16_t* P, bf16_t* AP, int row0, int ts0, int L, int c, int half) {
    for (int blk = 0; blk < 2; ++blk) {
        const int t0 = half * 32 + blk * 16;
        float in[16 + WIN - 1];
#pragma unroll
        for (int i = 0; i < 16 + WIN - 1; ++i) { const int d = i - WIN / 2; const int ts = ts0 + t0 + d;
            in[i] = (ts >= 0 && ts < L) ? bf2f(P[(size_t)(row0 + t0 + d) * NINP + OFF_POOL + c]) : 0.f; }
        float sum = 0.f;
#pragma unroll
        for (int j = 0; j < WIN; ++j) sum += in[j];
#pragma unroll
        for (int o = 0; o < 16; ++o) {
            const int ts = ts0 + t0 + o;
            const int lo = max(ts - WIN / 2, 0), hi = min(ts + WIN - 1 - WIN / 2, L - 1);
            AP[(size_t)(row0 + t0 + o) * 256 + c] = f2bf(sum / (float)(hi - lo + 1) - in[o + WIN / 2]);
            if (o < 15) sum += in[o + WIN] - in[o];
        }
    }
}
DI void pre_unit(const Params& p, LAS char* shm, int l, int tile, const int wv_) {
    const int tid = otid();
    const bf16_t* P = (const bf16_t*)(p.ws + WS_P);
    int row0, ts0, L;
    if (tile < 1024) { row0 = tile * 64; ts0 = row0 & 2047; L = SEQ; } else { row0 = TX + (tile - 1024) * 64; ts0 = (row0 - TX) & 255; L = CTXL; }
    const int c = tid & 255, half = tid >> 8;
    LAS float* cv = (LAS float*)shm;
    {
        float w[31];
#pragma unroll
        for (int j = 0; j < 31; ++j) w[j] = p.conv_dw[((size_t)l * 31 + j) * 256 + c];
        const float bias = p.conv_dw_b[l * 256 + c];
        const int t0 = half * 32;
        float in[62];
#pragma unroll
        for (int i = 0; i < 62; ++i) {
            const int ts = ts0 + t0 - 15 + i;
            in[i] = (ts >= 0 && ts < L) ? bf2f(P[(size_t)(row0 + t0 - 15 + i) * NINP + c]) : 0.f;
        }
#pragma unroll
        for (int o = 0; o < 32; ++o) { float s_ = bias;
#pragma unroll
            for (int j = 0; j < 31; ++j) s_ += w[j] * in[o + j];
            cv[(t0 + o) * 257 + c] = s_; }
    }
    __syncthreads();
    {
        const int wid = tid >> 6, lane = tid & 63;
        bf16_t* AC = (bf16_t*)(p.ws + WS_ACONV);
        for (int t = wid; t < 64; t += 8) {
            float x[4]; float s_ = 0.f;
#pragma unroll
            for (int j = 0; j < 4; ++j) { x[j] = cv[t * 257 + lane + 64 * j]; s_ += x[j]; }
            const float mu = wave_sum(s_) * (1.f / 256.f);
            float q = 0.f;
#pragma unroll
            for (int j = 0; j < 4; ++j) { x[j] -= mu; q += x[j] * x[j]; }
            const float rs = rsqrtf(wave_sum(q) * (1.f / 256.f) + EPS);
#pragma unroll
            for (int j = 0; j < 4; ++j) { const int ch = lane + 64 * j; const float y = x[j] * rs * p.conv_ln_g[l * 256 + ch] + p.conv_ln_b[l * 256 + ch];
                AC[(size_t)(row0 + t) * 256 + ch] = f2bf(siluf_(y)); }
        }
    }
    {
        bf16_t* AP = (bf16_t*)(p.ws + WS_APOOL);
        const int g = __builtin_amdgcn_readfirstlane(c >> 6);
        if (g == 0) pool_run<2>(P, AP, row0, ts0, L, c, half);
        else if (g == 1) pool_run<4>(P, AP, row0, ts0, L, c, half);
        else if (g == 2) pool_run<8>(P, AP, row0, ts0, L, c, half);
        else pool_run<16>(P, AP, row0, ts0, L, c, half);
    }
    __syncthreads();
}
struct PvS5State {
    const Params& p; int l;
    static constexpr int NT = 16; static constexpr int FP8 = 0; static constexpr bool PARK = false; typedef ASimple AS; typedef BSimple BS;
    DI int first() const { return lin_first(0, 80); }
    DI int next(int u) const { return lin_next(u, 80); }
    DI void src(int u, AS& as, BS& bs, const int wv_) const {
        const int g = u / 5, mt = u % 5;
        int R[2], C[2]; stage_coords(R, C, wv_);
        as.base = (const char*)(p.ws + WS_P); as.kstride = 4 * NINP * 2;
#pragma unroll
        for (int h = 0; h < 2; ++h)
#pragma unroll
            for (int i = 0; i < 2; ++i) { const int cr = min(mt * 256 + h * 128 + R[i], NCROW - 1);
                as.off[h][i] = (unsigned)(((size_t)(crow_tok(cr) + (C[i] >> 4)) * NINP + OFF_SSM + g * 16 + (C[i] & 15)) * 2); }
        const bf16_t* W = (const bf16_t*)(p.ws + WS_WS5) + (size_t)(l * 16 + g) * 256 * 1024;
        bs = make_b(W, W + (size_t)128 * 1024, 1024);
    }
    DI void epi(f32x4 (&acc)[2][2][4][2], int u, const int wv_) const {
        const int g = u / 5, mt = u % 5;
        float* SST = (float*)(p.ws + WS_SST);
        EPI_FOR(acc, { const int cr = mt * 256 + lr; if (cr < NCROW) *(f32x4*)(SST + ((size_t)cr * 16 + g) * 256 + lc) = v; });
    }
};
struct PvQKV {
    const Params& p; int l;
    static constexpr int NT = 4; static constexpr int FP8 = 0; static constexpr bool PARK = false; typedef APlain AS; typedef BSimple BS;
    DI int first() const { return lin_first(80, 1152); }
    DI int next(int u) const { return lin_next(u, 1152); }
    DI void src(int u, AS& a, BS& b, const int wv_) const {
        const bool isq = u < 576; const int w_ = isq ? u : u - 576; const int mt = w_ >> 1, nt = w_ & 1;
        a = make_a_plain((const bf16_t*)(p.ws + WS_P), (size_t)mt * 256, NINP, isq ? OFF_Q : OFF_KV);
        const bf16_t* W = (const bf16_t*)(p.ws + (isq ? WS_WQ : WS_WKV)) + (size_t)l * 512 * 256 + (size_t)nt * 256 * 256;
        b = make_b(W, W + (size_t)128 * 256, 256);
    }
    DI void epi(f32x4 (&acc)[2][2][4][2], int u, const int wv_) const {
        const bool isq = u < 576; const int w_ = isq ? u : u - 576; const int mt = w_ >> 1, nt = w_ & 1;
        float* RAW = (float*)(p.ws + (isq ? WS_RAWQ : WS_RAWKV));
        EPI_FOR(acc, { *(f32x4*)(RAW + (size_t)(mt * 256 + lr) * 512 + nt * 256 + lc) = v; });
    }
};
DI void phase_A(const Params& p, LAS char* shm, int l, const int wv_) {
    { PvS5State pv{p, l}; gemm_stream(shm, pv, wv_); }
    { PvQKV pv{p, l}; gemm_stream(shm, pv, wv_); }
    for (int u = first_unit(80 + 1152); u < 1152; u += gridDim.x) pre_unit(p, shm, l, u, wv_);
}

DI void qkvpost_unit(const Params& p, LAS char* shm, int l, int unit, const int wv_) {
    const int tid = otid(), wid = tid >> 6, lane = tid & 63;
    const bf16_t* P = (const bf16_t*)(p.ws + WS_P);
    const float* RAWQ = (const float*)(p.ws + WS_RAWQ);
    const float* RAWKV = (const float*)(p.ws + WS_RAWKV);
    bf16_t* Q = (bf16_t*)(p.ws + WS_Q);
    bf16_t* KB = (bf16_t*)(p.ws + WS_KB);
    bf16_t* VT = (bf16_t*)(p.ws + WS_VT);
    LAS bf16_t* vt = (LAS bf16_t*)shm;
    const int row0 = unit * 64;
    const bool lat = row0 < TX;
    const int b = lat ? (row0 >> 11) : ((row0 - TX) >> 8);
    const int key0 = lat ? (row0 & 2047) : 2048 + ((row0 - TX) & 255);
    const int head = lane >> 4, sub = lane & 15;
    const float lninv = -9.210340371976184f / 8.f;
    for (int tk = wid * 8; tk < wid * 8 + 8; ++tk) {
        const int r = row0 + tk;
        const bf16_t* pr = P + (size_t)r * NINP;
        float sq = 0.f, skv = 0.f;
#pragma unroll
        for (int j = 0; j < 3; ++j) { const float a = bf2f(pr[OFF_Q + lane + 64 * j]); sq += a * a; }
#pragma unroll
        for (int j = 0; j < 2; ++j) { const float a = bf2f(pr[OFF_KV + lane + 64 * j]); skv += a * a; }
        sq = wave_sum(sq); skv = wave_sum(skv);
        const float rq = rsqrtf(sq * (1.f / 192.f) + EPS), rkv = rsqrtf(skv * (1.f / 128.f) + EPS);
        float cs[2], sn[2];
        { const int tseq = r & 2047; const float fr_ = __expf(lninv * (float)(sub & 7));
          const float a0 = (float)(tseq >> 6) * fr_, a1 = (float)(tseq & 63) * fr_;
          cs[0] = cosf(a0); sn[0] = sinf(a0); cs[1] = cosf(a1); sn[1] = sinf(a1); }
        {
            float q[6]; float ss = 0.f;
#pragma unroll
            for (int j = 0; j < 6; ++j) { q[j] = RAWQ[(size_t)r * 512 + head * 96 + sub + 16 * j] * rq; ss += q[j] * q[j]; }
#pragma unroll
            for (int o = 8; o > 0; o >>= 1) ss += shx(ss, o);
            const float rn = rsqrtf(ss * (1.f / 96.f) + EPS);
#pragma unroll
            for (int j = 0; j < 6; ++j) q[j] = q[j] * rn * p.mla_q_g[l * 96 + sub + 16 * j];
            if (lat) {
#pragma unroll
                for (int j = 4; j < 6; ++j) { const float other = shx(q[j], 8);
                    q[j] = (sub < 8) ? q[j] * cs[j - 4] - other * sn[j - 4] : q[j] * cs[j - 4] + other * sn[j - 4]; }
            }
#pragma unroll
            for (int j = 0; j < 6; ++j) Q[(size_t)r * 384 + head * 96 + sub + 16 * j] = f2bf(q[j]);
        }
        {
            float k[6]; float ss = 0.f;
#pragma unroll
            for (int j = 0; j < 4; ++j) { k[j] = RAWKV[(size_t)r * 512 + head * 128 + sub + 16 * j] * rkv; ss += k[j] * k[j]; }
#pragma unroll
            for (int j = 4; j < 6; ++j) { k[j] = bf2f(pr[OFF_KPE + sub + 16 * (j - 4)]); ss += k[j] * k[j]; }
#pragma unroll
            for (int o = 8; o > 0; o >>= 1) ss += shx(ss, o);
            const float rn = rsqrtf(ss * (1.f / 96.f) + EPS);
#pragma unroll
            for (int j = 0; j < 6; ++j) k[j] = k[j] * rn * p.mla_k_g[l * 96 + sub + 16 * j];
            if (lat) {
#pragma unroll
                for (int j = 4; j < 6; ++j) { const float other = shx(k[j], 8);
                    k[j] = (sub < 8) ? k[j] * cs[j - 4] - other * sn[j - 4] : k[j] * cs[j - 4] + other * sn[j - 4]; }
            }
            bf16_t* kr = KB + ((size_t)(b * 4 + head) * 2304 + key0 + tk) * 96;
#pragma unroll
            for (int j = 0; j < 6; ++j) kr[sub + 16 * j] = f2bf(k[j]);
        }
#pragma unroll
        for (int j = 0; j < 4; ++j) { const float v = RAWKV[(size_t)r * 512 + head * 128 + 64 + sub + 16 * j] * rkv; vt[(head * 64 + sub + 16 * j) * 72 + tk] = f2bf(v); }
    }
    __syncthreads();
    { const int hv = tid >> 1, hf = tid & 1;
      bf16_t* dst = VT + ((size_t)(b * 4 + (hv >> 6)) * 64 + (hv & 63)) * 2304 + key0 + hf * 32;
#pragma unroll
      for (int i = 0; i < 4; ++i) *(u32x4*)(dst + i * 8) = *(const LAS u32x4*)(vt + hv * 72 + hf * 32 + i * 8); }
    __syncthreads();
}
DI void s5carry_unit(const Params& p, int l, int unit, const int wv_) {
    const int gid = unit * 512 + otid();
    const int q = gid & 63, dir = (gid >> 6) & 1, g = (gid >> 7) & 15, b = gid >> 11;
    const float* A64 = (const float*)(p.ws + WS_A64) + (size_t)(((l * 2 + dir) * 16 + g) * 64 + q) * 2;
    const float ar = A64[0], ai = A64[1];
    const float* SST = (const float*)(p.ws + WS_SST);
    bf16_t* HIN = (bf16_t*)(p.ws + WS_HIN);
    float sr[NCH], si[NCH];
#pragma unroll
    for (int s = 0; s < NCH; ++s) { const int j = dir == 0 ? s : (s < 4 ? 3 - s : 39 - s);
        const size_t base = ((size_t)(b * NCH + j) * 16 + g) * 256 + dir * 128 + q; sr[s] = SST[base]; si[s] = SST[base + 64]; }
    float hr = 0.f, hi = 0.f;
#pragma unroll
    for (int s = 0; s < NCH; ++s) {
        const int j = dir == 0 ? s : (s < 4 ? 3 - s : 39 - s);
        const size_t base = ((size_t)(b * NCH + j) * 16 + g) * 256 + dir * 128 + q;
        HIN[base] = f2bf(hr); HIN[base + 64] = f2bf(hi);
        const float nr = ar * hr - ai * hi + sr[s], ni = ar * hi + ai * hr + si[s];
        hr = nr; hi = ni;
    }
}
struct PvConvPool {
    const Params& p; int l;
    static constexpr int NT = 4; static constexpr int FP8 = 0; static constexpr bool PARK = false; typedef APlain AS; typedef BSimple BS;
    DI int first() const { return lin_first(0, 576); }
    DI int next(int u) const { return lin_next(u, 576); }
    DI void src(int u, AS& a, BS& b, const int wv_) const {
        const bool isconv = u < 288; const int mt = isconv ? u : u - 288;
        a = make_a_plain((const bf16_t*)(p.ws + (isconv ? WS_ACONV : WS_APOOL)), (size_t)mt * 256, 256, 0);
        const bf16_t* W = (const bf16_t*)(p.ws + (isconv ? WS_WPW : WS_WPOOL)) + (size_t)l * 65536;
        b = make_b(W, W + (size_t)128 * 256, 256);
    }
    DI void epi(f32x4 (&acc)[2][2][4][2], int u, const int wv_) const {
        const bool isconv = u < 288; const int mt = isconv ? u : u - 288;
        bf16_t* CAT = (bf16_t*)(p.ws + WS_CAT);
        if (isconv) { EPI_FOR(acc, { store_bf16x4(CAT + (size_t)(mt * 256 + lr) * 1024 + lc, v[0], v[1], v[2], v[3]); }); }
        else { EPI_FOR(acc, { const f32x4 s_ = *(const f32x4*)(p.pool_scale + l * 256 + lc);
                              store_bf16x4(CAT + (size_t)(mt * 256 + lr) * 1024 + 256 + lc, v[0] * s_[0], v[1] * s_[1], v[2] * s_[2], v[3] * s_[3]); }); }
    }
};
DI void phase_B(const Params& p, LAS char* shm, int l, const int wv_) {
    { PvConvPool pv{p, l}; gemm_stream(shm, pv, wv_); }
    const int n_post = TT / 64, n_carry = 128;
    for (int u = first_unit(576); u < n_post + n_carry; u += gridDim.x) {
        if (u < n_post) qkvpost_unit(p, shm, l, u, wv_);
        else s5carry_unit(p, l, u - n_post, wv_);
    }
}

DI void attn_unit(const Params& p, LAS char* shm, int l, int b, int h, int qrow0, int nq, int key_lo, int nkeys, const int wv_) {
    const int tid = otid(), wid = tid >> 6, lane = tid & 63, l31 = lane & 31, hh = lane >> 5;
    const bf16_t* Q = (const bf16_t*)(p.ws + WS_Q);
    const bf16_t* KBp = (const bf16_t*)(p.ws + WS_KB) + (size_t)(b * 4 + h) * 2304 * 96;
    const bf16_t* VTp = (const bf16_t*)(p.ws + WS_VT) + (size_t)(b * 4 + h) * 64 * 2304;
    bf16_t* CAT = (bf16_t*)(p.ws + WS_CAT);
    LAS char* kl = shm;
    LAS char* vl = shm + 13312;
    const bool active = wid * 64 < nq;
    float gq = 0.f, gk = 0.f;
    for (int i = lane; i < 96; i += 64) { gq = fmaxf(gq, fabsf(p.mla_q_g[l * 96 + i])); gk = fmaxf(gk, fabsf(p.mla_k_g[l * 96 + i])); }
    gq = wave_max(gq); gk = wave_max(gk);
    const float LOG2E = 1.4426950408889634f;
    const float sc2 = 0.10206207261596575f * LOG2E;
    const float c2 = 9.797958971132712f * gq * gk * LOG2E;
    bf16x8 qf[2][6];
    if (active) {
#pragma unroll
        for (int qb = 0; qb < 2; ++qb)
#pragma unroll
            for (int ks = 0; ks < 6; ++ks) qf[qb][ks] = *(const bf16x8*)(Q + (size_t)(qrow0 + wid * 64 + qb * 32 + l31) * 384 + h * 96 + ks * 16 + hh * 8);
    }
    f32x16 O[2][2];
#pragma unroll
    for (int a = 0; a < 2; ++a)
#pragma unroll
        for (int c = 0; c < 2; ++c)
#pragma unroll
            for (int i = 0; i < 16; ++i) O[a][c][i] = 0.f;
    float lsum[2] = {0.f, 0.f};
    const int ntile = nkeys / 64;
    u32x4 kreg0, kreg1, vreg;
    auto load_tile = [&](int t) {
        const int key = key_lo + t * 64;
        { const int id = tid, kr = id / 12, part = id % 12; kreg0 = *(const u32x4*)(KBp + (size_t)(key + kr) * 96 + part * 8); }
        if (tid < 256) { const int id = tid + 512, kr = id / 12, part = id % 12; kreg1 = *(const u32x4*)(KBp + (size_t)(key + kr) * 96 + part * 8); }
        { const int vd = tid >> 3, part = tid & 7; vreg = *(const u32x4*)(VTp + (size_t)vd * 2304 + key + part * 8); }
    };
    auto write_tile = [&]() {
        { const int id = tid, kr = id / 12, part = id % 12; *(LAS u32x4*)(kl + kr * 208 + part * 16) = kreg0; }
        if (tid < 256) { const int id = tid + 512, kr = id / 12, part = id % 12; *(LAS u32x4*)(kl + kr * 208 + part * 16) = kreg1; }
        { const int vd = tid >> 3, part = tid & 7; *(LAS u32x4*)(vl + vd * 144 + part * 16) = vreg; }
    };
    load_tile(0);
    for (int t = 0; t < ntile; ++t) {
        __syncthreads();
        write_tile();
        __syncthreads();
        if (t + 1 < ntile) load_tile(t + 1);
        if (active) {
#pragma unroll
            for (int kb = 0; kb < 2; ++kb) {
                f32x16 S[2];
#pragma unroll
                for (int qb = 0; qb < 2; ++qb)
#pragma unroll
                    for (int i = 0; i < 16; ++i) S[qb][i] = 0.f;
#pragma unroll
                for (int ks = 0; ks < 6; ++ks) {
                    const bf16x8 a = *(const LAS bf16x8*)(kl + (kb * 32 + l31) * 208 + ks * 32 + hh * 16);
#pragma unroll
                    for (int qb = 0; qb < 2; ++qb) S[qb] = __builtin_amdgcn_mfma_f32_32x32x16_bf16(a, qf[qb][ks], S[qb], 0, 0, 0);
                }
                bf16x8 pf[2][2];
#pragma unroll
                for (int qb = 0; qb < 2; ++qb) {
                    float e[16];
#pragma unroll
                    for (int i = 0; i < 16; ++i) { e[i] = exp2f(S[qb][i] * sc2 - c2); lsum[qb] += e[i]; }
#pragma unroll
                    for (int s = 0; s < 2; ++s) { u32x4 w; w.x = pk_bf16(e[8 * s], e[8 * s + 1]); w.y = pk_bf16(e[8 * s + 2], e[8 * s + 3]); w.z = pk_bf16(e[8 * s + 4], e[8 * s + 5]); w.w = pk_bf16(e[8 * s + 6], e[8 * s + 7]);
                        pf[qb][s] = __builtin_bit_cast(bf16x8, w); }
                }
#pragma unroll
                for (int s = 0; s < 2; ++s) {
                    const int kk = kb * 2 + s;
#pragma unroll
                    for (int vb = 0; vb < 2; ++vb) {
                        const s16x4 lo = *(const LAS s16x4*)(vl + (vb * 32 + l31) * 144 + (16 * kk + 4 * hh) * 2);
                        const s16x4 hi = *(const LAS s16x4*)(vl + (vb * 32 + l31) * 144 + (16 * kk + 8 + 4 * hh) * 2);
                        const bf16x8 va = __builtin_shufflevector(lo, hi, 0, 1, 2, 3, 4, 5, 6, 7);
#pragma unroll
                        for (int qb = 0; qb < 2; ++qb) O[vb][qb] = __builtin_amdgcn_mfma_f32_32x32x16_bf16(va, pf[qb][s], O[vb][qb], 0, 0, 0);
                    }
                }
            }
        }
    }
    if (active) {
#pragma unroll
        for (int qb = 0; qb < 2; ++qb) {
            const float tot = lsum[qb] + shx(lsum[qb], 32);
            const float inv = 1.f / tot;
            bf16_t* orow = CAT + (size_t)(qrow0 + wid * 64 + qb * 32 + l31) * 1024 + 768 + h * 64;
#pragma unroll
            for (int vb = 0; vb < 2; ++vb)
#pragma unroll
                for (int i4 = 0; i4 < 4; ++i4)
                    store_bf16x4(orow + vb * 32 + 8 * i4 + 4 * hh, O[vb][qb][4 * i4] * inv, O[vb][qb][4 * i4 + 1] * inv, O[vb][qb][4 * i4 + 2] * inv, O[vb][qb][4 * i4 + 3] * inv);
        }
    }
    __syncthreads();
}
struct PvS5Out {
    const Params& p; int l;
    static constexpr int NT = 20; static constexpr int FP8 = 0; static constexpr bool PARK = false; typedef ASeg2 AS; typedef BSimple BS;
    DI int first() const { return lin_first(512, 320); }
    DI int next(int u) const { return lin_next(u, 320); }
    DI void src(int u, AS& as, BS& bs, const int wv_) const {
        const int ntile = u & 3, mt = (u >> 2) % 5, g = u / 20;
        int R[2], C[2]; stage_coords(R, C, wv_);
        as.base0 = (const char*)(p.ws + WS_P); as.base1 = (const char*)(p.ws + WS_HIN); as.ks0 = 4 * NINP * 2; as.nt0 = 16;
#pragma unroll
        for (int h = 0; h < 2; ++h)
#pragma unroll
            for (int i = 0; i < 2; ++i) { const int cr = min(mt * 256 + h * 128 + R[i], NCROW - 1);
                as.off0[h][i] = (unsigned)(((size_t)(crow_tok(cr) + (C[i] >> 4)) * NINP + OFF_SSM + g * 16 + (C[i] & 15)) * 2);
                as.off1[h][i] = (unsigned)((((size_t)cr * 16 + g) * 256 + C[i]) * 2); }
        const bf16_t* W = (const bf16_t*)(p.ws + WS_TS5) + ((size_t)(l * 16 + g) * 1024 + ntile * 256) * 1280;
        bs = make_b(W, W + (size_t)128 * 1280, 1280);
    }
    DI void epi(f32x4 (&acc)[2][2][4][2], int u, const int wv_) const {
        const int ntile = u & 3, mt = (u >> 2) % 5, g = u / 20;
        bf16_t* Z = (bf16_t*)(p.ws + WS_Z);
        EPI_FOR(acc, { const int cr = mt * 256 + lr; if (cr < NCROW) { const int col = ntile * 256 + lc, t = col >> 4, co = col & 15;
            store_bf16x4(Z + (size_t)(crow_tok(cr) + t) * 256 + g * 16 + co, gelu_tanh(v[0]), gelu_tanh(v[1]), gelu_tanh(v[2]), gelu_tanh(v[3])); } });
    }
};
DI void phase_C(const Params& p, LAS char* shm, int l, const int wv_) {
    for (int u = blockIdx.x; u < 512; u += gridDim.x) { const int qb = u & 3, h = (u >> 2) & 3, b = u >> 4;
        attn_unit(p, shm, l, b, h, b * SEQ + qb * 512, 512, 0, 2304, wv_); }
    { PvS5Out pv{p, l}; gemm_stream(shm, pv, wv_); }
    if (l == 0) for (int u = first_unit(512 + 320); u < 128; u += gridDim.x) { const int h = u & 3, b = u >> 2;
        attn_unit(p, shm, l, b, h, TX + b * CTXL, 256, 2048, 256, wv_); }
}

struct PvGlu {
    const Params& p; int l;
    static constexpr int NT = 4; static constexpr int FP8 = 0; static constexpr bool PARK = false; typedef APlain AS; typedef BSimple BS;
    DI int first() const { return lin_first(0, 288); }
    DI int next(int u) const { return lin_next(u, 288); }
    DI void src(int u, AS& a, BS& b, const int wv_) const {
        a = make_a_plain((const bf16_t*)(p.ws + WS_Z), (size_t)u * 256, 256, 0);
        const bf16_t* W = (const bf16_t*)(p.ws + WS_WGLU) + (size_t)l * 65536;
        b = make_b(W, W + (size_t)128 * 256, 256);
    }
    DI void epi(f32x4 (&acc)[2][2][4][2], int u, const int wv_) const {
        const bf16_t* Z = (const bf16_t*)(p.ws + WS_Z); bf16_t* CAT = (bf16_t*)(p.ws + WS_CAT);
        EPI_FOR(acc, { const size_t r = (size_t)(u * 256 + lr); const f32x4 bsv = *(const f32x4*)(p.ssm_glu_b + l * 256 + lc);
            const u32x2 zz = *(const u32x2*)(Z + r * 256 + lc);
            const float z0 = bflo(zz.x), z1 = bfhi(zz.x), z2 = bflo(zz.y), z3 = bfhi(zz.y);
            store_bf16x4(CAT + r * 1024 + 512 + lc, z0 * sigmoidf_(v[0] + bsv[0]), z1 * sigmoidf_(v[1] + bsv[1]), z2 * sigmoidf_(v[2] + bsv[2]), z3 * sigmoidf_(v[3] + bsv[3])); });
    }
};
DI void phase_D(const Params& p, LAS char* shm, int l, const int wv_) {
    PvGlu pv{p, l}; gemm_stream(shm, pv, wv_);
}

struct PvOutproj {
    const Params& p; int l;
    static constexpr int NT = 16; static constexpr int FP8 = 0; static constexpr bool PARK = false; typedef APlain AS; typedef BSimple BS;
    XcdDeal<4, 4> deal;
    DI int first() const { return deal.first(); }
    DI int next(int u) const { return deal.next(u); }
    DI void src(int u, AS& a, BS& b, const int wv_) const {
        int mt, nt; deal.decode(u, mt, nt);
        const bf16_t* W = (const bf16_t*)(p.ws + WS_WMO) + (size_t)l * 1024 * 1024;
        a = make_a_plain((const bf16_t*)(p.ws + WS_CAT), (size_t)mt * 256, 1024, 0);
        b = make_b(W + (size_t)(nt * 256) * 1024, W + (size_t)(nt * 256 + 128) * 1024, 1024);
    }
    DI void epi(f32x4 (&acc)[2][2][4][2], int u, const int wv_) const {
        int mt, nt; deal.decode(u, mt, nt);
        float* X = (float*)(p.ws + WS_X);
        const float* MOD = (const float*)(p.ws + WS_MOD) + (size_t)l * 33 * 6144;
        EPI_FOR(acc, { const int r = mt * 256 + lr; const int col = nt * 256 + lc;
            const float* xo = (l == 0) ? (r < TX ? p.x + (size_t)r * 1024 : p.ctx + (size_t)(r - TX) * 1024) : X + (size_t)r * 1024;
            const f32x4 xv = *(const f32x4*)(xo + col); const f32x4 g1 = *(const f32x4*)(MOD + (size_t)mod_row(r) * 6144 + 2048 + col);
            *(f32x4*)(X + (size_t)r * 1024 + col) = xv + g1 * v; });
    }
};
DI void phase_E(const Params& p, LAS char* shm, int l, const int wv_) {
    PvOutproj pv{p, l, {(l == 1 ? TX : TT) / 256}}; gemm_stream(shm, pv, wv_);
}

DI void phase_router(const Params& p, LAS char* shm, int l, const int wv_) {
    const int tid = otid(), wid = tid >> 6, lane = tid & 63;
    const int Tm = (l == 1) ? TX : TT;
    const float* X = (const float*)(p.ws + WS_X);
    const float* MOD = (const float*)(p.ws + WS_MOD) + (size_t)l * 33 * 6144;
    unsigned char* H8 = (unsigned char*)(p.ws + WS_H);
    int* CNT = (int*)(p.ws + WS_CNT) + l * 32;
    int* LIST = (int*)(p.ws + WS_LIST);
    float* TOPW = (float*)(p.ws + WS_TOPW);
    LAS float* wl = (LAS float*)shm;
    LAS int* lcnt = (LAS int*)(shm + 131072);
    LAS int* lbase = lcnt + 32;
    LAS unsigned* lrec = (LAS unsigned*)(lbase + 32);
    LAS float* lwt = (LAS float*)(lrec + 1024);
    for (int i = tid; i < 1024 * 8; i += 512) { const int k = i >> 3, gq = i & 7;
        *(LAS f32x4*)(wl + k * 32 + ((gq ^ ((k >> 1) & 7)) << 2)) = *(const f32x4*)(p.router_w + (size_t)l * 32768 + k * 32 + gq * 4); }
    const int tpw = (Tm + gridDim.x - 1) / gridDim.x;
    const int tbeg = blockIdx.x * tpw, tend = min(tbeg + tpw, Tm);
    for (int c0 = tbeg; c0 < tend; c0 += 256) {
        const int c1 = min(c0 + 256, tend);
        if (tid < 32) lcnt[tid] = 0;
        __syncthreads();
        for (int t = c0 + wid; t < c1; t += 8) {
            float v[16]; float ss = 0.f;
#pragma unroll
            for (int j = 0; j < 16; ++j) { v[j] = X[(size_t)t * 1024 + lane + 64 * j]; ss += v[j] * v[j]; }
            ss = wave_sum(ss);
            const float rn = rsqrtf(ss * (1.f / 1024.f) + EPS);
            const float* mr = MOD + (size_t)mod_row(t) * 6144;
#pragma unroll
            for (int j = 0; j < 16; ++j) { const int k = lane + 64 * j; v[j] = v[j] * rn * p.norm2_g[l * 1024 + k] * (1.f + mr[4096 + k]) + mr[3072 + k]; H8[(size_t)t * 1024 + k] = (unsigned char)f2fp8(v[j]); }
            float lg[32];
#pragma unroll
            for (int e = 0; e < 32; ++e) lg[e] = 0.f;
#pragma unroll
            for (int j = 0; j < 16; ++j) { const int k = lane + 64 * j; const int sw = (k >> 1) & 7;
#pragma unroll
                for (int gq = 0; gq < 8; ++gq) { const f32x4 w = *(const LAS f32x4*)(wl + k * 32 + ((gq ^ sw) << 2));
                    lg[gq * 4] += v[j] * w[0]; lg[gq * 4 + 1] += v[j] * w[1]; lg[gq * 4 + 2] += v[j] * w[2]; lg[gq * 4 + 3] += v[j] * w[3]; } }
            float r16[16];
            { const bool up = (lane & 32) != 0;
#pragma unroll
              for (int i = 0; i < 16; ++i) { const float send = up ? lg[i] : lg[i + 16]; const float keep = up ? lg[i + 16] : lg[i]; r16[i] = keep + shx(send, 32); } }
            float r8[8];
            { const bool up = (lane & 16) != 0;
#pragma unroll
              for (int i = 0; i < 8; ++i) { const float send = up ? r16[i] : r16[i + 8]; const float keep = up ? r16[i + 8] : r16[i]; r8[i] = keep + shx(send, 16); } }
            float r4[4];
            { const bool up = (lane & 8) != 0;
#pragma unroll
              for (int i = 0; i < 4; ++i) { const float send = up ? r8[i] : r8[i + 4]; const float keep = up ? r8[i + 4] : r8[i]; r4[i] = keep + shx(send, 8); } }
            float r2[2];
            { const bool up = (lane & 4) != 0;
#pragma unroll
              for (int i = 0; i < 2; ++i) { const float send = up ? r4[i] : r4[i + 2]; const float keep = up ? r4[i + 2] : r4[i]; r2[i] = keep + shx(send, 4); } }
            float r1;
            { const bool up = (lane & 2) != 0; const float send = up ? r2[0] : r2[1]; const float keep = up ? r2[1] : r2[0]; r1 = keep + shx(send, 2); }
            r1 += shx(r1, 1);
            int e = lane >> 1; asm volatile("" : "+v"(e));
            float logit = r1 + p.router_b[l * 32 + e];
            logit = fminf(fmaxf(logit, -1e30f), 1e30f);
            int rank = 0;
#pragma unroll
            for (int j = 0; j < 32; ++j) { const float o = shi(logit, 2 * j); rank += (o > logit || (o == logit && j < e)) ? 1 : 0; }
            const float mx = wave_max(logit);
            const bool sel = rank < 4;
            const float ex = sel ? __expf(logit - mx) : 0.f;
            const float den = wave_sum(ex) * 0.5f;
            if (sel && (lane & 1) == 0) {
                const int pos = atomicAdd((int*)&lcnt[e], 1);
                lrec[(t - c0) * 4 + rank] = (unsigned)e | ((unsigned)pos << 8);
                lwt[(t - c0) * 4 + rank] = ex / den;
            }
        }
        __syncthreads();
        if (tid < 32) lbase[tid] = atomicAdd(&CNT[tid], lcnt[tid]);
        __syncthreads();
        for (int i = tid; i < (c1 - c0) * 4; i += 512) { const unsigned rec = lrec[i]; const int e = rec & 255, pos = rec >> 8;
            u32x2 ent; ent.x = (unsigned)((c0 * 4) + i); ent.y = __float_as_uint(lwt[i]);
            *(u32x2*)(LIST + ((size_t)e * TT + lbase[e] + pos) * 2) = ent; }
        __syncthreads();
    }
}

DI void moe_tiles(const Params& p, LAS int* tstart, int l, const int wv_) {
    const int* CNT = (const int*)(p.ws + WS_CNT) + l * 32;
    if (otid() == 0) { int s = 0; for (int e = 0; e < 32; ++e) { tstart[e] = s; s += (CNT[e] + 255) >> 8; } tstart[32] = s; }
    __syncthreads();
}
DI int moe_find(const LAS int* tstart, int mt) { int e = 0;
#pragma unroll
    for (int i = 1; i < 32; ++i) e += (mt >= tstart[i]) ? 1 : 0;
    return e; }
struct PvMoe1 {
    const Params& p; int l; const LAS int* tstart;
    static constexpr int NT = 8; static constexpr int FP8 = 2; static constexpr bool PARK = false; typedef ASimple AS; typedef BSimple BS;
    XcdDeal<4, 8> deal;
    DI int first() const { return deal.first(); }
    DI int next(int u) const { return deal.next(u); }
    DI void src(int u, AS& as, BS& bs, const int wv_) const {
        int mt, n8; deal.decode(u, mt, n8);
        const int e = moe_find(tstart, mt);
        const int r0 = (mt - tstart[e]) * 256, cnt = ((const int*)(p.ws + WS_CNT))[l * 32 + e];
        const int* lst = (const int*)(p.ws + WS_LIST) + (size_t)e * TT * 2;
        int R[2], C[2]; stage_coords(R, C, wv_);
        as.base = (const char*)(p.ws + WS_H); as.kstride = 128;
#pragma unroll
        for (int h = 0; h < 2; ++h)
#pragma unroll
            for (int i = 0; i < 2; ++i) { const int slot = lst[2 * min(r0 + h * 128 + R[i], cnt - 1)]; as.off[h][i] = (unsigned)((size_t)(slot >> 2) * 1024 + C[i] * 2); }
        const char* W = (const char*)(p.ws + WS_W1) + (size_t)(l * NE + e) * 2048 * 1024;
        bs.base[0] = W + (size_t)(n8 * 128) * 1024; bs.base[1] = W + (size_t)(1024 + n8 * 128) * 1024; bs.ldb2 = 1024;
    }
    DI void epi(f32x4 (&acc)[2][2][4][2], int u, const int wv_) const {
        int mt, n8; deal.decode(u, mt, n8);
        const int e = moe_find(tstart, mt);
        unsigned char* ACT = (unsigned char*)(p.ws + WS_RA);
        const int _tz = otid(), _w = _tz >> 6, _l = _tz & 63, _wr = _w >> 2, _wc = _w & 3, _fr = _l & 15, _fq = _l >> 4;
        const float* bin = p.exp_b_in + (size_t)(l * NE + e) * 2048 + n8 * 128 + _wc * 32 + _fq * 4;
        f32x4 bg[2], bu[2];
#pragma unroll
        for (int n = 0; n < 2; ++n) { bg[n] = *(const f32x4*)(bin + n * 16); bu[n] = *(const f32x4*)(bin + 1024 + n * 16); }
#pragma unroll
        for (int ai = 0; ai < 2; ++ai)
#pragma unroll
            for (int m = 0; m < 4; ++m) { const int lr = ai * 128 + _wr * 64 + m * 16 + _fr;
                unsigned char* orow = ACT + ((size_t)mt * 256 + lr) * 1024 + n8 * 128 + _wc * 32 + _fq * 4;
#pragma unroll
                for (int n = 0; n < 2; ++n) {
                    float o[4];
#pragma unroll
                    for (int r = 0; r < 4; ++r) { const float gate = fminf(acc[ai][0][m][n][r] * (1.f / 256.f) + bg[n][r], 7.f); const float up = fminf(fmaxf(acc[ai][1][m][n][r] * (1.f / 256.f) + bu[n][r], -7.f), 7.f);
                        o[r] = (up + 1.f) * gate * sigmoidf_(1.702f * gate); }
                    *(unsigned*)(orow + n * 16) = pk_fp8x4(o[0], o[1], o[2], o[3]); } }
    }
};
DI void phase_moe1(const Params& p, LAS char* shm, int l, const int wv_) {
    LAS int* tstart = (LAS int*)(shm + LDS_MISC + 64);
    moe_tiles(p, tstart, l, wv_);
    PvMoe1 pv{p, l, tstart, {tstart[32]}}; gemm_stream(shm, pv, wv_);
}
struct PvMoe2 {
    const Params& p; int l; const LAS int* tstart;
    static constexpr int NT = 8; static constexpr int FP8 = 2; static constexpr bool PARK = false; typedef APlain AS; typedef BSimple BS;
    XcdDeal<4, 4> deal;
    DI int first() const { return deal.first(); }
    DI int next(int u) const { return deal.next(u); }
    DI void src(int u, AS& as, BS& bs, const int wv_) const {
        int mt, n4; deal.decode(u, mt, n4);
        const int e = moe_find(tstart, mt);
        as.base = (const char*)(p.ws + WS_RA) + (size_t)mt * 256 * 1024; as.lda2 = 1024;
        const char* W = (const char*)(p.ws + WS_W2) + (size_t)(l * NE + e) * 1024 * 1024;
        bs.base[0] = W + (size_t)(n4 * 256) * 1024; bs.base[1] = W + (size_t)(n4 * 256 + 128) * 1024; bs.ldb2 = 1024;
    }
    DI void epi(f32x4 (&acc)[2][2][4][2], int u, const int wv_) const {
        int mt, n4; deal.decode(u, mt, n4);
        const int e = moe_find(tstart, mt);
        const int r0 = (mt - tstart[e]) * 256, cnt = ((const int*)(p.ws + WS_CNT))[l * 32 + e];
        const int* lst = (const int*)(p.ws + WS_LIST) + (size_t)e * TT * 2;
        bf16_t* Y = (bf16_t*)(p.ws + WS_RY);
        const int _tz = otid(), _w = _tz >> 6, _l = _tz & 63, _wr = _w >> 2, _wc = _w & 3, _fr = _l & 15, _fq = _l >> 4;
        const float* bo = p.exp_b_out + (size_t)(l * NE + e) * 1024 + n4 * 256 + _wc * 32 + _fq * 4;
        u32x2 ent[2][4]; f32x4 bv[2][2];
#pragma unroll
        for (int ai = 0; ai < 2; ++ai)
#pragma unroll
            for (int m = 0; m < 4; ++m) ent[ai][m] = *(const u32x2*)(lst + 2 * min(r0 + ai * 128 + _wr * 64 + m * 16 + _fr, cnt - 1));
#pragma unroll
        for (int bj = 0; bj < 2; ++bj)
#pragma unroll
            for (int n = 0; n < 2; ++n) bv[bj][n] = *(const f32x4*)(bo + bj * 128 + n * 16);
#pragma unroll
        for (int ai = 0; ai < 2; ++ai)
#pragma unroll
            for (int m = 0; m < 4; ++m) { const int lr = r0 + ai * 128 + _wr * 64 + m * 16 + _fr;
                if (lr < cnt) { const float w = __uint_as_float(ent[ai][m].y); bf16_t* orow = Y + (size_t)ent[ai][m].x * 1024 + n4 * 256 + _wc * 32 + _fq * 4;
#pragma unroll
                    for (int bj = 0; bj < 2; ++bj)
#pragma unroll
                        for (int n = 0; n < 2; ++n) { const f32x4 v = acc[ai][bj][m][n]; const f32x4 b_ = bv[bj][n];
                            const float sc_ = 1.f / 256.f; store_bf16x4(orow + bj * 128 + n * 16, (v[0] * sc_ + b_[0]) * w, (v[1] * sc_ + b_[1]) * w, (v[2] * sc_ + b_[2]) * w, (v[3] * sc_ + b_[3]) * w); } } }
    }
};
DI void phase_moe2(const Params& p, LAS char* shm, int l, const int wv_) {
    LAS int* tstart = (LAS int*)(shm + LDS_MISC + 64);
    moe_tiles(p, tstart, l, wv_);
    PvMoe2 pv{p, l, tstart, {tstart[32]}}; gemm_stream(shm, pv, wv_);
}

DI void phase_combine(const Params& p, LAS char* shm, int l, const int wv_) {
    const int tid = otid(), wid = tid >> 6, lane = tid & 63;
    float* X = (float*)(p.ws + WS_X);
    const bf16_t* Y = (const bf16_t*)(p.ws + WS_RY);
    const float* MOD = (const float*)(p.ws + WS_MOD);
    bf16_t* H = (bf16_t*)(p.ws + WS_H);
    const int Tm = (l == 1) ? TX : TT;
    for (int r = blockIdx.x * 8 + wid; r < Tm; r += gridDim.x * 8) {
        const float* g2 = MOD + (size_t)(l * 33 + mod_row(r)) * 6144 + 5120;
        float v[16];
#pragma unroll
        for (int j = 0; j < 4; ++j) {
            const int col = j * 256 + lane * 4;
            f32x4 s = (f32x4){0.f, 0.f, 0.f, 0.f};
#pragma unroll
            for (int k = 0; k < 4; ++k) { const u32x2 yy = *(const u32x2*)(Y + ((size_t)r * 4 + k) * 1024 + col); s[0] += bflo(yy.x); s[1] += bfhi(yy.x); s[2] += bflo(yy.y); s[3] += bfhi(yy.y); }
            const f32x4 xv = *(const f32x4*)(X + (size_t)r * 1024 + col), gg = *(const f32x4*)(g2 + col);
            const f32x4 o = xv + gg * s;
            if (l == 1) *(f32x4*)(p.out + (size_t)r * 1024 + col) = o; else *(f32x4*)(X + (size_t)r * 1024 + col) = o;
            v[j * 4] = o[0]; v[j * 4 + 1] = o[1]; v[j * 4 + 2] = o[2]; v[j * 4 + 3] = o[3];
        }
        if (l == 0) norm_mod_store(v, p.norm1_g + 1024, MOD + (size_t)(1 * 33 + mod_row(r)) * 6144, H + (size_t)r * 1024, wv_);
    }
}

constexpr int NPH_LAYER = 10;
constexpr int NPH = 2 + 2 * NPH_LAYER;

__global__ void __launch_bounds__(512, 2) mk_forward(Params p_unused) {
    extern __shared__ __attribute__((aligned(16))) char smem_raw[];
    LAS char* shm = (LAS char*)smem_raw;
    volatile LAS unsigned* xb_words = (volatile LAS unsigned*)(shm + LDS_MISC);
    const int wv_ = __builtin_amdgcn_readfirstlane((int)(threadIdx.x >> 6));
    if (wv_ == 0 && olane() < 4) xb_words[olane()] = 0u;
    __syncthreads();
    kaptr_t ka = (kaptr_t)__builtin_amdgcn_kernarg_segment_ptr();
    const int tok0 = ptoken();
    const int lo = (int)kld64<__builtin_offsetof(Params, ph_lo)>(ka, tok0), hi = (int)kld64<__builtin_offsetof(Params, ph_hi)>(ka, tok0);
    const bool multi = (hi - lo) > 1;
    unsigned* barw = (unsigned*)((__attribute__((address_space(1))) char*)kld64<__builtin_offsetof(Params, ws)>(ka, tok0) + WS_BAR);
    XcdBarrier bar; bar.bar = barw; bar.x = 0; bar.st = xb_words;
    if (multi) bar = xcd_barrier_post(barw, xb_words, wv_);
#ifndef ONLY_KIND
#define ONLY_KIND (-1)
#endif
#define PHASE(idx, kind, FN, ...) do { if ((ONLY_KIND < 0 || ONLY_KIND == (kind)) && (idx) >= lo && (idx) < hi) { const Params p = kparams(ka, ptoken()); int nrep_ = 1 + ((MK_REPEAT_MASK >> (kind)) & 1); asm volatile("" : "+s"(nrep_)); for (int rep_ = 0; rep_ < nrep_; ++rep_) { FN(p, ##__VA_ARGS__, wv_); } if ((idx) + 1 < hi) xcd_barrier(bar, wv_); } } while (0)
    PHASE(0, 0, phase_prologue, shm);
    PHASE(1, 1, phase_norm1_l0);
    for (int l = 0; l < 2; ++l) {
        const int b0 = 2 + l * NPH_LAYER;
        PHASE(b0 + 0, 2, phase_inproj, shm, l);
        PHASE(b0 + 1, 3, phase_A, shm, l);
        PHASE(b0 + 2, 4, phase_B, shm, l);
        PHASE(b0 + 3, 5, phase_C, shm, l);
        PHASE(b0 + 4, 6, phase_D, shm, l);
        PHASE(b0 + 5, 7, phase_E, shm, l);
        PHASE(b0 + 6, 8, phase_router, shm, l);
        PHASE(b0 + 7, 9, phase_moe1, shm, l);
        PHASE(b0 + 8, 10, phase_moe2, shm, l);
        PHASE(b0 + 9, 11, phase_combine, shm, l);
    }
#undef PHASE
}


extern "C" void kernel_launch(void* const* d_in, const int* in_sizes, int n_in, void* d_out, int out_size, void* d_ws, size_t ws_size, hipStream_t stream) {
    static int grid = 0;
    if (grid == 0) {
        if (n_in != 39 || ws_size < WS_END) { fprintf(stderr, "kernel_launch: unexpected n_in %d or ws_size %zu (< %zu)\n", n_in, ws_size, (size_t)WS_END); grid = -1; return; }
        int dev = 0, cus = 0;
        if (hipGetDevice(&dev) != hipSuccess || hipDeviceGetAttribute(&cus, hipDeviceAttributeMultiprocessorCount, dev) != hipSuccess) { grid = -1; return; }
        if (hipFuncSetAttribute((const void*)mk_forward, hipFuncAttributeMaxDynamicSharedMemorySize, LDS_BYTES) != hipSuccess) { fprintf(stderr, "kernel_launch: hipFuncSetAttribute failed\n"); grid = -1; return; }
        int per_cu = 0;
        if (hipOccupancyMaxActiveBlocksPerMultiprocessor(&per_cu, (const void*)mk_forward, 512, LDS_BYTES) != hipSuccess || per_cu < 1) fprintf(stderr, "kernel_launch: occupancy query says %d\n", per_cu);
        (void)hipGetLastError();
        grid = cus;
    }
    if (grid < 0) return;
    (void)hipMemsetAsync((char*)d_ws + WS_BAR, 0, 16384 + 1024, stream);
    Params p{};
    const float** pf = (const float**)&p;
    for (int i = 0; i < 39; ++i) pf[i] = (const float*)d_in[i];
    p.out = (float*)d_out; p.ws = (char*)d_ws;
#if MK_ONE_LAUNCH
    p.ph_lo = 0; p.ph_hi = NPH;
    hipLaunchKernelGGL(mk_forward, dim3(grid), dim3(512), LDS_BYTES, stream, p);
#else
#ifndef MK_LAST_PHASE
#define MK_LAST_PHASE NPH
#endif
    for (int ph = 0; ph < MK_LAST_PHASE; ++ph) { p.ph_lo = ph; p.ph_hi = ph + 1; hipLaunchKernelGGL(mk_forward, dim3(grid), dim3(512), LDS_BYTES, stream, p); }
#endif
}
```

```cpp
#include <hip/hip_runtime.h>
#include <stdint.h>
#include <stdio.h>

#ifndef MK_REPEAT_MASK
#define MK_REPEAT_MASK 0x0
#endif
#ifndef MK_ONE_LAUNCH
#define MK_ONE_LAUNCH 1
#endif

#define DI __device__ __forceinline__
#define LAS __attribute__((address_space(3)))
typedef unsigned short bf16_t;
typedef short bf16x8 __attribute__((ext_vector_type(8)));
typedef short s16x4 __attribute__((ext_vector_type(4)));
typedef float f32x4 __attribute__((ext_vector_type(4)));
typedef float f32x16 __attribute__((ext_vector_type(16)));
typedef unsigned u32x2 __attribute__((ext_vector_type(2)));
typedef unsigned u32x4 __attribute__((ext_vector_type(4)));
typedef int i32x4 __attribute__((ext_vector_type(4)));
typedef int i32x8 __attribute__((ext_vector_type(8)));

constexpr int D = 1024, NB = 32, SEQ = 2048, CTXL = 256;
constexpr int TX = NB * SEQ, TC = NB * CTXL, TT = TX + TC;
constexpr int NINP = 1536;
constexpr int OFF_POOL = 512, OFF_Q = 768, OFF_SSM = 960, OFF_KV = 1216, OFF_KPE = 1344, N_IN = 1376;
constexpr int NE = 32;
constexpr int NCH = 36;
constexpr int NCROW = NB * NCH;
constexpr float EPS = 1e-6f;

constexpr size_t WS_BAR = 0;
constexpr size_t WS_CNT = 16384;
constexpr size_t WS_MOD = WS_CNT + 1024;
constexpr size_t WS_A64 = WS_MOD + (size_t)2 * 33 * 6144 * 4;
constexpr size_t WS_WMI = WS_A64 + (size_t)2 * 2 * 16 * 64 * 2 * 4;
constexpr size_t WS_WMO = WS_WMI + (size_t)2 * 1536 * 1024 * 2;
constexpr size_t WS_WPW = WS_WMO + (size_t)2 * 1024 * 1024 * 2;
constexpr size_t WS_WGLU = WS_WPW + (size_t)2 * 256 * 256 * 2;
constexpr size_t WS_WPOOL = WS_WGLU + (size_t)2 * 256 * 256 * 2;
constexpr size_t WS_WQ = WS_WPOOL + (size_t)2 * 256 * 256 * 2;
constexpr size_t WS_WKV = WS_WQ + (size_t)2 * 512 * 256 * 2;
constexpr size_t WS_TS5 = WS_WKV + (size_t)2 * 512 * 256 * 2;
constexpr size_t WS_WS5 = WS_TS5 + (size_t)2 * 16 * 1024 * 1280 * 2;
constexpr size_t WS_W1 = WS_WS5 + (size_t)2 * 16 * 256 * 1024 * 2;
constexpr size_t WS_W2 = WS_W1 + (size_t)32 * 2048 * 1024 * 2;
constexpr size_t WS_X = WS_W2 + (size_t)32 * 1024 * 1024 * 2;
constexpr size_t WS_H = WS_X + (size_t)TT * 1024 * 4;
constexpr size_t WS_LIST = WS_H + (size_t)TT * 1024 * 2;
constexpr size_t WS_TOPW = WS_LIST + (size_t)32 * TT * 8;
constexpr size_t WS_RA = WS_TOPW + (size_t)TT * 4 * 4;
constexpr size_t WS_RY = WS_RA + (size_t)TT * 4 * 1024 * 2;
constexpr size_t WS_END = WS_RY + (size_t)TT * 4 * 1024 * 2;
constexpr size_t WS_P = WS_RA;
constexpr size_t WS_ACONV = WS_P + (size_t)TT * NINP * 2;
constexpr size_t WS_APOOL = WS_ACONV + (size_t)TT * 256 * 2;
constexpr size_t WS_RAWQ = WS_APOOL + (size_t)TT * 256 * 2;
constexpr size_t WS_RAWKV = WS_RAWQ + (size_t)TT * 512 * 4;
constexpr size_t WS_Q = WS_RAWKV + (size_t)TT * 512 * 4;
constexpr size_t WS_KB = WS_Q + (size_t)TT * 384 * 2;
constexpr size_t WS_VT = WS_KB + (size_t)128 * 2304 * 96 * 2;
constexpr size_t WS_SST = WS_VT + (size_t)128 * 64 * 2304 * 2;
constexpr size_t WS_HIN = WS_SST + (size_t)NCROW * 16 * 256 * 4;
constexpr size_t WS_Z = WS_HIN + (size_t)NCROW * 16 * 256 * 2;
constexpr size_t WS_CAT = WS_Z + (size_t)TT * 256 * 2;
constexpr size_t WS_MIX_END = WS_CAT + (size_t)TT * 1024 * 2;
static_assert(WS_MIX_END <= WS_END, "mixer buffers must fit in the ACT/Y regions");
static_assert(WS_END <= (size_t)2147483648ull, "workspace budget");

constexpr int LDS_BYTES = 147456;
constexpr int LDS_MISC = 146432;

struct Params {
    const float *x, *c, *ctx, *c_ctx, *ada_w, *ada_b, *norm1_g, *norm2_g, *w_mix_in, *w_mix_out,
        *conv_dw, *conv_dw_b, *conv_ln_g, *conv_ln_b, *conv_pw, *pool_w, *pool_scale,
        *ssm_a_re, *ssm_a_im, *ssm_log_dt, *ssm_b_re, *ssm_b_im, *ssm_c_re, *ssm_c_im, *ssm_d, *ssm_glu_w, *ssm_glu_b,
        *mla_q_a_g, *mla_wq_b, *mla_kv_a_g, *mla_wkv_b, *mla_q_g, *mla_k_g,
        *router_w, *router_b, *exp_w_in, *exp_b_in, *exp_w_out, *exp_b_out;
    float* out;
    char* ws;
    long long ph_lo, ph_hi;
};

typedef const __attribute__((address_space(4))) char* kaptr_t;
template <int OFF> DI unsigned long long kld64(kaptr_t ka, int tok) {
    unsigned long long v;
    asm("s_load_dwordx2 %0, %1, %3\n\ts_waitcnt lgkmcnt(0)" : "=&s"(v) : "s"(ka), "s"(tok), "n"(OFF));
    return v;
}
DI int ptoken() { int t; asm volatile("s_mov_b32 %0, 0" : "=s"(t)); return t; }
DI Params kparams(kaptr_t ka, int tok) {
    Params p;
#define KL_(f) p.f = (decltype(p.f))((__attribute__((address_space(1))) char*)kld64<__builtin_offsetof(Params, f)>(ka, tok))
    KL_(x); KL_(c); KL_(ctx); KL_(c_ctx); KL_(ada_w); KL_(ada_b); KL_(norm1_g); KL_(norm2_g); KL_(w_mix_in); KL_(w_mix_out); KL_(conv_dw); KL_(conv_dw_b); KL_(conv_ln_g); KL_(conv_ln_b); KL_(conv_pw); KL_(pool_w); KL_(pool_scale); KL_(ssm_a_re); KL_(ssm_a_im); KL_(ssm_log_dt); KL_(ssm_b_re); KL_(ssm_b_im); KL_(ssm_c_re); KL_(ssm_c_im); KL_(ssm_d); KL_(ssm_glu_w); KL_(ssm_glu_b); KL_(mla_q_a_g); KL_(mla_wq_b); KL_(mla_kv_a_g); KL_(mla_wkv_b); KL_(mla_q_g); KL_(mla_k_g); KL_(router_w); KL_(router_b); KL_(exp_w_in); KL_(exp_b_in); KL_(exp_w_out); KL_(exp_b_out); KL_(out); KL_(ws);
#undef KL_
    p.ph_lo = 0; p.ph_hi = 0;
    return p;
}

typedef __bf16 bf16v2_t __attribute__((ext_vector_type(2)));
typedef float f32v2_t __attribute__((ext_vector_type(2)));
DI unsigned pk_bf16(float lo, float hi) { const f32v2_t f = {lo, hi}; const bf16v2_t b = __builtin_convertvector(f, bf16v2_t); return __builtin_bit_cast(unsigned, b); }
DI bf16_t f2bf(float x) { return (bf16_t)(pk_bf16(x, 0.f) & 0xffffu); }
DI float bf2f(bf16_t v) { return __uint_as_float(((unsigned)v) << 16); }
DI unsigned f2fp8(float x) { x = fminf(fmaxf(x, -448.f), 448.f); return (unsigned)__builtin_amdgcn_cvt_pk_fp8_f32(x, x, 0, false) & 0xffu; }
DI unsigned pk_fp8x4(float a, float b, float c, float d) { int v = __builtin_amdgcn_cvt_pk_fp8_f32(a, b, 0, false); v = __builtin_amdgcn_cvt_pk_fp8_f32(c, d, v, true); return (unsigned)v; }
DI float bflo(unsigned u) { return __uint_as_float(u << 16); }
DI float bfhi(unsigned u) { return __uint_as_float(u & 0xffff0000u); }
DI int olane() { int l = (int)__builtin_amdgcn_mbcnt_hi(~0u, __builtin_amdgcn_mbcnt_lo(~0u, 0u)); asm volatile("" : "+v"(l)); return l; }
DI float shx(float v, int o) { const int l = olane(); return __int_as_float(__builtin_amdgcn_ds_bpermute((l ^ o) << 2, __float_as_int(v))); }
DI float shi(float v, int src) { return __int_as_float(__builtin_amdgcn_ds_bpermute(src << 2, __float_as_int(v))); }
#define otid() otid_(wv_)
DI int otid_(int wv) { int t = (wv << 6) | olane(); asm volatile("" : "+v"(t)); return t; }
DI float wave_sum(float v) {
#pragma unroll
    for (int o = 32; o > 0; o >>= 1) v += shx(v, o);
    return v;
}
DI float wave_max(float v) {
#pragma unroll
    for (int o = 32; o > 0; o >>= 1) v = fmaxf(v, shx(v, o));
    return v;
}
DI float sigmoidf_(float x) { return __builtin_amdgcn_rcpf(1.f + __builtin_amdgcn_exp2f(-1.4426950408889634f * x)); }
DI float siluf_(float x) { return x * sigmoidf_(x); }
DI float gelu_tanh(float x) {
    const float u = 0.7978845608028654f * (x + 0.044715f * x * x * x);
    return x * __builtin_amdgcn_rcpf(1.f + __builtin_amdgcn_exp2f(-2.8853900817779268f * u));
}
DI void glds16(const void* src, LAS char* dst) {
    __builtin_amdgcn_global_load_lds((const __attribute__((address_space(1))) void*)src, (LAS void*)dst, 16, 0, 0);
}

#define XB_TMO      128
#define XB_XCNT(j)  (256  + 64 * (j))
#define XB_XSUB(j)  (1280 + 64 * (j))
#define XB_XGEN(j)  (2304 + 64 * (j))
#define XB_TOP      3328
#define XB_TOPGEN   3392
#define XCD_BAR_WORDS 3456
#define XB_SPIN_CAP (1u << 18)
__device__ __forceinline__ unsigned xb_ld(unsigned* p)              { return __hip_atomic_load(p, __ATOMIC_RELAXED, __HIP_MEMORY_SCOPE_AGENT); }
__device__ __forceinline__ unsigned xb_add(unsigned* p, unsigned v) { return __hip_atomic_fetch_add(p, v, __ATOMIC_RELAXED, __HIP_MEMORY_SCOPE_AGENT); }
__device__ __forceinline__ unsigned xb_xcc_id() { return (unsigned)__builtin_amdgcn_s_getreg((3 << 11) | 20) & 0xFu; }
#define XB_SPIN(cond, bar) do { unsigned _sp = 0; while (cond) { __builtin_amdgcn_s_sleep(1); \
    if ((++_sp & 255u) == 0u) { if (xb_ld(&(bar)[XB_TMO])) break; if (_sp > XB_SPIN_CAP) { atomicAdd(&(bar)[XB_TMO], 1u); break; } } } } while (0)
struct XcdBarrier { unsigned* bar; unsigned x; volatile LAS unsigned* st; };
__device__ __forceinline__ XcdBarrier xcd_barrier_post(unsigned* bar, volatile LAS unsigned* st, const int wv_) {
    XcdBarrier b; b.bar = bar; b.x = xb_xcc_id(); b.st = st;
    if (otid() == 0) (void)xb_add(&bar[XB_XCNT(b.x)], 1u);
    return b;
}
__device__ __forceinline__ void xcd_barrier_complete(unsigned* bar, unsigned x, unsigned& nloc, unsigned& nx) {
    const unsigned G = gridDim.x * gridDim.y * gridDim.z;
    unsigned sum, cnt, mine, sp = 0u;
    for (;;) {
        sum = 0u; cnt = 0u; mine = 0u;
#pragma unroll
        for (unsigned j = 0; j < 16; ++j) { const unsigned c = xb_ld(&bar[XB_XCNT(j)]); sum += c; cnt += (c > 0u) ? 1u : 0u; mine = (j == x) ? c : mine; }
        if (sum == G) break;
        __builtin_amdgcn_s_sleep(1);
        if ((++sp & 255u) == 0u) { if (xb_ld(&bar[XB_TMO])) break; if (sp > XB_SPIN_CAP) { atomicAdd(&bar[XB_TMO], 1u); break; } }
    }
    nloc = mine > 0u ? mine : 1u; nx = cnt > 0u ? cnt : 1u;
}
__device__ __forceinline__ void xcd_barrier(const XcdBarrier& b, const int wv_) {
    asm volatile("s_waitcnt vmcnt(0)" ::: "memory");
    __syncthreads();
    if (otid() == 0) {
        unsigned* bar = b.bar;
        __builtin_amdgcn_s_waitcnt(0);
        unsigned nloc = b.st[0], nx = b.st[1];
        if (nloc == 0u) { xcd_barrier_complete(bar, b.x, nloc, nx); b.st[0] = nloc; b.st[1] = nx; }
        const unsigned old = xb_add(&bar[XB_XSUB(b.x)], 1u);
        const unsigned gen = old / nloc;
        if (old + 1u == (gen + 1u) * nloc) {
            __builtin_amdgcn_fence(__ATOMIC_RELEASE, "agent");
            asm volatile("s_waitcnt vmcnt(0)" ::: "memory");
            const unsigned og = xb_add(&bar[XB_TOP], 1u);
            const unsigned tg = og / nx;
            if (og + 1u == (tg + 1u) * nx) xb_add(&bar[XB_TOPGEN], 1u);
            else XB_SPIN(xb_ld(&bar[XB_TOPGEN]) == tg, bar);
            __builtin_amdgcn_fence(__ATOMIC_ACQUIRE, "agent");
            xb_add(&bar[XB_XGEN(b.x)], 1u);
            asm volatile("s_waitcnt vmcnt(0)" ::: "memory");
        } else {
            XB_SPIN(xb_ld(&bar[XB_XGEN(b.x)]) == gen, bar);
            __builtin_amdgcn_fence(__ATOMIC_ACQUIRE, "agent");
            asm volatile("s_waitcnt vmcnt(0)" ::: "memory");
        }
    }
    __syncthreads();
}

constexpr int HTB = 128 * 64 * 2;
DI int lds_byte(int r, int c) { const int st = (r >> 4) * 2 + (c >> 5), rr = r & 15, cc = c & 31, ob = rr * 64 + cc * 2; return st * 1024 + (ob ^ (((ob >> 9) & 1) << 5)); }
DI void stage_rc(int b, int& R, int& C) { const int st = b / 1024, sb = b % 1024, swz = sb ^ (((sb >> 9) & 1) << 5); R = (st >> 1) * 16 + swz / 64; C = (st & 1) * 32 + (swz % 64) / 2; }

DI void stage_rc_t(int tz, int i, int& R, int& C) { stage_rc(tz * 16 + i * 8192, R, C); }
struct APlain {
    const char* base; int lda2;
    DI void park(LAS unsigned*) const {} DI void unpark(const LAS unsigned*) {} DI void take_uniform(const APlain&) {}
    DI const char* ptr(int tz, int h, int i, int kt) const { int R, C; stage_rc_t(tz, i, R, C); return base + (unsigned)((h * 128 + R) * lda2 + C * 2 + kt * 128); }
};
struct ASimple {
    const char* base; unsigned off[2][2]; unsigned kstride;
    DI void park(LAS unsigned* q) const { *(LAS u32x4*)q = (u32x4){off[0][0], off[0][1], off[1][0], off[1][1]}; }
    DI void unpark(const LAS unsigned* q) { const u32x4 v = *(const LAS u32x4*)q; off[0][0] = v.x; off[0][1] = v.y; off[1][0] = v.z; off[1][1] = v.w; }
    DI void take_uniform(const ASimple& o) { base = o.base; kstride = o.kstride; }
    DI const char* ptr(int tz, int h, int i, int kt) const { return base + (unsigned)(off[h][i] + (unsigned)kt * kstride); }
};
struct ASeg2 {
    const char* base0; const char* base1; unsigned off0[2][2]; unsigned off1[2][2]; unsigned ks0; int nt0;
    DI void park(LAS unsigned*) const {} DI void unpark(const LAS unsigned*) {} DI void take_uniform(const ASeg2&) {}
    DI const char* ptr(int tz, int h, int i, int kt) const { return kt < nt0 ? base0 + (unsigned)(off0[h][i] + (unsigned)kt * ks0) : base1 + (unsigned)(off1[h][i] + (unsigned)(kt - nt0) * 128u); }
};
struct BSimple {
    const char* base[2]; int ldb2;
    DI const char* ptr(int tz, int h, int i, int kt) const { int R, C; stage_rc_t(tz, i, R, C); return base[h] + (unsigned)(R * ldb2 + C * 2 + kt * 128); }
};

#define WAIT_V(n) asm volatile("s_waitcnt vmcnt(" #n ")" ::: "memory")
#define WAIT_L(n) asm volatile("s_waitcnt lgkmcnt(" #n ")" ::: "memory")
#define BAR_ __builtin_amdgcn_s_barrier()
#define SCHED_ __builtin_amdgcn_sched_barrier(0)

DI void zero_acc(f32x4 (&acc)[2][2][4][2]) {
#pragma unroll
    for (int a = 0; a < 2; ++a)
#pragma unroll
        for (int b = 0; b < 2; ++b)
#pragma unroll
            for (int m = 0; m < 4; ++m)
#pragma unroll
                for (int n = 0; n < 2; ++n) acc[a][b][m][n] = (f32x4){0.f, 0.f, 0.f, 0.f};
}
template <int MODE> struct FragT;
template <> struct FragT<0> {
    i32x4 lo, hi;
    DI void load(const LAS char* p0, const LAS char* p1) { lo = *(const LAS i32x4*)p0; hi = *(const LAS i32x4*)p1; }
    static DI f32x4 mma(const FragT& b, const FragT& a, f32x4 c) {
        c = __builtin_amdgcn_mfma_f32_16x16x32_bf16(__builtin_bit_cast(bf16x8, b.lo), __builtin_bit_cast(bf16x8, a.lo), c, 0, 0, 0);
        return __builtin_amdgcn_mfma_f32_16x16x32_bf16(__builtin_bit_cast(bf16x8, b.hi), __builtin_bit_cast(bf16x8, a.hi), c, 0, 0, 0); }
};
template <> struct FragT<1> {
    i32x4 lo, hi;
    DI void load(const LAS char* p0, const LAS char* p1) { lo = *(const LAS i32x4*)p0; hi = *(const LAS i32x4*)p1; }
    static DI long pk(int x, int y) { return (long)(((unsigned long long)(unsigned)y << 32) | (unsigned)x); }
    static DI f32x4 mma(const FragT& b, const FragT& a, f32x4 c) {
        c = __builtin_amdgcn_mfma_f32_16x16x32_fp8_fp8(pk(b.lo.x, b.lo.y), pk(a.lo.x, a.lo.y), c, 0, 0, 0);
        c = __builtin_amdgcn_mfma_f32_16x16x32_fp8_fp8(pk(b.lo.z, b.lo.w), pk(a.lo.z, a.lo.w), c, 0, 0, 0);
        c = __builtin_amdgcn_mfma_f32_16x16x32_fp8_fp8(pk(b.hi.x, b.hi.y), pk(a.hi.x, a.hi.y), c, 0, 0, 0);
        return __builtin_amdgcn_mfma_f32_16x16x32_fp8_fp8(pk(b.hi.z, b.hi.w), pk(a.hi.z, a.hi.w), c, 0, 0, 0); }
};
template <> struct FragT<2> {
    i32x8 v;
    DI void load(const LAS char* p0, const LAS char* p1) { const i32x4 lo = *(const LAS i32x4*)p0, hi = *(const LAS i32x4*)p1; v = __builtin_shufflevector(lo, hi, 0, 1, 2, 3, 4, 5, 6, 7); }
    static DI f32x4 mma(const FragT& b, const FragT& a, f32x4 c) {
        const int one = 0x7f7f7f7f;
        asm volatile("v_mfma_scale_f32_16x16x128_f8f6f4 %0, %1, %2, %0, %3, %3 op_sel_hi:[0,0,0]" : "+v"(c) : "v"(b.v), "v"(a.v), "v"(one));
        return c; }
};
template <class PV>
DI void gemm_stream(LAS char* shm, const PV& pv, const int wv_) {
    typedef typename PV::AS AS; typedef typename PV::BS BS;
    constexpr int nt = PV::NT;
    int u = pv.first();
    if (u < 0) return;
    const int tz = otid();
    const int wr = wv_ >> 2, wc = wv_ & 3, lane = tz & 63, fr = lane & 15, fq = lane >> 4;
    const int aoff = lds_byte(wr * 64 + fr, fq * 8), boff = lds_byte(wc * 32 + fr, fq * 8);
    const unsigned ldsw = (unsigned)wv_ * 1024u;
    f32x4 acc[2][2][4][2]; zero_acc(acc);
    typedef FragT<PV::FP8> Frag;
    Frag At[4], B0[2], B1[2];
    AS ca, na; BS cb, nb;
    pv.src(u, ca, cb, wv_);
    constexpr bool F8 = PV::FP8 != 0;
    LAS unsigned* park = (LAS unsigned*)(shm + 131072) + tz * 4;
    const int aoff0 = F8 ? lds_byte(wr * 64 + fr, fq * 16) : aoff, aoff1 = F8 ? aoff0 + 16 : aoff + 1024;
    const int boff0 = F8 ? lds_byte(wc * 32 + fr, fq * 16) : boff, boff1 = F8 ? boff0 + 16 : boff + 1024;
#define SA_(b, h) (((b) * 2 + (h)) * HTB)
#define SB_(b, h) ((4 + (b) * 2 + (h)) * HTB)
#define STG_(bufoff, S, h, kt) do { _Pragma("unroll") for (int i_ = 0; i_ < 2; ++i_) glds16((S).ptr(tz, h, i_, kt), shm + (bufoff) + ldsw + i_ * 8192); } while (0)
#define LDA_(dst, b, h) do { _Pragma("unroll") for (int m = 0; m < 4; ++m) dst[m].load(shm + SA_(b, h) + aoff0 + m * 2048, shm + SA_(b, h) + aoff1 + m * 2048); } while (0)
#define LDB_(dst, b, h) do { _Pragma("unroll") for (int n = 0; n < 2; ++n) dst[n].load(shm + SB_(b, h) + boff0 + n * 2048, shm + SB_(b, h) + boff1 + n * 2048); } while (0)
#define MMA_(ai, bj, A_, B_) do { __builtin_amdgcn_s_setprio(1); \
        _Pragma("unroll") for (int m = 0; m < 4; ++m) _Pragma("unroll") for (int n = 0; n < 2; ++n) { \
            acc[ai][bj][m][n] = Frag::mma(B_[n], A_[m], acc[ai][bj][m][n]); } \
        __builtin_amdgcn_s_setprio(0); } while (0)
    STG_(SB_(0, 0), cb, 0, 0); STG_(SA_(0, 0), ca, 0, 0); STG_(SB_(0, 1), cb, 1, 0); STG_(SA_(0, 1), ca, 1, 0);
    if (wr == 1) BAR_;
    WAIT_V(4); BAR_;
    STG_(SB_(1, 0), cb, 0, 1); STG_(SA_(1, 0), ca, 0, 1); STG_(SB_(1, 1), cb, 1, 1);
    WAIT_V(6); BAR_;
    for (;;) {
        const int un = pv.next(u); const bool has_next = un >= 0;
        if (has_next) pv.src(un, na, nb, wv_); else { na = ca; nb = cb; }
        if (PV::PARK) { na.park(park); asm volatile("s_waitcnt lgkmcnt(0)" ::: "memory"); }
#pragma clang loop unroll(disable)
        for (int t = 0; t < nt; t += 2) {
            const bool last = (t == nt - 2);
            AS a2 = last ? na : ca; const BS b2 = last ? nb : cb; const int k2 = last ? 0 : t + 2;
            if (PV::PARK) { if (last) a2.unpark(park); }
            LDB_(B0, 0, 0); SCHED_; LDA_(At, 0, 0); STG_(SA_(1, 1), ca, 1, t + 1);
            WAIT_L(8); BAR_; WAIT_L(0); MMA_(0, 0, At, B0); BAR_; SCHED_;
            LDB_(B1, 0, 1); STG_(SB_(0, 0), b2, 0, k2);
            BAR_; WAIT_L(0); MMA_(0, 1, At, B1); BAR_;
            LDA_(At, 0, 1); STG_(SA_(0, 0), a2, 0, k2);
            BAR_; WAIT_L(0); MMA_(1, 0, At, B0); BAR_; SCHED_;
            STG_(SB_(0, 1), b2, 1, k2);
            WAIT_V(6); BAR_; MMA_(1, 1, At, B1); BAR_;
            LDB_(B0, 1, 0); SCHED_; LDA_(At, 1, 0); STG_(SA_(0, 1), a2, 1, k2);
            WAIT_L(8); BAR_; WAIT_L(0); MMA_(0, 0, At, B0); BAR_; SCHED_;
            LDB_(B1, 1, 1); STG_(SB_(1, 0), b2, 0, k2 + 1);
            BAR_; WAIT_L(0); MMA_(0, 1, At, B1); BAR_;
            LDA_(At, 1, 1); STG_(SA_(1, 0), a2, 0, k2 + 1);
            BAR_; WAIT_L(0); MMA_(1, 0, At, B0); BAR_; SCHED_;
            STG_(SB_(1, 1), b2, 1, k2 + 1);
            WAIT_V(6); BAR_; MMA_(1, 1, At, B1); BAR_;
            if (PV::PARK) { if (last) ca = a2; }
        }
        if (PV::FP8 == 2) asm volatile("s_nop 15\n\ts_nop 15" ::: "memory");
        pv.epi(acc, u, wv_);
        if (!has_next) break;
        zero_acc(acc);
        u = un; if (!PV::PARK) ca = na; cb = nb;
        if (PV::PARK) ca.take_uniform(na);
    }
    WAIT_V(0);
    if (wr == 0) BAR_;
    BAR_;
#undef SA_
#undef SB_
#undef STG_
#undef LDA_
#undef LDB_
#undef MMA_
}
DI int lin_first(int shift, int count) { const int G = gridDim.x; const int u = (int)((blockIdx.x + G - (shift % G)) % G); return u < count ? u : -1; }
DI int lin_next(int u, int count) { const int un = u + (int)gridDim.x; return un < count ? un : -1; }
template <int MG, int NTL> struct XcdDeal {
    int MT;
    DI bool decode(int J, int& mt, int& nt) const { const int x = blockIdx.x & 7; const int grp = (J / (MG * NTL)) * 8 + x, w = J % (MG * NTL); mt = grp * MG + w / NTL; nt = w % NTL; return mt < MT; }
    DI int jmax() const { return ((MT + 8 * MG - 1) / (8 * MG)) * (MG * NTL); }
    DI int first() const { int J = blockIdx.x >> 3; const int per = gridDim.x >> 3, jm = jmax(); int mt, nt;
        while (J < jm && !decode(J, mt, nt)) J += per;
        return J < jm ? J : -1; }
    DI int next(int J) const { const int per = gridDim.x >> 3, jm = jmax(); int mt, nt; J += per;
        while (J < jm && !decode(J, mt, nt)) J += per;
        return J < jm ? J : -1; }
};
DI int first_unit(int shift) { const int G = gridDim.x; return (int)((blockIdx.x + G - (shift % G)) % G); }

DI void stage_coords(int (&R)[2], int (&C)[2], const int wv_) {
    const int t_ = otid();
#pragma unroll
    for (int i = 0; i < 2; ++i) stage_rc(t_ * 16 + i * 8192, R[i], C[i]);
}
DI APlain make_a_plain(const bf16_t* A, size_t row0, int lda, int col0) {
    APlain a; a.base = (const char*)(A + row0 * (size_t)lda + col0); a.lda2 = lda * 2; return a;
}
DI BSimple make_b(const bf16_t* Bt0, const bf16_t* Bt1, int ldb) {
    BSimple b; b.base[0] = (const char*)Bt0; b.base[1] = (const char*)Bt1; b.ldb2 = ldb * 2; return b;
}
#define EPI_FOR(acc, ...) do { const int _tz = otid(), _w = _tz >> 6, _l = _tz & 63, _wr = _w >> 2, _wc = _w & 3, _fr = _l & 15, _fq = _l >> 4; \
    _Pragma("unroll") for (int ai = 0; ai < 2; ++ai) _Pragma("unroll") for (int m = 0; m < 4; ++m) { const int lr = ai * 128 + _wr * 64 + m * 16 + _fr; \
    _Pragma("unroll") for (int bj = 0; bj < 2; ++bj) _Pragma("unroll") for (int n = 0; n < 2; ++n) { const int lc = bj * 128 + _wc * 32 + n * 16 + _fq * 4; const f32x4 v = acc[ai][bj][m][n]; __VA_ARGS__ } } } while (0)

DI void store_bf16x4(bf16_t* p, float a, float b, float c, float d) { u32x2 v; v.x = pk_bf16(a, b); v.y = pk_bf16(c, d); *(u32x2*)p = v; }

DI int mod_row(int r) { return r < TX ? (r >> 11) : 32; }
DI int crow_tok(int cr) { const int b = cr / NCH, j = cr - b * NCH; return j < 4 ? TX + b * CTXL + j * 64 : b * SEQ + (j - 4) * 64; }

DI void cvt_tile(LAS char* wl  , const float* src, int ld_src, int kvalid, int nvalid, const float* scale, bf16_t* dst, int ld_dst, const int wv_) {
    const int lane = otid() & 63;
    const int lr = lane >> 4, lc = (lane & 15) * 4;
    f32x4 v[16];
#pragma unroll
    for (int it = 0; it < 16; ++it) {
        const int k = it * 4 + lr;
        v[it] = (f32x4){0.f, 0.f, 0.f, 0.f};
        if (src != nullptr && k < kvalid && lc < nvalid) { v[it] = *(const f32x4*)(src + (size_t)k * ld_src + lc); if (scale) { const float s = scale[k]; v[it] *= s; } }
    }
#pragma unroll
    for (int it = 0; it < 16; ++it) {
        const int k = it * 4 + lr;
#pragma unroll
        for (int j = 0; j < 4; ++j) *(LAS bf16_t*)(wl + (lc + j) * 144 + k * 2) = f2bf(v[it][j]);
    }
    asm volatile("s_waitcnt lgkmcnt(0)" ::: "memory");
#pragma unroll
    for (int i = 0; i < 8; ++i) {
        const int q = i * 64 + lane, n = q >> 3, c = q & 7;
        const u32x4 w = *(const LAS u32x4*)(wl + n * 144 + c * 16);
        *(u32x4*)(dst + (size_t)n * ld_dst + c * 8) = w;
    }
    asm volatile("s_waitcnt lgkmcnt(0)" ::: "memory");
}
DI void cvt_tile8(LAS char* wl  , const float* src, int ld_src, unsigned char* dst, int ld_dst, const int wv_) {
    const int lane = otid() & 63;
    const int lr = lane >> 4, lc = (lane & 15) * 4;
    f32x4 v[16];
#pragma unroll
    for (int it = 0; it < 16; ++it) v[it] = *(const f32x4*)(src + (size_t)(it * 4 + lr) * ld_src + lc);
#pragma unroll
    for (int it = 0; it < 16; ++it) {
        const int k = it * 4 + lr;
#pragma unroll
        for (int j = 0; j < 4; ++j) *(LAS unsigned char*)(wl + (lc + j) * 80 + k) = (unsigned char)f2fp8(v[it][j] * 256.f);
    }
    asm volatile("s_waitcnt lgkmcnt(0)" ::: "memory");
#pragma unroll
    for (int i = 0; i < 4; ++i) {
        const int q = i * 64 + lane, n = q >> 2, c = q & 3;
        const u32x4 w = *(const LAS u32x4*)(wl + n * 80 + c * 16);
        *(u32x4*)(dst + (size_t)n * ld_dst + c * 16) = w;
    }
    asm volatile("s_waitcnt lgkmcnt(0)" ::: "memory");
}
constexpr int CVT_SMALL_TILES = 768 + 512 + 32 + 32 + 64 + 64 + 32;
constexpr int CVT_EXP_TILES = 32 * (32 * 16 + 16 * 16);
DI void cvt_small(const Params& p, LAS char* wl, int t, const int wv_) {
    char* ws = p.ws;
    if (t < 768) { const int l = t / 384, r = t % 384, nt = r / 16, kt = r % 16;
        cvt_tile(wl, p.w_mix_in + (size_t)l * 1024 * N_IN + (size_t)kt * 64 * N_IN + nt * 64, N_IN, 64, N_IN - nt * 64, nullptr,
                 (bf16_t*)(ws + WS_WMI) + ((size_t)l * 1536 + nt * 64) * 1024 + kt * 64, 1024, wv_); return; }
    t -= 768;
    if (t < 512) { const int l = t / 256, r = t % 256, nt = r / 16, kt = r % 16;
        cvt_tile(wl, p.w_mix_out + (size_t)l * 1024 * 1024 + (size_t)kt * 64 * 1024 + nt * 64, 1024, 64, 64, nullptr,
                 (bf16_t*)(ws + WS_WMO) + ((size_t)l * 1024 + nt * 64) * 1024 + kt * 64, 1024, wv_); return; }
    t -= 512;
    if (t < 32) { const int l = t / 16, r = t % 16, nt = r / 4, kt = r % 4;
        cvt_tile(wl, p.conv_pw + (size_t)l * 65536 + (size_t)kt * 64 * 256 + nt * 64, 256, 64, 64, nullptr,
                 (bf16_t*)(ws + WS_WPW) + ((size_t)l * 256 + nt * 64) * 256 + kt * 64, 256, wv_); return; }
    t -= 32;
    if (t < 32) { const int l = t / 16, r = t % 16, nt = r / 4, kt = r % 4;
        cvt_tile(wl, p.ssm_glu_w + (size_t)l * 65536 + (size_t)kt * 64 * 256 + nt * 64, 256, 64, 64, nullptr,
                 (bf16_t*)(ws + WS_WGLU) + ((size_t)l * 256 + nt * 64) * 256 + kt * 64, 256, wv_); return; }
    t -= 32;
    if (t < 64) { const int l = t / 32, r = t % 32, nt = r / 4, kt = r % 4;
        const bool any = (kt < 3) && (nt < 6);
        cvt_tile(wl, any ? p.mla_wq_b + (size_t)l * 192 * 384 + (size_t)kt * 64 * 384 + nt * 64 : nullptr, 384, 64, 64, p.mla_q_a_g + l * 192 + kt * 64,
                 (bf16_t*)(ws + WS_WQ) + ((size_t)l * 512 + nt * 64) * 256 + kt * 64, 256, wv_); return; }
    t -= 64;
    if (t < 64) { const int l = t / 32, r = t % 32, nt = r / 4, kt = r % 4;
        const bool any = (kt < 2);
        cvt_tile(wl, any ? p.mla_wkv_b + (size_t)l * 128 * 512 + (size_t)kt * 64 * 512 + nt * 64 : nullptr, 512, 64, 64, p.mla_kv_a_g + l * 128 + kt * 64,
                 (bf16_t*)(ws + WS_WKV) + ((size_t)l * 512 + nt * 64) * 256 + kt * 64, 256, wv_); return; }
    t -= 64;
    { const int l = t / 16, r = t % 16, nt = r / 4, kt = r % 4;
        cvt_tile(wl, nt == kt ? p.pool_w + ((size_t)l * 4 + nt) * 4096 : nullptr, 64, 64, 64, nullptr,
                 (bf16_t*)(ws + WS_WPOOL) + ((size_t)l * 256 + nt * 64) * 256 + kt * 64, 256, wv_); }
}
DI void cvt_expert(const Params& p, LAS char* wl, int l, int t, const int wv_) {
    char* ws = p.ws;
    const int e = t / 768, r = t % 768;
    if (r < 512) { const int nt = r / 16, kt = r % 16;
        cvt_tile8(wl, p.exp_w_in + ((size_t)(l * NE + e) * 1024 + kt * 64) * 2048 + nt * 64, 2048,
                  (unsigned char*)(ws + WS_W1) + ((size_t)(l * NE + e) * 2048 + nt * 64) * 1024 + kt * 64, 1024, wv_);
    } else { const int q = r - 512, nt = q / 16, kt = q % 16;
        cvt_tile8(wl, p.exp_w_out + ((size_t)(l * NE + e) * 1024 + kt * 64) * 1024 + nt * 64, 1024,
                  (unsigned char*)(ws + WS_W2) + ((size_t)(l * NE + e) * 1024 + nt * 64) * 1024 + kt * 64, 1024, wv_);
    }
}

DI void ada_unit(const Params& p, LAS char* shm, int u, const int wv_) {
    const int tid = otid();
    const int l = u / 48, jc = u % 48;
    LAS float* sc = (LAS float*)shm;
    for (int i = tid; i < 33 * 1024; i += 512) { const int r = i >> 10, k = i & 1023; const float v = r < 32 ? p.c[r * 1024 + k] : p.c_ctx[k]; sc[i] = siluf_(v); }
    __syncthreads();
    const int col = tid & 127, kq = tid >> 7;
    float acc[33];
#pragma unroll
    for (int r = 0; r < 33; ++r) acc[r] = 0.f;
    const float* wp = p.ada_w + ((size_t)l * 1024 + kq * 256) * 6144 + jc * 128 + col;
    for (int k4 = 0; k4 < 256; k4 += 4) {
        float w[4];
#pragma unroll
        for (int i = 0; i < 4; ++i) w[i] = wp[(size_t)(k4 + i) * 6144];
#pragma unroll
        for (int r = 0; r < 33; ++r) { const f32x4 s = *(const LAS f32x4*)(sc + r * 1024 + kq * 256 + k4); acc[r] += s[0] * w[0] + s[1] * w[1] + s[2] * w[2] + s[3] * w[3]; }
    }
    __syncthreads();
    LAS float* red = (LAS float*)shm;
#pragma unroll
    for (int r = 0; r < 33; ++r) red[(kq * 33 + r) * 128 + col] = acc[r];
    __syncthreads();
    for (int i = tid; i < 33 * 128; i += 512) { const int r = i >> 7, cc = i & 127;
        const float s = red[(0 * 33 + r) * 128 + cc] + red[(1 * 33 + r) * 128 + cc] + red[(2 * 33 + r) * 128 + cc] + red[(3 * 33 + r) * 128 + cc];
        ((float*)(p.ws + WS_MOD))[((size_t)l * 33 + r) * 6144 + jc * 128 + cc] = s + p.ada_b[l * 6144 + jc * 128 + cc]; }
    __syncthreads();
}

DI void s5_load_bc(const Params& p, LAS float* bb, LAS float* cc, int l, int dir, int g, int tid) {
    const int pbase = ((l * 2 + dir) * 16 + g) * 64;
    const double dt = exp((double)p.ssm_log_dt[(l * 2 + dir) * 16 + g]);
    for (int i = tid; i < 64 * 16; i += 512) { const int q = i >> 4, ci = i & 15;
        const double are = fmin((double)p.ssm_a_re[pbase + q], -1e-4), aim = (double)p.ssm_a_im[pbase + q];
        const double mg = exp(are * dt), abr = mg * cos(aim * dt), abi = mg * sin(aim * dt), den = are * are + aim * aim;
        const double fre = ((abr - 1.0) * are + abi * aim) / den, fim = (abi * are - (abr - 1.0) * aim) / den;
        const double br = (double)p.ssm_b_re[(size_t)(pbase + q) * 16 + ci], bi = (double)p.ssm_b_im[(size_t)(pbase + q) * 16 + ci];
        bb[i * 2] = (float)(fre * br - fim * bi); bb[i * 2 + 1] = (float)(fre * bi + fim * br); }
    for (int i = tid; i < 16 * 64; i += 512) { const int co = i >> 6, q = i & 63;
        const size_t ix = ((size_t)((l * 2 + dir) * 16 + g) * 16 + co) * 64 + q;
        cc[i * 2] = p.ssm_c_re[ix]; cc[i * 2 + 1] = p.ssm_c_im[ix]; }
}
DI void s5pre_unit(const Params& p, LAS char* shm, int u, const int wv_) {
    const int tid = otid();
    const int l = u >> 5, g = (u >> 1) & 15, dir = u & 1;
    LAS float* pw = (LAS float*)shm;
    LAS float* bb = pw + 65 * 64 * 2;
    LAS float* cc = bb + 64 * 16 * 2;
    LAS float* kk = cc + 16 * 64 * 2;
    LAS float* k0o = kk + 64 * 256;
    bf16_t* TS = (bf16_t*)(p.ws + WS_TS5) + (size_t)(l * 16 + g) * 1024 * 1280;
    bf16_t* WS = (bf16_t*)(p.ws + WS_WS5) + (size_t)(l * 16 + g) * 256 * 1024;
    const int cocip = tid & 255, co_ = cocip >> 4, ci_ = cocip & 15;
    if (dir == 0) {
        s5_load_bc(p, bb, cc, l, 1, g, tid);
        __syncthreads();
        if (tid < 256) { float s_ = 0.f;
            for (int q = 0; q < 64; ++q) s_ += cc[(co_ * 64 + q) * 2] * bb[(q * 16 + ci_) * 2] - cc[(co_ * 64 + q) * 2 + 1] * bb[(q * 16 + ci_) * 2 + 1];
            k0o[tid] = s_; }
        __syncthreads();
    }
    {
        const int pbase = ((l * 2 + dir) * 16 + g) * 64;
        const double dt = exp((double)p.ssm_log_dt[(l * 2 + dir) * 16 + g]);
        for (int i = tid; i < 65 * 64; i += 512) { const int tau = i >> 6, q = i & 63;
            const double are = fmin((double)p.ssm_a_re[pbase + q], -1e-4), aim = (double)p.ssm_a_im[pbase + q];
            const double mg = exp(are * dt * tau), an = aim * dt * tau;
            pw[i * 2] = (float)(mg * cos(an)); pw[i * 2 + 1] = (float)(mg * sin(an)); }
        s5_load_bc(p, bb, cc, l, dir, g, tid);
        __syncthreads();
        if (tid < 64) { float* a64 = (float*)(p.ws + WS_A64) + (size_t)(((l * 2 + dir) * 16 + g) * 64 + tid) * 2; a64[0] = pw[(64 * 64 + tid) * 2]; a64[1] = pw[(64 * 64 + tid) * 2 + 1]; }
        { float gr[64], gi[64];
#pragma unroll
          for (int q = 0; q < 64; ++q) { const float cr = cc[(co_ * 64 + q) * 2], cim = cc[(co_ * 64 + q) * 2 + 1], br = bb[(q * 16 + ci_) * 2], bi = bb[(q * 16 + ci_) * 2 + 1];
              gr[q] = cr * br - cim * bi; gi[q] = cr * bi + cim * br; }
          for (int tau = (tid >> 8); tau < 64; tau += 2) {
              float s_ = 0.f;
#pragma unroll
              for (int q = 0; q < 64; ++q) s_ += gr[q] * pw[(tau * 64 + q) * 2] - gi[q] * pw[(tau * 64 + q) * 2 + 1];
              kk[tau * 256 + cocip] = s_;
          } }
        for (int i = tid; i < 128 * 512; i += 512) { const int row = i >> 9, kp = (i & 511) * 2, ri = row >> 6, q = row & 63, s_ = kp >> 4, ci = kp & 15;
            const int e = dir == 0 ? 63 - s_ : s_;
            const float pr = pw[(e * 64 + q) * 2], pi = pw[(e * 64 + q) * 2 + 1];
            float o[2];
#pragma unroll
            for (int j = 0; j < 2; ++j) { const float br = bb[(q * 16 + ci + j) * 2], bi = bb[(q * 16 + ci + j) * 2 + 1]; o[j] = ri == 0 ? pr * br - pi * bi : pr * bi + pi * br; }
            *(unsigned*)(WS + (size_t)(dir * 128 + row) * 1024 + kp) = pk_bf16(o[0], o[1]); }
        for (int i = tid; i < 1024 * 64; i += 512) { const int row = i >> 6, kp = (i & 63) * 2, t = row >> 4, co = row & 15, ri = kp >> 6, q = kp & 63;
            const int e = dir == 0 ? t + 1 : 64 - t;
            float o[2];
#pragma unroll
            for (int j = 0; j < 2; ++j) { const float pr = pw[(e * 64 + q + j) * 2], pi = pw[(e * 64 + q + j) * 2 + 1];
                const float cr = cc[(co * 64 + q + j) * 2], cim = cc[(co * 64 + q + j) * 2 + 1];
                o[j] = ri == 0 ? (cr * pr - cim * pi) : -(cr * pi + cim * pr); }
            *(unsigned*)(TS + (size_t)row * 1280 + 1024 + dir * 128 + kp) = pk_bf16(o[0], o[1]); }
        __syncthreads();
        for (int rr = tid; rr < 1024; rr += 512) { const int t = rr >> 4, co = rr & 15;
            const float dco = p.ssm_d[l * 256 + g * 16 + co];
            bf16_t* rowp = TS + (size_t)rr * 1280;
            const int s_lo = dir == 0 ? 0 : t + 1, s_hi = dir == 0 ? t : 63;
            for (int s_ = s_lo; s_ <= s_hi; ++s_) { const int tau = dir == 0 ? t - s_ : s_ - t;
                unsigned w[8];
#pragma unroll
                for (int j = 0; j < 8; ++j) { float a = kk[tau * 256 + co * 16 + 2 * j], b2 = kk[tau * 256 + co * 16 + 2 * j + 1];
                    if (s_ == t) { a += k0o[co * 16 + 2 * j]; b2 += k0o[co * 16 + 2 * j + 1]; if (2 * j == co) a += dco; if (2 * j + 1 == co) b2 += dco; }
                    w[j] = pk_bf16(a, b2); }
                *(u32x4*)(rowp + s_ * 16) = (u32x4){w[0], w[1], w[2], w[3]}; *(u32x4*)(rowp + s_ * 16 + 8) = (u32x4){w[4], w[5], w[6], w[7]}; }
        }
        __syncthreads();
    }
}

DI void phase_prologue(const Params& p, LAS char* shm, const int wv_) {
    const int tid = otid();
    __syncthreads();
    if (blockIdx.x == 0 && tid < 64) ((int*)(p.ws + WS_CNT))[tid] = 0;
    const int n_cvt = (CVT_SMALL_TILES + 2 * CVT_EXP_TILES + 7) / 8;
    const int n_units = 64 + 96 + n_cvt;
    for (int u = blockIdx.x; u < n_units; u += gridDim.x) {
        if (u < 64) s5pre_unit(p, shm, u, wv_);
        else if (u < 160) ada_unit(p, shm, u - 64, wv_);
        else {
            const int t = (u - 160) * 8 + (tid >> 6);
            LAS char* wl = shm + (tid >> 6) * (64 * 144);
            if (t < CVT_SMALL_TILES) cvt_small(p, wl, t, wv_);
            else if (t < CVT_SMALL_TILES + 2 * CVT_EXP_TILES) { const int te = t - CVT_SMALL_TILES; cvt_expert(p, wl, te / CVT_EXP_TILES, te % CVT_EXP_TILES, wv_); }
        }
    }
}

DI void norm_mod_store(const float (&v)[16], const float* g, const float* modrow  , bf16_t* hrow, const int wv_) {
    const int lane = otid() & 63;
    float ss = 0.f;
#pragma unroll
    for (int i = 0; i < 16; ++i) ss += v[i] * v[i];
    ss = wave_sum(ss);
    const float rn = rsqrtf(ss * (1.f / 1024.f) + EPS);
#pragma unroll
    for (int j = 0; j < 4; ++j) {
        const int col = j * 256 + lane * 4;
        const f32x4 gg = *(const f32x4*)(g + col), sh = *(const f32x4*)(modrow + col), sc = *(const f32x4*)(modrow + 1024 + col);
        float o[4];
#pragma unroll
        for (int i = 0; i < 4; ++i) o[i] = v[j * 4 + i] * rn * gg[i] * (1.f + sc[i]) + sh[i];
        store_bf16x4(hrow + col, o[0], o[1], o[2], o[3]);
    }
}
DI void phase_norm1_l0(const Params& p, const int wv_) {
    const int tid_ = otid(); const int wid = tid_ >> 6, lane = tid_ & 63;
    const float* MOD = (const float*)(p.ws + WS_MOD);
    bf16_t* H = (bf16_t*)(p.ws + WS_H);
    for (int r = blockIdx.x * 8 + wid; r < TT; r += gridDim.x * 8) {
        const float* src = r < TX ? p.x + (size_t)r * 1024 : p.ctx + (size_t)(r - TX) * 1024;
        float v[16];
#pragma unroll
        for (int j = 0; j < 4; ++j) { const f32x4 t = *(const f32x4*)(src + j * 256 + lane * 4); v[j * 4] = t[0]; v[j * 4 + 1] = t[1]; v[j * 4 + 2] = t[2]; v[j * 4 + 3] = t[3]; }
        norm_mod_store(v, p.norm1_g, MOD + (size_t)(0 * 33 + mod_row(r)) * 6144, H + (size_t)r * 1024, wv_);
    }
}

struct PvInproj {
    const Params& p; int l;
    static constexpr int NT = 16; static constexpr int FP8 = 0; static constexpr bool PARK = false; typedef APlain AS; typedef BSimple BS;
    XcdDeal<4, 6> deal;
    DI int first() const { return deal.first(); }
    DI int next(int u) const { return deal.next(u); }
    DI void src(int u, AS& a, BS& b, const int wv_) const {
        int mt, nt; deal.decode(u, mt, nt);
        const bf16_t* W = (const bf16_t*)(p.ws + WS_WMI) + (size_t)l * 1536 * 1024;
        a = make_a_plain((const bf16_t*)(p.ws + WS_H), (size_t)mt * 256, 1024, 0);
        b = nt < 2 ? make_b(W + (size_t)(nt * 128) * 1024, W + (size_t)(256 + nt * 128) * 1024, 1024)
                   : make_b(W + (size_t)(nt * 256) * 1024, W + (size_t)(nt * 256 + 128) * 1024, 1024);
    }
    DI void epi(f32x4 (&acc)[2][2][4][2], int u, const int wv_) const {
        int mt, nt; deal.decode(u, mt, nt);
        bf16_t* P = (bf16_t*)(p.ws + WS_P);
        if (nt < 2) {
            const int _tz = otid(), _w = _tz >> 6, _l = _tz & 63, _wr = _w >> 2, _wc = _w & 3, _fr = _l & 15, _fq = _l >> 4;
#pragma unroll
            for (int ai = 0; ai < 2; ++ai)
#pragma unroll
                for (int m = 0; m < 4; ++m) { const int lr = ai * 128 + _wr * 64 + m * 16 + _fr;
#pragma unroll
                    for (int n = 0; n < 2; ++n) { const int lc = _wc * 32 + n * 16 + _fq * 4; const f32x4 va = acc[ai][0][m][n], ga = acc[ai][1][m][n];
                        store_bf16x4(P + (size_t)(mt * 256 + lr) * NINP + nt * 128 + lc, va[0] * sigmoidf_(ga[0]), va[1] * sigmoidf_(ga[1]), va[2] * sigmoidf_(ga[2]), va[3] * sigmoidf_(ga[3])); } }
        } else {
            EPI_FOR(acc, { store_bf16x4(P + (size_t)(mt * 256 + lr) * NINP + nt * 256 + lc, v[0], v[1], v[2], v[3]); });
        }
    }
};
DI void phase_inproj(const Params& p, LAS char* shm, int l, const int wv_) {
    PvInproj pv{p, l, {TT / 256}};
    gemm_stream(shm, pv, wv_);
}

template <int WIN>
DI void pool_run(const bf16_t* P, bf16_t* AP, int row0, int ts0, int L, int c, int half) {
    for (int blk = 0; blk < 2; ++blk) {
        const int t0 = half * 32 + blk * 16;
        float in[16 + WIN - 1];
#pragma unroll
        for (int i = 0; i < 16 + WIN - 1; ++i) { const int d = i - WIN / 2; const int ts = ts0 + t0 + d;
            in[i] = (ts >= 0 && ts < L) ? bf2f(P[(size_t)(row0 + t0 + d) * NINP + OFF_POOL + c]) : 0.f; }
        float sum = 0.f;
#pragma unroll
        for (int j = 0; j < WIN; ++j) sum += in[j];
#pragma unroll
        for (int o = 0; o < 16; ++o) {
            const int ts = ts0 + t0 + o;
            const int lo = max(ts - WIN / 2, 0), hi = min(ts + WIN - 1 - WIN / 2, L - 1);
            AP[(size_t)(row0 + t0 + o) * 256 + c] = f2bf(sum / (float)(hi - lo + 1) - in[o + WIN / 2]);
            if (o < 15) sum += in[o + WIN] - in[o];
        }
    }
}
DI void pre_unit(const Params& p, LAS char* shm, int l, int tile, const int wv_) {
    const int tid = otid();
    const bf16_t* P = (const bf16_t*)(p.ws + WS_P);
    int row0, ts0, L;
    if (tile < 1024) { row0 = tile * 64; ts0 = row0 & 2047; L = SEQ; } else { row0 = TX + (tile - 1024) * 64; ts0 = (row0 - TX) & 255; L = CTXL; }
    const int c = tid & 255, half = tid >> 8;
    LAS float* cv = (LAS float*)shm;
    {
        float w[31];
#pragma unroll
        for (int j = 0; j < 31; ++j) w[j] = p.conv_dw[((size_t)l * 31 + j) * 256 + c];
        const float bias = p.conv_dw_b[l * 256 + c];
        const int t0 = half * 32;
        float in[62];
#pragma unroll
        for (int i = 0; i < 62; ++i) {
            const int ts = ts0 + t0 - 15 + i;
            in[i] = (ts >= 0 && ts < L) ? bf2f(P[(size_t)(row0 + t0 - 15 + i) * NINP + c]) : 0.f;
        }
#pragma unroll
        for (int o = 0; o < 32; ++o) { float s_ = bias;
#pragma unroll
            for (int j = 0; j < 31; ++j) s_ += w[j] * in[o + j];
            cv[(t0 + o) * 257 + c] = s_; }
    }
    __syncthreads();
    {
        const int wid = tid >> 6, lane = tid & 63;
        bf16_t* AC = (bf16_t*)(p.ws + WS_ACONV);
        for (int t = wid; t < 64; t += 8) {
            float x[4]; float s_ = 0.f;
#pragma unroll
            for (int j = 0; j < 4; ++j) { x[j] = cv[t * 257 + lane + 64 * j]; s_ += x[j]; }
            const float mu = wave_sum(s_) * (1.f / 256.f);
            float q = 0.f;
#pragma unroll
            for (int j = 0; j < 4; ++j) { x[j] -= mu; q += x[j] * x[j]; }
            const float rs = rsqrtf(wave_sum(q) * (1.f / 256.f) + EPS);
#pragma unroll
            for (int j = 0; j < 4; ++j) { const int ch = lane + 64 * j; const float y = x[j] * rs * p.conv_ln_g[l * 256 + ch] + p.conv_ln_b[l * 256 + ch];
                AC[(size_t)(row0 + t) * 256 + ch] = f2bf(siluf_(y)); }
        }
    }
    {
        bf16_t* AP = (bf16_t*)(p.ws + WS_APOOL);
        const int g = __builtin_amdgcn_readfirstlane(c >> 6);
        if (g == 0) pool_run<2>(P, AP, row0, ts0, L, c, half);
        else if (g == 1) pool_run<4>(P, AP, row0, ts0, L, c, half);
        else if (g == 2) pool_run<8>(P, AP, row0, ts0, L, c, half);
        else pool_run<16>(P, AP, row0, ts0, L, c, half);
    }
    __syncthreads();
}
struct PvS5State {
    const Params& p; int l;
    static constexpr int NT = 16; static constexpr int FP8 = 0; static constexpr bool PARK = false; typedef ASimple AS; typedef BSimple BS;
    DI int first() const { return lin_first(0, 80); }
    DI int next(int u) const { return lin_next(u, 80); }
    DI void src(int u, AS& as, BS& bs, const int wv_) const {
        const int g = u / 5, mt = u % 5;
        int R[2], C[2]; stage_coords(R, C, wv_);
        as.base = (const char*)(p.ws + WS_P); as.kstride = 4 * NINP * 2;
#pragma unroll
        for (int h = 0; h < 2; ++h)
#pragma unroll
            for (int i = 0; i < 2; ++i) { const int cr = min(mt * 256 + h * 128 + R[i], NCROW - 1);
                as.off[h][i] = (unsigned)(((size_t)(crow_tok(cr) + (C[i] >> 4)) * NINP + OFF_SSM + g * 16 + (C[i] & 15)) * 2); }
        const bf16_t* W = (const bf16_t*)(p.ws + WS_WS5) + (size_t)(l * 16 + g) * 256 * 1024;
        bs = make_b(W, W + (size_t)128 * 1024, 1024);
    }
    DI void epi(f32x4 (&acc)[2][2][4][2], int u, const int wv_) const {
        const int g = u / 5, mt = u % 5;
        float* SST = (float*)(p.ws + WS_SST);
        EPI_FOR(acc, { const int cr = mt * 256 + lr; if (cr < NCROW) *(f32x4*)(SST + ((size_t)cr * 16 + g) * 256 + lc) = v; });
    }
};
struct PvQKV {
    const Params& p; int l;
    static constexpr int NT = 4; static constexpr int FP8 = 0; static constexpr bool PARK = false; typedef APlain AS; typedef BSimple BS;
    DI int first() const { return lin_first(80, 1152); }
    DI int next(int u) const { return lin_next(u, 1152); }
    DI void src(int u, AS& a, BS& b, const int wv_) const {
        const bool isq = u < 576; const int w_ = isq ? u : u - 576; const int mt = w_ >> 1, nt = w_ & 1;
        a = make_a_plain((const bf16_t*)(p.ws + WS_P), (size_t)mt * 256, NINP, isq ? OFF_Q : OFF_KV);
        const bf16_t* W = (const bf16_t*)(p.ws + (isq ? WS_WQ : WS_WKV)) + (size_t)l * 512 * 256 + (size_t)nt * 256 * 256;
        b = make_b(W, W + (size_t)128 * 256, 256);
    }
    DI void epi(f32x4 (&acc)[2][2][4][2], int u, const int wv_) const {
        const bool isq = u < 576; const int w_ = isq ? u : u - 576; const int mt = w_ >> 1, nt = w_ & 1;
        float* RAW = (float*)(p.ws + (isq ? WS_RAWQ : WS_RAWKV));
        EPI_FOR(acc, { *(f32x4*)(RAW + (size_t)(mt * 256 + lr) * 512 + nt * 256 + lc) = v; });
    }
};
DI void phase_A(const Params& p, LAS char* shm, int l, const int wv_) {
    { PvS5State pv{p, l}; gemm_stream(shm, pv, wv_); }
    { PvQKV pv{p, l}; gemm_stream(shm, pv, wv_); }
    for (int u = first_unit(80 + 1152); u < 1152; u += gridDim.x) pre_unit(p, shm, l, u, wv_);
}

DI void qkvpost_unit(const Params& p, LAS char* shm, int l, int unit, const int wv_) {
    const int tid = otid(), wid = tid >> 6, lane = tid & 63;
    const bf16_t* P = (const bf16_t*)(p.ws + WS_P);
    const float* RAWQ = (const float*)(p.ws + WS_RAWQ);
    const float* RAWKV = (const float*)(p.ws + WS_RAWKV);
    bf16_t* Q = (bf16_t*)(p.ws + WS_Q);
    bf16_t* KB = (bf16_t*)(p.ws + WS_KB);
    bf16_t* VT = (bf16_t*)(p.ws + WS_VT);
    LAS bf16_t* vt = (LAS bf16_t*)shm;
    const int row0 = unit * 64;
    const bool lat = row0 < TX;
    const int b = lat ? (row0 >> 11) : ((row0 - TX) >> 8);
    const int key0 = lat ? (row0 & 2047) : 2048 + ((row0 - TX) & 255);
    const int head = lane >> 4, sub = lane & 15;
    const float lninv = -9.210340371976184f / 8.f;
    for (int tk = wid * 8; tk < wid * 8 + 8; ++tk) {
        const int r = row0 + tk;
        const bf16_t* pr = P + (size_t)r * NINP;
        float sq = 0.f, skv = 0.f;
#pragma unroll
        for (int j = 0; j < 3; ++j) { const float a = bf2f(pr[OFF_Q + lane + 64 * j]); sq += a * a; }
#pragma unroll
        for (int j = 0; j < 2; ++j) { const float a = bf2f(pr[OFF_KV + lane + 64 * j]); skv += a * a; }
        sq = wave_sum(sq); skv = wave_sum(skv);
        const float rq = rsqrtf(sq * (1.f / 192.f) + EPS), rkv = rsqrtf(skv * (1.f / 128.f) + EPS);
        float cs[2], sn[2];
        { const int tseq = r & 2047; const float fr_ = __expf(lninv * (float)(sub & 7));
          const float a0 = (float)(tseq >> 6) * fr_, a1 = (float)(tseq & 63) * fr_;
          cs[0] = cosf(a0); sn[0] = sinf(a0); cs[1] = cosf(a1); sn[1] = sinf(a1); }
        {
            float q[6]; float ss = 0.f;
#pragma unroll
            for (int j = 0; j < 6; ++j) { q[j] = RAWQ[(size_t)r * 512 + head * 96 + sub + 16 * j] * rq; ss += q[j] * q[j]; }
#pragma unroll
            for (int o = 8; o > 0; o >>= 1) ss += shx(ss, o);
            const float rn = rsqrtf(ss * (1.f / 96.f) + EPS);
#pragma unroll
            for (int j = 0; j < 6; ++j) q[j] = q[j] * rn * p.mla_q_g[l * 96 + sub + 16 * j];
            if (lat) {
#pragma unroll
                for (int j = 4; j < 6; ++j) { const float other = shx(q[j], 8);
                    q[j] = (sub < 8) ? q[j] * cs[j - 4] - other * sn[j - 4] : q[j] * cs[j - 4] + other * sn[j - 4]; }
            }
#pragma unroll
            for (int j = 0; j < 6; ++j) Q[(size_t)r * 384 + head * 96 + sub + 16 * j] = f2bf(q[j]);
        }
        {
            float k[6]; float ss = 0.f;
#pragma unroll
            for (int j = 0; j < 4; ++j) { k[j] = RAWKV[(size_t)r * 512 + head * 128 + sub + 16 * j] * rkv; ss += k[j] * k[j]; }
#pragma unroll
            for (int j = 4; j < 6; ++j) { k[j] = bf2f(pr[OFF_KPE + sub + 16 * (j - 4)]); ss += k[j] * k[j]; }
#pragma unroll
            for (int o = 8; o > 0; o >>= 1) ss += shx(ss, o);
            const float rn = rsqrtf(ss * (1.f / 96.f) + EPS);
#pragma unroll
            for (int j = 0; j < 6; ++j) k[j] = k[j] * rn * p.mla_k_g[l * 96 + sub + 16 * j];
            if (lat) {
#pragma unroll
                for (int j = 4; j < 6; ++j) { const float other = shx(k[j], 8);
                    k[j] = (sub < 8) ? k[j] * cs[j - 4] - other * sn[j - 4] : k[j] * cs[j - 4] + other * sn[j - 4]; }
            }
            bf16_t* kr = KB + ((size_t)(b * 4 + head) * 2304 + key0 + tk) * 96;
#pragma unroll
            for (int j = 0; j < 6; ++j) kr[sub + 16 * j] = f2bf(k[j]);
        }
#pragma unroll
        for (int j = 0; j < 4; ++j) { const float v = RAWKV[(size_t)r * 512 + head * 128 + 64 + sub + 16 * j] * rkv; vt[(head * 64 + sub + 16 * j) * 72 + tk] = f2bf(v); }
    }
    __syncthreads();
    { const int hv = tid >> 1, hf = tid & 1;
      bf16_t* dst = VT + ((size_t)(b * 4 + (hv >> 6)) * 64 + (hv & 63)) * 2304 + key0 + hf * 32;
#pragma unroll
      for (int i = 0; i < 4; ++i) *(u32x4*)(dst + i * 8) = *(const LAS u32x4*)(vt + hv * 72 + hf * 32 + i * 8); }
    __syncthreads();
}
DI void s5carry_unit(const Params& p, int l, int unit, const int wv_) {
    const int gid = unit * 512 + otid();
    const int q = gid & 63, dir = (gid >> 6) & 1, g = (gid >> 7) & 15, b = gid >> 11;
    const float* A64 = (const float*)(p.ws + WS_A64) + (size_t)(((l * 2 + dir) * 16 + g) * 64 + q) * 2;
    const float ar = A64[0], ai = A64[1];
    const float* SST = (const float*)(p.ws + WS_SST);
    bf16_t* HIN = (bf16_t*)(p.ws + WS_HIN);
    float sr[NCH], si[NCH];
#pragma unroll
    for (int s = 0; s < NCH; ++s) { const int j = dir == 0 ? s : (s < 4 ? 3 - s : 39 - s);
        const size_t base = ((size_t)(b * NCH + j) * 16 + g) * 256 + dir * 128 + q; sr[s] = SST[base]; si[s] = SST[base + 64]; }
    float hr = 0.f, hi = 0.f;
#pragma unroll
    for (int s = 0; s < NCH; ++s) {
        const int j = dir == 0 ? s : (s < 4 ? 3 - s : 39 - s);
        const size_t base = ((size_t)(b * NCH + j) * 16 + g) * 256 + dir * 128 + q;
        HIN[base] = f2bf(hr); HIN[base + 64] = f2bf(hi);
        const float nr = ar * hr - ai * hi + sr[s], ni = ar * hi + ai * hr + si[s];
        hr = nr; hi = ni;
    }
}
struct PvConvPool {
    const Params& p; int l;
    static constexpr int NT = 4; static constexpr int FP8 = 0; static constexpr bool PARK = false; typedef APlain AS; typedef BSimple BS;
    DI int first() const { return lin_first(0, 576); }
    DI int next(int u) const { return lin_next(u, 576); }
    DI void src(int u, AS& a, BS& b, const int wv_) const {
        const bool isconv = u < 288; const int mt = isconv ? u : u - 288;
        a = make_a_plain((const bf16_t*)(p.ws + (isconv ? WS_ACONV : WS_APOOL)), (size_t)mt * 256, 256, 0);
        const bf16_t* W = (const bf16_t*)(p.ws + (isconv ? WS_WPW : WS_WPOOL)) + (size_t)l * 65536;
        b = make_b(W, W + (size_t)128 * 256, 256);
    }
    DI void epi(f32x4 (&acc)[2][2][4][2], int u, const int wv_) const {
        const bool isconv = u < 288; const int mt = isconv ? u : u - 288;
        bf16_t* CAT = (bf16_t*)(p.ws + WS_CAT);
        if (isconv) { EPI_FOR(acc, { store_bf16x4(CAT + (size_t)(mt * 256 + lr) * 1024 + lc, v[0], v[1], v[2], v[3]); }); }
        else { const int t_ = otid(), c0_ = ((t_ >> 6) & 3) * 32 + ((t_ & 63) >> 4) * 4; f32x4 sc_[2][2];
#pragma unroll
               for (int bj = 0; bj < 2; ++bj)
#pragma unroll
                   for (int n = 0; n < 2; ++n) sc_[bj][n] = *(const f32x4*)(p.pool_scale + l * 256 + bj * 128 + n * 16 + c0_);
               EPI_FOR(acc, { const f32x4 s_ = sc_[bj][n];
                              store_bf16x4(CAT + (size_t)(mt * 256 + lr) * 1024 + 256 + lc, v[0] * s_[0], v[1] * s_[1], v[2] * s_[2], v[3] * s_[3]); }); }
    }
};
DI void phase_B(const Params& p, LAS char* shm, int l, const int wv_) {
    { PvConvPool pv{p, l}; gemm_stream(shm, pv, wv_); }
    const int n_post = TT / 64, n_carry = 128;
    for (int u = first_unit(576); u < n_post + n_carry; u += gridDim.x) {
        if (u < n_post) qkvpost_unit(p, shm, l, u, wv_);
        else s5carry_unit(p, l, u - n_post, wv_);
    }
}

DI void attn_unit(const Params& p, LAS char* shm, int l, int b, int h, int qrow0, int nq, int key_lo, int nkeys, const int wv_) {
    const int tid = otid(), wid = tid >> 6, lane = tid & 63, l31 = lane & 31, hh = lane >> 5;
    const bf16_t* Q = (const bf16_t*)(p.ws + WS_Q);
    const bf16_t* KBp = (const bf16_t*)(p.ws + WS_KB) + (size_t)(b * 4 + h) * 2304 * 96;
    const bf16_t* VTp = (const bf16_t*)(p.ws + WS_VT) + (size_t)(b * 4 + h) * 64 * 2304;
    bf16_t* CAT = (bf16_t*)(p.ws + WS_CAT);
    LAS char* kl = shm;
    LAS char* vl = shm + 13312;
    const bool active = wid * 64 < nq;
    float gq = 0.f, gk = 0.f;
    for (int i = lane; i < 96; i += 64) { gq = fmaxf(gq, fabsf(p.mla_q_g[l * 96 + i])); gk = fmaxf(gk, fabsf(p.mla_k_g[l * 96 + i])); }
    gq = wave_max(gq); gk = wave_max(gk);
    const float LOG2E = 1.4426950408889634f;
    const float sc2 = 0.10206207261596575f * LOG2E;
    const float c2 = 9.797958971132712f * gq * gk * LOG2E;
    bf16x8 qf[2][6];
    if (active) {
#pragma unroll
        for (int qb = 0; qb < 2; ++qb)
#pragma unroll
            for (int ks = 0; ks < 6; ++ks) qf[qb][ks] = *(const bf16x8*)(Q + (size_t)(qrow0 + wid * 64 + qb * 32 + l31) * 384 + h * 96 + ks * 16 + hh * 8);
    }
    f32x16 O[2][2];
#pragma unroll
    for (int a = 0; a < 2; ++a)
#pragma unroll
        for (int c = 0; c < 2; ++c)
#pragma unroll
            for (int i = 0; i < 16; ++i) O[a][c][i] = 0.f;
    float lsum[2] = {0.f, 0.f};
    const int ntile = nkeys / 64;
    u32x4 kreg0, kreg1, vreg;
    auto load_tile = [&](int t) {
        const int key = key_lo + t * 64;
        { const int id = tid, kr = id / 12, part = id % 12; kreg0 = *(const u32x4*)(KBp + (size_t)(key + kr) * 96 + part * 8); }
        if (tid < 256) { const int id = tid + 512, kr = id / 12, part = id % 12; kreg1 = *(const u32x4*)(KBp + (size_t)(key + kr) * 96 + part * 8); }
        { const int vd = tid >> 3, part = tid & 7; vreg = *(const u32x4*)(VTp + (size_t)vd * 2304 + key + part * 8); }
    };
    auto write_tile = [&]() {
        { const int id = tid, kr = id / 12, part = id % 12; *(LAS u32x4*)(kl + kr * 208 + part * 16) = kreg0; }
        if (tid < 256) { const int id = tid + 512, kr = id / 12, part = id % 12; *(LAS u32x4*)(kl + kr * 208 + part * 16) = kreg1; }
        { const int vd = tid >> 3, part = tid & 7; *(LAS u32x4*)(vl + vd * 144 + part * 16) = vreg; }
    };
    load_tile(0);
    for (int t = 0; t < ntile; ++t) {
        __syncthreads();
        write_tile();
        __syncthreads();
        if (t + 1 < ntile) load_tile(t + 1);
        if (active) {
#pragma unroll
            for (int kb = 0; kb < 2; ++kb) {
                f32x16 S[2];
#pragma unroll
                for (int qb = 0; qb < 2; ++qb)
#pragma unroll
                    for (int i = 0; i < 16; ++i) S[qb][i] = 0.f;
#pragma unroll
                for (int ks = 0; ks < 6; ++ks) {
                    const bf16x8 a = *(const LAS bf16x8*)(kl + (kb * 32 + l31) * 208 + ks * 32 + hh * 16);
#pragma unroll
                    for (int qb = 0; qb < 2; ++qb) S[qb] = __builtin_amdgcn_mfma_f32_32x32x16_bf16(a, qf[qb][ks], S[qb], 0, 0, 0);
                }
                bf16x8 pf[2][2];
#pragma unroll
                for (int qb = 0; qb < 2; ++qb) {
                    float e[16];
#pragma unroll
                    for (int i = 0; i < 16; ++i) { e[i] = exp2f(S[qb][i] * sc2 - c2); lsum[qb] += e[i]; }
#pragma unroll
                    for (int s = 0; s < 2; ++s) { u32x4 w; w.x = pk_bf16(e[8 * s], e[8 * s + 1]); w.y = pk_bf16(e[8 * s + 2], e[8 * s + 3]); w.z = pk_bf16(e[8 * s + 4], e[8 * s + 5]); w.w = pk_bf16(e[8 * s + 6], e[8 * s + 7]);
                        pf[qb][s] = __builtin_bit_cast(bf16x8, w); }
                }
#pragma unroll
                for (int s = 0; s < 2; ++s) {
                    const int kk = kb * 2 + s;
#pragma unroll
                    for (int vb = 0; vb < 2; ++vb) {
                        const s16x4 lo = *(const LAS s16x4*)(vl + (vb * 32 + l31) * 144 + (16 * kk + 4 * hh) * 2);
                        const s16x4 hi = *(const LAS s16x4*)(vl + (vb * 32 + l31) * 144 + (16 * kk + 8 + 4 * hh) * 2);
                        const bf16x8 va = __builtin_shufflevector(lo, hi, 0, 1, 2, 3, 4, 5, 6, 7);
#pragma unroll
                        for (int qb = 0; qb < 2; ++qb) O[vb][qb] = __builtin_amdgcn_mfma_f32_32x32x16_bf16(va, pf[qb][s], O[vb][qb], 0, 0, 0);
                    }
                }
            }
        }
    }
    if (active) {
#pragma unroll
        for (int qb = 0; qb < 2; ++qb) {
            const float tot = lsum[qb] + shx(lsum[qb], 32);
            const float inv = 1.f / tot;
            bf16_t* orow = CAT + (size_t)(qrow0 + wid * 64 + qb * 32 + l31) * 1024 + 768 + h * 64;
#pragma unroll
            for (int vb = 0; vb < 2; ++vb)
#pragma unroll
                for (int i4 = 0; i4 < 4; ++i4)
                    store_bf16x4(orow + vb * 32 + 8 * i4 + 4 * hh, O[vb][qb][4 * i4] * inv, O[vb][qb][4 * i4 + 1] * inv, O[vb][qb][4 * i4 + 2] * inv, O[vb][qb][4 * i4 + 3] * inv);
        }
    }
    __syncthreads();
}
struct PvS5Out {
    const Params& p; int l;
    static constexpr int NT = 20; static constexpr int FP8 = 0; static constexpr bool PARK = false; typedef ASeg2 AS; typedef BSimple BS;
    DI int first() const { return lin_first(512, 320); }
    DI int next(int u) const { return lin_next(u, 320); }
    DI void src(int u, AS& as, BS& bs, const int wv_) const {
        const int ntile = u & 3, mt = (u >> 2) % 5, g = u / 20;
        int R[2], C[2]; stage_coords(R, C, wv_);
        as.base0 = (const char*)(p.ws + WS_P); as.base1 = (const char*)(p.ws + WS_HIN); as.ks0 = 4 * NINP * 2; as.nt0 = 16;
#pragma unroll
        for (int h = 0; h < 2; ++h)
#pragma unroll
            for (int i = 0; i < 2; ++i) { const int cr = min(mt * 256 + h * 128 + R[i], NCROW - 1);
                as.off0[h][i] = (unsigned)(((size_t)(crow_tok(cr) + (C[i] >> 4)) * NINP + OFF_SSM + g * 16 + (C[i] & 15)) * 2);
                as.off1[h][i] = (unsigned)((((size_t)cr * 16 + g) * 256 + C[i]) * 2); }
        const bf16_t* W = (const bf16_t*)(p.ws + WS_TS5) + ((size_t)(l * 16 + g) * 1024 + ntile * 256) * 1280;
        bs = make_b(W, W + (size_t)128 * 1280, 1280);
    }
    DI void epi(f32x4 (&acc)[2][2][4][2], int u, const int wv_) const {
        const int ntile = u & 3, mt = (u >> 2) % 5, g = u / 20;
        bf16_t* Z = (bf16_t*)(p.ws + WS_Z);
        EPI_FOR(acc, { const int cr = mt * 256 + lr; if (cr < NCROW) { const int col = ntile * 256 + lc, t = col >> 4, co = col & 15;
            store_bf16x4(Z + (size_t)(crow_tok(cr) + t) * 256 + g * 16 + co, gelu_tanh(v[0]), gelu_tanh(v[1]), gelu_tanh(v[2]), gelu_tanh(v[3])); } });
    }
};
DI void phase_C(const Params& p, LAS char* shm, int l, const int wv_) {
    for (int u = blockIdx.x; u < 512; u += gridDim.x) { const int qb = u & 3, h = (u >> 2) & 3, b = u >> 4;
        attn_unit(p, shm, l, b, h, b * SEQ + qb * 512, 512, 0, 2304, wv_); }
    { PvS5Out pv{p, l}; gemm_stream(shm, pv, wv_); }
    if (l == 0) for (int u = first_unit(512 + 320); u < 128; u += gridDim.x) { const int h = u & 3, b = u >> 2;
        attn_unit(p, shm, l, b, h, TX + b * CTXL, 256, 2048, 256, wv_); }
}

struct PvGlu {
    const Params& p; int l;
    static constexpr int NT = 4; static constexpr int FP8 = 0; static constexpr bool PARK = false; typedef APlain AS; typedef BSimple BS;
    DI int first() const { return lin_first(0, 288); }
    DI int next(int u) const { return lin_next(u, 288); }
    DI void src(int u, AS& a, BS& b, const int wv_) const {
        a = make_a_plain((const bf16_t*)(p.ws + WS_Z), (size_t)u * 256, 256, 0);
        const bf16_t* W = (const bf16_t*)(p.ws + WS_WGLU) + (size_t)l * 65536;
        b = make_b(W, W + (size_t)128 * 256, 256);
    }
    DI void epi(f32x4 (&acc)[2][2][4][2], int u, const int wv_) const {
        const bf16_t* Z = (const bf16_t*)(p.ws + WS_Z); bf16_t* CAT = (bf16_t*)(p.ws + WS_CAT);
        const int _tz = otid(), _w = _tz >> 6, _l = _tz & 63, _wr = _w >> 2, _wc = _w & 3, _fr = _l & 15, _fq = _l >> 4;
        const int c0 = _wc * 32 + _fq * 4;
        f32x4 bsv[2][2];
#pragma unroll
        for (int bj = 0; bj < 2; ++bj)
#pragma unroll
            for (int n = 0; n < 2; ++n) bsv[bj][n] = *(const f32x4*)(p.ssm_glu_b + l * 256 + bj * 128 + n * 16 + c0);
#pragma unroll
        for (int ai = 0; ai < 2; ++ai) {
            u32x2 zz[4][2][2];
#pragma unroll
            for (int m = 0; m < 4; ++m)
#pragma unroll
                for (int bj = 0; bj < 2; ++bj)
#pragma unroll
                    for (int n = 0; n < 2; ++n) zz[m][bj][n] = *(const u32x2*)(Z + (size_t)(u * 256 + ai * 128 + _wr * 64 + m * 16 + _fr) * 256 + bj * 128 + n * 16 + c0);
#pragma unroll
            for (int m = 0; m < 4; ++m) { const size_t r = (size_t)(u * 256 + ai * 128 + _wr * 64 + m * 16 + _fr);
#pragma unroll
                for (int bj = 0; bj < 2; ++bj)
#pragma unroll
                    for (int n = 0; n < 2; ++n) { const f32x4 v = acc[ai][bj][m][n]; const f32x4 b_ = bsv[bj][n]; const u32x2 z_ = zz[m][bj][n];
                        store_bf16x4(CAT + r * 1024 + 512 + bj * 128 + n * 16 + c0, bflo(z_.x) * sigmoidf_(v[0] + b_[0]), bfhi(z_.x) * sigmoidf_(v[1] + b_[1]), bflo(z_.y) * sigmoidf_(v[2] + b_[2]), bfhi(z_.y) * sigmoidf_(v[3] + b_[3])); } }
        }
    }
};
DI void phase_D(const Params& p, LAS char* shm, int l, const int wv_) {
    PvGlu pv{p, l}; gemm_stream(shm, pv, wv_);
}

struct PvOutproj {
    const Params& p; int l;
    static constexpr int NT = 16; static constexpr int FP8 = 0; static constexpr bool PARK = false; typedef APlain AS; typedef BSimple BS;
    XcdDeal<4, 4> deal;
    DI int first() const { return deal.first(); }
    DI int next(int u) const { return deal.next(u); }
    DI void src(int u, AS& a, BS& b, const int wv_) const {
        int mt, nt; deal.decode(u, mt, nt);
        const bf16_t* W = (const bf16_t*)(p.ws + WS_WMO) + (size_t)l * 1024 * 1024;
        a = make_a_plain((const bf16_t*)(p.ws + WS_CAT), (size_t)mt * 256, 1024, 0);
        b = make_b(W + (size_t)(nt * 256) * 1024, W + (size_t)(nt * 256 + 128) * 1024, 1024);
    }
    DI void epi(f32x4 (&acc)[2][2][4][2], int u, const int wv_) const {
        int mt, nt; deal.decode(u, mt, nt);
        float* X = (float*)(p.ws + WS_X);
        const bool alt = p.ph_lo != 0;
        const float* MOD = (const float*)(p.ws + WS_MOD) + (size_t)l * 33 * 6144;
        const int _tz = otid(), _w = _tz >> 6, _l = _tz & 63, _wr = _w >> 2, _wc = _w & 3, _fr = _l & 15, _fq = _l >> 4;
        const int c0 = nt * 256 + _wc * 32 + _fq * 4;
        const int row0 = mt * 256;
        const float* g1p = MOD + (size_t)mod_row(row0) * 6144 + 2048 + c0;
        const float* xbase = (l == 0) ? (row0 < TX ? p.x + (size_t)row0 * 1024 : p.ctx + (size_t)(row0 - TX) * 1024) : X + (size_t)row0 * 1024;
        float* obase = alt ? p.out + (size_t)(row0 < TX ? row0 : 0) * 1024 : X + (size_t)row0 * 1024;
        f32x4 g1[2][2];
#pragma unroll
        for (int bj = 0; bj < 2; ++bj)
#pragma unroll
            for (int n = 0; n < 2; ++n) g1[bj][n] = *(const f32x4*)(g1p + bj * 128 + n * 16);
#pragma unroll
        for (int ai = 0; ai < 2; ++ai)
#pragma unroll
            for (int mp = 0; mp < 2; ++mp) {
                f32x4 xv[2][2][2];
#pragma unroll
                for (int mm = 0; mm < 2; ++mm)
#pragma unroll
                    for (int bj = 0; bj < 2; ++bj)
#pragma unroll
                        for (int n = 0; n < 2; ++n) xv[mm][bj][n] = *(const f32x4*)(xbase + (size_t)(ai * 128 + _wr * 64 + (mp * 2 + mm) * 16 + _fr) * 1024 + c0 + bj * 128 + n * 16);
#pragma unroll
                for (int mm = 0; mm < 2; ++mm)
#pragma unroll
                    for (int bj = 0; bj < 2; ++bj)
#pragma unroll
                        for (int n = 0; n < 2; ++n) *(f32x4*)(obase + (size_t)(ai * 128 + _wr * 64 + (mp * 2 + mm) * 16 + _fr) * 1024 + c0 + bj * 128 + n * 16) = xv[mm][bj][n] + g1[bj][n] * acc[ai][bj][mp * 2 + mm][n];
            }
    }
};
DI void phase_E(const Params& p, LAS char* shm, int l, const int wv_) {
    PvOutproj pv{p, l, {(l == 1 ? TX : TT) / 256}}; gemm_stream(shm, pv, wv_);
}

template <int S> DI float row_rot_f(float v) { return __int_as_float(__builtin_amdgcn_update_dpp(0, __float_as_int(v), 0x120 | S, 0xf, 0xf, false)); }
template <int S> DI int row_rot_i(int v) { return __builtin_amdgcn_update_dpp(0, v, 0x120 | S, 0xf, 0xf, false); }
template <int S> struct RankAcc {
    static DI void run(float o0, float o1, int oe, float v0, float v1, int e0, int& r0, int& r1) {
        const float a0 = S ? row_rot_f<S>(o0) : o0, a1 = S ? row_rot_f<S>(o1) : o1; const int ae = S ? row_rot_i<S>(oe) : oe;
        r0 += (a0 > v0 || (a0 == v0 && ae < e0)) ? 1 : 0;
        r0 += (a1 > v0) ? 1 : 0;
        r1 += (a0 > v1 || a0 == v1) ? 1 : 0;
        r1 += (a1 > v1 || (a1 == v1 && ae < e0)) ? 1 : 0;
        RankAcc<S + 1>::run(o0, o1, oe, v0, v1, e0, r0, r1);
    }
};
template <> struct RankAcc<16> { static DI void run(float, float, int, float, float, int, int&, int&) {} };
DI float row_sum16(float v) { v += row_rot_f<8>(v); v += row_rot_f<4>(v); v += row_rot_f<2>(v); v += row_rot_f<1>(v); return v; }
DI float row_max16(float v) { v = fmaxf(v, row_rot_f<8>(v)); v = fmaxf(v, row_rot_f<4>(v)); v = fmaxf(v, row_rot_f<2>(v)); v = fmaxf(v, row_rot_f<1>(v)); return v; }

DI void phase_router(const Params& p, LAS char* shm, int l, const int wv_) {
    const int tid = otid(), wid = tid >> 6, lane = tid & 63;
    const int Tm = (l == 1) ? TX : TT;
    const float* X = (const float*)(p.ws + WS_X);
    const float* MOD = (const float*)(p.ws + WS_MOD) + (size_t)l * 33 * 6144;
    unsigned char* H8 = (unsigned char*)(p.ws + WS_H);
    const bool alt = p.ph_lo != 0;
    int* CNT = (int*)(p.ws + WS_CNT) + l * 32 + (alt ? 64 : 0);
    int* LIST = alt ? (int*)(p.ws + WS_RY) : (int*)(p.ws + WS_LIST);
    LAS char* wfr = shm;
    LAS bf16_t* gml = (LAS bf16_t*)(shm + 131072);
    LAS bf16_t* shl = gml + 1024;
    LAS float* cvec = (LAS float*)(shm + 131072 + 4096);
    LAS int* lcnt = (LAS int*)(cvec + 32);
    LAS int* lbase = lcnt + 32;
    LAS unsigned* lrec = (LAS unsigned*)(lbase + 32);
    LAS float* lwt = (LAS float*)(lrec + 1152);
    const int tpw = (Tm + gridDim.x - 1) / gridDim.x;
    const int tbeg = blockIdx.x * tpw, tend = min(tbeg + tpw, Tm);
    if (tid < 32) lcnt[tid] = 0;
    int seg_beg = tbeg;
    while (seg_beg < tend) {
        const int mrow = mod_row(seg_beg);
        int seg_end = tend;
        if (mrow < 32) seg_end = min(tend, (mrow + 1) * SEQ); else seg_end = tend;
        const float* mr = MOD + (size_t)mrow * 6144;
        __syncthreads();
        for (int k = tid; k < 1024; k += 512) { const float gmv = p.norm2_g[l * 1024 + k] * (1.f + mr[4096 + k]); gml[k] = f2bf(gmv); shl[k] = f2bf(mr[3072 + k]); }
        for (int i = tid; i < 1024 * 8; i += 512) {
            const int k = i >> 3, e4 = (i & 7) * 4;
            const float gmv = p.norm2_g[l * 1024 + k] * (1.f + mr[4096 + k]);
            const f32x4 w = *(const f32x4*)(p.router_w + (size_t)l * 32768 + k * 32 + e4);
            const int ks = k >> 5, kq = (k >> 3) & 3, j = k & 7;
#pragma unroll
            for (int c = 0; c < 4; ++c) { const int e = e4 + c, nb = e >> 4, ei = e & 15; const float wv = w[c] * gmv;
                const bf16_t hi = f2bf(wv); const bf16_t lo = f2bf(wv - bf2f(hi));
                LAS bf16_t* dst = (LAS bf16_t*)(wfr + ((size_t)((ks * 2 + nb) * 2) * 64 + (kq * 16 + ei)) * 16) + j;
                dst[0] = hi; dst[64 * 8] = lo; }
        }
        {
            float s4[4] = {0.f, 0.f, 0.f, 0.f};
            for (int k = lane; k < 1024; k += 64) { const float shv = mr[3072 + k]; const f32x4 w = *(const f32x4*)(p.router_w + (size_t)l * 32768 + k * 32 + wid * 4);
                s4[0] += shv * w[0]; s4[1] += shv * w[1]; s4[2] += shv * w[2]; s4[3] += shv * w[3]; }
#pragma unroll
            for (int c = 0; c < 4; ++c) { const float t_ = wave_sum(s4[c]); if (lane == 0) cvec[wid * 4 + c] = t_ + p.router_b[l * 32 + wid * 4 + c]; }
        }
        __syncthreads();
        const int ngroups = (seg_end - seg_beg) >> 4;
        for (int gi = wid; gi < ngroups; gi += 8) {
            const int t0 = seg_beg + gi * 16;
            const int tok = lane & 15, kq = lane >> 4;
            const float* xr = X + (size_t)(t0 + tok) * 1024 + kq * 8;
            f32x4 acc0 = {0.f, 0.f, 0.f, 0.f}, acc1 = {0.f, 0.f, 0.f, 0.f};
            float ss = 0.f;
#pragma unroll 4
            for (int ks = 0; ks < 32; ++ks) {
                const f32x4 xa = *(const f32x4*)(xr + ks * 32), xb = *(const f32x4*)(xr + ks * 32 + 4);
                ss += xa[0] * xa[0] + xa[1] * xa[1] + xa[2] * xa[2] + xa[3] * xa[3] + xb[0] * xb[0] + xb[1] * xb[1] + xb[2] * xb[2] + xb[3] * xb[3];
                u32x4 hi, lo;
                hi.x = pk_bf16(xa[0], xa[1]); hi.y = pk_bf16(xa[2], xa[3]); hi.z = pk_bf16(xb[0], xb[1]); hi.w = pk_bf16(xb[2], xb[3]);
                lo.x = pk_bf16(xa[0] - bflo(hi.x), xa[1] - bfhi(hi.x)); lo.y = pk_bf16(xa[2] - bflo(hi.y), xa[3] - bfhi(hi.y));
                lo.z = pk_bf16(xb[0] - bflo(hi.z), xb[1] - bfhi(hi.z)); lo.w = pk_bf16(xb[2] - bflo(hi.w), xb[3] - bfhi(hi.w));
                const bf16x8 ah = __builtin_bit_cast(bf16x8, hi), al = __builtin_bit_cast(bf16x8, lo);
                const LAS char* wb = wfr + (size_t)(ks * 4) * 1024 + lane * 16;
                const bf16x8 b0h = *(const LAS bf16x8*)(wb), b0l = *(const LAS bf16x8*)(wb + 1024), b1h = *(const LAS bf16x8*)(wb + 2048), b1l = *(const LAS bf16x8*)(wb + 3072);
                acc0 = __builtin_amdgcn_mfma_f32_16x16x32_bf16(ah, b0h, acc0, 0, 0, 0); acc0 = __builtin_amdgcn_mfma_f32_16x16x32_bf16(ah, b0l, acc0, 0, 0, 0); acc0 = __builtin_amdgcn_mfma_f32_16x16x32_bf16(al, b0h, acc0, 0, 0, 0);
                acc1 = __builtin_amdgcn_mfma_f32_16x16x32_bf16(ah, b1h, acc1, 0, 0, 0); acc1 = __builtin_amdgcn_mfma_f32_16x16x32_bf16(ah, b1l, acc1, 0, 0, 0); acc1 = __builtin_amdgcn_mfma_f32_16x16x32_bf16(al, b1h, acc1, 0, 0, 0);
            }
            ss += shx(ss, 16); ss += shx(ss, 32);
            const float rn = rsqrtf(ss * (1.f / 1024.f) + EPS);
            const int ei = lane & 15;
            const float c0v = cvec[ei], c1v = cvec[16 + ei];
#pragma unroll
            for (int r = 0; r < 4; ++r) {
                const int tl = (lane >> 4) * 4 + r;
                const float rnt = shi(rn, tl);
                float v0 = fminf(fmaxf(acc0[r] * rnt + c0v, -1e30f), 1e30f), v1 = fminf(fmaxf(acc1[r] * rnt + c1v, -1e30f), 1e30f);
                int r0 = 0, r1 = 0;
                RankAcc<0>::run(v0, v1, ei, v0, v1, ei, r0, r1);
                const float mx = row_max16(fmaxf(v0, v1));
                const bool s0 = r0 < 4, s1 = r1 < 4;
                const float e0 = s0 ? __expf(v0 - mx) : 0.f, e1 = s1 ? __expf(v1 - mx) : 0.f;
                const float inv = 1.f / row_sum16(e0 + e1);
                const int t = t0 + tl;
                if (s0) { const int pos = atomicAdd((int*)&lcnt[ei], 1); lrec[(t - tbeg) * 4 + r0] = (unsigned)ei | ((unsigned)pos << 8); lwt[(t - tbeg) * 4 + r0] = e0 * inv; }
                if (s1) { const int pos = atomicAdd((int*)&lcnt[16 + ei], 1); lrec[(t - tbeg) * 4 + r1] = (unsigned)(16 + ei) | ((unsigned)pos << 8); lwt[(t - tbeg) * 4 + r1] = e1 * inv; }
            }
            unsigned char* hr = H8 + (size_t)(t0 + tok) * 1024 + kq * 8;
#pragma unroll 4
            for (int ks = 0; ks < 32; ++ks) {
                const f32x4 xa = *(const f32x4*)(xr + ks * 32), xb = *(const f32x4*)(xr + ks * 32 + 4);
                const u32x4 gq = *(const LAS u32x4*)(gml + ks * 32 + kq * 8), sq = *(const LAS u32x4*)(shl + ks * 32 + kq * 8);
                float h[8];
                h[0] = xa[0] * rn * bflo(gq.x) + bflo(sq.x); h[1] = xa[1] * rn * bfhi(gq.x) + bfhi(sq.x); h[2] = xa[2] * rn * bflo(gq.y) + bflo(sq.y); h[3] = xa[3] * rn * bfhi(gq.y) + bfhi(sq.y);
                h[4] = xb[0] * rn * bflo(gq.z) + bflo(sq.z); h[5] = xb[1] * rn * bfhi(gq.z) + bfhi(sq.z); h[6] = xb[2] * rn * bflo(gq.w) + bflo(sq.w); h[7] = xb[3] * rn * bfhi(gq.w) + bfhi(sq.w);
#pragma unroll
                for (int i = 0; i < 8; ++i) h[i] = __builtin_amdgcn_fmed3f(h[i], -448.f, 448.f);
                u32x2 o; o.x = pk_fp8x4(h[0], h[1], h[2], h[3]); o.y = pk_fp8x4(h[4], h[5], h[6], h[7]);
                *(u32x2*)(hr + ks * 32) = o;
            }
        }
        seg_beg = seg_end;
    }
    __syncthreads();
    if (tid < 32) lbase[tid] = atomicAdd(&CNT[tid], lcnt[tid]);
    __syncthreads();
    for (int i = tid; i < (tend - tbeg) * 4; i += 512) { const unsigned rec = lrec[i]; const int e = rec & 255, pos = rec >> 8;
        u32x2 ent; ent.x = (unsigned)(tbeg * 4 + i); ent.y = __float_as_uint(lwt[i]);
        *(u32x2*)(LIST + ((size_t)e * TT + lbase[e] + pos) * 2) = ent; }
    __syncthreads();
}

DI void moe_tiles(const Params& p, LAS int* tstart, int l, const int wv_) {
    const int* CNT = (const int*)(p.ws + WS_CNT) + l * 32;
    if (otid() == 0) { int s = 0; for (int e = 0; e < 32; ++e) { tstart[e] = s; s += (CNT[e] + 255) >> 8; } tstart[32] = s; }
    __syncthreads();
}
DI int moe_find(const LAS int* tstart, int mt) { int e = 0;
#pragma unroll
    for (int i = 1; i < 32; ++i) e += (mt >= tstart[i]) ? 1 : 0;
    return e; }
struct PvMoe1 {
    const Params& p; int l; const LAS int* tstart;
    static constexpr int NT = 8; static constexpr int FP8 = 2; static constexpr bool PARK = false; typedef ASimple AS; typedef BSimple BS;
    XcdDeal<4, 8> deal;
    DI int first() const { return deal.first(); }
    DI int next(int u) const { return deal.next(u); }
    DI void src(int u, AS& as, BS& bs, const int wv_) const {
        int mt, n8; deal.decode(u, mt, n8);
        const int e = moe_find(tstart, mt);
        const int r0 = (mt - tstart[e]) * 256, cnt = ((const int*)(p.ws + WS_CNT))[l * 32 + e];
        const int* lst = (const int*)(p.ws + WS_LIST) + (size_t)e * TT * 2;
        int R[2], C[2]; stage_coords(R, C, wv_);
        as.base = (const char*)(p.ws + WS_H); as.kstride = 128;
#pragma unroll
        for (int h = 0; h < 2; ++h)
#pragma unroll
            for (int i = 0; i < 2; ++i) { const int slot = lst[2 * min(r0 + h * 128 + R[i], cnt - 1)]; as.off[h][i] = (unsigned)((size_t)(slot >> 2) * 1024 + C[i] * 2); }
        const char* W = (const char*)(p.ws + WS_W1) + (size_t)(l * NE + e) * 2048 * 1024;
        bs.base[0] = W + (size_t)(n8 * 128) * 1024; bs.base[1] = W + (size_t)(1024 + n8 * 128) * 1024; bs.ldb2 = 1024;
    }
    DI void epi(f32x4 (&acc)[2][2][4][2], int u, const int wv_) const {
        int mt, n8; deal.decode(u, mt, n8);
        const int e = moe_find(tstart, mt);
        unsigned char* ACT = (unsigned char*)(p.ws + WS_RA);
        const int _tz = otid(), _w = _tz >> 6, _l = _tz & 63, _wr = _w >> 2, _wc = _w & 3, _fr = _l & 15, _fq = _l >> 4;
        const float* bin = p.exp_b_in + (size_t)(l * NE + e) * 2048 + n8 * 128 + _wc * 32 + _fq * 4;
        f32x4 bg[2], bu[2];
#pragma unroll
        for (int n = 0; n < 2; ++n) { bg[n] = *(const f32x4*)(bin + n * 16); bu[n] = *(const f32x4*)(bin + 1024 + n * 16); }
#pragma unroll
        for (int ai = 0; ai < 2; ++ai)
#pragma unroll
            for (int m = 0; m < 4; ++m) { const int lr = ai * 128 + _wr * 64 + m * 16 + _fr;
                unsigned char* orow = ACT + ((size_t)mt * 256 + lr) * 1024 + n8 * 128 + _wc * 32 + _fq * 4;
#pragma unroll
                for (int n = 0; n < 2; ++n) {
                    float o[4];
#pragma unroll
                    for (int r = 0; r < 4; ++r) { const float gate = fminf(__builtin_fmaf(acc[ai][0][m][n][r], 1.f / 256.f, bg[n][r]), 7.f); const float up = __builtin_amdgcn_fmed3f(__builtin_fmaf(acc[ai][1][m][n][r], 1.f / 256.f, bu[n][r]), -7.f, 7.f);
                        o[r] = (up + 1.f) * gate * __builtin_amdgcn_rcpf(1.f + __builtin_amdgcn_exp2f(-2.4554669595930156f * gate)); }
                    *(unsigned*)(orow + n * 16) = pk_fp8x4(o[0], o[1], o[2], o[3]); } }
    }
};
DI void phase_moe1(const Params& p, LAS char* shm, int l, const int wv_) {
    LAS int* tstart = (LAS int*)(shm + LDS_MISC + 64);
    moe_tiles(p, tstart, l, wv_);
    PvMoe1 pv{p, l, tstart, {tstart[32]}}; gemm_stream(shm, pv, wv_);
}
struct PvMoe2 {
    const Params& p; int l; const LAS int* tstart;
    static constexpr int NT = 8; static constexpr int FP8 = 2; static constexpr bool PARK = false; typedef APlain AS; typedef BSimple BS;
    XcdDeal<4, 4> deal;
    DI int first() const { return deal.first(); }
    DI int next(int u) const { return deal.next(u); }
    DI void src(int u, AS& as, BS& bs, const int wv_) const {
        int mt, n4; deal.decode(u, mt, n4);
        const int e = moe_find(tstart, mt);
        as.base = (const char*)(p.ws + WS_RA) + (size_t)mt * 256 * 1024; as.lda2 = 1024;
        const char* W = (const char*)(p.ws + WS_W2) + (size_t)(l * NE + e) * 1024 * 1024;
        bs.base[0] = W + (size_t)(n4 * 256) * 1024; bs.base[1] = W + (size_t)(n4 * 256 + 128) * 1024; bs.ldb2 = 1024;
    }
    DI void epi(f32x4 (&acc)[2][2][4][2], int u, const int wv_) const {
        int mt, n4; deal.decode(u, mt, n4);
        const int e = moe_find(tstart, mt);
        const int r0 = (mt - tstart[e]) * 256, cnt = ((const int*)(p.ws + WS_CNT))[l * 32 + e];
        const int* lst = (const int*)(p.ws + WS_LIST) + (size_t)e * TT * 2;
        bf16_t* Y = (bf16_t*)(p.ws + WS_RY);
        const int _tz = otid(), _w = _tz >> 6, _l = _tz & 63, _wr = _w >> 2, _wc = _w & 3, _fr = _l & 15, _fq = _l >> 4;
        const float* bo = p.exp_b_out + (size_t)(l * NE + e) * 1024 + n4 * 256 + _wc * 32 + _fq * 4;
        u32x2 ent[2][4]; f32x4 bv[2][2];
#pragma unroll
        for (int ai = 0; ai < 2; ++ai)
#pragma unroll
            for (int m = 0; m < 4; ++m) ent[ai][m] = *(const u32x2*)(lst + 2 * min(r0 + ai * 128 + _wr * 64 + m * 16 + _fr, cnt - 1));
#pragma unroll
        for (int bj = 0; bj < 2; ++bj)
#pragma unroll
            for (int n = 0; n < 2; ++n) bv[bj][n] = *(const f32x4*)(bo + bj * 128 + n * 16);
#pragma unroll
        for (int ai = 0; ai < 2; ++ai)
#pragma unroll
            for (int m = 0; m < 4; ++m) { const int lr = r0 + ai * 128 + _wr * 64 + m * 16 + _fr;
                if (lr < cnt) { const float w = __uint_as_float(ent[ai][m].y); bf16_t* orow = Y + (size_t)ent[ai][m].x * 1024 + n4 * 256 + _wc * 32 + _fq * 4;
#pragma unroll
                    for (int bj = 0; bj < 2; ++bj)
#pragma unroll
                        for (int n = 0; n < 2; ++n) { const f32x4 v = acc[ai][bj][m][n]; const f32x4 b_ = bv[bj][n];
                            const float sc_ = 1.f / 256.f; store_bf16x4(orow + bj * 128 + n * 16, (v[0] * sc_ + b_[0]) * w, (v[1] * sc_ + b_[1]) * w, (v[2] * sc_ + b_[2]) * w, (v[3] * sc_ + b_[3]) * w); } } }
    }
};
DI void phase_moe2(const Params& p, LAS char* shm, int l, const int wv_) {
    LAS int* tstart = (LAS int*)(shm + LDS_MISC + 64);
    moe_tiles(p, tstart, l, wv_);
    PvMoe2 pv{p, l, tstart, {tstart[32]}}; gemm_stream(shm, pv, wv_);
}

DI void phase_combine(const Params& p, LAS char* shm, int l, const int wv_) {
    const int tid = otid(), wid = tid >> 6, lane = tid & 63;
    const bool alt = p.ph_lo != 0;
    const float* X = (const float*)(p.ws + WS_X);
    float* XO = alt ? (float*)(p.ws + WS_RA) : (float*)(p.ws + WS_X);
    float* OUT = alt ? (float*)(p.ws + WS_RA) : p.out;
    const bf16_t* Y = (const bf16_t*)(p.ws + WS_RY);
    const float* MOD = (const float*)(p.ws + WS_MOD);
    bf16_t* H = alt ? (bf16_t*)(p.ws + WS_RA + (size_t)TT * 1024 * 4) : (bf16_t*)(p.ws + WS_H);
    const int Tm = (l == 1) ? TX : TT;
    for (int r = blockIdx.x * 8 + wid; r < Tm; r += gridDim.x * 8) {
        const float* g2 = MOD + (size_t)(l * 33 + mod_row(r)) * 6144 + 5120;
        float v[16];
#pragma unroll
        for (int j = 0; j < 4; ++j) {
            const int col = j * 256 + lane * 4;
            f32x4 s = (f32x4){0.f, 0.f, 0.f, 0.f};
#pragma unroll
            for (int k = 0; k < 4; ++k) { const u32x2 yy = *(const u32x2*)(Y + ((size_t)r * 4 + k) * 1024 + col); s[0] += bflo(yy.x); s[1] += bfhi(yy.x); s[2] += bflo(yy.y); s[3] += bfhi(yy.y); }
            const f32x4 xv = *(const f32x4*)(X + (size_t)r * 1024 + col), gg = *(const f32x4*)(g2 + col);
            const f32x4 o = xv + gg * s;
            if (l == 1) *(f32x4*)(OUT + (size_t)r * 1024 + col) = o; else *(f32x4*)(XO + (size_t)r * 1024 + col) = o;
            v[j * 4] = o[0]; v[j * 4 + 1] = o[1]; v[j * 4 + 2] = o[2]; v[j * 4 + 3] = o[3];
        }
        if (l == 0) norm_mod_store(v, p.norm1_g + 1024, MOD + (size_t)(1 * 33 + mod_row(r)) * 6144, H + (size_t)r * 1024, wv_);
    }
}

constexpr int NPH_LAYER = 10;
constexpr int NPH = 2 + 2 * NPH_LAYER;

__global__ void __launch_bounds__(512, 2) mk_forward(Params p_unused) {
    extern __shared__ __attribute__((aligned(16))) char smem_raw[];
    LAS char* shm = (LAS char*)smem_raw;
    volatile LAS unsigned* xb_words = (volatile LAS unsigned*)(shm + LDS_MISC);
    const int wv_ = __builtin_amdgcn_readfirstlane((int)(threadIdx.x >> 6));
    if (wv_ == 0 && olane() < 4) xb_words[olane()] = 0u;
    __syncthreads();
    kaptr_t ka = (kaptr_t)__builtin_amdgcn_kernarg_segment_ptr();
    const int tok0 = ptoken();
    const int lo = (int)kld64<__builtin_offsetof(Params, ph_lo)>(ka, tok0), hi = (int)kld64<__builtin_offsetof(Params, ph_hi)>(ka, tok0);
    const bool multi = (hi - lo) > 1;
    unsigned* barw = (unsigned*)((__attribute__((address_space(1))) char*)kld64<__builtin_offsetof(Params, ws)>(ka, tok0) + WS_BAR);
    XcdBarrier bar; bar.bar = barw; bar.x = 0; bar.st = xb_words;
    if (multi) bar = xcd_barrier_post(barw, xb_words, wv_);
#ifndef ONLY_KIND
#define ONLY_KIND (-1)
#endif
#define PHASE(idx, kind, FN, ...) do { if ((ONLY_KIND < 0 || ONLY_KIND == (kind)) && (idx) >= lo && (idx) < hi) { const Params p = kparams(ka, ptoken()); int nrep_ = 1 + ((MK_REPEAT_MASK >> (kind)) & 1); asm volatile("" : "+s"(nrep_)); for (int rep_ = 0; rep_ < nrep_; ++rep_) { Params p2 = p; p2.ph_lo = rep_; FN(p2, ##__VA_ARGS__, wv_); } if ((idx) + 1 < hi) xcd_barrier(bar, wv_); } } while (0)
    PHASE(0, 0, phase_prologue, shm);
    PHASE(1, 1, phase_norm1_l0);
    for (int l = 0; l < 2; ++l) {
        const int b0 = 2 + l * NPH_LAYER;
        PHASE(b0 + 0, 2, phase_inproj, shm, l);
        PHASE(b0 + 1, 3, phase_A, shm, l);
        PHASE(b0 + 2, 4, phase_B, shm, l);
        PHASE(b0 + 3, 5, phase_C, shm, l);
        PHASE(b0 + 4, 6, phase_D, shm, l);
        PHASE(b0 + 5, 7, phase_E, shm, l);
        PHASE(b0 + 6, 8, phase_router, shm, l);
        PHASE(b0 + 7, 9, phase_moe1, shm, l);
        PHASE(b0 + 8, 10, phase_moe2, shm, l);
        PHASE(b0 + 9, 11, phase_combine, shm, l);
    }
#undef PHASE
}


extern "C" void kernel_launch(void* const* d_in, const int* in_sizes, int n_in, void* d_out, int out_size, void* d_ws, size_t ws_size, hipStream_t stream) {
    static int grid = 0;
    if (grid == 0) {
        if (n_in != 39 || ws_size < WS_END) { fprintf(stderr, "kernel_launch: unexpected n_in %d or ws_size %zu (< %zu)\n", n_in, ws_size, (size_t)WS_END); grid = -1; return; }
        int dev = 0, cus = 0;
        if (hipGetDevice(&dev) != hipSuccess || hipDeviceGetAttribute(&cus, hipDeviceAttributeMultiprocessorCount, dev) != hipSuccess) { grid = -1; return; }
        if (hipFuncSetAttribute((const void*)mk_forward, hipFuncAttributeMaxDynamicSharedMemorySize, LDS_BYTES) != hipSuccess) { fprintf(stderr, "kernel_launch: hipFuncSetAttribute failed\n"); grid = -1; return; }
        int per_cu = 0;
        if (hipOccupancyMaxActiveBlocksPerMultiprocessor(&per_cu, (const void*)mk_forward, 512, LDS_BYTES) != hipSuccess || per_cu < 1) fprintf(stderr, "kernel_launch: occupancy query says %d\n", per_cu);
        (void)hipGetLastError();
        grid = cus;
    }
    if (grid < 0) return;
    (void)hipMemsetAsync((char*)d_ws + WS_BAR, 0, 16384 + 1024, stream);
    Params p{};
    const float** pf = (const float**)&p;
    for (int i = 0; i < 39; ++i) pf[i] = (const float*)d_in[i];
    p.out = (float*)d_out; p.ws = (char*)d_ws;
#if MK_ONE_LAUNCH
    p.ph_lo = 0; p.ph_hi = NPH;
    hipLaunchKernelGGL(mk_forward, dim3(grid), dim3(512), LDS_BYTES, stream, p);
#else
#ifndef MK_LAST_PHASE
#define MK_LAST_PHASE NPH
#endif
    for (int ph = 0; ph < MK_LAST_PHASE; ++ph) { p.ph_lo = ph; p.ph_hi = ph + 1; hipLaunchKernelGGL(mk_forward, dim3(grid), dim3(512), LDS_BYTES, stream, p); }
#endif
}
```

```cpp
#include <hip/hip_runtime.h>
#include <stdint.h>
#include <stdio.h>

#ifndef MK_REPEAT_MASK
#define MK_REPEAT_MASK 0x0
#endif
#ifndef MK_ONE_LAUNCH
#define MK_ONE_LAUNCH 1
#endif

#define DI __device__ __forceinline__
#define LAS __attribute__((address_space(3)))
typedef unsigned short bf16_t;
typedef short bf16x8 __attribute__((ext_vector_type(8)));
typedef short s16x4 __attribute__((ext_vector_type(4)));
typedef float f32x4 __attribute__((ext_vector_type(4)));
typedef float f32x16 __attribute__((ext_vector_type(16)));
typedef unsigned u32x2 __attribute__((ext_vector_type(2)));
typedef unsigned u32x4 __attribute__((ext_vector_type(4)));
typedef int i32x4 __attribute__((ext_vector_type(4)));
typedef int i32x8 __attribute__((ext_vector_type(8)));

constexpr int D = 1024, NB = 32, SEQ = 2048, CTXL = 256;
constexpr int TX = NB * SEQ, TC = NB * CTXL, TT = TX + TC;
constexpr int NINP = 1536;
constexpr int OFF_POOL = 512, OFF_Q = 768, OFF_SSM = 960, OFF_KV = 1216, OFF_KPE = 1344, N_IN = 1376;
constexpr int NE = 32;
constexpr int NCH = 36;
constexpr int NCROW = NB * NCH;
constexpr float EPS = 1e-6f;

constexpr size_t WS_BAR = 0;
constexpr size_t WS_CNT = 16384;
constexpr size_t WS_MOD = WS_CNT + 1024;
constexpr size_t WS_A64 = WS_MOD + (size_t)2 * 33 * 6144 * 4;
constexpr size_t WS_WMI = WS_A64 + (size_t)2 * 2 * 16 * 64 * 2 * 4;
constexpr size_t WS_WMO = WS_WMI + (size_t)2 * 1536 * 1024 * 2;
constexpr size_t WS_WPW = WS_WMO + (size_t)2 * 1024 * 1024 * 2;
constexpr size_t WS_WGLU = WS_WPW + (size_t)2 * 256 * 256 * 2;
constexpr size_t WS_WPOOL = WS_WGLU + (size_t)2 * 256 * 256 * 2;
constexpr size_t WS_WQ = WS_WPOOL + (size_t)2 * 256 * 256 * 2;
constexpr size_t WS_WKV = WS_WQ + (size_t)2 * 512 * 256 * 2;
constexpr size_t WS_TS5 = WS_WKV + (size_t)2 * 512 * 256 * 2;
constexpr size_t WS_WS5 = WS_TS5 + (size_t)2 * 16 * 1024 * 1280 * 2;
constexpr size_t WS_W1 = WS_WS5 + (size_t)2 * 16 * 256 * 1024 * 2;
constexpr size_t WS_W2 = WS_W1 + (size_t)32 * 2048 * 1024 * 2;
constexpr size_t WS_X = WS_W2 + (size_t)32 * 1024 * 1024 * 2;
constexpr size_t WS_H = WS_X + (size_t)TT * 1024 * 4;
constexpr size_t WS_LIST = WS_H + (size_t)TT * 1024 * 2;
constexpr size_t WS_TOPW = WS_LIST + (size_t)32 * TT * 8;
constexpr size_t WS_RA = WS_TOPW + (size_t)TT * 4 * 4;
constexpr size_t WS_RY = WS_RA + (size_t)TT * 4 * 1024 * 2;
constexpr size_t WS_END = WS_RY + (size_t)TT * 4 * 1024 * 2;
constexpr size_t WS_P = WS_RA;
constexpr size_t WS_ACONV = WS_P + (size_t)TT * NINP * 2;
constexpr size_t WS_APOOL = WS_ACONV + (size_t)TT * 256 * 2;
constexpr size_t WS_RAWQ = WS_APOOL + (size_t)TT * 256 * 2;
constexpr size_t WS_RAWKV = WS_RAWQ + (size_t)TT * 512 * 4;
constexpr size_t WS_Q = WS_RAWKV + (size_t)TT * 512 * 4;
constexpr size_t WS_KB = WS_Q + (size_t)TT * 384 * 2;
constexpr size_t WS_VT = WS_KB + (size_t)128 * 2304 * 96 * 2;
constexpr size_t WS_SST = WS_VT + (size_t)128 * 64 * 2304 * 2;
constexpr size_t WS_HIN = WS_SST + (size_t)NCROW * 16 * 256 * 4;
constexpr size_t WS_Z = WS_HIN + (size_t)NCROW * 16 * 256 * 2;
constexpr size_t WS_CAT = WS_Z + (size_t)TT * 256 * 2;
constexpr size_t WS_MIX_END = WS_CAT + (size_t)TT * 1024 * 2;
static_assert(WS_MIX_END <= WS_END, "mixer buffers must fit in the ACT/Y regions");
static_assert(WS_END <= (size_t)2147483648ull, "workspace budget");

constexpr int LDS_BYTES = 147456;
constexpr int LDS_MISC = 146432;

struct Params {
    const float *x, *c, *ctx, *c_ctx, *ada_w, *ada_b, *norm1_g, *norm2_g, *w_mix_in, *w_mix_out,
        *conv_dw, *conv_dw_b, *conv_ln_g, *conv_ln_b, *conv_pw, *pool_w, *pool_scale,
        *ssm_a_re, *ssm_a_im, *ssm_log_dt, *ssm_b_re, *ssm_b_im, *ssm_c_re, *ssm_c_im, *ssm_d, *ssm_glu_w, *ssm_glu_b,
        *mla_q_a_g, *mla_wq_b, *mla_kv_a_g, *mla_wkv_b, *mla_q_g, *mla_k_g,
        *router_w, *router_b, *exp_w_in, *exp_b_in, *exp_w_out, *exp_b_out;
    float* out;
    char* ws;
    long long ph_lo, ph_hi;
};

typedef const __attribute__((address_space(4))) char* kaptr_t;
template <int OFF> DI unsigned long long kld64(kaptr_t ka, int tok) {
    unsigned long long v;
    asm("s_load_dwordx2 %0, %1, %3\n\ts_waitcnt lgkmcnt(0)" : "=&s"(v) : "s"(ka), "s"(tok), "n"(OFF));
    return v;
}
DI int ptoken() { int t; asm volatile("s_mov_b32 %0, 0" : "=s"(t)); return t; }
DI Params kparams(kaptr_t ka, int tok) {
    Params p;
#define KL_(f) p.f = (decltype(p.f))((__attribute__((address_space(1))) char*)kld64<__builtin_offsetof(Params, f)>(ka, tok))
    KL_(x); KL_(c); KL_(ctx); KL_(c_ctx); KL_(ada_w); KL_(ada_b); KL_(norm1_g); KL_(norm2_g); KL_(w_mix_in); KL_(w_mix_out); KL_(conv_dw); KL_(conv_dw_b); KL_(conv_ln_g); KL_(conv_ln_b); KL_(conv_pw); KL_(pool_w); KL_(pool_scale); KL_(ssm_a_re); KL_(ssm_a_im); KL_(ssm_log_dt); KL_(ssm_b_re); KL_(ssm_b_im); KL_(ssm_c_re); KL_(ssm_c_im); KL_(ssm_d); KL_(ssm_glu_w); KL_(ssm_glu_b); KL_(mla_q_a_g); KL_(mla_wq_b); KL_(mla_kv_a_g); KL_(mla_wkv_b); KL_(mla_q_g); KL_(mla_k_g); KL_(router_w); KL_(router_b); KL_(exp_w_in); KL_(exp_b_in); KL_(exp_w_out); KL_(exp_b_out); KL_(out); KL_(ws);
#undef KL_
    p.ph_lo = 0; p.ph_hi = 0;
    return p;
}

typedef __bf16 bf16v2_t __attribute__((ext_vector_type(2)));
typedef float f32v2_t __attribute__((ext_vector_type(2)));
DI unsigned pk_bf16(float lo, float hi) { const f32v2_t f = {lo, hi}; const bf16v2_t b = __builtin_convertvector(f, bf16v2_t); return __builtin_bit_cast(unsigned, b); }
DI bf16_t f2bf(float x) { return (bf16_t)(pk_bf16(x, 0.f) & 0xffffu); }
DI float bf2f(bf16_t v) { return __uint_as_float(((unsigned)v) << 16); }
DI unsigned f2fp8(float x) { x = fminf(fmaxf(x, -448.f), 448.f); return (unsigned)__builtin_amdgcn_cvt_pk_fp8_f32(x, x, 0, false) & 0xffu; }
DI unsigned pk_fp8x4(float a, float b, float c, float d) { int v = __builtin_amdgcn_cvt_pk_fp8_f32(a, b, 0, false); v = __builtin_amdgcn_cvt_pk_fp8_f32(c, d, v, true); return (unsigned)v; }
DI float bflo(unsigned u) { return __uint_as_float(u << 16); }
DI float bfhi(unsigned u) { return __uint_as_float(u & 0xffff0000u); }
DI int olane() { int l = (int)__builtin_amdgcn_mbcnt_hi(~0u, __builtin_amdgcn_mbcnt_lo(~0u, 0u)); asm volatile("" : "+v"(l)); return l; }
DI float shx(float v, int o) { const int l = olane(); return __int_as_float(__builtin_amdgcn_ds_bpermute((l ^ o) << 2, __float_as_int(v))); }
DI float shi(float v, int src) { return __int_as_float(__builtin_amdgcn_ds_bpermute(src << 2, __float_as_int(v))); }
#define otid() otid_(wv_)
DI int otid_(int wv) { int t = (wv << 6) | olane(); asm volatile("" : "+v"(t)); return t; }
DI float wave_sum(float v) {
#pragma unroll
    for (int o = 32; o > 0; o >>= 1) v += shx(v, o);
    return v;
}
DI float wave_max(float v) {
#pragma unroll
    for (int o = 32; o > 0; o >>= 1) v = fmaxf(v, shx(v, o));
    return v;
}
DI float sigmoidf_(float x) { return __builtin_amdgcn_rcpf(1.f + __builtin_amdgcn_exp2f(-1.4426950408889634f * x)); }
DI float siluf_(float x) { return x * sigmoidf_(x); }
DI float gelu_tanh(float x) {
    const float u = 0.7978845608028654f * (x + 0.044715f * x * x * x);
    return x * __builtin_amdgcn_rcpf(1.f + __builtin_amdgcn_exp2f(-2.8853900817779268f * u));
}
DI void glds16(const void* src, LAS char* dst) {
    __builtin_amdgcn_global_load_lds((const __attribute__((address_space(1))) void*)src, (LAS void*)dst, 16, 0, 0);
}

#define XB_TMO      128
#define XB_XCNT(j)  (256  + 64 * (j))
#define XB_XSUB(j)  (1280 + 64 * (j))
#define XB_XGEN(j)  (2304 + 64 * (j))
#define XB_TOP      3328
#define XB_TOPGEN   3392
#define XCD_BAR_WORDS 3456
#define XB_SPIN_CAP (1u << 18)
__device__ __forceinline__ unsigned xb_ld(unsigned* p)              { return __hip_atomic_load(p, __ATOMIC_RELAXED, __HIP_MEMORY_SCOPE_AGENT); }
__device__ __forceinline__ unsigned xb_add(unsigned* p, unsigned v) { return __hip_atomic_fetch_add(p, v, __ATOMIC_RELAXED, __HIP_MEMORY_SCOPE_AGENT); }
__device__ __forceinline__ unsigned xb_xcc_id() { return (unsigned)__builtin_amdgcn_s_getreg((3 << 11) | 20) & 0xFu; }
#define XB_SPIN(cond, bar) do { unsigned _sp = 0; while (cond) { __builtin_amdgcn_s_sleep(1); \
    if ((++_sp & 255u) == 0u) { if (xb_ld(&(bar)[XB_TMO])) break; if (_sp > XB_SPIN_CAP) { atomicAdd(&(bar)[XB_TMO], 1u); break; } } } } while (0)
struct XcdBarrier { unsigned* bar; unsigned x; volatile LAS unsigned* st; };
__device__ __forceinline__ XcdBarrier xcd_barrier_post(unsigned* bar, volatile LAS unsigned* st, const int wv_) {
    XcdBarrier b; b.bar = bar; b.x = xb_xcc_id(); b.st = st;
    if (otid() == 0) (void)xb_add(&bar[XB_XCNT(b.x)], 1u);
    return b;
}
__device__ __forceinline__ void xcd_barrier_complete(unsigned* bar, unsigned x, unsigned& nloc, unsigned& nx) {
    const unsigned G = gridDim.x * gridDim.y * gridDim.z;
    unsigned sum, cnt, mine, sp = 0u;
    for (;;) {
        sum = 0u; cnt = 0u; mine = 0u;
#pragma unroll
        for (unsigned j = 0; j < 16; ++j) { const unsigned c = xb_ld(&bar[XB_XCNT(j)]); sum += c; cnt += (c > 0u) ? 1u : 0u; mine = (j == x) ? c : mine; }
        if (sum == G) break;
        __builtin_amdgcn_s_sleep(1);
        if ((++sp & 255u) == 0u) { if (xb_ld(&bar[XB_TMO])) break; if (sp > XB_SPIN_CAP) { atomicAdd(&bar[XB_TMO], 1u); break; } }
    }
    nloc = mine > 0u ? mine : 1u; nx = cnt > 0u ? cnt : 1u;
}
__device__ __forceinline__ void xcd_barrier(const XcdBarrier& b, const int wv_) {
    asm volatile("s_waitcnt vmcnt(0)" ::: "memory");
    __syncthreads();
    if (otid() == 0) {
        unsigned* bar = b.bar;
        __builtin_amdgcn_s_waitcnt(0);
        unsigned nloc = b.st[0], nx = b.st[1];
        if (nloc == 0u) { xcd_barrier_complete(bar, b.x, nloc, nx); b.st[0] = nloc; b.st[1] = nx; }
        const unsigned old = xb_add(&bar[XB_XSUB(b.x)], 1u);
        const unsigned gen = old / nloc;
        if (old + 1u == (gen + 1u) * nloc) {
            __builtin_amdgcn_fence(__ATOMIC_RELEASE, "agent");
            asm volatile("s_waitcnt vmcnt(0)" ::: "memory");
            const unsigned og = xb_add(&bar[XB_TOP], 1u);
            const unsigned tg = og / nx;
            if (og + 1u == (tg + 1u) * nx) xb_add(&bar[XB_TOPGEN], 1u);
            else XB_SPIN(xb_ld(&bar[XB_TOPGEN]) == tg, bar);
            __builtin_amdgcn_fence(__ATOMIC_ACQUIRE, "agent");
            xb_add(&bar[XB_XGEN(b.x)], 1u);
            asm volatile("s_waitcnt vmcnt(0)" ::: "memory");
        } else {
            XB_SPIN(xb_ld(&bar[XB_XGEN(b.x)]) == gen, bar);
            __builtin_amdgcn_fence(__ATOMIC_ACQUIRE, "agent");
            asm volatile("s_waitcnt vmcnt(0)" ::: "memory");
        }
    }
    __syncthreads();
}

constexpr int HTB = 128 * 64 * 2;
DI int lds_byte(int r, int c) { const int st = (r >> 4) * 2 + (c >> 5), rr = r & 15, cc = c & 31, ob = rr * 64 + cc * 2; return st * 1024 + (ob ^ (((ob >> 9) & 1) << 5)); }
DI void stage_rc(int b, int& R, int& C) { const int st = b / 1024, sb = b % 1024, swz = sb ^ (((sb >> 9) & 1) << 5); R = (st >> 1) * 16 + swz / 64; C = (st & 1) * 32 + (swz % 64) / 2; }

DI void stage_rc_t(int tz, int i, int& R, int& C) { stage_rc(tz * 16 + i * 8192, R, C); }
struct APlain {
    const char* base; int lda2;
    DI void park(LAS unsigned*) const {} DI void unpark(const LAS unsigned*) {} DI void take_uniform(const APlain&) {}
    DI const char* ptr(int tz, int h, int i, int kt) const { int R, C; stage_rc_t(tz, i, R, C); return base + (unsigned)((h * 128 + R) * lda2 + C * 2 + kt * 128); }
};
struct ASimple {
    const char* base; unsigned off[2][2]; unsigned kstride;
    DI void park(LAS unsigned* q) const { *(LAS u32x4*)q = (u32x4){off[0][0], off[0][1], off[1][0], off[1][1]}; }
    DI void unpark(const LAS unsigned* q) { const u32x4 v = *(const LAS u32x4*)q; off[0][0] = v.x; off[0][1] = v.y; off[1][0] = v.z; off[1][1] = v.w; }
    DI void take_uniform(const ASimple& o) { base = o.base; kstride = o.kstride; }
    DI const char* ptr(int tz, int h, int i, int kt) const { return base + (unsigned)(off[h][i] + (unsigned)kt * kstride); }
};
struct ASeg2 {
    const char* base0; const char* base1; unsigned off0[2][2]; unsigned off1[2][2]; unsigned ks0; int nt0;
    DI void park(LAS unsigned*) const {} DI void unpark(const LAS unsigned*) {} DI void take_uniform(const ASeg2&) {}
    DI const char* ptr(int tz, int h, int i, int kt) const { return kt < nt0 ? base0 + (unsigned)(off0[h][i] + (unsigned)kt * ks0) : base1 + (unsigned)(off1[h][i] + (unsigned)(kt - nt0) * 128u); }
};
struct BSimple {
    const char* base[2]; int ldb2;
    DI const char* ptr(int tz, int h, int i, int kt) const { int R, C; stage_rc_t(tz, i, R, C); return base[h] + (unsigned)(R * ldb2 + C * 2 + kt * 128); }
};

#define WAIT_V(n) asm volatile("s_waitcnt vmcnt(" #n ")" ::: "memory")
#define WAIT_L(n) asm volatile("s_waitcnt lgkmcnt(" #n ")" ::: "memory")
#define BAR_ __builtin_amdgcn_s_barrier()
#define SCHED_ __builtin_amdgcn_sched_barrier(0)

DI void zero_acc(f32x4 (&acc)[2][2][4][2]) {
#pragma unroll
    for (int a = 0; a < 2; ++a)
#pragma unroll
        for (int b = 0; b < 2; ++b)
#pragma unroll
            for (int m = 0; m < 4; ++m)
#pragma unroll
                for (int n = 0; n < 2; ++n) acc[a][b][m][n] = (f32x4){0.f, 0.f, 0.f, 0.f};
}
template <int MODE> struct FragT;
template <> struct FragT<0> {
    i32x4 lo, hi;
    DI void load(const LAS char* p0, const LAS char* p1) { lo = *(const LAS i32x4*)p0; hi = *(const LAS i32x4*)p1; }
    static DI f32x4 mma(const FragT& b, const FragT& a, f32x4 c) {
        c = __builtin_amdgcn_mfma_f32_16x16x32_bf16(__builtin_bit_cast(bf16x8, b.lo), __builtin_bit_cast(bf16x8, a.lo), c, 0, 0, 0);
        return __builtin_amdgcn_mfma_f32_16x16x32_bf16(__builtin_bit_cast(bf16x8, b.hi), __builtin_bit_cast(bf16x8, a.hi), c, 0, 0, 0); }
};
template <> struct FragT<1> {
    i32x4 lo, hi;
    DI void load(const LAS char* p0, const LAS char* p1) { lo = *(const LAS i32x4*)p0; hi = *(const LAS i32x4*)p1; }
    static DI long pk(int x, int y) { return (long)(((unsigned long long)(unsigned)y << 32) | (unsigned)x); }
    static DI f32x4 mma(const FragT& b, const FragT& a, f32x4 c) {
        c = __builtin_amdgcn_mfma_f32_16x16x32_fp8_fp8(pk(b.lo.x, b.lo.y), pk(a.lo.x, a.lo.y), c, 0, 0, 0);
        c = __builtin_amdgcn_mfma_f32_16x16x32_fp8_fp8(pk(b.lo.z, b.lo.w), pk(a.lo.z, a.lo.w), c, 0, 0, 0);
        c = __builtin_amdgcn_mfma_f32_16x16x32_fp8_fp8(pk(b.hi.x, b.hi.y), pk(a.hi.x, a.hi.y), c, 0, 0, 0);
        return __builtin_amdgcn_mfma_f32_16x16x32_fp8_fp8(pk(b.hi.z, b.hi.w), pk(a.hi.z, a.hi.w), c, 0, 0, 0); }
};
template <> struct FragT<2> {
    i32x8 v;
    DI void load(const LAS char* p0, const LAS char* p1) { const i32x4 lo = *(const LAS i32x4*)p0, hi = *(const LAS i32x4*)p1; v = __builtin_shufflevector(lo, hi, 0, 1, 2, 3, 4, 5, 6, 7); }
    static DI f32x4 mma(const FragT& b, const FragT& a, f32x4 c) {
        const int one = 0x7f7f7f7f;
        asm volatile("v_mfma_scale_f32_16x16x128_f8f6f4 %0, %1, %2, %0, %3, %3 op_sel_hi:[0,0,0]" : "+v"(c) : "v"(b.v), "v"(a.v), "v"(one));
        return c; }
};
template <class PV>
DI void gemm_stream(LAS char* shm, const PV& pv, const int wv_) {
    typedef typename PV::AS AS; typedef typename PV::BS BS;
    constexpr int nt = PV::NT;
    int u = pv.first();
    if (u < 0) return;
    const int tz = otid();
    const int wr = wv_ >> 2, wc = wv_ & 3, lane = tz & 63, fr = lane & 15, fq = lane >> 4;
    const int aoff = lds_byte(wr * 64 + fr, fq * 8), boff = lds_byte(wc * 32 + fr, fq * 8);
    const unsigned ldsw = (unsigned)wv_ * 1024u;
    f32x4 acc[2][2][4][2]; zero_acc(acc);
    typedef FragT<PV::FP8> Frag;
    Frag At[4], B0[2], B1[2];
    AS ca, na; BS cb, nb;
    pv.src(u, ca, cb, wv_);
    constexpr bool F8 = PV::FP8 != 0;
    LAS unsigned* park = (LAS unsigned*)(shm + 131072) + tz * 4;
    const int aoff0 = aoff, aoff1 = aoff + 1024;
    const int boff0 = boff, boff1 = boff + 1024;
#define SA_(b, h) (((b) * 2 + (h)) * HTB)
#define SB_(b, h) ((4 + (b) * 2 + (h)) * HTB)
#define STG_(bufoff, S, h, kt) do { _Pragma("unroll") for (int i_ = 0; i_ < 2; ++i_) glds16((S).ptr(tz, h, i_, kt), shm + (bufoff) + ldsw + i_ * 8192); } while (0)
#define LDA_(dst, b, h) do { _Pragma("unroll") for (int m = 0; m < 4; ++m) dst[m].load(shm + SA_(b, h) + aoff0 + m * 2048, shm + SA_(b, h) + aoff1 + m * 2048); } while (0)
#define LDB_(dst, b, h) do { _Pragma("unroll") for (int n = 0; n < 2; ++n) dst[n].load(shm + SB_(b, h) + boff0 + n * 2048, shm + SB_(b, h) + boff1 + n * 2048); } while (0)
#define MMA_(ai, bj, A_, B_) do { __builtin_amdgcn_s_setprio(1); \
        _Pragma("unroll") for (int m = 0; m < 4; ++m) _Pragma("unroll") for (int n = 0; n < 2; ++n) { \
            acc[ai][bj][m][n] = Frag::mma(B_[n], A_[m], acc[ai][bj][m][n]); } \
        __builtin_amdgcn_s_setprio(0); } while (0)
    STG_(SB_(0, 0), cb, 0, 0); STG_(SA_(0, 0), ca, 0, 0); STG_(SB_(0, 1), cb, 1, 0); STG_(SA_(0, 1), ca, 1, 0);
    if (wr == 1) BAR_;
    WAIT_V(4); BAR_;
    STG_(SB_(1, 0), cb, 0, 1); STG_(SA_(1, 0), ca, 0, 1); STG_(SB_(1, 1), cb, 1, 1);
    WAIT_V(6); BAR_;
    for (;;) {
        const int un = pv.next(u); const bool has_next = un >= 0;
        if (has_next) pv.src(un, na, nb, wv_); else { na = ca; nb = cb; }
        if (PV::PARK) { na.park(park); asm volatile("s_waitcnt lgkmcnt(0)" ::: "memory"); }
#pragma clang loop unroll(disable)
        for (int t = 0; t < nt; t += 2) {
            const bool last = (t == nt - 2);
            AS a2 = last ? na : ca; const BS b2 = last ? nb : cb; const int k2 = last ? 0 : t + 2;
            if (PV::PARK) { if (last) a2.unpark(park); }
            LDB_(B0, 0, 0); SCHED_; LDA_(At, 0, 0); STG_(SA_(1, 1), ca, 1, t + 1);
            WAIT_L(8); BAR_; WAIT_L(0); MMA_(0, 0, At, B0); BAR_; SCHED_;
            LDB_(B1, 0, 1); STG_(SB_(0, 0), b2, 0, k2);
            BAR_; WAIT_L(0); MMA_(0, 1, At, B1); BAR_;
            LDA_(At, 0, 1); STG_(SA_(0, 0), a2, 0, k2);
            BAR_; WAIT_L(0); MMA_(1, 0, At, B0); BAR_; SCHED_;
            STG_(SB_(0, 1), b2, 1, k2);
            WAIT_V(6); BAR_; MMA_(1, 1, At, B1); BAR_;
            LDB_(B0, 1, 0); SCHED_; LDA_(At, 1, 0); STG_(SA_(0, 1), a2, 1, k2);
            WAIT_L(8); BAR_; WAIT_L(0); MMA_(0, 0, At, B0); BAR_; SCHED_;
            LDB_(B1, 1, 1); STG_(SB_(1, 0), b2, 0, k2 + 1);
            BAR_; WAIT_L(0); MMA_(0, 1, At, B1); BAR_;
            LDA_(At, 1, 1); STG_(SA_(1, 0), a2, 0, k2 + 1);
            BAR_; WAIT_L(0); MMA_(1, 0, At, B0); BAR_; SCHED_;
            STG_(SB_(1, 1), b2, 1, k2 + 1);
            WAIT_V(6); BAR_; MMA_(1, 1, At, B1); BAR_;
            if (PV::PARK) { if (last) ca = a2; }
        }
        if (PV::FP8 == 2) asm volatile("s_nop 15\n\ts_nop 15" ::: "memory");
        pv.epi(acc, u, wv_);
        if (!has_next) break;
        zero_acc(acc);
        u = un; if (!PV::PARK) ca = na; cb = nb;
        if (PV::PARK) ca.take_uniform(na);
    }
    WAIT_V(0);
    if (wr == 0) BAR_;
    BAR_;
#undef SA_
#undef SB_
#undef STG_
#undef LDA_
#undef LDB_
#undef MMA_
}
DI int lin_first(int shift, int count) { const int G = gridDim.x; const int u = (int)((blockIdx.x + G - (shift % G)) % G); return u < count ? u : -1; }
DI int lin_next(int u, int count) { const int un = u + (int)gridDim.x; return un < count ? un : -1; }
template <int MG, int NTL> struct XcdDeal {
    int MT;
    DI bool decode(int J, int& mt, int& nt) const { const int x = blockIdx.x & 7; const int grp = (J / (MG * NTL)) * 8 + x, w = J % (MG * NTL); mt = grp * MG + w / NTL; nt = w % NTL; return mt < MT; }
    DI int jmax() const { return ((MT + 8 * MG - 1) / (8 * MG)) * (MG * NTL); }
    DI int first() const { int J = blockIdx.x >> 3; const int per = gridDim.x >> 3, jm = jmax(); int mt, nt;
        while (J < jm && !decode(J, mt, nt)) J += per;
        return J < jm ? J : -1; }
    DI int next(int J) const { const int per = gridDim.x >> 3, jm = jmax(); int mt, nt; J += per;
        while (J < jm && !decode(J, mt, nt)) J += per;
        return J < jm ? J : -1; }
};
DI int first_unit(int shift) { const int G = gridDim.x; return (int)((blockIdx.x + G - (shift % G)) % G); }

DI void stage_coords(int (&R)[2], int (&C)[2], const int wv_) {
    const int t_ = otid();
#pragma unroll
    for (int i = 0; i < 2; ++i) stage_rc(t_ * 16 + i * 8192, R[i], C[i]);
}
DI APlain make_a_plain(const bf16_t* A, size_t row0, int lda, int col0) {
    APlain a; a.base = (const char*)(A + row0 * (size_t)lda + col0); a.lda2 = lda * 2; return a;
}
DI BSimple make_b(const bf16_t* Bt0, const bf16_t* Bt1, int ldb) {
    BSimple b; b.base[0] = (const char*)Bt0; b.base[1] = (const char*)Bt1; b.ldb2 = ldb * 2; return b;
}
#define EPI_FOR(acc, ...) do { const int _tz = otid(), _w = _tz >> 6, _l = _tz & 63, _wr = _w >> 2, _wc = _w & 3, _fr = _l & 15, _fq = _l >> 4; \
    _Pragma("unroll") for (int ai = 0; ai < 2; ++ai) _Pragma("unroll") for (int m = 0; m < 4; ++m) { const int lr = ai * 128 + _wr * 64 + m * 16 + _fr; \
    _Pragma("unroll") for (int bj = 0; bj < 2; ++bj) _Pragma("unroll") for (int n = 0; n < 2; ++n) { const int lc = bj * 128 + _wc * 32 + n * 16 + _fq * 4; const f32x4 v = acc[ai][bj][m][n]; __VA_ARGS__ } } } while (0)

DI void store_bf16x4(bf16_t* p, float a, float b, float c, float d) { u32x2 v; v.x = pk_bf16(a, b); v.y = pk_bf16(c, d); *(u32x2*)p = v; }

DI int mod_row(int r) { return r < TX ? (r >> 11) : 32; }
DI int crow_tok(int cr) { const int b = cr / NCH, j = cr - b * NCH; return j < 4 ? TX + b * CTXL + j * 64 : b * SEQ + (j - 4) * 64; }

DI void cvt_tile(LAS char* wl  , const float* src, int ld_src, int kvalid, int nvalid, const float* scale, bf16_t* dst, int ld_dst, const int wv_) {
    const int lane = otid() & 63;
    const int lr = lane >> 4, lc = (lane & 15) * 4;
    f32x4 v[16];
#pragma unroll
    for (int it = 0; it < 16; ++it) {
        const int k = it * 4 + lr;
        v[it] = (f32x4){0.f, 0.f, 0.f, 0.f};
        if (src != nullptr && k < kvalid && lc < nvalid) { v[it] = *(const f32x4*)(src + (size_t)k * ld_src + lc); if (scale) { const float s = scale[k]; v[it] *= s; } }
    }
#pragma unroll
    for (int it = 0; it < 16; ++it) {
        const int k = it * 4 + lr;
#pragma unroll
        for (int j = 0; j < 4; ++j) *(LAS bf16_t*)(wl + (lc + j) * 144 + k * 2) = f2bf(v[it][j]);
    }
    asm volatile("s_waitcnt lgkmcnt(0)" ::: "memory");
#pragma unroll
    for (int i = 0; i < 8; ++i) {
        const int q = i * 64 + lane, n = q >> 3, c = q & 7;
        const u32x4 w = *(const LAS u32x4*)(wl + n * 144 + c * 16);
        *(u32x4*)(dst + (size_t)n * ld_dst + c * 8) = w;
    }
    asm volatile("s_waitcnt lgkmcnt(0)" ::: "memory");
}
DI void cvt_tile8(LAS char* wl  , const float* src, int ld_src, unsigned char* dst, int ld_dst, const int wv_) {
    const int lane = otid() & 63;
    const int lr = lane >> 4, lc = (lane & 15) * 4;
    f32x4 v[16];
#pragma unroll
    for (int it = 0; it < 16; ++it) v[it] = *(const f32x4*)(src + (size_t)(it * 4 + lr) * ld_src + lc);
#pragma unroll
    for (int it = 0; it < 16; ++it) {
        const int k = it * 4 + lr;
#pragma unroll
        for (int j = 0; j < 4; ++j) *(LAS unsigned char*)(wl + (lc + j) * 80 + k) = (unsigned char)f2fp8(v[it][j] * 256.f);
    }
    asm volatile("s_waitcnt lgkmcnt(0)" ::: "memory");
#pragma unroll
    for (int i = 0; i < 4; ++i) {
        const int q = i * 64 + lane, n = q >> 2, c = q & 3;
        const u32x4 w = *(const LAS u32x4*)(wl + n * 80 + c * 16);
        *(u32x4*)(dst + (size_t)n * ld_dst + c * 16) = w;
    }
    asm volatile("s_waitcnt lgkmcnt(0)" ::: "memory");
}
constexpr int CVT_SMALL_TILES = 768 + 512 + 32 + 32 + 64 + 64 + 32;
constexpr int CVT_EXP_TILES = 32 * (32 * 16 + 16 * 16);
DI void cvt_small(const Params& p, LAS char* wl, int t, const int wv_) {
    char* ws = p.ws;
    if (t < 768) { const int l = t / 384, r = t % 384, nt = r / 16, kt = r % 16;
        cvt_tile(wl, p.w_mix_in + (size_t)l * 1024 * N_IN + (size_t)kt * 64 * N_IN + nt * 64, N_IN, 64, N_IN - nt * 64, nullptr,
                 (bf16_t*)(ws + WS_WMI) + ((size_t)l * 1536 + nt * 64) * 1024 + kt * 64, 1024, wv_); return; }
    t -= 768;
    if (t < 512) { const int l = t / 256, r = t % 256, nt = r / 16, kt = r % 16;
        cvt_tile(wl, p.w_mix_out + (size_t)l * 1024 * 1024 + (size_t)kt * 64 * 1024 + nt * 64, 1024, 64, 64, nullptr,
                 (bf16_t*)(ws + WS_WMO) + ((size_t)l * 1024 + nt * 64) * 1024 + kt * 64, 1024, wv_); return; }
    t -= 512;
    if (t < 32) { const int l = t / 16, r = t % 16, nt = r / 4, kt = r % 4;
        cvt_tile(wl, p.conv_pw + (size_t)l * 65536 + (size_t)kt * 64 * 256 + nt * 64, 256, 64, 64, nullptr,
                 (bf16_t*)(ws + WS_WPW) + ((size_t)l * 256 + nt * 64) * 256 + kt * 64, 256, wv_); return; }
    t -= 32;
    if (t < 32) { const int l = t / 16, r = t % 16, nt = r / 4, kt = r % 4;
        cvt_tile(wl, p.ssm_glu_w + (size_t)l * 65536 + (size_t)kt * 64 * 256 + nt * 64, 256, 64, 64, nullptr,
                 (bf16_t*)(ws + WS_WGLU) + ((size_t)l * 256 + nt * 64) * 256 + kt * 64, 256, wv_); return; }
    t -= 32;
    if (t < 64) { const int l = t / 32, r = t % 32, nt = r / 4, kt = r % 4;
        const bool any = (kt < 3) && (nt < 6);
        cvt_tile(wl, any ? p.mla_wq_b + (size_t)l * 192 * 384 + (size_t)kt * 64 * 384 + nt * 64 : nullptr, 384, 64, 64, p.mla_q_a_g + l * 192 + kt * 64,
                 (bf16_t*)(ws + WS_WQ) + ((size_t)l * 512 + nt * 64) * 256 + kt * 64, 256, wv_); return; }
    t -= 64;
    if (t < 64) { const int l = t / 32, r = t % 32, nt = r / 4, kt = r % 4;
        const bool any = (kt < 2);
        cvt_tile(wl, any ? p.mla_wkv_b + (size_t)l * 128 * 512 + (size_t)kt * 64 * 512 + nt * 64 : nullptr, 512, 64, 64, p.mla_kv_a_g + l * 128 + kt * 64,
                 (bf16_t*)(ws + WS_WKV) + ((size_t)l * 512 + nt * 64) * 256 + kt * 64, 256, wv_); return; }
    t -= 64;
    { const int l = t / 16, r = t % 16, nt = r / 4, kt = r % 4;
        cvt_tile(wl, nt == kt ? p.pool_w + ((size_t)l * 4 + nt) * 4096 : nullptr, 64, 64, 64, nullptr,
                 (bf16_t*)(ws + WS_WPOOL) + ((size_t)l * 256 + nt * 64) * 256 + kt * 64, 256, wv_); }
}
DI void cvt_expert(const Params& p, LAS char* wl, int l, int t, const int wv_) {
    char* ws = p.ws;
    const int e = t / 768, r = t % 768;
    if (r < 512) { const int nt = r / 16, kt = r % 16;
        cvt_tile8(wl, p.exp_w_in + ((size_t)(l * NE + e) * 1024 + kt * 64) * 2048 + nt * 64, 2048,
                  (unsigned char*)(ws + WS_W1) + ((size_t)(l * NE + e) * 2048 + nt * 64) * 1024 + kt * 64, 1024, wv_);
    } else { const int q = r - 512, nt = q / 16, kt = q % 16;
        cvt_tile8(wl, p.exp_w_out + ((size_t)(l * NE + e) * 1024 + kt * 64) * 1024 + nt * 64, 1024,
                  (unsigned char*)(ws + WS_W2) + ((size_t)(l * NE + e) * 1024 + nt * 64) * 1024 + kt * 64, 1024, wv_);
    }
}

DI void ada_unit(const Params& p, LAS char* shm, int u, const int wv_) {
    const int tid = otid();
    const int l = u / 48, jc = u % 48;
    LAS float* sc = (LAS float*)shm;
    for (int i = tid; i < 33 * 1024; i += 512) { const int r = i >> 10, k = i & 1023; const float v = r < 32 ? p.c[r * 1024 + k] : p.c_ctx[k]; sc[i] = siluf_(v); }
    __syncthreads();
    const int col = tid & 127, kq = tid >> 7;
    float acc[33];
#pragma unroll
    for (int r = 0; r < 33; ++r) acc[r] = 0.f;
    const float* wp = p.ada_w + ((size_t)l * 1024 + kq * 256) * 6144 + jc * 128 + col;
    for (int k4 = 0; k4 < 256; k4 += 4) {
        float w[4];
#pragma unroll
        for (int i = 0; i < 4; ++i) w[i] = wp[(size_t)(k4 + i) * 6144];
#pragma unroll
        for (int r = 0; r < 33; ++r) { const f32x4 s = *(const LAS f32x4*)(sc + r * 1024 + kq * 256 + k4); acc[r] += s[0] * w[0] + s[1] * w[1] + s[2] * w[2] + s[3] * w[3]; }
    }
    __syncthreads();
    LAS float* red = (LAS float*)shm;
#pragma unroll
    for (int r = 0; r < 33; ++r) red[(kq * 33 + r) * 128 + col] = acc[r];
    __syncthreads();
    for (int i = tid; i < 33 * 128; i += 512) { const int r = i >> 7, cc = i & 127;
        const float s = red[(0 * 33 + r) * 128 + cc] + red[(1 * 33 + r) * 128 + cc] + red[(2 * 33 + r) * 128 + cc] + red[(3 * 33 + r) * 128 + cc];
        ((float*)(p.ws + WS_MOD))[((size_t)l * 33 + r) * 6144 + jc * 128 + cc] = s + p.ada_b[l * 6144 + jc * 128 + cc]; }
    __syncthreads();
}

DI void s5_load_bc(const Params& p, LAS float* bb, LAS float* cc, int l, int dir, int g, int tid) {
    const int pbase = ((l * 2 + dir) * 16 + g) * 64;
    const double dt = exp((double)p.ssm_log_dt[(l * 2 + dir) * 16 + g]);
    for (int i = tid; i < 64 * 16; i += 512) { const int q = i >> 4, ci = i & 15;
        const double are = fmin((double)p.ssm_a_re[pbase + q], -1e-4), aim = (double)p.ssm_a_im[pbase + q];
        const double mg = exp(are * dt), abr = mg * cos(aim * dt), abi = mg * sin(aim * dt), den = are * are + aim * aim;
        const double fre = ((abr - 1.0) * are + abi * aim) / den, fim = (abi * are - (abr - 1.0) * aim) / den;
        const double br = (double)p.ssm_b_re[(size_t)(pbase + q) * 16 + ci], bi = (double)p.ssm_b_im[(size_t)(pbase + q) * 16 + ci];
        bb[i * 2] = (float)(fre * br - fim * bi); bb[i * 2 + 1] = (float)(fre * bi + fim * br); }
    for (int i = tid; i < 16 * 64; i += 512) { const int co = i >> 6, q = i & 63;
        const size_t ix = ((size_t)((l * 2 + dir) * 16 + g) * 16 + co) * 64 + q;
        cc[i * 2] = p.ssm_c_re[ix]; cc[i * 2 + 1] = p.ssm_c_im[ix]; }
}
DI void s5pre_unit(const Params& p, LAS char* shm, int u, const int wv_) {
    const int tid = otid();
    const int l = u >> 5, g = (u >> 1) & 15, dir = u & 1;
    LAS float* pw = (LAS float*)shm;
    LAS float* bb = pw + 65 * 64 * 2;
    LAS float* cc = bb + 64 * 16 * 2;
    LAS float* kk = cc + 16 * 64 * 2;
    LAS float* k0o = kk + 64 * 256;
    bf16_t* TS = (bf16_t*)(p.ws + WS_TS5) + (size_t)(l * 16 + g) * 1024 * 1280;
    bf16_t* WS = (bf16_t*)(p.ws + WS_WS5) + (size_t)(l * 16 + g) * 256 * 1024;
    const int cocip = tid & 255, co_ = cocip >> 4, ci_ = cocip & 15;
    if (dir == 0) {
        s5_load_bc(p, bb, cc, l, 1, g, tid);
        __syncthreads();
        if (tid < 256) { float s_ = 0.f;
            for (int q = 0; q < 64; ++q) s_ += cc[(co_ * 64 + q) * 2] * bb[(q * 16 + ci_) * 2] - cc[(co_ * 64 + q) * 2 + 1] * bb[(q * 16 + ci_) * 2 + 1];
            k0o[tid] = s_; }
        __syncthreads();
    }
    {
        const int pbase = ((l * 2 + dir) * 16 + g) * 64;
        const double dt = exp((double)p.ssm_log_dt[(l * 2 + dir) * 16 + g]);
        for (int i = tid; i < 65 * 64; i += 512) { const int tau = i >> 6, q = i & 63;
            const double are = fmin((double)p.ssm_a_re[pbase + q], -1e-4), aim = (double)p.ssm_a_im[pbase + q];
            const double mg = exp(are * dt * tau), an = aim * dt * tau;
            pw[i * 2] = (float)(mg * cos(an)); pw[i * 2 + 1] = (float)(mg * sin(an)); }
        s5_load_bc(p, bb, cc, l, dir, g, tid);
        __syncthreads();
        if (tid < 64) { float* a64 = (float*)(p.ws + WS_A64) + (size_t)(((l * 2 + dir) * 16 + g) * 64 + tid) * 2; a64[0] = pw[(64 * 64 + tid) * 2]; a64[1] = pw[(64 * 64 + tid) * 2 + 1]; }
        { float gr[64], gi[64];
#pragma unroll
          for (int q = 0; q < 64; ++q) { const float cr = cc[(co_ * 64 + q) * 2], cim = cc[(co_ * 64 + q) * 2 + 1], br = bb[(q * 16 + ci_) * 2], bi = bb[(q * 16 + ci_) * 2 + 1];
              gr[q] = cr * br - cim * bi; gi[q] = cr * bi + cim * br; }
          for (int tau = (tid >> 8); tau < 64; tau += 2) {
              float s_ = 0.f;
#pragma unroll
              for (int q = 0; q < 64; ++q) s_ += gr[q] * pw[(tau * 64 + q) * 2] - gi[q] * pw[(tau * 64 + q) * 2 + 1];
              kk[tau * 256 + cocip] = s_;
          } }
        for (int i = tid; i < 128 * 512; i += 512) { const int row = i >> 9, kp = (i & 511) * 2, ri = row >> 6, q = row & 63, s_ = kp >> 4, ci = kp & 15;
            const int e = dir == 0 ? 63 - s_ : s_;
            const float pr = pw[(e * 64 + q) * 2], pi = pw[(e * 64 + q) * 2 + 1];
            float o[2];
#pragma unroll
            for (int j = 0; j < 2; ++j) { const float br = bb[(q * 16 + ci + j) * 2], bi = bb[(q * 16 + ci + j) * 2 + 1]; o[j] = ri == 0 ? pr * br - pi * bi : pr * bi + pi * br; }
            *(unsigned*)(WS + (size_t)(dir * 128 + row) * 1024 + kp) = pk_bf16(o[0], o[1]); }
        for (int i = tid; i < 1024 * 64; i += 512) { const int row = i >> 6, kp = (i & 63) * 2, t = row >> 4, co = row & 15, ri = kp >> 6, q = kp & 63;
            const int e = dir == 0 ? t + 1 : 64 - t;
            float o[2];
#pragma unroll
            for (int j = 0; j < 2; ++j) { const float pr = pw[(e * 64 + q + j) * 2], pi = pw[(e * 64 + q + j) * 2 + 1];
                const float cr = cc[(co * 64 + q + j) * 2], cim = cc[(co * 64 + q + j) * 2 + 1];
                o[j] = ri == 0 ? (cr * pr - cim * pi) : -(cr * pi + cim * pr); }
            *(unsigned*)(TS + (size_t)row * 1280 + 1024 + dir * 128 + kp) = pk_bf16(o[0], o[1]); }
        __syncthreads();
        for (int rr = tid; rr < 1024; rr += 512) { const int t = rr >> 4, co = rr & 15;
            const float dco = p.ssm_d[l * 256 + g * 16 + co];
            bf16_t* rowp = TS + (size_t)rr * 1280;
            const int s_lo = dir == 0 ? 0 : t + 1, s_hi = dir == 0 ? t : 63;
            for (int s_ = s_lo; s_ <= s_hi; ++s_) { const int tau = dir == 0 ? t - s_ : s_ - t;
                unsigned w[8];
#pragma unroll
                for (int j = 0; j < 8; ++j) { float a = kk[tau * 256 + co * 16 + 2 * j], b2 = kk[tau * 256 + co * 16 + 2 * j + 1];
                    if (s_ == t) { a += k0o[co * 16 + 2 * j]; b2 += k0o[co * 16 + 2 * j + 1]; if (2 * j == co) a += dco; if (2 * j + 1 == co) b2 += dco; }
                    w[j] = pk_bf16(a, b2); }
                *(u32x4*)(rowp + s_ * 16) = (u32x4){w[0], w[1], w[2], w[3]}; *(u32x4*)(rowp + s_ * 16 + 8) = (u32x4){w[4], w[5], w[6], w[7]}; }
        }
        __syncthreads();
    }
}

DI void phase_prologue(const Params& p, LAS char* shm, const int wv_) {
    const int tid = otid();
    __syncthreads();
    if (blockIdx.x == 0 && tid < 64) ((int*)(p.ws + WS_CNT))[tid] = 0;
    const int n_cvt = (CVT_SMALL_TILES + 2 * CVT_EXP_TILES + 7) / 8;
    const int n_units = 64 + 96 + n_cvt;
    for (int u = blockIdx.x; u < n_units; u += gridDim.x) {
        if (u < 64) s5pre_unit(p, shm, u, wv_);
        else if (u < 160) ada_unit(p, shm, u - 64, wv_);
        else {
            const int t = (u - 160) * 8 + (tid >> 6);
            LAS char* wl = shm + (tid >> 6) * (64 * 144);
            if (t < CVT_SMALL_TILES) cvt_small(p, wl, t, wv_);
            else if (t < CVT_SMALL_TILES + 2 * CVT_EXP_TILES) { const int te = t - CVT_SMALL_TILES; cvt_expert(p, wl, te / CVT_EXP_TILES, te % CVT_EXP_TILES, wv_); }
        }
    }
}

DI void norm_mod_store(const float (&v)[16], const float* g, const float* modrow  , bf16_t* hrow, const int wv_) {
    const int lane = otid() & 63;
    float ss = 0.f;
#pragma unroll
    for (int i = 0; i < 16; ++i) ss += v[i] * v[i];
    ss = wave_sum(ss);
    const float rn = rsqrtf(ss * (1.f / 1024.f) + EPS);
#pragma unroll
    for (int j = 0; j < 4; ++j) {
        const int col = j * 256 + lane * 4;
        const f32x4 gg = *(const f32x4*)(g + col), sh = *(const f32x4*)(modrow + col), sc = *(const f32x4*)(modrow + 1024 + col);
        float o[4];
#pragma unroll
        for (int i = 0; i < 4; ++i) o[i] = v[j * 4 + i] * rn * gg[i] * (1.f + sc[i]) + sh[i];
        store_bf16x4(hrow + col, o[0], o[1], o[2], o[3]);
    }
}
DI void phase_norm1_l0(const Params& p, const int wv_) {
    const int tid_ = otid(); const int wid = tid_ >> 6, lane = tid_ & 63;
    const float* MOD = (const float*)(p.ws + WS_MOD);
    bf16_t* H = (bf16_t*)(p.ws + WS_H);
    for (int r = blockIdx.x * 8 + wid; r < TT; r += gridDim.x * 8) {
        const float* src = r < TX ? p.x + (size_t)r * 1024 : p.ctx + (size_t)(r - TX) * 1024;
        float v[16];
#pragma unroll
        for (int j = 0; j < 4; ++j) { const f32x4 t = *(const f32x4*)(src + j * 256 + lane * 4); v[j * 4] = t[0]; v[j * 4 + 1] = t[1]; v[j * 4 + 2] = t[2]; v[j * 4 + 3] = t[3]; }
        norm_mod_store(v, p.norm1_g, MOD + (size_t)(0 * 33 + mod_row(r)) * 6144, H + (size_t)r * 1024, wv_);
    }
}

struct PvInproj {
    const Params& p; int l;
    static constexpr int NT = 16; static constexpr int FP8 = 0; static constexpr bool PARK = false; typedef APlain AS; typedef BSimple BS;
    XcdDeal<4, 6> deal;
    DI int first() const { return deal.first(); }
    DI int next(int u) const { return deal.next(u); }
    DI void src(int u, AS& a, BS& b, const int wv_) const {
        int mt, nt; deal.decode(u, mt, nt);
        const bf16_t* W = (const bf16_t*)(p.ws + WS_WMI) + (size_t)l * 1536 * 1024;
        a = make_a_plain((const bf16_t*)(p.ws + WS_H), (size_t)mt * 256, 1024, 0);
        b = nt < 2 ? make_b(W + (size_t)(nt * 128) * 1024, W + (size_t)(256 + nt * 128) * 1024, 1024)
                   : make_b(W + (size_t)(nt * 256) * 1024, W + (size_t)(nt * 256 + 128) * 1024, 1024);
    }
    DI void epi(f32x4 (&acc)[2][2][4][2], int u, const int wv_) const {
        int mt, nt; deal.decode(u, mt, nt);
        bf16_t* P = (bf16_t*)(p.ws + WS_P);
        if (nt < 2) {
            const int _tz = otid(), _w = _tz >> 6, _l = _tz & 63, _wr = _w >> 2, _wc = _w & 3, _fr = _l & 15, _fq = _l >> 4;
#pragma unroll
            for (int ai = 0; ai < 2; ++ai)
#pragma unroll
                for (int m = 0; m < 4; ++m) { const int lr = ai * 128 + _wr * 64 + m * 16 + _fr;
#pragma unroll
                    for (int n = 0; n < 2; ++n) { const int lc = _wc * 32 + n * 16 + _fq * 4; const f32x4 va = acc[ai][0][m][n], ga = acc[ai][1][m][n];
                        store_bf16x4(P + (size_t)(mt * 256 + lr) * NINP + nt * 128 + lc, va[0] * sigmoidf_(ga[0]), va[1] * sigmoidf_(ga[1]), va[2] * sigmoidf_(ga[2]), va[3] * sigmoidf_(ga[3])); } }
        } else {
            EPI_FOR(acc, { store_bf16x4(P + (size_t)(mt * 256 + lr) * NINP + nt * 256 + lc, v[0], v[1], v[2], v[3]); });
        }
    }
};
DI void phase_inproj(const Params& p, LAS char* shm, int l, const int wv_) {
    PvInproj pv{p, l, {TT / 256}};
    gemm_stream(shm, pv, wv_);
}

template <int N> DI void wave_sum_n(float (&v)[N]) {
    const int l4 = olane();
#pragma unroll
    for (int o = 32; o > 0; o >>= 1) {
        float t_[N];
#pragma unroll
        for (int i = 0; i < N; ++i) t_[i] = __int_as_float(__builtin_amdgcn_ds_bpermute((l4 ^ o) << 2, __float_as_int(v[i])));
#pragma unroll
        for (int i = 0; i < N; ++i) v[i] += t_[i];
    }
}
template <int WIN, bool EDGE>
DI void pool_run(const bf16_t* P, bf16_t* AP, int row0, int ts0, int L, int c, int half) {
    for (int blk = 0; blk < 2; ++blk) {
        const int t0 = half * 32 + blk * 16;
        float in[16 + WIN - 1];
#pragma unroll
        for (int i = 0; i < 16 + WIN - 1; ++i) { const int d = i - WIN / 2; const int ts = ts0 + t0 + d;
            in[i] = (!EDGE || (ts >= 0 && ts < L)) ? bf2f(P[(size_t)(row0 + t0 + d) * NINP + OFF_POOL + c]) : 0.f; }
        float sum = 0.f;
#pragma unroll
        for (int j = 0; j < WIN; ++j) sum += in[j];
#pragma unroll
        for (int o = 0; o < 16; ++o) {
            float inv = 1.f / (float)WIN;
            if (EDGE) { const int ts = ts0 + t0 + o; const int lo = max(ts - WIN / 2, 0), hi = min(ts + WIN - 1 - WIN / 2, L - 1); inv = 1.f / (float)(hi - lo + 1); }
            AP[(size_t)(row0 + t0 + o) * 256 + c] = f2bf(sum * inv - in[o + WIN / 2]);
            if (o < 15) sum += in[o + WIN] - in[o];
        }
    }
}
template <bool EDGE>
DI void pre_unit_t(const Params& p, LAS char* shm, int l, int row0, int ts0, int L, const int wv_) {
    const int tid = otid();
    const bf16_t* P = (const bf16_t*)(p.ws + WS_P);
    const int c = tid & 255, half = tid >> 8;
    LAS float* cv = (LAS float*)shm;
    {
        float w[31];
#pragma unroll
        for (int j = 0; j < 31; ++j) w[j] = p.conv_dw[((size_t)l * 31 + j) * 256 + c];
        const float bias = p.conv_dw_b[l * 256 + c];
        const int t0 = half * 32;
        float in[62];
#pragma unroll
        for (int i = 0; i < 62; ++i) {
            const int ts = ts0 + t0 - 15 + i;
            in[i] = (!EDGE || (ts >= 0 && ts < L)) ? bf2f(P[(size_t)(row0 + t0 - 15 + i) * NINP + c]) : 0.f;
        }
#pragma unroll
        for (int o = 0; o < 32; ++o) { float s_ = bias;
#pragma unroll
            for (int j = 0; j < 31; ++j) s_ += w[j] * in[o + j];
            cv[(t0 + o) * 257 + c] = s_; }
    }
    __syncthreads();
    {
        const int wid = tid >> 6, lane = tid & 63;
        bf16_t* AC = (bf16_t*)(p.ws + WS_ACONV);
        float lg[4], lb[4];
#pragma unroll
        for (int j = 0; j < 4; ++j) { lg[j] = p.conv_ln_g[l * 256 + lane + 64 * j]; lb[j] = p.conv_ln_b[l * 256 + lane + 64 * j]; }
        float x[8][4], s8[8];
#pragma unroll
        for (int i = 0; i < 8; ++i) { s8[i] = 0.f;
#pragma unroll
            for (int j = 0; j < 4; ++j) { x[i][j] = cv[(wid * 8 + i) * 257 + lane + 64 * j]; s8[i] += x[i][j]; } }
        wave_sum_n<8>(s8);
#pragma unroll
        for (int i = 0; i < 8; ++i) { const float mu = s8[i] * (1.f / 256.f); s8[i] = 0.f;
#pragma unroll
            for (int j = 0; j < 4; ++j) { x[i][j] -= mu; s8[i] += x[i][j] * x[i][j]; } }
        wave_sum_n<8>(s8);
#pragma unroll
        for (int i = 0; i < 8; ++i) { const float rs = rsqrtf(s8[i] * (1.f / 256.f) + EPS);
#pragma unroll
            for (int j = 0; j < 4; ++j) { const float y = x[i][j] * rs * lg[j] + lb[j]; AC[(size_t)(row0 + wid * 8 + i) * 256 + lane + 64 * j] = f2bf(siluf_(y)); } }
    }
    {
        bf16_t* AP = (bf16_t*)(p.ws + WS_APOOL);
        const int g = __builtin_amdgcn_readfirstlane(c >> 6);
        if (g == 0) pool_run<2, EDGE>(P, AP, row0, ts0, L, c, half);
        else if (g == 1) pool_run<4, EDGE>(P, AP, row0, ts0, L, c, half);
        else if (g == 2) pool_run<8, EDGE>(P, AP, row0, ts0, L, c, half);
        else pool_run<16, EDGE>(P, AP, row0, ts0, L, c, half);
    }
    __syncthreads();
}
DI void pre_unit(const Params& p, LAS char* shm, int l, int tile, const int wv_) {
    int row0, ts0, L;
    if (tile < 1024) { row0 = tile * 64; ts0 = row0 & 2047; L = SEQ; } else { row0 = TX + (tile - 1024) * 64; ts0 = (row0 - TX) & 255; L = CTXL; }
    if (ts0 >= 16 && ts0 + 64 + 16 <= L) pre_unit_t<false>(p, shm, l, row0, ts0, L, wv_);
    else pre_unit_t<true>(p, shm, l, row0, ts0, L, wv_);
}
struct PvS5State {
    const Params& p; int l;
    static constexpr int NT = 16; static constexpr int FP8 = 0; static constexpr bool PARK = false; typedef ASimple AS; typedef BSimple BS;
    DI int first() const { return lin_first(0, 80); }
    DI int next(int u) const { return lin_next(u, 80); }
    DI void src(int u, AS& as, BS& bs, const int wv_) const {
        const int g = u / 5, mt = u % 5;
        int R[2], C[2]; stage_coords(R, C, wv_);
        as.base = (const char*)(p.ws + WS_P); as.kstride = 4 * NINP * 2;
#pragma unroll
        for (int h = 0; h < 2; ++h)
#pragma unroll
            for (int i = 0; i < 2; ++i) { const int cr = min(mt * 256 + h * 128 + R[i], NCROW - 1);
                as.off[h][i] = (unsigned)(((size_t)(crow_tok(cr) + (C[i] >> 4)) * NINP + OFF_SSM + g * 16 + (C[i] & 15)) * 2); }
        const bf16_t* W = (const bf16_t*)(p.ws + WS_WS5) + (size_t)(l * 16 + g) * 256 * 1024;
        bs = make_b(W, W + (size_t)128 * 1024, 1024);
    }
    DI void epi(f32x4 (&acc)[2][2][4][2], int u, const int wv_) const {
        const int g = u / 5, mt = u % 5;
        float* SST = (float*)(p.ws + WS_SST);
        EPI_FOR(acc, { const int cr = mt * 256 + lr; if (cr < NCROW) *(f32x4*)(SST + ((size_t)cr * 16 + g) * 256 + lc) = v; });
    }
};
struct PvQKV {
    const Params& p; int l;
    static constexpr int NT = 4; static constexpr int FP8 = 0; static constexpr bool PARK = false; typedef APlain AS; typedef BSimple BS;
    DI int first() const { return lin_first(80, 1152); }
    DI int next(int u) const { return lin_next(u, 1152); }
    DI void src(int u, AS& a, BS& b, const int wv_) const {
        const bool isq = u < 576; const int w_ = isq ? u : u - 576; const int mt = w_ >> 1, nt = w_ & 1;
        a = make_a_plain((const bf16_t*)(p.ws + WS_P), (size_t)mt * 256, NINP, isq ? OFF_Q : OFF_KV);
        const bf16_t* W = (const bf16_t*)(p.ws + (isq ? WS_WQ : WS_WKV)) + (size_t)l * 512 * 256 + (size_t)nt * 256 * 256;
        b = make_b(W, W + (size_t)128 * 256, 256);
    }
    DI void epi(f32x4 (&acc)[2][2][4][2], int u, const int wv_) const {
        const bool isq = u < 576; const int w_ = isq ? u : u - 576; const int mt = w_ >> 1, nt = w_ & 1;
        float* RAW = (float*)(p.ws + (isq ? WS_RAWQ : WS_RAWKV));
        EPI_FOR(acc, { *(f32x4*)(RAW + (size_t)(mt * 256 + lr) * 512 + nt * 256 + lc) = v; });
    }
};
DI void phase_A(const Params& p, LAS char* shm, int l, const int wv_) {
    { PvS5State pv{p, l}; gemm_stream(shm, pv, wv_); }
    { PvQKV pv{p, l}; gemm_stream(shm, pv, wv_); }
    for (int u = first_unit(80 + 1152); u < 1152; u += gridDim.x) pre_unit(p, shm, l, u, wv_);
}

DI void qkvpost_unit(const Params& p, LAS char* shm, int l, int unit, const int wv_) {
    const int tid = otid(), wid = tid >> 6, lane = tid & 63;
    const bf16_t* P = (const bf16_t*)(p.ws + WS_P);
    const float* RAWQ = (const float*)(p.ws + WS_RAWQ);
    const float* RAWKV = (const float*)(p.ws + WS_RAWKV);
    bf16_t* Q = (bf16_t*)(p.ws + WS_Q);
    bf16_t* KB = (bf16_t*)(p.ws + WS_KB);
    bf16_t* VT = (bf16_t*)(p.ws + WS_VT);
    LAS bf16_t* vt = (LAS bf16_t*)shm;
    const int row0 = unit * 64;
    const bool lat = row0 < TX;
    const int b = lat ? (row0 >> 11) : ((row0 - TX) >> 8);
    const int key0 = lat ? (row0 & 2047) : 2048 + ((row0 - TX) & 255);
    const int head = lane >> 4, sub = lane & 15;
    const float lninv = -9.210340371976184f / 8.f;
    const float frq = __expf(lninv * (float)(sub & 7));
    float qg[6], kg[6];
#pragma unroll
    for (int j = 0; j < 6; ++j) { qg[j] = p.mla_q_g[l * 96 + sub + 16 * j] * 0.14724444674085666f; kg[j] = p.mla_k_g[l * 96 + sub + 16 * j]; }
    constexpr int NB = 4;
    for (int tk0 = wid * 8; tk0 < wid * 8 + 8; tk0 += NB) {
        float pq[NB][3], pkv[NB][2], qr[NB][6], kr[NB][6], vr[NB][4];
#pragma unroll
        for (int i = 0; i < NB; ++i) { const int r = row0 + tk0 + i; const bf16_t* pr = P + (size_t)r * NINP;
#pragma unroll
            for (int j = 0; j < 3; ++j) pq[i][j] = bf2f(pr[OFF_Q + lane + 64 * j]);
#pragma unroll
            for (int j = 0; j < 2; ++j) pkv[i][j] = bf2f(pr[OFF_KV + lane + 64 * j]);
#pragma unroll
            for (int j = 0; j < 6; ++j) qr[i][j] = RAWQ[(size_t)r * 512 + head * 96 + sub + 16 * j];
#pragma unroll
            for (int j = 0; j < 4; ++j) kr[i][j] = RAWKV[(size_t)r * 512 + head * 128 + sub + 16 * j];
#pragma unroll
            for (int j = 4; j < 6; ++j) kr[i][j] = bf2f(pr[OFF_KPE + sub + 16 * (j - 4)]);
#pragma unroll
            for (int j = 0; j < 4; ++j) vr[i][j] = RAWKV[(size_t)r * 512 + head * 128 + 64 + sub + 16 * j]; }
        float red[2 * NB];
#pragma unroll
        for (int i = 0; i < NB; ++i) { red[2 * i] = pq[i][0] * pq[i][0] + pq[i][1] * pq[i][1] + pq[i][2] * pq[i][2]; red[2 * i + 1] = pkv[i][0] * pkv[i][0] + pkv[i][1] * pkv[i][1]; }
        wave_sum_n<2 * NB>(red);
        float ssq[2 * NB];
#pragma unroll
        for (int i = 0; i < NB; ++i) {
            const float rq = rsqrtf(red[2 * i] * (1.f / 192.f) + EPS), rkv = rsqrtf(red[2 * i + 1] * (1.f / 128.f) + EPS);
            float s0 = 0.f, s1 = 0.f;
#pragma unroll
            for (int j = 0; j < 6; ++j) { qr[i][j] *= rq; s0 += qr[i][j] * qr[i][j]; }
#pragma unroll
            for (int j = 0; j < 4; ++j) { kr[i][j] *= rkv; s1 += kr[i][j] * kr[i][j]; }
#pragma unroll
            for (int j = 4; j < 6; ++j) s1 += kr[i][j] * kr[i][j];
#pragma unroll
            for (int j = 0; j < 4; ++j) vr[i][j] *= rkv;
            ssq[2 * i] = s0; ssq[2 * i + 1] = s1;
        }
        { const int l4 = olane();
#pragma unroll
          for (int o = 8; o > 0; o >>= 1) { float t_[2 * NB];
#pragma unroll
              for (int i = 0; i < 2 * NB; ++i) t_[i] = __int_as_float(__builtin_amdgcn_ds_bpermute((l4 ^ o) << 2, __float_as_int(ssq[i])));
#pragma unroll
              for (int i = 0; i < 2 * NB; ++i) ssq[i] += t_[i]; } }
#pragma unroll
        for (int i = 0; i < NB; ++i) {
            const int tk = tk0 + i, r = row0 + tk;
            const float rnq = rsqrtf(ssq[2 * i] * (1.f / 96.f) + EPS), rnk = rsqrtf(ssq[2 * i + 1] * (1.f / 96.f) + EPS);
#pragma unroll
            for (int j = 0; j < 6; ++j) { qr[i][j] *= rnq * qg[j]; kr[i][j] *= rnk * kg[j]; }
            if (lat) {
                const int tseq = r & 2047; const float a0 = (float)(tseq >> 6) * frq, a1 = (float)(tseq & 63) * frq;
                const float cs0 = __cosf(a0), sn0 = __sinf(a0), cs1 = __cosf(a1), sn1 = __sinf(a1);
                const float oq4 = shx(qr[i][4], 8), oq5 = shx(qr[i][5], 8), ok4 = shx(kr[i][4], 8), ok5 = shx(kr[i][5], 8);
                const float sg = (sub < 8) ? -1.f : 1.f;
                qr[i][4] = qr[i][4] * cs0 + sg * oq4 * sn0; qr[i][5] = qr[i][5] * cs1 + sg * oq5 * sn1;
                kr[i][4] = kr[i][4] * cs0 + sg * ok4 * sn0; kr[i][5] = kr[i][5] * cs1 + sg * ok5 * sn1;
            }
            bf16_t* kro = KB + ((size_t)(b * 4 + head) * 2304 + key0 + tk) * 96;
#pragma unroll
            for (int j = 0; j < 6; ++j) { Q[(size_t)r * 384 + head * 96 + sub + 16 * j] = f2bf(qr[i][j]); kro[sub + 16 * j] = f2bf(kr[i][j]); }
#pragma unroll
            for (int j = 0; j < 4; ++j) vt[(head * 64 + sub + 16 * j) * 72 + tk] = f2bf(vr[i][j]);
        }
    }
    __syncthreads();
    { const int hv = tid >> 1, hf = tid & 1;
      bf16_t* dst = VT + ((size_t)(b * 4 + (hv >> 6)) * 64 + (hv & 63)) * 2304 + key0 + hf * 32;
#pragma unroll
      for (int i = 0; i < 4; ++i) *(u32x4*)(dst + i * 8) = *(const LAS u32x4*)(vt + hv * 72 + hf * 32 + i * 8); }
    __syncthreads();
}
DI void s5carry_unit(const Params& p, int l, int unit, const int wv_) {
    const int gid = unit * 512 + otid();
    const int q = gid & 63, dir = (gid >> 6) & 1, g = (gid >> 7) & 15, b = gid >> 11;
    const float* A64 = (const float*)(p.ws + WS_A64) + (size_t)(((l * 2 + dir) * 16 + g) * 64 + q) * 2;
    const float ar = A64[0], ai = A64[1];
    const float* SST = (const float*)(p.ws + WS_SST);
    bf16_t* HIN = (bf16_t*)(p.ws + WS_HIN);
    float sr[NCH], si[NCH];
#pragma unroll
    for (int s = 0; s < NCH; ++s) { const int j = dir == 0 ? s : (s < 4 ? 3 - s : 39 - s);
        const size_t base = ((size_t)(b * NCH + j) * 16 + g) * 256 + dir * 128 + q; sr[s] = SST[base]; si[s] = SST[base + 64]; }
    float hr = 0.f, hi = 0.f;
#pragma unroll
    for (int s = 0; s < NCH; ++s) {
        const int j = dir == 0 ? s : (s < 4 ? 3 - s : 39 - s);
        const size_t base = ((size_t)(b * NCH + j) * 16 + g) * 256 + dir * 128 + q;
        HIN[base] = f2bf(hr); HIN[base + 64] = f2bf(hi);
        const float nr = ar * hr - ai * hi + sr[s], ni = ar * hi + ai * hr + si[s];
        hr = nr; hi = ni;
    }
}
struct PvConvPool {
    const Params& p; int l;
    static constexpr int NT = 4; static constexpr int FP8 = 0; static constexpr bool PARK = false; typedef APlain AS; typedef BSimple BS;
    DI int first() const { return lin_first(0, 576); }
    DI int next(int u) const { return lin_next(u, 576); }
    DI void src(int u, AS& a, BS& b, const int wv_) const {
        const bool isconv = u < 288; const int mt = isconv ? u : u - 288;
        a = make_a_plain((const bf16_t*)(p.ws + (isconv ? WS_ACONV : WS_APOOL)), (size_t)mt * 256, 256, 0);
        const bf16_t* W = (const bf16_t*)(p.ws + (isconv ? WS_WPW : WS_WPOOL)) + (size_t)l * 65536;
        b = make_b(W, W + (size_t)128 * 256, 256);
    }
    DI void epi(f32x4 (&acc)[2][2][4][2], int u, const int wv_) const {
        const bool isconv = u < 288; const int mt = isconv ? u : u - 288;
        bf16_t* CAT = (bf16_t*)(p.ws + WS_CAT);
        if (isconv) { EPI_FOR(acc, { store_bf16x4(CAT + (size_t)(mt * 256 + lr) * 1024 + lc, v[0], v[1], v[2], v[3]); }); }
        else { const int t_ = otid(), c0_ = ((t_ >> 6) & 3) * 32 + ((t_ & 63) >> 4) * 4; f32x4 sc_[2][2];
#pragma unroll
               for (int bj = 0; bj < 2; ++bj)
#pragma unroll
                   for (int n = 0; n < 2; ++n) sc_[bj][n] = *(const f32x4*)(p.pool_scale + l * 256 + bj * 128 + n * 16 + c0_);
               EPI_FOR(acc, { const f32x4 s_ = sc_[bj][n];
                              store_bf16x4(CAT + (size_t)(mt * 256 + lr) * 1024 + 256 + lc, v[0] * s_[0], v[1] * s_[1], v[2] * s_[2], v[3] * s_[3]); }); }
    }
};
DI void phase_B(const Params& p, LAS char* shm, int l, const int wv_) {
    { PvConvPool pv{p, l}; gemm_stream(shm, pv, wv_); }
    const int n_post = TT / 64, n_carry = 128;
    for (int u = first_unit(576); u < n_post + n_carry; u += gridDim.x) {
        if (u < n_post) qkvpost_unit(p, shm, l, u, wv_);
        else s5carry_unit(p, l, u - n_post, wv_);
    }
}

DI void attn_unit(const Params& p, LAS char* shm, int l, int b, int h, int qrow0, int nq, int key_lo, int nkeys, const int wv_) {
    const int tid = otid(), wid = tid >> 6, lane = tid & 63, l31 = lane & 31, hh = lane >> 5;
    const bf16_t* Q = (const bf16_t*)(p.ws + WS_Q);
    const bf16_t* KBp = (const bf16_t*)(p.ws + WS_KB) + (size_t)(b * 4 + h) * 2304 * 96;
    const bf16_t* VTp = (const bf16_t*)(p.ws + WS_VT) + (size_t)(b * 4 + h) * 64 * 2304;
    bf16_t* CAT = (bf16_t*)(p.ws + WS_CAT);
    LAS char* kl = shm;
    LAS char* vl = shm + 13312;
    const bool active = wid * 64 < nq;
    float gq = 0.f, gk = 0.f;
    for (int i = lane; i < 96; i += 64) { gq = fmaxf(gq, fabsf(p.mla_q_g[l * 96 + i])); gk = fmaxf(gk, fabsf(p.mla_k_g[l * 96 + i])); }
    gq = wave_max(gq); gk = wave_max(gk);
    const float LOG2E = 1.4426950408889634f;
    const float c2 = 9.797958971132712f * gq * gk * LOG2E;
    const float sh2 = fmaxf(c2 - 64.f, 0.f);
    bf16x8 qf[2][6];
    if (active) {
#pragma unroll
        for (int qb = 0; qb < 2; ++qb)
#pragma unroll
            for (int ks = 0; ks < 6; ++ks) qf[qb][ks] = *(const bf16x8*)(Q + (size_t)(qrow0 + wid * 64 + qb * 32 + l31) * 384 + h * 96 + ks * 16 + hh * 8);
    }
    f32x16 O[2][2];
#pragma unroll
    for (int a = 0; a < 2; ++a)
#pragma unroll
        for (int c = 0; c < 2; ++c)
#pragma unroll
            for (int i = 0; i < 16; ++i) O[a][c][i] = 0.f;
    float lsum[2] = {0.f, 0.f};
    const int ntile = nkeys / 64;
    u32x4 kreg0, kreg1, vreg;
    auto load_tile = [&](int t) {
        const int key = key_lo + t * 64;
        { const int id = tid, kr = id / 12, part = id % 12; kreg0 = *(const u32x4*)(KBp + (size_t)(key + kr) * 96 + part * 8); }
        if (tid < 256) { const int id = tid + 512, kr = id / 12, part = id % 12; kreg1 = *(const u32x4*)(KBp + (size_t)(key + kr) * 96 + part * 8); }
        { const int vd = tid >> 3, part = tid & 7; vreg = *(const u32x4*)(VTp + (size_t)vd * 2304 + key + part * 8); }
    };
    auto write_tile = [&]() {
        { const int id = tid, kr = id / 12, part = id % 12; *(LAS u32x4*)(kl + kr * 208 + part * 16) = kreg0; }
        if (tid < 256) { const int id = tid + 512, kr = id / 12, part = id % 12; *(LAS u32x4*)(kl + kr * 208 + part * 16) = kreg1; }
        { const int vd = tid >> 3, part = tid & 7; *(LAS u32x4*)(vl + vd * 144 + part * 16) = vreg; }
    };
    load_tile(0);
    for (int t = 0; t < ntile; ++t) {
        __syncthreads();
        write_tile();
        __syncthreads();
        if (t + 1 < ntile) load_tile(t + 1);
        if (active) {
#pragma unroll
            for (int kb = 0; kb < 2; ++kb) {
                f32x16 S[2];
#pragma unroll
                for (int qb = 0; qb < 2; ++qb)
#pragma unroll
                    for (int i = 0; i < 16; ++i) S[qb][i] = 0.f;
#pragma unroll
                for (int ks = 0; ks < 6; ++ks) {
                    const bf16x8 a = *(const LAS bf16x8*)(kl + (kb * 32 + l31) * 208 + ks * 32 + hh * 16);
#pragma unroll
                    for (int qb = 0; qb < 2; ++qb) S[qb] = __builtin_amdgcn_mfma_f32_32x32x16_bf16(a, qf[qb][ks], S[qb], 0, 0, 0);
                }
                bf16x8 pf[2][2];
#pragma unroll
                for (int qb = 0; qb < 2; ++qb) {
                    float e[16];
#pragma unroll
                    for (int i = 0; i < 16; ++i) { e[i] = __builtin_amdgcn_exp2f(S[qb][i] - sh2); lsum[qb] += e[i]; }
#pragma unroll
                    for (int s = 0; s < 2; ++s) { u32x4 w; w.x = pk_bf16(e[8 * s], e[8 * s + 1]); w.y = pk_bf16(e[8 * s + 2], e[8 * s + 3]); w.z = pk_bf16(e[8 * s + 4], e[8 * s + 5]); w.w = pk_bf16(e[8 * s + 6], e[8 * s + 7]);
                        pf[qb][s] = __builtin_bit_cast(bf16x8, w); }
                }
#pragma unroll
                for (int s = 0; s < 2; ++s) {
                    const int kk = kb * 2 + s;
#pragma unroll
                    for (int vb = 0; vb < 2; ++vb) {
                        const s16x4 lo = *(const LAS s16x4*)(vl + (vb * 32 + l31) * 144 + (16 * kk + 4 * hh) * 2);
                        const s16x4 hi = *(const LAS s16x4*)(vl + (vb * 32 + l31) * 144 + (16 * kk + 8 + 4 * hh) * 2);
                        const bf16x8 va = __builtin_shufflevector(lo, hi, 0, 1, 2, 3, 4, 5, 6, 7);
#pragma unroll
                        for (int qb = 0; qb < 2; ++qb) O[vb][qb] = __builtin_amdgcn_mfma_f32_32x32x16_bf16(va, pf[qb][s], O[vb][qb], 0, 0, 0);
                    }
                }
            }
        }
    }
    if (active) {
#pragma unroll
        for (int qb = 0; qb < 2; ++qb) {
            const float tot = lsum[qb] + shx(lsum[qb], 32);
            const float inv = 1.f / tot;
            bf16_t* orow = CAT + (size_t)(qrow0 + wid * 64 + qb * 32 + l31) * 1024 + 768 + h * 64;
#pragma unroll
            for (int vb = 0; vb < 2; ++vb)
#pragma unroll
                for (int i4 = 0; i4 < 4; ++i4)
                    store_bf16x4(orow + vb * 32 + 8 * i4 + 4 * hh, O[vb][qb][4 * i4] * inv, O[vb][qb][4 * i4 + 1] * inv, O[vb][qb][4 * i4 + 2] * inv, O[vb][qb][4 * i4 + 3] * inv);
        }
    }
    __syncthreads();
}
struct PvS5Out {
    const Params& p; int l;
    static constexpr int NT = 20; static constexpr int FP8 = 0; static constexpr bool PARK = false; typedef ASeg2 AS; typedef BSimple BS;
    DI int first() const { return lin_first(512, 320); }
    DI int next(int u) const { return lin_next(u, 320); }
    DI void src(int u, AS& as, BS& bs, const int wv_) const {
        const int ntile = u & 3, mt = (u >> 2) % 5, g = u / 20;
        int R[2], C[2]; stage_coords(R, C, wv_);
        as.base0 = (const char*)(p.ws + WS_P); as.base1 = (const char*)(p.ws + WS_HIN); as.ks0 = 4 * NINP * 2; as.nt0 = 16;
#pragma unroll
        for (int h = 0; h < 2; ++h)
#pragma unroll
            for (int i = 0; i < 2; ++i) { const int cr = min(mt * 256 + h * 128 + R[i], NCROW - 1);
                as.off0[h][i] = (unsigned)(((size_t)(crow_tok(cr) + (C[i] >> 4)) * NINP + OFF_SSM + g * 16 + (C[i] & 15)) * 2);
                as.off1[h][i] = (unsigned)((((size_t)cr * 16 + g) * 256 + C[i]) * 2); }
        const bf16_t* W = (const bf16_t*)(p.ws + WS_TS5) + ((size_t)(l * 16 + g) * 1024 + ntile * 256) * 1280;
        bs = make_b(W, W + (size_t)128 * 1280, 1280);
    }
    DI void epi(f32x4 (&acc)[2][2][4][2], int u, const int wv_) const {
        const int ntile = u & 3, mt = (u >> 2) % 5, g = u / 20;
        bf16_t* Z = (bf16_t*)(p.ws + WS_Z);
        EPI_FOR(acc, { const int cr = mt * 256 + lr; if (cr < NCROW) { const int col = ntile * 256 + lc, t = col >> 4, co = col & 15;
            store_bf16x4(Z + (size_t)(crow_tok(cr) + t) * 256 + g * 16 + co, gelu_tanh(v[0]), gelu_tanh(v[1]), gelu_tanh(v[2]), gelu_tanh(v[3])); } });
    }
};
DI void phase_C(const Params& p, LAS char* shm, int l, const int wv_) {
    for (int u = blockIdx.x; u < 512; u += gridDim.x) { const int qb = u & 3, h = (u >> 2) & 3, b = u >> 4;
        attn_unit(p, shm, l, b, h, b * SEQ + qb * 512, 512, 0, 2304, wv_); }
    { PvS5Out pv{p, l}; gemm_stream(shm, pv, wv_); }
    if (l == 0) for (int u = first_unit(512 + 320); u < 128; u += gridDim.x) { const int h = u & 3, b = u >> 2;
        attn_unit(p, shm, l, b, h, TX + b * CTXL, 256, 2048, 256, wv_); }
}

struct PvGlu {
    const Params& p; int l;
    static constexpr int NT = 4; static constexpr int FP8 = 0; static constexpr bool PARK = false; typedef APlain AS; typedef BSimple BS;
    DI int first() const { return lin_first(0, 288); }
    DI int next(int u) const { return lin_next(u, 288); }
    DI void src(int u, AS& a, BS& b, const int wv_) const {
        a = make_a_plain((const bf16_t*)(p.ws + WS_Z), (size_t)u * 256, 256, 0);
        const bf16_t* W = (const bf16_t*)(p.ws + WS_WGLU) + (size_t)l * 65536;
        b = make_b(W, W + (size_t)128 * 256, 256);
    }
    DI void epi(f32x4 (&acc)[2][2][4][2], int u, const int wv_) const {
        const bf16_t* Z = (const bf16_t*)(p.ws + WS_Z); bf16_t* CAT = (bf16_t*)(p.ws + WS_CAT);
        const int _tz = otid(), _w = _tz >> 6, _l = _tz & 63, _wr = _w >> 2, _wc = _w & 3, _fr = _l & 15, _fq = _l >> 4;
        const int c0 = _wc * 32 + _fq * 4;
        f32x4 bsv[2][2];
#pragma unroll
        for (int bj = 0; bj < 2; ++bj)
#pragma unroll
            for (int n = 0; n < 2; ++n) bsv[bj][n] = *(const f32x4*)(p.ssm_glu_b + l * 256 + bj * 128 + n * 16 + c0);
#pragma unroll
        for (int ai = 0; ai < 2; ++ai) {
            u32x2 zz[4][2][2];
#pragma unroll
            for (int m = 0; m < 4; ++m)
#pragma unroll
                for (int bj = 0; bj < 2; ++bj)
#pragma unroll
                    for (int n = 0; n < 2; ++n) zz[m][bj][n] = *(const u32x2*)(Z + (size_t)(u * 256 + ai * 128 + _wr * 64 + m * 16 + _fr) * 256 + bj * 128 + n * 16 + c0);
#pragma unroll
            for (int m = 0; m < 4; ++m) { const size_t r = (size_t)(u * 256 + ai * 128 + _wr * 64 + m * 16 + _fr);
#pragma unroll
                for (int bj = 0; bj < 2; ++bj)
#pragma unroll
                    for (int n = 0; n < 2; ++n) { const f32x4 v = acc[ai][bj][m][n]; const f32x4 b_ = bsv[bj][n]; const u32x2 z_ = zz[m][bj][n];
                        store_bf16x4(CAT + r * 1024 + 512 + bj * 128 + n * 16 + c0, bflo(z_.x) * sigmoidf_(v[0] + b_[0]), bfhi(z_.x) * sigmoidf_(v[1] + b_[1]), bflo(z_.y) * sigmoidf_(v[2] + b_[2]), bfhi(z_.y) * sigmoidf_(v[3] + b_[3])); } }
        }
    }
};
DI void phase_D(const Params& p, LAS char* shm, int l, const int wv_) {
    PvGlu pv{p, l}; gemm_stream(shm, pv, wv_);
}

struct PvOutproj {
    const Params& p; int l;
    static constexpr int NT = 16; static constexpr int FP8 = 0; static constexpr bool PARK = false; typedef APlain AS; typedef BSimple BS;
    XcdDeal<4, 4> deal;
    DI int first() const { return deal.first(); }
    DI int next(int u) const { return deal.next(u); }
    DI void src(int u, AS& a, BS& b, const int wv_) const {
        int mt, nt; deal.decode(u, mt, nt);
        const bf16_t* W = (const bf16_t*)(p.ws + WS_WMO) + (size_t)l * 1024 * 1024;
        a = make_a_plain((const bf16_t*)(p.ws + WS_CAT), (size_t)mt * 256, 1024, 0);
        b = make_b(W + (size_t)(nt * 256) * 1024, W + (size_t)(nt * 256 + 128) * 1024, 1024);
    }
    DI void epi(f32x4 (&acc)[2][2][4][2], int u, const int wv_) const {
        int mt, nt; deal.decode(u, mt, nt);
        bf16_t* X = (bf16_t*)(p.ws + WS_X);
        const float* MOD = (const float*)(p.ws + WS_MOD) + (size_t)l * 33 * 6144;
        const int _tz = otid(), _w = _tz >> 6, _l = _tz & 63, _wr = _w >> 2, _wc = _w & 3, _fr = _l & 15, _fq = _l >> 4;
        const int c0 = nt * 256 + _wc * 32 + _fq * 4;
        const int row0 = mt * 256;
        const float* g1p = MOD + (size_t)mod_row(row0) * 6144 + 2048 + c0;
        f32x4 g1[2][2];
#pragma unroll
        for (int bj = 0; bj < 2; ++bj)
#pragma unroll
            for (int n = 0; n < 2; ++n) g1[bj][n] = *(const f32x4*)(g1p + bj * 128 + n * 16);
        bf16_t* obase = X + (size_t)row0 * 1024;
        if (l == 0) {
            const float* xbase = row0 < TX ? p.x + (size_t)row0 * 1024 : p.ctx + (size_t)(row0 - TX) * 1024;
#pragma unroll
            for (int ai = 0; ai < 2; ++ai)
#pragma unroll
                for (int mp = 0; mp < 2; ++mp) {
                    f32x4 xv[2][2][2];
#pragma unroll
                    for (int mm = 0; mm < 2; ++mm)
#pragma unroll
                        for (int bj = 0; bj < 2; ++bj)
#pragma unroll
                            for (int n = 0; n < 2; ++n) xv[mm][bj][n] = *(const f32x4*)(xbase + (size_t)(ai * 128 + _wr * 64 + (mp * 2 + mm) * 16 + _fr) * 1024 + c0 + bj * 128 + n * 16);
#pragma unroll
                    for (int mm = 0; mm < 2; ++mm)
#pragma unroll
                        for (int bj = 0; bj < 2; ++bj)
#pragma unroll
                            for (int n = 0; n < 2; ++n) { const f32x4 o = xv[mm][bj][n] + g1[bj][n] * acc[ai][bj][mp * 2 + mm][n];
                                store_bf16x4(obase + (size_t)(ai * 128 + _wr * 64 + (mp * 2 + mm) * 16 + _fr) * 1024 + c0 + bj * 128 + n * 16, o[0], o[1], o[2], o[3]); }
                }
        } else {
#pragma unroll
            for (int ai = 0; ai < 2; ++ai) {
                u32x2 xv[4][2][2];
#pragma unroll
                for (int m = 0; m < 4; ++m)
#pragma unroll
                    for (int bj = 0; bj < 2; ++bj)
#pragma unroll
                        for (int n = 0; n < 2; ++n) xv[m][bj][n] = *(const u32x2*)(obase + (size_t)(ai * 128 + _wr * 64 + m * 16 + _fr) * 1024 + c0 + bj * 128 + n * 16);
#pragma unroll
                for (int m = 0; m < 4; ++m)
#pragma unroll
                    for (int bj = 0; bj < 2; ++bj)
#pragma unroll
                        for (int n = 0; n < 2; ++n) { const u32x2 x_ = xv[m][bj][n]; const f32x4 g_ = g1[bj][n]; const f32x4 a_ = acc[ai][bj][m][n];
                            store_bf16x4(obase + (size_t)(ai * 128 + _wr * 64 + m * 16 + _fr) * 1024 + c0 + bj * 128 + n * 16, bflo(x_.x) + g_[0] * a_[0], bfhi(x_.x) + g_[1] * a_[1], bflo(x_.y) + g_[2] * a_[2], bfhi(x_.y) + g_[3] * a_[3]); }
            }
        }
    }
};
DI void phase_E(const Params& p, LAS char* shm, int l, const int wv_) {
    PvOutproj pv{p, l, {(l == 1 ? TX : TT) / 256}}; gemm_stream(shm, pv, wv_);
}

template <int S> DI float row_rot_f(float v) { return __int_as_float(__builtin_amdgcn_update_dpp(0, __float_as_int(v), 0x120 | S, 0xf, 0xf, false)); }
template <int S> DI int row_rot_i(int v) { return __builtin_amdgcn_update_dpp(0, v, 0x120 | S, 0xf, 0xf, false); }
template <int S> struct RankAcc {
    static DI void run(float o0, float o1, int oe, float v0, float v1, int e0, int& r0, int& r1) {
        const float a0 = S ? row_rot_f<S>(o0) : o0, a1 = S ? row_rot_f<S>(o1) : o1; const int ae = S ? row_rot_i<S>(oe) : oe;
        r0 += (a0 > v0 || (a0 == v0 && ae < e0)) ? 1 : 0;
        r0 += (a1 > v0) ? 1 : 0;
        r1 += (a0 > v1 || a0 == v1) ? 1 : 0;
        r1 += (a1 > v1 || (a1 == v1 && ae < e0)) ? 1 : 0;
        RankAcc<S + 1>::run(o0, o1, oe, v0, v1, e0, r0, r1);
    }
};
template <> struct RankAcc<16> { static DI void run(float, float, int, float, float, int, int&, int&) {} };
DI float row_sum16(float v) { v += row_rot_f<8>(v); v += row_rot_f<4>(v); v += row_rot_f<2>(v); v += row_rot_f<1>(v); return v; }
DI float row_max16(float v) { v = fmaxf(v, row_rot_f<8>(v)); v = fmaxf(v, row_rot_f<4>(v)); v = fmaxf(v, row_rot_f<2>(v)); v = fmaxf(v, row_rot_f<1>(v)); return v; }

DI void phase_router(const Params& p, LAS char* shm, int l, const int wv_) {
    const int tid = otid(), wid = tid >> 6, lane = tid & 63;
    const int Tm = (l == 1) ? TX : TT;
    const bf16_t* X = (const bf16_t*)(p.ws + WS_X);
    const float* MOD = (const float*)(p.ws + WS_MOD) + (size_t)l * 33 * 6144;
    unsigned char* H8 = (unsigned char*)(p.ws + WS_H);
    const bool alt = p.ph_lo != 0;
    int* CNT = (int*)(p.ws + WS_CNT) + l * 32 + (alt ? 64 : 0);
    int* LIST = alt ? (int*)(p.ws + WS_RY) : (int*)(p.ws + WS_LIST);
    LAS char* wfr = shm;
    LAS bf16_t* gml = (LAS bf16_t*)(shm + 131072);
    LAS bf16_t* shl = gml + 1024;
    LAS float* cvec = (LAS float*)(shm + 131072 + 4096);
    LAS int* lcnt = (LAS int*)(cvec + 32);
    LAS int* lbase = lcnt + 32;
    LAS unsigned* lrec = (LAS unsigned*)(lbase + 32);
    LAS float* lwt = (LAS float*)(lrec + 1152);
    const int tpw = (Tm + gridDim.x - 1) / gridDim.x;
    const int tbeg = blockIdx.x * tpw, tend = min(tbeg + tpw, Tm);
    if (tid < 32) lcnt[tid] = 0;
    int seg_beg = tbeg;
    while (seg_beg < tend) {
        const int mrow = mod_row(seg_beg);
        int seg_end = tend;
        if (mrow < 32) seg_end = min(tend, (mrow + 1) * SEQ); else seg_end = tend;
        const float* mr = MOD + (size_t)mrow * 6144;
        __syncthreads();
        for (int k = tid; k < 1024; k += 512) { const float gmv = p.norm2_g[l * 1024 + k] * (1.f + mr[4096 + k]); gml[k] = f2bf(gmv); shl[k] = f2bf(mr[3072 + k]); }
        for (int i = tid; i < 1024 * 8; i += 512) {
            const int k = i >> 3, e4 = (i & 7) * 4;
            const float gmv = p.norm2_g[l * 1024 + k] * (1.f + mr[4096 + k]);
            const f32x4 w = *(const f32x4*)(p.router_w + (size_t)l * 32768 + k * 32 + e4);
            const int ks = k >> 5, kq = (k >> 3) & 3, j = k & 7;
#pragma unroll
            for (int c = 0; c < 4; ++c) { const int e = e4 + c, nb = e >> 4, ei = e & 15; const float wv = w[c] * gmv;
                const bf16_t hi = f2bf(wv); const bf16_t lo = f2bf(wv - bf2f(hi));
                LAS bf16_t* dst = (LAS bf16_t*)(wfr + ((size_t)((ks * 2 + nb) * 2) * 64 + (kq * 16 + ei)) * 16) + j;
                dst[0] = hi; dst[64 * 8] = lo; }
        }
        {
            float s4[4] = {0.f, 0.f, 0.f, 0.f};
            for (int k = lane; k < 1024; k += 64) { const float shv = mr[3072 + k]; const f32x4 w = *(const f32x4*)(p.router_w + (size_t)l * 32768 + k * 32 + wid * 4);
                s4[0] += shv * w[0]; s4[1] += shv * w[1]; s4[2] += shv * w[2]; s4[3] += shv * w[3]; }
#pragma unroll
            for (int c = 0; c < 4; ++c) { const float t_ = wave_sum(s4[c]); if (lane == 0) cvec[wid * 4 + c] = t_ + p.router_b[l * 32 + wid * 4 + c]; }
        }
        __syncthreads();
        const int ngroups = (seg_end - seg_beg) >> 4;
        for (int gi = wid; gi < ngroups; gi += 8) {
            const int t0 = seg_beg + gi * 16;
            const int tok = lane & 15, kq = lane >> 4;
            const bf16_t* xr = X + (size_t)(t0 + tok) * 1024 + kq * 8;
            f32x4 acc0 = {0.f, 0.f, 0.f, 0.f}, acc1 = {0.f, 0.f, 0.f, 0.f};
            float ss = 0.f;
#pragma unroll 8
            for (int ks = 0; ks < 32; ++ks) {
                const u32x4 xh = *(const u32x4*)(xr + ks * 32);
                const float x0 = bflo(xh.x), x1 = bfhi(xh.x), x2 = bflo(xh.y), x3 = bfhi(xh.y), x4 = bflo(xh.z), x5 = bfhi(xh.z), x6 = bflo(xh.w), x7 = bfhi(xh.w);
                ss += x0 * x0 + x1 * x1 + x2 * x2 + x3 * x3 + x4 * x4 + x5 * x5 + x6 * x6 + x7 * x7;
                const bf16x8 ah = __builtin_bit_cast(bf16x8, xh);
                const LAS char* wb = wfr + (size_t)(ks * 4) * 1024 + lane * 16;
                const bf16x8 b0h = *(const LAS bf16x8*)(wb), b0l = *(const LAS bf16x8*)(wb + 1024), b1h = *(const LAS bf16x8*)(wb + 2048), b1l = *(const LAS bf16x8*)(wb + 3072);
                acc0 = __builtin_amdgcn_mfma_f32_16x16x32_bf16(ah, b0h, acc0, 0, 0, 0); acc0 = __builtin_amdgcn_mfma_f32_16x16x32_bf16(ah, b0l, acc0, 0, 0, 0);
                acc1 = __builtin_amdgcn_mfma_f32_16x16x32_bf16(ah, b1h, acc1, 0, 0, 0); acc1 = __builtin_amdgcn_mfma_f32_16x16x32_bf16(ah, b1l, acc1, 0, 0, 0);
            }
            ss += shx(ss, 16); ss += shx(ss, 32);
            const float rn = rsqrtf(ss * (1.f / 1024.f) + EPS);
            const int ei = lane & 15;
            const float c0v = cvec[ei], c1v = cvec[16 + ei];
#pragma unroll
            for (int r = 0; r < 4; ++r) {
                const int tl = (lane >> 4) * 4 + r;
                const float rnt = shi(rn, tl);
                float v0 = fminf(fmaxf(acc0[r] * rnt + c0v, -1e30f), 1e30f), v1 = fminf(fmaxf(acc1[r] * rnt + c1v, -1e30f), 1e30f);
                int r0 = 0, r1 = 0;
                RankAcc<0>::run(v0, v1, ei, v0, v1, ei, r0, r1);
                const float mx = row_max16(fmaxf(v0, v1));
                const bool s0 = r0 < 4, s1 = r1 < 4;
                const float e0 = s0 ? __expf(v0 - mx) : 0.f, e1 = s1 ? __expf(v1 - mx) : 0.f;
                const float inv = 1.f / row_sum16(e0 + e1);
                const int t = t0 + tl;
                if (s0) { const int pos = atomicAdd((int*)&lcnt[ei], 1); lrec[(t - tbeg) * 4 + r0] = (unsigned)ei | ((unsigned)pos << 8); lwt[(t - tbeg) * 4 + r0] = e0 * inv; }
                if (s1) { const int pos = atomicAdd((int*)&lcnt[16 + ei], 1); lrec[(t - tbeg) * 4 + r1] = (unsigned)(16 + ei) | ((unsigned)pos << 8); lwt[(t - tbeg) * 4 + r1] = e1 * inv; }
            }
            unsigned char* hr = H8 + (size_t)(t0 + tok) * 1024 + kq * 8;
#pragma unroll 8
            for (int ks = 0; ks < 32; ++ks) {
                const u32x4 xh = *(const u32x4*)(xr + ks * 32);
                const u32x4 gq = *(const LAS u32x4*)(gml + ks * 32 + kq * 8), sq = *(const LAS u32x4*)(shl + ks * 32 + kq * 8);
                float h[8];
                h[0] = bflo(xh.x) * rn * bflo(gq.x) + bflo(sq.x); h[1] = bfhi(xh.x) * rn * bfhi(gq.x) + bfhi(sq.x); h[2] = bflo(xh.y) * rn * bflo(gq.y) + bflo(sq.y); h[3] = bfhi(xh.y) * rn * bfhi(gq.y) + bfhi(sq.y);
                h[4] = bflo(xh.z) * rn * bflo(gq.z) + bflo(sq.z); h[5] = bfhi(xh.z) * rn * bfhi(gq.z) + bfhi(sq.z); h[6] = bflo(xh.w) * rn * bflo(gq.w) + bflo(sq.w); h[7] = bfhi(xh.w) * rn * bfhi(gq.w) + bfhi(sq.w);
#pragma unroll
                for (int i = 0; i < 8; ++i) h[i] = __builtin_amdgcn_fmed3f(h[i], -448.f, 448.f);
                u32x2 o; o.x = pk_fp8x4(h[0], h[1], h[2], h[3]); o.y = pk_fp8x4(h[4], h[5], h[6], h[7]);
                *(u32x2*)(hr + ks * 32) = o;
            }
        }
        seg_beg = seg_end;
    }
    __syncthreads();
    if (tid < 32) lbase[tid] = atomicAdd(&CNT[tid], lcnt[tid]);
    __syncthreads();
    for (int i = tid; i < (tend - tbeg) * 4; i += 512) { const unsigned rec = lrec[i]; const int e = rec & 255, pos = rec >> 8;
        u32x2 ent; ent.x = (unsigned)(tbeg * 4 + i); ent.y = __float_as_uint(lwt[i]);
        *(u32x2*)(LIST + ((size_t)e * TT + lbase[e] + pos) * 2) = ent; }
    __syncthreads();
}

DI void moe_tiles(const Params& p, LAS int* tstart, int l, const int wv_) {
    const int* CNT = (const int*)(p.ws + WS_CNT) + l * 32;
    if (otid() == 0) { int s = 0; for (int e = 0; e < 32; ++e) { tstart[e] = s; s += (CNT[e] + 255) >> 8; } tstart[32] = s; }
    __syncthreads();
}
DI int moe_find(const LAS int* tstart, int mt) { int e = 0;
#pragma unroll
    for (int i = 1; i < 32; ++i) e += (mt >= tstart[i]) ? 1 : 0;
    return e; }
struct PvMoe1 {
    const Params& p; int l; const LAS int* tstart;
    static constexpr int NT = 8; static constexpr int FP8 = 2; static constexpr bool PARK = false; typedef ASimple AS; typedef BSimple BS;
    XcdDeal<4, 8> deal;
    DI int first() const { return deal.first(); }
    DI int next(int u) const { return deal.next(u); }
    DI void src(int u, AS& as, BS& bs, const int wv_) const {
        int mt, n8; deal.decode(u, mt, n8);
        const int e = moe_find(tstart, mt);
        const int r0 = (mt - tstart[e]) * 256, cnt = ((const int*)(p.ws + WS_CNT))[l * 32 + e];
        const int* lst = (const int*)(p.ws + WS_LIST) + (size_t)e * TT * 2;
        int R[2], C[2]; stage_coords(R, C, wv_);
        as.base = (const char*)(p.ws + WS_H); as.kstride = 128;
#pragma unroll
        for (int h = 0; h < 2; ++h)
#pragma unroll
            for (int i = 0; i < 2; ++i) { const int slot = lst[2 * min(r0 + h * 128 + R[i], cnt - 1)]; as.off[h][i] = (unsigned)((size_t)(slot >> 2) * 1024 + C[i] * 2); }
        const char* W = (const char*)(p.ws + WS_W1) + (size_t)(l * NE + e) * 2048 * 1024;
        bs.base[0] = W + (size_t)(n8 * 128) * 1024; bs.base[1] = W + (size_t)(1024 + n8 * 128) * 1024; bs.ldb2 = 1024;
    }
    DI void epi(f32x4 (&acc)[2][2][4][2], int u, const int wv_) const {
        int mt, n8; deal.decode(u, mt, n8);
        const int e = moe_find(tstart, mt);
        unsigned char* ACT = (unsigned char*)(p.ws + WS_RA);
        const int _tz = otid(), _w = _tz >> 6, _l = _tz & 63, _wr = _w >> 2, _wc = _w & 3, _fr = _l & 15, _fq = _l >> 4;
        const float* bin = p.exp_b_in + (size_t)(l * NE + e) * 2048 + n8 * 128 + _wc * 32 + _fq * 4;
        f32x4 bg[2], bu[2];
#pragma unroll
        for (int n = 0; n < 2; ++n) { bg[n] = *(const f32x4*)(bin + n * 16); bu[n] = *(const f32x4*)(bin + 1024 + n * 16); }
#pragma unroll
        for (int ai = 0; ai < 2; ++ai)
#pragma unroll
            for (int m = 0; m < 4; ++m) { const int lr = ai * 128 + _wr * 64 + m * 16 + _fr;
                unsigned char* orow = ACT + ((size_t)mt * 256 + lr) * 1024 + n8 * 128 + _wc * 32 + _fq * 4;
#pragma unroll
                for (int n = 0; n < 2; ++n) {
                    float o[4];
#pragma unroll
                    for (int r = 0; r < 4; ++r) { const float gate = fminf(__builtin_fmaf(acc[ai][0][m][n][r], 1.f / 256.f, bg[n][r]), 7.f); const float up = __builtin_amdgcn_fmed3f(__builtin_fmaf(acc[ai][1][m][n][r], 1.f / 256.f, bu[n][r]), -7.f, 7.f);
                        o[r] = (up + 1.f) * gate * __builtin_amdgcn_rcpf(1.f + __builtin_amdgcn_exp2f(-2.4554669595930156f * gate)); }
                    *(unsigned*)(orow + n * 16) = pk_fp8x4(o[0], o[1], o[2], o[3]); } }
    }
};
DI void phase_moe1(const Params& p, LAS char* shm, int l, const int wv_) {
    LAS int* tstart = (LAS int*)(shm + LDS_MISC + 64);
    moe_tiles(p, tstart, l, wv_);
    PvMoe1 pv{p, l, tstart, {tstart[32]}}; gemm_stream(shm, pv, wv_);
}
struct PvMoe2 {
    const Params& p; int l; const LAS int* tstart;
    static constexpr int NT = 8; static constexpr int FP8 = 2; static constexpr bool PARK = false; typedef APlain AS; typedef BSimple BS;
    XcdDeal<4, 4> deal;
    DI int first() const { return deal.first(); }
    DI int next(int u) const { return deal.next(u); }
    DI void src(int u, AS& as, BS& bs, const int wv_) const {
        int mt, n4; deal.decode(u, mt, n4);
        const int e = moe_find(tstart, mt);
        as.base = (const char*)(p.ws + WS_RA) + (size_t)mt * 256 * 1024; as.lda2 = 1024;
        const char* W = (const char*)(p.ws + WS_W2) + (size_t)(l * NE + e) * 1024 * 1024;
        bs.base[0] = W + (size_t)(n4 * 256) * 1024; bs.base[1] = W + (size_t)(n4 * 256 + 128) * 1024; bs.ldb2 = 1024;
    }
    DI void epi(f32x4 (&acc)[2][2][4][2], int u, const int wv_) const {
        int mt, n4; deal.decode(u, mt, n4);
        const int e = moe_find(tstart, mt);
        const int r0 = (mt - tstart[e]) * 256, cnt = ((const int*)(p.ws + WS_CNT))[l * 32 + e];
        const int* lst = (const int*)(p.ws + WS_LIST) + (size_t)e * TT * 2;
        bf16_t* Y = (bf16_t*)(p.ws + WS_RY);
        const int _tz = otid(), _w = _tz >> 6, _l = _tz & 63, _wr = _w >> 2, _wc = _w & 3, _fr = _l & 15, _fq = _l >> 4;
        const float* bo = p.exp_b_out + (size_t)(l * NE + e) * 1024 + n4 * 256 + _wc * 32 + _fq * 4;
        u32x2 ent[2][4]; f32x4 bv[2][2];
#pragma unroll
        for (int ai = 0; ai < 2; ++ai)
#pragma unroll
            for (int m = 0; m < 4; ++m) ent[ai][m] = *(const u32x2*)(lst + 2 * min(r0 + ai * 128 + _wr * 64 + m * 16 + _fr, cnt - 1));
#pragma unroll
        for (int bj = 0; bj < 2; ++bj)
#pragma unroll
            for (int n = 0; n < 2; ++n) bv[bj][n] = *(const f32x4*)(bo + bj * 128 + n * 16);
#pragma unroll
        for (int ai = 0; ai < 2; ++ai)
#pragma unroll
            for (int m = 0; m < 4; ++m) { const int lr = r0 + ai * 128 + _wr * 64 + m * 16 + _fr;
                if (lr < cnt) { const float w = __uint_as_float(ent[ai][m].y); bf16_t* orow = Y + (size_t)ent[ai][m].x * 1024 + n4 * 256 + _wc * 32 + _fq * 4;
#pragma unroll
                    for (int bj = 0; bj < 2; ++bj)
#pragma unroll
                        for (int n = 0; n < 2; ++n) { const f32x4 v = acc[ai][bj][m][n]; const f32x4 b_ = bv[bj][n];
                            const float sc_ = 1.f / 256.f; store_bf16x4(orow + bj * 128 + n * 16, (v[0] * sc_ + b_[0]) * w, (v[1] * sc_ + b_[1]) * w, (v[2] * sc_ + b_[2]) * w, (v[3] * sc_ + b_[3]) * w); } } }
    }
};
DI void phase_moe2(const Params& p, LAS char* shm, int l, const int wv_) {
    LAS int* tstart = (LAS int*)(shm + LDS_MISC + 64);
    moe_tiles(p, tstart, l, wv_);
    PvMoe2 pv{p, l, tstart, {tstart[32]}}; gemm_stream(shm, pv, wv_);
}

DI void phase_combine(const Params& p, LAS char* shm, int l, const int wv_) {
    const int tid = otid(), wid = tid >> 6, lane = tid & 63;
    const bool alt = p.ph_lo != 0;
    const bf16_t* X = (const bf16_t*)(p.ws + WS_X);
    bf16_t* XO = alt ? (bf16_t*)(p.ws + WS_RA) : (bf16_t*)(p.ws + WS_X);
    float* OUT = alt ? (float*)(p.ws + WS_RA) : p.out;
    const bf16_t* Y = (const bf16_t*)(p.ws + WS_RY);
    const float* MOD = (const float*)(p.ws + WS_MOD);
    bf16_t* H = alt ? (bf16_t*)(p.ws + WS_RA + (size_t)TT * 1024 * 4) : (bf16_t*)(p.ws + WS_H);
    const int Tm = (l == 1) ? TX : TT;
    for (int r = blockIdx.x * 8 + wid; r < Tm; r += gridDim.x * 8) {
        const float* g2 = MOD + (size_t)(l * 33 + mod_row(r)) * 6144 + 5120;
        float v[16];
#pragma unroll
        for (int j = 0; j < 4; ++j) {
            const int col = j * 256 + lane * 4;
            f32x4 s = (f32x4){0.f, 0.f, 0.f, 0.f};
#pragma unroll
            for (int k = 0; k < 4; ++k) { const u32x2 yy = *(const u32x2*)(Y + ((size_t)r * 4 + k) * 1024 + col); s[0] += bflo(yy.x); s[1] += bfhi(yy.x); s[2] += bflo(yy.y); s[3] += bfhi(yy.y); }
            const u32x2 xb_ = *(const u32x2*)(X + (size_t)r * 1024 + col); const f32x4 gg = *(const f32x4*)(g2 + col);
            const f32x4 xv = (f32x4){bflo(xb_.x), bfhi(xb_.x), bflo(xb_.y), bfhi(xb_.y)};
            const f32x4 o = xv + gg * s;
            if (l == 1) *(f32x4*)(OUT + (size_t)r * 1024 + col) = o; else store_bf16x4(XO + (size_t)r * 1024 + col, o[0], o[1], o[2], o[3]);
            v[j * 4] = o[0]; v[j * 4 + 1] = o[1]; v[j * 4 + 2] = o[2]; v[j * 4 + 3] = o[3];
        }
        if (l == 0) norm_mod_store(v, p.norm1_g + 1024, MOD + (size_t)(1 * 33 + mod_row(r)) * 6144, H + (size_t)r * 1024, wv_);
    }
}

constexpr int NPH_LAYER = 10;
constexpr int NPH = 2 + 2 * NPH_LAYER;

__global__ void __launch_bounds__(512, 2) mk_forward(Params p_unused) {
    extern __shared__ __attribute__((aligned(16))) char smem_raw[];
    LAS char* shm = (LAS char*)smem_raw;
    volatile LAS unsigned* xb_words = (volatile LAS unsigned*)(shm + LDS_MISC);
    const int wv_ = __builtin_amdgcn_readfirstlane((int)(threadIdx.x >> 6));
    if (wv_ == 0 && olane() < 4) xb_words[olane()] = 0u;
    __syncthreads();
    kaptr_t ka = (kaptr_t)__builtin_amdgcn_kernarg_segment_ptr();
    const int tok0 = ptoken();
    const int lo = (int)kld64<__builtin_offsetof(Params, ph_lo)>(ka, tok0), hi = (int)kld64<__builtin_offsetof(Params, ph_hi)>(ka, tok0);
    const bool multi = (hi - lo) > 1;
    unsigned* barw = (unsigned*)((__attribute__((address_space(1))) char*)kld64<__builtin_offsetof(Params, ws)>(ka, tok0) + WS_BAR);
    XcdBarrier bar; bar.bar = barw; bar.x = 0; bar.st = xb_words;
    if (multi) bar = xcd_barrier_post(barw, xb_words, wv_);
#ifndef ONLY_KIND
#define ONLY_KIND (-1)
#endif
#define PHASE(idx, kind, FN, ...) do { if ((ONLY_KIND < 0 || ONLY_KIND == (kind)) && (idx) >= lo && (idx) < hi) { const Params p = kparams(ka, ptoken()); int nrep_ = 1 + ((MK_REPEAT_MASK >> (kind)) & 1); asm volatile("" : "+s"(nrep_)); for (int rep_ = 0; rep_ < nrep_; ++rep_) { Params p2 = p; p2.ph_lo = rep_; FN(p2, ##__VA_ARGS__, wv_); } if ((idx) + 1 < hi) xcd_barrier(bar, wv_); } } while (0)
    PHASE(0, 0, phase_prologue, shm);
    PHASE(1, 1, phase_norm1_l0);
    for (int l = 0; l < 2; ++l) {
        const int b0 = 2 + l * NPH_LAYER;
        PHASE(b0 + 0, 2, phase_inproj, shm, l);
        PHASE(b0 + 1, 3, phase_A, shm, l);
        PHASE(b0 + 2, 4, phase_B, shm, l);
        PHASE(b0 + 3, 5, phase_C, shm, l);
        PHASE(b0 + 4, 6, phase_D, shm, l);
        PHASE(b0 + 5, 7, phase_E, shm, l);
        PHASE(b0 + 6, 8, phase_router, shm, l);
        PHASE(b0 + 7, 9, phase_moe1, shm, l);
        PHASE(b0 + 8, 10, phase_moe2, shm, l);
        PHASE(b0 + 9, 11, phase_combine, shm, l);
    }
#undef PHASE
}


extern "C" void kernel_launch(void* const* d_in, const int* in_sizes, int n_in, void* d_out, int out_size, void* d_ws, size_t ws_size, hipStream_t stream) {
    static int grid = 0;
    if (grid == 0) {
        if (n_in != 39 || ws_size < WS_END) { fprintf(stderr, "kernel_launch: unexpected n_in %d or ws_size %zu (< %zu)\n", n_in, ws_size, (size_t)WS_END); grid = -1; return; }
        int dev = 0, cus = 0;
        if (hipGetDevice(&dev) != hipSuccess || hipDeviceGetAttribute(&cus, hipDeviceAttributeMultiprocessorCount, dev) != hipSuccess) { grid = -1; return; }
        if (hipFuncSetAttribute((const void*)mk_forward, hipFuncAttributeMaxDynamicSharedMemorySize, LDS_BYTES) != hipSuccess) { fprintf(stderr, "kernel_launch: hipFuncSetAttribute failed\n"); grid = -1; return; }
        int per_cu = 0;
        if (hipOccupancyMaxActiveBlocksPerMultiprocessor(&per_cu, (const void*)mk_forward, 512, LDS_BYTES) != hipSuccess || per_cu < 1) fprintf(stderr, "kernel_launch: occupancy query says %d\n", per_cu);
        (void)hipGetLastError();
        grid = cus;
    }
    if (grid < 0) return;
    (void)hipMemsetAsync((char*)d_ws + WS_BAR, 0, 16384 + 1024, stream);
    Params p{};
    const float** pf = (const float**)&p;
    for (int i = 0; i < 39; ++i) pf[i] = (const float*)d_in[i];
    p.out = (float*)d_out; p.ws = (char*)d_ws;
#if MK_ONE_LAUNCH
    p.ph_lo = 0; p.ph_hi = NPH;
    hipLaunchKernelGGL(mk_forward, dim3(grid), dim3(512), LDS_BYTES, stream, p);
#else
#ifndef MK_LAST_PHASE
#define MK_LAST_PHASE NPH
#endif
    for (int ph = 0; ph < MK_LAST_PHASE; ++ph) { p.ph_lo = ph; p.ph_hi = ph + 1; hipLaunchKernelGGL(mk_forward, dim3(grid), dim3(512), LDS_BYTES, stream, p); }
#endif
}
```

```cpp
#include <hip/hip_runtime.h>
#include <stdint.h>
#include <stdio.h>

#ifndef MK_REPEAT_MASK
#define MK_REPEAT_MASK 0x0
#endif
#ifndef MK_ONE_LAUNCH
#define MK_ONE_LAUNCH 1
#endif

#define DI __device__ __forceinline__
#define LAS __attribute__((address_space(3)))
typedef unsigned short bf16_t;
typedef short bf16x8 __attribute__((ext_vector_type(8)));
typedef short s16x4 __attribute__((ext_vector_type(4)));
typedef float f32x4 __attribute__((ext_vector_type(4)));
typedef float f32x16 __attribute__((ext_vector_type(16)));
typedef unsigned u32x2 __attribute__((ext_vector_type(2)));
typedef unsigned u32x4 __attribute__((ext_vector_type(4)));
typedef int i32x4 __attribute__((ext_vector_type(4)));
typedef int i32x8 __attribute__((ext_vector_type(8)));

constexpr int D = 1024, NB = 32, SEQ = 2048, CTXL = 256;
constexpr int TX = NB * SEQ, TC = NB * CTXL, TT = TX + TC;
constexpr int NINP = 1536;
constexpr int OFF_POOL = 512, OFF_Q = 768, OFF_SSM = 960, OFF_KV = 1216, OFF_KPE = 1344, N_IN = 1376;
constexpr int NE = 32;
constexpr int NCH = 36;
constexpr int NCROW = NB * NCH;
constexpr float EPS = 1e-6f;

constexpr size_t WS_BAR = 0;
constexpr size_t WS_CNT = 16384;
constexpr size_t WS_MOD = WS_CNT + 1024;
constexpr size_t WS_A64 = WS_MOD + (size_t)2 * 33 * 6144 * 4;
constexpr size_t WS_WMI = WS_A64 + (size_t)2 * 2 * 16 * 64 * 2 * 4;
constexpr size_t WS_WMO = WS_WMI + (size_t)2 * 1536 * 1024 * 2;
constexpr size_t WS_WPW = WS_WMO + (size_t)2 * 1024 * 1024 * 2;
constexpr size_t WS_WGLU = WS_WPW + (size_t)2 * 256 * 256 * 2;
constexpr size_t WS_WPOOL = WS_WGLU + (size_t)2 * 256 * 256 * 2;
constexpr size_t WS_WQ = WS_WPOOL + (size_t)2 * 256 * 256 * 2;
constexpr size_t WS_WKV = WS_WQ + (size_t)2 * 512 * 256 * 2;
constexpr size_t WS_TS5 = WS_WKV + (size_t)2 * 512 * 256 * 2;
constexpr size_t WS_WS5 = WS_TS5 + (size_t)2 * 16 * 1024 * 1280 * 2;
constexpr size_t WS_W1 = WS_WS5 + (size_t)2 * 16 * 256 * 1024 * 2;
constexpr size_t WS_W2 = WS_W1 + (size_t)32 * 2048 * 1024 * 2;
constexpr size_t WS_X = WS_W2 + (size_t)32 * 1024 * 1024 * 2;
constexpr size_t WS_H = WS_X + (size_t)TT * 1024 * 4;
constexpr size_t WS_LIST = WS_H + (size_t)TT * 1024 * 2;
constexpr size_t WS_TOPW = WS_LIST + (size_t)32 * TT * 8;
constexpr size_t WS_RA = WS_TOPW + (size_t)TT * 4 * 4;
constexpr size_t WS_RY = WS_RA + (size_t)TT * 4 * 1024 * 2;
constexpr size_t WS_END = WS_RY + (size_t)TT * 4 * 1024 * 2;
constexpr size_t WS_P = WS_RA;
constexpr size_t WS_ACONV = WS_P + (size_t)TT * NINP * 2;
constexpr size_t WS_APOOL = WS_ACONV + (size_t)TT * 256 * 2;
constexpr size_t WS_RAWQ = WS_APOOL + (size_t)TT * 256 * 2;
constexpr size_t WS_RAWKV = WS_RAWQ + (size_t)TT * 512 * 4;
constexpr size_t WS_Q = WS_RAWKV + (size_t)TT * 512 * 4;
constexpr size_t WS_KB = WS_Q + (size_t)TT * 384 * 2;
constexpr size_t WS_VT = WS_KB + (size_t)128 * 2304 * 96 * 2;
constexpr size_t WS_SST = WS_VT + (size_t)128 * 64 * 2304 * 2;
constexpr size_t WS_HIN = WS_SST + (size_t)NCROW * 16 * 256 * 4;
constexpr size_t WS_Z = WS_HIN + (size_t)NCROW * 16 * 256 * 2;
constexpr size_t WS_CAT = WS_Z + (size_t)TT * 256 * 2;
constexpr size_t WS_MIX_END = WS_CAT + (size_t)TT * 1024 * 2;
static_assert(WS_MIX_END <= WS_END, "mixer buffers must fit in the ACT/Y regions");
static_assert(WS_END <= (size_t)2147483648ull, "workspace budget");

constexpr int LDS_BYTES = 147456;
constexpr int LDS_MISC = 146432;

struct Params {
    const float *x, *c, *ctx, *c_ctx, *ada_w, *ada_b, *norm1_g, *norm2_g, *w_mix_in, *w_mix_out,
        *conv_dw, *conv_dw_b, *conv_ln_g, *conv_ln_b, *conv_pw, *pool_w, *pool_scale,
        *ssm_a_re, *ssm_a_im, *ssm_log_dt, *ssm_b_re, *ssm_b_im, *ssm_c_re, *ssm_c_im, *ssm_d, *ssm_glu_w, *ssm_glu_b,
        *mla_q_a_g, *mla_wq_b, *mla_kv_a_g, *mla_wkv_b, *mla_q_g, *mla_k_g,
        *router_w, *router_b, *exp_w_in, *exp_b_in, *exp_w_out, *exp_b_out;
    float* out;
    char* ws;
    long long ph_lo, ph_hi;
};

typedef const __attribute__((address_space(4))) char* kaptr_t;
template <int OFF> DI unsigned long long kld64(kaptr_t ka, int tok) {
    unsigned long long v;
    asm("s_load_dwordx2 %0, %1, %3\n\ts_waitcnt lgkmcnt(0)" : "=&s"(v) : "s"(ka), "s"(tok), "n"(OFF));
    return v;
}
DI int ptoken() { int t; asm volatile("s_mov_b32 %0, 0" : "=s"(t)); return t; }
DI Params kparams(kaptr_t ka, int tok) {
    Params p;
#define KL_(f) p.f = (decltype(p.f))((__attribute__((address_space(1))) char*)kld64<__builtin_offsetof(Params, f)>(ka, tok))
    KL_(x); KL_(c); KL_(ctx); KL_(c_ctx); KL_(ada_w); KL_(ada_b); KL_(norm1_g); KL_(norm2_g); KL_(w_mix_in); KL_(w_mix_out); KL_(conv_dw); KL_(conv_dw_b); KL_(conv_ln_g); KL_(conv_ln_b); KL_(conv_pw); KL_(pool_w); KL_(pool_scale); KL_(ssm_a_re); KL_(ssm_a_im); KL_(ssm_log_dt); KL_(ssm_b_re); KL_(ssm_b_im); KL_(ssm_c_re); KL_(ssm_c_im); KL_(ssm_d); KL_(ssm_glu_w); KL_(ssm_glu_b); KL_(mla_q_a_g); KL_(mla_wq_b); KL_(mla_kv_a_g); KL_(mla_wkv_b); KL_(mla_q_g); KL_(mla_k_g); KL_(router_w); KL_(router_b); KL_(exp_w_in); KL_(exp_b_in); KL_(exp_w_out); KL_(exp_b_out); KL_(out); KL_(ws);
#undef KL_
    p.ph_lo = 0; p.ph_hi = 0;
    return p;
}

typedef __bf16 bf16v2_t __attribute__((ext_vector_type(2)));
typedef float f32v2_t __attribute__((ext_vector_type(2)));
DI unsigned pk_bf16(float lo, float hi) { const f32v2_t f = {lo, hi}; const bf16v2_t b = __builtin_convertvector(f, bf16v2_t); return __builtin_bit_cast(unsigned, b); }
DI bf16_t f2bf(float x) { return (bf16_t)(pk_bf16(x, 0.f) & 0xffffu); }
DI float bf2f(bf16_t v) { return __uint_as_float(((unsigned)v) << 16); }
DI unsigned f2fp8(float x) { x = fminf(fmaxf(x, -448.f), 448.f); return (unsigned)__builtin_amdgcn_cvt_pk_fp8_f32(x, x, 0, false) & 0xffu; }
DI unsigned pk_fp8x4(float a, float b, float c, float d) { int v = __builtin_amdgcn_cvt_pk_fp8_f32(a, b, 0, false); v = __builtin_amdgcn_cvt_pk_fp8_f32(c, d, v, true); return (unsigned)v; }
DI float bflo(unsigned u) { return __uint_as_float(u << 16); }
DI float bfhi(unsigned u) { return __uint_as_float(u & 0xffff0000u); }
DI int olane() { int l = (int)__builtin_amdgcn_mbcnt_hi(~0u, __builtin_amdgcn_mbcnt_lo(~0u, 0u)); asm volatile("" : "+v"(l)); return l; }
DI float shx(float v, int o) { const int l = olane(); return __int_as_float(__builtin_amdgcn_ds_bpermute((l ^ o) << 2, __float_as_int(v))); }
DI float shi(float v, int src) { return __int_as_float(__builtin_amdgcn_ds_bpermute(src << 2, __float_as_int(v))); }
#define otid() otid_(wv_)
DI int otid_(int wv) { int t = (wv << 6) | olane(); asm volatile("" : "+v"(t)); return t; }
DI float wave_sum(float v) {
#pragma unroll
    for (int o = 32; o > 0; o >>= 1) v += shx(v, o);
    return v;
}
DI float wave_max(float v) {
#pragma unroll
    for (int o = 32; o > 0; o >>= 1) v = fmaxf(v, shx(v, o));
    return v;
}
DI float sigmoidf_(float x) { return __builtin_amdgcn_rcpf(1.f + __builtin_amdgcn_exp2f(-1.4426950408889634f * x)); }
DI float siluf_(float x) { return x * sigmoidf_(x); }
DI float gelu_tanh(float x) {
    const float u = 0.7978845608028654f * (x + 0.044715f * x * x * x);
    return x * __builtin_amdgcn_rcpf(1.f + __builtin_amdgcn_exp2f(-2.8853900817779268f * u));
}
DI void glds16(const void* src, LAS char* dst) {
    __builtin_amdgcn_global_load_lds((const __attribute__((address_space(1))) void*)src, (LAS void*)dst, 16, 0, 0);
}

#define XB_TMO      128
#define XB_XCNT(j)  (256  + 64 * (j))
#define XB_XSUB(j)  (1280 + 64 * (j))
#define XB_XGEN(j)  (2304 + 64 * (j))
#define XB_TOP      3328
#define XB_TOPGEN   3392
#define XCD_BAR_WORDS 3456
#define XB_SPIN_CAP (1u << 18)
__device__ __forceinline__ unsigned xb_ld(unsigned* p)              { return __hip_atomic_load(p, __ATOMIC_RELAXED, __HIP_MEMORY_SCOPE_AGENT); }
__device__ __forceinline__ unsigned xb_add(unsigned* p, unsigned v) { return __hip_atomic_fetch_add(p, v, __ATOMIC_RELAXED, __HIP_MEMORY_SCOPE_AGENT); }
__device__ __forceinline__ unsigned xb_xcc_id() { return (unsigned)__builtin_amdgcn_s_getreg((3 << 11) | 20) & 0xFu; }
#define XB_SPIN(cond, bar) do { unsigned _sp = 0; while (cond) { __builtin_amdgcn_s_sleep(1); \
    if ((++_sp & 255u) == 0u) { if (xb_ld(&(bar)[XB_TMO])) break; if (_sp > XB_SPIN_CAP) { atomicAdd(&(bar)[XB_TMO], 1u); break; } } } } while (0)
struct XcdBarrier { unsigned* bar; unsigned x; volatile LAS unsigned* st; };
__device__ __forceinline__ XcdBarrier xcd_barrier_post(unsigned* bar, volatile LAS unsigned* st, const int wv_) {
    XcdBarrier b; b.bar = bar; b.x = xb_xcc_id(); b.st = st;
    if (otid() == 0) (void)xb_add(&bar[XB_XCNT(b.x)], 1u);
    return b;
}
__device__ __forceinline__ void xcd_barrier_complete(unsigned* bar, unsigned x, unsigned& nloc, unsigned& nx) {
    const unsigned G = gridDim.x * gridDim.y * gridDim.z;
    unsigned sum, cnt, mine, sp = 0u;
    for (;;) {
        sum = 0u; cnt = 0u; mine = 0u;
#pragma unroll
        for (unsigned j = 0; j < 16; ++j) { const unsigned c = xb_ld(&bar[XB_XCNT(j)]); sum += c; cnt += (c > 0u) ? 1u : 0u; mine = (j == x) ? c : mine; }
        if (sum == G) break;
        __builtin_amdgcn_s_sleep(1);
        if ((++sp & 255u) == 0u) { if (xb_ld(&bar[XB_TMO])) break; if (sp > XB_SPIN_CAP) { atomicAdd(&bar[XB_TMO], 1u); break; } }
    }
    nloc = mine > 0u ? mine : 1u; nx = cnt > 0u ? cnt : 1u;
}
__device__ __forceinline__ void xcd_barrier(const XcdBarrier& b, const int wv_) {
    asm volatile("s_waitcnt vmcnt(0)" ::: "memory");
    __syncthreads();
    if (otid() == 0) {
        unsigned* bar = b.bar;
        __builtin_amdgcn_s_waitcnt(0);
        unsigned nloc = b.st[0], nx = b.st[1];
        if (nloc == 0u) { xcd_barrier_complete(bar, b.x, nloc, nx); b.st[0] = nloc; b.st[1] = nx; }
        const unsigned old = xb_add(&bar[XB_XSUB(b.x)], 1u);
        const unsigned gen = old / nloc;
        if (old + 1u == (gen + 1u) * nloc) {
            __builtin_amdgcn_fence(__ATOMIC_RELEASE, "agent");
            asm volatile("s_waitcnt vmcnt(0)" ::: "memory");
            const unsigned og = xb_add(&bar[XB_TOP], 1u);
            const unsigned tg = og / nx;
            if (og + 1u == (tg + 1u) * nx) xb_add(&bar[XB_TOPGEN], 1u);
            else XB_SPIN(xb_ld(&bar[XB_TOPGEN]) == tg, bar);
            __builtin_amdgcn_fence(__ATOMIC_ACQUIRE, "agent");
            xb_add(&bar[XB_XGEN(b.x)], 1u);
            asm volatile("s_waitcnt vmcnt(0)" ::: "memory");
        } else {
            XB_SPIN(xb_ld(&bar[XB_XGEN(b.x)]) == gen, bar);
            __builtin_amdgcn_fence(__ATOMIC_ACQUIRE, "agent");
            asm volatile("s_waitcnt vmcnt(0)" ::: "memory");
        }
    }
    __syncthreads();
}

constexpr int HTB = 128 * 64 * 2;
DI int lds_byte(int r, int c) { const int st = (r >> 4) * 2 + (c >> 5), rr = r & 15, cc = c & 31, ob = rr * 64 + cc * 2; return st * 1024 + (ob ^ (((ob >> 9) & 1) << 5)); }
DI void stage_rc(int b, int& R, int& C) { const int st = b / 1024, sb = b % 1024, swz = sb ^ (((sb >> 9) & 1) << 5); R = (st >> 1) * 16 + swz / 64; C = (st & 1) * 32 + (swz % 64) / 2; }

DI void stage_rc_t(int tz, int i, int& R, int& C) { stage_rc(tz * 16 + i * 8192, R, C); }
struct APlain {
    const char* base; int lda2;
    DI void park(LAS unsigned*) const {} DI void unpark(const LAS unsigned*) {} DI void take_uniform(const APlain&) {}
    DI const char* ptr(int tz, int h, int i, int kt) const { int R, C; stage_rc_t(tz, i, R, C); return base + (unsigned)((h * 128 + R) * lda2 + C * 2 + kt * 128); }
};
struct ASimple {
    const char* base; unsigned off[2][2]; unsigned kstride;
    DI void park(LAS unsigned* q) const { *(LAS u32x4*)q = (u32x4){off[0][0], off[0][1], off[1][0], off[1][1]}; }
    DI void unpark(const LAS unsigned* q) { const u32x4 v = *(const LAS u32x4*)q; off[0][0] = v.x; off[0][1] = v.y; off[1][0] = v.z; off[1][1] = v.w; }
    DI void take_uniform(const ASimple& o) { base = o.base; kstride = o.kstride; }
    DI const char* ptr(int tz, int h, int i, int kt) const { return base + (unsigned)(off[h][i] + (unsigned)kt * kstride); }
};
struct ASeg2 {
    const char* base0; const char* base1; unsigned off0[2][2]; unsigned off1[2][2]; unsigned ks0; int nt0;
    DI void park(LAS unsigned*) const {} DI void unpark(const LAS unsigned*) {} DI void take_uniform(const ASeg2&) {}
    DI const char* ptr(int tz, int h, int i, int kt) const { return kt < nt0 ? base0 + (unsigned)(off0[h][i] + (unsigned)kt * ks0) : base1 + (unsigned)(off1[h][i] + (unsigned)(kt - nt0) * 128u); }
};
DI int perm32(int rho) { const int n = rho >> 4, i = rho & 15; return 8 * (i >> 2) + 4 * n + (i & 3); }
struct BSimple {
    const char* base[2]; int ldb2;
    DI const char* ptr(int tz, int h, int i, int kt) const { int R, C; stage_rc_t(tz, i, R, C); const int Rb = (R & ~31) + perm32(R & 31); return base[h] + (unsigned)(Rb * ldb2 + C * 2 + kt * 128); }
};

#define WAIT_V(n) asm volatile("s_waitcnt vmcnt(" #n ")" ::: "memory")
#define WAIT_L(n) asm volatile("s_waitcnt lgkmcnt(" #n ")" ::: "memory")
#define BAR_ __builtin_amdgcn_s_barrier()
#define SCHED_ __builtin_amdgcn_sched_barrier(0)

DI void zero_acc(f32x4 (&acc)[2][2][4][2]) {
#pragma unroll
    for (int a = 0; a < 2; ++a)
#pragma unroll
        for (int b = 0; b < 2; ++b)
#pragma unroll
            for (int m = 0; m < 4; ++m)
#pragma unroll
                for (int n = 0; n < 2; ++n) acc[a][b][m][n] = (f32x4){0.f, 0.f, 0.f, 0.f};
}
template <int MODE> struct FragT;
template <> struct FragT<0> {
    i32x4 lo, hi;
    DI void load(const LAS char* p0, const LAS char* p1) { lo = *(const LAS i32x4*)p0; hi = *(const LAS i32x4*)p1; }
    static DI f32x4 mma(const FragT& b, const FragT& a, f32x4 c) {
        c = __builtin_amdgcn_mfma_f32_16x16x32_bf16(__builtin_bit_cast(bf16x8, b.lo), __builtin_bit_cast(bf16x8, a.lo), c, 0, 0, 0);
        return __builtin_amdgcn_mfma_f32_16x16x32_bf16(__builtin_bit_cast(bf16x8, b.hi), __builtin_bit_cast(bf16x8, a.hi), c, 0, 0, 0); }
};
template <> struct FragT<1> {
    i32x4 lo, hi;
    DI void load(const LAS char* p0, const LAS char* p1) { lo = *(const LAS i32x4*)p0; hi = *(const LAS i32x4*)p1; }
    static DI long pk(int x, int y) { return (long)(((unsigned long long)(unsigned)y << 32) | (unsigned)x); }
    static DI f32x4 mma(const FragT& b, const FragT& a, f32x4 c) {
        c = __builtin_amdgcn_mfma_f32_16x16x32_fp8_fp8(pk(b.lo.x, b.lo.y), pk(a.lo.x, a.lo.y), c, 0, 0, 0);
        c = __builtin_amdgcn_mfma_f32_16x16x32_fp8_fp8(pk(b.lo.z, b.lo.w), pk(a.lo.z, a.lo.w), c, 0, 0, 0);
        c = __builtin_amdgcn_mfma_f32_16x16x32_fp8_fp8(pk(b.hi.x, b.hi.y), pk(a.hi.x, a.hi.y), c, 0, 0, 0);
        return __builtin_amdgcn_mfma_f32_16x16x32_fp8_fp8(pk(b.hi.z, b.hi.w), pk(a.hi.z, a.hi.w), c, 0, 0, 0); }
};
template <> struct FragT<2> {
    i32x8 v;
    DI void load(const LAS char* p0, const LAS char* p1) { const i32x4 lo = *(const LAS i32x4*)p0, hi = *(const LAS i32x4*)p1; v = __builtin_shufflevector(lo, hi, 0, 1, 2, 3, 4, 5, 6, 7); }
    static DI f32x4 mma(const FragT& b, const FragT& a, f32x4 c) {
        const int one = 0x7f7f7f7f;
        asm volatile("v_mfma_scale_f32_16x16x128_f8f6f4 %0, %1, %2, %0, %3, %3 op_sel_hi:[0,0,0]" : "+v"(c) : "v"(b.v), "v"(a.v), "v"(one));
        return c; }
};
template <class PV>
DI void gemm_stream(LAS char* shm, const PV& pv, const int wv_) {
    typedef typename PV::AS AS; typedef typename PV::BS BS;
    constexpr int nt = PV::NT;
    int u = pv.first();
    if (u < 0) return;
    const int tz = otid();
    const int wr = wv_ >> 2, wc = wv_ & 3, lane = tz & 63, fr = lane & 15, fq = lane >> 4;
    const int aoff = lds_byte(wr * 64 + fr, fq * 8), boff = lds_byte(wc * 32 + fr, fq * 8);
    const unsigned ldsw = (unsigned)wv_ * 1024u;
    f32x4 acc[2][2][4][2]; zero_acc(acc);
    typedef FragT<PV::FP8> Frag;
    Frag At[4], B0[2], B1[2];
    AS ca, na; BS cb, nb;
    pv.src(u, ca, cb, wv_);
    constexpr bool F8 = PV::FP8 != 0;
    LAS unsigned* park = (LAS unsigned*)(shm + 131072) + tz * 4;
    const int aoff0 = aoff, aoff1 = aoff + 1024;
    const int boff0 = boff, boff1 = boff + 1024;
#define SA_(b, h) (((b) * 2 + (h)) * HTB)
#define SB_(b, h) ((4 + (b) * 2 + (h)) * HTB)
#define STG_(bufoff, S, h, kt) do { _Pragma("unroll") for (int i_ = 0; i_ < 2; ++i_) glds16((S).ptr(tz, h, i_, kt), shm + (bufoff) + ldsw + i_ * 8192); } while (0)
#define LDA_(dst, b, h) do { _Pragma("unroll") for (int m = 0; m < 4; ++m) dst[m].load(shm + SA_(b, h) + aoff0 + m * 2048, shm + SA_(b, h) + aoff1 + m * 2048); } while (0)
#define LDB_(dst, b, h) do { _Pragma("unroll") for (int n = 0; n < 2; ++n) dst[n].load(shm + SB_(b, h) + boff0 + n * 2048, shm + SB_(b, h) + boff1 + n * 2048); } while (0)
#define MMAS_(ai, bj, A_, B_, STGSTMT) do { __builtin_amdgcn_s_setprio(1); \
        acc[ai][bj][0][0] = Frag::mma(B_[0], A_[0], acc[ai][bj][0][0]); acc[ai][bj][0][1] = Frag::mma(B_[1], A_[0], acc[ai][bj][0][1]); \
        STGSTMT; \
        _Pragma("unroll") for (int m = 1; m < 4; ++m) _Pragma("unroll") for (int n = 0; n < 2; ++n) { \
            acc[ai][bj][m][n] = Frag::mma(B_[n], A_[m], acc[ai][bj][m][n]); } \
        __builtin_amdgcn_s_setprio(0); } while (0)
    STG_(SB_(0, 0), cb, 0, 0); STG_(SA_(0, 0), ca, 0, 0); STG_(SB_(0, 1), cb, 1, 0); STG_(SA_(0, 1), ca, 1, 0);
    if (wr == 1) BAR_;
    WAIT_V(4); BAR_;
    STG_(SB_(1, 0), cb, 0, 1); STG_(SA_(1, 0), ca, 0, 1); STG_(SB_(1, 1), cb, 1, 1);
    WAIT_V(6); BAR_;
    for (;;) {
        const int un = pv.next(u); const bool has_next = un >= 0;
        if (has_next) pv.src(un, na, nb, wv_); else { na = ca; nb = cb; }
        if (PV::PARK) { na.park(park); asm volatile("s_waitcnt lgkmcnt(0)" ::: "memory"); }
#pragma clang loop unroll(disable)
        for (int t = 0; t < nt; t += 2) {
            const bool last = (t == nt - 2);
            AS a2 = last ? na : ca; const BS b2 = last ? nb : cb; const int k2 = last ? 0 : t + 2;
            if (PV::PARK) { if (last) a2.unpark(park); }
            LDB_(B0, 0, 0); SCHED_; LDA_(At, 0, 0);
            WAIT_L(8); BAR_; WAIT_L(0); MMAS_(0, 0, At, B0, STG_(SA_(1, 1), ca, 1, t + 1)); BAR_; SCHED_;
            LDB_(B1, 0, 1);
            BAR_; WAIT_L(0); MMAS_(0, 1, At, B1, STG_(SB_(0, 0), b2, 0, k2)); BAR_;
            LDA_(At, 0, 1);
            BAR_; WAIT_L(0); MMAS_(1, 0, At, B0, STG_(SA_(0, 0), a2, 0, k2)); BAR_; SCHED_;
            WAIT_V(4); BAR_; MMAS_(1, 1, At, B1, STG_(SB_(0, 1), b2, 1, k2)); BAR_;
            LDB_(B0, 1, 0); SCHED_; LDA_(At, 1, 0);
            WAIT_L(8); BAR_; WAIT_L(0); MMAS_(0, 0, At, B0, STG_(SA_(0, 1), a2, 1, k2)); BAR_; SCHED_;
            LDB_(B1, 1, 1);
            BAR_; WAIT_L(0); MMAS_(0, 1, At, B1, STG_(SB_(1, 0), b2, 0, k2 + 1)); BAR_;
            LDA_(At, 1, 1);
            BAR_; WAIT_L(0); MMAS_(1, 0, At, B0, STG_(SA_(1, 0), a2, 0, k2 + 1)); BAR_; SCHED_;
            WAIT_V(4); BAR_; MMAS_(1, 1, At, B1, STG_(SB_(1, 1), b2, 1, k2 + 1)); BAR_;
            if (PV::PARK) { if (last) ca = a2; }
        }
        if (PV::FP8 == 2) asm volatile("s_nop 15\n\ts_nop 15" ::: "memory");
        pv.epi(acc, u, wv_);
        if (!has_next) break;
        zero_acc(acc);
        u = un; if (!PV::PARK) ca = na; cb = nb;
        if (PV::PARK) ca.take_uniform(na);
    }
    WAIT_V(0);
    if (wr == 0) BAR_;
    BAR_;
#undef SA_
#undef SB_
#undef STG_
#undef LDA_
#undef LDB_
#undef MMAS_
}
DI int lin_first(int shift, int count) { const int G = gridDim.x; const int u = (int)((blockIdx.x + G - (shift % G)) % G); return u < count ? u : -1; }
DI int lin_next(int u, int count) { const int un = u + (int)gridDim.x; return un < count ? un : -1; }
template <int MG, int NTL> struct XcdDeal {
    int MT;
    DI bool decode(int J, int& mt, int& nt) const { const int x = blockIdx.x & 7; const int grp = (J / (MG * NTL)) * 8 + x, w = J % (MG * NTL); mt = grp * MG + w / NTL; nt = w % NTL; return mt < MT; }
    DI int jmax() const { return ((MT + 8 * MG - 1) / (8 * MG)) * (MG * NTL); }
    DI int first() const { int J = blockIdx.x >> 3; const int per = gridDim.x >> 3, jm = jmax(); int mt, nt;
        while (J < jm && !decode(J, mt, nt)) J += per;
        return J < jm ? J : -1; }
    DI int next(int J) const { const int per = gridDim.x >> 3, jm = jmax(); int mt, nt; J += per;
        while (J < jm && !decode(J, mt, nt)) J += per;
        return J < jm ? J : -1; }
};
DI int first_unit(int shift) { const int G = gridDim.x; return (int)((blockIdx.x + G - (shift % G)) % G); }

DI void stage_coords(int (&R)[2], int (&C)[2], const int wv_) {
    const int t_ = otid();
#pragma unroll
    for (int i = 0; i < 2; ++i) stage_rc(t_ * 16 + i * 8192, R[i], C[i]);
}
DI APlain make_a_plain(const bf16_t* A, size_t row0, int lda, int col0) {
    APlain a; a.base = (const char*)(A + row0 * (size_t)lda + col0); a.lda2 = lda * 2; return a;
}
DI BSimple make_b(const bf16_t* Bt0, const bf16_t* Bt1, int ldb) {
    BSimple b; b.base[0] = (const char*)Bt0; b.base[1] = (const char*)Bt1; b.ldb2 = ldb * 2; return b;
}
#define EPI_FOR(acc, ...) do { const int _tz = otid(), _w = _tz >> 6, _l = _tz & 63, _wr = _w >> 2, _wc = _w & 3, _fr = _l & 15, _fq = _l >> 4; \
    _Pragma("unroll") for (int ai = 0; ai < 2; ++ai) _Pragma("unroll") for (int m = 0; m < 4; ++m) { const int lr = ai * 128 + _wr * 64 + m * 16 + _fr; \
    _Pragma("unroll") for (int bj = 0; bj < 2; ++bj) _Pragma("unroll") for (int n = 0; n < 2; ++n) { const int lc = bj * 128 + _wc * 32 + n * 16 + _fq * 4; const f32x4 v = acc[ai][bj][m][n]; __VA_ARGS__ } } } while (0)

DI void store_bf16x4(bf16_t* p, float a, float b, float c, float d) { u32x2 v; v.x = pk_bf16(a, b); v.y = pk_bf16(c, d); *(u32x2*)p = v; }
DI void store_bf16x8(bf16_t* p, const f32x4 a, const f32x4 b) { u32x4 v; v.x = pk_bf16(a[0], a[1]); v.y = pk_bf16(a[2], a[3]); v.z = pk_bf16(b[0], b[1]); v.w = pk_bf16(b[2], b[3]); *(u32x4*)p = v; }
#define EPI_FOR8(acc, ...) do { const int _tz = otid(), _w = _tz >> 6, _l = _tz & 63, _wr = _w >> 2, _wc = _w & 3, _fr = _l & 15, _fq = _l >> 4; \
    _Pragma("unroll") for (int ai = 0; ai < 2; ++ai) _Pragma("unroll") for (int m = 0; m < 4; ++m) { const int lr = ai * 128 + _wr * 64 + m * 16 + _fr; \
    _Pragma("unroll") for (int bj = 0; bj < 2; ++bj) { const int lc = bj * 128 + _wc * 32 + _fq * 8; const f32x4 v0 = acc[ai][bj][m][0], v1 = acc[ai][bj][m][1]; __VA_ARGS__ } } } while (0)

DI int mod_row(int r) { return r < TX ? (r >> 11) : 32; }
DI int crow_tok(int cr) { const int b = cr / NCH, j = cr - b * NCH; return j < 4 ? TX + b * CTXL + j * 64 : b * SEQ + (j - 4) * 64; }

DI void cvt_tile(LAS char* wl  , const float* src, int ld_src, int kvalid, int nvalid, const float* scale, bf16_t* dst, int ld_dst, const int wv_) {
    const int lane = otid() & 63;
    const int lr = lane >> 4, lc = (lane & 15) * 4;
    f32x4 v[16];
#pragma unroll
    for (int it = 0; it < 16; ++it) {
        const int k = it * 4 + lr;
        v[it] = (f32x4){0.f, 0.f, 0.f, 0.f};
        if (src != nullptr && k < kvalid && lc < nvalid) { v[it] = *(const f32x4*)(src + (size_t)k * ld_src + lc); if (scale) { const float s = scale[k]; v[it] *= s; } }
    }
#pragma unroll
    for (int it = 0; it < 16; ++it) {
        const int k = it * 4 + lr;
#pragma unroll
        for (int j = 0; j < 4; ++j) *(LAS bf16_t*)(wl + (lc + j) * 144 + k * 2) = f2bf(v[it][j]);
    }
    asm volatile("s_waitcnt lgkmcnt(0)" ::: "memory");
#pragma unroll
    for (int i = 0; i < 8; ++i) {
        const int q = i * 64 + lane, n = q >> 3, c = q & 7;
        const u32x4 w = *(const LAS u32x4*)(wl + n * 144 + c * 16);
        *(u32x4*)(dst + (size_t)n * ld_dst + c * 8) = w;
    }
    asm volatile("s_waitcnt lgkmcnt(0)" ::: "memory");
}
DI void cvt_tile8(LAS char* wl  , const float* src, int ld_src, unsigned char* dst, int ld_dst, const int wv_) {
    const int lane = otid() & 63;
    const int lr = lane >> 4, lc = (lane & 15) * 4;
    f32x4 v[16];
#pragma unroll
    for (int it = 0; it < 16; ++it) v[it] = *(const f32x4*)(src + (size_t)(it * 4 + lr) * ld_src + lc);
#pragma unroll
    for (int it = 0; it < 16; ++it) {
        const int k = it * 4 + lr;
#pragma unroll
        for (int j = 0; j < 4; ++j) *(LAS unsigned char*)(wl + (lc + j) * 80 + k) = (unsigned char)f2fp8(v[it][j] * 256.f);
    }
    asm volatile("s_waitcnt lgkmcnt(0)" ::: "memory");
#pragma unroll
    for (int i = 0; i < 4; ++i) {
        const int q = i * 64 + lane, n = q >> 2, c = q & 3;
        const u32x4 w = *(const LAS u32x4*)(wl + n * 80 + c * 16);
        *(u32x4*)(dst + (size_t)n * ld_dst + c * 16) = w;
    }
    asm volatile("s_waitcnt lgkmcnt(0)" ::: "memory");
}
constexpr int CVT_SMALL_TILES = 768 + 512 + 32 + 32 + 64 + 64 + 32;
constexpr int CVT_EXP_TILES = 32 * (32 * 16 + 16 * 16);
DI void cvt_small(const Params& p, LAS char* wl, int t, const int wv_) {
    char* ws = p.ws;
    if (t < 768) { const int l = t / 384, r = t % 384, nt = r / 16, kt = r % 16;
        cvt_tile(wl, p.w_mix_in + (size_t)l * 1024 * N_IN + (size_t)kt * 64 * N_IN + nt * 64, N_IN, 64, N_IN - nt * 64, nullptr,
                 (bf16_t*)(ws + WS_WMI) + ((size_t)l * 1536 + nt * 64) * 1024 + kt * 64, 1024, wv_); return; }
    t -= 768;
    if (t < 512) { const int l = t / 256, r = t % 256, nt = r / 16, kt = r % 16;
        cvt_tile(wl, p.w_mix_out + (size_t)l * 1024 * 1024 + (size_t)kt * 64 * 1024 + nt * 64, 1024, 64, 64, nullptr,
                 (bf16_t*)(ws + WS_WMO) + ((size_t)l * 1024 + nt * 64) * 1024 + kt * 64, 1024, wv_); return; }
    t -= 512;
    if (t < 32) { const int l = t / 16, r = t % 16, nt = r / 4, kt = r % 4;
        cvt_tile(wl, p.conv_pw + (size_t)l * 65536 + (size_t)kt * 64 * 256 + nt * 64, 256, 64, 64, nullptr,
                 (bf16_t*)(ws + WS_WPW) + ((size_t)l * 256 + nt * 64) * 256 + kt * 64, 256, wv_); return; }
    t -= 32;
    if (t < 32) { const int l = t / 16, r = t % 16, nt = r / 4, kt = r % 4;
        cvt_tile(wl, p.ssm_glu_w + (size_t)l * 65536 + (size_t)kt * 64 * 256 + nt * 64, 256, 64, 64, nullptr,
                 (bf16_t*)(ws + WS_WGLU) + ((size_t)l * 256 + nt * 64) * 256 + kt * 64, 256, wv_); return; }
    t -= 32;
    if (t < 64) { const int l = t / 32, r = t % 32, nt = r / 4, kt = r % 4;
        const bool any = (kt < 3) && (nt < 6);
        cvt_tile(wl, any ? p.mla_wq_b + (size_t)l * 192 * 384 + (size_t)kt * 64 * 384 + nt * 64 : nullptr, 384, 64, 64, p.mla_q_a_g + l * 192 + kt * 64,
                 (bf16_t*)(ws + WS_WQ) + ((size_t)l * 512 + nt * 64) * 256 + kt * 64, 256, wv_); return; }
    t -= 64;
    if (t < 64) { const int l = t / 32, r = t % 32, nt = r / 4, kt = r % 4;
        const bool any = (kt < 2);
        cvt_tile(wl, any ? p.mla_wkv_b + (size_t)l * 128 * 512 + (size_t)kt * 64 * 512 + nt * 64 : nullptr, 512, 64, 64, p.mla_kv_a_g + l * 128 + kt * 64,
                 (bf16_t*)(ws + WS_WKV) + ((size_t)l * 512 + nt * 64) * 256 + kt * 64, 256, wv_); return; }
    t -= 64;
    { const int l = t / 16, r = t % 16, nt = r / 4, kt = r % 4;
        cvt_tile(wl, nt == kt ? p.pool_w + ((size_t)l * 4 + nt) * 4096 : nullptr, 64, 64, 64, nullptr,
                 (bf16_t*)(ws + WS_WPOOL) + ((size_t)l * 256 + nt * 64) * 256 + kt * 64, 256, wv_); }
}
DI void cvt_expert(const Params& p, LAS char* wl, int l, int t, const int wv_) {
    char* ws = p.ws;
    const int e = t / 768, r = t % 768;
    if (r < 512) { const int nt = r / 16, kt = r % 16;
        cvt_tile8(wl, p.exp_w_in + ((size_t)(l * NE + e) * 1024 + kt * 64) * 2048 + nt * 64, 2048,
                  (unsigned char*)(ws + WS_W1) + ((size_t)(l * NE + e) * 2048 + nt * 64) * 1024 + kt * 64, 1024, wv_);
    } else { const int q = r - 512, nt = q / 16, kt = q % 16;
        cvt_tile8(wl, p.exp_w_out + ((size_t)(l * NE + e) * 1024 + kt * 64) * 1024 + nt * 64, 1024,
                  (unsigned char*)(ws + WS_W2) + ((size_t)(l * NE + e) * 1024 + nt * 64) * 1024 + kt * 64, 1024, wv_);
    }
}

DI void ada_unit(const Params& p, LAS char* shm, int u, const int wv_) {
    const int tid = otid();
    const int l = u / 48, jc = u % 48;
    LAS float* sc = (LAS float*)shm;
    for (int i = tid; i < 33 * 1024; i += 512) { const int r = i >> 10, k = i & 1023; const float v = r < 32 ? p.c[r * 1024 + k] : p.c_ctx[k]; sc[i] = siluf_(v); }
    __syncthreads();
    const int col = tid & 127, kq = tid >> 7;
    float acc[33];
#pragma unroll
    for (int r = 0; r < 33; ++r) acc[r] = 0.f;
    const float* wp = p.ada_w + ((size_t)l * 1024 + kq * 256) * 6144 + jc * 128 + col;
    for (int k4 = 0; k4 < 256; k4 += 4) {
        float w[4];
#pragma unroll
        for (int i = 0; i < 4; ++i) w[i] = wp[(size_t)(k4 + i) * 6144];
#pragma unroll
        for (int r = 0; r < 33; ++r) { const f32x4 s = *(const LAS f32x4*)(sc + r * 1024 + kq * 256 + k4); acc[r] += s[0] * w[0] + s[1] * w[1] + s[2] * w[2] + s[3] * w[3]; }
    }
    __syncthreads();
    LAS float* red = (LAS float*)shm;
#pragma unroll
    for (int r = 0; r < 33; ++r) red[(kq * 33 + r) * 128 + col] = acc[r];
    __syncthreads();
    for (int i = tid; i < 33 * 128; i += 512) { const int r = i >> 7, cc = i & 127;
        const float s = red[(0 * 33 + r) * 128 + cc] + red[(1 * 33 + r) * 128 + cc] + red[(2 * 33 + r) * 128 + cc] + red[(3 * 33 + r) * 128 + cc];
        ((float*)(p.ws + WS_MOD))[((size_t)l * 33 + r) * 6144 + jc * 128 + cc] = s + p.ada_b[l * 6144 + jc * 128 + cc]; }
    __syncthreads();
}

DI void s5_load_bc(const Params& p, LAS float* bb, LAS float* cc, int l, int dir, int g, int tid) {
    const int pbase = ((l * 2 + dir) * 16 + g) * 64;
    const double dt = exp((double)p.ssm_log_dt[(l * 2 + dir) * 16 + g]);
    for (int i = tid; i < 64 * 16; i += 512) { const int q = i >> 4, ci = i & 15;
        const double are = fmin((double)p.ssm_a_re[pbase + q], -1e-4), aim = (double)p.ssm_a_im[pbase + q];
        const double mg = exp(are * dt), abr = mg * cos(aim * dt), abi = mg * sin(aim * dt), den = are * are + aim * aim;
        const double fre = ((abr - 1.0) * are + abi * aim) / den, fim = (abi * are - (abr - 1.0) * aim) / den;
        const double br = (double)p.ssm_b_re[(size_t)(pbase + q) * 16 + ci], bi = (double)p.ssm_b_im[(size_t)(pbase + q) * 16 + ci];
        bb[i * 2] = (float)(fre * br - fim * bi); bb[i * 2 + 1] = (float)(fre * bi + fim * br); }
    for (int i = tid; i < 16 * 64; i += 512) { const int co = i >> 6, q = i & 63;
        const size_t ix = ((size_t)((l * 2 + dir) * 16 + g) * 16 + co) * 64 + q;
        cc[i * 2] = p.ssm_c_re[ix]; cc[i * 2 + 1] = p.ssm_c_im[ix]; }
}
DI void s5pre_unit(const Params& p, LAS char* shm, int u, const int wv_) {
    const int tid = otid();
    const int l = u >> 5, g = (u >> 1) & 15, dir = u & 1;
    LAS float* pw = (LAS float*)shm;
    LAS float* bb = pw + 65 * 64 * 2;
    LAS float* cc = bb + 64 * 16 * 2;
    LAS float* kk = cc + 16 * 64 * 2;
    LAS float* k0o = kk + 64 * 256;
    bf16_t* TS = (bf16_t*)(p.ws + WS_TS5) + (size_t)(l * 16 + g) * 1024 * 1280;
    bf16_t* WS = (bf16_t*)(p.ws + WS_WS5) + (size_t)(l * 16 + g) * 256 * 1024;
    const int cocip = tid & 255, co_ = cocip >> 4, ci_ = cocip & 15;
    if (dir == 0) {
        s5_load_bc(p, bb, cc, l, 1, g, tid);
        __syncthreads();
        if (tid < 256) { float s_ = 0.f;
            for (int q = 0; q < 64; ++q) s_ += cc[(co_ * 64 + q) * 2] * bb[(q * 16 + ci_) * 2] - cc[(co_ * 64 + q) * 2 + 1] * bb[(q * 16 + ci_) * 2 + 1];
            k0o[tid] = s_; }
        __syncthreads();
    }
    {
        const int pbase = ((l * 2 + dir) * 16 + g) * 64;
        const double dt = exp((double)p.ssm_log_dt[(l * 2 + dir) * 16 + g]);
        for (int i = tid; i < 65 * 64; i += 512) { const int tau = i >> 6, q = i & 63;
            const double are = fmin((double)p.ssm_a_re[pbase + q], -1e-4), aim = (double)p.ssm_a_im[pbase + q];
            const double mg = exp(are * dt * tau), an = aim * dt * tau;
            pw[i * 2] = (float)(mg * cos(an)); pw[i * 2 + 1] = (float)(mg * sin(an)); }
        s5_load_bc(p, bb, cc, l, dir, g, tid);
        __syncthreads();
        if (tid < 64) { float* a64 = (float*)(p.ws + WS_A64) + (size_t)(((l * 2 + dir) * 16 + g) * 64 + tid) * 2; a64[0] = pw[(64 * 64 + tid) * 2]; a64[1] = pw[(64 * 64 + tid) * 2 + 1]; }
        { float gr[64], gi[64];
#pragma unroll
          for (int q = 0; q < 64; ++q) { const float cr = cc[(co_ * 64 + q) * 2], cim = cc[(co_ * 64 + q) * 2 + 1], br = bb[(q * 16 + ci_) * 2], bi = bb[(q * 16 + ci_) * 2 + 1];
              gr[q] = cr * br - cim * bi; gi[q] = cr * bi + cim * br; }
          for (int tau = (tid >> 8); tau < 64; tau += 2) {
              float s_ = 0.f;
#pragma unroll
              for (int q = 0; q < 64; ++q) s_ += gr[q] * pw[(tau * 64 + q) * 2] - gi[q] * pw[(tau * 64 + q) * 2 + 1];
              kk[tau * 256 + cocip] = s_;
          } }
        for (int i = tid; i < 128 * 512; i += 512) { const int row = i >> 9, kp = (i & 511) * 2, ri = row >> 6, q = row & 63, s_ = kp >> 4, ci = kp & 15;
            const int e = dir == 0 ? 63 - s_ : s_;
            const float pr = pw[(e * 64 + q) * 2], pi = pw[(e * 64 + q) * 2 + 1];
            float o[2];
#pragma unroll
            for (int j = 0; j < 2; ++j) { const float br = bb[(q * 16 + ci + j) * 2], bi = bb[(q * 16 + ci + j) * 2 + 1]; o[j] = ri == 0 ? pr * br - pi * bi : pr * bi + pi * br; }
            *(unsigned*)(WS + (size_t)(dir * 128 + row) * 1024 + kp) = pk_bf16(o[0], o[1]); }
        for (int i = tid; i < 1024 * 64; i += 512) { const int row = i >> 6, kp = (i & 63) * 2, t = row >> 4, co = row & 15, ri = kp >> 6, q = kp & 63;
            const int e = dir == 0 ? t + 1 : 64 - t;
            float o[2];
#pragma unroll
            for (int j = 0; j < 2; ++j) { const float pr = pw[(e * 64 + q + j) * 2], pi = pw[(e * 64 + q + j) * 2 + 1];
                const float cr = cc[(co * 64 + q + j) * 2], cim = cc[(co * 64 + q + j) * 2 + 1];
                o[j] = ri == 0 ? (cr * pr - cim * pi) : -(cr * pi + cim * pr); }
            *(unsigned*)(TS + (size_t)row * 1280 + 1024 + dir * 128 + kp) = pk_bf16(o[0], o[1]); }
        __syncthreads();
        for (int rr = tid; rr < 1024; rr += 512) { const int t = rr >> 4, co = rr & 15;
            const float dco = p.ssm_d[l * 256 + g * 16 + co];
            bf16_t* rowp = TS + (size_t)rr * 1280;
            const int s_lo = dir == 0 ? 0 : t + 1, s_hi = dir == 0 ? t : 63;
            for (int s_ = s_lo; s_ <= s_hi; ++s_) { const int tau = dir == 0 ? t - s_ : s_ - t;
                unsigned w[8];
#pragma unroll
                for (int j = 0; j < 8; ++j) { float a = kk[tau * 256 + co * 16 + 2 * j], b2 = kk[tau * 256 + co * 16 + 2 * j + 1];
                    if (s_ == t) { a += k0o[co * 16 + 2 * j]; b2 += k0o[co * 16 + 2 * j + 1]; if (2 * j == co) a += dco; if (2 * j + 1 == co) b2 += dco; }
                    w[j] = pk_bf16(a, b2); }
                *(u32x4*)(rowp + s_ * 16) = (u32x4){w[0], w[1], w[2], w[3]}; *(u32x4*)(rowp + s_ * 16 + 8) = (u32x4){w[4], w[5], w[6], w[7]}; }
        }
        __syncthreads();
    }
}

DI void phase_prologue(const Params& p, LAS char* shm, const int wv_) {
    const int tid = otid();
    __syncthreads();
    if (blockIdx.x == 0 && tid < 64) ((int*)(p.ws + WS_CNT))[tid] = 0;
    const int n_cvt = (CVT_SMALL_TILES + 2 * CVT_EXP_TILES + 7) / 8;
    const int n_units = 64 + 96 + n_cvt;
    for (int u = blockIdx.x; u < n_units; u += gridDim.x) {
        if (u < 64) s5pre_unit(p, shm, u, wv_);
        else if (u < 160) ada_unit(p, shm, u - 64, wv_);
        else {
            const int t = (u - 160) * 8 + (tid >> 6);
            LAS char* wl = shm + (tid >> 6) * (64 * 144);
            if (t < CVT_SMALL_TILES) cvt_small(p, wl, t, wv_);
            else if (t < CVT_SMALL_TILES + 2 * CVT_EXP_TILES) { const int te = t - CVT_SMALL_TILES; cvt_expert(p, wl, te / CVT_EXP_TILES, te % CVT_EXP_TILES, wv_); }
        }
    }
}

DI void norm_mod_store(const float (&v)[16], const float* g, const float* modrow  , bf16_t* hrow, const int wv_) {
    const int lane = otid() & 63;
    float ss = 0.f;
#pragma unroll
    for (int i = 0; i < 16; ++i) ss += v[i] * v[i];
    ss = wave_sum(ss);
    const float rn = rsqrtf(ss * (1.f / 1024.f) + EPS);
#pragma unroll
    for (int j = 0; j < 4; ++j) {
        const int col = j * 256 + lane * 4;
        const f32x4 gg = *(const f32x4*)(g + col), sh = *(const f32x4*)(modrow + col), sc = *(const f32x4*)(modrow + 1024 + col);
        float o[4];
#pragma unroll
        for (int i = 0; i < 4; ++i) o[i] = v[j * 4 + i] * rn * gg[i] * (1.f + sc[i]) + sh[i];
        store_bf16x4(hrow + col, o[0], o[1], o[2], o[3]);
    }
}
DI void phase_norm1_l0(const Params& p, const int wv_) {
    const int tid_ = otid(); const int wid = tid_ >> 6, lane = tid_ & 63;
    const float* MOD = (const float*)(p.ws + WS_MOD);
    bf16_t* H = (bf16_t*)(p.ws + WS_H);
    for (int r = blockIdx.x * 8 + wid; r < TT; r += gridDim.x * 8) {
        const float* src = r < TX ? p.x + (size_t)r * 1024 : p.ctx + (size_t)(r - TX) * 1024;
        float v[16];
#pragma unroll
        for (int j = 0; j < 4; ++j) { const f32x4 t = *(const f32x4*)(src + j * 256 + lane * 4); v[j * 4] = t[0]; v[j * 4 + 1] = t[1]; v[j * 4 + 2] = t[2]; v[j * 4 + 3] = t[3]; }
        norm_mod_store(v, p.norm1_g, MOD + (size_t)(0 * 33 + mod_row(r)) * 6144, H + (size_t)r * 1024, wv_);
    }
}

struct PvInproj {
    const Params& p; int l;
    static constexpr int NT = 16; static constexpr int FP8 = 0; static constexpr bool PARK = false; typedef APlain AS; typedef BSimple BS;
    XcdDeal<4, 6> deal;
    DI int first() const { return deal.first(); }
    DI int next(int u) const { return deal.next(u); }
    DI void src(int u, AS& a, BS& b, const int wv_) const {
        int mt, nt; deal.decode(u, mt, nt);
        const bf16_t* W = (const bf16_t*)(p.ws + WS_WMI) + (size_t)l * 1536 * 1024;
        a = make_a_plain((const bf16_t*)(p.ws + WS_H), (size_t)mt * 256, 1024, 0);
        b = nt < 2 ? make_b(W + (size_t)(nt * 128) * 1024, W + (size_t)(256 + nt * 128) * 1024, 1024)
                   : make_b(W + (size_t)(nt * 256) * 1024, W + (size_t)(nt * 256 + 128) * 1024, 1024);
    }
    DI void epi(f32x4 (&acc)[2][2][4][2], int u, const int wv_) const {
        int mt, nt; deal.decode(u, mt, nt);
        bf16_t* P = (bf16_t*)(p.ws + WS_P);
        if (nt < 2) {
            const int _tz = otid(), _w = _tz >> 6, _l = _tz & 63, _wr = _w >> 2, _wc = _w & 3, _fr = _l & 15, _fq = _l >> 4;
#pragma unroll
            for (int ai = 0; ai < 2; ++ai)
#pragma unroll
                for (int m = 0; m < 4; ++m) { const int lr = ai * 128 + _wr * 64 + m * 16 + _fr; const int lc = _wc * 32 + _fq * 8;
                    f32x4 o0, o1;
#pragma unroll
                    for (int r = 0; r < 4; ++r) { o0[r] = acc[ai][0][m][0][r] * sigmoidf_(acc[ai][1][m][0][r]); o1[r] = acc[ai][0][m][1][r] * sigmoidf_(acc[ai][1][m][1][r]); }
                    store_bf16x8(P + (size_t)(mt * 256 + lr) * NINP + nt * 128 + lc, o0, o1); }
        } else {
            EPI_FOR8(acc, { store_bf16x8(P + (size_t)(mt * 256 + lr) * NINP + nt * 256 + lc, v0, v1); });
        }
    }
};
DI void phase_inproj(const Params& p, LAS char* shm, int l, const int wv_) {
    PvInproj pv{p, l, {TT / 256}};
    gemm_stream(shm, pv, wv_);
}

template <int N> DI void wave_sum_n(float (&v)[N]) {
    const int l4 = olane();
#pragma unroll
    for (int o = 32; o > 0; o >>= 1) {
        float t_[N];
#pragma unroll
        for (int i = 0; i < N; ++i) t_[i] = __int_as_float(__builtin_amdgcn_ds_bpermute((l4 ^ o) << 2, __float_as_int(v[i])));
#pragma unroll
        for (int i = 0; i < N; ++i) v[i] += t_[i];
    }
}
template <int WIN, bool EDGE>
DI void pool_run(const bf16_t* P, bf16_t* AP, int row0, int ts0, int L, int c, int half) {
    for (int blk = 0; blk < 2; ++blk) {
        const int t0 = half * 32 + blk * 16;
        float in[16 + WIN - 1];
#pragma unroll
        for (int i = 0; i < 16 + WIN - 1; ++i) { const int d = i - WIN / 2; const int ts = ts0 + t0 + d;
            in[i] = (!EDGE || (ts >= 0 && ts < L)) ? bf2f(P[(size_t)(row0 + t0 + d) * NINP + OFF_POOL + c]) : 0.f; }
        float sum = 0.f;
#pragma unroll
        for (int j = 0; j < WIN; ++j) sum += in[j];
#pragma unroll
        for (int o = 0; o < 16; ++o) {
            float inv = 1.f / (float)WIN;
            if (EDGE) { const int ts = ts0 + t0 + o; const int lo = max(ts - WIN / 2, 0), hi = min(ts + WIN - 1 - WIN / 2, L - 1); inv = 1.f / (float)(hi - lo + 1); }
            AP[(size_t)(row0 + t0 + o) * 256 + c] = f2bf(sum * inv - in[o + WIN / 2]);
            if (o < 15) sum += in[o + WIN] - in[o];
        }
    }
}
template <bool EDGE>
DI void pre_unit_t(const Params& p, LAS char* shm, int l, int row0, int ts0, int L, const int wv_) {
    const int tid = otid();
    const bf16_t* P = (const bf16_t*)(p.ws + WS_P);
    const int c = tid & 255, half = tid >> 8;
    LAS float* cv = (LAS float*)shm;
    {
        float w[31];
#pragma unroll
        for (int j = 0; j < 31; ++j) w[j] = p.conv_dw[((size_t)l * 31 + j) * 256 + c];
        const float bias = p.conv_dw_b[l * 256 + c];
        const int t0 = half * 32;
        float in[62];
#pragma unroll
        for (int i = 0; i < 62; ++i) {
            const int ts = ts0 + t0 - 15 + i;
            in[i] = (!EDGE || (ts >= 0 && ts < L)) ? bf2f(P[(size_t)(row0 + t0 - 15 + i) * NINP + c]) : 0.f;
        }
#pragma unroll
        for (int o = 0; o < 32; ++o) { float s_ = bias;
#pragma unroll
            for (int j = 0; j < 31; ++j) s_ += w[j] * in[o + j];
            cv[(t0 + o) * 257 + c] = s_; }
    }
    __syncthreads();
    {
        const int wid = tid >> 6, lane = tid & 63;
        bf16_t* AC = (bf16_t*)(p.ws + WS_ACONV);
        float lg[4], lb[4];
#pragma unroll
        for (int j = 0; j < 4; ++j) { lg[j] = p.conv_ln_g[l * 256 + lane + 64 * j]; lb[j] = p.conv_ln_b[l * 256 + lane + 64 * j]; }
        float x[8][4], s8[8];
#pragma unroll
        for (int i = 0; i < 8; ++i) { s8[i] = 0.f;
#pragma unroll
            for (int j = 0; j < 4; ++j) { x[i][j] = cv[(wid * 8 + i) * 257 + lane + 64 * j]; s8[i] += x[i][j]; } }
        wave_sum_n<8>(s8);
#pragma unroll
        for (int i = 0; i < 8; ++i) { const float mu = s8[i] * (1.f / 256.f); s8[i] = 0.f;
#pragma unroll
            for (int j = 0; j < 4; ++j) { x[i][j] -= mu; s8[i] += x[i][j] * x[i][j]; } }
        wave_sum_n<8>(s8);
#pragma unroll
        for (int i = 0; i < 8; ++i) { const float rs = rsqrtf(s8[i] * (1.f / 256.f) + EPS);
#pragma unroll
            for (int j = 0; j < 4; ++j) { const float y = x[i][j] * rs * lg[j] + lb[j]; AC[(size_t)(row0 + wid * 8 + i) * 256 + lane + 64 * j] = f2bf(siluf_(y)); } }
    }
    {
        bf16_t* AP = (bf16_t*)(p.ws + WS_APOOL);
        const int g = __builtin_amdgcn_readfirstlane(c >> 6);
        if (g == 0) pool_run<2, EDGE>(P, AP, row0, ts0, L, c, half);
        else if (g == 1) pool_run<4, EDGE>(P, AP, row0, ts0, L, c, half);
        else if (g == 2) pool_run<8, EDGE>(P, AP, row0, ts0, L, c, half);
        else pool_run<16, EDGE>(P, AP, row0, ts0, L, c, half);
    }
    __syncthreads();
}
DI void pre_unit(const Params& p, LAS char* shm, int l, int tile, const int wv_) {
    int row0, ts0, L;
    if (tile < 1024) { row0 = tile * 64; ts0 = row0 & 2047; L = SEQ; } else { row0 = TX + (tile - 1024) * 64; ts0 = (row0 - TX) & 255; L = CTXL; }
    if (ts0 >= 16 && ts0 + 64 + 16 <= L) pre_unit_t<false>(p, shm, l, row0, ts0, L, wv_);
    else pre_unit_t<true>(p, shm, l, row0, ts0, L, wv_);
}
struct PvS5State {
    const Params& p; int l;
    static constexpr int NT = 16; static constexpr int FP8 = 0; static constexpr bool PARK = false; typedef ASimple AS; typedef BSimple BS;
    DI int first() const { return lin_first(0, 80); }
    DI int next(int u) const { return lin_next(u, 80); }
    DI void src(int u, AS& as, BS& bs, const int wv_) const {
        const int g = u / 5, mt = u % 5;
        int R[2], C[2]; stage_coords(R, C, wv_);
        as.base = (const char*)(p.ws + WS_P); as.kstride = 4 * NINP * 2;
#pragma unroll
        for (int h = 0; h < 2; ++h)
#pragma unroll
            for (int i = 0; i < 2; ++i) { const int cr = min(mt * 256 + h * 128 + R[i], NCROW - 1);
                as.off[h][i] = (unsigned)(((size_t)(crow_tok(cr) + (C[i] >> 4)) * NINP + OFF_SSM + g * 16 + (C[i] & 15)) * 2); }
        const bf16_t* W = (const bf16_t*)(p.ws + WS_WS5) + (size_t)(l * 16 + g) * 256 * 1024;
        bs = make_b(W, W + (size_t)128 * 1024, 1024);
    }
    DI void epi(f32x4 (&acc)[2][2][4][2], int u, const int wv_) const {
        const int g = u / 5, mt = u % 5;
        float* SST = (float*)(p.ws + WS_SST);
        EPI_FOR8(acc, { const int cr = mt * 256 + lr; if (cr < NCROW) { float* o_ = SST + ((size_t)cr * 16 + g) * 256 + lc; *(f32x4*)o_ = v0; *(f32x4*)(o_ + 4) = v1; } });
    }
};
struct PvQKV {
    const Params& p; int l;
    static constexpr int NT = 4; static constexpr int FP8 = 0; static constexpr bool PARK = false; typedef APlain AS; typedef BSimple BS;
    DI int first() const { return lin_first(80, 1152); }
    DI int next(int u) const { return lin_next(u, 1152); }
    DI void src(int u, AS& a, BS& b, const int wv_) const {
        const bool isq = u < 576; const int w_ = isq ? u : u - 576; const int mt = w_ >> 1, nt = w_ & 1;
        a = make_a_plain((const bf16_t*)(p.ws + WS_P), (size_t)mt * 256, NINP, isq ? OFF_Q : OFF_KV);
        const bf16_t* W = (const bf16_t*)(p.ws + (isq ? WS_WQ : WS_WKV)) + (size_t)l * 512 * 256 + (size_t)nt * 256 * 256;
        b = make_b(W, W + (size_t)128 * 256, 256);
    }
    DI void epi(f32x4 (&acc)[2][2][4][2], int u, const int wv_) const {
        const bool isq = u < 576; const int w_ = isq ? u : u - 576; const int mt = w_ >> 1, nt = w_ & 1;
        bf16_t* RAW = (bf16_t*)(p.ws + (isq ? WS_RAWQ : WS_RAWKV));
        EPI_FOR8(acc, { store_bf16x8(RAW + (size_t)(mt * 256 + lr) * 512 + nt * 256 + lc, v0, v1); });
    }
};
DI void phase_A(const Params& p, LAS char* shm, int l, const int wv_) {
    { PvS5State pv{p, l}; gemm_stream(shm, pv, wv_); }
    { PvQKV pv{p, l}; gemm_stream(shm, pv, wv_); }
    for (int u = first_unit(80 + 1152); u < 1152; u += gridDim.x) pre_unit(p, shm, l, u, wv_);
}

DI void qkvpost_unit(const Params& p, LAS char* shm, int l, int unit, const int wv_) {
    const int tid = otid(), wid = tid >> 6, lane = tid & 63;
    const bf16_t* P = (const bf16_t*)(p.ws + WS_P);
    const bf16_t* RAWQ = (const bf16_t*)(p.ws + WS_RAWQ);
    const bf16_t* RAWKV = (const bf16_t*)(p.ws + WS_RAWKV);
    bf16_t* Q = (bf16_t*)(p.ws + WS_Q);
    bf16_t* KB = (bf16_t*)(p.ws + WS_KB);
    bf16_t* VT = (bf16_t*)(p.ws + WS_VT);
    LAS bf16_t* vt = (LAS bf16_t*)shm;
    const int row0 = unit * 64;
    const bool lat = row0 < TX;
    const int b = lat ? (row0 >> 11) : ((row0 - TX) >> 8);
    const int key0 = lat ? (row0 & 2047) : 2048 + ((row0 - TX) & 255);
    const int head = lane >> 4, sub = lane & 15;
    const float lninv = -9.210340371976184f / 8.f;
    const float frq = __expf(lninv * (float)(sub & 7));
    float qg[6], kg[6];
#pragma unroll
    for (int j = 0; j < 6; ++j) { qg[j] = p.mla_q_g[l * 96 + sub + 16 * j] * 0.14724444674085666f; kg[j] = p.mla_k_g[l * 96 + sub + 16 * j]; }
    constexpr int NB = 4;
    for (int tk0 = wid * 8; tk0 < wid * 8 + 8; tk0 += NB) {
        float pq[NB][3], pkv[NB][2], qr[NB][6], kr[NB][6], vr[NB][4];
#pragma unroll
        for (int i = 0; i < NB; ++i) { const int r = row0 + tk0 + i; const bf16_t* pr = P + (size_t)r * NINP;
#pragma unroll
            for (int j = 0; j < 3; ++j) pq[i][j] = bf2f(pr[OFF_Q + lane + 64 * j]);
#pragma unroll
            for (int j = 0; j < 2; ++j) pkv[i][j] = bf2f(pr[OFF_KV + lane + 64 * j]);
#pragma unroll
            for (int j = 0; j < 6; ++j) qr[i][j] = bf2f(RAWQ[(size_t)r * 512 + head * 96 + sub + 16 * j]);
#pragma unroll
            for (int j = 0; j < 4; ++j) kr[i][j] = bf2f(RAWKV[(size_t)r * 512 + head * 128 + sub + 16 * j]);
#pragma unroll
            for (int j = 4; j < 6; ++j) kr[i][j] = bf2f(pr[OFF_KPE + sub + 16 * (j - 4)]);
#pragma unroll
            for (int j = 0; j < 4; ++j) vr[i][j] = bf2f(RAWKV[(size_t)r * 512 + head * 128 + 64 + sub + 16 * j]); }
        float red[2 * NB];
#pragma unroll
        for (int i = 0; i < NB; ++i) { red[2 * i] = pq[i][0] * pq[i][0] + pq[i][1] * pq[i][1] + pq[i][2] * pq[i][2]; red[2 * i + 1] = pkv[i][0] * pkv[i][0] + pkv[i][1] * pkv[i][1]; }
        wave_sum_n<2 * NB>(red);
        float ssq[2 * NB];
#pragma unroll
        for (int i = 0; i < NB; ++i) {
            const float rq = rsqrtf(red[2 * i] * (1.f / 192.f) + EPS), rkv = rsqrtf(red[2 * i + 1] * (1.f / 128.f) + EPS);
            float s0 = 0.f, s1 = 0.f;
#pragma unroll
            for (int j = 0; j < 6; ++j) { qr[i][j] *= rq; s0 += qr[i][j] * qr[i][j]; }
#pragma unroll
            for (int j = 0; j < 4; ++j) { kr[i][j] *= rkv; s1 += kr[i][j] * kr[i][j]; }
#pragma unroll
            for (int j = 4; j < 6; ++j) s1 += kr[i][j] * kr[i][j];
#pragma unroll
            for (int j = 0; j < 4; ++j) vr[i][j] *= rkv;
            ssq[2 * i] = s0; ssq[2 * i + 1] = s1;
        }
        { const int l4 = olane();
#pragma unroll
          for (int o = 8; o > 0; o >>= 1) { float t_[2 * NB];
#pragma unroll
              for (int i = 0; i < 2 * NB; ++i) t_[i] = __int_as_float(__builtin_amdgcn_ds_bpermute((l4 ^ o) << 2, __float_as_int(ssq[i])));
#pragma unroll
              for (int i = 0; i < 2 * NB; ++i) ssq[i] += t_[i]; } }
#pragma unroll
        for (int i = 0; i < NB; ++i) {
            const int tk = tk0 + i, r = row0 + tk;
            const float rnq = rsqrtf(ssq[2 * i] * (1.f / 96.f) + EPS), rnk = rsqrtf(ssq[2 * i + 1] * (1.f / 96.f) + EPS);
#pragma unroll
            for (int j = 0; j < 6; ++j) { qr[i][j] *= rnq * qg[j]; kr[i][j] *= rnk * kg[j]; }
            if (lat) {
                const int tseq = r & 2047; const float a0 = (float)(tseq >> 6) * frq, a1 = (float)(tseq & 63) * frq;
                const float cs0 = __cosf(a0), sn0 = __sinf(a0), cs1 = __cosf(a1), sn1 = __sinf(a1);
                const float oq4 = shx(qr[i][4], 8), oq5 = shx(qr[i][5], 8), ok4 = shx(kr[i][4], 8), ok5 = shx(kr[i][5], 8);
                const float sg = (sub < 8) ? -1.f : 1.f;
                qr[i][4] = qr[i][4] * cs0 + sg * oq4 * sn0; qr[i][5] = qr[i][5] * cs1 + sg * oq5 * sn1;
                kr[i][4] = kr[i][4] * cs0 + sg * ok4 * sn0; kr[i][5] = kr[i][5] * cs1 + sg * ok5 * sn1;
            }
            bf16_t* kro = KB + ((size_t)(b * 4 + head) * 2304 + key0 + tk) * 96;
#pragma unroll
            for (int j = 0; j < 6; ++j) { Q[(size_t)r * 384 + head * 96 + sub + 16 * j] = f2bf(qr[i][j]); kro[sub + 16 * j] = f2bf(kr[i][j]); }
#pragma unroll
            for (int j = 0; j < 4; ++j) vt[(head * 64 + sub + 16 * j) * 72 + tk] = f2bf(vr[i][j]);
        }
    }
    __syncthreads();
    { const int hv = tid >> 1, hf = tid & 1;
      bf16_t* dst = VT + ((size_t)(b * 4 + (hv >> 6)) * 64 + (hv & 63)) * 2304 + key0 + hf * 32;
#pragma unroll
      for (int i = 0; i < 4; ++i) *(u32x4*)(dst + i * 8) = *(const LAS u32x4*)(vt + hv * 72 + hf * 32 + i * 8); }
    __syncthreads();
}
DI void s5carry_unit(const Params& p, int l, int unit, const int wv_) {
    const int gid = unit * 512 + otid();
    const int q = gid & 63, dir = (gid >> 6) & 1, g = (gid >> 7) & 15, b = gid >> 11;
    const float* A64 = (const float*)(p.ws + WS_A64) + (size_t)(((l * 2 + dir) * 16 + g) * 64 + q) * 2;
    const float ar = A64[0], ai = A64[1];
    const float* SST = (const float*)(p.ws + WS_SST);
    bf16_t* HIN = (bf16_t*)(p.ws + WS_HIN);
    float sr[NCH], si[NCH];
#pragma unroll
    for (int s = 0; s < NCH; ++s) { const int j = dir == 0 ? s : (s < 4 ? 3 - s : 39 - s);
        const size_t base = ((size_t)(b * NCH + j) * 16 + g) * 256 + dir * 128 + q; sr[s] = SST[base]; si[s] = SST[base + 64]; }
    float hr = 0.f, hi = 0.f;
#pragma unroll
    for (int s = 0; s < NCH; ++s) {
        const int j = dir == 0 ? s : (s < 4 ? 3 - s : 39 - s);
        const size_t base = ((size_t)(b * NCH + j) * 16 + g) * 256 + dir * 128 + q;
        HIN[base] = f2bf(hr); HIN[base + 64] = f2bf(hi);
        const float nr = ar * hr - ai * hi + sr[s], ni = ar * hi + ai * hr + si[s];
        hr = nr; hi = ni;
    }
}
struct PvConvPool {
    const Params& p; int l;
    static constexpr int NT = 4; static constexpr int FP8 = 0; static constexpr bool PARK = false; typedef APlain AS; typedef BSimple BS;
    DI int first() const { return lin_first(0, 576); }
    DI int next(int u) const { return lin_next(u, 576); }
    DI void src(int u, AS& a, BS& b, const int wv_) const {
        const bool isconv = u < 288; const int mt = isconv ? u : u - 288;
        a = make_a_plain((const bf16_t*)(p.ws + (isconv ? WS_ACONV : WS_APOOL)), (size_t)mt * 256, 256, 0);
        const bf16_t* W = (const bf16_t*)(p.ws + (isconv ? WS_WPW : WS_WPOOL)) + (size_t)l * 65536;
        b = make_b(W, W + (size_t)128 * 256, 256);
    }
    DI void epi(f32x4 (&acc)[2][2][4][2], int u, const int wv_) const {
        const bool isconv = u < 288; const int mt = isconv ? u : u - 288;
        bf16_t* CAT = (bf16_t*)(p.ws + WS_CAT);
        if (isconv) { EPI_FOR8(acc, { store_bf16x8(CAT + (size_t)(mt * 256 + lr) * 1024 + lc, v0, v1); }); }
        else { const int t_ = otid(), c0_ = ((t_ >> 6) & 3) * 32 + ((t_ & 63) >> 4) * 8; f32x4 sc_[2][2];
#pragma unroll
               for (int bj = 0; bj < 2; ++bj)
#pragma unroll
                   for (int n = 0; n < 2; ++n) sc_[bj][n] = *(const f32x4*)(p.pool_scale + l * 256 + bj * 128 + n * 4 + c0_);
               EPI_FOR8(acc, { store_bf16x8(CAT + (size_t)(mt * 256 + lr) * 1024 + 256 + lc, v0 * sc_[bj][0], v1 * sc_[bj][1]); }); }
    }
};
DI void phase_B(const Params& p, LAS char* shm, int l, const int wv_) {
    { PvConvPool pv{p, l}; gemm_stream(shm, pv, wv_); }
    const int n_post = TT / 64, n_carry = 128;
    for (int u = first_unit(576); u < n_post + n_carry; u += gridDim.x) {
        if (u < n_post) qkvpost_unit(p, shm, l, u, wv_);
        else s5carry_unit(p, l, u - n_post, wv_);
    }
}

DI void attn_unit(const Params& p, LAS char* shm, int l, int b, int h, int qrow0, int nq, int key_lo, int nkeys, const int wv_) {
    const int tid = otid(), wid = tid >> 6, lane = tid & 63, l31 = lane & 31, hh = lane >> 5;
    const bf16_t* Q = (const bf16_t*)(p.ws + WS_Q);
    const bf16_t* KBp = (const bf16_t*)(p.ws + WS_KB) + (size_t)(b * 4 + h) * 2304 * 96;
    const bf16_t* VTp = (const bf16_t*)(p.ws + WS_VT) + (size_t)(b * 4 + h) * 64 * 2304;
    bf16_t* CAT = (bf16_t*)(p.ws + WS_CAT);
    LAS char* kl = shm;
    LAS char* vl = shm + 13312;
    const bool active = wid * 64 < nq;
    float gq = 0.f, gk = 0.f;
    for (int i = lane; i < 96; i += 64) { gq = fmaxf(gq, fabsf(p.mla_q_g[l * 96 + i])); gk = fmaxf(gk, fabsf(p.mla_k_g[l * 96 + i])); }
    gq = wave_max(gq); gk = wave_max(gk);
    const float LOG2E = 1.4426950408889634f;
    const float c2 = 9.797958971132712f * gq * gk * LOG2E;
    const float sh2 = fmaxf(c2 - 64.f, 0.f);
    bf16x8 qf[2][6];
    if (active) {
#pragma unroll
        for (int qb = 0; qb < 2; ++qb)
#pragma unroll
            for (int ks = 0; ks < 6; ++ks) qf[qb][ks] = *(const bf16x8*)(Q + (size_t)(qrow0 + wid * 64 + qb * 32 + l31) * 384 + h * 96 + ks * 16 + hh * 8);
    }
    f32x16 O[2][2];
#pragma unroll
    for (int a = 0; a < 2; ++a)
#pragma unroll
        for (int c = 0; c < 2; ++c)
#pragma unroll
            for (int i = 0; i < 16; ++i) O[a][c][i] = 0.f;
    float lsum[2] = {0.f, 0.f};
    const int ntile = nkeys / 64;
    u32x4 kreg0, kreg1, vreg;
    auto load_tile = [&](int t) {
        const int key = key_lo + t * 64;
        { const int id = tid, kr = id / 12, part = id % 12; kreg0 = *(const u32x4*)(KBp + (size_t)(key + kr) * 96 + part * 8); }
        if (tid < 256) { const int id = tid + 512, kr = id / 12, part = id % 12; kreg1 = *(const u32x4*)(KBp + (size_t)(key + kr) * 96 + part * 8); }
        { const int vd = tid >> 3, part = tid & 7; vreg = *(const u32x4*)(VTp + (size_t)vd * 2304 + key + part * 8); }
    };
    auto write_tile = [&]() {
        { const int id = tid, kr = id / 12, part = id % 12; *(LAS u32x4*)(kl + kr * 208 + part * 16) = kreg0; }
        if (tid < 256) { const int id = tid + 512, kr = id / 12, part = id % 12; *(LAS u32x4*)(kl + kr * 208 + part * 16) = kreg1; }
        { const int vd = tid >> 3, part = tid & 7; *(LAS u32x4*)(vl + vd * 144 + part * 16) = vreg; }
    };
    load_tile(0);
    for (int t = 0; t < ntile; ++t) {
        __syncthreads();
        write_tile();
        __syncthreads();
        if (t + 1 < ntile) load_tile(t + 1);
        if (active) {
#pragma unroll
            for (int kb = 0; kb < 2; ++kb) {
                f32x16 S[2];
#pragma unroll
                for (int qb = 0; qb < 2; ++qb)
#pragma unroll
                    for (int i = 0; i < 16; ++i) S[qb][i] = 0.f;
#pragma unroll
                for (int ks = 0; ks < 6; ++ks) {
                    const bf16x8 a = *(const LAS bf16x8*)(kl + (kb * 32 + l31) * 208 + ks * 32 + hh * 16);
#pragma unroll
                    for (int qb = 0; qb < 2; ++qb) S[qb] = __builtin_amdgcn_mfma_f32_32x32x16_bf16(a, qf[qb][ks], S[qb], 0, 0, 0);
                }
                bf16x8 pf[2][2];
#pragma unroll
                for (int qb = 0; qb < 2; ++qb) {
                    float e[16];
#pragma unroll
                    for (int i = 0; i < 16; ++i) { e[i] = __builtin_amdgcn_exp2f(S[qb][i] - sh2); lsum[qb] += e[i]; }
#pragma unroll
                    for (int s = 0; s < 2; ++s) { u32x4 w; w.x = pk_bf16(e[8 * s], e[8 * s + 1]); w.y = pk_bf16(e[8 * s + 2], e[8 * s + 3]); w.z = pk_bf16(e[8 * s + 4], e[8 * s + 5]); w.w = pk_bf16(e[8 * s + 6], e[8 * s + 7]);
                        pf[qb][s] = __builtin_bit_cast(bf16x8, w); }
                }
#pragma unroll
                for (int s = 0; s < 2; ++s) {
                    const int kk = kb * 2 + s;
#pragma unroll
                    for (int vb = 0; vb < 2; ++vb) {
                        const s16x4 lo = *(const LAS s16x4*)(vl + (vb * 32 + l31) * 144 + (16 * kk + 4 * hh) * 2);
                        const s16x4 hi = *(const LAS s16x4*)(vl + (vb * 32 + l31) * 144 + (16 * kk + 8 + 4 * hh) * 2);
                        const bf16x8 va = __builtin_shufflevector(lo, hi, 0, 1, 2, 3, 4, 5, 6, 7);
#pragma unroll
                        for (int qb = 0; qb < 2; ++qb) O[vb][qb] = __builtin_amdgcn_mfma_f32_32x32x16_bf16(va, pf[qb][s], O[vb][qb], 0, 0, 0);
                    }
                }
            }
        }
    }
    if (active) {
#pragma unroll
        for (int qb = 0; qb < 2; ++qb) {
            const float tot = lsum[qb] + shx(lsum[qb], 32);
            const float inv = 1.f / tot;
            bf16_t* orow = CAT + (size_t)(qrow0 + wid * 64 + qb * 32 + l31) * 1024 + 768 + h * 64;
#pragma unroll
            for (int vb = 0; vb < 2; ++vb)
#pragma unroll
                for (int i4 = 0; i4 < 4; ++i4)
                    store_bf16x4(orow + vb * 32 + 8 * i4 + 4 * hh, O[vb][qb][4 * i4] * inv, O[vb][qb][4 * i4 + 1] * inv, O[vb][qb][4 * i4 + 2] * inv, O[vb][qb][4 * i4 + 3] * inv);
        }
    }
    __syncthreads();
}
struct PvS5Out {
    const Params& p; int l;
    static constexpr int NT = 20; static constexpr int FP8 = 0; static constexpr bool PARK = false; typedef ASeg2 AS; typedef BSimple BS;
    DI int first() const { return lin_first(512, 320); }
    DI int next(int u) const { return lin_next(u, 320); }
    DI void src(int u, AS& as, BS& bs, const int wv_) const {
        const int ntile = u & 3, mt = (u >> 2) % 5, g = u / 20;
        int R[2], C[2]; stage_coords(R, C, wv_);
        as.base0 = (const char*)(p.ws + WS_P); as.base1 = (const char*)(p.ws + WS_HIN); as.ks0 = 4 * NINP * 2; as.nt0 = 16;
#pragma unroll
        for (int h = 0; h < 2; ++h)
#pragma unroll
            for (int i = 0; i < 2; ++i) { const int cr = min(mt * 256 + h * 128 + R[i], NCROW - 1);
                as.off0[h][i] = (unsigned)(((size_t)(crow_tok(cr) + (C[i] >> 4)) * NINP + OFF_SSM + g * 16 + (C[i] & 15)) * 2);
                as.off1[h][i] = (unsigned)((((size_t)cr * 16 + g) * 256 + C[i]) * 2); }
        const bf16_t* W = (const bf16_t*)(p.ws + WS_TS5) + ((size_t)(l * 16 + g) * 1024 + ntile * 256) * 1280;
        bs = make_b(W, W + (size_t)128 * 1280, 1280);
    }
    DI void epi(f32x4 (&acc)[2][2][4][2], int u, const int wv_) const {
        const int ntile = u & 3, mt = (u >> 2) % 5, g = u / 20;
        bf16_t* Z = (bf16_t*)(p.ws + WS_Z);
        EPI_FOR8(acc, { const int cr = mt * 256 + lr; if (cr < NCROW) { const int col = ntile * 256 + lc, t = col >> 4, co = col & 15;
            const f32x4 g0 = (f32x4){gelu_tanh(v0[0]), gelu_tanh(v0[1]), gelu_tanh(v0[2]), gelu_tanh(v0[3])}, g1_ = (f32x4){gelu_tanh(v1[0]), gelu_tanh(v1[1]), gelu_tanh(v1[2]), gelu_tanh(v1[3])};
            store_bf16x8(Z + (size_t)(crow_tok(cr) + t) * 256 + g * 16 + co, g0, g1_); } });
    }
};
DI void phase_C(const Params& p, LAS char* shm, int l, const int wv_) {
    for (int u = blockIdx.x; u < 512; u += gridDim.x) { const int qb = u & 3, h = (u >> 2) & 3, b = u >> 4;
        attn_unit(p, shm, l, b, h, b * SEQ + qb * 512, 512, 0, 2304, wv_); }
    { PvS5Out pv{p, l}; gemm_stream(shm, pv, wv_); }
    if (l == 0) for (int u = first_unit(512 + 320); u < 128; u += gridDim.x) { const int h = u & 3, b = u >> 2;
        attn_unit(p, shm, l, b, h, TX + b * CTXL, 256, 2048, 256, wv_); }
}

struct PvGlu {
    const Params& p; int l;
    static constexpr int NT = 4; static constexpr int FP8 = 0; static constexpr bool PARK = false; typedef APlain AS; typedef BSimple BS;
    DI int first() const { return lin_first(0, 288); }
    DI int next(int u) const { return lin_next(u, 288); }
    DI void src(int u, AS& a, BS& b, const int wv_) const {
        a = make_a_plain((const bf16_t*)(p.ws + WS_Z), (size_t)u * 256, 256, 0);
        const bf16_t* W = (const bf16_t*)(p.ws + WS_WGLU) + (size_t)l * 65536;
        b = make_b(W, W + (size_t)128 * 256, 256);
    }
    DI void epi(f32x4 (&acc)[2][2][4][2], int u, const int wv_) const {
        const bf16_t* Z = (const bf16_t*)(p.ws + WS_Z); bf16_t* CAT = (bf16_t*)(p.ws + WS_CAT);
        const int _tz = otid(), _w = _tz >> 6, _l = _tz & 63, _wr = _w >> 2, _wc = _w & 3, _fr = _l & 15, _fq = _l >> 4;
        const int c0 = _wc * 32 + _fq * 8;
        f32x4 bsv[2][2];
#pragma unroll
        for (int bj = 0; bj < 2; ++bj)
#pragma unroll
            for (int n = 0; n < 2; ++n) bsv[bj][n] = *(const f32x4*)(p.ssm_glu_b + l * 256 + bj * 128 + n * 4 + c0);
#pragma unroll
        for (int ai = 0; ai < 2; ++ai) {
            u32x4 zz[4][2];
#pragma unroll
            for (int m = 0; m < 4; ++m)
#pragma unroll
                for (int bj = 0; bj < 2; ++bj) zz[m][bj] = *(const u32x4*)(Z + (size_t)(u * 256 + ai * 128 + _wr * 64 + m * 16 + _fr) * 256 + bj * 128 + c0);
#pragma unroll
            for (int m = 0; m < 4; ++m) { const size_t r = (size_t)(u * 256 + ai * 128 + _wr * 64 + m * 16 + _fr);
#pragma unroll
                for (int bj = 0; bj < 2; ++bj) { const f32x4 a0 = acc[ai][bj][m][0], a1 = acc[ai][bj][m][1]; const f32x4 b0 = bsv[bj][0], b1 = bsv[bj][1]; const u32x4 z_ = zz[m][bj];
                    const f32x4 o0 = (f32x4){bflo(z_.x) * sigmoidf_(a0[0] + b0[0]), bfhi(z_.x) * sigmoidf_(a0[1] + b0[1]), bflo(z_.y) * sigmoidf_(a0[2] + b0[2]), bfhi(z_.y) * sigmoidf_(a0[3] + b0[3])};
                    const f32x4 o1 = (f32x4){bflo(z_.z) * sigmoidf_(a1[0] + b1[0]), bfhi(z_.z) * sigmoidf_(a1[1] + b1[1]), bflo(z_.w) * sigmoidf_(a1[2] + b1[2]), bfhi(z_.w) * sigmoidf_(a1[3] + b1[3])};
                    store_bf16x8(CAT + r * 1024 + 512 + bj * 128 + c0, o0, o1); } }
        }
    }
};
DI void phase_D(const Params& p, LAS char* shm, int l, const int wv_) {
    PvGlu pv{p, l}; gemm_stream(shm, pv, wv_);
}

struct PvOutproj {
    const Params& p; int l;
    static constexpr int NT = 16; static constexpr int FP8 = 0; static constexpr bool PARK = false; typedef APlain AS; typedef BSimple BS;
    XcdDeal<4, 4> deal;
    DI int first() const { return deal.first(); }
    DI int next(int u) const { return deal.next(u); }
    DI void src(int u, AS& a, BS& b, const int wv_) const {
        int mt, nt; deal.decode(u, mt, nt);
        const bf16_t* W = (const bf16_t*)(p.ws + WS_WMO) + (size_t)l * 1024 * 1024;
        a = make_a_plain((const bf16_t*)(p.ws + WS_CAT), (size_t)mt * 256, 1024, 0);
        b = make_b(W + (size_t)(nt * 256) * 1024, W + (size_t)(nt * 256 + 128) * 1024, 1024);
    }
    DI void epi(f32x4 (&acc)[2][2][4][2], int u, const int wv_) const {
        int mt, nt; deal.decode(u, mt, nt);
        bf16_t* X = (bf16_t*)(p.ws + WS_X);
        const float* MOD = (const float*)(p.ws + WS_MOD) + (size_t)l * 33 * 6144;
        const int _tz = otid(), _w = _tz >> 6, _l = _tz & 63, _wr = _w >> 2, _wc = _w & 3, _fr = _l & 15, _fq = _l >> 4;
        const int c0 = nt * 256 + _wc * 32 + _fq * 8;
        const int row0 = mt * 256;
        const float* g1p = MOD + (size_t)mod_row(row0) * 6144 + 2048 + c0;
        f32x4 g1[2][2];
#pragma unroll
        for (int bj = 0; bj < 2; ++bj)
#pragma unroll
            for (int n = 0; n < 2; ++n) g1[bj][n] = *(const f32x4*)(g1p + bj * 128 + n * 4);
        bf16_t* obase = X + (size_t)row0 * 1024;
        if (l == 0) {
            const float* xbase = row0 < TX ? p.x + (size_t)row0 * 1024 : p.ctx + (size_t)(row0 - TX) * 1024;
#pragma unroll
            for (int ai = 0; ai < 2; ++ai)
#pragma unroll
                for (int mp = 0; mp < 2; ++mp) {
                    f32x4 xv[2][2][2];
#pragma unroll
                    for (int mm = 0; mm < 2; ++mm)
#pragma unroll
                        for (int bj = 0; bj < 2; ++bj)
#pragma unroll
                            for (int n = 0; n < 2; ++n) xv[mm][bj][n] = *(const f32x4*)(xbase + (size_t)(ai * 128 + _wr * 64 + (mp * 2 + mm) * 16 + _fr) * 1024 + c0 + bj * 128 + n * 4);
#pragma unroll
                    for (int mm = 0; mm < 2; ++mm)
#pragma unroll
                        for (int bj = 0; bj < 2; ++bj)
                            store_bf16x8(obase + (size_t)(ai * 128 + _wr * 64 + (mp * 2 + mm) * 16 + _fr) * 1024 + c0 + bj * 128,
                                         xv[mm][bj][0] + g1[bj][0] * acc[ai][bj][mp * 2 + mm][0], xv[mm][bj][1] + g1[bj][1] * acc[ai][bj][mp * 2 + mm][1]);
                }
        } else {
#pragma unroll
            for (int ai = 0; ai < 2; ++ai) {
                u32x4 xv[4][2];
#pragma unroll
                for (int m = 0; m < 4; ++m)
#pragma unroll
                    for (int bj = 0; bj < 2; ++bj) xv[m][bj] = *(const u32x4*)(obase + (size_t)(ai * 128 + _wr * 64 + m * 16 + _fr) * 1024 + c0 + bj * 128);
#pragma unroll
                for (int m = 0; m < 4; ++m)
#pragma unroll
                    for (int bj = 0; bj < 2; ++bj) { const u32x4 x_ = xv[m][bj];
                        const f32x4 x0 = (f32x4){bflo(x_.x), bfhi(x_.x), bflo(x_.y), bfhi(x_.y)}, x1 = (f32x4){bflo(x_.z), bfhi(x_.z), bflo(x_.w), bfhi(x_.w)};
                        store_bf16x8(obase + (size_t)(ai * 128 + _wr * 64 + m * 16 + _fr) * 1024 + c0 + bj * 128, x0 + g1[bj][0] * acc[ai][bj][m][0], x1 + g1[bj][1] * acc[ai][bj][m][1]); }
            }
        }
    }
};
DI void phase_E(const Params& p, LAS char* shm, int l, const int wv_) {
    PvOutproj pv{p, l, {(l == 1 ? TX : TT) / 256}}; gemm_stream(shm, pv, wv_);
}

template <int S> DI float row_rot_f(float v) { return __int_as_float(__builtin_amdgcn_update_dpp(0, __float_as_int(v), 0x120 | S, 0xf, 0xf, false)); }
template <int S> DI int row_rot_i(int v) { return __builtin_amdgcn_update_dpp(0, v, 0x120 | S, 0xf, 0xf, false); }
template <int S> struct RankAcc {
    static DI void run(float o0, float o1, int oe, float v0, float v1, int e0, int& r0, int& r1) {
        const float a0 = S ? row_rot_f<S>(o0) : o0, a1 = S ? row_rot_f<S>(o1) : o1; const int ae = S ? row_rot_i<S>(oe) : oe;
        r0 += (a0 > v0 || (a0 == v0 && ae < e0)) ? 1 : 0;
        r0 += (a1 > v0) ? 1 : 0;
        r1 += (a0 > v1 || a0 == v1) ? 1 : 0;
        r1 += (a1 > v1 || (a1 == v1 && ae < e0)) ? 1 : 0;
        RankAcc<S + 1>::run(o0, o1, oe, v0, v1, e0, r0, r1);
    }
};
template <> struct RankAcc<16> { static DI void run(float, float, int, float, float, int, int&, int&) {} };
DI float row_sum16(float v) { v += row_rot_f<8>(v); v += row_rot_f<4>(v); v += row_rot_f<2>(v); v += row_rot_f<1>(v); return v; }
DI float row_max16(float v) { v = fmaxf(v, row_rot_f<8>(v)); v = fmaxf(v, row_rot_f<4>(v)); v = fmaxf(v, row_rot_f<2>(v)); v = fmaxf(v, row_rot_f<1>(v)); return v; }

DI void phase_router(const Params& p, LAS char* shm, int l, const int wv_) {
    const int tid = otid(), wid = tid >> 6, lane = tid & 63;
    const int Tm = (l == 1) ? TX : TT;
    const bf16_t* X = (const bf16_t*)(p.ws + WS_X);
    const float* MOD = (const float*)(p.ws + WS_MOD) + (size_t)l * 33 * 6144;
    unsigned char* H8 = (unsigned char*)(p.ws + WS_H);
    const bool alt = p.ph_lo != 0;
    int* CNT = (int*)(p.ws + WS_CNT) + l * 32 + (alt ? 64 : 0);
    int* LIST = alt ? (int*)(p.ws + WS_RY) : (int*)(p.ws + WS_LIST);
    LAS char* wfr = shm;
    LAS bf16_t* gml = (LAS bf16_t*)(shm + 131072);
    LAS bf16_t* shl = gml + 1024;
    LAS float* cvec = (LAS float*)(shm + 131072 + 4096);
    LAS int* lcnt = (LAS int*)(cvec + 32);
    LAS int* lbase = lcnt + 32;
    LAS unsigned* lrec = (LAS unsigned*)(lbase + 32);
    LAS float* lwt = (LAS float*)(lrec + 1152);
    const int tpw = (Tm + gridDim.x - 1) / gridDim.x;
    const int tbeg = blockIdx.x * tpw, tend = min(tbeg + tpw, Tm);
    if (tid < 32) lcnt[tid] = 0;
    int seg_beg = tbeg;
    while (seg_beg < tend) {
        const int mrow = mod_row(seg_beg);
        int seg_end = tend;
        if (mrow < 32) seg_end = min(tend, (mrow + 1) * SEQ); else seg_end = tend;
        const float* mr = MOD + (size_t)mrow * 6144;
        __syncthreads();
        for (int k = tid; k < 1024; k += 512) { const float gmv = p.norm2_g[l * 1024 + k] * (1.f + mr[4096 + k]); gml[k] = f2bf(gmv); shl[k] = f2bf(mr[3072 + k]); }
        for (int i = tid; i < 1024 * 8; i += 512) {
            const int k = i >> 3, e4 = (i & 7) * 4;
            const float gmv = p.norm2_g[l * 1024 + k] * (1.f + mr[4096 + k]);
            const f32x4 w = *(const f32x4*)(p.router_w + (size_t)l * 32768 + k * 32 + e4);
            const int ks = k >> 5, kq = (k >> 3) & 3, j = k & 7;
#pragma unroll
            for (int c = 0; c < 4; ++c) { const int e = e4 + c, nb = e >> 4, ei = e & 15; const float wv = w[c] * gmv;
                const bf16_t hi = f2bf(wv); const bf16_t lo = f2bf(wv - bf2f(hi));
                LAS bf16_t* dst = (LAS bf16_t*)(wfr + ((size_t)((ks * 2 + nb) * 2) * 64 + (kq * 16 + ei)) * 16) + j;
                dst[0] = hi; dst[64 * 8] = lo; }
        }
        {
            float s4[4] = {0.f, 0.f, 0.f, 0.f};
            for (int k = lane; k < 1024; k += 64) { const float shv = mr[3072 + k]; const f32x4 w = *(const f32x4*)(p.router_w + (size_t)l * 32768 + k * 32 + wid * 4);
                s4[0] += shv * w[0]; s4[1] += shv * w[1]; s4[2] += shv * w[2]; s4[3] += shv * w[3]; }
#pragma unroll
            for (int c = 0; c < 4; ++c) { const float t_ = wave_sum(s4[c]); if (lane == 0) cvec[wid * 4 + c] = t_ + p.router_b[l * 32 + wid * 4 + c]; }
        }
        __syncthreads();
        const int ngroups = (seg_end - seg_beg) >> 4;
        for (int gi = wid; gi < ngroups; gi += 8) {
            const int t0 = seg_beg + gi * 16;
            const int tok = lane & 15, kq = lane >> 4;
            const bf16_t* xr = X + (size_t)(t0 + tok) * 1024 + kq * 8;
            f32x4 acc0 = {0.f, 0.f, 0.f, 0.f}, acc1 = {0.f, 0.f, 0.f, 0.f};
            float ss = 0.f;
#pragma unroll 8
            for (int ks = 0; ks < 32; ++ks) {
                const u32x4 xh = *(const u32x4*)(xr + ks * 32);
                const float x0 = bflo(xh.x), x1 = bfhi(xh.x), x2 = bflo(xh.y), x3 = bfhi(xh.y), x4 = bflo(xh.z), x5 = bfhi(xh.z), x6 = bflo(xh.w), x7 = bfhi(xh.w);
                ss += x0 * x0 + x1 * x1 + x2 * x2 + x3 * x3 + x4 * x4 + x5 * x5 + x6 * x6 + x7 * x7;
                const bf16x8 ah = __builtin_bit_cast(bf16x8, xh);
                const LAS char* wb = wfr + (size_t)(ks * 4) * 1024 + lane * 16;
                const bf16x8 b0h = *(const LAS bf16x8*)(wb), b0l = *(const LAS bf16x8*)(wb + 1024), b1h = *(const LAS bf16x8*)(wb + 2048), b1l = *(const LAS bf16x8*)(wb + 3072);
                acc0 = __builtin_amdgcn_mfma_f32_16x16x32_bf16(ah, b0h, acc0, 0, 0, 0); acc0 = __builtin_amdgcn_mfma_f32_16x16x32_bf16(ah, b0l, acc0, 0, 0, 0);
                acc1 = __builtin_amdgcn_mfma_f32_16x16x32_bf16(ah, b1h, acc1, 0, 0, 0); acc1 = __builtin_amdgcn_mfma_f32_16x16x32_bf16(ah, b1l, acc1, 0, 0, 0);
            }
            ss += shx(ss, 16); ss += shx(ss, 32);
            const float rn = rsqrtf(ss * (1.f / 1024.f) + EPS);
            const int ei = lane & 15;
            const float c0v = cvec[ei], c1v = cvec[16 + ei];
#pragma unroll
            for (int r = 0; r < 4; ++r) {
                const int tl = (lane >> 4) * 4 + r;
                const float rnt = shi(rn, tl);
                float v0 = fminf(fmaxf(acc0[r] * rnt + c0v, -1e30f), 1e30f), v1 = fminf(fmaxf(acc1[r] * rnt + c1v, -1e30f), 1e30f);
                int r0 = 0, r1 = 0;
                RankAcc<0>::run(v0, v1, ei, v0, v1, ei, r0, r1);
                const float mx = row_max16(fmaxf(v0, v1));
                const bool s0 = r0 < 4, s1 = r1 < 4;
                const float e0 = s0 ? __expf(v0 - mx) : 0.f, e1 = s1 ? __expf(v1 - mx) : 0.f;
                const float inv = 1.f / row_sum16(e0 + e1);
                const int t = t0 + tl;
                if (s0) { const int pos = atomicAdd((int*)&lcnt[ei], 1); lrec[(t - tbeg) * 4 + r0] = (unsigned)ei | ((unsigned)pos << 8); lwt[(t - tbeg) * 4 + r0] = e0 * inv; }
                if (s1) { const int pos = atomicAdd((int*)&lcnt[16 + ei], 1); lrec[(t - tbeg) * 4 + r1] = (unsigned)(16 + ei) | ((unsigned)pos << 8); lwt[(t - tbeg) * 4 + r1] = e1 * inv; }
            }
            unsigned char* hr = H8 + (size_t)(t0 + tok) * 1024 + kq * 8;
#pragma unroll 8
            for (int ks = 0; ks < 32; ++ks) {
                const u32x4 xh = *(const u32x4*)(xr + ks * 32);
                const u32x4 gq = *(const LAS u32x4*)(gml + ks * 32 + kq * 8), sq = *(const LAS u32x4*)(shl + ks * 32 + kq * 8);
                float h[8];
                h[0] = bflo(xh.x) * rn * bflo(gq.x) + bflo(sq.x); h[1] = bfhi(xh.x) * rn * bfhi(gq.x) + bfhi(sq.x); h[2] = bflo(xh.y) * rn * bflo(gq.y) + bflo(sq.y); h[3] = bfhi(xh.y) * rn * bfhi(gq.y) + bfhi(sq.y);
                h[4] = bflo(xh.z) * rn * bflo(gq.z) + bflo(sq.z); h[5] = bfhi(xh.z) * rn * bfhi(gq.z) + bfhi(sq.z); h[6] = bflo(xh.w) * rn * bflo(gq.w) + bflo(sq.w); h[7] = bfhi(xh.w) * rn * bfhi(gq.w) + bfhi(sq.w);
#pragma unroll
                for (int i = 0; i < 8; ++i) h[i] = __builtin_amdgcn_fmed3f(h[i], -448.f, 448.f);
                u32x2 o; o.x = pk_fp8x4(h[0], h[1], h[2], h[3]); o.y = pk_fp8x4(h[4], h[5], h[6], h[7]);
                *(u32x2*)(hr + ks * 32) = o;
            }
        }
        seg_beg = seg_end;
    }
    __syncthreads();
    if (tid < 32) lbase[tid] = atomicAdd(&CNT[tid], lcnt[tid]);
    __syncthreads();
    for (int i = tid; i < (tend - tbeg) * 4; i += 512) { const unsigned rec = lrec[i]; const int e = rec & 255, pos = rec >> 8;
        u32x2 ent; ent.x = (unsigned)(tbeg * 4 + i); ent.y = __float_as_uint(lwt[i]);
        *(u32x2*)(LIST + ((size_t)e * TT + lbase[e] + pos) * 2) = ent; }
    __syncthreads();
}

DI void moe_tiles(const Params& p, LAS int* tstart, int l, const int wv_) {
    const int* CNT = (const int*)(p.ws + WS_CNT) + l * 32;
    if (otid() == 0) { int s = 0; for (int e = 0; e < 32; ++e) { tstart[e] = s; s += (CNT[e] + 255) >> 8; } tstart[32] = s; }
    __syncthreads();
}
DI int moe_find(const LAS int* tstart, int mt) { int e = 0;
#pragma unroll
    for (int i = 1; i < 32; ++i) e += (mt >= tstart[i]) ? 1 : 0;
    return e; }
struct PvMoe1 {
    const Params& p; int l; const LAS int* tstart;
    static constexpr int NT = 8; static constexpr int FP8 = 2; static constexpr bool PARK = false; typedef ASimple AS; typedef BSimple BS;
    XcdDeal<4, 8> deal;
    DI int first() const { return deal.first(); }
    DI int next(int u) const { return deal.next(u); }
    DI void src(int u, AS& as, BS& bs, const int wv_) const {
        int mt, n8; deal.decode(u, mt, n8);
        const int e = moe_find(tstart, mt);
        const int r0 = (mt - tstart[e]) * 256, cnt = ((const int*)(p.ws + WS_CNT))[l * 32 + e];
        const int* lst = (const int*)(p.ws + WS_LIST) + (size_t)e * TT * 2;
        int R[2], C[2]; stage_coords(R, C, wv_);
        as.base = (const char*)(p.ws + WS_H); as.kstride = 128;
#pragma unroll
        for (int h = 0; h < 2; ++h)
#pragma unroll
            for (int i = 0; i < 2; ++i) { const int slot = lst[2 * min(r0 + h * 128 + R[i], cnt - 1)]; as.off[h][i] = (unsigned)((size_t)(slot >> 2) * 1024 + C[i] * 2); }
        const char* W = (const char*)(p.ws + WS_W1) + (size_t)(l * NE + e) * 2048 * 1024;
        bs.base[0] = W + (size_t)(n8 * 128) * 1024; bs.base[1] = W + (size_t)(1024 + n8 * 128) * 1024; bs.ldb2 = 1024;
    }
    DI void epi(f32x4 (&acc)[2][2][4][2], int u, const int wv_) const {
        int mt, n8; deal.decode(u, mt, n8);
        const int e = moe_find(tstart, mt);
        unsigned char* ACT = (unsigned char*)(p.ws + WS_RA);
        const int _tz = otid(), _w = _tz >> 6, _l = _tz & 63, _wr = _w >> 2, _wc = _w & 3, _fr = _l & 15, _fq = _l >> 4;
        const float* bin = p.exp_b_in + (size_t)(l * NE + e) * 2048 + n8 * 128 + _wc * 32 + _fq * 8;
        f32x4 bg[2], bu[2];
#pragma unroll
        for (int n = 0; n < 2; ++n) { bg[n] = *(const f32x4*)(bin + n * 4); bu[n] = *(const f32x4*)(bin + 1024 + n * 4); }
#pragma unroll
        for (int ai = 0; ai < 2; ++ai)
#pragma unroll
            for (int m = 0; m < 4; ++m) { const int lr = ai * 128 + _wr * 64 + m * 16 + _fr;
                unsigned char* orow = ACT + ((size_t)mt * 256 + lr) * 1024 + n8 * 128 + _wc * 32 + _fq * 8;
                u32x2 pk;
#pragma unroll
                for (int n = 0; n < 2; ++n) {
                    float o[4];
#pragma unroll
                    for (int r = 0; r < 4; ++r) { const float gate = fminf(__builtin_fmaf(acc[ai][0][m][n][r], 1.f / 256.f, bg[n][r]), 7.f); const float up = __builtin_amdgcn_fmed3f(__builtin_fmaf(acc[ai][1][m][n][r], 1.f / 256.f, bu[n][r]), -7.f, 7.f);
                        o[r] = (up + 1.f) * gate * __builtin_amdgcn_rcpf(1.f + __builtin_amdgcn_exp2f(-2.4554669595930156f * gate)); }
                    if (n == 0) pk.x = pk_fp8x4(o[0], o[1], o[2], o[3]); else pk.y = pk_fp8x4(o[0], o[1], o[2], o[3]); }
                *(u32x2*)orow = pk; }
    }
};
DI void phase_moe1(const Params& p, LAS char* shm, int l, const int wv_) {
    LAS int* tstart = (LAS int*)(shm + LDS_MISC + 64);
    moe_tiles(p, tstart, l, wv_);
    PvMoe1 pv{p, l, tstart, {tstart[32]}}; gemm_stream(shm, pv, wv_);
}
struct PvMoe2 {
    const Params& p; int l; const LAS int* tstart;
    static constexpr int NT = 8; static constexpr int FP8 = 2; static constexpr bool PARK = false; typedef APlain AS; typedef BSimple BS;
    XcdDeal<4, 4> deal;
    DI int first() const { return deal.first(); }
    DI int next(int u) const { return deal.next(u); }
    DI void src(int u, AS& as, BS& bs, const int wv_) const {
        int mt, n4; deal.decode(u, mt, n4);
        const int e = moe_find(tstart, mt);
        as.base = (const char*)(p.ws + WS_RA) + (size_t)mt * 256 * 1024; as.lda2 = 1024;
        const char* W = (const char*)(p.ws + WS_W2) + (size_t)(l * NE + e) * 1024 * 1024;
        bs.base[0] = W + (size_t)(n4 * 256) * 1024; bs.base[1] = W + (size_t)(n4 * 256 + 128) * 1024; bs.ldb2 = 1024;
    }
    DI void epi(f32x4 (&acc)[2][2][4][2], int u, const int wv_) const {
        int mt, n4; deal.decode(u, mt, n4);
        const int e = moe_find(tstart, mt);
        const int r0 = (mt - tstart[e]) * 256, cnt = ((const int*)(p.ws + WS_CNT))[l * 32 + e];
        const int* lst = (const int*)(p.ws + WS_LIST) + (size_t)e * TT * 2;
        bf16_t* Y = (bf16_t*)(p.ws + WS_RY);
        const int _tz = otid(), _w = _tz >> 6, _l = _tz & 63, _wr = _w >> 2, _wc = _w & 3, _fr = _l & 15, _fq = _l >> 4;
        const float* bo = p.exp_b_out + (size_t)(l * NE + e) * 1024 + n4 * 256 + _wc * 32 + _fq * 8;
        u32x2 ent[2][4]; f32x4 bv[2][2];
#pragma unroll
        for (int ai = 0; ai < 2; ++ai)
#pragma unroll
            for (int m = 0; m < 4; ++m) ent[ai][m] = *(const u32x2*)(lst + 2 * min(r0 + ai * 128 + _wr * 64 + m * 16 + _fr, cnt - 1));
#pragma unroll
        for (int bj = 0; bj < 2; ++bj)
#pragma unroll
            for (int n = 0; n < 2; ++n) bv[bj][n] = *(const f32x4*)(bo + bj * 128 + n * 4);
#pragma unroll
        for (int ai = 0; ai < 2; ++ai)
#pragma unroll
            for (int m = 0; m < 4; ++m) { const int lr = r0 + ai * 128 + _wr * 64 + m * 16 + _fr;
                if (lr < cnt) { const float w = __uint_as_float(ent[ai][m].y); bf16_t* orow = Y + (size_t)ent[ai][m].x * 1024 + n4 * 256 + _wc * 32 + _fq * 8;
                    const float sc_ = 1.f / 256.f;
#pragma unroll
                    for (int bj = 0; bj < 2; ++bj) store_bf16x8(orow + bj * 128, (acc[ai][bj][m][0] * sc_ + bv[bj][0]) * w, (acc[ai][bj][m][1] * sc_ + bv[bj][1]) * w); } }
    }
};
DI void phase_moe2(const Params& p, LAS char* shm, int l, const int wv_) {
    LAS int* tstart = (LAS int*)(shm + LDS_MISC + 64);
    moe_tiles(p, tstart, l, wv_);
    PvMoe2 pv{p, l, tstart, {tstart[32]}}; gemm_stream(shm, pv, wv_);
}

DI void phase_combine(const Params& p, LAS char* shm, int l, const int wv_) {
    const int tid = otid(), wid = tid >> 6, lane = tid & 63;
    const bool alt = p.ph_lo != 0;
    const bf16_t* X = (const bf16_t*)(p.ws + WS_X);
    bf16_t* XO = alt ? (bf16_t*)(p.ws + WS_RA) : (bf16_t*)(p.ws + WS_X);
    float* OUT = alt ? (float*)(p.ws + WS_RA) : p.out;
    const bf16_t* Y = (const bf16_t*)(p.ws + WS_RY);
    const float* MOD = (const float*)(p.ws + WS_MOD);
    bf16_t* H = alt ? (bf16_t*)(p.ws + WS_RA + (size_t)TT * 1024 * 4) : (bf16_t*)(p.ws + WS_H);
    const int Tm = (l == 1) ? TX : TT;
    for (int r = blockIdx.x * 8 + wid; r < Tm; r += gridDim.x * 8) {
        const float* g2 = MOD + (size_t)(l * 33 + mod_row(r)) * 6144 + 5120;
        float v[16];
#pragma unroll
        for (int j = 0; j < 4; ++j) {
            const int col = j * 256 + lane * 4;
            f32x4 s = (f32x4){0.f, 0.f, 0.f, 0.f};
#pragma unroll
            for (int k = 0; k < 4; ++k) { const u32x2 yy = *(const u32x2*)(Y + ((size_t)r * 4 + k) * 1024 + col); s[0] += bflo(yy.x); s[1] += bfhi(yy.x); s[2] += bflo(yy.y); s[3] += bfhi(yy.y); }
            const u32x2 xb_ = *(const u32x2*)(X + (size_t)r * 1024 + col); const f32x4 gg = *(const f32x4*)(g2 + col);
            const f32x4 xv = (f32x4){bflo(xb_.x), bfhi(xb_.x), bflo(xb_.y), bfhi(xb_.y)};
            const f32x4 o = xv + gg * s;
            if (l == 1) *(f32x4*)(OUT + (size_t)r * 1024 + col) = o; else store_bf16x4(XO + (size_t)r * 1024 + col, o[0], o[1], o[2], o[3]);
            v[j * 4] = o[0]; v[j * 4 + 1] = o[1]; v[j * 4 + 2] = o[2]; v[j * 4 + 3] = o[3];
        }
        if (l == 0) norm_mod_store(v, p.norm1_g + 1024, MOD + (size_t)(1 * 33 + mod_row(r)) * 6144, H + (size_t)r * 1024, wv_);
    }
}

constexpr int NPH_LAYER = 10;
constexpr int NPH = 2 + 2 * NPH_LAYER;

__global__ void __launch_bounds__(512, 2) mk_forward(Params p_unused) {
    extern __shared__ __attribute__((aligned(16))) char smem_raw[];
    LAS char* shm = (LAS char*)smem_raw;
    volatile LAS unsigned* xb_words = (volatile LAS unsigned*)(shm + LDS_MISC);
    const int wv_ = __builtin_amdgcn_readfirstlane((int)(threadIdx.x >> 6));
    if (wv_ == 0 && olane() < 4) xb_words[olane()] = 0u;
    __syncthreads();
    kaptr_t ka = (kaptr_t)__builtin_amdgcn_kernarg_segment_ptr();
    const int tok0 = ptoken();
    const int lo = (int)kld64<__builtin_offsetof(Params, ph_lo)>(ka, tok0), hi = (int)kld64<__builtin_offsetof(Params, ph_hi)>(ka, tok0);
    const bool multi = (hi - lo) > 1;
    unsigned* barw = (unsigned*)((__attribute__((address_space(1))) char*)kld64<__builtin_offsetof(Params, ws)>(ka, tok0) + WS_BAR);
    XcdBarrier bar; bar.bar = barw; bar.x = 0; bar.st = xb_words;
    if (multi) bar = xcd_barrier_post(barw, xb_words, wv_);
#ifndef ONLY_KIND
#define ONLY_KIND (-1)
#endif
#define PHASE(idx, kind, FN, ...) do { if ((ONLY_KIND < 0 || ONLY_KIND == (kind)) && (idx) >= lo && (idx) < hi) { const Params p = kparams(ka, ptoken()); int nrep_ = 1 + ((MK_REPEAT_MASK >> (kind)) & 1); asm volatile("" : "+s"(nrep_)); for (int rep_ = 0; rep_ < nrep_; ++rep_) { Params p2 = p; p2.ph_lo = rep_; FN(p2, ##__VA_ARGS__, wv_); } if ((idx) + 1 < hi) xcd_barrier(bar, wv_); } } while (0)
    PHASE(0, 0, phase_prologue, shm);
    PHASE(1, 1, phase_norm1_l0);
    for (int l = 0; l < 2; ++l) {
        const int b0 = 2 + l * NPH_LAYER;
        PHASE(b0 + 0, 2, phase_inproj, shm, l);
        PHASE(b0 + 1, 3, phase_A, shm, l);
        PHASE(b0 + 2, 4, phase_B, shm, l);
        PHASE(b0 + 3, 5, phase_C, shm, l);
        PHASE(b0 + 4, 6, phase_D, shm, l);
        PHASE(b0 + 5, 7, phase_E, shm, l);
        PHASE(b0 + 6, 8, phase_router, shm, l);
        PHASE(b0 + 7, 9, phase_moe1, shm, l);
        PHASE(b0 + 8, 10, phase_moe2, shm, l);
        PHASE(b0 + 9, 11, phase_combine, shm, l);
    }
#undef PHASE
}


extern "C" void kernel_launch(void* const* d_in, const int* in_sizes, int n_in, void* d_out, int out_size, void* d_ws, size_t ws_size, hipStream_t stream) {
    static int grid = 0;
    if (grid == 0) {
        if (n_in != 39 || ws_size < WS_END) { fprintf(stderr, "kernel_launch: unexpected n_in %d or ws_size %zu (< %zu)\n", n_in, ws_size, (size_t)WS_END); grid = -1; return; }
        int dev = 0, cus = 0;
        if (hipGetDevice(&dev) != hipSuccess || hipDeviceGetAttribute(&cus, hipDeviceAttributeMultiprocessorCount, dev) != hipSuccess) { grid = -1; return; }
        if (hipFuncSetAttribute((const void*)mk_forward, hipFuncAttributeMaxDynamicSharedMemorySize, LDS_BYTES) != hipSuccess) { fprintf(stderr, "kernel_launch: hipFuncSetAttribute failed\n"); grid = -1; return; }
        int per_cu = 0;
        if (hipOccupancyMaxActiveBlocksPerMultiprocessor(&per_cu, (const void*)mk_forward, 512, LDS_BYTES) != hipSuccess || per_cu < 1) fprintf(stderr, "kernel_launch: occupancy query says %d\n", per_cu);
        (void)hipGetLastError();
        grid = cus;
    }
    if (grid < 0) return;
    (void)hipMemsetAsync((char*)d_ws + WS_BAR, 0, 16384 + 1024, stream);
    Params p{};
    const float** pf = (const float**)&p;
    for (int i = 0; i < 39; ++i) pf[i] = (const float*)d_in[i];
    p.out = (float*)d_out; p.ws = (char*)d_ws;
#if MK_ONE_LAUNCH
    p.ph_lo = 0; p.ph_hi = NPH;
    hipLaunchKernelGGL(mk_forward, dim3(grid), dim3(512), LDS_BYTES, stream, p);
#else
#ifndef MK_LAST_PHASE
#define MK_LAST_PHASE NPH
#endif
    for (int ph = 0; ph < MK_LAST_PHASE; ++ph) { p.ph_lo = ph; p.ph_hi = ph + 1; hipLaunchKernelGGL(mk_forward, dim3(grid), dim3(512), LDS_BYTES, stream, p); }
#endif
}
```

```cpp
#include <hip/hip_runtime.h>
#include <stdint.h>
#include <stdio.h>

#ifndef MK_REPEAT_MASK
#define MK_REPEAT_MASK 0x0
#endif
#ifndef MK_ONE_LAUNCH
#define MK_ONE_LAUNCH 1
#endif

#define DI __device__ __forceinline__
#define LAS __attribute__((address_space(3)))
typedef unsigned short bf16_t;
typedef short bf16x8 __attribute__((ext_vector_type(8)));
typedef short s16x4 __attribute__((ext_vector_type(4)));
typedef float f32x4 __attribute__((ext_vector_type(4)));
typedef float f32x16 __attribute__((ext_vector_type(16)));
typedef unsigned u32x2 __attribute__((ext_vector_type(2)));
typedef unsigned u32x4 __attribute__((ext_vector_type(4)));
typedef int i32x4 __attribute__((ext_vector_type(4)));
typedef int i32x8 __attribute__((ext_vector_type(8)));

constexpr int D = 1024, NB = 32, SEQ = 2048, CTXL = 256;
constexpr int TX = NB * SEQ, TC = NB * CTXL, TT = TX + TC;
constexpr int NINP = 1536;
constexpr int OFF_POOL = 512, OFF_Q = 768, OFF_SSM = 960, OFF_KV = 1216, OFF_KPE = 1344, N_IN = 1376;
constexpr int NE = 32;
constexpr int NCH = 36;
constexpr int NCROW = NB * NCH;
constexpr float EPS = 1e-6f;

constexpr size_t WS_BAR = 0;
constexpr size_t WS_CNT = 16384;
constexpr size_t WS_MOD = WS_CNT + 1024;
constexpr size_t WS_A64 = WS_MOD + (size_t)2 * 33 * 6144 * 4;
constexpr size_t WS_WMI = WS_A64 + (size_t)2 * 2 * 16 * 64 * 2 * 4;
constexpr size_t WS_WMO = WS_WMI + (size_t)2 * 1536 * 1024 * 2;
constexpr size_t WS_WPW = WS_WMO + (size_t)2 * 1024 * 1024 * 2;
constexpr size_t WS_WGLU = WS_WPW + (size_t)2 * 256 * 256 * 2;
constexpr size_t WS_WPOOL = WS_WGLU + (size_t)2 * 256 * 256 * 2;
constexpr size_t WS_WQ = WS_WPOOL + (size_t)2 * 256 * 256 * 2;
constexpr size_t WS_WKV = WS_WQ + (size_t)2 * 512 * 256 * 2;
constexpr size_t WS_TS5 = WS_WKV + (size_t)2 * 512 * 256 * 2;
constexpr size_t WS_WS5 = WS_TS5 + (size_t)2 * 16 * 1024 * 1280 * 2;
constexpr size_t WS_W1 = WS_WS5 + (size_t)2 * 16 * 256 * 1024 * 2;
constexpr size_t WS_W2 = WS_W1 + (size_t)32 * 2048 * 1024 * 2;
constexpr size_t WS_X = WS_W2 + (size_t)32 * 1024 * 1024 * 2;
constexpr size_t WS_H = WS_X + (size_t)TT * 1024 * 4;
constexpr size_t WS_LIST = WS_H + (size_t)TT * 1024 * 2;
constexpr size_t WS_TOPW = WS_LIST + (size_t)32 * TT * 8;
constexpr size_t WS_RA = WS_TOPW + (size_t)TT * 4 * 4;
constexpr size_t WS_RY = WS_RA + (size_t)TT * 4 * 1024 * 2;
constexpr size_t WS_END = WS_RY + (size_t)TT * 4 * 1024 * 2;
constexpr size_t WS_P = WS_RA;
constexpr size_t WS_ACONV = WS_P + (size_t)TT * NINP * 2;
constexpr size_t WS_APOOL = WS_ACONV + (size_t)TT * 256 * 2;
constexpr size_t WS_RAWQ = WS_APOOL + (size_t)TT * 256 * 2;
constexpr size_t WS_RAWKV = WS_RAWQ + (size_t)TT * 512 * 4;
constexpr size_t WS_Q = WS_RAWKV + (size_t)TT * 512 * 4;
constexpr size_t WS_KB = WS_Q + (size_t)TT * 384 * 2;
constexpr size_t WS_VT = WS_KB + (size_t)128 * 2304 * 96 * 2;
constexpr size_t WS_SST = WS_VT + (size_t)128 * 64 * 2304 * 2;
constexpr size_t WS_HIN = WS_SST + (size_t)NCROW * 16 * 256 * 4;
constexpr size_t WS_Z = WS_HIN + (size_t)NCROW * 16 * 256 * 2;
constexpr size_t WS_CAT = WS_Z + (size_t)TT * 256 * 2;
constexpr size_t WS_MIX_END = WS_CAT + (size_t)TT * 1024 * 2;
static_assert(WS_MIX_END <= WS_END, "mixer buffers must fit in the ACT/Y regions");
static_assert(WS_END <= (size_t)2147483648ull, "workspace budget");

constexpr int LDS_BYTES = 147456;
constexpr int LDS_MISC = 146432;

struct Params {
    const float *x, *c, *ctx, *c_ctx, *ada_w, *ada_b, *norm1_g, *norm2_g, *w_mix_in, *w_mix_out,
        *conv_dw, *conv_dw_b, *conv_ln_g, *conv_ln_b, *conv_pw, *pool_w, *pool_scale,
        *ssm_a_re, *ssm_a_im, *ssm_log_dt, *ssm_b_re, *ssm_b_im, *ssm_c_re, *ssm_c_im, *ssm_d, *ssm_glu_w, *ssm_glu_b,
        *mla_q_a_g, *mla_wq_b, *mla_kv_a_g, *mla_wkv_b, *mla_q_g, *mla_k_g,
        *router_w, *router_b, *exp_w_in, *exp_b_in, *exp_w_out, *exp_b_out;
    float* out;
    char* ws;
    long long ph_lo, ph_hi;
};

typedef const __attribute__((address_space(4))) char* kaptr_t;
template <int OFF> DI unsigned long long kld64(kaptr_t ka, int tok) {
    unsigned long long v;
    asm("s_load_dwordx2 %0, %1, %3\n\ts_waitcnt lgkmcnt(0)" : "=&s"(v) : "s"(ka), "s"(tok), "n"(OFF));
    return v;
}
DI int ptoken() { int t; asm volatile("s_mov_b32 %0, 0" : "=s"(t)); return t; }
DI Params kparams(kaptr_t ka, int tok) {
    Params p;
#define KL_(f) p.f = (decltype(p.f))((__attribute__((address_space(1))) char*)kld64<__builtin_offsetof(Params, f)>(ka, tok))
    KL_(x); KL_(c); KL_(ctx); KL_(c_ctx); KL_(ada_w); KL_(ada_b); KL_(norm1_g); KL_(norm2_g); KL_(w_mix_in); KL_(w_mix_out); KL_(conv_dw); KL_(conv_dw_b); KL_(conv_ln_g); KL_(conv_ln_b); KL_(conv_pw); KL_(pool_w); KL_(pool_scale); KL_(ssm_a_re); KL_(ssm_a_im); KL_(ssm_log_dt); KL_(ssm_b_re); KL_(ssm_b_im); KL_(ssm_c_re); KL_(ssm_c_im); KL_(ssm_d); KL_(ssm_glu_w); KL_(ssm_glu_b); KL_(mla_q_a_g); KL_(mla_wq_b); KL_(mla_kv_a_g); KL_(mla_wkv_b); KL_(mla_q_g); KL_(mla_k_g); KL_(router_w); KL_(router_b); KL_(exp_w_in); KL_(exp_b_in); KL_(exp_w_out); KL_(exp_b_out); KL_(out); KL_(ws);
#undef KL_
    p.ph_lo = 0; p.ph_hi = 0;
    return p;
}

typedef __bf16 bf16v2_t __attribute__((ext_vector_type(2)));
typedef float f32v2_t __attribute__((ext_vector_type(2)));
DI unsigned pk_bf16(float lo, float hi) { const f32v2_t f = {lo, hi}; const bf16v2_t b = __builtin_convertvector(f, bf16v2_t); return __builtin_bit_cast(unsigned, b); }
DI bf16_t f2bf(float x) { return (bf16_t)(pk_bf16(x, 0.f) & 0xffffu); }
DI float bf2f(bf16_t v) { return __uint_as_float(((unsigned)v) << 16); }
DI unsigned f2fp8(float x) { x = fminf(fmaxf(x, -448.f), 448.f); return (unsigned)__builtin_amdgcn_cvt_pk_fp8_f32(x, x, 0, false) & 0xffu; }
DI unsigned pk_fp8x4(float a, float b, float c, float d) { int v = __builtin_amdgcn_cvt_pk_fp8_f32(a, b, 0, false); v = __builtin_amdgcn_cvt_pk_fp8_f32(c, d, v, true); return (unsigned)v; }
DI float bflo(unsigned u) { return __uint_as_float(u << 16); }
DI float bfhi(unsigned u) { return __uint_as_float(u & 0xffff0000u); }
DI int olane() { int l = (int)__builtin_amdgcn_mbcnt_hi(~0u, __builtin_amdgcn_mbcnt_lo(~0u, 0u)); asm volatile("" : "+v"(l)); return l; }
DI float shx(float v, int o) { const int l = olane(); return __int_as_float(__builtin_amdgcn_ds_bpermute((l ^ o) << 2, __float_as_int(v))); }
DI float shi(float v, int src) { return __int_as_float(__builtin_amdgcn_ds_bpermute(src << 2, __float_as_int(v))); }
#define otid() otid_(wv_)
DI int otid_(int wv) { int t = (wv << 6) | olane(); asm volatile("" : "+v"(t)); return t; }
DI float wave_sum(float v) {
#pragma unroll
    for (int o = 32; o > 0; o >>= 1) v += shx(v, o);
    return v;
}
DI float wave_max(float v) {
#pragma unroll
    for (int o = 32; o > 0; o >>= 1) v = fmaxf(v, shx(v, o));
    return v;
}
DI float sigmoidf_(float x) { return __builtin_amdgcn_rcpf(1.f + __builtin_amdgcn_exp2f(-1.4426950408889634f * x)); }
DI float siluf_(float x) { return x * sigmoidf_(x); }
DI float gelu_tanh(float x) {
    const float u = 0.7978845608028654f * (x + 0.044715f * x * x * x);
    return x * __builtin_amdgcn_rcpf(1.f + __builtin_amdgcn_exp2f(-2.8853900817779268f * u));
}
DI unsigned aload32(const void* p_) { unsigned r; asm volatile("global_load_dword %0, %1, off" : "=v"(r) : "v"(p_) : "memory"); return r; }
DI u32x4 aload128(const void* p_) { u32x4 r; asm volatile("global_load_dwordx4 %0, %1, off" : "=v"(r) : "v"(p_) : "memory"); return r; }
#define PV_NOHOOKS typedef int Aux; DI void top(int, Aux&, const int) const {} DI void mid(Aux&, const int) const {} template <class A_> DI void fix(A_&, bool, const int) const {}
DI void glds16(const void* src, LAS char* dst) {
    __builtin_amdgcn_global_load_lds((const __attribute__((address_space(1))) void*)src, (LAS void*)dst, 16, 0, 0);
}

#define XB_TMO      128
#define XB_XCNT(j)  (256  + 64 * (j))
#define XB_XSUB(j)  (1280 + 64 * (j))
#define XB_XGEN(j)  (2304 + 64 * (j))
#define XB_TOP      3328
#define XB_TOPGEN   3392
#define XCD_BAR_WORDS 3456
#define XB_SPIN_CAP (1u << 18)
__device__ __forceinline__ unsigned xb_ld(unsigned* p)              { return __hip_atomic_load(p, __ATOMIC_RELAXED, __HIP_MEMORY_SCOPE_AGENT); }
__device__ __forceinline__ unsigned xb_add(unsigned* p, unsigned v) { return __hip_atomic_fetch_add(p, v, __ATOMIC_RELAXED, __HIP_MEMORY_SCOPE_AGENT); }
__device__ __forceinline__ unsigned xb_xcc_id() { return (unsigned)__builtin_amdgcn_s_getreg((3 << 11) | 20) & 0xFu; }
#define XB_SPIN(cond, bar) do { unsigned _sp = 0; while (cond) { __builtin_amdgcn_s_sleep(1); \
    if ((++_sp & 255u) == 0u) { if (xb_ld(&(bar)[XB_TMO])) break; if (_sp > XB_SPIN_CAP) { atomicAdd(&(bar)[XB_TMO], 1u); break; } } } } while (0)
struct XcdBarrier { unsigned* bar; unsigned x; volatile LAS unsigned* st; };
__device__ __forceinline__ XcdBarrier xcd_barrier_post(unsigned* bar, volatile LAS unsigned* st, const int wv_) {
    XcdBarrier b; b.bar = bar; b.x = xb_xcc_id(); b.st = st;
    if (otid() == 0) (void)xb_add(&bar[XB_XCNT(b.x)], 1u);
    return b;
}
__device__ __forceinline__ void xcd_barrier_complete(unsigned* bar, unsigned x, unsigned& nloc, unsigned& nx) {
    const unsigned G = gridDim.x * gridDim.y * gridDim.z;
    unsigned sum, cnt, mine, sp = 0u;
    for (;;) {
        sum = 0u; cnt = 0u; mine = 0u;
#pragma unroll
        for (unsigned j = 0; j < 16; ++j) { const unsigned c = xb_ld(&bar[XB_XCNT(j)]); sum += c; cnt += (c > 0u) ? 1u : 0u; mine = (j == x) ? c : mine; }
        if (sum == G) break;
        __builtin_amdgcn_s_sleep(1);
        if ((++sp & 255u) == 0u) { if (xb_ld(&bar[XB_TMO])) break; if (sp > XB_SPIN_CAP) { atomicAdd(&bar[XB_TMO], 1u); break; } }
    }
    nloc = mine > 0u ? mine : 1u; nx = cnt > 0u ? cnt : 1u;
}
__device__ __forceinline__ void xcd_barrier(const XcdBarrier& b, const int wv_) {
    asm volatile("s_waitcnt vmcnt(0)" ::: "memory");
    __syncthreads();
    if (otid() == 0) {
        unsigned* bar = b.bar;
        __builtin_amdgcn_s_waitcnt(0);
        unsigned nloc = b.st[0], nx = b.st[1];
        if (nloc == 0u) { xcd_barrier_complete(bar, b.x, nloc, nx); b.st[0] = nloc; b.st[1] = nx; }
        const unsigned old = xb_add(&bar[XB_XSUB(b.x)], 1u);
        const unsigned gen = old / nloc;
        if (old + 1u == (gen + 1u) * nloc) {
            __builtin_amdgcn_fence(__ATOMIC_RELEASE, "agent");
            asm volatile("s_waitcnt vmcnt(0)" ::: "memory");
            const unsigned og = xb_add(&bar[XB_TOP], 1u);
            const unsigned tg = og / nx;
            if (og + 1u == (tg + 1u) * nx) xb_add(&bar[XB_TOPGEN], 1u);
            else XB_SPIN(xb_ld(&bar[XB_TOPGEN]) == tg, bar);
            __builtin_amdgcn_fence(__ATOMIC_ACQUIRE, "agent");
            xb_add(&bar[XB_XGEN(b.x)], 1u);
            asm volatile("s_waitcnt vmcnt(0)" ::: "memory");
        } else {
            XB_SPIN(xb_ld(&bar[XB_XGEN(b.x)]) == gen, bar);
            __builtin_amdgcn_fence(__ATOMIC_ACQUIRE, "agent");
            asm volatile("s_waitcnt vmcnt(0)" ::: "memory");
        }
    }
    __syncthreads();
}

constexpr int HTB = 128 * 64 * 2;
DI int lds_byte(int r, int c) { const int st = (r >> 4) * 2 + (c >> 5), rr = r & 15, cc = c & 31, ob = rr * 64 + cc * 2; return st * 1024 + (ob ^ (((ob >> 9) & 1) << 5)); }
DI void stage_rc(int b, int& R, int& C) { const int st = b / 1024, sb = b % 1024, swz = sb ^ (((sb >> 9) & 1) << 5); R = (st >> 1) * 16 + swz / 64; C = (st & 1) * 32 + (swz % 64) / 2; }

DI void stage_rc_t(int tz, int i, int& R, int& C) { stage_rc(tz * 16 + i * 8192, R, C); }
struct APlain {
    const char* base; int lda2;
    DI void park(LAS unsigned*) const {} DI void unpark(const LAS unsigned*) {} DI void take_uniform(const APlain&) {}
    DI const char* ptr(int tz, int h, int i, int kt) const { int R, C; stage_rc_t(tz, i, R, C); return base + (unsigned)((h * 128 + R) * lda2 + C * 2 + kt * 128); }
};
struct ASimple {
    const char* base; unsigned off[2][2]; unsigned kstride;
    DI void park(LAS unsigned* q) const { *(LAS u32x4*)q = (u32x4){off[0][0], off[0][1], off[1][0], off[1][1]}; }
    DI void unpark(const LAS unsigned* q) { const u32x4 v = *(const LAS u32x4*)q; off[0][0] = v.x; off[0][1] = v.y; off[1][0] = v.z; off[1][1] = v.w; }
    DI void take_uniform(const ASimple& o) { base = o.base; kstride = o.kstride; }
    DI const char* ptr(int tz, int h, int i, int kt) const { return base + (unsigned)(off[h][i] + (unsigned)kt * kstride); }
};
struct ASeg2 {
    const char* base0; const char* base1; unsigned off0[2][2]; unsigned off1[2][2]; unsigned ks0; int nt0;
    DI void park(LAS unsigned*) const {} DI void unpark(const LAS unsigned*) {} DI void take_uniform(const ASeg2&) {}
    DI const char* ptr(int tz, int h, int i, int kt) const { return kt < nt0 ? base0 + (unsigned)(off0[h][i] + (unsigned)kt * ks0) : base1 + (unsigned)(off1[h][i] + (unsigned)(kt - nt0) * 128u); }
};
DI int perm32(int rho) { const int n = rho >> 4, i = rho & 15; return 8 * (i >> 2) + 4 * n + (i & 3); }
struct BSimple {
    const char* base[2]; int ldb2;
    DI const char* ptr(int tz, int h, int i, int kt) const { int R, C; stage_rc_t(tz, i, R, C); const int Rb = (R & ~31) + perm32(R & 31); return base[h] + (unsigned)(Rb * ldb2 + C * 2 + kt * 128); }
};

#define WAIT_V(n) asm volatile("s_waitcnt vmcnt(" #n ")" ::: "memory")
#define WAIT_L(n) asm volatile("s_waitcnt lgkmcnt(" #n ")" ::: "memory")
#define BAR_ __builtin_amdgcn_s_barrier()
#define SCHED_ __builtin_amdgcn_sched_barrier(0)

DI void zero_acc(f32x4 (&acc)[2][2][4][2]) {
#pragma unroll
    for (int a = 0; a < 2; ++a)
#pragma unroll
        for (int b = 0; b < 2; ++b)
#pragma unroll
            for (int m = 0; m < 4; ++m)
#pragma unroll
                for (int n = 0; n < 2; ++n) acc[a][b][m][n] = (f32x4){0.f, 0.f, 0.f, 0.f};
}
template <int MODE> struct FragT;
template <> struct FragT<0> {
    i32x4 lo, hi;
    DI void load(const LAS char* p0, const LAS char* p1) { lo = *(const LAS i32x4*)p0; hi = *(const LAS i32x4*)p1; }
    static DI f32x4 mma(const FragT& b, const FragT& a, f32x4 c) {
        c = __builtin_amdgcn_mfma_f32_16x16x32_bf16(__builtin_bit_cast(bf16x8, b.lo), __builtin_bit_cast(bf16x8, a.lo), c, 0, 0, 0);
        return __builtin_amdgcn_mfma_f32_16x16x32_bf16(__builtin_bit_cast(bf16x8, b.hi), __builtin_bit_cast(bf16x8, a.hi), c, 0, 0, 0); }
};
template <> struct FragT<1> {
    i32x4 lo, hi;
    DI void load(const LAS char* p0, const LAS char* p1) { lo = *(const LAS i32x4*)p0; hi = *(const LAS i32x4*)p1; }
    static DI long pk(int x, int y) { return (long)(((unsigned long long)(unsigned)y << 32) | (unsigned)x); }
    static DI f32x4 mma(const FragT& b, const FragT& a, f32x4 c) {
        c = __builtin_amdgcn_mfma_f32_16x16x32_fp8_fp8(pk(b.lo.x, b.lo.y), pk(a.lo.x, a.lo.y), c, 0, 0, 0);
        c = __builtin_amdgcn_mfma_f32_16x16x32_fp8_fp8(pk(b.lo.z, b.lo.w), pk(a.lo.z, a.lo.w), c, 0, 0, 0);
        c = __builtin_amdgcn_mfma_f32_16x16x32_fp8_fp8(pk(b.hi.x, b.hi.y), pk(a.hi.x, a.hi.y), c, 0, 0, 0);
        return __builtin_amdgcn_mfma_f32_16x16x32_fp8_fp8(pk(b.hi.z, b.hi.w), pk(a.hi.z, a.hi.w), c, 0, 0, 0); }
};
template <> struct FragT<2> {
    i32x8 v;
    DI void load(const LAS char* p0, const LAS char* p1) { const i32x4 lo = *(const LAS i32x4*)p0, hi = *(const LAS i32x4*)p1; v = __builtin_shufflevector(lo, hi, 0, 1, 2, 3, 4, 5, 6, 7); }
    static DI f32x4 mma(const FragT& b, const FragT& a, f32x4 c) {
        const int one = 0x7f7f7f7f;
        asm volatile("v_mfma_scale_f32_16x16x128_f8f6f4 %0, %1, %2, %0, %3, %3 op_sel_hi:[0,0,0]" : "+v"(c) : "v"(b.v), "v"(a.v), "v"(one));
        return c; }
};
template <class PV>
DI void gemm_stream(LAS char* shm, const PV& pv, const int wv_) {
    typedef typename PV::AS AS; typedef typename PV::BS BS;
    constexpr int nt = PV::NT;
    int u = pv.first();
    if (u < 0) return;
    const int tz = otid();
    const int wr = wv_ >> 2, wc = wv_ & 3, lane = tz & 63, fr = lane & 15, fq = lane >> 4;
    const int aoff = lds_byte(wr * 64 + fr, fq * 8), boff = lds_byte(wc * 32 + fr, fq * 8);
    const unsigned ldsw = (unsigned)wv_ * 1024u;
    f32x4 acc[2][2][4][2]; zero_acc(acc);
    typedef FragT<PV::FP8> Frag;
    Frag At[4], B0[2], B1[2];
    AS ca, na; BS cb, nb;
    pv.src(u, ca, cb, wv_); pv.fix(ca, true, wv_);
    constexpr bool F8 = PV::FP8 != 0;
    LAS unsigned* park = (LAS unsigned*)(shm + 131072) + tz * 4;
    const int aoff0 = aoff, aoff1 = aoff + 1024;
    const int boff0 = boff, boff1 = boff + 1024;
#define SA_(b, h) (((b) * 2 + (h)) * HTB)
#define SB_(b, h) ((4 + (b) * 2 + (h)) * HTB)
#define STG_(bufoff, S, h, kt) do { _Pragma("unroll") for (int i_ = 0; i_ < 2; ++i_) glds16((S).ptr(tz, h, i_, kt), shm + (bufoff) + ldsw + i_ * 8192); } while (0)
#define LDA_(dst, b, h) do { _Pragma("unroll") for (int m = 0; m < 4; ++m) dst[m].load(shm + SA_(b, h) + aoff0 + m * 2048, shm + SA_(b, h) + aoff1 + m * 2048); } while (0)
#define LDB_(dst, b, h) do { _Pragma("unroll") for (int n = 0; n < 2; ++n) dst[n].load(shm + SB_(b, h) + boff0 + n * 2048, shm + SB_(b, h) + boff1 + n * 2048); } while (0)
#define MMAS_(ai, bj, A_, B_, STGSTMT) do { __builtin_amdgcn_s_setprio(1); \
        acc[ai][bj][0][0] = Frag::mma(B_[0], A_[0], acc[ai][bj][0][0]); acc[ai][bj][0][1] = Frag::mma(B_[1], A_[0], acc[ai][bj][0][1]); \
        STGSTMT; \
        _Pragma("unroll") for (int m = 1; m < 4; ++m) _Pragma("unroll") for (int n = 0; n < 2; ++n) { \
            acc[ai][bj][m][n] = Frag::mma(B_[n], A_[m], acc[ai][bj][m][n]); } \
        __builtin_amdgcn_s_setprio(0); } while (0)
    STG_(SB_(0, 0), cb, 0, 0); STG_(SA_(0, 0), ca, 0, 0); STG_(SB_(0, 1), cb, 1, 0); STG_(SA_(0, 1), ca, 1, 0);
    if (wr == 1) BAR_;
    WAIT_V(4); BAR_;
    STG_(SB_(1, 0), cb, 0, 1); STG_(SA_(1, 0), ca, 0, 1); STG_(SB_(1, 1), cb, 1, 1);
    WAIT_V(6); BAR_;
    for (;;) {
        const int un = pv.next(u); const bool has_next = un >= 0;
        if (has_next) pv.src(un, na, nb, wv_); else { na = ca; nb = cb; }
        if (PV::PARK) { na.park(park); asm volatile("s_waitcnt lgkmcnt(0)" ::: "memory"); }
        typename PV::Aux aux; pv.top(u, aux, wv_);
#pragma clang loop unroll(disable)
        for (int t = 0; t < nt; t += 2) {
            const bool last = (t == nt - 2);
            if (last && has_next) pv.fix(na, false, wv_);
            AS a2 = last ? na : ca; const BS b2 = last ? nb : cb; const int k2 = last ? 0 : t + 2;
            if (PV::PARK) { if (last) a2.unpark(park); }
            LDB_(B0, 0, 0); SCHED_; LDA_(At, 0, 0);
            WAIT_L(8); BAR_; WAIT_L(0); MMAS_(0, 0, At, B0, STG_(SA_(1, 1), ca, 1, t + 1)); BAR_; SCHED_;
            LDB_(B1, 0, 1);
            BAR_; WAIT_L(0); MMAS_(0, 1, At, B1, STG_(SB_(0, 0), b2, 0, k2)); BAR_;
            LDA_(At, 0, 1);
            BAR_; WAIT_L(0); MMAS_(1, 0, At, B0, STG_(SA_(0, 0), a2, 0, k2)); BAR_; SCHED_;
            WAIT_V(4); BAR_; if (t == 0) pv.mid(aux, wv_); MMAS_(1, 1, At, B1, STG_(SB_(0, 1), b2, 1, k2)); BAR_;
            LDB_(B0, 1, 0); SCHED_; LDA_(At, 1, 0);
            WAIT_L(8); BAR_; WAIT_L(0); MMAS_(0, 0, At, B0, STG_(SA_(0, 1), a2, 1, k2)); BAR_; SCHED_;
            LDB_(B1, 1, 1);
            BAR_; WAIT_L(0); MMAS_(0, 1, At, B1, STG_(SB_(1, 0), b2, 0, k2 + 1)); BAR_;
            LDA_(At, 1, 1);
            BAR_; WAIT_L(0); MMAS_(1, 0, At, B0, STG_(SA_(1, 0), a2, 0, k2 + 1)); BAR_; SCHED_;
            WAIT_V(4); BAR_; MMAS_(1, 1, At, B1, STG_(SB_(1, 1), b2, 1, k2 + 1)); BAR_;
            if (PV::PARK) { if (last) ca = a2; }
        }
        if (PV::FP8 == 2) asm volatile("s_nop 15\n\ts_nop 15" ::: "memory");
        pv.epi(acc, u, wv_);
        if (!has_next) break;
        zero_acc(acc);
        u = un; if (!PV::PARK) ca = na; cb = nb;
        if (PV::PARK) ca.take_uniform(na);
    }
    WAIT_V(0);
    if (wr == 0) BAR_;
    BAR_;
#undef SA_
#undef SB_
#undef STG_
#undef LDA_
#undef LDB_
#undef MMAS_
}
DI int lin_first(int shift, int count) { const int G = gridDim.x; const int u = (int)((blockIdx.x + G - (shift % G)) % G); return u < count ? u : -1; }
DI int lin_next(int u, int count) { const int un = u + (int)gridDim.x; return un < count ? un : -1; }
template <int MG, int NTL> struct XcdDeal {
    int MT;
    DI bool decode(int J, int& mt, int& nt) const { const int x = blockIdx.x & 7; const int grp = (J / (MG * NTL)) * 8 + x, w = J % (MG * NTL); mt = grp * MG + w / NTL; nt = w % NTL; return mt < MT; }
    DI int jmax() const { return ((MT + 8 * MG - 1) / (8 * MG)) * (MG * NTL); }
    DI int first() const { int J = blockIdx.x >> 3; const int per = gridDim.x >> 3, jm = jmax(); int mt, nt;
        while (J < jm && !decode(J, mt, nt)) J += per;
        return J < jm ? J : -1; }
    DI int next(int J) const { const int per = gridDim.x >> 3, jm = jmax(); int mt, nt; J += per;
        while (J < jm && !decode(J, mt, nt)) J += per;
        return J < jm ? J : -1; }
};
DI int first_unit(int shift) { const int G = gridDim.x; return (int)((blockIdx.x + G - (shift % G)) % G); }

DI void stage_coords(int (&R)[2], int (&C)[2], const int wv_) {
    const int t_ = otid();
#pragma unroll
    for (int i = 0; i < 2; ++i) stage_rc(t_ * 16 + i * 8192, R[i], C[i]);
}
DI APlain make_a_plain(const bf16_t* A, size_t row0, int lda, int col0) {
    APlain a; a.base = (const char*)(A + row0 * (size_t)lda + col0); a.lda2 = lda * 2; return a;
}
DI BSimple make_b(const bf16_t* Bt0, const bf16_t* Bt1, int ldb) {
    BSimple b; b.base[0] = (const char*)Bt0; b.base[1] = (const char*)Bt1; b.ldb2 = ldb * 2; return b;
}
#define EPI_FOR(acc, ...) do { const int _tz = otid(), _w = _tz >> 6, _l = _tz & 63, _wr = _w >> 2, _wc = _w & 3, _fr = _l & 15, _fq = _l >> 4; \
    _Pragma("unroll") for (int ai = 0; ai < 2; ++ai) _Pragma("unroll") for (int m = 0; m < 4; ++m) { const int lr = ai * 128 + _wr * 64 + m * 16 + _fr; \
    _Pragma("unroll") for (int bj = 0; bj < 2; ++bj) _Pragma("unroll") for (int n = 0; n < 2; ++n) { const int lc = bj * 128 + _wc * 32 + n * 16 + _fq * 4; const f32x4 v = acc[ai][bj][m][n]; __VA_ARGS__ } } } while (0)

DI void store_bf16x4(bf16_t* p, float a, float b, float c, float d) { u32x2 v; v.x = pk_bf16(a, b); v.y = pk_bf16(c, d); *(u32x2*)p = v; }
DI void store_bf16x8(bf16_t* p, const f32x4 a, const f32x4 b) { u32x4 v; v.x = pk_bf16(a[0], a[1]); v.y = pk_bf16(a[2], a[3]); v.z = pk_bf16(b[0], b[1]); v.w = pk_bf16(b[2], b[3]); *(u32x4*)p = v; }
#define EPI_FOR8(acc, ...) do { const int _tz = otid(), _w = _tz >> 6, _l = _tz & 63, _wr = _w >> 2, _wc = _w & 3, _fr = _l & 15, _fq = _l >> 4; \
    _Pragma("unroll") for (int ai = 0; ai < 2; ++ai) _Pragma("unroll") for (int m = 0; m < 4; ++m) { const int lr = ai * 128 + _wr * 64 + m * 16 + _fr; \
    _Pragma("unroll") for (int bj = 0; bj < 2; ++bj) { const int lc = bj * 128 + _wc * 32 + _fq * 8; const f32x4 v0 = acc[ai][bj][m][0], v1 = acc[ai][bj][m][1]; __VA_ARGS__ } } } while (0)

DI int mod_row(int r) { return r < TX ? (r >> 11) : 32; }
DI int crow_tok(int cr) { const int b = cr / NCH, j = cr - b * NCH; return j < 4 ? TX + b * CTXL + j * 64 : b * SEQ + (j - 4) * 64; }

DI void cvt_tile(LAS char* wl  , const float* src, int ld_src, int kvalid, int nvalid, const float* scale, bf16_t* dst, int ld_dst, const int wv_) {
    const int lane = otid() & 63;
    const int lr = lane >> 4, lc = (lane & 15) * 4;
    f32x4 v[16];
#pragma unroll
    for (int it = 0; it < 16; ++it) {
        const int k = it * 4 + lr;
        v[it] = (f32x4){0.f, 0.f, 0.f, 0.f};
        if (src != nullptr && k < kvalid && lc < nvalid) { v[it] = *(const f32x4*)(src + (size_t)k * ld_src + lc); if (scale) { const float s = scale[k]; v[it] *= s; } }
    }
#pragma unroll
    for (int it = 0; it < 16; ++it) {
        const int k = it * 4 + lr;
#pragma unroll
        for (int j = 0; j < 4; ++j) *(LAS bf16_t*)(wl + (lc + j) * 144 + k * 2) = f2bf(v[it][j]);
    }
    asm volatile("s_waitcnt lgkmcnt(0)" ::: "memory");
#pragma unroll
    for (int i = 0; i < 8; ++i) {
        const int q = i * 64 + lane, n = q >> 3, c = q & 7;
        const u32x4 w = *(const LAS u32x4*)(wl + n * 144 + c * 16);
        *(u32x4*)(dst + (size_t)n * ld_dst + c * 8) = w;
    }
    asm volatile("s_waitcnt lgkmcnt(0)" ::: "memory");
}
DI void cvt_tile8(LAS char* wl  , const float* src, int ld_src, unsigned char* dst, int ld_dst, const int wv_) {
    const int lane = otid() & 63;
    const int lr = lane >> 4, lc = (lane & 15) * 4;
    f32x4 v[16];
#pragma unroll
    for (int it = 0; it < 16; ++it) v[it] = *(const f32x4*)(src + (size_t)(it * 4 + lr) * ld_src + lc);
#pragma unroll
    for (int it = 0; it < 16; ++it) {
        const int k = it * 4 + lr;
#pragma unroll
        for (int j = 0; j < 4; ++j) *(LAS unsigned char*)(wl + (lc + j) * 80 + k) = (unsigned char)f2fp8(v[it][j] * 256.f);
    }
    asm volatile("s_waitcnt lgkmcnt(0)" ::: "memory");
#pragma unroll
    for (int i = 0; i < 4; ++i) {
        const int q = i * 64 + lane, n = q >> 2, c = q & 3;
        const u32x4 w = *(const LAS u32x4*)(wl + n * 80 + c * 16);
        *(u32x4*)(dst + (size_t)n * ld_dst + c * 16) = w;
    }
    asm volatile("s_waitcnt lgkmcnt(0)" ::: "memory");
}
constexpr int CVT_SMALL_TILES = 768 + 512 + 32 + 32 + 64 + 64 + 32;
constexpr int CVT_EXP_TILES = 32 * (32 * 16 + 16 * 16);
DI void cvt_small(const Params& p, LAS char* wl, int t, const int wv_) {
    char* ws = p.ws;
    if (t < 768) { const int l = t / 384, r = t % 384, nt = r / 16, kt = r % 16;
        cvt_tile(wl, p.w_mix_in + (size_t)l * 1024 * N_IN + (size_t)kt * 64 * N_IN + nt * 64, N_IN, 64, N_IN - nt * 64, nullptr,
                 (bf16_t*)(ws + WS_WMI) + ((size_t)l * 1536 + nt * 64) * 1024 + kt * 64, 1024, wv_); return; }
    t -= 768;
    if (t < 512) { const int l = t / 256, r = t % 256, nt = r / 16, kt = r % 16;
        cvt_tile(wl, p.w_mix_out + (size_t)l * 1024 * 1024 + (size_t)kt * 64 * 1024 + nt * 64, 1024, 64, 64, nullptr,
                 (bf16_t*)(ws + WS_WMO) + ((size_t)l * 1024 + nt * 64) * 1024 + kt * 64, 1024, wv_); return; }
    t -= 512;
    if (t < 32) { const int l = t / 16, r = t % 16, nt = r / 4, kt = r % 4;
        cvt_tile(wl, p.conv_pw + (size_t)l * 65536 + (size_t)kt * 64 * 256 + nt * 64, 256, 64, 64, nullptr,
                 (bf16_t*)(ws + WS_WPW) + ((size_t)l * 256 + nt * 64) * 256 + kt * 64, 256, wv_); return; }
    t -= 32;
    if (t < 32) { const int l = t / 16, r = t % 16, nt = r / 4, kt = r % 4;
        cvt_tile(wl, p.ssm_glu_w + (size_t)l * 65536 + (size_t)kt * 64 * 256 + nt * 64, 256, 64, 64, nullptr,
                 (bf16_t*)(ws + WS_WGLU) + ((size_t)l * 256 + nt * 64) * 256 + kt * 64, 256, wv_); return; }
    t -= 32;
    if (t < 64) { const int l = t / 32, r = t % 32, nt = r / 4, kt = r % 4;
        const bool any = (kt < 3) && (nt < 6);
        cvt_tile(wl, any ? p.mla_wq_b + (size_t)l * 192 * 384 + (size_t)kt * 64 * 384 + nt * 64 : nullptr, 384, 64, 64, p.mla_q_a_g + l * 192 + kt * 64,
                 (bf16_t*)(ws + WS_WQ) + ((size_t)l * 512 + nt * 64) * 256 + kt * 64, 256, wv_); return; }
    t -= 64;
    if (t < 64) { const int l = t / 32, r = t % 32, nt = r / 4, kt = r % 4;
        const bool any = (kt < 2);
        cvt_tile(wl, any ? p.mla_wkv_b + (size_t)l * 128 * 512 + (size_t)kt * 64 * 512 + nt * 64 : nullptr, 512, 64, 64, p.mla_kv_a_g + l * 128 + kt * 64,
                 (bf16_t*)(ws + WS_WKV) + ((size_t)l * 512 + nt * 64) * 256 + kt * 64, 256, wv_); return; }
    t -= 64;
    { const int l = t / 16, r = t % 16, nt = r / 4, kt = r % 4;
        cvt_tile(wl, nt == kt ? p.pool_w + ((size_t)l * 4 + nt) * 4096 : nullptr, 64, 64, 64, nullptr,
                 (bf16_t*)(ws + WS_WPOOL) + ((size_t)l * 256 + nt * 64) * 256 + kt * 64, 256, wv_); }
}
DI void cvt_expert(const Params& p, LAS char* wl, int l, int t, const int wv_) {
    char* ws = p.ws;
    const int e = t / 768, r = t % 768;
    if (r < 512) { const int nt = r / 16, kt = r % 16;
        cvt_tile8(wl, p.exp_w_in + ((size_t)(l * NE + e) * 1024 + kt * 64) * 2048 + nt * 64, 2048,
                  (unsigned char*)(ws + WS_W1) + ((size_t)(l * NE + e) * 2048 + nt * 64) * 1024 + kt * 64, 1024, wv_);
    } else { const int q = r - 512, nt = q / 16, kt = q % 16;
        cvt_tile8(wl, p.exp_w_out + ((size_t)(l * NE + e) * 1024 + kt * 64) * 1024 + nt * 64, 1024,
                  (unsigned char*)(ws + WS_W2) + ((size_t)(l * NE + e) * 1024 + nt * 64) * 1024 + kt * 64, 1024, wv_);
    }
}

DI void ada_unit(const Params& p, LAS char* shm, int u, const int wv_) {
    const int tid = otid();
    const int l = u / 48, jc = u % 48;
    LAS float* sc = (LAS float*)shm;
    for (int i = tid; i < 33 * 1024; i += 512) { const int r = i >> 10, k = i & 1023; const float v = r < 32 ? p.c[r * 1024 + k] : p.c_ctx[k]; sc[i] = siluf_(v); }
    __syncthreads();
    const int col = tid & 127, kq = tid >> 7;
    float acc[33];
#pragma unroll
    for (int r = 0; r < 33; ++r) acc[r] = 0.f;
    const float* wp = p.ada_w + ((size_t)l * 1024 + kq * 256) * 6144 + jc * 128 + col;
    for (int k4 = 0; k4 < 256; k4 += 4) {
        float w[4];
#pragma unroll
        for (int i = 0; i < 4; ++i) w[i] = wp[(size_t)(k4 + i) * 6144];
#pragma unroll
        for (int r = 0; r < 33; ++r) { const f32x4 s = *(const LAS f32x4*)(sc + r * 1024 + kq * 256 + k4); acc[r] += s[0] * w[0] + s[1] * w[1] + s[2] * w[2] + s[3] * w[3]; }
    }
    __syncthreads();
    LAS float* red = (LAS float*)shm;
#pragma unroll
    for (int r = 0; r < 33; ++r) red[(kq * 33 + r) * 128 + col] = acc[r];
    __syncthreads();
    for (int i = tid; i < 33 * 128; i += 512) { const int r = i >> 7, cc = i & 127;
        const float s = red[(0 * 33 + r) * 128 + cc] + red[(1 * 33 + r) * 128 + cc] + red[(2 * 33 + r) * 128 + cc] + red[(3 * 33 + r) * 128 + cc];
        ((float*)(p.ws + WS_MOD))[((size_t)l * 33 + r) * 6144 + jc * 128 + cc] = s + p.ada_b[l * 6144 + jc * 128 + cc]; }
    __syncthreads();
}

DI void s5_load_bc(const Params& p, LAS float* bb, LAS float* cc, int l, int dir, int g, int tid) {
    const int pbase = ((l * 2 + dir) * 16 + g) * 64;
    const double dt = exp((double)p.ssm_log_dt[(l * 2 + dir) * 16 + g]);
    for (int i = tid; i < 64 * 16; i += 512) { const int q = i >> 4, ci = i & 15;
        const double are = fmin((double)p.ssm_a_re[pbase + q], -1e-4), aim = (double)p.ssm_a_im[pbase + q];
        const double mg = exp(are * dt), abr = mg * cos(aim * dt), abi = mg * sin(aim * dt), den = are * are + aim * aim;
        const double fre = ((abr - 1.0) * are + abi * aim) / den, fim = (abi * are - (abr - 1.0) * aim) / den;
        const double br = (double)p.ssm_b_re[(size_t)(pbase + q) * 16 + ci], bi = (double)p.ssm_b_im[(size_t)(pbase + q) * 16 + ci];
        bb[i * 2] = (float)(fre * br - fim * bi); bb[i * 2 + 1] = (float)(fre * bi + fim * br); }
    for (int i = tid; i < 16 * 64; i += 512) { const int co = i >> 6, q = i & 63;
        const size_t ix = ((size_t)((l * 2 + dir) * 16 + g) * 16 + co) * 64 + q;
        cc[i * 2] = p.ssm_c_re[ix]; cc[i * 2 + 1] = p.ssm_c_im[ix]; }
}
DI void s5pre_unit(const Params& p, LAS char* shm, int u, const int wv_) {
    const int tid = otid();
    const int l = u >> 5, g = (u >> 1) & 15, dir = u & 1;
    LAS float* pw = (LAS float*)shm;
    LAS float* bb = pw + 65 * 64 * 2;
    LAS float* cc = bb + 64 * 16 * 2;
    LAS float* kk = cc + 16 * 64 * 2;
    LAS float* k0o = kk + 64 * 256;
    bf16_t* TS = (bf16_t*)(p.ws + WS_TS5) + (size_t)(l * 16 + g) * 1024 * 1280;
    bf16_t* WS = (bf16_t*)(p.ws + WS_WS5) + (size_t)(l * 16 + g) * 256 * 1024;
    const int cocip = tid & 255, co_ = cocip >> 4, ci_ = cocip & 15;
    if (dir == 0) {
        s5_load_bc(p, bb, cc, l, 1, g, tid);
        __syncthreads();
        if (tid < 256) { float s_ = 0.f;
            for (int q = 0; q < 64; ++q) s_ += cc[(co_ * 64 + q) * 2] * bb[(q * 16 + ci_) * 2] - cc[(co_ * 64 + q) * 2 + 1] * bb[(q * 16 + ci_) * 2 + 1];
            k0o[tid] = s_; }
        __syncthreads();
    }
    {
        const int pbase = ((l * 2 + dir) * 16 + g) * 64;
        const double dt = exp((double)p.ssm_log_dt[(l * 2 + dir) * 16 + g]);
        for (int i = tid; i < 65 * 64; i += 512) { const int tau = i >> 6, q = i & 63;
            const double are = fmin((double)p.ssm_a_re[pbase + q], -1e-4), aim = (double)p.ssm_a_im[pbase + q];
            const double mg = exp(are * dt * tau), an = aim * dt * tau;
            pw[i * 2] = (float)(mg * cos(an)); pw[i * 2 + 1] = (float)(mg * sin(an)); }
        s5_load_bc(p, bb, cc, l, dir, g, tid);
        __syncthreads();
        if (tid < 64) { float* a64 = (float*)(p.ws + WS_A64) + (size_t)(((l * 2 + dir) * 16 + g) * 64 + tid) * 2; a64[0] = pw[(64 * 64 + tid) * 2]; a64[1] = pw[(64 * 64 + tid) * 2 + 1]; }
        { float gr[64], gi[64];
#pragma unroll
          for (int q = 0; q < 64; ++q) { const float cr = cc[(co_ * 64 + q) * 2], cim = cc[(co_ * 64 + q) * 2 + 1], br = bb[(q * 16 + ci_) * 2], bi = bb[(q * 16 + ci_) * 2 + 1];
              gr[q] = cr * br - cim * bi; gi[q] = cr * bi + cim * br; }
          for (int tau = (tid >> 8); tau < 64; tau += 2) {
              float s_ = 0.f;
#pragma unroll
              for (int q = 0; q < 64; ++q) s_ += gr[q] * pw[(tau * 64 + q) * 2] - gi[q] * pw[(tau * 64 + q) * 2 + 1];
              kk[tau * 256 + cocip] = s_;
          } }
        for (int i = tid; i < 128 * 512; i += 512) { const int row = i >> 9, kp = (i & 511) * 2, ri = row >> 6, q = row & 63, s_ = kp >> 4, ci = kp & 15;
            const int e = dir == 0 ? 63 - s_ : s_;
            const float pr = pw[(e * 64 + q) * 2], pi = pw[(e * 64 + q) * 2 + 1];
            float o[2];
#pragma unroll
            for (int j = 0; j < 2; ++j) { const float br = bb[(q * 16 + ci + j) * 2], bi = bb[(q * 16 + ci + j) * 2 + 1]; o[j] = ri == 0 ? pr * br - pi * bi : pr * bi + pi * br; }
            *(unsigned*)(WS + (size_t)(dir * 128 + row) * 1024 + kp) = pk_bf16(o[0], o[1]); }
        for (int i = tid; i < 1024 * 64; i += 512) { const int row = i >> 6, kp = (i & 63) * 2, t = row >> 4, co = row & 15, ri = kp >> 6, q = kp & 63;
            const int e = dir == 0 ? t + 1 : 64 - t;
            float o[2];
#pragma unroll
            for (int j = 0; j < 2; ++j) { const float pr = pw[(e * 64 + q + j) * 2], pi = pw[(e * 64 + q + j) * 2 + 1];
                const float cr = cc[(co * 64 + q + j) * 2], cim = cc[(co * 64 + q + j) * 2 + 1];
                o[j] = ri == 0 ? (cr * pr - cim * pi) : -(cr * pi + cim * pr); }
            *(unsigned*)(TS + (size_t)row * 1280 + 1024 + dir * 128 + kp) = pk_bf16(o[0], o[1]); }
        __syncthreads();
        for (int rr = tid; rr < 1024; rr += 512) { const int t = rr >> 4, co = rr & 15;
            const float dco = p.ssm_d[l * 256 + g * 16 + co];
            bf16_t* rowp = TS + (size_t)rr * 1280;
            const int s_lo = dir == 0 ? 0 : t + 1, s_hi = dir == 0 ? t : 63;
            for (int s_ = s_lo; s_ <= s_hi; ++s_) { const int tau = dir == 0 ? t - s_ : s_ - t;
                unsigned w[8];
#pragma unroll
                for (int j = 0; j < 8; ++j) { float a = kk[tau * 256 + co * 16 + 2 * j], b2 = kk[tau * 256 + co * 16 + 2 * j + 1];
                    if (s_ == t) { a += k0o[co * 16 + 2 * j]; b2 += k0o[co * 16 + 2 * j + 1]; if (2 * j == co) a += dco; if (2 * j + 1 == co) b2 += dco; }
                    w[j] = pk_bf16(a, b2); }
                *(u32x4*)(rowp + s_ * 16) = (u32x4){w[0], w[1], w[2], w[3]}; *(u32x4*)(rowp + s_ * 16 + 8) = (u32x4){w[4], w[5], w[6], w[7]}; }
        }
        __syncthreads();
    }
}

DI void phase_prologue(const Params& p, LAS char* shm, const int wv_) {
    const int tid = otid();
    __syncthreads();
    if (blockIdx.x == 0 && tid < 64) ((int*)(p.ws + WS_CNT))[tid] = 0;
    const int n_cvt = (CVT_SMALL_TILES + 2 * CVT_EXP_TILES + 7) / 8;
    const int n_units = 64 + 96 + n_cvt;
    for (int u = blockIdx.x; u < n_units; u += gridDim.x) {
        if (u < 64) s5pre_unit(p, shm, u, wv_);
        else if (u < 160) ada_unit(p, shm, u - 64, wv_);
        else {
            const int t = (u - 160) * 8 + (tid >> 6);
            LAS char* wl = shm + (tid >> 6) * (64 * 144);
            if (t < CVT_SMALL_TILES) cvt_small(p, wl, t, wv_);
            else if (t < CVT_SMALL_TILES + 2 * CVT_EXP_TILES) { const int te = t - CVT_SMALL_TILES; cvt_expert(p, wl, te / CVT_EXP_TILES, te % CVT_EXP_TILES, wv_); }
        }
    }
}

DI void norm_mod_store(const float (&v)[16], const float* g, const float* modrow  , bf16_t* hrow, const int wv_) {
    const int lane = otid() & 63;
    float ss = 0.f;
#pragma unroll
    for (int i = 0; i < 16; ++i) ss += v[i] * v[i];
    ss = wave_sum(ss);
    const float rn = rsqrtf(ss * (1.f / 1024.f) + EPS);
#pragma unroll
    for (int j = 0; j < 4; ++j) {
        const int col = j * 256 + lane * 4;
        const f32x4 gg = *(const f32x4*)(g + col), sh = *(const f32x4*)(modrow + col), sc = *(const f32x4*)(modrow + 1024 + col);
        float o[4];
#pragma unroll
        for (int i = 0; i < 4; ++i) o[i] = v[j * 4 + i] * rn * gg[i] * (1.f + sc[i]) + sh[i];
        store_bf16x4(hrow + col, o[0], o[1], o[2], o[3]);
    }
}
DI void phase_norm1_l0(const Params& p, const int wv_) {
    const int tid_ = otid(); const int wid = tid_ >> 6, lane = tid_ & 63;
    const float* MOD = (const float*)(p.ws + WS_MOD);
    bf16_t* H = (bf16_t*)(p.ws + WS_H);
    for (int r = blockIdx.x * 8 + wid; r < TT; r += gridDim.x * 8) {
        const float* src = r < TX ? p.x + (size_t)r * 1024 : p.ctx + (size_t)(r - TX) * 1024;
        float v[16];
#pragma unroll
        for (int j = 0; j < 4; ++j) { const f32x4 t = *(const f32x4*)(src + j * 256 + lane * 4); v[j * 4] = t[0]; v[j * 4 + 1] = t[1]; v[j * 4 + 2] = t[2]; v[j * 4 + 3] = t[3]; }
        norm_mod_store(v, p.norm1_g, MOD + (size_t)(0 * 33 + mod_row(r)) * 6144, H + (size_t)r * 1024, wv_);
    }
}

struct PvInproj {
    const Params& p; int l;
    PV_NOHOOKS
    static constexpr int NT = 16; static constexpr int FP8 = 0; static constexpr bool PARK = false; typedef APlain AS; typedef BSimple BS;
    XcdDeal<4, 6> deal;
    DI int first() const { return deal.first(); }
    DI int next(int u) const { return deal.next(u); }
    DI void src(int u, AS& a, BS& b, const int wv_) const {
        int mt, nt; deal.decode(u, mt, nt);
        const bf16_t* W = (const bf16_t*)(p.ws + WS_WMI) + (size_t)l * 1536 * 1024;
        a = make_a_plain((const bf16_t*)(p.ws + WS_H), (size_t)mt * 256, 1024, 0);
        b = nt < 2 ? make_b(W + (size_t)(nt * 128) * 1024, W + (size_t)(256 + nt * 128) * 1024, 1024)
                   : make_b(W + (size_t)(nt * 256) * 1024, W + (size_t)(nt * 256 + 128) * 1024, 1024);
    }
    DI void epi(f32x4 (&acc)[2][2][4][2], int u, const int wv_) const {
        int mt, nt; deal.decode(u, mt, nt);
        bf16_t* P = (bf16_t*)(p.ws + WS_P);
        if (nt < 2) {
            const int _tz = otid(), _w = _tz >> 6, _l = _tz & 63, _wr = _w >> 2, _wc = _w & 3, _fr = _l & 15, _fq = _l >> 4;
#pragma unroll
            for (int ai = 0; ai < 2; ++ai)
#pragma unroll
                for (int m = 0; m < 4; ++m) { const int lr = ai * 128 + _wr * 64 + m * 16 + _fr; const int lc = _wc * 32 + _fq * 8;
                    f32x4 o0, o1;
#pragma unroll
                    for (int r = 0; r < 4; ++r) { o0[r] = acc[ai][0][m][0][r] * sigmoidf_(acc[ai][1][m][0][r]); o1[r] = acc[ai][0][m][1][r] * sigmoidf_(acc[ai][1][m][1][r]); }
                    store_bf16x8(P + (size_t)(mt * 256 + lr) * NINP + nt * 128 + lc, o0, o1); }
        } else {
            EPI_FOR8(acc, { store_bf16x8(P + (size_t)(mt * 256 + lr) * NINP + nt * 256 + lc, v0, v1); });
        }
    }
};
DI void phase_inproj(const Params& p, LAS char* shm, int l, const int wv_) {
    PvInproj pv{p, l, {TT / 256}};
    gemm_stream(shm, pv, wv_);
}

template <int N> DI void wave_sum_n(float (&v)[N]) {
    const int l4 = olane();
#pragma unroll
    for (int o = 32; o > 0; o >>= 1) {
        float t_[N];
#pragma unroll
        for (int i = 0; i < N; ++i) t_[i] = __int_as_float(__builtin_amdgcn_ds_bpermute((l4 ^ o) << 2, __float_as_int(v[i])));
#pragma unroll
        for (int i = 0; i < N; ++i) v[i] += t_[i];
    }
}
template <int WIN, bool EDGE>
DI void pool_run(const LAS bf16_t* pin  , bf16_t* AP, int row0, int ts0, int L, int c, int half) {
    for (int blk = 0; blk < 2; ++blk) {
        const int t0 = half * 32 + blk * 16;
        float in[16 + WIN - 1];
#pragma unroll
        for (int i = 0; i < 16 + WIN - 1; ++i) in[i] = bf2f(pin[(t0 + i - WIN / 2 + 8) * 256 + c]);
        float sum = 0.f;
#pragma unroll
        for (int j = 0; j < WIN; ++j) sum += in[j];
#pragma unroll
        for (int o = 0; o < 16; ++o) {
            float inv = 1.f / (float)WIN;
            if (EDGE) { const int ts = ts0 + t0 + o; const int lo = max(ts - WIN / 2, 0), hi = min(ts + WIN - 1 - WIN / 2, L - 1); inv = 1.f / (float)(hi - lo + 1); }
            AP[(size_t)(row0 + t0 + o) * 256 + c] = f2bf(sum * inv - in[o + WIN / 2]);
            if (o < 15) sum += in[o + WIN] - in[o];
        }
    }
}
template <bool EDGE>
DI void pre_unit_t(const Params& p, LAS char* shm, int l, int row0, int ts0, int L, const float (&w)[31], const float bias, const int wv_) {
    const int tid = otid();
    const bf16_t* P = (const bf16_t*)(p.ws + WS_P);
    const int c = tid & 255, half = tid >> 8;
    LAS bf16_t* cin = (LAS bf16_t*)shm;
    LAS float* cv = (LAS float*)(shm + 49152);
    u32x4 creg[6], preg[5];
#pragma unroll
    for (int it = 0; it < 6; ++it) { const int q = it * 512 + tid, row = q >> 5, part = q & 31; const int ts = ts0 - 15 + row;
        creg[it] = (u32x4){0u, 0u, 0u, 0u};
        if (q < 94 * 32 && (!EDGE || (ts >= 0 && ts < L))) creg[it] = *(const u32x4*)(P + (size_t)(row0 - 15 + row) * NINP + part * 8); }
#pragma unroll
    for (int it = 0; it < 5; ++it) { const int q = it * 512 + tid, row = q >> 5, part = q & 31; const int ts = ts0 - 8 + row;
        preg[it] = (u32x4){0u, 0u, 0u, 0u};
        if (!EDGE || (ts >= 0 && ts < L)) preg[it] = *(const u32x4*)(P + (size_t)(row0 - 8 + row) * NINP + OFF_POOL + part * 8); }
#pragma unroll
    for (int it = 0; it < 6; ++it) { const int q = it * 512 + tid; if (q < 94 * 32) *(LAS u32x4*)(cin + q * 8) = creg[it]; }
    __syncthreads();
    {
        const int t0 = half * 32;
        float in[62];
#pragma unroll
        for (int i = 0; i < 62; ++i) in[i] = bf2f(cin[(t0 + i) * 256 + c]);
#pragma unroll
        for (int o = 0; o < 32; ++o) { float s_ = bias;
#pragma unroll
            for (int j = 0; j < 31; ++j) s_ += w[j] * in[o + j];
            cv[(t0 + o) * 257 + c] = s_; }
    }
    __syncthreads();
#pragma unroll
    for (int it = 0; it < 5; ++it) *(LAS u32x4*)(cin + (it * 512 + tid) * 8) = preg[it];
    {
        const int wid = tid >> 6, lane = tid & 63;
        bf16_t* AC = (bf16_t*)(p.ws + WS_ACONV);
        float lg[4], lb[4];
#pragma unroll
        for (int j = 0; j < 4; ++j) { lg[j] = p.conv_ln_g[l * 256 + lane + 64 * j]; lb[j] = p.conv_ln_b[l * 256 + lane + 64 * j]; }
        float x[8][4], s8[8];
#pragma unroll
        for (int i = 0; i < 8; ++i) { s8[i] = 0.f;
#pragma unroll
            for (int j = 0; j < 4; ++j) { x[i][j] = cv[(wid * 8 + i) * 257 + lane + 64 * j]; s8[i] += x[i][j]; } }
        wave_sum_n<8>(s8);
#pragma unroll
        for (int i = 0; i < 8; ++i) { const float mu = s8[i] * (1.f / 256.f); s8[i] = 0.f;
#pragma unroll
            for (int j = 0; j < 4; ++j) { x[i][j] -= mu; s8[i] += x[i][j] * x[i][j]; } }
        wave_sum_n<8>(s8);
#pragma unroll
        for (int i = 0; i < 8; ++i) { const float rs = rsqrtf(s8[i] * (1.f / 256.f) + EPS);
#pragma unroll
            for (int j = 0; j < 4; ++j) { const float y = x[i][j] * rs * lg[j] + lb[j]; AC[(size_t)(row0 + wid * 8 + i) * 256 + lane + 64 * j] = f2bf(siluf_(y)); } }
    }
    __syncthreads();
    {
        bf16_t* AP = (bf16_t*)(p.ws + WS_APOOL);
        const int g = __builtin_amdgcn_readfirstlane(c >> 6);
        if (g == 0) pool_run<2, EDGE>(cin, AP, row0, ts0, L, c, half);
        else if (g == 1) pool_run<4, EDGE>(cin, AP, row0, ts0, L, c, half);
        else if (g == 2) pool_run<8, EDGE>(cin, AP, row0, ts0, L, c, half);
        else pool_run<16, EDGE>(cin, AP, row0, ts0, L, c, half);
    }
    __syncthreads();
}
DI void pre_unit(const Params& p, LAS char* shm, int l, int tile, const float (&w)[31], const float bias, const int wv_) {
    int row0, ts0, L;
    if (tile < 1024) { row0 = tile * 64; ts0 = row0 & 2047; L = SEQ; } else { row0 = TX + (tile - 1024) * 64; ts0 = (row0 - TX) & 255; L = CTXL; }
    if (ts0 >= 16 && ts0 + 64 + 16 <= L) pre_unit_t<false>(p, shm, l, row0, ts0, L, w, bias, wv_);
    else pre_unit_t<true>(p, shm, l, row0, ts0, L, w, bias, wv_);
}
struct PvS5State {
    const Params& p; int l;
    PV_NOHOOKS
    static constexpr int NT = 16; static constexpr int FP8 = 0; static constexpr bool PARK = false; typedef ASimple AS; typedef BSimple BS;
    DI int first() const { return lin_first(0, 80); }
    DI int next(int u) const { return lin_next(u, 80); }
    DI void src(int u, AS& as, BS& bs, const int wv_) const {
        const int g = u / 5, mt = u % 5;
        int R[2], C[2]; stage_coords(R, C, wv_);
        as.base = (const char*)(p.ws + WS_P); as.kstride = 4 * NINP * 2;
#pragma unroll
        for (int h = 0; h < 2; ++h)
#pragma unroll
            for (int i = 0; i < 2; ++i) { const int cr = min(mt * 256 + h * 128 + R[i], NCROW - 1);
                as.off[h][i] = (unsigned)(((size_t)(crow_tok(cr) + (C[i] >> 4)) * NINP + OFF_SSM + g * 16 + (C[i] & 15)) * 2); }
        const bf16_t* W = (const bf16_t*)(p.ws + WS_WS5) + (size_t)(l * 16 + g) * 256 * 1024;
        bs = make_b(W, W + (size_t)128 * 1024, 1024);
    }
    DI void epi(f32x4 (&acc)[2][2][4][2], int u, const int wv_) const {
        const int g = u / 5, mt = u % 5;
        float* SST = (float*)(p.ws + WS_SST);
        EPI_FOR8(acc, { const int cr = mt * 256 + lr; if (cr < NCROW) { float* o_ = SST + ((size_t)cr * 16 + g) * 256 + lc; *(f32x4*)o_ = v0; *(f32x4*)(o_ + 4) = v1; } });
    }
};
struct PvQKV {
    const Params& p; int l;
    PV_NOHOOKS
    static constexpr int NT = 4; static constexpr int FP8 = 0; static constexpr bool PARK = false; typedef APlain AS; typedef BSimple BS;
    DI int first() const { return lin_first(80, 1152); }
    DI int next(int u) const { return lin_next(u, 1152); }
    DI void src(int u, AS& a, BS& b, const int wv_) const {
        const bool isq = u < 576; const int w_ = isq ? u : u - 576; const int mt = w_ >> 1, nt = w_ & 1;
        a = make_a_plain((const bf16_t*)(p.ws + WS_P), (size_t)mt * 256, NINP, isq ? OFF_Q : OFF_KV);
        const bf16_t* W = (const bf16_t*)(p.ws + (isq ? WS_WQ : WS_WKV)) + (size_t)l * 512 * 256 + (size_t)nt * 256 * 256;
        b = make_b(W, W + (size_t)128 * 256, 256);
    }
    DI void epi(f32x4 (&acc)[2][2][4][2], int u, const int wv_) const {
        const bool isq = u < 576; const int w_ = isq ? u : u - 576; const int mt = w_ >> 1, nt = w_ & 1;
        bf16_t* RAW = (bf16_t*)(p.ws + (isq ? WS_RAWQ : WS_RAWKV));
        EPI_FOR8(acc, { store_bf16x8(RAW + (size_t)(mt * 256 + lr) * 512 + nt * 256 + lc, v0, v1); });
    }
};
DI void phase_A(const Params& p, LAS char* shm, int l, const int wv_) {
    { PvS5State pv{p, l}; gemm_stream(shm, pv, wv_); }
    { PvQKV pv{p, l}; gemm_stream(shm, pv, wv_); }
    { const int c_ = otid() & 255;
      float w[31];
#pragma unroll
      for (int j = 0; j < 31; ++j) w[j] = p.conv_dw[((size_t)l * 31 + j) * 256 + c_];
      const float bias = p.conv_dw_b[l * 256 + c_];
      for (int u = first_unit(80 + 1152); u < 1152; u += gridDim.x) pre_unit(p, shm, l, u, w, bias, wv_); }
}

DI void qkvpost_unit(const Params& p, LAS char* shm, int l, int unit, const int wv_) {
    const int tid = otid(), wid = tid >> 6, lane = tid & 63;
    const bf16_t* P = (const bf16_t*)(p.ws + WS_P);
    const bf16_t* RAWQ = (const bf16_t*)(p.ws + WS_RAWQ);
    const bf16_t* RAWKV = (const bf16_t*)(p.ws + WS_RAWKV);
    bf16_t* Q = (bf16_t*)(p.ws + WS_Q);
    bf16_t* KB = (bf16_t*)(p.ws + WS_KB);
    bf16_t* VT = (bf16_t*)(p.ws + WS_VT);
    LAS bf16_t* vt = (LAS bf16_t*)shm;
    const int row0 = unit * 64;
    const bool lat = row0 < TX;
    const int b = lat ? (row0 >> 11) : ((row0 - TX) >> 8);
    const int key0 = lat ? (row0 & 2047) : 2048 + ((row0 - TX) & 255);
    const int head = lane >> 4, sub = lane & 15;
    const float lninv = -9.210340371976184f / 8.f;
    const float frq = __expf(lninv * (float)(sub & 7));
    float qg[6], kg[6];
#pragma unroll
    for (int j = 0; j < 6; ++j) { qg[j] = p.mla_q_g[l * 96 + sub + 16 * j] * 0.14724444674085666f; kg[j] = p.mla_k_g[l * 96 + sub + 16 * j]; }
    constexpr int NB = 4;
    for (int tk0 = wid * 8; tk0 < wid * 8 + 8; tk0 += NB) {
        float pq[NB][3], pkv[NB][2], qr[NB][6], kr[NB][6], vr[NB][4];
#pragma unroll
        for (int i = 0; i < NB; ++i) { const int r = row0 + tk0 + i; const bf16_t* pr = P + (size_t)r * NINP;
#pragma unroll
            for (int j = 0; j < 3; ++j) pq[i][j] = bf2f(pr[OFF_Q + lane + 64 * j]);
#pragma unroll
            for (int j = 0; j < 2; ++j) pkv[i][j] = bf2f(pr[OFF_KV + lane + 64 * j]);
#pragma unroll
            for (int j = 0; j < 6; ++j) qr[i][j] = bf2f(RAWQ[(size_t)r * 512 + head * 96 + sub + 16 * j]);
#pragma unroll
            for (int j = 0; j < 4; ++j) kr[i][j] = bf2f(RAWKV[(size_t)r * 512 + head * 128 + sub + 16 * j]);
#pragma unroll
            for (int j = 4; j < 6; ++j) kr[i][j] = bf2f(pr[OFF_KPE + sub + 16 * (j - 4)]);
#pragma unroll
            for (int j = 0; j < 4; ++j) vr[i][j] = bf2f(RAWKV[(size_t)r * 512 + head * 128 + 64 + sub + 16 * j]); }
        float red[2 * NB];
#pragma unroll
        for (int i = 0; i < NB; ++i) { red[2 * i] = pq[i][0] * pq[i][0] + pq[i][1] * pq[i][1] + pq[i][2] * pq[i][2]; red[2 * i + 1] = pkv[i][0] * pkv[i][0] + pkv[i][1] * pkv[i][1]; }
        wave_sum_n<2 * NB>(red);
        float ssq[2 * NB];
#pragma unroll
        for (int i = 0; i < NB; ++i) {
            const float rq = rsqrtf(red[2 * i] * (1.f / 192.f) + EPS), rkv = rsqrtf(red[2 * i + 1] * (1.f / 128.f) + EPS);
            float s0 = 0.f, s1 = 0.f;
#pragma unroll
            for (int j = 0; j < 6; ++j) { qr[i][j] *= rq; s0 += qr[i][j] * qr[i][j]; }
#pragma unroll
            for (int j = 0; j < 4; ++j) { kr[i][j] *= rkv; s1 += kr[i][j] * kr[i][j]; }
#pragma unroll
            for (int j = 4; j < 6; ++j) s1 += kr[i][j] * kr[i][j];
#pragma unroll
            for (int j = 0; j < 4; ++j) vr[i][j] *= rkv;
            ssq[2 * i] = s0; ssq[2 * i + 1] = s1;
        }
        { const int l4 = olane();
#pragma unroll
          for (int o = 8; o > 0; o >>= 1) { float t_[2 * NB];
#pragma unroll
              for (int i = 0; i < 2 * NB; ++i) t_[i] = __int_as_float(__builtin_amdgcn_ds_bpermute((l4 ^ o) << 2, __float_as_int(ssq[i])));
#pragma unroll
              for (int i = 0; i < 2 * NB; ++i) ssq[i] += t_[i]; } }
#pragma unroll
        for (int i = 0; i < NB; ++i) {
            const int tk = tk0 + i, r = row0 + tk;
            const float rnq = rsqrtf(ssq[2 * i] * (1.f / 96.f) + EPS), rnk = rsqrtf(ssq[2 * i + 1] * (1.f / 96.f) + EPS);
#pragma unroll
            for (int j = 0; j < 6; ++j) { qr[i][j] *= rnq * qg[j]; kr[i][j] *= rnk * kg[j]; }
            if (lat) {
                const int tseq = r & 2047; const float a0 = (float)(tseq >> 6) * frq, a1 = (float)(tseq & 63) * frq;
                const float cs0 = __cosf(a0), sn0 = __sinf(a0), cs1 = __cosf(a1), sn1 = __sinf(a1);
                const float oq4 = shx(qr[i][4], 8), oq5 = shx(qr[i][5], 8), ok4 = shx(kr[i][4], 8), ok5 = shx(kr[i][5], 8);
                const float sg = (sub < 8) ? -1.f : 1.f;
                qr[i][4] = qr[i][4] * cs0 + sg * oq4 * sn0; qr[i][5] = qr[i][5] * cs1 + sg * oq5 * sn1;
                kr[i][4] = kr[i][4] * cs0 + sg * ok4 * sn0; kr[i][5] = kr[i][5] * cs1 + sg * ok5 * sn1;
            }
            bf16_t* kro = KB + ((size_t)(b * 4 + head) * 2304 + key0 + tk) * 96;
#pragma unroll
            for (int j = 0; j < 6; ++j) { Q[(size_t)r * 384 + head * 96 + sub + 16 * j] = f2bf(qr[i][j]); kro[sub + 16 * j] = f2bf(kr[i][j]); }
#pragma unroll
            for (int j = 0; j < 4; ++j) vt[(head * 64 + sub + 16 * j) * 72 + tk] = f2bf(vr[i][j]);
        }
    }
    __syncthreads();
    { const int hv = tid >> 1, hf = tid & 1;
      bf16_t* dst = VT + ((size_t)(b * 4 + (hv >> 6)) * 64 + (hv & 63)) * 2304 + key0 + hf * 32;
#pragma unroll
      for (int i = 0; i < 4; ++i) *(u32x4*)(dst + i * 8) = *(const LAS u32x4*)(vt + hv * 72 + hf * 32 + i * 8); }
    __syncthreads();
}
DI void s5carry_unit(const Params& p, int l, int unit, const int wv_) {
    const int gid = unit * 512 + otid();
    const int q = gid & 63, dir = (gid >> 6) & 1, g = (gid >> 7) & 15, b = gid >> 11;
    const float* A64 = (const float*)(p.ws + WS_A64) + (size_t)(((l * 2 + dir) * 16 + g) * 64 + q) * 2;
    const float ar = A64[0], ai = A64[1];
    const float* SST = (const float*)(p.ws + WS_SST);
    bf16_t* HIN = (bf16_t*)(p.ws + WS_HIN);
    float sr[NCH], si[NCH];
#pragma unroll
    for (int s = 0; s < NCH; ++s) { const int j = dir == 0 ? s : (s < 4 ? 3 - s : 39 - s);
        const size_t base = ((size_t)(b * NCH + j) * 16 + g) * 256 + dir * 128 + q; sr[s] = SST[base]; si[s] = SST[base + 64]; }
    float hr = 0.f, hi = 0.f;
#pragma unroll
    for (int s = 0; s < NCH; ++s) {
        const int j = dir == 0 ? s : (s < 4 ? 3 - s : 39 - s);
        const size_t base = ((size_t)(b * NCH + j) * 16 + g) * 256 + dir * 128 + q;
        HIN[base] = f2bf(hr); HIN[base + 64] = f2bf(hi);
        const float nr = ar * hr - ai * hi + sr[s], ni = ar * hi + ai * hr + si[s];
        hr = nr; hi = ni;
    }
}
struct PvConvPool {
    const Params& p; int l;
    PV_NOHOOKS
    static constexpr int NT = 4; static constexpr int FP8 = 0; static constexpr bool PARK = false; typedef APlain AS; typedef BSimple BS;
    DI int first() const { return lin_first(0, 576); }
    DI int next(int u) const { return lin_next(u, 576); }
    DI void src(int u, AS& a, BS& b, const int wv_) const {
        const bool isconv = u < 288; const int mt = isconv ? u : u - 288;
        a = make_a_plain((const bf16_t*)(p.ws + (isconv ? WS_ACONV : WS_APOOL)), (size_t)mt * 256, 256, 0);
        const bf16_t* W = (const bf16_t*)(p.ws + (isconv ? WS_WPW : WS_WPOOL)) + (size_t)l * 65536;
        b = make_b(W, W + (size_t)128 * 256, 256);
    }
    DI void epi(f32x4 (&acc)[2][2][4][2], int u, const int wv_) const {
        const bool isconv = u < 288; const int mt = isconv ? u : u - 288;
        bf16_t* CAT = (bf16_t*)(p.ws + WS_CAT);
        if (isconv) { EPI_FOR8(acc, { store_bf16x8(CAT + (size_t)(mt * 256 + lr) * 1024 + lc, v0, v1); }); }
        else { const int t_ = otid(), c0_ = ((t_ >> 6) & 3) * 32 + ((t_ & 63) >> 4) * 8; f32x4 sc_[2][2];
#pragma unroll
               for (int bj = 0; bj < 2; ++bj)
#pragma unroll
                   for (int n = 0; n < 2; ++n) sc_[bj][n] = *(const f32x4*)(p.pool_scale + l * 256 + bj * 128 + n * 4 + c0_);
               EPI_FOR8(acc, { store_bf16x8(CAT + (size_t)(mt * 256 + lr) * 1024 + 256 + lc, v0 * sc_[bj][0], v1 * sc_[bj][1]); }); }
    }
};
DI void phase_B(const Params& p, LAS char* shm, int l, const int wv_) {
    { PvConvPool pv{p, l}; gemm_stream(shm, pv, wv_); }
    const int n_post = TT / 64, n_carry = 128;
    for (int u = first_unit(576); u < n_post + n_carry; u += gridDim.x) {
        if (u < n_post) qkvpost_unit(p, shm, l, u, wv_);
        else s5carry_unit(p, l, u - n_post, wv_);
    }
}

DI void attn_unit(const Params& p, LAS char* shm, int l, int b, int h, int qrow0, int nq, int key_lo, int nkeys, const int wv_) {
    const int tid = otid(), wid = tid >> 6, lane = tid & 63, l31 = lane & 31, hh = lane >> 5;
    const bf16_t* Q = (const bf16_t*)(p.ws + WS_Q);
    const bf16_t* KBp = (const bf16_t*)(p.ws + WS_KB) + (size_t)(b * 4 + h) * 2304 * 96;
    const bf16_t* VTp = (const bf16_t*)(p.ws + WS_VT) + (size_t)(b * 4 + h) * 64 * 2304;
    bf16_t* CAT = (bf16_t*)(p.ws + WS_CAT);
    LAS char* kl = shm;
    LAS char* vl = shm + 13312;
    const bool active = wid * 64 < nq;
    float gq = 0.f, gk = 0.f;
    for (int i = lane; i < 96; i += 64) { gq = fmaxf(gq, fabsf(p.mla_q_g[l * 96 + i])); gk = fmaxf(gk, fabsf(p.mla_k_g[l * 96 + i])); }
    gq = wave_max(gq); gk = wave_max(gk);
    const float LOG2E = 1.4426950408889634f;
    const float c2 = 9.797958971132712f * gq * gk * LOG2E;
    const float sh2 = fmaxf(c2 - 64.f, 0.f);
    bf16x8 qf[2][6];
    if (active) {
#pragma unroll
        for (int qb = 0; qb < 2; ++qb)
#pragma unroll
            for (int ks = 0; ks < 6; ++ks) qf[qb][ks] = *(const bf16x8*)(Q + (size_t)(qrow0 + wid * 64 + qb * 32 + l31) * 384 + h * 96 + ks * 16 + hh * 8);
    }
    f32x16 O[2][2];
#pragma unroll
    for (int a = 0; a < 2; ++a)
#pragma unroll
        for (int c = 0; c < 2; ++c)
#pragma unroll
            for (int i = 0; i < 16; ++i) O[a][c][i] = 0.f;
    float lsum[2] = {0.f, 0.f};
    const int ntile = nkeys / 64;
    u32x4 kreg0, kreg1, vreg;
    auto load_tile = [&](int t) {
        const int key = key_lo + t * 64;
        { const int id = tid, kr = id / 12, part = id % 12; kreg0 = *(const u32x4*)(KBp + (size_t)(key + kr) * 96 + part * 8); }
        if (tid < 256) { const int id = tid + 512, kr = id / 12, part = id % 12; kreg1 = *(const u32x4*)(KBp + (size_t)(key + kr) * 96 + part * 8); }
        { const int vd = tid >> 3, part = tid & 7; vreg = *(const u32x4*)(VTp + (size_t)vd * 2304 + key + part * 8); }
    };
    auto write_tile = [&]() {
        { const int id = tid, kr = id / 12, part = id % 12; *(LAS u32x4*)(kl + kr * 208 + part * 16) = kreg0; }
        if (tid < 256) { const int id = tid + 512, kr = id / 12, part = id % 12; *(LAS u32x4*)(kl + kr * 208 + part * 16) = kreg1; }
        { const int vd = tid >> 3, part = tid & 7; *(LAS u32x4*)(vl + vd * 144 + part * 16) = vreg; }
    };
    load_tile(0);
    for (int t = 0; t < ntile; ++t) {
        __syncthreads();
        write_tile();
        __syncthreads();
        if (t + 1 < ntile) load_tile(t + 1);
        if (active) {
#pragma unroll
            for (int kb = 0; kb < 2; ++kb) {
                f32x16 S[2];
#pragma unroll
                for (int qb = 0; qb < 2; ++qb)
#pragma unroll
                    for (int i = 0; i < 16; ++i) S[qb][i] = 0.f;
#pragma unroll
                for (int ks = 0; ks < 6; ++ks) {
                    const bf16x8 a = *(const LAS bf16x8*)(kl + (kb * 32 + l31) * 208 + ks * 32 + hh * 16);
#pragma unroll
                    for (int qb = 0; qb < 2; ++qb) S[qb] = __builtin_amdgcn_mfma_f32_32x32x16_bf16(a, qf[qb][ks], S[qb], 0, 0, 0);
                }
                bf16x8 pf[2][2];
#pragma unroll
                for (int qb = 0; qb < 2; ++qb) {
                    float e[16];
#pragma unroll
                    for (int i = 0; i < 16; ++i) { e[i] = __builtin_amdgcn_exp2f(S[qb][i] - sh2); lsum[qb] += e[i]; }
#pragma unroll
                    for (int s = 0; s < 2; ++s) { u32x4 w; w.x = pk_bf16(e[8 * s], e[8 * s + 1]); w.y = pk_bf16(e[8 * s + 2], e[8 * s + 3]); w.z = pk_bf16(e[8 * s + 4], e[8 * s + 5]); w.w = pk_bf16(e[8 * s + 6], e[8 * s + 7]);
                        pf[qb][s] = __builtin_bit_cast(bf16x8, w); }
                }
#pragma unroll
                for (int s = 0; s < 2; ++s) {
                    const int kk = kb * 2 + s;
#pragma unroll
                    for (int vb = 0; vb < 2; ++vb) {
                        const s16x4 lo = *(const LAS s16x4*)(vl + (vb * 32 + l31) * 144 + (16 * kk + 4 * hh) * 2);
                        const s16x4 hi = *(const LAS s16x4*)(vl + (vb * 32 + l31) * 144 + (16 * kk + 8 + 4 * hh) * 2);
                        const bf16x8 va = __builtin_shufflevector(lo, hi, 0, 1, 2, 3, 4, 5, 6, 7);
#pragma unroll
                        for (int qb = 0; qb < 2; ++qb) O[vb][qb] = __builtin_amdgcn_mfma_f32_32x32x16_bf16(va, pf[qb][s], O[vb][qb], 0, 0, 0);
                    }
                }
            }
        }
    }
    if (active) {
#pragma unroll
        for (int qb = 0; qb < 2; ++qb) {
            const float tot = lsum[qb] + shx(lsum[qb], 32);
            const float inv = 1.f / tot;
            bf16_t* orow = CAT + (size_t)(qrow0 + wid * 64 + qb * 32 + l31) * 1024 + 768 + h * 64;
#pragma unroll
            for (int vb = 0; vb < 2; ++vb)
#pragma unroll
                for (int i4 = 0; i4 < 4; ++i4)
                    store_bf16x4(orow + vb * 32 + 8 * i4 + 4 * hh, O[vb][qb][4 * i4] * inv, O[vb][qb][4 * i4 + 1] * inv, O[vb][qb][4 * i4 + 2] * inv, O[vb][qb][4 * i4 + 3] * inv);
        }
    }
    __syncthreads();
}
struct PvS5Out {
    const Params& p; int l;
    PV_NOHOOKS
    static constexpr int NT = 20; static constexpr int FP8 = 0; static constexpr bool PARK = false; typedef ASeg2 AS; typedef BSimple BS;
    DI int first() const { return lin_first(512, 320); }
    DI int next(int u) const { return lin_next(u, 320); }
    DI void src(int u, AS& as, BS& bs, const int wv_) const {
        const int ntile = u & 3, mt = (u >> 2) % 5, g = u / 20;
        int R[2], C[2]; stage_coords(R, C, wv_);
        as.base0 = (const char*)(p.ws + WS_P); as.base1 = (const char*)(p.ws + WS_HIN); as.ks0 = 4 * NINP * 2; as.nt0 = 16;
#pragma unroll
        for (int h = 0; h < 2; ++h)
#pragma unroll
            for (int i = 0; i < 2; ++i) { const int cr = min(mt * 256 + h * 128 + R[i], NCROW - 1);
                as.off0[h][i] = (unsigned)(((size_t)(crow_tok(cr) + (C[i] >> 4)) * NINP + OFF_SSM + g * 16 + (C[i] & 15)) * 2);
                as.off1[h][i] = (unsigned)((((size_t)cr * 16 + g) * 256 + C[i]) * 2); }
        const bf16_t* W = (const bf16_t*)(p.ws + WS_TS5) + ((size_t)(l * 16 + g) * 1024 + ntile * 256) * 1280;
        bs = make_b(W, W + (size_t)128 * 1280, 1280);
    }
    DI void epi(f32x4 (&acc)[2][2][4][2], int u, const int wv_) const {
        const int ntile = u & 3, mt = (u >> 2) % 5, g = u / 20;
        bf16_t* Z = (bf16_t*)(p.ws + WS_Z);
        EPI_FOR8(acc, { const int cr = mt * 256 + lr; if (cr < NCROW) { const int col = ntile * 256 + lc, t = col >> 4, co = col & 15;
            const f32x4 g0 = (f32x4){gelu_tanh(v0[0]), gelu_tanh(v0[1]), gelu_tanh(v0[2]), gelu_tanh(v0[3])}, g1_ = (f32x4){gelu_tanh(v1[0]), gelu_tanh(v1[1]), gelu_tanh(v1[2]), gelu_tanh(v1[3])};
            store_bf16x8(Z + (size_t)(crow_tok(cr) + t) * 256 + g * 16 + co, g0, g1_); } });
    }
};
DI void phase_C(const Params& p, LAS char* shm, int l, const int wv_) {
    for (int u = blockIdx.x; u < 512; u += gridDim.x) { const int qb = u & 3, h = (u >> 2) & 3, b = u >> 4;
        attn_unit(p, shm, l, b, h, b * SEQ + qb * 512, 512, 0, 2304, wv_); }
    { PvS5Out pv{p, l}; gemm_stream(shm, pv, wv_); }
    if (l == 0) for (int u = first_unit(512 + 320); u < 128; u += gridDim.x) { const int h = u & 3, b = u >> 2;
        attn_unit(p, shm, l, b, h, TX + b * CTXL, 256, 2048, 256, wv_); }
}

struct PvGlu {
    const Params& p; int l;
    PV_NOHOOKS
    static constexpr int NT = 4; static constexpr int FP8 = 0; static constexpr bool PARK = false; typedef APlain AS; typedef BSimple BS;
    DI int first() const { return lin_first(0, 288); }
    DI int next(int u) const { return lin_next(u, 288); }
    DI void src(int u, AS& a, BS& b, const int wv_) const {
        a = make_a_plain((const bf16_t*)(p.ws + WS_Z), (size_t)u * 256, 256, 0);
        const bf16_t* W = (const bf16_t*)(p.ws + WS_WGLU) + (size_t)l * 65536;
        b = make_b(W, W + (size_t)128 * 256, 256);
    }
    DI void epi(f32x4 (&acc)[2][2][4][2], int u, const int wv_) const {
        const bf16_t* Z = (const bf16_t*)(p.ws + WS_Z); bf16_t* CAT = (bf16_t*)(p.ws + WS_CAT);
        const int _tz = otid(), _w = _tz >> 6, _l = _tz & 63, _wr = _w >> 2, _wc = _w & 3, _fr = _l & 15, _fq = _l >> 4;
        const int c0 = _wc * 32 + _fq * 8;
        f32x4 bsv[2][2];
#pragma unroll
        for (int bj = 0; bj < 2; ++bj)
#pragma unroll
            for (int n = 0; n < 2; ++n) bsv[bj][n] = *(const f32x4*)(p.ssm_glu_b + l * 256 + bj * 128 + n * 4 + c0);
#pragma unroll
        for (int ai = 0; ai < 2; ++ai) {
            u32x4 zz[4][2];
#pragma unroll
            for (int m = 0; m < 4; ++m)
#pragma unroll
                for (int bj = 0; bj < 2; ++bj) zz[m][bj] = *(const u32x4*)(Z + (size_t)(u * 256 + ai * 128 + _wr * 64 + m * 16 + _fr) * 256 + bj * 128 + c0);
#pragma unroll
            for (int m = 0; m < 4; ++m) { const size_t r = (size_t)(u * 256 + ai * 128 + _wr * 64 + m * 16 + _fr);
#pragma unroll
                for (int bj = 0; bj < 2; ++bj) { const f32x4 a0 = acc[ai][bj][m][0], a1 = acc[ai][bj][m][1]; const f32x4 b0 = bsv[bj][0], b1 = bsv[bj][1]; const u32x4 z_ = zz[m][bj];
                    const f32x4 o0 = (f32x4){bflo(z_.x) * sigmoidf_(a0[0] + b0[0]), bfhi(z_.x) * sigmoidf_(a0[1] + b0[1]), bflo(z_.y) * sigmoidf_(a0[2] + b0[2]), bfhi(z_.y) * sigmoidf_(a0[3] + b0[3])};
                    const f32x4 o1 = (f32x4){bflo(z_.z) * sigmoidf_(a1[0] + b1[0]), bfhi(z_.z) * sigmoidf_(a1[1] + b1[1]), bflo(z_.w) * sigmoidf_(a1[2] + b1[2]), bfhi(z_.w) * sigmoidf_(a1[3] + b1[3])};
                    store_bf16x8(CAT + r * 1024 + 512 + bj * 128 + c0, o0, o1); } }
        }
    }
};
DI void phase_D(const Params& p, LAS char* shm, int l, const int wv_) {
    PvGlu pv{p, l}; gemm_stream(shm, pv, wv_);
}

struct PvOutproj {
    const Params& p; int l;
    PV_NOHOOKS
    static constexpr int NT = 16; static constexpr int FP8 = 0; static constexpr bool PARK = false; typedef APlain AS; typedef BSimple BS;
    XcdDeal<4, 4> deal;
    DI int first() const { return deal.first(); }
    DI int next(int u) const { return deal.next(u); }
    DI void src(int u, AS& a, BS& b, const int wv_) const {
        int mt, nt; deal.decode(u, mt, nt);
        const bf16_t* W = (const bf16_t*)(p.ws + WS_WMO) + (size_t)l * 1024 * 1024;
        a = make_a_plain((const bf16_t*)(p.ws + WS_CAT), (size_t)mt * 256, 1024, 0);
        b = make_b(W + (size_t)(nt * 256) * 1024, W + (size_t)(nt * 256 + 128) * 1024, 1024);
    }
    DI void epi(f32x4 (&acc)[2][2][4][2], int u, const int wv_) const {
        int mt, nt; deal.decode(u, mt, nt);
        bf16_t* X = (bf16_t*)(p.ws + WS_X);
        const float* MOD = (const float*)(p.ws + WS_MOD) + (size_t)l * 33 * 6144;
        const int _tz = otid(), _w = _tz >> 6, _l = _tz & 63, _wr = _w >> 2, _wc = _w & 3, _fr = _l & 15, _fq = _l >> 4;
        const int c0 = nt * 256 + _wc * 32 + _fq * 8;
        const int row0 = mt * 256;
        const float* g1p = MOD + (size_t)mod_row(row0) * 6144 + 2048 + c0;
        f32x4 g1[2][2];
#pragma unroll
        for (int bj = 0; bj < 2; ++bj)
#pragma unroll
            for (int n = 0; n < 2; ++n) g1[bj][n] = *(const f32x4*)(g1p + bj * 128 + n * 4);
        bf16_t* obase = X + (size_t)row0 * 1024;
        if (l == 0) {
            const float* xbase = row0 < TX ? p.x + (size_t)row0 * 1024 : p.ctx + (size_t)(row0 - TX) * 1024;
#pragma unroll
            for (int ai = 0; ai < 2; ++ai)
#pragma unroll
                for (int mp = 0; mp < 2; ++mp) {
                    f32x4 xv[2][2][2];
#pragma unroll
                    for (int mm = 0; mm < 2; ++mm)
#pragma unroll
                        for (int bj = 0; bj < 2; ++bj)
#pragma unroll
                            for (int n = 0; n < 2; ++n) xv[mm][bj][n] = *(const f32x4*)(xbase + (size_t)(ai * 128 + _wr * 64 + (mp * 2 + mm) * 16 + _fr) * 1024 + c0 + bj * 128 + n * 4);
#pragma unroll
                    for (int mm = 0; mm < 2; ++mm)
#pragma unroll
                        for (int bj = 0; bj < 2; ++bj)
                            store_bf16x8(obase + (size_t)(ai * 128 + _wr * 64 + (mp * 2 + mm) * 16 + _fr) * 1024 + c0 + bj * 128,
                                         xv[mm][bj][0] + g1[bj][0] * acc[ai][bj][mp * 2 + mm][0], xv[mm][bj][1] + g1[bj][1] * acc[ai][bj][mp * 2 + mm][1]);
                }
        } else {
#pragma unroll
            for (int ai = 0; ai < 2; ++ai) {
                u32x4 xv[4][2];
#pragma unroll
                for (int m = 0; m < 4; ++m)
#pragma unroll
                    for (int bj = 0; bj < 2; ++bj) xv[m][bj] = *(const u32x4*)(obase + (size_t)(ai * 128 + _wr * 64 + m * 16 + _fr) * 1024 + c0 + bj * 128);
#pragma unroll
                for (int m = 0; m < 4; ++m)
#pragma unroll
                    for (int bj = 0; bj < 2; ++bj) { const u32x4 x_ = xv[m][bj];
                        const f32x4 x0 = (f32x4){bflo(x_.x), bfhi(x_.x), bflo(x_.y), bfhi(x_.y)}, x1 = (f32x4){bflo(x_.z), bfhi(x_.z), bflo(x_.w), bfhi(x_.w)};
                        store_bf16x8(obase + (size_t)(ai * 128 + _wr * 64 + m * 16 + _fr) * 1024 + c0 + bj * 128, x0 + g1[bj][0] * acc[ai][bj][m][0], x1 + g1[bj][1] * acc[ai][bj][m][1]); }
            }
        }
    }
};
DI void phase_E(const Params& p, LAS char* shm, int l, const int wv_) {
    PvOutproj pv{p, l, {(l == 1 ? TX : TT) / 256}}; gemm_stream(shm, pv, wv_);
}

template <int S> DI float row_rot_f(float v) { return __int_as_float(__builtin_amdgcn_update_dpp(0, __float_as_int(v), 0x120 | S, 0xf, 0xf, false)); }
template <int S> DI int row_rot_i(int v) { return __builtin_amdgcn_update_dpp(0, v, 0x120 | S, 0xf, 0xf, false); }
template <int S> struct RankAcc {
    static DI void run(float o0, float o1, int oe, float v0, float v1, int e0, int& r0, int& r1) {
        const float a0 = S ? row_rot_f<S>(o0) : o0, a1 = S ? row_rot_f<S>(o1) : o1; const int ae = S ? row_rot_i<S>(oe) : oe;
        r0 += (a0 > v0 || (a0 == v0 && ae < e0)) ? 1 : 0;
        r0 += (a1 > v0) ? 1 : 0;
        r1 += (a0 > v1 || a0 == v1) ? 1 : 0;
        r1 += (a1 > v1 || (a1 == v1 && ae < e0)) ? 1 : 0;
        RankAcc<S + 1>::run(o0, o1, oe, v0, v1, e0, r0, r1);
    }
};
template <> struct RankAcc<16> { static DI void run(float, float, int, float, float, int, int&, int&) {} };
DI float row_sum16(float v) { v += row_rot_f<8>(v); v += row_rot_f<4>(v); v += row_rot_f<2>(v); v += row_rot_f<1>(v); return v; }
DI float row_max16(float v) { v = fmaxf(v, row_rot_f<8>(v)); v = fmaxf(v, row_rot_f<4>(v)); v = fmaxf(v, row_rot_f<2>(v)); v = fmaxf(v, row_rot_f<1>(v)); return v; }

DI void phase_router(const Params& p, LAS char* shm, int l, const int wv_) {
    const int tid = otid(), wid = tid >> 6, lane = tid & 63;
    const int Tm = (l == 1) ? TX : TT;
    const bf16_t* X = (const bf16_t*)(p.ws + WS_X);
    const float* MOD = (const float*)(p.ws + WS_MOD) + (size_t)l * 33 * 6144;
    unsigned char* H8 = (unsigned char*)(p.ws + WS_H);
    const bool alt = p.ph_lo != 0;
    int* CNT = (int*)(p.ws + WS_CNT) + l * 32 + (alt ? 64 : 0);
    int* LIST = alt ? (int*)(p.ws + WS_RY) : (int*)(p.ws + WS_LIST);
    LAS char* wfr = shm;
    LAS bf16_t* gml = (LAS bf16_t*)(shm + 131072);
    LAS bf16_t* shl = gml + 1024;
    LAS float* cvec = (LAS float*)(shm + 131072 + 4096);
    LAS int* lcnt = (LAS int*)(cvec + 32);
    LAS int* lbase = lcnt + 32;
    LAS unsigned* lrec = (LAS unsigned*)(lbase + 32);
    LAS float* lwt = (LAS float*)(lrec + 1152);
    const int tpw = (Tm + gridDim.x - 1) / gridDim.x;
    const int tbeg = blockIdx.x * tpw, tend = min(tbeg + tpw, Tm);
    if (tid < 32) lcnt[tid] = 0;
    int seg_beg = tbeg;
    while (seg_beg < tend) {
        const int mrow = mod_row(seg_beg);
        int seg_end = tend;
        if (mrow < 32) seg_end = min(tend, (mrow + 1) * SEQ); else seg_end = tend;
        const float* mr = MOD + (size_t)mrow * 6144;
        __syncthreads();
        for (int k = tid; k < 1024; k += 512) { const float gmv = p.norm2_g[l * 1024 + k] * (1.f + mr[4096 + k]); gml[k] = f2bf(gmv); shl[k] = f2bf(mr[3072 + k]); }
        for (int i = tid; i < 1024 * 8; i += 512) {
            const int k = i >> 3, e4 = (i & 7) * 4;
            const float gmv = p.norm2_g[l * 1024 + k] * (1.f + mr[4096 + k]);
            const f32x4 w = *(const f32x4*)(p.router_w + (size_t)l * 32768 + k * 32 + e4);
            const int ks = k >> 5, kq = (k >> 3) & 3, j = k & 7;
#pragma unroll
            for (int c = 0; c < 4; ++c) { const int e = e4 + c, nb = e >> 4, ei = e & 15; const float wv = w[c] * gmv;
                const bf16_t hi = f2bf(wv); const bf16_t lo = f2bf(wv - bf2f(hi));
                LAS bf16_t* dst = (LAS bf16_t*)(wfr + ((size_t)((ks * 2 + nb) * 2) * 64 + (kq * 16 + ei)) * 16) + j;
                dst[0] = hi; dst[64 * 8] = lo; }
        }
        {
            float s4[4] = {0.f, 0.f, 0.f, 0.f};
            for (int k = lane; k < 1024; k += 64) { const float shv = mr[3072 + k]; const f32x4 w = *(const f32x4*)(p.router_w + (size_t)l * 32768 + k * 32 + wid * 4);
                s4[0] += shv * w[0]; s4[1] += shv * w[1]; s4[2] += shv * w[2]; s4[3] += shv * w[3]; }
#pragma unroll
            for (int c = 0; c < 4; ++c) { const float t_ = wave_sum(s4[c]); if (lane == 0) cvec[wid * 4 + c] = t_ + p.router_b[l * 32 + wid * 4 + c]; }
        }
        __syncthreads();
        const int ngroups = (seg_end - seg_beg) >> 4;
        for (int gi = wid; gi < ngroups; gi += 8) {
            const int t0 = seg_beg + gi * 16;
            const int tok = lane & 15, kq = lane >> 4;
            const bf16_t* xr = X + (size_t)(t0 + tok) * 1024 + kq * 8;
            f32x4 acc0 = {0.f, 0.f, 0.f, 0.f}, acc1 = {0.f, 0.f, 0.f, 0.f};
            float ss = 0.f;
#pragma unroll 8
            for (int ks = 0; ks < 32; ++ks) {
                const u32x4 xh = *(const u32x4*)(xr + ks * 32);
                const float x0 = bflo(xh.x), x1 = bfhi(xh.x), x2 = bflo(xh.y), x3 = bfhi(xh.y), x4 = bflo(xh.z), x5 = bfhi(xh.z), x6 = bflo(xh.w), x7 = bfhi(xh.w);
                ss += x0 * x0 + x1 * x1 + x2 * x2 + x3 * x3 + x4 * x4 + x5 * x5 + x6 * x6 + x7 * x7;
                const bf16x8 ah = __builtin_bit_cast(bf16x8, xh);
                const LAS char* wb = wfr + (size_t)(ks * 4) * 1024 + lane * 16;
                const bf16x8 b0h = *(const LAS bf16x8*)(wb), b0l = *(const LAS bf16x8*)(wb + 1024), b1h = *(const LAS bf16x8*)(wb + 2048), b1l = *(const LAS bf16x8*)(wb + 3072);
                acc0 = __builtin_amdgcn_mfma_f32_16x16x32_bf16(ah, b0h, acc0, 0, 0, 0); acc0 = __builtin_amdgcn_mfma_f32_16x16x32_bf16(ah, b0l, acc0, 0, 0, 0);
                acc1 = __builtin_amdgcn_mfma_f32_16x16x32_bf16(ah, b1h, acc1, 0, 0, 0); acc1 = __builtin_amdgcn_mfma_f32_16x16x32_bf16(ah, b1l, acc1, 0, 0, 0);
            }
            ss += shx(ss, 16); ss += shx(ss, 32);
            const float rn = rsqrtf(ss * (1.f / 1024.f) + EPS);
            const int ei = lane & 15;
            const float c0v = cvec[ei], c1v = cvec[16 + ei];
#pragma unroll
            for (int r = 0; r < 4; ++r) {
                const int tl = (lane >> 4) * 4 + r;
                const float rnt = shi(rn, tl);
                float v0 = fminf(fmaxf(acc0[r] * rnt + c0v, -1e30f), 1e30f), v1 = fminf(fmaxf(acc1[r] * rnt + c1v, -1e30f), 1e30f);
                int r0 = 0, r1 = 0;
                RankAcc<0>::run(v0, v1, ei, v0, v1, ei, r0, r1);
                const float mx = row_max16(fmaxf(v0, v1));
                const bool s0 = r0 < 4, s1 = r1 < 4;
                const float e0 = s0 ? __expf(v0 - mx) : 0.f, e1 = s1 ? __expf(v1 - mx) : 0.f;
                const float inv = 1.f / row_sum16(e0 + e1);
                const int t = t0 + tl;
                if (s0) { const int pos = atomicAdd((int*)&lcnt[ei], 1); lrec[(t - tbeg) * 4 + r0] = (unsigned)ei | ((unsigned)pos << 8); lwt[(t - tbeg) * 4 + r0] = e0 * inv; }
                if (s1) { const int pos = atomicAdd((int*)&lcnt[16 + ei], 1); lrec[(t - tbeg) * 4 + r1] = (unsigned)(16 + ei) | ((unsigned)pos << 8); lwt[(t - tbeg) * 4 + r1] = e1 * inv; }
            }
            unsigned char* hr = H8 + (size_t)(t0 + tok) * 1024 + kq * 8;
#pragma unroll 8
            for (int ks = 0; ks < 32; ++ks) {
                const u32x4 xh = *(const u32x4*)(xr + ks * 32);
                const u32x4 gq = *(const LAS u32x4*)(gml + ks * 32 + kq * 8), sq = *(const LAS u32x4*)(shl + ks * 32 + kq * 8);
                float h[8];
                h[0] = bflo(xh.x) * rn * bflo(gq.x) + bflo(sq.x); h[1] = bfhi(xh.x) * rn * bfhi(gq.x) + bfhi(sq.x); h[2] = bflo(xh.y) * rn * bflo(gq.y) + bflo(sq.y); h[3] = bfhi(xh.y) * rn * bfhi(gq.y) + bfhi(sq.y);
                h[4] = bflo(xh.z) * rn * bflo(gq.z) + bflo(sq.z); h[5] = bfhi(xh.z) * rn * bfhi(gq.z) + bfhi(sq.z); h[6] = bflo(xh.w) * rn * bflo(gq.w) + bflo(sq.w); h[7] = bfhi(xh.w) * rn * bfhi(gq.w) + bfhi(sq.w);
#pragma unroll
                for (int i = 0; i < 8; ++i) h[i] = __builtin_amdgcn_fmed3f(h[i], -448.f, 448.f);
                u32x2 o; o.x = pk_fp8x4(h[0], h[1], h[2], h[3]); o.y = pk_fp8x4(h[4], h[5], h[6], h[7]);
                *(u32x2*)(hr + ks * 32) = o;
            }
        }
        seg_beg = seg_end;
    }
    __syncthreads();
    if (tid < 32) lbase[tid] = atomicAdd(&CNT[tid], lcnt[tid]);
    __syncthreads();
    for (int i = tid; i < (tend - tbeg) * 4; i += 512) { const unsigned rec = lrec[i]; const int e = rec & 255, pos = rec >> 8;
        u32x2 ent; ent.x = (unsigned)(tbeg * 4 + i); ent.y = __float_as_uint(lwt[i]);
        *(u32x2*)(LIST + ((size_t)e * TT + lbase[e] + pos) * 2) = ent; }
    __syncthreads();
}

DI void moe_tiles(const Params& p, LAS int* tstart, int l, const int wv_) {
    const int* CNT = (const int*)(p.ws + WS_CNT) + l * 32;
    if (otid() == 0) { int s = 0; for (int e = 0; e < 32; ++e) { tstart[e] = s; s += (CNT[e] + 255) >> 8; } tstart[32] = s; }
    __syncthreads();
}
DI int moe_find(const LAS int* tstart, int mt) { int e = 0;
#pragma unroll
    for (int i = 1; i < 32; ++i) e += (mt >= tstart[i]) ? 1 : 0;
    return e; }
struct PvMoe1 {
    const Params& p; int l; const LAS int* tstart; LAS char* tbl;
    static constexpr int NT = 8; static constexpr int FP8 = 2; static constexpr bool PARK = false; typedef ASimple AS; typedef BSimple BS;
    XcdDeal<4, 8> deal;
    DI int first() const { return deal.first(); }
    DI int next(int u) const { return deal.next(u); }
    typedef u32x4 Aux;
    DI void top(int u, Aux& aux, const int wv_) const {
        int mt, n8; deal.decode(u, mt, n8);
        const int e = moe_find(tstart, mt);
        const int t_ = otid() & 63;
        aux = aload128(p.exp_b_in + (size_t)(l * NE + e) * 2048 + (t_ < 32 ? n8 * 128 + t_ * 4 : 1024 + n8 * 128 + (t_ - 32) * 4));
    }
    DI void mid(Aux& aux, const int wv_) const { const int t_ = otid(); asm volatile("" : "+v"(aux)); if (t_ < 64) *(LAS u32x4*)(tbl + t_ * 16) = aux; }
    DI void fix(AS& as, bool wait, const int wv_) const {
        if (wait) asm volatile("s_waitcnt vmcnt(0)" ::: "memory");
        int R[2], C[2]; stage_coords(R, C, wv_);
#pragma unroll
        for (int h = 0; h < 2; ++h)
#pragma unroll
            for (int i = 0; i < 2; ++i) { unsigned sl = as.off[h][i]; asm volatile("" : "+v"(sl)); as.off[h][i] = (sl >> 2) * 1024u + (unsigned)(C[i] * 2); }
    }
    DI void src(int u, AS& as, BS& bs, const int wv_) const {
        int mt, n8; deal.decode(u, mt, n8);
        const int e = moe_find(tstart, mt);
        const int r0 = (mt - tstart[e]) * 256, cnt = ((const int*)(p.ws + WS_CNT))[l * 32 + e];
        const int* lst = (const int*)(p.ws + WS_LIST) + (size_t)e * TT * 2;
        int R[2], C[2]; stage_coords(R, C, wv_);
        as.base = (const char*)(p.ws + WS_H); as.kstride = 128;
#pragma unroll
        for (int h = 0; h < 2; ++h)
#pragma unroll
            for (int i = 0; i < 2; ++i) as.off[h][i] = aload32(lst + 2 * min(r0 + h * 128 + R[i], cnt - 1));
        const char* W = (const char*)(p.ws + WS_W1) + (size_t)(l * NE + e) * 2048 * 1024;
        bs.base[0] = W + (size_t)(n8 * 128) * 1024; bs.base[1] = W + (size_t)(1024 + n8 * 128) * 1024; bs.ldb2 = 1024;
    }
    DI void epi(f32x4 (&acc)[2][2][4][2], int u, const int wv_) const {
        int mt, n8; deal.decode(u, mt, n8);
        const int e = moe_find(tstart, mt);
        unsigned char* ACT = (unsigned char*)(p.ws + WS_RA);
        const int _tz = otid(), _w = _tz >> 6, _l = _tz & 63, _wr = _w >> 2, _wc = _w & 3, _fr = _l & 15, _fq = _l >> 4;
        const LAS float* bin = (const LAS float*)tbl + _wc * 32 + _fq * 8;
        f32x4 bg[2], bu[2];
#pragma unroll
        for (int n = 0; n < 2; ++n) { bg[n] = *(const LAS f32x4*)(bin + n * 4); bu[n] = *(const LAS f32x4*)(bin + 128 + n * 4); }
        (void)e;
#pragma unroll
        for (int ai = 0; ai < 2; ++ai)
#pragma unroll
            for (int m = 0; m < 4; ++m) { const int lr = ai * 128 + _wr * 64 + m * 16 + _fr;
                unsigned char* orow = ACT + ((size_t)mt * 256 + lr) * 1024 + n8 * 128 + _wc * 32 + _fq * 8;
                u32x2 pk;
#pragma unroll
                for (int n = 0; n < 2; ++n) {
                    float o[4];
#pragma unroll
                    for (int r = 0; r < 4; ++r) { const float gate = fminf(__builtin_fmaf(acc[ai][0][m][n][r], 1.f / 256.f, bg[n][r]), 7.f); const float up = __builtin_amdgcn_fmed3f(__builtin_fmaf(acc[ai][1][m][n][r], 1.f / 256.f, bu[n][r]), -7.f, 7.f);
                        o[r] = (up + 1.f) * gate * __builtin_amdgcn_rcpf(1.f + __builtin_amdgcn_exp2f(-2.4554669595930156f * gate)); }
                    if (n == 0) pk.x = pk_fp8x4(o[0], o[1], o[2], o[3]); else pk.y = pk_fp8x4(o[0], o[1], o[2], o[3]); }
                *(u32x2*)orow = pk; }
    }
};
DI void phase_moe1(const Params& p, LAS char* shm, int l, const int wv_) {
    LAS int* tstart = (LAS int*)(shm + LDS_MISC + 64);
    moe_tiles(p, tstart, l, wv_);
    PvMoe1 pv{p, l, tstart, shm + 131072, {tstart[32]}}; gemm_stream(shm, pv, wv_);
}
struct PvMoe2 {
    const Params& p; int l; const LAS int* tstart; LAS char* tbl;
    static constexpr int NT = 8; static constexpr int FP8 = 2; static constexpr bool PARK = false; typedef APlain AS; typedef BSimple BS;
    XcdDeal<4, 4> deal;
    DI int first() const { return deal.first(); }
    DI int next(int u) const { return deal.next(u); }
    template <class A_> DI void fix(A_&, bool, const int) const {}
    typedef u32x4 Aux;
    DI void top(int u, Aux& aux, const int wv_) const {
        int mt, n4; deal.decode(u, mt, n4);
        const int e = moe_find(tstart, mt); const int r0 = (mt - tstart[e]) * 256;
        const int t_ = otid();
        const char* src_ = t_ < 128 ? (const char*)((const int*)(p.ws + WS_LIST) + (size_t)e * TT * 2 + (size_t)(r0 + 2 * t_) * 2)
                                    : (const char*)(p.exp_b_out + (size_t)(l * NE + e) * 1024 + n4 * 256 + ((t_ - 128) & 63) * 4);
        aux = aload128(src_);
    }
    DI void mid(Aux& aux, const int wv_) const { const int t_ = otid(); asm volatile("" : "+v"(aux)); if (t_ < 192) *(LAS u32x4*)(tbl + t_ * 16) = aux; }
    DI void src(int u, AS& as, BS& bs, const int wv_) const {
        int mt, n4; deal.decode(u, mt, n4);
        const int e = moe_find(tstart, mt);
        as.base = (const char*)(p.ws + WS_RA) + (size_t)mt * 256 * 1024; as.lda2 = 1024;
        const char* W = (const char*)(p.ws + WS_W2) + (size_t)(l * NE + e) * 1024 * 1024;
        bs.base[0] = W + (size_t)(n4 * 256) * 1024; bs.base[1] = W + (size_t)(n4 * 256 + 128) * 1024; bs.ldb2 = 1024;
    }
    DI void epi(f32x4 (&acc)[2][2][4][2], int u, const int wv_) const {
        int mt, n4; deal.decode(u, mt, n4);
        const int e = moe_find(tstart, mt);
        const int r0 = (mt - tstart[e]) * 256, cnt = ((const int*)(p.ws + WS_CNT))[l * 32 + e];
        const int* lst = (const int*)(p.ws + WS_LIST) + (size_t)e * TT * 2;
        bf16_t* Y = (bf16_t*)(p.ws + WS_RY);
        const int _tz = otid(), _w = _tz >> 6, _l = _tz & 63, _wr = _w >> 2, _wc = _w & 3, _fr = _l & 15, _fq = _l >> 4;
        const LAS float* bo = (const LAS float*)(tbl + 2048) + _wc * 32 + _fq * 8;
        u32x2 ent[2][4]; f32x4 bv[2][2];
#pragma unroll
        for (int ai = 0; ai < 2; ++ai)
#pragma unroll
            for (int m = 0; m < 4; ++m) ent[ai][m] = *(const LAS u32x2*)(tbl + (ai * 128 + _wr * 64 + m * 16 + _fr) * 8);
#pragma unroll
        for (int bj = 0; bj < 2; ++bj)
#pragma unroll
            for (int n = 0; n < 2; ++n) bv[bj][n] = *(const LAS f32x4*)(bo + bj * 128 + n * 4);
        (void)lst;
#pragma unroll
        for (int ai = 0; ai < 2; ++ai)
#pragma unroll
            for (int m = 0; m < 4; ++m) { const int lr = r0 + ai * 128 + _wr * 64 + m * 16 + _fr;
                if (lr < cnt) { const float w = __uint_as_float(ent[ai][m].y); bf16_t* orow = Y + (size_t)ent[ai][m].x * 1024 + n4 * 256 + _wc * 32 + _fq * 8;
                    const float sc_ = 1.f / 256.f;
#pragma unroll
                    for (int bj = 0; bj < 2; ++bj) store_bf16x8(orow + bj * 128, (acc[ai][bj][m][0] * sc_ + bv[bj][0]) * w, (acc[ai][bj][m][1] * sc_ + bv[bj][1]) * w); } }
    }
};
DI void phase_moe2(const Params& p, LAS char* shm, int l, const int wv_) {
    LAS int* tstart = (LAS int*)(shm + LDS_MISC + 64);
    moe_tiles(p, tstart, l, wv_);
    PvMoe2 pv{p, l, tstart, shm + 131072, {tstart[32]}}; gemm_stream(shm, pv, wv_);
}

DI void phase_combine(const Params& p, LAS char* shm, int l, const int wv_) {
    const int tid = otid(), wid = tid >> 6, lane = tid & 63;
    const bool alt = p.ph_lo != 0;
    const bf16_t* X = (const bf16_t*)(p.ws + WS_X);
    bf16_t* XO = alt ? (bf16_t*)(p.ws + WS_RA) : (bf16_t*)(p.ws + WS_X);
    float* OUT = alt ? (float*)(p.ws + WS_RA) : p.out;
    const bf16_t* Y = (const bf16_t*)(p.ws + WS_RY);
    const float* MOD = (const float*)(p.ws + WS_MOD);
    bf16_t* H = alt ? (bf16_t*)(p.ws + WS_RA + (size_t)TT * 1024 * 4) : (bf16_t*)(p.ws + WS_H);
    const int Tm = (l == 1) ? TX : TT;
    for (int r = blockIdx.x * 8 + wid; r < Tm; r += gridDim.x * 8) {
        const float* g2 = MOD + (size_t)(l * 33 + mod_row(r)) * 6144 + 5120;
        float v[16];
#pragma unroll
        for (int j = 0; j < 4; ++j) {
            const int col = j * 256 + lane * 4;
            f32x4 s = (f32x4){0.f, 0.f, 0.f, 0.f};
#pragma unroll
            for (int k = 0; k < 4; ++k) { const u32x2 yy = *(const u32x2*)(Y + ((size_t)r * 4 + k) * 1024 + col); s[0] += bflo(yy.x); s[1] += bfhi(yy.x); s[2] += bflo(yy.y); s[3] += bfhi(yy.y); }
            const u32x2 xb_ = *(const u32x2*)(X + (size_t)r * 1024 + col); const f32x4 gg = *(const f32x4*)(g2 + col);
            const f32x4 xv = (f32x4){bflo(xb_.x), bfhi(xb_.x), bflo(xb_.y), bfhi(xb_.y)};
            const f32x4 o = xv + gg * s;
            if (l == 1) *(f32x4*)(OUT + (size_t)r * 1024 + col) = o; else store_bf16x4(XO + (size_t)r * 1024 + col, o[0], o[1], o[2], o[3]);
            v[j * 4] = o[0]; v[j * 4 + 1] = o[1]; v[j * 4 + 2] = o[2]; v[j * 4 + 3] = o[3];
        }
        if (l == 0) norm_mod_store(v, p.norm1_g + 1024, MOD + (size_t)(1 * 33 + mod_row(r)) * 6144, H + (size_t)r * 1024, wv_);
    }
}

constexpr int NPH_LAYER = 10;
constexpr int NPH = 2 + 2 * NPH_LAYER;

__global__ void __launch_bounds__(512, 2) mk_forward(Params p_unused) {
    extern __shared__ __attribute__((aligned(16))) char smem_raw[];
    LAS char* shm = (LAS char*)smem_raw;
    volatile LAS unsigned* xb_words = (volatile LAS unsigned*)(shm + LDS_MISC);
    const int wv_ = __builtin_amdgcn_readfirstlane((int)(threadIdx.x >> 6));
    if (wv_ == 0 && olane() < 4) xb_words[olane()] = 0u;
    __syncthreads();
    kaptr_t ka = (kaptr_t)__builtin_amdgcn_kernarg_segment_ptr();
    const int tok0 = ptoken();
    const int lo = (int)kld64<__builtin_offsetof(Params, ph_lo)>(ka, tok0), hi = (int)kld64<__builtin_offsetof(Params, ph_hi)>(ka, tok0);
    const bool multi = (hi - lo) > 1;
    unsigned* barw = (unsigned*)((__attribute__((address_space(1))) char*)kld64<__builtin_offsetof(Params, ws)>(ka, tok0) + WS_BAR);
    XcdBarrier bar; bar.bar = barw; bar.x = 0; bar.st = xb_words;
    if (multi) bar = xcd_barrier_post(barw, xb_words, wv_);
#ifndef ONLY_KIND
#define ONLY_KIND (-1)
#endif
#define PHASE(idx, kind, FN, ...) do { if ((ONLY_KIND < 0 || ONLY_KIND == (kind)) && (idx) >= lo && (idx) < hi) { const Params p = kparams(ka, ptoken()); int nrep_ = 1 + ((MK_REPEAT_MASK >> (kind)) & 1); asm volatile("" : "+s"(nrep_)); for (int rep_ = 0; rep_ < nrep_; ++rep_) { Params p2 = p; p2.ph_lo = rep_; FN(p2, ##__VA_ARGS__, wv_); } if ((idx) + 1 < hi) xcd_barrier(bar, wv_); } } while (0)
    PHASE(0, 0, phase_prologue, shm);
    PHASE(1, 1, phase_norm1_l0);
    for (int l = 0; l < 2; ++l) {
        const int b0 = 2 + l * NPH_LAYER;
        PHASE(b0 + 0, 2, phase_inproj, shm, l);
        PHASE(b0 + 1, 3, phase_A, shm, l);
        PHASE(b0 + 2, 4, phase_B, shm, l);
        PHASE(b0 + 3, 5, phase_C, shm, l);
        PHASE(b0 + 4, 6, phase_D, shm, l);
        PHASE(b0 + 5, 7, phase_E, shm, l);
        PHASE(b0 + 6, 8, phase_router, shm, l);
        PHASE(b0 + 7, 9, phase_moe1, shm, l);
        PHASE(b0 + 8, 10, phase_moe2, shm, l);
        PHASE(b0 + 9, 11, phase_combine, shm, l);
    }
#undef PHASE
}


extern "C" void kernel_launch(void* const* d_in, const int* in_sizes, int n_in, void* d_out, int out_size, void* d_ws, size_t ws_size, hipStream_t stream) {
    static int grid = 0;
    if (grid == 0) {
        if (n_in != 39 || ws_size < WS_END) { fprintf(stderr, "kernel_launch: unexpected n_in %d or ws_size %zu (< %zu)\n", n_in, ws_size, (size_t)WS_END); grid = -1; return; }
        int dev = 0, cus = 0;
        if (hipGetDevice(&dev) != hipSuccess || hipDeviceGetAttribute(&cus, hipDeviceAttributeMultiprocessorCount, dev) != hipSuccess) { grid = -1; return; }
        if (hipFuncSetAttribute((const void*)mk_forward, hipFuncAttributeMaxDynamicSharedMemorySize, LDS_BYTES) != hipSuccess) { fprintf(stderr, "kernel_launch: hipFuncSetAttribute failed\n"); grid = -1; return; }
        int per_cu = 0;
        if (hipOccupancyMaxActiveBlocksPerMultiprocessor(&per_cu, (const void*)mk_forward, 512, LDS_BYTES) != hipSuccess || per_cu < 1) fprintf(stderr, "kernel_launch: occupancy query says %d\n", per_cu);
        (void)hipGetLastError();
        grid = cus;
    }
    if (grid < 0) return;
    (void)hipMemsetAsync((char*)d_ws + WS_BAR, 0, 16384 + 1024, stream);
    Params p{};
    const float** pf = (const float**)&p;
    for (int i = 0; i < 39; ++i) pf[i] = (const float*)d_in[i];
    p.out = (float*)d_out; p.ws = (char*)d_ws;
#if MK_ONE_LAUNCH
    p.ph_lo = 0; p.ph_hi = NPH;
    hipLaunchKernelGGL(mk_forward, dim3(grid), dim3(512), LDS_BYTES, stream, p);
#else
#ifndef MK_LAST_PHASE
#define MK_LAST_PHASE NPH
#endif
    for (int ph = 0; ph < MK_LAST_PHASE; ++ph) { p.ph_lo = ph; p.ph_hi = ph + 1; hipLaunchKernelGGL(mk_forward, dim3(grid), dim3(512), LDS_BYTES, stream, p); }
#endif
}
```

```cpp
#include <hip/hip_runtime.h>
#include <stdint.h>
#include <stdio.h>

#ifndef MK_REPEAT_MASK
#define MK_REPEAT_MASK 0x0
#endif
#ifndef MK_ONE_LAUNCH
#define MK_ONE_LAUNCH 1
#endif

#define DI __device__ __forceinline__
#define LAS __attribute__((address_space(3)))
typedef unsigned short bf16_t;
typedef short bf16x8 __attribute__((ext_vector_type(8)));
typedef short s16x4 __attribute__((ext_vector_type(4)));
typedef float f32x4 __attribute__((ext_vector_type(4)));
typedef float f32x16 __attribute__((ext_vector_type(16)));
typedef unsigned u32x2 __attribute__((ext_vector_type(2)));
typedef unsigned u32x4 __attribute__((ext_vector_type(4)));
typedef int i32x4 __attribute__((ext_vector_type(4)));
typedef int i32x8 __attribute__((ext_vector_type(8)));

constexpr int D = 1024, NB = 32, SEQ = 2048, CTXL = 256;
constexpr int TX = NB * SEQ, TC = NB * CTXL, TT = TX + TC;
constexpr int NINP = 1536;
constexpr int OFF_POOL = 512, OFF_Q = 768, OFF_SSM = 960, OFF_KV = 1216, OFF_KPE = 1344, N_IN = 1376;
constexpr int NE = 32;
constexpr int NCH = 36;
constexpr int NCROW = NB * NCH;
constexpr float EPS = 1e-6f;

constexpr size_t WS_BAR = 0;
constexpr size_t WS_CNT = 16384;
constexpr size_t WS_MOD = WS_CNT + 1024;
constexpr size_t WS_A64 = WS_MOD + (size_t)2 * 33 * 6144 * 4;
constexpr size_t WS_WMI = WS_A64 + (size_t)2 * 2 * 16 * 64 * 2 * 4;
constexpr size_t WS_WMO = WS_WMI + (size_t)2 * 1536 * 1024 * 2;
constexpr size_t WS_WPW = WS_WMO + (size_t)2 * 1024 * 1024 * 2;
constexpr size_t WS_WGLU = WS_WPW + (size_t)2 * 256 * 256 * 2;
constexpr size_t WS_WPOOL = WS_WGLU + (size_t)2 * 256 * 256 * 2;
constexpr size_t WS_WQ = WS_WPOOL + (size_t)2 * 256 * 256 * 2;
constexpr size_t WS_WKV = WS_WQ + (size_t)2 * 512 * 256 * 2;
constexpr size_t WS_TS5 = WS_WKV + (size_t)2 * 512 * 256 * 2;
constexpr size_t WS_WS5 = WS_TS5 + (size_t)2 * 16 * 1024 * 1280 * 2;
constexpr size_t WS_W1 = WS_WS5 + (size_t)2 * 16 * 256 * 1024 * 2;
constexpr size_t WS_W2 = WS_W1 + (size_t)32 * 2048 * 1024 * 2;
constexpr size_t WS_X = WS_W2 + (size_t)32 * 1024 * 1024 * 2;
constexpr size_t WS_H = WS_X + (size_t)TT * 1024 * 4;
constexpr size_t WS_LIST = WS_H + (size_t)TT * 1024 * 2;
constexpr size_t WS_TOPW = WS_LIST + (size_t)32 * TT * 8;
constexpr size_t WS_RA = WS_TOPW + (size_t)TT * 4 * 4;
constexpr float YSCALE = 32.f;
constexpr size_t WS_RY = WS_RA + (size_t)TT * 4 * 1024 * 2;
constexpr size_t WS_END = WS_RY + (size_t)TT * 4 * 1024 * 2;
constexpr size_t WS_P = WS_RA;
constexpr size_t WS_ACONV = WS_P + (size_t)TT * NINP * 2;
constexpr size_t WS_APOOL = WS_ACONV + (size_t)TT * 256 * 2;
constexpr size_t WS_RAWQ = WS_APOOL + (size_t)TT * 256 * 2;
constexpr size_t WS_RAWKV = WS_RAWQ + (size_t)TT * 512 * 4;
constexpr size_t WS_Q = WS_RAWKV + (size_t)TT * 512 * 4;
constexpr size_t WS_KB = WS_Q + (size_t)TT * 384 * 2;
constexpr size_t WS_VT = WS_KB + (size_t)128 * 2304 * 96 * 2;
constexpr size_t WS_SST = WS_VT + (size_t)128 * 64 * 2304 * 2;
constexpr size_t WS_HIN = WS_SST + (size_t)NCROW * 16 * 256 * 4;
constexpr size_t WS_Z = WS_HIN + (size_t)NCROW * 16 * 256 * 2;
constexpr size_t WS_CAT = WS_Z + (size_t)TT * 256 * 2;
constexpr size_t WS_MIX_END = WS_CAT + (size_t)TT * 1024 * 2;
static_assert(WS_MIX_END <= WS_END, "mixer buffers must fit in the ACT/Y regions");
static_assert(WS_END <= (size_t)2147483648ull, "workspace budget");

constexpr int LDS_BYTES = 147456;
constexpr int LDS_TTAB = 131072 + 4096;
constexpr int LDS_MISC = 146432;

struct Params {
    const float *x, *c, *ctx, *c_ctx, *ada_w, *ada_b, *norm1_g, *norm2_g, *w_mix_in, *w_mix_out,
        *conv_dw, *conv_dw_b, *conv_ln_g, *conv_ln_b, *conv_pw, *pool_w, *pool_scale,
        *ssm_a_re, *ssm_a_im, *ssm_log_dt, *ssm_b_re, *ssm_b_im, *ssm_c_re, *ssm_c_im, *ssm_d, *ssm_glu_w, *ssm_glu_b,
        *mla_q_a_g, *mla_wq_b, *mla_kv_a_g, *mla_wkv_b, *mla_q_g, *mla_k_g,
        *router_w, *router_b, *exp_w_in, *exp_b_in, *exp_w_out, *exp_b_out;
    float* out;
    char* ws;
    long long ph_lo, ph_hi;
};

typedef const __attribute__((address_space(4))) char* kaptr_t;
template <int OFF> DI unsigned long long kld64(kaptr_t ka, int tok) {
    unsigned long long v;
    asm("s_load_dwordx2 %0, %1, %3\n\ts_waitcnt lgkmcnt(0)" : "=&s"(v) : "s"(ka), "s"(tok), "n"(OFF));
    return v;
}
DI int ptoken() { int t; asm volatile("s_mov_b32 %0, 0" : "=s"(t)); return t; }
DI Params kparams(kaptr_t ka, int tok) {
    Params p;
#define KL_(f) p.f = (decltype(p.f))((__attribute__((address_space(1))) char*)kld64<__builtin_offsetof(Params, f)>(ka, tok))
    KL_(x); KL_(c); KL_(ctx); KL_(c_ctx); KL_(ada_w); KL_(ada_b); KL_(norm1_g); KL_(norm2_g); KL_(w_mix_in); KL_(w_mix_out); KL_(conv_dw); KL_(conv_dw_b); KL_(conv_ln_g); KL_(conv_ln_b); KL_(conv_pw); KL_(pool_w); KL_(pool_scale); KL_(ssm_a_re); KL_(ssm_a_im); KL_(ssm_log_dt); KL_(ssm_b_re); KL_(ssm_b_im); KL_(ssm_c_re); KL_(ssm_c_im); KL_(ssm_d); KL_(ssm_glu_w); KL_(ssm_glu_b); KL_(mla_q_a_g); KL_(mla_wq_b); KL_(mla_kv_a_g); KL_(mla_wkv_b); KL_(mla_q_g); KL_(mla_k_g); KL_(router_w); KL_(router_b); KL_(exp_w_in); KL_(exp_b_in); KL_(exp_w_out); KL_(exp_b_out); KL_(out); KL_(ws);
#undef KL_
    p.ph_lo = 0; p.ph_hi = 0;
    return p;
}

typedef __bf16 bf16v2_t __attribute__((ext_vector_type(2)));
typedef float f32v2_t __attribute__((ext_vector_type(2)));
DI unsigned pk_bf16(float lo, float hi) { const f32v2_t f = {lo, hi}; const bf16v2_t b = __builtin_convertvector(f, bf16v2_t); return __builtin_bit_cast(unsigned, b); }
DI bf16_t f2bf(float x) { return (bf16_t)(pk_bf16(x, 0.f) & 0xffffu); }
DI float bf2f(bf16_t v) { return __uint_as_float(((unsigned)v) << 16); }
DI unsigned f2fp8(float x) { x = fminf(fmaxf(x, -448.f), 448.f); return (unsigned)__builtin_amdgcn_cvt_pk_fp8_f32(x, x, 0, false) & 0xffu; }
DI unsigned pk_fp8x4(float a, float b, float c, float d) { int v = __builtin_amdgcn_cvt_pk_fp8_f32(a, b, 0, false); v = __builtin_amdgcn_cvt_pk_fp8_f32(c, d, v, true); return (unsigned)v; }
DI float bflo(unsigned u) { return __uint_as_float(u << 16); }
DI float bfhi(unsigned u) { return __uint_as_float(u & 0xffff0000u); }
DI int olane() { int l = (int)__builtin_amdgcn_mbcnt_hi(~0u, __builtin_amdgcn_mbcnt_lo(~0u, 0u)); asm volatile("" : "+v"(l)); return l; }
DI float shx(float v, int o) { const int l = olane(); return __int_as_float(__builtin_amdgcn_ds_bpermute((l ^ o) << 2, __float_as_int(v))); }
DI float shi(float v, int src) { return __int_as_float(__builtin_amdgcn_ds_bpermute(src << 2, __float_as_int(v))); }
#define otid() otid_(wv_)
DI int otid_(int wv) { int t = (wv << 6) | olane(); asm volatile("" : "+v"(t)); return t; }
DI float wave_sum(float v) {
#pragma unroll
    for (int o = 32; o > 0; o >>= 1) v += shx(v, o);
    return v;
}
DI float wave_max(float v) {
#pragma unroll
    for (int o = 32; o > 0; o >>= 1) v = fmaxf(v, shx(v, o));
    return v;
}
DI float sigmoidf_(float x) { return __builtin_amdgcn_rcpf(1.f + __builtin_amdgcn_exp2f(-1.4426950408889634f * x)); }
DI float siluf_(float x) { return x * sigmoidf_(x); }
DI float gelu_tanh(float x) {
    const float u = 0.7978845608028654f * (x + 0.044715f * x * x * x);
    return x * __builtin_amdgcn_rcpf(1.f + __builtin_amdgcn_exp2f(-2.8853900817779268f * u));
}
DI unsigned aload32(const void* p_) { unsigned r; asm volatile("global_load_dword %0, %1, off" : "=v"(r) : "v"(p_) : "memory"); return r; }
DI u32x4 aload128(const void* p_) { u32x4 r; asm volatile("global_load_dwordx4 %0, %1, off" : "=v"(r) : "v"(p_) : "memory"); return r; }
#define PV_NOHOOKS typedef int Aux; DI void top(int, Aux&, const int) const {} DI void mid(Aux&, const int) const {} template <class A_> DI void fix(A_&, bool, const int) const {}
DI void glds16(const void* src, LAS char* dst) {
    __builtin_amdgcn_global_load_lds((const __attribute__((address_space(1))) void*)src, (LAS void*)dst, 16, 0, 0);
}

#define XB_TMO      128
#define XB_XCNT(j)  (256  + 64 * (j))
#define XB_XSUB(j)  (1280 + 64 * (j))
#define XB_XGEN(j)  (2304 + 64 * (j))
#define XB_TOP      3328
#define XB_TOPGEN   3392
#define XCD_BAR_WORDS 3456
#define XB_SPIN_CAP (1u << 18)
__device__ __forceinline__ unsigned xb_ld(unsigned* p)              { return __hip_atomic_load(p, __ATOMIC_RELAXED, __HIP_MEMORY_SCOPE_AGENT); }
__device__ __forceinline__ unsigned xb_add(unsigned* p, unsigned v) { return __hip_atomic_fetch_add(p, v, __ATOMIC_RELAXED, __HIP_MEMORY_SCOPE_AGENT); }
__device__ __forceinline__ unsigned xb_xcc_id() { return (unsigned)__builtin_amdgcn_s_getreg((3 << 11) | 20) & 0xFu; }
#define XB_SPIN(cond, bar) do { unsigned _sp = 0; while (cond) { __builtin_amdgcn_s_sleep(1); \
    if ((++_sp & 255u) == 0u) { if (xb_ld(&(bar)[XB_TMO])) break; if (_sp > XB_SPIN_CAP) { atomicAdd(&(bar)[XB_TMO], 1u); break; } } } } while (0)
struct XcdBarrier { unsigned* bar; unsigned x; volatile LAS unsigned* st; };
__device__ __forceinline__ XcdBarrier xcd_barrier_post(unsigned* bar, volatile LAS unsigned* st, const int wv_) {
    XcdBarrier b; b.bar = bar; b.x = xb_xcc_id(); b.st = st;
    if (otid() == 0) (void)xb_add(&bar[XB_XCNT(b.x)], 1u);
    return b;
}
__device__ __forceinline__ void xcd_barrier_complete(unsigned* bar, unsigned x, unsigned& nloc, unsigned& nx) {
    const unsigned G = gridDim.x * gridDim.y * gridDim.z;
    unsigned sum, cnt, mine, sp = 0u;
    for (;;) {
        sum = 0u; cnt = 0u; mine = 0u;
#pragma unroll
        for (unsigned j = 0; j < 16; ++j) { const unsigned c = xb_ld(&bar[XB_XCNT(j)]); sum += c; cnt += (c > 0u) ? 1u : 0u; mine = (j == x) ? c : mine; }
        if (sum == G) break;
        __builtin_amdgcn_s_sleep(1);
        if ((++sp & 255u) == 0u) { if (xb_ld(&bar[XB_TMO])) break; if (sp > XB_SPIN_CAP) { atomicAdd(&bar[XB_TMO], 1u); break; } }
    }
    nloc = mine > 0u ? mine : 1u; nx = cnt > 0u ? cnt : 1u;
}
__device__ __forceinline__ void xcd_barrier(const XcdBarrier& b, const int wv_) {
    asm volatile("s_waitcnt vmcnt(0)" ::: "memory");
    __syncthreads();
    if (otid() == 0) {
        unsigned* bar = b.bar;
        __builtin_amdgcn_s_waitcnt(0);
        unsigned nloc = b.st[0], nx = b.st[1];
        if (nloc == 0u) { xcd_barrier_complete(bar, b.x, nloc, nx); b.st[0] = nloc; b.st[1] = nx; }
        const unsigned old = xb_add(&bar[XB_XSUB(b.x)], 1u);
        const unsigned gen = old / nloc;
        if (old + 1u == (gen + 1u) * nloc) {
            __builtin_amdgcn_fence(__ATOMIC_RELEASE, "agent");
            asm volatile("s_waitcnt vmcnt(0)" ::: "memory");
            const unsigned og = xb_add(&bar[XB_TOP], 1u);
            const unsigned tg = og / nx;
            if (og + 1u == (tg + 1u) * nx) xb_add(&bar[XB_TOPGEN], 1u);
            else XB_SPIN(xb_ld(&bar[XB_TOPGEN]) == tg, bar);
            __builtin_amdgcn_fence(__ATOMIC_ACQUIRE, "agent");
            xb_add(&bar[XB_XGEN(b.x)], 1u);
            asm volatile("s_waitcnt vmcnt(0)" ::: "memory");
        } else {
            XB_SPIN(xb_ld(&bar[XB_XGEN(b.x)]) == gen, bar);
            __builtin_amdgcn_fence(__ATOMIC_ACQUIRE, "agent");
            asm volatile("s_waitcnt vmcnt(0)" ::: "memory");
        }
    }
    __syncthreads();
}

constexpr int HTB = 128 * 64 * 2;
DI int lds_byte(int r, int c) { const int st = (r >> 4) * 2 + (c >> 5), rr = r & 15, cc = c & 31, ob = rr * 64 + cc * 2; return st * 1024 + (ob ^ (((ob >> 9) & 1) << 5)); }
DI void stage_rc(int b, int& R, int& C) { const int st = b / 1024, sb = b % 1024, swz = sb ^ (((sb >> 9) & 1) << 5); R = (st >> 1) * 16 + swz / 64; C = (st & 1) * 32 + (swz % 64) / 2; }

DI void stage_rc_t(int tz, int i, int& R, int& C) { stage_rc(tz * 16 + i * 8192, R, C); }
struct APlain {
    const char* base; int lda2;
    DI void park(LAS unsigned*) const {} DI void unpark(const LAS unsigned*) {} DI void take_uniform(const APlain&) {}
    DI const char* ptr(int tz, int h, int i, int kt) const { int R, C; stage_rc_t(tz, i, R, C); return base + (unsigned)((h * 128 + R) * lda2 + C * 2 + kt * 128); }
};
struct ASimple {
    const char* base; unsigned off[2][2]; unsigned kstride;
    DI void park(LAS unsigned* q) const { *(LAS u32x4*)q = (u32x4){off[0][0], off[0][1], off[1][0], off[1][1]}; }
    DI void unpark(const LAS unsigned* q) { const u32x4 v = *(const LAS u32x4*)q; off[0][0] = v.x; off[0][1] = v.y; off[1][0] = v.z; off[1][1] = v.w; }
    DI void take_uniform(const ASimple& o) { base = o.base; kstride = o.kstride; }
    DI const char* ptr(int tz, int h, int i, int kt) const { return base + (unsigned)(off[h][i] + (unsigned)kt * kstride); }
};
struct ASeg2 {
    const char* base0; const char* base1; unsigned off0[2][2]; unsigned off1[2][2]; unsigned ks0; int nt0;
    DI void park(LAS unsigned*) const {} DI void unpark(const LAS unsigned*) {} DI void take_uniform(const ASeg2&) {}
    DI const char* ptr(int tz, int h, int i, int kt) const { return kt < nt0 ? base0 + (unsigned)(off0[h][i] + (unsigned)kt * ks0) : base1 + (unsigned)(off1[h][i] + (unsigned)(kt - nt0) * 128u); }
};
DI int perm32(int rho) { const int n = rho >> 4, i = rho & 15; return 8 * (i >> 2) + 4 * n + (i & 3); }
struct BSimple {
    const char* base[2]; int ldb2;
    DI const char* ptr(int tz, int h, int i, int kt) const { int R, C; stage_rc_t(tz, i, R, C); const int Rb = (R & ~31) + perm32(R & 31); return base[h] + (unsigned)(Rb * ldb2 + C * 2 + kt * 128); }
};

struct BSeq16 {
    const char* base; int ldb2;
    DI const char* ptr(int tz, int h, int i, int kt) const { int R, C; stage_rc_t(tz, i, R, C); const int rho = R & 31;
        const int Rb = (R >> 5) * 64 + ((rho & 15) >> 2) * 16 + h * 8 + (rho >> 4) * 4 + (rho & 3); return base + (unsigned)(Rb * ldb2 + C * 2 + kt * 128); }
};

#define WAIT_V(n) asm volatile("s_waitcnt vmcnt(" #n ")" ::: "memory")
#define WAIT_L(n) asm volatile("s_waitcnt lgkmcnt(" #n ")" ::: "memory")
#define BAR_ __builtin_amdgcn_s_barrier()
#define SCHED_ __builtin_amdgcn_sched_barrier(0)

DI void zero_acc(f32x4 (&acc)[2][2][4][2]) {
#pragma unroll
    for (int a = 0; a < 2; ++a)
#pragma unroll
        for (int b = 0; b < 2; ++b)
#pragma unroll
            for (int m = 0; m < 4; ++m)
#pragma unroll
                for (int n = 0; n < 2; ++n) acc[a][b][m][n] = (f32x4){0.f, 0.f, 0.f, 0.f};
}
template <int MODE> struct FragT;
template <> struct FragT<0> {
    i32x4 lo, hi;
    DI void load(const LAS char* p0, const LAS char* p1) { lo = *(const LAS i32x4*)p0; hi = *(const LAS i32x4*)p1; }
    static DI f32x4 mma(const FragT& b, const FragT& a, f32x4 c) {
        c = __builtin_amdgcn_mfma_f32_16x16x32_bf16(__builtin_bit_cast(bf16x8, b.lo), __builtin_bit_cast(bf16x8, a.lo), c, 0, 0, 0);
        return __builtin_amdgcn_mfma_f32_16x16x32_bf16(__builtin_bit_cast(bf16x8, b.hi), __builtin_bit_cast(bf16x8, a.hi), c, 0, 0, 0); }
};
template <> struct FragT<1> {
    i32x4 lo, hi;
    DI void load(const LAS char* p0, const LAS char* p1) { lo = *(const LAS i32x4*)p0; hi = *(const LAS i32x4*)p1; }
    static DI long pk(int x, int y) { return (long)(((unsigned long long)(unsigned)y << 32) | (unsigned)x); }
    static DI f32x4 mma(const FragT& b, const FragT& a, f32x4 c) {
        c = __builtin_amdgcn_mfma_f32_16x16x32_fp8_fp8(pk(b.lo.x, b.lo.y), pk(a.lo.x, a.lo.y), c, 0, 0, 0);
        c = __builtin_amdgcn_mfma_f32_16x16x32_fp8_fp8(pk(b.lo.z, b.lo.w), pk(a.lo.z, a.lo.w), c, 0, 0, 0);
        c = __builtin_amdgcn_mfma_f32_16x16x32_fp8_fp8(pk(b.hi.x, b.hi.y), pk(a.hi.x, a.hi.y), c, 0, 0, 0);
        return __builtin_amdgcn_mfma_f32_16x16x32_fp8_fp8(pk(b.hi.z, b.hi.w), pk(a.hi.z, a.hi.w), c, 0, 0, 0); }
};
template <> struct FragT<2> {
    i32x8 v;
    DI void load(const LAS char* p0, const LAS char* p1) { const i32x4 lo = *(const LAS i32x4*)p0, hi = *(const LAS i32x4*)p1; v = __builtin_shufflevector(lo, hi, 0, 1, 2, 3, 4, 5, 6, 7); }
    static DI f32x4 mma(const FragT& b, const FragT& a, f32x4 c) {
        const int one = 0x7f7f7f7f;
        asm volatile("v_mfma_scale_f32_16x16x128_f8f6f4 %0, %1, %2, %0, %3, %3 op_sel_hi:[0,0,0]" : "+v"(c) : "v"(b.v), "v"(a.v), "v"(one));
        return c; }
};
template <class PV>
DI void gemm_stream(LAS char* shm, const PV& pv, const int wv_) {
    typedef typename PV::AS AS; typedef typename PV::BS BS;
    constexpr int nt = PV::NT;
    int u = pv.first();
    if (u < 0) return;
    const int tz = otid();
    const int wr = wv_ >> 2, wc = wv_ & 3, lane = tz & 63, fr = lane & 15, fq = lane >> 4;
    const int aoff = lds_byte(wr * 64 + fr, fq * 8), boff = lds_byte(wc * 32 + fr, fq * 8);
    const unsigned ldsw = (unsigned)wv_ * 1024u;
    f32x4 acc[2][2][4][2]; zero_acc(acc);
    typedef FragT<PV::FP8> Frag;
    Frag At[4], B0[2], B1[2];
    AS ca, na; BS cb, nb;
    pv.src(u, ca, cb, wv_); pv.fix(ca, true, wv_);
    constexpr bool F8 = PV::FP8 != 0;
    LAS unsigned* park = (LAS unsigned*)(shm + 131072) + tz * 4;
    const int aoff0 = aoff, aoff1 = aoff + 1024;
    const int boff0 = boff, boff1 = boff + 1024;
#define SA_(b, h) (((b) * 2 + (h)) * HTB)
#define SB_(b, h) ((4 + (b) * 2 + (h)) * HTB)
#define STG_(bufoff, S, h, kt) do { _Pragma("unroll") for (int i_ = 0; i_ < 2; ++i_) glds16((S).ptr(tz, h, i_, kt), shm + (bufoff) + ldsw + i_ * 8192); } while (0)
#define LDA_(dst, b, h) do { _Pragma("unroll") for (int m = 0; m < 4; ++m) dst[m].load(shm + SA_(b, h) + aoff0 + m * 2048, shm + SA_(b, h) + aoff1 + m * 2048); } while (0)
#define LDB_(dst, b, h) do { _Pragma("unroll") for (int n = 0; n < 2; ++n) dst[n].load(shm + SB_(b, h) + boff0 + n * 2048, shm + SB_(b, h) + boff1 + n * 2048); } while (0)
#define MMAS_(ai, bj, A_, B_, STGSTMT) do { __builtin_amdgcn_s_setprio(1); \
        acc[ai][bj][0][0] = Frag::mma(B_[0], A_[0], acc[ai][bj][0][0]); acc[ai][bj][0][1] = Frag::mma(B_[1], A_[0], acc[ai][bj][0][1]); \
        STGSTMT; \
        _Pragma("unroll") for (int m = 1; m < 4; ++m) _Pragma("unroll") for (int n = 0; n < 2; ++n) { \
            acc[ai][bj][m][n] = Frag::mma(B_[n], A_[m], acc[ai][bj][m][n]); } \
        __builtin_amdgcn_s_setprio(0); } while (0)
    STG_(SB_(0, 0), cb, 0, 0); STG_(SA_(0, 0), ca, 0, 0); STG_(SB_(0, 1), cb, 1, 0); STG_(SA_(0, 1), ca, 1, 0);
    if (wr == 1) BAR_;
    WAIT_V(4); BAR_;
    STG_(SB_(1, 0), cb, 0, 1); STG_(SA_(1, 0), ca, 0, 1); STG_(SB_(1, 1), cb, 1, 1);
    WAIT_V(6); BAR_;
#define ZQ_(ai, bj) do { _Pragma("unroll") for (int m_ = 0; m_ < 4; ++m_) _Pragma("unroll") for (int n_ = 0; n_ < 2; ++n_) acc[ai][bj][m_][n_] = (f32x4){0.f, 0.f, 0.f, 0.f}; } while (0)
    int un = -1; bool has_next = false;
    na = ca; nb = cb;
    for (;;) {
        typename PV::Aux aux;
#pragma clang loop unroll(disable)
        for (int t = 0; t < nt; t += 2) {
            const bool last = (t == nt - 2);
            if (last && has_next) pv.fix(na, false, wv_);
            AS a2 = last ? na : ca; const BS b2 = last ? nb : cb; const int k2 = last ? 0 : t + 2;
            LDB_(B0, 0, 0); SCHED_; LDA_(At, 0, 0);
            if (t == 0) ZQ_(0, 0);
            WAIT_L(8); BAR_; WAIT_L(0); MMAS_(0, 0, At, B0, STG_(SA_(1, 1), ca, 1, t + 1)); BAR_; SCHED_;
            LDB_(B1, 0, 1);
            if (t == 0) { ZQ_(0, 1); pv.top(u, aux, wv_); }
            BAR_; WAIT_L(0); MMAS_(0, 1, At, B1, STG_(SB_(0, 0), b2, 0, k2)); BAR_;
            LDA_(At, 0, 1);
            if (t == 0) ZQ_(1, 0);
            BAR_; WAIT_L(0); MMAS_(1, 0, At, B0, STG_(SA_(0, 0), a2, 0, k2)); BAR_; SCHED_;
            if (t == 0) ZQ_(1, 1);
            WAIT_V(4); BAR_; if (t == 0) pv.mid(aux, wv_); MMAS_(1, 1, At, B1, STG_(SB_(0, 1), b2, 1, k2)); BAR_;
            LDB_(B0, 1, 0); SCHED_; LDA_(At, 1, 0);
            WAIT_L(8); BAR_; WAIT_L(0); MMAS_(0, 0, At, B0, STG_(SA_(0, 1), a2, 1, k2)); BAR_; SCHED_;
            LDB_(B1, 1, 1);
            BAR_; WAIT_L(0); MMAS_(0, 1, At, B1, STG_(SB_(1, 0), b2, 0, k2 + 1)); BAR_;
            LDA_(At, 1, 1);
            BAR_; WAIT_L(0); MMAS_(1, 0, At, B0, STG_(SA_(1, 0), a2, 0, k2 + 1)); BAR_; SCHED_;
            WAIT_V(4);
            if (t == 0) { un = pv.next(u); has_next = un >= 0; if (has_next) pv.src(un, na, nb, wv_); else { na = ca; nb = cb; } }
            BAR_; MMAS_(1, 1, At, B1, STG_(SB_(1, 1), b2, 1, k2 + 1)); BAR_;
        }
        if (PV::FP8 == 2) asm volatile("s_nop 15\n\ts_nop 15" ::: "memory");
        pv.epi(acc, u, wv_);
        if (!has_next) break;
        u = un; ca = na; cb = nb;
    }
#undef ZQ_
    WAIT_V(0);
    if (wr == 0) BAR_;
    BAR_;
#undef SA_
#undef SB_
#undef STG_
#undef LDA_
#undef LDB_
#undef MMAS_
}
DI int lin_first(int shift, int count) { const int G = gridDim.x; const int u = (int)((blockIdx.x + G - (shift % G)) % G); return u < count ? u : -1; }
DI int lin_next(int u, int count) { const int un = u + (int)gridDim.x; return un < count ? un : -1; }
template <int MG, int NTL> struct XcdDeal {
    int MT;
    DI bool decode(int J, int& mt, int& nt) const { const int x = blockIdx.x & 7; const int grp = (J / (MG * NTL)) * 8 + x, w = J % (MG * NTL); mt = grp * MG + w / NTL; nt = w % NTL; return mt < MT; }
    DI int jmax() const { return ((MT + 8 * MG - 1) / (8 * MG)) * (MG * NTL); }
    DI int first() const { int J = blockIdx.x >> 3; const int per = gridDim.x >> 3, jm = jmax(); int mt, nt;
        while (J < jm && !decode(J, mt, nt)) J += per;
        return J < jm ? J : -1; }
    DI int next(int J) const { const int per = gridDim.x >> 3, jm = jmax(); int mt, nt; J += per;
        while (J < jm && !decode(J, mt, nt)) J += per;
        return J < jm ? J : -1; }
};
DI int first_unit(int shift) { const int G = gridDim.x; return (int)((blockIdx.x + G - (shift % G)) % G); }

DI void stage_coords(int (&R)[2], int (&C)[2], const int wv_) {
    const int t_ = otid();
#pragma unroll
    for (int i = 0; i < 2; ++i) stage_rc(t_ * 16 + i * 8192, R[i], C[i]);
}
DI APlain make_a_plain(const bf16_t* A, size_t row0, int lda, int col0) {
    APlain a; a.base = (const char*)(A + row0 * (size_t)lda + col0); a.lda2 = lda * 2; return a;
}
DI BSimple make_b(const bf16_t* Bt0, const bf16_t* Bt1, int ldb) {
    BSimple b; b.base[0] = (const char*)Bt0; b.base[1] = (const char*)Bt1; b.ldb2 = ldb * 2; return b;
}
#define EPI_FOR(acc, ...) do { const int _tz = otid(), _w = _tz >> 6, _l = _tz & 63, _wr = _w >> 2, _wc = _w & 3, _fr = _l & 15, _fq = _l >> 4; \
    _Pragma("unroll") for (int ai = 0; ai < 2; ++ai) _Pragma("unroll") for (int m = 0; m < 4; ++m) { const int lr = ai * 128 + _wr * 64 + m * 16 + _fr; \
    _Pragma("unroll") for (int bj = 0; bj < 2; ++bj) _Pragma("unroll") for (int n = 0; n < 2; ++n) { const int lc = bj * 128 + _wc * 32 + n * 16 + _fq * 4; const f32x4 v = acc[ai][bj][m][n]; __VA_ARGS__ } } } while (0)

DI void store_bf16x4(bf16_t* p, float a, float b, float c, float d) { u32x2 v; v.x = pk_bf16(a, b); v.y = pk_bf16(c, d); *(u32x2*)p = v; }
DI void store_bf16x8(bf16_t* p, const f32x4 a, const f32x4 b) { u32x4 v; v.x = pk_bf16(a[0], a[1]); v.y = pk_bf16(a[2], a[3]); v.z = pk_bf16(b[0], b[1]); v.w = pk_bf16(b[2], b[3]); *(u32x4*)p = v; }
#define EPI_FOR8(acc, ...) do { const int _tz = otid(), _w = _tz >> 6, _l = _tz & 63, _wr = _w >> 2, _wc = _w & 3, _fr = _l & 15, _fq = _l >> 4; \
    _Pragma("unroll") for (int ai = 0; ai < 2; ++ai) _Pragma("unroll") for (int m = 0; m < 4; ++m) { const int lr = ai * 128 + _wr * 64 + m * 16 + _fr; \
    _Pragma("unroll") for (int bj = 0; bj < 2; ++bj) { const int lc = bj * 128 + _wc * 32 + _fq * 8; const f32x4 v0 = acc[ai][bj][m][0], v1 = acc[ai][bj][m][1]; __VA_ARGS__ } } } while (0)

DI int mod_row(int r) { return r < TX ? (r >> 11) : 32; }
DI int crow_tok(int cr) { const int b = cr / NCH, j = cr - b * NCH; return j < 4 ? TX + b * CTXL + j * 64 : b * SEQ + (j - 4) * 64; }

DI void cvt_tile(LAS char* wl  , const float* src, int ld_src, int kvalid, int nvalid, const float* scale, bf16_t* dst, int ld_dst, const int wv_) {
    const int lane = otid() & 63;
    const int lr = lane >> 4, lc = (lane & 15) * 4;
    f32x4 v[16];
#pragma unroll
    for (int it = 0; it < 16; ++it) {
        const int k = it * 4 + lr;
        v[it] = (f32x4){0.f, 0.f, 0.f, 0.f};
        if (src != nullptr && k < kvalid && lc < nvalid) { v[it] = *(const f32x4*)(src + (size_t)k * ld_src + lc); if (scale) { const float s = scale[k]; v[it] *= s; } }
    }
#pragma unroll
    for (int it = 0; it < 16; ++it) {
        const int k = it * 4 + lr;
#pragma unroll
        for (int j = 0; j < 4; ++j) *(LAS bf16_t*)(wl + (lc + j) * 144 + k * 2) = f2bf(v[it][j]);
    }
    asm volatile("s_waitcnt lgkmcnt(0)" ::: "memory");
#pragma unroll
    for (int i = 0; i < 8; ++i) {
        const int q = i * 64 + lane, n = q >> 3, c = q & 7;
        const u32x4 w = *(const LAS u32x4*)(wl + n * 144 + c * 16);
        *(u32x4*)(dst + (size_t)n * ld_dst + c * 8) = w;
    }
    asm volatile("s_waitcnt lgkmcnt(0)" ::: "memory");
}
DI void cvt_tile8(LAS char* wl  , const float* src, int ld_src, unsigned char* dst, int ld_dst, const int wv_) {
    const int lane = otid() & 63;
    const int lr = lane >> 4, lc = (lane & 15) * 4;
    f32x4 v[16];
#pragma unroll
    for (int it = 0; it < 16; ++it) v[it] = *(const f32x4*)(src + (size_t)(it * 4 + lr) * ld_src + lc);
#pragma unroll
    for (int it = 0; it < 16; ++it) {
        const int k = it * 4 + lr;
#pragma unroll
        for (int j = 0; j < 4; ++j) *(LAS unsigned char*)(wl + (lc + j) * 80 + k) = (unsigned char)f2fp8(v[it][j] * 256.f);
    }
    asm volatile("s_waitcnt lgkmcnt(0)" ::: "memory");
#pragma unroll
    for (int i = 0; i < 4; ++i) {
        const int q = i * 64 + lane, n = q >> 2, c = q & 3;
        const u32x4 w = *(const LAS u32x4*)(wl + n * 80 + c * 16);
        *(u32x4*)(dst + (size_t)n * ld_dst + c * 16) = w;
    }
    asm volatile("s_waitcnt lgkmcnt(0)" ::: "memory");
}
constexpr int CVT_SMALL_TILES = 768 + 512 + 32 + 32 + 64 + 64 + 32;
constexpr int CVT_EXP_TILES = 32 * (32 * 16 + 16 * 16);
DI void cvt_small(const Params& p, LAS char* wl, int t, const int wv_) {
    char* ws = p.ws;
    if (t < 768) { const int l = t / 384, r = t % 384, nt = r / 16, kt = r % 16;
        cvt_tile(wl, p.w_mix_in + (size_t)l * 1024 * N_IN + (size_t)kt * 64 * N_IN + nt * 64, N_IN, 64, N_IN - nt * 64, nullptr,
                 (bf16_t*)(ws + WS_WMI) + ((size_t)l * 1536 + nt * 64) * 1024 + kt * 64, 1024, wv_); return; }
    t -= 768;
    if (t < 512) { const int l = t / 256, r = t % 256, nt = r / 16, kt = r % 16;
        cvt_tile(wl, p.w_mix_out + (size_t)l * 1024 * 1024 + (size_t)kt * 64 * 1024 + nt * 64, 1024, 64, 64, nullptr,
                 (bf16_t*)(ws + WS_WMO) + ((size_t)l * 1024 + nt * 64) * 1024 + kt * 64, 1024, wv_); return; }
    t -= 512;
    if (t < 32) { const int l = t / 16, r = t % 16, nt = r / 4, kt = r % 4;
        cvt_tile(wl, p.conv_pw + (size_t)l * 65536 + (size_t)kt * 64 * 256 + nt * 64, 256, 64, 64, nullptr,
                 (bf16_t*)(ws + WS_WPW) + ((size_t)l * 256 + nt * 64) * 256 + kt * 64, 256, wv_); return; }
    t -= 32;
    if (t < 32) { const int l = t / 16, r = t % 16, nt = r / 4, kt = r % 4;
        cvt_tile(wl, p.ssm_glu_w + (size_t)l * 65536 + (size_t)kt * 64 * 256 + nt * 64, 256, 64, 64, nullptr,
                 (bf16_t*)(ws + WS_WGLU) + ((size_t)l * 256 + nt * 64) * 256 + kt * 64, 256, wv_); return; }
    t -= 32;
    if (t < 64) { const int l = t / 32, r = t % 32, nt = r / 4, kt = r % 4;
        const bool any = (kt < 3) && (nt < 6);
        cvt_tile(wl, any ? p.mla_wq_b + (size_t)l * 192 * 384 + (size_t)kt * 64 * 384 + nt * 64 : nullptr, 384, 64, 64, p.mla_q_a_g + l * 192 + kt * 64,
                 (bf16_t*)(ws + WS_WQ) + ((size_t)l * 512 + nt * 64) * 256 + kt * 64, 256, wv_); return; }
    t -= 64;
    if (t < 64) { const int l = t / 32, r = t % 32, nt = r / 4, kt = r % 4;
        const bool any = (kt < 2);
        cvt_tile(wl, any ? p.mla_wkv_b + (size_t)l * 128 * 512 + (size_t)kt * 64 * 512 + nt * 64 : nullptr, 512, 64, 64, p.mla_kv_a_g + l * 128 + kt * 64,
                 (bf16_t*)(ws + WS_WKV) + ((size_t)l * 512 + nt * 64) * 256 + kt * 64, 256, wv_); return; }
    t -= 64;
    { const int l = t / 16, r = t % 16, nt = r / 4, kt = r % 4;
        cvt_tile(wl, nt == kt ? p.pool_w + ((size_t)l * 4 + nt) * 4096 : nullptr, 64, 64, 64, nullptr,
                 (bf16_t*)(ws + WS_WPOOL) + ((size_t)l * 256 + nt * 64) * 256 + kt * 64, 256, wv_); }
}
DI void cvt_expert(const Params& p, LAS char* wl, int l, int t, const int wv_) {
    char* ws = p.ws;
    const int e = t / 768, r = t % 768;
    if (r < 512) { const int nt = r / 16, kt = r % 16;
        cvt_tile8(wl, p.exp_w_in + ((size_t)(l * NE + e) * 1024 + kt * 64) * 2048 + nt * 64, 2048,
                  (unsigned char*)(ws + WS_W1) + ((size_t)(l * NE + e) * 2048 + nt * 64) * 1024 + kt * 64, 1024, wv_);
    } else { const int q = r - 512, nt = q / 16, kt = q % 16;
        cvt_tile8(wl, p.exp_w_out + ((size_t)(l * NE + e) * 1024 + kt * 64) * 1024 + nt * 64, 1024,
                  (unsigned char*)(ws + WS_W2) + ((size_t)(l * NE + e) * 1024 + nt * 64) * 1024 + kt * 64, 1024, wv_);
    }
}

DI void ada_unit(const Params& p, LAS char* shm, int u, const int wv_) {
    const int tid = otid();
    const int l = u / 48, jc = u % 48;
    LAS float* sc = (LAS float*)shm;
    for (int i = tid; i < 33 * 1024; i += 512) { const int r = i >> 10, k = i & 1023; const float v = r < 32 ? p.c[r * 1024 + k] : p.c_ctx[k]; sc[i] = siluf_(v); }
    __syncthreads();
    const int col = tid & 127, kq = tid >> 7;
    float acc[33];
#pragma unroll
    for (int r = 0; r < 33; ++r) acc[r] = 0.f;
    const float* wp = p.ada_w + ((size_t)l * 1024 + kq * 256) * 6144 + jc * 128 + col;
    for (int k4 = 0; k4 < 256; k4 += 4) {
        float w[4];
#pragma unroll
        for (int i = 0; i < 4; ++i) w[i] = wp[(size_t)(k4 + i) * 6144];
#pragma unroll
        for (int r = 0; r < 33; ++r) { const f32x4 s = *(const LAS f32x4*)(sc + r * 1024 + kq * 256 + k4); acc[r] += s[0] * w[0] + s[1] * w[1] + s[2] * w[2] + s[3] * w[3]; }
    }
    __syncthreads();
    LAS float* red = (LAS float*)shm;
#pragma unroll
    for (int r = 0; r < 33; ++r) red[(kq * 33 + r) * 128 + col] = acc[r];
    __syncthreads();
    for (int i = tid; i < 33 * 128; i += 512) { const int r = i >> 7, cc = i & 127;
        const float s = red[(0 * 33 + r) * 128 + cc] + red[(1 * 33 + r) * 128 + cc] + red[(2 * 33 + r) * 128 + cc] + red[(3 * 33 + r) * 128 + cc];
        ((float*)(p.ws + WS_MOD))[((size_t)l * 33 + r) * 6144 + jc * 128 + cc] = s + p.ada_b[l * 6144 + jc * 128 + cc]; }
    __syncthreads();
}

DI void s5_load_bc(const Params& p, LAS float* bb, LAS float* cc, int l, int dir, int g, int tid) {
    const int pbase = ((l * 2 + dir) * 16 + g) * 64;
    const double dt = exp((double)p.ssm_log_dt[(l * 2 + dir) * 16 + g]);
    for (int i = tid; i < 64 * 16; i += 512) { const int q = i >> 4, ci = i & 15;
        const double are = fmin((double)p.ssm_a_re[pbase + q], -1e-4), aim = (double)p.ssm_a_im[pbase + q];
        const double mg = exp(are * dt), abr = mg * cos(aim * dt), abi = mg * sin(aim * dt), den = are * are + aim * aim;
        const double fre = ((abr - 1.0) * are + abi * aim) / den, fim = (abi * are - (abr - 1.0) * aim) / den;
        const double br = (double)p.ssm_b_re[(size_t)(pbase + q) * 16 + ci], bi = (double)p.ssm_b_im[(size_t)(pbase + q) * 16 + ci];
        bb[i * 2] = (float)(fre * br - fim * bi); bb[i * 2 + 1] = (float)(fre * bi + fim * br); }
    for (int i = tid; i < 16 * 64; i += 512) { const int co = i >> 6, q = i & 63;
        const size_t ix = ((size_t)((l * 2 + dir) * 16 + g) * 16 + co) * 64 + q;
        cc[i * 2] = p.ssm_c_re[ix]; cc[i * 2 + 1] = p.ssm_c_im[ix]; }
}
DI void s5pre_unit(const Params& p, LAS char* shm, int u, const int wv_) {
    const int tid = otid();
    const int l = u >> 5, g = (u >> 1) & 15, dir = u & 1;
    LAS float* pw = (LAS float*)shm;
    LAS float* bb = pw + 65 * 64 * 2;
    LAS float* cc = bb + 64 * 16 * 2;
    LAS float* kk = cc + 16 * 64 * 2;
    LAS float* k0o = kk + 64 * 256;
    bf16_t* TS = (bf16_t*)(p.ws + WS_TS5) + (size_t)(l * 16 + g) * 1024 * 1280;
    bf16_t* WS = (bf16_t*)(p.ws + WS_WS5) + (size_t)(l * 16 + g) * 256 * 1024;
    const int cocip = tid & 255, co_ = cocip >> 4, ci_ = cocip & 15;
    if (dir == 0) {
        s5_load_bc(p, bb, cc, l, 1, g, tid);
        __syncthreads();
        if (tid < 256) { float s_ = 0.f;
            for (int q = 0; q < 64; ++q) s_ += cc[(co_ * 64 + q) * 2] * bb[(q * 16 + ci_) * 2] - cc[(co_ * 64 + q) * 2 + 1] * bb[(q * 16 + ci_) * 2 + 1];
            k0o[tid] = s_; }
        __syncthreads();
    }
    {
        const int pbase = ((l * 2 + dir) * 16 + g) * 64;
        const double dt = exp((double)p.ssm_log_dt[(l * 2 + dir) * 16 + g]);
        for (int i = tid; i < 65 * 64; i += 512) { const int tau = i >> 6, q = i & 63;
            const double are = fmin((double)p.ssm_a_re[pbase + q], -1e-4), aim = (double)p.ssm_a_im[pbase + q];
            const double mg = exp(are * dt * tau), an = aim * dt * tau;
            pw[i * 2] = (float)(mg * cos(an)); pw[i * 2 + 1] = (float)(mg * sin(an)); }
        s5_load_bc(p, bb, cc, l, dir, g, tid);
        __syncthreads();
        if (tid < 64) { float* a64 = (float*)(p.ws + WS_A64) + (size_t)(((l * 2 + dir) * 16 + g) * 64 + tid) * 2; a64[0] = pw[(64 * 64 + tid) * 2]; a64[1] = pw[(64 * 64 + tid) * 2 + 1]; }
        { float gr[64], gi[64];
#pragma unroll
          for (int q = 0; q < 64; ++q) { const float cr = cc[(co_ * 64 + q) * 2], cim = cc[(co_ * 64 + q) * 2 + 1], br = bb[(q * 16 + ci_) * 2], bi = bb[(q * 16 + ci_) * 2 + 1];
              gr[q] = cr * br - cim * bi; gi[q] = cr * bi + cim * br; }
          for (int tau = (tid >> 8); tau < 64; tau += 2) {
              float s_ = 0.f;
#pragma unroll
              for (int q = 0; q < 64; ++q) s_ += gr[q] * pw[(tau * 64 + q) * 2] - gi[q] * pw[(tau * 64 + q) * 2 + 1];
              kk[tau * 256 + cocip] = s_;
          } }
        for (int i = tid; i < 128 * 512; i += 512) { const int row = i >> 9, kp = (i & 511) * 2, ri = row >> 6, q = row & 63, s_ = kp >> 4, ci = kp & 15;
            const int e = dir == 0 ? 63 - s_ : s_;
            const float pr = pw[(e * 64 + q) * 2], pi = pw[(e * 64 + q) * 2 + 1];
            float o[2];
#pragma unroll
            for (int j = 0; j < 2; ++j) { const float br = bb[(q * 16 + ci + j) * 2], bi = bb[(q * 16 + ci + j) * 2 + 1]; o[j] = ri == 0 ? pr * br - pi * bi : pr * bi + pi * br; }
            *(unsigned*)(WS + (size_t)(dir * 128 + row) * 1024 + kp) = pk_bf16(o[0], o[1]); }
        for (int i = tid; i < 1024 * 64; i += 512) { const int row = i >> 6, kp = (i & 63) * 2, t = row >> 4, co = row & 15, ri = kp >> 6, q = kp & 63;
            const int e = dir == 0 ? t + 1 : 64 - t;
            float o[2];
#pragma unroll
            for (int j = 0; j < 2; ++j) { const float pr = pw[(e * 64 + q + j) * 2], pi = pw[(e * 64 + q + j) * 2 + 1];
                const float cr = cc[(co * 64 + q + j) * 2], cim = cc[(co * 64 + q + j) * 2 + 1];
                o[j] = ri == 0 ? (cr * pr - cim * pi) : -(cr * pi + cim * pr); }
            *(unsigned*)(TS + (size_t)row * 1280 + 1024 + dir * 128 + kp) = pk_bf16(o[0], o[1]); }
        __syncthreads();
        for (int rr = tid; rr < 1024; rr += 512) { const int t = rr >> 4, co = rr & 15;
            const float dco = p.ssm_d[l * 256 + g * 16 + co];
            bf16_t* rowp = TS + (size_t)rr * 1280;
            const int s_lo = dir == 0 ? 0 : t + 1, s_hi = dir == 0 ? t : 63;
            for (int s_ = s_lo; s_ <= s_hi; ++s_) { const int tau = dir == 0 ? t - s_ : s_ - t;
                unsigned w[8];
#pragma unroll
                for (int j = 0; j < 8; ++j) { float a = kk[tau * 256 + co * 16 + 2 * j], b2 = kk[tau * 256 + co * 16 + 2 * j + 1];
                    if (s_ == t) { a += k0o[co * 16 + 2 * j]; b2 += k0o[co * 16 + 2 * j + 1]; if (2 * j == co) a += dco; if (2 * j + 1 == co) b2 += dco; }
                    w[j] = pk_bf16(a, b2); }
                *(u32x4*)(rowp + s_ * 16) = (u32x4){w[0], w[1], w[2], w[3]}; *(u32x4*)(rowp + s_ * 16 + 8) = (u32x4){w[4], w[5], w[6], w[7]}; }
        }
        __syncthreads();
    }
}

DI void phase_prologue(const Params& p, LAS char* shm, const int wv_) {
    const int tid = otid();
    __syncthreads();
    if (blockIdx.x == 0 && tid < 64) ((int*)(p.ws + WS_CNT))[tid] = 0;
    const int n_cvt = (CVT_SMALL_TILES + 2 * CVT_EXP_TILES + 7) / 8;
    const int n_units = 64 + 96 + n_cvt;
    for (int u = blockIdx.x; u < n_units; u += gridDim.x) {
        if (u < 64) s5pre_unit(p, shm, u, wv_);
        else if (u < 160) ada_unit(p, shm, u - 64, wv_);
        else {
            const int t = (u - 160) * 8 + (tid >> 6);
            LAS char* wl = shm + (tid >> 6) * (64 * 144);
            if (t < CVT_SMALL_TILES) cvt_small(p, wl, t, wv_);
            else if (t < CVT_SMALL_TILES + 2 * CVT_EXP_TILES) { const int te = t - CVT_SMALL_TILES; cvt_expert(p, wl, te / CVT_EXP_TILES, te % CVT_EXP_TILES, wv_); }
        }
    }
}

DI void norm_mod_store(const float (&v)[16], const float* g, const float* modrow  , bf16_t* hrow, const int wv_) {
    const int lane = otid() & 63;
    float ss = 0.f;
#pragma unroll
    for (int i = 0; i < 16; ++i) ss += v[i] * v[i];
    ss = wave_sum(ss);
    const float rn = rsqrtf(ss * (1.f / 1024.f) + EPS);
#pragma unroll
    for (int j = 0; j < 4; ++j) {
        const int col = j * 256 + lane * 4;
        const f32x4 gg = *(const f32x4*)(g + col), sh = *(const f32x4*)(modrow + col), sc = *(const f32x4*)(modrow + 1024 + col);
        float o[4];
#pragma unroll
        for (int i = 0; i < 4; ++i) o[i] = v[j * 4 + i] * rn * gg[i] * (1.f + sc[i]) + sh[i];
        store_bf16x4(hrow + col, o[0], o[1], o[2], o[3]);
    }
}
DI void phase_norm1_l0(const Params& p, const int wv_) {
    const int tid_ = otid(); const int wid = tid_ >> 6, lane = tid_ & 63;
    const float* MOD = (const float*)(p.ws + WS_MOD);
    bf16_t* H = (bf16_t*)(p.ws + WS_H);
    for (int r = blockIdx.x * 8 + wid; r < TT; r += gridDim.x * 8) {
        const float* src = r < TX ? p.x + (size_t)r * 1024 : p.ctx + (size_t)(r - TX) * 1024;
        float v[16];
#pragma unroll
        for (int j = 0; j < 4; ++j) { const f32x4 t = *(const f32x4*)(src + j * 256 + lane * 4); v[j * 4] = t[0]; v[j * 4 + 1] = t[1]; v[j * 4 + 2] = t[2]; v[j * 4 + 3] = t[3]; }
        norm_mod_store(v, p.norm1_g, MOD + (size_t)(0 * 33 + mod_row(r)) * 6144, H + (size_t)r * 1024, wv_);
    }
}

struct PvInproj {
    const Params& p; int l;
    PV_NOHOOKS
    static constexpr int NT = 16; static constexpr int FP8 = 0; static constexpr bool PARK = false; typedef APlain AS; typedef BSimple BS;
    XcdDeal<4, 6> deal;
    DI int first() const { return deal.first(); }
    DI int next(int u) const { return deal.next(u); }
    DI void src(int u, AS& a, BS& b, const int wv_) const {
        int mt, nt; deal.decode(u, mt, nt);
        const bf16_t* W = (const bf16_t*)(p.ws + WS_WMI) + (size_t)l * 1536 * 1024;
        a = make_a_plain((const bf16_t*)(p.ws + WS_H), (size_t)mt * 256, 1024, 0);
        b = nt < 2 ? make_b(W + (size_t)(nt * 128) * 1024, W + (size_t)(256 + nt * 128) * 1024, 1024)
                   : make_b(W + (size_t)(nt * 256) * 1024, W + (size_t)(nt * 256 + 128) * 1024, 1024);
    }
    DI void epi(f32x4 (&acc)[2][2][4][2], int u, const int wv_) const {
        int mt, nt; deal.decode(u, mt, nt);
        bf16_t* P = (bf16_t*)(p.ws + WS_P);
        if (nt < 2) {
            const int _tz = otid(), _w = _tz >> 6, _l = _tz & 63, _wr = _w >> 2, _wc = _w & 3, _fr = _l & 15, _fq = _l >> 4;
#pragma unroll
            for (int ai = 0; ai < 2; ++ai)
#pragma unroll
                for (int m = 0; m < 4; ++m) { const int lr = ai * 128 + _wr * 64 + m * 16 + _fr; const int lc = _wc * 32 + _fq * 8;
                    f32x4 o0, o1;
#pragma unroll
                    for (int r = 0; r < 4; ++r) { o0[r] = acc[ai][0][m][0][r] * sigmoidf_(acc[ai][1][m][0][r]); o1[r] = acc[ai][0][m][1][r] * sigmoidf_(acc[ai][1][m][1][r]); }
                    store_bf16x8(P + (size_t)(mt * 256 + lr) * NINP + nt * 128 + lc, o0, o1); }
        } else {
            EPI_FOR8(acc, { store_bf16x8(P + (size_t)(mt * 256 + lr) * NINP + nt * 256 + lc, v0, v1); });
        }
    }
};
DI void phase_inproj(const Params& p, LAS char* shm, int l, const int wv_) {
    PvInproj pv{p, l, {TT / 256}};
    gemm_stream(shm, pv, wv_);
}

template <int N> DI void wave_sum_n(float (&v)[N]) {
    const int l4 = olane();
#pragma unroll
    for (int o = 32; o > 0; o >>= 1) {
        float t_[N];
#pragma unroll
        for (int i = 0; i < N; ++i) t_[i] = __int_as_float(__builtin_amdgcn_ds_bpermute((l4 ^ o) << 2, __float_as_int(v[i])));
#pragma unroll
        for (int i = 0; i < N; ++i) v[i] += t_[i];
    }
}
template <int WIN, bool EDGE>
DI void pool_run(const LAS bf16_t* pin  , bf16_t* AP, int row0, int ts0, int L, int c, int half) {
    for (int blk = 0; blk < 2; ++blk) {
        const int t0 = half * 32 + blk * 16;
        float in[16 + WIN - 1];
#pragma unroll
        for (int i = 0; i < 16 + WIN - 1; ++i) in[i] = bf2f(pin[(t0 + i - WIN / 2 + 8) * 256 + c]);
        float sum = 0.f;
#pragma unroll
        for (int j = 0; j < WIN; ++j) sum += in[j];
#pragma unroll
        for (int o = 0; o < 16; ++o) {
            float inv = 1.f / (float)WIN;
            if (EDGE) { const int ts = ts0 + t0 + o; const int lo = max(ts - WIN / 2, 0), hi = min(ts + WIN - 1 - WIN / 2, L - 1); inv = 1.f / (float)(hi - lo + 1); }
            AP[(size_t)(row0 + t0 + o) * 256 + c] = f2bf(sum * inv - in[o + WIN / 2]);
            if (o < 15) sum += in[o + WIN] - in[o];
        }
    }
}
template <bool EDGE>
DI void pre_unit_t(const Params& p, LAS char* shm, int l, int row0, int ts0, int L, const float (&w)[31], const float bias, const int wv_) {
    const int tid = otid();
    const bf16_t* P = (const bf16_t*)(p.ws + WS_P);
    const int c = tid & 255, half = tid >> 8;
    LAS bf16_t* cin = (LAS bf16_t*)shm;
    LAS float* cv = (LAS float*)(shm + 49152);
    u32x4 creg[6], preg[5];
#pragma unroll
    for (int it = 0; it < 6; ++it) { const int q = it * 512 + tid, row = q >> 5, part = q & 31; const int ts = ts0 - 15 + row;
        creg[it] = (u32x4){0u, 0u, 0u, 0u};
        if (q < 94 * 32 && (!EDGE || (ts >= 0 && ts < L))) creg[it] = *(const u32x4*)(P + (size_t)(row0 - 15 + row) * NINP + part * 8); }
#pragma unroll
    for (int it = 0; it < 5; ++it) { const int q = it * 512 + tid, row = q >> 5, part = q & 31; const int ts = ts0 - 8 + row;
        preg[it] = (u32x4){0u, 0u, 0u, 0u};
        if (!EDGE || (ts >= 0 && ts < L)) preg[it] = *(const u32x4*)(P + (size_t)(row0 - 8 + row) * NINP + OFF_POOL + part * 8); }
#pragma unroll
    for (int it = 0; it < 6; ++it) { const int q = it * 512 + tid; if (q < 94 * 32) *(LAS u32x4*)(cin + q * 8) = creg[it]; }
    __syncthreads();
    {
        const int t0 = half * 32;
        float in[62];
#pragma unroll
        for (int i = 0; i < 62; ++i) in[i] = bf2f(cin[(t0 + i) * 256 + c]);
#pragma unroll
        for (int o = 0; o < 32; ++o) { float s_ = bias;
#pragma unroll
            for (int j = 0; j < 31; ++j) s_ += w[j] * in[o + j];
            cv[(t0 + o) * 257 + c] = s_; }
    }
    __syncthreads();
#pragma unroll
    for (int it = 0; it < 5; ++it) *(LAS u32x4*)(cin + (it * 512 + tid) * 8) = preg[it];
    {
        const int wid = tid >> 6, lane = tid & 63;
        bf16_t* AC = (bf16_t*)(p.ws + WS_ACONV);
        float lg[4], lb[4];
#pragma unroll
        for (int j = 0; j < 4; ++j) { lg[j] = p.conv_ln_g[l * 256 + lane + 64 * j]; lb[j] = p.conv_ln_b[l * 256 + lane + 64 * j]; }
        float x[8][4], s8[8];
#pragma unroll
        for (int i = 0; i < 8; ++i) { s8[i] = 0.f;
#pragma unroll
            for (int j = 0; j < 4; ++j) { x[i][j] = cv[(wid * 8 + i) * 257 + lane + 64 * j]; s8[i] += x[i][j]; } }
        wave_sum_n<8>(s8);
#pragma unroll
        for (int i = 0; i < 8; ++i) { const float mu = s8[i] * (1.f / 256.f); s8[i] = 0.f;
#pragma unroll
            for (int j = 0; j < 4; ++j) { x[i][j] -= mu; s8[i] += x[i][j] * x[i][j]; } }
        wave_sum_n<8>(s8);
#pragma unroll
        for (int i = 0; i < 8; ++i) { const float rs = rsqrtf(s8[i] * (1.f / 256.f) + EPS);
#pragma unroll
            for (int j = 0; j < 4; ++j) { const float y = x[i][j] * rs * lg[j] + lb[j]; AC[(size_t)(row0 + wid * 8 + i) * 256 + lane + 64 * j] = f2bf(siluf_(y)); } }
    }
    __syncthreads();
    {
        bf16_t* AP = (bf16_t*)(p.ws + WS_APOOL);
        const int g = __builtin_amdgcn_readfirstlane(c >> 6);
        if (g == 0) pool_run<2, EDGE>(cin, AP, row0, ts0, L, c, half);
        else if (g == 1) pool_run<4, EDGE>(cin, AP, row0, ts0, L, c, half);
        else if (g == 2) pool_run<8, EDGE>(cin, AP, row0, ts0, L, c, half);
        else pool_run<16, EDGE>(cin, AP, row0, ts0, L, c, half);
    }
    __syncthreads();
}
DI void pre_unit(const Params& p, LAS char* shm, int l, int tile, const float (&w)[31], const float bias, const int wv_) {
    int row0, ts0, L;
    if (tile < 1024) { row0 = tile * 64; ts0 = row0 & 2047; L = SEQ; } else { row0 = TX + (tile - 1024) * 64; ts0 = (row0 - TX) & 255; L = CTXL; }
    if (ts0 >= 16 && ts0 + 64 + 16 <= L) pre_unit_t<false>(p, shm, l, row0, ts0, L, w, bias, wv_);
    else pre_unit_t<true>(p, shm, l, row0, ts0, L, w, bias, wv_);
}
struct PvS5State {
    const Params& p; int l;
    PV_NOHOOKS
    static constexpr int NT = 16; static constexpr int FP8 = 0; static constexpr bool PARK = false; typedef ASimple AS; typedef BSimple BS;
    DI int first() const { return lin_first(0, 80); }
    DI int next(int u) const { return lin_next(u, 80); }
    DI void src(int u, AS& as, BS& bs, const int wv_) const {
        const int g = u / 5, mt = u % 5;
        int R[2], C[2]; stage_coords(R, C, wv_);
        as.base = (const char*)(p.ws + WS_P); as.kstride = 4 * NINP * 2;
#pragma unroll
        for (int h = 0; h < 2; ++h)
#pragma unroll
            for (int i = 0; i < 2; ++i) { const int cr = min(mt * 256 + h * 128 + R[i], NCROW - 1);
                as.off[h][i] = (unsigned)(((size_t)(crow_tok(cr) + (C[i] >> 4)) * NINP + OFF_SSM + g * 16 + (C[i] & 15)) * 2); }
        const bf16_t* W = (const bf16_t*)(p.ws + WS_WS5) + (size_t)(l * 16 + g) * 256 * 1024;
        bs = make_b(W, W + (size_t)128 * 1024, 1024);
    }
    DI void epi(f32x4 (&acc)[2][2][4][2], int u, const int wv_) const {
        const int g = u / 5, mt = u % 5;
        float* SST = (float*)(p.ws + WS_SST);
        EPI_FOR8(acc, { const int cr = mt * 256 + lr; if (cr < NCROW) { float* o_ = SST + ((size_t)cr * 16 + g) * 256 + lc; *(f32x4*)o_ = v0; *(f32x4*)(o_ + 4) = v1; } });
    }
};
struct PvQKV {
    const Params& p; int l;
    PV_NOHOOKS
    static constexpr int NT = 4; static constexpr int FP8 = 0; static constexpr bool PARK = false; typedef APlain AS; typedef BSimple BS;
    DI int first() const { return lin_first(80, 1152); }
    DI int next(int u) const { return lin_next(u, 1152); }
    DI void src(int u, AS& a, BS& b, const int wv_) const {
        const bool isq = u < 576; const int w_ = isq ? u : u - 576; const int mt = w_ >> 1, nt = w_ & 1;
        a = make_a_plain((const bf16_t*)(p.ws + WS_P), (size_t)mt * 256, NINP, isq ? OFF_Q : OFF_KV);
        const bf16_t* W = (const bf16_t*)(p.ws + (isq ? WS_WQ : WS_WKV)) + (size_t)l * 512 * 256 + (size_t)nt * 256 * 256;
        b = make_b(W, W + (size_t)128 * 256, 256);
    }
    DI void epi(f32x4 (&acc)[2][2][4][2], int u, const int wv_) const {
        const bool isq = u < 576; const int w_ = isq ? u : u - 576; const int mt = w_ >> 1, nt = w_ & 1;
        bf16_t* RAW = (bf16_t*)(p.ws + (isq ? WS_RAWQ : WS_RAWKV));
        EPI_FOR8(acc, { store_bf16x8(RAW + (size_t)(mt * 256 + lr) * 512 + nt * 256 + lc, v0, v1); });
    }
};
DI void phase_A(const Params& p, LAS char* shm, int l, const int wv_) {
    { PvS5State pv{p, l}; gemm_stream(shm, pv, wv_); }
    { PvQKV pv{p, l}; gemm_stream(shm, pv, wv_); }
    { const int c_ = otid() & 255;
      float w[31];
#pragma unroll
      for (int j = 0; j < 31; ++j) w[j] = p.conv_dw[((size_t)l * 31 + j) * 256 + c_];
      const float bias = p.conv_dw_b[l * 256 + c_];
      for (int u = first_unit(80 + 1152); u < 1152; u += gridDim.x) pre_unit(p, shm, l, u, w, bias, wv_); }
}

DI void qkvpost_unit(const Params& p, LAS char* shm, int l, int unit, const int wv_) {
    const int tid = otid(), wid = tid >> 6, lane = tid & 63;
    const bf16_t* P = (const bf16_t*)(p.ws + WS_P);
    const bf16_t* RAWQ = (const bf16_t*)(p.ws + WS_RAWQ);
    const bf16_t* RAWKV = (const bf16_t*)(p.ws + WS_RAWKV);
    bf16_t* Q = (bf16_t*)(p.ws + WS_Q);
    bf16_t* KB = (bf16_t*)(p.ws + WS_KB);
    bf16_t* VT = (bf16_t*)(p.ws + WS_VT);
    LAS bf16_t* vt = (LAS bf16_t*)shm;
    const int row0 = unit * 64;
    const bool lat = row0 < TX;
    const int b = lat ? (row0 >> 11) : ((row0 - TX) >> 8);
    const int key0 = lat ? (row0 & 2047) : 2048 + ((row0 - TX) & 255);
    const int head = lane >> 4, sub = lane & 15;
    const float lninv = -9.210340371976184f / 8.f;
    const float frq = __expf(lninv * (float)(sub & 7));
    float qg[6], kg[6];
#pragma unroll
    for (int j = 0; j < 6; ++j) { qg[j] = p.mla_q_g[l * 96 + sub + 16 * j] * 0.14724444674085666f; kg[j] = p.mla_k_g[l * 96 + sub + 16 * j]; }
    constexpr int NB = 4;
    for (int tk0 = wid * 8; tk0 < wid * 8 + 8; tk0 += NB) {
        float pq[NB][3], pkv[NB][2], qr[NB][6], kr[NB][6], vr[NB][4];
#pragma unroll
        for (int i = 0; i < NB; ++i) { const int r = row0 + tk0 + i; const bf16_t* pr = P + (size_t)r * NINP;
#pragma unroll
            for (int j = 0; j < 3; ++j) pq[i][j] = bf2f(pr[OFF_Q + lane + 64 * j]);
#pragma unroll
            for (int j = 0; j < 2; ++j) pkv[i][j] = bf2f(pr[OFF_KV + lane + 64 * j]);
#pragma unroll
            for (int j = 0; j < 6; ++j) qr[i][j] = bf2f(RAWQ[(size_t)r * 512 + head * 96 + sub + 16 * j]);
#pragma unroll
            for (int j = 0; j < 4; ++j) kr[i][j] = bf2f(RAWKV[(size_t)r * 512 + head * 128 + sub + 16 * j]);
#pragma unroll
            for (int j = 4; j < 6; ++j) kr[i][j] = bf2f(pr[OFF_KPE + sub + 16 * (j - 4)]);
#pragma unroll
            for (int j = 0; j < 4; ++j) vr[i][j] = bf2f(RAWKV[(size_t)r * 512 + head * 128 + 64 + sub + 16 * j]); }
        float red[2 * NB];
#pragma unroll
        for (int i = 0; i < NB; ++i) { red[2 * i] = pq[i][0] * pq[i][0] + pq[i][1] * pq[i][1] + pq[i][2] * pq[i][2]; red[2 * i + 1] = pkv[i][0] * pkv[i][0] + pkv[i][1] * pkv[i][1]; }
        wave_sum_n<2 * NB>(red);
        float ssq[2 * NB];
#pragma unroll
        for (int i = 0; i < NB; ++i) {
            const float rq = rsqrtf(red[2 * i] * (1.f / 192.f) + EPS), rkv = rsqrtf(red[2 * i + 1] * (1.f / 128.f) + EPS);
            float s0 = 0.f, s1 = 0.f;
#pragma unroll
            for (int j = 0; j < 6; ++j) { qr[i][j] *= rq; s0 += qr[i][j] * qr[i][j]; }
#pragma unroll
            for (int j = 0; j < 4; ++j) { kr[i][j] *= rkv; s1 += kr[i][j] * kr[i][j]; }
#pragma unroll
            for (int j = 4; j < 6; ++j) s1 += kr[i][j] * kr[i][j];
#pragma unroll
            for (int j = 0; j < 4; ++j) vr[i][j] *= rkv;
            ssq[2 * i] = s0; ssq[2 * i + 1] = s1;
        }
        { const int l4 = olane();
#pragma unroll
          for (int o = 8; o > 0; o >>= 1) { float t_[2 * NB];
#pragma unroll
              for (int i = 0; i < 2 * NB; ++i) t_[i] = __int_as_float(__builtin_amdgcn_ds_bpermute((l4 ^ o) << 2, __float_as_int(ssq[i])));
#pragma unroll
              for (int i = 0; i < 2 * NB; ++i) ssq[i] += t_[i]; } }
#pragma unroll
        for (int i = 0; i < NB; ++i) {
            const int tk = tk0 + i, r = row0 + tk;
            const float rnq = rsqrtf(ssq[2 * i] * (1.f / 96.f) + EPS), rnk = rsqrtf(ssq[2 * i + 1] * (1.f / 96.f) + EPS);
#pragma unroll
            for (int j = 0; j < 6; ++j) { qr[i][j] *= rnq * qg[j]; kr[i][j] *= rnk * kg[j]; }
            if (lat) {
                const int tseq = r & 2047; const float a0 = (float)(tseq >> 6) * frq, a1 = (float)(tseq & 63) * frq;
                const float cs0 = __cosf(a0), sn0 = __sinf(a0), cs1 = __cosf(a1), sn1 = __sinf(a1);
                const float oq4 = shx(qr[i][4], 8), oq5 = shx(qr[i][5], 8), ok4 = shx(kr[i][4], 8), ok5 = shx(kr[i][5], 8);
                const float sg = (sub < 8) ? -1.f : 1.f;
                qr[i][4] = qr[i][4] * cs0 + sg * oq4 * sn0; qr[i][5] = qr[i][5] * cs1 + sg * oq5 * sn1;
                kr[i][4] = kr[i][4] * cs0 + sg * ok4 * sn0; kr[i][5] = kr[i][5] * cs1 + sg * ok5 * sn1;
            }
            bf16_t* kro = KB + ((size_t)(b * 4 + head) * 2304 + key0 + tk) * 96;
#pragma unroll
            for (int j = 0; j < 6; ++j) { Q[(size_t)r * 384 + head * 96 + sub + 16 * j] = f2bf(qr[i][j]); kro[sub + 16 * j] = f2bf(kr[i][j]); }
#pragma unroll
            for (int j = 0; j < 4; ++j) vt[(head * 64 + sub + 16 * j) * 72 + tk] = f2bf(vr[i][j]);
        }
    }
    __syncthreads();
    { const int hv = tid >> 1, hf = tid & 1;
      bf16_t* dst = VT + ((size_t)(b * 4 + (hv >> 6)) * 64 + (hv & 63)) * 2304 + key0 + hf * 32;
#pragma unroll
      for (int i = 0; i < 4; ++i) *(u32x4*)(dst + i * 8) = *(const LAS u32x4*)(vt + hv * 72 + hf * 32 + i * 8); }
    __syncthreads();
}
DI void s5carry_unit(const Params& p, int l, int unit, const int wv_) {
    const int gid = unit * 512 + otid();
    const int q = gid & 63, dir = (gid >> 6) & 1, g = (gid >> 7) & 15, b = gid >> 11;
    const float* A64 = (const float*)(p.ws + WS_A64) + (size_t)(((l * 2 + dir) * 16 + g) * 64 + q) * 2;
    const float ar = A64[0], ai = A64[1];
    const float* SST = (const float*)(p.ws + WS_SST);
    bf16_t* HIN = (bf16_t*)(p.ws + WS_HIN);
    float sr[NCH], si[NCH];
#pragma unroll
    for (int s = 0; s < NCH; ++s) { const int j = dir == 0 ? s : (s < 4 ? 3 - s : 39 - s);
        const size_t base = ((size_t)(b * NCH + j) * 16 + g) * 256 + dir * 128 + q; sr[s] = SST[base]; si[s] = SST[base + 64]; }
    float hr = 0.f, hi = 0.f;
#pragma unroll
    for (int s = 0; s < NCH; ++s) {
        const int j = dir == 0 ? s : (s < 4 ? 3 - s : 39 - s);
        const size_t base = ((size_t)(b * NCH + j) * 16 + g) * 256 + dir * 128 + q;
        HIN[base] = f2bf(hr); HIN[base + 64] = f2bf(hi);
        const float nr = ar * hr - ai * hi + sr[s], ni = ar * hi + ai * hr + si[s];
        hr = nr; hi = ni;
    }
}
struct PvConvPool {
    const Params& p; int l;
    PV_NOHOOKS
    static constexpr int NT = 4; static constexpr int FP8 = 0; static constexpr bool PARK = false; typedef APlain AS; typedef BSimple BS;
    DI int first() const { return lin_first(0, 576); }
    DI int next(int u) const { return lin_next(u, 576); }
    DI void src(int u, AS& a, BS& b, const int wv_) const {
        const bool isconv = u < 288; const int mt = isconv ? u : u - 288;
        a = make_a_plain((const bf16_t*)(p.ws + (isconv ? WS_ACONV : WS_APOOL)), (size_t)mt * 256, 256, 0);
        const bf16_t* W = (const bf16_t*)(p.ws + (isconv ? WS_WPW : WS_WPOOL)) + (size_t)l * 65536;
        b = make_b(W, W + (size_t)128 * 256, 256);
    }
    DI void epi(f32x4 (&acc)[2][2][4][2], int u, const int wv_) const {
        const bool isconv = u < 288; const int mt = isconv ? u : u - 288;
        bf16_t* CAT = (bf16_t*)(p.ws + WS_CAT);
        if (isconv) { EPI_FOR8(acc, { store_bf16x8(CAT + (size_t)(mt * 256 + lr) * 1024 + lc, v0, v1); }); }
        else { const int t_ = otid(), c0_ = ((t_ >> 6) & 3) * 32 + ((t_ & 63) >> 4) * 8; f32x4 sc_[2][2];
#pragma unroll
               for (int bj = 0; bj < 2; ++bj)
#pragma unroll
                   for (int n = 0; n < 2; ++n) sc_[bj][n] = *(const f32x4*)(p.pool_scale + l * 256 + bj * 128 + n * 4 + c0_);
               EPI_FOR8(acc, { store_bf16x8(CAT + (size_t)(mt * 256 + lr) * 1024 + 256 + lc, v0 * sc_[bj][0], v1 * sc_[bj][1]); }); }
    }
};
DI void phase_B(const Params& p, LAS char* shm, int l, const int wv_) {
    { PvConvPool pv{p, l}; gemm_stream(shm, pv, wv_); }
    const int n_post = TT / 64, n_carry = 128;
    for (int u = first_unit(576); u < n_post + n_carry; u += gridDim.x) {
        if (u < n_post) qkvpost_unit(p, shm, l, u, wv_);
        else s5carry_unit(p, l, u - n_post, wv_);
    }
}

DI void attn_unit(const Params& p, LAS char* shm, int l, int b, int h, int qrow0, int nq, int key_lo, int nkeys, const int wv_) {
    const int tid = otid(), wid = tid >> 6, lane = tid & 63, l31 = lane & 31, hh = lane >> 5;
    const bf16_t* Q = (const bf16_t*)(p.ws + WS_Q);
    const bf16_t* KBp = (const bf16_t*)(p.ws + WS_KB) + (size_t)(b * 4 + h) * 2304 * 96;
    const bf16_t* VTp = (const bf16_t*)(p.ws + WS_VT) + (size_t)(b * 4 + h) * 64 * 2304;
    bf16_t* CAT = (bf16_t*)(p.ws + WS_CAT);
    LAS char* kl = shm;
    LAS char* vl = shm + 13312;
    const bool active = wid * 64 < nq;
    float gq = 0.f, gk = 0.f;
    for (int i = lane; i < 96; i += 64) { gq = fmaxf(gq, fabsf(p.mla_q_g[l * 96 + i])); gk = fmaxf(gk, fabsf(p.mla_k_g[l * 96 + i])); }
    gq = wave_max(gq); gk = wave_max(gk);
    const float LOG2E = 1.4426950408889634f;
    const float c2 = 9.797958971132712f * gq * gk * LOG2E;
    const float sh2 = fmaxf(c2 - 64.f, 0.f);
    bf16x8 qf[2][6];
    if (active) {
#pragma unroll
        for (int qb = 0; qb < 2; ++qb)
#pragma unroll
            for (int ks = 0; ks < 6; ++ks) qf[qb][ks] = *(const bf16x8*)(Q + (size_t)(qrow0 + wid * 64 + qb * 32 + l31) * 384 + h * 96 + ks * 16 + hh * 8);
    }
    f32x16 O[2][2];
#pragma unroll
    for (int a = 0; a < 2; ++a)
#pragma unroll
        for (int c = 0; c < 2; ++c)
#pragma unroll
            for (int i = 0; i < 16; ++i) O[a][c][i] = 0.f;
    float lsum[2] = {0.f, 0.f};
    const int ntile = nkeys / 64;
    u32x4 kreg0, kreg1, vreg;
    auto load_tile = [&](int t) {
        const int key = key_lo + t * 64;
        { const int id = tid, kr = id / 12, part = id % 12; kreg0 = *(const u32x4*)(KBp + (size_t)(key + kr) * 96 + part * 8); }
        if (tid < 256) { const int id = tid + 512, kr = id / 12, part = id % 12; kreg1 = *(const u32x4*)(KBp + (size_t)(key + kr) * 96 + part * 8); }
        { const int vd = tid >> 3, part = tid & 7; vreg = *(const u32x4*)(VTp + (size_t)vd * 2304 + key + part * 8); }
    };
    auto write_tile = [&]() {
        { const int id = tid, kr = id / 12, part = id % 12; *(LAS u32x4*)(kl + kr * 208 + part * 16) = kreg0; }
        if (tid < 256) { const int id = tid + 512, kr = id / 12, part = id % 12; *(LAS u32x4*)(kl + kr * 208 + part * 16) = kreg1; }
        { const int vd = tid >> 3, part = tid & 7; *(LAS u32x4*)(vl + vd * 144 + part * 16) = vreg; }
    };
    load_tile(0);
    for (int t = 0; t < ntile; ++t) {
        __syncthreads();
        write_tile();
        __syncthreads();
        if (t + 1 < ntile) load_tile(t + 1);
        if (active) {
#pragma unroll
            for (int kb = 0; kb < 2; ++kb) {
                f32x16 S[2];
#pragma unroll
                for (int qb = 0; qb < 2; ++qb)
#pragma unroll
                    for (int i = 0; i < 16; ++i) S[qb][i] = 0.f;
#pragma unroll
                for (int ks = 0; ks < 6; ++ks) {
                    const bf16x8 a = *(const LAS bf16x8*)(kl + (kb * 32 + l31) * 208 + ks * 32 + hh * 16);
#pragma unroll
                    for (int qb = 0; qb < 2; ++qb) S[qb] = __builtin_amdgcn_mfma_f32_32x32x16_bf16(a, qf[qb][ks], S[qb], 0, 0, 0);
                }
                bf16x8 pf[2][2];
#pragma unroll
                for (int qb = 0; qb < 2; ++qb) {
                    float e[16];
#pragma unroll
                    for (int i = 0; i < 16; ++i) { e[i] = __builtin_amdgcn_exp2f(S[qb][i] - sh2); lsum[qb] += e[i]; }
#pragma unroll
                    for (int s = 0; s < 2; ++s) { u32x4 w; w.x = pk_bf16(e[8 * s], e[8 * s + 1]); w.y = pk_bf16(e[8 * s + 2], e[8 * s + 3]); w.z = pk_bf16(e[8 * s + 4], e[8 * s + 5]); w.w = pk_bf16(e[8 * s + 6], e[8 * s + 7]);
                        pf[qb][s] = __builtin_bit_cast(bf16x8, w); }
                }
#pragma unroll
                for (int s = 0; s < 2; ++s) {
                    const int kk = kb * 2 + s;
#pragma unroll
                    for (int vb = 0; vb < 2; ++vb) {
                        const s16x4 lo = *(const LAS s16x4*)(vl + (vb * 32 + l31) * 144 + (16 * kk + 4 * hh) * 2);
                        const s16x4 hi = *(const LAS s16x4*)(vl + (vb * 32 + l31) * 144 + (16 * kk + 8 + 4 * hh) * 2);
                        const bf16x8 va = __builtin_shufflevector(lo, hi, 0, 1, 2, 3, 4, 5, 6, 7);
#pragma unroll
                        for (int qb = 0; qb < 2; ++qb) O[vb][qb] = __builtin_amdgcn_mfma_f32_32x32x16_bf16(va, pf[qb][s], O[vb][qb], 0, 0, 0);
                    }
                }
            }
        }
    }
    if (active) {
#pragma unroll
        for (int qb = 0; qb < 2; ++qb) {
            const float tot = lsum[qb] + shx(lsum[qb], 32);
            const float inv = 1.f / tot;
            bf16_t* orow = CAT + (size_t)(qrow0 + wid * 64 + qb * 32 + l31) * 1024 + 768 + h * 64;
#pragma unroll
            for (int vb = 0; vb < 2; ++vb)
#pragma unroll
                for (int i4 = 0; i4 < 4; ++i4)
                    store_bf16x4(orow + vb * 32 + 8 * i4 + 4 * hh, O[vb][qb][4 * i4] * inv, O[vb][qb][4 * i4 + 1] * inv, O[vb][qb][4 * i4 + 2] * inv, O[vb][qb][4 * i4 + 3] * inv);
        }
    }
    __syncthreads();
}
struct PvS5Out {
    const Params& p; int l;
    PV_NOHOOKS
    static constexpr int NT = 20; static constexpr int FP8 = 0; static constexpr bool PARK = false; typedef ASeg2 AS; typedef BSimple BS;
    DI int first() const { return lin_first(512, 320); }
    DI int next(int u) const { return lin_next(u, 320); }
    DI void src(int u, AS& as, BS& bs, const int wv_) const {
        const int ntile = u & 3, mt = (u >> 2) % 5, g = u / 20;
        int R[2], C[2]; stage_coords(R, C, wv_);
        as.base0 = (const char*)(p.ws + WS_P); as.base1 = (const char*)(p.ws + WS_HIN); as.ks0 = 4 * NINP * 2; as.nt0 = 16;
#pragma unroll
        for (int h = 0; h < 2; ++h)
#pragma unroll
            for (int i = 0; i < 2; ++i) { const int cr = min(mt * 256 + h * 128 + R[i], NCROW - 1);
                as.off0[h][i] = (unsigned)(((size_t)(crow_tok(cr) + (C[i] >> 4)) * NINP + OFF_SSM + g * 16 + (C[i] & 15)) * 2);
                as.off1[h][i] = (unsigned)((((size_t)cr * 16 + g) * 256 + C[i]) * 2); }
        const bf16_t* W = (const bf16_t*)(p.ws + WS_TS5) + ((size_t)(l * 16 + g) * 1024 + ntile * 256) * 1280;
        bs = make_b(W, W + (size_t)128 * 1280, 1280);
    }
    DI void epi(f32x4 (&acc)[2][2][4][2], int u, const int wv_) const {
        const int ntile = u & 3, mt = (u >> 2) % 5, g = u / 20;
        bf16_t* Z = (bf16_t*)(p.ws + WS_Z);
        EPI_FOR8(acc, { const int cr = mt * 256 + lr; if (cr < NCROW) { const int col = ntile * 256 + lc, t = col >> 4, co = col & 15;
            const f32x4 g0 = (f32x4){gelu_tanh(v0[0]), gelu_tanh(v0[1]), gelu_tanh(v0[2]), gelu_tanh(v0[3])}, g1_ = (f32x4){gelu_tanh(v1[0]), gelu_tanh(v1[1]), gelu_tanh(v1[2]), gelu_tanh(v1[3])};
            store_bf16x8(Z + (size_t)(crow_tok(cr) + t) * 256 + g * 16 + co, g0, g1_); } });
    }
};
DI void phase_C(const Params& p, LAS char* shm, int l, const int wv_) {
    for (int u = blockIdx.x; u < 512; u += gridDim.x) { const int qb = u & 3, h = (u >> 2) & 3, b = u >> 4;
        attn_unit(p, shm, l, b, h, b * SEQ + qb * 512, 512, 0, 2304, wv_); }
    { PvS5Out pv{p, l}; gemm_stream(shm, pv, wv_); }
    if (l == 0) for (int u = first_unit(512 + 320); u < 128; u += gridDim.x) { const int h = u & 3, b = u >> 2;
        attn_unit(p, shm, l, b, h, TX + b * CTXL, 256, 2048, 256, wv_); }
}

struct PvGlu {
    const Params& p; int l;
    PV_NOHOOKS
    static constexpr int NT = 4; static constexpr int FP8 = 0; static constexpr bool PARK = false; typedef APlain AS; typedef BSimple BS;
    DI int first() const { return lin_first(0, 288); }
    DI int next(int u) const { return lin_next(u, 288); }
    DI void src(int u, AS& a, BS& b, const int wv_) const {
        a = make_a_plain((const bf16_t*)(p.ws + WS_Z), (size_t)u * 256, 256, 0);
        const bf16_t* W = (const bf16_t*)(p.ws + WS_WGLU) + (size_t)l * 65536;
        b = make_b(W, W + (size_t)128 * 256, 256);
    }
    DI void epi(f32x4 (&acc)[2][2][4][2], int u, const int wv_) const {
        const bf16_t* Z = (const bf16_t*)(p.ws + WS_Z); bf16_t* CAT = (bf16_t*)(p.ws + WS_CAT);
        const int _tz = otid(), _w = _tz >> 6, _l = _tz & 63, _wr = _w >> 2, _wc = _w & 3, _fr = _l & 15, _fq = _l >> 4;
        const int c0 = _wc * 32 + _fq * 8;
        f32x4 bsv[2][2];
#pragma unroll
        for (int bj = 0; bj < 2; ++bj)
#pragma unroll
            for (int n = 0; n < 2; ++n) bsv[bj][n] = *(const f32x4*)(p.ssm_glu_b + l * 256 + bj * 128 + n * 4 + c0);
#pragma unroll
        for (int ai = 0; ai < 2; ++ai) {
            u32x4 zz[4][2];
#pragma unroll
            for (int m = 0; m < 4; ++m)
#pragma unroll
                for (int bj = 0; bj < 2; ++bj) zz[m][bj] = *(const u32x4*)(Z + (size_t)(u * 256 + ai * 128 + _wr * 64 + m * 16 + _fr) * 256 + bj * 128 + c0);
#pragma unroll
            for (int m = 0; m < 4; ++m) { const size_t r = (size_t)(u * 256 + ai * 128 + _wr * 64 + m * 16 + _fr);
#pragma unroll
                for (int bj = 0; bj < 2; ++bj) { const f32x4 a0 = acc[ai][bj][m][0], a1 = acc[ai][bj][m][1]; const f32x4 b0 = bsv[bj][0], b1 = bsv[bj][1]; const u32x4 z_ = zz[m][bj];
                    const f32x4 o0 = (f32x4){bflo(z_.x) * sigmoidf_(a0[0] + b0[0]), bfhi(z_.x) * sigmoidf_(a0[1] + b0[1]), bflo(z_.y) * sigmoidf_(a0[2] + b0[2]), bfhi(z_.y) * sigmoidf_(a0[3] + b0[3])};
                    const f32x4 o1 = (f32x4){bflo(z_.z) * sigmoidf_(a1[0] + b1[0]), bfhi(z_.z) * sigmoidf_(a1[1] + b1[1]), bflo(z_.w) * sigmoidf_(a1[2] + b1[2]), bfhi(z_.w) * sigmoidf_(a1[3] + b1[3])};
                    store_bf16x8(CAT + r * 1024 + 512 + bj * 128 + c0, o0, o1); } }
        }
    }
};
DI void phase_D(const Params& p, LAS char* shm, int l, const int wv_) {
    PvGlu pv{p, l}; gemm_stream(shm, pv, wv_);
}

struct PvOutproj {
    const Params& p; int l;
    PV_NOHOOKS
    static constexpr int NT = 16; static constexpr int FP8 = 0; static constexpr bool PARK = false; typedef APlain AS; typedef BSimple BS;
    XcdDeal<4, 4> deal;
    DI int first() const { return deal.first(); }
    DI int next(int u) const { return deal.next(u); }
    DI void src(int u, AS& a, BS& b, const int wv_) const {
        int mt, nt; deal.decode(u, mt, nt);
        const bf16_t* W = (const bf16_t*)(p.ws + WS_WMO) + (size_t)l * 1024 * 1024;
        a = make_a_plain((const bf16_t*)(p.ws + WS_CAT), (size_t)mt * 256, 1024, 0);
        b = make_b(W + (size_t)(nt * 256) * 1024, W + (size_t)(nt * 256 + 128) * 1024, 1024);
    }
    DI void epi(f32x4 (&acc)[2][2][4][2], int u, const int wv_) const {
        int mt, nt; deal.decode(u, mt, nt);
        bf16_t* X = (bf16_t*)(p.ws + WS_X);
        const float* MOD = (const float*)(p.ws + WS_MOD) + (size_t)l * 33 * 6144;
        const int _tz = otid(), _w = _tz >> 6, _l = _tz & 63, _wr = _w >> 2, _wc = _w & 3, _fr = _l & 15, _fq = _l >> 4;
        const int c0 = nt * 256 + _wc * 32 + _fq * 8;
        const int row0 = mt * 256;
        const float* g1p = MOD + (size_t)mod_row(row0) * 6144 + 2048 + c0;
        f32x4 g1[2][2];
#pragma unroll
        for (int bj = 0; bj < 2; ++bj)
#pragma unroll
            for (int n = 0; n < 2; ++n) g1[bj][n] = *(const f32x4*)(g1p + bj * 128 + n * 4);
        bf16_t* obase = X + (size_t)row0 * 1024;
        if (l == 0) {
            const float* xbase = row0 < TX ? p.x + (size_t)row0 * 1024 : p.ctx + (size_t)(row0 - TX) * 1024;
#pragma unroll
            for (int ai = 0; ai < 2; ++ai)
#pragma unroll
                for (int mp = 0; mp < 2; ++mp) {
                    f32x4 xv[2][2][2];
#pragma unroll
                    for (int mm = 0; mm < 2; ++mm)
#pragma unroll
                        for (int bj = 0; bj < 2; ++bj)
#pragma unroll
                            for (int n = 0; n < 2; ++n) xv[mm][bj][n] = *(const f32x4*)(xbase + (size_t)(ai * 128 + _wr * 64 + (mp * 2 + mm) * 16 + _fr) * 1024 + c0 + bj * 128 + n * 4);
#pragma unroll
                    for (int mm = 0; mm < 2; ++mm)
#pragma unroll
                        for (int bj = 0; bj < 2; ++bj)
                            store_bf16x8(obase + (size_t)(ai * 128 + _wr * 64 + (mp * 2 + mm) * 16 + _fr) * 1024 + c0 + bj * 128,
                                         xv[mm][bj][0] + g1[bj][0] * acc[ai][bj][mp * 2 + mm][0], xv[mm][bj][1] + g1[bj][1] * acc[ai][bj][mp * 2 + mm][1]);
                }
        } else {
#pragma unroll
            for (int ai = 0; ai < 2; ++ai) {
                u32x4 xv[4][2];
#pragma unroll
                for (int m = 0; m < 4; ++m)
#pragma unroll
                    for (int bj = 0; bj < 2; ++bj) xv[m][bj] = *(const u32x4*)(obase + (size_t)(ai * 128 + _wr * 64 + m * 16 + _fr) * 1024 + c0 + bj * 128);
#pragma unroll
                for (int m = 0; m < 4; ++m)
#pragma unroll
                    for (int bj = 0; bj < 2; ++bj) { const u32x4 x_ = xv[m][bj];
                        const f32x4 x0 = (f32x4){bflo(x_.x), bfhi(x_.x), bflo(x_.y), bfhi(x_.y)}, x1 = (f32x4){bflo(x_.z), bfhi(x_.z), bflo(x_.w), bfhi(x_.w)};
                        store_bf16x8(obase + (size_t)(ai * 128 + _wr * 64 + m * 16 + _fr) * 1024 + c0 + bj * 128, x0 + g1[bj][0] * acc[ai][bj][m][0], x1 + g1[bj][1] * acc[ai][bj][m][1]); }
            }
        }
    }
};
DI void phase_E(const Params& p, LAS char* shm, int l, const int wv_) {
    PvOutproj pv{p, l, {(l == 1 ? TX : TT) / 256}}; gemm_stream(shm, pv, wv_);
}

template <int S> DI float row_rot_f(float v) { return __int_as_float(__builtin_amdgcn_update_dpp(0, __float_as_int(v), 0x120 | S, 0xf, 0xf, false)); }
template <int S> DI int row_rot_i(int v) { return __builtin_amdgcn_update_dpp(0, v, 0x120 | S, 0xf, 0xf, false); }
template <int S> struct RankAcc {
    static DI void run(float o0, float o1, int oe, float v0, float v1, int e0, int& r0, int& r1) {
        const float a0 = S ? row_rot_f<S>(o0) : o0, a1 = S ? row_rot_f<S>(o1) : o1; const int ae = S ? row_rot_i<S>(oe) : oe;
        r0 += (a0 > v0 || (a0 == v0 && ae < e0)) ? 1 : 0;
        r0 += (a1 > v0) ? 1 : 0;
        r1 += (a0 > v1 || a0 == v1) ? 1 : 0;
        r1 += (a1 > v1 || (a1 == v1 && ae < e0)) ? 1 : 0;
        RankAcc<S + 1>::run(o0, o1, oe, v0, v1, e0, r0, r1);
    }
};
template <> struct RankAcc<16> { static DI void run(float, float, int, float, float, int, int&, int&) {} };
DI float row_sum16(float v) { v += row_rot_f<8>(v); v += row_rot_f<4>(v); v += row_rot_f<2>(v); v += row_rot_f<1>(v); return v; }
DI float row_max16(float v) { v = fmaxf(v, row_rot_f<8>(v)); v = fmaxf(v, row_rot_f<4>(v)); v = fmaxf(v, row_rot_f<2>(v)); v = fmaxf(v, row_rot_f<1>(v)); return v; }

DI void phase_router(const Params& p, LAS char* shm, int l, const int wv_) {
    const int tid = otid(), wid = tid >> 6, lane = tid & 63;
    const int Tm = (l == 1) ? TX : TT;
    const bf16_t* X = (const bf16_t*)(p.ws + WS_X);
    const float* MOD = (const float*)(p.ws + WS_MOD) + (size_t)l * 33 * 6144;
    unsigned char* H8 = (unsigned char*)(p.ws + WS_H);
    const bool alt = p.ph_lo != 0;
    int* CNT = (int*)(p.ws + WS_CNT) + l * 32 + (alt ? 64 : 0);
    int* LIST = alt ? (int*)(p.ws + WS_RY) : (int*)(p.ws + WS_LIST);
    LAS char* wfr = shm;
    LAS bf16_t* gml = (LAS bf16_t*)(shm + 131072);
    LAS bf16_t* shl = gml + 1024;
    LAS float* cvec = (LAS float*)(shm + 131072 + 4096);
    LAS int* lcnt = (LAS int*)(cvec + 32);
    LAS int* lbase = lcnt + 32;
    LAS unsigned* lrec = (LAS unsigned*)(lbase + 32);
    LAS float* lwt = (LAS float*)(lrec + 1152);
    const int tpw = (Tm + gridDim.x - 1) / gridDim.x;
    const int tbeg = blockIdx.x * tpw, tend = min(tbeg + tpw, Tm);
    if (tid < 32) lcnt[tid] = 0;
    int seg_beg = tbeg;
    while (seg_beg < tend) {
        const int mrow = mod_row(seg_beg);
        int seg_end = tend;
        if (mrow < 32) seg_end = min(tend, (mrow + 1) * SEQ); else seg_end = tend;
        const float* mr = MOD + (size_t)mrow * 6144;
        __syncthreads();
        for (int k = tid; k < 1024; k += 512) { const float gmv = p.norm2_g[l * 1024 + k] * (1.f + mr[4096 + k]); gml[k] = f2bf(gmv); shl[k] = f2bf(mr[3072 + k]); }
        for (int i = tid; i < 1024 * 8; i += 512) {
            const int k = i >> 3, e4 = (i & 7) * 4;
            const float gmv = p.norm2_g[l * 1024 + k] * (1.f + mr[4096 + k]);
            const f32x4 w = *(const f32x4*)(p.router_w + (size_t)l * 32768 + k * 32 + e4);
            const int ks = k >> 5, kq = (k >> 3) & 3, j = k & 7;
#pragma unroll
            for (int c = 0; c < 4; ++c) { const int e = e4 + c, nb = e >> 4, ei = e & 15; const float wv = w[c] * gmv;
                const bf16_t hi = f2bf(wv); const bf16_t lo = f2bf(wv - bf2f(hi));
                LAS bf16_t* dst = (LAS bf16_t*)(wfr + ((size_t)((ks * 2 + nb) * 2) * 64 + (kq * 16 + ei)) * 16) + j;
                dst[0] = hi; dst[64 * 8] = lo; }
        }
        {
            float s4[4] = {0.f, 0.f, 0.f, 0.f};
            for (int k = lane; k < 1024; k += 64) { const float shv = mr[3072 + k]; const f32x4 w = *(const f32x4*)(p.router_w + (size_t)l * 32768 + k * 32 + wid * 4);
                s4[0] += shv * w[0]; s4[1] += shv * w[1]; s4[2] += shv * w[2]; s4[3] += shv * w[3]; }
#pragma unroll
            for (int c = 0; c < 4; ++c) { const float t_ = wave_sum(s4[c]); if (lane == 0) cvec[wid * 4 + c] = t_ + p.router_b[l * 32 + wid * 4 + c]; }
        }
        __syncthreads();
        const int ngroups = (seg_end - seg_beg) >> 4;
        for (int gi = wid; gi < ngroups; gi += 8) {
            const int t0 = seg_beg + gi * 16;
            const int tok = lane & 15, kq = lane >> 4;
            const bf16_t* xr = X + (size_t)(t0 + tok) * 1024 + kq * 8;
            f32x4 acc0 = {0.f, 0.f, 0.f, 0.f}, acc1 = {0.f, 0.f, 0.f, 0.f};
            float ss = 0.f;
#pragma unroll 8
            for (int ks = 0; ks < 32; ++ks) {
                const u32x4 xh = *(const u32x4*)(xr + ks * 32);
                const float x0 = bflo(xh.x), x1 = bfhi(xh.x), x2 = bflo(xh.y), x3 = bfhi(xh.y), x4 = bflo(xh.z), x5 = bfhi(xh.z), x6 = bflo(xh.w), x7 = bfhi(xh.w);
                ss += x0 * x0 + x1 * x1 + x2 * x2 + x3 * x3 + x4 * x4 + x5 * x5 + x6 * x6 + x7 * x7;
                const bf16x8 ah = __builtin_bit_cast(bf16x8, xh);
                const LAS char* wb = wfr + (size_t)(ks * 4) * 1024 + lane * 16;
                const bf16x8 b0h = *(const LAS bf16x8*)(wb), b0l = *(const LAS bf16x8*)(wb + 1024), b1h = *(const LAS bf16x8*)(wb + 2048), b1l = *(const LAS bf16x8*)(wb + 3072);
                acc0 = __builtin_amdgcn_mfma_f32_16x16x32_bf16(ah, b0h, acc0, 0, 0, 0); acc0 = __builtin_amdgcn_mfma_f32_16x16x32_bf16(ah, b0l, acc0, 0, 0, 0);
                acc1 = __builtin_amdgcn_mfma_f32_16x16x32_bf16(ah, b1h, acc1, 0, 0, 0); acc1 = __builtin_amdgcn_mfma_f32_16x16x32_bf16(ah, b1l, acc1, 0, 0, 0);
            }
            ss += shx(ss, 16); ss += shx(ss, 32);
            const float rn = rsqrtf(ss * (1.f / 1024.f) + EPS);
            const int ei = lane & 15;
            const float c0v = cvec[ei], c1v = cvec[16 + ei];
#pragma unroll
            for (int r = 0; r < 4; ++r) {
                const int tl = (lane >> 4) * 4 + r;
                const float rnt = shi(rn, tl);
                float v0 = fminf(fmaxf(acc0[r] * rnt + c0v, -1e30f), 1e30f), v1 = fminf(fmaxf(acc1[r] * rnt + c1v, -1e30f), 1e30f);
                int r0 = 0, r1 = 0;
                RankAcc<0>::run(v0, v1, ei, v0, v1, ei, r0, r1);
                const float mx = row_max16(fmaxf(v0, v1));
                const bool s0 = r0 < 4, s1 = r1 < 4;
                const float e0 = s0 ? __expf(v0 - mx) : 0.f, e1 = s1 ? __expf(v1 - mx) : 0.f;
                const float inv = 1.f / row_sum16(e0 + e1);
                const int t = t0 + tl;
                if (s0) { const int pos = atomicAdd((int*)&lcnt[ei], 1); lrec[(t - tbeg) * 4 + r0] = (unsigned)ei | ((unsigned)pos << 8); lwt[(t - tbeg) * 4 + r0] = e0 * inv; }
                if (s1) { const int pos = atomicAdd((int*)&lcnt[16 + ei], 1); lrec[(t - tbeg) * 4 + r1] = (unsigned)(16 + ei) | ((unsigned)pos << 8); lwt[(t - tbeg) * 4 + r1] = e1 * inv; }
            }
            unsigned char* hr = H8 + (size_t)(t0 + tok) * 1024 + kq * 8;
#pragma unroll 8
            for (int ks = 0; ks < 32; ++ks) {
                const u32x4 xh = *(const u32x4*)(xr + ks * 32);
                const u32x4 gq = *(const LAS u32x4*)(gml + ks * 32 + kq * 8), sq = *(const LAS u32x4*)(shl + ks * 32 + kq * 8);
                float h[8];
                h[0] = bflo(xh.x) * rn * bflo(gq.x) + bflo(sq.x); h[1] = bfhi(xh.x) * rn * bfhi(gq.x) + bfhi(sq.x); h[2] = bflo(xh.y) * rn * bflo(gq.y) + bflo(sq.y); h[3] = bfhi(xh.y) * rn * bfhi(gq.y) + bfhi(sq.y);
                h[4] = bflo(xh.z) * rn * bflo(gq.z) + bflo(sq.z); h[5] = bfhi(xh.z) * rn * bfhi(gq.z) + bfhi(sq.z); h[6] = bflo(xh.w) * rn * bflo(gq.w) + bflo(sq.w); h[7] = bfhi(xh.w) * rn * bfhi(gq.w) + bfhi(sq.w);
#pragma unroll
                for (int i = 0; i < 8; ++i) h[i] = __builtin_amdgcn_fmed3f(h[i], -448.f, 448.f);
                u32x2 o; o.x = pk_fp8x4(h[0], h[1], h[2], h[3]); o.y = pk_fp8x4(h[4], h[5], h[6], h[7]);
                *(u32x2*)(hr + ks * 32) = o;
            }
        }
        seg_beg = seg_end;
    }
    __syncthreads();
    if (tid < 32) lbase[tid] = atomicAdd(&CNT[tid], lcnt[tid]);
    __syncthreads();
    for (int i = tid; i < (tend - tbeg) * 4; i += 512) { const unsigned rec = lrec[i]; const int e = rec & 255, pos = rec >> 8;
        u32x2 ent; ent.x = (unsigned)(tbeg * 4 + i); ent.y = __float_as_uint(lwt[i]);
        *(u32x2*)(LIST + ((size_t)e * TT + lbase[e] + pos) * 2) = ent; }
    __syncthreads();
}

DI void moe_tiles(const Params& p, LAS int* tstart, int l, const int wv_) {
    const int* CNT = (const int*)(p.ws + WS_CNT) + l * 32;
    if (otid() == 0) { int s = 0; for (int e = 0; e < 32; ++e) { tstart[e] = s; s += (CNT[e] + 255) >> 8; } tstart[32] = s; }
    __syncthreads();
    LAS int* ttab = (LAS int*)((LAS char*)tstart - (LDS_MISC + 64) + LDS_TTAB);
    const int MT_ = tstart[32];
    for (int mt = otid(); mt < MT_; mt += 512) { int e = 0;
#pragma unroll
        for (int i = 1; i < 32; ++i) e += (mt >= tstart[i]) ? 1 : 0;
        ttab[mt] = e | ((mt - tstart[e]) << 8); }
    __syncthreads();
}
DI int moe_find(const LAS int* tstart, int mt) { const LAS int* ttab = (const LAS int*)((const LAS char*)tstart - (LDS_MISC + 64) + LDS_TTAB); return __builtin_amdgcn_readfirstlane(ttab[mt]); }
struct PvMoe1 {
    const Params& p; int l; const LAS int* tstart; LAS char* tbl;
    static constexpr int NT = 8; static constexpr int FP8 = 2; static constexpr bool PARK = false; typedef ASimple AS; typedef BSimple BS;
    XcdDeal<4, 8> deal;
    DI int first() const { return deal.first(); }
    DI int next(int u) const { return deal.next(u); }
    typedef u32x4 Aux;
    DI void top(int u, Aux& aux, const int wv_) const {
        int mt, n8; deal.decode(u, mt, n8);
        const int ev_ = moe_find(tstart, mt); const int e = ev_ & 255;
        const int t_ = otid() & 63;
        aux = aload128(p.exp_b_in + (size_t)(l * NE + e) * 2048 + (t_ < 32 ? n8 * 128 + t_ * 4 : 1024 + n8 * 128 + (t_ - 32) * 4));
    }
    DI void mid(Aux& aux, const int wv_) const { const int t_ = otid(); asm volatile("" : "+v"(aux)); if (t_ < 64) *(LAS u32x4*)(tbl + t_ * 16) = aux; }
    DI void fix(AS& as, bool wait, const int wv_) const {
        if (wait) asm volatile("s_waitcnt vmcnt(0)" ::: "memory");
        int R[2], C[2]; stage_coords(R, C, wv_);
#pragma unroll
        for (int h = 0; h < 2; ++h)
#pragma unroll
            for (int i = 0; i < 2; ++i) { unsigned sl = as.off[h][i]; asm volatile("" : "+v"(sl)); as.off[h][i] = (sl >> 2) * 1024u + (unsigned)(C[i] * 2); }
    }
    DI void src(int u, AS& as, BS& bs, const int wv_) const {
        int mt, n8; deal.decode(u, mt, n8);
        const int ev_ = moe_find(tstart, mt); const int e = ev_ & 255;
        const int r0 = (ev_ >> 8) * 256, cnt = ((const int*)(p.ws + WS_CNT))[l * 32 + e];
        const int* lst = (const int*)(p.ws + WS_LIST) + (size_t)e * TT * 2;
        int R[2], C[2]; stage_coords(R, C, wv_);
        as.base = (const char*)(p.ws + WS_H); as.kstride = 128;
#pragma unroll
        for (int h = 0; h < 2; ++h)
#pragma unroll
            for (int i = 0; i < 2; ++i) as.off[h][i] = aload32(lst + 2 * min(r0 + h * 128 + R[i], cnt - 1));
        const char* W = (const char*)(p.ws + WS_W1) + (size_t)(l * NE + e) * 2048 * 1024;
        bs.base[0] = W + (size_t)(n8 * 128) * 1024; bs.base[1] = W + (size_t)(1024 + n8 * 128) * 1024; bs.ldb2 = 1024;
    }
    DI void epi(f32x4 (&acc)[2][2][4][2], int u, const int wv_) const {
        int mt, n8; deal.decode(u, mt, n8);
        const int ev_ = moe_find(tstart, mt); const int e = ev_ & 255;
        unsigned char* ACT = (unsigned char*)(p.ws + WS_RA);
        const int _tz = otid(), _w = _tz >> 6, _l = _tz & 63, _wr = _w >> 2, _wc = _w & 3, _fr = _l & 15, _fq = _l >> 4;
        const LAS float* bin = (const LAS float*)tbl + _wc * 32 + _fq * 8;
        f32x4 bg[2], bu[2];
#pragma unroll
        for (int n = 0; n < 2; ++n) { bg[n] = *(const LAS f32x4*)(bin + n * 4); bu[n] = *(const LAS f32x4*)(bin + 128 + n * 4); }
        (void)e;
#pragma unroll
        for (int ai = 0; ai < 2; ++ai)
#pragma unroll
            for (int m = 0; m < 4; ++m) { const int lr = ai * 128 + _wr * 64 + m * 16 + _fr;
                unsigned char* orow = ACT + ((size_t)mt * 256 + lr) * 1024 + n8 * 128 + _wc * 32 + _fq * 8;
                u32x2 pk;
#pragma unroll
                for (int n = 0; n < 2; ++n) {
                    float o[4];
#pragma unroll
                    for (int h2 = 0; h2 < 2; ++h2) {
                        const f32v2_t ag = {acc[ai][0][m][n][2 * h2], acc[ai][0][m][n][2 * h2 + 1]}, au = {acc[ai][1][m][n][2 * h2], acc[ai][1][m][n][2 * h2 + 1]};
                        const f32v2_t bgv = {bg[n][2 * h2], bg[n][2 * h2 + 1]}, buv = {bu[n][2 * h2], bu[n][2 * h2 + 1]};
                        f32v2_t g2 = ag * (1.f / 256.f) + bgv, u2 = au * (1.f / 256.f) + buv;
                        g2[0] = fminf(g2[0], 7.f); g2[1] = fminf(g2[1], 7.f);
                        u2[0] = __builtin_amdgcn_fmed3f(u2[0], -7.f, 7.f); u2[1] = __builtin_amdgcn_fmed3f(u2[1], -7.f, 7.f);
                        const f32v2_t t2 = g2 * (-2.4554669595930156f);
                        f32v2_t e2; e2[0] = __builtin_amdgcn_exp2f(t2[0]); e2[1] = __builtin_amdgcn_exp2f(t2[1]);
                        const f32v2_t d2 = e2 + 1.f;
                        f32v2_t r2; r2[0] = __builtin_amdgcn_rcpf(d2[0]); r2[1] = __builtin_amdgcn_rcpf(d2[1]);
                        const f32v2_t o2 = (u2 + 1.f) * g2 * r2;
                        o[2 * h2] = o2[0]; o[2 * h2 + 1] = o2[1]; }
                    if (n == 0) pk.x = pk_fp8x4(o[0], o[1], o[2], o[3]); else pk.y = pk_fp8x4(o[0], o[1], o[2], o[3]); }
                *(u32x2*)orow = pk; }
    }
};
DI void phase_moe1(const Params& p, LAS char* shm, int l, const int wv_) {
    LAS int* tstart = (LAS int*)(shm + LDS_MISC + 64);
    moe_tiles(p, tstart, l, wv_);
    PvMoe1 pv{p, l, tstart, shm + 131072, {tstart[32]}}; gemm_stream(shm, pv, wv_);
}
struct PvMoe2 {
    const Params& p; int l; const LAS int* tstart; LAS char* tbl;
    static constexpr int NT = 8; static constexpr int FP8 = 2; static constexpr bool PARK = false; typedef APlain AS; typedef BSeq16 BS;
    XcdDeal<4, 4> deal;
    DI int first() const { return deal.first(); }
    DI int next(int u) const { return deal.next(u); }
    template <class A_> DI void fix(A_&, bool, const int) const {}
    typedef u32x4 Aux;
    DI void top(int u, Aux& aux, const int wv_) const {
        int mt, n4; deal.decode(u, mt, n4);
        const int ev_ = moe_find(tstart, mt); const int e = ev_ & 255; const int r0 = (ev_ >> 8) * 256;
        const int t_ = otid();
        const char* src_ = t_ < 128 ? (const char*)((const int*)(p.ws + WS_LIST) + (size_t)e * TT * 2 + (size_t)(r0 + 2 * t_) * 2)
                                    : (const char*)(p.exp_b_out + (size_t)(l * NE + e) * 1024 + n4 * 256 + ((t_ - 128) & 63) * 4);
        aux = aload128(src_);
    }
    DI void mid(Aux& aux, const int wv_) const { const int t_ = otid(); asm volatile("" : "+v"(aux)); if (t_ < 192) *(LAS u32x4*)(tbl + t_ * 16) = aux; }
    DI void src(int u, AS& as, BS& bs, const int wv_) const {
        int mt, n4; deal.decode(u, mt, n4);
        const int ev_ = moe_find(tstart, mt); const int e = ev_ & 255;
        as.base = (const char*)(p.ws + WS_RA) + (size_t)mt * 256 * 1024; as.lda2 = 1024;
        const char* W = (const char*)(p.ws + WS_W2) + (size_t)(l * NE + e) * 1024 * 1024;
        bs.base = W + (size_t)(n4 * 256) * 1024; bs.ldb2 = 1024;
    }
    DI void epi(f32x4 (&acc)[2][2][4][2], int u, const int wv_) const {
        int mt, n4; deal.decode(u, mt, n4);
        const int ev_ = moe_find(tstart, mt); const int e = ev_ & 255;
        const int r0 = (ev_ >> 8) * 256, cnt = ((const int*)(p.ws + WS_CNT))[l * 32 + e];
        const int* lst = (const int*)(p.ws + WS_LIST) + (size_t)e * TT * 2;
        unsigned char* Y = (unsigned char*)(p.ws + WS_RY);
        const int _tz = otid(), _w = _tz >> 6, _l = _tz & 63, _wr = _w >> 2, _wc = _w & 3, _fr = _l & 15, _fq = _l >> 4;
        const LAS float* bo = (const LAS float*)(tbl + 2048) + _wc * 64 + _fq * 16;
        u32x2 ent[2][4]; f32x4 bv[2][2];
#pragma unroll
        for (int ai = 0; ai < 2; ++ai)
#pragma unroll
            for (int m = 0; m < 4; ++m) ent[ai][m] = *(const LAS u32x2*)(tbl + (ai * 128 + _wr * 64 + m * 16 + _fr) * 8);
#pragma unroll
        for (int bj = 0; bj < 2; ++bj)
#pragma unroll
            for (int n = 0; n < 2; ++n) bv[bj][n] = *(const LAS f32x4*)(bo + bj * 8 + n * 4);
        (void)lst;
#pragma unroll
        for (int ai = 0; ai < 2; ++ai)
#pragma unroll
            for (int m = 0; m < 4; ++m) { const int lr = r0 + ai * 128 + _wr * 64 + m * 16 + _fr;
                if (lr < cnt) { const float w = __uint_as_float(ent[ai][m].y) * YSCALE; unsigned char* orow = Y + (size_t)ent[ai][m].x * 1024 + n4 * 256 + _wc * 64 + _fq * 16;
                    const float sc_ = 1.f / 256.f;
                    u32x4 pk;
#pragma unroll
                    for (int bj = 0; bj < 2; ++bj)
#pragma unroll
                        for (int n = 0; n < 2; ++n) { const f32x4 v = (acc[ai][bj][m][n] * sc_ + bv[bj][n]) * w;
                            pk[bj * 2 + n] = pk_fp8x4(__builtin_amdgcn_fmed3f(v[0], -448.f, 448.f), __builtin_amdgcn_fmed3f(v[1], -448.f, 448.f), __builtin_amdgcn_fmed3f(v[2], -448.f, 448.f), __builtin_amdgcn_fmed3f(v[3], -448.f, 448.f)); }
                    *(u32x4*)orow = pk; } }
    }
};
DI void phase_moe2(const Params& p, LAS char* shm, int l, const int wv_) {
    LAS int* tstart = (LAS int*)(shm + LDS_MISC + 64);
    moe_tiles(p, tstart, l, wv_);
    PvMoe2 pv{p, l, tstart, shm + 131072, {tstart[32]}}; gemm_stream(shm, pv, wv_);
}

DI void phase_combine(const Params& p, LAS char* shm, int l, const int wv_) {
    const int tid = otid(), wid = tid >> 6, lane = tid & 63;
    const bool alt = p.ph_lo != 0;
    const bf16_t* X = (const bf16_t*)(p.ws + WS_X);
    bf16_t* XO = alt ? (bf16_t*)(p.ws + WS_RA) : (bf16_t*)(p.ws + WS_X);
    float* OUT = alt ? (float*)(p.ws + WS_RA) : p.out;
    const unsigned char* Y = (const unsigned char*)(p.ws + WS_RY);
    const float* MOD = (const float*)(p.ws + WS_MOD);
    bf16_t* H = alt ? (bf16_t*)(p.ws + WS_RA + (size_t)TT * 1024 * 4) : (bf16_t*)(p.ws + WS_H);
    const int Tm = (l == 1) ? TX : TT;
    for (int r = blockIdx.x * 8 + wid; r < Tm; r += gridDim.x * 8) {
        const float* g2 = MOD + (size_t)(l * 33 + mod_row(r)) * 6144 + 5120;
        float v[16];
#pragma unroll
        for (int j = 0; j < 4; ++j) {
            const int col = j * 256 + lane * 4;
            f32x4 s = (f32x4){0.f, 0.f, 0.f, 0.f};
#pragma unroll
            for (int k = 0; k < 4; ++k) { const int yy = *(const int*)(Y + ((size_t)r * 4 + k) * 1024 + col); const f32v2_t ya = __builtin_amdgcn_cvt_pk_f32_fp8(yy, false), yb = __builtin_amdgcn_cvt_pk_f32_fp8(yy, true);
                s[0] += ya[0]; s[1] += ya[1]; s[2] += yb[0]; s[3] += yb[1]; }
            s *= 1.f / YSCALE;
            const u32x2 xb_ = *(const u32x2*)(X + (size_t)r * 1024 + col); const f32x4 gg = *(const f32x4*)(g2 + col);
            const f32x4 xv = (f32x4){bflo(xb_.x), bfhi(xb_.x), bflo(xb_.y), bfhi(xb_.y)};
            const f32x4 o = xv + gg * s;
            if (l == 1) *(f32x4*)(OUT + (size_t)r * 1024 + col) = o; else store_bf16x4(XO + (size_t)r * 1024 + col, o[0], o[1], o[2], o[3]);
            v[j * 4] = o[0]; v[j * 4 + 1] = o[1]; v[j * 4 + 2] = o[2]; v[j * 4 + 3] = o[3];
        }
        if (l == 0) norm_mod_store(v, p.norm1_g + 1024, MOD + (size_t)(1 * 33 + mod_row(r)) * 6144, H + (size_t)r * 1024, wv_);
    }
}

constexpr int NPH_LAYER = 10;
constexpr int NPH = 2 + 2 * NPH_LAYER;

__global__ void __launch_bounds__(512, 2) mk_forward(Params p_unused) {
    extern __shared__ __attribute__((aligned(16))) char smem_raw[];
    LAS char* shm = (LAS char*)smem_raw;
    volatile LAS unsigned* xb_words = (volatile LAS unsigned*)(shm + LDS_MISC);
    const int wv_ = __builtin_amdgcn_readfirstlane((int)(threadIdx.x >> 6));
    if (wv_ == 0 && olane() < 4) xb_words[olane()] = 0u;
    __syncthreads();
    kaptr_t ka = (kaptr_t)__builtin_amdgcn_kernarg_segment_ptr();
    const int tok0 = ptoken();
    const int lo = (int)kld64<__builtin_offsetof(Params, ph_lo)>(ka, tok0), hi = (int)kld64<__builtin_offsetof(Params, ph_hi)>(ka, tok0);
    const bool multi = (hi - lo) > 1;
    unsigned* barw = (unsigned*)((__attribute__((address_space(1))) char*)kld64<__builtin_offsetof(Params, ws)>(ka, tok0) + WS_BAR);
    XcdBarrier bar; bar.bar = barw; bar.x = 0; bar.st = xb_words;
    if (multi) bar = xcd_barrier_post(barw, xb_words, wv_);
#ifndef ONLY_KIND
#define ONLY_KIND (-1)
#endif
#define PHASE(idx, kind, FN, ...) do { if ((ONLY_KIND < 0 || ONLY_KIND == (kind)) && (idx) >= lo && (idx) < hi) { const Params p = kparams(ka, ptoken()); int nrep_ = 1 + ((MK_REPEAT_MASK >> (kind)) & 1); asm volatile("" : "+s"(nrep_)); for (int rep_ = 0; rep_ < nrep_; ++rep_) { Params p2 = p; p2.ph_lo = rep_; FN(p2, ##__VA_ARGS__, wv_); } if ((idx) + 1 < hi) xcd_barrier(bar, wv_); } } while (0)
    PHASE(0, 0, phase_prologue, shm);
    PHASE(1, 1, phase_norm1_l0);
    for (int l = 0; l < 2; ++l) {
        const int b0 = 2 + l * NPH_LAYER;
        PHASE(b0 + 0, 2, phase_inproj, shm, l);
        PHASE(b0 + 1, 3, phase_A, shm, l);
        PHASE(b0 + 2, 4, phase_B, shm, l);
        PHASE(b0 + 3, 5, phase_C, shm, l);
        PHASE(b0 + 4, 6, phase_D, shm, l);
        PHASE(b0 + 5, 7, phase_E, shm, l);
        PHASE(b0 + 6, 8, phase_router, shm, l);
        PHASE(b0 + 7, 9, phase_moe1, shm, l);
        PHASE(b0 + 8, 10, phase_moe2, shm, l);
        PHASE(b0 + 9, 11, phase_combine, shm, l);
    }
#undef PHASE
}


extern "C" void kernel_launch(void* const* d_in, const int* in_sizes, int n_in, void* d_out, int out_size, void* d_ws, size_t ws_size, hipStream_t stream) {
    static int grid = 0;
    if (grid == 0) {
        if (n_in != 39 || ws_size < WS_END) { fprintf(stderr, "kernel_launch: unexpected n_in %d or ws_size %zu (< %zu)\n", n_in, ws_size, (size_t)WS_END); grid = -1; return; }
        int dev = 0, cus = 0;
        if (hipGetDevice(&dev) != hipSuccess || hipDeviceGetAttribute(&cus, hipDeviceAttributeMultiprocessorCount, dev) != hipSuccess) { grid = -1; return; }
        if (hipFuncSetAttribute((const void*)mk_forward, hipFuncAttributeMaxDynamicSharedMemorySize, LDS_BYTES) != hipSuccess) { fprintf(stderr, "kernel_launch: hipFuncSetAttribute failed\n"); grid = -1; return; }
        int per_cu = 0;
        if (hipOccupancyMaxActiveBlocksPerMultiprocessor(&per_cu, (const void*)mk_forward, 512, LDS_BYTES) != hipSuccess || per_cu < 1) fprintf(stderr, "kernel_launch: occupancy query says %d\n", per_cu);
        (void)hipGetLastError();
        grid = cus > 256 ? 256 : cus;
    }
    if (grid < 0) return;
    (void)hipMemsetAsync((char*)d_ws + WS_BAR, 0, 16384 + 1024, stream);
    Params p{};
    const float** pf = (const float**)&p;
    for (int i = 0; i < 39; ++i) pf[i] = (const float*)d_in[i];
    p.out = (float*)d_out; p.ws = (char*)d_ws;
#if MK_ONE_LAUNCH
    p.ph_lo = 0; p.ph_hi = NPH;
    hipLaunchKernelGGL(mk_forward, dim3(grid), dim3(512), LDS_BYTES, stream, p);
#else
#ifndef MK_LAST_PHASE
#define MK_LAST_PHASE NPH
#endif
    for (int ph = 0; ph < MK_LAST_PHASE; ++ph) { p.ph_lo = ph; p.ph_hi = ph + 1; hipLaunchKernelGGL(mk_forward, dim3(grid), dim3(512), LDS_BYTES, stream, p); }
#endif
}
```

```cpp
#include <hip/hip_runtime.h>
#include <stdint.h>
#include <stdio.h>

#ifndef MK_REPEAT_MASK
#define MK_REPEAT_MASK 0x0
#endif
#ifndef MK_ONE_LAUNCH
#define MK_ONE_LAUNCH 1
#endif

#define DI __device__ __forceinline__
#define LAS __attribute__((address_space(3)))
typedef unsigned short bf16_t;
typedef short bf16x8 __attribute__((ext_vector_type(8)));
typedef short s16x4 __attribute__((ext_vector_type(4)));
typedef float f32x4 __attribute__((ext_vector_type(4)));
typedef float f32x16 __attribute__((ext_vector_type(16)));
typedef unsigned u32x2 __attribute__((ext_vector_type(2)));
typedef unsigned u32x4 __attribute__((ext_vector_type(4)));
typedef int i32x4 __attribute__((ext_vector_type(4)));
typedef int i32x8 __attribute__((ext_vector_type(8)));

constexpr int D = 1024, NB = 32, SEQ = 2048, CTXL = 256;
constexpr int TX = NB * SEQ, TC = NB * CTXL, TT = TX + TC;
constexpr int NINP = 1536;
constexpr int OFF_POOL = 512, OFF_Q = 768, OFF_SSM = 960, OFF_KV = 1216, OFF_KPE = 1344, N_IN = 1376;
constexpr int NE = 32;
constexpr int NCH = 36;
constexpr int NCROW = NB * NCH;
constexpr float EPS = 1e-6f;

constexpr size_t WS_BAR = 0;
constexpr size_t WS_CNT = 16384;
constexpr size_t WS_MOD = WS_CNT + 1024;
constexpr size_t WS_A64 = WS_MOD + (size_t)2 * 33 * 6144 * 4;
constexpr size_t WS_WMI = WS_A64 + (size_t)2 * 2 * 16 * 64 * 2 * 4;
constexpr size_t WS_WMO = WS_WMI + (size_t)2 * 1536 * 1024 * 2;
constexpr size_t WS_WPW = WS_WMO + (size_t)2 * 1024 * 1024 * 2;
constexpr size_t WS_WGLU = WS_WPW + (size_t)2 * 256 * 256 * 2;
constexpr size_t WS_WPOOL = WS_WGLU + (size_t)2 * 256 * 256 * 2;
constexpr size_t WS_WQ = WS_WPOOL + (size_t)2 * 256 * 256 * 2;
constexpr size_t WS_WKV = WS_WQ + (size_t)2 * 512 * 256 * 2;
constexpr size_t WS_TS5 = WS_WKV + (size_t)2 * 512 * 256 * 2;
constexpr size_t WS_WS5 = WS_TS5 + (size_t)2 * 16 * 1024 * 1280 * 2;
constexpr size_t WS_W1 = WS_WS5 + (size_t)2 * 16 * 256 * 1024 * 2;
constexpr size_t WS_W2 = WS_W1 + (size_t)32 * 2048 * 1024 * 2;
constexpr size_t WS_X = WS_W2 + (size_t)32 * 1024 * 1024 * 2;
constexpr size_t WS_H = WS_X + (size_t)TT * 1024 * 4;
constexpr size_t WS_LIST = WS_H + (size_t)TT * 1024 * 2;
constexpr size_t WS_TOPW = WS_LIST + (size_t)32 * TT * 8;
constexpr size_t WS_RA = WS_TOPW + (size_t)TT * 4 * 4;
constexpr float YSCALE = 32.f;
constexpr size_t WS_RY = WS_RA + (size_t)TT * 4 * 1024 * 2;
constexpr size_t WS_END = WS_RY + (size_t)TT * 4 * 1024 * 2;
constexpr size_t WS_P = WS_RA;
constexpr size_t WS_ACONV = WS_P + (size_t)TT * NINP * 2;
constexpr size_t WS_APOOL = WS_ACONV + (size_t)TT * 256 * 2;
constexpr size_t WS_RAWQ = WS_APOOL + (size_t)TT * 256 * 2;
constexpr size_t WS_RAWKV = WS_RAWQ + (size_t)TT * 512 * 4;
constexpr size_t WS_Q = WS_RAWKV + (size_t)TT * 512 * 4;
constexpr size_t WS_KB = WS_Q + (size_t)TT * 384 * 2;
constexpr size_t WS_VT = WS_KB + (size_t)128 * 2304 * 96 * 2;
constexpr size_t WS_SST = WS_VT + (size_t)128 * 64 * 2304 * 2;
constexpr size_t WS_HIN = WS_SST + (size_t)NCROW * 16 * 256 * 4;
constexpr size_t WS_Z = WS_HIN + (size_t)NCROW * 16 * 256 * 2;
constexpr size_t WS_CAT = WS_Z + (size_t)TT * 256 * 2;
constexpr size_t WS_MIX_END = WS_CAT + (size_t)TT * 1024 * 2;
static_assert(WS_MIX_END <= WS_END, "mixer buffers must fit in the ACT/Y regions");
static_assert(WS_END <= (size_t)2147483648ull, "workspace budget");

constexpr int LDS_BYTES = 147456;
constexpr int LDS_TTAB = 131072 + 4096;
constexpr int LDS_MISC = 146432;

struct Params {
    const float *x, *c, *ctx, *c_ctx, *ada_w, *ada_b, *norm1_g, *norm2_g, *w_mix_in, *w_mix_out,
        *conv_dw, *conv_dw_b, *conv_ln_g, *conv_ln_b, *conv_pw, *pool_w, *pool_scale,
        *ssm_a_re, *ssm_a_im, *ssm_log_dt, *ssm_b_re, *ssm_b_im, *ssm_c_re, *ssm_c_im, *ssm_d, *ssm_glu_w, *ssm_glu_b,
        *mla_q_a_g, *mla_wq_b, *mla_kv_a_g, *mla_wkv_b, *mla_q_g, *mla_k_g,
        *router_w, *router_b, *exp_w_in, *exp_b_in, *exp_w_out, *exp_b_out;
    float* out;
    char* ws;
    long long ph_lo, ph_hi;
};

typedef const __attribute__((address_space(4))) char* kaptr_t;
template <int OFF> DI unsigned long long kld64(kaptr_t ka, int tok) {
    unsigned long long v;
    asm("s_load_dwordx2 %0, %1, %3\n\ts_waitcnt lgkmcnt(0)" : "=&s"(v) : "s"(ka), "s"(tok), "n"(OFF));
    return v;
}
DI int ptoken() { int t; asm volatile("s_mov_b32 %0, 0" : "=s"(t)); return t; }
DI Params kparams(kaptr_t ka, int tok) {
    Params p;
#define KL_(f) p.f = (decltype(p.f))((__attribute__((address_space(1))) char*)kld64<__builtin_offsetof(Params, f)>(ka, tok))
    KL_(x); KL_(c); KL_(ctx); KL_(c_ctx); KL_(ada_w); KL_(ada_b); KL_(norm1_g); KL_(norm2_g); KL_(w_mix_in); KL_(w_mix_out); KL_(conv_dw); KL_(conv_dw_b); KL_(conv_ln_g); KL_(conv_ln_b); KL_(conv_pw); KL_(pool_w); KL_(pool_scale); KL_(ssm_a_re); KL_(ssm_a_im); KL_(ssm_log_dt); KL_(ssm_b_re); KL_(ssm_b_im); KL_(ssm_c_re); KL_(ssm_c_im); KL_(ssm_d); KL_(ssm_glu_w); KL_(ssm_glu_b); KL_(mla_q_a_g); KL_(mla_wq_b); KL_(mla_kv_a_g); KL_(mla_wkv_b); KL_(mla_q_g); KL_(mla_k_g); KL_(router_w); KL_(router_b); KL_(exp_w_in); KL_(exp_b_in); KL_(exp_w_out); KL_(exp_b_out); KL_(out); KL_(ws);
#undef KL_
    p.ph_lo = 0; p.ph_hi = 0;
    return p;
}

typedef __bf16 bf16v2_t __attribute__((ext_vector_type(2)));
typedef float f32v2_t __attribute__((ext_vector_type(2)));
DI unsigned pk_bf16(float lo, float hi) { const f32v2_t f = {lo, hi}; const bf16v2_t b = __builtin_convertvector(f, bf16v2_t); return __builtin_bit_cast(unsigned, b); }
DI bf16_t f2bf(float x) { return (bf16_t)(pk_bf16(x, 0.f) & 0xffffu); }
DI float bf2f(bf16_t v) { return __uint_as_float(((unsigned)v) << 16); }
DI unsigned f2fp8(float x) { x = fminf(fmaxf(x, -448.f), 448.f); return (unsigned)__builtin_amdgcn_cvt_pk_fp8_f32(x, x, 0, false) & 0xffu; }
DI unsigned pk_fp8x4(float a, float b, float c, float d) { int v = __builtin_amdgcn_cvt_pk_fp8_f32(a, b, 0, false); v = __builtin_amdgcn_cvt_pk_fp8_f32(c, d, v, true); return (unsigned)v; }
DI float bflo(unsigned u) { return __uint_as_float(u << 16); }
DI float bfhi(unsigned u) { return __uint_as_float(u & 0xffff0000u); }
DI int olane() { int l = (int)__builtin_amdgcn_mbcnt_hi(~0u, __builtin_amdgcn_mbcnt_lo(~0u, 0u)); asm volatile("" : "+v"(l)); return l; }
DI float shx(float v, int o) { const int l = olane(); return __int_as_float(__builtin_amdgcn_ds_bpermute((l ^ o) << 2, __float_as_int(v))); }
DI float shi(float v, int src) { return __int_as_float(__builtin_amdgcn_ds_bpermute(src << 2, __float_as_int(v))); }
#define otid() otid_(wv_)
DI int otid_(int wv) { int t = (wv << 6) | olane(); asm volatile("" : "+v"(t)); return t; }
DI float wave_sum(float v) {
#pragma unroll
    for (int o = 32; o > 0; o >>= 1) v += shx(v, o);
    return v;
}
DI float wave_max(float v) {
#pragma unroll
    for (int o = 32; o > 0; o >>= 1) v = fmaxf(v, shx(v, o));
    return v;
}
DI float sigmoidf_(float x) { return __builtin_amdgcn_rcpf(1.f + __builtin_amdgcn_exp2f(-1.4426950408889634f * x)); }
DI float siluf_(float x) { return x * sigmoidf_(x); }
DI float gelu_tanh(float x) {
    const float u = 0.7978845608028654f * (x + 0.044715f * x * x * x);
    return x * __builtin_amdgcn_rcpf(1.f + __builtin_amdgcn_exp2f(-2.8853900817779268f * u));
}
DI unsigned aload32(const void* p_) { unsigned r; asm volatile("global_load_dword %0, %1, off" : "=v"(r) : "v"(p_) : "memory"); return r; }
DI u32x4 aload128(const void* p_) { u32x4 r; asm volatile("global_load_dwordx4 %0, %1, off" : "=v"(r) : "v"(p_) : "memory"); return r; }
#define PV_NOHOOKS typedef int Aux; DI void top(int, Aux&, const int) const {} DI void mid(Aux&, const int) const {} template <class A_> DI void fix(A_&, bool, const int) const {}
DI void glds16(const void* src, LAS char* dst) {
    __builtin_amdgcn_global_load_lds((const __attribute__((address_space(1))) void*)src, (LAS void*)dst, 16, 0, 0);
}

#define XB_TMO      128
#define XB_XCNT(j)  (256  + 64 * (j))
#define XB_XSUB(j)  (1280 + 64 * (j))
#define XB_XGEN(j)  (2304 + 64 * (j))
#define XB_TOP      3328
#define XB_TOPGEN   3392
#define XCD_BAR_WORDS 3456
#define XB_SPIN_CAP (1u << 18)
__device__ __forceinline__ unsigned xb_ld(unsigned* p)              { return __hip_atomic_load(p, __ATOMIC_RELAXED, __HIP_MEMORY_SCOPE_AGENT); }
__device__ __forceinline__ unsigned xb_add(unsigned* p, unsigned v) { return __hip_atomic_fetch_add(p, v, __ATOMIC_RELAXED, __HIP_MEMORY_SCOPE_AGENT); }
__device__ __forceinline__ unsigned xb_xcc_id() { return (unsigned)__builtin_amdgcn_s_getreg((3 << 11) | 20) & 0xFu; }
#define XB_SPIN(cond, bar) do { unsigned _sp = 0; while (cond) { __builtin_amdgcn_s_sleep(1); \
    if ((++_sp & 255u) == 0u) { if (xb_ld(&(bar)[XB_TMO])) break; if (_sp > XB_SPIN_CAP) { atomicAdd(&(bar)[XB_TMO], 1u); break; } } } } while (0)
struct XcdBarrier { unsigned* bar; unsigned x; volatile LAS unsigned* st; };
__device__ __forceinline__ XcdBarrier xcd_barrier_post(unsigned* bar, volatile LAS unsigned* st, const int wv_) {
    XcdBarrier b; b.bar = bar; b.x = xb_xcc_id(); b.st = st;
    if (otid() == 0) (void)xb_add(&bar[XB_XCNT(b.x)], 1u);
    return b;
}
__device__ __forceinline__ void xcd_barrier_complete(unsigned* bar, unsigned x, unsigned& nloc, unsigned& nx) {
    const unsigned G = gridDim.x * gridDim.y * gridDim.z;
    unsigned sum, cnt, mine, sp = 0u;
    for (;;) {
        sum = 0u; cnt = 0u; mine = 0u;
#pragma unroll
        for (unsigned j = 0; j < 16; ++j) { const unsigned c = xb_ld(&bar[XB_XCNT(j)]); sum += c; cnt += (c > 0u) ? 1u : 0u; mine = (j == x) ? c : mine; }
        if (sum == G) break;
        __builtin_amdgcn_s_sleep(1);
        if ((++sp & 255u) == 0u) { if (xb_ld(&bar[XB_TMO])) break; if (sp > XB_SPIN_CAP) { atomicAdd(&bar[XB_TMO], 1u); break; } }
    }
    nloc = mine > 0u ? mine : 1u; nx = cnt > 0u ? cnt : 1u;
}
__device__ __forceinline__ void xcd_barrier(const XcdBarrier& b, const int wv_) {
    asm volatile("s_waitcnt vmcnt(0)" ::: "memory");
    __syncthreads();
    if (otid() == 0) {
        unsigned* bar = b.bar;
        __builtin_amdgcn_s_waitcnt(0);
        unsigned nloc = b.st[0], nx = b.st[1];
        if (nloc == 0u) { xcd_barrier_complete(bar, b.x, nloc, nx); b.st[0] = nloc; b.st[1] = nx; }
        const unsigned old = xb_add(&bar[XB_XSUB(b.x)], 1u);
        const unsigned gen = old / nloc;
        if (old + 1u == (gen + 1u) * nloc) {
            __builtin_amdgcn_fence(__ATOMIC_RELEASE, "agent");
            asm volatile("s_waitcnt vmcnt(0)" ::: "memory");
            const unsigned og = xb_add(&bar[XB_TOP], 1u);
            const unsigned tg = og / nx;
            if (og + 1u == (tg + 1u) * nx) xb_add(&bar[XB_TOPGEN], 1u);
            else XB_SPIN(xb_ld(&bar[XB_TOPGEN]) == tg, bar);
            __builtin_amdgcn_fence(__ATOMIC_ACQUIRE, "agent");
            xb_add(&bar[XB_XGEN(b.x)], 1u);
            asm volatile("s_waitcnt vmcnt(0)" ::: "memory");
        } else {
            XB_SPIN(xb_ld(&bar[XB_XGEN(b.x)]) == gen, bar);
            __builtin_amdgcn_fence(__ATOMIC_ACQUIRE, "agent");
            asm volatile("s_waitcnt vmcnt(0)" ::: "memory");
        }
    }
    __syncthreads();
}

constexpr int HTB = 128 * 64 * 2;
DI int lds_byte(int r, int c) { const int st = (r >> 4) * 2 + (c >> 5), rr = r & 15, cc = c & 31, ob = rr * 64 + cc * 2; return st * 1024 + (ob ^ (((ob >> 9) & 1) << 5)); }
DI void stage_rc(int b, int& R, int& C) { const int st = b / 1024, sb = b % 1024, swz = sb ^ (((sb >> 9) & 1) << 5); R = (st >> 1) * 16 + swz / 64; C = (st & 1) * 32 + (swz % 64) / 2; }

DI void stage_rc_t(int tz, int i, int& R, int& C) { stage_rc(tz * 16 + i * 8192, R, C); }
struct APlain {
    const char* base; int lda2;
    DI void park(LAS unsigned*) const {} DI void unpark(const LAS unsigned*) {} DI void take_uniform(const APlain&) {}
    DI const char* ptr(int tz, int h, int i, int kt) const { int R, C; stage_rc_t(tz, i, R, C); return base + (unsigned)((h * 128 + R) * lda2 + C * 2 + kt * 128); }
};
struct ASimple {
    const char* base; unsigned off[2][2]; unsigned kstride;
    DI void park(LAS unsigned* q) const { *(LAS u32x4*)q = (u32x4){off[0][0], off[0][1], off[1][0], off[1][1]}; }
    DI void unpark(const LAS unsigned* q) { const u32x4 v = *(const LAS u32x4*)q; off[0][0] = v.x; off[0][1] = v.y; off[1][0] = v.z; off[1][1] = v.w; }
    DI void take_uniform(const ASimple& o) { base = o.base; kstride = o.kstride; }
    DI const char* ptr(int tz, int h, int i, int kt) const { return base + (unsigned)(off[h][i] + (unsigned)kt * kstride); }
};
struct ASeg2 {
    const char* base0; const char* base1; unsigned off0[2][2]; unsigned off1[2][2]; unsigned ks0; int nt0;
    DI void park(LAS unsigned*) const {} DI void unpark(const LAS unsigned*) {} DI void take_uniform(const ASeg2&) {}
    DI const char* ptr(int tz, int h, int i, int kt) const { return kt < nt0 ? base0 + (unsigned)(off0[h][i] + (unsigned)kt * ks0) : base1 + (unsigned)(off1[h][i] + (unsigned)(kt - nt0) * 128u); }
};
DI int perm32(int rho) { const int n = rho >> 4, i = rho & 15; return 8 * (i >> 2) + 4 * n + (i & 3); }
struct BSimple {
    const char* base[2]; int ldb2;
    DI const char* ptr(int tz, int h, int i, int kt) const { int R, C; stage_rc_t(tz, i, R, C); const int Rb = (R & ~31) + perm32(R & 31); return base[h] + (unsigned)(Rb * ldb2 + C * 2 + kt * 128); }
};

struct BSeq16 {
    const char* base; int ldb2;
    DI const char* ptr(int tz, int h, int i, int kt) const { int R, C; stage_rc_t(tz, i, R, C); const int rho = R & 31;
        const int Rb = (R >> 5) * 64 + ((rho & 15) >> 2) * 16 + h * 8 + (rho >> 4) * 4 + (rho & 3); return base + (unsigned)(Rb * ldb2 + C * 2 + kt * 128); }
};

#define WAIT_V(n) asm volatile("s_waitcnt vmcnt(" #n ")" ::: "memory")
#define WAIT_L(n) asm volatile("s_waitcnt lgkmcnt(" #n ")" ::: "memory")
#define BAR_ __builtin_amdgcn_s_barrier()
#define SCHED_ __builtin_amdgcn_sched_barrier(0)

DI void zero_acc(f32x4 (&acc)[2][2][4][2]) {
#pragma unroll
    for (int a = 0; a < 2; ++a)
#pragma unroll
        for (int b = 0; b < 2; ++b)
#pragma unroll
            for (int m = 0; m < 4; ++m)
#pragma unroll
                for (int n = 0; n < 2; ++n) acc[a][b][m][n] = (f32x4){0.f, 0.f, 0.f, 0.f};
}
template <int MODE> struct FragT;
template <> struct FragT<0> {
    i32x4 lo, hi;
    DI void load(const LAS char* p0, const LAS char* p1) { lo = *(const LAS i32x4*)p0; hi = *(const LAS i32x4*)p1; }
    static DI f32x4 mma(const FragT& b, const FragT& a, f32x4 c) {
        c = __builtin_amdgcn_mfma_f32_16x16x32_bf16(__builtin_bit_cast(bf16x8, b.lo), __builtin_bit_cast(bf16x8, a.lo), c, 0, 0, 0);
        return __builtin_amdgcn_mfma_f32_16x16x32_bf16(__builtin_bit_cast(bf16x8, b.hi), __builtin_bit_cast(bf16x8, a.hi), c, 0, 0, 0); }
};
template <> struct FragT<1> {
    i32x4 lo, hi;
    DI void load(const LAS char* p0, const LAS char* p1) { lo = *(const LAS i32x4*)p0; hi = *(const LAS i32x4*)p1; }
    static DI long pk(int x, int y) { return (long)(((unsigned long long)(unsigned)y << 32) | (unsigned)x); }
    static DI f32x4 mma(const FragT& b, const FragT& a, f32x4 c) {
        c = __builtin_amdgcn_mfma_f32_16x16x32_fp8_fp8(pk(b.lo.x, b.lo.y), pk(a.lo.x, a.lo.y), c, 0, 0, 0);
        c = __builtin_amdgcn_mfma_f32_16x16x32_fp8_fp8(pk(b.lo.z, b.lo.w), pk(a.lo.z, a.lo.w), c, 0, 0, 0);
        c = __builtin_amdgcn_mfma_f32_16x16x32_fp8_fp8(pk(b.hi.x, b.hi.y), pk(a.hi.x, a.hi.y), c, 0, 0, 0);
        return __builtin_amdgcn_mfma_f32_16x16x32_fp8_fp8(pk(b.hi.z, b.hi.w), pk(a.hi.z, a.hi.w), c, 0, 0, 0); }
};
template <> struct FragT<2> {
    i32x8 v;
    DI void load(const LAS char* p0, const LAS char* p1) { const i32x4 lo = *(const LAS i32x4*)p0, hi = *(const LAS i32x4*)p1; v = __builtin_shufflevector(lo, hi, 0, 1, 2, 3, 4, 5, 6, 7); }
    static DI f32x4 mma(const FragT& b, const FragT& a, f32x4 c) {
        const int one = 0x7f7f7f7f;
        asm volatile("v_mfma_scale_f32_16x16x128_f8f6f4 %0, %1, %2, %0, %3, %3 op_sel_hi:[0,0,0]" : "+v"(c) : "v"(b.v), "v"(a.v), "v"(one));
        return c; }
};
template <class PV>
DI void gemm_stream(LAS char* shm, const PV& pv, const int wv_) {
    typedef typename PV::AS AS; typedef typename PV::BS BS;
    constexpr int nt = PV::NT;
    int u = pv.first();
    if (u < 0) return;
    const int tz = otid();
    const int wr = wv_ >> 2, wc = wv_ & 3, lane = tz & 63, fr = lane & 15, fq = lane >> 4;
    const int aoff = lds_byte(wr * 64 + fr, fq * 8), boff = lds_byte(wc * 32 + fr, fq * 8);
    const unsigned ldsw = (unsigned)wv_ * 1024u;
    f32x4 acc[2][2][4][2]; zero_acc(acc);
    typedef FragT<PV::FP8> Frag;
    Frag At[4], B0[2], B1[2];
    AS ca, na; BS cb, nb;
    pv.src(u, ca, cb, wv_); pv.fix(ca, true, wv_);
    constexpr bool F8 = PV::FP8 != 0;
    LAS unsigned* park = (LAS unsigned*)(shm + 131072) + tz * 4;
    const int aoff0 = aoff, aoff1 = aoff + 1024;
    const int boff0 = boff, boff1 = boff + 1024;
#define SA_(b, h) (((b) * 2 + (h)) * HTB)
#define SB_(b, h) ((4 + (b) * 2 + (h)) * HTB)
#define STG_(bufoff, S, h, kt) do { _Pragma("unroll") for (int i_ = 0; i_ < 2; ++i_) glds16((S).ptr(tz, h, i_, kt), shm + (bufoff) + ldsw + i_ * 8192); } while (0)
#define LDA_(dst, b, h) do { _Pragma("unroll") for (int m = 0; m < 4; ++m) dst[m].load(shm + SA_(b, h) + aoff0 + m * 2048, shm + SA_(b, h) + aoff1 + m * 2048); } while (0)
#define LDB_(dst, b, h) do { _Pragma("unroll") for (int n = 0; n < 2; ++n) dst[n].load(shm + SB_(b, h) + boff0 + n * 2048, shm + SB_(b, h) + boff1 + n * 2048); } while (0)
#define MMAS_(ai, bj, A_, B_, STGSTMT) do { __builtin_amdgcn_s_setprio(1); \
        acc[ai][bj][0][0] = Frag::mma(B_[0], A_[0], acc[ai][bj][0][0]); acc[ai][bj][0][1] = Frag::mma(B_[1], A_[0], acc[ai][bj][0][1]); \
        STGSTMT; \
        _Pragma("unroll") for (int m = 1; m < 4; ++m) _Pragma("unroll") for (int n = 0; n < 2; ++n) { \
            acc[ai][bj][m][n] = Frag::mma(B_[n], A_[m], acc[ai][bj][m][n]); } \
        __builtin_amdgcn_s_setprio(0); } while (0)
    STG_(SB_(0, 0), cb, 0, 0); STG_(SA_(0, 0), ca, 0, 0); STG_(SB_(0, 1), cb, 1, 0); STG_(SA_(0, 1), ca, 1, 0);
    if (wr == 1) BAR_;
    WAIT_V(4); BAR_;
    STG_(SB_(1, 0), cb, 0, 1); STG_(SA_(1, 0), ca, 0, 1); STG_(SB_(1, 1), cb, 1, 1);
    WAIT_V(6); BAR_;
#define ZQ_(ai, bj) do { _Pragma("unroll") for (int m_ = 0; m_ < 4; ++m_) _Pragma("unroll") for (int n_ = 0; n_ < 2; ++n_) acc[ai][bj][m_][n_] = (f32x4){0.f, 0.f, 0.f, 0.f}; } while (0)
    int un = -1; bool has_next = false;
    na = ca; nb = cb;
    for (;;) {
        typename PV::Aux aux;
#pragma clang loop unroll(disable)
        for (int t = 0; t < nt; t += 2) {
            const bool last = (t == nt - 2);
            if (last && has_next) pv.fix(na, false, wv_);
            AS a2 = last ? na : ca; const BS b2 = last ? nb : cb; const int k2 = last ? 0 : t + 2;
            LDB_(B0, 0, 0); SCHED_; LDA_(At, 0, 0);
            if (t == 0) ZQ_(0, 0);
            WAIT_L(8); BAR_; WAIT_L(0); MMAS_(0, 0, At, B0, STG_(SA_(1, 1), ca, 1, t + 1)); BAR_; SCHED_;
            LDB_(B1, 0, 1);
            if (t == 0) { ZQ_(0, 1); pv.top(u, aux, wv_); }
            BAR_; WAIT_L(0); MMAS_(0, 1, At, B1, STG_(SB_(0, 0), b2, 0, k2)); BAR_;
            LDA_(At, 0, 1);
            if (t == 0) ZQ_(1, 0);
            BAR_; WAIT_L(0); MMAS_(1, 0, At, B0, STG_(SA_(0, 0), a2, 0, k2)); BAR_; SCHED_;
            if (t == 0) ZQ_(1, 1);
            WAIT_V(4); BAR_; if (t == 0) pv.mid(aux, wv_); MMAS_(1, 1, At, B1, STG_(SB_(0, 1), b2, 1, k2)); BAR_;
            LDB_(B0, 1, 0); SCHED_; LDA_(At, 1, 0);
            WAIT_L(8); BAR_; WAIT_L(0); MMAS_(0, 0, At, B0, STG_(SA_(0, 1), a2, 1, k2)); BAR_; SCHED_;
            LDB_(B1, 1, 1);
            BAR_; WAIT_L(0); MMAS_(0, 1, At, B1, STG_(SB_(1, 0), b2, 0, k2 + 1)); BAR_;
            LDA_(At, 1, 1);
            BAR_; WAIT_L(0); MMAS_(1, 0, At, B0, STG_(SA_(1, 0), a2, 0, k2 + 1)); BAR_; SCHED_;
            WAIT_V(4);
            if (t == 0) { un = pv.next(u); has_next = un >= 0; if (has_next) pv.src(un, na, nb, wv_); else { na = ca; nb = cb; } }
            BAR_; MMAS_(1, 1, At, B1, STG_(SB_(1, 1), b2, 1, k2 + 1)); BAR_;
        }
        if (PV::FP8 == 2) asm volatile("s_nop 15\n\ts_nop 15" ::: "memory");
        pv.epi(acc, u, wv_);
        if (!has_next) break;
        u = un; ca = na; cb = nb;
    }
#undef ZQ_
    WAIT_V(0);
    if (wr == 0) BAR_;
    BAR_;
#undef SA_
#undef SB_
#undef STG_
#undef LDA_
#undef LDB_
#undef MMAS_
}
DI int lin_first(int shift, int count) { const int G = gridDim.x; const int u = (int)((blockIdx.x + G - (shift % G)) % G); return u < count ? u : -1; }
DI int lin_next(int u, int count) { const int un = u + (int)gridDim.x; return un < count ? un : -1; }
template <int MG, int NTL> struct XcdDeal {
    int MT;
    DI bool decode(int J, int& mt, int& nt) const { const int x = blockIdx.x & 7; const int grp = (J / (MG * NTL)) * 8 + x, w = J % (MG * NTL); mt = grp * MG + w / NTL; nt = w % NTL; return mt < MT; }
    DI int jmax() const { return ((MT + 8 * MG - 1) / (8 * MG)) * (MG * NTL); }
    DI int first() const { int J = blockIdx.x >> 3; const int per = gridDim.x >> 3, jm = jmax(); int mt, nt;
        while (J < jm && !decode(J, mt, nt)) J += per;
        return J < jm ? J : -1; }
    DI int next(int J) const { const int per = gridDim.x >> 3, jm = jmax(); int mt, nt; J += per;
        while (J < jm && !decode(J, mt, nt)) J += per;
        return J < jm ? J : -1; }
};
DI int first_unit(int shift) { const int G = gridDim.x; return (int)((blockIdx.x + G - (shift % G)) % G); }

DI void stage_coords(int (&R)[2], int (&C)[2], const int wv_) {
    const int t_ = otid();
#pragma unroll
    for (int i = 0; i < 2; ++i) stage_rc(t_ * 16 + i * 8192, R[i], C[i]);
}
DI APlain make_a_plain(const bf16_t* A, size_t row0, int lda, int col0) {
    APlain a; a.base = (const char*)(A + row0 * (size_t)lda + col0); a.lda2 = lda * 2; return a;
}
DI BSimple make_b(const bf16_t* Bt0, const bf16_t* Bt1, int ldb) {
    BSimple b; b.base[0] = (const char*)Bt0; b.base[1] = (const char*)Bt1; b.ldb2 = ldb * 2; return b;
}
#define EPI_FOR(acc, ...) do { const int _tz = otid(), _w = _tz >> 6, _l = _tz & 63, _wr = _w >> 2, _wc = _w & 3, _fr = _l & 15, _fq = _l >> 4; \
    _Pragma("unroll") for (int ai = 0; ai < 2; ++ai) _Pragma("unroll") for (int m = 0; m < 4; ++m) { const int lr = ai * 128 + _wr * 64 + m * 16 + _fr; \
    _Pragma("unroll") for (int bj = 0; bj < 2; ++bj) _Pragma("unroll") for (int n = 0; n < 2; ++n) { const int lc = bj * 128 + _wc * 32 + n * 16 + _fq * 4; const f32x4 v = acc[ai][bj][m][n]; __VA_ARGS__ } } } while (0)

DI void store_bf16x4(bf16_t* p, float a, float b, float c, float d) { u32x2 v; v.x = pk_bf16(a, b); v.y = pk_bf16(c, d); *(u32x2*)p = v; }
DI void store_bf16x8(bf16_t* p, const f32x4 a, const f32x4 b) { u32x4 v; v.x = pk_bf16(a[0], a[1]); v.y = pk_bf16(a[2], a[3]); v.z = pk_bf16(b[0], b[1]); v.w = pk_bf16(b[2], b[3]); *(u32x4*)p = v; }
#define EPI_FOR8(acc, ...) do { const int _tz = otid(), _w = _tz >> 6, _l = _tz & 63, _wr = _w >> 2, _wc = _w & 3, _fr = _l & 15, _fq = _l >> 4; \
    _Pragma("unroll") for (int ai = 0; ai < 2; ++ai) _Pragma("unroll") for (int m = 0; m < 4; ++m) { const int lr = ai * 128 + _wr * 64 + m * 16 + _fr; \
    _Pragma("unroll") for (int bj = 0; bj < 2; ++bj) { const int lc = bj * 128 + _wc * 32 + _fq * 8; const f32x4 v0 = acc[ai][bj][m][0], v1 = acc[ai][bj][m][1]; __VA_ARGS__ } } } while (0)

DI int mod_row(int r) { return r < TX ? (r >> 11) : 32; }
DI int crow_tok(int cr) { const int b = cr / NCH, j = cr - b * NCH; return j < 4 ? TX + b * CTXL + j * 64 : b * SEQ + (j - 4) * 64; }

DI void cvt_tile(LAS char* wl  , const float* src, int ld_src, int kvalid, int nvalid, const float* scale, bf16_t* dst, int ld_dst, const int wv_) {
    const int lane = otid() & 63;
    const int lr = lane >> 4, lc = (lane & 15) * 4;
    f32x4 v[16];
#pragma unroll
    for (int it = 0; it < 16; ++it) {
        const int k = it * 4 + lr;
        v[it] = (f32x4){0.f, 0.f, 0.f, 0.f};
        if (src != nullptr && k < kvalid && lc < nvalid) { v[it] = *(const f32x4*)(src + (size_t)k * ld_src + lc); if (scale) { const float s = scale[k]; v[it] *= s; } }
    }
#pragma unroll
    for (int it = 0; it < 16; ++it) {
        const int k = it * 4 + lr;
#pragma unroll
        for (int j = 0; j < 4; ++j) *(LAS bf16_t*)(wl + (lc + j) * 144 + k * 2) = f2bf(v[it][j]);
    }
    asm volatile("s_waitcnt lgkmcnt(0)" ::: "memory");
#pragma unroll
    for (int i = 0; i < 8; ++i) {
        const int q = i * 64 + lane, n = q >> 3, c = q & 7;
        const u32x4 w = *(const LAS u32x4*)(wl + n * 144 + c * 16);
        *(u32x4*)(dst + (size_t)n * ld_dst + c * 8) = w;
    }
    asm volatile("s_waitcnt lgkmcnt(0)" ::: "memory");
}
DI void cvt_tile8(LAS char* wl  , const float* src, int ld_src, unsigned char* dst, int ld_dst, const int wv_) {
    const int lane = otid() & 63;
    const int lr = lane >> 4, lc = (lane & 15) * 4;
    f32x4 v[16];
#pragma unroll
    for (int it = 0; it < 16; ++it) v[it] = *(const f32x4*)(src + (size_t)(it * 4 + lr) * ld_src + lc);
#pragma unroll
    for (int it = 0; it < 16; ++it) {
        const int k = it * 4 + lr;
#pragma unroll
        for (int j = 0; j < 4; ++j) *(LAS unsigned char*)(wl + (lc + j) * 80 + k) = (unsigned char)f2fp8(v[it][j] * 256.f);
    }
    asm volatile("s_waitcnt lgkmcnt(0)" ::: "memory");
#pragma unroll
    for (int i = 0; i < 4; ++i) {
        const int q = i * 64 + lane, n = q >> 2, c = q & 3;
        const u32x4 w = *(const LAS u32x4*)(wl + n * 80 + c * 16);
        *(u32x4*)(dst + (size_t)n * ld_dst + c * 16) = w;
    }
    asm volatile("s_waitcnt lgkmcnt(0)" ::: "memory");
}
constexpr int CVT_SMALL_TILES = 768 + 512 + 32 + 32 + 64 + 64 + 32;
constexpr int CVT_EXP_TILES = 32 * (32 * 16 + 16 * 16);
DI void cvt_small(const Params& p, LAS char* wl, int t, const int wv_) {
    char* ws = p.ws;
    if (t < 768) { const int l = t / 384, r = t % 384, nt = r / 16, kt = r % 16;
        cvt_tile(wl, p.w_mix_in + (size_t)l * 1024 * N_IN + (size_t)kt * 64 * N_IN + nt * 64, N_IN, 64, N_IN - nt * 64, nullptr,
                 (bf16_t*)(ws + WS_WMI) + ((size_t)l * 1536 + nt * 64) * 1024 + kt * 64, 1024, wv_); return; }
    t -= 768;
    if (t < 512) { const int l = t / 256, r = t % 256, nt = r / 16, kt = r % 16;
        cvt_tile(wl, p.w_mix_out + (size_t)l * 1024 * 1024 + (size_t)kt * 64 * 1024 + nt * 64, 1024, 64, 64, nullptr,
                 (bf16_t*)(ws + WS_WMO) + ((size_t)l * 1024 + nt * 64) * 1024 + kt * 64, 1024, wv_); return; }
    t -= 512;
    if (t < 32) { const int l = t / 16, r = t % 16, nt = r / 4, kt = r % 4;
        cvt_tile(wl, p.conv_pw + (size_t)l * 65536 + (size_t)kt * 64 * 256 + nt * 64, 256, 64, 64, nullptr,
                 (bf16_t*)(ws + WS_WPW) + ((size_t)l * 256 + nt * 64) * 256 + kt * 64, 256, wv_); return; }
    t -= 32;
    if (t < 32) { const int l = t / 16, r = t % 16, nt = r / 4, kt = r % 4;
        cvt_tile(wl, p.ssm_glu_w + (size_t)l * 65536 + (size_t)kt * 64 * 256 + nt * 64, 256, 64, 64, nullptr,
                 (bf16_t*)(ws + WS_WGLU) + ((size_t)l * 256 + nt * 64) * 256 + kt * 64, 256, wv_); return; }
    t -= 32;
    if (t < 64) { const int l = t / 32, r = t % 32, nt = r / 4, kt = r % 4;
        const bool any = (kt < 3) && (nt < 6);
        cvt_tile(wl, any ? p.mla_wq_b + (size_t)l * 192 * 384 + (size_t)kt * 64 * 384 + nt * 64 : nullptr, 384, 64, 64, p.mla_q_a_g + l * 192 + kt * 64,
                 (bf16_t*)(ws + WS_WQ) + ((size_t)l * 512 + nt * 64) * 256 + kt * 64, 256, wv_); return; }
    t -= 64;
    if (t < 64) { const int l = t / 32, r = t % 32, nt = r / 4, kt = r % 4;
        const bool any = (kt < 2);
        cvt_tile(wl, any ? p.mla_wkv_b + (size_t)l * 128 * 512 + (size_t)kt * 64 * 512 + nt * 64 : nullptr, 512, 64, 64, p.mla_kv_a_g + l * 128 + kt * 64,
                 (bf16_t*)(ws + WS_WKV) + ((size_t)l * 512 + nt * 64) * 256 + kt * 64, 256, wv_); return; }
    t -= 64;
    { const int l = t / 16, r = t % 16, nt = r / 4, kt = r % 4;
        cvt_tile(wl, nt == kt ? p.pool_w + ((size_t)l * 4 + nt) * 4096 : nullptr, 64, 64, 64, nullptr,
                 (bf16_t*)(ws + WS_WPOOL) + ((size_t)l * 256 + nt * 64) * 256 + kt * 64, 256, wv_); }
}
DI void cvt_expert(const Params& p, LAS char* wl, int l, int t, const int wv_) {
    char* ws = p.ws;
    const int e = t / 768, r = t % 768;
    if (r < 512) { const int nt = r / 16, kt = r % 16;
        cvt_tile8(wl, p.exp_w_in + ((size_t)(l * NE + e) * 1024 + kt * 64) * 2048 + nt * 64, 2048,
                  (unsigned char*)(ws + WS_W1) + ((size_t)(l * NE + e) * 2048 + nt * 64) * 1024 + kt * 64, 1024, wv_);
    } else { const int q = r - 512, nt = q / 16, kt = q % 16;
        cvt_tile8(wl, p.exp_w_out + ((size_t)(l * NE + e) * 1024 + kt * 64) * 1024 + nt * 64, 1024,
                  (unsigned char*)(ws + WS_W2) + ((size_t)(l * NE + e) * 1024 + nt * 64) * 1024 + kt * 64, 1024, wv_);
    }
}

DI void ada_unit(const Params& p, LAS char* shm, int u, const int wv_) {
    const int tid = otid();
    const int l = u / 48, jc = u % 48;
    LAS float* sc = (LAS float*)shm;
    for (int i = tid; i < 33 * 1024; i += 512) { const int r = i >> 10, k = i & 1023; const float v = r < 32 ? p.c[r * 1024 + k] : p.c_ctx[k]; sc[i] = siluf_(v); }
    __syncthreads();
    const int col = tid & 127, kq = tid >> 7;
    float acc[33];
#pragma unroll
    for (int r = 0; r < 33; ++r) acc[r] = 0.f;
    const float* wp = p.ada_w + ((size_t)l * 1024 + kq * 256) * 6144 + jc * 128 + col;
    for (int k4 = 0; k4 < 256; k4 += 4) {
        float w[4];
#pragma unroll
        for (int i = 0; i < 4; ++i) w[i] = wp[(size_t)(k4 + i) * 6144];
#pragma unroll
        for (int r = 0; r < 33; ++r) { const f32x4 s = *(const LAS f32x4*)(sc + r * 1024 + kq * 256 + k4); acc[r] += s[0] * w[0] + s[1] * w[1] + s[2] * w[2] + s[3] * w[3]; }
    }
    __syncthreads();
    LAS float* red = (LAS float*)shm;
#pragma unroll
    for (int r = 0; r < 33; ++r) red[(kq * 33 + r) * 128 + col] = acc[r];
    __syncthreads();
    for (int i = tid; i < 33 * 128; i += 512) { const int r = i >> 7, cc = i & 127;
        const float s = red[(0 * 33 + r) * 128 + cc] + red[(1 * 33 + r) * 128 + cc] + red[(2 * 33 + r) * 128 + cc] + red[(3 * 33 + r) * 128 + cc];
        ((float*)(p.ws + WS_MOD))[((size_t)l * 33 + r) * 6144 + jc * 128 + cc] = s + p.ada_b[l * 6144 + jc * 128 + cc]; }
    __syncthreads();
}

DI void s5_load_bc(const Params& p, LAS float* bb, LAS float* cc, int l, int dir, int g, int tid) {
    const int pbase = ((l * 2 + dir) * 16 + g) * 64;
    const double dt = exp((double)p.ssm_log_dt[(l * 2 + dir) * 16 + g]);
    for (int i = tid; i < 64 * 16; i += 512) { const int q = i >> 4, ci = i & 15;
        const double are = fmin((double)p.ssm_a_re[pbase + q], -1e-4), aim = (double)p.ssm_a_im[pbase + q];
        const double mg = exp(are * dt), abr = mg * cos(aim * dt), abi = mg * sin(aim * dt), den = are * are + aim * aim;
        const double fre = ((abr - 1.0) * are + abi * aim) / den, fim = (abi * are - (abr - 1.0) * aim) / den;
        const double br = (double)p.ssm_b_re[(size_t)(pbase + q) * 16 + ci], bi = (double)p.ssm_b_im[(size_t)(pbase + q) * 16 + ci];
        bb[i * 2] = (float)(fre * br - fim * bi); bb[i * 2 + 1] = (float)(fre * bi + fim * br); }
    for (int i = tid; i < 16 * 64; i += 512) { const int co = i >> 6, q = i & 63;
        const size_t ix = ((size_t)((l * 2 + dir) * 16 + g) * 16 + co) * 64 + q;
        cc[i * 2] = p.ssm_c_re[ix]; cc[i * 2 + 1] = p.ssm_c_im[ix]; }
}
DI void s5pre_unit(const Params& p, LAS char* shm, int u, const int wv_) {
    const int tid = otid();
    const int l = u >> 5, g = (u >> 1) & 15, dir = u & 1;
    LAS float* pw = (LAS float*)shm;
    LAS float* bb = pw + 65 * 64 * 2;
    LAS float* cc = bb + 64 * 16 * 2;
    LAS float* kk = cc + 16 * 64 * 2;
    LAS float* k0o = kk + 64 * 256;
    bf16_t* TS = (bf16_t*)(p.ws + WS_TS5) + (size_t)(l * 16 + g) * 1024 * 1280;
    bf16_t* WS = (bf16_t*)(p.ws + WS_WS5) + (size_t)(l * 16 + g) * 256 * 1024;
    const int cocip = tid & 255, co_ = cocip >> 4, ci_ = cocip & 15;
    if (dir == 0) {
        s5_load_bc(p, bb, cc, l, 1, g, tid);
        __syncthreads();
        if (tid < 256) { float s_ = 0.f;
            for (int q = 0; q < 64; ++q) s_ += cc[(co_ * 64 + q) * 2] * bb[(q * 16 + ci_) * 2] - cc[(co_ * 64 + q) * 2 + 1] * bb[(q * 16 + ci_) * 2 + 1];
            k0o[tid] = s_; }
        __syncthreads();
    }
    {
        const int pbase = ((l * 2 + dir) * 16 + g) * 64;
        const double dt = exp((double)p.ssm_log_dt[(l * 2 + dir) * 16 + g]);
        for (int i = tid; i < 65 * 64; i += 512) { const int tau = i >> 6, q = i & 63;
            const double are = fmin((double)p.ssm_a_re[pbase + q], -1e-4), aim = (double)p.ssm_a_im[pbase + q];
            const double mg = exp(are * dt * tau), an = aim * dt * tau;
            pw[i * 2] = (float)(mg * cos(an)); pw[i * 2 + 1] = (float)(mg * sin(an)); }
        s5_load_bc(p, bb, cc, l, dir, g, tid);
        __syncthreads();
        if (tid < 64) { float* a64 = (float*)(p.ws + WS_A64) + (size_t)(((l * 2 + dir) * 16 + g) * 64 + tid) * 2; a64[0] = pw[(64 * 64 + tid) * 2]; a64[1] = pw[(64 * 64 + tid) * 2 + 1]; }
        { float gr[64], gi[64];
#pragma unroll
          for (int q = 0; q < 64; ++q) { const float cr = cc[(co_ * 64 + q) * 2], cim = cc[(co_ * 64 + q) * 2 + 1], br = bb[(q * 16 + ci_) * 2], bi = bb[(q * 16 + ci_) * 2 + 1];
              gr[q] = cr * br - cim * bi; gi[q] = cr * bi + cim * br; }
          for (int tau = (tid >> 8); tau < 64; tau += 2) {
              float s_ = 0.f;
#pragma unroll
              for (int q = 0; q < 64; ++q) s_ += gr[q] * pw[(tau * 64 + q) * 2] - gi[q] * pw[(tau * 64 + q) * 2 + 1];
              kk[tau * 256 + cocip] = s_;
          } }
        for (int i = tid; i < 128 * 512; i += 512) { const int row = i >> 9, kp = (i & 511) * 2, ri = row >> 6, q = row & 63, s_ = kp >> 4, ci = kp & 15;
            const int e = dir == 0 ? 63 - s_ : s_;
            const float pr = pw[(e * 64 + q) * 2], pi = pw[(e * 64 + q) * 2 + 1];
            float o[2];
#pragma unroll
            for (int j = 0; j < 2; ++j) { const float br = bb[(q * 16 + ci + j) * 2], bi = bb[(q * 16 + ci + j) * 2 + 1]; o[j] = ri == 0 ? pr * br - pi * bi : pr * bi + pi * br; }
            *(unsigned*)(WS + (size_t)(dir * 128 + row) * 1024 + kp) = pk_bf16(o[0], o[1]); }
        for (int i = tid; i < 1024 * 64; i += 512) { const int row = i >> 6, kp = (i & 63) * 2, t = row >> 4, co = row & 15, ri = kp >> 6, q = kp & 63;
            const int e = dir == 0 ? t + 1 : 64 - t;
            float o[2];
#pragma unroll
            for (int j = 0; j < 2; ++j) { const float pr = pw[(e * 64 + q + j) * 2], pi = pw[(e * 64 + q + j) * 2 + 1];
                const float cr = cc[(co * 64 + q + j) * 2], cim = cc[(co * 64 + q + j) * 2 + 1];
                o[j] = ri == 0 ? (cr * pr - cim * pi) : -(cr * pi + cim * pr); }
            *(unsigned*)(TS + (size_t)row * 1280 + 1024 + dir * 128 + kp) = pk_bf16(o[0], o[1]); }
        __syncthreads();
        for (int rr = tid; rr < 1024; rr += 512) { const int t = rr >> 4, co = rr & 15;
            const float dco = p.ssm_d[l * 256 + g * 16 + co];
            bf16_t* rowp = TS + (size_t)rr * 1280;
            const int s_lo = dir == 0 ? 0 : t + 1, s_hi = dir == 0 ? t : 63;
            for (int s_ = s_lo; s_ <= s_hi; ++s_) { const int tau = dir == 0 ? t - s_ : s_ - t;
                unsigned w[8];
#pragma unroll
                for (int j = 0; j < 8; ++j) { float a = kk[tau * 256 + co * 16 + 2 * j], b2 = kk[tau * 256 + co * 16 + 2 * j + 1];
                    if (s_ == t) { a += k0o[co * 16 + 2 * j]; b2 += k0o[co * 16 + 2 * j + 1]; if (2 * j == co) a += dco; if (2 * j + 1 == co) b2 += dco; }
                    w[j] = pk_bf16(a, b2); }
                *(u32x4*)(rowp + s_ * 16) = (u32x4){w[0], w[1], w[2], w[3]}; *(u32x4*)(rowp + s_ * 16 + 8) = (u32x4){w[4], w[5], w[6], w[7]}; }
        }
        __syncthreads();
    }
}

DI void phase_prologue(const Params& p, LAS char* shm, const int wv_) {
    const int tid = otid();
    __syncthreads();
    if (blockIdx.x == 0 && tid < 64) ((int*)(p.ws + WS_CNT))[tid] = 0;
    const int n_cvt = (CVT_SMALL_TILES + 2 * CVT_EXP_TILES + 7) / 8;
    const int n_units = 64 + 96 + n_cvt;
    for (int u = blockIdx.x; u < n_units; u += gridDim.x) {
        if (u < 64) s5pre_unit(p, shm, u, wv_);
        else if (u < 160) ada_unit(p, shm, u - 64, wv_);
        else {
            const int t = (u - 160) * 8 + (tid >> 6);
            LAS char* wl = shm + (tid >> 6) * (64 * 144);
            if (t < CVT_SMALL_TILES) cvt_small(p, wl, t, wv_);
            else if (t < CVT_SMALL_TILES + 2 * CVT_EXP_TILES) { const int te = t - CVT_SMALL_TILES; cvt_expert(p, wl, te / CVT_EXP_TILES, te % CVT_EXP_TILES, wv_); }
        }
    }
}

DI void norm_mod_store(const float (&v)[16], const float* g, const float* modrow  , bf16_t* hrow, const int wv_) {
    const int lane = otid() & 63;
    float ss = 0.f;
#pragma unroll
    for (int i = 0; i < 16; ++i) ss += v[i] * v[i];
    ss = wave_sum(ss);
    const float rn = rsqrtf(ss * (1.f / 1024.f) + EPS);
#pragma unroll
    for (int j = 0; j < 4; ++j) {
        const int col = j * 256 + lane * 4;
        const f32x4 gg = *(const f32x4*)(g + col), sh = *(const f32x4*)(modrow + col), sc = *(const f32x4*)(modrow + 1024 + col);
        float o[4];
#pragma unroll
        for (int i = 0; i < 4; ++i) o[i] = v[j * 4 + i] * rn * gg[i] * (1.f + sc[i]) + sh[i];
        store_bf16x4(hrow + col, o[0], o[1], o[2], o[3]);
    }
}
DI void phase_norm1_l0(const Params& p, const int wv_) {
    const int tid_ = otid(); const int wid = tid_ >> 6, lane = tid_ & 63;
    const float* MOD = (const float*)(p.ws + WS_MOD);
    bf16_t* H = (bf16_t*)(p.ws + WS_H);
    for (int r = blockIdx.x * 8 + wid; r < TT; r += gridDim.x * 8) {
        const float* src = r < TX ? p.x + (size_t)r * 1024 : p.ctx + (size_t)(r - TX) * 1024;
        float v[16];
#pragma unroll
        for (int j = 0; j < 4; ++j) { const f32x4 t = *(const f32x4*)(src + j * 256 + lane * 4); v[j * 4] = t[0]; v[j * 4 + 1] = t[1]; v[j * 4 + 2] = t[2]; v[j * 4 + 3] = t[3]; }
        norm_mod_store(v, p.norm1_g, MOD + (size_t)(0 * 33 + mod_row(r)) * 6144, H + (size_t)r * 1024, wv_);
    }
}

struct PvInproj {
    const Params& p; int l;
    PV_NOHOOKS
    static constexpr int NT = 16; static constexpr int FP8 = 0; static constexpr bool PARK = false; typedef APlain AS; typedef BSimple BS;
    XcdDeal<4, 6> deal;
    DI int first() const { return deal.first(); }
    DI int next(int u) const { return deal.next(u); }
    DI void src(int u, AS& a, BS& b, const int wv_) const {
        int mt, nt; deal.decode(u, mt, nt);
        const bf16_t* W = (const bf16_t*)(p.ws + WS_WMI) + (size_t)l * 1536 * 1024;
        a = make_a_plain((const bf16_t*)(p.ws + WS_H), (size_t)mt * 256, 1024, 0);
        b = nt < 2 ? make_b(W + (size_t)(nt * 128) * 1024, W + (size_t)(256 + nt * 128) * 1024, 1024)
                   : make_b(W + (size_t)(nt * 256) * 1024, W + (size_t)(nt * 256 + 128) * 1024, 1024);
    }
    DI void epi(f32x4 (&acc)[2][2][4][2], int u, const int wv_) const {
        int mt, nt; deal.decode(u, mt, nt);
        bf16_t* P = (bf16_t*)(p.ws + WS_P);
        if (nt < 2) {
            const int _tz = otid(), _w = _tz >> 6, _l = _tz & 63, _wr = _w >> 2, _wc = _w & 3, _fr = _l & 15, _fq = _l >> 4;
#pragma unroll
            for (int ai = 0; ai < 2; ++ai)
#pragma unroll
                for (int m = 0; m < 4; ++m) { const int lr = ai * 128 + _wr * 64 + m * 16 + _fr; const int lc = _wc * 32 + _fq * 8;
                    f32x4 o0, o1;
#pragma unroll
                    for (int r = 0; r < 4; ++r) { o0[r] = acc[ai][0][m][0][r] * sigmoidf_(acc[ai][1][m][0][r]); o1[r] = acc[ai][0][m][1][r] * sigmoidf_(acc[ai][1][m][1][r]); }
                    store_bf16x8(P + (size_t)(mt * 256 + lr) * NINP + nt * 128 + lc, o0, o1); }
        } else {
            EPI_FOR8(acc, { store_bf16x8(P + (size_t)(mt * 256 + lr) * NINP + nt * 256 + lc, v0, v1); });
        }
    }
};
DI void phase_inproj(const Params& p, LAS char* shm, int l, const int wv_) {
    PvInproj pv{p, l, {TT / 256}};
    gemm_stream(shm, pv, wv_);
}

template <int N> DI void wave_sum_n(float (&v)[N]) {
    const int l4 = olane();
#pragma unroll
    for (int o = 32; o > 0; o >>= 1) {
        float t_[N];
#pragma unroll
        for (int i = 0; i < N; ++i) t_[i] = __int_as_float(__builtin_amdgcn_ds_bpermute((l4 ^ o) << 2, __float_as_int(v[i])));
#pragma unroll
        for (int i = 0; i < N; ++i) v[i] += t_[i];
    }
}
template <int WIN, bool EDGE>
DI void pool_run(const LAS bf16_t* pin  , bf16_t* AP, int row0, int ts0, int L, int c, int half) {
    for (int blk = 0; blk < 2; ++blk) {
        const int t0 = half * 32 + blk * 16;
        float in[16 + WIN - 1];
#pragma unroll
        for (int i = 0; i < 16 + WIN - 1; ++i) in[i] = bf2f(pin[(t0 + i - WIN / 2 + 8) * 256 + c]);
        float sum = 0.f;
#pragma unroll
        for (int j = 0; j < WIN; ++j) sum += in[j];
#pragma unroll
        for (int o = 0; o < 16; ++o) {
            float inv = 1.f / (float)WIN;
            if (EDGE) { const int ts = ts0 + t0 + o; const int lo = max(ts - WIN / 2, 0), hi = min(ts + WIN - 1 - WIN / 2, L - 1); inv = 1.f / (float)(hi - lo + 1); }
            AP[(size_t)(row0 + t0 + o) * 256 + c] = f2bf(sum * inv - in[o + WIN / 2]);
            if (o < 15) sum += in[o + WIN] - in[o];
        }
    }
}
template <bool EDGE>
DI void pre_unit_t(const Params& p, LAS char* shm, int l, int row0, int ts0, int L, const float (&w)[31], const float bias, const int wv_) {
    const int tid = otid();
    const bf16_t* P = (const bf16_t*)(p.ws + WS_P);
    const int c = tid & 255, half = tid >> 8;
    LAS bf16_t* cin = (LAS bf16_t*)shm;
    LAS float* cv = (LAS float*)(shm + 49152);
    u32x4 creg[6], preg[5];
#pragma unroll
    for (int it = 0; it < 6; ++it) { const int q = it * 512 + tid, row = q >> 5, part = q & 31; const int ts = ts0 - 15 + row;
        creg[it] = (u32x4){0u, 0u, 0u, 0u};
        if (q < 94 * 32 && (!EDGE || (ts >= 0 && ts < L))) creg[it] = *(const u32x4*)(P + (size_t)(row0 - 15 + row) * NINP + part * 8); }
#pragma unroll
    for (int it = 0; it < 5; ++it) { const int q = it * 512 + tid, row = q >> 5, part = q & 31; const int ts = ts0 - 8 + row;
        preg[it] = (u32x4){0u, 0u, 0u, 0u};
        if (!EDGE || (ts >= 0 && ts < L)) preg[it] = *(const u32x4*)(P + (size_t)(row0 - 8 + row) * NINP + OFF_POOL + part * 8); }
#pragma unroll
    for (int it = 0; it < 6; ++it) { const int q = it * 512 + tid; if (q < 94 * 32) *(LAS u32x4*)(cin + q * 8) = creg[it]; }
    __syncthreads();
    {
        const int t0 = half * 32;
        float in[62];
#pragma unroll
        for (int i = 0; i < 62; ++i) in[i] = bf2f(cin[(t0 + i) * 256 + c]);
#pragma unroll
        for (int o = 0; o < 32; ++o) { float s_ = bias;
#pragma unroll
            for (int j = 0; j < 31; ++j) s_ += w[j] * in[o + j];
            cv[(t0 + o) * 257 + c] = s_; }
    }
    __syncthreads();
#pragma unroll
    for (int it = 0; it < 5; ++it) *(LAS u32x4*)(cin + (it * 512 + tid) * 8) = preg[it];
    {
        const int wid = tid >> 6, lane = tid & 63;
        bf16_t* AC = (bf16_t*)(p.ws + WS_ACONV);
        float lg[4], lb[4];
#pragma unroll
        for (int j = 0; j < 4; ++j) { lg[j] = p.conv_ln_g[l * 256 + lane + 64 * j]; lb[j] = p.conv_ln_b[l * 256 + lane + 64 * j]; }
        float x[8][4], s8[8];
#pragma unroll
        for (int i = 0; i < 8; ++i) { s8[i] = 0.f;
#pragma unroll
            for (int j = 0; j < 4; ++j) { x[i][j] = cv[(wid * 8 + i) * 257 + lane + 64 * j]; s8[i] += x[i][j]; } }
        wave_sum_n<8>(s8);
#pragma unroll
        for (int i = 0; i < 8; ++i) { const float mu = s8[i] * (1.f / 256.f); s8[i] = 0.f;
#pragma unroll
            for (int j = 0; j < 4; ++j) { x[i][j] -= mu; s8[i] += x[i][j] * x[i][j]; } }
        wave_sum_n<8>(s8);
#pragma unroll
        for (int i = 0; i < 8; ++i) { const float rs = rsqrtf(s8[i] * (1.f / 256.f) + EPS);
#pragma unroll
            for (int j = 0; j < 4; ++j) { const float y = x[i][j] * rs * lg[j] + lb[j]; AC[(size_t)(row0 + wid * 8 + i) * 256 + lane + 64 * j] = f2bf(siluf_(y)); } }
    }
    __syncthreads();
    {
        bf16_t* AP = (bf16_t*)(p.ws + WS_APOOL);
        const int g = __builtin_amdgcn_readfirstlane(c >> 6);
        if (g == 0) pool_run<2, EDGE>(cin, AP, row0, ts0, L, c, half);
        else if (g == 1) pool_run<4, EDGE>(cin, AP, row0, ts0, L, c, half);
        else if (g == 2) pool_run<8, EDGE>(cin, AP, row0, ts0, L, c, half);
        else pool_run<16, EDGE>(cin, AP, row0, ts0, L, c, half);
    }
    __syncthreads();
}
DI void pre_unit(const Params& p, LAS char* shm, int l, int tile, const float (&w)[31], const float bias, const int wv_) {
    int row0, ts0, L;
    if (tile < 1024) { row0 = tile * 64; ts0 = row0 & 2047; L = SEQ; } else { row0 = TX + (tile - 1024) * 64; ts0 = (row0 - TX) & 255; L = CTXL; }
    if (ts0 >= 16 && ts0 + 64 + 16 <= L) pre_unit_t<false>(p, shm, l, row0, ts0, L, w, bias, wv_);
    else pre_unit_t<true>(p, shm, l, row0, ts0, L, w, bias, wv_);
}
struct PvS5State {
    const Params& p; int l;
    PV_NOHOOKS
    static constexpr int NT = 16; static constexpr int FP8 = 0; static constexpr bool PARK = false; typedef ASimple AS; typedef BSimple BS;
    DI int first() const { return lin_first(0, 80); }
    DI int next(int u) const { return lin_next(u, 80); }
    DI void src(int u, AS& as, BS& bs, const int wv_) const {
        const int g = u / 5, mt = u % 5;
        int R[2], C[2]; stage_coords(R, C, wv_);
        as.base = (const char*)(p.ws + WS_P); as.kstride = 4 * NINP * 2;
#pragma unroll
        for (int h = 0; h < 2; ++h)
#pragma unroll
            for (int i = 0; i < 2; ++i) { const int cr = min(mt * 256 + h * 128 + R[i], NCROW - 1);
                as.off[h][i] = (unsigned)(((size_t)(crow_tok(cr) + (C[i] >> 4)) * NINP + OFF_SSM + g * 16 + (C[i] & 15)) * 2); }
        const bf16_t* W = (const bf16_t*)(p.ws + WS_WS5) + (size_t)(l * 16 + g) * 256 * 1024;
        bs = make_b(W, W + (size_t)128 * 1024, 1024);
    }
    DI void epi(f32x4 (&acc)[2][2][4][2], int u, const int wv_) const {
        const int g = u / 5, mt = u % 5;
        float* SST = (float*)(p.ws + WS_SST);
        EPI_FOR8(acc, { const int cr = mt * 256 + lr; if (cr < NCROW) { float* o_ = SST + ((size_t)cr * 16 + g) * 256 + lc; *(f32x4*)o_ = v0; *(f32x4*)(o_ + 4) = v1; } });
    }
};
struct PvQKV {
    const Params& p; int l;
    PV_NOHOOKS
    static constexpr int NT = 4; static constexpr int FP8 = 0; static constexpr bool PARK = false; typedef APlain AS; typedef BSimple BS;
    DI int first() const { return lin_first(80, 1152); }
    DI int next(int u) const { return lin_next(u, 1152); }
    DI void src(int u, AS& a, BS& b, const int wv_) const {
        const bool isq = u < 576; const int w_ = isq ? u : u - 576; const int mt = w_ >> 1, nt = w_ & 1;
        a = make_a_plain((const bf16_t*)(p.ws + WS_P), (size_t)mt * 256, NINP, isq ? OFF_Q : OFF_KV);
        const bf16_t* W = (const bf16_t*)(p.ws + (isq ? WS_WQ : WS_WKV)) + (size_t)l * 512 * 256 + (size_t)nt * 256 * 256;
        b = make_b(W, W + (size_t)128 * 256, 256);
    }
    DI void epi(f32x4 (&acc)[2][2][4][2], int u, const int wv_) const {
        const bool isq = u < 576; const int w_ = isq ? u : u - 576; const int mt = w_ >> 1, nt = w_ & 1;
        bf16_t* RAW = (bf16_t*)(p.ws + (isq ? WS_RAWQ : WS_RAWKV));
        EPI_FOR8(acc, { store_bf16x8(RAW + (size_t)(mt * 256 + lr) * 512 + nt * 256 + lc, v0, v1); });
    }
};
DI void phase_A(const Params& p, LAS char* shm, int l, const int wv_) {
    { PvS5State pv{p, l}; gemm_stream(shm, pv, wv_); }
    { PvQKV pv{p, l}; gemm_stream(shm, pv, wv_); }
    { const int c_ = otid() & 255;
      float w[31];
#pragma unroll
      for (int j = 0; j < 31; ++j) w[j] = p.conv_dw[((size_t)l * 31 + j) * 256 + c_];
      const float bias = p.conv_dw_b[l * 256 + c_];
      for (int u = first_unit(80 + 1152); u < 1152; u += gridDim.x) pre_unit(p, shm, l, u, w, bias, wv_); }
}

DI void qkvpost_unit(const Params& p, LAS char* shm, int l, int unit, const int wv_) {
    const int tid = otid(), wid = tid >> 6, lane = tid & 63;
    const bf16_t* P = (const bf16_t*)(p.ws + WS_P);
    const bf16_t* RAWQ = (const bf16_t*)(p.ws + WS_RAWQ);
    const bf16_t* RAWKV = (const bf16_t*)(p.ws + WS_RAWKV);
    bf16_t* Q = (bf16_t*)(p.ws + WS_Q);
    bf16_t* KB = (bf16_t*)(p.ws + WS_KB);
    bf16_t* VT = (bf16_t*)(p.ws + WS_VT);
    LAS bf16_t* vt = (LAS bf16_t*)shm;
    const int row0 = unit * 64;
    const bool lat = row0 < TX;
    const int b = lat ? (row0 >> 11) : ((row0 - TX) >> 8);
    const int key0 = lat ? (row0 & 2047) : 2048 + ((row0 - TX) & 255);
    const int head = lane >> 4, sub = lane & 15;
    const float lninv = -9.210340371976184f / 8.f;
    const float frq = __expf(lninv * (float)(sub & 7));
    float qg[6], kg[6];
#pragma unroll
    for (int j = 0; j < 6; ++j) { qg[j] = p.mla_q_g[l * 96 + sub + 16 * j] * 0.14724444674085666f; kg[j] = p.mla_k_g[l * 96 + sub + 16 * j]; }
    constexpr int NB = 4;
    for (int tk0 = wid * 8; tk0 < wid * 8 + 8; tk0 += NB) {
        float pq[NB][3], pkv[NB][2], qr[NB][6], kr[NB][6], vr[NB][4];
#pragma unroll
        for (int i = 0; i < NB; ++i) { const int r = row0 + tk0 + i; const bf16_t* pr = P + (size_t)r * NINP;
#pragma unroll
            for (int j = 0; j < 3; ++j) pq[i][j] = bf2f(pr[OFF_Q + lane + 64 * j]);
#pragma unroll
            for (int j = 0; j < 2; ++j) pkv[i][j] = bf2f(pr[OFF_KV + lane + 64 * j]);
#pragma unroll
            for (int j = 0; j < 6; ++j) qr[i][j] = bf2f(RAWQ[(size_t)r * 512 + head * 96 + sub + 16 * j]);
#pragma unroll
            for (int j = 0; j < 4; ++j) kr[i][j] = bf2f(RAWKV[(size_t)r * 512 + head * 128 + sub + 16 * j]);
#pragma unroll
            for (int j = 4; j < 6; ++j) kr[i][j] = bf2f(pr[OFF_KPE + sub + 16 * (j - 4)]);
#pragma unroll
            for (int j = 0; j < 4; ++j) vr[i][j] = bf2f(RAWKV[(size_t)r * 512 + head * 128 + 64 + sub + 16 * j]); }
        float red[2 * NB];
#pragma unroll
        for (int i = 0; i < NB; ++i) { red[2 * i] = pq[i][0] * pq[i][0] + pq[i][1] * pq[i][1] + pq[i][2] * pq[i][2]; red[2 * i + 1] = pkv[i][0] * pkv[i][0] + pkv[i][1] * pkv[i][1]; }
        wave_sum_n<2 * NB>(red);
        float ssq[2 * NB];
#pragma unroll
        for (int i = 0; i < NB; ++i) {
            const float rq = rsqrtf(red[2 * i] * (1.f / 192.f) + EPS), rkv = rsqrtf(red[2 * i + 1] * (1.f / 128.f) + EPS);
            float s0 = 0.f, s1 = 0.f;
#pragma unroll
            for (int j = 0; j < 6; ++j) { qr[i][j] *= rq; s0 += qr[i][j] * qr[i][j]; }
#pragma unroll
            for (int j = 0; j < 4; ++j) { kr[i][j] *= rkv; s1 += kr[i][j] * kr[i][j]; }
#pragma unroll
            for (int j = 4; j < 6; ++j) s1 += kr[i][j] * kr[i][j];
#pragma unroll
            for (int j = 0; j < 4; ++j) vr[i][j] *= rkv;
            ssq[2 * i] = s0; ssq[2 * i + 1] = s1;
        }
        { const int l4 = olane();
#pragma unroll
          for (int o = 8; o > 0; o >>= 1) { float t_[2 * NB];
#pragma unroll
              for (int i = 0; i < 2 * NB; ++i) t_[i] = __int_as_float(__builtin_amdgcn_ds_bpermute((l4 ^ o) << 2, __float_as_int(ssq[i])));
#pragma unroll
              for (int i = 0; i < 2 * NB; ++i) ssq[i] += t_[i]; } }
#pragma unroll
        for (int i = 0; i < NB; ++i) {
            const int tk = tk0 + i, r = row0 + tk;
            const float rnq = rsqrtf(ssq[2 * i] * (1.f / 96.f) + EPS), rnk = rsqrtf(ssq[2 * i + 1] * (1.f / 96.f) + EPS);
#pragma unroll
            for (int j = 0; j < 6; ++j) { qr[i][j] *= rnq * qg[j]; kr[i][j] *= rnk * kg[j]; }
            if (lat) {
                const int tseq = r & 2047; const float a0 = (float)(tseq >> 6) * frq, a1 = (float)(tseq & 63) * frq;
                const float cs0 = __cosf(a0), sn0 = __sinf(a0), cs1 = __cosf(a1), sn1 = __sinf(a1);
                const float oq4 = shx(qr[i][4], 8), oq5 = shx(qr[i][5], 8), ok4 = shx(kr[i][4], 8), ok5 = shx(kr[i][5], 8);
                const float sg = (sub < 8) ? -1.f : 1.f;
                qr[i][4] = qr[i][4] * cs0 + sg * oq4 * sn0; qr[i][5] = qr[i][5] * cs1 + sg * oq5 * sn1;
                kr[i][4] = kr[i][4] * cs0 + sg * ok4 * sn0; kr[i][5] = kr[i][5] * cs1 + sg * ok5 * sn1;
            }
            bf16_t* kro = KB + ((size_t)(b * 4 + head) * 2304 + key0 + tk) * 96;
#pragma unroll
            for (int j = 0; j < 6; ++j) { Q[(size_t)r * 384 + head * 96 + sub + 16 * j] = f2bf(qr[i][j]); kro[sub + 16 * j] = f2bf(kr[i][j]); }
#pragma unroll
            for (int j = 0; j < 4; ++j) vt[(head * 64 + sub + 16 * j) * 72 + tk] = f2bf(vr[i][j]);
        }
    }
    __syncthreads();
    { const int hv = tid >> 1, hf = tid & 1;
      bf16_t* dst = VT + ((size_t)(b * 4 + (hv >> 6)) * 64 + (hv & 63)) * 2304 + key0 + hf * 32;
#pragma unroll
      for (int i = 0; i < 4; ++i) *(u32x4*)(dst + i * 8) = *(const LAS u32x4*)(vt + hv * 72 + hf * 32 + i * 8); }
    __syncthreads();
}
DI void s5carry_unit(const Params& p, int l, int unit, const int wv_) {
    const int gid = unit * 512 + otid();
    const int q = gid & 63, dir = (gid >> 6) & 1, g = (gid >> 7) & 15, b = gid >> 11;
    const float* A64 = (const float*)(p.ws + WS_A64) + (size_t)(((l * 2 + dir) * 16 + g) * 64 + q) * 2;
    const float ar = A64[0], ai = A64[1];
    const float* SST = (const float*)(p.ws + WS_SST);
    bf16_t* HIN = (bf16_t*)(p.ws + WS_HIN);
    float sr[NCH], si[NCH];
#pragma unroll
    for (int s = 0; s < NCH; ++s) { const int j = dir == 0 ? s : (s < 4 ? 3 - s : 39 - s);
        const size_t base = ((size_t)(b * NCH + j) * 16 + g) * 256 + dir * 128 + q; sr[s] = SST[base]; si[s] = SST[base + 64]; }
    float hr = 0.f, hi = 0.f;
#pragma unroll
    for (int s = 0; s < NCH; ++s) {
        const int j = dir == 0 ? s : (s < 4 ? 3 - s : 39 - s);
        const size_t base = ((size_t)(b * NCH + j) * 16 + g) * 256 + dir * 128 + q;
        HIN[base] = f2bf(hr); HIN[base + 64] = f2bf(hi);
        const float nr = ar * hr - ai * hi + sr[s], ni = ar * hi + ai * hr + si[s];
        hr = nr; hi = ni;
    }
}
struct PvConvPool {
    const Params& p; int l;
    PV_NOHOOKS
    static constexpr int NT = 4; static constexpr int FP8 = 0; static constexpr bool PARK = false; typedef APlain AS; typedef BSimple BS;
    DI int first() const { return lin_first(0, 576); }
    DI int next(int u) const { return lin_next(u, 576); }
    DI void src(int u, AS& a, BS& b, const int wv_) const {
        const bool isconv = u < 288; const int mt = isconv ? u : u - 288;
        a = make_a_plain((const bf16_t*)(p.ws + (isconv ? WS_ACONV : WS_APOOL)), (size_t)mt * 256, 256, 0);
        const bf16_t* W = (const bf16_t*)(p.ws + (isconv ? WS_WPW : WS_WPOOL)) + (size_t)l * 65536;
        b = make_b(W, W + (size_t)128 * 256, 256);
    }
    DI void epi(f32x4 (&acc)[2][2][4][2], int u, const int wv_) const {
        const bool isconv = u < 288; const int mt = isconv ? u : u - 288;
        bf16_t* CAT = (bf16_t*)(p.ws + WS_CAT);
        if (isconv) { EPI_FOR8(acc, { store_bf16x8(CAT + (size_t)(mt * 256 + lr) * 1024 + lc, v0, v1); }); }
        else { const int t_ = otid(), c0_ = ((t_ >> 6) & 3) * 32 + ((t_ & 63) >> 4) * 8; f32x4 sc_[2][2];
#pragma unroll
               for (int bj = 0; bj < 2; ++bj)
#pragma unroll
                   for (int n = 0; n < 2; ++n) sc_[bj][n] = *(const f32x4*)(p.pool_scale + l * 256 + bj * 128 + n * 4 + c0_);
               EPI_FOR8(acc, { store_bf16x8(CAT + (size_t)(mt * 256 + lr) * 1024 + 256 + lc, v0 * sc_[bj][0], v1 * sc_[bj][1]); }); }
    }
};
DI void phase_B(const Params& p, LAS char* shm, int l, const int wv_) {
    { PvConvPool pv{p, l}; gemm_stream(shm, pv, wv_); }
    const int n_post = TT / 64, n_carry = 128;
    for (int u = first_unit(576); u < n_post + n_carry; u += gridDim.x) {
        if (u < n_post) qkvpost_unit(p, shm, l, u, wv_);
        else s5carry_unit(p, l, u - n_post, wv_);
    }
}

DI void attn_unit(const Params& p, LAS char* shm, int l, int b, int h, int qrow0, int nq, int key_lo, int nkeys, const int wv_) {
    const int tid = otid(), wid = tid >> 6, lane = tid & 63, l31 = lane & 31, hh = lane >> 5;
    const bf16_t* Q = (const bf16_t*)(p.ws + WS_Q);
    const bf16_t* KBp = (const bf16_t*)(p.ws + WS_KB) + (size_t)(b * 4 + h) * 2304 * 96;
    const bf16_t* VTp = (const bf16_t*)(p.ws + WS_VT) + (size_t)(b * 4 + h) * 64 * 2304;
    bf16_t* CAT = (bf16_t*)(p.ws + WS_CAT);
    LAS char* kl = shm;
    LAS char* vl = shm + 13312;
    const bool active = wid * 64 < nq;
    float gq = 0.f, gk = 0.f;
    for (int i = lane; i < 96; i += 64) { gq = fmaxf(gq, fabsf(p.mla_q_g[l * 96 + i])); gk = fmaxf(gk, fabsf(p.mla_k_g[l * 96 + i])); }
    gq = wave_max(gq); gk = wave_max(gk);
    const float LOG2E = 1.4426950408889634f;
    const float c2 = 9.797958971132712f * gq * gk * LOG2E;
    const float sh2 = fmaxf(c2 - 64.f, 0.f);
    bf16x8 qf[2][6];
    if (active) {
#pragma unroll
        for (int qb = 0; qb < 2; ++qb)
#pragma unroll
            for (int ks = 0; ks < 6; ++ks) qf[qb][ks] = *(const bf16x8*)(Q + (size_t)(qrow0 + wid * 64 + qb * 32 + l31) * 384 + h * 96 + ks * 16 + hh * 8);
    }
    f32x16 O[2][2];
#pragma unroll
    for (int a = 0; a < 2; ++a)
#pragma unroll
        for (int c = 0; c < 2; ++c)
#pragma unroll
            for (int i = 0; i < 16; ++i) O[a][c][i] = 0.f;
    float lsum[2] = {0.f, 0.f};
    const int ntile = nkeys / 64;
    u32x4 kreg0, kreg1, vreg;
    auto load_tile = [&](int t) {
        const int key = key_lo + t * 64;
        { const int id = tid, kr = id / 12, part = id % 12; kreg0 = *(const u32x4*)(KBp + (size_t)(key + kr) * 96 + part * 8); }
        if (tid < 256) { const int id = tid + 512, kr = id / 12, part = id % 12; kreg1 = *(const u32x4*)(KBp + (size_t)(key + kr) * 96 + part * 8); }
        { const int vd = tid >> 3, part = tid & 7; vreg = *(const u32x4*)(VTp + (size_t)vd * 2304 + key + part * 8); }
    };
    auto write_tile = [&]() {
        { const int id = tid, kr = id / 12, part = id % 12; *(LAS u32x4*)(kl + kr * 208 + part * 16) = kreg0; }
        if (tid < 256) { const int id = tid + 512, kr = id / 12, part = id % 12; *(LAS u32x4*)(kl + kr * 208 + part * 16) = kreg1; }
        { const int vd = tid >> 3, part = tid & 7; *(LAS u32x4*)(vl + vd * 144 + part * 16) = vreg; }
    };
    load_tile(0);
    for (int t = 0; t < ntile; ++t) {
        __syncthreads();
        write_tile();
        __syncthreads();
        if (t + 1 < ntile) load_tile(t + 1);
        if (active) {
#pragma unroll
            for (int kb = 0; kb < 2; ++kb) {
                f32x16 S[2];
#pragma unroll
                for (int qb = 0; qb < 2; ++qb)
#pragma unroll
                    for (int i = 0; i < 16; ++i) S[qb][i] = 0.f;
#pragma unroll
                for (int ks = 0; ks < 6; ++ks) {
                    const bf16x8 a = *(const LAS bf16x8*)(kl + (kb * 32 + l31) * 208 + ks * 32 + hh * 16);
#pragma unroll
                    for (int qb = 0; qb < 2; ++qb) S[qb] = __builtin_amdgcn_mfma_f32_32x32x16_bf16(a, qf[qb][ks], S[qb], 0, 0, 0);
                }
                bf16x8 pf[2][2];
#pragma unroll
                for (int qb = 0; qb < 2; ++qb) {
                    float e[16];
#pragma unroll
                    for (int i = 0; i < 16; ++i) { e[i] = __builtin_amdgcn_exp2f(S[qb][i] - sh2); lsum[qb] += e[i]; }
#pragma unroll
                    for (int s = 0; s < 2; ++s) { u32x4 w; w.x = pk_bf16(e[8 * s], e[8 * s + 1]); w.y = pk_bf16(e[8 * s + 2], e[8 * s + 3]); w.z = pk_bf16(e[8 * s + 4], e[8 * s + 5]); w.w = pk_bf16(e[8 * s + 6], e[8 * s + 7]);
                        pf[qb][s] = __builtin_bit_cast(bf16x8, w); }
                }
#pragma unroll
                for (int s = 0; s < 2; ++s) {
                    const int kk = kb * 2 + s;
#pragma unroll
                    for (int vb = 0; vb < 2; ++vb) {
                        const s16x4 lo = *(const LAS s16x4*)(vl + (vb * 32 + l31) * 144 + (16 * kk + 4 * hh) * 2);
                        const s16x4 hi = *(const LAS s16x4*)(vl + (vb * 32 + l31) * 144 + (16 * kk + 8 + 4 * hh) * 2);
                        const bf16x8 va = __builtin_shufflevector(lo, hi, 0, 1, 2, 3, 4, 5, 6, 7);
#pragma unroll
                        for (int qb = 0; qb < 2; ++qb) O[vb][qb] = __builtin_amdgcn_mfma_f32_32x32x16_bf16(va, pf[qb][s], O[vb][qb], 0, 0, 0);
                    }
                }
            }
        }
    }
    if (active) {
#pragma unroll
        for (int qb = 0; qb < 2; ++qb) {
            const float tot = lsum[qb] + shx(lsum[qb], 32);
            const float inv = 1.f / tot;
            bf16_t* orow = CAT + (size_t)(qrow0 + wid * 64 + qb * 32 + l31) * 1024 + 768 + h * 64;
#pragma unroll
            for (int vb = 0; vb < 2; ++vb)
#pragma unroll
                for (int i4 = 0; i4 < 4; ++i4)
                    store_bf16x4(orow + vb * 32 + 8 * i4 + 4 * hh, O[vb][qb][4 * i4] * inv, O[vb][qb][4 * i4 + 1] * inv, O[vb][qb][4 * i4 + 2] * inv, O[vb][qb][4 * i4 + 3] * inv);
        }
    }
    __syncthreads();
}
struct PvS5Out {
    const Params& p; int l;
    PV_NOHOOKS
    static constexpr int NT = 20; static constexpr int FP8 = 0; static constexpr bool PARK = false; typedef ASeg2 AS; typedef BSimple BS;
    DI int first() const { return lin_first(512, 320); }
    DI int next(int u) const { return lin_next(u, 320); }
    DI void src(int u, AS& as, BS& bs, const int wv_) const {
        const int ntile = u & 3, mt = (u >> 2) % 5, g = u / 20;
        int R[2], C[2]; stage_coords(R, C, wv_);
        as.base0 = (const char*)(p.ws + WS_P); as.base1 = (const char*)(p.ws + WS_HIN); as.ks0 = 4 * NINP * 2; as.nt0 = 16;
#pragma unroll
        for (int h = 0; h < 2; ++h)
#pragma unroll
            for (int i = 0; i < 2; ++i) { const int cr = min(mt * 256 + h * 128 + R[i], NCROW - 1);
                as.off0[h][i] = (unsigned)(((size_t)(crow_tok(cr) + (C[i] >> 4)) * NINP + OFF_SSM + g * 16 + (C[i] & 15)) * 2);
                as.off1[h][i] = (unsigned)((((size_t)cr * 16 + g) * 256 + C[i]) * 2); }
        const bf16_t* W = (const bf16_t*)(p.ws + WS_TS5) + ((size_t)(l * 16 + g) * 1024 + ntile * 256) * 1280;
        bs = make_b(W, W + (size_t)128 * 1280, 1280);
    }
    DI void epi(f32x4 (&acc)[2][2][4][2], int u, const int wv_) const {
        const int ntile = u & 3, mt = (u >> 2) % 5, g = u / 20;
        bf16_t* Z = (bf16_t*)(p.ws + WS_Z);
        EPI_FOR8(acc, { const int cr = mt * 256 + lr; if (cr < NCROW) { const int col = ntile * 256 + lc, t = col >> 4, co = col & 15;
            const f32x4 g0 = (f32x4){gelu_tanh(v0[0]), gelu_tanh(v0[1]), gelu_tanh(v0[2]), gelu_tanh(v0[3])}, g1_ = (f32x4){gelu_tanh(v1[0]), gelu_tanh(v1[1]), gelu_tanh(v1[2]), gelu_tanh(v1[3])};
            store_bf16x8(Z + (size_t)(crow_tok(cr) + t) * 256 + g * 16 + co, g0, g1_); } });
    }
};
DI void phase_C(const Params& p, LAS char* shm, int l, const int wv_) {
    for (int u = blockIdx.x; u < 512; u += gridDim.x) { const int qb = u & 3, h = (u >> 2) & 3, b = u >> 4;
        attn_unit(p, shm, l, b, h, b * SEQ + qb * 512, 512, 0, 2304, wv_); }
    { PvS5Out pv{p, l}; gemm_stream(shm, pv, wv_); }
    if (l == 0) for (int u = first_unit(512 + 320); u < 128; u += gridDim.x) { const int h = u & 3, b = u >> 2;
        attn_unit(p, shm, l, b, h, TX + b * CTXL, 256, 2048, 256, wv_); }
}

struct PvGlu {
    const Params& p; int l;
    PV_NOHOOKS
    static constexpr int NT = 4; static constexpr int FP8 = 0; static constexpr bool PARK = false; typedef APlain AS; typedef BSimple BS;
    DI int first() const { return lin_first(0, 288); }
    DI int next(int u) const { return lin_next(u, 288); }
    DI void src(int u, AS& a, BS& b, const int wv_) const {
        a = make_a_plain((const bf16_t*)(p.ws + WS_Z), (size_t)u * 256, 256, 0);
        const bf16_t* W = (const bf16_t*)(p.ws + WS_WGLU) + (size_t)l * 65536;
        b = make_b(W, W + (size_t)128 * 256, 256);
    }
    DI void epi(f32x4 (&acc)[2][2][4][2], int u, const int wv_) const {
        const bf16_t* Z = (const bf16_t*)(p.ws + WS_Z); bf16_t* CAT = (bf16_t*)(p.ws + WS_CAT);
        const int _tz = otid(), _w = _tz >> 6, _l = _tz & 63, _wr = _w >> 2, _wc = _w & 3, _fr = _l & 15, _fq = _l >> 4;
        const int c0 = _wc * 32 + _fq * 8;
        f32x4 bsv[2][2];
#pragma unroll
        for (int bj = 0; bj < 2; ++bj)
#pragma unroll
            for (int n = 0; n < 2; ++n) bsv[bj][n] = *(const f32x4*)(p.ssm_glu_b + l * 256 + bj * 128 + n * 4 + c0);
#pragma unroll
        for (int ai = 0; ai < 2; ++ai) {
            u32x4 zz[4][2];
#pragma unroll
            for (int m = 0; m < 4; ++m)
#pragma unroll
                for (int bj = 0; bj < 2; ++bj) zz[m][bj] = *(const u32x4*)(Z + (size_t)(u * 256 + ai * 128 + _wr * 64 + m * 16 + _fr) * 256 + bj * 128 + c0);
#pragma unroll
            for (int m = 0; m < 4; ++m) { const size_t r = (size_t)(u * 256 + ai * 128 + _wr * 64 + m * 16 + _fr);
#pragma unroll
                for (int bj = 0; bj < 2; ++bj) { const f32x4 a0 = acc[ai][bj][m][0], a1 = acc[ai][bj][m][1]; const f32x4 b0 = bsv[bj][0], b1 = bsv[bj][1]; const u32x4 z_ = zz[m][bj];
                    const f32x4 o0 = (f32x4){bflo(z_.x) * sigmoidf_(a0[0] + b0[0]), bfhi(z_.x) * sigmoidf_(a0[1] + b0[1]), bflo(z_.y) * sigmoidf_(a0[2] + b0[2]), bfhi(z_.y) * sigmoidf_(a0[3] + b0[3])};
                    const f32x4 o1 = (f32x4){bflo(z_.z) * sigmoidf_(a1[0] + b1[0]), bfhi(z_.z) * sigmoidf_(a1[1] + b1[1]), bflo(z_.w) * sigmoidf_(a1[2] + b1[2]), bfhi(z_.w) * sigmoidf_(a1[3] + b1[3])};
                    store_bf16x8(CAT + r * 1024 + 512 + bj * 128 + c0, o0, o1); } }
        }
    }
};
DI void phase_D(const Params& p, LAS char* shm, int l, const int wv_) {
    PvGlu pv{p, l}; gemm_stream(shm, pv, wv_);
}

struct PvOutproj {
    const Params& p; int l;
    PV_NOHOOKS
    static constexpr int NT = 16; static constexpr int FP8 = 0; static constexpr bool PARK = false; typedef APlain AS; typedef BSimple BS;
    XcdDeal<4, 4> deal;
    DI int first() const { return deal.first(); }
    DI int next(int u) const { return deal.next(u); }
    DI void src(int u, AS& a, BS& b, const int wv_) const {
        int mt, nt; deal.decode(u, mt, nt);
        const bf16_t* W = (const bf16_t*)(p.ws + WS_WMO) + (size_t)l * 1024 * 1024;
        a = make_a_plain((const bf16_t*)(p.ws + WS_CAT), (size_t)mt * 256, 1024, 0);
        b = make_b(W + (size_t)(nt * 256) * 1024, W + (size_t)(nt * 256 + 128) * 1024, 1024);
    }
    DI void epi(f32x4 (&acc)[2][2][4][2], int u, const int wv_) const {
        int mt, nt; deal.decode(u, mt, nt);
        bf16_t* X = (bf16_t*)(p.ws + WS_X);
        const float* MOD = (const float*)(p.ws + WS_MOD) + (size_t)l * 33 * 6144;
        const int _tz = otid(), _w = _tz >> 6, _l = _tz & 63, _wr = _w >> 2, _wc = _w & 3, _fr = _l & 15, _fq = _l >> 4;
        const int c0 = nt * 256 + _wc * 32 + _fq * 8;
        const int row0 = mt * 256;
        const float* g1p = MOD + (size_t)mod_row(row0) * 6144 + 2048 + c0;
        f32x4 g1[2][2];
#pragma unroll
        for (int bj = 0; bj < 2; ++bj)
#pragma unroll
            for (int n = 0; n < 2; ++n) g1[bj][n] = *(const f32x4*)(g1p + bj * 128 + n * 4);
        bf16_t* obase = X + (size_t)row0 * 1024;
        if (l == 0) {
            const float* xbase = row0 < TX ? p.x + (size_t)row0 * 1024 : p.ctx + (size_t)(row0 - TX) * 1024;
#pragma unroll
            for (int ai = 0; ai < 2; ++ai)
#pragma unroll
                for (int mp = 0; mp < 2; ++mp) {
                    f32x4 xv[2][2][2];
#pragma unroll
                    for (int mm = 0; mm < 2; ++mm)
#pragma unroll
                        for (int bj = 0; bj < 2; ++bj)
#pragma unroll
                            for (int n = 0; n < 2; ++n) xv[mm][bj][n] = *(const f32x4*)(xbase + (size_t)(ai * 128 + _wr * 64 + (mp * 2 + mm) * 16 + _fr) * 1024 + c0 + bj * 128 + n * 4);
#pragma unroll
                    for (int mm = 0; mm < 2; ++mm)
#pragma unroll
                        for (int bj = 0; bj < 2; ++bj)
                            store_bf16x8(obase + (size_t)(ai * 128 + _wr * 64 + (mp * 2 + mm) * 16 + _fr) * 1024 + c0 + bj * 128,
                                         xv[mm][bj][0] + g1[bj][0] * acc[ai][bj][mp * 2 + mm][0], xv[mm][bj][1] + g1[bj][1] * acc[ai][bj][mp * 2 + mm][1]);
                }
        } else {
#pragma unroll
            for (int ai = 0; ai < 2; ++ai) {
                u32x4 xv[4][2];
#pragma unroll
                for (int m = 0; m < 4; ++m)
#pragma unroll
                    for (int bj = 0; bj < 2; ++bj) xv[m][bj] = *(const u32x4*)(obase + (size_t)(ai * 128 + _wr * 64 + m * 16 + _fr) * 1024 + c0 + bj * 128);
#pragma unroll
                for (int m = 0; m < 4; ++m)
#pragma unroll
                    for (int bj = 0; bj < 2; ++bj) { const u32x4 x_ = xv[m][bj];
                        const f32x4 x0 = (f32x4){bflo(x_.x), bfhi(x_.x), bflo(x_.y), bfhi(x_.y)}, x1 = (f32x4){bflo(x_.z), bfhi(x_.z), bflo(x_.w), bfhi(x_.w)};
                        store_bf16x8(obase + (size_t)(ai * 128 + _wr * 64 + m * 16 + _fr) * 1024 + c0 + bj * 128, x0 + g1[bj][0] * acc[ai][bj][m][0], x1 + g1[bj][1] * acc[ai][bj][m][1]); }
            }
        }
    }
};
DI void phase_E(const Params& p, LAS char* shm, int l, const int wv_) {
    PvOutproj pv{p, l, {(l == 1 ? TX : TT) / 256}}; gemm_stream(shm, pv, wv_);
}

template <int S> DI float row_rot_f(float v) { return __int_as_float(__builtin_amdgcn_update_dpp(0, __float_as_int(v), 0x120 | S, 0xf, 0xf, false)); }
template <int S> DI int row_rot_i(int v) { return __builtin_amdgcn_update_dpp(0, v, 0x120 | S, 0xf, 0xf, false); }
template <int S> struct RankAcc {
    static DI void run(float o0, float o1, int oe, float v0, float v1, int e0, int& r0, int& r1) {
        const float a0 = S ? row_rot_f<S>(o0) : o0, a1 = S ? row_rot_f<S>(o1) : o1; const int ae = S ? row_rot_i<S>(oe) : oe;
        r0 += (a0 > v0 || (a0 == v0 && ae < e0)) ? 1 : 0;
        r0 += (a1 > v0) ? 1 : 0;
        r1 += (a0 > v1 || a0 == v1) ? 1 : 0;
        r1 += (a1 > v1 || (a1 == v1 && ae < e0)) ? 1 : 0;
        RankAcc<S + 1>::run(o0, o1, oe, v0, v1, e0, r0, r1);
    }
};
template <> struct RankAcc<16> { static DI void run(float, float, int, float, float, int, int&, int&) {} };
DI float row_sum16(float v) { v += row_rot_f<8>(v); v += row_rot_f<4>(v); v += row_rot_f<2>(v); v += row_rot_f<1>(v); return v; }
DI float row_max16(float v) { v = fmaxf(v, row_rot_f<8>(v)); v = fmaxf(v, row_rot_f<4>(v)); v = fmaxf(v, row_rot_f<2>(v)); v = fmaxf(v, row_rot_f<1>(v)); return v; }

DI void phase_router(const Params& p, LAS char* shm, int l, const int wv_) {
    const int tid = otid(), wid = tid >> 6, lane = tid & 63;
    const int Tm = (l == 1) ? TX : TT;
    const bf16_t* X = (const bf16_t*)(p.ws + WS_X);
    const float* MOD = (const float*)(p.ws + WS_MOD) + (size_t)l * 33 * 6144;
    unsigned char* H8 = (unsigned char*)(p.ws + WS_H);
    const bool alt = p.ph_lo != 0;
    int* CNT = (int*)(p.ws + WS_CNT) + l * 32 + (alt ? 64 : 0);
    int* LIST = alt ? (int*)(p.ws + WS_RY) : (int*)(p.ws + WS_LIST);
    LAS char* wfr = shm;
    LAS bf16_t* gml = (LAS bf16_t*)(shm + 131072);
    LAS bf16_t* shl = gml + 1024;
    LAS float* cvec = (LAS float*)(shm + 131072 + 4096);
    LAS int* lcnt = (LAS int*)(cvec + 32);
    LAS int* lbase = lcnt + 32;
    LAS unsigned* lrec = (LAS unsigned*)(lbase + 32);
    LAS float* lwt = (LAS float*)(lrec + 1152);
    const int tpw = (Tm + gridDim.x - 1) / gridDim.x;
    const int tbeg = blockIdx.x * tpw, tend = min(tbeg + tpw, Tm);
    if (tid < 32) lcnt[tid] = 0;
    int seg_beg = tbeg;
    while (seg_beg < tend) {
        const int mrow = mod_row(seg_beg);
        int seg_end = tend;
        if (mrow < 32) seg_end = min(tend, (mrow + 1) * SEQ); else seg_end = tend;
        const float* mr = MOD + (size_t)mrow * 6144;
        __syncthreads();
        for (int k = tid; k < 1024; k += 512) { const float gmv = p.norm2_g[l * 1024 + k] * (1.f + mr[4096 + k]); gml[k] = f2bf(gmv); shl[k] = f2bf(mr[3072 + k]); }
#pragma unroll 8
        for (int i = tid; i < 1024 * 8; i += 512) {
            const int k = i >> 3, e4 = (i & 7) * 4;
            const float gmv = p.norm2_g[l * 1024 + k] * (1.f + mr[4096 + k]);
            const f32x4 w = *(const f32x4*)(p.router_w + (size_t)l * 32768 + k * 32 + e4);
            const int ks = k >> 5, kq = (k >> 3) & 3, j = k & 7;
#pragma unroll
            for (int c = 0; c < 4; ++c) { const int e = e4 + c, nb = e >> 4, ei = e & 15; const float wv = w[c] * gmv;
                const bf16_t hi = f2bf(wv); const bf16_t lo = f2bf(wv - bf2f(hi));
                LAS bf16_t* dst = (LAS bf16_t*)(wfr + ((size_t)((ks * 2 + nb) * 2) * 64 + (kq * 16 + ei)) * 16) + j;
                dst[0] = hi; dst[64 * 8] = lo; }
        }
        {
            float s4[4] = {0.f, 0.f, 0.f, 0.f};
#pragma unroll 8
            for (int k = lane; k < 1024; k += 64) { const float shv = mr[3072 + k]; const f32x4 w = *(const f32x4*)(p.router_w + (size_t)l * 32768 + k * 32 + wid * 4);
                s4[0] += shv * w[0]; s4[1] += shv * w[1]; s4[2] += shv * w[2]; s4[3] += shv * w[3]; }
#pragma unroll
            for (int c = 0; c < 4; ++c) { const float t_ = wave_sum(s4[c]); if (lane == 0) cvec[wid * 4 + c] = t_ + p.router_b[l * 32 + wid * 4 + c]; }
        }
        __syncthreads();
        const int ngroups = (seg_end - seg_beg) >> 4;
        for (int gi = wid; gi < ngroups; gi += 8) {
            const int t0 = seg_beg + gi * 16;
            const int tok = lane & 15, kq = lane >> 4;
            const bf16_t* xr = X + (size_t)(t0 + tok) * 1024 + kq * 8;
            f32x4 acc0 = {0.f, 0.f, 0.f, 0.f}, acc1 = {0.f, 0.f, 0.f, 0.f};
            float ss = 0.f;
            u32x4 xa[16], xb[16];
#pragma unroll
            for (int k2 = 0; k2 < 16; ++k2) xa[k2] = *(const u32x4*)(xr + k2 * 32);
#pragma unroll
            for (int k2 = 0; k2 < 16; ++k2) xb[k2] = *(const u32x4*)(xr + (16 + k2) * 32);
#pragma unroll
            for (int kc = 0; kc < 2; ++kc) {
#pragma unroll
            for (int k2 = 0; k2 < 16; ++k2) { const int ks = kc * 16 + k2;
                if ((k2 & 3) == 0) __builtin_amdgcn_sched_barrier(0);
                const u32x4 xh = kc == 0 ? xa[k2] : xb[k2];
                const float x0 = bflo(xh.x), x1 = bfhi(xh.x), x2 = bflo(xh.y), x3 = bfhi(xh.y), x4 = bflo(xh.z), x5 = bfhi(xh.z), x6 = bflo(xh.w), x7 = bfhi(xh.w);
                ss += x0 * x0 + x1 * x1 + x2 * x2 + x3 * x3 + x4 * x4 + x5 * x5 + x6 * x6 + x7 * x7;
                const bf16x8 ah = __builtin_bit_cast(bf16x8, xh);
                const LAS char* wb = wfr + (size_t)(ks * 4) * 1024 + lane * 16;
                const bf16x8 b0h = *(const LAS bf16x8*)(wb), b0l = *(const LAS bf16x8*)(wb + 1024), b1h = *(const LAS bf16x8*)(wb + 2048), b1l = *(const LAS bf16x8*)(wb + 3072);
                acc0 = __builtin_amdgcn_mfma_f32_16x16x32_bf16(ah, b0h, acc0, 0, 0, 0); acc0 = __builtin_amdgcn_mfma_f32_16x16x32_bf16(ah, b0l, acc0, 0, 0, 0);
                acc1 = __builtin_amdgcn_mfma_f32_16x16x32_bf16(ah, b1h, acc1, 0, 0, 0); acc1 = __builtin_amdgcn_mfma_f32_16x16x32_bf16(ah, b1l, acc1, 0, 0, 0);
            } }
            u32x4 xp[16];
#pragma unroll
            for (int k2 = 0; k2 < 16; ++k2) xp[k2] = *(const u32x4*)(xr + k2 * 32);
            ss += shx(ss, 16); ss += shx(ss, 32);
            const float rn = rsqrtf(ss * (1.f / 1024.f) + EPS);
            const int ei = lane & 15;
            const float c0v = cvec[ei], c1v = cvec[16 + ei];
#pragma unroll
            for (int r = 0; r < 4; ++r) {
                const int tl = (lane >> 4) * 4 + r;
                const float rnt = shi(rn, tl);
                float v0 = fminf(fmaxf(acc0[r] * rnt + c0v, -1e30f), 1e30f), v1 = fminf(fmaxf(acc1[r] * rnt + c1v, -1e30f), 1e30f);
                int r0 = 0, r1 = 0;
                RankAcc<0>::run(v0, v1, ei, v0, v1, ei, r0, r1);
                const float mx = row_max16(fmaxf(v0, v1));
                const bool s0 = r0 < 4, s1 = r1 < 4;
                const float e0 = s0 ? __expf(v0 - mx) : 0.f, e1 = s1 ? __expf(v1 - mx) : 0.f;
                const float inv = 1.f / row_sum16(e0 + e1);
                const int t = t0 + tl;
                if (s0) { const int pos = atomicAdd((int*)&lcnt[ei], 1); lrec[(t - tbeg) * 4 + r0] = (unsigned)ei | ((unsigned)pos << 8); lwt[(t - tbeg) * 4 + r0] = e0 * inv; }
                if (s1) { const int pos = atomicAdd((int*)&lcnt[16 + ei], 1); lrec[(t - tbeg) * 4 + r1] = (unsigned)(16 + ei) | ((unsigned)pos << 8); lwt[(t - tbeg) * 4 + r1] = e1 * inv; }
            }
            unsigned char* hr = H8 + (size_t)(t0 + tok) * 1024 + kq * 8;
#pragma unroll 1
            for (int kc = 0; kc < 2; ++kc) {
            u32x4 xv[16];
            if (kc == 0) {
#pragma unroll
                for (int k2 = 0; k2 < 16; ++k2) xv[k2] = xp[k2];
            } else {
#pragma unroll
                for (int k2 = 0; k2 < 16; ++k2) xv[k2] = *(const u32x4*)(xr + (16 + k2) * 32);
            }
#pragma unroll
            for (int k2 = 0; k2 < 16; ++k2) { const int ks = kc * 16 + k2;
                const u32x4 xh = xv[k2];
                const u32x4 gq = *(const LAS u32x4*)(gml + ks * 32 + kq * 8), sq = *(const LAS u32x4*)(shl + ks * 32 + kq * 8);
                float h[8];
                h[0] = bflo(xh.x) * rn * bflo(gq.x) + bflo(sq.x); h[1] = bfhi(xh.x) * rn * bfhi(gq.x) + bfhi(sq.x); h[2] = bflo(xh.y) * rn * bflo(gq.y) + bflo(sq.y); h[3] = bfhi(xh.y) * rn * bfhi(gq.y) + bfhi(sq.y);
                h[4] = bflo(xh.z) * rn * bflo(gq.z) + bflo(sq.z); h[5] = bfhi(xh.z) * rn * bfhi(gq.z) + bfhi(sq.z); h[6] = bflo(xh.w) * rn * bflo(gq.w) + bflo(sq.w); h[7] = bfhi(xh.w) * rn * bfhi(gq.w) + bfhi(sq.w);
#pragma unroll
                for (int i = 0; i < 8; ++i) h[i] = __builtin_amdgcn_fmed3f(h[i], -448.f, 448.f);
                u32x2 o; o.x = pk_fp8x4(h[0], h[1], h[2], h[3]); o.y = pk_fp8x4(h[4], h[5], h[6], h[7]);
                *(u32x2*)(hr + ks * 32) = o;
            } }
        }
        seg_beg = seg_end;
    }
    __syncthreads();
    if (tid < 32) lbase[tid] = atomicAdd(&CNT[tid], lcnt[tid]);
    __syncthreads();
    for (int i = tid; i < (tend - tbeg) * 4; i += 512) { const unsigned rec = lrec[i]; const int e = rec & 255, pos = rec >> 8;
        u32x2 ent; ent.x = (unsigned)(tbeg * 4 + i); ent.y = __float_as_uint(lwt[i]);
        *(u32x2*)(LIST + ((size_t)e * TT + lbase[e] + pos) * 2) = ent; }
    __syncthreads();
}

DI void moe_tiles(const Params& p, LAS int* tstart, int l, const int wv_) {
    const int* CNT = (const int*)(p.ws + WS_CNT) + l * 32;
    if (otid() == 0) { int s = 0; for (int e = 0; e < 32; ++e) { tstart[e] = s; s += (CNT[e] + 255) >> 8; } tstart[32] = s; }
    __syncthreads();
    LAS int* ttab = (LAS int*)((LAS char*)tstart - (LDS_MISC + 64) + LDS_TTAB);
    const int MT_ = tstart[32];
    for (int mt = otid(); mt < MT_; mt += 512) { int e = 0;
#pragma unroll
        for (int i = 1; i < 32; ++i) e += (mt >= tstart[i]) ? 1 : 0;
        ttab[mt] = e | ((mt - tstart[e]) << 8); }
    __syncthreads();
}
DI int moe_find(const LAS int* tstart, int mt) { const LAS int* ttab = (const LAS int*)((const LAS char*)tstart - (LDS_MISC + 64) + LDS_TTAB); return __builtin_amdgcn_readfirstlane(ttab[mt]); }
struct PvMoe1 {
    const Params& p; int l; const LAS int* tstart; LAS char* tbl;
    static constexpr int NT = 8; static constexpr int FP8 = 2; static constexpr bool PARK = false; typedef ASimple AS; typedef BSimple BS;
    XcdDeal<4, 8> deal;
    DI int first() const { return deal.first(); }
    DI int next(int u) const { return deal.next(u); }
    typedef u32x4 Aux;
    DI void top(int u, Aux& aux, const int wv_) const {
        int mt, n8; deal.decode(u, mt, n8);
        const int ev_ = moe_find(tstart, mt); const int e = ev_ & 255;
        const int t_ = otid() & 63;
        aux = aload128(p.exp_b_in + (size_t)(l * NE + e) * 2048 + (t_ < 32 ? n8 * 128 + t_ * 4 : 1024 + n8 * 128 + (t_ - 32) * 4));
    }
    DI void mid(Aux& aux, const int wv_) const { const int t_ = otid(); asm volatile("" : "+v"(aux)); if (t_ < 64) *(LAS u32x4*)(tbl + t_ * 16) = aux; }
    DI void fix(AS& as, bool wait, const int wv_) const {
        if (wait) asm volatile("s_waitcnt vmcnt(0)" ::: "memory");
        int R[2], C[2]; stage_coords(R, C, wv_);
#pragma unroll
        for (int h = 0; h < 2; ++h)
#pragma unroll
            for (int i = 0; i < 2; ++i) { unsigned sl = as.off[h][i]; asm volatile("" : "+v"(sl)); as.off[h][i] = (sl >> 2) * 1024u + (unsigned)(C[i] * 2); }
    }
    DI void src(int u, AS& as, BS& bs, const int wv_) const {
        int mt, n8; deal.decode(u, mt, n8);
        const int ev_ = moe_find(tstart, mt); const int e = ev_ & 255;
        const int r0 = (ev_ >> 8) * 256, cnt = ((const int*)(p.ws + WS_CNT))[l * 32 + e];
        const int* lst = (const int*)(p.ws + WS_LIST) + (size_t)e * TT * 2;
        int R[2], C[2]; stage_coords(R, C, wv_);
        as.base = (const char*)(p.ws + WS_H); as.kstride = 128;
#pragma unroll
        for (int h = 0; h < 2; ++h)
#pragma unroll
            for (int i = 0; i < 2; ++i) as.off[h][i] = aload32(lst + 2 * min(r0 + h * 128 + R[i], cnt - 1));
        const char* W = (const char*)(p.ws + WS_W1) + (size_t)(l * NE + e) * 2048 * 1024;
        bs.base[0] = W + (size_t)(n8 * 128) * 1024; bs.base[1] = W + (size_t)(1024 + n8 * 128) * 1024; bs.ldb2 = 1024;
    }
    DI void epi(f32x4 (&acc)[2][2][4][2], int u, const int wv_) const {
        int mt, n8; deal.decode(u, mt, n8);
        const int ev_ = moe_find(tstart, mt); const int e = ev_ & 255;
        unsigned char* ACT = (unsigned char*)(p.ws + WS_RA);
        const int _tz = otid(), _w = _tz >> 6, _l = _tz & 63, _wr = _w >> 2, _wc = _w & 3, _fr = _l & 15, _fq = _l >> 4;
        const LAS float* bin = (const LAS float*)tbl + _wc * 32 + _fq * 8;
        f32x4 bg[2], bu[2];
#pragma unroll
        for (int n = 0; n < 2; ++n) { bg[n] = *(const LAS f32x4*)(bin + n * 4); bu[n] = *(const LAS f32x4*)(bin + 128 + n * 4); }
        (void)e;
#pragma unroll
        for (int ai = 0; ai < 2; ++ai)
#pragma unroll
            for (int m = 0; m < 4; ++m) { const int lr = ai * 128 + _wr * 64 + m * 16 + _fr;
                unsigned char* orow = ACT + ((size_t)mt * 256 + lr) * 1024 + n8 * 128 + _wc * 32 + _fq * 8;
                u32x2 pk;
#pragma unroll
                for (int n = 0; n < 2; ++n) {
                    float o[4];
#pragma unroll
                    for (int h2 = 0; h2 < 2; ++h2) {
                        const f32v2_t ag = {acc[ai][0][m][n][2 * h2], acc[ai][0][m][n][2 * h2 + 1]}, au = {acc[ai][1][m][n][2 * h2], acc[ai][1][m][n][2 * h2 + 1]};
                        const f32v2_t bgv = {bg[n][2 * h2], bg[n][2 * h2 + 1]}, buv = {bu[n][2 * h2], bu[n][2 * h2 + 1]};
                        f32v2_t g2 = ag * (1.f / 256.f) + bgv, u2 = au * (1.f / 256.f) + buv;
                        g2[0] = fminf(g2[0], 7.f); g2[1] = fminf(g2[1], 7.f);
                        u2[0] = __builtin_amdgcn_fmed3f(u2[0], -7.f, 7.f); u2[1] = __builtin_amdgcn_fmed3f(u2[1], -7.f, 7.f);
                        const f32v2_t t2 = g2 * (-2.4554669595930156f);
                        f32v2_t e2; e2[0] = __builtin_amdgcn_exp2f(t2[0]); e2[1] = __builtin_amdgcn_exp2f(t2[1]);
                        const f32v2_t d2 = e2 + 1.f;
                        f32v2_t r2; r2[0] = __builtin_amdgcn_rcpf(d2[0]); r2[1] = __builtin_amdgcn_rcpf(d2[1]);
                        const f32v2_t o2 = (u2 + 1.f) * g2 * r2;
                        o[2 * h2] = o2[0]; o[2 * h2 + 1] = o2[1]; }
                    if (n == 0) pk.x = pk_fp8x4(o[0], o[1], o[2], o[3]); else pk.y = pk_fp8x4(o[0], o[1], o[2], o[3]); }
                *(u32x2*)orow = pk; }
    }
};
DI void phase_moe1(const Params& p, LAS char* shm, int l, const int wv_) {
    LAS int* tstart = (LAS int*)(shm + LDS_MISC + 64);
    moe_tiles(p, tstart, l, wv_);
    PvMoe1 pv{p, l, tstart, shm + 131072, {tstart[32]}}; gemm_stream(shm, pv, wv_);
}
struct PvMoe2 {
    const Params& p; int l; const LAS int* tstart; LAS char* tbl;
    static constexpr int NT = 8; static constexpr int FP8 = 2; static constexpr bool PARK = false; typedef APlain AS; typedef BSeq16 BS;
    XcdDeal<4, 4> deal;
    DI int first() const { return deal.first(); }
    DI int next(int u) const { return deal.next(u); }
    template <class A_> DI void fix(A_&, bool, const int) const {}
    typedef u32x4 Aux;
    DI void top(int u, Aux& aux, const int wv_) const {
        int mt, n4; deal.decode(u, mt, n4);
        const int ev_ = moe_find(tstart, mt); const int e = ev_ & 255; const int r0 = (ev_ >> 8) * 256;
        const int t_ = otid();
        const char* src_ = t_ < 128 ? (const char*)((const int*)(p.ws + WS_LIST) + (size_t)e * TT * 2 + (size_t)(r0 + 2 * t_) * 2)
                                    : (const char*)(p.exp_b_out + (size_t)(l * NE + e) * 1024 + n4 * 256 + ((t_ - 128) & 63) * 4);
        aux = aload128(src_);
    }
    DI void mid(Aux& aux, const int wv_) const { const int t_ = otid(); asm volatile("" : "+v"(aux)); if (t_ < 192) *(LAS u32x4*)(tbl + t_ * 16) = aux; }
    DI void src(int u, AS& as, BS& bs, const int wv_) const {
        int mt, n4; deal.decode(u, mt, n4);
        const int ev_ = moe_find(tstart, mt); const int e = ev_ & 255;
        as.base = (const char*)(p.ws + WS_RA) + (size_t)mt * 256 * 1024; as.lda2 = 1024;
        const char* W = (const char*)(p.ws + WS_W2) + (size_t)(l * NE + e) * 1024 * 1024;
        bs.base = W + (size_t)(n4 * 256) * 1024; bs.ldb2 = 1024;
    }
    DI void epi(f32x4 (&acc)[2][2][4][2], int u, const int wv_) const {
        int mt, n4; deal.decode(u, mt, n4);
        const int ev_ = moe_find(tstart, mt); const int e = ev_ & 255;
        const int r0 = (ev_ >> 8) * 256, cnt = ((const int*)(p.ws + WS_CNT))[l * 32 + e];
        const int* lst = (const int*)(p.ws + WS_LIST) + (size_t)e * TT * 2;
        unsigned char* Y = (unsigned char*)(p.ws + WS_RY);
        const int _tz = otid(), _w = _tz >> 6, _l = _tz & 63, _wr = _w >> 2, _wc = _w & 3, _fr = _l & 15, _fq = _l >> 4;
        const LAS float* bo = (const LAS float*)(tbl + 2048) + _wc * 64 + _fq * 16;
        u32x2 ent[2][4]; f32x4 bv[2][2];
#pragma unroll
        for (int ai = 0; ai < 2; ++ai)
#pragma unroll
            for (int m = 0; m < 4; ++m) ent[ai][m] = *(const LAS u32x2*)(tbl + (ai * 128 + _wr * 64 + m * 16 + _fr) * 8);
#pragma unroll
        for (int bj = 0; bj < 2; ++bj)
#pragma unroll
            for (int n = 0; n < 2; ++n) bv[bj][n] = *(const LAS f32x4*)(bo + bj * 8 + n * 4);
        (void)lst;
#pragma unroll
        for (int ai = 0; ai < 2; ++ai)
#pragma unroll
            for (int m = 0; m < 4; ++m) { const int lr = r0 + ai * 128 + _wr * 64 + m * 16 + _fr;
                if (lr < cnt) { const float w = __uint_as_float(ent[ai][m].y) * YSCALE; unsigned char* orow = Y + (size_t)ent[ai][m].x * 1024 + n4 * 256 + _wc * 64 + _fq * 16;
                    const float sc_ = 1.f / 256.f;
                    u32x4 pk;
#pragma unroll
                    for (int bj = 0; bj < 2; ++bj)
#pragma unroll
                        for (int n = 0; n < 2; ++n) { const f32x4 v = (acc[ai][bj][m][n] * sc_ + bv[bj][n]) * w;
                            pk[bj * 2 + n] = pk_fp8x4(__builtin_amdgcn_fmed3f(v[0], -448.f, 448.f), __builtin_amdgcn_fmed3f(v[1], -448.f, 448.f), __builtin_amdgcn_fmed3f(v[2], -448.f, 448.f), __builtin_amdgcn_fmed3f(v[3], -448.f, 448.f)); }
                    *(u32x4*)orow = pk; } }
    }
};
DI void phase_moe2(const Params& p, LAS char* shm, int l, const int wv_) {
    LAS int* tstart = (LAS int*)(shm + LDS_MISC + 64);
    moe_tiles(p, tstart, l, wv_);
    PvMoe2 pv{p, l, tstart, shm + 131072, {tstart[32]}}; gemm_stream(shm, pv, wv_);
}

DI void phase_combine(const Params& p, LAS char* shm, int l, const int wv_) {
    const int tid = otid(), wid = tid >> 6, lane = tid & 63;
    const bool alt = p.ph_lo != 0;
    const bf16_t* X = (const bf16_t*)(p.ws + WS_X);
    bf16_t* XO = alt ? (bf16_t*)(p.ws + WS_RA) : (bf16_t*)(p.ws + WS_X);
    float* OUT = alt ? (float*)(p.ws + WS_RA) : p.out;
    const unsigned char* Y = (const unsigned char*)(p.ws + WS_RY);
    const float* MOD = (const float*)(p.ws + WS_MOD);
    bf16_t* H = alt ? (bf16_t*)(p.ws + WS_RA + (size_t)TT * 1024 * 4) : (bf16_t*)(p.ws + WS_H);
    const int Tm = (l == 1) ? TX : TT;
    for (int r = blockIdx.x * 8 + wid; r < Tm; r += gridDim.x * 8) {
        const float* g2 = MOD + (size_t)(l * 33 + mod_row(r)) * 6144 + 5120;
        float v[16];
#pragma unroll
        for (int j = 0; j < 4; ++j) {
            const int col = j * 256 + lane * 4;
            f32x4 s = (f32x4){0.f, 0.f, 0.f, 0.f};
#pragma unroll
            for (int k = 0; k < 4; ++k) { const int yy = *(const int*)(Y + ((size_t)r * 4 + k) * 1024 + col); const f32v2_t ya = __builtin_amdgcn_cvt_pk_f32_fp8(yy, false), yb = __builtin_amdgcn_cvt_pk_f32_fp8(yy, true);
                s[0] += ya[0]; s[1] += ya[1]; s[2] += yb[0]; s[3] += yb[1]; }
            s *= 1.f / YSCALE;
            const u32x2 xb_ = *(const u32x2*)(X + (size_t)r * 1024 + col); const f32x4 gg = *(const f32x4*)(g2 + col);
            const f32x4 xv = (f32x4){bflo(xb_.x), bfhi(xb_.x), bflo(xb_.y), bfhi(xb_.y)};
            const f32x4 o = xv + gg * s;
            if (l == 1) *(f32x4*)(OUT + (size_t)r * 1024 + col) = o; else store_bf16x4(XO + (size_t)r * 1024 + col, o[0], o[1], o[2], o[3]);
            v[j * 4] = o[0]; v[j * 4 + 1] = o[1]; v[j * 4 + 2] = o[2]; v[j * 4 + 3] = o[3];
        }
        if (l == 0) norm_mod_store(v, p.norm1_g + 1024, MOD + (size_t)(1 * 33 + mod_row(r)) * 6144, H + (size_t)r * 1024, wv_);
    }
}

constexpr int NPH_LAYER = 10;
constexpr int NPH = 2 + 2 * NPH_LAYER;

__global__ void __launch_bounds__(512, 2) mk_forward(Params p_unused) {
    extern __shared__ __attribute__((aligned(16))) char smem_raw[];
    LAS char* shm = (LAS char*)smem_raw;
    volatile LAS unsigned* xb_words = (volatile LAS unsigned*)(shm + LDS_MISC);
    const int wv_ = __builtin_amdgcn_readfirstlane((int)(threadIdx.x >> 6));
    if (wv_ == 0 && olane() < 4) xb_words[olane()] = 0u;
    __syncthreads();
    kaptr_t ka = (kaptr_t)__builtin_amdgcn_kernarg_segment_ptr();
    const int tok0 = ptoken();
    const int lo = (int)kld64<__builtin_offsetof(Params, ph_lo)>(ka, tok0), hi = (int)kld64<__builtin_offsetof(Params, ph_hi)>(ka, tok0);
    const bool multi = (hi - lo) > 1;
    unsigned* barw = (unsigned*)((__attribute__((address_space(1))) char*)kld64<__builtin_offsetof(Params, ws)>(ka, tok0) + WS_BAR);
    XcdBarrier bar; bar.bar = barw; bar.x = 0; bar.st = xb_words;
    if (multi) bar = xcd_barrier_post(barw, xb_words, wv_);
#ifndef ONLY_KIND
#define ONLY_KIND (-1)
#endif
#define PHASE(idx, kind, FN, ...) do { if ((ONLY_KIND < 0 || ONLY_KIND == (kind)) && (idx) >= lo && (idx) < hi) { const Params p = kparams(ka, ptoken()); int nrep_ = 1 + ((MK_REPEAT_MASK >> (kind)) & 1); asm volatile("" : "+s"(nrep_)); for (int rep_ = 0; rep_ < nrep_; ++rep_) { Params p2 = p; p2.ph_lo = rep_; FN(p2, ##__VA_ARGS__, wv_); } if ((idx) + 1 < hi) xcd_barrier(bar, wv_); } } while (0)
    PHASE(0, 0, phase_prologue, shm);
    PHASE(1, 1, phase_norm1_l0);
    for (int l = 0; l < 2; ++l) {
        const int b0 = 2 + l * NPH_LAYER;
        PHASE(b0 + 0, 2, phase_inproj, shm, l);
        PHASE(b0 + 1, 3, phase_A, shm, l);
        PHASE(b0 + 2, 4, phase_B, shm, l);
        PHASE(b0 + 3, 5, phase_C, shm, l);
        PHASE(b0 + 4, 6, phase_D, shm, l);
        PHASE(b0 + 5, 7, phase_E, shm, l);
        PHASE(b0 + 6, 8, phase_router, shm, l);
        PHASE(b0 + 7, 9, phase_moe1, shm, l);
        PHASE(b0 + 8, 10, phase_moe2, shm, l);
        PHASE(b0 + 9, 11, phase_combine, shm, l);
    }
#undef PHASE
}


extern "C" void kernel_launch(void* const* d_in, const int* in_sizes, int n_in, void* d_out, int out_size, void* d_ws, size_t ws_size, hipStream_t stream) {
    static int grid = 0;
    if (grid == 0) {
        if (n_in != 39 || ws_size < WS_END) { fprintf(stderr, "kernel_launch: unexpected n_in %d or ws_size %zu (< %zu)\n", n_in, ws_size, (size_t)WS_END); grid = -1; return; }
        int dev = 0, cus = 0;
        if (hipGetDevice(&dev) != hipSuccess || hipDeviceGetAttribute(&cus, hipDeviceAttributeMultiprocessorCount, dev) != hipSuccess) { grid = -1; return; }
        if (hipFuncSetAttribute((const void*)mk_forward, hipFuncAttributeMaxDynamicSharedMemorySize, LDS_BYTES) != hipSuccess) { fprintf(stderr, "kernel_launch: hipFuncSetAttribute failed\n"); grid = -1; return; }
        int per_cu = 0;
        if (hipOccupancyMaxActiveBlocksPerMultiprocessor(&per_cu, (const void*)mk_forward, 512, LDS_BYTES) != hipSuccess || per_cu < 1) fprintf(stderr, "kernel_launch: occupancy query says %d\n", per_cu);
        (void)hipGetLastError();
        grid = cus > 256 ? 256 : cus;
    }
    if (grid < 0) return;
    (void)hipMemsetAsync((char*)d_ws + WS_BAR, 0, 16384 + 1024, stream);
    Params p{};
    const float** pf = (const float**)&p;
    for (int i = 0; i < 39; ++i) pf[i] = (const float*)d_in[i];
    p.out = (float*)d_out; p.ws = (char*)d_ws;
#if MK_ONE_LAUNCH
    p.ph_lo = 0; p.ph_hi = NPH;
    hipLaunchKernelGGL(mk_forward, dim3(grid), dim3(512), LDS_BYTES, stream, p);
#else
#ifndef MK_LAST_PHASE
#define MK_LAST_PHASE NPH
#endif
    for (int ph = 0; ph < MK_LAST_PHASE; ++ph) { p.ph_lo = ph; p.ph_hi = ph + 1; hipLaunchKernelGGL(mk_forward, dim3(grid), dim3(512), LDS_BYTES, stream, p); }
#endif
}
```

```cpp
#include <hip/hip_runtime.h>
#include <stdint.h>
#include <stdio.h>

#ifndef MK_REPEAT_MASK
#define MK_REPEAT_MASK 0x0
#endif
#ifndef MK_ONE_LAUNCH
#define MK_ONE_LAUNCH 1
#endif

#define DI __device__ __forceinline__
#define LAS __attribute__((address_space(3)))
typedef unsigned short bf16_t;
typedef short bf16x8 __attribute__((ext_vector_type(8)));
typedef short s16x4 __attribute__((ext_vector_type(4)));
typedef float f32x4 __attribute__((ext_vector_type(4)));
typedef float f32x16 __attribute__((ext_vector_type(16)));
typedef unsigned u32x2 __attribute__((ext_vector_type(2)));
typedef unsigned u32x4 __attribute__((ext_vector_type(4)));
typedef int i32x4 __attribute__((ext_vector_type(4)));
typedef int i32x8 __attribute__((ext_vector_type(8)));

constexpr int D = 1024, NB = 32, SEQ = 2048, CTXL = 256;
constexpr int TX = NB * SEQ, TC = NB * CTXL, TT = TX + TC;
constexpr int NINP = 1536;
constexpr int OFF_POOL = 512, OFF_Q = 768, OFF_SSM = 960, OFF_KV = 1216, OFF_KPE = 1344, N_IN = 1376;
constexpr int NE = 32;
constexpr int NCH = 36;
constexpr int NCROW = NB * NCH;
constexpr float EPS = 1e-6f;

constexpr size_t WS_BAR = 0;
constexpr size_t WS_CNT = 16384;
constexpr size_t WS_MOD = WS_CNT + 1024;
constexpr size_t WS_A64 = WS_MOD + (size_t)2 * 33 * 6144 * 4;
constexpr size_t WS_WMI = WS_A64 + (size_t)2 * 2 * 16 * 64 * 2 * 4;
constexpr size_t WS_WMO = WS_WMI + (size_t)2 * 1536 * 1024 * 2;
constexpr size_t WS_WPW = WS_WMO + (size_t)2 * 1024 * 1024 * 2;
constexpr size_t WS_WGLU = WS_WPW + (size_t)2 * 256 * 256 * 2;
constexpr size_t WS_WPOOL = WS_WGLU + (size_t)2 * 256 * 256 * 2;
constexpr size_t WS_WQ = WS_WPOOL + (size_t)2 * 256 * 256 * 2;
constexpr size_t WS_WKV = WS_WQ + (size_t)2 * 512 * 256 * 2;
constexpr size_t WS_TS5 = WS_WKV + (size_t)2 * 512 * 256 * 2;
constexpr size_t WS_WS5 = WS_TS5 + (size_t)2 * 16 * 1024 * 1280 * 2;
constexpr size_t WS_W1 = WS_WS5 + (size_t)2 * 16 * 256 * 1024 * 2;
constexpr size_t WS_W2 = WS_W1 + (size_t)32 * 2048 * 1024 * 2;
constexpr size_t WS_X = WS_W2 + (size_t)32 * 1024 * 1024 * 2;
constexpr size_t WS_H = WS_X + (size_t)TT * 1024 * 4;
constexpr size_t WS_LIST = WS_H + (size_t)TT * 1024 * 2;
constexpr size_t WS_TOPW = WS_LIST + (size_t)32 * TT * 8;
constexpr size_t WS_RA = WS_TOPW + (size_t)TT * 4 * 4;
constexpr float YSCALE = 32.f;
constexpr size_t WS_RY = WS_RA + (size_t)TT * 4 * 1024 * 2;
constexpr size_t WS_END = WS_RY + (size_t)TT * 4 * 1024 * 2;
constexpr size_t WS_P = WS_RA;
constexpr size_t WS_ACONV = WS_P + (size_t)TT * NINP * 2;
constexpr size_t WS_APOOL = WS_ACONV + (size_t)TT * 256 * 2;
constexpr size_t WS_RAWQ = WS_APOOL + (size_t)TT * 256 * 2;
constexpr size_t WS_RAWKV = WS_RAWQ + (size_t)TT * 512 * 4;
constexpr size_t WS_Q = WS_RAWKV + (size_t)TT * 512 * 4;
constexpr size_t WS_KB = WS_Q + (size_t)TT * 384 * 2;
constexpr size_t WS_VT = WS_KB + (size_t)128 * 2304 * 96 * 2;
constexpr size_t WS_SST = WS_VT + (size_t)128 * 64 * 2304 * 2;
constexpr size_t WS_HIN = WS_SST + (size_t)NCROW * 16 * 256 * 4;
constexpr size_t WS_Z = WS_HIN + (size_t)NCROW * 16 * 256 * 2;
constexpr size_t WS_CAT = WS_Z + (size_t)TT * 256 * 2;
constexpr size_t WS_MIX_END = WS_CAT + (size_t)TT * 1024 * 2;
static_assert(WS_MIX_END <= WS_END, "mixer buffers must fit in the ACT/Y regions");
static_assert(WS_END <= (size_t)2147483648ull, "workspace budget");

constexpr int LDS_BYTES = 147456;
constexpr int LDS_TTAB = 131072 + 4096;
constexpr int LDS_MISC = 146432;

struct Params {
    const float *x, *c, *ctx, *c_ctx, *ada_w, *ada_b, *norm1_g, *norm2_g, *w_mix_in, *w_mix_out,
        *conv_dw, *conv_dw_b, *conv_ln_g, *conv_ln_b, *conv_pw, *pool_w, *pool_scale,
        *ssm_a_re, *ssm_a_im, *ssm_log_dt, *ssm_b_re, *ssm_b_im, *ssm_c_re, *ssm_c_im, *ssm_d, *ssm_glu_w, *ssm_glu_b,
        *mla_q_a_g, *mla_wq_b, *mla_kv_a_g, *mla_wkv_b, *mla_q_g, *mla_k_g,
        *router_w, *router_b, *exp_w_in, *exp_b_in, *exp_w_out, *exp_b_out;
    float* out;
    char* ws;
    long long ph_lo, ph_hi;
};

typedef const __attribute__((address_space(4))) char* kaptr_t;
template <int OFF> DI unsigned long long kld64(kaptr_t ka, int tok) {
    unsigned long long v;
    asm("s_load_dwordx2 %0, %1, %3\n\ts_waitcnt lgkmcnt(0)" : "=&s"(v) : "s"(ka), "s"(tok), "n"(OFF));
    return v;
}
DI int ptoken() { int t; asm volatile("s_mov_b32 %0, 0" : "=s"(t)); return t; }
DI Params kparams(kaptr_t ka, int tok) {
    Params p;
#define KL_(f) p.f = (decltype(p.f))((__attribute__((address_space(1))) char*)kld64<__builtin_offsetof(Params, f)>(ka, tok))
    KL_(x); KL_(c); KL_(ctx); KL_(c_ctx); KL_(ada_w); KL_(ada_b); KL_(norm1_g); KL_(norm2_g); KL_(w_mix_in); KL_(w_mix_out); KL_(conv_dw); KL_(conv_dw_b); KL_(conv_ln_g); KL_(conv_ln_b); KL_(conv_pw); KL_(pool_w); KL_(pool_scale); KL_(ssm_a_re); KL_(ssm_a_im); KL_(ssm_log_dt); KL_(ssm_b_re); KL_(ssm_b_im); KL_(ssm_c_re); KL_(ssm_c_im); KL_(ssm_d); KL_(ssm_glu_w); KL_(ssm_glu_b); KL_(mla_q_a_g); KL_(mla_wq_b); KL_(mla_kv_a_g); KL_(mla_wkv_b); KL_(mla_q_g); KL_(mla_k_g); KL_(router_w); KL_(router_b); KL_(exp_w_in); KL_(exp_b_in); KL_(exp_w_out); KL_(exp_b_out); KL_(out); KL_(ws);
#undef KL_
    p.ph_lo = 0; p.ph_hi = 0;
    return p;
}

typedef __bf16 bf16v2_t __attribute__((ext_vector_type(2)));
typedef float f32v2_t __attribute__((ext_vector_type(2)));
DI unsigned pk_bf16(float lo, float hi) { const f32v2_t f = {lo, hi}; const bf16v2_t b = __builtin_convertvector(f, bf16v2_t); return __builtin_bit_cast(unsigned, b); }
DI bf16_t f2bf(float x) { return (bf16_t)(pk_bf16(x, 0.f) & 0xffffu); }
DI float bf2f(bf16_t v) { return __uint_as_float(((unsigned)v) << 16); }
DI unsigned f2fp8(float x) { x = fminf(fmaxf(x, -448.f), 448.f); return (unsigned)__builtin_amdgcn_cvt_pk_fp8_f32(x, x, 0, false) & 0xffu; }
DI unsigned pk_fp8x4(float a, float b, float c, float d) { int v = __builtin_amdgcn_cvt_pk_fp8_f32(a, b, 0, false); v = __builtin_amdgcn_cvt_pk_fp8_f32(c, d, v, true); return (unsigned)v; }
DI float bflo(unsigned u) { return __uint_as_float(u << 16); }
DI float bfhi(unsigned u) { return __uint_as_float(u & 0xffff0000u); }
DI int olane() { int l = (int)__builtin_amdgcn_mbcnt_hi(~0u, __builtin_amdgcn_mbcnt_lo(~0u, 0u)); asm volatile("" : "+v"(l)); return l; }
DI float shx(float v, int o) { const int l = olane(); return __int_as_float(__builtin_amdgcn_ds_bpermute((l ^ o) << 2, __float_as_int(v))); }
DI float shi(float v, int src) { return __int_as_float(__builtin_amdgcn_ds_bpermute(src << 2, __float_as_int(v))); }
#define otid() otid_(wv_)
DI int otid_(int wv) { int t = (wv << 6) | olane(); asm volatile("" : "+v"(t)); return t; }
DI float wave_sum(float v) {
#pragma unroll
    for (int o = 32; o > 0; o >>= 1) v += shx(v, o);
    return v;
}
DI float wave_max(float v) {
#pragma unroll
    for (int o = 32; o > 0; o >>= 1) v = fmaxf(v, shx(v, o));
    return v;
}
DI float sigmoidf_(float x) { return __builtin_amdgcn_rcpf(1.f + __builtin_amdgcn_exp2f(-1.4426950408889634f * x)); }
DI float siluf_(float x) { return x * sigmoidf_(x); }
DI float gelu_tanh(float x) {
    const float u = 0.7978845608028654f * (x + 0.044715f * x * x * x);
    return x * __builtin_amdgcn_rcpf(1.f + __builtin_amdgcn_exp2f(-2.8853900817779268f * u));
}
DI unsigned aload32(const void* p_) { unsigned r; asm volatile("global_load_dword %0, %1, off" : "=v"(r) : "v"(p_) : "memory"); return r; }
DI u32x4 aload128(const void* p_) { u32x4 r; asm volatile("global_load_dwordx4 %0, %1, off" : "=v"(r) : "v"(p_) : "memory"); return r; }
#define PV_NOHOOKS typedef int Aux; DI void top(int, Aux&, const int) const {} DI void mid(Aux&, const int) const {} template <class A_> DI void fix(A_&, bool, const int) const {}
DI void glds16(const void* src, LAS char* dst) {
    __builtin_amdgcn_global_load_lds((const __attribute__((address_space(1))) void*)src, (LAS void*)dst, 16, 0, 0);
}

#define XB_TMO      128
#define XB_XCNT(j)  (256  + 64 * (j))
#define XB_XSUB(j)  (1280 + 64 * (j))
#define XB_XGEN(j)  (2304 + 64 * (j))
#define XB_TOP      3328
#define XB_TOPGEN   3392
#define XCD_BAR_WORDS 3456
#define XB_SPIN_CAP (1u << 18)
__device__ __forceinline__ unsigned xb_ld(unsigned* p)              { return __hip_atomic_load(p, __ATOMIC_RELAXED, __HIP_MEMORY_SCOPE_AGENT); }
__device__ __forceinline__ unsigned xb_add(unsigned* p, unsigned v) { return __hip_atomic_fetch_add(p, v, __ATOMIC_RELAXED, __HIP_MEMORY_SCOPE_AGENT); }
__device__ __forceinline__ unsigned xb_xcc_id() { return (unsigned)__builtin_amdgcn_s_getreg((3 << 11) | 20) & 0xFu; }
#define XB_SPIN(cond, bar) do { unsigned _sp = 0; while (cond) { __builtin_amdgcn_s_sleep(1); \
    if ((++_sp & 255u) == 0u) { if (xb_ld(&(bar)[XB_TMO])) break; if (_sp > XB_SPIN_CAP) { atomicAdd(&(bar)[XB_TMO], 1u); break; } } } } while (0)
struct XcdBarrier { unsigned* bar; unsigned x; volatile LAS unsigned* st; };
__device__ __forceinline__ XcdBarrier xcd_barrier_post(unsigned* bar, volatile LAS unsigned* st, const int wv_) {
    XcdBarrier b; b.bar = bar; b.x = xb_xcc_id(); b.st = st;
    if (otid() == 0) (void)xb_add(&bar[XB_XCNT(b.x)], 1u);
    return b;
}
__device__ __forceinline__ void xcd_barrier_complete(unsigned* bar, unsigned x, unsigned& nloc, unsigned& nx) {
    const unsigned G = gridDim.x * gridDim.y * gridDim.z;
    unsigned sum, cnt, mine, sp = 0u;
    for (;;) {
        sum = 0u; cnt = 0u; mine = 0u;
#pragma unroll
        for (unsigned j = 0; j < 16; ++j) { const unsigned c = xb_ld(&bar[XB_XCNT(j)]); sum += c; cnt += (c > 0u) ? 1u : 0u; mine = (j == x) ? c : mine; }
        if (sum == G) break;
        __builtin_amdgcn_s_sleep(1);
        if ((++sp & 255u) == 0u) { if (xb_ld(&bar[XB_TMO])) break; if (sp > XB_SPIN_CAP) { atomicAdd(&bar[XB_TMO], 1u); break; } }
    }
    nloc = mine > 0u ? mine : 1u; nx = cnt > 0u ? cnt : 1u;
}
__device__ __forceinline__ void xcd_barrier(const XcdBarrier& b, const int wv_) {
    asm volatile("s_waitcnt vmcnt(0)" ::: "memory");
    __syncthreads();
    if (otid() == 0) {
        unsigned* bar = b.bar;
        __builtin_amdgcn_s_waitcnt(0);
        unsigned nloc = b.st[0], nx = b.st[1];
        if (nloc == 0u) { xcd_barrier_complete(bar, b.x, nloc, nx); b.st[0] = nloc; b.st[1] = nx; }
        const unsigned old = xb_add(&bar[XB_XSUB(b.x)], 1u);
        const unsigned gen = old / nloc;
        if (old + 1u == (gen + 1u) * nloc) {
            __builtin_amdgcn_fence(__ATOMIC_RELEASE, "agent");
            asm volatile("s_waitcnt vmcnt(0)" ::: "memory");
            const unsigned og = xb_add(&bar[XB_TOP], 1u);
            const unsigned tg = og / nx;
            if (og + 1u == (tg + 1u) * nx) xb_add(&bar[XB_TOPGEN], 1u);
            else XB_SPIN(xb_ld(&bar[XB_TOPGEN]) == tg, bar);
            __builtin_amdgcn_fence(__ATOMIC_ACQUIRE, "agent");
            xb_add(&bar[XB_XGEN(b.x)], 1u);
            asm volatile("s_waitcnt vmcnt(0)" ::: "memory");
        } else {
            XB_SPIN(xb_ld(&bar[XB_XGEN(b.x)]) == gen, bar);
            __builtin_amdgcn_fence(__ATOMIC_ACQUIRE, "agent");
            asm volatile("s_waitcnt vmcnt(0)" ::: "memory");
        }
    }
    __syncthreads();
}

constexpr int HTB = 128 * 64 * 2;
DI int lds_byte(int r, int c) { const int st = (r >> 4) * 2 + (c >> 5), rr = r & 15, cc = c & 31, ob = rr * 64 + cc * 2; return st * 1024 + (ob ^ (((ob >> 9) & 1) << 5)); }
DI void stage_rc(int b, int& R, int& C) { const int st = b / 1024, sb = b % 1024, swz = sb ^ (((sb >> 9) & 1) << 5); R = (st >> 1) * 16 + swz / 64; C = (st & 1) * 32 + (swz % 64) / 2; }

DI void stage_rc_t(int tz, int i, int& R, int& C) { stage_rc(tz * 16 + i * 8192, R, C); }
struct APlain {
    const char* base; int lda2;
    DI void park(LAS unsigned*) const {} DI void unpark(const LAS unsigned*) {} DI void take_uniform(const APlain&) {}
    DI const char* ptr(int tz, int h, int i, int kt) const { int R, C; stage_rc_t(tz, i, R, C); return base + (unsigned)((h * 128 + R) * lda2 + C * 2 + kt * 128); }
};
struct ASimple {
    const char* base; unsigned off[2][2]; unsigned kstride;
    DI void park(LAS unsigned* q) const { *(LAS u32x4*)q = (u32x4){off[0][0], off[0][1], off[1][0], off[1][1]}; }
    DI void unpark(const LAS unsigned* q) { const u32x4 v = *(const LAS u32x4*)q; off[0][0] = v.x; off[0][1] = v.y; off[1][0] = v.z; off[1][1] = v.w; }
    DI void take_uniform(const ASimple& o) { base = o.base; kstride = o.kstride; }
    DI const char* ptr(int tz, int h, int i, int kt) const { return base + (unsigned)(off[h][i] + (unsigned)kt * kstride); }
};
struct ASeg2 {
    const char* base0; const char* base1; unsigned off0[2][2]; unsigned off1[2][2]; unsigned ks0; int nt0;
    DI void park(LAS unsigned*) const {} DI void unpark(const LAS unsigned*) {} DI void take_uniform(const ASeg2&) {}
    DI const char* ptr(int tz, int h, int i, int kt) const { return kt < nt0 ? base0 + (unsigned)(off0[h][i] + (unsigned)kt * ks0) : base1 + (unsigned)(off1[h][i] + (unsigned)(kt - nt0) * 128u); }
};
DI int perm32(int rho) { const int n = rho >> 4, i = rho & 15; return 8 * (i >> 2) + 4 * n + (i & 3); }
struct BSimple {
    const char* base[2]; int ldb2;
    DI const char* ptr(int tz, int h, int i, int kt) const { int R, C; stage_rc_t(tz, i, R, C); const int Rb = (R & ~31) + perm32(R & 31); return base[h] + (unsigned)(Rb * ldb2 + C * 2 + kt * 128); }
};

struct BSeq16 {
    const char* base; int ldb2;
    DI const char* ptr(int tz, int h, int i, int kt) const { int R, C; stage_rc_t(tz, i, R, C); const int rho = R & 31;
        const int Rb = (R >> 5) * 64 + ((rho & 15) >> 2) * 16 + h * 8 + (rho >> 4) * 4 + (rho & 3); return base + (unsigned)(Rb * ldb2 + C * 2 + kt * 128); }
};

#define WAIT_V(n) asm volatile("s_waitcnt vmcnt(" #n ")" ::: "memory")
#define WAIT_L(n) asm volatile("s_waitcnt lgkmcnt(" #n ")" ::: "memory")
#define BAR_ __builtin_amdgcn_s_barrier()
#define SCHED_ __builtin_amdgcn_sched_barrier(0)

DI void zero_acc(f32x4 (&acc)[2][2][4][2]) {
#pragma unroll
    for (int a = 0; a < 2; ++a)
#pragma unroll
        for (int b = 0; b < 2; ++b)
#pragma unroll
            for (int m = 0; m < 4; ++m)
#pragma unroll
                for (int n = 0; n < 2; ++n) acc[a][b][m][n] = (f32x4){0.f, 0.f, 0.f, 0.f};
}
template <int MODE> struct FragT;
template <> struct FragT<0> {
    i32x4 lo, hi;
    DI void load(const LAS char* p0, const LAS char* p1) { lo = *(const LAS i32x4*)p0; hi = *(const LAS i32x4*)p1; }
    static DI f32x4 mma(const FragT& b, const FragT& a, f32x4 c) {
        c = __builtin_amdgcn_mfma_f32_16x16x32_bf16(__builtin_bit_cast(bf16x8, b.lo), __builtin_bit_cast(bf16x8, a.lo), c, 0, 0, 0);
        return __builtin_amdgcn_mfma_f32_16x16x32_bf16(__builtin_bit_cast(bf16x8, b.hi), __builtin_bit_cast(bf16x8, a.hi), c, 0, 0, 0); }
};
template <> struct FragT<1> {
    i32x4 lo, hi;
    DI void load(const LAS char* p0, const LAS char* p1) { lo = *(const LAS i32x4*)p0; hi = *(const LAS i32x4*)p1; }
    static DI long pk(int x, int y) { return (long)(((unsigned long long)(unsigned)y << 32) | (unsigned)x); }
    static DI f32x4 mma(const FragT& b, const FragT& a, f32x4 c) {
        c = __builtin_amdgcn_mfma_f32_16x16x32_fp8_fp8(pk(b.lo.x, b.lo.y), pk(a.lo.x, a.lo.y), c, 0, 0, 0);
        c = __builtin_amdgcn_mfma_f32_16x16x32_fp8_fp8(pk(b.lo.z, b.lo.w), pk(a.lo.z, a.lo.w), c, 0, 0, 0);
        c = __builtin_amdgcn_mfma_f32_16x16x32_fp8_fp8(pk(b.hi.x, b.hi.y), pk(a.hi.x, a.hi.y), c, 0, 0, 0);
        return __builtin_amdgcn_mfma_f32_16x16x32_fp8_fp8(pk(b.hi.z, b.hi.w), pk(a.hi.z, a.hi.w), c, 0, 0, 0); }
};
template <> struct FragT<2> {
    i32x8 v;
    DI void load(const LAS char* p0, const LAS char* p1) { const i32x4 lo = *(const LAS i32x4*)p0, hi = *(const LAS i32x4*)p1; v = __builtin_shufflevector(lo, hi, 0, 1, 2, 3, 4, 5, 6, 7); }
    static DI f32x4 mma(const FragT& b, const FragT& a, f32x4 c) {
        const int one = 0x7f7f7f7f;
        asm volatile("v_mfma_scale_f32_16x16x128_f8f6f4 %0, %1, %2, %0, %3, %3 op_sel_hi:[0,0,0]" : "+v"(c) : "v"(b.v), "v"(a.v), "v"(one));
        return c; }
};
template <class PV>
DI void gemm_stream(LAS char* shm, const PV& pv, const int wv_) {
    typedef typename PV::AS AS; typedef typename PV::BS BS;
    constexpr int nt = PV::NT;
    int u = pv.first();
    if (u < 0) return;
    const int tz = otid();
    const int wr = wv_ >> 2, wc = wv_ & 3, lane = tz & 63, fr = lane & 15, fq = lane >> 4;
    const int aoff = lds_byte(wr * 64 + fr, fq * 8), boff = lds_byte(wc * 32 + fr, fq * 8);
    const unsigned ldsw = (unsigned)wv_ * 1024u;
    f32x4 acc[2][2][4][2]; zero_acc(acc);
    typedef FragT<PV::FP8> Frag;
    Frag At[4], B0[2], B1[2];
    AS ca, na; BS cb, nb;
    pv.src(u, ca, cb, wv_); pv.fix(ca, true, wv_);
    constexpr bool F8 = PV::FP8 != 0;
    LAS unsigned* park = (LAS unsigned*)(shm + 131072) + tz * 4;
    const int aoff0 = aoff, aoff1 = aoff + 1024;
    const int boff0 = boff, boff1 = boff + 1024;
#define SA_(b, h) (((b) * 2 + (h)) * HTB)
#define SB_(b, h) ((4 + (b) * 2 + (h)) * HTB)
#define STG_(bufoff, S, h, kt) do { _Pragma("unroll") for (int i_ = 0; i_ < 2; ++i_) glds16((S).ptr(tz, h, i_, kt), shm + (bufoff) + ldsw + i_ * 8192); } while (0)
#define LDA_(dst, b, h) do { _Pragma("unroll") for (int m = 0; m < 4; ++m) dst[m].load(shm + SA_(b, h) + aoff0 + m * 2048, shm + SA_(b, h) + aoff1 + m * 2048); } while (0)
#define LDB_(dst, b, h) do { _Pragma("unroll") for (int n = 0; n < 2; ++n) dst[n].load(shm + SB_(b, h) + boff0 + n * 2048, shm + SB_(b, h) + boff1 + n * 2048); } while (0)
#define MMAS_(ai, bj, A_, B_, STGSTMT) do { __builtin_amdgcn_s_setprio(1); \
        acc[ai][bj][0][0] = Frag::mma(B_[0], A_[0], acc[ai][bj][0][0]); acc[ai][bj][0][1] = Frag::mma(B_[1], A_[0], acc[ai][bj][0][1]); \
        STGSTMT; \
        _Pragma("unroll") for (int m = 1; m < 4; ++m) _Pragma("unroll") for (int n = 0; n < 2; ++n) { \
            acc[ai][bj][m][n] = Frag::mma(B_[n], A_[m], acc[ai][bj][m][n]); } \
        __builtin_amdgcn_s_setprio(0); } while (0)
    STG_(SB_(0, 0), cb, 0, 0); STG_(SA_(0, 0), ca, 0, 0); STG_(SB_(0, 1), cb, 1, 0); STG_(SA_(0, 1), ca, 1, 0);
    if (wr == 1) BAR_;
    WAIT_V(4); BAR_;
    STG_(SB_(1, 0), cb, 0, 1); STG_(SA_(1, 0), ca, 0, 1); STG_(SB_(1, 1), cb, 1, 1);
    WAIT_V(6); BAR_;
#define ZQ_(ai, bj) do { _Pragma("unroll") for (int m_ = 0; m_ < 4; ++m_) _Pragma("unroll") for (int n_ = 0; n_ < 2; ++n_) acc[ai][bj][m_][n_] = (f32x4){0.f, 0.f, 0.f, 0.f}; } while (0)
    int un = -1; bool has_next = false;
    na = ca; nb = cb;
    for (;;) {
        typename PV::Aux aux;
#pragma clang loop unroll(disable)
        for (int t = 0; t < nt; t += 2) {
            const bool last = (t == nt - 2);
            if (last && has_next) pv.fix(na, false, wv_);
            AS a2 = last ? na : ca; const BS b2 = last ? nb : cb; const int k2 = last ? 0 : t + 2;
            LDB_(B0, 0, 0); SCHED_; LDA_(At, 0, 0);
            if (t == 0) ZQ_(0, 0);
            WAIT_L(8); BAR_; WAIT_L(0); MMAS_(0, 0, At, B0, STG_(SA_(1, 1), ca, 1, t + 1)); BAR_; SCHED_;
            LDB_(B1, 0, 1);
            if (t == 0) { ZQ_(0, 1); pv.top(u, aux, wv_); }
            BAR_; WAIT_L(0); MMAS_(0, 1, At, B1, STG_(SB_(0, 0), b2, 0, k2)); BAR_;
            LDA_(At, 0, 1);
            if (t == 0) ZQ_(1, 0);
            BAR_; WAIT_L(0); MMAS_(1, 0, At, B0, STG_(SA_(0, 0), a2, 0, k2)); BAR_; SCHED_;
            if (t == 0) ZQ_(1, 1);
            WAIT_V(4); BAR_; if (t == 0) pv.mid(aux, wv_); MMAS_(1, 1, At, B1, STG_(SB_(0, 1), b2, 1, k2)); BAR_;
            LDB_(B0, 1, 0); SCHED_; LDA_(At, 1, 0);
            WAIT_L(8); BAR_; WAIT_L(0); MMAS_(0, 0, At, B0, STG_(SA_(0, 1), a2, 1, k2)); BAR_; SCHED_;
            LDB_(B1, 1, 1);
            BAR_; WAIT_L(0); MMAS_(0, 1, At, B1, STG_(SB_(1, 0), b2, 0, k2 + 1)); BAR_;
            LDA_(At, 1, 1);
            BAR_; WAIT_L(0); MMAS_(1, 0, At, B0, STG_(SA_(1, 0), a2, 0, k2 + 1)); BAR_; SCHED_;
            WAIT_V(4);
            if (t == 0) { un = pv.next(u); has_next = un >= 0; if (has_next) pv.src(un, na, nb, wv_); else { na = ca; nb = cb; } }
            BAR_; MMAS_(1, 1, At, B1, STG_(SB_(1, 1), b2, 1, k2 + 1)); BAR_;
        }
        if (PV::FP8 == 2) asm volatile("s_nop 15\n\ts_nop 15" ::: "memory");
        pv.epi(acc, u, wv_);
        if (!has_next) break;
        u = un; ca = na; cb = nb;
    }
#undef ZQ_
    WAIT_V(0);
    if (wr == 0) BAR_;
    BAR_;
#undef SA_
#undef SB_
#undef STG_
#undef LDA_
#undef LDB_
#undef MMAS_
}
DI int lin_first(int shift, int count) { const int G = gridDim.x; const int u = (int)((blockIdx.x + G - (shift % G)) % G); return u < count ? u : -1; }
DI int lin_next(int u, int count) { const int un = u + (int)gridDim.x; return un < count ? un : -1; }
template <int MG, int NTL> struct XcdDeal {
    int MT;
    DI bool decode(int J, int& mt, int& nt) const { const int x = blockIdx.x & 7; const int grp = (J / (MG * NTL)) * 8 + x, w = J % (MG * NTL); mt = grp * MG + w / NTL; nt = w % NTL; return mt < MT; }
    DI int jmax() const { return ((MT + 8 * MG - 1) / (8 * MG)) * (MG * NTL); }
    DI int first() const { int J = blockIdx.x >> 3; const int per = gridDim.x >> 3, jm = jmax(); int mt, nt;
        while (J < jm && !decode(J, mt, nt)) J += per;
        return J < jm ? J : -1; }
    DI int next(int J) const { const int per = gridDim.x >> 3, jm = jmax(); int mt, nt; J += per;
        while (J < jm && !decode(J, mt, nt)) J += per;
        return J < jm ? J : -1; }
};
DI int first_unit(int shift) { const int G = gridDim.x; return (int)((blockIdx.x + G - (shift % G)) % G); }

DI void stage_coords(int (&R)[2], int (&C)[2], const int wv_) {
    const int t_ = otid();
#pragma unroll
    for (int i = 0; i < 2; ++i) stage_rc(t_ * 16 + i * 8192, R[i], C[i]);
}
DI APlain make_a_plain(const bf16_t* A, size_t row0, int lda, int col0) {
    APlain a; a.base = (const char*)(A + row0 * (size_t)lda + col0); a.lda2 = lda * 2; return a;
}
DI BSimple make_b(const bf16_t* Bt0, const bf16_t* Bt1, int ldb) {
    BSimple b; b.base[0] = (const char*)Bt0; b.base[1] = (const char*)Bt1; b.ldb2 = ldb * 2; return b;
}
#define EPI_FOR(acc, ...) do { const int _tz = otid(), _w = _tz >> 6, _l = _tz & 63, _wr = _w >> 2, _wc = _w & 3, _fr = _l & 15, _fq = _l >> 4; \
    _Pragma("unroll") for (int ai = 0; ai < 2; ++ai) _Pragma("unroll") for (int m = 0; m < 4; ++m) { const int lr = ai * 128 + _wr * 64 + m * 16 + _fr; \
    _Pragma("unroll") for (int bj = 0; bj < 2; ++bj) _Pragma("unroll") for (int n = 0; n < 2; ++n) { const int lc = bj * 128 + _wc * 32 + n * 16 + _fq * 4; const f32x4 v = acc[ai][bj][m][n]; __VA_ARGS__ } } } while (0)

DI void store_bf16x4(bf16_t* p, float a, float b, float c, float d) { u32x2 v; v.x = pk_bf16(a, b); v.y = pk_bf16(c, d); *(u32x2*)p = v; }
DI void store_bf16x8(bf16_t* p, const f32x4 a, const f32x4 b) { u32x4 v; v.x = pk_bf16(a[0], a[1]); v.y = pk_bf16(a[2], a[3]); v.z = pk_bf16(b[0], b[1]); v.w = pk_bf16(b[2], b[3]); *(u32x4*)p = v; }
#define EPI_FOR8(acc, ...) do { const int _tz = otid(), _w = _tz >> 6, _l = _tz & 63, _wr = _w >> 2, _wc = _w & 3, _fr = _l & 15, _fq = _l >> 4; \
    _Pragma("unroll") for (int ai = 0; ai < 2; ++ai) _Pragma("unroll") for (int m = 0; m < 4; ++m) { const int lr = ai * 128 + _wr * 64 + m * 16 + _fr; \
    _Pragma("unroll") for (int bj = 0; bj < 2; ++bj) { const int lc = bj * 128 + _wc * 32 + _fq * 8; const f32x4 v0 = acc[ai][bj][m][0], v1 = acc[ai][bj][m][1]; __VA_ARGS__ } } } while (0)

DI int mod_row(int r) { return r < TX ? (r >> 11) : 32; }
DI int crow_tok(int cr) { const int b = cr / NCH, j = cr - b * NCH; return j < 4 ? TX + b * CTXL + j * 64 : b * SEQ + (j - 4) * 64; }

DI void cvt_tile(LAS char* wl  , const float* src, int ld_src, int kvalid, int nvalid, const float* scale, bf16_t* dst, int ld_dst, const int wv_) {
    const int lane = otid() & 63;
    const int lr = lane >> 4, lc = (lane & 15) * 4;
    f32x4 v[16];
#pragma unroll
    for (int it = 0; it < 16; ++it) {
        const int k = it * 4 + lr;
        v[it] = (f32x4){0.f, 0.f, 0.f, 0.f};
        if (src != nullptr && k < kvalid && lc < nvalid) { v[it] = *(const f32x4*)(src + (size_t)k * ld_src + lc); if (scale) { const float s = scale[k]; v[it] *= s; } }
    }
#pragma unroll
    for (int it = 0; it < 16; ++it) {
        const int k = it * 4 + lr;
#pragma unroll
        for (int j = 0; j < 4; ++j) *(LAS bf16_t*)(wl + (lc + j) * 144 + k * 2) = f2bf(v[it][j]);
    }
    asm volatile("s_waitcnt lgkmcnt(0)" ::: "memory");
#pragma unroll
    for (int i = 0; i < 8; ++i) {
        const int q = i * 64 + lane, n = q >> 3, c = q & 7;
        const u32x4 w = *(const LAS u32x4*)(wl + n * 144 + c * 16);
        *(u32x4*)(dst + (size_t)n * ld_dst + c * 8) = w;
    }
    asm volatile("s_waitcnt lgkmcnt(0)" ::: "memory");
}
DI void cvt_tile8(LAS char* wl  , const float* src, int ld_src, unsigned char* dst, int ld_dst, const int wv_) {
    const int lane = otid() & 63;
    const int lr = lane >> 4, lc = (lane & 15) * 4;
    f32x4 v[16];
#pragma unroll
    for (int it = 0; it < 16; ++it) v[it] = *(const f32x4*)(src + (size_t)(it * 4 + lr) * ld_src + lc);
#pragma unroll
    for (int it = 0; it < 16; ++it) {
        const int k = it * 4 + lr;
#pragma unroll
        for (int j = 0; j < 4; ++j) *(LAS unsigned char*)(wl + (lc + j) * 80 + k) = (unsigned char)f2fp8(v[it][j] * 256.f);
    }
    asm volatile("s_waitcnt lgkmcnt(0)" ::: "memory");
#pragma unroll
    for (int i = 0; i < 4; ++i) {
        const int q = i * 64 + lane, n = q >> 2, c = q & 3;
        const u32x4 w = *(const LAS u32x4*)(wl + n * 80 + c * 16);
        *(u32x4*)(dst + (size_t)n * ld_dst + c * 16) = w;
    }
    asm volatile("s_waitcnt lgkmcnt(0)" ::: "memory");
}
constexpr int CVT_SMALL_TILES = 768 + 512 + 32 + 32 + 64 + 64 + 32;
constexpr int CVT_EXP_TILES = 32 * (32 * 16 + 16 * 16);
DI void cvt_small(const Params& p, LAS char* wl, int t, const int wv_) {
    char* ws = p.ws;
    if (t < 768) { const int l = t / 384, r = t % 384, nt = r / 16, kt = r % 16;
        cvt_tile(wl, p.w_mix_in + (size_t)l * 1024 * N_IN + (size_t)kt * 64 * N_IN + nt * 64, N_IN, 64, N_IN - nt * 64, nullptr,
                 (bf16_t*)(ws + WS_WMI) + ((size_t)l * 1536 + nt * 64) * 1024 + kt * 64, 1024, wv_); return; }
    t -= 768;
    if (t < 512) { const int l = t / 256, r = t % 256, nt = r / 16, kt = r % 16;
        cvt_tile(wl, p.w_mix_out + (size_t)l * 1024 * 1024 + (size_t)kt * 64 * 1024 + nt * 64, 1024, 64, 64, nullptr,
                 (bf16_t*)(ws + WS_WMO) + ((size_t)l * 1024 + nt * 64) * 1024 + kt * 64, 1024, wv_); return; }
    t -= 512;
    if (t < 32) { const int l = t / 16, r = t % 16, nt = r / 4, kt = r % 4;
        cvt_tile(wl, p.conv_pw + (size_t)l * 65536 + (size_t)kt * 64 * 256 + nt * 64, 256, 64, 64, nullptr,
                 (bf16_t*)(ws + WS_WPW) + ((size_t)l * 256 + nt * 64) * 256 + kt * 64, 256, wv_); return; }
    t -= 32;
    if (t < 32) { const int l = t / 16, r = t % 16, nt = r / 4, kt = r % 4;
        cvt_tile(wl, p.ssm_glu_w + (size_t)l * 65536 + (size_t)kt * 64 * 256 + nt * 64, 256, 64, 64, nullptr,
                 (bf16_t*)(ws + WS_WGLU) + ((size_t)l * 256 + nt * 64) * 256 + kt * 64, 256, wv_); return; }
    t -= 32;
    if (t < 64) { const int l = t / 32, r = t % 32, nt = r / 4, kt = r % 4;
        const bool any = (kt < 3) && (nt < 6);
        cvt_tile(wl, any ? p.mla_wq_b + (size_t)l * 192 * 384 + (size_t)kt * 64 * 384 + nt * 64 : nullptr, 384, 64, 64, p.mla_q_a_g + l * 192 + kt * 64,
                 (bf16_t*)(ws + WS_WQ) + ((size_t)l * 512 + nt * 64) * 256 + kt * 64, 256, wv_); return; }
    t -= 64;
    if (t < 64) { const int l = t / 32, r = t % 32, nt = r / 4, kt = r % 4;
        const bool any = (kt < 2);
        cvt_tile(wl, any ? p.mla_wkv_b + (size_t)l * 128 * 512 + (size_t)kt * 64 * 512 + nt * 64 : nullptr, 512, 64, 64, p.mla_kv_a_g + l * 128 + kt * 64,
                 (bf16_t*)(ws + WS_WKV) + ((size_t)l * 512 + nt * 64) * 256 + kt * 64, 256, wv_); return; }
    t -= 64;
    { const int l = t / 16, r = t % 16, nt = r / 4, kt = r % 4;
        cvt_tile(wl, nt == kt ? p.pool_w + ((size_t)l * 4 + nt) * 4096 : nullptr, 64, 64, 64, nullptr,
                 (bf16_t*)(ws + WS_WPOOL) + ((size_t)l * 256 + nt * 64) * 256 + kt * 64, 256, wv_); }
}
DI void cvt_expert(const Params& p, LAS char* wl, int l, int t, const int wv_) {
    char* ws = p.ws;
    const int e = t / 768, r = t % 768;
    if (r < 512) { const int nt = r / 16, kt = r % 16;
        cvt_tile8(wl, p.exp_w_in + ((size_t)(l * NE + e) * 1024 + kt * 64) * 2048 + nt * 64, 2048,
                  (unsigned char*)(ws + WS_W1) + ((size_t)(l * NE + e) * 2048 + nt * 64) * 1024 + kt * 64, 1024, wv_);
    } else { const int q = r - 512, nt = q / 16, kt = q % 16;
        cvt_tile8(wl, p.exp_w_out + ((size_t)(l * NE + e) * 1024 + kt * 64) * 1024 + nt * 64, 1024,
                  (unsigned char*)(ws + WS_W2) + ((size_t)(l * NE + e) * 1024 + nt * 64) * 1024 + kt * 64, 1024, wv_);
    }
}

DI void ada_unit(const Params& p, LAS char* shm, int u, const int wv_) {
    const int tid = otid();
    const int l = u / 48, jc = u % 48;
    LAS float* sc = (LAS float*)shm;
    for (int i = tid; i < 33 * 1024; i += 512) { const int r = i >> 10, k = i & 1023; const float v = r < 32 ? p.c[r * 1024 + k] : p.c_ctx[k]; sc[i] = siluf_(v); }
    __syncthreads();
    const int col = tid & 127, kq = tid >> 7;
    float acc[33];
#pragma unroll
    for (int r = 0; r < 33; ++r) acc[r] = 0.f;
    const float* wp = p.ada_w + ((size_t)l * 1024 + kq * 256) * 6144 + jc * 128 + col;
    for (int k4 = 0; k4 < 256; k4 += 4) {
        float w[4];
#pragma unroll
        for (int i = 0; i < 4; ++i) w[i] = wp[(size_t)(k4 + i) * 6144];
#pragma unroll
        for (int r = 0; r < 33; ++r) { const f32x4 s = *(const LAS f32x4*)(sc + r * 1024 + kq * 256 + k4); acc[r] += s[0] * w[0] + s[1] * w[1] + s[2] * w[2] + s[3] * w[3]; }
    }
    __syncthreads();
    LAS float* red = (LAS float*)shm;
#pragma unroll
    for (int r = 0; r < 33; ++r) red[(kq * 33 + r) * 128 + col] = acc[r];
    __syncthreads();
    for (int i = tid; i < 33 * 128; i += 512) { const int r = i >> 7, cc = i & 127;
        const float s = red[(0 * 33 + r) * 128 + cc] + red[(1 * 33 + r) * 128 + cc] + red[(2 * 33 + r) * 128 + cc] + red[(3 * 33 + r) * 128 + cc];
        ((float*)(p.ws + WS_MOD))[((size_t)l * 33 + r) * 6144 + jc * 128 + cc] = s + p.ada_b[l * 6144 + jc * 128 + cc]; }
    __syncthreads();
}

DI void s5_load_bc(const Params& p, LAS float* bb, LAS float* cc, int l, int dir, int g, int tid) {
    const int pbase = ((l * 2 + dir) * 16 + g) * 64;
    const double dt = exp((double)p.ssm_log_dt[(l * 2 + dir) * 16 + g]);
    for (int i = tid; i < 64 * 16; i += 512) { const int q = i >> 4, ci = i & 15;
        const double are = fmin((double)p.ssm_a_re[pbase + q], -1e-4), aim = (double)p.ssm_a_im[pbase + q];
        const double mg = exp(are * dt), abr = mg * cos(aim * dt), abi = mg * sin(aim * dt), den = are * are + aim * aim;
        const double fre = ((abr - 1.0) * are + abi * aim) / den, fim = (abi * are - (abr - 1.0) * aim) / den;
        const double br = (double)p.ssm_b_re[(size_t)(pbase + q) * 16 + ci], bi = (double)p.ssm_b_im[(size_t)(pbase + q) * 16 + ci];
        bb[i * 2] = (float)(fre * br - fim * bi); bb[i * 2 + 1] = (float)(fre * bi + fim * br); }
    for (int i = tid; i < 16 * 64; i += 512) { const int co = i >> 6, q = i & 63;
        const size_t ix = ((size_t)((l * 2 + dir) * 16 + g) * 16 + co) * 64 + q;
        cc[i * 2] = p.ssm_c_re[ix]; cc[i * 2 + 1] = p.ssm_c_im[ix]; }
}
DI void s5pre_unit(const Params& p, LAS char* shm, int u, const int wv_) {
    const int tid = otid();
    const int l = u >> 5, g = (u >> 1) & 15, dir = u & 1;
    LAS float* pw = (LAS float*)shm;
    LAS float* bb = pw + 65 * 64 * 2;
    LAS float* cc = bb + 64 * 16 * 2;
    LAS float* kk = cc + 16 * 64 * 2;
    LAS float* k0o = kk + 64 * 256;
    bf16_t* TS = (bf16_t*)(p.ws + WS_TS5) + (size_t)(l * 16 + g) * 1024 * 1280;
    bf16_t* WS = (bf16_t*)(p.ws + WS_WS5) + (size_t)(l * 16 + g) * 256 * 1024;
    const int cocip = tid & 255, co_ = cocip >> 4, ci_ = cocip & 15;
    if (dir == 0) {
        s5_load_bc(p, bb, cc, l, 1, g, tid);
        __syncthreads();
        if (tid < 256) { float s_ = 0.f;
            for (int q = 0; q < 64; ++q) s_ += cc[(co_ * 64 + q) * 2] * bb[(q * 16 + ci_) * 2] - cc[(co_ * 64 + q) * 2 + 1] * bb[(q * 16 + ci_) * 2 + 1];
            k0o[tid] = s_; }
        __syncthreads();
    }
    {
        const int pbase = ((l * 2 + dir) * 16 + g) * 64;
        const double dt = exp((double)p.ssm_log_dt[(l * 2 + dir) * 16 + g]);
        for (int i = tid; i < 65 * 64; i += 512) { const int tau = i >> 6, q = i & 63;
            const double are = fmin((double)p.ssm_a_re[pbase + q], -1e-4), aim = (double)p.ssm_a_im[pbase + q];
            const double mg = exp(are * dt * tau), an = aim * dt * tau;
            pw[i * 2] = (float)(mg * cos(an)); pw[i * 2 + 1] = (float)(mg * sin(an)); }
        s5_load_bc(p, bb, cc, l, dir, g, tid);
        __syncthreads();
        if (tid < 64) { float* a64 = (float*)(p.ws + WS_A64) + (size_t)(((l * 2 + dir) * 16 + g) * 64 + tid) * 2; a64[0] = pw[(64 * 64 + tid) * 2]; a64[1] = pw[(64 * 64 + tid) * 2 + 1]; }
        { float gr[64], gi[64];
#pragma unroll
          for (int q = 0; q < 64; ++q) { const float cr = cc[(co_ * 64 + q) * 2], cim = cc[(co_ * 64 + q) * 2 + 1], br = bb[(q * 16 + ci_) * 2], bi = bb[(q * 16 + ci_) * 2 + 1];
              gr[q] = cr * br - cim * bi; gi[q] = cr * bi + cim * br; }
          for (int tau = (tid >> 8); tau < 64; tau += 2) {
              float s_ = 0.f;
#pragma unroll
              for (int q = 0; q < 64; ++q) s_ += gr[q] * pw[(tau * 64 + q) * 2] - gi[q] * pw[(tau * 64 + q) * 2 + 1];
              kk[tau * 256 + cocip] = s_;
          } }
        for (int i = tid; i < 128 * 512; i += 512) { const int row = i >> 9, kp = (i & 511) * 2, ri = row >> 6, q = row & 63, s_ = kp >> 4, ci = kp & 15;
            const int e = dir == 0 ? 63 - s_ : s_;
            const float pr = pw[(e * 64 + q) * 2], pi = pw[(e * 64 + q) * 2 + 1];
            float o[2];
#pragma unroll
            for (int j = 0; j < 2; ++j) { const float br = bb[(q * 16 + ci + j) * 2], bi = bb[(q * 16 + ci + j) * 2 + 1]; o[j] = ri == 0 ? pr * br - pi * bi : pr * bi + pi * br; }
            *(unsigned*)(WS + (size_t)(dir * 128 + row) * 1024 + kp) = pk_bf16(o[0], o[1]); }
        for (int i = tid; i < 1024 * 64; i += 512) { const int row = i >> 6, kp = (i & 63) * 2, t = row >> 4, co = row & 15, ri = kp >> 6, q = kp & 63;
            const int e = dir == 0 ? t + 1 : 64 - t;
            float o[2];
#pragma unroll
            for (int j = 0; j < 2; ++j) { const float pr = pw[(e * 64 + q + j) * 2], pi = pw[(e * 64 + q + j) * 2 + 1];
                const float cr = cc[(co * 64 + q + j) * 2], cim = cc[(co * 64 + q + j) * 2 + 1];
                o[j] = ri == 0 ? (cr * pr - cim * pi) : -(cr * pi + cim * pr); }
            *(unsigned*)(TS + (size_t)row * 1280 + 1024 + dir * 128 + kp) = pk_bf16(o[0], o[1]); }
        __syncthreads();
        for (int rr = tid; rr < 1024; rr += 512) { const int t = rr >> 4, co = rr & 15;
            const float dco = p.ssm_d[l * 256 + g * 16 + co];
            bf16_t* rowp = TS + (size_t)rr * 1280;
            const int s_lo = dir == 0 ? 0 : t + 1, s_hi = dir == 0 ? t : 63;
            for (int s_ = s_lo; s_ <= s_hi; ++s_) { const int tau = dir == 0 ? t - s_ : s_ - t;
                unsigned w[8];
#pragma unroll
                for (int j = 0; j < 8; ++j) { float a = kk[tau * 256 + co * 16 + 2 * j], b2 = kk[tau * 256 + co * 16 + 2 * j + 1];
                    if (s_ == t) { a += k0o[co * 16 + 2 * j]; b2 += k0o[co * 16 + 2 * j + 1]; if (2 * j == co) a += dco; if (2 * j + 1 == co) b2 += dco; }
                    w[j] = pk_bf16(a, b2); }
                *(u32x4*)(rowp + s_ * 16) = (u32x4){w[0], w[1], w[2], w[3]}; *(u32x4*)(rowp + s_ * 16 + 8) = (u32x4){w[4], w[5], w[6], w[7]}; }
        }
        __syncthreads();
    }
}

DI void phase_prologue(const Params& p, LAS char* shm, const int wv_) {
    const int tid = otid();
    __syncthreads();
    if (blockIdx.x == 0 && tid < 64) ((int*)(p.ws + WS_CNT))[tid] = 0;
    const int n_cvt = (CVT_SMALL_TILES + 2 * CVT_EXP_TILES + 7) / 8;
    const int n_units = 64 + 96 + n_cvt;
    for (int u = blockIdx.x; u < n_units; u += gridDim.x) {
        if (u < 64) s5pre_unit(p, shm, u, wv_);
        else if (u < 160) ada_unit(p, shm, u - 64, wv_);
        else {
            const int t = (u - 160) * 8 + (tid >> 6);
            LAS char* wl = shm + (tid >> 6) * (64 * 144);
            if (t < CVT_SMALL_TILES) cvt_small(p, wl, t, wv_);
            else if (t < CVT_SMALL_TILES + 2 * CVT_EXP_TILES) { const int te = t - CVT_SMALL_TILES; cvt_expert(p, wl, te / CVT_EXP_TILES, te % CVT_EXP_TILES, wv_); }
        }
    }
}

DI void norm_mod_store(const float (&v)[16], const float* g, const float* modrow  , bf16_t* hrow, const int wv_) {
    const int lane = otid() & 63;
    float ss = 0.f;
#pragma unroll
    for (int i = 0; i < 16; ++i) ss += v[i] * v[i];
    ss = wave_sum(ss);
    const float rn = rsqrtf(ss * (1.f / 1024.f) + EPS);
#pragma unroll
    for (int j = 0; j < 4; ++j) {
        const int col = j * 256 + lane * 4;
        const f32x4 gg = *(const f32x4*)(g + col), sh = *(const f32x4*)(modrow + col), sc = *(const f32x4*)(modrow + 1024 + col);
        float o[4];
#pragma unroll
        for (int i = 0; i < 4; ++i) o[i] = v[j * 4 + i] * rn * gg[i] * (1.f + sc[i]) + sh[i];
        store_bf16x4(hrow + col, o[0], o[1], o[2], o[3]);
    }
}
DI void phase_norm1_l0(const Params& p, const int wv_) {
    const int tid_ = otid(); const int wid = tid_ >> 6, lane = tid_ & 63;
    const float* MOD = (const float*)(p.ws + WS_MOD);
    bf16_t* H = (bf16_t*)(p.ws + WS_H);
    for (int r = blockIdx.x * 8 + wid; r < TT; r += gridDim.x * 8) {
        const float* src = r < TX ? p.x + (size_t)r * 1024 : p.ctx + (size_t)(r - TX) * 1024;
        float v[16];
#pragma unroll
        for (int j = 0; j < 4; ++j) { const f32x4 t = *(const f32x4*)(src + j * 256 + lane * 4); v[j * 4] = t[0]; v[j * 4 + 1] = t[1]; v[j * 4 + 2] = t[2]; v[j * 4 + 3] = t[3]; }
        norm_mod_store(v, p.norm1_g, MOD + (size_t)(0 * 33 + mod_row(r)) * 6144, H + (size_t)r * 1024, wv_);
    }
}

struct PvInproj {
    const Params& p; int l;
    PV_NOHOOKS
    static constexpr int NT = 16; static constexpr int FP8 = 0; static constexpr bool PARK = false; typedef APlain AS; typedef BSimple BS;
    XcdDeal<4, 6> deal;
    DI int first() const { return deal.first(); }
    DI int next(int u) const { return deal.next(u); }
    DI void src(int u, AS& a, BS& b, const int wv_) const {
        int mt, nt; deal.decode(u, mt, nt);
        const bf16_t* W = (const bf16_t*)(p.ws + WS_WMI) + (size_t)l * 1536 * 1024;
        a = make_a_plain((const bf16_t*)(p.ws + WS_H), (size_t)mt * 256, 1024, 0);
        b = nt < 2 ? make_b(W + (size_t)(nt * 128) * 1024, W + (size_t)(256 + nt * 128) * 1024, 1024)
                   : make_b(W + (size_t)(nt * 256) * 1024, W + (size_t)(nt * 256 + 128) * 1024, 1024);
    }
    DI void epi(f32x4 (&acc)[2][2][4][2], int u, const int wv_) const {
        int mt, nt; deal.decode(u, mt, nt);
        bf16_t* P = (bf16_t*)(p.ws + WS_P);
        if (nt < 2) {
            const int _tz = otid(), _w = _tz >> 6, _l = _tz & 63, _wr = _w >> 2, _wc = _w & 3, _fr = _l & 15, _fq = _l >> 4;
#pragma unroll
            for (int ai = 0; ai < 2; ++ai)
#pragma unroll
                for (int m = 0; m < 4; ++m) { const int lr = ai * 128 + _wr * 64 + m * 16 + _fr; const int lc = _wc * 32 + _fq * 8;
                    f32x4 o0, o1;
#pragma unroll
                    for (int r = 0; r < 4; ++r) { o0[r] = acc[ai][0][m][0][r] * sigmoidf_(acc[ai][1][m][0][r]); o1[r] = acc[ai][0][m][1][r] * sigmoidf_(acc[ai][1][m][1][r]); }
                    store_bf16x8(P + (size_t)(mt * 256 + lr) * NINP + nt * 128 + lc, o0, o1); }
        } else {
            EPI_FOR8(acc, { store_bf16x8(P + (size_t)(mt * 256 + lr) * NINP + nt * 256 + lc, v0, v1); });
        }
    }
};
DI void phase_inproj(const Params& p, LAS char* shm, int l, const int wv_) {
    PvInproj pv{p, l, {TT / 256}};
    gemm_stream(shm, pv, wv_);
}

template <int N> DI void wave_sum_n(float (&v)[N]) {
    const int l4 = olane();
#pragma unroll
    for (int o = 32; o > 0; o >>= 1) {
        float t_[N];
#pragma unroll
        for (int i = 0; i < N; ++i) t_[i] = __int_as_float(__builtin_amdgcn_ds_bpermute((l4 ^ o) << 2, __float_as_int(v[i])));
#pragma unroll
        for (int i = 0; i < N; ++i) v[i] += t_[i];
    }
}
template <int WIN, bool EDGE>
DI void pool_run(const LAS bf16_t* pin  , bf16_t* AP, int row0, int ts0, int L, int c, int half) {
    for (int blk = 0; blk < 2; ++blk) {
        const int t0 = half * 32 + blk * 16;
        float in[16 + WIN - 1];
#pragma unroll
        for (int i = 0; i < 16 + WIN - 1; ++i) in[i] = bf2f(pin[(t0 + i - WIN / 2 + 8) * 256 + c]);
        float sum = 0.f;
#pragma unroll
        for (int j = 0; j < WIN; ++j) sum += in[j];
#pragma unroll
        for (int o = 0; o < 16; ++o) {
            float inv = 1.f / (float)WIN;
            if (EDGE) { const int ts = ts0 + t0 + o; const int lo = max(ts - WIN / 2, 0), hi = min(ts + WIN - 1 - WIN / 2, L - 1); inv = 1.f / (float)(hi - lo + 1); }
            AP[(size_t)(row0 + t0 + o) * 256 + c] = f2bf(sum * inv - in[o + WIN / 2]);
            if (o < 15) sum += in[o + WIN] - in[o];
        }
    }
}
template <bool EDGE>
DI void pre_unit_t(const Params& p, LAS char* shm, int l, int row0, int ts0, int L, const float (&w)[31], const float bias, const int wv_) {
    const int tid = otid();
    const bf16_t* P = (const bf16_t*)(p.ws + WS_P);
    const int c = tid & 255, half = tid >> 8;
    LAS bf16_t* cin = (LAS bf16_t*)shm;
    LAS float* cv = (LAS float*)(shm + 49152);
    u32x4 creg[6], preg[5];
#pragma unroll
    for (int it = 0; it < 6; ++it) { const int q = it * 512 + tid, row = q >> 5, part = q & 31; const int ts = ts0 - 15 + row;
        creg[it] = (u32x4){0u, 0u, 0u, 0u};
        if (q < 94 * 32 && (!EDGE || (ts >= 0 && ts < L))) creg[it] = *(const u32x4*)(P + (size_t)(row0 - 15 + row) * NINP + part * 8); }
#pragma unroll
    for (int it = 0; it < 5; ++it) { const int q = it * 512 + tid, row = q >> 5, part = q & 31; const int ts = ts0 - 8 + row;
        preg[it] = (u32x4){0u, 0u, 0u, 0u};
        if (!EDGE || (ts >= 0 && ts < L)) preg[it] = *(const u32x4*)(P + (size_t)(row0 - 8 + row) * NINP + OFF_POOL + part * 8); }
#pragma unroll
    for (int it = 0; it < 6; ++it) { const int q = it * 512 + tid; if (q < 94 * 32) *(LAS u32x4*)(cin + q * 8) = creg[it]; }
    __syncthreads();
    {
        const int t0 = half * 32;
        float in[62];
#pragma unroll
        for (int i = 0; i < 62; ++i) in[i] = bf2f(cin[(t0 + i) * 256 + c]);
#pragma unroll
        for (int o = 0; o < 32; ++o) { float s_ = bias;
#pragma unroll
            for (int j = 0; j < 31; ++j) s_ += w[j] * in[o + j];
            cv[(t0 + o) * 257 + c] = s_; }
    }
    __syncthreads();
#pragma unroll
    for (int it = 0; it < 5; ++it) *(LAS u32x4*)(cin + (it * 512 + tid) * 8) = preg[it];
    {
        const int wid = tid >> 6, lane = tid & 63;
        bf16_t* AC = (bf16_t*)(p.ws + WS_ACONV);
        float lg[4], lb[4];
#pragma unroll
        for (int j = 0; j < 4; ++j) { lg[j] = p.conv_ln_g[l * 256 + lane + 64 * j]; lb[j] = p.conv_ln_b[l * 256 + lane + 64 * j]; }
        float x[8][4], s8[8];
#pragma unroll
        for (int i = 0; i < 8; ++i) { s8[i] = 0.f;
#pragma unroll
            for (int j = 0; j < 4; ++j) { x[i][j] = cv[(wid * 8 + i) * 257 + lane + 64 * j]; s8[i] += x[i][j]; } }
        wave_sum_n<8>(s8);
#pragma unroll
        for (int i = 0; i < 8; ++i) { const float mu = s8[i] * (1.f / 256.f); s8[i] = 0.f;
#pragma unroll
            for (int j = 0; j < 4; ++j) { x[i][j] -= mu; s8[i] += x[i][j] * x[i][j]; } }
        wave_sum_n<8>(s8);
#pragma unroll
        for (int i = 0; i < 8; ++i) { const float rs = rsqrtf(s8[i] * (1.f / 256.f) + EPS);
#pragma unroll
            for (int j = 0; j < 4; ++j) { const float y = x[i][j] * rs * lg[j] + lb[j]; AC[(size_t)(row0 + wid * 8 + i) * 256 + lane + 64 * j] = f2bf(siluf_(y)); } }
    }
    __syncthreads();
    {
        bf16_t* AP = (bf16_t*)(p.ws + WS_APOOL);
        const int g = __builtin_amdgcn_readfirstlane(c >> 6);
        if (g == 0) pool_run<2, EDGE>(cin, AP, row0, ts0, L, c, half);
        else if (g == 1) pool_run<4, EDGE>(cin, AP, row0, ts0, L, c, half);
        else if (g == 2) pool_run<8, EDGE>(cin, AP, row0, ts0, L, c, half);
        else pool_run<16, EDGE>(cin, AP, row0, ts0, L, c, half);
    }
    __syncthreads();
}
DI void pre_unit(const Params& p, LAS char* shm, int l, int tile, const float (&w)[31], const float bias, const int wv_) {
    int row0, ts0, L;
    if (tile < 1024) { row0 = tile * 64; ts0 = row0 & 2047; L = SEQ; } else { row0 = TX + (tile - 1024) * 64; ts0 = (row0 - TX) & 255; L = CTXL; }
    if (ts0 >= 16 && ts0 + 64 + 16 <= L) pre_unit_t<false>(p, shm, l, row0, ts0, L, w, bias, wv_);
    else pre_unit_t<true>(p, shm, l, row0, ts0, L, w, bias, wv_);
}
struct PvS5State {
    const Params& p; int l;
    PV_NOHOOKS
    static constexpr int NT = 16; static constexpr int FP8 = 0; static constexpr bool PARK = false; typedef ASimple AS; typedef BSimple BS;
    DI int first() const { return lin_first(0, 80); }
    DI int next(int u) const { return lin_next(u, 80); }
    DI void src(int u, AS& as, BS& bs, const int wv_) const {
        const int g = u / 5, mt = u % 5;
        int R[2], C[2]; stage_coords(R, C, wv_);
        as.base = (const char*)(p.ws + WS_P); as.kstride = 4 * NINP * 2;
#pragma unroll
        for (int h = 0; h < 2; ++h)
#pragma unroll
            for (int i = 0; i < 2; ++i) { const int cr = min(mt * 256 + h * 128 + R[i], NCROW - 1);
                as.off[h][i] = (unsigned)(((size_t)(crow_tok(cr) + (C[i] >> 4)) * NINP + OFF_SSM + g * 16 + (C[i] & 15)) * 2); }
        const bf16_t* W = (const bf16_t*)(p.ws + WS_WS5) + (size_t)(l * 16 + g) * 256 * 1024;
        bs = make_b(W, W + (size_t)128 * 1024, 1024);
    }
    DI void epi(f32x4 (&acc)[2][2][4][2], int u, const int wv_) const {
        const int g = u / 5, mt = u % 5;
        float* SST = (float*)(p.ws + WS_SST);
        EPI_FOR8(acc, { const int cr = mt * 256 + lr; if (cr < NCROW) { float* o_ = SST + ((size_t)cr * 16 + g) * 256 + lc; *(f32x4*)o_ = v0; *(f32x4*)(o_ + 4) = v1; } });
    }
};
struct PvQKV {
    const Params& p; int l;
    PV_NOHOOKS
    static constexpr int NT = 4; static constexpr int FP8 = 0; static constexpr bool PARK = false; typedef APlain AS; typedef BSimple BS;
    DI int first() const { return lin_first(80, 1152); }
    DI int next(int u) const { return lin_next(u, 1152); }
    DI void src(int u, AS& a, BS& b, const int wv_) const {
        const bool isq = u < 576; const int w_ = isq ? u : u - 576; const int mt = w_ >> 1, nt = w_ & 1;
        a = make_a_plain((const bf16_t*)(p.ws + WS_P), (size_t)mt * 256, NINP, isq ? OFF_Q : OFF_KV);
        const bf16_t* W = (const bf16_t*)(p.ws + (isq ? WS_WQ : WS_WKV)) + (size_t)l * 512 * 256 + (size_t)nt * 256 * 256;
        b = make_b(W, W + (size_t)128 * 256, 256);
    }
    DI void epi(f32x4 (&acc)[2][2][4][2], int u, const int wv_) const {
        const bool isq = u < 576; const int w_ = isq ? u : u - 576; const int mt = w_ >> 1, nt = w_ & 1;
        bf16_t* RAW = (bf16_t*)(p.ws + (isq ? WS_RAWQ : WS_RAWKV));
        EPI_FOR8(acc, { store_bf16x8(RAW + (size_t)(mt * 256 + lr) * 512 + nt * 256 + lc, v0, v1); });
    }
};
DI void phase_A(const Params& p, LAS char* shm, int l, const int wv_) {
    { PvS5State pv{p, l}; gemm_stream(shm, pv, wv_); }
    { PvQKV pv{p, l}; gemm_stream(shm, pv, wv_); }
    { const int c_ = otid() & 255;
      float w[31];
#pragma unroll
      for (int j = 0; j < 31; ++j) w[j] = p.conv_dw[((size_t)l * 31 + j) * 256 + c_];
      const float bias = p.conv_dw_b[l * 256 + c_];
      for (int u = first_unit(80 + 1152); u < 1152; u += gridDim.x) pre_unit(p, shm, l, u, w, bias, wv_); }
}

DI void qkvpost_unit(const Params& p, LAS char* shm, int l, int unit, const int wv_) {
    const int tid = otid(), wid = tid >> 6, lane = tid & 63;
    const bf16_t* P = (const bf16_t*)(p.ws + WS_P);
    const bf16_t* RAWQ = (const bf16_t*)(p.ws + WS_RAWQ);
    const bf16_t* RAWKV = (const bf16_t*)(p.ws + WS_RAWKV);
    bf16_t* Q = (bf16_t*)(p.ws + WS_Q);
    bf16_t* KB = (bf16_t*)(p.ws + WS_KB);
    bf16_t* VT = (bf16_t*)(p.ws + WS_VT);
    LAS bf16_t* vt = (LAS bf16_t*)shm;
    const int row0 = unit * 64;
    const bool lat = row0 < TX;
    const int b = lat ? (row0 >> 11) : ((row0 - TX) >> 8);
    const int key0 = lat ? (row0 & 2047) : 2048 + ((row0 - TX) & 255);
    const int head = lane >> 4, sub = lane & 15;
    const float lninv = -9.210340371976184f / 8.f;
    const float frq = __expf(lninv * (float)(sub & 7));
    float qg[6], kg[6];
#pragma unroll
    for (int j = 0; j < 6; ++j) { qg[j] = p.mla_q_g[l * 96 + sub + 16 * j] * 0.14724444674085666f; kg[j] = p.mla_k_g[l * 96 + sub + 16 * j]; }
    constexpr int NB = 4;
    for (int tk0 = wid * 8; tk0 < wid * 8 + 8; tk0 += NB) {
        float pq[NB][3], pkv[NB][2], qr[NB][6], kr[NB][6], vr[NB][4];
#pragma unroll
        for (int i = 0; i < NB; ++i) { const int r = row0 + tk0 + i; const bf16_t* pr = P + (size_t)r * NINP;
#pragma unroll
            for (int j = 0; j < 3; ++j) pq[i][j] = bf2f(pr[OFF_Q + lane + 64 * j]);
#pragma unroll
            for (int j = 0; j < 2; ++j) pkv[i][j] = bf2f(pr[OFF_KV + lane + 64 * j]);
#pragma unroll
            for (int j = 0; j < 6; ++j) qr[i][j] = bf2f(RAWQ[(size_t)r * 512 + head * 96 + sub + 16 * j]);
#pragma unroll
            for (int j = 0; j < 4; ++j) kr[i][j] = bf2f(RAWKV[(size_t)r * 512 + head * 128 + sub + 16 * j]);
#pragma unroll
            for (int j = 4; j < 6; ++j) kr[i][j] = bf2f(pr[OFF_KPE + sub + 16 * (j - 4)]);
#pragma unroll
            for (int j = 0; j < 4; ++j) vr[i][j] = bf2f(RAWKV[(size_t)r * 512 + head * 128 + 64 + sub + 16 * j]); }
        float red[2 * NB];
#pragma unroll
        for (int i = 0; i < NB; ++i) { red[2 * i] = pq[i][0] * pq[i][0] + pq[i][1] * pq[i][1] + pq[i][2] * pq[i][2]; red[2 * i + 1] = pkv[i][0] * pkv[i][0] + pkv[i][1] * pkv[i][1]; }
        wave_sum_n<2 * NB>(red);
        float ssq[2 * NB];
#pragma unroll
        for (int i = 0; i < NB; ++i) {
            const float rq = rsqrtf(red[2 * i] * (1.f / 192.f) + EPS), rkv = rsqrtf(red[2 * i + 1] * (1.f / 128.f) + EPS);
            float s0 = 0.f, s1 = 0.f;
#pragma unroll
            for (int j = 0; j < 6; ++j) { qr[i][j] *= rq; s0 += qr[i][j] * qr[i][j]; }
#pragma unroll
            for (int j = 0; j < 4; ++j) { kr[i][j] *= rkv; s1 += kr[i][j] * kr[i][j]; }
#pragma unroll
            for (int j = 4; j < 6; ++j) s1 += kr[i][j] * kr[i][j];
#pragma unroll
            for (int j = 0; j < 4; ++j) vr[i][j] *= rkv;
            ssq[2 * i] = s0; ssq[2 * i + 1] = s1;
        }
        { const int l4 = olane();
#pragma unroll
          for (int o = 8; o > 0; o >>= 1) { float t_[2 * NB];
#pragma unroll
              for (int i = 0; i < 2 * NB; ++i) t_[i] = __int_as_float(__builtin_amdgcn_ds_bpermute((l4 ^ o) << 2, __float_as_int(ssq[i])));
#pragma unroll
              for (int i = 0; i < 2 * NB; ++i) ssq[i] += t_[i]; } }
#pragma unroll
        for (int i = 0; i < NB; ++i) {
            const int tk = tk0 + i, r = row0 + tk;
            const float rnq = rsqrtf(ssq[2 * i] * (1.f / 96.f) + EPS), rnk = rsqrtf(ssq[2 * i + 1] * (1.f / 96.f) + EPS);
#pragma unroll
            for (int j = 0; j < 6; ++j) { qr[i][j] *= rnq * qg[j]; kr[i][j] *= rnk * kg[j]; }
            if (lat) {
                const int tseq = r & 2047; const float a0 = (float)(tseq >> 6) * frq, a1 = (float)(tseq & 63) * frq;
                const float cs0 = __cosf(a0), sn0 = __sinf(a0), cs1 = __cosf(a1), sn1 = __sinf(a1);
                const float oq4 = shx(qr[i][4], 8), oq5 = shx(qr[i][5], 8), ok4 = shx(kr[i][4], 8), ok5 = shx(kr[i][5], 8);
                const float sg = (sub < 8) ? -1.f : 1.f;
                qr[i][4] = qr[i][4] * cs0 + sg * oq4 * sn0; qr[i][5] = qr[i][5] * cs1 + sg * oq5 * sn1;
                kr[i][4] = kr[i][4] * cs0 + sg * ok4 * sn0; kr[i][5] = kr[i][5] * cs1 + sg * ok5 * sn1;
            }
            bf16_t* kro = KB + ((size_t)(b * 4 + head) * 2304 + key0 + tk) * 96;
#pragma unroll
            for (int j = 0; j < 6; ++j) { Q[(size_t)r * 384 + head * 96 + sub + 16 * j] = f2bf(qr[i][j]); kro[sub + 16 * j] = f2bf(kr[i][j]); }
#pragma unroll
            for (int j = 0; j < 4; ++j) vt[(head * 64 + sub + 16 * j) * 72 + tk] = f2bf(vr[i][j]);
        }
    }
    __syncthreads();
    { const int hv = tid >> 1, hf = tid & 1;
      bf16_t* dst = VT + ((size_t)(b * 4 + (hv >> 6)) * 64 + (hv & 63)) * 2304 + key0 + hf * 32;
#pragma unroll
      for (int i = 0; i < 4; ++i) *(u32x4*)(dst + i * 8) = *(const LAS u32x4*)(vt + hv * 72 + hf * 32 + i * 8); }
    __syncthreads();
}
DI void s5carry_unit(const Params& p, int l, int unit, const int wv_) {
    const int gid = unit * 512 + otid();
    const int q = gid & 63, dir = (gid >> 6) & 1, g = (gid >> 7) & 15, b = gid >> 11;
    const float* A64 = (const float*)(p.ws + WS_A64) + (size_t)(((l * 2 + dir) * 16 + g) * 64 + q) * 2;
    const float ar = A64[0], ai = A64[1];
    const float* SST = (const float*)(p.ws + WS_SST);
    bf16_t* HIN = (bf16_t*)(p.ws + WS_HIN);
    float sr[NCH], si[NCH];
#pragma unroll
    for (int s = 0; s < NCH; ++s) { const int j = dir == 0 ? s : (s < 4 ? 3 - s : 39 - s);
        const size_t base = ((size_t)(b * NCH + j) * 16 + g) * 256 + dir * 128 + q; sr[s] = SST[base]; si[s] = SST[base + 64]; }
    float hr = 0.f, hi = 0.f;
#pragma unroll
    for (int s = 0; s < NCH; ++s) {
        const int j = dir == 0 ? s : (s < 4 ? 3 - s : 39 - s);
        const size_t base = ((size_t)(b * NCH + j) * 16 + g) * 256 + dir * 128 + q;
        HIN[base] = f2bf(hr); HIN[base + 64] = f2bf(hi);
        const float nr = ar * hr - ai * hi + sr[s], ni = ar * hi + ai * hr + si[s];
        hr = nr; hi = ni;
    }
}
struct PvConvPool {
    const Params& p; int l;
    PV_NOHOOKS
    static constexpr int NT = 4; static constexpr int FP8 = 0; static constexpr bool PARK = false; typedef APlain AS; typedef BSimple BS;
    DI int first() const { return lin_first(0, 576); }
    DI int next(int u) const { return lin_next(u, 576); }
    DI void src(int u, AS& a, BS& b, const int wv_) const {
        const bool isconv = u < 288; const int mt = isconv ? u : u - 288;
        a = make_a_plain((const bf16_t*)(p.ws + (isconv ? WS_ACONV : WS_APOOL)), (size_t)mt * 256, 256, 0);
        const bf16_t* W = (const bf16_t*)(p.ws + (isconv ? WS_WPW : WS_WPOOL)) + (size_t)l * 65536;
        b = make_b(W, W + (size_t)128 * 256, 256);
    }
    DI void epi(f32x4 (&acc)[2][2][4][2], int u, const int wv_) const {
        const bool isconv = u < 288; const int mt = isconv ? u : u - 288;
        bf16_t* CAT = (bf16_t*)(p.ws + WS_CAT);
        if (isconv) { EPI_FOR8(acc, { store_bf16x8(CAT + (size_t)(mt * 256 + lr) * 1024 + lc, v0, v1); }); }
        else { const int t_ = otid(), c0_ = ((t_ >> 6) & 3) * 32 + ((t_ & 63) >> 4) * 8; f32x4 sc_[2][2];
#pragma unroll
               for (int bj = 0; bj < 2; ++bj)
#pragma unroll
                   for (int n = 0; n < 2; ++n) sc_[bj][n] = *(const f32x4*)(p.pool_scale + l * 256 + bj * 128 + n * 4 + c0_);
               EPI_FOR8(acc, { store_bf16x8(CAT + (size_t)(mt * 256 + lr) * 1024 + 256 + lc, v0 * sc_[bj][0], v1 * sc_[bj][1]); }); }
    }
};
DI void phase_B(const Params& p, LAS char* shm, int l, const int wv_) {
    { PvConvPool pv{p, l}; gemm_stream(shm, pv, wv_); }
    const int n_post = TT / 64, n_carry = 128;
    for (int u = first_unit(576); u < n_post + n_carry; u += gridDim.x) {
        if (u < n_post) qkvpost_unit(p, shm, l, u, wv_);
        else s5carry_unit(p, l, u - n_post, wv_);
    }
}

DI void attn_unit(const Params& p, LAS char* shm, int l, int b, int h, int qrow0, int nq, int key_lo, int nkeys, const int wv_) {
    const int tid = otid(), wid = tid >> 6, lane = tid & 63, l31 = lane & 31, hh = lane >> 5;
    const bf16_t* Q = (const bf16_t*)(p.ws + WS_Q);
    const bf16_t* KBp = (const bf16_t*)(p.ws + WS_KB) + (size_t)(b * 4 + h) * 2304 * 96;
    const bf16_t* VTp = (const bf16_t*)(p.ws + WS_VT) + (size_t)(b * 4 + h) * 64 * 2304;
    bf16_t* CAT = (bf16_t*)(p.ws + WS_CAT);
    LAS char* kl = shm;
    LAS char* vl = shm + 13312;
    const bool active = wid * 64 < nq;
    float gq = 0.f, gk = 0.f;
    for (int i = lane; i < 96; i += 64) { gq = fmaxf(gq, fabsf(p.mla_q_g[l * 96 + i])); gk = fmaxf(gk, fabsf(p.mla_k_g[l * 96 + i])); }
    gq = wave_max(gq); gk = wave_max(gk);
    const float LOG2E = 1.4426950408889634f;
    const float c2 = 9.797958971132712f * gq * gk * LOG2E;
    const float sh2 = fmaxf(c2 - 64.f, 0.f);
    bf16x8 qf[2][6];
    if (active) {
#pragma unroll
        for (int qb = 0; qb < 2; ++qb)
#pragma unroll
            for (int ks = 0; ks < 6; ++ks) qf[qb][ks] = *(const bf16x8*)(Q + (size_t)(qrow0 + wid * 64 + qb * 32 + l31) * 384 + h * 96 + ks * 16 + hh * 8);
    }
    f32x16 O[2][2];
#pragma unroll
    for (int a = 0; a < 2; ++a)
#pragma unroll
        for (int c = 0; c < 2; ++c)
#pragma unroll
            for (int i = 0; i < 16; ++i) O[a][c][i] = 0.f;
    float lsum[2] = {0.f, 0.f};
    const int ntile = nkeys / 64;
    u32x4 kreg0, kreg1, vreg;
    auto load_tile = [&](int t) {
        const int key = key_lo + t * 64;
        { const int id = tid, kr = id / 12, part = id % 12; kreg0 = *(const u32x4*)(KBp + (size_t)(key + kr) * 96 + part * 8); }
        if (tid < 256) { const int id = tid + 512, kr = id / 12, part = id % 12; kreg1 = *(const u32x4*)(KBp + (size_t)(key + kr) * 96 + part * 8); }
        { const int vd = tid >> 3, part = tid & 7; vreg = *(const u32x4*)(VTp + (size_t)vd * 2304 + key + part * 8); }
    };
    auto write_tile = [&]() {
        { const int id = tid, kr = id / 12, part = id % 12; *(LAS u32x4*)(kl + kr * 208 + part * 16) = kreg0; }
        if (tid < 256) { const int id = tid + 512, kr = id / 12, part = id % 12; *(LAS u32x4*)(kl + kr * 208 + part * 16) = kreg1; }
        { const int vd = tid >> 3, part = tid & 7; *(LAS u32x4*)(vl + vd * 144 + part * 16) = vreg; }
    };
    load_tile(0);
    for (int t = 0; t < ntile; ++t) {
        __syncthreads();
        write_tile();
        __syncthreads();
        if (t + 1 < ntile) load_tile(t + 1);
        if (active) {
#pragma unroll
            for (int kb = 0; kb < 2; ++kb) {
                f32x16 S[2];
#pragma unroll
                for (int qb = 0; qb < 2; ++qb)
#pragma unroll
                    for (int i = 0; i < 16; ++i) S[qb][i] = 0.f;
#pragma unroll
                for (int ks = 0; ks < 6; ++ks) {
                    const bf16x8 a = *(const LAS bf16x8*)(kl + (kb * 32 + l31) * 208 + ks * 32 + hh * 16);
#pragma unroll
                    for (int qb = 0; qb < 2; ++qb) S[qb] = __builtin_amdgcn_mfma_f32_32x32x16_bf16(a, qf[qb][ks], S[qb], 0, 0, 0);
                }
                bf16x8 pf[2][2];
#pragma unroll
                for (int qb = 0; qb < 2; ++qb) {
                    float e[16];
#pragma unroll
                    for (int i = 0; i < 16; ++i) { e[i] = __builtin_amdgcn_exp2f(S[qb][i] - sh2); lsum[qb] += e[i]; }
#pragma unroll
                    for (int s = 0; s < 2; ++s) { u32x4 w; w.x = pk_bf16(e[8 * s], e[8 * s + 1]); w.y = pk_bf16(e[8 * s + 2], e[8 * s + 3]); w.z = pk_bf16(e[8 * s + 4], e[8 * s + 5]); w.w = pk_bf16(e[8 * s + 6], e[8 * s + 7]);
                        pf[qb][s] = __builtin_bit_cast(bf16x8, w); }
                }
#pragma unroll
                for (int s = 0; s < 2; ++s) {
                    const int kk = kb * 2 + s;
#pragma unroll
                    for (int vb = 0; vb < 2; ++vb) {
                        const s16x4 lo = *(const LAS s16x4*)(vl + (vb * 32 + l31) * 144 + (16 * kk + 4 * hh) * 2);
                        const s16x4 hi = *(const LAS s16x4*)(vl + (vb * 32 + l31) * 144 + (16 * kk + 8 + 4 * hh) * 2);
                        const bf16x8 va = __builtin_shufflevector(lo, hi, 0, 1, 2, 3, 4, 5, 6, 7);
#pragma unroll
                        for (int qb = 0; qb < 2; ++qb) O[vb][qb] = __builtin_amdgcn_mfma_f32_32x32x16_bf16(va, pf[qb][s], O[vb][qb], 0, 0, 0);
                    }
                }
            }
        }
    }
    if (active) {
#pragma unroll
        for (int qb = 0; qb < 2; ++qb) {
            const float tot = lsum[qb] + shx(lsum[qb], 32);
            const float inv = 1.f / tot;
            bf16_t* orow = CAT + (size_t)(qrow0 + wid * 64 + qb * 32 + l31) * 1024 + 768 + h * 64;
#pragma unroll
            for (int vb = 0; vb < 2; ++vb)
#pragma unroll
                for (int i4 = 0; i4 < 4; ++i4)
                    store_bf16x4(orow + vb * 32 + 8 * i4 + 4 * hh, O[vb][qb][4 * i4] * inv, O[vb][qb][4 * i4 + 1] * inv, O[vb][qb][4 * i4 + 2] * inv, O[vb][qb][4 * i4 + 3] * inv);
        }
    }
    __syncthreads();
}
struct PvS5Out {
    const Params& p; int l;
    PV_NOHOOKS
    static constexpr int NT = 20; static constexpr int FP8 = 0; static constexpr bool PARK = false; typedef ASeg2 AS; typedef BSimple BS;
    DI int first() const { return lin_first(512, 320); }
    DI int next(int u) const { return lin_next(u, 320); }
    DI void src(int u, AS& as, BS& bs, const int wv_) const {
        const int ntile = u & 3, mt = (u >> 2) % 5, g = u / 20;
        int R[2], C[2]; stage_coords(R, C, wv_);
        as.base0 = (const char*)(p.ws + WS_P); as.base1 = (const char*)(p.ws + WS_HIN); as.ks0 = 4 * NINP * 2; as.nt0 = 16;
#pragma unroll
        for (int h = 0; h < 2; ++h)
#pragma unroll
            for (int i = 0; i < 2; ++i) { const int cr = min(mt * 256 + h * 128 + R[i], NCROW - 1);
                as.off0[h][i] = (unsigned)(((size_t)(crow_tok(cr) + (C[i] >> 4)) * NINP + OFF_SSM + g * 16 + (C[i] & 15)) * 2);
                as.off1[h][i] = (unsigned)((((size_t)cr * 16 + g) * 256 + C[i]) * 2); }
        const bf16_t* W = (const bf16_t*)(p.ws + WS_TS5) + ((size_t)(l * 16 + g) * 1024 + ntile * 256) * 1280;
        bs = make_b(W, W + (size_t)128 * 1280, 1280);
    }
    DI void epi(f32x4 (&acc)[2][2][4][2], int u, const int wv_) const {
        const int ntile = u & 3, mt = (u >> 2) % 5, g = u / 20;
        bf16_t* Z = (bf16_t*)(p.ws + WS_Z);
        EPI_FOR8(acc, { const int cr = mt * 256 + lr; if (cr < NCROW) { const int col = ntile * 256 + lc, t = col >> 4, co = col & 15;
            const f32x4 g0 = (f32x4){gelu_tanh(v0[0]), gelu_tanh(v0[1]), gelu_tanh(v0[2]), gelu_tanh(v0[3])}, g1_ = (f32x4){gelu_tanh(v1[0]), gelu_tanh(v1[1]), gelu_tanh(v1[2]), gelu_tanh(v1[3])};
            store_bf16x8(Z + (size_t)(crow_tok(cr) + t) * 256 + g * 16 + co, g0, g1_); } });
    }
};
DI void phase_C(const Params& p, LAS char* shm, int l, const int wv_) {
    for (int u = blockIdx.x; u < 512; u += gridDim.x) { const int qb = u & 3, h = (u >> 2) & 3, b = u >> 4;
        attn_unit(p, shm, l, b, h, b * SEQ + qb * 512, 512, 0, 2304, wv_); }
    { PvS5Out pv{p, l}; gemm_stream(shm, pv, wv_); }
    if (l == 0) for (int u = first_unit(512 + 320); u < 128; u += gridDim.x) { const int h = u & 3, b = u >> 2;
        attn_unit(p, shm, l, b, h, TX + b * CTXL, 256, 2048, 256, wv_); }
}

struct PvGlu {
    const Params& p; int l;
    PV_NOHOOKS
    static constexpr int NT = 4; static constexpr int FP8 = 0; static constexpr bool PARK = false; typedef APlain AS; typedef BSimple BS;
    DI int first() const { return lin_first(0, 288); }
    DI int next(int u) const { return lin_next(u, 288); }
    DI void src(int u, AS& a, BS& b, const int wv_) const {
        a = make_a_plain((const bf16_t*)(p.ws + WS_Z), (size_t)u * 256, 256, 0);
        const bf16_t* W = (const bf16_t*)(p.ws + WS_WGLU) + (size_t)l * 65536;
        b = make_b(W, W + (size_t)128 * 256, 256);
    }
    DI void epi(f32x4 (&acc)[2][2][4][2], int u, const int wv_) const {
        const bf16_t* Z = (const bf16_t*)(p.ws + WS_Z); bf16_t* CAT = (bf16_t*)(p.ws + WS_CAT);
        const int _tz = otid(), _w = _tz >> 6, _l = _tz & 63, _wr = _w >> 2, _wc = _w & 3, _fr = _l & 15, _fq = _l >> 4;
        const int c0 = _wc * 32 + _fq * 8;
        f32x4 bsv[2][2];
#pragma unroll
        for (int bj = 0; bj < 2; ++bj)
#pragma unroll
            for (int n = 0; n < 2; ++n) bsv[bj][n] = *(const f32x4*)(p.ssm_glu_b + l * 256 + bj * 128 + n * 4 + c0);
#pragma unroll
        for (int ai = 0; ai < 2; ++ai) {
            u32x4 zz[4][2];
#pragma unroll
            for (int m = 0; m < 4; ++m)
#pragma unroll
                for (int bj = 0; bj < 2; ++bj) zz[m][bj] = *(const u32x4*)(Z + (size_t)(u * 256 + ai * 128 + _wr * 64 + m * 16 + _fr) * 256 + bj * 128 + c0);
#pragma unroll
            for (int m = 0; m < 4; ++m) { const size_t r = (size_t)(u * 256 + ai * 128 + _wr * 64 + m * 16 + _fr);
#pragma unroll
                for (int bj = 0; bj < 2; ++bj) { const f32x4 a0 = acc[ai][bj][m][0], a1 = acc[ai][bj][m][1]; const f32x4 b0 = bsv[bj][0], b1 = bsv[bj][1]; const u32x4 z_ = zz[m][bj];
                    const f32x4 o0 = (f32x4){bflo(z_.x) * sigmoidf_(a0[0] + b0[0]), bfhi(z_.x) * sigmoidf_(a0[1] + b0[1]), bflo(z_.y) * sigmoidf_(a0[2] + b0[2]), bfhi(z_.y) * sigmoidf_(a0[3] + b0[3])};
                    const f32x4 o1 = (f32x4){bflo(z_.z) * sigmoidf_(a1[0] + b1[0]), bfhi(z_.z) * sigmoidf_(a1[1] + b1[1]), bflo(z_.w) * sigmoidf_(a1[2] + b1[2]), bfhi(z_.w) * sigmoidf_(a1[3] + b1[3])};
                    store_bf16x8(CAT + r * 1024 + 512 + bj * 128 + c0, o0, o1); } }
        }
    }
};
DI void phase_D(const Params& p, LAS char* shm, int l, const int wv_) {
    PvGlu pv{p, l}; gemm_stream(shm, pv, wv_);
}

struct PvOutproj {
    const Params& p; int l;
    PV_NOHOOKS
    static constexpr int NT = 16; static constexpr int FP8 = 0; static constexpr bool PARK = false; typedef APlain AS; typedef BSimple BS;
    XcdDeal<4, 4> deal;
    DI int first() const { return deal.first(); }
    DI int next(int u) const { return deal.next(u); }
    DI void src(int u, AS& a, BS& b, const int wv_) const {
        int mt, nt; deal.decode(u, mt, nt);
        const bf16_t* W = (const bf16_t*)(p.ws + WS_WMO) + (size_t)l * 1024 * 1024;
        a = make_a_plain((const bf16_t*)(p.ws + WS_CAT), (size_t)mt * 256, 1024, 0);
        b = make_b(W + (size_t)(nt * 256) * 1024, W + (size_t)(nt * 256 + 128) * 1024, 1024);
    }
    DI void epi(f32x4 (&acc)[2][2][4][2], int u, const int wv_) const {
        int mt, nt; deal.decode(u, mt, nt);
        bf16_t* X = (bf16_t*)(p.ws + WS_X);
        const float* MOD = (const float*)(p.ws + WS_MOD) + (size_t)l * 33 * 6144;
        const int _tz = otid(), _w = _tz >> 6, _l = _tz & 63, _wr = _w >> 2, _wc = _w & 3, _fr = _l & 15, _fq = _l >> 4;
        const int c0 = nt * 256 + _wc * 32 + _fq * 8;
        const int row0 = mt * 256;
        const float* g1p = MOD + (size_t)mod_row(row0) * 6144 + 2048 + c0;
        f32x4 g1[2][2];
#pragma unroll
        for (int bj = 0; bj < 2; ++bj)
#pragma unroll
            for (int n = 0; n < 2; ++n) g1[bj][n] = *(const f32x4*)(g1p + bj * 128 + n * 4);
        bf16_t* obase = X + (size_t)row0 * 1024;
        if (l == 0) {
            const float* xbase = row0 < TX ? p.x + (size_t)row0 * 1024 : p.ctx + (size_t)(row0 - TX) * 1024;
#pragma unroll
            for (int ai = 0; ai < 2; ++ai)
#pragma unroll
                for (int mp = 0; mp < 2; ++mp) {
                    f32x4 xv[2][2][2];
#pragma unroll
                    for (int mm = 0; mm < 2; ++mm)
#pragma unroll
                        for (int bj = 0; bj < 2; ++bj)
#pragma unroll
                            for (int n = 0; n < 2; ++n) xv[mm][bj][n] = *(const f32x4*)(xbase + (size_t)(ai * 128 + _wr * 64 + (mp * 2 + mm) * 16 + _fr) * 1024 + c0 + bj * 128 + n * 4);
#pragma unroll
                    for (int mm = 0; mm < 2; ++mm)
#pragma unroll
                        for (int bj = 0; bj < 2; ++bj)
                            store_bf16x8(obase + (size_t)(ai * 128 + _wr * 64 + (mp * 2 + mm) * 16 + _fr) * 1024 + c0 + bj * 128,
                                         xv[mm][bj][0] + g1[bj][0] * acc[ai][bj][mp * 2 + mm][0], xv[mm][bj][1] + g1[bj][1] * acc[ai][bj][mp * 2 + mm][1]);
                }
        } else {
#pragma unroll
            for (int ai = 0; ai < 2; ++ai) {
                u32x4 xv[4][2];
#pragma unroll
                for (int m = 0; m < 4; ++m)
#pragma unroll
                    for (int bj = 0; bj < 2; ++bj) xv[m][bj] = *(const u32x4*)(obase + (size_t)(ai * 128 + _wr * 64 + m * 16 + _fr) * 1024 + c0 + bj * 128);
#pragma unroll
                for (int m = 0; m < 4; ++m)
#pragma unroll
                    for (int bj = 0; bj < 2; ++bj) { const u32x4 x_ = xv[m][bj];
                        const f32x4 x0 = (f32x4){bflo(x_.x), bfhi(x_.x), bflo(x_.y), bfhi(x_.y)}, x1 = (f32x4){bflo(x_.z), bfhi(x_.z), bflo(x_.w), bfhi(x_.w)};
                        store_bf16x8(obase + (size_t)(ai * 128 + _wr * 64 + m * 16 + _fr) * 1024 + c0 + bj * 128, x0 + g1[bj][0] * acc[ai][bj][m][0], x1 + g1[bj][1] * acc[ai][bj][m][1]); }
            }
        }
    }
};
DI void phase_E(const Params& p, LAS char* shm, int l, const int wv_) {
    PvOutproj pv{p, l, {(l == 1 ? TX : TT) / 256}}; gemm_stream(shm, pv, wv_);
}

template <int S> DI float row_rot_f(float v) { return __int_as_float(__builtin_amdgcn_update_dpp(0, __float_as_int(v), 0x120 | S, 0xf, 0xf, false)); }
template <int S> DI int row_rot_i(int v) { return __builtin_amdgcn_update_dpp(0, v, 0x120 | S, 0xf, 0xf, false); }
template <int S> struct RankAcc {
    static DI void run(float o0, float o1, int oe, float v0, float v1, int e0, int& r0, int& r1) {
        const float a0 = S ? row_rot_f<S>(o0) : o0, a1 = S ? row_rot_f<S>(o1) : o1; const int ae = S ? row_rot_i<S>(oe) : oe;
        r0 += (a0 > v0 || (a0 == v0 && ae < e0)) ? 1 : 0;
        r0 += (a1 > v0) ? 1 : 0;
        r1 += (a0 > v1 || a0 == v1) ? 1 : 0;
        r1 += (a1 > v1 || (a1 == v1 && ae < e0)) ? 1 : 0;
        RankAcc<S + 1>::run(o0, o1, oe, v0, v1, e0, r0, r1);
    }
};
template <> struct RankAcc<16> { static DI void run(float, float, int, float, float, int, int&, int&) {} };
DI float row_sum16(float v) { v += row_rot_f<8>(v); v += row_rot_f<4>(v); v += row_rot_f<2>(v); v += row_rot_f<1>(v); return v; }
DI float row_max16(float v) { v = fmaxf(v, row_rot_f<8>(v)); v = fmaxf(v, row_rot_f<4>(v)); v = fmaxf(v, row_rot_f<2>(v)); v = fmaxf(v, row_rot_f<1>(v)); return v; }

DI void phase_router(const Params& p, LAS char* shm, int l, const int wv_) {
    const int tid = otid(), wid = tid >> 6, lane = tid & 63;
    const int Tm = (l == 1) ? TX : TT;
    const bf16_t* X = (const bf16_t*)(p.ws + WS_X);
    const float* MOD = (const float*)(p.ws + WS_MOD) + (size_t)l * 33 * 6144;
    unsigned char* H8 = (unsigned char*)(p.ws + WS_H);
    const bool alt = p.ph_lo != 0;
    int* CNT = (int*)(p.ws + WS_CNT) + l * 32 + (alt ? 64 : 0);
    int* LIST = alt ? (int*)(p.ws + WS_RY) : (int*)(p.ws + WS_LIST);
    LAS char* wfr = shm;
    LAS bf16_t* gml = (LAS bf16_t*)(shm + 131072);
    LAS bf16_t* shl = gml + 1024;
    LAS float* cvec = (LAS float*)(shm + 131072 + 4096);
    LAS int* lcnt = (LAS int*)(cvec + 32);
    LAS int* lbase = lcnt + 32;
    LAS unsigned* lrec = (LAS unsigned*)(lbase + 32);
    LAS float* lwt = (LAS float*)(lrec + 1152);
    const int tpw = (Tm + gridDim.x - 1) / gridDim.x;
    const int tbeg = blockIdx.x * tpw, tend = min(tbeg + tpw, Tm);
    if (tid < 32) lcnt[tid] = 0;
    int seg_beg = tbeg;
    while (seg_beg < tend) {
        const int mrow = mod_row(seg_beg);
        int seg_end = tend;
        if (mrow < 32) seg_end = min(tend, (mrow + 1) * SEQ); else seg_end = tend;
        const float* mr = MOD + (size_t)mrow * 6144;
        __syncthreads();
        for (int k = tid; k < 1024; k += 512) { const float gmv = p.norm2_g[l * 1024 + k] * (1.f + mr[4096 + k]); gml[k] = f2bf(gmv); shl[k] = f2bf(mr[3072 + k]); }
#pragma unroll 8
        for (int i = tid; i < 1024 * 8; i += 512) {
            const int k = i >> 3, e4 = (i & 7) * 4;
            const float gmv = p.norm2_g[l * 1024 + k] * (1.f + mr[4096 + k]);
            const f32x4 w = *(const f32x4*)(p.router_w + (size_t)l * 32768 + k * 32 + e4);
            const int ks = k >> 5, kq = (k >> 3) & 3, j = k & 7;
#pragma unroll
            for (int c = 0; c < 4; ++c) { const int e = e4 + c, nb = e >> 4, ei = e & 15; const float wv = w[c] * gmv;
                const bf16_t hi = f2bf(wv); const bf16_t lo = f2bf(wv - bf2f(hi));
                LAS bf16_t* dst = (LAS bf16_t*)(wfr + ((size_t)((ks * 2 + nb) * 2) * 64 + (kq * 16 + ei)) * 16) + j;
                dst[0] = hi; dst[64 * 8] = lo; }
        }
        {
            float s4[4] = {0.f, 0.f, 0.f, 0.f};
#pragma unroll 8
            for (int k = lane; k < 1024; k += 64) { const float shv = mr[3072 + k]; const f32x4 w = *(const f32x4*)(p.router_w + (size_t)l * 32768 + k * 32 + wid * 4);
                s4[0] += shv * w[0]; s4[1] += shv * w[1]; s4[2] += shv * w[2]; s4[3] += shv * w[3]; }
#pragma unroll
            for (int c = 0; c < 4; ++c) { const float t_ = wave_sum(s4[c]); if (lane == 0) cvec[wid * 4 + c] = t_ + p.router_b[l * 32 + wid * 4 + c]; }
        }
        __syncthreads();
        const int ngroups = (seg_end - seg_beg) >> 4;
        for (int gi = wid; gi < ngroups; gi += 8) {
            const int t0 = seg_beg + gi * 16;
            const int tok = lane & 15, kq = lane >> 4;
            const bf16_t* xr = X + (size_t)(t0 + tok) * 1024 + kq * 8;
            f32x4 acc0 = {0.f, 0.f, 0.f, 0.f}, acc1 = {0.f, 0.f, 0.f, 0.f};
            float ss = 0.f;
            u32x4 xa[16], xb[16];
#pragma unroll
            for (int k2 = 0; k2 < 16; ++k2) xa[k2] = *(const u32x4*)(xr + k2 * 32);
#pragma unroll
            for (int k2 = 0; k2 < 16; ++k2) xb[k2] = *(const u32x4*)(xr + (16 + k2) * 32);
#pragma unroll
            for (int kc = 0; kc < 2; ++kc) {
#pragma unroll
            for (int k2 = 0; k2 < 16; ++k2) { const int ks = kc * 16 + k2;
                if ((k2 & 3) == 0) __builtin_amdgcn_sched_barrier(0);
                const u32x4 xh = kc == 0 ? xa[k2] : xb[k2];
                const float x0 = bflo(xh.x), x1 = bfhi(xh.x), x2 = bflo(xh.y), x3 = bfhi(xh.y), x4 = bflo(xh.z), x5 = bfhi(xh.z), x6 = bflo(xh.w), x7 = bfhi(xh.w);
                ss += x0 * x0 + x1 * x1 + x2 * x2 + x3 * x3 + x4 * x4 + x5 * x5 + x6 * x6 + x7 * x7;
                const bf16x8 ah = __builtin_bit_cast(bf16x8, xh);
                const LAS char* wb = wfr + (size_t)(ks * 4) * 1024 + lane * 16;
                const bf16x8 b0h = *(const LAS bf16x8*)(wb), b0l = *(const LAS bf16x8*)(wb + 1024), b1h = *(const LAS bf16x8*)(wb + 2048), b1l = *(const LAS bf16x8*)(wb + 3072);
                acc0 = __builtin_amdgcn_mfma_f32_16x16x32_bf16(ah, b0h, acc0, 0, 0, 0); acc0 = __builtin_amdgcn_mfma_f32_16x16x32_bf16(ah, b0l, acc0, 0, 0, 0);
                acc1 = __builtin_amdgcn_mfma_f32_16x16x32_bf16(ah, b1h, acc1, 0, 0, 0); acc1 = __builtin_amdgcn_mfma_f32_16x16x32_bf16(ah, b1l, acc1, 0, 0, 0);
            } }
            u32x4 xp[16];
#pragma unroll
            for (int k2 = 0; k2 < 16; ++k2) xp[k2] = *(const u32x4*)(xr + k2 * 32);
            ss += shx(ss, 16); ss += shx(ss, 32);
            const float rn = rsqrtf(ss * (1.f / 1024.f) + EPS);
            const int ei = lane & 15;
            const float c0v = cvec[ei], c1v = cvec[16 + ei];
#pragma unroll
            for (int r = 0; r < 4; ++r) {
                const int tl = (lane >> 4) * 4 + r;
                const float rnt = shi(rn, tl);
                float v0 = fminf(fmaxf(acc0[r] * rnt + c0v, -1e30f), 1e30f), v1 = fminf(fmaxf(acc1[r] * rnt + c1v, -1e30f), 1e30f);
                int r0 = 0, r1 = 0;
                RankAcc<0>::run(v0, v1, ei, v0, v1, ei, r0, r1);
                const float mx = row_max16(fmaxf(v0, v1));
                const bool s0 = r0 < 4, s1 = r1 < 4;
                const float e0 = s0 ? __expf(v0 - mx) : 0.f, e1 = s1 ? __expf(v1 - mx) : 0.f;
                const float inv = 1.f / row_sum16(e0 + e1);
                const int t = t0 + tl;
                if (s0) { const int pos = atomicAdd((int*)&lcnt[ei], 1); lrec[(t - tbeg) * 4 + r0] = (unsigned)ei | ((unsigned)pos << 8); lwt[(t - tbeg) * 4 + r0] = e0 * inv; }
                if (s1) { const int pos = atomicAdd((int*)&lcnt[16 + ei], 1); lrec[(t - tbeg) * 4 + r1] = (unsigned)(16 + ei) | ((unsigned)pos << 8); lwt[(t - tbeg) * 4 + r1] = e1 * inv; }
            }
            unsigned char* hr = H8 + (size_t)(t0 + tok) * 1024 + kq * 8;
#pragma unroll 1
            for (int kc = 0; kc < 2; ++kc) {
            u32x4 xv[16];
            if (kc == 0) {
#pragma unroll
                for (int k2 = 0; k2 < 16; ++k2) xv[k2] = xp[k2];
            } else {
#pragma unroll
                for (int k2 = 0; k2 < 16; ++k2) xv[k2] = *(const u32x4*)(xr + (16 + k2) * 32);
            }
#pragma unroll
            for (int k2 = 0; k2 < 16; ++k2) { const int ks = kc * 16 + k2;
                const u32x4 xh = xv[k2];
                const u32x4 gq = *(const LAS u32x4*)(gml + ks * 32 + kq * 8), sq = *(const LAS u32x4*)(shl + ks * 32 + kq * 8);
                float h[8];
                h[0] = bflo(xh.x) * rn * bflo(gq.x) + bflo(sq.x); h[1] = bfhi(xh.x) * rn * bfhi(gq.x) + bfhi(sq.x); h[2] = bflo(xh.y) * rn * bflo(gq.y) + bflo(sq.y); h[3] = bfhi(xh.y) * rn * bfhi(gq.y) + bfhi(sq.y);
                h[4] = bflo(xh.z) * rn * bflo(gq.z) + bflo(sq.z); h[5] = bfhi(xh.z) * rn * bfhi(gq.z) + bfhi(sq.z); h[6] = bflo(xh.w) * rn * bflo(gq.w) + bflo(sq.w); h[7] = bfhi(xh.w) * rn * bfhi(gq.w) + bfhi(sq.w);
#pragma unroll
                for (int i = 0; i < 8; ++i) h[i] = __builtin_amdgcn_fmed3f(h[i], -448.f, 448.f);
                u32x2 o; o.x = pk_fp8x4(h[0], h[1], h[2], h[3]); o.y = pk_fp8x4(h[4], h[5], h[6], h[7]);
                *(u32x2*)(hr + ks * 32) = o;
            } }
        }
        seg_beg = seg_end;
    }
    __syncthreads();
    if (tid < 32) lbase[tid] = atomicAdd(&CNT[tid], lcnt[tid]);
    __syncthreads();
    for (int i = tid; i < (tend - tbeg) * 4; i += 512) { const unsigned rec = lrec[i]; const int e = rec & 255, pos = rec >> 8;
        u32x2 ent; ent.x = (unsigned)(tbeg * 4 + i); ent.y = __float_as_uint(lwt[i]);
        *(u32x2*)(LIST + ((size_t)e * TT + lbase[e] + pos) * 2) = ent; }
    __syncthreads();
}

DI void moe_tiles(const Params& p, LAS int* tstart, int l, const int wv_) {
    const int* CNT = (const int*)(p.ws + WS_CNT) + l * 32;
    if (otid() == 0) { int s = 0; for (int e = 0; e < 32; ++e) { tstart[e] = s; s += (CNT[e] + 255) >> 8; } tstart[32] = s; }
    __syncthreads();
    LAS int* ttab = (LAS int*)((LAS char*)tstart - (LDS_MISC + 64) + LDS_TTAB);
    const int MT_ = tstart[32];
    for (int mt = otid(); mt < MT_; mt += 512) { int e = 0;
#pragma unroll
        for (int i = 1; i < 32; ++i) e += (mt >= tstart[i]) ? 1 : 0;
        ttab[mt] = e | ((mt - tstart[e]) << 8); }
    __syncthreads();
}
DI int moe_find(const LAS int* tstart, int mt) { const LAS int* ttab = (const LAS int*)((const LAS char*)tstart - (LDS_MISC + 64) + LDS_TTAB); return __builtin_amdgcn_readfirstlane(ttab[mt]); }
struct PvMoe1 {
    const Params& p; int l; const LAS int* tstart; LAS char* tbl;
    static constexpr int NT = 8; static constexpr int FP8 = 2; static constexpr bool PARK = false; typedef ASimple AS; typedef BSimple BS;
    XcdDeal<4, 8> deal;
    DI int first() const { return deal.first(); }
    DI int next(int u) const { return deal.next(u); }
    typedef u32x4 Aux;
    DI void top(int u, Aux& aux, const int wv_) const {
        int mt, n8; deal.decode(u, mt, n8);
        const int ev_ = moe_find(tstart, mt); const int e = ev_ & 255;
        const int t_ = otid() & 63;
        aux = aload128(p.exp_b_in + (size_t)(l * NE + e) * 2048 + (t_ < 32 ? n8 * 128 + t_ * 4 : 1024 + n8 * 128 + (t_ - 32) * 4));
    }
    DI void mid(Aux& aux, const int wv_) const { const int t_ = otid(); asm volatile("" : "+v"(aux)); if (t_ < 64) *(LAS u32x4*)(tbl + t_ * 16) = aux; }
    DI void fix(AS& as, bool wait, const int wv_) const {
        if (wait) asm volatile("s_waitcnt vmcnt(0)" ::: "memory");
        int R[2], C[2]; stage_coords(R, C, wv_);
#pragma unroll
        for (int h = 0; h < 2; ++h)
#pragma unroll
            for (int i = 0; i < 2; ++i) { unsigned sl = as.off[h][i]; asm volatile("" : "+v"(sl)); as.off[h][i] = (sl >> 2) * 1024u + (unsigned)(C[i] * 2); }
    }
    DI void src(int u, AS& as, BS& bs, const int wv_) const {
        int mt, n8; deal.decode(u, mt, n8);
        const int ev_ = moe_find(tstart, mt); const int e = ev_ & 255;
        const int r0 = (ev_ >> 8) * 256, cnt = ((const int*)(p.ws + WS_CNT))[l * 32 + e];
        const int* lst = (const int*)(p.ws + WS_LIST) + (size_t)e * TT * 2;
        int R[2], C[2]; stage_coords(R, C, wv_);
        as.base = (const char*)(p.ws + WS_H); as.kstride = 128;
#pragma unroll
        for (int h = 0; h < 2; ++h)
#pragma unroll
            for (int i = 0; i < 2; ++i) as.off[h][i] = aload32(lst + 2 * min(r0 + h * 128 + R[i], cnt - 1));
        const char* W = (const char*)(p.ws + WS_W1) + (size_t)(l * NE + e) * 2048 * 1024;
        bs.base[0] = W + (size_t)(n8 * 128) * 1024; bs.base[1] = W + (size_t)(1024 + n8 * 128) * 1024; bs.ldb2 = 1024;
    }
    DI void epi(f32x4 (&acc)[2][2][4][2], int u, const int wv_) const {
        int mt, n8; deal.decode(u, mt, n8);
        const int ev_ = moe_find(tstart, mt); const int e = ev_ & 255;
        unsigned char* ACT = (unsigned char*)(p.ws + WS_RA);
        const int _tz = otid(), _w = _tz >> 6, _l = _tz & 63, _wr = _w >> 2, _wc = _w & 3, _fr = _l & 15, _fq = _l >> 4;
        const LAS float* bin = (const LAS float*)tbl + _wc * 32 + _fq * 8;
        f32x4 bg[2], bu[2];
#pragma unroll
        for (int n = 0; n < 2; ++n) { bg[n] = *(const LAS f32x4*)(bin + n * 4); bu[n] = *(const LAS f32x4*)(bin + 128 + n * 4) + 1.f; }
        (void)e;
#pragma unroll
        for (int ai = 0; ai < 2; ++ai)
#pragma unroll
            for (int m = 0; m < 4; ++m) { const int lr = ai * 128 + _wr * 64 + m * 16 + _fr;
                unsigned char* orow = ACT + ((size_t)mt * 256 + lr) * 1024 + n8 * 128 + _wc * 32 + _fq * 8;
                u32x2 pk;
#pragma unroll
                for (int n = 0; n < 2; ++n) {
                    float o[4];
#pragma unroll
                    for (int h2 = 0; h2 < 2; ++h2) {
                        const f32v2_t ag = {acc[ai][0][m][n][2 * h2], acc[ai][0][m][n][2 * h2 + 1]}, au = {acc[ai][1][m][n][2 * h2], acc[ai][1][m][n][2 * h2 + 1]};
                        const f32v2_t bgv = {bg[n][2 * h2], bg[n][2 * h2 + 1]}, buv = {bu[n][2 * h2], bu[n][2 * h2 + 1]};
                        f32v2_t g2 = ag * (1.f / 256.f) + bgv, u2 = au * (1.f / 256.f) + buv;
                        g2[0] = fminf(g2[0], 7.f); g2[1] = fminf(g2[1], 7.f);
                        u2[0] = __builtin_amdgcn_fmed3f(u2[0], -6.f, 8.f); u2[1] = __builtin_amdgcn_fmed3f(u2[1], -6.f, 8.f);
                        const f32v2_t t2 = g2 * (-2.4554669595930156f);
                        f32v2_t e2; e2[0] = __builtin_amdgcn_exp2f(t2[0]); e2[1] = __builtin_amdgcn_exp2f(t2[1]);
                        const f32v2_t d2 = e2 + 1.f;
                        f32v2_t r2; r2[0] = __builtin_amdgcn_rcpf(d2[0]); r2[1] = __builtin_amdgcn_rcpf(d2[1]);
                        const f32v2_t o2 = u2 * g2 * r2;
                        o[2 * h2] = o2[0]; o[2 * h2 + 1] = o2[1]; }
                    if (n == 0) pk.x = pk_fp8x4(o[0], o[1], o[2], o[3]); else pk.y = pk_fp8x4(o[0], o[1], o[2], o[3]); }
                *(u32x2*)orow = pk; }
    }
};
DI void phase_moe1(const Params& p, LAS char* shm, int l, const int wv_) {
    LAS int* tstart = (LAS int*)(shm + LDS_MISC + 64);
    moe_tiles(p, tstart, l, wv_);
    PvMoe1 pv{p, l, tstart, shm + 131072, {tstart[32]}}; gemm_stream(shm, pv, wv_);
}
struct PvMoe2 {
    const Params& p; int l; const LAS int* tstart; LAS char* tbl;
    static constexpr int NT = 8; static constexpr int FP8 = 2; static constexpr bool PARK = false; typedef APlain AS; typedef BSeq16 BS;
    XcdDeal<4, 4> deal;
    DI int first() const { return deal.first(); }
    DI int next(int u) const { return deal.next(u); }
    template <class A_> DI void fix(A_&, bool, const int) const {}
    typedef u32x4 Aux;
    DI void top(int u, Aux& aux, const int wv_) const {
        int mt, n4; deal.decode(u, mt, n4);
        const int ev_ = moe_find(tstart, mt); const int e = ev_ & 255; const int r0 = (ev_ >> 8) * 256;
        const int t_ = otid();
        const char* src_ = t_ < 128 ? (const char*)((const int*)(p.ws + WS_LIST) + (size_t)e * TT * 2 + (size_t)(r0 + 2 * t_) * 2)
                                    : (const char*)(p.exp_b_out + (size_t)(l * NE + e) * 1024 + n4 * 256 + ((t_ - 128) & 63) * 4);
        aux = aload128(src_);
    }
    DI void mid(Aux& aux, const int wv_) const { const int t_ = otid(); asm volatile("" : "+v"(aux)); if (t_ < 192) *(LAS u32x4*)(tbl + t_ * 16) = aux; }
    DI void src(int u, AS& as, BS& bs, const int wv_) const {
        int mt, n4; deal.decode(u, mt, n4);
        const int ev_ = moe_find(tstart, mt); const int e = ev_ & 255;
        as.base = (const char*)(p.ws + WS_RA) + (size_t)mt * 256 * 1024; as.lda2 = 1024;
        const char* W = (const char*)(p.ws + WS_W2) + (size_t)(l * NE + e) * 1024 * 1024;
        bs.base = W + (size_t)(n4 * 256) * 1024; bs.ldb2 = 1024;
    }
    DI void epi(f32x4 (&acc)[2][2][4][2], int u, const int wv_) const {
        int mt, n4; deal.decode(u, mt, n4);
        const int ev_ = moe_find(tstart, mt); const int e = ev_ & 255;
        const int r0 = (ev_ >> 8) * 256, cnt = ((const int*)(p.ws + WS_CNT))[l * 32 + e];
        const int* lst = (const int*)(p.ws + WS_LIST) + (size_t)e * TT * 2;
        unsigned char* Y = (unsigned char*)(p.ws + WS_RY);
        const int _tz = otid(), _w = _tz >> 6, _l = _tz & 63, _wr = _w >> 2, _wc = _w & 3, _fr = _l & 15, _fq = _l >> 4;
        const LAS float* bo = (const LAS float*)(tbl + 2048) + _wc * 64 + _fq * 16;
        u32x2 ent[2][4]; f32x4 bv[2][2];
#pragma unroll
        for (int ai = 0; ai < 2; ++ai)
#pragma unroll
            for (int m = 0; m < 4; ++m) ent[ai][m] = *(const LAS u32x2*)(tbl + (ai * 128 + _wr * 64 + m * 16 + _fr) * 8);
#pragma unroll
        for (int bj = 0; bj < 2; ++bj)
#pragma unroll
            for (int n = 0; n < 2; ++n) bv[bj][n] = *(const LAS f32x4*)(bo + bj * 8 + n * 4);
        (void)lst;
#pragma unroll
        for (int ai = 0; ai < 2; ++ai)
#pragma unroll
            for (int m = 0; m < 4; ++m) { const int lr = r0 + ai * 128 + _wr * 64 + m * 16 + _fr;
                if (lr < cnt) { const float w = __uint_as_float(ent[ai][m].y) * YSCALE; unsigned char* orow = Y + (size_t)ent[ai][m].x * 1024 + n4 * 256 + _wc * 64 + _fq * 16;
                    const float sc_ = 1.f / 256.f;
                    u32x4 pk;
#pragma unroll
                    for (int bj = 0; bj < 2; ++bj)
#pragma unroll
                        for (int n = 0; n < 2; ++n) { const f32x4 v = (acc[ai][bj][m][n] * sc_ + bv[bj][n]) * w;
                            pk[bj * 2 + n] = pk_fp8x4(__builtin_amdgcn_fmed3f(v[0], -448.f, 448.f), __builtin_amdgcn_fmed3f(v[1], -448.f, 448.f), __builtin_amdgcn_fmed3f(v[2], -448.f, 448.f), __builtin_amdgcn_fmed3f(v[3], -448.f, 448.f)); }
                    *(u32x4*)orow = pk; } }
    }
};
DI void phase_moe2(const Params& p, LAS char* shm, int l, const int wv_) {
    LAS int* tstart = (LAS int*)(shm + LDS_MISC + 64);
    moe_tiles(p, tstart, l, wv_);
    PvMoe2 pv{p, l, tstart, shm + 131072, {tstart[32]}}; gemm_stream(shm, pv, wv_);
}

DI void phase_combine(const Params& p, LAS char* shm, int l, const int wv_) {
    const int tid = otid(), wid = tid >> 6, lane = tid & 63;
    const bool alt = p.ph_lo != 0;
    const bf16_t* X = (const bf16_t*)(p.ws + WS_X);
    bf16_t* XO = alt ? (bf16_t*)(p.ws + WS_RA) : (bf16_t*)(p.ws + WS_X);
    float* OUT = alt ? (float*)(p.ws + WS_RA) : p.out;
    const unsigned char* Y = (const unsigned char*)(p.ws + WS_RY);
    const float* MOD = (const float*)(p.ws + WS_MOD);
    bf16_t* H = alt ? (bf16_t*)(p.ws + WS_RA + (size_t)TT * 1024 * 4) : (bf16_t*)(p.ws + WS_H);
    const int Tm = (l == 1) ? TX : TT;
    for (int r = blockIdx.x * 8 + wid; r < Tm; r += gridDim.x * 8) {
        const float* g2 = MOD + (size_t)(l * 33 + mod_row(r)) * 6144 + 5120;
        float v[16];
#pragma unroll
        for (int j = 0; j < 4; ++j) {
            const int col = j * 256 + lane * 4;
            f32x4 s = (f32x4){0.f, 0.f, 0.f, 0.f};
#pragma unroll
            for (int k = 0; k < 4; ++k) { const int yy = *(const int*)(Y + ((size_t)r * 4 + k) * 1024 + col); const f32v2_t ya = __builtin_amdgcn_cvt_pk_f32_fp8(yy, false), yb = __builtin_amdgcn_cvt_pk_f32_fp8(yy, true);
                s[0] += ya[0]; s[1] += ya[1]; s[2] += yb[0]; s[3] += yb[1]; }
            s *= 1.f / YSCALE;
            const u32x2 xb_ = *(const u32x2*)(X + (size_t)r * 1024 + col); const f32x4 gg = *(const f32x4*)(g2 + col);
            const f32x4 xv = (f32x4){bflo(xb_.x), bfhi(xb_.x), bflo(xb_.y), bfhi(xb_.y)};
            const f32x4 o = xv + gg * s;
            if (l == 1) *(f32x4*)(OUT + (size_t)r * 1024 + col) = o; else store_bf16x4(XO + (size_t)r * 1024 + col, o[0], o[1], o[2], o[3]);
            v[j * 4] = o[0]; v[j * 4 + 1] = o[1]; v[j * 4 + 2] = o[2]; v[j * 4 + 3] = o[3];
        }
        if (l == 0) norm_mod_store(v, p.norm1_g + 1024, MOD + (size_t)(1 * 33 + mod_row(r)) * 6144, H + (size_t)r * 1024, wv_);
    }
}

constexpr int NPH_LAYER = 10;
constexpr int NPH = 2 + 2 * NPH_LAYER;

__global__ void __launch_bounds__(512, 2) mk_forward(Params p_unused) {
    extern __shared__ __attribute__((aligned(16))) char smem_raw[];
    LAS char* shm = (LAS char*)smem_raw;
    volatile LAS unsigned* xb_words = (volatile LAS unsigned*)(shm + LDS_MISC);
    const int wv_ = __builtin_amdgcn_readfirstlane((int)(threadIdx.x >> 6));
    if (wv_ == 0 && olane() < 4) xb_words[olane()] = 0u;
    __syncthreads();
    kaptr_t ka = (kaptr_t)__builtin_amdgcn_kernarg_segment_ptr();
    const int tok0 = ptoken();
    const int lo = (int)kld64<__builtin_offsetof(Params, ph_lo)>(ka, tok0), hi = (int)kld64<__builtin_offsetof(Params, ph_hi)>(ka, tok0);
    const bool multi = (hi - lo) > 1;
    unsigned* barw = (unsigned*)((__attribute__((address_space(1))) char*)kld64<__builtin_offsetof(Params, ws)>(ka, tok0) + WS_BAR);
    XcdBarrier bar; bar.bar = barw; bar.x = 0; bar.st = xb_words;
    if (multi) bar = xcd_barrier_post(barw, xb_words, wv_);
#ifndef ONLY_KIND
#define ONLY_KIND (-1)
#endif
#define PHASE(idx, kind, FN, ...) do { if ((ONLY_KIND < 0 || ONLY_KIND == (kind)) && (idx) >= lo && (idx) < hi) { const Params p = kparams(ka, ptoken()); int nrep_ = 1 + ((MK_REPEAT_MASK >> (kind)) & 1); asm volatile("" : "+s"(nrep_)); for (int rep_ = 0; rep_ < nrep_; ++rep_) { Params p2 = p; p2.ph_lo = rep_; FN(p2, ##__VA_ARGS__, wv_); } if ((idx) + 1 < hi) xcd_barrier(bar, wv_); } } while (0)
    PHASE(0, 0, phase_prologue, shm);
    PHASE(1, 1, phase_norm1_l0);
    for (int l = 0; l < 2; ++l) {
        const int b0 = 2 + l * NPH_LAYER;
        PHASE(b0 + 0, 2, phase_inproj, shm, l);
        PHASE(b0 + 1, 3, phase_A, shm, l);
        PHASE(b0 + 2, 4, phase_B, shm, l);
        PHASE(b0 + 3, 5, phase_C, shm, l);
        PHASE(b0 + 4, 6, phase_D, shm, l);
        PHASE(b0 + 5, 7, phase_E, shm, l);
        PHASE(b0 + 6, 8, phase_router, shm, l);
        PHASE(b0 + 7, 9, phase_moe1, shm, l);
        PHASE(b0 + 8, 10, phase_moe2, shm, l);
        PHASE(b0 + 9, 11, phase_combine, shm, l);
    }
#undef PHASE
}


extern "C" void kernel_launch(void* const* d_in, const int* in_sizes, int n_in, void* d_out, int out_size, void* d_ws, size_t ws_size, hipStream_t stream) {
    static int grid = 0;
    if (grid == 0) {
        if (n_in != 39 || ws_size < WS_END) { fprintf(stderr, "kernel_launch: unexpected n_in %d or ws_size %zu (< %zu)\n", n_in, ws_size, (size_t)WS_END); grid = -1; return; }
        int dev = 0, cus = 0;
        if (hipGetDevice(&dev) != hipSuccess || hipDeviceGetAttribute(&cus, hipDeviceAttributeMultiprocessorCount, dev) != hipSuccess) { grid = -1; return; }
        if (hipFuncSetAttribute((const void*)mk_forward, hipFuncAttributeMaxDynamicSharedMemorySize, LDS_BYTES) != hipSuccess) { fprintf(stderr, "kernel_launch: hipFuncSetAttribute failed\n"); grid = -1; return; }
        int per_cu = 0;
        if (hipOccupancyMaxActiveBlocksPerMultiprocessor(&per_cu, (const void*)mk_forward, 512, LDS_BYTES) != hipSuccess || per_cu < 1) fprintf(stderr, "kernel_launch: occupancy query says %d\n", per_cu);
        (void)hipGetLastError();
        grid = cus > 256 ? 256 : cus;
    }
    if (grid < 0) return;
    (void)hipMemsetAsync((char*)d_ws + WS_BAR, 0, 16384 + 1024, stream);
    Params p{};
    const float** pf = (const float**)&p;
    for (int i = 0; i < 39; ++i) pf[i] = (const float*)d_in[i];
    p.out = (float*)d_out; p.ws = (char*)d_ws;
#if MK_ONE_LAUNCH
    p.ph_lo = 0; p.ph_hi = NPH;
    hipLaunchKernelGGL(mk_forward, dim3(grid), dim3(512), LDS_BYTES, stream, p);
#else
#ifndef MK_LAST_PHASE
#define MK_LAST_PHASE NPH
#endif
    for (int ph = 0; ph < MK_LAST_PHASE; ++ph) { p.ph_lo = ph; p.ph_hi = ph + 1; hipLaunchKernelGGL(mk_forward, dim3(grid), dim3(512), LDS_BYTES, stream, p); }
#endif
}
```

```cpp
#include <hip/hip_runtime.h>
#include <stdint.h>
#include <stdio.h>

#ifndef MK_REPEAT_MASK
#define MK_REPEAT_MASK 0x0
#endif
#ifndef MK_ONE_LAUNCH
#define MK_ONE_LAUNCH 1
#endif

#define DI __device__ __forceinline__
#define LAS __attribute__((address_space(3)))
typedef unsigned short bf16_t;
typedef short bf16x8 __attribute__((ext_vector_type(8)));
typedef short s16x4 __attribute__((ext_vector_type(4)));
typedef float f32x4 __attribute__((ext_vector_type(4)));
typedef float f32x16 __attribute__((ext_vector_type(16)));
typedef unsigned u32x2 __attribute__((ext_vector_type(2)));
typedef unsigned u32x4 __attribute__((ext_vector_type(4)));
typedef int i32x4 __attribute__((ext_vector_type(4)));
typedef int i32x8 __attribute__((ext_vector_type(8)));

constexpr int D = 1024, NB = 32, SEQ = 2048, CTXL = 256;
constexpr int TX = NB * SEQ, TC = NB * CTXL, TT = TX + TC;
constexpr int NINP = 1536;
constexpr int OFF_POOL = 512, OFF_Q = 768, OFF_SSM = 960, OFF_KV = 1216, OFF_KPE = 1344, N_IN = 1376;
constexpr int NE = 32;
constexpr int NCH = 36;
constexpr int NCROW = NB * NCH;
constexpr float EPS = 1e-6f;

constexpr size_t WS_BAR = 0;
constexpr size_t WS_CNT = 16384;
constexpr size_t WS_MOD = WS_CNT + 1024;
constexpr size_t WS_A64 = WS_MOD + (size_t)2 * 33 * 6144 * 4;
constexpr size_t WS_WMI = WS_A64 + (size_t)2 * 2 * 16 * 64 * 2 * 4;
constexpr size_t WS_WMO = WS_WMI + (size_t)2 * 1536 * 1024 * 2;
constexpr size_t WS_WPW = WS_WMO + (size_t)2 * 1024 * 1024 * 2;
constexpr size_t WS_WGLU = WS_WPW + (size_t)2 * 256 * 256 * 2;
constexpr size_t WS_WPOOL = WS_WGLU + (size_t)2 * 256 * 256 * 2;
constexpr size_t WS_WQ = WS_WPOOL + (size_t)2 * 256 * 256 * 2;
constexpr size_t WS_WKV = WS_WQ + (size_t)2 * 512 * 256 * 2;
constexpr size_t WS_TS5 = WS_WKV + (size_t)2 * 512 * 256 * 2;
constexpr size_t WS_WS5 = WS_TS5 + (size_t)2 * 16 * 1024 * 1280 * 2;
constexpr size_t WS_W1 = WS_WS5 + (size_t)2 * 16 * 256 * 1024 * 2;
constexpr size_t WS_W2 = WS_W1 + (size_t)32 * 2048 * 1024 * 2;
constexpr size_t WS_X = WS_W2 + (size_t)32 * 1024 * 1024 * 2;
constexpr size_t WS_H = WS_X + (size_t)TT * 1024 * 4;
constexpr size_t WS_LIST = WS_H + (size_t)TT * 1024 * 2;
constexpr size_t WS_TOPW = WS_LIST + (size_t)32 * TT * 8;
constexpr size_t WS_RA = WS_TOPW + (size_t)TT * 4 * 4;
constexpr float YSCALE = 32.f;
constexpr size_t WS_RY = WS_RA + (size_t)TT * 4 * 1024 * 2;
constexpr size_t WS_END = WS_RY + (size_t)TT * 4 * 1024 * 2;
constexpr size_t WS_P = WS_RA;
constexpr size_t WS_ACONV = WS_P + (size_t)TT * NINP * 2;
constexpr size_t WS_APOOL = WS_ACONV + (size_t)TT * 256 * 2;
constexpr size_t WS_RAWQ = WS_APOOL + (size_t)TT * 256 * 2;
constexpr size_t WS_RAWKV = WS_RAWQ + (size_t)TT * 512 * 4;
constexpr size_t WS_Q = WS_RAWKV + (size_t)TT * 512 * 4;
constexpr size_t WS_KB = WS_Q + (size_t)TT * 384 * 2;
constexpr size_t WS_VT = WS_KB + (size_t)128 * 2304 * 96 * 2;
constexpr size_t WS_SST = WS_VT + (size_t)128 * 64 * 2304 * 2;
constexpr size_t WS_HIN = WS_SST + (size_t)NCROW * 16 * 256 * 4;
constexpr size_t WS_Z = WS_HIN + (size_t)NCROW * 16 * 256 * 2;
constexpr size_t WS_CAT = WS_Z + (size_t)TT * 256 * 2;
constexpr size_t WS_MIX_END = WS_CAT + (size_t)TT * 1024 * 2;
static_assert(WS_MIX_END <= WS_END, "mixer buffers must fit in the ACT/Y regions");
static_assert(WS_END <= (size_t)2147483648ull, "workspace budget");

constexpr int LDS_BYTES = 147456;
constexpr int LDS_TTAB = 131072 + 8192;
constexpr int LDS_MISC = 146432;

struct Params {
    const float *x, *c, *ctx, *c_ctx, *ada_w, *ada_b, *norm1_g, *norm2_g, *w_mix_in, *w_mix_out,
        *conv_dw, *conv_dw_b, *conv_ln_g, *conv_ln_b, *conv_pw, *pool_w, *pool_scale,
        *ssm_a_re, *ssm_a_im, *ssm_log_dt, *ssm_b_re, *ssm_b_im, *ssm_c_re, *ssm_c_im, *ssm_d, *ssm_glu_w, *ssm_glu_b,
        *mla_q_a_g, *mla_wq_b, *mla_kv_a_g, *mla_wkv_b, *mla_q_g, *mla_k_g,
        *router_w, *router_b, *exp_w_in, *exp_b_in, *exp_w_out, *exp_b_out;
    float* out;
    char* ws;
    long long ph_lo, ph_hi;
};

typedef const __attribute__((address_space(4))) char* kaptr_t;
template <int OFF> DI unsigned long long kld64(kaptr_t ka, int tok) {
    unsigned long long v;
    asm("s_load_dwordx2 %0, %1, %3\n\ts_waitcnt lgkmcnt(0)" : "=&s"(v) : "s"(ka), "s"(tok), "n"(OFF));
    return v;
}
DI int ptoken() { int t; asm volatile("s_mov_b32 %0, 0" : "=s"(t)); return t; }
DI Params kparams(kaptr_t ka, int tok) {
    Params p;
#define KL_(f) p.f = (decltype(p.f))((__attribute__((address_space(1))) char*)kld64<__builtin_offsetof(Params, f)>(ka, tok))
    KL_(x); KL_(c); KL_(ctx); KL_(c_ctx); KL_(ada_w); KL_(ada_b); KL_(norm1_g); KL_(norm2_g); KL_(w_mix_in); KL_(w_mix_out); KL_(conv_dw); KL_(conv_dw_b); KL_(conv_ln_g); KL_(conv_ln_b); KL_(conv_pw); KL_(pool_w); KL_(pool_scale); KL_(ssm_a_re); KL_(ssm_a_im); KL_(ssm_log_dt); KL_(ssm_b_re); KL_(ssm_b_im); KL_(ssm_c_re); KL_(ssm_c_im); KL_(ssm_d); KL_(ssm_glu_w); KL_(ssm_glu_b); KL_(mla_q_a_g); KL_(mla_wq_b); KL_(mla_kv_a_g); KL_(mla_wkv_b); KL_(mla_q_g); KL_(mla_k_g); KL_(router_w); KL_(router_b); KL_(exp_w_in); KL_(exp_b_in); KL_(exp_w_out); KL_(exp_b_out); KL_(out); KL_(ws);
#undef KL_
    p.ph_lo = 0; p.ph_hi = 0;
    return p;
}

typedef __bf16 bf16v2_t __attribute__((ext_vector_type(2)));
typedef float f32v2_t __attribute__((ext_vector_type(2)));
DI unsigned pk_bf16(float lo, float hi) { const f32v2_t f = {lo, hi}; const bf16v2_t b = __builtin_convertvector(f, bf16v2_t); return __builtin_bit_cast(unsigned, b); }
DI bf16_t f2bf(float x) { return (bf16_t)(pk_bf16(x, 0.f) & 0xffffu); }
DI float bf2f(bf16_t v) { return __uint_as_float(((unsigned)v) << 16); }
DI unsigned f2fp8(float x) { x = fminf(fmaxf(x, -448.f), 448.f); return (unsigned)__builtin_amdgcn_cvt_pk_fp8_f32(x, x, 0, false) & 0xffu; }
DI unsigned pk_fp8x4(float a, float b, float c, float d) { int v = __builtin_amdgcn_cvt_pk_fp8_f32(a, b, 0, false); v = __builtin_amdgcn_cvt_pk_fp8_f32(c, d, v, true); return (unsigned)v; }
DI float bflo(unsigned u) { return __uint_as_float(u << 16); }
DI float bfhi(unsigned u) { return __uint_as_float(u & 0xffff0000u); }
DI int olane() { int l = (int)__builtin_amdgcn_mbcnt_hi(~0u, __builtin_amdgcn_mbcnt_lo(~0u, 0u)); asm volatile("" : "+v"(l)); return l; }
DI float shx(float v, int o) { const int l = olane(); return __int_as_float(__builtin_amdgcn_ds_bpermute((l ^ o) << 2, __float_as_int(v))); }
DI float shi(float v, int src) { return __int_as_float(__builtin_amdgcn_ds_bpermute(src << 2, __float_as_int(v))); }
#define otid() otid_(wv_)
DI int otid_(int wv) { int t = (wv << 6) | olane(); asm volatile("" : "+v"(t)); return t; }
DI float wave_sum(float v) {
#pragma unroll
    for (int o = 32; o > 0; o >>= 1) v += shx(v, o);
    return v;
}
DI float wave_max(float v) {
#pragma unroll
    for (int o = 32; o > 0; o >>= 1) v = fmaxf(v, shx(v, o));
    return v;
}
DI float sigmoidf_(float x) { return __builtin_amdgcn_rcpf(1.f + __builtin_amdgcn_exp2f(-1.4426950408889634f * x)); }
DI float siluf_(float x) { return x * sigmoidf_(x); }
DI float gelu_tanh(float x) {
    const float u = 0.7978845608028654f * (x + 0.044715f * x * x * x);
    return x * __builtin_amdgcn_rcpf(1.f + __builtin_amdgcn_exp2f(-2.8853900817779268f * u));
}
DI unsigned aload32(const void* p_) { unsigned r; asm volatile("global_load_dword %0, %1, off" : "=v"(r) : "v"(p_) : "memory"); return r; }
DI u32x4 aload128(const void* p_) { u32x4 r; asm volatile("global_load_dwordx4 %0, %1, off" : "=v"(r) : "v"(p_) : "memory"); return r; }
#define PV_NOHOOKS typedef int Aux; static constexpr bool BIASINIT = false; DI void top(int, Aux&, const int) const {} DI void mid(Aux&, const int, const int) const {} template <class A_> DI void fix(A_&, bool, const int) const {}
DI void glds16(const void* src, LAS char* dst) {
    __builtin_amdgcn_global_load_lds((const __attribute__((address_space(1))) void*)src, (LAS void*)dst, 16, 0, 0);
}

#define XB_TMO      128
#define XB_XCNT(j)  (256  + 64 * (j))
#define XB_XSUB(j)  (1280 + 64 * (j))
#define XB_XGEN(j)  (2304 + 64 * (j))
#define XB_TOP      3328
#define XB_TOPGEN   3392
#define XCD_BAR_WORDS 3456
#define XB_SPIN_CAP (1u << 18)
__device__ __forceinline__ unsigned xb_ld(unsigned* p)              { return __hip_atomic_load(p, __ATOMIC_RELAXED, __HIP_MEMORY_SCOPE_AGENT); }
__device__ __forceinline__ unsigned xb_add(unsigned* p, unsigned v) { return __hip_atomic_fetch_add(p, v, __ATOMIC_RELAXED, __HIP_MEMORY_SCOPE_AGENT); }
__device__ __forceinline__ unsigned xb_xcc_id() { return (unsigned)__builtin_amdgcn_s_getreg((3 << 11) | 20) & 0xFu; }
#define XB_SPIN(cond, bar) do { unsigned _sp = 0; while (cond) { __builtin_amdgcn_s_sleep(1); \
    if ((++_sp & 255u) == 0u) { if (xb_ld(&(bar)[XB_TMO])) break; if (_sp > XB_SPIN_CAP) { atomicAdd(&(bar)[XB_TMO], 1u); break; } } } } while (0)
struct XcdBarrier { unsigned* bar; unsigned x; volatile LAS unsigned* st; };
__device__ __forceinline__ XcdBarrier xcd_barrier_post(unsigned* bar, volatile LAS unsigned* st, const int wv_) {
    XcdBarrier b; b.bar = bar; b.x = xb_xcc_id(); b.st = st;
    if (otid() == 0) (void)xb_add(&bar[XB_XCNT(b.x)], 1u);
    return b;
}
__device__ __forceinline__ void xcd_barrier_complete(unsigned* bar, unsigned x, unsigned& nloc, unsigned& nx) {
    const unsigned G = gridDim.x * gridDim.y * gridDim.z;
    unsigned sum, cnt, mine, sp = 0u;
    for (;;) {
        sum = 0u; cnt = 0u; mine = 0u;
#pragma unroll
        for (unsigned j = 0; j < 16; ++j) { const unsigned c = xb_ld(&bar[XB_XCNT(j)]); sum += c; cnt += (c > 0u) ? 1u : 0u; mine = (j == x) ? c : mine; }
        if (sum == G) break;
        __builtin_amdgcn_s_sleep(1);
        if ((++sp & 255u) == 0u) { if (xb_ld(&bar[XB_TMO])) break; if (sp > XB_SPIN_CAP) { atomicAdd(&bar[XB_TMO], 1u); break; } }
    }
    nloc = mine > 0u ? mine : 1u; nx = cnt > 0u ? cnt : 1u;
}
__device__ __forceinline__ void xcd_barrier(const XcdBarrier& b, const int wv_) {
    asm volatile("s_waitcnt vmcnt(0)" ::: "memory");
    __syncthreads();
    if (otid() == 0) {
        unsigned* bar = b.bar;
        __builtin_amdgcn_s_waitcnt(0);
        unsigned nloc = b.st[0], nx = b.st[1];
        if (nloc == 0u) { xcd_barrier_complete(bar, b.x, nloc, nx); b.st[0] = nloc; b.st[1] = nx; }
        const unsigned old = xb_add(&bar[XB_XSUB(b.x)], 1u);
        const unsigned gen = old / nloc;
        if (old + 1u == (gen + 1u) * nloc) {
            __builtin_amdgcn_fence(__ATOMIC_RELEASE, "agent");
            asm volatile("s_waitcnt vmcnt(0)" ::: "memory");
            const unsigned og = xb_add(&bar[XB_TOP], 1u);
            const unsigned tg = og / nx;
            if (og + 1u == (tg + 1u) * nx) xb_add(&bar[XB_TOPGEN], 1u);
            else XB_SPIN(xb_ld(&bar[XB_TOPGEN]) == tg, bar);
            __builtin_amdgcn_fence(__ATOMIC_ACQUIRE, "agent");
            xb_add(&bar[XB_XGEN(b.x)], 1u);
            asm volatile("s_waitcnt vmcnt(0)" ::: "memory");
        } else {
            XB_SPIN(xb_ld(&bar[XB_XGEN(b.x)]) == gen, bar);
            __builtin_amdgcn_fence(__ATOMIC_ACQUIRE, "agent");
            asm volatile("s_waitcnt vmcnt(0)" ::: "memory");
        }
    }
    __syncthreads();
}

constexpr int HTB = 128 * 64 * 2;
DI int lds_byte(int r, int c) { const int st = (r >> 4) * 2 + (c >> 5), rr = r & 15, cc = c & 31, ob = rr * 64 + cc * 2; return st * 1024 + (ob ^ (((ob >> 9) & 1) << 5)); }
DI void stage_rc(int b, int& R, int& C) { const int st = b / 1024, sb = b % 1024, swz = sb ^ (((sb >> 9) & 1) << 5); R = (st >> 1) * 16 + swz / 64; C = (st & 1) * 32 + (swz % 64) / 2; }

DI void stage_rc_t(int tz, int i, int& R, int& C) { stage_rc(tz * 16 + i * 8192, R, C); }
struct APlain {
    const char* base; int lda2;
    DI void park(LAS unsigned*) const {} DI void unpark(const LAS unsigned*) {} DI void take_uniform(const APlain&) {}
    DI const char* ptr(int tz, int h, int i, int kt) const { int R, C; stage_rc_t(tz, i, R, C); return base + (unsigned)((h * 128 + R) * lda2 + C * 2 + kt * 128); }
};
struct ASimple {
    const char* base; unsigned off[2][2]; unsigned kstride;
    DI void park(LAS unsigned* q) const { *(LAS u32x4*)q = (u32x4){off[0][0], off[0][1], off[1][0], off[1][1]}; }
    DI void unpark(const LAS unsigned* q) { const u32x4 v = *(const LAS u32x4*)q; off[0][0] = v.x; off[0][1] = v.y; off[1][0] = v.z; off[1][1] = v.w; }
    DI void take_uniform(const ASimple& o) { base = o.base; kstride = o.kstride; }
    DI const char* ptr(int tz, int h, int i, int kt) const { return base + (unsigned)(off[h][i] + (unsigned)kt * kstride); }
};
struct ASeg2 {
    const char* base0; const char* base1; unsigned off0[2][2]; unsigned off1[2][2]; unsigned ks0; int nt0;
    DI void park(LAS unsigned*) const {} DI void unpark(const LAS unsigned*) {} DI void take_uniform(const ASeg2&) {}
    DI const char* ptr(int tz, int h, int i, int kt) const { return kt < nt0 ? base0 + (unsigned)(off0[h][i] + (unsigned)kt * ks0) : base1 + (unsigned)(off1[h][i] + (unsigned)(kt - nt0) * 128u); }
};
DI int perm32(int rho) { const int n = rho >> 4, i = rho & 15; return 8 * (i >> 2) + 4 * n + (i & 3); }
struct BSimple {
    const char* base[2]; int ldb2;
    DI const char* ptr(int tz, int h, int i, int kt) const { int R, C; stage_rc_t(tz, i, R, C); const int Rb = (R & ~31) + perm32(R & 31); return base[h] + (unsigned)(Rb * ldb2 + C * 2 + kt * 128); }
};

struct BSeq16 {
    const char* base; int ldb2;
    DI const char* ptr(int tz, int h, int i, int kt) const { int R, C; stage_rc_t(tz, i, R, C); const int rho = R & 31;
        const int Rb = (R >> 5) * 64 + ((rho & 15) >> 2) * 16 + h * 8 + (rho >> 4) * 4 + (rho & 3); return base + (unsigned)(Rb * ldb2 + C * 2 + kt * 128); }
};

#define WAIT_V(n) asm volatile("s_waitcnt vmcnt(" #n ")" ::: "memory")
#define WAIT_L(n) asm volatile("s_waitcnt lgkmcnt(" #n ")" ::: "memory")
#define BAR_ __builtin_amdgcn_s_barrier()
#define SCHED_ __builtin_amdgcn_sched_barrier(0)

DI void zero_acc(f32x4 (&acc)[2][2][4][2]) {
#pragma unroll
    for (int a = 0; a < 2; ++a)
#pragma unroll
        for (int b = 0; b < 2; ++b)
#pragma unroll
            for (int m = 0; m < 4; ++m)
#pragma unroll
                for (int n = 0; n < 2; ++n) acc[a][b][m][n] = (f32x4){0.f, 0.f, 0.f, 0.f};
}
template <int MODE> struct FragT;
template <> struct FragT<0> {
    i32x4 lo, hi;
    DI void load(const LAS char* p0, const LAS char* p1) { lo = *(const LAS i32x4*)p0; hi = *(const LAS i32x4*)p1; }
    static DI f32x4 mma(const FragT& b, const FragT& a, f32x4 c) {
        c = __builtin_amdgcn_mfma_f32_16x16x32_bf16(__builtin_bit_cast(bf16x8, b.lo), __builtin_bit_cast(bf16x8, a.lo), c, 0, 0, 0);
        return __builtin_amdgcn_mfma_f32_16x16x32_bf16(__builtin_bit_cast(bf16x8, b.hi), __builtin_bit_cast(bf16x8, a.hi), c, 0, 0, 0); }
};
template <> struct FragT<1> {
    i32x4 lo, hi;
    DI void load(const LAS char* p0, const LAS char* p1) { lo = *(const LAS i32x4*)p0; hi = *(const LAS i32x4*)p1; }
    static DI long pk(int x, int y) { return (long)(((unsigned long long)(unsigned)y << 32) | (unsigned)x); }
    static DI f32x4 mma(const FragT& b, const FragT& a, f32x4 c) {
        c = __builtin_amdgcn_mfma_f32_16x16x32_fp8_fp8(pk(b.lo.x, b.lo.y), pk(a.lo.x, a.lo.y), c, 0, 0, 0);
        c = __builtin_amdgcn_mfma_f32_16x16x32_fp8_fp8(pk(b.lo.z, b.lo.w), pk(a.lo.z, a.lo.w), c, 0, 0, 0);
        c = __builtin_amdgcn_mfma_f32_16x16x32_fp8_fp8(pk(b.hi.x, b.hi.y), pk(a.hi.x, a.hi.y), c, 0, 0, 0);
        return __builtin_amdgcn_mfma_f32_16x16x32_fp8_fp8(pk(b.hi.z, b.hi.w), pk(a.hi.z, a.hi.w), c, 0, 0, 0); }
};
template <> struct FragT<2> {
    i32x8 v;
    DI void load(const LAS char* p0, const LAS char* p1) { const i32x4 lo = *(const LAS i32x4*)p0, hi = *(const LAS i32x4*)p1; v = __builtin_shufflevector(lo, hi, 0, 1, 2, 3, 4, 5, 6, 7); }
    static DI f32x4 mma(const FragT& b, const FragT& a, f32x4 c) {
        const int one = 0x7f7f7f7f, wsc = 0x77777777;
        asm volatile("v_mfma_scale_f32_16x16x128_f8f6f4 %0, %1, %2, %0, %3, %4 op_sel_hi:[0,0,0]" : "+v"(c) : "v"(b.v), "v"(a.v), "v"(wsc), "v"(one));
        return c; }
};
template <class PV>
DI void gemm_stream(LAS char* shm, const PV& pv, const int wv_) {
    typedef typename PV::AS AS; typedef typename PV::BS BS;
    constexpr int nt = PV::NT;
    int u = pv.first();
    if (u < 0) return;
    const int tz = otid();
    const int wr = wv_ >> 2, wc = wv_ & 3, lane = tz & 63, fr = lane & 15, fq = lane >> 4;
    const int aoff = lds_byte(wr * 64 + fr, fq * 8), boff = lds_byte(wc * 32 + fr, fq * 8);
    const unsigned ldsw = (unsigned)wv_ * 1024u;
    f32x4 acc[2][2][4][2]; zero_acc(acc);
    typedef FragT<PV::FP8> Frag;
    Frag At[4], B0[2], B1[2];
    AS ca, na; BS cb, nb;
    pv.src(u, ca, cb, wv_); pv.fix(ca, true, wv_);
    constexpr bool F8 = PV::FP8 != 0;
    LAS unsigned* park = (LAS unsigned*)(shm + 131072) + tz * 4;
    const int aoff0 = aoff, aoff1 = aoff + 1024;
    const int boff0 = boff, boff1 = boff + 1024;
#define SA_(b, h) (((b) * 2 + (h)) * HTB)
#define SB_(b, h) ((4 + (b) * 2 + (h)) * HTB)
#define STG_(bufoff, S, h, kt) do { _Pragma("unroll") for (int i_ = 0; i_ < 2; ++i_) glds16((S).ptr(tz, h, i_, kt), shm + (bufoff) + ldsw + i_ * 8192); } while (0)
#define LDA_(dst, b, h) do { _Pragma("unroll") for (int m = 0; m < 4; ++m) dst[m].load(shm + SA_(b, h) + aoff0 + m * 2048, shm + SA_(b, h) + aoff1 + m * 2048); } while (0)
#define LDB_(dst, b, h) do { _Pragma("unroll") for (int n = 0; n < 2; ++n) dst[n].load(shm + SB_(b, h) + boff0 + n * 2048, shm + SB_(b, h) + boff1 + n * 2048); } while (0)
#define MMA2_(ai, A_, BA_, BB_) do { __builtin_amdgcn_s_setprio(1); \
        _Pragma("unroll") for (int m = 0; m < 4; ++m) _Pragma("unroll") for (int n = 0; n < 2; ++n) acc[ai][0][m][n] = Frag::mma(BA_[n], A_[m], acc[ai][0][m][n]); \
        _Pragma("unroll") for (int m = 0; m < 4; ++m) _Pragma("unroll") for (int n = 0; n < 2; ++n) acc[ai][1][m][n] = Frag::mma(BB_[n], A_[m], acc[ai][1][m][n]); \
        __builtin_amdgcn_s_setprio(0); } while (0)
#define CMEM_ asm volatile("" ::: "memory")
    STG_(SB_(0, 0), cb, 0, 0); STG_(SB_(0, 1), cb, 1, 0); STG_(SA_(0, 0), ca, 0, 0); STG_(SA_(0, 1), ca, 1, 0);
    int par = 0;
    { typename PV::Aux aux0; pv.top(u, aux0, wv_); WAIT_V(0); pv.mid(aux0, wv_, 0); WAIT_L(0); }
    if (wr == 1) BAR_;
    BAR_; CMEM_;
#define ZQ_(ai, bj) do { if constexpr (PV::BIASINIT) pv.binit(acc[ai][bj], bj, par, wv_); else { _Pragma("unroll") for (int m_ = 0; m_ < 4; ++m_) _Pragma("unroll") for (int n_ = 0; n_ < 2; ++n_) acc[ai][bj][m_][n_] = (f32x4){0.f, 0.f, 0.f, 0.f}; } } while (0)
    int un = -1; bool has_next = false;
    na = ca; nb = cb;
    for (;;) {
        typename PV::Aux aux;
#pragma clang loop unroll(disable)
        for (int t = 0; t < nt; t += 2) {
            const bool last = (t == nt - 2);
            if (last && has_next) pv.fix(na, false, wv_);
            AS a2 = last ? na : ca; const BS b2 = last ? nb : cb; const int k2 = last ? 0 : t + 2;
            STG_(SB_(1, 0), cb, 0, t + 1); STG_(SB_(1, 1), cb, 1, t + 1); STG_(SA_(1, 0), ca, 0, t + 1); SCHED_;
            LDB_(B0, 0, 0); LDB_(B1, 0, 1); SCHED_; LDA_(At, 0, 0); SCHED_;
            if (t == 0) { ZQ_(0, 0); ZQ_(0, 1); }
            WAIT_V(6); BAR_; WAIT_L(0); MMA2_(0, At, B0, B1); BAR_; SCHED_; CMEM_;
            if (t == 2 && has_next) pv.top(un, aux, wv_);
            STG_(SA_(1, 1), ca, 1, t + 1); SCHED_;
            LDA_(At, 0, 1); SCHED_;
            if (t == 0) { ZQ_(1, 0); ZQ_(1, 1); }
            WAIT_V(2); BAR_; WAIT_L(0); if (t == 2 && has_next) pv.mid(aux, wv_, par ^ 1); MMA2_(1, At, B0, B1); BAR_; SCHED_; CMEM_;
            STG_(SB_(0, 0), b2, 0, k2); STG_(SB_(0, 1), b2, 1, k2); STG_(SA_(0, 0), a2, 0, k2); SCHED_;
            LDB_(B0, 1, 0); LDB_(B1, 1, 1); SCHED_; LDA_(At, 1, 0); SCHED_;
            WAIT_V(6); BAR_; WAIT_L(0); MMA2_(0, At, B0, B1); BAR_; SCHED_; CMEM_;
            STG_(SA_(0, 1), a2, 1, k2); SCHED_;
            LDA_(At, 1, 1); SCHED_;
            WAIT_V(2);
            if (t == 0) { un = pv.next(u); has_next = un >= 0; if (has_next) pv.src(un, na, nb, wv_); else { na = ca; nb = cb; } }
            BAR_; WAIT_L(0); MMA2_(1, At, B0, B1); BAR_; SCHED_; CMEM_;
        }
        if (PV::FP8 == 2) asm volatile("s_nop 15\n\ts_nop 15" ::: "memory");
        pv.epi(acc, u, wv_, par);
        if (!has_next) break;
        u = un; ca = na; cb = nb; par ^= 1;
    }
#undef ZQ_
    WAIT_V(0);
    if (wr == 0) BAR_;
    BAR_;
#undef SA_
#undef SB_
#undef STG_
#undef LDA_
#undef LDB_
#undef MMA2_
#undef CMEM_
}
DI int lin_first(int shift, int count) { const int G = gridDim.x; const int u = (int)((blockIdx.x + G - (shift % G)) % G); return u < count ? u : -1; }
DI int lin_next(int u, int count) { const int un = u + (int)gridDim.x; return un < count ? un : -1; }
template <int MG, int NTL> struct XcdDeal {
    int MT;
    DI bool decode(int J, int& mt, int& nt) const { const int x = blockIdx.x & 7; const int grp = (J / (MG * NTL)) * 8 + x, w = J % (MG * NTL); mt = grp * MG + w / NTL; nt = w % NTL; return mt < MT; }
    DI int jmax() const { return ((MT + 8 * MG - 1) / (8 * MG)) * (MG * NTL); }
    DI int first() const { int J = blockIdx.x >> 3; const int per = gridDim.x >> 3, jm = jmax(); int mt, nt;
        while (J < jm && !decode(J, mt, nt)) J += per;
        return J < jm ? J : -1; }
    DI int next(int J) const { const int per = gridDim.x >> 3, jm = jmax(); int mt, nt; J += per;
        while (J < jm && !decode(J, mt, nt)) J += per;
        return J < jm ? J : -1; }
};
DI int first_unit(int shift) { const int G = gridDim.x; return (int)((blockIdx.x + G - (shift % G)) % G); }

DI void stage_coords(int (&R)[2], int (&C)[2], const int wv_) {
    const int t_ = otid();
#pragma unroll
    for (int i = 0; i < 2; ++i) stage_rc(t_ * 16 + i * 8192, R[i], C[i]);
}
DI APlain make_a_plain(const bf16_t* A, size_t row0, int lda, int col0) {
    APlain a; a.base = (const char*)(A + row0 * (size_t)lda + col0); a.lda2 = lda * 2; return a;
}
DI BSimple make_b(const bf16_t* Bt0, const bf16_t* Bt1, int ldb) {
    BSimple b; b.base[0] = (const char*)Bt0; b.base[1] = (const char*)Bt1; b.ldb2 = ldb * 2; return b;
}
#define EPI_FOR(acc, ...) do { const int _tz = otid(), _w = _tz >> 6, _l = _tz & 63, _wr = _w >> 2, _wc = _w & 3, _fr = _l & 15, _fq = _l >> 4; \
    _Pragma("unroll") for (int ai = 0; ai < 2; ++ai) _Pragma("unroll") for (int m = 0; m < 4; ++m) { const int lr = ai * 128 + _wr * 64 + m * 16 + _fr; \
    _Pragma("unroll") for (int bj = 0; bj < 2; ++bj) _Pragma("unroll") for (int n = 0; n < 2; ++n) { const int lc = bj * 128 + _wc * 32 + n * 16 + _fq * 4; const f32x4 v = acc[ai][bj][m][n]; __VA_ARGS__ } } } while (0)

DI void store_bf16x4(bf16_t* p, float a, float b, float c, float d) { u32x2 v; v.x = pk_bf16(a, b); v.y = pk_bf16(c, d); *(u32x2*)p = v; }
DI void store_bf16x8(bf16_t* p, const f32x4 a, const f32x4 b) { u32x4 v; v.x = pk_bf16(a[0], a[1]); v.y = pk_bf16(a[2], a[3]); v.z = pk_bf16(b[0], b[1]); v.w = pk_bf16(b[2], b[3]); *(u32x4*)p = v; }
#define EPI_FOR8(acc, ...) do { const int _tz = otid(), _w = _tz >> 6, _l = _tz & 63, _wr = _w >> 2, _wc = _w & 3, _fr = _l & 15, _fq = _l >> 4; \
    _Pragma("unroll") for (int ai = 0; ai < 2; ++ai) _Pragma("unroll") for (int m = 0; m < 4; ++m) { const int lr = ai * 128 + _wr * 64 + m * 16 + _fr; \
    _Pragma("unroll") for (int bj = 0; bj < 2; ++bj) { const int lc = bj * 128 + _wc * 32 + _fq * 8; const f32x4 v0 = acc[ai][bj][m][0], v1 = acc[ai][bj][m][1]; __VA_ARGS__ } } } while (0)

DI int mod_row(int r) { return r < TX ? (r >> 11) : 32; }
DI int crow_tok(int cr) { const int b = cr / NCH, j = cr - b * NCH; return j < 4 ? TX + b * CTXL + j * 64 : b * SEQ + (j - 4) * 64; }

DI void cvt_tile(LAS char* wl  , const float* src, int ld_src, int kvalid, int nvalid, const float* scale, bf16_t* dst, int ld_dst, const int wv_) {
    const int lane = otid() & 63;
    const int lr = lane >> 4, lc = (lane & 15) * 4;
    f32x4 v[16];
#pragma unroll
    for (int it = 0; it < 16; ++it) {
        const int k = it * 4 + lr;
        v[it] = (f32x4){0.f, 0.f, 0.f, 0.f};
        if (src != nullptr && k < kvalid && lc < nvalid) { v[it] = *(const f32x4*)(src + (size_t)k * ld_src + lc); if (scale) { const float s = scale[k]; v[it] *= s; } }
    }
#pragma unroll
    for (int it = 0; it < 16; ++it) {
        const int k = it * 4 + lr;
#pragma unroll
        for (int j = 0; j < 4; ++j) *(LAS bf16_t*)(wl + (lc + j) * 144 + k * 2) = f2bf(v[it][j]);
    }
    asm volatile("s_waitcnt lgkmcnt(0)" ::: "memory");
#pragma unroll
    for (int i = 0; i < 8; ++i) {
        const int q = i * 64 + lane, n = q >> 3, c = q & 7;
        const u32x4 w = *(const LAS u32x4*)(wl + n * 144 + c * 16);
        *(u32x4*)(dst + (size_t)n * ld_dst + c * 8) = w;
    }
    asm volatile("s_waitcnt lgkmcnt(0)" ::: "memory");
}
constexpr float SWI_A = 2.4554669595930156f;
DI void cvt_tile8(LAS char* wl  , const float* src, int ld_src, unsigned char* dst, int ld_dst, const float wscale, const int wv_) {
    const int lane = otid() & 63;
    const int lr = lane >> 4, lc = (lane & 15) * 4;
    f32x4 v[16];
#pragma unroll
    for (int it = 0; it < 16; ++it) v[it] = *(const f32x4*)(src + (size_t)(it * 4 + lr) * ld_src + lc);
#pragma unroll
    for (int it = 0; it < 16; ++it) {
        const int k = it * 4 + lr;
#pragma unroll
        for (int j = 0; j < 4; ++j) *(LAS unsigned char*)(wl + (lc + j) * 80 + k) = (unsigned char)f2fp8(v[it][j] * wscale);
    }
    asm volatile("s_waitcnt lgkmcnt(0)" ::: "memory");
#pragma unroll
    for (int i = 0; i < 4; ++i) {
        const int q = i * 64 + lane, n = q >> 2, c = q & 3;
        const u32x4 w = *(const LAS u32x4*)(wl + n * 80 + c * 16);
        *(u32x4*)(dst + (size_t)n * ld_dst + c * 16) = w;
    }
    asm volatile("s_waitcnt lgkmcnt(0)" ::: "memory");
}
constexpr int CVT_SMALL_TILES = 768 + 512 + 32 + 32 + 64 + 64 + 32;
constexpr int CVT_EXP_TILES = 32 * (32 * 16 + 16 * 16);
DI void cvt_small(const Params& p, LAS char* wl, int t, const int wv_) {
    char* ws = p.ws;
    if (t < 768) { const int l = t / 384, r = t % 384, nt = r / 16, kt = r % 16;
        cvt_tile(wl, p.w_mix_in + (size_t)l * 1024 * N_IN + (size_t)kt * 64 * N_IN + nt * 64, N_IN, 64, N_IN - nt * 64, nullptr,
                 (bf16_t*)(ws + WS_WMI) + ((size_t)l * 1536 + nt * 64) * 1024 + kt * 64, 1024, wv_); return; }
    t -= 768;
    if (t < 512) { const int l = t / 256, r = t % 256, nt = r / 16, kt = r % 16;
        cvt_tile(wl, p.w_mix_out + (size_t)l * 1024 * 1024 + (size_t)kt * 64 * 1024 + nt * 64, 1024, 64, 64, nullptr,
                 (bf16_t*)(ws + WS_WMO) + ((size_t)l * 1024 + nt * 64) * 1024 + kt * 64, 1024, wv_); return; }
    t -= 512;
    if (t < 32) { const int l = t / 16, r = t % 16, nt = r / 4, kt = r % 4;
        cvt_tile(wl, p.conv_pw + (size_t)l * 65536 + (size_t)kt * 64 * 256 + nt * 64, 256, 64, 64, nullptr,
                 (bf16_t*)(ws + WS_WPW) + ((size_t)l * 256 + nt * 64) * 256 + kt * 64, 256, wv_); return; }
    t -= 32;
    if (t < 32) { const int l = t / 16, r = t % 16, nt = r / 4, kt = r % 4;
        cvt_tile(wl, p.ssm_glu_w + (size_t)l * 65536 + (size_t)kt * 64 * 256 + nt * 64, 256, 64, 64, nullptr,
                 (bf16_t*)(ws + WS_WGLU) + ((size_t)l * 256 + nt * 64) * 256 + kt * 64, 256, wv_); return; }
    t -= 32;
    if (t < 64) { const int l = t / 32, r = t % 32, nt = r / 4, kt = r % 4;
        const bool any = (kt < 3) && (nt < 6);
        cvt_tile(wl, any ? p.mla_wq_b + (size_t)l * 192 * 384 + (size_t)kt * 64 * 384 + nt * 64 : nullptr, 384, 64, 64, p.mla_q_a_g + l * 192 + kt * 64,
                 (bf16_t*)(ws + WS_WQ) + ((size_t)l * 512 + nt * 64) * 256 + kt * 64, 256, wv_); return; }
    t -= 64;
    if (t < 64) { const int l = t / 32, r = t % 32, nt = r / 4, kt = r % 4;
        const bool any = (kt < 2);
        cvt_tile(wl, any ? p.mla_wkv_b + (size_t)l * 128 * 512 + (size_t)kt * 64 * 512 + nt * 64 : nullptr, 512, 64, 64, p.mla_kv_a_g + l * 128 + kt * 64,
                 (bf16_t*)(ws + WS_WKV) + ((size_t)l * 512 + nt * 64) * 256 + kt * 64, 256, wv_); return; }
    t -= 64;
    { const int l = t / 16, r = t % 16, nt = r / 4, kt = r % 4;
        cvt_tile(wl, nt == kt ? p.pool_w + ((size_t)l * 4 + nt) * 4096 : nullptr, 64, 64, 64, nullptr,
                 (bf16_t*)(ws + WS_WPOOL) + ((size_t)l * 256 + nt * 64) * 256 + kt * 64, 256, wv_); }
}
DI void cvt_expert(const Params& p, LAS char* wl, int l, int t, const int wv_) {
    char* ws = p.ws;
    const int e = t / 768, r = t % 768;
    if (r < 512) { const int nt = r / 16, kt = r % 16;
        cvt_tile8(wl, p.exp_w_in + ((size_t)(l * NE + e) * 1024 + kt * 64) * 2048 + nt * 64, 2048,
                  (unsigned char*)(ws + WS_W1) + ((size_t)(l * NE + e) * 2048 + nt * 64) * 1024 + kt * 64, 1024, nt < 16 ? 256.f * SWI_A : 256.f / SWI_A, wv_);
    } else { const int q = r - 512, nt = q / 16, kt = q % 16;
        cvt_tile8(wl, p.exp_w_out + ((size_t)(l * NE + e) * 1024 + kt * 64) * 1024 + nt * 64, 1024,
                  (unsigned char*)(ws + WS_W2) + ((size_t)(l * NE + e) * 1024 + nt * 64) * 1024 + kt * 64, 1024, 256.f, wv_);
    }
}

DI void ada_unit(const Params& p, LAS char* shm, int u, const int wv_) {
    const int tid = otid();
    const int l = u / 48, jc = u % 48;
    LAS float* sc = (LAS float*)shm;
    for (int i = tid; i < 33 * 1024; i += 512) { const int r = i >> 10, k = i & 1023; const float v = r < 32 ? p.c[r * 1024 + k] : p.c_ctx[k]; sc[i] = siluf_(v); }
    __syncthreads();
    const int col = tid & 127, kq = tid >> 7;
    float acc[33];
#pragma unroll
    for (int r = 0; r < 33; ++r) acc[r] = 0.f;
    const float* wp = p.ada_w + ((size_t)l * 1024 + kq * 256) * 6144 + jc * 128 + col;
    for (int k4 = 0; k4 < 256; k4 += 4) {
        float w[4];
#pragma unroll
        for (int i = 0; i < 4; ++i) w[i] = wp[(size_t)(k4 + i) * 6144];
#pragma unroll
        for (int r = 0; r < 33; ++r) { const f32x4 s = *(const LAS f32x4*)(sc + r * 1024 + kq * 256 + k4); acc[r] += s[0] * w[0] + s[1] * w[1] + s[2] * w[2] + s[3] * w[3]; }
    }
    __syncthreads();
    LAS float* red = (LAS float*)shm;
#pragma unroll
    for (int r = 0; r < 33; ++r) red[(kq * 33 + r) * 128 + col] = acc[r];
    __syncthreads();
    for (int i = tid; i < 33 * 128; i += 512) { const int r = i >> 7, cc = i & 127;
        const float s = red[(0 * 33 + r) * 128 + cc] + red[(1 * 33 + r) * 128 + cc] + red[(2 * 33 + r) * 128 + cc] + red[(3 * 33 + r) * 128 + cc];
        ((float*)(p.ws + WS_MOD))[((size_t)l * 33 + r) * 6144 + jc * 128 + cc] = s + p.ada_b[l * 6144 + jc * 128 + cc]; }
    __syncthreads();
}

DI void s5_load_bc(const Params& p, LAS float* bb, LAS float* cc, int l, int dir, int g, int tid) {
    const int pbase = ((l * 2 + dir) * 16 + g) * 64;
    const double dt = exp((double)p.ssm_log_dt[(l * 2 + dir) * 16 + g]);
    for (int i = tid; i < 64 * 16; i += 512) { const int q = i >> 4, ci = i & 15;
        const double are = fmin((double)p.ssm_a_re[pbase + q], -1e-4), aim = (double)p.ssm_a_im[pbase + q];
        const double mg = exp(are * dt), abr = mg * cos(aim * dt), abi = mg * sin(aim * dt), den = are * are + aim * aim;
        const double fre = ((abr - 1.0) * are + abi * aim) / den, fim = (abi * are - (abr - 1.0) * aim) / den;
        const double br = (double)p.ssm_b_re[(size_t)(pbase + q) * 16 + ci], bi = (double)p.ssm_b_im[(size_t)(pbase + q) * 16 + ci];
        bb[i * 2] = (float)(fre * br - fim * bi); bb[i * 2 + 1] = (float)(fre * bi + fim * br); }
    for (int i = tid; i < 16 * 64; i += 512) { const int co = i >> 6, q = i & 63;
        const size_t ix = ((size_t)((l * 2 + dir) * 16 + g) * 16 + co) * 64 + q;
        cc[i * 2] = p.ssm_c_re[ix]; cc[i * 2 + 1] = p.ssm_c_im[ix]; }
}
DI void s5pre_unit(const Params& p, LAS char* shm, int u, const int wv_) {
    const int tid = otid();
    const int l = u >> 5, g = (u >> 1) & 15, dir = u & 1;
    LAS float* pw = (LAS float*)shm;
    LAS float* bb = pw + 65 * 64 * 2;
    LAS float* cc = bb + 64 * 16 * 2;
    LAS float* kk = cc + 16 * 64 * 2;
    LAS float* k0o = kk + 64 * 256;
    bf16_t* TS = (bf16_t*)(p.ws + WS_TS5) + (size_t)(l * 16 + g) * 1024 * 1280;
    bf16_t* WS = (bf16_t*)(p.ws + WS_WS5) + (size_t)(l * 16 + g) * 256 * 1024;
    const int cocip = tid & 255, co_ = cocip >> 4, ci_ = cocip & 15;
    if (dir == 0) {
        s5_load_bc(p, bb, cc, l, 1, g, tid);
        __syncthreads();
        if (tid < 256) { float s_ = 0.f;
            for (int q = 0; q < 64; ++q) s_ += cc[(co_ * 64 + q) * 2] * bb[(q * 16 + ci_) * 2] - cc[(co_ * 64 + q) * 2 + 1] * bb[(q * 16 + ci_) * 2 + 1];
            k0o[tid] = s_; }
        __syncthreads();
    }
    {
        const int pbase = ((l * 2 + dir) * 16 + g) * 64;
        const double dt = exp((double)p.ssm_log_dt[(l * 2 + dir) * 16 + g]);
        for (int i = tid; i < 65 * 64; i += 512) { const int tau = i >> 6, q = i & 63;
            const double are = fmin((double)p.ssm_a_re[pbase + q], -1e-4), aim = (double)p.ssm_a_im[pbase + q];
            const double mg = exp(are * dt * tau), an = aim * dt * tau;
            pw[i * 2] = (float)(mg * cos(an)); pw[i * 2 + 1] = (float)(mg * sin(an)); }
        s5_load_bc(p, bb, cc, l, dir, g, tid);
        __syncthreads();
        if (tid < 64) { float* a64 = (float*)(p.ws + WS_A64) + (size_t)(((l * 2 + dir) * 16 + g) * 64 + tid) * 2; a64[0] = pw[(64 * 64 + tid) * 2]; a64[1] = pw[(64 * 64 + tid) * 2 + 1]; }
        { float gr[64], gi[64];
#pragma unroll
          for (int q = 0; q < 64; ++q) { const float cr = cc[(co_ * 64 + q) * 2], cim = cc[(co_ * 64 + q) * 2 + 1], br = bb[(q * 16 + ci_) * 2], bi = bb[(q * 16 + ci_) * 2 + 1];
              gr[q] = cr * br - cim * bi; gi[q] = cr * bi + cim * br; }
          for (int tau = (tid >> 8); tau < 64; tau += 2) {
              float s_ = 0.f;
#pragma unroll
              for (int q = 0; q < 64; ++q) s_ += gr[q] * pw[(tau * 64 + q) * 2] - gi[q] * pw[(tau * 64 + q) * 2 + 1];
              kk[tau * 256 + cocip] = s_;
          } }
        for (int i = tid; i < 128 * 512; i += 512) { const int row = i >> 9, kp = (i & 511) * 2, ri = row >> 6, q = row & 63, s_ = kp >> 4, ci = kp & 15;
            const int e = dir == 0 ? 63 - s_ : s_;
            const float pr = pw[(e * 64 + q) * 2], pi = pw[(e * 64 + q) * 2 + 1];
            float o[2];
#pragma unroll
            for (int j = 0; j < 2; ++j) { const float br = bb[(q * 16 + ci + j) * 2], bi = bb[(q * 16 + ci + j) * 2 + 1]; o[j] = ri == 0 ? pr * br - pi * bi : pr * bi + pi * br; }
            *(unsigned*)(WS + (size_t)(dir * 128 + row) * 1024 + kp) = pk_bf16(o[0], o[1]); }
        for (int i = tid; i < 1024 * 64; i += 512) { const int row = i >> 6, kp = (i & 63) * 2, t = row >> 4, co = row & 15, ri = kp >> 6, q = kp & 63;
            const int e = dir == 0 ? t + 1 : 64 - t;
            float o[2];
#pragma unroll
            for (int j = 0; j < 2; ++j) { const float pr = pw[(e * 64 + q + j) * 2], pi = pw[(e * 64 + q + j) * 2 + 1];
                const float cr = cc[(co * 64 + q + j) * 2], cim = cc[(co * 64 + q + j) * 2 + 1];
                o[j] = ri == 0 ? (cr * pr - cim * pi) : -(cr * pi + cim * pr); }
            *(unsigned*)(TS + (size_t)row * 1280 + 1024 + dir * 128 + kp) = pk_bf16(o[0], o[1]); }
        __syncthreads();
        for (int rr = tid; rr < 1024; rr += 512) { const int t = rr >> 4, co = rr & 15;
            const float dco = p.ssm_d[l * 256 + g * 16 + co];
            bf16_t* rowp = TS + (size_t)rr * 1280;
            const int s_lo = dir == 0 ? 0 : t + 1, s_hi = dir == 0 ? t : 63;
            for (int s_ = s_lo; s_ <= s_hi; ++s_) { const int tau = dir == 0 ? t - s_ : s_ - t;
                unsigned w[8];
#pragma unroll
                for (int j = 0; j < 8; ++j) { float a = kk[tau * 256 + co * 16 + 2 * j], b2 = kk[tau * 256 + co * 16 + 2 * j + 1];
                    if (s_ == t) { a += k0o[co * 16 + 2 * j]; b2 += k0o[co * 16 + 2 * j + 1]; if (2 * j == co) a += dco; if (2 * j + 1 == co) b2 += dco; }
                    w[j] = pk_bf16(a, b2); }
                *(u32x4*)(rowp + s_ * 16) = (u32x4){w[0], w[1], w[2], w[3]}; *(u32x4*)(rowp + s_ * 16 + 8) = (u32x4){w[4], w[5], w[6], w[7]}; }
        }
        __syncthreads();
    }
}

DI void phase_prologue(const Params& p, LAS char* shm, const int wv_) {
    const int tid = otid();
    __syncthreads();
    if (blockIdx.x == 0 && tid < 64) ((int*)(p.ws + WS_CNT))[tid] = 0;
    const int n_cvt = (CVT_SMALL_TILES + 2 * CVT_EXP_TILES + 7) / 8;
    for (int u = blockIdx.x; u < 160; u += gridDim.x) {
        if (u < 64) s5pre_unit(p, shm, u, wv_);
        else ada_unit(p, shm, u - 64, wv_);
    }
    int* wq = (int*)(p.ws + WS_CNT) + 192;
    volatile LAS int* slot = (volatile LAS int*)(shm + LDS_MISC + 32);
    __syncthreads();
    if (tid == 0) slot[0] = atomicAdd(wq, 1);
    __syncthreads();
    int cu = slot[0], par = 0;
    while (cu < n_cvt) {
        int nxt = 0;
        if (tid == 0) nxt = atomicAdd(wq, 1);
        const int t = cu * 8 + wv_;
        LAS char* wl = shm + wv_ * (64 * 144);
        if (t < CVT_SMALL_TILES) cvt_small(p, wl, t, wv_);
        else if (t < CVT_SMALL_TILES + 2 * CVT_EXP_TILES) { const int te = t - CVT_SMALL_TILES; cvt_expert(p, wl, te / CVT_EXP_TILES, te % CVT_EXP_TILES, wv_); }
        par ^= 1;
        if (tid == 0) slot[par] = nxt;
        __syncthreads();
        cu = slot[par];
    }
}

DI void norm_mod_store(const float (&v)[16], const float* g, const float* modrow  , bf16_t* hrow, const int wv_) {
    const int lane = otid() & 63;
    float ss = 0.f;
#pragma unroll
    for (int i = 0; i < 16; ++i) ss += v[i] * v[i];
    ss = wave_sum(ss);
    const float rn = rsqrtf(ss * (1.f / 1024.f) + EPS);
#pragma unroll
    for (int j = 0; j < 4; ++j) {
        const int col = j * 256 + lane * 4;
        const f32x4 gg = *(const f32x4*)(g + col), sh = *(const f32x4*)(modrow + col), sc = *(const f32x4*)(modrow + 1024 + col);
        float o[4];
#pragma unroll
        for (int i = 0; i < 4; ++i) o[i] = v[j * 4 + i] * rn * gg[i] * (1.f + sc[i]) + sh[i];
        store_bf16x4(hrow + col, o[0], o[1], o[2], o[3]);
    }
}
DI void phase_norm1_l0(const Params& p, const int wv_) {
    const int tid_ = otid(); const int wid = tid_ >> 6, lane = tid_ & 63;
    const float* MOD = (const float*)(p.ws + WS_MOD);
    bf16_t* H = (bf16_t*)(p.ws + WS_H);
    for (int r = blockIdx.x * 8 + wid; r < TT; r += gridDim.x * 8) {
        const float* src = r < TX ? p.x + (size_t)r * 1024 : p.ctx + (size_t)(r - TX) * 1024;
        float v[16];
#pragma unroll
        for (int j = 0; j < 4; ++j) { const f32x4 t = *(const f32x4*)(src + j * 256 + lane * 4); v[j * 4] = t[0]; v[j * 4 + 1] = t[1]; v[j * 4 + 2] = t[2]; v[j * 4 + 3] = t[3]; }
        norm_mod_store(v, p.norm1_g, MOD + (size_t)(0 * 33 + mod_row(r)) * 6144, H + (size_t)r * 1024, wv_);
    }
}

struct PvInproj {
    const Params& p; int l;
    PV_NOHOOKS
    static constexpr int NT = 16; static constexpr int FP8 = 0; static constexpr bool PARK = false; typedef APlain AS; typedef BSimple BS;
    XcdDeal<4, 6> deal;
    DI int first() const { return deal.first(); }
    DI int next(int u) const { return deal.next(u); }
    DI void src(int u, AS& a, BS& b, const int wv_) const {
        int mt, nt; deal.decode(u, mt, nt);
        const bf16_t* W = (const bf16_t*)(p.ws + WS_WMI) + (size_t)l * 1536 * 1024;
        a = make_a_plain((const bf16_t*)(p.ws + WS_H), (size_t)mt * 256, 1024, 0);
        b = nt < 2 ? make_b(W + (size_t)(nt * 128) * 1024, W + (size_t)(256 + nt * 128) * 1024, 1024)
                   : make_b(W + (size_t)(nt * 256) * 1024, W + (size_t)(nt * 256 + 128) * 1024, 1024);
    }
    DI void epi(f32x4 (&acc)[2][2][4][2], int u, const int wv_, const int par = 0) const {
        int mt, nt; deal.decode(u, mt, nt);
        bf16_t* P = (bf16_t*)(p.ws + WS_P);
        if (nt < 2) {
            const int _tz = otid(), _w = _tz >> 6, _l = _tz & 63, _wr = _w >> 2, _wc = _w & 3, _fr = _l & 15, _fq = _l >> 4;
#pragma unroll
            for (int ai = 0; ai < 2; ++ai)
#pragma unroll
                for (int m = 0; m < 4; ++m) { const int lr = ai * 128 + _wr * 64 + m * 16 + _fr; const int lc = _wc * 32 + _fq * 8;
                    f32x4 o0, o1;
#pragma unroll
                    for (int r = 0; r < 4; ++r) { o0[r] = acc[ai][0][m][0][r] * sigmoidf_(acc[ai][1][m][0][r]); o1[r] = acc[ai][0][m][1][r] * sigmoidf_(acc[ai][1][m][1][r]); }
                    store_bf16x8(P + (size_t)(mt * 256 + lr) * NINP + nt * 128 + lc, o0, o1); }
        } else {
            EPI_FOR8(acc, { store_bf16x8(P + (size_t)(mt * 256 + lr) * NINP + nt * 256 + lc, v0, v1); });
        }
    }
};
DI void phase_inproj(const Params& p, LAS char* shm, int l, const int wv_) {
    PvInproj pv{p, l, {TT / 256}};
    gemm_stream(shm, pv, wv_);
}

template <int N> DI void wave_sum_n(float (&v)[N]) {
    const int l4 = olane();
#pragma unroll
    for (int o = 32; o > 0; o >>= 1) {
        float t_[N];
#pragma unroll
        for (int i = 0; i < N; ++i) t_[i] = __int_as_float(__builtin_amdgcn_ds_bpermute((l4 ^ o) << 2, __float_as_int(v[i])));
#pragma unroll
        for (int i = 0; i < N; ++i) v[i] += t_[i];
    }
}
template <int WIN, bool EDGE>
DI void pool_run(const LAS bf16_t* pin  , bf16_t* AP, int row0, int ts0, int L, int c, int half) {
    for (int blk = 0; blk < 2; ++blk) {
        const int t0 = half * 32 + blk * 16;
        float in[16 + WIN - 1];
#pragma unroll
        for (int i = 0; i < 16 + WIN - 1; ++i) in[i] = bf2f(pin[(t0 + i - WIN / 2 + 8) * 256 + c]);
        float sum = 0.f;
#pragma unroll
        for (int j = 0; j < WIN; ++j) sum += in[j];
#pragma unroll
        for (int o = 0; o < 16; ++o) {
            float inv = 1.f / (float)WIN;
            if (EDGE) { const int ts = ts0 + t0 + o; const int lo = max(ts - WIN / 2, 0), hi = min(ts + WIN - 1 - WIN / 2, L - 1); inv = 1.f / (float)(hi - lo + 1); }
            AP[(size_t)(row0 + t0 + o) * 256 + c] = f2bf(sum * inv - in[o + WIN / 2]);
            if (o < 15) sum += in[o + WIN] - in[o];
        }
    }
}
template <bool EDGE>
DI void pre_unit_t(const Params& p, LAS char* shm, int l, int row0, int ts0, int L, const float (&w)[31], const float bias, const int wv_) {
    const int tid = otid();
    const bf16_t* P = (const bf16_t*)(p.ws + WS_P);
    const int c = tid & 255, half = tid >> 8;
    LAS bf16_t* cin = (LAS bf16_t*)shm;
    LAS float* cv = (LAS float*)(shm + 49152);
    u32x4 creg[6], preg[5];
#pragma unroll
    for (int it = 0; it < 6; ++it) { const int q = it * 512 + tid, row = q >> 5, part = q & 31; const int ts = ts0 - 15 + row;
        creg[it] = (u32x4){0u, 0u, 0u, 0u};
        if (q < 94 * 32 && (!EDGE || (ts >= 0 && ts < L))) creg[it] = *(const u32x4*)(P + (size_t)(row0 - 15 + row) * NINP + part * 8); }
#pragma unroll
    for (int it = 0; it < 5; ++it) { const int q = it * 512 + tid, row = q >> 5, part = q & 31; const int ts = ts0 - 8 + row;
        preg[it] = (u32x4){0u, 0u, 0u, 0u};
        if (!EDGE || (ts >= 0 && ts < L)) preg[it] = *(const u32x4*)(P + (size_t)(row0 - 8 + row) * NINP + OFF_POOL + part * 8); }
#pragma unroll
    for (int it = 0; it < 6; ++it) { const int q = it * 512 + tid; if (q < 94 * 32) *(LAS u32x4*)(cin + q * 8) = creg[it]; }
    __syncthreads();
    {
        const int t0 = half * 32;
        float in[62];
#pragma unroll
        for (int i = 0; i < 62; ++i) in[i] = bf2f(cin[(t0 + i) * 256 + c]);
#pragma unroll
        for (int o = 0; o < 32; ++o) { float s_ = bias;
#pragma unroll
            for (int j = 0; j < 31; ++j) s_ += w[j] * in[o + j];
            cv[(t0 + o) * 257 + c] = s_; }
    }
    __syncthreads();
#pragma unroll
    for (int it = 0; it < 5; ++it) *(LAS u32x4*)(cin + (it * 512 + tid) * 8) = preg[it];
    {
        const int wid = tid >> 6, lane = tid & 63;
        bf16_t* AC = (bf16_t*)(p.ws + WS_ACONV);
        float lg[4], lb[4];
#pragma unroll
        for (int j = 0; j < 4; ++j) { lg[j] = p.conv_ln_g[l * 256 + lane + 64 * j]; lb[j] = p.conv_ln_b[l * 256 + lane + 64 * j]; }
        float x[8][4], s8[8];
#pragma unroll
        for (int i = 0; i < 8; ++i) { s8[i] = 0.f;
#pragma unroll
            for (int j = 0; j < 4; ++j) { x[i][j] = cv[(wid * 8 + i) * 257 + lane + 64 * j]; s8[i] += x[i][j]; } }
        wave_sum_n<8>(s8);
#pragma unroll
        for (int i = 0; i < 8; ++i) { const float mu = s8[i] * (1.f / 256.f); s8[i] = 0.f;
#pragma unroll
            for (int j = 0; j < 4; ++j) { x[i][j] -= mu; s8[i] += x[i][j] * x[i][j]; } }
        wave_sum_n<8>(s8);
#pragma unroll
        for (int i = 0; i < 8; ++i) { const float rs = rsqrtf(s8[i] * (1.f / 256.f) + EPS);
#pragma unroll
            for (int j = 0; j < 4; ++j) { const float y = x[i][j] * rs * lg[j] + lb[j]; AC[(size_t)(row0 + wid * 8 + i) * 256 + lane + 64 * j] = f2bf(siluf_(y)); } }
    }
    __syncthreads();
    {
        bf16_t* AP = (bf16_t*)(p.ws + WS_APOOL);
        const int g = __builtin_amdgcn_readfirstlane(c >> 6);
        if (g == 0) pool_run<2, EDGE>(cin, AP, row0, ts0, L, c, half);
        else if (g == 1) pool_run<4, EDGE>(cin, AP, row0, ts0, L, c, half);
        else if (g == 2) pool_run<8, EDGE>(cin, AP, row0, ts0, L, c, half);
        else pool_run<16, EDGE>(cin, AP, row0, ts0, L, c, half);
    }
    __syncthreads();
}
DI void pre_unit(const Params& p, LAS char* shm, int l, int tile, const float (&w)[31], const float bias, const int wv_) {
    int row0, ts0, L;
    if (tile < 1024) { row0 = tile * 64; ts0 = row0 & 2047; L = SEQ; } else { row0 = TX + (tile - 1024) * 64; ts0 = (row0 - TX) & 255; L = CTXL; }
    if (ts0 >= 16 && ts0 + 64 + 16 <= L) pre_unit_t<false>(p, shm, l, row0, ts0, L, w, bias, wv_);
    else pre_unit_t<true>(p, shm, l, row0, ts0, L, w, bias, wv_);
}
struct PvS5State {
    const Params& p; int l;
    PV_NOHOOKS
    static constexpr int NT = 16; static constexpr int FP8 = 0; static constexpr bool PARK = false; typedef ASimple AS; typedef BSimple BS;
    DI int first() const { return lin_first(0, 80); }
    DI int next(int u) const { return lin_next(u, 80); }
    DI void src(int u, AS& as, BS& bs, const int wv_) const {
        const int g = u / 5, mt = u % 5;
        int R[2], C[2]; stage_coords(R, C, wv_);
        as.base = (const char*)(p.ws + WS_P); as.kstride = 4 * NINP * 2;
#pragma unroll
        for (int h = 0; h < 2; ++h)
#pragma unroll
            for (int i = 0; i < 2; ++i) { const int cr = min(mt * 256 + h * 128 + R[i], NCROW - 1);
                as.off[h][i] = (unsigned)(((size_t)(crow_tok(cr) + (C[i] >> 4)) * NINP + OFF_SSM + g * 16 + (C[i] & 15)) * 2); }
        const bf16_t* W = (const bf16_t*)(p.ws + WS_WS5) + (size_t)(l * 16 + g) * 256 * 1024;
        bs = make_b(W, W + (size_t)128 * 1024, 1024);
    }
    DI void epi(f32x4 (&acc)[2][2][4][2], int u, const int wv_, const int par = 0) const {
        const int g = u / 5, mt = u % 5;
        float* SST = (float*)(p.ws + WS_SST);
        EPI_FOR8(acc, { const int cr = mt * 256 + lr; if (cr < NCROW) { float* o_ = SST + ((size_t)cr * 16 + g) * 256 + lc; *(f32x4*)o_ = v0; *(f32x4*)(o_ + 4) = v1; } });
    }
};
struct PvQKV {
    const Params& p; int l;
    PV_NOHOOKS
    static constexpr int NT = 4; static constexpr int FP8 = 0; static constexpr bool PARK = false; typedef APlain AS; typedef BSimple BS;
    DI int first() const { return lin_first(80, 1152); }
    DI int next(int u) const { return lin_next(u, 1152); }
    DI void src(int u, AS& a, BS& b, const int wv_) const {
        const bool isq = u < 576; const int w_ = isq ? u : u - 576; const int mt = w_ >> 1, nt = w_ & 1;
        a = make_a_plain((const bf16_t*)(p.ws + WS_P), (size_t)mt * 256, NINP, isq ? OFF_Q : OFF_KV);
        const bf16_t* W = (const bf16_t*)(p.ws + (isq ? WS_WQ : WS_WKV)) + (size_t)l * 512 * 256 + (size_t)nt * 256 * 256;
        b = make_b(W, W + (size_t)128 * 256, 256);
    }
    DI void epi(f32x4 (&acc)[2][2][4][2], int u, const int wv_, const int par = 0) const {
        const bool isq = u < 576; const int w_ = isq ? u : u - 576; const int mt = w_ >> 1, nt = w_ & 1;
        bf16_t* RAW = (bf16_t*)(p.ws + (isq ? WS_RAWQ : WS_RAWKV));
        EPI_FOR8(acc, { store_bf16x8(RAW + (size_t)(mt * 256 + lr) * 512 + nt * 256 + lc, v0, v1); });
    }
};
DI void phase_A(const Params& p, LAS char* shm, int l, const int wv_) {
    { PvS5State pv{p, l}; gemm_stream(shm, pv, wv_); }
    { PvQKV pv{p, l}; gemm_stream(shm, pv, wv_); }
    { const int c_ = otid() & 255;
      float w[31];
#pragma unroll
      for (int j = 0; j < 31; ++j) w[j] = p.conv_dw[((size_t)l * 31 + j) * 256 + c_];
      const float bias = p.conv_dw_b[l * 256 + c_];
      for (int u = first_unit(80 + 1152); u < 1152; u += gridDim.x) pre_unit(p, shm, l, u, w, bias, wv_); }
}

DI void qkvpost_unit(const Params& p, LAS char* shm, int l, int unit, const int wv_) {
    const int tid = otid(), wid = tid >> 6, lane = tid & 63;
    const bf16_t* P = (const bf16_t*)(p.ws + WS_P);
    const bf16_t* RAWQ = (const bf16_t*)(p.ws + WS_RAWQ);
    const bf16_t* RAWKV = (const bf16_t*)(p.ws + WS_RAWKV);
    bf16_t* Q = (bf16_t*)(p.ws + WS_Q);
    bf16_t* KB = (bf16_t*)(p.ws + WS_KB);
    bf16_t* VT = (bf16_t*)(p.ws + WS_VT);
    LAS bf16_t* vt = (LAS bf16_t*)shm;
    const int row0 = unit * 64;
    const bool lat = row0 < TX;
    const int b = lat ? (row0 >> 11) : ((row0 - TX) >> 8);
    const int key0 = lat ? (row0 & 2047) : 2048 + ((row0 - TX) & 255);
    const int head = lane >> 4, sub = lane & 15;
    const float lninv = -9.210340371976184f / 8.f;
    const float frq = __expf(lninv * (float)(sub & 7));
    float qg[6], kg[6];
#pragma unroll
    for (int j = 0; j < 6; ++j) { qg[j] = p.mla_q_g[l * 96 + sub + 16 * j] * 0.14724444674085666f; kg[j] = p.mla_k_g[l * 96 + sub + 16 * j]; }
    constexpr int NB = 4;
    for (int tk0 = wid * 8; tk0 < wid * 8 + 8; tk0 += NB) {
        float pq[NB][3], pkv[NB][2], qr[NB][6], kr[NB][6], vr[NB][4];
#pragma unroll
        for (int i = 0; i < NB; ++i) { const int r = row0 + tk0 + i; const bf16_t* pr = P + (size_t)r * NINP;
#pragma unroll
            for (int j = 0; j < 3; ++j) pq[i][j] = bf2f(pr[OFF_Q + lane + 64 * j]);
#pragma unroll
            for (int j = 0; j < 2; ++j) pkv[i][j] = bf2f(pr[OFF_KV + lane + 64 * j]);
#pragma unroll
            for (int j = 0; j < 6; ++j) qr[i][j] = bf2f(RAWQ[(size_t)r * 512 + head * 96 + sub + 16 * j]);
#pragma unroll
            for (int j = 0; j < 4; ++j) kr[i][j] = bf2f(RAWKV[(size_t)r * 512 + head * 128 + sub + 16 * j]);
#pragma unroll
            for (int j = 4; j < 6; ++j) kr[i][j] = bf2f(pr[OFF_KPE + sub + 16 * (j - 4)]);
#pragma unroll
            for (int j = 0; j < 4; ++j) vr[i][j] = bf2f(RAWKV[(size_t)r * 512 + head * 128 + 64 + sub + 16 * j]); }
        float red[2 * NB];
#pragma unroll
        for (int i = 0; i < NB; ++i) { red[2 * i] = pq[i][0] * pq[i][0] + pq[i][1] * pq[i][1] + pq[i][2] * pq[i][2]; red[2 * i + 1] = pkv[i][0] * pkv[i][0] + pkv[i][1] * pkv[i][1]; }
        wave_sum_n<2 * NB>(red);
        float ssq[2 * NB];
#pragma unroll
        for (int i = 0; i < NB; ++i) {
            const float rq = rsqrtf(red[2 * i] * (1.f / 192.f) + EPS), rkv = rsqrtf(red[2 * i + 1] * (1.f / 128.f) + EPS);
            float s0 = 0.f, s1 = 0.f;
#pragma unroll
            for (int j = 0; j < 6; ++j) { qr[i][j] *= rq; s0 += qr[i][j] * qr[i][j]; }
#pragma unroll
            for (int j = 0; j < 4; ++j) { kr[i][j] *= rkv; s1 += kr[i][j] * kr[i][j]; }
#pragma unroll
            for (int j = 4; j < 6; ++j) s1 += kr[i][j] * kr[i][j];
#pragma unroll
            for (int j = 0; j < 4; ++j) vr[i][j] *= rkv;
            ssq[2 * i] = s0; ssq[2 * i + 1] = s1;
        }
        { const int l4 = olane();
#pragma unroll
          for (int o = 8; o > 0; o >>= 1) { float t_[2 * NB];
#pragma unroll
              for (int i = 0; i < 2 * NB; ++i) t_[i] = __int_as_float(__builtin_amdgcn_ds_bpermute((l4 ^ o) << 2, __float_as_int(ssq[i])));
#pragma unroll
              for (int i = 0; i < 2 * NB; ++i) ssq[i] += t_[i]; } }
#pragma unroll
        for (int i = 0; i < NB; ++i) {
            const int tk = tk0 + i, r = row0 + tk;
            const float rnq = rsqrtf(ssq[2 * i] * (1.f / 96.f) + EPS), rnk = rsqrtf(ssq[2 * i + 1] * (1.f / 96.f) + EPS);
#pragma unroll
            for (int j = 0; j < 6; ++j) { qr[i][j] *= rnq * qg[j]; kr[i][j] *= rnk * kg[j]; }
            if (lat) {
                const int tseq = r & 2047; const float a0 = (float)(tseq >> 6) * frq, a1 = (float)(tseq & 63) * frq;
                const float cs0 = __cosf(a0), sn0 = __sinf(a0), cs1 = __cosf(a1), sn1 = __sinf(a1);
                const float oq4 = shx(qr[i][4], 8), oq5 = shx(qr[i][5], 8), ok4 = shx(kr[i][4], 8), ok5 = shx(kr[i][5], 8);
                const float sg = (sub < 8) ? -1.f : 1.f;
                qr[i][4] = qr[i][4] * cs0 + sg * oq4 * sn0; qr[i][5] = qr[i][5] * cs1 + sg * oq5 * sn1;
                kr[i][4] = kr[i][4] * cs0 + sg * ok4 * sn0; kr[i][5] = kr[i][5] * cs1 + sg * ok5 * sn1;
            }
            bf16_t* kro = KB + ((size_t)(b * 4 + head) * 2304 + key0 + tk) * 96;
#pragma unroll
            for (int j = 0; j < 6; ++j) { Q[(size_t)r * 384 + head * 96 + sub + 16 * j] = f2bf(qr[i][j]); kro[sub + 16 * j] = f2bf(kr[i][j]); }
#pragma unroll
            for (int j = 0; j < 4; ++j) vt[(head * 64 + sub + 16 * j) * 72 + tk] = f2bf(vr[i][j]);
        }
    }
    __syncthreads();
    { const int hv = tid >> 1, hf = tid & 1;
      bf16_t* dst = VT + ((size_t)(b * 4 + (hv >> 6)) * 64 + (hv & 63)) * 2304 + key0 + hf * 32;
#pragma unroll
      for (int i = 0; i < 4; ++i) *(u32x4*)(dst + i * 8) = *(const LAS u32x4*)(vt + hv * 72 + hf * 32 + i * 8); }
    __syncthreads();
}
DI void s5carry_unit(const Params& p, int l, int unit, const int wv_) {
    const int gid = unit * 512 + otid();
    const int q = gid & 63, dir = (gid >> 6) & 1, g = (gid >> 7) & 15, b = gid >> 11;
    const float* A64 = (const float*)(p.ws + WS_A64) + (size_t)(((l * 2 + dir) * 16 + g) * 64 + q) * 2;
    const float ar = A64[0], ai = A64[1];
    const float* SST = (const float*)(p.ws + WS_SST);
    bf16_t* HIN = (bf16_t*)(p.ws + WS_HIN);
    float sr[NCH], si[NCH];
#pragma unroll
    for (int s = 0; s < NCH; ++s) { const int j = dir == 0 ? s : (s < 4 ? 3 - s : 39 - s);
        const size_t base = ((size_t)(b * NCH + j) * 16 + g) * 256 + dir * 128 + q; sr[s] = SST[base]; si[s] = SST[base + 64]; }
    float hr = 0.f, hi = 0.f;
#pragma unroll
    for (int s = 0; s < NCH; ++s) {
        const int j = dir == 0 ? s : (s < 4 ? 3 - s : 39 - s);
        const size_t base = ((size_t)(b * NCH + j) * 16 + g) * 256 + dir * 128 + q;
        HIN[base] = f2bf(hr); HIN[base + 64] = f2bf(hi);
        const float nr = ar * hr - ai * hi + sr[s], ni = ar * hi + ai * hr + si[s];
        hr = nr; hi = ni;
    }
}
struct PvConvPool {
    const Params& p; int l;
    PV_NOHOOKS
    static constexpr int NT = 4; static constexpr int FP8 = 0; static constexpr bool PARK = false; typedef APlain AS; typedef BSimple BS;
    DI int first() const { return lin_first(0, 576); }
    DI int next(int u) const { return lin_next(u, 576); }
    DI void src(int u, AS& a, BS& b, const int wv_) const {
        const bool isconv = u < 288; const int mt = isconv ? u : u - 288;
        a = make_a_plain((const bf16_t*)(p.ws + (isconv ? WS_ACONV : WS_APOOL)), (size_t)mt * 256, 256, 0);
        const bf16_t* W = (const bf16_t*)(p.ws + (isconv ? WS_WPW : WS_WPOOL)) + (size_t)l * 65536;
        b = make_b(W, W + (size_t)128 * 256, 256);
    }
    DI void epi(f32x4 (&acc)[2][2][4][2], int u, const int wv_, const int par = 0) const {
        const bool isconv = u < 288; const int mt = isconv ? u : u - 288;
        bf16_t* CAT = (bf16_t*)(p.ws + WS_CAT);
        if (isconv) { EPI_FOR8(acc, { store_bf16x8(CAT + (size_t)(mt * 256 + lr) * 1024 + lc, v0, v1); }); }
        else { const int t_ = otid(), c0_ = ((t_ >> 6) & 3) * 32 + ((t_ & 63) >> 4) * 8; f32x4 sc_[2][2];
#pragma unroll
               for (int bj = 0; bj < 2; ++bj)
#pragma unroll
                   for (int n = 0; n < 2; ++n) sc_[bj][n] = *(const f32x4*)(p.pool_scale + l * 256 + bj * 128 + n * 4 + c0_);
               EPI_FOR8(acc, { store_bf16x8(CAT + (size_t)(mt * 256 + lr) * 1024 + 256 + lc, v0 * sc_[bj][0], v1 * sc_[bj][1]); }); }
    }
};
DI void phase_B(const Params& p, LAS char* shm, int l, const int wv_) {
    { PvConvPool pv{p, l}; gemm_stream(shm, pv, wv_); }
    const int n_post = TT / 64, n_carry = 128;
    for (int u = first_unit(576); u < n_post + n_carry; u += gridDim.x) {
        if (u < n_post) qkvpost_unit(p, shm, l, u, wv_);
        else s5carry_unit(p, l, u - n_post, wv_);
    }
}

DI void attn_unit(const Params& p, LAS char* shm, int l, int b, int h, int qrow0, int nq, int key_lo, int nkeys, const int wv_) {
    const int tid = otid(), wid = tid >> 6, lane = tid & 63, l31 = lane & 31, hh = lane >> 5;
    const bf16_t* Q = (const bf16_t*)(p.ws + WS_Q);
    const bf16_t* KBp = (const bf16_t*)(p.ws + WS_KB) + (size_t)(b * 4 + h) * 2304 * 96;
    const bf16_t* VTp = (const bf16_t*)(p.ws + WS_VT) + (size_t)(b * 4 + h) * 64 * 2304;
    bf16_t* CAT = (bf16_t*)(p.ws + WS_CAT);
    LAS char* kl = shm;
    LAS char* vl = shm + 13312;
    const bool active = wid * 64 < nq;
    float gq = 0.f, gk = 0.f;
    for (int i = lane; i < 96; i += 64) { gq = fmaxf(gq, fabsf(p.mla_q_g[l * 96 + i])); gk = fmaxf(gk, fabsf(p.mla_k_g[l * 96 + i])); }
    gq = wave_max(gq); gk = wave_max(gk);
    const float LOG2E = 1.4426950408889634f;
    const float c2 = 9.797958971132712f * gq * gk * LOG2E;
    const float sh2 = fmaxf(c2 - 64.f, 0.f);
    bf16x8 qf[2][6];
    if (active) {
#pragma unroll
        for (int qb = 0; qb < 2; ++qb)
#pragma unroll
            for (int ks = 0; ks < 6; ++ks) qf[qb][ks] = *(const bf16x8*)(Q + (size_t)(qrow0 + wid * 64 + qb * 32 + l31) * 384 + h * 96 + ks * 16 + hh * 8);
    }
    f32x16 O[2][2];
#pragma unroll
    for (int a = 0; a < 2; ++a)
#pragma unroll
        for (int c = 0; c < 2; ++c)
#pragma unroll
            for (int i = 0; i < 16; ++i) O[a][c][i] = 0.f;
    float lsum[2] = {0.f, 0.f};
    const int ntile = nkeys / 64;
    u32x4 kreg0, kreg1, vreg;
    auto load_tile = [&](int t) {
        const int key = key_lo + t * 64;
        { const int id = tid, kr = id / 12, part = id % 12; kreg0 = *(const u32x4*)(KBp + (size_t)(key + kr) * 96 + part * 8); }
        if (tid < 256) { const int id = tid + 512, kr = id / 12, part = id % 12; kreg1 = *(const u32x4*)(KBp + (size_t)(key + kr) * 96 + part * 8); }
        { const int vd = tid >> 3, part = tid & 7; vreg = *(const u32x4*)(VTp + (size_t)vd * 2304 + key + part * 8); }
    };
    auto write_tile = [&]() {
        { const int id = tid, kr = id / 12, part = id % 12; *(LAS u32x4*)(kl + kr * 208 + part * 16) = kreg0; }
        if (tid < 256) { const int id = tid + 512, kr = id / 12, part = id % 12; *(LAS u32x4*)(kl + kr * 208 + part * 16) = kreg1; }
        { const int vd = tid >> 3, part = tid & 7; *(LAS u32x4*)(vl + vd * 144 + part * 16) = vreg; }
    };
    load_tile(0);
    for (int t = 0; t < ntile; ++t) {
        __syncthreads();
        write_tile();
        __syncthreads();
        if (t + 1 < ntile) load_tile(t + 1);
        if (active) {
#pragma unroll
            for (int kb = 0; kb < 2; ++kb) {
                f32x16 S[2];
#pragma unroll
                for (int qb = 0; qb < 2; ++qb)
#pragma unroll
                    for (int i = 0; i < 16; ++i) S[qb][i] = 0.f;
#pragma unroll
                for (int ks = 0; ks < 6; ++ks) {
                    const bf16x8 a = *(const LAS bf16x8*)(kl + (kb * 32 + l31) * 208 + ks * 32 + hh * 16);
#pragma unroll
                    for (int qb = 0; qb < 2; ++qb) S[qb] = __builtin_amdgcn_mfma_f32_32x32x16_bf16(a, qf[qb][ks], S[qb], 0, 0, 0);
                }
                bf16x8 pf[2][2];
#pragma unroll
                for (int qb = 0; qb < 2; ++qb) {
                    float e[16];
#pragma unroll
                    for (int i = 0; i < 16; ++i) { e[i] = __builtin_amdgcn_exp2f(S[qb][i] - sh2); lsum[qb] += e[i]; }
#pragma unroll
                    for (int s = 0; s < 2; ++s) { u32x4 w; w.x = pk_bf16(e[8 * s], e[8 * s + 1]); w.y = pk_bf16(e[8 * s + 2], e[8 * s + 3]); w.z = pk_bf16(e[8 * s + 4], e[8 * s + 5]); w.w = pk_bf16(e[8 * s + 6], e[8 * s + 7]);
                        pf[qb][s] = __builtin_bit_cast(bf16x8, w); }
                }
#pragma unroll
                for (int s = 0; s < 2; ++s) {
                    const int kk = kb * 2 + s;
#pragma unroll
                    for (int vb = 0; vb < 2; ++vb) {
                        const s16x4 lo = *(const LAS s16x4*)(vl + (vb * 32 + l31) * 144 + (16 * kk + 4 * hh) * 2);
                        const s16x4 hi = *(const LAS s16x4*)(vl + (vb * 32 + l31) * 144 + (16 * kk + 8 + 4 * hh) * 2);
                        const bf16x8 va = __builtin_shufflevector(lo, hi, 0, 1, 2, 3, 4, 5, 6, 7);
#pragma unroll
                        for (int qb = 0; qb < 2; ++qb) O[vb][qb] = __builtin_amdgcn_mfma_f32_32x32x16_bf16(va, pf[qb][s], O[vb][qb], 0, 0, 0);
                    }
                }
            }
        }
    }
    if (active) {
#pragma unroll
        for (int qb = 0; qb < 2; ++qb) {
            const float tot = lsum[qb] + shx(lsum[qb], 32);
            const float inv = 1.f / tot;
            bf16_t* orow = CAT + (size_t)(qrow0 + wid * 64 + qb * 32 + l31) * 1024 + 768 + h * 64;
#pragma unroll
            for (int vb = 0; vb < 2; ++vb)
#pragma unroll
                for (int i4 = 0; i4 < 4; ++i4)
                    store_bf16x4(orow + vb * 32 + 8 * i4 + 4 * hh, O[vb][qb][4 * i4] * inv, O[vb][qb][4 * i4 + 1] * inv, O[vb][qb][4 * i4 + 2] * inv, O[vb][qb][4 * i4 + 3] * inv);
        }
    }
    __syncthreads();
}
struct PvS5Out {
    const Params& p; int l;
    PV_NOHOOKS
    static constexpr int NT = 20; static constexpr int FP8 = 0; static constexpr bool PARK = false; typedef ASeg2 AS; typedef BSimple BS;
    DI int first() const { return lin_first(512, 320); }
    DI int next(int u) const { return lin_next(u, 320); }
    DI void src(int u, AS& as, BS& bs, const int wv_) const {
        const int ntile = u & 3, mt = (u >> 2) % 5, g = u / 20;
        int R[2], C[2]; stage_coords(R, C, wv_);
        as.base0 = (const char*)(p.ws + WS_P); as.base1 = (const char*)(p.ws + WS_HIN); as.ks0 = 4 * NINP * 2; as.nt0 = 16;
#pragma unroll
        for (int h = 0; h < 2; ++h)
#pragma unroll
            for (int i = 0; i < 2; ++i) { const int cr = min(mt * 256 + h * 128 + R[i], NCROW - 1);
                as.off0[h][i] = (unsigned)(((size_t)(crow_tok(cr) + (C[i] >> 4)) * NINP + OFF_SSM + g * 16 + (C[i] & 15)) * 2);
                as.off1[h][i] = (unsigned)((((size_t)cr * 16 + g) * 256 + C[i]) * 2); }
        const bf16_t* W = (const bf16_t*)(p.ws + WS_TS5) + ((size_t)(l * 16 + g) * 1024 + ntile * 256) * 1280;
        bs = make_b(W, W + (size_t)128 * 1280, 1280);
    }
    DI void epi(f32x4 (&acc)[2][2][4][2], int u, const int wv_, const int par = 0) const {
        const int ntile = u & 3, mt = (u >> 2) % 5, g = u / 20;
        bf16_t* Z = (bf16_t*)(p.ws + WS_Z);
        EPI_FOR8(acc, { const int cr = mt * 256 + lr; if (cr < NCROW) { const int col = ntile * 256 + lc, t = col >> 4, co = col & 15;
            const f32x4 g0 = (f32x4){gelu_tanh(v0[0]), gelu_tanh(v0[1]), gelu_tanh(v0[2]), gelu_tanh(v0[3])}, g1_ = (f32x4){gelu_tanh(v1[0]), gelu_tanh(v1[1]), gelu_tanh(v1[2]), gelu_tanh(v1[3])};
            store_bf16x8(Z + (size_t)(crow_tok(cr) + t) * 256 + g * 16 + co, g0, g1_); } });
    }
};
DI void phase_C(const Params& p, LAS char* shm, int l, const int wv_) {
    for (int u = blockIdx.x; u < 512; u += gridDim.x) { const int qb = u & 3, h = (u >> 2) & 3, b = u >> 4;
        attn_unit(p, shm, l, b, h, b * SEQ + qb * 512, 512, 0, 2304, wv_); }
    { PvS5Out pv{p, l}; gemm_stream(shm, pv, wv_); }
    if (l == 0) for (int u = first_unit(512 + 320); u < 128; u += gridDim.x) { const int h = u & 3, b = u >> 2;
        attn_unit(p, shm, l, b, h, TX + b * CTXL, 256, 2048, 256, wv_); }
}

struct PvGlu {
    const Params& p; int l;
    PV_NOHOOKS
    static constexpr int NT = 4; static constexpr int FP8 = 0; static constexpr bool PARK = false; typedef APlain AS; typedef BSimple BS;
    DI int first() const { return lin_first(0, 288); }
    DI int next(int u) const { return lin_next(u, 288); }
    DI void src(int u, AS& a, BS& b, const int wv_) const {
        a = make_a_plain((const bf16_t*)(p.ws + WS_Z), (size_t)u * 256, 256, 0);
        const bf16_t* W = (const bf16_t*)(p.ws + WS_WGLU) + (size_t)l * 65536;
        b = make_b(W, W + (size_t)128 * 256, 256);
    }
    DI void epi(f32x4 (&acc)[2][2][4][2], int u, const int wv_, const int par = 0) const {
        const bf16_t* Z = (const bf16_t*)(p.ws + WS_Z); bf16_t* CAT = (bf16_t*)(p.ws + WS_CAT);
        const int _tz = otid(), _w = _tz >> 6, _l = _tz & 63, _wr = _w >> 2, _wc = _w & 3, _fr = _l & 15, _fq = _l >> 4;
        const int c0 = _wc * 32 + _fq * 8;
        f32x4 bsv[2][2];
#pragma unroll
        for (int bj = 0; bj < 2; ++bj)
#pragma unroll
            for (int n = 0; n < 2; ++n) bsv[bj][n] = *(const f32x4*)(p.ssm_glu_b + l * 256 + bj * 128 + n * 4 + c0);
#pragma unroll
        for (int ai = 0; ai < 2; ++ai) {
            u32x4 zz[4][2];
#pragma unroll
            for (int m = 0; m < 4; ++m)
#pragma unroll
                for (int bj = 0; bj < 2; ++bj) zz[m][bj] = *(const u32x4*)(Z + (size_t)(u * 256 + ai * 128 + _wr * 64 + m * 16 + _fr) * 256 + bj * 128 + c0);
#pragma unroll
            for (int m = 0; m < 4; ++m) { const size_t r = (size_t)(u * 256 + ai * 128 + _wr * 64 + m * 16 + _fr);
#pragma unroll
                for (int bj = 0; bj < 2; ++bj) { const f32x4 a0 = acc[ai][bj][m][0], a1 = acc[ai][bj][m][1]; const f32x4 b0 = bsv[bj][0], b1 = bsv[bj][1]; const u32x4 z_ = zz[m][bj];
                    const f32x4 o0 = (f32x4){bflo(z_.x) * sigmoidf_(a0[0] + b0[0]), bfhi(z_.x) * sigmoidf_(a0[1] + b0[1]), bflo(z_.y) * sigmoidf_(a0[2] + b0[2]), bfhi(z_.y) * sigmoidf_(a0[3] + b0[3])};
                    const f32x4 o1 = (f32x4){bflo(z_.z) * sigmoidf_(a1[0] + b1[0]), bfhi(z_.z) * sigmoidf_(a1[1] + b1[1]), bflo(z_.w) * sigmoidf_(a1[2] + b1[2]), bfhi(z_.w) * sigmoidf_(a1[3] + b1[3])};
                    store_bf16x8(CAT + r * 1024 + 512 + bj * 128 + c0, o0, o1); } }
        }
    }
};
DI void phase_D(const Params& p, LAS char* shm, int l, const int wv_) {
    PvGlu pv{p, l}; gemm_stream(shm, pv, wv_);
}

struct PvOutproj {
    const Params& p; int l;
    PV_NOHOOKS
    static constexpr int NT = 16; static constexpr int FP8 = 0; static constexpr bool PARK = false; typedef APlain AS; typedef BSimple BS;
    XcdDeal<4, 4> deal;
    DI int first() const { return deal.first(); }
    DI int next(int u) const { return deal.next(u); }
    DI void src(int u, AS& a, BS& b, const int wv_) const {
        int mt, nt; deal.decode(u, mt, nt);
        const bf16_t* W = (const bf16_t*)(p.ws + WS_WMO) + (size_t)l * 1024 * 1024;
        a = make_a_plain((const bf16_t*)(p.ws + WS_CAT), (size_t)mt * 256, 1024, 0);
        b = make_b(W + (size_t)(nt * 256) * 1024, W + (size_t)(nt * 256 + 128) * 1024, 1024);
    }
    DI void epi(f32x4 (&acc)[2][2][4][2], int u, const int wv_, const int par = 0) const {
        int mt, nt; deal.decode(u, mt, nt);
        bf16_t* X = (bf16_t*)(p.ws + WS_X);
        const float* MOD = (const float*)(p.ws + WS_MOD) + (size_t)l * 33 * 6144;
        const int _tz = otid(), _w = _tz >> 6, _l = _tz & 63, _wr = _w >> 2, _wc = _w & 3, _fr = _l & 15, _fq = _l >> 4;
        const int c0 = nt * 256 + _wc * 32 + _fq * 8;
        const int row0 = mt * 256;
        const float* g1p = MOD + (size_t)mod_row(row0) * 6144 + 2048 + c0;
        f32x4 g1[2][2];
#pragma unroll
        for (int bj = 0; bj < 2; ++bj)
#pragma unroll
            for (int n = 0; n < 2; ++n) g1[bj][n] = *(const f32x4*)(g1p + bj * 128 + n * 4);
        bf16_t* obase = X + (size_t)row0 * 1024;
        if (l == 0) {
            const float* xbase = row0 < TX ? p.x + (size_t)row0 * 1024 : p.ctx + (size_t)(row0 - TX) * 1024;
#pragma unroll
            for (int ai = 0; ai < 2; ++ai)
#pragma unroll
                for (int mp = 0; mp < 2; ++mp) {
                    f32x4 xv[2][2][2];
#pragma unroll
                    for (int mm = 0; mm < 2; ++mm)
#pragma unroll
                        for (int bj = 0; bj < 2; ++bj)
#pragma unroll
                            for (int n = 0; n < 2; ++n) xv[mm][bj][n] = *(const f32x4*)(xbase + (size_t)(ai * 128 + _wr * 64 + (mp * 2 + mm) * 16 + _fr) * 1024 + c0 + bj * 128 + n * 4);
#pragma unroll
                    for (int mm = 0; mm < 2; ++mm)
#pragma unroll
                        for (int bj = 0; bj < 2; ++bj)
                            store_bf16x8(obase + (size_t)(ai * 128 + _wr * 64 + (mp * 2 + mm) * 16 + _fr) * 1024 + c0 + bj * 128,
                                         xv[mm][bj][0] + g1[bj][0] * acc[ai][bj][mp * 2 + mm][0], xv[mm][bj][1] + g1[bj][1] * acc[ai][bj][mp * 2 + mm][1]);
                }
        } else {
#pragma unroll
            for (int ai = 0; ai < 2; ++ai) {
                u32x4 xv[4][2];
#pragma unroll
                for (int m = 0; m < 4; ++m)
#pragma unroll
                    for (int bj = 0; bj < 2; ++bj) xv[m][bj] = *(const u32x4*)(obase + (size_t)(ai * 128 + _wr * 64 + m * 16 + _fr) * 1024 + c0 + bj * 128);
#pragma unroll
                for (int m = 0; m < 4; ++m)
#pragma unroll
                    for (int bj = 0; bj < 2; ++bj) { const u32x4 x_ = xv[m][bj];
                        const f32x4 x0 = (f32x4){bflo(x_.x), bfhi(x_.x), bflo(x_.y), bfhi(x_.y)}, x1 = (f32x4){bflo(x_.z), bfhi(x_.z), bflo(x_.w), bfhi(x_.w)};
                        store_bf16x8(obase + (size_t)(ai * 128 + _wr * 64 + m * 16 + _fr) * 1024 + c0 + bj * 128, x0 + g1[bj][0] * acc[ai][bj][m][0], x1 + g1[bj][1] * acc[ai][bj][m][1]); }
            }
        }
    }
};
DI void phase_E(const Params& p, LAS char* shm, int l, const int wv_) {
    PvOutproj pv{p, l, {(l == 1 ? TX : TT) / 256}}; gemm_stream(shm, pv, wv_);
}

template <int S> DI float row_rot_f(float v) { return __int_as_float(__builtin_amdgcn_update_dpp(0, __float_as_int(v), 0x120 | S, 0xf, 0xf, false)); }
template <int S> DI int row_rot_i(int v) { return __builtin_amdgcn_update_dpp(0, v, 0x120 | S, 0xf, 0xf, false); }
template <int S> struct RankAcc {
    static DI void run(float o0, float o1, int oe, float v0, float v1, int e0, int& r0, int& r1) {
        const float a0 = S ? row_rot_f<S>(o0) : o0, a1 = S ? row_rot_f<S>(o1) : o1; const int ae = S ? row_rot_i<S>(oe) : oe;
        r0 += (a0 > v0 || (a0 == v0 && ae < e0)) ? 1 : 0;
        r0 += (a1 > v0) ? 1 : 0;
        r1 += (a0 > v1 || a0 == v1) ? 1 : 0;
        r1 += (a1 > v1 || (a1 == v1 && ae < e0)) ? 1 : 0;
        RankAcc<S + 1>::run(o0, o1, oe, v0, v1, e0, r0, r1);
    }
};
template <> struct RankAcc<16> { static DI void run(float, float, int, float, float, int, int&, int&) {} };
DI float row_sum16(float v) { v += row_rot_f<8>(v); v += row_rot_f<4>(v); v += row_rot_f<2>(v); v += row_rot_f<1>(v); return v; }
DI float row_max16(float v) { v = fmaxf(v, row_rot_f<8>(v)); v = fmaxf(v, row_rot_f<4>(v)); v = fmaxf(v, row_rot_f<2>(v)); v = fmaxf(v, row_rot_f<1>(v)); return v; }

DI void phase_router(const Params& p, LAS char* shm, int l, const int wv_) {
    const int tid = otid(), wid = tid >> 6, lane = tid & 63;
    const int Tm = (l == 1) ? TX : TT;
    const bf16_t* X = (const bf16_t*)(p.ws + WS_X);
    const float* MOD = (const float*)(p.ws + WS_MOD) + (size_t)l * 33 * 6144;
    unsigned char* H8 = (unsigned char*)(p.ws + WS_H);
    const bool alt = p.ph_lo != 0;
    int* CNT = (int*)(p.ws + WS_CNT) + l * 32 + (alt ? 64 : 0);
    int* LIST = alt ? (int*)(p.ws + WS_RY) : (int*)(p.ws + WS_LIST);
    LAS char* wfr = shm;
    LAS bf16_t* gml = (LAS bf16_t*)(shm + 131072);
    LAS bf16_t* shl = gml + 1024;
    LAS float* cvec = (LAS float*)(shm + 131072 + 4096);
    LAS int* lcnt = (LAS int*)(cvec + 32);
    LAS int* lbase = lcnt + 32;
    LAS unsigned* lrec = (LAS unsigned*)(lbase + 32);
    LAS float* lwt = (LAS float*)(lrec + 1152);
    const int tpw = (Tm + gridDim.x - 1) / gridDim.x;
    const int tbeg = blockIdx.x * tpw, tend = min(tbeg + tpw, Tm);
    if (tid < 32) lcnt[tid] = 0;
    int seg_beg = tbeg;
    while (seg_beg < tend) {
        const int mrow = mod_row(seg_beg);
        int seg_end = tend;
        if (mrow < 32) seg_end = min(tend, (mrow + 1) * SEQ); else seg_end = tend;
        const float* mr = MOD + (size_t)mrow * 6144;
        __syncthreads();
        for (int k = tid; k < 1024; k += 512) { const float gmv = p.norm2_g[l * 1024 + k] * (1.f + mr[4096 + k]); gml[k] = f2bf(gmv); shl[k] = f2bf(mr[3072 + k]); }
#pragma unroll 8
        for (int i = tid; i < 1024 * 8; i += 512) {
            const int k = i >> 3, e4 = (i & 7) * 4;
            const float gmv = p.norm2_g[l * 1024 + k] * (1.f + mr[4096 + k]);
            const f32x4 w = *(const f32x4*)(p.router_w + (size_t)l * 32768 + k * 32 + e4);
            const int ks = k >> 5, kq = (k >> 3) & 3, j = k & 7;
#pragma unroll
            for (int c = 0; c < 4; ++c) { const int e = e4 + c, nb = e >> 4, ei = e & 15; const float wv = w[c] * gmv;
                const bf16_t hi = f2bf(wv); const bf16_t lo = f2bf(wv - bf2f(hi));
                LAS bf16_t* dst = (LAS bf16_t*)(wfr + ((size_t)((ks * 2 + nb) * 2) * 64 + (kq * 16 + ei)) * 16) + j;
                dst[0] = hi; dst[64 * 8] = lo; }
        }
        {
            float s4[4] = {0.f, 0.f, 0.f, 0.f};
#pragma unroll 8
            for (int k = lane; k < 1024; k += 64) { const float shv = mr[3072 + k]; const f32x4 w = *(const f32x4*)(p.router_w + (size_t)l * 32768 + k * 32 + wid * 4);
                s4[0] += shv * w[0]; s4[1] += shv * w[1]; s4[2] += shv * w[2]; s4[3] += shv * w[3]; }
#pragma unroll
            for (int c = 0; c < 4; ++c) { const float t_ = wave_sum(s4[c]); if (lane == 0) cvec[wid * 4 + c] = t_ + p.router_b[l * 32 + wid * 4 + c]; }
        }
        __syncthreads();
        const int ngroups = (seg_end - seg_beg) >> 4;
        for (int gi = wid; gi < ngroups; gi += 8) {
            const int t0 = seg_beg + gi * 16;
            const int tok = lane & 15, kq = lane >> 4;
            const bf16_t* xr = X + (size_t)(t0 + tok) * 1024 + kq * 8;
            f32x4 acc0 = {0.f, 0.f, 0.f, 0.f}, acc1 = {0.f, 0.f, 0.f, 0.f};
            float ss = 0.f;
            u32x4 xa[16], xb[16];
#pragma unroll
            for (int k2 = 0; k2 < 16; ++k2) xa[k2] = *(const u32x4*)(xr + k2 * 32);
#pragma unroll
            for (int k2 = 0; k2 < 16; ++k2) xb[k2] = *(const u32x4*)(xr + (16 + k2) * 32);
#pragma unroll
            for (int kc = 0; kc < 2; ++kc) {
#pragma unroll
            for (int k2 = 0; k2 < 16; ++k2) { const int ks = kc * 16 + k2;
                if ((k2 & 3) == 0) __builtin_amdgcn_sched_barrier(0);
                const u32x4 xh = kc == 0 ? xa[k2] : xb[k2];
                const float x0 = bflo(xh.x), x1 = bfhi(xh.x), x2 = bflo(xh.y), x3 = bfhi(xh.y), x4 = bflo(xh.z), x5 = bfhi(xh.z), x6 = bflo(xh.w), x7 = bfhi(xh.w);
                ss += x0 * x0 + x1 * x1 + x2 * x2 + x3 * x3 + x4 * x4 + x5 * x5 + x6 * x6 + x7 * x7;
                const bf16x8 ah = __builtin_bit_cast(bf16x8, xh);
                const LAS char* wb = wfr + (size_t)(ks * 4) * 1024 + lane * 16;
                const bf16x8 b0h = *(const LAS bf16x8*)(wb), b0l = *(const LAS bf16x8*)(wb + 1024), b1h = *(const LAS bf16x8*)(wb + 2048), b1l = *(const LAS bf16x8*)(wb + 3072);
                acc0 = __builtin_amdgcn_mfma_f32_16x16x32_bf16(ah, b0h, acc0, 0, 0, 0); acc0 = __builtin_amdgcn_mfma_f32_16x16x32_bf16(ah, b0l, acc0, 0, 0, 0);
                acc1 = __builtin_amdgcn_mfma_f32_16x16x32_bf16(ah, b1h, acc1, 0, 0, 0); acc1 = __builtin_amdgcn_mfma_f32_16x16x32_bf16(ah, b1l, acc1, 0, 0, 0);
            } }
            u32x4 xp[16];
#pragma unroll
            for (int k2 = 0; k2 < 16; ++k2) xp[k2] = *(const u32x4*)(xr + k2 * 32);
            ss += shx(ss, 16); ss += shx(ss, 32);
            const float rn = rsqrtf(ss * (1.f / 1024.f) + EPS);
            const int ei = lane & 15;
            const float c0v = cvec[ei], c1v = cvec[16 + ei];
#pragma unroll
            for (int r = 0; r < 4; ++r) {
                const int tl = (lane >> 4) * 4 + r;
                const float rnt = shi(rn, tl);
                float v0 = fminf(fmaxf(acc0[r] * rnt + c0v, -1e30f), 1e30f), v1 = fminf(fmaxf(acc1[r] * rnt + c1v, -1e30f), 1e30f);
                int r0 = 0, r1 = 0;
                RankAcc<0>::run(v0, v1, ei, v0, v1, ei, r0, r1);
                const float mx = row_max16(fmaxf(v0, v1));
                const bool s0 = r0 < 4, s1 = r1 < 4;
                const float e0 = s0 ? __expf(v0 - mx) : 0.f, e1 = s1 ? __expf(v1 - mx) : 0.f;
                const float inv = 1.f / row_sum16(e0 + e1);
                const int t = t0 + tl;
                if (s0) { const int pos = atomicAdd((int*)&lcnt[ei], 1); lrec[(t - tbeg) * 4 + r0] = (unsigned)ei | ((unsigned)pos << 8); lwt[(t - tbeg) * 4 + r0] = e0 * inv; }
                if (s1) { const int pos = atomicAdd((int*)&lcnt[16 + ei], 1); lrec[(t - tbeg) * 4 + r1] = (unsigned)(16 + ei) | ((unsigned)pos << 8); lwt[(t - tbeg) * 4 + r1] = e1 * inv; }
            }
            unsigned char* hr = H8 + (size_t)(t0 + tok) * 1024 + kq * 8;
#pragma unroll 1
            for (int kc = 0; kc < 2; ++kc) {
            u32x4 xv[16];
            if (kc == 0) {
#pragma unroll
                for (int k2 = 0; k2 < 16; ++k2) xv[k2] = xp[k2];
            } else {
#pragma unroll
                for (int k2 = 0; k2 < 16; ++k2) xv[k2] = *(const u32x4*)(xr + (16 + k2) * 32);
            }
#pragma unroll
            for (int k2 = 0; k2 < 16; ++k2) { const int ks = kc * 16 + k2;
                const u32x4 xh = xv[k2];
                const u32x4 gq = *(const LAS u32x4*)(gml + ks * 32 + kq * 8), sq = *(const LAS u32x4*)(shl + ks * 32 + kq * 8);
                float h[8];
                h[0] = bflo(xh.x) * rn * bflo(gq.x) + bflo(sq.x); h[1] = bfhi(xh.x) * rn * bfhi(gq.x) + bfhi(sq.x); h[2] = bflo(xh.y) * rn * bflo(gq.y) + bflo(sq.y); h[3] = bfhi(xh.y) * rn * bfhi(gq.y) + bfhi(sq.y);
                h[4] = bflo(xh.z) * rn * bflo(gq.z) + bflo(sq.z); h[5] = bfhi(xh.z) * rn * bfhi(gq.z) + bfhi(sq.z); h[6] = bflo(xh.w) * rn * bflo(gq.w) + bflo(sq.w); h[7] = bfhi(xh.w) * rn * bfhi(gq.w) + bfhi(sq.w);
#pragma unroll
                for (int i = 0; i < 8; ++i) h[i] = __builtin_amdgcn_fmed3f(h[i], -448.f, 448.f);
                u32x2 o; o.x = pk_fp8x4(h[0], h[1], h[2], h[3]); o.y = pk_fp8x4(h[4], h[5], h[6], h[7]);
                *(u32x2*)(hr + ks * 32) = o;
            } }
        }
        seg_beg = seg_end;
    }
    __syncthreads();
    if (tid < 32) lbase[tid] = atomicAdd(&CNT[tid], lcnt[tid]);
    __syncthreads();
    for (int i = tid; i < (tend - tbeg) * 4; i += 512) { const unsigned rec = lrec[i]; const int e = rec & 255, pos = rec >> 8;
        u32x2 ent; ent.x = (unsigned)(tbeg * 4 + i); ent.y = __float_as_uint(lwt[i]);
        *(u32x2*)(LIST + ((size_t)e * TT + lbase[e] + pos) * 2) = ent; }
    __syncthreads();
}

DI void moe_tiles(const Params& p, LAS int* tstart, int l, const int wv_) {
    const int* CNT = (const int*)(p.ws + WS_CNT) + l * 32;
    if (otid() == 0) { int s = 0; for (int e = 0; e < 32; ++e) { tstart[e] = s; s += (CNT[e] + 255) >> 8; } tstart[32] = s; }
    __syncthreads();
    LAS int* ttab = (LAS int*)((LAS char*)tstart - (LDS_MISC + 64) + LDS_TTAB);
    const int MT_ = tstart[32];
    for (int mt = otid(); mt < MT_; mt += 512) { int e = 0;
#pragma unroll
        for (int i = 1; i < 32; ++i) e += (mt >= tstart[i]) ? 1 : 0;
        ttab[mt] = e | ((mt - tstart[e]) << 8); }
    __syncthreads();
}
DI int moe_find(const LAS int* tstart, int mt) { const LAS int* ttab = (const LAS int*)((const LAS char*)tstart - (LDS_MISC + 64) + LDS_TTAB); return __builtin_amdgcn_readfirstlane(ttab[mt]); }
struct PvMoe1 {
    const Params& p; int l; const LAS int* tstart; LAS char* tbl;
    static constexpr int NT = 8; static constexpr int FP8 = 2; static constexpr bool PARK = false; typedef ASimple AS; typedef BSimple BS;
    XcdDeal<4, 8> deal;
    DI int first() const { return deal.first(); }
    DI int next(int u) const { return deal.next(u); }
    typedef u32x4 Aux;
    DI void top(int u, Aux& aux, const int wv_) const {
        int mt, n8; deal.decode(u, mt, n8);
        const int ev_ = moe_find(tstart, mt); const int e = ev_ & 255;
        const int t_ = otid() & 63;
        aux = aload128(p.exp_b_in + (size_t)(l * NE + e) * 2048 + (t_ < 32 ? n8 * 128 + t_ * 4 : 1024 + n8 * 128 + (t_ - 32) * 4));
    }
    static constexpr bool BIASINIT = true;
    DI void mid(Aux& aux, const int wv_, const int slot) const { const int t_ = otid(); asm volatile("" : "+v"(aux));
        if (t_ < 64) { const f32x4 f = __builtin_bit_cast(f32x4, aux); const f32x4 o = t_ < 32 ? f * SWI_A : (f + 1.f) * (1.f / SWI_A); *(LAS f32x4*)(tbl + slot * 3072 + t_ * 16) = o; } }
    DI void binit(f32x4 (&q)[4][2], const int bj, const int par, const int wv_) const {
        const int _tz = otid(), _w = _tz >> 6, _l = _tz & 63, _wc = _w & 3, _fq = _l >> 4;
        const LAS float* bin = (const LAS float*)(tbl + par * 3072) + bj * 128 + _wc * 32 + _fq * 8;
        const f32x4 v0 = *(const LAS f32x4*)bin, v1 = *(const LAS f32x4*)(bin + 4);
#pragma unroll
        for (int m = 0; m < 4; ++m) { q[m][0] = v0; q[m][1] = v1; }
    }
    DI void fix(AS& as, bool wait, const int wv_) const {
        if (wait) asm volatile("s_waitcnt vmcnt(0)" ::: "memory");
        int R[2], C[2]; stage_coords(R, C, wv_);
#pragma unroll
        for (int h = 0; h < 2; ++h)
#pragma unroll
            for (int i = 0; i < 2; ++i) { unsigned sl = as.off[h][i]; asm volatile("" : "+v"(sl)); as.off[h][i] = (sl >> 2) * 1024u + (unsigned)(C[i] * 2); }
    }
    DI void src(int u, AS& as, BS& bs, const int wv_) const {
        int mt, n8; deal.decode(u, mt, n8);
        const int ev_ = moe_find(tstart, mt); const int e = ev_ & 255;
        const int r0 = (ev_ >> 8) * 256, cnt = ((const int*)(p.ws + WS_CNT))[l * 32 + e];
        const int* lst = (const int*)(p.ws + WS_LIST) + (size_t)e * TT * 2;
        int R[2], C[2]; stage_coords(R, C, wv_);
        as.base = (const char*)(p.ws + WS_H); as.kstride = 128;
#pragma unroll
        for (int h = 0; h < 2; ++h)
#pragma unroll
            for (int i = 0; i < 2; ++i) as.off[h][i] = aload32(lst + 2 * min(r0 + h * 128 + R[i], cnt - 1));
        const char* W = (const char*)(p.ws + WS_W1) + (size_t)(l * NE + e) * 2048 * 1024;
        bs.base[0] = W + (size_t)(n8 * 128) * 1024; bs.base[1] = W + (size_t)(1024 + n8 * 128) * 1024; bs.ldb2 = 1024;
    }
    DI void epi(f32x4 (&acc)[2][2][4][2], int u, const int wv_, const int par = 0) const {
        int mt, n8; deal.decode(u, mt, n8);
        const int ev_ = moe_find(tstart, mt); const int e = ev_ & 255;
        unsigned char* ACT = (unsigned char*)(p.ws + WS_RA);
        const int _tz = otid(), _w = _tz >> 6, _l = _tz & 63, _wr = _w >> 2, _wc = _w & 3, _fr = _l & 15, _fq = _l >> 4;
        (void)e;
#pragma unroll
        for (int ai = 0; ai < 2; ++ai)
#pragma unroll
            for (int m = 0; m < 4; ++m) { const int lr = ai * 128 + _wr * 64 + m * 16 + _fr;
                unsigned char* orow = ACT + ((size_t)mt * 256 + lr) * 1024 + n8 * 128 + _wc * 32 + _fq * 8;
                u32x2 pk;
#pragma unroll
                for (int n = 0; n < 2; ++n) {
                    float o[4];
#pragma unroll
                    for (int h2 = 0; h2 < 2; ++h2) {
                        const f32v2_t ag = {acc[ai][0][m][n][2 * h2], acc[ai][0][m][n][2 * h2 + 1]}, au = {acc[ai][1][m][n][2 * h2], acc[ai][1][m][n][2 * h2 + 1]};
                        f32v2_t g2 = ag, u2 = au;
                        g2[0] = fminf(g2[0], 7.f * SWI_A); g2[1] = fminf(g2[1], 7.f * SWI_A);
                        u2[0] = __builtin_amdgcn_fmed3f(u2[0], -6.f / SWI_A, 8.f / SWI_A); u2[1] = __builtin_amdgcn_fmed3f(u2[1], -6.f / SWI_A, 8.f / SWI_A);
                        f32v2_t e2; e2[0] = __builtin_amdgcn_exp2f(-g2[0]); e2[1] = __builtin_amdgcn_exp2f(-g2[1]);
                        const f32v2_t d2 = e2 + 1.f;
                        f32v2_t r2; r2[0] = __builtin_amdgcn_rcpf(d2[0]); r2[1] = __builtin_amdgcn_rcpf(d2[1]);
                        const f32v2_t o2 = u2 * g2 * r2;
                        o[2 * h2] = o2[0]; o[2 * h2 + 1] = o2[1]; }
                    if (n == 0) pk.x = pk_fp8x4(o[0], o[1], o[2], o[3]); else pk.y = pk_fp8x4(o[0], o[1], o[2], o[3]); }
                *(u32x2*)orow = pk; }
    }
};
DI void phase_moe1(const Params& p, LAS char* shm, int l, const int wv_) {
    LAS int* tstart = (LAS int*)(shm + LDS_MISC + 64);
    moe_tiles(p, tstart, l, wv_);
    PvMoe1 pv{p, l, tstart, shm + 131072, {tstart[32]}}; gemm_stream(shm, pv, wv_);
}
struct PvMoe2 {
    const Params& p; int l; const LAS int* tstart; LAS char* tbl;
    static constexpr int NT = 8; static constexpr int FP8 = 2; static constexpr bool PARK = false; typedef APlain AS; typedef BSeq16 BS;
    XcdDeal<4, 4> deal;
    DI int first() const { return deal.first(); }
    DI int next(int u) const { return deal.next(u); }
    template <class A_> DI void fix(A_&, bool, const int) const {}
    typedef u32x4 Aux;
    DI void top(int u, Aux& aux, const int wv_) const {
        int mt, n4; deal.decode(u, mt, n4);
        const int ev_ = moe_find(tstart, mt); const int e = ev_ & 255; const int r0 = (ev_ >> 8) * 256;
        const int t_ = otid();
        const char* src_ = t_ < 128 ? (const char*)((const int*)(p.ws + WS_LIST) + (size_t)e * TT * 2 + (size_t)(r0 + 2 * t_) * 2)
                                    : (const char*)(p.exp_b_out + (size_t)(l * NE + e) * 1024 + n4 * 256 + ((t_ - 128) & 63) * 4);
        aux = aload128(src_);
    }
    static constexpr bool BIASINIT = true;
    DI void mid(Aux& aux, const int wv_, const int slot) const { const int t_ = otid(); asm volatile("" : "+v"(aux)); if (t_ < 192) *(LAS u32x4*)(tbl + slot * 3072 + t_ * 16) = aux; }
    DI void binit(f32x4 (&q)[4][2], const int bj, const int par, const int wv_) const {
        const int _tz = otid(), _w = _tz >> 6, _l = _tz & 63, _wc = _w & 3, _fq = _l >> 4;
        const LAS float* bo = (const LAS float*)(tbl + par * 3072 + 2048) + _wc * 64 + _fq * 16 + bj * 8;
        const f32x4 v0 = *(const LAS f32x4*)bo, v1 = *(const LAS f32x4*)(bo + 4);
#pragma unroll
        for (int m = 0; m < 4; ++m) { q[m][0] = v0; q[m][1] = v1; }
    }
    DI void src(int u, AS& as, BS& bs, const int wv_) const {
        int mt, n4; deal.decode(u, mt, n4);
        const int ev_ = moe_find(tstart, mt); const int e = ev_ & 255;
        as.base = (const char*)(p.ws + WS_RA) + (size_t)mt * 256 * 1024; as.lda2 = 1024;
        const char* W = (const char*)(p.ws + WS_W2) + (size_t)(l * NE + e) * 1024 * 1024;
        bs.base = W + (size_t)(n4 * 256) * 1024; bs.ldb2 = 1024;
    }
    DI void epi(f32x4 (&acc)[2][2][4][2], int u, const int wv_, const int par = 0) const {
        int mt, n4; deal.decode(u, mt, n4);
        const int ev_ = moe_find(tstart, mt); const int e = ev_ & 255;
        const int r0 = (ev_ >> 8) * 256, cnt = ((const int*)(p.ws + WS_CNT))[l * 32 + e];
        const int* lst = (const int*)(p.ws + WS_LIST) + (size_t)e * TT * 2;
        unsigned char* Y = (unsigned char*)(p.ws + WS_RY);
        const int _tz = otid(), _w = _tz >> 6, _l = _tz & 63, _wr = _w >> 2, _wc = _w & 3, _fr = _l & 15, _fq = _l >> 4;
        u32x2 ent[2][4];
#pragma unroll
        for (int ai = 0; ai < 2; ++ai)
#pragma unroll
            for (int m = 0; m < 4; ++m) ent[ai][m] = *(const LAS u32x2*)(tbl + par * 3072 + (ai * 128 + _wr * 64 + m * 16 + _fr) * 8);
        (void)lst;
#pragma unroll
        for (int ai = 0; ai < 2; ++ai)
#pragma unroll
            for (int m = 0; m < 4; ++m) { const int lr = r0 + ai * 128 + _wr * 64 + m * 16 + _fr;
                if (lr < cnt) { const float w = __uint_as_float(ent[ai][m].y) * YSCALE; unsigned char* orow = Y + (size_t)ent[ai][m].x * 1024 + n4 * 256 + _wc * 64 + _fq * 16;
                    u32x4 pk;
#pragma unroll
                    for (int bj = 0; bj < 2; ++bj)
#pragma unroll
                        for (int n = 0; n < 2; ++n) { const f32x4 v = acc[ai][bj][m][n] * w;
                            pk[bj * 2 + n] = pk_fp8x4(__builtin_amdgcn_fmed3f(v[0], -448.f, 448.f), __builtin_amdgcn_fmed3f(v[1], -448.f, 448.f), __builtin_amdgcn_fmed3f(v[2], -448.f, 448.f), __builtin_amdgcn_fmed3f(v[3], -448.f, 448.f)); }
                    *(u32x4*)orow = pk; } }
    }
};
DI void phase_moe2(const Params& p, LAS char* shm, int l, const int wv_) {
    LAS int* tstart = (LAS int*)(shm + LDS_MISC + 64);
    moe_tiles(p, tstart, l, wv_);
    PvMoe2 pv{p, l, tstart, shm + 131072, {tstart[32]}}; gemm_stream(shm, pv, wv_);
}

DI void phase_combine(const Params& p, LAS char* shm, int l, const int wv_) {
    const int tid = otid(), wid = tid >> 6, lane = tid & 63;
    const bool alt = p.ph_lo != 0;
    const bf16_t* X = (const bf16_t*)(p.ws + WS_X);
    bf16_t* XO = alt ? (bf16_t*)(p.ws + WS_RA) : (bf16_t*)(p.ws + WS_X);
    float* OUT = alt ? (float*)(p.ws + WS_RA) : p.out;
    const unsigned char* Y = (const unsigned char*)(p.ws + WS_RY);
    const float* MOD = (const float*)(p.ws + WS_MOD);
    bf16_t* H = alt ? (bf16_t*)(p.ws + WS_RA + (size_t)TT * 1024 * 4) : (bf16_t*)(p.ws + WS_H);
    const int Tm = (l == 1) ? TX : TT;
    for (int r = blockIdx.x * 8 + wid; r < Tm; r += gridDim.x * 8) {
        const float* g2 = MOD + (size_t)(l * 33 + mod_row(r)) * 6144 + 5120;
        float v[16];
#pragma unroll
        for (int j = 0; j < 4; ++j) {
            const int col = j * 256 + lane * 4;
            f32x4 s = (f32x4){0.f, 0.f, 0.f, 0.f};
#pragma unroll
            for (int k = 0; k < 4; ++k) { const int yy = *(const int*)(Y + ((size_t)r * 4 + k) * 1024 + col); const f32v2_t ya = __builtin_amdgcn_cvt_pk_f32_fp8(yy, false), yb = __builtin_amdgcn_cvt_pk_f32_fp8(yy, true);
                s[0] += ya[0]; s[1] += ya[1]; s[2] += yb[0]; s[3] += yb[1]; }
            s *= 1.f / YSCALE;
            const u32x2 xb_ = *(const u32x2*)(X + (size_t)r * 1024 + col); const f32x4 gg = *(const f32x4*)(g2 + col);
            const f32x4 xv = (f32x4){bflo(xb_.x), bfhi(xb_.x), bflo(xb_.y), bfhi(xb_.y)};
            const f32x4 o = xv + gg * s;
            if (l == 1) *(f32x4*)(OUT + (size_t)r * 1024 + col) = o; else store_bf16x4(XO + (size_t)r * 1024 + col, o[0], o[1], o[2], o[3]);
            v[j * 4] = o[0]; v[j * 4 + 1] = o[1]; v[j * 4 + 2] = o[2]; v[j * 4 + 3] = o[3];
        }
        if (l == 0) norm_mod_store(v, p.norm1_g + 1024, MOD + (size_t)(1 * 33 + mod_row(r)) * 6144, H + (size_t)r * 1024, wv_);
    }
}

constexpr int NPH_LAYER = 10;
constexpr int NPH = 2 + 2 * NPH_LAYER;

__global__ void __launch_bounds__(512, 2) mk_forward(Params p_unused) {
    extern __shared__ __attribute__((aligned(16))) char smem_raw[];
    LAS char* shm = (LAS char*)smem_raw;
    volatile LAS unsigned* xb_words = (volatile LAS unsigned*)(shm + LDS_MISC);
    const int wv_ = __builtin_amdgcn_readfirstlane((int)(threadIdx.x >> 6));
    if (wv_ == 0 && olane() < 4) xb_words[olane()] = 0u;
    __syncthreads();
    kaptr_t ka = (kaptr_t)__builtin_amdgcn_kernarg_segment_ptr();
    const int tok0 = ptoken();
    const int lo = (int)kld64<__builtin_offsetof(Params, ph_lo)>(ka, tok0), hi = (int)kld64<__builtin_offsetof(Params, ph_hi)>(ka, tok0);
    const bool multi = (hi - lo) > 1;
    unsigned* barw = (unsigned*)((__attribute__((address_space(1))) char*)kld64<__builtin_offsetof(Params, ws)>(ka, tok0) + WS_BAR);
    XcdBarrier bar; bar.bar = barw; bar.x = 0; bar.st = xb_words;
    if (multi) bar = xcd_barrier_post(barw, xb_words, wv_);
#ifndef ONLY_KIND
#define ONLY_KIND (-1)
#endif
#define PHASE(idx, kind, FN, ...) do { if ((ONLY_KIND < 0 || ONLY_KIND == (kind)) && (idx) >= lo && (idx) < hi) { const Params p = kparams(ka, ptoken()); int nrep_ = 1 + ((MK_REPEAT_MASK >> (kind)) & 1); asm volatile("" : "+s"(nrep_)); for (int rep_ = 0; rep_ < nrep_; ++rep_) { Params p2 = p; p2.ph_lo = rep_; FN(p2, ##__VA_ARGS__, wv_); } if ((idx) + 1 < hi) xcd_barrier(bar, wv_); } } while (0)
    PHASE(0, 0, phase_prologue, shm);
    PHASE(1, 1, phase_norm1_l0);
    for (int l = 0; l < 2; ++l) {
        const int b0 = 2 + l * NPH_LAYER;
        PHASE(b0 + 0, 2, phase_inproj, shm, l);
        PHASE(b0 + 1, 3, phase_A, shm, l);
        PHASE(b0 + 2, 4, phase_B, shm, l);
        PHASE(b0 + 3, 5, phase_C, shm, l);
        PHASE(b0 + 4, 6, phase_D, shm, l);
        PHASE(b0 + 5, 7, phase_E, shm, l);
        PHASE(b0 + 6, 8, phase_router, shm, l);
        PHASE(b0 + 7, 9, phase_moe1, shm, l);
        PHASE(b0 + 8, 10, phase_moe2, shm, l);
        PHASE(b0 + 9, 11, phase_combine, shm, l);
    }
#undef PHASE
}


extern "C" void kernel_launch(void* const* d_in, const int* in_sizes, int n_in, void* d_out, int out_size, void* d_ws, size_t ws_size, hipStream_t stream) {
    static int grid = 0;
    if (grid == 0) {
        if (n_in != 39 || ws_size < WS_END) { fprintf(stderr, "kernel_launch: unexpected n_in %d or ws_size %zu (< %zu)\n", n_in, ws_size, (size_t)WS_END); grid = -1; return; }
        int dev = 0, cus = 0;
        if (hipGetDevice(&dev) != hipSuccess || hipDeviceGetAttribute(&cus, hipDeviceAttributeMultiprocessorCount, dev) != hipSuccess) { grid = -1; return; }
        if (hipFuncSetAttribute((const void*)mk_forward, hipFuncAttributeMaxDynamicSharedMemorySize, LDS_BYTES) != hipSuccess) { fprintf(stderr, "kernel_launch: hipFuncSetAttribute failed\n"); grid = -1; return; }
        int per_cu = 0;
        if (hipOccupancyMaxActiveBlocksPerMultiprocessor(&per_cu, (const void*)mk_forward, 512, LDS_BYTES) != hipSuccess || per_cu < 1) fprintf(stderr, "kernel_launch: occupancy query says %d\n", per_cu);
        (void)hipGetLastError();
        grid = cus > 256 ? 256 : cus;
    }
    if (grid < 0) return;
    (void)hipMemsetAsync((char*)d_ws + WS_BAR, 0, 16384 + 1024, stream);
    Params p{};
    const float** pf = (const float**)&p;
    for (int i = 0; i < 39; ++i) pf[i] = (const float*)d_in[i];
    p.out = (float*)d_out; p.ws = (char*)d_ws;
#if MK_ONE_LAUNCH
    p.ph_lo = 0; p.ph_hi = NPH;
    hipLaunchKernelGGL(mk_forward, dim3(grid), dim3(512), LDS_BYTES, stream, p);
#else
#ifndef MK_LAST_PHASE
#define MK_LAST_PHASE NPH
#endif
    for (int ph = 0; ph < MK_LAST_PHASE; ++ph) { p.ph_lo = ph; p.ph_hi = ph + 1; hipLaunchKernelGGL(mk_forward, dim3(grid), dim3(512), LDS_BYTES, stream, p); }
#endif
}
```

```cpp
#include <hip/hip_runtime.h>
#include <stdint.h>
#include <stdio.h>

#ifndef MK_REPEAT_MASK
#define MK_REPEAT_MASK 0x0
#endif
#ifndef MK_ONE_LAUNCH
#define MK_ONE_LAUNCH 1
#endif

#define DI __device__ __forceinline__
#define LAS __attribute__((address_space(3)))
typedef unsigned short bf16_t;
typedef short bf16x8 __attribute__((ext_vector_type(8)));
typedef short s16x4 __attribute__((ext_vector_type(4)));
typedef float f32x4 __attribute__((ext_vector_type(4)));
typedef float f32x16 __attribute__((ext_vector_type(16)));
typedef unsigned u32x2 __attribute__((ext_vector_type(2)));
typedef unsigned u32x4 __attribute__((ext_vector_type(4)));
typedef int i32x4 __attribute__((ext_vector_type(4)));
typedef int i32x8 __attribute__((ext_vector_type(8)));

constexpr int D = 1024, NB = 32, SEQ = 2048, CTXL = 256;
constexpr int TX = NB * SEQ, TC = NB * CTXL, TT = TX + TC;
constexpr int NINP = 1536;
constexpr int OFF_POOL = 512, OFF_Q = 768, OFF_SSM = 960, OFF_KV = 1216, OFF_KPE = 1344, N_IN = 1376;
constexpr int NE = 32;
constexpr int NCH = 36;
constexpr int NCROW = NB * NCH;
constexpr float EPS = 1e-6f;

constexpr size_t WS_BAR = 0;
constexpr size_t WS_CNT = 16384;
constexpr size_t WS_MOD = WS_CNT + 1024;
constexpr size_t WS_A64 = WS_MOD + (size_t)2 * 33 * 6144 * 4;
constexpr size_t WS_WMI = WS_A64 + (size_t)2 * 2 * 16 * 64 * 2 * 4;
constexpr size_t WS_WMO = WS_WMI + (size_t)2 * 1536 * 1024 * 2;
constexpr size_t WS_WPW = WS_WMO + (size_t)2 * 1024 * 1024 * 2;
constexpr size_t WS_WGLU = WS_WPW + (size_t)2 * 256 * 256 * 2;
constexpr size_t WS_WPOOL = WS_WGLU + (size_t)2 * 256 * 256 * 2;
constexpr size_t WS_WQ = WS_WPOOL + (size_t)2 * 256 * 256 * 2;
constexpr size_t WS_WKV = WS_WQ + (size_t)2 * 512 * 256 * 2;
constexpr size_t WS_TS5 = WS_WKV + (size_t)2 * 512 * 256 * 2;
constexpr size_t WS_WS5 = WS_TS5 + (size_t)2 * 16 * 1024 * 1280 * 2;
constexpr size_t WS_W1 = WS_WS5 + (size_t)2 * 16 * 256 * 1024 * 2;
constexpr size_t WS_W2 = WS_W1 + (size_t)32 * 2048 * 1024 * 2;
constexpr size_t WS_X = WS_W2 + (size_t)32 * 1024 * 1024 * 2;
constexpr size_t WS_H = WS_X + (size_t)TT * 1024 * 4;
constexpr size_t WS_LIST = WS_H + (size_t)TT * 1024 * 2;
constexpr size_t WS_TOPW = WS_LIST + (size_t)32 * TT * 8;
constexpr size_t WS_RA = WS_TOPW + (size_t)TT * 4 * 4;
constexpr float YSCALE = 32.f;
constexpr size_t WS_RY = WS_RA + (size_t)TT * 4 * 1024 * 2;
constexpr size_t WS_END = WS_RY + (size_t)TT * 4 * 1024 * 2;
constexpr size_t WS_P = WS_RA;
constexpr size_t WS_ACONV = WS_P + (size_t)TT * NINP * 2;
constexpr size_t WS_APOOL = WS_ACONV + (size_t)TT * 256 * 2;
constexpr size_t WS_RAWQ = WS_APOOL + (size_t)TT * 256 * 2;
constexpr size_t WS_RAWKV = WS_RAWQ + (size_t)TT * 512 * 4;
constexpr size_t WS_Q = WS_RAWKV + (size_t)TT * 512 * 4;
constexpr size_t WS_KB = WS_Q + (size_t)TT * 384 * 2;
constexpr size_t WS_VT = WS_KB + (size_t)128 * 2304 * 96 * 2;
constexpr size_t WS_SST = WS_VT + (size_t)128 * 64 * 2304 * 2;
constexpr size_t WS_HIN = WS_SST + (size_t)NCROW * 16 * 256 * 4;
constexpr size_t WS_Z = WS_HIN + (size_t)NCROW * 16 * 256 * 2;
constexpr size_t WS_CAT = WS_Z + (size_t)TT * 256 * 2;
constexpr size_t WS_MIX_END = WS_CAT + (size_t)TT * 1024 * 2;
static_assert(WS_MIX_END <= WS_END, "mixer buffers must fit in the ACT/Y regions");
static_assert(WS_END <= (size_t)2147483648ull, "workspace budget");

constexpr int LDS_BYTES = 147456;
constexpr int LDS_TTAB = 131072 + 4096;
constexpr int LDS_MISC = 146432;

struct Params {
    const float *x, *c, *ctx, *c_ctx, *ada_w, *ada_b, *norm1_g, *norm2_g, *w_mix_in, *w_mix_out,
        *conv_dw, *conv_dw_b, *conv_ln_g, *conv_ln_b, *conv_pw, *pool_w, *pool_scale,
        *ssm_a_re, *ssm_a_im, *ssm_log_dt, *ssm_b_re, *ssm_b_im, *ssm_c_re, *ssm_c_im, *ssm_d, *ssm_glu_w, *ssm_glu_b,
        *mla_q_a_g, *mla_wq_b, *mla_kv_a_g, *mla_wkv_b, *mla_q_g, *mla_k_g,
        *router_w, *router_b, *exp_w_in, *exp_b_in, *exp_w_out, *exp_b_out;
    float* out;
    char* ws;
    long long ph_lo, ph_hi;
};

typedef const __attribute__((address_space(4))) char* kaptr_t;
template <int OFF> DI unsigned long long kld64(kaptr_t ka, int tok) {
    unsigned long long v;
    asm("s_load_dwordx2 %0, %1, %3\n\ts_waitcnt lgkmcnt(0)" : "=&s"(v) : "s"(ka), "s"(tok), "n"(OFF));
    return v;
}
DI int ptoken() { int t; asm volatile("s_mov_b32 %0, 0" : "=s"(t)); return t; }
DI Params kparams(kaptr_t ka, int tok) {
    Params p;
#define KL_(f) p.f = (decltype(p.f))((__attribute__((address_space(1))) char*)kld64<__builtin_offsetof(Params, f)>(ka, tok))
    KL_(x); KL_(c); KL_(ctx); KL_(c_ctx); KL_(ada_w); KL_(ada_b); KL_(norm1_g); KL_(norm2_g); KL_(w_mix_in); KL_(w_mix_out); KL_(conv_dw); KL_(conv_dw_b); KL_(conv_ln_g); KL_(conv_ln_b); KL_(conv_pw); KL_(pool_w); KL_(pool_scale); KL_(ssm_a_re); KL_(ssm_a_im); KL_(ssm_log_dt); KL_(ssm_b_re); KL_(ssm_b_im); KL_(ssm_c_re); KL_(ssm_c_im); KL_(ssm_d); KL_(ssm_glu_w); KL_(ssm_glu_b); KL_(mla_q_a_g); KL_(mla_wq_b); KL_(mla_kv_a_g); KL_(mla_wkv_b); KL_(mla_q_g); KL_(mla_k_g); KL_(router_w); KL_(router_b); KL_(exp_w_in); KL_(exp_b_in); KL_(exp_w_out); KL_(exp_b_out); KL_(out); KL_(ws);
#undef KL_
    p.ph_lo = 0; p.ph_hi = 0;
    return p;
}

typedef __bf16 bf16v2_t __attribute__((ext_vector_type(2)));
typedef float f32v2_t __attribute__((ext_vector_type(2)));
DI unsigned pk_bf16(float lo, float hi) { const f32v2_t f = {lo, hi}; const bf16v2_t b = __builtin_convertvector(f, bf16v2_t); return __builtin_bit_cast(unsigned, b); }
DI bf16_t f2bf(float x) { return (bf16_t)(pk_bf16(x, 0.f) & 0xffffu); }
DI float bf2f(bf16_t v) { return __uint_as_float(((unsigned)v) << 16); }
DI unsigned f2fp8(float x) { x = fminf(fmaxf(x, -448.f), 448.f); return (unsigned)__builtin_amdgcn_cvt_pk_fp8_f32(x, x, 0, false) & 0xffu; }
DI unsigned pk_fp8x4(float a, float b, float c, float d) { int v = __builtin_amdgcn_cvt_pk_fp8_f32(a, b, 0, false); v = __builtin_amdgcn_cvt_pk_fp8_f32(c, d, v, true); return (unsigned)v; }
DI float bflo(unsigned u) { return __uint_as_float(u << 16); }
DI float bfhi(unsigned u) { return __uint_as_float(u & 0xffff0000u); }
DI int olane() { int l = (int)__builtin_amdgcn_mbcnt_hi(~0u, __builtin_amdgcn_mbcnt_lo(~0u, 0u)); asm volatile("" : "+v"(l)); return l; }
DI float shx(float v, int o) { const int l = olane(); return __int_as_float(__builtin_amdgcn_ds_bpermute((l ^ o) << 2, __float_as_int(v))); }
DI float shi(float v, int src) { return __int_as_float(__builtin_amdgcn_ds_bpermute(src << 2, __float_as_int(v))); }
#define otid() otid_(wv_)
DI int otid_(int wv) { int t = (wv << 6) | olane(); asm volatile("" : "+v"(t)); return t; }
DI float wave_sum(float v) {
#pragma unroll
    for (int o = 32; o > 0; o >>= 1) v += shx(v, o);
    return v;
}
DI float wave_max(float v) {
#pragma unroll
    for (int o = 32; o > 0; o >>= 1) v = fmaxf(v, shx(v, o));
    return v;
}
DI float sigmoidf_(float x) { return __builtin_amdgcn_rcpf(1.f + __builtin_amdgcn_exp2f(-1.4426950408889634f * x)); }
DI float siluf_(float x) { return x * sigmoidf_(x); }
DI float gelu_tanh(float x) {
    const float u = 0.7978845608028654f * (x + 0.044715f * x * x * x);
    return x * __builtin_amdgcn_rcpf(1.f + __builtin_amdgcn_exp2f(-2.8853900817779268f * u));
}
DI unsigned aload32(const void* p_) { unsigned r; asm volatile("global_load_dword %0, %1, off" : "=v"(r) : "v"(p_) : "memory"); return r; }
DI u32x4 aload128(const void* p_) { u32x4 r; asm volatile("global_load_dwordx4 %0, %1, off" : "=v"(r) : "v"(p_) : "memory"); return r; }
#define PV_NOHOOKS typedef int Aux; DI void top(int, Aux&, const int) const {} DI void mid(Aux&, const int) const {} template <class A_> DI void fix(A_&, bool, const int) const {}
DI void glds16(const void* src, LAS char* dst) {
    __builtin_amdgcn_global_load_lds((const __attribute__((address_space(1))) void*)src, (LAS void*)dst, 16, 0, 0);
}

#define XB_TMO      128
#define XB_XCNT(j)  (256  + 64 * (j))
#define XB_XSUB(j)  (1280 + 64 * (j))
#define XB_XGEN(j)  (2304 + 64 * (j))
#define XB_TOP      3328
#define XB_TOPGEN   3392
#define XCD_BAR_WORDS 3456
#define XB_SPIN_CAP (1u << 18)
__device__ __forceinline__ unsigned xb_ld(unsigned* p)              { return __hip_atomic_load(p, __ATOMIC_RELAXED, __HIP_MEMORY_SCOPE_AGENT); }
__device__ __forceinline__ unsigned xb_add(unsigned* p, unsigned v) { return __hip_atomic_fetch_add(p, v, __ATOMIC_RELAXED, __HIP_MEMORY_SCOPE_AGENT); }
__device__ __forceinline__ unsigned xb_xcc_id() { return (unsigned)__builtin_amdgcn_s_getreg((3 << 11) | 20) & 0xFu; }
#define XB_SPIN(cond, bar) do { unsigned _sp = 0; while (cond) { __builtin_amdgcn_s_sleep(1); \
    if ((++_sp & 255u) == 0u) { if (xb_ld(&(bar)[XB_TMO])) break; if (_sp > XB_SPIN_CAP) { atomicAdd(&(bar)[XB_TMO], 1u); break; } } } } while (0)
struct XcdBarrier { unsigned* bar; unsigned x; volatile LAS unsigned* st; };
__device__ __forceinline__ XcdBarrier xcd_barrier_post(unsigned* bar, volatile LAS unsigned* st, const int wv_) {
    XcdBarrier b; b.bar = bar; b.x = xb_xcc_id(); b.st = st;
    if (otid() == 0) (void)xb_add(&bar[XB_XCNT(b.x)], 1u);
    return b;
}
__device__ __forceinline__ void xcd_barrier_complete(unsigned* bar, unsigned x, unsigned& nloc, unsigned& nx) {
    const unsigned G = gridDim.x * gridDim.y * gridDim.z;
    unsigned sum, cnt, mine, sp = 0u;
    for (;;) {
        sum = 0u; cnt = 0u; mine = 0u;
#pragma unroll
        for (unsigned j = 0; j < 16; ++j) { const unsigned c = xb_ld(&bar[XB_XCNT(j)]); sum += c; cnt += (c > 0u) ? 1u : 0u; mine = (j == x) ? c : mine; }
        if (sum == G) break;
        __builtin_amdgcn_s_sleep(1);
        if ((++sp & 255u) == 0u) { if (xb_ld(&bar[XB_TMO])) break; if (sp > XB_SPIN_CAP) { atomicAdd(&bar[XB_TMO], 1u); break; } }
    }
    nloc = mine > 0u ? mine : 1u; nx = cnt > 0u ? cnt : 1u;
}
__device__ __forceinline__ void xcd_barrier(const XcdBarrier& b, const int wv_) {
    asm volatile("s_waitcnt vmcnt(0)" ::: "memory");
    __syncthreads();
    if (otid() == 0) {
        unsigned* bar = b.bar;
        __builtin_amdgcn_s_waitcnt(0);
        unsigned nloc = b.st[0], nx = b.st[1];
        if (nloc == 0u) { xcd_barrier_complete(bar, b.x, nloc, nx); b.st[0] = nloc; b.st[1] = nx; }
        const unsigned old = xb_add(&bar[XB_XSUB(b.x)], 1u);
        const unsigned gen = old / nloc;
        if (old + 1u == (gen + 1u) * nloc) {
            __builtin_amdgcn_fence(__ATOMIC_RELEASE, "agent");
            asm volatile("s_waitcnt vmcnt(0)" ::: "memory");
            const unsigned og = xb_add(&bar[XB_TOP], 1u);
            const unsigned tg = og / nx;
            if (og + 1u == (tg + 1u) * nx) xb_add(&bar[XB_TOPGEN], 1u);
            else XB_SPIN(xb_ld(&bar[XB_TOPGEN]) == tg, bar);
            __builtin_amdgcn_fence(__ATOMIC_ACQUIRE, "agent");
            xb_add(&bar[XB_XGEN(b.x)], 1u);
            asm volatile("s_waitcnt vmcnt(0)" ::: "memory");
        } else {
            XB_SPIN(xb_ld(&bar[XB_XGEN(b.x)]) == gen, bar);
            __builtin_amdgcn_fence(__ATOMIC_ACQUIRE, "agent");
            asm volatile("s_waitcnt vmcnt(0)" ::: "memory");
        }
    }
    __syncthreads();
}

constexpr int HTB = 128 * 64 * 2;
DI int lds_byte(int r, int c) { const int st = (r >> 4) * 2 + (c >> 5), rr = r & 15, cc = c & 31, ob = rr * 64 + cc * 2; return st * 1024 + (ob ^ (((ob >> 9) & 1) << 5)); }
DI void stage_rc(int b, int& R, int& C) { const int st = b / 1024, sb = b % 1024, swz = sb ^ (((sb >> 9) & 1) << 5); R = (st >> 1) * 16 + swz / 64; C = (st & 1) * 32 + (swz % 64) / 2; }

DI void stage_rc_t(int tz, int i, int& R, int& C) { stage_rc(tz * 16 + i * 8192, R, C); }
struct APlain {
    const char* base; int lda2;
    DI void park(LAS unsigned*) const {} DI void unpark(const LAS unsigned*) {} DI void take_uniform(const APlain&) {}
    DI const char* ptr(int tz, int h, int i, int kt) const { int R, C; stage_rc_t(tz, i, R, C); return base + (unsigned)((h * 128 + R) * lda2 + C * 2 + kt * 128); }
};
struct ASimple {
    const char* base; unsigned off[2][2]; unsigned kstride;
    DI void park(LAS unsigned* q) const { *(LAS u32x4*)q = (u32x4){off[0][0], off[0][1], off[1][0], off[1][1]}; }
    DI void unpark(const LAS unsigned* q) { const u32x4 v = *(const LAS u32x4*)q; off[0][0] = v.x; off[0][1] = v.y; off[1][0] = v.z; off[1][1] = v.w; }
    DI void take_uniform(const ASimple& o) { base = o.base; kstride = o.kstride; }
    DI const char* ptr(int tz, int h, int i, int kt) const { return base + (unsigned)(off[h][i] + (unsigned)kt * kstride); }
};
struct ASeg2 {
    const char* base0; const char* base1; unsigned off0[2][2]; unsigned off1[2][2]; unsigned ks0; int nt0;
    DI void park(LAS unsigned*) const {} DI void unpark(const LAS unsigned*) {} DI void take_uniform(const ASeg2&) {}
    DI const char* ptr(int tz, int h, int i, int kt) const { return kt < nt0 ? base0 + (unsigned)(off0[h][i] + (unsigned)kt * ks0) : base1 + (unsigned)(off1[h][i] + (unsigned)(kt - nt0) * 128u); }
};
DI int perm32(int rho) { const int n = rho >> 4, i = rho & 15; return 8 * (i >> 2) + 4 * n + (i & 3); }
struct BSimple {
    const char* base[2]; int ldb2;
    DI const char* ptr(int tz, int h, int i, int kt) const { int R, C; stage_rc_t(tz, i, R, C); const int Rb = (R & ~31) + perm32(R & 31); return base[h] + (unsigned)(Rb * ldb2 + C * 2 + kt * 128); }
};

struct BSeq16 {
    const char* base; int ldb2;
    DI const char* ptr(int tz, int h, int i, int kt) const { int R, C; stage_rc_t(tz, i, R, C); const int rho = R & 31;
        const int Rb = (R >> 5) * 64 + ((rho & 15) >> 2) * 16 + h * 8 + (rho >> 4) * 4 + (rho & 3); return base + (unsigned)(Rb * ldb2 + C * 2 + kt * 128); }
};

#define WAIT_V(n) asm volatile("s_waitcnt vmcnt(" #n ")" ::: "memory")
#define WAIT_L(n) asm volatile("s_waitcnt lgkmcnt(" #n ")" ::: "memory")
#define BAR_ __builtin_amdgcn_s_barrier()
#define SCHED_ __builtin_amdgcn_sched_barrier(0)

DI void zero_acc(f32x4 (&acc)[2][2][4][2]) {
#pragma unroll
    for (int a = 0; a < 2; ++a)
#pragma unroll
        for (int b = 0; b < 2; ++b)
#pragma unroll
            for (int m = 0; m < 4; ++m)
#pragma unroll
                for (int n = 0; n < 2; ++n) acc[a][b][m][n] = (f32x4){0.f, 0.f, 0.f, 0.f};
}
template <int MODE> struct FragT;
template <> struct FragT<0> {
    i32x4 lo, hi;
    DI void load(const LAS char* p0, const LAS char* p1) { lo = *(const LAS i32x4*)p0; hi = *(const LAS i32x4*)p1; }
    static DI f32x4 mma(const FragT& b, const FragT& a, f32x4 c) {
        c = __builtin_amdgcn_mfma_f32_16x16x32_bf16(__builtin_bit_cast(bf16x8, b.lo), __builtin_bit_cast(bf16x8, a.lo), c, 0, 0, 0);
        return __builtin_amdgcn_mfma_f32_16x16x32_bf16(__builtin_bit_cast(bf16x8, b.hi), __builtin_bit_cast(bf16x8, a.hi), c, 0, 0, 0); }
};
template <> struct FragT<1> {
    i32x4 lo, hi;
    DI void load(const LAS char* p0, const LAS char* p1) { lo = *(const LAS i32x4*)p0; hi = *(const LAS i32x4*)p1; }
    static DI long pk(int x, int y) { return (long)(((unsigned long long)(unsigned)y << 32) | (unsigned)x); }
    static DI f32x4 mma(const FragT& b, const FragT& a, f32x4 c) {
        c = __builtin_amdgcn_mfma_f32_16x16x32_fp8_fp8(pk(b.lo.x, b.lo.y), pk(a.lo.x, a.lo.y), c, 0, 0, 0);
        c = __builtin_amdgcn_mfma_f32_16x16x32_fp8_fp8(pk(b.lo.z, b.lo.w), pk(a.lo.z, a.lo.w), c, 0, 0, 0);
        c = __builtin_amdgcn_mfma_f32_16x16x32_fp8_fp8(pk(b.hi.x, b.hi.y), pk(a.hi.x, a.hi.y), c, 0, 0, 0);
        return __builtin_amdgcn_mfma_f32_16x16x32_fp8_fp8(pk(b.hi.z, b.hi.w), pk(a.hi.z, a.hi.w), c, 0, 0, 0); }
};
template <> struct FragT<2> {
    i32x8 v;
    DI void load(const LAS char* p0, const LAS char* p1) { const i32x4 lo = *(const LAS i32x4*)p0, hi = *(const LAS i32x4*)p1; v = __builtin_shufflevector(lo, hi, 0, 1, 2, 3, 4, 5, 6, 7); }
    static DI f32x4 mma(const FragT& b, const FragT& a, f32x4 c) {
        const int one = 0x7f7f7f7f;
        asm volatile("v_mfma_scale_f32_16x16x128_f8f6f4 %0, %1, %2, %0, %3, %3 op_sel_hi:[0,0,0]" : "+v"(c) : "v"(b.v), "v"(a.v), "v"(one));
        return c; }
};
template <class PV>
DI void gemm_stream(LAS char* shm, const PV& pv, const int wv_) {
    typedef typename PV::AS AS; typedef typename PV::BS BS;
    constexpr int nt = PV::NT;
    int u = pv.first();
    if (u < 0) return;
    const int tz = otid();
    const int wr = wv_ >> 2, wc = wv_ & 3, lane = tz & 63, fr = lane & 15, fq = lane >> 4;
    const int aoff = lds_byte(wr * 64 + fr, fq * 8), boff = lds_byte(wc * 32 + fr, fq * 8);
    const unsigned ldsw = (unsigned)wv_ * 1024u;
    f32x4 acc[2][2][4][2]; zero_acc(acc);
    typedef FragT<PV::FP8> Frag;
    Frag At[4], B0[2], B1[2];
    AS ca, na; BS cb, nb;
    pv.src(u, ca, cb, wv_); pv.fix(ca, true, wv_);
    constexpr bool F8 = PV::FP8 != 0;
    LAS unsigned* park = (LAS unsigned*)(shm + 131072) + tz * 4;
    const int aoff0 = aoff, aoff1 = aoff + 1024;
    const int boff0 = boff, boff1 = boff + 1024;
#define SA_(b, h) (((b) * 2 + (h)) * HTB)
#define SB_(b, h) ((4 + (b) * 2 + (h)) * HTB)
#define STG_(bufoff, S, h, kt) do { _Pragma("unroll") for (int i_ = 0; i_ < 2; ++i_) glds16((S).ptr(tz, h, i_, kt), shm + (bufoff) + ldsw + i_ * 8192); } while (0)
#define LDA_(dst, b, h) do { _Pragma("unroll") for (int m = 0; m < 4; ++m) dst[m].load(shm + SA_(b, h) + aoff0 + m * 2048, shm + SA_(b, h) + aoff1 + m * 2048); } while (0)
#define LDB_(dst, b, h) do { _Pragma("unroll") for (int n = 0; n < 2; ++n) dst[n].load(shm + SB_(b, h) + boff0 + n * 2048, shm + SB_(b, h) + boff1 + n * 2048); } while (0)
#define MMA2_(ai, A_, BA_, BB_) do { __builtin_amdgcn_s_setprio(1); \
        _Pragma("unroll") for (int m = 0; m < 4; ++m) _Pragma("unroll") for (int n = 0; n < 2; ++n) acc[ai][0][m][n] = Frag::mma(BA_[n], A_[m], acc[ai][0][m][n]); \
        _Pragma("unroll") for (int m = 0; m < 4; ++m) _Pragma("unroll") for (int n = 0; n < 2; ++n) acc[ai][1][m][n] = Frag::mma(BB_[n], A_[m], acc[ai][1][m][n]); \
        __builtin_amdgcn_s_setprio(0); } while (0)
#define CMEM_ asm volatile("" ::: "memory")
    STG_(SB_(0, 0), cb, 0, 0); STG_(SB_(0, 1), cb, 1, 0); STG_(SA_(0, 0), ca, 0, 0); STG_(SA_(0, 1), ca, 1, 0);
    WAIT_V(0);
    if (wr == 1) BAR_;
    BAR_; CMEM_;
#define ZQ_(ai, bj) do { _Pragma("unroll") for (int m_ = 0; m_ < 4; ++m_) _Pragma("unroll") for (int n_ = 0; n_ < 2; ++n_) acc[ai][bj][m_][n_] = (f32x4){0.f, 0.f, 0.f, 0.f}; } while (0)
    int un = -1; bool has_next = false;
    na = ca; nb = cb;
    for (;;) {
        typename PV::Aux aux;
#pragma clang loop unroll(disable)
        for (int t = 0; t < nt; t += 2) {
            const bool last = (t == nt - 2);
            if (last && has_next) pv.fix(na, false, wv_);
            AS a2 = last ? na : ca; const BS b2 = last ? nb : cb; const int k2 = last ? 0 : t + 2;
            STG_(SB_(1, 0), cb, 0, t + 1); STG_(SB_(1, 1), cb, 1, t + 1); STG_(SA_(1, 0), ca, 0, t + 1); SCHED_;
            LDB_(B0, 0, 0); LDB_(B1, 0, 1); SCHED_; LDA_(At, 0, 0); SCHED_;
            if (t == 0) { ZQ_(0, 0); ZQ_(0, 1); }
            WAIT_V(6); BAR_; WAIT_L(0); MMA2_(0, At, B0, B1); BAR_; SCHED_; CMEM_;
            if (t == 0) pv.top(u, aux, wv_);
            STG_(SA_(1, 1), ca, 1, t + 1); SCHED_;
            LDA_(At, 0, 1); SCHED_;
            if (t == 0) { ZQ_(1, 0); ZQ_(1, 1); }
            WAIT_V(2); BAR_; WAIT_L(0); if (t == 0) pv.mid(aux, wv_); MMA2_(1, At, B0, B1); BAR_; SCHED_; CMEM_;
            STG_(SB_(0, 0), b2, 0, k2); STG_(SB_(0, 1), b2, 1, k2); STG_(SA_(0, 0), a2, 0, k2); SCHED_;
            LDB_(B0, 1, 0); LDB_(B1, 1, 1); SCHED_; LDA_(At, 1, 0); SCHED_;
            WAIT_V(6); BAR_; WAIT_L(0); MMA2_(0, At, B0, B1); BAR_; SCHED_; CMEM_;
            STG_(SA_(0, 1), a2, 1, k2); SCHED_;
            LDA_(At, 1, 1); SCHED_;
            WAIT_V(2);
            if (t == 0) { un = pv.next(u); has_next = un >= 0; if (has_next) pv.src(un, na, nb, wv_); else { na = ca; nb = cb; } }
            BAR_; WAIT_L(0); MMA2_(1, At, B0, B1); BAR_; SCHED_; CMEM_;
        }
        if (PV::FP8 == 2) asm volatile("s_nop 15\n\ts_nop 15" ::: "memory");
        pv.epi(acc, u, wv_);
        if (!has_next) break;
        u = un; ca = na; cb = nb;
    }
#undef ZQ_
    WAIT_V(0);
    if (wr == 0) BAR_;
    BAR_;
#undef SA_
#undef SB_
#undef STG_
#undef LDA_
#undef LDB_
#undef MMA2_
#undef CMEM_
}
DI int lin_first(int shift, int count) { const int G = gridDim.x; const int u = (int)((blockIdx.x + G - (shift % G)) % G); return u < count ? u : -1; }
DI int lin_next(int u, int count) { const int un = u + (int)gridDim.x; return un < count ? un : -1; }
template <int MG, int NTL> struct XcdDeal {
    int MT;
    DI bool decode(int J, int& mt, int& nt) const { const int x = blockIdx.x & 7; const int grp = (J / (MG * NTL)) * 8 + x, w = J % (MG * NTL); mt = grp * MG + w / NTL; nt = w % NTL; return mt < MT; }
    DI int jmax() const { return ((MT + 8 * MG - 1) / (8 * MG)) * (MG * NTL); }
    DI int first() const { int J = blockIdx.x >> 3; const int per = gridDim.x >> 3, jm = jmax(); int mt, nt;
        while (J < jm && !decode(J, mt, nt)) J += per;
        return J < jm ? J : -1; }
    DI int next(int J) const { const int per = gridDim.x >> 3, jm = jmax(); int mt, nt; J += per;
        while (J < jm && !decode(J, mt, nt)) J += per;
        return J < jm ? J : -1; }
};
DI int first_unit(int shift) { const int G = gridDim.x; return (int)((blockIdx.x + G - (shift % G)) % G); }

DI void stage_coords(int (&R)[2], int (&C)[2], const int wv_) {
    const int t_ = otid();
#pragma unroll
    for (int i = 0; i < 2; ++i) stage_rc(t_ * 16 + i * 8192, R[i], C[i]);
}
DI APlain make_a_plain(const bf16_t* A, size_t row0, int lda, int col0) {
    APlain a; a.base = (const char*)(A + row0 * (size_t)lda + col0); a.lda2 = lda * 2; return a;
}
DI BSimple make_b(const bf16_t* Bt0, const bf16_t* Bt1, int ldb) {
    BSimple b; b.base[0] = (const char*)Bt0; b.base[1] = (const char*)Bt1; b.ldb2 = ldb * 2; return b;
}
#define EPI_FOR(acc, ...) do { const int _tz = otid(), _w = _tz >> 6, _l = _tz & 63, _wr = _w >> 2, _wc = _w & 3, _fr = _l & 15, _fq = _l >> 4; \
    _Pragma("unroll") for (int ai = 0; ai < 2; ++ai) _Pragma("unroll") for (int m = 0; m < 4; ++m) { const int lr = ai * 128 + _wr * 64 + m * 16 + _fr; \
    _Pragma("unroll") for (int bj = 0; bj < 2; ++bj) _Pragma("unroll") for (int n = 0; n < 2; ++n) { const int lc = bj * 128 + _wc * 32 + n * 16 + _fq * 4; const f32x4 v = acc[ai][bj][m][n]; __VA_ARGS__ } } } while (0)

DI void store_bf16x4(bf16_t* p, float a, float b, float c, float d) { u32x2 v; v.x = pk_bf16(a, b); v.y = pk_bf16(c, d); *(u32x2*)p = v; }
DI void store_bf16x8(bf16_t* p, const f32x4 a, const f32x4 b) { u32x4 v; v.x = pk_bf16(a[0], a[1]); v.y = pk_bf16(a[2], a[3]); v.z = pk_bf16(b[0], b[1]); v.w = pk_bf16(b[2], b[3]); *(u32x4*)p = v; }
#define EPI_FOR8(acc, ...) do { const int _tz = otid(), _w = _tz >> 6, _l = _tz & 63, _wr = _w >> 2, _wc = _w & 3, _fr = _l & 15, _fq = _l >> 4; \
    _Pragma("unroll") for (int ai = 0; ai < 2; ++ai) _Pragma("unroll") for (int m = 0; m < 4; ++m) { const int lr = ai * 128 + _wr * 64 + m * 16 + _fr; \
    _Pragma("unroll") for (int bj = 0; bj < 2; ++bj) { const int lc = bj * 128 + _wc * 32 + _fq * 8; const f32x4 v0 = acc[ai][bj][m][0], v1 = acc[ai][bj][m][1]; __VA_ARGS__ } } } while (0)

DI int mod_row(int r) { return r < TX ? (r >> 11) : 32; }
DI int crow_tok(int cr) { const int b = cr / NCH, j = cr - b * NCH; return j < 4 ? TX + b * CTXL + j * 64 : b * SEQ + (j - 4) * 64; }

DI void cvt_tile(LAS char* wl  , const float* src, int ld_src, int kvalid, int nvalid, const float* scale, bf16_t* dst, int ld_dst, const int wv_) {
    const int lane = otid() & 63;
    const int lr = lane >> 4, lc = (lane & 15) * 4;
    f32x4 v[16];
#pragma unroll
    for (int it = 0; it < 16; ++it) {
        const int k = it * 4 + lr;
        v[it] = (f32x4){0.f, 0.f, 0.f, 0.f};
        if (src != nullptr && k < kvalid && lc < nvalid) { v[it] = *(const f32x4*)(src + (size_t)k * ld_src + lc); if (scale) { const float s = scale[k]; v[it] *= s; } }
    }
#pragma unroll
    for (int it = 0; it < 16; ++it) {
        const int k = it * 4 + lr;
#pragma unroll
        for (int j = 0; j < 4; ++j) *(LAS bf16_t*)(wl + (lc + j) * 144 + k * 2) = f2bf(v[it][j]);
    }
    asm volatile("s_waitcnt lgkmcnt(0)" ::: "memory");
#pragma unroll
    for (int i = 0; i < 8; ++i) {
        const int q = i * 64 + lane, n = q >> 3, c = q & 7;
        const u32x4 w = *(const LAS u32x4*)(wl + n * 144 + c * 16);
        *(u32x4*)(dst + (size_t)n * ld_dst + c * 8) = w;
    }
    asm volatile("s_waitcnt lgkmcnt(0)" ::: "memory");
}
constexpr float SWI_A = 2.4554669595930156f;
DI void cvt_tile8(LAS char* wl  , const float* src, int ld_src, unsigned char* dst, int ld_dst, const float wscale, const int wv_) {
    const int lane = otid() & 63;
    const int lr = lane >> 4, lc = (lane & 15) * 4;
    f32x4 v[16];
#pragma unroll
    for (int it = 0; it < 16; ++it) v[it] = *(const f32x4*)(src + (size_t)(it * 4 + lr) * ld_src + lc);
#pragma unroll
    for (int it = 0; it < 16; ++it) {
        const int k = it * 4 + lr;
#pragma unroll
        for (int j = 0; j < 4; ++j) *(LAS unsigned char*)(wl + (lc + j) * 80 + k) = (unsigned char)f2fp8(v[it][j] * wscale);
    }
    asm volatile("s_waitcnt lgkmcnt(0)" ::: "memory");
#pragma unroll
    for (int i = 0; i < 4; ++i) {
        const int q = i * 64 + lane, n = q >> 2, c = q & 3;
        const u32x4 w = *(const LAS u32x4*)(wl + n * 80 + c * 16);
        *(u32x4*)(dst + (size_t)n * ld_dst + c * 16) = w;
    }
    asm volatile("s_waitcnt lgkmcnt(0)" ::: "memory");
}
constexpr int CVT_SMALL_TILES = 768 + 512 + 32 + 32 + 64 + 64 + 32;
constexpr int CVT_EXP_TILES = 32 * (32 * 16 + 16 * 16);
DI void cvt_small(const Params& p, LAS char* wl, int t, const int wv_) {
    char* ws = p.ws;
    if (t < 768) { const int l = t / 384, r = t % 384, nt = r / 16, kt = r % 16;
        cvt_tile(wl, p.w_mix_in + (size_t)l * 1024 * N_IN + (size_t)kt * 64 * N_IN + nt * 64, N_IN, 64, N_IN - nt * 64, nullptr,
                 (bf16_t*)(ws + WS_WMI) + ((size_t)l * 1536 + nt * 64) * 1024 + kt * 64, 1024, wv_); return; }
    t -= 768;
    if (t < 512) { const int l = t / 256, r = t % 256, nt = r / 16, kt = r % 16;
        cvt_tile(wl, p.w_mix_out + (size_t)l * 1024 * 1024 + (size_t)kt * 64 * 1024 + nt * 64, 1024, 64, 64, nullptr,
                 (bf16_t*)(ws + WS_WMO) + ((size_t)l * 1024 + nt * 64) * 1024 + kt * 64, 1024, wv_); return; }
    t -= 512;
    if (t < 32) { const int l = t / 16, r = t % 16, nt = r / 4, kt = r % 4;
        cvt_tile(wl, p.conv_pw + (size_t)l * 65536 + (size_t)kt * 64 * 256 + nt * 64, 256, 64, 64, nullptr,
                 (bf16_t*)(ws + WS_WPW) + ((size_t)l * 256 + nt * 64) * 256 + kt * 64, 256, wv_); return; }
    t -= 32;
    if (t < 32) { const int l = t / 16, r = t % 16, nt = r / 4, kt = r % 4;
        cvt_tile(wl, p.ssm_glu_w + (size_t)l * 65536 + (size_t)kt * 64 * 256 + nt * 64, 256, 64, 64, nullptr,
                 (bf16_t*)(ws + WS_WGLU) + ((size_t)l * 256 + nt * 64) * 256 + kt * 64, 256, wv_); return; }
    t -= 32;
    if (t < 64) { const int l = t / 32, r = t % 32, nt = r / 4, kt = r % 4;
        const bool any = (kt < 3) && (nt < 6);
        cvt_tile(wl, any ? p.mla_wq_b + (size_t)l * 192 * 384 + (size_t)kt * 64 * 384 + nt * 64 : nullptr, 384, 64, 64, p.mla_q_a_g + l * 192 + kt * 64,
                 (bf16_t*)(ws + WS_WQ) + ((size_t)l * 512 + nt * 64) * 256 + kt * 64, 256, wv_); return; }
    t -= 64;
    if (t < 64) { const int l = t / 32, r = t % 32, nt = r / 4, kt = r % 4;
        const bool any = (kt < 2);
        cvt_tile(wl, any ? p.mla_wkv_b + (size_t)l * 128 * 512 + (size_t)kt * 64 * 512 + nt * 64 : nullptr, 512, 64, 64, p.mla_kv_a_g + l * 128 + kt * 64,
                 (bf16_t*)(ws + WS_WKV) + ((size_t)l * 512 + nt * 64) * 256 + kt * 64, 256, wv_); return; }
    t -= 64;
    { const int l = t / 16, r = t % 16, nt = r / 4, kt = r % 4;
        cvt_tile(wl, nt == kt ? p.pool_w + ((size_t)l * 4 + nt) * 4096 : nullptr, 64, 64, 64, nullptr,
                 (bf16_t*)(ws + WS_WPOOL) + ((size_t)l * 256 + nt * 64) * 256 + kt * 64, 256, wv_); }
}
DI void cvt_expert(const Params& p, LAS char* wl, int l, int t, const int wv_) {
    char* ws = p.ws;
    const int e = t / 768, r = t % 768;
    if (r < 512) { const int nt = r / 16, kt = r % 16;
        cvt_tile8(wl, p.exp_w_in + ((size_t)(l * NE + e) * 1024 + kt * 64) * 2048 + nt * 64, 2048,
                  (unsigned char*)(ws + WS_W1) + ((size_t)(l * NE + e) * 2048 + nt * 64) * 1024 + kt * 64, 1024, nt < 16 ? 256.f * SWI_A : 256.f / SWI_A, wv_);
    } else { const int q = r - 512, nt = q / 16, kt = q % 16;
        cvt_tile8(wl, p.exp_w_out + ((size_t)(l * NE + e) * 1024 + kt * 64) * 1024 + nt * 64, 1024,
                  (unsigned char*)(ws + WS_W2) + ((size_t)(l * NE + e) * 1024 + nt * 64) * 1024 + kt * 64, 1024, 256.f, wv_);
    }
}

DI void ada_unit(const Params& p, LAS char* shm, int u, const int wv_) {
    const int tid = otid();
    const int l = u / 48, jc = u % 48;
    LAS float* sc = (LAS float*)shm;
    for (int i = tid; i < 33 * 1024; i += 512) { const int r = i >> 10, k = i & 1023; const float v = r < 32 ? p.c[r * 1024 + k] : p.c_ctx[k]; sc[i] = siluf_(v); }
    __syncthreads();
    const int col = tid & 127, kq = tid >> 7;
    float acc[33];
#pragma unroll
    for (int r = 0; r < 33; ++r) acc[r] = 0.f;
    const float* wp = p.ada_w + ((size_t)l * 1024 + kq * 256) * 6144 + jc * 128 + col;
    for (int k4 = 0; k4 < 256; k4 += 4) {
        float w[4];
#pragma unroll
        for (int i = 0; i < 4; ++i) w[i] = wp[(size_t)(k4 + i) * 6144];
#pragma unroll
        for (int r = 0; r < 33; ++r) { const f32x4 s = *(const LAS f32x4*)(sc + r * 1024 + kq * 256 + k4); acc[r] += s[0] * w[0] + s[1] * w[1] + s[2] * w[2] + s[3] * w[3]; }
    }
    __syncthreads();
    LAS float* red = (LAS float*)shm;
#pragma unroll
    for (int r = 0; r < 33; ++r) red[(kq * 33 + r) * 128 + col] = acc[r];
    __syncthreads();
    for (int i = tid; i < 33 * 128; i += 512) { const int r = i >> 7, cc = i & 127;
        const float s = red[(0 * 33 + r) * 128 + cc] + red[(1 * 33 + r) * 128 + cc] + red[(2 * 33 + r) * 128 + cc] + red[(3 * 33 + r) * 128 + cc];
        ((float*)(p.ws + WS_MOD))[((size_t)l * 33 + r) * 6144 + jc * 128 + cc] = s + p.ada_b[l * 6144 + jc * 128 + cc]; }
    __syncthreads();
}

DI void s5_load_bc(const Params& p, LAS float* bb, LAS float* cc, int l, int dir, int g, int tid) {
    const int pbase = ((l * 2 + dir) * 16 + g) * 64;
    const double dt = exp((double)p.ssm_log_dt[(l * 2 + dir) * 16 + g]);
    for (int i = tid; i < 64 * 16; i += 512) { const int q = i >> 4, ci = i & 15;
        const double are = fmin((double)p.ssm_a_re[pbase + q], -1e-4), aim = (double)p.ssm_a_im[pbase + q];
        const double mg = exp(are * dt), abr = mg * cos(aim * dt), abi = mg * sin(aim * dt), den = are * are + aim * aim;
        const double fre = ((abr - 1.0) * are + abi * aim) / den, fim = (abi * are - (abr - 1.0) * aim) / den;
        const double br = (double)p.ssm_b_re[(size_t)(pbase + q) * 16 + ci], bi = (double)p.ssm_b_im[(size_t)(pbase + q) * 16 + ci];
        bb[i * 2] = (float)(fre * br - fim * bi); bb[i * 2 + 1] = (float)(fre * bi + fim * br); }
    for (int i = tid; i < 16 * 64; i += 512) { const int co = i >> 6, q = i & 63;
        const size_t ix = ((size_t)((l * 2 + dir) * 16 + g) * 16 + co) * 64 + q;
        cc[i * 2] = p.ssm_c_re[ix]; cc[i * 2 + 1] = p.ssm_c_im[ix]; }
}
DI void s5pre_unit(const Params& p, LAS char* shm, int u, const int wv_) {
    const int tid = otid();
    const int l = u >> 5, g = (u >> 1) & 15, dir = u & 1;
    LAS float* pw = (LAS float*)shm;
    LAS float* bb = pw + 65 * 64 * 2;
    LAS float* cc = bb + 64 * 16 * 2;
    LAS float* kk = cc + 16 * 64 * 2;
    LAS float* k0o = kk + 64 * 256;
    bf16_t* TS = (bf16_t*)(p.ws + WS_TS5) + (size_t)(l * 16 + g) * 1024 * 1280;
    bf16_t* WS = (bf16_t*)(p.ws + WS_WS5) + (size_t)(l * 16 + g) * 256 * 1024;
    const int cocip = tid & 255, co_ = cocip >> 4, ci_ = cocip & 15;
    if (dir == 0) {
        s5_load_bc(p, bb, cc, l, 1, g, tid);
        __syncthreads();
        if (tid < 256) { float s_ = 0.f;
            for (int q = 0; q < 64; ++q) s_ += cc[(co_ * 64 + q) * 2] * bb[(q * 16 + ci_) * 2] - cc[(co_ * 64 + q) * 2 + 1] * bb[(q * 16 + ci_) * 2 + 1];
            k0o[tid] = s_; }
        __syncthreads();
    }
    {
        const int pbase = ((l * 2 + dir) * 16 + g) * 64;
        const double dt = exp((double)p.ssm_log_dt[(l * 2 + dir) * 16 + g]);
        for (int i = tid; i < 65 * 64; i += 512) { const int tau = i >> 6, q = i & 63;
            const double are = fmin((double)p.ssm_a_re[pbase + q], -1e-4), aim = (double)p.ssm_a_im[pbase + q];
            const double mg = exp(are * dt * tau), an = aim * dt * tau;
            pw[i * 2] = (float)(mg * cos(an)); pw[i * 2 + 1] = (float)(mg * sin(an)); }
        s5_load_bc(p, bb, cc, l, dir, g, tid);
        __syncthreads();
        if (tid < 64) { float* a64 = (float*)(p.ws + WS_A64) + (size_t)(((l * 2 + dir) * 16 + g) * 64 + tid) * 2; a64[0] = pw[(64 * 64 + tid) * 2]; a64[1] = pw[(64 * 64 + tid) * 2 + 1]; }
        { float gr[64], gi[64];
#pragma unroll
          for (int q = 0; q < 64; ++q) { const float cr = cc[(co_ * 64 + q) * 2], cim = cc[(co_ * 64 + q) * 2 + 1], br = bb[(q * 16 + ci_) * 2], bi = bb[(q * 16 + ci_) * 2 + 1];
              gr[q] = cr * br - cim * bi; gi[q] = cr * bi + cim * br; }
          for (int tau = (tid >> 8); tau < 64; tau += 2) {
              float s_ = 0.f;
#pragma unroll
              for (int q = 0; q < 64; ++q) s_ += gr[q] * pw[(tau * 64 + q) * 2] - gi[q] * pw[(tau * 64 + q) * 2 + 1];
              kk[tau * 256 + cocip] = s_;
          } }
        for (int i = tid; i < 128 * 512; i += 512) { const int row = i >> 9, kp = (i & 511) * 2, ri = row >> 6, q = row & 63, s_ = kp >> 4, ci = kp & 15;
            const int e = dir == 0 ? 63 - s_ : s_;
            const float pr = pw[(e * 64 + q) * 2], pi = pw[(e * 64 + q) * 2 + 1];
            float o[2];
#pragma unroll
            for (int j = 0; j < 2; ++j) { const float br = bb[(q * 16 + ci + j) * 2], bi = bb[(q * 16 + ci + j) * 2 + 1]; o[j] = ri == 0 ? pr * br - pi * bi : pr * bi + pi * br; }
            *(unsigned*)(WS + (size_t)(dir * 128 + row) * 1024 + kp) = pk_bf16(o[0], o[1]); }
        for (int i = tid; i < 1024 * 64; i += 512) { const int row = i >> 6, kp = (i & 63) * 2, t = row >> 4, co = row & 15, ri = kp >> 6, q = kp & 63;
            const int e = dir == 0 ? t + 1 : 64 - t;
            float o[2];
#pragma unroll
            for (int j = 0; j < 2; ++j) { const float pr = pw[(e * 64 + q + j) * 2], pi = pw[(e * 64 + q + j) * 2 + 1];
                const float cr = cc[(co * 64 + q + j) * 2], cim = cc[(co * 64 + q + j) * 2 + 1];
                o[j] = ri == 0 ? (cr * pr - cim * pi) : -(cr * pi + cim * pr); }
            *(unsigned*)(TS + (size_t)row * 1280 + 1024 + dir * 128 + kp) = pk_bf16(o[0], o[1]); }
        __syncthreads();
        for (int rr = tid; rr < 1024; rr += 512) { const int t = rr >> 4, co = rr & 15;
            const float dco = p.ssm_d[l * 256 + g * 16 + co];
            bf16_t* rowp = TS + (size_t)rr * 1280;
            const int s_lo = dir == 0 ? 0 : t + 1, s_hi = dir == 0 ? t : 63;
            for (int s_ = s_lo; s_ <= s_hi; ++s_) { const int tau = dir == 0 ? t - s_ : s_ - t;
                unsigned w[8];
#pragma unroll
                for (int j = 0; j < 8; ++j) { float a = kk[tau * 256 + co * 16 + 2 * j], b2 = kk[tau * 256 + co * 16 + 2 * j + 1];
                    if (s_ == t) { a += k0o[co * 16 + 2 * j]; b2 += k0o[co * 16 + 2 * j + 1]; if (2 * j == co) a += dco; if (2 * j + 1 == co) b2 += dco; }
                    w[j] = pk_bf16(a, b2); }
                *(u32x4*)(rowp + s_ * 16) = (u32x4){w[0], w[1], w[2], w[3]}; *(u32x4*)(rowp + s_ * 16 + 8) = (u32x4){w[4], w[5], w[6], w[7]}; }
        }
        __syncthreads();
    }
}

DI void phase_prologue(const Params& p, LAS char* shm, const int wv_) {
    const int tid = otid();
    __syncthreads();
    if (blockIdx.x == 0 && tid < 64) ((int*)(p.ws + WS_CNT))[tid] = 0;
    const int n_cvt = (CVT_SMALL_TILES + 2 * CVT_EXP_TILES + 7) / 8;
    for (int u = blockIdx.x; u < 160; u += gridDim.x) {
        if (u < 64) s5pre_unit(p, shm, u, wv_);
        else ada_unit(p, shm, u - 64, wv_);
    }
    int* wq = (int*)(p.ws + WS_CNT) + 192;
    volatile LAS int* slot = (volatile LAS int*)(shm + LDS_MISC + 32);
    __syncthreads();
    if (tid == 0) slot[0] = atomicAdd(wq, 1);
    __syncthreads();
    int cu = slot[0], par = 0;
    while (cu < n_cvt) {
        int nxt = 0;
        if (tid == 0) nxt = atomicAdd(wq, 1);
        const int t = cu * 8 + wv_;
        LAS char* wl = shm + wv_ * (64 * 144);
        if (t < CVT_SMALL_TILES) cvt_small(p, wl, t, wv_);
        else if (t < CVT_SMALL_TILES + 2 * CVT_EXP_TILES) { const int te = t - CVT_SMALL_TILES; cvt_expert(p, wl, te / CVT_EXP_TILES, te % CVT_EXP_TILES, wv_); }
        par ^= 1;
        if (tid == 0) slot[par] = nxt;
        __syncthreads();
        cu = slot[par];
    }
}

DI void norm_mod_store(const float (&v)[16], const float* g, const float* modrow  , bf16_t* hrow, const int wv_) {
    const int lane = otid() & 63;
    float ss = 0.f;
#pragma unroll
    for (int i = 0; i < 16; ++i) ss += v[i] * v[i];
    ss = wave_sum(ss);
    const float rn = rsqrtf(ss * (1.f / 1024.f) + EPS);
#pragma unroll
    for (int j = 0; j < 4; ++j) {
        const int col = j * 256 + lane * 4;
        const f32x4 gg = *(const f32x4*)(g + col), sh = *(const f32x4*)(modrow + col), sc = *(const f32x4*)(modrow + 1024 + col);
        float o[4];
#pragma unroll
        for (int i = 0; i < 4; ++i) o[i] = v[j * 4 + i] * rn * gg[i] * (1.f + sc[i]) + sh[i];
        store_bf16x4(hrow + col, o[0], o[1], o[2], o[3]);
    }
}
DI void phase_norm1_l0(const Params& p, const int wv_) {
    const int tid_ = otid(); const int wid = tid_ >> 6, lane = tid_ & 63;
    const float* MOD = (const float*)(p.ws + WS_MOD);
    bf16_t* H = (bf16_t*)(p.ws + WS_H);
    for (int r = blockIdx.x * 8 + wid; r < TT; r += gridDim.x * 8) {
        const float* src = r < TX ? p.x + (size_t)r * 1024 : p.ctx + (size_t)(r - TX) * 1024;
        float v[16];
#pragma unroll
        for (int j = 0; j < 4; ++j) { const f32x4 t = *(const f32x4*)(src + j * 256 + lane * 4); v[j * 4] = t[0]; v[j * 4 + 1] = t[1]; v[j * 4 + 2] = t[2]; v[j * 4 + 3] = t[3]; }
        norm_mod_store(v, p.norm1_g, MOD + (size_t)(0 * 33 + mod_row(r)) * 6144, H + (size_t)r * 1024, wv_);
    }
}

struct PvInproj {
    const Params& p; int l;
    PV_NOHOOKS
    static constexpr int NT = 16; static constexpr int FP8 = 0; static constexpr bool PARK = false; typedef APlain AS; typedef BSimple BS;
    XcdDeal<4, 6> deal;
    DI int first() const { return deal.first(); }
    DI int next(int u) const { return deal.next(u); }
    DI void src(int u, AS& a, BS& b, const int wv_) const {
        int mt, nt; deal.decode(u, mt, nt);
        const bf16_t* W = (const bf16_t*)(p.ws + WS_WMI) + (size_t)l * 1536 * 1024;
        a = make_a_plain((const bf16_t*)(p.ws + WS_H), (size_t)mt * 256, 1024, 0);
        b = nt < 2 ? make_b(W + (size_t)(nt * 128) * 1024, W + (size_t)(256 + nt * 128) * 1024, 1024)
                   : make_b(W + (size_t)(nt * 256) * 1024, W + (size_t)(nt * 256 + 128) * 1024, 1024);
    }
    DI void epi(f32x4 (&acc)[2][2][4][2], int u, const int wv_) const {
        int mt, nt; deal.decode(u, mt, nt);
        bf16_t* P = (bf16_t*)(p.ws + WS_P);
        if (nt < 2) {
            const int _tz = otid(), _w = _tz >> 6, _l = _tz & 63, _wr = _w >> 2, _wc = _w & 3, _fr = _l & 15, _fq = _l >> 4;
#pragma unroll
            for (int ai = 0; ai < 2; ++ai)
#pragma unroll
                for (int m = 0; m < 4; ++m) { const int lr = ai * 128 + _wr * 64 + m * 16 + _fr; const int lc = _wc * 32 + _fq * 8;
                    f32x4 o0, o1;
#pragma unroll
                    for (int r = 0; r < 4; ++r) { o0[r] = acc[ai][0][m][0][r] * sigmoidf_(acc[ai][1][m][0][r]); o1[r] = acc[ai][0][m][1][r] * sigmoidf_(acc[ai][1][m][1][r]); }
                    store_bf16x8(P + (size_t)(mt * 256 + lr) * NINP + nt * 128 + lc, o0, o1); }
        } else {
            EPI_FOR8(acc, { store_bf16x8(P + (size_t)(mt * 256 + lr) * NINP + nt * 256 + lc, v0, v1); });
        }
    }
};
DI void phase_inproj(const Params& p, LAS char* shm, int l, const int wv_) {
    PvInproj pv{p, l, {TT / 256}};
    gemm_stream(shm, pv, wv_);
}

template <int N> DI void wave_sum_n(float (&v)[N]) {
    const int l4 = olane();
#pragma unroll
    for (int o = 32; o > 0; o >>= 1) {
        float t_[N];
#pragma unroll
        for (int i = 0; i < N; ++i) t_[i] = __int_as_float(__builtin_amdgcn_ds_bpermute((l4 ^ o) << 2, __float_as_int(v[i])));
#pragma unroll
        for (int i = 0; i < N; ++i) v[i] += t_[i];
    }
}
template <int WIN, bool EDGE>
DI void pool_run(const LAS bf16_t* pin  , bf16_t* AP, int row0, int ts0, int L, int c, int half) {
    for (int blk = 0; blk < 2; ++blk) {
        const int t0 = half * 32 + blk * 16;
        float in[16 + WIN - 1];
#pragma unroll
        for (int i = 0; i < 16 + WIN - 1; ++i) in[i] = bf2f(pin[(t0 + i - WIN / 2 + 8) * 256 + c]);
        float sum = 0.f;
#pragma unroll
        for (int j = 0; j < WIN; ++j) sum += in[j];
#pragma unroll
        for (int o = 0; o < 16; ++o) {
            float inv = 1.f / (float)WIN;
            if (EDGE) { const int ts = ts0 + t0 + o; const int lo = max(ts - WIN / 2, 0), hi = min(ts + WIN - 1 - WIN / 2, L - 1); inv = 1.f / (float)(hi - lo + 1); }
            AP[(size_t)(row0 + t0 + o) * 256 + c] = f2bf(sum * inv - in[o + WIN / 2]);
            if (o < 15) sum += in[o + WIN] - in[o];
        }
    }
}
template <bool EDGE>
DI void pre_unit_t(const Params& p, LAS char* shm, int l, int row0, int ts0, int L, const float (&w)[31], const float bias, const int wv_) {
    const int tid = otid();
    const bf16_t* P = (const bf16_t*)(p.ws + WS_P);
    const int c = tid & 255, half = tid >> 8;
    LAS bf16_t* cin = (LAS bf16_t*)shm;
    LAS float* cv = (LAS float*)(shm + 49152);
    u32x4 creg[6], preg[5];
#pragma unroll
    for (int it = 0; it < 6; ++it) { const int q = it * 512 + tid, row = q >> 5, part = q & 31; const int ts = ts0 - 15 + row;
        creg[it] = (u32x4){0u, 0u, 0u, 0u};
        if (q < 94 * 32 && (!EDGE || (ts >= 0 && ts < L))) creg[it] = *(const u32x4*)(P + (size_t)(row0 - 15 + row) * NINP + part * 8); }
#pragma unroll
    for (int it = 0; it < 5; ++it) { const int q = it * 512 + tid, row = q >> 5, part = q & 31; const int ts = ts0 - 8 + row;
        preg[it] = (u32x4){0u, 0u, 0u, 0u};
        if (!EDGE || (ts >= 0 && ts < L)) preg[it] = *(const u32x4*)(P + (size_t)(row0 - 8 + row) * NINP + OFF_POOL + part * 8); }
#pragma unroll
    for (int it = 0; it < 6; ++it) { const int q = it * 512 + tid; if (q < 94 * 32) *(LAS u32x4*)(cin + q * 8) = creg[it]; }
    __syncthreads();
    {
        const int t0 = half * 32;
        float in[62];
#pragma unroll
        for (int i = 0; i < 62; ++i) in[i] = bf2f(cin[(t0 + i) * 256 + c]);
#pragma unroll
        for (int o = 0; o < 32; ++o) { float s_ = bias;
#pragma unroll
            for (int j = 0; j < 31; ++j) s_ += w[j] * in[o + j];
            cv[(t0 + o) * 257 + c] = s_; }
    }
    __syncthreads();
#pragma unroll
    for (int it = 0; it < 5; ++it) *(LAS u32x4*)(cin + (it * 512 + tid) * 8) = preg[it];
    {
        const int wid = tid >> 6, lane = tid & 63;
        bf16_t* AC = (bf16_t*)(p.ws + WS_ACONV);
        float lg[4], lb[4];
#pragma unroll
        for (int j = 0; j < 4; ++j) { lg[j] = p.conv_ln_g[l * 256 + lane + 64 * j]; lb[j] = p.conv_ln_b[l * 256 + lane + 64 * j]; }
        float x[8][4], s8[8];
#pragma unroll
        for (int i = 0; i < 8; ++i) { s8[i] = 0.f;
#pragma unroll
            for (int j = 0; j < 4; ++j) { x[i][j] = cv[(wid * 8 + i) * 257 + lane + 64 * j]; s8[i] += x[i][j]; } }
        wave_sum_n<8>(s8);
#pragma unroll
        for (int i = 0; i < 8; ++i) { const float mu = s8[i] * (1.f / 256.f); s8[i] = 0.f;
#pragma unroll
            for (int j = 0; j < 4; ++j) { x[i][j] -= mu; s8[i] += x[i][j] * x[i][j]; } }
        wave_sum_n<8>(s8);
#pragma unroll
        for (int i = 0; i < 8; ++i) { const float rs = rsqrtf(s8[i] * (1.f / 256.f) + EPS);
#pragma unroll
            for (int j = 0; j < 4; ++j) { const float y = x[i][j] * rs * lg[j] + lb[j]; AC[(size_t)(row0 + wid * 8 + i) * 256 + lane + 64 * j] = f2bf(siluf_(y)); } }
    }
    __syncthreads();
    {
        bf16_t* AP = (bf16_t*)(p.ws + WS_APOOL);
        const int g = __builtin_amdgcn_readfirstlane(c >> 6);
        if (g == 0) pool_run<2, EDGE>(cin, AP, row0, ts0, L, c, half);
        else if (g == 1) pool_run<4, EDGE>(cin, AP, row0, ts0, L, c, half);
        else if (g == 2) pool_run<8, EDGE>(cin, AP, row0, ts0, L, c, half);
        else pool_run<16, EDGE>(cin, AP, row0, ts0, L, c, half);
    }
    __syncthreads();
}
DI void pre_unit(const Params& p, LAS char* shm, int l, int tile, const float (&w)[31], const float bias, const int wv_) {
    int row0, ts0, L;
    if (tile < 1024) { row0 = tile * 64; ts0 = row0 & 2047; L = SEQ; } else { row0 = TX + (tile - 1024) * 64; ts0 = (row0 - TX) & 255; L = CTXL; }
    if (ts0 >= 16 && ts0 + 64 + 16 <= L) pre_unit_t<false>(p, shm, l, row0, ts0, L, w, bias, wv_);
    else pre_unit_t<true>(p, shm, l, row0, ts0, L, w, bias, wv_);
}
struct PvS5State {
    const Params& p; int l;
    PV_NOHOOKS
    static constexpr int NT = 16; static constexpr int FP8 = 0; static constexpr bool PARK = false; typedef ASimple AS; typedef BSimple BS;
    DI int first() const { return lin_first(0, 80); }
    DI int next(int u) const { return lin_next(u, 80); }
    DI void src(int u, AS& as, BS& bs, const int wv_) const {
        const int g = u / 5, mt = u % 5;
        int R[2], C[2]; stage_coords(R, C, wv_);
        as.base = (const char*)(p.ws + WS_P); as.kstride = 4 * NINP * 2;
#pragma unroll
        for (int h = 0; h < 2; ++h)
#pragma unroll
            for (int i = 0; i < 2; ++i) { const int cr = min(mt * 256 + h * 128 + R[i], NCROW - 1);
                as.off[h][i] = (unsigned)(((size_t)(crow_tok(cr) + (C[i] >> 4)) * NINP + OFF_SSM + g * 16 + (C[i] & 15)) * 2); }
        const bf16_t* W = (const bf16_t*)(p.ws + WS_WS5) + (size_t)(l * 16 + g) * 256 * 1024;
        bs = make_b(W, W + (size_t)128 * 1024, 1024);
    }
    DI void epi(f32x4 (&acc)[2][2][4][2], int u, const int wv_) const {
        const int g = u / 5, mt = u % 5;
        float* SST = (float*)(p.ws + WS_SST);
        EPI_FOR8(acc, { const int cr = mt * 256 + lr; if (cr < NCROW) { float* o_ = SST + ((size_t)cr * 16 + g) * 256 + lc; *(f32x4*)o_ = v0; *(f32x4*)(o_ + 4) = v1; } });
    }
};
struct PvQKV {
    const Params& p; int l;
    PV_NOHOOKS
    static constexpr int NT = 4; static constexpr int FP8 = 0; static constexpr bool PARK = false; typedef APlain AS; typedef BSimple BS;
    DI int first() const { return lin_first(80, 1152); }
    DI int next(int u) const { return lin_next(u, 1152); }
    DI void src(int u, AS& a, BS& b, const int wv_) const {
        const bool isq = u < 576; const int w_ = isq ? u : u - 576; const int mt = w_ >> 1, nt = w_ & 1;
        a = make_a_plain((const bf16_t*)(p.ws + WS_P), (size_t)mt * 256, NINP, isq ? OFF_Q : OFF_KV);
        const bf16_t* W = (const bf16_t*)(p.ws + (isq ? WS_WQ : WS_WKV)) + (size_t)l * 512 * 256 + (size_t)nt * 256 * 256;
        b = make_b(W, W + (size_t)128 * 256, 256);
    }
    DI void epi(f32x4 (&acc)[2][2][4][2], int u, const int wv_) const {
        const bool isq = u < 576; const int w_ = isq ? u : u - 576; const int mt = w_ >> 1, nt = w_ & 1;
        bf16_t* RAW = (bf16_t*)(p.ws + (isq ? WS_RAWQ : WS_RAWKV));
        EPI_FOR8(acc, { store_bf16x8(RAW + (size_t)(mt * 256 + lr) * 512 + nt * 256 + lc, v0, v1); });
    }
};
DI void phase_A(const Params& p, LAS char* shm, int l, const int wv_) {
    { PvS5State pv{p, l}; gemm_stream(shm, pv, wv_); }
    { PvQKV pv{p, l}; gemm_stream(shm, pv, wv_); }
    { const int c_ = otid() & 255;
      float w[31];
#pragma unroll
      for (int j = 0; j < 31; ++j) w[j] = p.conv_dw[((size_t)l * 31 + j) * 256 + c_];
      const float bias = p.conv_dw_b[l * 256 + c_];
      for (int u = first_unit(80 + 1152); u < 1152; u += gridDim.x) pre_unit(p, shm, l, u, w, bias, wv_); }
}

DI void qkvpost_unit(const Params& p, LAS char* shm, int l, int unit, const int wv_) {
    const int tid = otid(), wid = tid >> 6, lane = tid & 63;
    const bf16_t* P = (const bf16_t*)(p.ws + WS_P);
    const bf16_t* RAWQ = (const bf16_t*)(p.ws + WS_RAWQ);
    const bf16_t* RAWKV = (const bf16_t*)(p.ws + WS_RAWKV);
    bf16_t* Q = (bf16_t*)(p.ws + WS_Q);
    bf16_t* KB = (bf16_t*)(p.ws + WS_KB);
    bf16_t* VT = (bf16_t*)(p.ws + WS_VT);
    LAS bf16_t* vt = (LAS bf16_t*)shm;
    const int row0 = unit * 64;
    const bool lat = row0 < TX;
    const int b = lat ? (row0 >> 11) : ((row0 - TX) >> 8);
    const int key0 = lat ? (row0 & 2047) : 2048 + ((row0 - TX) & 255);
    const int head = lane >> 4, sub = lane & 15;
    const float lninv = -9.210340371976184f / 8.f;
    const float frq = __expf(lninv * (float)(sub & 7));
    float qg[6], kg[6];
#pragma unroll
    for (int j = 0; j < 6; ++j) { qg[j] = p.mla_q_g[l * 96 + sub + 16 * j] * 0.14724444674085666f; kg[j] = p.mla_k_g[l * 96 + sub + 16 * j]; }
    constexpr int NB = 4;
    for (int tk0 = wid * 8; tk0 < wid * 8 + 8; tk0 += NB) {
        float pq[NB][3], pkv[NB][2], qr[NB][6], kr[NB][6], vr[NB][4];
#pragma unroll
        for (int i = 0; i < NB; ++i) { const int r = row0 + tk0 + i; const bf16_t* pr = P + (size_t)r * NINP;
#pragma unroll
            for (int j = 0; j < 3; ++j) pq[i][j] = bf2f(pr[OFF_Q + lane + 64 * j]);
#pragma unroll
            for (int j = 0; j < 2; ++j) pkv[i][j] = bf2f(pr[OFF_KV + lane + 64 * j]);
#pragma unroll
            for (int j = 0; j < 6; ++j) qr[i][j] = bf2f(RAWQ[(size_t)r * 512 + head * 96 + sub + 16 * j]);
#pragma unroll
            for (int j = 0; j < 4; ++j) kr[i][j] = bf2f(RAWKV[(size_t)r * 512 + head * 128 + sub + 16 * j]);
#pragma unroll
            for (int j = 4; j < 6; ++j) kr[i][j] = bf2f(pr[OFF_KPE + sub + 16 * (j - 4)]);
#pragma unroll
            for (int j = 0; j < 4; ++j) vr[i][j] = bf2f(RAWKV[(size_t)r * 512 + head * 128 + 64 + sub + 16 * j]); }
        float red[2 * NB];
#pragma unroll
        for (int i = 0; i < NB; ++i) { red[2 * i] = pq[i][0] * pq[i][0] + pq[i][1] * pq[i][1] + pq[i][2] * pq[i][2]; red[2 * i + 1] = pkv[i][0] * pkv[i][0] + pkv[i][1] * pkv[i][1]; }
        wave_sum_n<2 * NB>(red);
        float ssq[2 * NB];
#pragma unroll
        for (int i = 0; i < NB; ++i) {
            const float rq = rsqrtf(red[2 * i] * (1.f / 192.f) + EPS), rkv = rsqrtf(red[2 * i + 1] * (1.f / 128.f) + EPS);
            float s0 = 0.f, s1 = 0.f;
#pragma unroll
            for (int j = 0; j < 6; ++j) { qr[i][j] *= rq; s0 += qr[i][j] * qr[i][j]; }
#pragma unroll
            for (int j = 0; j < 4; ++j) { kr[i][j] *= rkv; s1 += kr[i][j] * kr[i][j]; }
#pragma unroll
            for (int j = 4; j < 6; ++j) s1 += kr[i][j] * kr[i][j];
#pragma unroll
            for (int j = 0; j < 4; ++j) vr[i][j] *= rkv;
            ssq[2 * i] = s0; ssq[2 * i + 1] = s1;
        }
        { const int l4 = olane();
#pragma unroll
          for (int o = 8; o > 0; o >>= 1) { float t_[2 * NB];
#pragma unroll
              for (int i = 0; i < 2 * NB; ++i) t_[i] = __int_as_float(__builtin_amdgcn_ds_bpermute((l4 ^ o) << 2, __float_as_int(ssq[i])));
#pragma unroll
              for (int i = 0; i < 2 * NB; ++i) ssq[i] += t_[i]; } }
#pragma unroll
        for (int i = 0; i < NB; ++i) {
            const int tk = tk0 + i, r = row0 + tk;
            const float rnq = rsqrtf(ssq[2 * i] * (1.f / 96.f) + EPS), rnk = rsqrtf(ssq[2 * i + 1] * (1.f / 96.f) + EPS);
#pragma unroll
            for (int j = 0; j < 6; ++j) { qr[i][j] *= rnq * qg[j]; kr[i][j] *= rnk * kg[j]; }
            if (lat) {
                const int tseq = r & 2047; const float a0 = (float)(tseq >> 6) * frq, a1 = (float)(tseq & 63) * frq;
                const float cs0 = __cosf(a0), sn0 = __sinf(a0), cs1 = __cosf(a1), sn1 = __sinf(a1);
                const float oq4 = shx(qr[i][4], 8), oq5 = shx(qr[i][5], 8), ok4 = shx(kr[i][4], 8), ok5 = shx(kr[i][5], 8);
                const float sg = (sub < 8) ? -1.f : 1.f;
                qr[i][4] = qr[i][4] * cs0 + sg * oq4 * sn0; qr[i][5] = qr[i][5] * cs1 + sg * oq5 * sn1;
                kr[i][4] = kr[i][4] * cs0 + sg * ok4 * sn0; kr[i][5] = kr[i][5] * cs1 + sg * ok5 * sn1;
            }
            bf16_t* kro = KB + ((size_t)(b * 4 + head) * 2304 + key0 + tk) * 96;
#pragma unroll
            for (int j = 0; j < 6; ++j) { Q[(size_t)r * 384 + head * 96 + sub + 16 * j] = f2bf(qr[i][j]); kro[sub + 16 * j] = f2bf(kr[i][j]); }
#pragma unroll
            for (int j = 0; j < 4; ++j) vt[(head * 64 + sub + 16 * j) * 72 + tk] = f2bf(vr[i][j]);
        }
    }
    __syncthreads();
    { const int hv = tid >> 1, hf = tid & 1;
      bf16_t* dst = VT + ((size_t)(b * 4 + (hv >> 6)) * 64 + (hv & 63)) * 2304 + key0 + hf * 32;
#pragma unroll
      for (int i = 0; i < 4; ++i) *(u32x4*)(dst + i * 8) = *(const LAS u32x4*)(vt + hv * 72 + hf * 32 + i * 8); }
    __syncthreads();
}
DI void s5carry_unit(const Params& p, int l, int unit, const int wv_) {
    const int gid = unit * 512 + otid();
    const int q = gid & 63, dir = (gid >> 6) & 1, g = (gid >> 7) & 15, b = gid >> 11;
    const float* A64 = (const float*)(p.ws + WS_A64) + (size_t)(((l * 2 + dir) * 16 + g) * 64 + q) * 2;
    const float ar = A64[0], ai = A64[1];
    const float* SST = (const float*)(p.ws + WS_SST);
    bf16_t* HIN = (bf16_t*)(p.ws + WS_HIN);
    float sr[NCH], si[NCH];
#pragma unroll
    for (int s = 0; s < NCH; ++s) { const int j = dir == 0 ? s : (s < 4 ? 3 - s : 39 - s);
        const size_t base = ((size_t)(b * NCH + j) * 16 + g) * 256 + dir * 128 + q; sr[s] = SST[base]; si[s] = SST[base + 64]; }
    float hr = 0.f, hi = 0.f;
#pragma unroll
    for (int s = 0; s < NCH; ++s) {
        const int j = dir == 0 ? s : (s < 4 ? 3 - s : 39 - s);
        const size_t base = ((size_t)(b * NCH + j) * 16 + g) * 256 + dir * 128 + q;
        HIN[base] = f2bf(hr); HIN[base + 64] = f2bf(hi);
        const float nr = ar * hr - ai * hi + sr[s], ni = ar * hi + ai * hr + si[s];
        hr = nr; hi = ni;
    }
}
struct PvConvPool {
    const Params& p; int l;
    PV_NOHOOKS
    static constexpr int NT = 4; static constexpr int FP8 = 0; static constexpr bool PARK = false; typedef APlain AS; typedef BSimple BS;
    DI int first() const { return lin_first(0, 576); }
    DI int next(int u) const { return lin_next(u, 576); }
    DI void src(int u, AS& a, BS& b, const int wv_) const {
        const bool isconv = u < 288; const int mt = isconv ? u : u - 288;
        a = make_a_plain((const bf16_t*)(p.ws + (isconv ? WS_ACONV : WS_APOOL)), (size_t)mt * 256, 256, 0);
        const bf16_t* W = (const bf16_t*)(p.ws + (isconv ? WS_WPW : WS_WPOOL)) + (size_t)l * 65536;
        b = make_b(W, W + (size_t)128 * 256, 256);
    }
    DI void epi(f32x4 (&acc)[2][2][4][2], int u, const int wv_) const {
        const bool isconv = u < 288; const int mt = isconv ? u : u - 288;
        bf16_t* CAT = (bf16_t*)(p.ws + WS_CAT);
        if (isconv) { EPI_FOR8(acc, { store_bf16x8(CAT + (size_t)(mt * 256 + lr) * 1024 + lc, v0, v1); }); }
        else { const int t_ = otid(), c0_ = ((t_ >> 6) & 3) * 32 + ((t_ & 63) >> 4) * 8; f32x4 sc_[2][2];
#pragma unroll
               for (int bj = 0; bj < 2; ++bj)
#pragma unroll
                   for (int n = 0; n < 2; ++n) sc_[bj][n] = *(const f32x4*)(p.pool_scale + l * 256 + bj * 128 + n * 4 + c0_);
               EPI_FOR8(acc, { store_bf16x8(CAT + (size_t)(mt * 256 + lr) * 1024 + 256 + lc, v0 * sc_[bj][0], v1 * sc_[bj][1]); }); }
    }
};
DI void phase_B(const Params& p, LAS char* shm, int l, const int wv_) {
    { PvConvPool pv{p, l}; gemm_stream(shm, pv, wv_); }
    const int n_post = TT / 64, n_carry = 128;
    for (int u = first_unit(576); u < n_post + n_carry; u += gridDim.x) {
        if (u < n_post) qkvpost_unit(p, shm, l, u, wv_);
        else s5carry_unit(p, l, u - n_post, wv_);
    }
}

DI void attn_unit(const Params& p, LAS char* shm, int l, int b, int h, int qrow0, int nq, int key_lo, int nkeys, const int wv_) {
    const int tid = otid(), wid = tid >> 6, lane = tid & 63, l31 = lane & 31, hh = lane >> 5;
    const bf16_t* Q = (const bf16_t*)(p.ws + WS_Q);
    const bf16_t* KBp = (const bf16_t*)(p.ws + WS_KB) + (size_t)(b * 4 + h) * 2304 * 96;
    const bf16_t* VTp = (const bf16_t*)(p.ws + WS_VT) + (size_t)(b * 4 + h) * 64 * 2304;
    bf16_t* CAT = (bf16_t*)(p.ws + WS_CAT);
    LAS char* kl = shm;
    LAS char* vl = shm + 13312;
    const bool active = wid * 64 < nq;
    float gq = 0.f, gk = 0.f;
    for (int i = lane; i < 96; i += 64) { gq = fmaxf(gq, fabsf(p.mla_q_g[l * 96 + i])); gk = fmaxf(gk, fabsf(p.mla_k_g[l * 96 + i])); }
    gq = wave_max(gq); gk = wave_max(gk);
    const float LOG2E = 1.4426950408889634f;
    const float c2 = 9.797958971132712f * gq * gk * LOG2E;
    const float sh2 = fmaxf(c2 - 64.f, 0.f);
    LAS char* const wq = shm + 2 * 13312 + 2 * 9216 + wid * 12288 + lane * 16;
    if (active) {
#pragma unroll
        for (int qb = 0; qb < 2; ++qb)
#pragma unroll
            for (int ks = 0; ks < 6; ++ks) *(LAS bf16x8*)(wq + (qb * 6 + ks) * 1024) = *(const bf16x8*)(Q + (size_t)(qrow0 + wid * 64 + qb * 32 + l31) * 384 + h * 96 + ks * 16 + hh * 8);
    }
    f32x16 O[2][2];
#pragma unroll
    for (int a = 0; a < 2; ++a)
#pragma unroll
        for (int c = 0; c < 2; ++c)
#pragma unroll
            for (int i = 0; i < 16; ++i) O[a][c][i] = 0.f;
    float lsum[2] = {0.f, 0.f};
    const int ntile = nkeys / 64;
    LAS char* const kb0 = shm;
    LAS char* const vb0 = shm + 2 * 13312;
    u32x4 kreg0, kreg1, vreg;
    const int k_kr0 = tid / 12, k_p0 = tid % 12, k_kr1 = (tid + 512) / 12, k_p1 = (tid + 512) % 12, v_vd = tid >> 3, v_p = tid & 7;
#define A_LOADK(T_) do { const int key_ = key_lo + (T_) * 64; kreg0 = *(const u32x4*)(KBp + (size_t)(key_ + k_kr0) * 96 + k_p0 * 8); \
        if (tid < 256) kreg1 = *(const u32x4*)(KBp + (size_t)(key_ + k_kr1) * 96 + k_p1 * 8); } while (0)
#define A_LOADV(T_) do { const int key_ = key_lo + (T_) * 64; vreg = *(const u32x4*)(VTp + (size_t)v_vd * 2304 + key_ + v_p * 8); } while (0)
#define A_WRITEK(buf_) do { LAS char* kl_ = kb0 + (buf_) * 13312; *(LAS u32x4*)(kl_ + k_kr0 * 208 + k_p0 * 16) = kreg0; if (tid < 256) *(LAS u32x4*)(kl_ + k_kr1 * 208 + k_p1 * 16) = kreg1; } while (0)
#define A_WRITEV(buf_) do { LAS char* vl_ = vb0 + (buf_) * 9216; *(LAS u32x4*)(vl_ + v_vd * 144 + v_p * 16) = vreg; } while (0)
#define A_QK(S_, kbuf_, half_) do { const LAS char* kl_ = kb0 + (kbuf_) * 13312 + ((half_) * 32 + l31) * 208 + hh * 16; \
        _Pragma("unroll") for (int ks = 0; ks < 6; ++ks) { const bf16x8 a_ = *(const LAS bf16x8*)(kl_ + ks * 32); \
            if (ks == 0) { _Pragma("unroll") for (int qb = 0; qb < 2; ++qb) { f32x16 z_; _Pragma("unroll") for (int i = 0; i < 16; ++i) z_[i] = 0.f; S_[qb] = __builtin_amdgcn_mfma_f32_32x32x16_bf16(a_, *(const LAS bf16x8*)(wq + (qb * 6) * 1024), z_, 0, 0, 0); } } \
            else { _Pragma("unroll") for (int qb = 0; qb < 2; ++qb) S_[qb] = __builtin_amdgcn_mfma_f32_32x32x16_bf16(a_, *(const LAS bf16x8*)(wq + (qb * 6 + ks) * 1024), S_[qb], 0, 0, 0); } } } while (0)
#define A_SOFTMAX(S_, P_) do { _Pragma("unroll") for (int qb = 0; qb < 2; ++qb) { float e_[16]; \
        _Pragma("unroll") for (int i = 0; i < 16; ++i) { e_[i] = __builtin_amdgcn_exp2f(S_[qb][i] - sh2); lsum[qb] += e_[i]; } \
        _Pragma("unroll") for (int s_ = 0; s_ < 2; ++s_) { u32x4 w_; w_.x = pk_bf16(e_[8 * s_], e_[8 * s_ + 1]); w_.y = pk_bf16(e_[8 * s_ + 2], e_[8 * s_ + 3]); w_.z = pk_bf16(e_[8 * s_ + 4], e_[8 * s_ + 5]); w_.w = pk_bf16(e_[8 * s_ + 6], e_[8 * s_ + 7]); \
            P_[qb][s_] = __builtin_bit_cast(bf16x8, w_); } } } while (0)
#define A_PV(P_, vbuf_, half_) do { const LAS char* vl_ = vb0 + (vbuf_) * 9216 + l31 * 144 + hh * 8; \
        _Pragma("unroll") for (int s_ = 0; s_ < 2; ++s_) { const int kk_ = (half_) * 2 + s_; \
            _Pragma("unroll") for (int vb = 0; vb < 2; ++vb) { \
                const s16x4 lo_ = *(const LAS s16x4*)(vl_ + vb * 32 * 144 + kk_ * 32); const s16x4 hi_ = *(const LAS s16x4*)(vl_ + vb * 32 * 144 + kk_ * 32 + 16); \
                const bf16x8 va_ = __builtin_shufflevector(lo_, hi_, 0, 1, 2, 3, 4, 5, 6, 7); \
                _Pragma("unroll") for (int qb = 0; qb < 2; ++qb) O[vb][qb] = __builtin_amdgcn_mfma_f32_32x32x16_bf16(va_, P_[qb][s_], O[vb][qb], 0, 0, 0); } } } while (0)
#define A_LDF(p_) (*(const LAS bf16x8*)(p_))
#define A_LDV(p_) __builtin_shufflevector(*(const LAS s16x4*)(p_), *(const LAS s16x4*)((p_) + 16), 0, 1, 2, 3, 4, 5, 6, 7)
#define A_SOFT4(g_, Ss_) do { _Pragma("unroll") for (int j_ = 0; j_ < 2; ++j_) { const int ix_ = (g_) * 4 + j_ * 2, qb_ = ix_ >> 4, i_ = ix_ & 15; \
        const float e0_ = __builtin_amdgcn_exp2f(Ss_[qb_][i_] - sh2), e1_ = __builtin_amdgcn_exp2f(Ss_[qb_][i_ + 1] - sh2); lsum[qb_] += e0_ + e1_; pw_[ix_ >> 1] = pk_bf16(e0_, e1_); } } while (0)
#define A_STEP(Sq_, kbufq_, halfq_, Ss_, Ps_, Pp_, vbufp_, halfp_) do { \
        const LAS char* kl_ = kb0 + (kbufq_) * 13312 + ((halfq_) * 32 + l31) * 208 + hh * 16; \
        const LAS char* vl_ = vb0 + (vbufp_) * 9216 + l31 * 144 + hh * 8 + (halfp_) * 64; \
        bf16x8 fa_[2], fq_[2][2], fv_[2]; unsigned pw_[16]; \
        fa_[0] = A_LDF(kl_); fq_[0][0] = A_LDF(wq); fq_[0][1] = A_LDF(wq + 6 * 1024); \
        __builtin_amdgcn_sched_barrier(0); \
        _Pragma("unroll") for (int g_ = 0; g_ < 6; ++g_) { \
            if (g_ < 5) { fa_[(g_ + 1) & 1] = A_LDF(kl_ + (g_ + 1) * 32); fq_[(g_ + 1) & 1][0] = A_LDF(wq + (g_ + 1) * 1024); fq_[(g_ + 1) & 1][1] = A_LDF(wq + (6 + g_ + 1) * 1024); } \
            else fv_[0] = A_LDV(vl_); \
            if (g_ == 0) { _Pragma("unroll") for (int qb = 0; qb < 2; ++qb) { f32x16 z_; _Pragma("unroll") for (int i = 0; i < 16; ++i) z_[i] = 0.f; Sq_[qb] = __builtin_amdgcn_mfma_f32_32x32x16_bf16(fa_[0], fq_[0][qb], z_, 0, 0, 0); } } \
            else { _Pragma("unroll") for (int qb = 0; qb < 2; ++qb) Sq_[qb] = __builtin_amdgcn_mfma_f32_32x32x16_bf16(fa_[g_ & 1], fq_[g_ & 1][qb], Sq_[qb], 0, 0, 0); } \
            A_SOFT4(g_, Ss_); \
            __builtin_amdgcn_sched_barrier(0); } \
        _Pragma("unroll") for (int g_ = 0; g_ < 4; ++g_) { const int s_ = g_ >> 1, vb_ = g_ & 1; \
            if (g_ < 3) fv_[(g_ + 1) & 1] = A_LDV(vl_ + ((g_ + 1) & 1) * 32 * 144 + ((g_ + 1) >> 1) * 32); \
            _Pragma("unroll") for (int qb = 0; qb < 2; ++qb) O[vb_][qb] = __builtin_amdgcn_mfma_f32_32x32x16_bf16(fv_[g_ & 1], Pp_[qb][s_], O[vb_][qb], 0, 0, 0); \
            if (g_ < 2) A_SOFT4(6 + g_, Ss_); \
            __builtin_amdgcn_sched_barrier(0); } \
        _Pragma("unroll") for (int qb = 0; qb < 2; ++qb) _Pragma("unroll") for (int s_ = 0; s_ < 2; ++s_) { u32x4 w_; w_.x = pw_[qb * 8 + s_ * 4]; w_.y = pw_[qb * 8 + s_ * 4 + 1]; w_.z = pw_[qb * 8 + s_ * 4 + 2]; w_.w = pw_[qb * 8 + s_ * 4 + 3]; Ps_[qb][s_] = __builtin_bit_cast(bf16x8, w_); } \
    } while (0)
#define A_SCHED(n_) do { _Pragma("unroll") for (int g_ = 0; g_ < (n_); ++g_) { __builtin_amdgcn_sched_group_barrier(0x008, 1, 0); __builtin_amdgcn_sched_group_barrier(0x002, 5, 0); } } while (0)
    {
        u32x4 k1a = (u32x4){0u, 0u, 0u, 0u}, k1b = k1a;
        A_LOADK(0); A_LOADV(0);
        if (ntile > 1) { const int key_ = key_lo + 64; k1a = *(const u32x4*)(KBp + (size_t)(key_ + k_kr0) * 96 + k_p0 * 8); if (tid < 256) k1b = *(const u32x4*)(KBp + (size_t)(key_ + k_kr1) * 96 + k_p1 * 8); }
        A_WRITEK(0); A_WRITEV(0);
        kreg0 = k1a; kreg1 = k1b; A_WRITEK(1);
        if (ntile > 2) A_LOADK(2);
        if (ntile > 1) A_LOADV(1);
    }
    __syncthreads();
    f32x16 Sa[2], Sb[2]; bf16x8 Pa[2][2], Pb[2][2];
    if (active) { A_QK(Sa, 0, 0); A_QK(Sb, 0, 1); A_SOFTMAX(Sa, Pa); A_SCHED(12); }
    for (int T = 0; T < ntile; ++T) {
        const int kcur = T & 1, knxt = kcur ^ 1;
        __syncthreads();
        if (T + 2 < ntile) A_WRITEK(kcur);
        if (T + 1 < ntile) A_WRITEV(knxt);
        if (T + 3 < ntile) A_LOADK(T + 3);
        if (T + 2 < ntile) A_LOADV(T + 2);
        if (active) {
            if (T + 1 < ntile) {
                A_STEP(Sa, knxt, 0, Sb, Pb, Pa, kcur, 0);
                A_STEP(Sb, knxt, 1, Sa, Pa, Pb, kcur, 1);
            } else {
                A_SOFTMAX(Sb, Pb); A_PV(Pa, kcur, 0); A_SCHED(8);
                __builtin_amdgcn_sched_barrier(0);
                A_PV(Pb, kcur, 1);
            }
        }
    }
#undef A_LOADK
#undef A_LOADV
#undef A_WRITEK
#undef A_WRITEV
#undef A_QK
#undef A_SOFTMAX
#undef A_PV
#undef A_SCHED
#undef A_STEP
#undef A_SOFT4
#undef A_LDF
#undef A_LDV
    if (active) {
#pragma unroll
        for (int qb = 0; qb < 2; ++qb) {
            const float tot = lsum[qb] + shx(lsum[qb], 32);
            const float inv = 1.f / tot;
            bf16_t* orow = CAT + (size_t)(qrow0 + wid * 64 + qb * 32 + l31) * 1024 + 768 + h * 64;
#pragma unroll
            for (int vb = 0; vb < 2; ++vb)
#pragma unroll
                for (int i4 = 0; i4 < 4; ++i4)
                    store_bf16x4(orow + vb * 32 + 8 * i4 + 4 * hh, O[vb][qb][4 * i4] * inv, O[vb][qb][4 * i4 + 1] * inv, O[vb][qb][4 * i4 + 2] * inv, O[vb][qb][4 * i4 + 3] * inv);
        }
    }
    __syncthreads();
}
struct PvS5Out {
    const Params& p; int l;
    PV_NOHOOKS
    static constexpr int NT = 20; static constexpr int FP8 = 0; static constexpr bool PARK = false; typedef ASeg2 AS; typedef BSimple BS;
    DI int first() const { return lin_first(512, 320); }
    DI int next(int u) const { return lin_next(u, 320); }
    DI void src(int u, AS& as, BS& bs, const int wv_) const {
        const int ntile = u & 3, mt = (u >> 2) % 5, g = u / 20;
        int R[2], C[2]; stage_coords(R, C, wv_);
        as.base0 = (const char*)(p.ws + WS_P); as.base1 = (const char*)(p.ws + WS_HIN); as.ks0 = 4 * NINP * 2; as.nt0 = 16;
#pragma unroll
        for (int h = 0; h < 2; ++h)
#pragma unroll
            for (int i = 0; i < 2; ++i) { const int cr = min(mt * 256 + h * 128 + R[i], NCROW - 1);
                as.off0[h][i] = (unsigned)(((size_t)(crow_tok(cr) + (C[i] >> 4)) * NINP + OFF_SSM + g * 16 + (C[i] & 15)) * 2);
                as.off1[h][i] = (unsigned)((((size_t)cr * 16 + g) * 256 + C[i]) * 2); }
        const bf16_t* W = (const bf16_t*)(p.ws + WS_TS5) + ((size_t)(l * 16 + g) * 1024 + ntile * 256) * 1280;
        bs = make_b(W, W + (size_t)128 * 1280, 1280);
    }
    DI void epi(f32x4 (&acc)[2][2][4][2], int u, const int wv_) const {
        const int ntile = u & 3, mt = (u >> 2) % 5, g = u / 20;
        bf16_t* Z = (bf16_t*)(p.ws + WS_Z);
        EPI_FOR8(acc, { const int cr = mt * 256 + lr; if (cr < NCROW) { const int col = ntile * 256 + lc, t = col >> 4, co = col & 15;
            const f32x4 g0 = (f32x4){gelu_tanh(v0[0]), gelu_tanh(v0[1]), gelu_tanh(v0[2]), gelu_tanh(v0[3])}, g1_ = (f32x4){gelu_tanh(v1[0]), gelu_tanh(v1[1]), gelu_tanh(v1[2]), gelu_tanh(v1[3])};
            store_bf16x8(Z + (size_t)(crow_tok(cr) + t) * 256 + g * 16 + co, g0, g1_); } });
    }
};
DI void phase_C(const Params& p, LAS char* shm, int l, const int wv_) {
    for (int u = blockIdx.x; u < 512; u += gridDim.x) { const int qb = u & 3, h = (u >> 2) & 3, b = u >> 4;
        attn_unit(p, shm, l, b, h, b * SEQ + qb * 512, 512, 0, 2304, wv_); }
    { PvS5Out pv{p, l}; gemm_stream(shm, pv, wv_); }
    if (l == 0) for (int u = first_unit(512 + 320); u < 128; u += gridDim.x) { const int h = u & 3, b = u >> 2;
        attn_unit(p, shm, l, b, h, TX + b * CTXL, 256, 2048, 256, wv_); }
}

struct PvGlu {
    const Params& p; int l;
    PV_NOHOOKS
    static constexpr int NT = 4; static constexpr int FP8 = 0; static constexpr bool PARK = false; typedef APlain AS; typedef BSimple BS;
    DI int first() const { return lin_first(0, 288); }
    DI int next(int u) const { return lin_next(u, 288); }
    DI void src(int u, AS& a, BS& b, const int wv_) const {
        a = make_a_plain((const bf16_t*)(p.ws + WS_Z), (size_t)u * 256, 256, 0);
        const bf16_t* W = (const bf16_t*)(p.ws + WS_WGLU) + (size_t)l * 65536;
        b = make_b(W, W + (size_t)128 * 256, 256);
    }
    DI void epi(f32x4 (&acc)[2][2][4][2], int u, const int wv_) const {
        const bf16_t* Z = (const bf16_t*)(p.ws + WS_Z); bf16_t* CAT = (bf16_t*)(p.ws + WS_CAT);
        const int _tz = otid(), _w = _tz >> 6, _l = _tz & 63, _wr = _w >> 2, _wc = _w & 3, _fr = _l & 15, _fq = _l >> 4;
        const int c0 = _wc * 32 + _fq * 8;
        f32x4 bsv[2][2];
#pragma unroll
        for (int bj = 0; bj < 2; ++bj)
#pragma unroll
            for (int n = 0; n < 2; ++n) bsv[bj][n] = *(const f32x4*)(p.ssm_glu_b + l * 256 + bj * 128 + n * 4 + c0);
#pragma unroll
        for (int ai = 0; ai < 2; ++ai) {
            u32x4 zz[4][2];
#pragma unroll
            for (int m = 0; m < 4; ++m)
#pragma unroll
                for (int bj = 0; bj < 2; ++bj) zz[m][bj] = *(const u32x4*)(Z + (size_t)(u * 256 + ai * 128 + _wr * 64 + m * 16 + _fr) * 256 + bj * 128 + c0);
#pragma unroll
            for (int m = 0; m < 4; ++m) { const size_t r = (size_t)(u * 256 + ai * 128 + _wr * 64 + m * 16 + _fr);
#pragma unroll
                for (int bj = 0; bj < 2; ++bj) { const f32x4 a0 = acc[ai][bj][m][0], a1 = acc[ai][bj][m][1]; const f32x4 b0 = bsv[bj][0], b1 = bsv[bj][1]; const u32x4 z_ = zz[m][bj];
                    const f32x4 o0 = (f32x4){bflo(z_.x) * sigmoidf_(a0[0] + b0[0]), bfhi(z_.x) * sigmoidf_(a0[1] + b0[1]), bflo(z_.y) * sigmoidf_(a0[2] + b0[2]), bfhi(z_.y) * sigmoidf_(a0[3] + b0[3])};
                    const f32x4 o1 = (f32x4){bflo(z_.z) * sigmoidf_(a1[0] + b1[0]), bfhi(z_.z) * sigmoidf_(a1[1] + b1[1]), bflo(z_.w) * sigmoidf_(a1[2] + b1[2]), bfhi(z_.w) * sigmoidf_(a1[3] + b1[3])};
                    store_bf16x8(CAT + r * 1024 + 512 + bj * 128 + c0, o0, o1); } }
        }
    }
};
DI void phase_D(const Params& p, LAS char* shm, int l, const int wv_) {
    PvGlu pv{p, l}; gemm_stream(shm, pv, wv_);
}

struct PvOutproj {
    const Params& p; int l;
    PV_NOHOOKS
    static constexpr int NT = 16; static constexpr int FP8 = 0; static constexpr bool PARK = false; typedef APlain AS; typedef BSimple BS;
    XcdDeal<4, 4> deal;
    DI int first() const { return deal.first(); }
    DI int next(int u) const { return deal.next(u); }
    DI void src(int u, AS& a, BS& b, const int wv_) const {
        int mt, nt; deal.decode(u, mt, nt);
        const bf16_t* W = (const bf16_t*)(p.ws + WS_WMO) + (size_t)l * 1024 * 1024;
        a = make_a_plain((const bf16_t*)(p.ws + WS_CAT), (size_t)mt * 256, 1024, 0);
        b = make_b(W + (size_t)(nt * 256) * 1024, W + (size_t)(nt * 256 + 128) * 1024, 1024);
    }
    DI void epi(f32x4 (&acc)[2][2][4][2], int u, const int wv_) const {
        int mt, nt; deal.decode(u, mt, nt);
        bf16_t* X = (bf16_t*)(p.ws + WS_X);
        const float* MOD = (const float*)(p.ws + WS_MOD) + (size_t)l * 33 * 6144;
        const int _tz = otid(), _w = _tz >> 6, _l = _tz & 63, _wr = _w >> 2, _wc = _w & 3, _fr = _l & 15, _fq = _l >> 4;
        const int c0 = nt * 256 + _wc * 32 + _fq * 8;
        const int row0 = mt * 256;
        const float* g1p = MOD + (size_t)mod_row(row0) * 6144 + 2048 + c0;
        f32x4 g1[2][2];
#pragma unroll
        for (int bj = 0; bj < 2; ++bj)
#pragma unroll
            for (int n = 0; n < 2; ++n) g1[bj][n] = *(const f32x4*)(g1p + bj * 128 + n * 4);
        bf16_t* obase = X + (size_t)row0 * 1024;
        if (l == 0) {
            const float* xbase = row0 < TX ? p.x + (size_t)row0 * 1024 : p.ctx + (size_t)(row0 - TX) * 1024;
#pragma unroll
            for (int ai = 0; ai < 2; ++ai)
#pragma unroll
                for (int mp = 0; mp < 2; ++mp) {
                    f32x4 xv[2][2][2];
#pragma unroll
                    for (int mm = 0; mm < 2; ++mm)
#pragma unroll
                        for (int bj = 0; bj < 2; ++bj)
#pragma unroll
                            for (int n = 0; n < 2; ++n) xv[mm][bj][n] = *(const f32x4*)(xbase + (size_t)(ai * 128 + _wr * 64 + (mp * 2 + mm) * 16 + _fr) * 1024 + c0 + bj * 128 + n * 4);
#pragma unroll
                    for (int mm = 0; mm < 2; ++mm)
#pragma unroll
                        for (int bj = 0; bj < 2; ++bj)
                            store_bf16x8(obase + (size_t)(ai * 128 + _wr * 64 + (mp * 2 + mm) * 16 + _fr) * 1024 + c0 + bj * 128,
                                         xv[mm][bj][0] + g1[bj][0] * acc[ai][bj][mp * 2 + mm][0], xv[mm][bj][1] + g1[bj][1] * acc[ai][bj][mp * 2 + mm][1]);
                }
        } else {
#pragma unroll
            for (int ai = 0; ai < 2; ++ai) {
                u32x4 xv[4][2];
#pragma unroll
                for (int m = 0; m < 4; ++m)
#pragma unroll
                    for (int bj = 0; bj < 2; ++bj) xv[m][bj] = *(const u32x4*)(obase + (size_t)(ai * 128 + _wr * 64 + m * 16 + _fr) * 1024 + c0 + bj * 128);
#pragma unroll
                for (int m = 0; m < 4; ++m)
#pragma unroll
                    for (int bj = 0; bj < 2; ++bj) { const u32x4 x_ = xv[m][bj];
                        const f32x4 x0 = (f32x4){bflo(x_.x), bfhi(x_.x), bflo(x_.y), bfhi(x_.y)}, x1 = (f32x4){bflo(x_.z), bfhi(x_.z), bflo(x_.w), bfhi(x_.w)};
                        store_bf16x8(obase + (size_t)(ai * 128 + _wr * 64 + m * 16 + _fr) * 1024 + c0 + bj * 128, x0 + g1[bj][0] * acc[ai][bj][m][0], x1 + g1[bj][1] * acc[ai][bj][m][1]); }
            }
        }
    }
};
DI void phase_E(const Params& p, LAS char* shm, int l, const int wv_) {
    PvOutproj pv{p, l, {(l == 1 ? TX : TT) / 256}}; gemm_stream(shm, pv, wv_);
}

template <int S> DI float row_rot_f(float v) { return __int_as_float(__builtin_amdgcn_update_dpp(0, __float_as_int(v), 0x120 | S, 0xf, 0xf, false)); }
template <int S> DI int row_rot_i(int v) { return __builtin_amdgcn_update_dpp(0, v, 0x120 | S, 0xf, 0xf, false); }
template <int S> struct RankAcc {
    static DI void run(float o0, float o1, int oe, float v0, float v1, int e0, int& r0, int& r1) {
        const float a0 = S ? row_rot_f<S>(o0) : o0, a1 = S ? row_rot_f<S>(o1) : o1; const int ae = S ? row_rot_i<S>(oe) : oe;
        r0 += (a0 > v0 || (a0 == v0 && ae < e0)) ? 1 : 0;
        r0 += (a1 > v0) ? 1 : 0;
        r1 += (a0 > v1 || a0 == v1) ? 1 : 0;
        r1 += (a1 > v1 || (a1 == v1 && ae < e0)) ? 1 : 0;
        RankAcc<S + 1>::run(o0, o1, oe, v0, v1, e0, r0, r1);
    }
};
template <> struct RankAcc<16> { static DI void run(float, float, int, float, float, int, int&, int&) {} };
DI float row_sum16(float v) { v += row_rot_f<8>(v); v += row_rot_f<4>(v); v += row_rot_f<2>(v); v += row_rot_f<1>(v); return v; }
DI float row_max16(float v) { v = fmaxf(v, row_rot_f<8>(v)); v = fmaxf(v, row_rot_f<4>(v)); v = fmaxf(v, row_rot_f<2>(v)); v = fmaxf(v, row_rot_f<1>(v)); return v; }

DI void phase_router(const Params& p, LAS char* shm, int l, const int wv_) {
    const int tid = otid(), wid = tid >> 6, lane = tid & 63;
    const int Tm = (l == 1) ? TX : TT;
    const bf16_t* X = (const bf16_t*)(p.ws + WS_X);
    const float* MOD = (const float*)(p.ws + WS_MOD) + (size_t)l * 33 * 6144;
    unsigned char* H8 = (unsigned char*)(p.ws + WS_H);
    const bool alt = p.ph_lo != 0;
    int* CNT = (int*)(p.ws + WS_CNT) + l * 32 + (alt ? 64 : 0);
    int* LIST = alt ? (int*)(p.ws + WS_RY) : (int*)(p.ws + WS_LIST);
    LAS char* wfr = shm;
    LAS bf16_t* gml = (LAS bf16_t*)(shm + 131072);
    LAS bf16_t* shl = gml + 1024;
    LAS float* cvec = (LAS float*)(shm + 131072 + 4096);
    LAS int* lcnt = (LAS int*)(cvec + 32);
    LAS int* lbase = lcnt + 32;
    LAS unsigned* lrec = (LAS unsigned*)(lbase + 32);
    LAS float* lwt = (LAS float*)(lrec + 1152);
    const int tpw = (Tm + gridDim.x - 1) / gridDim.x;
    const int tbeg = blockIdx.x * tpw, tend = min(tbeg + tpw, Tm);
    if (tid < 32) lcnt[tid] = 0;
    int seg_beg = tbeg;
    while (seg_beg < tend) {
        const int mrow = mod_row(seg_beg);
        int seg_end = tend;
        if (mrow < 32) seg_end = min(tend, (mrow + 1) * SEQ); else seg_end = tend;
        const float* mr = MOD + (size_t)mrow * 6144;
        __syncthreads();
        for (int k = tid; k < 1024; k += 512) { const float gmv = p.norm2_g[l * 1024 + k] * (1.f + mr[4096 + k]); gml[k] = f2bf(gmv); shl[k] = f2bf(mr[3072 + k]); }
#pragma unroll 8
        for (int i = tid; i < 1024 * 8; i += 512) {
            const int k = i >> 3, e4 = (i & 7) * 4;
            const float gmv = p.norm2_g[l * 1024 + k] * (1.f + mr[4096 + k]);
            const f32x4 w = *(const f32x4*)(p.router_w + (size_t)l * 32768 + k * 32 + e4);
            const int ks = k >> 5, kq = (k >> 3) & 3, j = k & 7;
#pragma unroll
            for (int c = 0; c < 4; ++c) { const int e = e4 + c, nb = e >> 4, ei = e & 15; const float wv = w[c] * gmv;
                const bf16_t hi = f2bf(wv); const bf16_t lo = f2bf(wv - bf2f(hi));
                LAS bf16_t* dst = (LAS bf16_t*)(wfr + ((size_t)((ks * 2 + nb) * 2) * 64 + (kq * 16 + ei)) * 16) + j;
                dst[0] = hi; dst[64 * 8] = lo; }
        }
        {
            float s4[4] = {0.f, 0.f, 0.f, 0.f};
#pragma unroll 8
            for (int k = lane; k < 1024; k += 64) { const float shv = mr[3072 + k]; const f32x4 w = *(const f32x4*)(p.router_w + (size_t)l * 32768 + k * 32 + wid * 4);
                s4[0] += shv * w[0]; s4[1] += shv * w[1]; s4[2] += shv * w[2]; s4[3] += shv * w[3]; }
#pragma unroll
            for (int c = 0; c < 4; ++c) { const float t_ = wave_sum(s4[c]); if (lane == 0) cvec[wid * 4 + c] = t_ + p.router_b[l * 32 + wid * 4 + c]; }
        }
        __syncthreads();
        const int ngroups = (seg_end - seg_beg) >> 4;
        for (int gi = wid; gi < ngroups; gi += 8) {
            const int t0 = seg_beg + gi * 16;
            const int tok = lane & 15, kq = lane >> 4;
            const bf16_t* xr = X + (size_t)(t0 + tok) * 1024 + kq * 8;
            f32x4 acc0 = {0.f, 0.f, 0.f, 0.f}, acc1 = {0.f, 0.f, 0.f, 0.f};
            float ss = 0.f;
            u32x4 xa[16], xb[16];
#pragma unroll
            for (int k2 = 0; k2 < 16; ++k2) xa[k2] = *(const u32x4*)(xr + k2 * 32);
#pragma unroll
            for (int k2 = 0; k2 < 16; ++k2) xb[k2] = *(const u32x4*)(xr + (16 + k2) * 32);
#pragma unroll
            for (int kc = 0; kc < 2; ++kc) {
#pragma unroll
            for (int k2 = 0; k2 < 16; ++k2) { const int ks = kc * 16 + k2;
                if ((k2 & 3) == 0) __builtin_amdgcn_sched_barrier(0);
                const u32x4 xh = kc == 0 ? xa[k2] : xb[k2];
                const float x0 = bflo(xh.x), x1 = bfhi(xh.x), x2 = bflo(xh.y), x3 = bfhi(xh.y), x4 = bflo(xh.z), x5 = bfhi(xh.z), x6 = bflo(xh.w), x7 = bfhi(xh.w);
                ss += x0 * x0 + x1 * x1 + x2 * x2 + x3 * x3 + x4 * x4 + x5 * x5 + x6 * x6 + x7 * x7;
                const bf16x8 ah = __builtin_bit_cast(bf16x8, xh);
                const LAS char* wb = wfr + (size_t)(ks * 4) * 1024 + lane * 16;
                const bf16x8 b0h = *(const LAS bf16x8*)(wb), b0l = *(const LAS bf16x8*)(wb + 1024), b1h = *(const LAS bf16x8*)(wb + 2048), b1l = *(const LAS bf16x8*)(wb + 3072);
                acc0 = __builtin_amdgcn_mfma_f32_16x16x32_bf16(ah, b0h, acc0, 0, 0, 0); acc0 = __builtin_amdgcn_mfma_f32_16x16x32_bf16(ah, b0l, acc0, 0, 0, 0);
                acc1 = __builtin_amdgcn_mfma_f32_16x16x32_bf16(ah, b1h, acc1, 0, 0, 0); acc1 = __builtin_amdgcn_mfma_f32_16x16x32_bf16(ah, b1l, acc1, 0, 0, 0);
            } }
            u32x4 xp[16];
#pragma unroll
            for (int k2 = 0; k2 < 16; ++k2) xp[k2] = *(const u32x4*)(xr + k2 * 32);
            ss += shx(ss, 16); ss += shx(ss, 32);
            const float rn = rsqrtf(ss * (1.f / 1024.f) + EPS);
            const int ei = lane & 15;
            const float c0v = cvec[ei], c1v = cvec[16 + ei];
#pragma unroll
            for (int r = 0; r < 4; ++r) {
                const int tl = (lane >> 4) * 4 + r;
                const float rnt = shi(rn, tl);
                float v0 = fminf(fmaxf(acc0[r] * rnt + c0v, -1e30f), 1e30f), v1 = fminf(fmaxf(acc1[r] * rnt + c1v, -1e30f), 1e30f);
                int r0 = 0, r1 = 0;
                RankAcc<0>::run(v0, v1, ei, v0, v1, ei, r0, r1);
                const float mx = row_max16(fmaxf(v0, v1));
                const bool s0 = r0 < 4, s1 = r1 < 4;
                const float e0 = s0 ? __expf(v0 - mx) : 0.f, e1 = s1 ? __expf(v1 - mx) : 0.f;
                const float inv = 1.f / row_sum16(e0 + e1);
                const int t = t0 + tl;
                if (s0) { const int pos = atomicAdd((int*)&lcnt[ei], 1); lrec[(t - tbeg) * 4 + r0] = (unsigned)ei | ((unsigned)pos << 8); lwt[(t - tbeg) * 4 + r0] = e0 * inv; }
                if (s1) { const int pos = atomicAdd((int*)&lcnt[16 + ei], 1); lrec[(t - tbeg) * 4 + r1] = (unsigned)(16 + ei) | ((unsigned)pos << 8); lwt[(t - tbeg) * 4 + r1] = e1 * inv; }
            }
            unsigned char* hr = H8 + (size_t)(t0 + tok) * 1024 + kq * 8;
#pragma unroll 1
            for (int kc = 0; kc < 2; ++kc) {
            u32x4 xv[16];
            if (kc == 0) {
#pragma unroll
                for (int k2 = 0; k2 < 16; ++k2) xv[k2] = xp[k2];
            } else {
#pragma unroll
                for (int k2 = 0; k2 < 16; ++k2) xv[k2] = *(const u32x4*)(xr + (16 + k2) * 32);
            }
#pragma unroll
            for (int k2 = 0; k2 < 16; ++k2) { const int ks = kc * 16 + k2;
                const u32x4 xh = xv[k2];
                const u32x4 gq = *(const LAS u32x4*)(gml + ks * 32 + kq * 8), sq = *(const LAS u32x4*)(shl + ks * 32 + kq * 8);
                float h[8];
                h[0] = bflo(xh.x) * rn * bflo(gq.x) + bflo(sq.x); h[1] = bfhi(xh.x) * rn * bfhi(gq.x) + bfhi(sq.x); h[2] = bflo(xh.y) * rn * bflo(gq.y) + bflo(sq.y); h[3] = bfhi(xh.y) * rn * bfhi(gq.y) + bfhi(sq.y);
                h[4] = bflo(xh.z) * rn * bflo(gq.z) + bflo(sq.z); h[5] = bfhi(xh.z) * rn * bfhi(gq.z) + bfhi(sq.z); h[6] = bflo(xh.w) * rn * bflo(gq.w) + bflo(sq.w); h[7] = bfhi(xh.w) * rn * bfhi(gq.w) + bfhi(sq.w);
#pragma unroll
                for (int i = 0; i < 8; ++i) h[i] = __builtin_amdgcn_fmed3f(h[i], -448.f, 448.f);
                u32x2 o; o.x = pk_fp8x4(h[0], h[1], h[2], h[3]); o.y = pk_fp8x4(h[4], h[5], h[6], h[7]);
                *(u32x2*)(hr + ks * 32) = o;
            } }
        }
        seg_beg = seg_end;
    }
    __syncthreads();
    if (tid < 32) lbase[tid] = atomicAdd(&CNT[tid], lcnt[tid]);
    __syncthreads();
    for (int i = tid; i < (tend - tbeg) * 4; i += 512) { const unsigned rec = lrec[i]; const int e = rec & 255, pos = rec >> 8;
        u32x2 ent; ent.x = (unsigned)(tbeg * 4 + i); ent.y = __float_as_uint(lwt[i]);
        *(u32x2*)(LIST + ((size_t)e * TT + lbase[e] + pos) * 2) = ent; }
    __syncthreads();
}

DI void moe_tiles(const Params& p, LAS int* tstart, int l, const int wv_) {
    const int* CNT = (const int*)(p.ws + WS_CNT) + l * 32;
    if (otid() == 0) { int s = 0; for (int e = 0; e < 32; ++e) { tstart[e] = s; s += (CNT[e] + 255) >> 8; } tstart[32] = s; }
    __syncthreads();
    LAS int* ttab = (LAS int*)((LAS char*)tstart - (LDS_MISC + 64) + LDS_TTAB);
    const int MT_ = tstart[32];
    for (int mt = otid(); mt < MT_; mt += 512) { int e = 0;
#pragma unroll
        for (int i = 1; i < 32; ++i) e += (mt >= tstart[i]) ? 1 : 0;
        ttab[mt] = e | ((mt - tstart[e]) << 8); }
    __syncthreads();
}
DI int moe_find(const LAS int* tstart, int mt) { const LAS int* ttab = (const LAS int*)((const LAS char*)tstart - (LDS_MISC + 64) + LDS_TTAB); return __builtin_amdgcn_readfirstlane(ttab[mt]); }
struct PvMoe1 {
    const Params& p; int l; const LAS int* tstart; LAS char* tbl;
    static constexpr int NT = 8; static constexpr int FP8 = 2; static constexpr bool PARK = false; typedef ASimple AS; typedef BSimple BS;
    XcdDeal<4, 8> deal;
    DI int first() const { return deal.first(); }
    DI int next(int u) const { return deal.next(u); }
    typedef u32x4 Aux;
    DI void top(int u, Aux& aux, const int wv_) const {
        int mt, n8; deal.decode(u, mt, n8);
        const int ev_ = moe_find(tstart, mt); const int e = ev_ & 255;
        const int t_ = otid() & 63;
        aux = aload128(p.exp_b_in + (size_t)(l * NE + e) * 2048 + (t_ < 32 ? n8 * 128 + t_ * 4 : 1024 + n8 * 128 + (t_ - 32) * 4));
    }
    DI void mid(Aux& aux, const int wv_) const { const int t_ = otid(); asm volatile("" : "+v"(aux)); if (t_ < 64) *(LAS u32x4*)(tbl + t_ * 16) = aux; }
    DI void fix(AS& as, bool wait, const int wv_) const {
        if (wait) asm volatile("s_waitcnt vmcnt(0)" ::: "memory");
        int R[2], C[2]; stage_coords(R, C, wv_);
#pragma unroll
        for (int h = 0; h < 2; ++h)
#pragma unroll
            for (int i = 0; i < 2; ++i) { unsigned sl = as.off[h][i]; asm volatile("" : "+v"(sl)); as.off[h][i] = (sl >> 2) * 1024u + (unsigned)(C[i] * 2); }
    }
    DI void src(int u, AS& as, BS& bs, const int wv_) const {
        int mt, n8; deal.decode(u, mt, n8);
        const int ev_ = moe_find(tstart, mt); const int e = ev_ & 255;
        const int r0 = (ev_ >> 8) * 256, cnt = ((const int*)(p.ws + WS_CNT))[l * 32 + e];
        const int* lst = (const int*)(p.ws + WS_LIST) + (size_t)e * TT * 2;
        int R[2], C[2]; stage_coords(R, C, wv_);
        as.base = (const char*)(p.ws + WS_H); as.kstride = 128;
#pragma unroll
        for (int h = 0; h < 2; ++h)
#pragma unroll
            for (int i = 0; i < 2; ++i) as.off[h][i] = aload32(lst + 2 * min(r0 + h * 128 + R[i], cnt - 1));
        const char* W = (const char*)(p.ws + WS_W1) + (size_t)(l * NE + e) * 2048 * 1024;
        bs.base[0] = W + (size_t)(n8 * 128) * 1024; bs.base[1] = W + (size_t)(1024 + n8 * 128) * 1024; bs.ldb2 = 1024;
    }
    DI void epi(f32x4 (&acc)[2][2][4][2], int u, const int wv_) const {
        int mt, n8; deal.decode(u, mt, n8);
        const int ev_ = moe_find(tstart, mt); const int e = ev_ & 255;
        unsigned char* ACT = (unsigned char*)(p.ws + WS_RA);
        const int _tz = otid(), _w = _tz >> 6, _l = _tz & 63, _wr = _w >> 2, _wc = _w & 3, _fr = _l & 15, _fq = _l >> 4;
        const LAS float* bin = (const LAS float*)tbl + _wc * 32 + _fq * 8;
        f32x4 bg[2], bu[2];
#pragma unroll
        for (int n = 0; n < 2; ++n) { bg[n] = *(const LAS f32x4*)(bin + n * 4) * SWI_A; bu[n] = (*(const LAS f32x4*)(bin + 128 + n * 4) + 1.f) * (1.f / SWI_A); }
        (void)e;
#pragma unroll
        for (int ai = 0; ai < 2; ++ai)
#pragma unroll
            for (int m = 0; m < 4; ++m) { const int lr = ai * 128 + _wr * 64 + m * 16 + _fr;
                unsigned char* orow = ACT + ((size_t)mt * 256 + lr) * 1024 + n8 * 128 + _wc * 32 + _fq * 8;
                u32x2 pk;
#pragma unroll
                for (int n = 0; n < 2; ++n) {
                    float o[4];
#pragma unroll
                    for (int h2 = 0; h2 < 2; ++h2) {
                        const f32v2_t ag = {acc[ai][0][m][n][2 * h2], acc[ai][0][m][n][2 * h2 + 1]}, au = {acc[ai][1][m][n][2 * h2], acc[ai][1][m][n][2 * h2 + 1]};
                        const f32v2_t bgv = {bg[n][2 * h2], bg[n][2 * h2 + 1]}, buv = {bu[n][2 * h2], bu[n][2 * h2 + 1]};
                        f32v2_t g2 = ag * (1.f / 256.f) + bgv, u2 = au * (1.f / 256.f) + buv;
                        g2[0] = fminf(g2[0], 7.f * SWI_A); g2[1] = fminf(g2[1], 7.f * SWI_A);
                        u2[0] = __builtin_amdgcn_fmed3f(u2[0], -6.f / SWI_A, 8.f / SWI_A); u2[1] = __builtin_amdgcn_fmed3f(u2[1], -6.f / SWI_A, 8.f / SWI_A);
                        f32v2_t e2; e2[0] = __builtin_amdgcn_exp2f(-g2[0]); e2[1] = __builtin_amdgcn_exp2f(-g2[1]);
                        const f32v2_t d2 = e2 + 1.f;
                        f32v2_t r2; r2[0] = __builtin_amdgcn_rcpf(d2[0]); r2[1] = __builtin_amdgcn_rcpf(d2[1]);
                        const f32v2_t o2 = u2 * g2 * r2;
                        o[2 * h2] = o2[0]; o[2 * h2 + 1] = o2[1]; }
                    if (n == 0) pk.x = pk_fp8x4(o[0], o[1], o[2], o[3]); else pk.y = pk_fp8x4(o[0], o[1], o[2], o[3]); }
                *(u32x2*)orow = pk; }
    }
};
DI void phase_moe1(const Params& p, LAS char* shm, int l, const int wv_) {
    LAS int* tstart = (LAS int*)(shm + LDS_MISC + 64);
    moe_tiles(p, tstart, l, wv_);
    PvMoe1 pv{p, l, tstart, shm + 131072, {tstart[32]}}; gemm_stream(shm, pv, wv_);
}
struct PvMoe2 {
    const Params& p; int l; const LAS int* tstart; LAS char* tbl;
    static constexpr int NT = 8; static constexpr int FP8 = 2; static constexpr bool PARK = false; typedef APlain AS; typedef BSeq16 BS;
    XcdDeal<4, 4> deal;
    DI int first() const { return deal.first(); }
    DI int next(int u) const { return deal.next(u); }
    template <class A_> DI void fix(A_&, bool, const int) const {}
    typedef u32x4 Aux;
    DI void top(int u, Aux& aux, const int wv_) const {
        int mt, n4; deal.decode(u, mt, n4);
        const int ev_ = moe_find(tstart, mt); const int e = ev_ & 255; const int r0 = (ev_ >> 8) * 256;
        const int t_ = otid();
        const char* src_ = t_ < 128 ? (const char*)((const int*)(p.ws + WS_LIST) + (size_t)e * TT * 2 + (size_t)(r0 + 2 * t_) * 2)
                                    : (const char*)(p.exp_b_out + (size_t)(l * NE + e) * 1024 + n4 * 256 + ((t_ - 128) & 63) * 4);
        aux = aload128(src_);
    }
    DI void mid(Aux& aux, const int wv_) const { const int t_ = otid(); asm volatile("" : "+v"(aux)); if (t_ < 192) *(LAS u32x4*)(tbl + t_ * 16) = aux; }
    DI void src(int u, AS& as, BS& bs, const int wv_) const {
        int mt, n4; deal.decode(u, mt, n4);
        const int ev_ = moe_find(tstart, mt); const int e = ev_ & 255;
        as.base = (const char*)(p.ws + WS_RA) + (size_t)mt * 256 * 1024; as.lda2 = 1024;
        const char* W = (const char*)(p.ws + WS_W2) + (size_t)(l * NE + e) * 1024 * 1024;
        bs.base = W + (size_t)(n4 * 256) * 1024; bs.ldb2 = 1024;
    }
    DI void epi(f32x4 (&acc)[2][2][4][2], int u, const int wv_) const {
        int mt, n4; deal.decode(u, mt, n4);
        const int ev_ = moe_find(tstart, mt); const int e = ev_ & 255;
        const int r0 = (ev_ >> 8) * 256, cnt = ((const int*)(p.ws + WS_CNT))[l * 32 + e];
        const int* lst = (const int*)(p.ws + WS_LIST) + (size_t)e * TT * 2;
        unsigned char* Y = (unsigned char*)(p.ws + WS_RY);
        const int _tz = otid(), _w = _tz >> 6, _l = _tz & 63, _wr = _w >> 2, _wc = _w & 3, _fr = _l & 15, _fq = _l >> 4;
        const LAS float* bo = (const LAS float*)(tbl + 2048) + _wc * 64 + _fq * 16;
        u32x2 ent[2][4]; f32x4 bv[2][2];
#pragma unroll
        for (int ai = 0; ai < 2; ++ai)
#pragma unroll
            for (int m = 0; m < 4; ++m) ent[ai][m] = *(const LAS u32x2*)(tbl + (ai * 128 + _wr * 64 + m * 16 + _fr) * 8);
#pragma unroll
        for (int bj = 0; bj < 2; ++bj)
#pragma unroll
            for (int n = 0; n < 2; ++n) bv[bj][n] = *(const LAS f32x4*)(bo + bj * 8 + n * 4);
        (void)lst;
#pragma unroll
        for (int ai = 0; ai < 2; ++ai)
#pragma unroll
            for (int m = 0; m < 4; ++m) { const int lr = r0 + ai * 128 + _wr * 64 + m * 16 + _fr;
                if (lr < cnt) { const float w = __uint_as_float(ent[ai][m].y) * YSCALE; unsigned char* orow = Y + (size_t)ent[ai][m].x * 1024 + n4 * 256 + _wc * 64 + _fq * 16;
                    const float sc_ = 1.f / 256.f;
                    u32x4 pk;
#pragma unroll
                    for (int bj = 0; bj < 2; ++bj)
#pragma unroll
                        for (int n = 0; n < 2; ++n) { const f32x4 v = (acc[ai][bj][m][n] * sc_ + bv[bj][n]) * w;
                            pk[bj * 2 + n] = pk_fp8x4(__builtin_amdgcn_fmed3f(v[0], -448.f, 448.f), __builtin_amdgcn_fmed3f(v[1], -448.f, 448.f), __builtin_amdgcn_fmed3f(v[2], -448.f, 448.f), __builtin_amdgcn_fmed3f(v[3], -448.f, 448.f)); }
                    *(u32x4*)orow = pk; } }
    }
};
DI void phase_moe2(const Params& p, LAS char* shm, int l, const int wv_) {
    LAS int* tstart = (LAS int*)(shm + LDS_MISC + 64);
    moe_tiles(p, tstart, l, wv_);
    PvMoe2 pv{p, l, tstart, shm + 131072, {tstart[32]}}; gemm_stream(shm, pv, wv_);
}

DI void phase_combine(const Params& p, LAS char* shm, int l, const int wv_) {
    const int tid = otid(), wid = tid >> 6, lane = tid & 63;
    const bool alt = p.ph_lo != 0;
    const bf16_t* X = (const bf16_t*)(p.ws + WS_X);
    bf16_t* XO = alt ? (bf16_t*)(p.ws + WS_RA) : (bf16_t*)(p.ws + WS_X);
    float* OUT = alt ? (float*)(p.ws + WS_RA) : p.out;
    const unsigned char* Y = (const unsigned char*)(p.ws + WS_RY);
    const float* MOD = (const float*)(p.ws + WS_MOD);
    bf16_t* H = alt ? (bf16_t*)(p.ws + WS_RA + (size_t)TT * 1024 * 4) : (bf16_t*)(p.ws + WS_H);
    const int Tm = (l == 1) ? TX : TT;
    for (int r = blockIdx.x * 8 + wid; r < Tm; r += gridDim.x * 8) {
        const float* g2 = MOD + (size_t)(l * 33 + mod_row(r)) * 6144 + 5120;
        float v[16];
#pragma unroll
        for (int j = 0; j < 4; ++j) {
            const int col = j * 256 + lane * 4;
            f32x4 s = (f32x4){0.f, 0.f, 0.f, 0.f};
#pragma unroll
            for (int k = 0; k < 4; ++k) { const int yy = *(const int*)(Y + ((size_t)r * 4 + k) * 1024 + col); const f32v2_t ya = __builtin_amdgcn_cvt_pk_f32_fp8(yy, false), yb = __builtin_amdgcn_cvt_pk_f32_fp8(yy, true);
                s[0] += ya[0]; s[1] += ya[1]; s[2] += yb[0]; s[3] += yb[1]; }
            s *= 1.f / YSCALE;
            const u32x2 xb_ = *(const u32x2*)(X + (size_t)r * 1024 + col); const f32x4 gg = *(const f32x4*)(g2 + col);
            const f32x4 xv = (f32x4){bflo(xb_.x), bfhi(xb_.x), bflo(xb_.y), bfhi(xb_.y)};
            const f32x4 o = xv + gg * s;
            if (l == 1) *(f32x4*)(OUT + (size_t)r * 1024 + col) = o; else store_bf16x4(XO + (size_t)r * 1024 + col, o[0], o[1], o[2], o[3]);
            v[j * 4] = o[0]; v[j * 4 + 1] = o[1]; v[j * 4 + 2] = o[2]; v[j * 4 + 3] = o[3];
        }
        if (l == 0) norm_mod_store(v, p.norm1_g + 1024, MOD + (size_t)(1 * 33 + mod_row(r)) * 6144, H + (size_t)r * 1024, wv_);
    }
}

constexpr int NPH_LAYER = 10;
constexpr int NPH = 2 + 2 * NPH_LAYER;

__global__ void __launch_bounds__(512, 2) mk_forward(Params p_unused) {
    extern __shared__ __attribute__((aligned(16))) char smem_raw[];
    LAS char* shm = (LAS char*)smem_raw;
    volatile LAS unsigned* xb_words = (volatile LAS unsigned*)(shm + LDS_MISC);
    const int wv_ = __builtin_amdgcn_readfirstlane((int)(threadIdx.x >> 6));
    if (wv_ == 0 && olane() < 4) xb_words[olane()] = 0u;
    __syncthreads();
    kaptr_t ka = (kaptr_t)__builtin_amdgcn_kernarg_segment_ptr();
    const int tok0 = ptoken();
    const int lo = (int)kld64<__builtin_offsetof(Params, ph_lo)>(ka, tok0), hi = (int)kld64<__builtin_offsetof(Params, ph_hi)>(ka, tok0);
    const bool multi = (hi - lo) > 1;
    unsigned* barw = (unsigned*)((__attribute__((address_space(1))) char*)kld64<__builtin_offsetof(Params, ws)>(ka, tok0) + WS_BAR);
    XcdBarrier bar; bar.bar = barw; bar.x = 0; bar.st = xb_words;
    if (multi) bar = xcd_barrier_post(barw, xb_words, wv_);
#ifndef ONLY_KIND
#define ONLY_KIND (-1)
#endif
#define PHASE(idx, kind, FN, ...) do { if ((ONLY_KIND < 0 || ONLY_KIND == (kind)) && (idx) >= lo && (idx) < hi) { const Params p = kparams(ka, ptoken()); int nrep_ = 1 + ((MK_REPEAT_MASK >> (kind)) & 1); asm volatile("" : "+s"(nrep_)); for (int rep_ = 0; rep_ < nrep_; ++rep_) { Params p2 = p; p2.ph_lo = rep_; FN(p2, ##__VA_ARGS__, wv_); } if ((idx) + 1 < hi) xcd_barrier(bar, wv_); } } while (0)
    PHASE(0, 0, phase_prologue, shm);
    PHASE(1, 1, phase_norm1_l0);
    for (int l = 0; l < 2; ++l) {
        const int b0 = 2 + l * NPH_LAYER;
        PHASE(b0 + 0, 2, phase_inproj, shm, l);
        PHASE(b0 + 1, 3, phase_A, shm, l);
        PHASE(b0 + 2, 4, phase_B, shm, l);
        PHASE(b0 + 3, 5, phase_C, shm, l);
        PHASE(b0 + 4, 6, phase_D, shm, l);
        PHASE(b0 + 5, 7, phase_E, shm, l);
        PHASE(b0 + 6, 8, phase_router, shm, l);
        PHASE(b0 + 7, 9, phase_moe1, shm, l);
        PHASE(b0 + 8, 10, phase_moe2, shm, l);
        PHASE(b0 + 9, 11, phase_combine, shm, l);
    }
#undef PHASE
}


extern "C" void kernel_launch(void* const* d_in, const int* in_sizes, int n_in, void* d_out, int out_size, void* d_ws, size_t ws_size, hipStream_t stream) {
    static int grid = 0;
    if (grid == 0) {
        if (n_in != 39 || ws_size < WS_END) { fprintf(stderr, "kernel_launch: unexpected n_in %d or ws_size %zu (< %zu)\n", n_in, ws_size, (size_t)WS_END); grid = -1; return; }
        int dev = 0, cus = 0;
        if (hipGetDevice(&dev) != hipSuccess || hipDeviceGetAttribute(&cus, hipDeviceAttributeMultiprocessorCount, dev) != hipSuccess) { grid = -1; return; }
        if (hipFuncSetAttribute((const void*)mk_forward, hipFuncAttributeMaxDynamicSharedMemorySize, LDS_BYTES) != hipSuccess) { fprintf(stderr, "kernel_launch: hipFuncSetAttribute failed\n"); grid = -1; return; }
        int per_cu = 0;
        if (hipOccupancyMaxActiveBlocksPerMultiprocessor(&per_cu, (const void*)mk_forward, 512, LDS_BYTES) != hipSuccess || per_cu < 1) fprintf(stderr, "kernel_launch: occupancy query says %d\n", per_cu);
        (void)hipGetLastError();
        grid = cus > 256 ? 256 : cus;
    }
    if (grid < 0) return;
    (void)hipMemsetAsync((char*)d_ws + WS_BAR, 0, 16384 + 1024, stream);
    Params p{};
    const float** pf = (const float**)&p;
    for (int i = 0; i < 39; ++i) pf[i] = (const float*)d_in[i];
    p.out = (float*)d_out; p.ws = (char*)d_ws;
#if MK_ONE_LAUNCH
    p.ph_lo = 0; p.ph_hi = NPH;
    hipLaunchKernelGGL(mk_forward, dim3(grid), dim3(512), LDS_BYTES, stream, p);
#else
#ifndef MK_LAST_PHASE
#define MK_LAST_PHASE NPH
#endif
    for (int ph = 0; ph < MK_LAST_PHASE; ++ph) { p.ph_lo = ph; p.ph_hi = ph + 1; hipLaunchKernelGGL(mk_forward, dim3(grid), dim3(512), LDS_BYTES, stream, p); }
#endif
}
```

```cpp
#include <hip/hip_runtime.h>
#include <stdint.h>
#include <stdio.h>

#ifndef MK_REPEAT_MASK
#define MK_REPEAT_MASK 0x0
#endif
#ifndef MK_ONE_LAUNCH
#define MK_ONE_LAUNCH 1
#endif

#define DI __device__ __forceinline__
#define LAS __attribute__((address_space(3)))
typedef unsigned short bf16_t;
typedef short bf16x8 __attribute__((ext_vector_type(8)));
typedef short s16x4 __attribute__((ext_vector_type(4)));
typedef float f32x4 __attribute__((ext_vector_type(4)));
typedef float f32x16 __attribute__((ext_vector_type(16)));
typedef unsigned u32x2 __attribute__((ext_vector_type(2)));
typedef unsigned u32x4 __attribute__((ext_vector_type(4)));
typedef int i32x4 __attribute__((ext_vector_type(4)));
typedef int i32x8 __attribute__((ext_vector_type(8)));

constexpr int D = 1024, NB = 32, SEQ = 2048, CTXL = 256;
constexpr int TX = NB * SEQ, TC = NB * CTXL, TT = TX + TC;
constexpr int NINP = 1536;
constexpr int OFF_POOL = 512, OFF_Q = 768, OFF_SSM = 960, OFF_KV = 1216, OFF_KPE = 1344, N_IN = 1376;
constexpr int NE = 32;
constexpr int NCH = 36;
constexpr int NCROW = NB * NCH;
constexpr float EPS = 1e-6f;

constexpr size_t WS_BAR = 0;
constexpr size_t WS_CNT = 16384;
constexpr size_t WS_MOD = WS_CNT + 1024;
constexpr size_t WS_A64 = WS_MOD + (size_t)2 * 33 * 6144 * 4;
constexpr size_t WS_WMI = WS_A64 + (size_t)2 * 2 * 16 * 64 * 2 * 4;
constexpr size_t WS_WMO = WS_WMI + (size_t)2 * 1536 * 1024 * 2;
constexpr size_t WS_WPW = WS_WMO + (size_t)2 * 1024 * 1024 * 2;
constexpr size_t WS_WGLU = WS_WPW + (size_t)2 * 256 * 256 * 2;
constexpr size_t WS_WPOOL = WS_WGLU + (size_t)2 * 256 * 256 * 2;
constexpr size_t WS_WQ = WS_WPOOL + (size_t)2 * 256 * 256 * 2;
constexpr size_t WS_WKV = WS_WQ + (size_t)2 * 512 * 256 * 2;
constexpr size_t WS_TS5 = WS_WKV + (size_t)2 * 512 * 256 * 2;
constexpr size_t WS_WS5 = WS_TS5 + (size_t)2 * 16 * 1024 * 1280 * 2;
constexpr size_t WS_W1 = WS_WS5 + (size_t)2 * 16 * 256 * 1024 * 2;
constexpr size_t WS_W2 = WS_W1 + (size_t)32 * 2048 * 1024 * 2;
constexpr size_t WS_X = WS_W2 + (size_t)32 * 1024 * 1024 * 2;
constexpr size_t WS_H = WS_X + (size_t)TT * 1024 * 4;
constexpr size_t WS_LIST = WS_H + (size_t)TT * 1024 * 2;
constexpr size_t WS_TOPW = WS_LIST + (size_t)32 * TT * 8;
constexpr size_t WS_RA = WS_TOPW + (size_t)TT * 4 * 4;
constexpr float YSCALE = 32.f;
constexpr size_t WS_RY = WS_RA + (size_t)TT * 4 * 1024 * 2;
constexpr size_t WS_END = WS_RY + (size_t)TT * 4 * 1024 * 2;
constexpr size_t WS_P = WS_RA;
constexpr size_t WS_ACONV = WS_P + (size_t)TT * NINP * 2;
constexpr size_t WS_APOOL = WS_ACONV + (size_t)TT * 256 * 2;
constexpr size_t WS_RAWQ = WS_APOOL + (size_t)TT * 256 * 2;
constexpr size_t WS_RAWKV = WS_RAWQ + (size_t)TT * 512 * 4;
constexpr size_t WS_Q = WS_RAWKV + (size_t)TT * 512 * 4;
constexpr size_t WS_KB = WS_Q + (size_t)TT * 384 * 2;
constexpr size_t WS_VT = WS_KB + (size_t)128 * 2304 * 96 * 2;
constexpr size_t WS_SST = WS_VT + (size_t)128 * 64 * 2304 * 2;
constexpr size_t WS_HIN = WS_SST + (size_t)NCROW * 16 * 256 * 4;
constexpr size_t WS_Z = WS_HIN + (size_t)NCROW * 16 * 256 * 2;
constexpr size_t WS_CAT = WS_Z + (size_t)TT * 256 * 2;
constexpr size_t WS_MIX_END = WS_CAT + (size_t)TT * 1024 * 2;
static_assert(WS_MIX_END <= WS_END, "mixer buffers must fit in the ACT/Y regions");
static_assert(WS_END <= (size_t)2147483648ull, "workspace budget");

constexpr int LDS_BYTES = 147456;
constexpr int LDS_TTAB = 131072 + 4096;
constexpr int LDS_MISC = 146432;

struct Params {
    const float *x, *c, *ctx, *c_ctx, *ada_w, *ada_b, *norm1_g, *norm2_g, *w_mix_in, *w_mix_out,
        *conv_dw, *conv_dw_b, *conv_ln_g, *conv_ln_b, *conv_pw, *pool_w, *pool_scale,
        *ssm_a_re, *ssm_a_im, *ssm_log_dt, *ssm_b_re, *ssm_b_im, *ssm_c_re, *ssm_c_im, *ssm_d, *ssm_glu_w, *ssm_glu_b,
        *mla_q_a_g, *mla_wq_b, *mla_kv_a_g, *mla_wkv_b, *mla_q_g, *mla_k_g,
        *router_w, *router_b, *exp_w_in, *exp_b_in, *exp_w_out, *exp_b_out;
    float* out;
    char* ws;
    long long ph_lo, ph_hi;
};

typedef const __attribute__((address_space(4))) char* kaptr_t;
template <int OFF> DI unsigned long long kld64(kaptr_t ka, int tok) {
    unsigned long long v;
    asm("s_load_dwordx2 %0, %1, %3\n\ts_waitcnt lgkmcnt(0)" : "=&s"(v) : "s"(ka), "s"(tok), "n"(OFF));
    return v;
}
DI int ptoken() { int t; asm volatile("s_mov_b32 %0, 0" : "=s"(t)); return t; }
DI Params kparams(kaptr_t ka, int tok) {
    Params p;
#define KL_(f) p.f = (decltype(p.f))((__attribute__((address_space(1))) char*)kld64<__builtin_offsetof(Params, f)>(ka, tok))
    KL_(x); KL_(c); KL_(ctx); KL_(c_ctx); KL_(ada_w); KL_(ada_b); KL_(norm1_g); KL_(norm2_g); KL_(w_mix_in); KL_(w_mix_out); KL_(conv_dw); KL_(conv_dw_b); KL_(conv_ln_g); KL_(conv_ln_b); KL_(conv_pw); KL_(pool_w); KL_(pool_scale); KL_(ssm_a_re); KL_(ssm_a_im); KL_(ssm_log_dt); KL_(ssm_b_re); KL_(ssm_b_im); KL_(ssm_c_re); KL_(ssm_c_im); KL_(ssm_d); KL_(ssm_glu_w); KL_(ssm_glu_b); KL_(mla_q_a_g); KL_(mla_wq_b); KL_(mla_kv_a_g); KL_(mla_wkv_b); KL_(mla_q_g); KL_(mla_k_g); KL_(router_w); KL_(router_b); KL_(exp_w_in); KL_(exp_b_in); KL_(exp_w_out); KL_(exp_b_out); KL_(out); KL_(ws);
#undef KL_
    p.ph_lo = 0; p.ph_hi = 0;
    return p;
}

typedef __bf16 bf16v2_t __attribute__((ext_vector_type(2)));
typedef float f32v2_t __attribute__((ext_vector_type(2)));
DI unsigned pk_bf16(float lo, float hi) { const f32v2_t f = {lo, hi}; const bf16v2_t b = __builtin_convertvector(f, bf16v2_t); return __builtin_bit_cast(unsigned, b); }
DI bf16_t f2bf(float x) { return (bf16_t)(pk_bf16(x, 0.f) & 0xffffu); }
DI float bf2f(bf16_t v) { return __uint_as_float(((unsigned)v) << 16); }
DI unsigned f2fp8(float x) { x = fminf(fmaxf(x, -448.f), 448.f); return (unsigned)__builtin_amdgcn_cvt_pk_fp8_f32(x, x, 0, false) & 0xffu; }
DI unsigned pk_fp8x4(float a, float b, float c, float d) { int v = __builtin_amdgcn_cvt_pk_fp8_f32(a, b, 0, false); v = __builtin_amdgcn_cvt_pk_fp8_f32(c, d, v, true); return (unsigned)v; }
DI float bflo(unsigned u) { return __uint_as_float(u << 16); }
DI float bfhi(unsigned u) { return __uint_as_float(u & 0xffff0000u); }
DI int olane() { int l = (int)__builtin_amdgcn_mbcnt_hi(~0u, __builtin_amdgcn_mbcnt_lo(~0u, 0u)); asm volatile("" : "+v"(l)); return l; }
DI float shx(float v, int o) { const int l = olane(); return __int_as_float(__builtin_amdgcn_ds_bpermute((l ^ o) << 2, __float_as_int(v))); }
DI float shi(float v, int src) { return __int_as_float(__builtin_amdgcn_ds_bpermute(src << 2, __float_as_int(v))); }
#define otid() otid_(wv_)
DI int otid_(int wv) { int t = (wv << 6) | olane(); asm volatile("" : "+v"(t)); return t; }
DI float wave_sum(float v) {
#pragma unroll
    for (int o = 32; o > 0; o >>= 1) v += shx(v, o);
    return v;
}
DI float wave_max(float v) {
#pragma unroll
    for (int o = 32; o > 0; o >>= 1) v = fmaxf(v, shx(v, o));
    return v;
}
DI float sigmoidf_(float x) { return __builtin_amdgcn_rcpf(1.f + __builtin_amdgcn_exp2f(-1.4426950408889634f * x)); }
DI float siluf_(float x) { return x * sigmoidf_(x); }
DI float gelu_tanh(float x) {
    const float u = 0.7978845608028654f * (x + 0.044715f * x * x * x);
    return x * __builtin_amdgcn_rcpf(1.f + __builtin_amdgcn_exp2f(-2.8853900817779268f * u));
}
DI unsigned aload32(const void* p_) { unsigned r; asm volatile("global_load_dword %0, %1, off" : "=v"(r) : "v"(p_) : "memory"); return r; }
DI u32x4 aload128(const void* p_) { u32x4 r; asm volatile("global_load_dwordx4 %0, %1, off" : "=v"(r) : "v"(p_) : "memory"); return r; }
#define PV_NOHOOKS typedef int Aux; DI void top(int, Aux&, const int) const {} DI void mid(Aux&, const int) const {} template <class A_> DI void fix(A_&, bool, const int) const {}
DI void glds16(const void* src, LAS char* dst) {
    __builtin_amdgcn_global_load_lds((const __attribute__((address_space(1))) void*)src, (LAS void*)dst, 16, 0, 0);
}

#define XB_TMO      128
#define XB_XCNT(j)  (256  + 64 * (j))
#define XB_XSUB(j)  (1280 + 64 * (j))
#define XB_XGEN(j)  (2304 + 64 * (j))
#define XB_TOP      3328
#define XB_TOPGEN   3392
#define XCD_BAR_WORDS 3456
#define XB_SPIN_CAP (1u << 18)
__device__ __forceinline__ unsigned xb_ld(unsigned* p)              { return __hip_atomic_load(p, __ATOMIC_RELAXED, __HIP_MEMORY_SCOPE_AGENT); }
__device__ __forceinline__ unsigned xb_add(unsigned* p, unsigned v) { return __hip_atomic_fetch_add(p, v, __ATOMIC_RELAXED, __HIP_MEMORY_SCOPE_AGENT); }
__device__ __forceinline__ unsigned xb_xcc_id() { return (unsigned)__builtin_amdgcn_s_getreg((3 << 11) | 20) & 0xFu; }
#define XB_SPIN(cond, bar) do { unsigned _sp = 0; while (cond) { __builtin_amdgcn_s_sleep(1); \
    if ((++_sp & 255u) == 0u) { if (xb_ld(&(bar)[XB_TMO])) break; if (_sp > XB_SPIN_CAP) { atomicAdd(&(bar)[XB_TMO], 1u); break; } } } } while (0)
struct XcdBarrier { unsigned* bar; unsigned x; volatile LAS unsigned* st; };
__device__ __forceinline__ XcdBarrier xcd_barrier_post(unsigned* bar, volatile LAS unsigned* st, const int wv_) {
    XcdBarrier b; b.bar = bar; b.x = xb_xcc_id(); b.st = st;
    if (otid() == 0) (void)xb_add(&bar[XB_XCNT(b.x)], 1u);
    return b;
}
__device__ __forceinline__ void xcd_barrier_complete(unsigned* bar, unsigned x, unsigned& nloc, unsigned& nx) {
    const unsigned G = gridDim.x * gridDim.y * gridDim.z;
    unsigned sum, cnt, mine, sp = 0u;
    for (;;) {
        sum = 0u; cnt = 0u; mine = 0u;
#pragma unroll
        for (unsigned j = 0; j < 16; ++j) { const unsigned c = xb_ld(&bar[XB_XCNT(j)]); sum += c; cnt += (c > 0u) ? 1u : 0u; mine = (j == x) ? c : mine; }
        if (sum == G) break;
        __builtin_amdgcn_s_sleep(1);
        if ((++sp & 255u) == 0u) { if (xb_ld(&bar[XB_TMO])) break; if (sp > XB_SPIN_CAP) { atomicAdd(&bar[XB_TMO], 1u); break; } }
    }
    nloc = mine > 0u ? mine : 1u; nx = cnt > 0u ? cnt : 1u;
}
__device__ __forceinline__ void xcd_barrier(const XcdBarrier& b, const int wv_) {
    asm volatile("s_waitcnt vmcnt(0)" ::: "memory");
    __syncthreads();
    if (otid() == 0) {
        unsigned* bar = b.bar;
        __builtin_amdgcn_s_waitcnt(0);
        unsigned nloc = b.st[0], nx = b.st[1];
        if (nloc == 0u) { xcd_barrier_complete(bar, b.x, nloc, nx); b.st[0] = nloc; b.st[1] = nx; }
        const unsigned old = xb_add(&bar[XB_XSUB(b.x)], 1u);
        const unsigned gen = old / nloc;
        if (old + 1u == (gen + 1u) * nloc) {
            __builtin_amdgcn_fence(__ATOMIC_RELEASE, "agent");
            asm volatile("s_waitcnt vmcnt(0)" ::: "memory");
            const unsigned og = xb_add(&bar[XB_TOP], 1u);
            const unsigned tg = og / nx;
            if (og + 1u == (tg + 1u) * nx) xb_add(&bar[XB_TOPGEN], 1u);
            else XB_SPIN(xb_ld(&bar[XB_TOPGEN]) == tg, bar);
            __builtin_amdgcn_fence(__ATOMIC_ACQUIRE, "agent");
            xb_add(&bar[XB_XGEN(b.x)], 1u);
            asm volatile("s_waitcnt vmcnt(0)" ::: "memory");
        } else {
            XB_SPIN(xb_ld(&bar[XB_XGEN(b.x)]) == gen, bar);
            __builtin_amdgcn_fence(__ATOMIC_ACQUIRE, "agent");
            asm volatile("s_waitcnt vmcnt(0)" ::: "memory");
        }
    }
    __syncthreads();
}

constexpr int HTB = 128 * 64 * 2;
DI int lds_byte(int r, int c) { const int st = (r >> 4) * 2 + (c >> 5), rr = r & 15, cc = c & 31, ob = rr * 64 + cc * 2; return st * 1024 + (ob ^ (((ob >> 9) & 1) << 5)); }
DI void stage_rc(int b, int& R, int& C) { const int st = b / 1024, sb = b % 1024, swz = sb ^ (((sb >> 9) & 1) << 5); R = (st >> 1) * 16 + swz / 64; C = (st & 1) * 32 + (swz % 64) / 2; }

DI void stage_rc_t(int tz, int i, int& R, int& C) { stage_rc(tz * 16 + i * 8192, R, C); }
struct APlain {
    const char* base; int lda2;
    DI void park(LAS unsigned*) const {} DI void unpark(const LAS unsigned*) {} DI void take_uniform(const APlain&) {}
    DI const char* ptr(int tz, int h, int i, int kt) const { int R, C; stage_rc_t(tz, i, R, C); return base + (unsigned)((h * 128 + R) * lda2 + C * 2 + kt * 128); }
};
struct ASimple {
    const char* base; unsigned off[2][2]; unsigned kstride;
    DI void park(LAS unsigned* q) const { *(LAS u32x4*)q = (u32x4){off[0][0], off[0][1], off[1][0], off[1][1]}; }
    DI void unpark(const LAS unsigned* q) { const u32x4 v = *(const LAS u32x4*)q; off[0][0] = v.x; off[0][1] = v.y; off[1][0] = v.z; off[1][1] = v.w; }
    DI void take_uniform(const ASimple& o) { base = o.base; kstride = o.kstride; }
    DI const char* ptr(int tz, int h, int i, int kt) const { return base + (unsigned)(off[h][i] + (unsigned)kt * kstride); }
};
struct ASeg2 {
    const char* base0; const char* base1; unsigned off0[2][2]; unsigned off1[2][2]; unsigned ks0; int nt0;
    DI void park(LAS unsigned*) const {} DI void unpark(const LAS unsigned*) {} DI void take_uniform(const ASeg2&) {}
    DI const char* ptr(int tz, int h, int i, int kt) const { return kt < nt0 ? base0 + (unsigned)(off0[h][i] + (unsigned)kt * ks0) : base1 + (unsigned)(off1[h][i] + (unsigned)(kt - nt0) * 128u); }
};
DI int perm32(int rho) { const int n = rho >> 4, i = rho & 15; return 8 * (i >> 2) + 4 * n + (i & 3); }
struct BSimple {
    const char* base[2]; int ldb2;
    DI const char* ptr(int tz, int h, int i, int kt) const { int R, C; stage_rc_t(tz, i, R, C); const int Rb = (R & ~31) + perm32(R & 31); return base[h] + (unsigned)(Rb * ldb2 + C * 2 + kt * 128); }
};

struct BSeq16 {
    const char* base; int ldb2;
    DI const char* ptr(int tz, int h, int i, int kt) const { int R, C; stage_rc_t(tz, i, R, C); const int rho = R & 31;
        const int Rb = (R >> 5) * 64 + ((rho & 15) >> 2) * 16 + h * 8 + (rho >> 4) * 4 + (rho & 3); return base + (unsigned)(Rb * ldb2 + C * 2 + kt * 128); }
};

#define WAIT_V(n) asm volatile("s_waitcnt vmcnt(" #n ")" ::: "memory")
#define WAIT_L(n) asm volatile("s_waitcnt lgkmcnt(" #n ")" ::: "memory")
#define BAR_ __builtin_amdgcn_s_barrier()
#define SCHED_ __builtin_amdgcn_sched_barrier(0)

DI void zero_acc(f32x4 (&acc)[2][2][4][2]) {
#pragma unroll
    for (int a = 0; a < 2; ++a)
#pragma unroll
        for (int b = 0; b < 2; ++b)
#pragma unroll
            for (int m = 0; m < 4; ++m)
#pragma unroll
                for (int n = 0; n < 2; ++n) acc[a][b][m][n] = (f32x4){0.f, 0.f, 0.f, 0.f};
}
template <int MODE> struct FragT;
template <> struct FragT<0> {
    i32x4 lo, hi;
    DI void load(const LAS char* p0, const LAS char* p1) { lo = *(const LAS i32x4*)p0; hi = *(const LAS i32x4*)p1; }
    static DI f32x4 mma(const FragT& b, const FragT& a, f32x4 c) {
        c = __builtin_amdgcn_mfma_f32_16x16x32_bf16(__builtin_bit_cast(bf16x8, b.lo), __builtin_bit_cast(bf16x8, a.lo), c, 0, 0, 0);
        return __builtin_amdgcn_mfma_f32_16x16x32_bf16(__builtin_bit_cast(bf16x8, b.hi), __builtin_bit_cast(bf16x8, a.hi), c, 0, 0, 0); }
};
template <> struct FragT<1> {
    i32x4 lo, hi;
    DI void load(const LAS char* p0, const LAS char* p1) { lo = *(const LAS i32x4*)p0; hi = *(const LAS i32x4*)p1; }
    static DI long pk(int x, int y) { return (long)(((unsigned long long)(unsigned)y << 32) | (unsigned)x); }
    static DI f32x4 mma(const FragT& b, const FragT& a, f32x4 c) {
        c = __builtin_amdgcn_mfma_f32_16x16x32_fp8_fp8(pk(b.lo.x, b.lo.y), pk(a.lo.x, a.lo.y), c, 0, 0, 0);
        c = __builtin_amdgcn_mfma_f32_16x16x32_fp8_fp8(pk(b.lo.z, b.lo.w), pk(a.lo.z, a.lo.w), c, 0, 0, 0);
        c = __builtin_amdgcn_mfma_f32_16x16x32_fp8_fp8(pk(b.hi.x, b.hi.y), pk(a.hi.x, a.hi.y), c, 0, 0, 0);
        return __builtin_amdgcn_mfma_f32_16x16x32_fp8_fp8(pk(b.hi.z, b.hi.w), pk(a.hi.z, a.hi.w), c, 0, 0, 0); }
};
template <> struct FragT<2> {
    i32x8 v;
    DI void load(const LAS char* p0, const LAS char* p1) { const i32x4 lo = *(const LAS i32x4*)p0, hi = *(const LAS i32x4*)p1; v = __builtin_shufflevector(lo, hi, 0, 1, 2, 3, 4, 5, 6, 7); }
    static DI f32x4 mma(const FragT& b, const FragT& a, f32x4 c) {
        const int one = 0x7f7f7f7f;
        asm volatile("v_mfma_scale_f32_16x16x128_f8f6f4 %0, %1, %2, %0, %3, %3 op_sel_hi:[0,0,0]" : "+v"(c) : "v"(b.v), "v"(a.v), "v"(one));
        return c; }
};
template <class PV>
DI void gemm_stream(LAS char* shm, const PV& pv, const int wv_) {
    typedef typename PV::AS AS; typedef typename PV::BS BS;
    constexpr int nt = PV::NT;
    int u = pv.first();
    if (u < 0) return;
    const int tz = otid();
    const int wr = wv_ >> 2, wc = wv_ & 3, lane = tz & 63, fr = lane & 15, fq = lane >> 4;
    const int aoff = lds_byte(wr * 64 + fr, fq * 8), boff = lds_byte(wc * 32 + fr, fq * 8);
    const unsigned ldsw = (unsigned)wv_ * 1024u;
    f32x4 acc[2][2][4][2]; zero_acc(acc);
    typedef FragT<PV::FP8> Frag;
    Frag At[4], B0[2], B1[2];
    AS ca, na; BS cb, nb;
    pv.src(u, ca, cb, wv_); pv.fix(ca, true, wv_);
    constexpr bool F8 = PV::FP8 != 0;
    LAS unsigned* park = (LAS unsigned*)(shm + 131072) + tz * 4;
    const int aoff0 = aoff, aoff1 = aoff + 1024;
    const int boff0 = boff, boff1 = boff + 1024;
#define SA_(b, h) (((b) * 2 + (h)) * HTB)
#define SB_(b, h) ((4 + (b) * 2 + (h)) * HTB)
#define STG_(bufoff, S, h, kt) do { _Pragma("unroll") for (int i_ = 0; i_ < 2; ++i_) glds16((S).ptr(tz, h, i_, kt), shm + (bufoff) + ldsw + i_ * 8192); } while (0)
#define LDA_(dst, b, h) do { _Pragma("unroll") for (int m = 0; m < 4; ++m) dst[m].load(shm + SA_(b, h) + aoff0 + m * 2048, shm + SA_(b, h) + aoff1 + m * 2048); } while (0)
#define LDB_(dst, b, h) do { _Pragma("unroll") for (int n = 0; n < 2; ++n) dst[n].load(shm + SB_(b, h) + boff0 + n * 2048, shm + SB_(b, h) + boff1 + n * 2048); } while (0)
#define MMA2_(ai, A_, BA_, BB_) do { __builtin_amdgcn_s_setprio(1); \
        _Pragma("unroll") for (int m = 0; m < 4; ++m) _Pragma("unroll") for (int n = 0; n < 2; ++n) acc[ai][0][m][n] = Frag::mma(BA_[n], A_[m], acc[ai][0][m][n]); \
        _Pragma("unroll") for (int m = 0; m < 4; ++m) _Pragma("unroll") for (int n = 0; n < 2; ++n) acc[ai][1][m][n] = Frag::mma(BB_[n], A_[m], acc[ai][1][m][n]); \
        __builtin_amdgcn_s_setprio(0); } while (0)
#define CMEM_ asm volatile("" ::: "memory")
    STG_(SB_(0, 0), cb, 0, 0); STG_(SB_(0, 1), cb, 1, 0); STG_(SA_(0, 0), ca, 0, 0); STG_(SA_(0, 1), ca, 1, 0);
    WAIT_V(0);
    if (wr == 1) BAR_;
    BAR_; CMEM_;
#define ZQ_(ai, bj) do { _Pragma("unroll") for (int m_ = 0; m_ < 4; ++m_) _Pragma("unroll") for (int n_ = 0; n_ < 2; ++n_) acc[ai][bj][m_][n_] = (f32x4){0.f, 0.f, 0.f, 0.f}; } while (0)
    int un = -1; bool has_next = false;
    na = ca; nb = cb;
    for (;;) {
        typename PV::Aux aux;
#pragma clang loop unroll(disable)
        for (int t = 0; t < nt; t += 2) {
            const bool last = (t == nt - 2);
            if (last && has_next) pv.fix(na, false, wv_);
            AS a2 = last ? na : ca; const BS b2 = last ? nb : cb; const int k2 = last ? 0 : t + 2;
            STG_(SB_(1, 0), cb, 0, t + 1); STG_(SB_(1, 1), cb, 1, t + 1); STG_(SA_(1, 0), ca, 0, t + 1); SCHED_;
            LDB_(B0, 0, 0); LDB_(B1, 0, 1); SCHED_; LDA_(At, 0, 0); SCHED_;
            if (t == 0) { ZQ_(0, 0); ZQ_(0, 1); }
            WAIT_V(6); BAR_; WAIT_L(0); MMA2_(0, At, B0, B1); BAR_; SCHED_; CMEM_;
            if (t == 0) pv.top(u, aux, wv_);
            STG_(SA_(1, 1), ca, 1, t + 1); SCHED_;
            LDA_(At, 0, 1); SCHED_;
            if (t == 0) { ZQ_(1, 0); ZQ_(1, 1); }
            WAIT_V(2); BAR_; WAIT_L(0); if (t == 0) pv.mid(aux, wv_); MMA2_(1, At, B0, B1); BAR_; SCHED_; CMEM_;
            STG_(SB_(0, 0), b2, 0, k2); STG_(SB_(0, 1), b2, 1, k2); STG_(SA_(0, 0), a2, 0, k2); SCHED_;
            LDB_(B0, 1, 0); LDB_(B1, 1, 1); SCHED_; LDA_(At, 1, 0); SCHED_;
            WAIT_V(6); BAR_; WAIT_L(0); MMA2_(0, At, B0, B1); BAR_; SCHED_; CMEM_;
            STG_(SA_(0, 1), a2, 1, k2); SCHED_;
            LDA_(At, 1, 1); SCHED_;
            WAIT_V(2);
            if (t == 0) { un = pv.next(u); has_next = un >= 0; if (has_next) pv.src(un, na, nb, wv_); else { na = ca; nb = cb; } }
            BAR_; WAIT_L(0); MMA2_(1, At, B0, B1); BAR_; SCHED_; CMEM_;
        }
        if (PV::FP8 == 2) asm volatile("s_nop 15\n\ts_nop 15" ::: "memory");
        pv.epi(acc, u, wv_);
        if (!has_next) break;
        u = un; ca = na; cb = nb;
    }
#undef ZQ_
    WAIT_V(0);
    if (wr == 0) BAR_;
    BAR_;
#undef SA_
#undef SB_
#undef STG_
#undef LDA_
#undef LDB_
#undef MMA2_
#undef CMEM_
}
DI int lin_first(int shift, int count) { const int G = gridDim.x; const int u = (int)((blockIdx.x + G - (shift % G)) % G); return u < count ? u : -1; }
DI int lin_next(int u, int count) { const int un = u + (int)gridDim.x; return un < count ? un : -1; }
template <int MG, int NTL> struct XcdDeal {
    int MT;
    DI bool decode(int J, int& mt, int& nt) const { const int x = blockIdx.x & 7; const int grp = (J / (MG * NTL)) * 8 + x, w = J % (MG * NTL); mt = grp * MG + w / NTL; nt = w % NTL; return mt < MT; }
    DI int jmax() const { return ((MT + 8 * MG - 1) / (8 * MG)) * (MG * NTL); }
    DI int first() const { int J = blockIdx.x >> 3; const int per = gridDim.x >> 3, jm = jmax(); int mt, nt;
        while (J < jm && !decode(J, mt, nt)) J += per;
        return J < jm ? J : -1; }
    DI int next(int J) const { const int per = gridDim.x >> 3, jm = jmax(); int mt, nt; J += per;
        while (J < jm && !decode(J, mt, nt)) J += per;
        return J < jm ? J : -1; }
};
DI int first_unit(int shift) { const int G = gridDim.x; return (int)((blockIdx.x + G - (shift % G)) % G); }

DI void stage_coords(int (&R)[2], int (&C)[2], const int wv_) {
    const int t_ = otid();
#pragma unroll
    for (int i = 0; i < 2; ++i) stage_rc(t_ * 16 + i * 8192, R[i], C[i]);
}
DI APlain make_a_plain(const bf16_t* A, size_t row0, int lda, int col0) {
    APlain a; a.base = (const char*)(A + row0 * (size_t)lda + col0); a.lda2 = lda * 2; return a;
}
DI BSimple make_b(const bf16_t* Bt0, const bf16_t* Bt1, int ldb) {
    BSimple b; b.base[0] = (const char*)Bt0; b.base[1] = (const char*)Bt1; b.ldb2 = ldb * 2; return b;
}
#define EPI_FOR(acc, ...) do { const int _tz = otid(), _w = _tz >> 6, _l = _tz & 63, _wr = _w >> 2, _wc = _w & 3, _fr = _l & 15, _fq = _l >> 4; \
    _Pragma("unroll") for (int ai = 0; ai < 2; ++ai) _Pragma("unroll") for (int m = 0; m < 4; ++m) { const int lr = ai * 128 + _wr * 64 + m * 16 + _fr; \
    _Pragma("unroll") for (int bj = 0; bj < 2; ++bj) _Pragma("unroll") for (int n = 0; n < 2; ++n) { const int lc = bj * 128 + _wc * 32 + n * 16 + _fq * 4; const f32x4 v = acc[ai][bj][m][n]; __VA_ARGS__ } } } while (0)

DI void store_bf16x4(bf16_t* p, float a, float b, float c, float d) { u32x2 v; v.x = pk_bf16(a, b); v.y = pk_bf16(c, d); *(u32x2*)p = v; }
DI void store_bf16x8(bf16_t* p, const f32x4 a, const f32x4 b) { u32x4 v; v.x = pk_bf16(a[0], a[1]); v.y = pk_bf16(a[2], a[3]); v.z = pk_bf16(b[0], b[1]); v.w = pk_bf16(b[2], b[3]); *(u32x4*)p = v; }
#define EPI_FOR8(acc, ...) do { const int _tz = otid(), _w = _tz >> 6, _l = _tz & 63, _wr = _w >> 2, _wc = _w & 3, _fr = _l & 15, _fq = _l >> 4; \
    _Pragma("unroll") for (int ai = 0; ai < 2; ++ai) _Pragma("unroll") for (int m = 0; m < 4; ++m) { const int lr = ai * 128 + _wr * 64 + m * 16 + _fr; \
    _Pragma("unroll") for (int bj = 0; bj < 2; ++bj) { const int lc = bj * 128 + _wc * 32 + _fq * 8; const f32x4 v0 = acc[ai][bj][m][0], v1 = acc[ai][bj][m][1]; __VA_ARGS__ } } } while (0)

DI int mod_row(int r) { return r < TX ? (r >> 11) : 32; }
DI int crow_tok(int cr) { const int b = cr / NCH, j = cr - b * NCH; return j < 4 ? TX + b * CTXL + j * 64 : b * SEQ + (j - 4) * 64; }

DI void cvt_tile(LAS char* wl  , const float* src, int ld_src, int kvalid, int nvalid, const float* scale, bf16_t* dst, int ld_dst, const int wv_) {
    const int lane = otid() & 63;
    const int lr = lane >> 4, lc = (lane & 15) * 4;
    f32x4 v[16];
#pragma unroll
    for (int it = 0; it < 16; ++it) {
        const int k = it * 4 + lr;
        v[it] = (f32x4){0.f, 0.f, 0.f, 0.f};
        if (src != nullptr && k < kvalid && lc < nvalid) { v[it] = *(const f32x4*)(src + (size_t)k * ld_src + lc); if (scale) { const float s = scale[k]; v[it] *= s; } }
    }
#pragma unroll
    for (int it = 0; it < 16; ++it) {
        const int k = it * 4 + lr;
#pragma unroll
        for (int j = 0; j < 4; ++j) *(LAS bf16_t*)(wl + (lc + j) * 144 + k * 2) = f2bf(v[it][j]);
    }
    asm volatile("s_waitcnt lgkmcnt(0)" ::: "memory");
#pragma unroll
    for (int i = 0; i < 8; ++i) {
        const int q = i * 64 + lane, n = q >> 3, c = q & 7;
        const u32x4 w = *(const LAS u32x4*)(wl + n * 144 + c * 16);
        *(u32x4*)(dst + (size_t)n * ld_dst + c * 8) = w;
    }
    asm volatile("s_waitcnt lgkmcnt(0)" ::: "memory");
}
constexpr float SWI_A = 2.4554669595930156f;
DI void cvt_tile8(LAS char* wl  , const float* src, int ld_src, unsigned char* dst, int ld_dst, const float wscale, const int wv_) {
    const int lane = otid() & 63;
    const int lr = lane >> 4, lc = (lane & 15) * 4;
    f32x4 v[16];
#pragma unroll
    for (int it = 0; it < 16; ++it) v[it] = *(const f32x4*)(src + (size_t)(it * 4 + lr) * ld_src + lc);
#pragma unroll
    for (int it = 0; it < 16; ++it) {
        const int k = it * 4 + lr;
#pragma unroll
        for (int j = 0; j < 4; ++j) *(LAS unsigned char*)(wl + (lc + j) * 80 + k) = (unsigned char)f2fp8(v[it][j] * wscale);
    }
    asm volatile("s_waitcnt lgkmcnt(0)" ::: "memory");
#pragma unroll
    for (int i = 0; i < 4; ++i) {
        const int q = i * 64 + lane, n = q >> 2, c = q & 3;
        const u32x4 w = *(const LAS u32x4*)(wl + n * 80 + c * 16);
        *(u32x4*)(dst + (size_t)n * ld_dst + c * 16) = w;
    }
    asm volatile("s_waitcnt lgkmcnt(0)" ::: "memory");
}
constexpr int CVT_SMALL_TILES = 768 + 512 + 32 + 32 + 64 + 64 + 32;
constexpr int CVT_EXP_TILES = 32 * (32 * 16 + 16 * 16);
DI void cvt_small(const Params& p, LAS char* wl, int t, const int wv_) {
    char* ws = p.ws;
    if (t < 768) { const int l = t / 384, r = t % 384, nt = r / 16, kt = r % 16;
        cvt_tile(wl, p.w_mix_in + (size_t)l * 1024 * N_IN + (size_t)kt * 64 * N_IN + nt * 64, N_IN, 64, N_IN - nt * 64, nullptr,
                 (bf16_t*)(ws + WS_WMI) + ((size_t)l * 1536 + nt * 64) * 1024 + kt * 64, 1024, wv_); return; }
    t -= 768;
    if (t < 512) { const int l = t / 256, r = t % 256, nt = r / 16, kt = r % 16;
        cvt_tile(wl, p.w_mix_out + (size_t)l * 1024 * 1024 + (size_t)kt * 64 * 1024 + nt * 64, 1024, 64, 64, nullptr,
                 (bf16_t*)(ws + WS_WMO) + ((size_t)l * 1024 + nt * 64) * 1024 + kt * 64, 1024, wv_); return; }
    t -= 512;
    if (t < 32) { const int l = t / 16, r = t % 16, nt = r / 4, kt = r % 4;
        cvt_tile(wl, p.conv_pw + (size_t)l * 65536 + (size_t)kt * 64 * 256 + nt * 64, 256, 64, 64, nullptr,
                 (bf16_t*)(ws + WS_WPW) + ((size_t)l * 256 + nt * 64) * 256 + kt * 64, 256, wv_); return; }
    t -= 32;
    if (t < 32) { const int l = t / 16, r = t % 16, nt = r / 4, kt = r % 4;
        cvt_tile(wl, p.ssm_glu_w + (size_t)l * 65536 + (size_t)kt * 64 * 256 + nt * 64, 256, 64, 64, nullptr,
                 (bf16_t*)(ws + WS_WGLU) + ((size_t)l * 256 + nt * 64) * 256 + kt * 64, 256, wv_); return; }
    t -= 32;
    if (t < 64) { const int l = t / 32, r = t % 32, nt = r / 4, kt = r % 4;
        const bool any = (kt < 3) && (nt < 6);
        cvt_tile(wl, any ? p.mla_wq_b + (size_t)l * 192 * 384 + (size_t)kt * 64 * 384 + nt * 64 : nullptr, 384, 64, 64, p.mla_q_a_g + l * 192 + kt * 64,
                 (bf16_t*)(ws + WS_WQ) + ((size_t)l * 512 + nt * 64) * 256 + kt * 64, 256, wv_); return; }
    t -= 64;
    if (t < 64) { const int l = t / 32, r = t % 32, nt = r / 4, kt = r % 4;
        const bool any = (kt < 2);
        cvt_tile(wl, any ? p.mla_wkv_b + (size_t)l * 128 * 512 + (size_t)kt * 64 * 512 + nt * 64 : nullptr, 512, 64, 64, p.mla_kv_a_g + l * 128 + kt * 64,
                 (bf16_t*)(ws + WS_WKV) + ((size_t)l * 512 + nt * 64) * 256 + kt * 64, 256, wv_); return; }
    t -= 64;
    { const int l = t / 16, r = t % 16, nt = r / 4, kt = r % 4;
        cvt_tile(wl, nt == kt ? p.pool_w + ((size_t)l * 4 + nt) * 4096 : nullptr, 64, 64, 64, nullptr,
                 (bf16_t*)(ws + WS_WPOOL) + ((size_t)l * 256 + nt * 64) * 256 + kt * 64, 256, wv_); }
}
DI void cvt_expert(const Params& p, LAS char* wl, int l, int t, const int wv_) {
    char* ws = p.ws;
    const int e = t / 768, r = t % 768;
    if (r < 512) { const int nt = r / 16, kt = r % 16;
        cvt_tile8(wl, p.exp_w_in + ((size_t)(l * NE + e) * 1024 + kt * 64) * 2048 + nt * 64, 2048,
                  (unsigned char*)(ws + WS_W1) + ((size_t)(l * NE + e) * 2048 + nt * 64) * 1024 + kt * 64, 1024, nt < 16 ? 256.f * SWI_A : 256.f / SWI_A, wv_);
    } else { const int q = r - 512, nt = q / 16, kt = q % 16;
        cvt_tile8(wl, p.exp_w_out + ((size_t)(l * NE + e) * 1024 + kt * 64) * 1024 + nt * 64, 1024,
                  (unsigned char*)(ws + WS_W2) + ((size_t)(l * NE + e) * 1024 + nt * 64) * 1024 + kt * 64, 1024, 256.f, wv_);
    }
}

DI void ada_unit(const Params& p, LAS char* shm, int u, const int wv_) {
    const int tid = otid();
    const int l = u / 48, jc = u % 48;
    LAS float* sc = (LAS float*)shm;
    for (int i = tid; i < 33 * 1024; i += 512) { const int r = i >> 10, k = i & 1023; const float v = r < 32 ? p.c[r * 1024 + k] : p.c_ctx[k]; sc[i] = siluf_(v); }
    __syncthreads();
    const int col = tid & 127, kq = tid >> 7;
    float acc[33];
#pragma unroll
    for (int r = 0; r < 33; ++r) acc[r] = 0.f;
    const float* wp = p.ada_w + ((size_t)l * 1024 + kq * 256) * 6144 + jc * 128 + col;
    for (int k4 = 0; k4 < 256; k4 += 4) {
        float w[4];
#pragma unroll
        for (int i = 0; i < 4; ++i) w[i] = wp[(size_t)(k4 + i) * 6144];
#pragma unroll
        for (int r = 0; r < 33; ++r) { const f32x4 s = *(const LAS f32x4*)(sc + r * 1024 + kq * 256 + k4); acc[r] += s[0] * w[0] + s[1] * w[1] + s[2] * w[2] + s[3] * w[3]; }
    }
    __syncthreads();
    LAS float* red = (LAS float*)shm;
#pragma unroll
    for (int r = 0; r < 33; ++r) red[(kq * 33 + r) * 128 + col] = acc[r];
    __syncthreads();
    for (int i = tid; i < 33 * 128; i += 512) { const int r = i >> 7, cc = i & 127;
        const float s = red[(0 * 33 + r) * 128 + cc] + red[(1 * 33 + r) * 128 + cc] + red[(2 * 33 + r) * 128 + cc] + red[(3 * 33 + r) * 128 + cc];
        ((float*)(p.ws + WS_MOD))[((size_t)l * 33 + r) * 6144 + jc * 128 + cc] = s + p.ada_b[l * 6144 + jc * 128 + cc]; }
    __syncthreads();
}

DI void s5_load_bc(const Params& p, LAS float* bb, LAS float* cc, int l, int dir, int g, int tid) {
    const int pbase = ((l * 2 + dir) * 16 + g) * 64;
    const double dt = exp((double)p.ssm_log_dt[(l * 2 + dir) * 16 + g]);
    for (int i = tid; i < 64 * 16; i += 512) { const int q = i >> 4, ci = i & 15;
        const double are = fmin((double)p.ssm_a_re[pbase + q], -1e-4), aim = (double)p.ssm_a_im[pbase + q];
        const double mg = exp(are * dt), abr = mg * cos(aim * dt), abi = mg * sin(aim * dt), den = are * are + aim * aim;
        const double fre = ((abr - 1.0) * are + abi * aim) / den, fim = (abi * are - (abr - 1.0) * aim) / den;
        const double br = (double)p.ssm_b_re[(size_t)(pbase + q) * 16 + ci], bi = (double)p.ssm_b_im[(size_t)(pbase + q) * 16 + ci];
        bb[i * 2] = (float)(fre * br - fim * bi); bb[i * 2 + 1] = (float)(fre * bi + fim * br); }
    for (int i = tid; i < 16 * 64; i += 512) { const int co = i >> 6, q = i & 63;
        const size_t ix = ((size_t)((l * 2 + dir) * 16 + g) * 16 + co) * 64 + q;
        cc[i * 2] = p.ssm_c_re[ix]; cc[i * 2 + 1] = p.ssm_c_im[ix]; }
}
DI void s5pre_unit(const Params& p, LAS char* shm, int u, const int wv_) {
    const int tid = otid();
    const int l = u >> 5, g = (u >> 1) & 15, dir = u & 1;
    LAS float* pw = (LAS float*)shm;
    LAS float* bb = pw + 65 * 64 * 2;
    LAS float* cc = bb + 64 * 16 * 2;
    LAS float* kk = cc + 16 * 64 * 2;
    LAS float* k0o = kk + 64 * 256;
    bf16_t* TS = (bf16_t*)(p.ws + WS_TS5) + (size_t)(l * 16 + g) * 1024 * 1280;
    bf16_t* WS = (bf16_t*)(p.ws + WS_WS5) + (size_t)(l * 16 + g) * 256 * 1024;
    const int cocip = tid & 255, co_ = cocip >> 4, ci_ = cocip & 15;
    if (dir == 0) {
        s5_load_bc(p, bb, cc, l, 1, g, tid);
        __syncthreads();
        if (tid < 256) { float s_ = 0.f;
            for (int q = 0; q < 64; ++q) s_ += cc[(co_ * 64 + q) * 2] * bb[(q * 16 + ci_) * 2] - cc[(co_ * 64 + q) * 2 + 1] * bb[(q * 16 + ci_) * 2 + 1];
            k0o[tid] = s_; }
        __syncthreads();
    }
    {
        const int pbase = ((l * 2 + dir) * 16 + g) * 64;
        const double dt = exp((double)p.ssm_log_dt[(l * 2 + dir) * 16 + g]);
        for (int i = tid; i < 65 * 64; i += 512) { const int tau = i >> 6, q = i & 63;
            const double are = fmin((double)p.ssm_a_re[pbase + q], -1e-4), aim = (double)p.ssm_a_im[pbase + q];
            const double mg = exp(are * dt * tau), an = aim * dt * tau;
            pw[i * 2] = (float)(mg * cos(an)); pw[i * 2 + 1] = (float)(mg * sin(an)); }
        s5_load_bc(p, bb, cc, l, dir, g, tid);
        __syncthreads();
        if (tid < 64) { float* a64 = (float*)(p.ws + WS_A64) + (size_t)(((l * 2 + dir) * 16 + g) * 64 + tid) * 2; a64[0] = pw[(64 * 64 + tid) * 2]; a64[1] = pw[(64 * 64 + tid) * 2 + 1]; }
        { float gr[64], gi[64];
#pragma unroll
          for (int q = 0; q < 64; ++q) { const float cr = cc[(co_ * 64 + q) * 2], cim = cc[(co_ * 64 + q) * 2 + 1], br = bb[(q * 16 + ci_) * 2], bi = bb[(q * 16 + ci_) * 2 + 1];
              gr[q] = cr * br - cim * bi; gi[q] = cr * bi + cim * br; }
          for (int tau = (tid >> 8); tau < 64; tau += 2) {
              float s_ = 0.f;
#pragma unroll
              for (int q = 0; q < 64; ++q) s_ += gr[q] * pw[(tau * 64 + q) * 2] - gi[q] * pw[(tau * 64 + q) * 2 + 1];
              kk[tau * 256 + cocip] = s_;
          } }
        for (int i = tid; i < 128 * 512; i += 512) { const int row = i >> 9, kp = (i & 511) * 2, ri = row >> 6, q = row & 63, s_ = kp >> 4, ci = kp & 15;
            const int e = dir == 0 ? 63 - s_ : s_;
            const float pr = pw[(e * 64 + q) * 2], pi = pw[(e * 64 + q) * 2 + 1];
            float o[2];
#pragma unroll
            for (int j = 0; j < 2; ++j) { const float br = bb[(q * 16 + ci + j) * 2], bi = bb[(q * 16 + ci + j) * 2 + 1]; o[j] = ri == 0 ? pr * br - pi * bi : pr * bi + pi * br; }
            *(unsigned*)(WS + (size_t)(dir * 128 + row) * 1024 + kp) = pk_bf16(o[0], o[1]); }
        for (int i = tid; i < 1024 * 64; i += 512) { const int row = i >> 6, kp = (i & 63) * 2, t = row >> 4, co = row & 15, ri = kp >> 6, q = kp & 63;
            const int e = dir == 0 ? t + 1 : 64 - t;
            float o[2];
#pragma unroll
            for (int j = 0; j < 2; ++j) { const float pr = pw[(e * 64 + q + j) * 2], pi = pw[(e * 64 + q + j) * 2 + 1];
                const float cr = cc[(co * 64 + q + j) * 2], cim = cc[(co * 64 + q + j) * 2 + 1];
                o[j] = ri == 0 ? (cr * pr - cim * pi) : -(cr * pi + cim * pr); }
            *(unsigned*)(TS + (size_t)row * 1280 + 1024 + dir * 128 + kp) = pk_bf16(o[0], o[1]); }
        __syncthreads();
        for (int rr = tid; rr < 1024; rr += 512) { const int t = rr >> 4, co = rr & 15;
            const float dco = p.ssm_d[l * 256 + g * 16 + co];
            bf16_t* rowp = TS + (size_t)rr * 1280;
            const int s_lo = dir == 0 ? 0 : t + 1, s_hi = dir == 0 ? t : 63;
            for (int s_ = s_lo; s_ <= s_hi; ++s_) { const int tau = dir == 0 ? t - s_ : s_ - t;
                unsigned w[8];
#pragma unroll
                for (int j = 0; j < 8; ++j) { float a = kk[tau * 256 + co * 16 + 2 * j], b2 = kk[tau * 256 + co * 16 + 2 * j + 1];
                    if (s_ == t) { a += k0o[co * 16 + 2 * j]; b2 += k0o[co * 16 + 2 * j + 1]; if (2 * j == co) a += dco; if (2 * j + 1 == co) b2 += dco; }
                    w[j] = pk_bf16(a, b2); }
                *(u32x4*)(rowp + s_ * 16) = (u32x4){w[0], w[1], w[2], w[3]}; *(u32x4*)(rowp + s_ * 16 + 8) = (u32x4){w[4], w[5], w[6], w[7]}; }
        }
        __syncthreads();
    }
}

DI void phase_prologue(const Params& p, LAS char* shm, const int wv_) {
    const int tid = otid();
    __syncthreads();
    if (blockIdx.x == 0 && tid < 64) ((int*)(p.ws + WS_CNT))[tid] = 0;
    const int n_cvt = (CVT_SMALL_TILES + 2 * CVT_EXP_TILES + 7) / 8;
    for (int u = blockIdx.x; u < 160; u += gridDim.x) {
        if (u < 64) s5pre_unit(p, shm, u, wv_);
        else ada_unit(p, shm, u - 64, wv_);
    }
    int* wq = (int*)(p.ws + WS_CNT) + 192;
    volatile LAS int* slot = (volatile LAS int*)(shm + LDS_MISC + 32);
    __syncthreads();
    if (tid == 0) slot[0] = atomicAdd(wq, 1);
    __syncthreads();
    int cu = slot[0], par = 0;
    while (cu < n_cvt) {
        int nxt = 0;
        if (tid == 0) nxt = atomicAdd(wq, 1);
        const int t = cu * 8 + wv_;
        LAS char* wl = shm + wv_ * (64 * 144);
        if (t < CVT_SMALL_TILES) cvt_small(p, wl, t, wv_);
        else if (t < CVT_SMALL_TILES + 2 * CVT_EXP_TILES) { const int te = t - CVT_SMALL_TILES; cvt_expert(p, wl, te / CVT_EXP_TILES, te % CVT_EXP_TILES, wv_); }
        par ^= 1;
        if (tid == 0) slot[par] = nxt;
        __syncthreads();
        cu = slot[par];
    }
}

DI void norm_mod_store(const float (&v)[16], const float* g, const float* modrow  , bf16_t* hrow, const int wv_) {
    const int lane = otid() & 63;
    float ss = 0.f;
#pragma unroll
    for (int i = 0; i < 16; ++i) ss += v[i] * v[i];
    ss = wave_sum(ss);
    const float rn = rsqrtf(ss * (1.f / 1024.f) + EPS);
#pragma unroll
    for (int j = 0; j < 4; ++j) {
        const int col = j * 256 + lane * 4;
        const f32x4 gg = *(const f32x4*)(g + col), sh = *(const f32x4*)(modrow + col), sc = *(const f32x4*)(modrow + 1024 + col);
        float o[4];
#pragma unroll
        for (int i = 0; i < 4; ++i) o[i] = v[j * 4 + i] * rn * gg[i] * (1.f + sc[i]) + sh[i];
        store_bf16x4(hrow + col, o[0], o[1], o[2], o[3]);
    }
}
DI void phase_norm1_l0(const Params& p, const int wv_) {
    const int tid_ = otid(); const int wid = tid_ >> 6, lane = tid_ & 63;
    const float* MOD = (const float*)(p.ws + WS_MOD);
    bf16_t* H = (bf16_t*)(p.ws + WS_H);
    for (int r = blockIdx.x * 8 + wid; r < TT; r += gridDim.x * 8) {
        const float* src = r < TX ? p.x + (size_t)r * 1024 : p.ctx + (size_t)(r - TX) * 1024;
        float v[16];
#pragma unroll
        for (int j = 0; j < 4; ++j) { const f32x4 t = *(const f32x4*)(src + j * 256 + lane * 4); v[j * 4] = t[0]; v[j * 4 + 1] = t[1]; v[j * 4 + 2] = t[2]; v[j * 4 + 3] = t[3]; }
        norm_mod_store(v, p.norm1_g, MOD + (size_t)(0 * 33 + mod_row(r)) * 6144, H + (size_t)r * 1024, wv_);
    }
}

struct PvInproj {
    const Params& p; int l;
    PV_NOHOOKS
    static constexpr int NT = 16; static constexpr int FP8 = 0; static constexpr bool PARK = false; typedef APlain AS; typedef BSimple BS;
    XcdDeal<4, 6> deal;
    DI int first() const { return deal.first(); }
    DI int next(int u) const { return deal.next(u); }
    DI void src(int u, AS& a, BS& b, const int wv_) const {
        int mt, nt; deal.decode(u, mt, nt);
        const bf16_t* W = (const bf16_t*)(p.ws + WS_WMI) + (size_t)l * 1536 * 1024;
        a = make_a_plain((const bf16_t*)(p.ws + WS_H), (size_t)mt * 256, 1024, 0);
        b = nt < 2 ? make_b(W + (size_t)(nt * 128) * 1024, W + (size_t)(256 + nt * 128) * 1024, 1024)
                   : make_b(W + (size_t)(nt * 256) * 1024, W + (size_t)(nt * 256 + 128) * 1024, 1024);
    }
    DI void epi(f32x4 (&acc)[2][2][4][2], int u, const int wv_) const {
        int mt, nt; deal.decode(u, mt, nt);
        bf16_t* P = (bf16_t*)(p.ws + WS_P);
        if (nt < 2) {
            const int _tz = otid(), _w = _tz >> 6, _l = _tz & 63, _wr = _w >> 2, _wc = _w & 3, _fr = _l & 15, _fq = _l >> 4;
#pragma unroll
            for (int ai = 0; ai < 2; ++ai)
#pragma unroll
                for (int m = 0; m < 4; ++m) { const int lr = ai * 128 + _wr * 64 + m * 16 + _fr; const int lc = _wc * 32 + _fq * 8;
                    f32x4 o0, o1;
#pragma unroll
                    for (int r = 0; r < 4; ++r) { o0[r] = acc[ai][0][m][0][r] * sigmoidf_(acc[ai][1][m][0][r]); o1[r] = acc[ai][0][m][1][r] * sigmoidf_(acc[ai][1][m][1][r]); }
                    store_bf16x8(P + (size_t)(mt * 256 + lr) * NINP + nt * 128 + lc, o0, o1); }
        } else {
            EPI_FOR8(acc, { store_bf16x8(P + (size_t)(mt * 256 + lr) * NINP + nt * 256 + lc, v0, v1); });
        }
    }
};
DI void phase_inproj(const Params& p, LAS char* shm, int l, const int wv_) {
    PvInproj pv{p, l, {TT / 256}};
    gemm_stream(shm, pv, wv_);
}

template <int N> DI void wave_sum_n(float (&v)[N]) {
    const int l4 = olane();
#pragma unroll
    for (int o = 32; o > 0; o >>= 1) {
        float t_[N];
#pragma unroll
        for (int i = 0; i < N; ++i) t_[i] = __int_as_float(__builtin_amdgcn_ds_bpermute((l4 ^ o) << 2, __float_as_int(v[i])));
#pragma unroll
        for (int i = 0; i < N; ++i) v[i] += t_[i];
    }
}
template <int WIN, bool EDGE>
DI void pool_run(const LAS bf16_t* pin  , bf16_t* AP, int row0, int ts0, int L, int c, int half) {
    for (int blk = 0; blk < 2; ++blk) {
        const int t0 = half * 32 + blk * 16;
        float in[16 + WIN - 1];
#pragma unroll
        for (int i = 0; i < 16 + WIN - 1; ++i) in[i] = bf2f(pin[(t0 + i - WIN / 2 + 8) * 256 + c]);
        float sum = 0.f;
#pragma unroll
        for (int j = 0; j < WIN; ++j) sum += in[j];
#pragma unroll
        for (int o = 0; o < 16; ++o) {
            float inv = 1.f / (float)WIN;
            if (EDGE) { const int ts = ts0 + t0 + o; const int lo = max(ts - WIN / 2, 0), hi = min(ts + WIN - 1 - WIN / 2, L - 1); inv = 1.f / (float)(hi - lo + 1); }
            AP[(size_t)(row0 + t0 + o) * 256 + c] = f2bf(sum * inv - in[o + WIN / 2]);
            if (o < 15) sum += in[o + WIN] - in[o];
        }
    }
}
template <bool EDGE>
DI void pre_unit_t(const Params& p, LAS char* shm, int l, int row0, int ts0, int L, const float (&w)[31], const float bias, const int wv_) {
    const int tid = otid();
    const bf16_t* P = (const bf16_t*)(p.ws + WS_P);
    const int c = tid & 255, half = tid >> 8;
    LAS bf16_t* cin = (LAS bf16_t*)shm;
    LAS float* cv = (LAS float*)(shm + 49152);
    u32x4 creg[6], preg[5];
#pragma unroll
    for (int it = 0; it < 6; ++it) { const int q = it * 512 + tid, row = q >> 5, part = q & 31; const int ts = ts0 - 15 + row;
        creg[it] = (u32x4){0u, 0u, 0u, 0u};
        if (q < 94 * 32 && (!EDGE || (ts >= 0 && ts < L))) creg[it] = *(const u32x4*)(P + (size_t)(row0 - 15 + row) * NINP + part * 8); }
#pragma unroll
    for (int it = 0; it < 5; ++it) { const int q = it * 512 + tid, row = q >> 5, part = q & 31; const int ts = ts0 - 8 + row;
        preg[it] = (u32x4){0u, 0u, 0u, 0u};
        if (!EDGE || (ts >= 0 && ts < L)) preg[it] = *(const u32x4*)(P + (size_t)(row0 - 8 + row) * NINP + OFF_POOL + part * 8); }
#pragma unroll
    for (int it = 0; it < 6; ++it) { const int q = it * 512 + tid; if (q < 94 * 32) *(LAS u32x4*)(cin + q * 8) = creg[it]; }
    __syncthreads();
    {
        const int t0 = half * 32;
        float in[62];
#pragma unroll
        for (int i = 0; i < 62; ++i) in[i] = bf2f(cin[(t0 + i) * 256 + c]);
#pragma unroll
        for (int o = 0; o < 32; ++o) { float s_ = bias;
#pragma unroll
            for (int j = 0; j < 31; ++j) s_ += w[j] * in[o + j];
            cv[(t0 + o) * 257 + c] = s_; }
    }
    __syncthreads();
#pragma unroll
    for (int it = 0; it < 5; ++it) *(LAS u32x4*)(cin + (it * 512 + tid) * 8) = preg[it];
    {
        const int wid = tid >> 6, lane = tid & 63;
        bf16_t* AC = (bf16_t*)(p.ws + WS_ACONV);
        float lg[4], lb[4];
#pragma unroll
        for (int j = 0; j < 4; ++j) { lg[j] = p.conv_ln_g[l * 256 + lane + 64 * j]; lb[j] = p.conv_ln_b[l * 256 + lane + 64 * j]; }
        float x[8][4], s8[8];
#pragma unroll
        for (int i = 0; i < 8; ++i) { s8[i] = 0.f;
#pragma unroll
            for (int j = 0; j < 4; ++j) { x[i][j] = cv[(wid * 8 + i) * 257 + lane + 64 * j]; s8[i] += x[i][j]; } }
        wave_sum_n<8>(s8);
#pragma unroll
        for (int i = 0; i < 8; ++i) { const float mu = s8[i] * (1.f / 256.f); s8[i] = 0.f;
#pragma unroll
            for (int j = 0; j < 4; ++j) { x[i][j] -= mu; s8[i] += x[i][j] * x[i][j]; } }
        wave_sum_n<8>(s8);
#pragma unroll
        for (int i = 0; i < 8; ++i) { const float rs = rsqrtf(s8[i] * (1.f / 256.f) + EPS);
#pragma unroll
            for (int j = 0; j < 4; ++j) { const float y = x[i][j] * rs * lg[j] + lb[j]; AC[(size_t)(row0 + wid * 8 + i) * 256 + lane + 64 * j] = f2bf(siluf_(y)); } }
    }
    __syncthreads();
    {
        bf16_t* AP = (bf16_t*)(p.ws + WS_APOOL);
        const int g = __builtin_amdgcn_readfirstlane(c >> 6);
        if (g == 0) pool_run<2, EDGE>(cin, AP, row0, ts0, L, c, half);
        else if (g == 1) pool_run<4, EDGE>(cin, AP, row0, ts0, L, c, half);
        else if (g == 2) pool_run<8, EDGE>(cin, AP, row0, ts0, L, c, half);
        else pool_run<16, EDGE>(cin, AP, row0, ts0, L, c, half);
    }
    __syncthreads();
}
DI void pre_unit(const Params& p, LAS char* shm, int l, int tile, const float (&w)[31], const float bias, const int wv_) {
    int row0, ts0, L;
    if (tile < 1024) { row0 = tile * 64; ts0 = row0 & 2047; L = SEQ; } else { row0 = TX + (tile - 1024) * 64; ts0 = (row0 - TX) & 255; L = CTXL; }
    if (ts0 >= 16 && ts0 + 64 + 16 <= L) pre_unit_t<false>(p, shm, l, row0, ts0, L, w, bias, wv_);
    else pre_unit_t<true>(p, shm, l, row0, ts0, L, w, bias, wv_);
}
struct PvS5State {
    const Params& p; int l;
    PV_NOHOOKS
    static constexpr int NT = 16; static constexpr int FP8 = 0; static constexpr bool PARK = false; typedef ASimple AS; typedef BSimple BS;
    DI int first() const { return lin_first(0, 80); }
    DI int next(int u) const { return lin_next(u, 80); }
    DI void src(int u, AS& as, BS& bs, const int wv_) const {
        const int g = u / 5, mt = u % 5;
        int R[2], C[2]; stage_coords(R, C, wv_);
        as.base = (const char*)(p.ws + WS_P); as.kstride = 4 * NINP * 2;
#pragma unroll
        for (int h = 0; h < 2; ++h)
#pragma unroll
            for (int i = 0; i < 2; ++i) { const int cr = min(mt * 256 + h * 128 + R[i], NCROW - 1);
                as.off[h][i] = (unsigned)(((size_t)(crow_tok(cr) + (C[i] >> 4)) * NINP + OFF_SSM + g * 16 + (C[i] & 15)) * 2); }
        const bf16_t* W = (const bf16_t*)(p.ws + WS_WS5) + (size_t)(l * 16 + g) * 256 * 1024;
        bs = make_b(W, W + (size_t)128 * 1024, 1024);
    }
    DI void epi(f32x4 (&acc)[2][2][4][2], int u, const int wv_) const {
        const int g = u / 5, mt = u % 5;
        float* SST = (float*)(p.ws + WS_SST);
        EPI_FOR8(acc, { const int cr = mt * 256 + lr; if (cr < NCROW) { float* o_ = SST + ((size_t)cr * 16 + g) * 256 + lc; *(f32x4*)o_ = v0; *(f32x4*)(o_ + 4) = v1; } });
    }
};
struct PvQKV {
    const Params& p; int l;
    PV_NOHOOKS
    static constexpr int NT = 4; static constexpr int FP8 = 0; static constexpr bool PARK = false; typedef APlain AS; typedef BSimple BS;
    DI int first() const { return lin_first(80, 1152); }
    DI int next(int u) const { return lin_next(u, 1152); }
    DI void src(int u, AS& a, BS& b, const int wv_) const {
        const bool isq = u < 576; const int w_ = isq ? u : u - 576; const int mt = w_ >> 1, nt = w_ & 1;
        a = make_a_plain((const bf16_t*)(p.ws + WS_P), (size_t)mt * 256, NINP, isq ? OFF_Q : OFF_KV);
        const bf16_t* W = (const bf16_t*)(p.ws + (isq ? WS_WQ : WS_WKV)) + (size_t)l * 512 * 256 + (size_t)nt * 256 * 256;
        b = make_b(W, W + (size_t)128 * 256, 256);
    }
    DI void epi(f32x4 (&acc)[2][2][4][2], int u, const int wv_) const {
        const bool isq = u < 576; const int w_ = isq ? u : u - 576; const int mt = w_ >> 1, nt = w_ & 1;
        bf16_t* RAW = (bf16_t*)(p.ws + (isq ? WS_RAWQ : WS_RAWKV));
        EPI_FOR8(acc, { store_bf16x8(RAW + (size_t)(mt * 256 + lr) * 512 + nt * 256 + lc, v0, v1); });
    }
};
DI void phase_A(const Params& p, LAS char* shm, int l, const int wv_) {
    { PvS5State pv{p, l}; gemm_stream(shm, pv, wv_); }
    { PvQKV pv{p, l}; gemm_stream(shm, pv, wv_); }
    { const int c_ = otid() & 255;
      float w[31];
#pragma unroll
      for (int j = 0; j < 31; ++j) w[j] = p.conv_dw[((size_t)l * 31 + j) * 256 + c_];
      const float bias = p.conv_dw_b[l * 256 + c_];
      for (int u = first_unit(80 + 1152); u < 1152; u += gridDim.x) pre_unit(p, shm, l, u, w, bias, wv_); }
}

DI void qkvpost_unit(const Params& p, LAS char* shm, int l, int unit, const int wv_) {
    const int tid = otid(), wid = tid >> 6, lane = tid & 63;
    const bf16_t* P = (const bf16_t*)(p.ws + WS_P);
    const bf16_t* RAWQ = (const bf16_t*)(p.ws + WS_RAWQ);
    const bf16_t* RAWKV = (const bf16_t*)(p.ws + WS_RAWKV);
    bf16_t* Q = (bf16_t*)(p.ws + WS_Q);
    bf16_t* KB = (bf16_t*)(p.ws + WS_KB);
    bf16_t* VT = (bf16_t*)(p.ws + WS_VT);
    LAS bf16_t* vt = (LAS bf16_t*)shm;
    const int row0 = unit * 64;
    const bool lat = row0 < TX;
    const int b = lat ? (row0 >> 11) : ((row0 - TX) >> 8);
    const int key0 = lat ? (row0 & 2047) : 2048 + ((row0 - TX) & 255);
    const int head = lane >> 4, sub = lane & 15;
    const float lninv = -9.210340371976184f / 8.f;
    const float frq = __expf(lninv * (float)(sub & 7));
    float qg[6], kg[6];
#pragma unroll
    for (int j = 0; j < 6; ++j) { qg[j] = p.mla_q_g[l * 96 + sub + 16 * j] * 0.14724444674085666f; kg[j] = p.mla_k_g[l * 96 + sub + 16 * j]; }
    constexpr int NB = 4;
    for (int tk0 = wid * 8; tk0 < wid * 8 + 8; tk0 += NB) {
        float pq[NB][3], pkv[NB][2], qr[NB][6], kr[NB][6], vr[NB][4];
#pragma unroll
        for (int i = 0; i < NB; ++i) { const int r = row0 + tk0 + i; const bf16_t* pr = P + (size_t)r * NINP;
#pragma unroll
            for (int j = 0; j < 3; ++j) pq[i][j] = bf2f(pr[OFF_Q + lane + 64 * j]);
#pragma unroll
            for (int j = 0; j < 2; ++j) pkv[i][j] = bf2f(pr[OFF_KV + lane + 64 * j]);
#pragma unroll
            for (int j = 0; j < 6; ++j) qr[i][j] = bf2f(RAWQ[(size_t)r * 512 + head * 96 + sub + 16 * j]);
#pragma unroll
            for (int j = 0; j < 4; ++j) kr[i][j] = bf2f(RAWKV[(size_t)r * 512 + head * 128 + sub + 16 * j]);
#pragma unroll
            for (int j = 4; j < 6; ++j) kr[i][j] = bf2f(pr[OFF_KPE + sub + 16 * (j - 4)]);
#pragma unroll
            for (int j = 0; j < 4; ++j) vr[i][j] = bf2f(RAWKV[(size_t)r * 512 + head * 128 + 64 + sub + 16 * j]); }
        float red[2 * NB];
#pragma unroll
        for (int i = 0; i < NB; ++i) { red[2 * i] = pq[i][0] * pq[i][0] + pq[i][1] * pq[i][1] + pq[i][2] * pq[i][2]; red[2 * i + 1] = pkv[i][0] * pkv[i][0] + pkv[i][1] * pkv[i][1]; }
        wave_sum_n<2 * NB>(red);
        float ssq[2 * NB];
#pragma unroll
        for (int i = 0; i < NB; ++i) {
            const float rq = rsqrtf(red[2 * i] * (1.f / 192.f) + EPS), rkv = rsqrtf(red[2 * i + 1] * (1.f / 128.f) + EPS);
            float s0 = 0.f, s1 = 0.f;
#pragma unroll
            for (int j = 0; j < 6; ++j) { qr[i][j] *= rq; s0 += qr[i][j] * qr[i][j]; }
#pragma unroll
            for (int j = 0; j < 4; ++j) { kr[i][j] *= rkv; s1 += kr[i][j] * kr[i][j]; }
#pragma unroll
            for (int j = 4; j < 6; ++j) s1 += kr[i][j] * kr[i][j];
#pragma unroll
            for (int j = 0; j < 4; ++j) vr[i][j] *= rkv;
            ssq[2 * i] = s0; ssq[2 * i + 1] = s1;
        }
        { const int l4 = olane();
#pragma unroll
          for (int o = 8; o > 0; o >>= 1) { float t_[2 * NB];
#pragma unroll
              for (int i = 0; i < 2 * NB; ++i) t_[i] = __int_as_float(__builtin_amdgcn_ds_bpermute((l4 ^ o) << 2, __float_as_int(ssq[i])));
#pragma unroll
              for (int i = 0; i < 2 * NB; ++i) ssq[i] += t_[i]; } }
#pragma unroll
        for (int i = 0; i < NB; ++i) {
            const int tk = tk0 + i, r = row0 + tk;
            const float rnq = rsqrtf(ssq[2 * i] * (1.f / 96.f) + EPS), rnk = rsqrtf(ssq[2 * i + 1] * (1.f / 96.f) + EPS);
#pragma unroll
            for (int j = 0; j < 6; ++j) { qr[i][j] *= rnq * qg[j]; kr[i][j] *= rnk * kg[j]; }
            if (lat) {
                const int tseq = r & 2047; const float a0 = (float)(tseq >> 6) * frq, a1 = (float)(tseq & 63) * frq;
                const float cs0 = __cosf(a0), sn0 = __sinf(a0), cs1 = __cosf(a1), sn1 = __sinf(a1);
                const float oq4 = shx(qr[i][4], 8), oq5 = shx(qr[i][5], 8), ok4 = shx(kr[i][4], 8), ok5 = shx(kr[i][5], 8);
                const float sg = (sub < 8) ? -1.f : 1.f;
                qr[i][4] = qr[i][4] * cs0 + sg * oq4 * sn0; qr[i][5] = qr[i][5] * cs1 + sg * oq5 * sn1;
                kr[i][4] = kr[i][4] * cs0 + sg * ok4 * sn0; kr[i][5] = kr[i][5] * cs1 + sg * ok5 * sn1;
            }
            bf16_t* kro = KB + ((size_t)(b * 4 + head) * 2304 + key0 + tk) * 96;
#pragma unroll
            for (int j = 0; j < 6; ++j) { Q[(size_t)r * 384 + head * 96 + sub + 16 * j] = f2bf(qr[i][j]); kro[sub + 16 * j] = f2bf(kr[i][j]); }
#pragma unroll
            for (int j = 0; j < 4; ++j) vt[(head * 64 + sub + 16 * j) * 72 + tk] = f2bf(vr[i][j]);
        }
    }
    __syncthreads();
    { const int hv = tid >> 1, hf = tid & 1;
      bf16_t* dst = VT + ((size_t)(b * 4 + (hv >> 6)) * 64 + (hv & 63)) * 2304 + key0 + hf * 32;
#pragma unroll
      for (int i = 0; i < 4; ++i) *(u32x4*)(dst + i * 8) = *(const LAS u32x4*)(vt + hv * 72 + hf * 32 + i * 8); }
    __syncthreads();
}
DI void s5carry_unit(const Params& p, int l, int unit, const int wv_) {
    const int gid = unit * 512 + otid();
    const int q = gid & 63, dir = (gid >> 6) & 1, g = (gid >> 7) & 15, b = gid >> 11;
    const float* A64 = (const float*)(p.ws + WS_A64) + (size_t)(((l * 2 + dir) * 16 + g) * 64 + q) * 2;
    const float ar = A64[0], ai = A64[1];
    const float* SST = (const float*)(p.ws + WS_SST);
    bf16_t* HIN = (bf16_t*)(p.ws + WS_HIN);
    float sr[NCH], si[NCH];
#pragma unroll
    for (int s = 0; s < NCH; ++s) { const int j = dir == 0 ? s : (s < 4 ? 3 - s : 39 - s);
        const size_t base = ((size_t)(b * NCH + j) * 16 + g) * 256 + dir * 128 + q; sr[s] = SST[base]; si[s] = SST[base + 64]; }
    float hr = 0.f, hi = 0.f;
#pragma unroll
    for (int s = 0; s < NCH; ++s) {
        const int j = dir == 0 ? s : (s < 4 ? 3 - s : 39 - s);
        const size_t base = ((size_t)(b * NCH + j) * 16 + g) * 256 + dir * 128 + q;
        HIN[base] = f2bf(hr); HIN[base + 64] = f2bf(hi);
        const float nr = ar * hr - ai * hi + sr[s], ni = ar * hi + ai * hr + si[s];
        hr = nr; hi = ni;
    }
}
struct PvConvPool {
    const Params& p; int l;
    PV_NOHOOKS
    static constexpr int NT = 4; static constexpr int FP8 = 0; static constexpr bool PARK = false; typedef APlain AS; typedef BSimple BS;
    DI int first() const { return lin_first(0, 576); }
    DI int next(int u) const { return lin_next(u, 576); }
    DI void src(int u, AS& a, BS& b, const int wv_) const {
        const bool isconv = u < 288; const int mt = isconv ? u : u - 288;
        a = make_a_plain((const bf16_t*)(p.ws + (isconv ? WS_ACONV : WS_APOOL)), (size_t)mt * 256, 256, 0);
        const bf16_t* W = (const bf16_t*)(p.ws + (isconv ? WS_WPW : WS_WPOOL)) + (size_t)l * 65536;
        b = make_b(W, W + (size_t)128 * 256, 256);
    }
    DI void epi(f32x4 (&acc)[2][2][4][2], int u, const int wv_) const {
        const bool isconv = u < 288; const int mt = isconv ? u : u - 288;
        bf16_t* CAT = (bf16_t*)(p.ws + WS_CAT);
        if (isconv) { EPI_FOR8(acc, { store_bf16x8(CAT + (size_t)(mt * 256 + lr) * 1024 + lc, v0, v1); }); }
        else { const int t_ = otid(), c0_ = ((t_ >> 6) & 3) * 32 + ((t_ & 63) >> 4) * 8; f32x4 sc_[2][2];
#pragma unroll
               for (int bj = 0; bj < 2; ++bj)
#pragma unroll
                   for (int n = 0; n < 2; ++n) sc_[bj][n] = *(const f32x4*)(p.pool_scale + l * 256 + bj * 128 + n * 4 + c0_);
               EPI_FOR8(acc, { store_bf16x8(CAT + (size_t)(mt * 256 + lr) * 1024 + 256 + lc, v0 * sc_[bj][0], v1 * sc_[bj][1]); }); }
    }
};
DI void phase_B(const Params& p, LAS char* shm, int l, const int wv_) {
    { PvConvPool pv{p, l}; gemm_stream(shm, pv, wv_); }
    const int n_post = TT / 64, n_carry = 128;
    for (int u = first_unit(576); u < n_post + n_carry; u += gridDim.x) {
        if (u < n_post) qkvpost_unit(p, shm, l, u, wv_);
        else s5carry_unit(p, l, u - n_post, wv_);
    }
}

template <bool NS> DI void attn_unit(const Params& p, LAS char* shm, int l, int b, int h, int qrow0, int nq, int key_lo, int nkeys, const float sh2, const int wv_) {
    const int tid = otid(), wid = tid >> 6, lane = tid & 63, l31 = lane & 31, hh = lane >> 5;
    const bf16_t* Q = (const bf16_t*)(p.ws + WS_Q);
    const bf16_t* KBp = (const bf16_t*)(p.ws + WS_KB) + (size_t)(b * 4 + h) * 2304 * 96;
    const bf16_t* VTp = (const bf16_t*)(p.ws + WS_VT) + (size_t)(b * 4 + h) * 64 * 2304;
    bf16_t* CAT = (bf16_t*)(p.ws + WS_CAT);
    LAS char* kl = shm;
    LAS char* vl = shm + 13312;
    const bool active = wid * 64 < nq;
    LAS char* const wq = shm + 2 * 13312 + 2 * 9216 + wid * 12288 + lane * 16;
    if (active) {
#pragma unroll
        for (int qb = 0; qb < 2; ++qb)
#pragma unroll
            for (int ks = 0; ks < 6; ++ks) *(LAS bf16x8*)(wq + (qb * 6 + ks) * 1024) = *(const bf16x8*)(Q + (size_t)(qrow0 + wid * 64 + qb * 32 + l31) * 384 + h * 96 + ks * 16 + hh * 8);
    }
    f32x16 O[2][2];
#pragma unroll
    for (int a = 0; a < 2; ++a)
#pragma unroll
        for (int c = 0; c < 2; ++c)
#pragma unroll
            for (int i = 0; i < 16; ++i) O[a][c][i] = 0.f;
    float lsum[2] = {0.f, 0.f};
    const int ntile = nkeys / 64;
    LAS char* const kb0 = shm;
    LAS char* const vb0 = shm + 2 * 13312;
    u32x4 kreg0, kreg1, vreg;
    const int k_kr0 = tid / 12, k_p0 = tid % 12, k_kr1 = (tid + 512) / 12, k_p1 = (tid + 512) % 12, v_vd = tid >> 3, v_p = tid & 7;
#define A_LOADK(T_) do { const int key_ = key_lo + (T_) * 64; kreg0 = *(const u32x4*)(KBp + (size_t)(key_ + k_kr0) * 96 + k_p0 * 8); \
        if (tid < 256) kreg1 = *(const u32x4*)(KBp + (size_t)(key_ + k_kr1) * 96 + k_p1 * 8); } while (0)
#define A_LOADV(T_) do { const int key_ = key_lo + (T_) * 64; vreg = *(const u32x4*)(VTp + (size_t)v_vd * 2304 + key_ + v_p * 8); } while (0)
#define A_WRITEK(buf_) do { LAS char* kl_ = kb0 + (buf_) * 13312; *(LAS u32x4*)(kl_ + k_kr0 * 208 + k_p0 * 16) = kreg0; if (tid < 256) *(LAS u32x4*)(kl_ + k_kr1 * 208 + k_p1 * 16) = kreg1; } while (0)
#define A_WRITEV(buf_) do { LAS char* vl_ = vb0 + (buf_) * 9216; *(LAS u32x4*)(vl_ + v_vd * 144 + v_p * 16) = vreg; } while (0)
#define A_QK(S_, kbuf_, half_) do { const LAS char* kl_ = kb0 + (kbuf_) * 13312 + ((half_) * 32 + l31) * 208 + hh * 16; \
        _Pragma("unroll") for (int ks = 0; ks < 6; ++ks) { const bf16x8 a_ = *(const LAS bf16x8*)(kl_ + ks * 32); \
            if (ks == 0) { _Pragma("unroll") for (int qb = 0; qb < 2; ++qb) { f32x16 z_; _Pragma("unroll") for (int i = 0; i < 16; ++i) z_[i] = 0.f; S_[qb] = __builtin_amdgcn_mfma_f32_32x32x16_bf16(a_, *(const LAS bf16x8*)(wq + (qb * 6) * 1024), z_, 0, 0, 0); } } \
            else { _Pragma("unroll") for (int qb = 0; qb < 2; ++qb) S_[qb] = __builtin_amdgcn_mfma_f32_32x32x16_bf16(a_, *(const LAS bf16x8*)(wq + (qb * 6 + ks) * 1024), S_[qb], 0, 0, 0); } } } while (0)
#define A_SOFTMAX(S_, P_) do { _Pragma("unroll") for (int qb = 0; qb < 2; ++qb) { float e_[16]; \
        _Pragma("unroll") for (int i = 0; i < 16; ++i) { e_[i] = __builtin_amdgcn_exp2f(NS ? S_[qb][i] : S_[qb][i] - sh2); lsum[qb] += e_[i]; } \
        _Pragma("unroll") for (int s_ = 0; s_ < 2; ++s_) { u32x4 w_; w_.x = pk_bf16(e_[8 * s_], e_[8 * s_ + 1]); w_.y = pk_bf16(e_[8 * s_ + 2], e_[8 * s_ + 3]); w_.z = pk_bf16(e_[8 * s_ + 4], e_[8 * s_ + 5]); w_.w = pk_bf16(e_[8 * s_ + 6], e_[8 * s_ + 7]); \
            P_[qb][s_] = __builtin_bit_cast(bf16x8, w_); } } } while (0)
#define A_PV(P_, vbuf_, half_) do { const LAS char* vl_ = vb0 + (vbuf_) * 9216 + l31 * 144 + hh * 8; \
        _Pragma("unroll") for (int s_ = 0; s_ < 2; ++s_) { const int kk_ = (half_) * 2 + s_; \
            _Pragma("unroll") for (int vb = 0; vb < 2; ++vb) { \
                const s16x4 lo_ = *(const LAS s16x4*)(vl_ + vb * 32 * 144 + kk_ * 32); const s16x4 hi_ = *(const LAS s16x4*)(vl_ + vb * 32 * 144 + kk_ * 32 + 16); \
                const bf16x8 va_ = __builtin_shufflevector(lo_, hi_, 0, 1, 2, 3, 4, 5, 6, 7); \
                _Pragma("unroll") for (int qb = 0; qb < 2; ++qb) O[vb][qb] = __builtin_amdgcn_mfma_f32_32x32x16_bf16(va_, P_[qb][s_], O[vb][qb], 0, 0, 0); } } } while (0)
#define A_LDF(p_) (*(const LAS bf16x8*)(p_))
#define A_LDV(p_) __builtin_shufflevector(*(const LAS s16x4*)(p_), *(const LAS s16x4*)((p_) + 16), 0, 1, 2, 3, 4, 5, 6, 7)
#define A_SOFT4(g_, Ss_) do { _Pragma("unroll") for (int j_ = 0; j_ < 2; ++j_) { const int ix_ = (g_) * 4 + j_ * 2, qb_ = ix_ >> 4, i_ = ix_ & 15; \
        const float e0_ = __builtin_amdgcn_exp2f(NS ? Ss_[qb_][i_] : Ss_[qb_][i_] - sh2), e1_ = __builtin_amdgcn_exp2f(NS ? Ss_[qb_][i_ + 1] : Ss_[qb_][i_ + 1] - sh2); lsum[qb_] += e0_ + e1_; pw_[ix_ >> 1] = pk_bf16(e0_, e1_); } } while (0)
#define A_STEP(Sq_, kbufq_, halfq_, Ss_, Ps_, Pp_, vbufp_, halfp_) do { \
        const LAS char* kl_ = kb0 + (kbufq_) * 13312 + ((halfq_) * 32 + l31) * 208 + hh * 16; \
        const LAS char* vl_ = vb0 + (vbufp_) * 9216 + l31 * 144 + hh * 8 + (halfp_) * 64; \
        bf16x8 fa_[2], fq_[2][2], fv_[2]; unsigned pw_[16]; \
        fa_[0] = A_LDF(kl_); fq_[0][0] = A_LDF(wq); fq_[0][1] = A_LDF(wq + 6 * 1024); \
        __builtin_amdgcn_sched_barrier(0); \
        _Pragma("unroll") for (int g_ = 0; g_ < 6; ++g_) { \
            if (g_ < 5) { fa_[(g_ + 1) & 1] = A_LDF(kl_ + (g_ + 1) * 32); fq_[(g_ + 1) & 1][0] = A_LDF(wq + (g_ + 1) * 1024); fq_[(g_ + 1) & 1][1] = A_LDF(wq + (6 + g_ + 1) * 1024); } \
            else fv_[0] = A_LDV(vl_); \
            if (g_ == 0) { _Pragma("unroll") for (int qb = 0; qb < 2; ++qb) { f32x16 z_; _Pragma("unroll") for (int i = 0; i < 16; ++i) z_[i] = 0.f; Sq_[qb] = __builtin_amdgcn_mfma_f32_32x32x16_bf16(fa_[0], fq_[0][qb], z_, 0, 0, 0); } } \
            else { _Pragma("unroll") for (int qb = 0; qb < 2; ++qb) Sq_[qb] = __builtin_amdgcn_mfma_f32_32x32x16_bf16(fa_[g_ & 1], fq_[g_ & 1][qb], Sq_[qb], 0, 0, 0); } \
            A_SOFT4(g_, Ss_); \
            __builtin_amdgcn_sched_barrier(0); } \
        _Pragma("unroll") for (int g_ = 0; g_ < 4; ++g_) { const int s_ = g_ >> 1, vb_ = g_ & 1; \
            if (g_ < 3) fv_[(g_ + 1) & 1] = A_LDV(vl_ + ((g_ + 1) & 1) * 32 * 144 + ((g_ + 1) >> 1) * 32); \
            _Pragma("unroll") for (int qb = 0; qb < 2; ++qb) O[vb_][qb] = __builtin_amdgcn_mfma_f32_32x32x16_bf16(fv_[g_ & 1], Pp_[qb][s_], O[vb_][qb], 0, 0, 0); \
            if (g_ < 2) A_SOFT4(6 + g_, Ss_); \
            __builtin_amdgcn_sched_barrier(0); } \
        _Pragma("unroll") for (int qb = 0; qb < 2; ++qb) _Pragma("unroll") for (int s_ = 0; s_ < 2; ++s_) { u32x4 w_; w_.x = pw_[qb * 8 + s_ * 4]; w_.y = pw_[qb * 8 + s_ * 4 + 1]; w_.z = pw_[qb * 8 + s_ * 4 + 2]; w_.w = pw_[qb * 8 + s_ * 4 + 3]; Ps_[qb][s_] = __builtin_bit_cast(bf16x8, w_); } \
    } while (0)
#define A_SCHED(n_) do { _Pragma("unroll") for (int g_ = 0; g_ < (n_); ++g_) { __builtin_amdgcn_sched_group_barrier(0x008, 1, 0); __builtin_amdgcn_sched_group_barrier(0x002, 5, 0); } } while (0)
    {
        u32x4 k1a = (u32x4){0u, 0u, 0u, 0u}, k1b = k1a;
        A_LOADK(0); A_LOADV(0);
        if (ntile > 1) { const int key_ = key_lo + 64; k1a = *(const u32x4*)(KBp + (size_t)(key_ + k_kr0) * 96 + k_p0 * 8); if (tid < 256) k1b = *(const u32x4*)(KBp + (size_t)(key_ + k_kr1) * 96 + k_p1 * 8); }
        A_WRITEK(0); A_WRITEV(0);
        kreg0 = k1a; kreg1 = k1b; A_WRITEK(1);
        if (ntile > 2) A_LOADK(2);
        if (ntile > 1) A_LOADV(1);
    }
    __syncthreads();
    f32x16 Sa[2], Sb[2]; bf16x8 Pa[2][2], Pb[2][2];
    if (active) { A_QK(Sa, 0, 0); A_QK(Sb, 0, 1); A_SOFTMAX(Sa, Pa); A_SCHED(12); }
    for (int T = 0; T < ntile; ++T) {
        const int kcur = T & 1, knxt = kcur ^ 1;
        __syncthreads();
        if (T + 2 < ntile) A_WRITEK(kcur);
        if (T + 1 < ntile) A_WRITEV(knxt);
        if (T + 3 < ntile) A_LOADK(T + 3);
        if (T + 2 < ntile) A_LOADV(T + 2);
        if (active) {
            if (T + 1 < ntile) {
                A_STEP(Sa, knxt, 0, Sb, Pb, Pa, kcur, 0);
                A_STEP(Sb, knxt, 1, Sa, Pa, Pb, kcur, 1);
            } else {
                A_SOFTMAX(Sb, Pb); A_PV(Pa, kcur, 0); A_SCHED(8);
                __builtin_amdgcn_sched_barrier(0);
                A_PV(Pb, kcur, 1);
            }
        }
    }
#undef A_LOADK
#undef A_LOADV
#undef A_WRITEK
#undef A_WRITEV
#undef A_QK
#undef A_SOFTMAX
#undef A_PV
#undef A_SCHED
#undef A_STEP
#undef A_SOFT4
#undef A_LDF
#undef A_LDV
    if (active) {
#pragma unroll
        for (int qb = 0; qb < 2; ++qb) {
            const float tot = lsum[qb] + shx(lsum[qb], 32);
            const float inv = 1.f / tot;
            bf16_t* orow = CAT + (size_t)(qrow0 + wid * 64 + qb * 32 + l31) * 1024 + 768 + h * 64;
#pragma unroll
            for (int vb = 0; vb < 2; ++vb)
#pragma unroll
                for (int i4 = 0; i4 < 4; ++i4)
                    store_bf16x4(orow + vb * 32 + 8 * i4 + 4 * hh, O[vb][qb][4 * i4] * inv, O[vb][qb][4 * i4 + 1] * inv, O[vb][qb][4 * i4 + 2] * inv, O[vb][qb][4 * i4 + 3] * inv);
        }
    }
    __syncthreads();
}
struct PvS5Out {
    const Params& p; int l;
    PV_NOHOOKS
    static constexpr int NT = 20; static constexpr int FP8 = 0; static constexpr bool PARK = false; typedef ASeg2 AS; typedef BSimple BS;
    DI int first() const { return lin_first(512, 320); }
    DI int next(int u) const { return lin_next(u, 320); }
    DI void src(int u, AS& as, BS& bs, const int wv_) const {
        const int ntile = u & 3, mt = (u >> 2) % 5, g = u / 20;
        int R[2], C[2]; stage_coords(R, C, wv_);
        as.base0 = (const char*)(p.ws + WS_P); as.base1 = (const char*)(p.ws + WS_HIN); as.ks0 = 4 * NINP * 2; as.nt0 = 16;
#pragma unroll
        for (int h = 0; h < 2; ++h)
#pragma unroll
            for (int i = 0; i < 2; ++i) { const int cr = min(mt * 256 + h * 128 + R[i], NCROW - 1);
                as.off0[h][i] = (unsigned)(((size_t)(crow_tok(cr) + (C[i] >> 4)) * NINP + OFF_SSM + g * 16 + (C[i] & 15)) * 2);
                as.off1[h][i] = (unsigned)((((size_t)cr * 16 + g) * 256 + C[i]) * 2); }
        const bf16_t* W = (const bf16_t*)(p.ws + WS_TS5) + ((size_t)(l * 16 + g) * 1024 + ntile * 256) * 1280;
        bs = make_b(W, W + (size_t)128 * 1280, 1280);
    }
    DI void epi(f32x4 (&acc)[2][2][4][2], int u, const int wv_) const {
        const int ntile = u & 3, mt = (u >> 2) % 5, g = u / 20;
        bf16_t* Z = (bf16_t*)(p.ws + WS_Z);
        EPI_FOR8(acc, { const int cr = mt * 256 + lr; if (cr < NCROW) { const int col = ntile * 256 + lc, t = col >> 4, co = col & 15;
            const f32x4 g0 = (f32x4){gelu_tanh(v0[0]), gelu_tanh(v0[1]), gelu_tanh(v0[2]), gelu_tanh(v0[3])}, g1_ = (f32x4){gelu_tanh(v1[0]), gelu_tanh(v1[1]), gelu_tanh(v1[2]), gelu_tanh(v1[3])};
            store_bf16x8(Z + (size_t)(crow_tok(cr) + t) * 256 + g * 16 + co, g0, g1_); } });
    }
};
DI void phase_C(const Params& p, LAS char* shm, int l, const int wv_) {
    float sh2;
    { const int lane = otid() & 63; float gq = 0.f, gk = 0.f;
      for (int i = lane; i < 96; i += 64) { gq = fmaxf(gq, fabsf(p.mla_q_g[l * 96 + i])); gk = fmaxf(gk, fabsf(p.mla_k_g[l * 96 + i])); }
      gq = wave_max(gq); gk = wave_max(gk);
      const float c2 = 9.797958971132712f * gq * gk * 1.4426950408889634f;
      sh2 = fmaxf(c2 - 64.f, 0.f); }
    const bool ns = __builtin_amdgcn_readfirstlane(__float_as_int(sh2)) == 0;
    for (int u = blockIdx.x; u < 512; u += gridDim.x) { const int qb = u & 3, h = (u >> 2) & 3, b = u >> 4;
        if (ns) attn_unit<true>(p, shm, l, b, h, b * SEQ + qb * 512, 512, 0, 2304, 0.f, wv_);
        else attn_unit<false>(p, shm, l, b, h, b * SEQ + qb * 512, 512, 0, 2304, sh2, wv_); }
    { PvS5Out pv{p, l}; gemm_stream(shm, pv, wv_); }
    if (l == 0) for (int u = first_unit(512 + 320); u < 128; u += gridDim.x) { const int h = u & 3, b = u >> 2;
        if (ns) attn_unit<true>(p, shm, l, b, h, TX + b * CTXL, 256, 2048, 256, 0.f, wv_);
        else attn_unit<false>(p, shm, l, b, h, TX + b * CTXL, 256, 2048, 256, sh2, wv_); }
}

struct PvGlu {
    const Params& p; int l;
    PV_NOHOOKS
    static constexpr int NT = 4; static constexpr int FP8 = 0; static constexpr bool PARK = false; typedef APlain AS; typedef BSimple BS;
    DI int first() const { return lin_first(0, 288); }
    DI int next(int u) const { return lin_next(u, 288); }
    DI void src(int u, AS& a, BS& b, const int wv_) const {
        a = make_a_plain((const bf16_t*)(p.ws + WS_Z), (size_t)u * 256, 256, 0);
        const bf16_t* W = (const bf16_t*)(p.ws + WS_WGLU) + (size_t)l * 65536;
        b = make_b(W, W + (size_t)128 * 256, 256);
    }
    DI void epi(f32x4 (&acc)[2][2][4][2], int u, const int wv_) const {
        const bf16_t* Z = (const bf16_t*)(p.ws + WS_Z); bf16_t* CAT = (bf16_t*)(p.ws + WS_CAT);
        const int _tz = otid(), _w = _tz >> 6, _l = _tz & 63, _wr = _w >> 2, _wc = _w & 3, _fr = _l & 15, _fq = _l >> 4;
        const int c0 = _wc * 32 + _fq * 8;
        f32x4 bsv[2][2];
#pragma unroll
        for (int bj = 0; bj < 2; ++bj)
#pragma unroll
            for (int n = 0; n < 2; ++n) bsv[bj][n] = *(const f32x4*)(p.ssm_glu_b + l * 256 + bj * 128 + n * 4 + c0);
#pragma unroll
        for (int ai = 0; ai < 2; ++ai) {
            u32x4 zz[4][2];
#pragma unroll
            for (int m = 0; m < 4; ++m)
#pragma unroll
                for (int bj = 0; bj < 2; ++bj) zz[m][bj] = *(const u32x4*)(Z + (size_t)(u * 256 + ai * 128 + _wr * 64 + m * 16 + _fr) * 256 + bj * 128 + c0);
#pragma unroll
            for (int m = 0; m < 4; ++m) { const size_t r = (size_t)(u * 256 + ai * 128 + _wr * 64 + m * 16 + _fr);
#pragma unroll
                for (int bj = 0; bj < 2; ++bj) { const f32x4 a0 = acc[ai][bj][m][0], a1 = acc[ai][bj][m][1]; const f32x4 b0 = bsv[bj][0], b1 = bsv[bj][1]; const u32x4 z_ = zz[m][bj];
                    const f32x4 o0 = (f32x4){bflo(z_.x) * sigmoidf_(a0[0] + b0[0]), bfhi(z_.x) * sigmoidf_(a0[1] + b0[1]), bflo(z_.y) * sigmoidf_(a0[2] + b0[2]), bfhi(z_.y) * sigmoidf_(a0[3] + b0[3])};
                    const f32x4 o1 = (f32x4){bflo(z_.z) * sigmoidf_(a1[0] + b1[0]), bfhi(z_.z) * sigmoidf_(a1[1] + b1[1]), bflo(z_.w) * sigmoidf_(a1[2] + b1[2]), bfhi(z_.w) * sigmoidf_(a1[3] + b1[3])};
                    store_bf16x8(CAT + r * 1024 + 512 + bj * 128 + c0, o0, o1); } }
        }
    }
};
DI void phase_D(const Params& p, LAS char* shm, int l, const int wv_) {
    PvGlu pv{p, l}; gemm_stream(shm, pv, wv_);
}

struct PvOutproj {
    const Params& p; int l;
    PV_NOHOOKS
    static constexpr int NT = 16; static constexpr int FP8 = 0; static constexpr bool PARK = false; typedef APlain AS; typedef BSimple BS;
    XcdDeal<4, 4> deal;
    DI int first() const { return deal.first(); }
    DI int next(int u) const { return deal.next(u); }
    DI void src(int u, AS& a, BS& b, const int wv_) const {
        int mt, nt; deal.decode(u, mt, nt);
        const bf16_t* W = (const bf16_t*)(p.ws + WS_WMO) + (size_t)l * 1024 * 1024;
        a = make_a_plain((const bf16_t*)(p.ws + WS_CAT), (size_t)mt * 256, 1024, 0);
        b = make_b(W + (size_t)(nt * 256) * 1024, W + (size_t)(nt * 256 + 128) * 1024, 1024);
    }
    DI void epi(f32x4 (&acc)[2][2][4][2], int u, const int wv_) const {
        int mt, nt; deal.decode(u, mt, nt);
        bf16_t* X = (bf16_t*)(p.ws + WS_X);
        const float* MOD = (const float*)(p.ws + WS_MOD) + (size_t)l * 33 * 6144;
        const int _tz = otid(), _w = _tz >> 6, _l = _tz & 63, _wr = _w >> 2, _wc = _w & 3, _fr = _l & 15, _fq = _l >> 4;
        const int c0 = nt * 256 + _wc * 32 + _fq * 8;
        const int row0 = mt * 256;
        const float* g1p = MOD + (size_t)mod_row(row0) * 6144 + 2048 + c0;
        f32x4 g1[2][2];
#pragma unroll
        for (int bj = 0; bj < 2; ++bj)
#pragma unroll
            for (int n = 0; n < 2; ++n) g1[bj][n] = *(const f32x4*)(g1p + bj * 128 + n * 4);
        bf16_t* obase = X + (size_t)row0 * 1024;
        if (l == 0) {
            const float* xbase = row0 < TX ? p.x + (size_t)row0 * 1024 : p.ctx + (size_t)(row0 - TX) * 1024;
#pragma unroll
            for (int ai = 0; ai < 2; ++ai)
#pragma unroll
                for (int mp = 0; mp < 2; ++mp) {
                    f32x4 xv[2][2][2];
#pragma unroll
                    for (int mm = 0; mm < 2; ++mm)
#pragma unroll
                        for (int bj = 0; bj < 2; ++bj)
#pragma unroll
                            for (int n = 0; n < 2; ++n) xv[mm][bj][n] = *(const f32x4*)(xbase + (size_t)(ai * 128 + _wr * 64 + (mp * 2 + mm) * 16 + _fr) * 1024 + c0 + bj * 128 + n * 4);
#pragma unroll
                    for (int mm = 0; mm < 2; ++mm)
#pragma unroll
                        for (int bj = 0; bj < 2; ++bj)
                            store_bf16x8(obase + (size_t)(ai * 128 + _wr * 64 + (mp * 2 + mm) * 16 + _fr) * 1024 + c0 + bj * 128,
                                         xv[mm][bj][0] + g1[bj][0] * acc[ai][bj][mp * 2 + mm][0], xv[mm][bj][1] + g1[bj][1] * acc[ai][bj][mp * 2 + mm][1]);
                }
        } else {
#pragma unroll
            for (int ai = 0; ai < 2; ++ai) {
                u32x4 xv[4][2];
#pragma unroll
                for (int m = 0; m < 4; ++m)
#pragma unroll
                    for (int bj = 0; bj < 2; ++bj) xv[m][bj] = *(const u32x4*)(obase + (size_t)(ai * 128 + _wr * 64 + m * 16 + _fr) * 1024 + c0 + bj * 128);
#pragma unroll
                for (int m = 0; m < 4; ++m)
#pragma unroll
                    for (int bj = 0; bj < 2; ++bj) { const u32x4 x_ = xv[m][bj];
                        const f32x4 x0 = (f32x4){bflo(x_.x), bfhi(x_.x), bflo(x_.y), bfhi(x_.y)}, x1 = (f32x4){bflo(x_.z), bfhi(x_.z), bflo(x_.w), bfhi(x_.w)};
                        store_bf16x8(obase + (size_t)(ai * 128 + _wr * 64 + m * 16 + _fr) * 1024 + c0 + bj * 128, x0 + g1[bj][0] * acc[ai][bj][m][0], x1 + g1[bj][1] * acc[ai][bj][m][1]); }
            }
        }
    }
};
DI void phase_E(const Params& p, LAS char* shm, int l, const int wv_) {
    PvOutproj pv{p, l, {(l == 1 ? TX : TT) / 256}}; gemm_stream(shm, pv, wv_);
}

template <int S> DI float row_rot_f(float v) { return __int_as_float(__builtin_amdgcn_update_dpp(0, __float_as_int(v), 0x120 | S, 0xf, 0xf, false)); }
template <int S> DI int row_rot_i(int v) { return __builtin_amdgcn_update_dpp(0, v, 0x120 | S, 0xf, 0xf, false); }
template <int S> struct RankAcc {
    static DI void run(float o0, float o1, int oe, float v0, float v1, int e0, int& r0, int& r1) {
        const float a0 = S ? row_rot_f<S>(o0) : o0, a1 = S ? row_rot_f<S>(o1) : o1; const int ae = S ? row_rot_i<S>(oe) : oe;
        r0 += (a0 > v0 || (a0 == v0 && ae < e0)) ? 1 : 0;
        r0 += (a1 > v0) ? 1 : 0;
        r1 += (a0 > v1 || a0 == v1) ? 1 : 0;
        r1 += (a1 > v1 || (a1 == v1 && ae < e0)) ? 1 : 0;
        RankAcc<S + 1>::run(o0, o1, oe, v0, v1, e0, r0, r1);
    }
};
template <> struct RankAcc<16> { static DI void run(float, float, int, float, float, int, int&, int&) {} };
DI float row_sum16(float v) { v += row_rot_f<8>(v); v += row_rot_f<4>(v); v += row_rot_f<2>(v); v += row_rot_f<1>(v); return v; }
DI float row_max16(float v) { v = fmaxf(v, row_rot_f<8>(v)); v = fmaxf(v, row_rot_f<4>(v)); v = fmaxf(v, row_rot_f<2>(v)); v = fmaxf(v, row_rot_f<1>(v)); return v; }

DI void phase_router(const Params& p, LAS char* shm, int l, const int wv_) {
    const int tid = otid(), wid = tid >> 6, lane = tid & 63;
    const int Tm = (l == 1) ? TX : TT;
    const bf16_t* X = (const bf16_t*)(p.ws + WS_X);
    const float* MOD = (const float*)(p.ws + WS_MOD) + (size_t)l * 33 * 6144;
    unsigned char* H8 = (unsigned char*)(p.ws + WS_H);
    const bool alt = p.ph_lo != 0;
    int* CNT = (int*)(p.ws + WS_CNT) + l * 32 + (alt ? 64 : 0);
    int* LIST = alt ? (int*)(p.ws + WS_RY) : (int*)(p.ws + WS_LIST);
    LAS char* wfr = shm;
    LAS bf16_t* gml = (LAS bf16_t*)(shm + 131072);
    LAS bf16_t* shl = gml + 1024;
    LAS float* cvec = (LAS float*)(shm + 131072 + 4096);
    LAS int* lcnt = (LAS int*)(cvec + 32);
    LAS int* lbase = lcnt + 32;
    LAS unsigned* lrec = (LAS unsigned*)(lbase + 32);
    LAS float* lwt = (LAS float*)(lrec + 1152);
    const int tpw = (Tm + gridDim.x - 1) / gridDim.x;
    const int tbeg = blockIdx.x * tpw, tend = min(tbeg + tpw, Tm);
    if (tid < 32) lcnt[tid] = 0;
    int seg_beg = tbeg;
    while (seg_beg < tend) {
        const int mrow = mod_row(seg_beg);
        int seg_end = tend;
        if (mrow < 32) seg_end = min(tend, (mrow + 1) * SEQ); else seg_end = tend;
        const float* mr = MOD + (size_t)mrow * 6144;
        __syncthreads();
        for (int k = tid; k < 1024; k += 512) { const float gmv = p.norm2_g[l * 1024 + k] * (1.f + mr[4096 + k]); gml[k] = f2bf(gmv); shl[k] = f2bf(mr[3072 + k]); }
#pragma unroll 8
        for (int i = tid; i < 1024 * 8; i += 512) {
            const int k = i >> 3, e4 = (i & 7) * 4;
            const float gmv = p.norm2_g[l * 1024 + k] * (1.f + mr[4096 + k]);
            const f32x4 w = *(const f32x4*)(p.router_w + (size_t)l * 32768 + k * 32 + e4);
            const int ks = k >> 5, kq = (k >> 3) & 3, j = k & 7;
#pragma unroll
            for (int c = 0; c < 4; ++c) { const int e = e4 + c, nb = e >> 4, ei = e & 15; const float wv = w[c] * gmv;
                const bf16_t hi = f2bf(wv); const bf16_t lo = f2bf(wv - bf2f(hi));
                LAS bf16_t* dst = (LAS bf16_t*)(wfr + ((size_t)((ks * 2 + nb) * 2) * 64 + (kq * 16 + ei)) * 16) + j;
                dst[0] = hi; dst[64 * 8] = lo; }
        }
        {
            float s4[4] = {0.f, 0.f, 0.f, 0.f};
#pragma unroll 8
            for (int k = lane; k < 1024; k += 64) { const float shv = mr[3072 + k]; const f32x4 w = *(const f32x4*)(p.router_w + (size_t)l * 32768 + k * 32 + wid * 4);
                s4[0] += shv * w[0]; s4[1] += shv * w[1]; s4[2] += shv * w[2]; s4[3] += shv * w[3]; }
#pragma unroll
            for (int c = 0; c < 4; ++c) { const float t_ = wave_sum(s4[c]); if (lane == 0) cvec[wid * 4 + c] = t_ + p.router_b[l * 32 + wid * 4 + c]; }
        }
        __syncthreads();
        const int ngroups = (seg_end - seg_beg) >> 4;
        for (int gi = wid; gi < ngroups; gi += 8) {
            const int t0 = seg_beg + gi * 16;
            const int tok = lane & 15, kq = lane >> 4;
            const bf16_t* xr = X + (size_t)(t0 + tok) * 1024 + kq * 8;
            f32x4 acc0 = {0.f, 0.f, 0.f, 0.f}, acc1 = {0.f, 0.f, 0.f, 0.f};
            float ss = 0.f;
            u32x4 xa[16], xb[16];
#pragma unroll
            for (int k2 = 0; k2 < 16; ++k2) xa[k2] = *(const u32x4*)(xr + k2 * 32);
#pragma unroll
            for (int k2 = 0; k2 < 16; ++k2) xb[k2] = *(const u32x4*)(xr + (16 + k2) * 32);
#pragma unroll
            for (int kc = 0; kc < 2; ++kc) {
#pragma unroll
            for (int k2 = 0; k2 < 16; ++k2) { const int ks = kc * 16 + k2;
                if ((k2 & 3) == 0) __builtin_amdgcn_sched_barrier(0);
                const u32x4 xh = kc == 0 ? xa[k2] : xb[k2];
                const float x0 = bflo(xh.x), x1 = bfhi(xh.x), x2 = bflo(xh.y), x3 = bfhi(xh.y), x4 = bflo(xh.z), x5 = bfhi(xh.z), x6 = bflo(xh.w), x7 = bfhi(xh.w);
                ss += x0 * x0 + x1 * x1 + x2 * x2 + x3 * x3 + x4 * x4 + x5 * x5 + x6 * x6 + x7 * x7;
                const bf16x8 ah = __builtin_bit_cast(bf16x8, xh);
                const LAS char* wb = wfr + (size_t)(ks * 4) * 1024 + lane * 16;
                const bf16x8 b0h = *(const LAS bf16x8*)(wb), b0l = *(const LAS bf16x8*)(wb + 1024), b1h = *(const LAS bf16x8*)(wb + 2048), b1l = *(const LAS bf16x8*)(wb + 3072);
                acc0 = __builtin_amdgcn_mfma_f32_16x16x32_bf16(ah, b0h, acc0, 0, 0, 0); acc0 = __builtin_amdgcn_mfma_f32_16x16x32_bf16(ah, b0l, acc0, 0, 0, 0);
                acc1 = __builtin_amdgcn_mfma_f32_16x16x32_bf16(ah, b1h, acc1, 0, 0, 0); acc1 = __builtin_amdgcn_mfma_f32_16x16x32_bf16(ah, b1l, acc1, 0, 0, 0);
            } }
            u32x4 xp[16];
#pragma unroll
            for (int k2 = 0; k2 < 16; ++k2) xp[k2] = *(const u32x4*)(xr + k2 * 32);
            ss += shx(ss, 16); ss += shx(ss, 32);
            const float rn = rsqrtf(ss * (1.f / 1024.f) + EPS);
            const int ei = lane & 15;
            const float c0v = cvec[ei], c1v = cvec[16 + ei];
#pragma unroll
            for (int r = 0; r < 4; ++r) {
                const int tl = (lane >> 4) * 4 + r;
                const float rnt = shi(rn, tl);
                float v0 = fminf(fmaxf(acc0[r] * rnt + c0v, -1e30f), 1e30f), v1 = fminf(fmaxf(acc1[r] * rnt + c1v, -1e30f), 1e30f);
                int r0 = 0, r1 = 0;
                RankAcc<0>::run(v0, v1, ei, v0, v1, ei, r0, r1);
                const float mx = row_max16(fmaxf(v0, v1));
                const bool s0 = r0 < 4, s1 = r1 < 4;
                const float e0 = s0 ? __expf(v0 - mx) : 0.f, e1 = s1 ? __expf(v1 - mx) : 0.f;
                const float inv = 1.f / row_sum16(e0 + e1);
                const int t = t0 + tl;
                if (s0) { const int pos = atomicAdd((int*)&lcnt[ei], 1); lrec[(t - tbeg) * 4 + r0] = (unsigned)ei | ((unsigned)pos << 8); lwt[(t - tbeg) * 4 + r0] = e0 * inv; }
                if (s1) { const int pos = atomicAdd((int*)&lcnt[16 + ei], 1); lrec[(t - tbeg) * 4 + r1] = (unsigned)(16 + ei) | ((unsigned)pos << 8); lwt[(t - tbeg) * 4 + r1] = e1 * inv; }
            }
            unsigned char* hr = H8 + (size_t)(t0 + tok) * 1024 + kq * 8;
#pragma unroll 1
            for (int kc = 0; kc < 2; ++kc) {
            u32x4 xv[16];
            if (kc == 0) {
#pragma unroll
                for (int k2 = 0; k2 < 16; ++k2) xv[k2] = xp[k2];
            } else {
#pragma unroll
                for (int k2 = 0; k2 < 16; ++k2) xv[k2] = *(const u32x4*)(xr + (16 + k2) * 32);
            }
#pragma unroll
            for (int k2 = 0; k2 < 16; ++k2) { const int ks = kc * 16 + k2;
                const u32x4 xh = xv[k2];
                const u32x4 gq = *(const LAS u32x4*)(gml + ks * 32 + kq * 8), sq = *(const LAS u32x4*)(shl + ks * 32 + kq * 8);
                float h[8];
                h[0] = bflo(xh.x) * rn * bflo(gq.x) + bflo(sq.x); h[1] = bfhi(xh.x) * rn * bfhi(gq.x) + bfhi(sq.x); h[2] = bflo(xh.y) * rn * bflo(gq.y) + bflo(sq.y); h[3] = bfhi(xh.y) * rn * bfhi(gq.y) + bfhi(sq.y);
                h[4] = bflo(xh.z) * rn * bflo(gq.z) + bflo(sq.z); h[5] = bfhi(xh.z) * rn * bfhi(gq.z) + bfhi(sq.z); h[6] = bflo(xh.w) * rn * bflo(gq.w) + bflo(sq.w); h[7] = bfhi(xh.w) * rn * bfhi(gq.w) + bfhi(sq.w);
#pragma unroll
                for (int i = 0; i < 8; ++i) h[i] = __builtin_amdgcn_fmed3f(h[i], -448.f, 448.f);
                u32x2 o; o.x = pk_fp8x4(h[0], h[1], h[2], h[3]); o.y = pk_fp8x4(h[4], h[5], h[6], h[7]);
                *(u32x2*)(hr + ks * 32) = o;
            } }
        }
        seg_beg = seg_end;
    }
    __syncthreads();
    if (tid < 32) lbase[tid] = atomicAdd(&CNT[tid], lcnt[tid]);
    __syncthreads();
    for (int i = tid; i < (tend - tbeg) * 4; i += 512) { const unsigned rec = lrec[i]; const int e = rec & 255, pos = rec >> 8;
        u32x2 ent; ent.x = (unsigned)(tbeg * 4 + i); ent.y = __float_as_uint(lwt[i]);
        *(u32x2*)(LIST + ((size_t)e * TT + lbase[e] + pos) * 2) = ent; }
    __syncthreads();
}

DI void moe_tiles(const Params& p, LAS int* tstart, int l, const int wv_) {
    const int* CNT = (const int*)(p.ws + WS_CNT) + l * 32;
    if (otid() == 0) { int s = 0; for (int e = 0; e < 32; ++e) { tstart[e] = s; s += (CNT[e] + 255) >> 8; } tstart[32] = s; }
    __syncthreads();
    LAS int* ttab = (LAS int*)((LAS char*)tstart - (LDS_MISC + 64) + LDS_TTAB);
    const int MT_ = tstart[32];
    for (int mt = otid(); mt < MT_; mt += 512) { int e = 0;
#pragma unroll
        for (int i = 1; i < 32; ++i) e += (mt >= tstart[i]) ? 1 : 0;
        ttab[mt] = e | ((mt - tstart[e]) << 8); }
    __syncthreads();
}
DI int moe_find(const LAS int* tstart, int mt) { const LAS int* ttab = (const LAS int*)((const LAS char*)tstart - (LDS_MISC + 64) + LDS_TTAB); return __builtin_amdgcn_readfirstlane(ttab[mt]); }
struct PvMoe1 {
    const Params& p; int l; const LAS int* tstart; LAS char* tbl;
    static constexpr int NT = 8; static constexpr int FP8 = 2; static constexpr bool PARK = false; typedef ASimple AS; typedef BSimple BS;
    XcdDeal<4, 8> deal;
    DI int first() const { return deal.first(); }
    DI int next(int u) const { return deal.next(u); }
    typedef u32x4 Aux;
    DI void top(int u, Aux& aux, const int wv_) const {
        int mt, n8; deal.decode(u, mt, n8);
        const int ev_ = moe_find(tstart, mt); const int e = ev_ & 255;
        const int t_ = otid() & 63;
        aux = aload128(p.exp_b_in + (size_t)(l * NE + e) * 2048 + (t_ < 32 ? n8 * 128 + t_ * 4 : 1024 + n8 * 128 + (t_ - 32) * 4));
    }
    DI void mid(Aux& aux, const int wv_) const { const int t_ = otid(); asm volatile("" : "+v"(aux)); if (t_ < 64) *(LAS u32x4*)(tbl + t_ * 16) = aux; }
    DI void fix(AS& as, bool wait, const int wv_) const {
        if (wait) asm volatile("s_waitcnt vmcnt(0)" ::: "memory");
        int R[2], C[2]; stage_coords(R, C, wv_);
#pragma unroll
        for (int h = 0; h < 2; ++h)
#pragma unroll
            for (int i = 0; i < 2; ++i) { unsigned sl = as.off[h][i]; asm volatile("" : "+v"(sl)); as.off[h][i] = (sl >> 2) * 1024u + (unsigned)(C[i] * 2); }
    }
    DI void src(int u, AS& as, BS& bs, const int wv_) const {
        int mt, n8; deal.decode(u, mt, n8);
        const int ev_ = moe_find(tstart, mt); const int e = ev_ & 255;
        const int r0 = (ev_ >> 8) * 256, cnt = ((const int*)(p.ws + WS_CNT))[l * 32 + e];
        const int* lst = (const int*)(p.ws + WS_LIST) + (size_t)e * TT * 2;
        int R[2], C[2]; stage_coords(R, C, wv_);
        as.base = (const char*)(p.ws + WS_H); as.kstride = 128;
#pragma unroll
        for (int h = 0; h < 2; ++h)
#pragma unroll
            for (int i = 0; i < 2; ++i) as.off[h][i] = aload32(lst + 2 * min(r0 + h * 128 + R[i], cnt - 1));
        const char* W = (const char*)(p.ws + WS_W1) + (size_t)(l * NE + e) * 2048 * 1024;
        bs.base[0] = W + (size_t)(n8 * 128) * 1024; bs.base[1] = W + (size_t)(1024 + n8 * 128) * 1024; bs.ldb2 = 1024;
    }
    DI void epi(f32x4 (&acc)[2][2][4][2], int u, const int wv_) const {
        int mt, n8; deal.decode(u, mt, n8);
        const int ev_ = moe_find(tstart, mt); const int e = ev_ & 255;
        unsigned char* ACT = (unsigned char*)(p.ws + WS_RA);
        const int _tz = otid(), _w = _tz >> 6, _l = _tz & 63, _wr = _w >> 2, _wc = _w & 3, _fr = _l & 15, _fq = _l >> 4;
        const LAS float* bin = (const LAS float*)tbl + _wc * 32 + _fq * 8;
        f32x4 bg[2], bu[2];
#pragma unroll
        for (int n = 0; n < 2; ++n) { bg[n] = *(const LAS f32x4*)(bin + n * 4) * SWI_A; bu[n] = (*(const LAS f32x4*)(bin + 128 + n * 4) + 1.f) * (1.f / SWI_A); }
        (void)e;
#pragma unroll
        for (int ai = 0; ai < 2; ++ai)
#pragma unroll
            for (int m = 0; m < 4; ++m) { const int lr = ai * 128 + _wr * 64 + m * 16 + _fr;
                unsigned char* orow = ACT + ((size_t)mt * 256 + lr) * 1024 + n8 * 128 + _wc * 32 + _fq * 8;
                u32x2 pk;
#pragma unroll
                for (int n = 0; n < 2; ++n) {
                    float o[4];
#pragma unroll
                    for (int h2 = 0; h2 < 2; ++h2) {
                        const f32v2_t ag = {acc[ai][0][m][n][2 * h2], acc[ai][0][m][n][2 * h2 + 1]}, au = {acc[ai][1][m][n][2 * h2], acc[ai][1][m][n][2 * h2 + 1]};
                        const f32v2_t bgv = {bg[n][2 * h2], bg[n][2 * h2 + 1]}, buv = {bu[n][2 * h2], bu[n][2 * h2 + 1]};
                        f32v2_t g2 = ag * (1.f / 256.f) + bgv, u2 = au * (1.f / 256.f) + buv;
                        g2[0] = fminf(g2[0], 7.f * SWI_A); g2[1] = fminf(g2[1], 7.f * SWI_A);
                        u2[0] = __builtin_amdgcn_fmed3f(u2[0], -6.f / SWI_A, 8.f / SWI_A); u2[1] = __builtin_amdgcn_fmed3f(u2[1], -6.f / SWI_A, 8.f / SWI_A);
                        f32v2_t e2; e2[0] = __builtin_amdgcn_exp2f(-g2[0]); e2[1] = __builtin_amdgcn_exp2f(-g2[1]);
                        const f32v2_t d2 = e2 + 1.f;
                        f32v2_t r2; r2[0] = __builtin_amdgcn_rcpf(d2[0]); r2[1] = __builtin_amdgcn_rcpf(d2[1]);
                        const f32v2_t o2 = u2 * g2 * r2;
                        o[2 * h2] = o2[0]; o[2 * h2 + 1] = o2[1]; }
                    if (n == 0) pk.x = pk_fp8x4(o[0], o[1], o[2], o[3]); else pk.y = pk_fp8x4(o[0], o[1], o[2], o[3]); }
                *(u32x2*)orow = pk; }
    }
};
DI void phase_moe1(const Params& p, LAS char* shm, int l, const int wv_) {
    LAS int* tstart = (LAS int*)(shm + LDS_MISC + 64);
    moe_tiles(p, tstart, l, wv_);
    PvMoe1 pv{p, l, tstart, shm + 131072, {tstart[32]}}; gemm_stream(shm, pv, wv_);
}
struct PvMoe2 {
    const Params& p; int l; const LAS int* tstart; LAS char* tbl;
    static constexpr int NT = 8; static constexpr int FP8 = 2; static constexpr bool PARK = false; typedef APlain AS; typedef BSeq16 BS;
    XcdDeal<4, 4> deal;
    DI int first() const { return deal.first(); }
    DI int next(int u) const { return deal.next(u); }
    template <class A_> DI void fix(A_&, bool, const int) const {}
    typedef u32x4 Aux;
    DI void top(int u, Aux& aux, const int wv_) const {
        int mt, n4; deal.decode(u, mt, n4);
        const int ev_ = moe_find(tstart, mt); const int e = ev_ & 255; const int r0 = (ev_ >> 8) * 256;
        const int t_ = otid();
        const char* src_ = t_ < 128 ? (const char*)((const int*)(p.ws + WS_LIST) + (size_t)e * TT * 2 + (size_t)(r0 + 2 * t_) * 2)
                                    : (const char*)(p.exp_b_out + (size_t)(l * NE + e) * 1024 + n4 * 256 + ((t_ - 128) & 63) * 4);
        aux = aload128(src_);
    }
    DI void mid(Aux& aux, const int wv_) const { const int t_ = otid(); asm volatile("" : "+v"(aux)); if (t_ < 192) *(LAS u32x4*)(tbl + t_ * 16) = aux; }
    DI void src(int u, AS& as, BS& bs, const int wv_) const {
        int mt, n4; deal.decode(u, mt, n4);
        const int ev_ = moe_find(tstart, mt); const int e = ev_ & 255;
        as.base = (const char*)(p.ws + WS_RA) + (size_t)mt * 256 * 1024; as.lda2 = 1024;
        const char* W = (const char*)(p.ws + WS_W2) + (size_t)(l * NE + e) * 1024 * 1024;
        bs.base = W + (size_t)(n4 * 256) * 1024; bs.ldb2 = 1024;
    }
    DI void epi(f32x4 (&acc)[2][2][4][2], int u, const int wv_) const {
        int mt, n4; deal.decode(u, mt, n4);
        const int ev_ = moe_find(tstart, mt); const int e = ev_ & 255;
        const int r0 = (ev_ >> 8) * 256, cnt = ((const int*)(p.ws + WS_CNT))[l * 32 + e];
        const int* lst = (const int*)(p.ws + WS_LIST) + (size_t)e * TT * 2;
        unsigned char* Y = (unsigned char*)(p.ws + WS_RY);
        const int _tz = otid(), _w = _tz >> 6, _l = _tz & 63, _wr = _w >> 2, _wc = _w & 3, _fr = _l & 15, _fq = _l >> 4;
        const LAS float* bo = (const LAS float*)(tbl + 2048) + _wc * 64 + _fq * 16;
        u32x2 ent[2][4]; f32x4 bv[2][2];
#pragma unroll
        for (int ai = 0; ai < 2; ++ai)
#pragma unroll
            for (int m = 0; m < 4; ++m) ent[ai][m] = *(const LAS u32x2*)(tbl + (ai * 128 + _wr * 64 + m * 16 + _fr) * 8);
#pragma unroll
        for (int bj = 0; bj < 2; ++bj)
#pragma unroll
            for (int n = 0; n < 2; ++n) bv[bj][n] = *(const LAS f32x4*)(bo + bj * 8 + n * 4);
        (void)lst;
#pragma unroll
        for (int ai = 0; ai < 2; ++ai)
#pragma unroll
            for (int m = 0; m < 4; ++m) { const int lr = r0 + ai * 128 + _wr * 64 + m * 16 + _fr;
                if (lr < cnt) { const float w = __uint_as_float(ent[ai][m].y) * YSCALE; unsigned char* orow = Y + (size_t)ent[ai][m].x * 1024 + n4 * 256 + _wc * 64 + _fq * 16;
                    const float sc_ = 1.f / 256.f;
                    u32x4 pk;
#pragma unroll
                    for (int bj = 0; bj < 2; ++bj)
#pragma unroll
                        for (int n = 0; n < 2; ++n) { const f32x4 v = (acc[ai][bj][m][n] * sc_ + bv[bj][n]) * w;
                            pk[bj * 2 + n] = pk_fp8x4(__builtin_amdgcn_fmed3f(v[0], -448.f, 448.f), __builtin_amdgcn_fmed3f(v[1], -448.f, 448.f), __builtin_amdgcn_fmed3f(v[2], -448.f, 448.f), __builtin_amdgcn_fmed3f(v[3], -448.f, 448.f)); }
                    *(u32x4*)orow = pk; } }
    }
};
DI void phase_moe2(const Params& p, LAS char* shm, int l, const int wv_) {
    LAS int* tstart = (LAS int*)(shm + LDS_MISC + 64);
    moe_tiles(p, tstart, l, wv_);
    PvMoe2 pv{p, l, tstart, shm + 131072, {tstart[32]}}; gemm_stream(shm, pv, wv_);
}

DI void phase_combine(const Params& p, LAS char* shm, int l, const int wv_) {
    const int tid = otid(), wid = tid >> 6, lane = tid & 63;
    const bool alt = p.ph_lo != 0;
    const bf16_t* X = (const bf16_t*)(p.ws + WS_X);
    bf16_t* XO = alt ? (bf16_t*)(p.ws + WS_RA) : (bf16_t*)(p.ws + WS_X);
    float* OUT = alt ? (float*)(p.ws + WS_RA) : p.out;
    const unsigned char* Y = (const unsigned char*)(p.ws + WS_RY);
    const float* MOD = (const float*)(p.ws + WS_MOD);
    bf16_t* H = alt ? (bf16_t*)(p.ws + WS_RA + (size_t)TT * 1024 * 4) : (bf16_t*)(p.ws + WS_H);
    const int Tm = (l == 1) ? TX : TT;
    for (int r = blockIdx.x * 8 + wid; r < Tm; r += gridDim.x * 8) {
        const float* g2 = MOD + (size_t)(l * 33 + mod_row(r)) * 6144 + 5120;
        float v[16];
#pragma unroll
        for (int j = 0; j < 4; ++j) {
            const int col = j * 256 + lane * 4;
            f32x4 s = (f32x4){0.f, 0.f, 0.f, 0.f};
#pragma unroll
            for (int k = 0; k < 4; ++k) { const int yy = *(const int*)(Y + ((size_t)r * 4 + k) * 1024 + col); const f32v2_t ya = __builtin_amdgcn_cvt_pk_f32_fp8(yy, false), yb = __builtin_amdgcn_cvt_pk_f32_fp8(yy, true);
                s[0] += ya[0]; s[1] += ya[1]; s[2] += yb[0]; s[3] += yb[1]; }
            s *= 1.f / YSCALE;
            const u32x2 xb_ = *(const u32x2*)(X + (size_t)r * 1024 + col); const f32x4 gg = *(const f32x4*)(g2 + col);
            const f32x4 xv = (f32x4){bflo(xb_.x), bfhi(xb_.x), bflo(xb_.y), bfhi(xb_.y)};
            const f32x4 o = xv + gg * s;
            if (l == 1) *(f32x4*)(OUT + (size_t)r * 1024 + col) = o; else store_bf16x4(XO + (size_t)r * 1024 + col, o[0], o[1], o[2], o[3]);
            v[j * 4] = o[0]; v[j * 4 + 1] = o[1]; v[j * 4 + 2] = o[2]; v[j * 4 + 3] = o[3];
        }
        if (l == 0) norm_mod_store(v, p.norm1_g + 1024, MOD + (size_t)(1 * 33 + mod_row(r)) * 6144, H + (size_t)r * 1024, wv_);
    }
}

constexpr int NPH_LAYER = 10;
constexpr int NPH = 2 + 2 * NPH_LAYER;

__global__ void __launch_bounds__(512, 2) mk_forward(Params p_unused) {
    extern __shared__ __attribute__((aligned(16))) char smem_raw[];
    LAS char* shm = (LAS char*)smem_raw;
    volatile LAS unsigned* xb_words = (volatile LAS unsigned*)(shm + LDS_MISC);
    const int wv_ = __builtin_amdgcn_readfirstlane((int)(threadIdx.x >> 6));
    if (wv_ == 0 && olane() < 4) xb_words[olane()] = 0u;
    __syncthreads();
    kaptr_t ka = (kaptr_t)__builtin_amdgcn_kernarg_segment_ptr();
    const int tok0 = ptoken();
    const int lo = (int)kld64<__builtin_offsetof(Params, ph_lo)>(ka, tok0), hi = (int)kld64<__builtin_offsetof(Params, ph_hi)>(ka, tok0);
    const bool multi = (hi - lo) > 1;
    unsigned* barw = (unsigned*)((__attribute__((address_space(1))) char*)kld64<__builtin_offsetof(Params, ws)>(ka, tok0) + WS_BAR);
    XcdBarrier bar; bar.bar = barw; bar.x = 0; bar.st = xb_words;
    if (multi) bar = xcd_barrier_post(barw, xb_words, wv_);
#ifndef ONLY_KIND
#define ONLY_KIND (-1)
#endif
#define PHASE(idx, kind, FN, ...) do { if ((ONLY_KIND < 0 || ONLY_KIND == (kind)) && (idx) >= lo && (idx) < hi) { const Params p = kparams(ka, ptoken()); int nrep_ = 1 + ((MK_REPEAT_MASK >> (kind)) & 1); asm volatile("" : "+s"(nrep_)); for (int rep_ = 0; rep_ < nrep_; ++rep_) { Params p2 = p; p2.ph_lo = rep_; FN(p2, ##__VA_ARGS__, wv_); } if ((idx) + 1 < hi) xcd_barrier(bar, wv_); } } while (0)
    PHASE(0, 0, phase_prologue, shm);
    PHASE(1, 1, phase_norm1_l0);
    for (int l = 0; l < 2; ++l) {
        const int b0 = 2 + l * NPH_LAYER;
        PHASE(b0 + 0, 2, phase_inproj, shm, l);
        PHASE(b0 + 1, 3, phase_A, shm, l);
        PHASE(b0 + 2, 4, phase_B, shm, l);
        PHASE(b0 + 3, 5, phase_C, shm, l);
        PHASE(b0 + 4, 6, phase_D, shm, l);
        PHASE(b0 + 5, 7, phase_E, shm, l);
        PHASE(b0 + 6, 8, phase_router, shm, l);
        PHASE(b0 + 7, 9, phase_moe1, shm, l);
        PHASE(b0 + 8, 10, phase_moe2, shm, l);
        PHASE(b0 + 9, 11, phase_combine, shm, l);
    }
#undef PHASE
}


extern "C" void kernel_launch(void* const* d_in, const int* in_sizes, int n_in, void* d_out, int out_size, void* d_ws, size_t ws_size, hipStream_t stream) {
    static int grid = 0;
    if (grid == 0) {
        if (n_in != 39 || ws_size < WS_END) { fprintf(stderr, "kernel_launch: unexpected n_in %d or ws_size %zu (< %zu)\n", n_in, ws_size, (size_t)WS_END); grid = -1; return; }
        int dev = 0, cus = 0;
        if (hipGetDevice(&dev) != hipSuccess || hipDeviceGetAttribute(&cus, hipDeviceAttributeMultiprocessorCount, dev) != hipSuccess) { grid = -1; return; }
        if (hipFuncSetAttribute((const void*)mk_forward, hipFuncAttributeMaxDynamicSharedMemorySize, LDS_BYTES) != hipSuccess) { fprintf(stderr, "kernel_launch: hipFuncSetAttribute failed\n"); grid = -1; return; }
        int per_cu = 0;
        if (hipOccupancyMaxActiveBlocksPerMultiprocessor(&per_cu, (const void*)mk_forward, 512, LDS_BYTES) != hipSuccess || per_cu < 1) fprintf(stderr, "kernel_launch: occupancy query says %d\n", per_cu);
        (void)hipGetLastError();
        grid = cus > 256 ? 256 : cus;
    }
    if (grid < 0) return;
    (void)hipMemsetAsync((char*)d_ws + WS_BAR, 0, 16384 + 1024, stream);
    Params p{};
    const float** pf = (const float**)&p;
    for (int i = 0; i < 39; ++i) pf[i] = (const float*)d_in[i];
    p.out = (float*)d_out; p.ws = (char*)d_ws;
#if MK_ONE_LAUNCH
    p.ph_lo = 0; p.ph_hi = NPH;
    hipLaunchKernelGGL(mk_forward, dim3(grid), dim3(512), LDS_BYTES, stream, p);
#else
#ifndef MK_LAST_PHASE
#define MK_LAST_PHASE NPH
#endif
    for (int ph = 0; ph < MK_LAST_PHASE; ++ph) { p.ph_lo = ph; p.ph_hi = ph + 1; hipLaunchKernelGGL(mk_forward, dim3(grid), dim3(512), LDS_BYTES, stream, p); }
#endif
}
```

```cpp
#include <hip/hip_runtime.h>
#include <stdint.h>
#include <stdio.h>

#ifndef MK_REPEAT_MASK
#define MK_REPEAT_MASK 0x0
#endif
#ifndef MK_ONE_LAUNCH
#define MK_ONE_LAUNCH 1
#endif

#define DI __device__ __forceinline__
#define LAS __attribute__((address_space(3)))
typedef unsigned short bf16_t;
typedef short bf16x8 __attribute__((ext_vector_type(8)));
typedef short s16x4 __attribute__((ext_vector_type(4)));
typedef float f32x4 __attribute__((ext_vector_type(4)));
typedef float f32x16 __attribute__((ext_vector_type(16)));
typedef unsigned u32x2 __attribute__((ext_vector_type(2)));
typedef unsigned u32x4 __attribute__((ext_vector_type(4)));
typedef int i32x4 __attribute__((ext_vector_type(4)));
typedef int i32x8 __attribute__((ext_vector_type(8)));

constexpr int D = 1024, NB = 32, SEQ = 2048, CTXL = 256;
constexpr int TX = NB * SEQ, TC = NB * CTXL, TT = TX + TC;
constexpr int NINP = 1536;
constexpr int OFF_POOL = 512, OFF_Q = 768, OFF_SSM = 960, OFF_KV = 1216, OFF_KPE = 1344, N_IN = 1376;
constexpr int NE = 32;
constexpr int NCH = 36;
constexpr int NCROW = NB * NCH;
constexpr float EPS = 1e-6f;

constexpr size_t WS_BAR = 0;
constexpr size_t WS_CNT = 16384;
constexpr size_t WS_MOD = WS_CNT + 1024;
constexpr size_t WS_A64 = WS_MOD + (size_t)2 * 33 * 6144 * 4;
constexpr size_t WS_WMI = WS_A64 + (size_t)2 * 2 * 16 * 64 * 2 * 4;
constexpr size_t WS_WMO = WS_WMI + (size_t)2 * 1536 * 1024 * 2;
constexpr size_t WS_WPW = WS_WMO + (size_t)2 * 1024 * 1024 * 2;
constexpr size_t WS_WGLU = WS_WPW + (size_t)2 * 256 * 256 * 2;
constexpr size_t WS_WPOOL = WS_WGLU + (size_t)2 * 256 * 256 * 2;
constexpr size_t WS_WQ = WS_WPOOL + (size_t)2 * 256 * 256 * 2;
constexpr size_t WS_WKV = WS_WQ + (size_t)2 * 512 * 256 * 2;
constexpr size_t WS_TS5 = WS_WKV + (size_t)2 * 512 * 256 * 2;
constexpr size_t WS_WS5 = WS_TS5 + (size_t)2 * 16 * 1024 * 1280 * 2;
constexpr size_t WS_W1 = WS_WS5 + (size_t)2 * 16 * 256 * 1024 * 2;
constexpr size_t WS_W2 = WS_W1 + (size_t)32 * 2048 * 1024 * 2;
constexpr size_t WS_X = WS_W2 + (size_t)32 * 1024 * 1024 * 2;
constexpr size_t WS_H = WS_X + (size_t)TT * 1024 * 4;
constexpr size_t WS_LIST = WS_H + (size_t)TT * 1024 * 2;
constexpr size_t WS_TOPW = WS_LIST + (size_t)32 * TT * 8;
constexpr size_t WS_RA = WS_TOPW + (size_t)TT * 4 * 4;
constexpr float YSCALE = 32.f;
constexpr size_t WS_RY = WS_RA + (size_t)TT * 4 * 1024 * 2;
constexpr size_t WS_END = WS_RY + (size_t)TT * 4 * 1024 * 2;
constexpr size_t WS_P = WS_RA;
constexpr size_t WS_ACONV = WS_P + (size_t)TT * NINP * 2;
constexpr size_t WS_APOOL = WS_ACONV + (size_t)TT * 256 * 2;
constexpr size_t WS_RAWQ = WS_APOOL + (size_t)TT * 256 * 2;
constexpr size_t WS_RAWKV = WS_RAWQ + (size_t)TT * 512 * 4;
constexpr size_t WS_Q = WS_RAWKV + (size_t)TT * 512 * 4;
constexpr size_t WS_KB = WS_Q + (size_t)TT * 384 * 2;
constexpr size_t WS_VT = WS_KB + (size_t)128 * 2304 * 96 * 2;
constexpr size_t WS_SST = WS_VT + (size_t)128 * 64 * 2304 * 2;
constexpr size_t WS_HIN = WS_SST + (size_t)NCROW * 16 * 256 * 4;
constexpr size_t WS_Z = WS_HIN + (size_t)NCROW * 16 * 256 * 2;
constexpr size_t WS_CAT = WS_Z + (size_t)TT * 256 * 2;
constexpr size_t WS_MIX_END = WS_CAT + (size_t)TT * 1024 * 2;
static_assert(WS_MIX_END <= WS_END, "mixer buffers must fit in the ACT/Y regions");
static_assert(WS_END <= (size_t)2147483648ull, "workspace budget");

constexpr int LDS_BYTES = 147456;
constexpr int LDS_TTAB = 131072 + 4096;
constexpr int LDS_MISC = 146432;

struct Params {
    const float *x, *c, *ctx, *c_ctx, *ada_w, *ada_b, *norm1_g, *norm2_g, *w_mix_in, *w_mix_out,
        *conv_dw, *conv_dw_b, *conv_ln_g, *conv_ln_b, *conv_pw, *pool_w, *pool_scale,
        *ssm_a_re, *ssm_a_im, *ssm_log_dt, *ssm_b_re, *ssm_b_im, *ssm_c_re, *ssm_c_im, *ssm_d, *ssm_glu_w, *ssm_glu_b,
        *mla_q_a_g, *mla_wq_b, *mla_kv_a_g, *mla_wkv_b, *mla_q_g, *mla_k_g,
        *router_w, *router_b, *exp_w_in, *exp_b_in, *exp_w_out, *exp_b_out;
    float* out;
    char* ws;
    long long ph_lo, ph_hi;
};

typedef const __attribute__((address_space(4))) char* kaptr_t;
template <int OFF> DI unsigned long long kld64(kaptr_t ka, int tok) {
    unsigned long long v;
    asm("s_load_dwordx2 %0, %1, %3\n\ts_waitcnt lgkmcnt(0)" : "=&s"(v) : "s"(ka), "s"(tok), "n"(OFF));
    return v;
}
DI int ptoken() { int t; asm volatile("s_mov_b32 %0, 0" : "=s"(t)); return t; }
DI Params kparams(kaptr_t ka, int tok) {
    Params p;
#define KL_(f) p.f = (decltype(p.f))((__attribute__((address_space(1))) char*)kld64<__builtin_offsetof(Params, f)>(ka, tok))
    KL_(x); KL_(c); KL_(ctx); KL_(c_ctx); KL_(ada_w); KL_(ada_b); KL_(norm1_g); KL_(norm2_g); KL_(w_mix_in); KL_(w_mix_out); KL_(conv_dw); KL_(conv_dw_b); KL_(conv_ln_g); KL_(conv_ln_b); KL_(conv_pw); KL_(pool_w); KL_(pool_scale); KL_(ssm_a_re); KL_(ssm_a_im); KL_(ssm_log_dt); KL_(ssm_b_re); KL_(ssm_b_im); KL_(ssm_c_re); KL_(ssm_c_im); KL_(ssm_d); KL_(ssm_glu_w); KL_(ssm_glu_b); KL_(mla_q_a_g); KL_(mla_wq_b); KL_(mla_kv_a_g); KL_(mla_wkv_b); KL_(mla_q_g); KL_(mla_k_g); KL_(router_w); KL_(router_b); KL_(exp_w_in); KL_(exp_b_in); KL_(exp_w_out); KL_(exp_b_out); KL_(out); KL_(ws);
#undef KL_
    p.ph_lo = 0; p.ph_hi = 0;
    return p;
}

typedef __bf16 bf16v2_t __attribute__((ext_vector_type(2)));
typedef float f32v2_t __attribute__((ext_vector_type(2)));
DI unsigned pk_bf16(float lo, float hi) { const f32v2_t f = {lo, hi}; const bf16v2_t b = __builtin_convertvector(f, bf16v2_t); return __builtin_bit_cast(unsigned, b); }
DI bf16_t f2bf(float x) { return (bf16_t)(pk_bf16(x, 0.f) & 0xffffu); }
DI float bf2f(bf16_t v) { return __uint_as_float(((unsigned)v) << 16); }
DI unsigned f2fp8(float x) { x = fminf(fmaxf(x, -448.f), 448.f); return (unsigned)__builtin_amdgcn_cvt_pk_fp8_f32(x, x, 0, false) & 0xffu; }
DI unsigned pk_fp8x4(float a, float b, float c, float d) { int v = __builtin_amdgcn_cvt_pk_fp8_f32(a, b, 0, false); v = __builtin_amdgcn_cvt_pk_fp8_f32(c, d, v, true); return (unsigned)v; }
DI float bflo(unsigned u) { return __uint_as_float(u << 16); }
DI float bfhi(unsigned u) { return __uint_as_float(u & 0xffff0000u); }
DI int olane() { int l = (int)__builtin_amdgcn_mbcnt_hi(~0u, __builtin_amdgcn_mbcnt_lo(~0u, 0u)); asm volatile("" : "+v"(l)); return l; }
DI float shx(float v, int o) { const int l = olane(); return __int_as_float(__builtin_amdgcn_ds_bpermute((l ^ o) << 2, __float_as_int(v))); }
DI float shi(float v, int src) { return __int_as_float(__builtin_amdgcn_ds_bpermute(src << 2, __float_as_int(v))); }
#define otid() otid_(wv_)
DI int otid_(int wv) { int t = (wv << 6) | olane(); asm volatile("" : "+v"(t)); return t; }
DI float wave_sum(float v) {
#pragma unroll
    for (int o = 32; o > 0; o >>= 1) v += shx(v, o);
    return v;
}
DI float wave_max(float v) {
#pragma unroll
    for (int o = 32; o > 0; o >>= 1) v = fmaxf(v, shx(v, o));
    return v;
}
DI float sigmoidf_(float x) { return __builtin_amdgcn_rcpf(1.f + __builtin_amdgcn_exp2f(-1.4426950408889634f * x)); }
DI float siluf_(float x) { return x * sigmoidf_(x); }
DI float gelu_tanh(float x) {
    const float u = 0.7978845608028654f * (x + 0.044715f * x * x * x);
    return x * __builtin_amdgcn_rcpf(1.f + __builtin_amdgcn_exp2f(-2.8853900817779268f * u));
}
DI unsigned aload32(const void* p_) { unsigned r; asm volatile("global_load_dword %0, %1, off" : "=v"(r) : "v"(p_) : "memory"); return r; }
DI u32x4 aload128(const void* p_) { u32x4 r; asm volatile("global_load_dwordx4 %0, %1, off" : "=v"(r) : "v"(p_) : "memory"); return r; }
#define PV_NOHOOKS typedef int Aux; DI void top(int, Aux&, const int) const {} DI void mid(Aux&, const int) const {} template <class A_> DI void fix(A_&, bool, const int) const {}
DI void glds16(const void* src, LAS char* dst) {
    __builtin_amdgcn_global_load_lds((const __attribute__((address_space(1))) void*)src, (LAS void*)dst, 16, 0, 0);
}

#define XB_TMO      128
#define XB_XCNT(j)  (256  + 64 * (j))
#define XB_XSUB(j)  (1280 + 64 * (j))
#define XB_XGEN(j)  (2304 + 64 * (j))
#define XB_TOP      3328
#define XB_TOPGEN   3392
#define XCD_BAR_WORDS 3456
#define XB_SPIN_CAP (1u << 18)
__device__ __forceinline__ unsigned xb_ld(unsigned* p)              { return __hip_atomic_load(p, __ATOMIC_RELAXED, __HIP_MEMORY_SCOPE_AGENT); }
__device__ __forceinline__ unsigned xb_add(unsigned* p, unsigned v) { return __hip_atomic_fetch_add(p, v, __ATOMIC_RELAXED, __HIP_MEMORY_SCOPE_AGENT); }
__device__ __forceinline__ unsigned xb_xcc_id() { return (unsigned)__builtin_amdgcn_s_getreg((3 << 11) | 20) & 0xFu; }
#define XB_SPIN(cond, bar) do { unsigned _sp = 0; while (cond) { __builtin_amdgcn_s_sleep(1); \
    if ((++_sp & 255u) == 0u) { if (xb_ld(&(bar)[XB_TMO])) break; if (_sp > XB_SPIN_CAP) { atomicAdd(&(bar)[XB_TMO], 1u); break; } } } } while (0)
struct XcdBarrier { unsigned* bar; unsigned x; volatile LAS unsigned* st; };
__device__ __forceinline__ XcdBarrier xcd_barrier_post(unsigned* bar, volatile LAS unsigned* st, const int wv_) {
    XcdBarrier b; b.bar = bar; b.x = xb_xcc_id(); b.st = st;
    if (otid() == 0) (void)xb_add(&bar[XB_XCNT(b.x)], 1u);
    return b;
}
__device__ __forceinline__ void xcd_barrier_complete(unsigned* bar, unsigned x, unsigned& nloc, unsigned& nx) {
    const unsigned G = gridDim.x * gridDim.y * gridDim.z;
    unsigned sum, cnt, mine, sp = 0u;
    for (;;) {
        sum = 0u; cnt = 0u; mine = 0u;
#pragma unroll
        for (unsigned j = 0; j < 16; ++j) { const unsigned c = xb_ld(&bar[XB_XCNT(j)]); sum += c; cnt += (c > 0u) ? 1u : 0u; mine = (j == x) ? c : mine; }
        if (sum == G) break;
        __builtin_amdgcn_s_sleep(1);
        if ((++sp & 255u) == 0u) { if (xb_ld(&bar[XB_TMO])) break; if (sp > XB_SPIN_CAP) { atomicAdd(&bar[XB_TMO], 1u); break; } }
    }
    nloc = mine > 0u ? mine : 1u; nx = cnt > 0u ? cnt : 1u;
}
__device__ __forceinline__ void xcd_barrier(const XcdBarrier& b, const int wv_) {
    asm volatile("s_waitcnt vmcnt(0)" ::: "memory");
    __syncthreads();
    if (otid() == 0) {
        unsigned* bar = b.bar;
        __builtin_amdgcn_s_waitcnt(0);
        unsigned nloc = b.st[0], nx = b.st[1];
        if (nloc == 0u) { xcd_barrier_complete(bar, b.x, nloc, nx); b.st[0] = nloc; b.st[1] = nx; }
        const unsigned old = xb_add(&bar[XB_XSUB(b.x)], 1u);
        const unsigned gen = old / nloc;
        if (old + 1u == (gen + 1u) * nloc) {
            __builtin_amdgcn_fence(__ATOMIC_RELEASE, "agent");
            asm volatile("s_waitcnt vmcnt(0)" ::: "memory");
            const unsigned og = xb_add(&bar[XB_TOP], 1u);
            const unsigned tg = og / nx;
            if (og + 1u == (tg + 1u) * nx) xb_add(&bar[XB_TOPGEN], 1u);
            else XB_SPIN(xb_ld(&bar[XB_TOPGEN]) == tg, bar);
            __builtin_amdgcn_fence(__ATOMIC_ACQUIRE, "agent");
            xb_add(&bar[XB_XGEN(b.x)], 1u);
            asm volatile("s_waitcnt vmcnt(0)" ::: "memory");
        } else {
            XB_SPIN(xb_ld(&bar[XB_XGEN(b.x)]) == gen, bar);
            __builtin_amdgcn_fence(__ATOMIC_ACQUIRE, "agent");
            asm volatile("s_waitcnt vmcnt(0)" ::: "memory");
        }
    }
    __syncthreads();
}

constexpr int HTB = 128 * 64 * 2;
DI int lds_byte(int r, int c) { const int st = (r >> 4) * 2 + (c >> 5), rr = r & 15, cc = c & 31, ob = rr * 64 + cc * 2; return st * 1024 + (ob ^ (((ob >> 9) & 1) << 5)); }
DI void stage_rc(int b, int& R, int& C) { const int st = b / 1024, sb = b % 1024, swz = sb ^ (((sb >> 9) & 1) << 5); R = (st >> 1) * 16 + swz / 64; C = (st & 1) * 32 + (swz % 64) / 2; }

DI void stage_rc_t(int tz, int i, int& R, int& C) { stage_rc(tz * 16 + i * 8192, R, C); }
struct APlain {
    const char* base; int lda2;
    DI void park(LAS unsigned*) const {} DI void unpark(const LAS unsigned*) {} DI void take_uniform(const APlain&) {}
    DI const char* ptr(int tz, int h, int i, int kt) const { int R, C; stage_rc_t(tz, i, R, C); return base + (unsigned)((h * 128 + R) * lda2 + C * 2 + kt * 128); }
};
struct ASimple {
    const char* base; unsigned off[2][2]; unsigned kstride;
    DI void park(LAS unsigned* q) const { *(LAS u32x4*)q = (u32x4){off[0][0], off[0][1], off[1][0], off[1][1]}; }
    DI void unpark(const LAS unsigned* q) { const u32x4 v = *(const LAS u32x4*)q; off[0][0] = v.x; off[0][1] = v.y; off[1][0] = v.z; off[1][1] = v.w; }
    DI void take_uniform(const ASimple& o) { base = o.base; kstride = o.kstride; }
    DI const char* ptr(int tz, int h, int i, int kt) const { return base + (unsigned)(off[h][i] + (unsigned)kt * kstride); }
};
struct ASeg2 {
    const char* base0; const char* base1; unsigned off0[2][2]; unsigned off1[2][2]; unsigned ks0; int nt0;
    DI void park(LAS unsigned*) const {} DI void unpark(const LAS unsigned*) {} DI void take_uniform(const ASeg2&) {}
    DI const char* ptr(int tz, int h, int i, int kt) const { return kt < nt0 ? base0 + (unsigned)(off0[h][i] + (unsigned)kt * ks0) : base1 + (unsigned)(off1[h][i] + (unsigned)(kt - nt0) * 128u); }
};
DI int perm32(int rho) { const int n = rho >> 4, i = rho & 15; return 8 * (i >> 2) + 4 * n + (i & 3); }
struct BSimple {
    const char* base[2]; int ldb2;
    DI const char* ptr(int tz, int h, int i, int kt) const { int R, C; stage_rc_t(tz, i, R, C); const int Rb = (R & ~31) + perm32(R & 31); return base[h] + (unsigned)(Rb * ldb2 + C * 2 + kt * 128); }
};

struct BSeq16 {
    const char* base; int ldb2;
    DI const char* ptr(int tz, int h, int i, int kt) const { int R, C; stage_rc_t(tz, i, R, C); const int rho = R & 31;
        const int Rb = (R >> 5) * 64 + ((rho & 15) >> 2) * 16 + h * 8 + (rho >> 4) * 4 + (rho & 3); return base + (unsigned)(Rb * ldb2 + C * 2 + kt * 128); }
};

#define WAIT_V(n) asm volatile("s_waitcnt vmcnt(" #n ")" ::: "memory")
#define WAIT_L(n) asm volatile("s_waitcnt lgkmcnt(" #n ")" ::: "memory")
#define BAR_ __builtin_amdgcn_s_barrier()
#define SCHED_ __builtin_amdgcn_sched_barrier(0)

DI void zero_acc(f32x4 (&acc)[2][2][4][2]) {
#pragma unroll
    for (int a = 0; a < 2; ++a)
#pragma unroll
        for (int b = 0; b < 2; ++b)
#pragma unroll
            for (int m = 0; m < 4; ++m)
#pragma unroll
                for (int n = 0; n < 2; ++n) acc[a][b][m][n] = (f32x4){0.f, 0.f, 0.f, 0.f};
}
template <int MODE> struct FragT;
template <> struct FragT<0> {
    i32x4 lo, hi;
    DI void load(const LAS char* p0, const LAS char* p1) { lo = *(const LAS i32x4*)p0; hi = *(const LAS i32x4*)p1; }
    static DI f32x4 mma(const FragT& b, const FragT& a, f32x4 c) {
        c = __builtin_amdgcn_mfma_f32_16x16x32_bf16(__builtin_bit_cast(bf16x8, b.lo), __builtin_bit_cast(bf16x8, a.lo), c, 0, 0, 0);
        return __builtin_amdgcn_mfma_f32_16x16x32_bf16(__builtin_bit_cast(bf16x8, b.hi), __builtin_bit_cast(bf16x8, a.hi), c, 0, 0, 0); }
};
template <> struct FragT<1> {
    i32x4 lo, hi;
    DI void load(const LAS char* p0, const LAS char* p1) { lo = *(const LAS i32x4*)p0; hi = *(const LAS i32x4*)p1; }
    static DI long pk(int x, int y) { return (long)(((unsigned long long)(unsigned)y << 32) | (unsigned)x); }
    static DI f32x4 mma(const FragT& b, const FragT& a, f32x4 c) {
        c = __builtin_amdgcn_mfma_f32_16x16x32_fp8_fp8(pk(b.lo.x, b.lo.y), pk(a.lo.x, a.lo.y), c, 0, 0, 0);
        c = __builtin_amdgcn_mfma_f32_16x16x32_fp8_fp8(pk(b.lo.z, b.lo.w), pk(a.lo.z, a.lo.w), c, 0, 0, 0);
        c = __builtin_amdgcn_mfma_f32_16x16x32_fp8_fp8(pk(b.hi.x, b.hi.y), pk(a.hi.x, a.hi.y), c, 0, 0, 0);
        return __builtin_amdgcn_mfma_f32_16x16x32_fp8_fp8(pk(b.hi.z, b.hi.w), pk(a.hi.z, a.hi.w), c, 0, 0, 0); }
};
template <> struct FragT<2> {
    i32x8 v;
    DI void load(const LAS char* p0, const LAS char* p1) { const i32x4 lo = *(const LAS i32x4*)p0, hi = *(const LAS i32x4*)p1; v = __builtin_shufflevector(lo, hi, 0, 1, 2, 3, 4, 5, 6, 7); }
    static DI f32x4 mma(const FragT& b, const FragT& a, f32x4 c) {
        const int one = 0x7f7f7f7f;
        asm volatile("v_mfma_scale_f32_16x16x128_f8f6f4 %0, %1, %2, %0, %3, %3 op_sel_hi:[0,0,0]" : "+v"(c) : "v"(b.v), "v"(a.v), "v"(one));
        return c; }
};
template <class PV>
DI void gemm_stream(LAS char* shm, const PV& pv, const int wv_) {
    typedef typename PV::AS AS; typedef typename PV::BS BS;
    constexpr int nt = PV::NT;
    int u = pv.first();
    if (u < 0) return;
    const int tz = otid();
    const int wr = wv_ >> 2, wc = wv_ & 3, lane = tz & 63, fr = lane & 15, fq = lane >> 4;
    const int aoff = lds_byte(wr * 64 + fr, fq * 8), boff = lds_byte(wc * 32 + fr, fq * 8);
    const unsigned ldsw = (unsigned)wv_ * 1024u;
    f32x4 acc[2][2][4][2]; zero_acc(acc);
    typedef FragT<PV::FP8> Frag;
    Frag At[4], B0[2], B1[2];
    AS ca, na; BS cb, nb;
    pv.src(u, ca, cb, wv_); pv.fix(ca, true, wv_);
    constexpr bool F8 = PV::FP8 != 0;
    LAS unsigned* park = (LAS unsigned*)(shm + 131072) + tz * 4;
    const int aoff0 = aoff, aoff1 = aoff + 1024;
    const int boff0 = boff, boff1 = boff + 1024;
#define SA_(b, h) (((b) * 2 + (h)) * HTB)
#define SB_(b, h) ((4 + (b) * 2 + (h)) * HTB)
#define STG_(bufoff, S, h, kt) do { _Pragma("unroll") for (int i_ = 0; i_ < 2; ++i_) glds16((S).ptr(tz, h, i_, kt), shm + (bufoff) + ldsw + i_ * 8192); } while (0)
#define LDA_(dst, b, h) do { _Pragma("unroll") for (int m = 0; m < 4; ++m) dst[m].load(shm + SA_(b, h) + aoff0 + m * 2048, shm + SA_(b, h) + aoff1 + m * 2048); } while (0)
#define LDB_(dst, b, h) do { _Pragma("unroll") for (int n = 0; n < 2; ++n) dst[n].load(shm + SB_(b, h) + boff0 + n * 2048, shm + SB_(b, h) + boff1 + n * 2048); } while (0)
#define MMA2_(ai, A_, BA_, BB_) do { __builtin_amdgcn_s_setprio(1); \
        _Pragma("unroll") for (int m = 0; m < 4; ++m) _Pragma("unroll") for (int n = 0; n < 2; ++n) acc[ai][0][m][n] = Frag::mma(BA_[n], A_[m], acc[ai][0][m][n]); \
        _Pragma("unroll") for (int m = 0; m < 4; ++m) _Pragma("unroll") for (int n = 0; n < 2; ++n) acc[ai][1][m][n] = Frag::mma(BB_[n], A_[m], acc[ai][1][m][n]); \
        __builtin_amdgcn_s_setprio(0); } while (0)
#define CMEM_ asm volatile("" ::: "memory")
    STG_(SB_(0, 0), cb, 0, 0); STG_(SB_(0, 1), cb, 1, 0); STG_(SA_(0, 0), ca, 0, 0); STG_(SA_(0, 1), ca, 1, 0);
    WAIT_V(0);
    if (wr == 1) BAR_;
    BAR_; CMEM_;
#define ZQ_(ai, bj) do { _Pragma("unroll") for (int m_ = 0; m_ < 4; ++m_) _Pragma("unroll") for (int n_ = 0; n_ < 2; ++n_) acc[ai][bj][m_][n_] = (f32x4){0.f, 0.f, 0.f, 0.f}; } while (0)
    int un = -1; bool has_next = false;
    na = ca; nb = cb;
    for (;;) {
        typename PV::Aux aux;
#pragma clang loop unroll(disable)
        for (int t = 0; t < nt; t += 2) {
            const bool last = (t == nt - 2);
            if (last && has_next) pv.fix(na, false, wv_);
            AS a2 = last ? na : ca; const BS b2 = last ? nb : cb; const int k2 = last ? 0 : t + 2;
            STG_(SB_(1, 0), cb, 0, t + 1); STG_(SB_(1, 1), cb, 1, t + 1); STG_(SA_(1, 0), ca, 0, t + 1); SCHED_;
            LDB_(B0, 0, 0); LDB_(B1, 0, 1); SCHED_; LDA_(At, 0, 0); SCHED_;
            if (t == 0) { ZQ_(0, 0); ZQ_(0, 1); }
            WAIT_V(6); BAR_; WAIT_L(0); MMA2_(0, At, B0, B1); BAR_; SCHED_; CMEM_;
            if (t == 0) pv.top(u, aux, wv_);
            STG_(SA_(1, 1), ca, 1, t + 1); SCHED_;
            LDA_(At, 0, 1); SCHED_;
            if (t == 0) { ZQ_(1, 0); ZQ_(1, 1); }
            WAIT_V(2); BAR_; WAIT_L(0); if (t == 0) pv.mid(aux, wv_); MMA2_(1, At, B0, B1); BAR_; SCHED_; CMEM_;
            STG_(SB_(0, 0), b2, 0, k2); STG_(SB_(0, 1), b2, 1, k2); STG_(SA_(0, 0), a2, 0, k2); SCHED_;
            LDB_(B0, 1, 0); LDB_(B1, 1, 1); SCHED_; LDA_(At, 1, 0); SCHED_;
            WAIT_V(6); BAR_; WAIT_L(0); MMA2_(0, At, B0, B1); BAR_; SCHED_; CMEM_;
            STG_(SA_(0, 1), a2, 1, k2); SCHED_;
            LDA_(At, 1, 1); SCHED_;
            WAIT_V(2);
            if (t == 0) { un = pv.next(u); has_next = un >= 0; if (has_next) pv.src(un, na, nb, wv_); else { na = ca; nb = cb; } }
            BAR_; WAIT_L(0); MMA2_(1, At, B0, B1); BAR_; SCHED_; CMEM_;
        }
        if (PV::FP8 == 2) asm volatile("s_nop 15\n\ts_nop 15" ::: "memory");
        pv.epi(acc, u, wv_);
        if (!has_next) break;
        u = un; ca = na; cb = nb;
    }
#undef ZQ_
    WAIT_V(0);
    if (wr == 0) BAR_;
    BAR_;
#undef SA_
#undef SB_
#undef STG_
#undef LDA_
#undef LDB_
#undef MMA2_
#undef CMEM_
}
DI int lin_first(int shift, int count) { const int G = gridDim.x; const int u = (int)((blockIdx.x + G - (shift % G)) % G); return u < count ? u : -1; }
DI int lin_next(int u, int count) { const int un = u + (int)gridDim.x; return un < count ? un : -1; }
template <int MG, int NTL> struct XcdDeal {
    int MT;
    DI bool decode(int J, int& mt, int& nt) const { const int x = blockIdx.x & 7; const int grp = (J / (MG * NTL)) * 8 + x, w = J % (MG * NTL); mt = grp * MG + w / NTL; nt = w % NTL; return mt < MT; }
    DI int jmax() const { return ((MT + 8 * MG - 1) / (8 * MG)) * (MG * NTL); }
    DI int first() const { int J = blockIdx.x >> 3; const int per = gridDim.x >> 3, jm = jmax(); int mt, nt;
        while (J < jm && !decode(J, mt, nt)) J += per;
        return J < jm ? J : -1; }
    DI int next(int J) const { const int per = gridDim.x >> 3, jm = jmax(); int mt, nt; J += per;
        while (J < jm && !decode(J, mt, nt)) J += per;
        return J < jm ? J : -1; }
};
DI int first_unit(int shift) { const int G = gridDim.x; return (int)((blockIdx.x + G - (shift % G)) % G); }

DI void stage_coords(int (&R)[2], int (&C)[2], const int wv_) {
    const int t_ = otid();
#pragma unroll
    for (int i = 0; i < 2; ++i) stage_rc(t_ * 16 + i * 8192, R[i], C[i]);
}
DI APlain make_a_plain(const bf16_t* A, size_t row0, int lda, int col0) {
    APlain a; a.base = (const char*)(A + row0 * (size_t)lda + col0); a.lda2 = lda * 2; return a;
}
DI BSimple make_b(const bf16_t* Bt0, const bf16_t* Bt1, int ldb) {
    BSimple b; b.base[0] = (const char*)Bt0; b.base[1] = (const char*)Bt1; b.ldb2 = ldb * 2; return b;
}
#define EPI_FOR(acc, ...) do { const int _tz = otid(), _w = _tz >> 6, _l = _tz & 63, _wr = _w >> 2, _wc = _w & 3, _fr = _l & 15, _fq = _l >> 4; \
    _Pragma("unroll") for (int ai = 0; ai < 2; ++ai) _Pragma("unroll") for (int m = 0; m < 4; ++m) { const int lr = ai * 128 + _wr * 64 + m * 16 + _fr; \
    _Pragma("unroll") for (int bj = 0; bj < 2; ++bj) _Pragma("unroll") for (int n = 0; n < 2; ++n) { const int lc = bj * 128 + _wc * 32 + n * 16 + _fq * 4; const f32x4 v = acc[ai][bj][m][n]; __VA_ARGS__ } } } while (0)

DI void store_bf16x4(bf16_t* p, float a, float b, float c, float d) { u32x2 v; v.x = pk_bf16(a, b); v.y = pk_bf16(c, d); *(u32x2*)p = v; }
DI void store_bf16x8(bf16_t* p, const f32x4 a, const f32x4 b) { u32x4 v; v.x = pk_bf16(a[0], a[1]); v.y = pk_bf16(a[2], a[3]); v.z = pk_bf16(b[0], b[1]); v.w = pk_bf16(b[2], b[3]); *(u32x4*)p = v; }
#define EPI_FOR8(acc, ...) do { const int _tz = otid(), _w = _tz >> 6, _l = _tz & 63, _wr = _w >> 2, _wc = _w & 3, _fr = _l & 15, _fq = _l >> 4; \
    _Pragma("unroll") for (int ai = 0; ai < 2; ++ai) _Pragma("unroll") for (int m = 0; m < 4; ++m) { const int lr = ai * 128 + _wr * 64 + m * 16 + _fr; \
    _Pragma("unroll") for (int bj = 0; bj < 2; ++bj) { const int lc = bj * 128 + _wc * 32 + _fq * 8; const f32x4 v0 = acc[ai][bj][m][0], v1 = acc[ai][bj][m][1]; __VA_ARGS__ } } } while (0)

DI int mod_row(int r) { return r < TX ? (r >> 11) : 32; }
DI int crow_tok(int cr) { const int b = cr / NCH, j = cr - b * NCH; return j < 4 ? TX + b * CTXL + j * 64 : b * SEQ + (j - 4) * 64; }

DI void cvt_tile(LAS char* wl  , const float* src, int ld_src, int kvalid, int nvalid, const float* scale, bf16_t* dst, int ld_dst, const int wv_) {
    const int lane = otid() & 63;
    const int lr = lane >> 4, lc = (lane & 15) * 4;
    f32x4 v[16];
#pragma unroll
    for (int it = 0; it < 16; ++it) {
        const int k = it * 4 + lr;
        v[it] = (f32x4){0.f, 0.f, 0.f, 0.f};
        if (src != nullptr && k < kvalid && lc < nvalid) { v[it] = *(const f32x4*)(src + (size_t)k * ld_src + lc); if (scale) { const float s = scale[k]; v[it] *= s; } }
    }
#pragma unroll
    for (int it = 0; it < 16; ++it) {
        const int k = it * 4 + lr;
#pragma unroll
        for (int j = 0; j < 4; ++j) *(LAS bf16_t*)(wl + (lc + j) * 144 + k * 2) = f2bf(v[it][j]);
    }
    asm volatile("s_waitcnt lgkmcnt(0)" ::: "memory");
#pragma unroll
    for (int i = 0; i < 8; ++i) {
        const int q = i * 64 + lane, n = q >> 3, c = q & 7;
        const u32x4 w = *(const LAS u32x4*)(wl + n * 144 + c * 16);
        *(u32x4*)(dst + (size_t)n * ld_dst + c * 8) = w;
    }
    asm volatile("s_waitcnt lgkmcnt(0)" ::: "memory");
}
constexpr float SWI_A = 2.4554669595930156f;
DI void cvt_tile8(LAS char* wl  , const float* src, int ld_src, unsigned char* dst, int ld_dst, const float wscale, const int wv_) {
    const int lane = otid() & 63;
    const int lr = lane >> 4, lc = (lane & 15) * 4;
    f32x4 v[16];
#pragma unroll
    for (int it = 0; it < 16; ++it) v[it] = *(const f32x4*)(src + (size_t)(it * 4 + lr) * ld_src + lc);
#pragma unroll
    for (int it = 0; it < 16; ++it) {
        const int k = it * 4 + lr;
#pragma unroll
        for (int j = 0; j < 4; ++j) *(LAS unsigned char*)(wl + (lc + j) * 80 + k) = (unsigned char)f2fp8(v[it][j] * wscale);
    }
    asm volatile("s_waitcnt lgkmcnt(0)" ::: "memory");
#pragma unroll
    for (int i = 0; i < 4; ++i) {
        const int q = i * 64 + lane, n = q >> 2, c = q & 3;
        const u32x4 w = *(const LAS u32x4*)(wl + n * 80 + c * 16);
        *(u32x4*)(dst + (size_t)n * ld_dst + c * 16) = w;
    }
    asm volatile("s_waitcnt lgkmcnt(0)" ::: "memory");
}
constexpr int CVT_SMALL_TILES = 768 + 512 + 32 + 32 + 64 + 64 + 32;
constexpr int CVT_EXP_TILES = 32 * (32 * 16 + 16 * 16);
DI void cvt_small(const Params& p, LAS char* wl, int t, const int wv_) {
    char* ws = p.ws;
    if (t < 768) { const int l = t / 384, r = t % 384, nt = r / 16, kt = r % 16;
        cvt_tile(wl, p.w_mix_in + (size_t)l * 1024 * N_IN + (size_t)kt * 64 * N_IN + nt * 64, N_IN, 64, N_IN - nt * 64, nullptr,
                 (bf16_t*)(ws + WS_WMI) + ((size_t)l * 1536 + nt * 64) * 1024 + kt * 64, 1024, wv_); return; }
    t -= 768;
    if (t < 512) { const int l = t / 256, r = t % 256, nt = r / 16, kt = r % 16;
        cvt_tile(wl, p.w_mix_out + (size_t)l * 1024 * 1024 + (size_t)kt * 64 * 1024 + nt * 64, 1024, 64, 64, nullptr,
                 (bf16_t*)(ws + WS_WMO) + ((size_t)l * 1024 + nt * 64) * 1024 + kt * 64, 1024, wv_); return; }
    t -= 512;
    if (t < 32) { const int l = t / 16, r = t % 16, nt = r / 4, kt = r % 4;
        cvt_tile(wl, p.conv_pw + (size_t)l * 65536 + (size_t)kt * 64 * 256 + nt * 64, 256, 64, 64, nullptr,
                 (bf16_t*)(ws + WS_WPW) + ((size_t)l * 256 + nt * 64) * 256 + kt * 64, 256, wv_); return; }
    t -= 32;
    if (t < 32) { const int l = t / 16, r = t % 16, nt = r / 4, kt = r % 4;
        cvt_tile(wl, p.ssm_glu_w + (size_t)l * 65536 + (size_t)kt * 64 * 256 + nt * 64, 256, 64, 64, nullptr,
                 (bf16_t*)(ws + WS_WGLU) + ((size_t)l * 256 + nt * 64) * 256 + kt * 64, 256, wv_); return; }
    t -= 32;
    if (t < 64) { const int l = t / 32, r = t % 32, nt = r / 4, kt = r % 4;
        const bool any = (kt < 3) && (nt < 6);
        cvt_tile(wl, any ? p.mla_wq_b + (size_t)l * 192 * 384 + (size_t)kt * 64 * 384 + nt * 64 : nullptr, 384, 64, 64, p.mla_q_a_g + l * 192 + kt * 64,
                 (bf16_t*)(ws + WS_WQ) + ((size_t)l * 512 + nt * 64) * 256 + kt * 64, 256, wv_); return; }
    t -= 64;
    if (t < 64) { const int l = t / 32, r = t % 32, nt = r / 4, kt = r % 4;
        const bool any = (kt < 2);
        cvt_tile(wl, any ? p.mla_wkv_b + (size_t)l * 128 * 512 + (size_t)kt * 64 * 512 + nt * 64 : nullptr, 512, 64, 64, p.mla_kv_a_g + l * 128 + kt * 64,
                 (bf16_t*)(ws + WS_WKV) + ((size_t)l * 512 + nt * 64) * 256 + kt * 64, 256, wv_); return; }
    t -= 64;
    { const int l = t / 16, r = t % 16, nt = r / 4, kt = r % 4;
        cvt_tile(wl, nt == kt ? p.pool_w + ((size_t)l * 4 + nt) * 4096 : nullptr, 64, 64, 64, nullptr,
                 (bf16_t*)(ws + WS_WPOOL) + ((size_t)l * 256 + nt * 64) * 256 + kt * 64, 256, wv_); }
}
DI void cvt_expert(const Params& p, LAS char* wl, int l, int t, const int wv_) {
    char* ws = p.ws;
    const int e = t / 768, r = t % 768;
    if (r < 512) { const int nt = r / 16, kt = r % 16;
        cvt_tile8(wl, p.exp_w_in + ((size_t)(l * NE + e) * 1024 + kt * 64) * 2048 + nt * 64, 2048,
                  (unsigned char*)(ws + WS_W1) + ((size_t)(l * NE + e) * 2048 + nt * 64) * 1024 + kt * 64, 1024, nt < 16 ? 256.f * SWI_A : 256.f / SWI_A, wv_);
    } else { const int q = r - 512, nt = q / 16, kt = q % 16;
        cvt_tile8(wl, p.exp_w_out + ((size_t)(l * NE + e) * 1024 + kt * 64) * 1024 + nt * 64, 1024,
                  (unsigned char*)(ws + WS_W2) + ((size_t)(l * NE + e) * 1024 + nt * 64) * 1024 + kt * 64, 1024, 256.f, wv_);
    }
}

DI void ada_unit(const Params& p, LAS char* shm, int u, const int wv_) {
    const int tid = otid();
    const int l = u / 48, jc = u % 48;
    LAS float* sc = (LAS float*)shm;
    for (int i = tid; i < 33 * 1024; i += 512) { const int r = i >> 10, k = i & 1023; const float v = r < 32 ? p.c[r * 1024 + k] : p.c_ctx[k]; sc[i] = siluf_(v); }
    __syncthreads();
    const int col = tid & 127, kq = tid >> 7;
    float acc[33];
#pragma unroll
    for (int r = 0; r < 33; ++r) acc[r] = 0.f;
    const float* wp = p.ada_w + ((size_t)l * 1024 + kq * 256) * 6144 + jc * 128 + col;
    for (int k4 = 0; k4 < 256; k4 += 4) {
        float w[4];
#pragma unroll
        for (int i = 0; i < 4; ++i) w[i] = wp[(size_t)(k4 + i) * 6144];
#pragma unroll
        for (int r = 0; r < 33; ++r) { const f32x4 s = *(const LAS f32x4*)(sc + r * 1024 + kq * 256 + k4); acc[r] += s[0] * w[0] + s[1] * w[1] + s[2] * w[2] + s[3] * w[3]; }
    }
    __syncthreads();
    LAS float* red = (LAS float*)shm;
#pragma unroll
    for (int r = 0; r < 33; ++r) red[(kq * 33 + r) * 128 + col] = acc[r];
    __syncthreads();
    for (int i = tid; i < 33 * 128; i += 512) { const int r = i >> 7, cc = i & 127;
        const float s = red[(0 * 33 + r) * 128 + cc] + red[(1 * 33 + r) * 128 + cc] + red[(2 * 33 + r) * 128 + cc] + red[(3 * 33 + r) * 128 + cc];
        ((float*)(p.ws + WS_MOD))[((size_t)l * 33 + r) * 6144 + jc * 128 + cc] = s + p.ada_b[l * 6144 + jc * 128 + cc]; }
    __syncthreads();
}

DI void s5_load_bc(const Params& p, LAS float* bb, LAS float* cc, int l, int dir, int g, int tid) {
    const int pbase = ((l * 2 + dir) * 16 + g) * 64;
    const double dt = exp((double)p.ssm_log_dt[(l * 2 + dir) * 16 + g]);
    for (int i = tid; i < 64 * 16; i += 512) { const int q = i >> 4, ci = i & 15;
        const double are = fmin((double)p.ssm_a_re[pbase + q], -1e-4), aim = (double)p.ssm_a_im[pbase + q];
        const double mg = exp(are * dt), abr = mg * cos(aim * dt), abi = mg * sin(aim * dt), den = are * are + aim * aim;
        const double fre = ((abr - 1.0) * are + abi * aim) / den, fim = (abi * are - (abr - 1.0) * aim) / den;
        const double br = (double)p.ssm_b_re[(size_t)(pbase + q) * 16 + ci], bi = (double)p.ssm_b_im[(size_t)(pbase + q) * 16 + ci];
        bb[i * 2] = (float)(fre * br - fim * bi); bb[i * 2 + 1] = (float)(fre * bi + fim * br); }
    for (int i = tid; i < 16 * 64; i += 512) { const int co = i >> 6, q = i & 63;
        const size_t ix = ((size_t)((l * 2 + dir) * 16 + g) * 16 + co) * 64 + q;
        cc[i * 2] = p.ssm_c_re[ix]; cc[i * 2 + 1] = p.ssm_c_im[ix]; }
}
DI void s5pre_unit(const Params& p, LAS char* shm, int u, const int wv_) {
    const int tid = otid();
    const int l = u >> 5, g = (u >> 1) & 15, dir = u & 1;
    LAS float* pw = (LAS float*)shm;
    LAS float* bb = pw + 65 * 64 * 2;
    LAS float* cc = bb + 64 * 16 * 2;
    LAS float* kk = cc + 16 * 64 * 2;
    LAS float* k0o = kk + 64 * 256;
    bf16_t* TS = (bf16_t*)(p.ws + WS_TS5) + (size_t)(l * 16 + g) * 1024 * 1280;
    bf16_t* WS = (bf16_t*)(p.ws + WS_WS5) + (size_t)(l * 16 + g) * 256 * 1024;
    const int cocip = tid & 255, co_ = cocip >> 4, ci_ = cocip & 15;
    if (dir == 0) {
        s5_load_bc(p, bb, cc, l, 1, g, tid);
        __syncthreads();
        if (tid < 256) { float s_ = 0.f;
            for (int q = 0; q < 64; ++q) s_ += cc[(co_ * 64 + q) * 2] * bb[(q * 16 + ci_) * 2] - cc[(co_ * 64 + q) * 2 + 1] * bb[(q * 16 + ci_) * 2 + 1];
            k0o[tid] = s_; }
        __syncthreads();
    }
    {
        const int pbase = ((l * 2 + dir) * 16 + g) * 64;
        const double dt = exp((double)p.ssm_log_dt[(l * 2 + dir) * 16 + g]);
        for (int i = tid; i < 65 * 64; i += 512) { const int tau = i >> 6, q = i & 63;
            const double are = fmin((double)p.ssm_a_re[pbase + q], -1e-4), aim = (double)p.ssm_a_im[pbase + q];
            const double mg = exp(are * dt * tau), an = aim * dt * tau;
            pw[i * 2] = (float)(mg * cos(an)); pw[i * 2 + 1] = (float)(mg * sin(an)); }
        s5_load_bc(p, bb, cc, l, dir, g, tid);
        __syncthreads();
        if (tid < 64) { float* a64 = (float*)(p.ws + WS_A64) + (size_t)(((l * 2 + dir) * 16 + g) * 64 + tid) * 2; a64[0] = pw[(64 * 64 + tid) * 2]; a64[1] = pw[(64 * 64 + tid) * 2 + 1]; }
        { float gr[64], gi[64];
#pragma unroll
          for (int q = 0; q < 64; ++q) { const float cr = cc[(co_ * 64 + q) * 2], cim = cc[(co_ * 64 + q) * 2 + 1], br = bb[(q * 16 + ci_) * 2], bi = bb[(q * 16 + ci_) * 2 + 1];
              gr[q] = cr * br - cim * bi; gi[q] = cr * bi + cim * br; }
          for (int tau = (tid >> 8); tau < 64; tau += 2) {
              float s_ = 0.f;
#pragma unroll
              for (int q = 0; q < 64; ++q) s_ += gr[q] * pw[(tau * 64 + q) * 2] - gi[q] * pw[(tau * 64 + q) * 2 + 1];
              kk[tau * 256 + cocip] = s_;
          } }
        for (int i = tid; i < 128 * 512; i += 512) { const int row = i >> 9, kp = (i & 511) * 2, ri = row >> 6, q = row & 63, s_ = kp >> 4, ci = kp & 15;
            const int e = dir == 0 ? 63 - s_ : s_;
            const float pr = pw[(e * 64 + q) * 2], pi = pw[(e * 64 + q) * 2 + 1];
            float o[2];
#pragma unroll
            for (int j = 0; j < 2; ++j) { const float br = bb[(q * 16 + ci + j) * 2], bi = bb[(q * 16 + ci + j) * 2 + 1]; o[j] = ri == 0 ? pr * br - pi * bi : pr * bi + pi * br; }
            *(unsigned*)(WS + (size_t)(dir * 128 + row) * 1024 + kp) = pk_bf16(o[0], o[1]); }
        for (int i = tid; i < 1024 * 64; i += 512) { const int row = i >> 6, kp = (i & 63) * 2, t = row >> 4, co = row & 15, ri = kp >> 6, q = kp & 63;
            const int e = dir == 0 ? t + 1 : 64 - t;
            float o[2];
#pragma unroll
            for (int j = 0; j < 2; ++j) { const float pr = pw[(e * 64 + q + j) * 2], pi = pw[(e * 64 + q + j) * 2 + 1];
                const float cr = cc[(co * 64 + q + j) * 2], cim = cc[(co * 64 + q + j) * 2 + 1];
                o[j] = ri == 0 ? (cr * pr - cim * pi) : -(cr * pi + cim * pr); }
            *(unsigned*)(TS + (size_t)row * 1280 + 1024 + dir * 128 + kp) = pk_bf16(o[0], o[1]); }
        __syncthreads();
        for (int rr = tid; rr < 1024; rr += 512) { const int t = rr >> 4, co = rr & 15;
            const float dco = p.ssm_d[l * 256 + g * 16 + co];
            bf16_t* rowp = TS + (size_t)rr * 1280;
            const int s_lo = dir == 0 ? 0 : t + 1, s_hi = dir == 0 ? t : 63;
            for (int s_ = s_lo; s_ <= s_hi; ++s_) { const int tau = dir == 0 ? t - s_ : s_ - t;
                unsigned w[8];
#pragma unroll
                for (int j = 0; j < 8; ++j) { float a = kk[tau * 256 + co * 16 + 2 * j], b2 = kk[tau * 256 + co * 16 + 2 * j + 1];
                    if (s_ == t) { a += k0o[co * 16 + 2 * j]; b2 += k0o[co * 16 + 2 * j + 1]; if (2 * j == co) a += dco; if (2 * j + 1 == co) b2 += dco; }
                    w[j] = pk_bf16(a, b2); }
                *(u32x4*)(rowp + s_ * 16) = (u32x4){w[0], w[1], w[2], w[3]}; *(u32x4*)(rowp + s_ * 16 + 8) = (u32x4){w[4], w[5], w[6], w[7]}; }
        }
        __syncthreads();
    }
}

DI void phase_prologue(const Params& p, LAS char* shm, const int wv_) {
    const int tid = otid();
    __syncthreads();
    if (blockIdx.x == 0 && tid < 64) ((int*)(p.ws + WS_CNT))[tid] = 0;
    const int n_cvt = (CVT_SMALL_TILES + 2 * CVT_EXP_TILES + 7) / 8;
    for (int u = blockIdx.x; u < 160; u += gridDim.x) {
        if (u < 64) s5pre_unit(p, shm, u, wv_);
        else ada_unit(p, shm, u - 64, wv_);
    }
    int* wq = (int*)(p.ws + WS_CNT) + 192;
    volatile LAS int* slot = (volatile LAS int*)(shm + LDS_MISC + 32);
    __syncthreads();
    if (tid == 0) slot[0] = atomicAdd(wq, 1);
    __syncthreads();
    int cu = slot[0], par = 0;
    while (cu < n_cvt) {
        int nxt = 0;
        if (tid == 0) nxt = atomicAdd(wq, 1);
        const int t = cu * 8 + wv_;
        LAS char* wl = shm + wv_ * (64 * 144);
        if (t < CVT_SMALL_TILES) cvt_small(p, wl, t, wv_);
        else if (t < CVT_SMALL_TILES + 2 * CVT_EXP_TILES) { const int te = t - CVT_SMALL_TILES; cvt_expert(p, wl, te / CVT_EXP_TILES, te % CVT_EXP_TILES, wv_); }
        par ^= 1;
        if (tid == 0) slot[par] = nxt;
        __syncthreads();
        cu = slot[par];
    }
}

DI void norm_mod_store(const float (&v)[16], const float* g, const float* modrow  , bf16_t* hrow, const int wv_) {
    const int lane = otid() & 63;
    float ss = 0.f;
#pragma unroll
    for (int i = 0; i < 16; ++i) ss += v[i] * v[i];
    ss = wave_sum(ss);
    const float rn = rsqrtf(ss * (1.f / 1024.f) + EPS);
#pragma unroll
    for (int j = 0; j < 4; ++j) {
        const int col = j * 256 + lane * 4;
        const f32x4 gg = *(const f32x4*)(g + col), sh = *(const f32x4*)(modrow + col), sc = *(const f32x4*)(modrow + 1024 + col);
        float o[4];
#pragma unroll
        for (int i = 0; i < 4; ++i) o[i] = v[j * 4 + i] * rn * gg[i] * (1.f + sc[i]) + sh[i];
        store_bf16x4(hrow + col, o[0], o[1], o[2], o[3]);
    }
}
DI void phase_norm1_l0(const Params& p, const int wv_) {
    const int tid_ = otid(); const int wid = tid_ >> 6, lane = tid_ & 63;
    const float* MOD = (const float*)(p.ws + WS_MOD);
    bf16_t* H = (bf16_t*)(p.ws + WS_H);
    for (int r = blockIdx.x * 8 + wid; r < TT; r += gridDim.x * 8) {
        const float* src = r < TX ? p.x + (size_t)r * 1024 : p.ctx + (size_t)(r - TX) * 1024;
        float v[16];
#pragma unroll
        for (int j = 0; j < 4; ++j) { const f32x4 t = *(const f32x4*)(src + j * 256 + lane * 4); v[j * 4] = t[0]; v[j * 4 + 1] = t[1]; v[j * 4 + 2] = t[2]; v[j * 4 + 3] = t[3]; }
        norm_mod_store(v, p.norm1_g, MOD + (size_t)(0 * 33 + mod_row(r)) * 6144, H + (size_t)r * 1024, wv_);
    }
}

struct PvInproj {
    const Params& p; int l;
    PV_NOHOOKS
    static constexpr int NT = 16; static constexpr int FP8 = 0; static constexpr bool PARK = false; typedef APlain AS; typedef BSimple BS;
    XcdDeal<4, 6> deal;
    DI int first() const { return deal.first(); }
    DI int next(int u) const { return deal.next(u); }
    DI void src(int u, AS& a, BS& b, const int wv_) const {
        int mt, nt; deal.decode(u, mt, nt);
        const bf16_t* W = (const bf16_t*)(p.ws + WS_WMI) + (size_t)l * 1536 * 1024;
        a = make_a_plain((const bf16_t*)(p.ws + WS_H), (size_t)mt * 256, 1024, 0);
        b = nt < 2 ? make_b(W + (size_t)(nt * 128) * 1024, W + (size_t)(256 + nt * 128) * 1024, 1024)
                   : make_b(W + (size_t)(nt * 256) * 1024, W + (size_t)(nt * 256 + 128) * 1024, 1024);
    }
    DI void epi(f32x4 (&acc)[2][2][4][2], int u, const int wv_) const {
        int mt, nt; deal.decode(u, mt, nt);
        bf16_t* P = (bf16_t*)(p.ws + WS_P);
        if (nt < 2) {
            const int _tz = otid(), _w = _tz >> 6, _l = _tz & 63, _wr = _w >> 2, _wc = _w & 3, _fr = _l & 15, _fq = _l >> 4;
#pragma unroll
            for (int ai = 0; ai < 2; ++ai)
#pragma unroll
                for (int m = 0; m < 4; ++m) { const int lr = ai * 128 + _wr * 64 + m * 16 + _fr; const int lc = _wc * 32 + _fq * 8;
                    f32x4 o0, o1;
#pragma unroll
                    for (int r = 0; r < 4; ++r) { o0[r] = acc[ai][0][m][0][r] * sigmoidf_(acc[ai][1][m][0][r]); o1[r] = acc[ai][0][m][1][r] * sigmoidf_(acc[ai][1][m][1][r]); }
                    store_bf16x8(P + (size_t)(mt * 256 + lr) * NINP + nt * 128 + lc, o0, o1); }
        } else {
            EPI_FOR8(acc, { store_bf16x8(P + (size_t)(mt * 256 + lr) * NINP + nt * 256 + lc, v0, v1); });
        }
    }
};
DI void phase_inproj(const Params& p, LAS char* shm, int l, const int wv_) {
    PvInproj pv{p, l, {TT / 256}};
    gemm_stream(shm, pv, wv_);
}

template <int N> DI void wave_sum_n(float (&v)[N]) {
    const int l4 = olane();
#pragma unroll
    for (int o = 32; o > 0; o >>= 1) {
        float t_[N];
#pragma unroll
        for (int i = 0; i < N; ++i) t_[i] = __int_as_float(__builtin_amdgcn_ds_bpermute((l4 ^ o) << 2, __float_as_int(v[i])));
#pragma unroll
        for (int i = 0; i < N; ++i) v[i] += t_[i];
    }
}
template <int WIN, bool EDGE>
DI void pool_run(const LAS bf16_t* pin  , bf16_t* AP, int row0, int ts0, int L, int c, int half) {
    for (int blk = 0; blk < 2; ++blk) {
        const int t0 = half * 32 + blk * 16;
        float in[16 + WIN - 1];
#pragma unroll
        for (int i = 0; i < 16 + WIN - 1; ++i) in[i] = bf2f(pin[(t0 + i - WIN / 2 + 8) * 256 + c]);
        float sum = 0.f;
#pragma unroll
        for (int j = 0; j < WIN; ++j) sum += in[j];
#pragma unroll
        for (int o = 0; o < 16; ++o) {
            float inv = 1.f / (float)WIN;
            if (EDGE) { const int ts = ts0 + t0 + o; const int lo = max(ts - WIN / 2, 0), hi = min(ts + WIN - 1 - WIN / 2, L - 1); inv = 1.f / (float)(hi - lo + 1); }
            AP[(size_t)(row0 + t0 + o) * 256 + c] = f2bf(sum * inv - in[o + WIN / 2]);
            if (o < 15) sum += in[o + WIN] - in[o];
        }
    }
}
template <bool EDGE>
DI void pre_unit_t(const Params& p, LAS char* shm, int l, int row0, int ts0, int L, const float (&w)[31], const float bias, const int wv_) {
    const int tid = otid();
    const bf16_t* P = (const bf16_t*)(p.ws + WS_P);
    const int c = tid & 255, half = tid >> 8;
    LAS bf16_t* cin = (LAS bf16_t*)shm;
    LAS float* cv = (LAS float*)(shm + 49152);
    u32x4 creg[6], preg[5];
#pragma unroll
    for (int it = 0; it < 6; ++it) { const int q = it * 512 + tid, row = q >> 5, part = q & 31; const int ts = ts0 - 15 + row;
        creg[it] = (u32x4){0u, 0u, 0u, 0u};
        if (q < 94 * 32 && (!EDGE || (ts >= 0 && ts < L))) creg[it] = *(const u32x4*)(P + (size_t)(row0 - 15 + row) * NINP + part * 8); }
#pragma unroll
    for (int it = 0; it < 5; ++it) { const int q = it * 512 + tid, row = q >> 5, part = q & 31; const int ts = ts0 - 8 + row;
        preg[it] = (u32x4){0u, 0u, 0u, 0u};
        if (!EDGE || (ts >= 0 && ts < L)) preg[it] = *(const u32x4*)(P + (size_t)(row0 - 8 + row) * NINP + OFF_POOL + part * 8); }
#pragma unroll
    for (int it = 0; it < 6; ++it) { const int q = it * 512 + tid; if (q < 94 * 32) *(LAS u32x4*)(cin + q * 8) = creg[it]; }
    __syncthreads();
    {
        const int t0 = half * 32;
        float in[62];
#pragma unroll
        for (int i = 0; i < 62; ++i) in[i] = bf2f(cin[(t0 + i) * 256 + c]);
#pragma unroll
        for (int o = 0; o < 32; ++o) { float s_ = bias;
#pragma unroll
            for (int j = 0; j < 31; ++j) s_ += w[j] * in[o + j];
            cv[(t0 + o) * 257 + c] = s_; }
    }
    __syncthreads();
#pragma unroll
    for (int it = 0; it < 5; ++it) *(LAS u32x4*)(cin + (it * 512 + tid) * 8) = preg[it];
    {
        const int wid = tid >> 6, lane = tid & 63;
        bf16_t* AC = (bf16_t*)(p.ws + WS_ACONV);
        float lg[4], lb[4];
#pragma unroll
        for (int j = 0; j < 4; ++j) { lg[j] = p.conv_ln_g[l * 256 + lane + 64 * j]; lb[j] = p.conv_ln_b[l * 256 + lane + 64 * j]; }
        float x[8][4], s8[8];
#pragma unroll
        for (int i = 0; i < 8; ++i) { s8[i] = 0.f;
#pragma unroll
            for (int j = 0; j < 4; ++j) { x[i][j] = cv[(wid * 8 + i) * 257 + lane + 64 * j]; s8[i] += x[i][j]; } }
        wave_sum_n<8>(s8);
#pragma unroll
        for (int i = 0; i < 8; ++i) { const float mu = s8[i] * (1.f / 256.f); s8[i] = 0.f;
#pragma unroll
            for (int j = 0; j < 4; ++j) { x[i][j] -= mu; s8[i] += x[i][j] * x[i][j]; } }
        wave_sum_n<8>(s8);
#pragma unroll
        for (int i = 0; i < 8; ++i) { const float rs = rsqrtf(s8[i] * (1.f / 256.f) + EPS);
#pragma unroll
            for (int j = 0; j < 4; ++j) { const float y = x[i][j] * rs * lg[j] + lb[j]; AC[(size_t)(row0 + wid * 8 + i) * 256 + lane + 64 * j] = f2bf(siluf_(y)); } }
    }
    __syncthreads();
    {
        bf16_t* AP = (bf16_t*)(p.ws + WS_APOOL);
        const int g = __builtin_amdgcn_readfirstlane(c >> 6);
        if (g == 0) pool_run<2, EDGE>(cin, AP, row0, ts0, L, c, half);
        else if (g == 1) pool_run<4, EDGE>(cin, AP, row0, ts0, L, c, half);
        else if (g == 2) pool_run<8, EDGE>(cin, AP, row0, ts0, L, c, half);
        else pool_run<16, EDGE>(cin, AP, row0, ts0, L, c, half);
    }
    __syncthreads();
}
DI void pre_unit(const Params& p, LAS char* shm, int l, int tile, const float (&w)[31], const float bias, const int wv_) {
    int row0, ts0, L;
    if (tile < 1024) { row0 = tile * 64; ts0 = row0 & 2047; L = SEQ; } else { row0 = TX + (tile - 1024) * 64; ts0 = (row0 - TX) & 255; L = CTXL; }
    if (ts0 >= 16 && ts0 + 64 + 16 <= L) pre_unit_t<false>(p, shm, l, row0, ts0, L, w, bias, wv_);
    else pre_unit_t<true>(p, shm, l, row0, ts0, L, w, bias, wv_);
}
struct PvS5State {
    const Params& p; int l;
    PV_NOHOOKS
    static constexpr int NT = 16; static constexpr int FP8 = 0; static constexpr bool PARK = false; typedef ASimple AS; typedef BSimple BS;
    DI int first() const { return lin_first(0, 80); }
    DI int next(int u) const { return lin_next(u, 80); }
    DI void src(int u, AS& as, BS& bs, const int wv_) const {
        const int g = u / 5, mt = u % 5;
        int R[2], C[2]; stage_coords(R, C, wv_);
        as.base = (const char*)(p.ws + WS_P); as.kstride = 4 * NINP * 2;
#pragma unroll
        for (int h = 0; h < 2; ++h)
#pragma unroll
            for (int i = 0; i < 2; ++i) { const int cr = min(mt * 256 + h * 128 + R[i], NCROW - 1);
                as.off[h][i] = (unsigned)(((size_t)(crow_tok(cr) + (C[i] >> 4)) * NINP + OFF_SSM + g * 16 + (C[i] & 15)) * 2); }
        const bf16_t* W = (const bf16_t*)(p.ws + WS_WS5) + (size_t)(l * 16 + g) * 256 * 1024;
        bs = make_b(W, W + (size_t)128 * 1024, 1024);
    }
    DI void epi(f32x4 (&acc)[2][2][4][2], int u, const int wv_) const {
        const int g = u / 5, mt = u % 5;
        float* SST = (float*)(p.ws + WS_SST);
        EPI_FOR8(acc, { const int cr = mt * 256 + lr; if (cr < NCROW) { float* o_ = SST + ((size_t)cr * 16 + g) * 256 + lc; *(f32x4*)o_ = v0; *(f32x4*)(o_ + 4) = v1; } });
    }
};
struct PvQKV {
    const Params& p; int l;
    PV_NOHOOKS
    static constexpr int NT = 4; static constexpr int FP8 = 0; static constexpr bool PARK = false; typedef APlain AS; typedef BSimple BS;
    DI int first() const { return lin_first(80, 1152); }
    DI int next(int u) const { return lin_next(u, 1152); }
    DI void src(int u, AS& a, BS& b, const int wv_) const {
        const bool isq = u < 576; const int w_ = isq ? u : u - 576; const int mt = w_ >> 1, nt = w_ & 1;
        a = make_a_plain((const bf16_t*)(p.ws + WS_P), (size_t)mt * 256, NINP, isq ? OFF_Q : OFF_KV);
        const bf16_t* W = (const bf16_t*)(p.ws + (isq ? WS_WQ : WS_WKV)) + (size_t)l * 512 * 256 + (size_t)nt * 256 * 256;
        b = make_b(W, W + (size_t)128 * 256, 256);
    }
    DI void epi(f32x4 (&acc)[2][2][4][2], int u, const int wv_) const {
        const bool isq = u < 576; const int w_ = isq ? u : u - 576; const int mt = w_ >> 1, nt = w_ & 1;
        bf16_t* RAW = (bf16_t*)(p.ws + (isq ? WS_RAWQ : WS_RAWKV));
        EPI_FOR8(acc, { store_bf16x8(RAW + (size_t)(mt * 256 + lr) * 512 + nt * 256 + lc, v0, v1); });
    }
};
DI void phase_A(const Params& p, LAS char* shm, int l, const int wv_) {
    { PvS5State pv{p, l}; gemm_stream(shm, pv, wv_); }
    { PvQKV pv{p, l}; gemm_stream(shm, pv, wv_); }
    { const int c_ = otid() & 255;
      float w[31];
#pragma unroll
      for (int j = 0; j < 31; ++j) w[j] = p.conv_dw[((size_t)l * 31 + j) * 256 + c_];
      const float bias = p.conv_dw_b[l * 256 + c_];
      const int n_pre = l == 1 ? 1024 : 1152;
      for (int u = first_unit(80 + 1152); u < n_pre; u += gridDim.x) pre_unit(p, shm, l, u, w, bias, wv_); }
}

DI void qkvpost_unit(const Params& p, LAS char* shm, int l, int unit, const int wv_) {
    const int tid = otid(), wid = tid >> 6, lane = tid & 63;
    const bf16_t* P = (const bf16_t*)(p.ws + WS_P);
    const bf16_t* RAWQ = (const bf16_t*)(p.ws + WS_RAWQ);
    const bf16_t* RAWKV = (const bf16_t*)(p.ws + WS_RAWKV);
    bf16_t* Q = (bf16_t*)(p.ws + WS_Q);
    bf16_t* KB = (bf16_t*)(p.ws + WS_KB);
    bf16_t* VT = (bf16_t*)(p.ws + WS_VT);
    LAS bf16_t* vt = (LAS bf16_t*)shm;
    const int row0 = unit * 64;
    const bool lat = row0 < TX;
    const int b = lat ? (row0 >> 11) : ((row0 - TX) >> 8);
    const int key0 = lat ? (row0 & 2047) : 2048 + ((row0 - TX) & 255);
    const int head = lane >> 4, sub = lane & 15;
    const float lninv = -9.210340371976184f / 8.f;
    const float frq = __expf(lninv * (float)(sub & 7));
    float qg[6], kg[6];
#pragma unroll
    for (int j = 0; j < 6; ++j) { qg[j] = p.mla_q_g[l * 96 + sub + 16 * j] * 0.14724444674085666f; kg[j] = p.mla_k_g[l * 96 + sub + 16 * j]; }
    constexpr int NB = 4;
    for (int tk0 = wid * 8; tk0 < wid * 8 + 8; tk0 += NB) {
        float pq[NB][3], pkv[NB][2], qr[NB][6], kr[NB][6], vr[NB][4];
#pragma unroll
        for (int i = 0; i < NB; ++i) { const int r = row0 + tk0 + i; const bf16_t* pr = P + (size_t)r * NINP;
#pragma unroll
            for (int j = 0; j < 3; ++j) pq[i][j] = bf2f(pr[OFF_Q + lane + 64 * j]);
#pragma unroll
            for (int j = 0; j < 2; ++j) pkv[i][j] = bf2f(pr[OFF_KV + lane + 64 * j]);
#pragma unroll
            for (int j = 0; j < 6; ++j) qr[i][j] = bf2f(RAWQ[(size_t)r * 512 + head * 96 + sub + 16 * j]);
#pragma unroll
            for (int j = 0; j < 4; ++j) kr[i][j] = bf2f(RAWKV[(size_t)r * 512 + head * 128 + sub + 16 * j]);
#pragma unroll
            for (int j = 4; j < 6; ++j) kr[i][j] = bf2f(pr[OFF_KPE + sub + 16 * (j - 4)]);
#pragma unroll
            for (int j = 0; j < 4; ++j) vr[i][j] = bf2f(RAWKV[(size_t)r * 512 + head * 128 + 64 + sub + 16 * j]); }
        float red[2 * NB];
#pragma unroll
        for (int i = 0; i < NB; ++i) { red[2 * i] = pq[i][0] * pq[i][0] + pq[i][1] * pq[i][1] + pq[i][2] * pq[i][2]; red[2 * i + 1] = pkv[i][0] * pkv[i][0] + pkv[i][1] * pkv[i][1]; }
        wave_sum_n<2 * NB>(red);
        float ssq[2 * NB];
#pragma unroll
        for (int i = 0; i < NB; ++i) {
            const float rq = rsqrtf(red[2 * i] * (1.f / 192.f) + EPS), rkv = rsqrtf(red[2 * i + 1] * (1.f / 128.f) + EPS);
            float s0 = 0.f, s1 = 0.f;
#pragma unroll
            for (int j = 0; j < 6; ++j) { qr[i][j] *= rq; s0 += qr[i][j] * qr[i][j]; }
#pragma unroll
            for (int j = 0; j < 4; ++j) { kr[i][j] *= rkv; s1 += kr[i][j] * kr[i][j]; }
#pragma unroll
            for (int j = 4; j < 6; ++j) s1 += kr[i][j] * kr[i][j];
#pragma unroll
            for (int j = 0; j < 4; ++j) vr[i][j] *= rkv;
            ssq[2 * i] = s0; ssq[2 * i + 1] = s1;
        }
        { const int l4 = olane();
#pragma unroll
          for (int o = 8; o > 0; o >>= 1) { float t_[2 * NB];
#pragma unroll
              for (int i = 0; i < 2 * NB; ++i) t_[i] = __int_as_float(__builtin_amdgcn_ds_bpermute((l4 ^ o) << 2, __float_as_int(ssq[i])));
#pragma unroll
              for (int i = 0; i < 2 * NB; ++i) ssq[i] += t_[i]; } }
#pragma unroll
        for (int i = 0; i < NB; ++i) {
            const int tk = tk0 + i, r = row0 + tk;
            const float rnq = rsqrtf(ssq[2 * i] * (1.f / 96.f) + EPS), rnk = rsqrtf(ssq[2 * i + 1] * (1.f / 96.f) + EPS);
#pragma unroll
            for (int j = 0; j < 6; ++j) { qr[i][j] *= rnq * qg[j]; kr[i][j] *= rnk * kg[j]; }
            if (lat) {
                const int tseq = r & 2047; const float a0 = (float)(tseq >> 6) * frq, a1 = (float)(tseq & 63) * frq;
                const float cs0 = __cosf(a0), sn0 = __sinf(a0), cs1 = __cosf(a1), sn1 = __sinf(a1);
                const float oq4 = shx(qr[i][4], 8), oq5 = shx(qr[i][5], 8), ok4 = shx(kr[i][4], 8), ok5 = shx(kr[i][5], 8);
                const float sg = (sub < 8) ? -1.f : 1.f;
                qr[i][4] = qr[i][4] * cs0 + sg * oq4 * sn0; qr[i][5] = qr[i][5] * cs1 + sg * oq5 * sn1;
                kr[i][4] = kr[i][4] * cs0 + sg * ok4 * sn0; kr[i][5] = kr[i][5] * cs1 + sg * ok5 * sn1;
            }
            bf16_t* kro = KB + ((size_t)(b * 4 + head) * 2304 + key0 + tk) * 96;
#pragma unroll
            for (int j = 0; j < 6; ++j) { Q[(size_t)r * 384 + head * 96 + sub + 16 * j] = f2bf(qr[i][j]); kro[sub + 16 * j] = f2bf(kr[i][j]); }
#pragma unroll
            for (int j = 0; j < 4; ++j) vt[(head * 64 + sub + 16 * j) * 72 + tk] = f2bf(vr[i][j]);
        }
    }
    __syncthreads();
    { const int hv = tid >> 1, hf = tid & 1;
      bf16_t* dst = VT + ((size_t)(b * 4 + (hv >> 6)) * 64 + (hv & 63)) * 2304 + key0 + hf * 32;
#pragma unroll
      for (int i = 0; i < 4; ++i) *(u32x4*)(dst + i * 8) = *(const LAS u32x4*)(vt + hv * 72 + hf * 32 + i * 8); }
    __syncthreads();
}
DI void s5carry_unit(const Params& p, int l, int unit, const int wv_) {
    const int gid = unit * 512 + otid();
    const int q = gid & 63, dir = (gid >> 6) & 1, g = (gid >> 7) & 15, b = gid >> 11;
    const float* A64 = (const float*)(p.ws + WS_A64) + (size_t)(((l * 2 + dir) * 16 + g) * 64 + q) * 2;
    const float ar = A64[0], ai = A64[1];
    const float* SST = (const float*)(p.ws + WS_SST);
    bf16_t* HIN = (bf16_t*)(p.ws + WS_HIN);
    float sr[NCH], si[NCH];
#pragma unroll
    for (int s = 0; s < NCH; ++s) { const int j = dir == 0 ? s : (s < 4 ? 3 - s : 39 - s);
        const size_t base = ((size_t)(b * NCH + j) * 16 + g) * 256 + dir * 128 + q; sr[s] = SST[base]; si[s] = SST[base + 64]; }
    float hr = 0.f, hi = 0.f;
#pragma unroll
    for (int s = 0; s < NCH; ++s) {
        const int j = dir == 0 ? s : (s < 4 ? 3 - s : 39 - s);
        const size_t base = ((size_t)(b * NCH + j) * 16 + g) * 256 + dir * 128 + q;
        HIN[base] = f2bf(hr); HIN[base + 64] = f2bf(hi);
        const float nr = ar * hr - ai * hi + sr[s], ni = ar * hi + ai * hr + si[s];
        hr = nr; hi = ni;
    }
}
struct PvConvPool {
    const Params& p; int l;
    PV_NOHOOKS
    static constexpr int NT = 4; static constexpr int FP8 = 0; static constexpr bool PARK = false; typedef APlain AS; typedef BSimple BS;
    DI int nrt() const { return l == 1 ? 256 : 288; }
    DI int first() const { return lin_first(0, 2 * nrt()); }
    DI int next(int u) const { return lin_next(u, 2 * nrt()); }
    DI void src(int u, AS& a, BS& b, const int wv_) const {
        const bool isconv = u < nrt(); const int mt = isconv ? u : u - nrt();
        a = make_a_plain((const bf16_t*)(p.ws + (isconv ? WS_ACONV : WS_APOOL)), (size_t)mt * 256, 256, 0);
        const bf16_t* W = (const bf16_t*)(p.ws + (isconv ? WS_WPW : WS_WPOOL)) + (size_t)l * 65536;
        b = make_b(W, W + (size_t)128 * 256, 256);
    }
    DI void epi(f32x4 (&acc)[2][2][4][2], int u, const int wv_) const {
        const bool isconv = u < nrt(); const int mt = isconv ? u : u - nrt();
        bf16_t* CAT = (bf16_t*)(p.ws + WS_CAT);
        if (isconv) { EPI_FOR8(acc, { store_bf16x8(CAT + (size_t)(mt * 256 + lr) * 1024 + lc, v0, v1); }); }
        else { const int t_ = otid(), c0_ = ((t_ >> 6) & 3) * 32 + ((t_ & 63) >> 4) * 8; f32x4 sc_[2][2];
#pragma unroll
               for (int bj = 0; bj < 2; ++bj)
#pragma unroll
                   for (int n = 0; n < 2; ++n) sc_[bj][n] = *(const f32x4*)(p.pool_scale + l * 256 + bj * 128 + n * 4 + c0_);
               EPI_FOR8(acc, { store_bf16x8(CAT + (size_t)(mt * 256 + lr) * 1024 + 256 + lc, v0 * sc_[bj][0], v1 * sc_[bj][1]); }); }
    }
};
DI void phase_B(const Params& p, LAS char* shm, int l, const int wv_) {
    { PvConvPool pv{p, l}; gemm_stream(shm, pv, wv_); }
    const int n_post = TT / 64, n_carry = 128;
    for (int u = first_unit(l == 1 ? 512 : 576); u < n_post + n_carry; u += gridDim.x) {
        if (u < n_post) qkvpost_unit(p, shm, l, u, wv_);
        else s5carry_unit(p, l, u - n_post, wv_);
    }
}

template <bool NS> DI void attn_unit(const Params& p, LAS char* shm, int l, int b, int h, int qrow0, int nq, int key_lo, int nkeys, const float sh2, const int wv_) {
    const int tid = otid(), wid = tid >> 6, lane = tid & 63, l31 = lane & 31, hh = lane >> 5;
    const bf16_t* Q = (const bf16_t*)(p.ws + WS_Q);
    const bf16_t* KBp = (const bf16_t*)(p.ws + WS_KB) + (size_t)(b * 4 + h) * 2304 * 96;
    const bf16_t* VTp = (const bf16_t*)(p.ws + WS_VT) + (size_t)(b * 4 + h) * 64 * 2304;
    bf16_t* CAT = (bf16_t*)(p.ws + WS_CAT);
    LAS char* kl = shm;
    LAS char* vl = shm + 13312;
    const bool active = wid * 64 < nq;
    LAS char* const wq = shm + 2 * 13312 + 2 * 9216 + wid * 12288 + lane * 16;
    if (active) {
#pragma unroll
        for (int qb = 0; qb < 2; ++qb)
#pragma unroll
            for (int ks = 0; ks < 6; ++ks) *(LAS bf16x8*)(wq + (qb * 6 + ks) * 1024) = *(const bf16x8*)(Q + (size_t)(qrow0 + wid * 64 + qb * 32 + l31) * 384 + h * 96 + ks * 16 + hh * 8);
    }
    f32x16 O[2][2];
#pragma unroll
    for (int a = 0; a < 2; ++a)
#pragma unroll
        for (int c = 0; c < 2; ++c)
#pragma unroll
            for (int i = 0; i < 16; ++i) O[a][c][i] = 0.f;
    float lsum[2] = {0.f, 0.f};
    const int ntile = nkeys / 64;
    LAS char* const kb0 = shm;
    LAS char* const vb0 = shm + 2 * 13312;
    u32x4 kreg0, kreg1, vreg;
    const int k_kr0 = tid / 12, k_p0 = tid % 12, k_kr1 = (tid + 512) / 12, k_p1 = (tid + 512) % 12, v_vd = tid >> 3, v_p = tid & 7;
#define A_LOADK(T_) do { const int key_ = key_lo + (T_) * 64; kreg0 = *(const u32x4*)(KBp + (size_t)(key_ + k_kr0) * 96 + k_p0 * 8); \
        if (tid < 256) kreg1 = *(const u32x4*)(KBp + (size_t)(key_ + k_kr1) * 96 + k_p1 * 8); } while (0)
#define A_LOADV(T_) do { const int key_ = key_lo + (T_) * 64; vreg = *(const u32x4*)(VTp + (size_t)v_vd * 2304 + key_ + v_p * 8); } while (0)
#define A_WRITEK(buf_) do { LAS char* kl_ = kb0 + (buf_) * 13312; *(LAS u32x4*)(kl_ + k_kr0 * 208 + k_p0 * 16) = kreg0; if (tid < 256) *(LAS u32x4*)(kl_ + k_kr1 * 208 + k_p1 * 16) = kreg1; } while (0)
#define A_WRITEV(buf_) do { LAS char* vl_ = vb0 + (buf_) * 9216; *(LAS u32x4*)(vl_ + v_vd * 144 + v_p * 16) = vreg; } while (0)
#define A_QK(S_, kbuf_, half_) do { const LAS char* kl_ = kb0 + (kbuf_) * 13312 + ((half_) * 32 + l31) * 208 + hh * 16; \
        _Pragma("unroll") for (int ks = 0; ks < 6; ++ks) { const bf16x8 a_ = *(const LAS bf16x8*)(kl_ + ks * 32); \
            if (ks == 0) { _Pragma("unroll") for (int qb = 0; qb < 2; ++qb) { f32x16 z_; _Pragma("unroll") for (int i = 0; i < 16; ++i) z_[i] = 0.f; S_[qb] = __builtin_amdgcn_mfma_f32_32x32x16_bf16(a_, *(const LAS bf16x8*)(wq + (qb * 6) * 1024), z_, 0, 0, 0); } } \
            else { _Pragma("unroll") for (int qb = 0; qb < 2; ++qb) S_[qb] = __builtin_amdgcn_mfma_f32_32x32x16_bf16(a_, *(const LAS bf16x8*)(wq + (qb * 6 + ks) * 1024), S_[qb], 0, 0, 0); } } } while (0)
#define A_SOFTMAX(S_, P_) do { _Pragma("unroll") for (int qb = 0; qb < 2; ++qb) { float e_[16]; \
        _Pragma("unroll") for (int i = 0; i < 16; ++i) { e_[i] = __builtin_amdgcn_exp2f(NS ? S_[qb][i] : S_[qb][i] - sh2); lsum[qb] += e_[i]; } \
        _Pragma("unroll") for (int s_ = 0; s_ < 2; ++s_) { u32x4 w_; w_.x = pk_bf16(e_[8 * s_], e_[8 * s_ + 1]); w_.y = pk_bf16(e_[8 * s_ + 2], e_[8 * s_ + 3]); w_.z = pk_bf16(e_[8 * s_ + 4], e_[8 * s_ + 5]); w_.w = pk_bf16(e_[8 * s_ + 6], e_[8 * s_ + 7]); \
            P_[qb][s_] = __builtin_bit_cast(bf16x8, w_); } } } while (0)
#define A_PV(P_, vbuf_, half_) do { const LAS char* vl_ = vb0 + (vbuf_) * 9216 + l31 * 144 + hh * 8; \
        _Pragma("unroll") for (int s_ = 0; s_ < 2; ++s_) { const int kk_ = (half_) * 2 + s_; \
            _Pragma("unroll") for (int vb = 0; vb < 2; ++vb) { \
                const s16x4 lo_ = *(const LAS s16x4*)(vl_ + vb * 32 * 144 + kk_ * 32); const s16x4 hi_ = *(const LAS s16x4*)(vl_ + vb * 32 * 144 + kk_ * 32 + 16); \
                const bf16x8 va_ = __builtin_shufflevector(lo_, hi_, 0, 1, 2, 3, 4, 5, 6, 7); \
                _Pragma("unroll") for (int qb = 0; qb < 2; ++qb) O[vb][qb] = __builtin_amdgcn_mfma_f32_32x32x16_bf16(va_, P_[qb][s_], O[vb][qb], 0, 0, 0); } } } while (0)
#define A_LDF(p_) (*(const LAS bf16x8*)(p_))
#define A_LDV(p_) __builtin_shufflevector(*(const LAS s16x4*)(p_), *(const LAS s16x4*)((p_) + 16), 0, 1, 2, 3, 4, 5, 6, 7)
#define A_SOFT4(g_, Ss_) do { _Pragma("unroll") for (int j_ = 0; j_ < 2; ++j_) { const int ix_ = (g_) * 4 + j_ * 2, qb_ = ix_ >> 4, i_ = ix_ & 15; \
        const float e0_ = __builtin_amdgcn_exp2f(NS ? Ss_[qb_][i_] : Ss_[qb_][i_] - sh2), e1_ = __builtin_amdgcn_exp2f(NS ? Ss_[qb_][i_ + 1] : Ss_[qb_][i_ + 1] - sh2); lsum[qb_] += e0_ + e1_; pw_[ix_ >> 1] = pk_bf16(e0_, e1_); } } while (0)
#define A_STEP(Sq_, kbufq_, halfq_, Ss_, Ps_, Pp_, vbufp_, halfp_) do { \
        const LAS char* kl_ = kb0 + (kbufq_) * 13312 + ((halfq_) * 32 + l31) * 208 + hh * 16; \
        const LAS char* vl_ = vb0 + (vbufp_) * 9216 + l31 * 144 + hh * 8 + (halfp_) * 64; \
        bf16x8 fa_[2], fq_[2][2], fv_[2]; unsigned pw_[16]; \
        fa_[0] = A_LDF(kl_); fq_[0][0] = A_LDF(wq); fq_[0][1] = A_LDF(wq + 6 * 1024); \
        __builtin_amdgcn_sched_barrier(0); \
        _Pragma("unroll") for (int g_ = 0; g_ < 6; ++g_) { \
            if (g_ < 5) { fa_[(g_ + 1) & 1] = A_LDF(kl_ + (g_ + 1) * 32); fq_[(g_ + 1) & 1][0] = A_LDF(wq + (g_ + 1) * 1024); fq_[(g_ + 1) & 1][1] = A_LDF(wq + (6 + g_ + 1) * 1024); } \
            else fv_[0] = A_LDV(vl_); \
            if (g_ == 0) { _Pragma("unroll") for (int qb = 0; qb < 2; ++qb) { f32x16 z_; _Pragma("unroll") for (int i = 0; i < 16; ++i) z_[i] = 0.f; Sq_[qb] = __builtin_amdgcn_mfma_f32_32x32x16_bf16(fa_[0], fq_[0][qb], z_, 0, 0, 0); } } \
            else { _Pragma("unroll") for (int qb = 0; qb < 2; ++qb) Sq_[qb] = __builtin_amdgcn_mfma_f32_32x32x16_bf16(fa_[g_ & 1], fq_[g_ & 1][qb], Sq_[qb], 0, 0, 0); } \
            A_SOFT4(g_, Ss_); \
            __builtin_amdgcn_sched_barrier(0); } \
        _Pragma("unroll") for (int g_ = 0; g_ < 4; ++g_) { const int s_ = g_ >> 1, vb_ = g_ & 1; \
            if (g_ < 3) fv_[(g_ + 1) & 1] = A_LDV(vl_ + ((g_ + 1) & 1) * 32 * 144 + ((g_ + 1) >> 1) * 32); \
            _Pragma("unroll") for (int qb = 0; qb < 2; ++qb) O[vb_][qb] = __builtin_amdgcn_mfma_f32_32x32x16_bf16(fv_[g_ & 1], Pp_[qb][s_], O[vb_][qb], 0, 0, 0); \
            if (g_ < 2) A_SOFT4(6 + g_, Ss_); \
            __builtin_amdgcn_sched_barrier(0); } \
        _Pragma("unroll") for (int qb = 0; qb < 2; ++qb) _Pragma("unroll") for (int s_ = 0; s_ < 2; ++s_) { u32x4 w_; w_.x = pw_[qb * 8 + s_ * 4]; w_.y = pw_[qb * 8 + s_ * 4 + 1]; w_.z = pw_[qb * 8 + s_ * 4 + 2]; w_.w = pw_[qb * 8 + s_ * 4 + 3]; Ps_[qb][s_] = __builtin_bit_cast(bf16x8, w_); } \
    } while (0)
#define A_SCHED(n_) do { _Pragma("unroll") for (int g_ = 0; g_ < (n_); ++g_) { __builtin_amdgcn_sched_group_barrier(0x008, 1, 0); __builtin_amdgcn_sched_group_barrier(0x002, 5, 0); } } while (0)
    {
        u32x4 k1a = (u32x4){0u, 0u, 0u, 0u}, k1b = k1a;
        A_LOADK(0); A_LOADV(0);
        if (ntile > 1) { const int key_ = key_lo + 64; k1a = *(const u32x4*)(KBp + (size_t)(key_ + k_kr0) * 96 + k_p0 * 8); if (tid < 256) k1b = *(const u32x4*)(KBp + (size_t)(key_ + k_kr1) * 96 + k_p1 * 8); }
        A_WRITEK(0); A_WRITEV(0);
        kreg0 = k1a; kreg1 = k1b; A_WRITEK(1);
        if (ntile > 2) A_LOADK(2);
        if (ntile > 1) A_LOADV(1);
    }
    __syncthreads();
    f32x16 Sa[2], Sb[2]; bf16x8 Pa[2][2], Pb[2][2];
    if (active) { A_QK(Sa, 0, 0); A_QK(Sb, 0, 1); A_SOFTMAX(Sa, Pa); A_SCHED(12); }
    for (int T = 0; T < ntile; ++T) {
        const int kcur = T & 1, knxt = kcur ^ 1;
        __syncthreads();
        if (T + 2 < ntile) A_WRITEK(kcur);
        if (T + 1 < ntile) A_WRITEV(knxt);
        if (T + 3 < ntile) A_LOADK(T + 3);
        if (T + 2 < ntile) A_LOADV(T + 2);
        if (active) {
            if (T + 1 < ntile) {
                A_STEP(Sa, knxt, 0, Sb, Pb, Pa, kcur, 0);
                A_STEP(Sb, knxt, 1, Sa, Pa, Pb, kcur, 1);
            } else {
                A_SOFTMAX(Sb, Pb); A_PV(Pa, kcur, 0); A_SCHED(8);
                __builtin_amdgcn_sched_barrier(0);
                A_PV(Pb, kcur, 1);
            }
        }
    }
#undef A_LOADK
#undef A_LOADV
#undef A_WRITEK
#undef A_WRITEV
#undef A_QK
#undef A_SOFTMAX
#undef A_PV
#undef A_SCHED
#undef A_STEP
#undef A_SOFT4
#undef A_LDF
#undef A_LDV
    if (active) {
#pragma unroll
        for (int qb = 0; qb < 2; ++qb) {
            const float tot = lsum[qb] + shx(lsum[qb], 32);
            const float inv = 1.f / tot;
            bf16_t* orow = CAT + (size_t)(qrow0 + wid * 64 + qb * 32 + l31) * 1024 + 768 + h * 64;
#pragma unroll
            for (int vb = 0; vb < 2; ++vb)
#pragma unroll
                for (int i4 = 0; i4 < 4; ++i4)
                    store_bf16x4(orow + vb * 32 + 8 * i4 + 4 * hh, O[vb][qb][4 * i4] * inv, O[vb][qb][4 * i4 + 1] * inv, O[vb][qb][4 * i4 + 2] * inv, O[vb][qb][4 * i4 + 3] * inv);
        }
    }
    __syncthreads();
}
struct PvS5Out {
    const Params& p; int l;
    PV_NOHOOKS
    static constexpr int NT = 20; static constexpr int FP8 = 0; static constexpr bool PARK = false; typedef ASeg2 AS; typedef BSimple BS;
    DI int first() const { return lin_first(512, 320); }
    DI int next(int u) const { return lin_next(u, 320); }
    DI void src(int u, AS& as, BS& bs, const int wv_) const {
        const int ntile = u & 3, mt = (u >> 2) % 5, g = u / 20;
        int R[2], C[2]; stage_coords(R, C, wv_);
        as.base0 = (const char*)(p.ws + WS_P); as.base1 = (const char*)(p.ws + WS_HIN); as.ks0 = 4 * NINP * 2; as.nt0 = 16;
#pragma unroll
        for (int h = 0; h < 2; ++h)
#pragma unroll
            for (int i = 0; i < 2; ++i) { const int cr = min(mt * 256 + h * 128 + R[i], NCROW - 1);
                as.off0[h][i] = (unsigned)(((size_t)(crow_tok(cr) + (C[i] >> 4)) * NINP + OFF_SSM + g * 16 + (C[i] & 15)) * 2);
                as.off1[h][i] = (unsigned)((((size_t)cr * 16 + g) * 256 + C[i]) * 2); }
        const bf16_t* W = (const bf16_t*)(p.ws + WS_TS5) + ((size_t)(l * 16 + g) * 1024 + ntile * 256) * 1280;
        bs = make_b(W, W + (size_t)128 * 1280, 1280);
    }
    DI void epi(f32x4 (&acc)[2][2][4][2], int u, const int wv_) const {
        const int ntile = u & 3, mt = (u >> 2) % 5, g = u / 20;
        bf16_t* Z = (bf16_t*)(p.ws + WS_Z);
        EPI_FOR8(acc, { const int cr = mt * 256 + lr; if (cr < NCROW) { const int col = ntile * 256 + lc, t = col >> 4, co = col & 15;
            const f32x4 g0 = (f32x4){gelu_tanh(v0[0]), gelu_tanh(v0[1]), gelu_tanh(v0[2]), gelu_tanh(v0[3])}, g1_ = (f32x4){gelu_tanh(v1[0]), gelu_tanh(v1[1]), gelu_tanh(v1[2]), gelu_tanh(v1[3])};
            store_bf16x8(Z + (size_t)(crow_tok(cr) + t) * 256 + g * 16 + co, g0, g1_); } });
    }
};
DI void phase_C(const Params& p, LAS char* shm, int l, const int wv_) {
    float sh2;
    { const int lane = otid() & 63; float gq = 0.f, gk = 0.f;
      for (int i = lane; i < 96; i += 64) { gq = fmaxf(gq, fabsf(p.mla_q_g[l * 96 + i])); gk = fmaxf(gk, fabsf(p.mla_k_g[l * 96 + i])); }
      gq = wave_max(gq); gk = wave_max(gk);
      const float c2 = 9.797958971132712f * gq * gk * 1.4426950408889634f;
      sh2 = fmaxf(c2 - 64.f, 0.f); }
    const bool ns = __builtin_amdgcn_readfirstlane(__float_as_int(sh2)) == 0;
    for (int u = blockIdx.x; u < 512; u += gridDim.x) { const int qb = u & 3, h = (u >> 2) & 3, b = u >> 4;
        if (ns) attn_unit<true>(p, shm, l, b, h, b * SEQ + qb * 512, 512, 0, 2304, 0.f, wv_);
        else attn_unit<false>(p, shm, l, b, h, b * SEQ + qb * 512, 512, 0, 2304, sh2, wv_); }
    { PvS5Out pv{p, l}; gemm_stream(shm, pv, wv_); }
    if (l == 0) for (int u = first_unit(512 + 320); u < 128; u += gridDim.x) { const int h = u & 3, b = u >> 2;
        if (ns) attn_unit<true>(p, shm, l, b, h, TX + b * CTXL, 256, 2048, 256, 0.f, wv_);
        else attn_unit<false>(p, shm, l, b, h, TX + b * CTXL, 256, 2048, 256, sh2, wv_); }
}

struct PvGlu {
    const Params& p; int l;
    PV_NOHOOKS
    static constexpr int NT = 4; static constexpr int FP8 = 0; static constexpr bool PARK = false; typedef APlain AS; typedef BSimple BS;
    DI int first() const { return lin_first(0, l == 1 ? 256 : 288); }
    DI int next(int u) const { return lin_next(u, l == 1 ? 256 : 288); }
    DI void src(int u, AS& a, BS& b, const int wv_) const {
        a = make_a_plain((const bf16_t*)(p.ws + WS_Z), (size_t)u * 256, 256, 0);
        const bf16_t* W = (const bf16_t*)(p.ws + WS_WGLU) + (size_t)l * 65536;
        b = make_b(W, W + (size_t)128 * 256, 256);
    }
    DI void epi(f32x4 (&acc)[2][2][4][2], int u, const int wv_) const {
        const bf16_t* Z = (const bf16_t*)(p.ws + WS_Z); bf16_t* CAT = (bf16_t*)(p.ws + WS_CAT);
        const int _tz = otid(), _w = _tz >> 6, _l = _tz & 63, _wr = _w >> 2, _wc = _w & 3, _fr = _l & 15, _fq = _l >> 4;
        const int c0 = _wc * 32 + _fq * 8;
        f32x4 bsv[2][2];
#pragma unroll
        for (int bj = 0; bj < 2; ++bj)
#pragma unroll
            for (int n = 0; n < 2; ++n) bsv[bj][n] = *(const f32x4*)(p.ssm_glu_b + l * 256 + bj * 128 + n * 4 + c0);
#pragma unroll
        for (int ai = 0; ai < 2; ++ai) {
            u32x4 zz[4][2];
#pragma unroll
            for (int m = 0; m < 4; ++m)
#pragma unroll
                for (int bj = 0; bj < 2; ++bj) zz[m][bj] = *(const u32x4*)(Z + (size_t)(u * 256 + ai * 128 + _wr * 64 + m * 16 + _fr) * 256 + bj * 128 + c0);
#pragma unroll
            for (int m = 0; m < 4; ++m) { const size_t r = (size_t)(u * 256 + ai * 128 + _wr * 64 + m * 16 + _fr);
#pragma unroll
                for (int bj = 0; bj < 2; ++bj) { const f32x4 a0 = acc[ai][bj][m][0], a1 = acc[ai][bj][m][1]; const f32x4 b0 = bsv[bj][0], b1 = bsv[bj][1]; const u32x4 z_ = zz[m][bj];
                    const f32x4 o0 = (f32x4){bflo(z_.x) * sigmoidf_(a0[0] + b0[0]), bfhi(z_.x) * sigmoidf_(a0[1] + b0[1]), bflo(z_.y) * sigmoidf_(a0[2] + b0[2]), bfhi(z_.y) * sigmoidf_(a0[3] + b0[3])};
                    const f32x4 o1 = (f32x4){bflo(z_.z) * sigmoidf_(a1[0] + b1[0]), bfhi(z_.z) * sigmoidf_(a1[1] + b1[1]), bflo(z_.w) * sigmoidf_(a1[2] + b1[2]), bfhi(z_.w) * sigmoidf_(a1[3] + b1[3])};
                    store_bf16x8(CAT + r * 1024 + 512 + bj * 128 + c0, o0, o1); } }
        }
    }
};
DI void phase_D(const Params& p, LAS char* shm, int l, const int wv_) {
    PvGlu pv{p, l}; gemm_stream(shm, pv, wv_);
}

struct PvOutproj {
    const Params& p; int l;
    PV_NOHOOKS
    static constexpr int NT = 16; static constexpr int FP8 = 0; static constexpr bool PARK = false; typedef APlain AS; typedef BSimple BS;
    XcdDeal<4, 4> deal;
    DI int first() const { return deal.first(); }
    DI int next(int u) const { return deal.next(u); }
    DI void src(int u, AS& a, BS& b, const int wv_) const {
        int mt, nt; deal.decode(u, mt, nt);
        const bf16_t* W = (const bf16_t*)(p.ws + WS_WMO) + (size_t)l * 1024 * 1024;
        a = make_a_plain((const bf16_t*)(p.ws + WS_CAT), (size_t)mt * 256, 1024, 0);
        b = make_b(W + (size_t)(nt * 256) * 1024, W + (size_t)(nt * 256 + 128) * 1024, 1024);
    }
    DI void epi(f32x4 (&acc)[2][2][4][2], int u, const int wv_) const {
        int mt, nt; deal.decode(u, mt, nt);
        bf16_t* X = (bf16_t*)(p.ws + WS_X);
        const float* MOD = (const float*)(p.ws + WS_MOD) + (size_t)l * 33 * 6144;
        const int _tz = otid(), _w = _tz >> 6, _l = _tz & 63, _wr = _w >> 2, _wc = _w & 3, _fr = _l & 15, _fq = _l >> 4;
        const int c0 = nt * 256 + _wc * 32 + _fq * 8;
        const int row0 = mt * 256;
        const float* g1p = MOD + (size_t)mod_row(row0) * 6144 + 2048 + c0;
        f32x4 g1[2][2];
#pragma unroll
        for (int bj = 0; bj < 2; ++bj)
#pragma unroll
            for (int n = 0; n < 2; ++n) g1[bj][n] = *(const f32x4*)(g1p + bj * 128 + n * 4);
        bf16_t* obase = X + (size_t)row0 * 1024;
        if (l == 0) {
            const float* xbase = row0 < TX ? p.x + (size_t)row0 * 1024 : p.ctx + (size_t)(row0 - TX) * 1024;
#pragma unroll
            for (int ai = 0; ai < 2; ++ai)
#pragma unroll
                for (int mp = 0; mp < 2; ++mp) {
                    f32x4 xv[2][2][2];
#pragma unroll
                    for (int mm = 0; mm < 2; ++mm)
#pragma unroll
                        for (int bj = 0; bj < 2; ++bj)
#pragma unroll
                            for (int n = 0; n < 2; ++n) xv[mm][bj][n] = *(const f32x4*)(xbase + (size_t)(ai * 128 + _wr * 64 + (mp * 2 + mm) * 16 + _fr) * 1024 + c0 + bj * 128 + n * 4);
#pragma unroll
                    for (int mm = 0; mm < 2; ++mm)
#pragma unroll
                        for (int bj = 0; bj < 2; ++bj)
                            store_bf16x8(obase + (size_t)(ai * 128 + _wr * 64 + (mp * 2 + mm) * 16 + _fr) * 1024 + c0 + bj * 128,
                                         xv[mm][bj][0] + g1[bj][0] * acc[ai][bj][mp * 2 + mm][0], xv[mm][bj][1] + g1[bj][1] * acc[ai][bj][mp * 2 + mm][1]);
                }
        } else {
#pragma unroll
            for (int ai = 0; ai < 2; ++ai) {
                u32x4 xv[4][2];
#pragma unroll
                for (int m = 0; m < 4; ++m)
#pragma unroll
                    for (int bj = 0; bj < 2; ++bj) xv[m][bj] = *(const u32x4*)(obase + (size_t)(ai * 128 + _wr * 64 + m * 16 + _fr) * 1024 + c0 + bj * 128);
#pragma unroll
                for (int m = 0; m < 4; ++m)
#pragma unroll
                    for (int bj = 0; bj < 2; ++bj) { const u32x4 x_ = xv[m][bj];
                        const f32x4 x0 = (f32x4){bflo(x_.x), bfhi(x_.x), bflo(x_.y), bfhi(x_.y)}, x1 = (f32x4){bflo(x_.z), bfhi(x_.z), bflo(x_.w), bfhi(x_.w)};
                        store_bf16x8(obase + (size_t)(ai * 128 + _wr * 64 + m * 16 + _fr) * 1024 + c0 + bj * 128, x0 + g1[bj][0] * acc[ai][bj][m][0], x1 + g1[bj][1] * acc[ai][bj][m][1]); }
            }
        }
    }
};
DI void phase_E(const Params& p, LAS char* shm, int l, const int wv_) {
    PvOutproj pv{p, l, {(l == 1 ? TX : TT) / 256}}; gemm_stream(shm, pv, wv_);
}

template <int S> DI float row_rot_f(float v) { return __int_as_float(__builtin_amdgcn_update_dpp(0, __float_as_int(v), 0x120 | S, 0xf, 0xf, false)); }
template <int S> DI int row_rot_i(int v) { return __builtin_amdgcn_update_dpp(0, v, 0x120 | S, 0xf, 0xf, false); }
template <int S> struct RankAcc {
    static DI void run(float o0, float o1, int oe, float v0, float v1, int e0, int& r0, int& r1) {
        const float a0 = S ? row_rot_f<S>(o0) : o0, a1 = S ? row_rot_f<S>(o1) : o1; const int ae = S ? row_rot_i<S>(oe) : oe;
        r0 += (a0 > v0 || (a0 == v0 && ae < e0)) ? 1 : 0;
        r0 += (a1 > v0) ? 1 : 0;
        r1 += (a0 > v1 || a0 == v1) ? 1 : 0;
        r1 += (a1 > v1 || (a1 == v1 && ae < e0)) ? 1 : 0;
        RankAcc<S + 1>::run(o0, o1, oe, v0, v1, e0, r0, r1);
    }
};
template <> struct RankAcc<16> { static DI void run(float, float, int, float, float, int, int&, int&) {} };
DI float row_sum16(float v) { v += row_rot_f<8>(v); v += row_rot_f<4>(v); v += row_rot_f<2>(v); v += row_rot_f<1>(v); return v; }
DI float row_max16(float v) { v = fmaxf(v, row_rot_f<8>(v)); v = fmaxf(v, row_rot_f<4>(v)); v = fmaxf(v, row_rot_f<2>(v)); v = fmaxf(v, row_rot_f<1>(v)); return v; }

DI void phase_router(const Params& p, LAS char* shm, int l, const int wv_) {
    const int tid = otid(), wid = tid >> 6, lane = tid & 63;
    const int Tm = (l == 1) ? TX : TT;
    const bf16_t* X = (const bf16_t*)(p.ws + WS_X);
    const float* MOD = (const float*)(p.ws + WS_MOD) + (size_t)l * 33 * 6144;
    unsigned char* H8 = (unsigned char*)(p.ws + WS_H);
    const bool alt = p.ph_lo != 0;
    int* CNT = (int*)(p.ws + WS_CNT) + l * 32 + (alt ? 64 : 0);
    int* LIST = alt ? (int*)(p.ws + WS_RY) : (int*)(p.ws + WS_LIST);
    LAS char* wfr = shm;
    LAS bf16_t* gml = (LAS bf16_t*)(shm + 131072);
    LAS bf16_t* shl = gml + 1024;
    LAS float* cvec = (LAS float*)(shm + 131072 + 4096);
    LAS int* lcnt = (LAS int*)(cvec + 32);
    LAS int* lbase = lcnt + 32;
    LAS unsigned* lrec = (LAS unsigned*)(lbase + 32);
    LAS float* lwt = (LAS float*)(lrec + 1152);
    const int tpw = (Tm + gridDim.x - 1) / gridDim.x;
    const int tbeg = blockIdx.x * tpw, tend = min(tbeg + tpw, Tm);
    if (tid < 32) lcnt[tid] = 0;
    int seg_beg = tbeg;
    while (seg_beg < tend) {
        const int mrow = mod_row(seg_beg);
        int seg_end = tend;
        if (mrow < 32) seg_end = min(tend, (mrow + 1) * SEQ); else seg_end = tend;
        const float* mr = MOD + (size_t)mrow * 6144;
        __syncthreads();
        for (int k = tid; k < 1024; k += 512) { const float gmv = p.norm2_g[l * 1024 + k] * (1.f + mr[4096 + k]); gml[k] = f2bf(gmv); shl[k] = f2bf(mr[3072 + k]); }
#pragma unroll 8
        for (int i = tid; i < 1024 * 8; i += 512) {
            const int k = i >> 3, e4 = (i & 7) * 4;
            const float gmv = p.norm2_g[l * 1024 + k] * (1.f + mr[4096 + k]);
            const f32x4 w = *(const f32x4*)(p.router_w + (size_t)l * 32768 + k * 32 + e4);
            const int ks = k >> 5, kq = (k >> 3) & 3, j = k & 7;
#pragma unroll
            for (int c = 0; c < 4; ++c) { const int e = e4 + c, nb = e >> 4, ei = e & 15; const float wv = w[c] * gmv;
                const bf16_t hi = f2bf(wv); const bf16_t lo = f2bf(wv - bf2f(hi));
                LAS bf16_t* dst = (LAS bf16_t*)(wfr + ((size_t)((ks * 2 + nb) * 2) * 64 + (kq * 16 + ei)) * 16) + j;
                dst[0] = hi; dst[64 * 8] = lo; }
        }
        {
            float s4[4] = {0.f, 0.f, 0.f, 0.f};
#pragma unroll 8
            for (int k = lane; k < 1024; k += 64) { const float shv = mr[3072 + k]; const f32x4 w = *(const f32x4*)(p.router_w + (size_t)l * 32768 + k * 32 + wid * 4);
                s4[0] += shv * w[0]; s4[1] += shv * w[1]; s4[2] += shv * w[2]; s4[3] += shv * w[3]; }
#pragma unroll
            for (int c = 0; c < 4; ++c) { const float t_ = wave_sum(s4[c]); if (lane == 0) cvec[wid * 4 + c] = t_ + p.router_b[l * 32 + wid * 4 + c]; }
        }
        __syncthreads();
        const int ngroups = (seg_end - seg_beg) >> 4;
        for (int gi = wid; gi < ngroups; gi += 8) {
            const int t0 = seg_beg + gi * 16;
            const int tok = lane & 15, kq = lane >> 4;
            const bf16_t* xr = X + (size_t)(t0 + tok) * 1024 + kq * 8;
            f32x4 acc0 = {0.f, 0.f, 0.f, 0.f}, acc1 = {0.f, 0.f, 0.f, 0.f};
            float ss = 0.f;
            u32x4 xa[16], xb[16];
#pragma unroll
            for (int k2 = 0; k2 < 16; ++k2) xa[k2] = *(const u32x4*)(xr + k2 * 32);
#pragma unroll
            for (int k2 = 0; k2 < 16; ++k2) xb[k2] = *(const u32x4*)(xr + (16 + k2) * 32);
#pragma unroll
            for (int kc = 0; kc < 2; ++kc) {
#pragma unroll
            for (int k2 = 0; k2 < 16; ++k2) { const int ks = kc * 16 + k2;
                if ((k2 & 3) == 0) __builtin_amdgcn_sched_barrier(0);
                const u32x4 xh = kc == 0 ? xa[k2] : xb[k2];
                const float x0 = bflo(xh.x), x1 = bfhi(xh.x), x2 = bflo(xh.y), x3 = bfhi(xh.y), x4 = bflo(xh.z), x5 = bfhi(xh.z), x6 = bflo(xh.w), x7 = bfhi(xh.w);
                ss += x0 * x0 + x1 * x1 + x2 * x2 + x3 * x3 + x4 * x4 + x5 * x5 + x6 * x6 + x7 * x7;
                const bf16x8 ah = __builtin_bit_cast(bf16x8, xh);
                const LAS char* wb = wfr + (size_t)(ks * 4) * 1024 + lane * 16;
                const bf16x8 b0h = *(const LAS bf16x8*)(wb), b0l = *(const LAS bf16x8*)(wb + 1024), b1h = *(const LAS bf16x8*)(wb + 2048), b1l = *(const LAS bf16x8*)(wb + 3072);
                acc0 = __builtin_amdgcn_mfma_f32_16x16x32_bf16(ah, b0h, acc0, 0, 0, 0); acc0 = __builtin_amdgcn_mfma_f32_16x16x32_bf16(ah, b0l, acc0, 0, 0, 0);
                acc1 = __builtin_amdgcn_mfma_f32_16x16x32_bf16(ah, b1h, acc1, 0, 0, 0); acc1 = __builtin_amdgcn_mfma_f32_16x16x32_bf16(ah, b1l, acc1, 0, 0, 0);
            } }
            u32x4 xp[16];
#pragma unroll
            for (int k2 = 0; k2 < 16; ++k2) xp[k2] = *(const u32x4*)(xr + k2 * 32);
            ss += shx(ss, 16); ss += shx(ss, 32);
            const float rn = rsqrtf(ss * (1.f / 1024.f) + EPS);
            const int ei = lane & 15;
            const float c0v = cvec[ei], c1v = cvec[16 + ei];
#pragma unroll
            for (int r = 0; r < 4; ++r) {
                const int tl = (lane >> 4) * 4 + r;
                const float rnt = shi(rn, tl);
                float v0 = fminf(fmaxf(acc0[r] * rnt + c0v, -1e30f), 1e30f), v1 = fminf(fmaxf(acc1[r] * rnt + c1v, -1e30f), 1e30f);
                int r0 = 0, r1 = 0;
                RankAcc<0>::run(v0, v1, ei, v0, v1, ei, r0, r1);
                const float mx = row_max16(fmaxf(v0, v1));
                const bool s0 = r0 < 4, s1 = r1 < 4;
                const float e0 = s0 ? __expf(v0 - mx) : 0.f, e1 = s1 ? __expf(v1 - mx) : 0.f;
                const float inv = 1.f / row_sum16(e0 + e1);
                const int t = t0 + tl;
                if (s0) { const int pos = atomicAdd((int*)&lcnt[ei], 1); lrec[(t - tbeg) * 4 + r0] = (unsigned)ei | ((unsigned)pos << 8); lwt[(t - tbeg) * 4 + r0] = e0 * inv; }
                if (s1) { const int pos = atomicAdd((int*)&lcnt[16 + ei], 1); lrec[(t - tbeg) * 4 + r1] = (unsigned)(16 + ei) | ((unsigned)pos << 8); lwt[(t - tbeg) * 4 + r1] = e1 * inv; }
            }
            unsigned char* hr = H8 + (size_t)(t0 + tok) * 1024 + kq * 8;
#pragma unroll 1
            for (int kc = 0; kc < 2; ++kc) {
            u32x4 xv[16];
            if (kc == 0) {
#pragma unroll
                for (int k2 = 0; k2 < 16; ++k2) xv[k2] = xp[k2];
            } else {
#pragma unroll
                for (int k2 = 0; k2 < 16; ++k2) xv[k2] = *(const u32x4*)(xr + (16 + k2) * 32);
            }
#pragma unroll
            for (int k2 = 0; k2 < 16; ++k2) { const int ks = kc * 16 + k2;
                const u32x4 xh = xv[k2];
                const u32x4 gq = *(const LAS u32x4*)(gml + ks * 32 + kq * 8), sq = *(const LAS u32x4*)(shl + ks * 32 + kq * 8);
                float h[8];
                h[0] = bflo(xh.x) * rn * bflo(gq.x) + bflo(sq.x); h[1] = bfhi(xh.x) * rn * bfhi(gq.x) + bfhi(sq.x); h[2] = bflo(xh.y) * rn * bflo(gq.y) + bflo(sq.y); h[3] = bfhi(xh.y) * rn * bfhi(gq.y) + bfhi(sq.y);
                h[4] = bflo(xh.z) * rn * bflo(gq.z) + bflo(sq.z); h[5] = bfhi(xh.z) * rn * bfhi(gq.z) + bfhi(sq.z); h[6] = bflo(xh.w) * rn * bflo(gq.w) + bflo(sq.w); h[7] = bfhi(xh.w) * rn * bfhi(gq.w) + bfhi(sq.w);
#pragma unroll
                for (int i = 0; i < 8; ++i) h[i] = __builtin_amdgcn_fmed3f(h[i], -448.f, 448.f);
                u32x2 o; o.x = pk_fp8x4(h[0], h[1], h[2], h[3]); o.y = pk_fp8x4(h[4], h[5], h[6], h[7]);
                *(u32x2*)(hr + ks * 32) = o;
            } }
        }
        seg_beg = seg_end;
    }
    __syncthreads();
    if (tid < 32) lbase[tid] = atomicAdd(&CNT[tid], lcnt[tid]);
    __syncthreads();
    for (int i = tid; i < (tend - tbeg) * 4; i += 512) { const unsigned rec = lrec[i]; const int e = rec & 255, pos = rec >> 8;
        u32x2 ent; ent.x = (unsigned)(tbeg * 4 + i); ent.y = __float_as_uint(lwt[i]);
        *(u32x2*)(LIST + ((size_t)e * TT + lbase[e] + pos) * 2) = ent; }
    __syncthreads();
}

DI void moe_tiles(const Params& p, LAS int* tstart, int l, const int wv_) {
    const int* CNT = (const int*)(p.ws + WS_CNT) + l * 32;
    if (otid() == 0) { int s = 0; for (int e = 0; e < 32; ++e) { tstart[e] = s; s += (CNT[e] + 255) >> 8; } tstart[32] = s; }
    __syncthreads();
    LAS int* ttab = (LAS int*)((LAS char*)tstart - (LDS_MISC + 64) + LDS_TTAB);
    const int MT_ = tstart[32];
    for (int mt = otid(); mt < MT_; mt += 512) { int e = 0;
#pragma unroll
        for (int i = 1; i < 32; ++i) e += (mt >= tstart[i]) ? 1 : 0;
        ttab[mt] = e | ((mt - tstart[e]) << 8); }
    __syncthreads();
}
DI int moe_find(const LAS int* tstart, int mt) { const LAS int* ttab = (const LAS int*)((const LAS char*)tstart - (LDS_MISC + 64) + LDS_TTAB); return __builtin_amdgcn_readfirstlane(ttab[mt]); }
struct PvMoe1 {
    const Params& p; int l; const LAS int* tstart; LAS char* tbl;
    static constexpr int NT = 8; static constexpr int FP8 = 2; static constexpr bool PARK = false; typedef ASimple AS; typedef BSimple BS;
    XcdDeal<4, 8> deal;
    DI int first() const { return deal.first(); }
    DI int next(int u) const { return deal.next(u); }
    typedef u32x4 Aux;
    DI void top(int u, Aux& aux, const int wv_) const {
        int mt, n8; deal.decode(u, mt, n8);
        const int ev_ = moe_find(tstart, mt); const int e = ev_ & 255;
        const int t_ = otid() & 63;
        aux = aload128(p.exp_b_in + (size_t)(l * NE + e) * 2048 + (t_ < 32 ? n8 * 128 + t_ * 4 : 1024 + n8 * 128 + (t_ - 32) * 4));
    }
    DI void mid(Aux& aux, const int wv_) const { const int t_ = otid(); asm volatile("" : "+v"(aux)); if (t_ < 64) *(LAS u32x4*)(tbl + t_ * 16) = aux; }
    DI void fix(AS& as, bool wait, const int wv_) const {
        if (wait) asm volatile("s_waitcnt vmcnt(0)" ::: "memory");
        int R[2], C[2]; stage_coords(R, C, wv_);
#pragma unroll
        for (int h = 0; h < 2; ++h)
#pragma unroll
            for (int i = 0; i < 2; ++i) { unsigned sl = as.off[h][i]; asm volatile("" : "+v"(sl)); as.off[h][i] = (sl >> 2) * 1024u + (unsigned)(C[i] * 2); }
    }
    DI void src(int u, AS& as, BS& bs, const int wv_) const {
        int mt, n8; deal.decode(u, mt, n8);
        const int ev_ = moe_find(tstart, mt); const int e = ev_ & 255;
        const int r0 = (ev_ >> 8) * 256, cnt = ((const int*)(p.ws + WS_CNT))[l * 32 + e];
        const int* lst = (const int*)(p.ws + WS_LIST) + (size_t)e * TT * 2;
        int R[2], C[2]; stage_coords(R, C, wv_);
        as.base = (const char*)(p.ws + WS_H); as.kstride = 128;
#pragma unroll
        for (int h = 0; h < 2; ++h)
#pragma unroll
            for (int i = 0; i < 2; ++i) as.off[h][i] = aload32(lst + 2 * min(r0 + h * 128 + R[i], cnt - 1));
        const char* W = (const char*)(p.ws + WS_W1) + (size_t)(l * NE + e) * 2048 * 1024;
        bs.base[0] = W + (size_t)(n8 * 128) * 1024; bs.base[1] = W + (size_t)(1024 + n8 * 128) * 1024; bs.ldb2 = 1024;
    }
    DI void epi(f32x4 (&acc)[2][2][4][2], int u, const int wv_) const {
        int mt, n8; deal.decode(u, mt, n8);
        const int ev_ = moe_find(tstart, mt); const int e = ev_ & 255;
        unsigned char* ACT = (unsigned char*)(p.ws + WS_RA);
        const int _tz = otid(), _w = _tz >> 6, _l = _tz & 63, _wr = _w >> 2, _wc = _w & 3, _fr = _l & 15, _fq = _l >> 4;
        const LAS float* bin = (const LAS float*)tbl + _wc * 32 + _fq * 8;
        f32x4 bg[2], bu[2];
#pragma unroll
        for (int n = 0; n < 2; ++n) { bg[n] = *(const LAS f32x4*)(bin + n * 4) * SWI_A; bu[n] = (*(const LAS f32x4*)(bin + 128 + n * 4) + 1.f) * (1.f / SWI_A); }
        (void)e;
#pragma unroll
        for (int ai = 0; ai < 2; ++ai)
#pragma unroll
            for (int m = 0; m < 4; ++m) { const int lr = ai * 128 + _wr * 64 + m * 16 + _fr;
                unsigned char* orow = ACT + ((size_t)mt * 256 + lr) * 1024 + n8 * 128 + _wc * 32 + _fq * 8;
                u32x2 pk;
#pragma unroll
                for (int n = 0; n < 2; ++n) {
                    float o[4];
#pragma unroll
                    for (int h2 = 0; h2 < 2; ++h2) {
                        const f32v2_t ag = {acc[ai][0][m][n][2 * h2], acc[ai][0][m][n][2 * h2 + 1]}, au = {acc[ai][1][m][n][2 * h2], acc[ai][1][m][n][2 * h2 + 1]};
                        const f32v2_t bgv = {bg[n][2 * h2], bg[n][2 * h2 + 1]}, buv = {bu[n][2 * h2], bu[n][2 * h2 + 1]};
                        f32v2_t g2 = ag * (1.f / 256.f) + bgv, u2 = au * (1.f / 256.f) + buv;
                        g2[0] = fminf(g2[0], 7.f * SWI_A); g2[1] = fminf(g2[1], 7.f * SWI_A);
                        u2[0] = __builtin_amdgcn_fmed3f(u2[0], -6.f / SWI_A, 8.f / SWI_A); u2[1] = __builtin_amdgcn_fmed3f(u2[1], -6.f / SWI_A, 8.f / SWI_A);
                        f32v2_t e2; e2[0] = __builtin_amdgcn_exp2f(-g2[0]); e2[1] = __builtin_amdgcn_exp2f(-g2[1]);
                        const f32v2_t d2 = e2 + 1.f;
                        f32v2_t r2; r2[0] = __builtin_amdgcn_rcpf(d2[0]); r2[1] = __builtin_amdgcn_rcpf(d2[1]);
                        const f32v2_t o2 = u2 * g2 * r2;
                        o[2 * h2] = o2[0]; o[2 * h2 + 1] = o2[1]; }
                    if (n == 0) pk.x = pk_fp8x4(o[0], o[1], o[2], o[3]); else pk.y = pk_fp8x4(o[0], o[1], o[2], o[3]); }
                *(u32x2*)orow = pk; }
    }
};
DI void phase_moe1(const Params& p, LAS char* shm, int l, const int wv_) {
    LAS int* tstart = (LAS int*)(shm + LDS_MISC + 64);
    moe_tiles(p, tstart, l, wv_);
    PvMoe1 pv{p, l, tstart, shm + 131072, {tstart[32]}}; gemm_stream(shm, pv, wv_);
}
struct PvMoe2 {
    const Params& p; int l; const LAS int* tstart; LAS char* tbl;
    static constexpr int NT = 8; static constexpr int FP8 = 2; static constexpr bool PARK = false; typedef APlain AS; typedef BSeq16 BS;
    XcdDeal<4, 4> deal;
    DI int first() const { return deal.first(); }
    DI int next(int u) const { return deal.next(u); }
    template <class A_> DI void fix(A_&, bool, const int) const {}
    typedef u32x4 Aux;
    DI void top(int u, Aux& aux, const int wv_) const {
        int mt, n4; deal.decode(u, mt, n4);
        const int ev_ = moe_find(tstart, mt); const int e = ev_ & 255; const int r0 = (ev_ >> 8) * 256;
        const int t_ = otid();
        const char* src_ = t_ < 128 ? (const char*)((const int*)(p.ws + WS_LIST) + (size_t)e * TT * 2 + (size_t)(r0 + 2 * t_) * 2)
                                    : (const char*)(p.exp_b_out + (size_t)(l * NE + e) * 1024 + n4 * 256 + ((t_ - 128) & 63) * 4);
        aux = aload128(src_);
    }
    DI void mid(Aux& aux, const int wv_) const { const int t_ = otid(); asm volatile("" : "+v"(aux)); if (t_ < 192) *(LAS u32x4*)(tbl + t_ * 16) = aux; }
    DI void src(int u, AS& as, BS& bs, const int wv_) const {
        int mt, n4; deal.decode(u, mt, n4);
        const int ev_ = moe_find(tstart, mt); const int e = ev_ & 255;
        as.base = (const char*)(p.ws + WS_RA) + (size_t)mt * 256 * 1024; as.lda2 = 1024;
        const char* W = (const char*)(p.ws + WS_W2) + (size_t)(l * NE + e) * 1024 * 1024;
        bs.base = W + (size_t)(n4 * 256) * 1024; bs.ldb2 = 1024;
    }
    DI void epi(f32x4 (&acc)[2][2][4][2], int u, const int wv_) const {
        int mt, n4; deal.decode(u, mt, n4);
        const int ev_ = moe_find(tstart, mt); const int e = ev_ & 255;
        const int r0 = (ev_ >> 8) * 256, cnt = ((const int*)(p.ws + WS_CNT))[l * 32 + e];
        const int* lst = (const int*)(p.ws + WS_LIST) + (size_t)e * TT * 2;
        unsigned char* Y = (unsigned char*)(p.ws + WS_RY);
        const int _tz = otid(), _w = _tz >> 6, _l = _tz & 63, _wr = _w >> 2, _wc = _w & 3, _fr = _l & 15, _fq = _l >> 4;
        const LAS float* bo = (const LAS float*)(tbl + 2048) + _wc * 64 + _fq * 16;
        u32x2 ent[2][4]; f32x4 bv[2][2];
#pragma unroll
        for (int ai = 0; ai < 2; ++ai)
#pragma unroll
            for (int m = 0; m < 4; ++m) ent[ai][m] = *(const LAS u32x2*)(tbl + (ai * 128 + _wr * 64 + m * 16 + _fr) * 8);
#pragma unroll
        for (int bj = 0; bj < 2; ++bj)
#pragma unroll
            for (int n = 0; n < 2; ++n) bv[bj][n] = *(const LAS f32x4*)(bo + bj * 8 + n * 4);
        (void)lst;
#pragma unroll
        for (int ai = 0; ai < 2; ++ai)
#pragma unroll
            for (int m = 0; m < 4; ++m) { const int lr = r0 + ai * 128 + _wr * 64 + m * 16 + _fr;
                if (lr < cnt) { const float w = __uint_as_float(ent[ai][m].y) * YSCALE; unsigned char* orow = Y + (size_t)ent[ai][m].x * 1024 + n4 * 256 + _wc * 64 + _fq * 16;
                    const float sc_ = 1.f / 256.f;
                    u32x4 pk;
#pragma unroll
                    for (int bj = 0; bj < 2; ++bj)
#pragma unroll
                        for (int n = 0; n < 2; ++n) { const f32x4 v = (acc[ai][bj][m][n] * sc_ + bv[bj][n]) * w;
                            pk[bj * 2 + n] = pk_fp8x4(__builtin_amdgcn_fmed3f(v[0], -448.f, 448.f), __builtin_amdgcn_fmed3f(v[1], -448.f, 448.f), __builtin_amdgcn_fmed3f(v[2], -448.f, 448.f), __builtin_amdgcn_fmed3f(v[3], -448.f, 448.f)); }
                    *(u32x4*)orow = pk; } }
    }
};
DI void phase_moe2(const Params& p, LAS char* shm, int l, const int wv_) {
    LAS int* tstart = (LAS int*)(shm + LDS_MISC + 64);
    moe_tiles(p, tstart, l, wv_);
    PvMoe2 pv{p, l, tstart, shm + 131072, {tstart[32]}}; gemm_stream(shm, pv, wv_);
}

DI void phase_combine(const Params& p, LAS char* shm, int l, const int wv_) {
    const int tid = otid(), wid = tid >> 6, lane = tid & 63;
    const bool alt = p.ph_lo != 0;
    const bf16_t* X = (const bf16_t*)(p.ws + WS_X);
    bf16_t* XO = alt ? (bf16_t*)(p.ws + WS_RA) : (bf16_t*)(p.ws + WS_X);
    float* OUT = alt ? (float*)(p.ws + WS_RA) : p.out;
    const unsigned char* Y = (const unsigned char*)(p.ws + WS_RY);
    const float* MOD = (const float*)(p.ws + WS_MOD);
    bf16_t* H = alt ? (bf16_t*)(p.ws + WS_RA + (size_t)TT * 1024 * 4) : (bf16_t*)(p.ws + WS_H);
    const int Tm = (l == 1) ? TX : TT;
    for (int r = blockIdx.x * 8 + wid; r < Tm; r += gridDim.x * 8) {
        const float* g2 = MOD + (size_t)(l * 33 + mod_row(r)) * 6144 + 5120;
        float v[16];
#pragma unroll
        for (int j = 0; j < 4; ++j) {
            const int col = j * 256 + lane * 4;
            f32x4 s = (f32x4){0.f, 0.f, 0.f, 0.f};
#pragma unroll
            for (int k = 0; k < 4; ++k) { const int yy = *(const int*)(Y + ((size_t)r * 4 + k) * 1024 + col); const f32v2_t ya = __builtin_amdgcn_cvt_pk_f32_fp8(yy, false), yb = __builtin_amdgcn_cvt_pk_f32_fp8(yy, true);
                s[0] += ya[0]; s[1] += ya[1]; s[2] += yb[0]; s[3] += yb[1]; }
            s *= 1.f / YSCALE;
            const u32x2 xb_ = *(const u32x2*)(X + (size_t)r * 1024 + col); const f32x4 gg = *(const f32x4*)(g2 + col);
            const f32x4 xv = (f32x4){bflo(xb_.x), bfhi(xb_.x), bflo(xb_.y), bfhi(xb_.y)};
            const f32x4 o = xv + gg * s;
            if (l == 1) *(f32x4*)(OUT + (size_t)r * 1024 + col) = o; else store_bf16x4(XO + (size_t)r * 1024 + col, o[0], o[1], o[2], o[3]);
            v[j * 4] = o[0]; v[j * 4 + 1] = o[1]; v[j * 4 + 2] = o[2]; v[j * 4 + 3] = o[3];
        }
        if (l == 0) norm_mod_store(v, p.norm1_g + 1024, MOD + (size_t)(1 * 33 + mod_row(r)) * 6144, H + (size_t)r * 1024, wv_);
    }
}

constexpr int NPH_LAYER = 10;
constexpr int NPH = 2 + 2 * NPH_LAYER;

__global__ void __launch_bounds__(512, 2) mk_forward(Params p_unused) {
    extern __shared__ __attribute__((aligned(16))) char smem_raw[];
    LAS char* shm = (LAS char*)smem_raw;
    volatile LAS unsigned* xb_words = (volatile LAS unsigned*)(shm + LDS_MISC);
    const int wv_ = __builtin_amdgcn_readfirstlane((int)(threadIdx.x >> 6));
    if (wv_ == 0 && olane() < 4) xb_words[olane()] = 0u;
    __syncthreads();
    kaptr_t ka = (kaptr_t)__builtin_amdgcn_kernarg_segment_ptr();
    const int tok0 = ptoken();
    const int lo = (int)kld64<__builtin_offsetof(Params, ph_lo)>(ka, tok0), hi = (int)kld64<__builtin_offsetof(Params, ph_hi)>(ka, tok0);
    const bool multi = (hi - lo) > 1;
    unsigned* barw = (unsigned*)((__attribute__((address_space(1))) char*)kld64<__builtin_offsetof(Params, ws)>(ka, tok0) + WS_BAR);
    XcdBarrier bar; bar.bar = barw; bar.x = 0; bar.st = xb_words;
    if (multi) bar = xcd_barrier_post(barw, xb_words, wv_);
#ifndef ONLY_KIND
#define ONLY_KIND (-1)
#endif
#define PHASE(idx, kind, FN, ...) do { if ((ONLY_KIND < 0 || ONLY_KIND == (kind)) && (idx) >= lo && (idx) < hi) { const Params p = kparams(ka, ptoken()); int nrep_ = 1 + ((MK_REPEAT_MASK >> (kind)) & 1); asm volatile("" : "+s"(nrep_)); for (int rep_ = 0; rep_ < nrep_; ++rep_) { Params p2 = p; p2.ph_lo = rep_; FN(p2, ##__VA_ARGS__, wv_); } if ((idx) + 1 < hi) xcd_barrier(bar, wv_); } } while (0)
    PHASE(0, 0, phase_prologue, shm);
    PHASE(1, 1, phase_norm1_l0);
    for (int l = 0; l < 2; ++l) {
        const int b0 = 2 + l * NPH_LAYER;
        PHASE(b0 + 0, 2, phase_inproj, shm, l);
        PHASE(b0 + 1, 3, phase_A, shm, l);
        PHASE(b0 + 2, 4, phase_B, shm, l);
        PHASE(b0 + 3, 5, phase_C, shm, l);
        PHASE(b0 + 4, 6, phase_D, shm, l);
        PHASE(b0 + 5, 7, phase_E, shm, l);
        PHASE(b0 + 6, 8, phase_router, shm, l);
        PHASE(b0 + 7, 9, phase_moe1, shm, l);
        PHASE(b0 + 8, 10, phase_moe2, shm, l);
        PHASE(b0 + 9, 11, phase_combine, shm, l);
    }
#undef PHASE
}


extern "C" void kernel_launch(void* const* d_in, const int* in_sizes, int n_in, void* d_out, int out_size, void* d_ws, size_t ws_size, hipStream_t stream) {
    static int grid = 0;
    if (grid == 0) {
        if (n_in != 39 || ws_size < WS_END) { fprintf(stderr, "kernel_launch: unexpected n_in %d or ws_size %zu (< %zu)\n", n_in, ws_size, (size_t)WS_END); grid = -1; return; }
        int dev = 0, cus = 0;
        if (hipGetDevice(&dev) != hipSuccess || hipDeviceGetAttribute(&cus, hipDeviceAttributeMultiprocessorCount, dev) != hipSuccess) { grid = -1; return; }
        if (hipFuncSetAttribute((const void*)mk_forward, hipFuncAttributeMaxDynamicSharedMemorySize, LDS_BYTES) != hipSuccess) { fprintf(stderr, "kernel_launch: hipFuncSetAttribute failed\n"); grid = -1; return; }
        int per_cu = 0;
        if (hipOccupancyMaxActiveBlocksPerMultiprocessor(&per_cu, (const void*)mk_forward, 512, LDS_BYTES) != hipSuccess || per_cu < 1) fprintf(stderr, "kernel_launch: occupancy query says %d\n", per_cu);
        (void)hipGetLastError();
        grid = cus > 256 ? 256 : cus;
    }
    if (grid < 0) return;
    (void)hipMemsetAsync((char*)d_ws + WS_BAR, 0, 16384 + 1024, stream);
    Params p{};
    const float** pf = (const float**)&p;
    for (int i = 0; i < 39; ++i) pf[i] = (const float*)d_in[i];
    p.out = (float*)d_out; p.ws = (char*)d_ws;
#if MK_ONE_LAUNCH
    p.ph_lo = 0; p.ph_hi = NPH;
    hipLaunchKernelGGL(mk_forward, dim3(grid), dim3(512), LDS_BYTES, stream, p);
#else
#ifndef MK_LAST_PHASE
#define MK_LAST_PHASE NPH
#endif
    for (int ph = 0; ph < MK_LAST_PHASE; ++ph) { p.ph_lo = ph; p.ph_hi = ph + 1; hipLaunchKernelGGL(mk_forward, dim3(grid), dim3(512), LDS_BYTES, stream, p); }
#endif
}
```

```cpp
#include <hip/hip_runtime.h>
#include <stdint.h>
#include <stdio.h>

#ifndef MK_REPEAT_MASK
#define MK_REPEAT_MASK 0x0
#endif
#ifndef MK_ONE_LAUNCH
#define MK_ONE_LAUNCH 1
#endif

#define DI __device__ __forceinline__
#define LAS __attribute__((address_space(3)))
typedef unsigned short bf16_t;
typedef short bf16x8 __attribute__((ext_vector_type(8)));
typedef short s16x4 __attribute__((ext_vector_type(4)));
typedef float f32x4 __attribute__((ext_vector_type(4)));
typedef float f32x16 __attribute__((ext_vector_type(16)));
typedef unsigned u32x2 __attribute__((ext_vector_type(2)));
typedef unsigned u32x4 __attribute__((ext_vector_type(4)));
typedef int i32x4 __attribute__((ext_vector_type(4)));
typedef int i32x8 __attribute__((ext_vector_type(8)));

constexpr int D = 1024, NB = 32, SEQ = 2048, CTXL = 256;
constexpr int TX = NB * SEQ, TC = NB * CTXL, TT = TX + TC;
constexpr int NINP = 1536;
constexpr int OFF_POOL = 512, OFF_Q = 768, OFF_SSM = 960, OFF_KV = 1216, OFF_KPE = 1344, N_IN = 1376;
constexpr int NE = 32;
constexpr int NCH = 36;
constexpr int NCROW = NB * NCH;
constexpr float EPS = 1e-6f;

constexpr size_t WS_BAR = 0;
constexpr size_t WS_CNT = 16384;
constexpr size_t WS_MOD = WS_CNT + 1024;
constexpr size_t WS_A64 = WS_MOD + (size_t)2 * 33 * 6144 * 4;
constexpr size_t WS_WMI = WS_A64 + (size_t)2 * 2 * 16 * 64 * 2 * 4;
constexpr size_t WS_WMO = WS_WMI + (size_t)2 * 1536 * 1024 * 2;
constexpr size_t WS_WPW = WS_WMO + (size_t)2 * 1024 * 1024 * 2;
constexpr size_t WS_WGLU = WS_WPW + (size_t)2 * 256 * 256 * 2;
constexpr size_t WS_WPOOL = WS_WGLU + (size_t)2 * 256 * 256 * 2;
constexpr size_t WS_WQ = WS_WPOOL + (size_t)2 * 256 * 256 * 2;
constexpr size_t WS_WKV = WS_WQ + (size_t)2 * 512 * 256 * 2;
constexpr size_t WS_TS5 = WS_WKV + (size_t)2 * 512 * 256 * 2;
constexpr size_t WS_WS5 = WS_TS5 + (size_t)2 * 16 * 1024 * 1280 * 2;
constexpr size_t WS_W1 = WS_WS5 + (size_t)2 * 16 * 256 * 1024 * 2;
constexpr size_t WS_W2 = WS_W1 + (size_t)32 * 2048 * 1024 * 2;
constexpr size_t WS_X = WS_W2 + (size_t)32 * 1024 * 1024 * 2;
constexpr size_t WS_H = WS_X + (size_t)TT * 1024 * 4;
constexpr size_t WS_LIST = WS_H + (size_t)TT * 1024 * 2;
constexpr size_t WS_TOPW = WS_LIST + (size_t)32 * TT * 8;
constexpr size_t WS_RA = WS_TOPW + (size_t)TT * 4 * 4;
constexpr float YSCALE = 32.f;
constexpr size_t WS_RY = WS_RA + (size_t)TT * 4 * 1024 * 2;
constexpr size_t WS_END = WS_RY + (size_t)TT * 4 * 1024 * 2;
constexpr size_t WS_P = WS_RA;
constexpr size_t WS_ACONV = WS_P + (size_t)TT * NINP * 2;
constexpr size_t WS_APOOL = WS_ACONV + (size_t)TT * 256 * 2;
constexpr size_t WS_RAWQ = WS_APOOL + (size_t)TT * 256 * 2;
constexpr size_t WS_RAWKV = WS_RAWQ + (size_t)TT * 512 * 4;
constexpr size_t WS_Q = WS_RAWKV + (size_t)TT * 512 * 4;
constexpr size_t WS_KB = WS_Q + (size_t)TT * 384 * 2;
constexpr size_t WS_VT = WS_KB + (size_t)128 * 2304 * 96 * 2;
constexpr size_t WS_SST = WS_VT + (size_t)128 * 64 * 2304 * 2;
constexpr size_t WS_HIN = WS_SST + (size_t)NCROW * 16 * 256 * 4;
constexpr size_t WS_Z = WS_HIN + (size_t)NCROW * 16 * 256 * 2;
constexpr size_t WS_CAT = WS_Z + (size_t)TT * 256 * 2;
constexpr size_t WS_MIX_END = WS_CAT + (size_t)TT * 1024 * 2;
static_assert(WS_MIX_END <= WS_END, "mixer buffers must fit in the ACT/Y regions");
static_assert(WS_END <= (size_t)2147483648ull, "workspace budget");

constexpr int LDS_BYTES = 147456;
constexpr int LDS_TTAB = 131072 + 4096;
constexpr int LDS_MISC = 146432;

struct Params {
    const float *x, *c, *ctx, *c_ctx, *ada_w, *ada_b, *norm1_g, *norm2_g, *w_mix_in, *w_mix_out,
        *conv_dw, *conv_dw_b, *conv_ln_g, *conv_ln_b, *conv_pw, *pool_w, *pool_scale,
        *ssm_a_re, *ssm_a_im, *ssm_log_dt, *ssm_b_re, *ssm_b_im, *ssm_c_re, *ssm_c_im, *ssm_d, *ssm_glu_w, *ssm_glu_b,
        *mla_q_a_g, *mla_wq_b, *mla_kv_a_g, *mla_wkv_b, *mla_q_g, *mla_k_g,
        *router_w, *router_b, *exp_w_in, *exp_b_in, *exp_w_out, *exp_b_out;
    float* out;
    char* ws;
    long long ph_lo, ph_hi;
};

typedef const __attribute__((address_space(4))) char* kaptr_t;
template <int OFF> DI unsigned long long kld64(kaptr_t ka, int tok) {
    unsigned long long v;
    asm("s_load_dwordx2 %0, %1, %3\n\ts_waitcnt lgkmcnt(0)" : "=&s"(v) : "s"(ka), "s"(tok), "n"(OFF));
    return v;
}
DI int ptoken() { int t; asm volatile("s_mov_b32 %0, 0" : "=s"(t)); return t; }
DI Params kparams(kaptr_t ka, int tok) {
    Params p;
#define KL_(f) p.f = (decltype(p.f))((__attribute__((address_space(1))) char*)kld64<__builtin_offsetof(Params, f)>(ka, tok))
    KL_(x); KL_(c); KL_(ctx); KL_(c_ctx); KL_(ada_w); KL_(ada_b); KL_(norm1_g); KL_(norm2_g); KL_(w_mix_in); KL_(w_mix_out); KL_(conv_dw); KL_(conv_dw_b); KL_(conv_ln_g); KL_(conv_ln_b); KL_(conv_pw); KL_(pool_w); KL_(pool_scale); KL_(ssm_a_re); KL_(ssm_a_im); KL_(ssm_log_dt); KL_(ssm_b_re); KL_(ssm_b_im); KL_(ssm_c_re); KL_(ssm_c_im); KL_(ssm_d); KL_(ssm_glu_w); KL_(ssm_glu_b); KL_(mla_q_a_g); KL_(mla_wq_b); KL_(mla_kv_a_g); KL_(mla_wkv_b); KL_(mla_q_g); KL_(mla_k_g); KL_(router_w); KL_(router_b); KL_(exp_w_in); KL_(exp_b_in); KL_(exp_w_out); KL_(exp_b_out); KL_(out); KL_(ws);
#undef KL_
    p.ph_lo = 0; p.ph_hi = 0;
    return p;
}

typedef __bf16 bf16v2_t __attribute__((ext_vector_type(2)));
typedef float f32v2_t __attribute__((ext_vector_type(2)));
DI unsigned pk_bf16(float lo, float hi) { const f32v2_t f = {lo, hi}; const bf16v2_t b = __builtin_convertvector(f, bf16v2_t); return __builtin_bit_cast(unsigned, b); }
DI bf16_t f2bf(float x) { return (bf16_t)(pk_bf16(x, 0.f) & 0xffffu); }
DI float bf2f(bf16_t v) { return __uint_as_float(((unsigned)v) << 16); }
DI unsigned f2fp8(float x) { x = fminf(fmaxf(x, -448.f), 448.f); return (unsigned)__builtin_amdgcn_cvt_pk_fp8_f32(x, x, 0, false) & 0xffu; }
DI unsigned pk_fp8x4(float a, float b, float c, float d) { int v = __builtin_amdgcn_cvt_pk_fp8_f32(a, b, 0, false); v = __builtin_amdgcn_cvt_pk_fp8_f32(c, d, v, true); return (unsigned)v; }
DI float bflo(unsigned u) { return __uint_as_float(u << 16); }
DI float bfhi(unsigned u) { return __uint_as_float(u & 0xffff0000u); }
DI int olane() { int l = (int)__builtin_amdgcn_mbcnt_hi(~0u, __builtin_amdgcn_mbcnt_lo(~0u, 0u)); asm volatile("" : "+v"(l)); return l; }
DI float shx(float v, int o) { const int l = olane(); return __int_as_float(__builtin_amdgcn_ds_bpermute((l ^ o) << 2, __float_as_int(v))); }
DI float shi(float v, int src) { return __int_as_float(__builtin_amdgcn_ds_bpermute(src << 2, __float_as_int(v))); }
#define otid() otid_(wv_)
DI int otid_(int wv) { int t = (wv << 6) | olane(); asm volatile("" : "+v"(t)); return t; }
DI float wave_sum(float v) {
#pragma unroll
    for (int o = 32; o > 0; o >>= 1) v += shx(v, o);
    return v;
}
DI float wave_max(float v) {
#pragma unroll
    for (int o = 32; o > 0; o >>= 1) v = fmaxf(v, shx(v, o));
    return v;
}
DI float sigmoidf_(float x) { return __builtin_amdgcn_rcpf(1.f + __builtin_amdgcn_exp2f(-1.4426950408889634f * x)); }
DI float siluf_(float x) { return x * sigmoidf_(x); }
DI float gelu_tanh(float x) {
    const float u = 0.7978845608028654f * (x + 0.044715f * x * x * x);
    return x * __builtin_amdgcn_rcpf(1.f + __builtin_amdgcn_exp2f(-2.8853900817779268f * u));
}
DI unsigned aload32(const void* p_) { unsigned r; asm volatile("global_load_dword %0, %1, off" : "=v"(r) : "v"(p_) : "memory"); return r; }
DI u32x4 aload128(const void* p_) { u32x4 r; asm volatile("global_load_dwordx4 %0, %1, off" : "=v"(r) : "v"(p_) : "memory"); return r; }
#define PV_NOHOOKS typedef int Aux; DI void top(int, Aux&, const int) const {} DI void mid(Aux&, const int) const {} template <class A_> DI void fix(A_&, bool, const int) const {}
DI void glds16(const void* src, LAS char* dst) {
    __builtin_amdgcn_global_load_lds((const __attribute__((address_space(1))) void*)src, (LAS void*)dst, 16, 0, 0);
}

#define XB_TMO      128
#define XB_XCNT(j)  (256  + 64 * (j))
#define XB_XSUB(j)  (1280 + 64 * (j))
#define XB_XGEN(j)  (2304 + 64 * (j))
#define XB_TOP      3328
#define XB_TOPGEN   3392
#define XCD_BAR_WORDS 3456
#define XB_SPIN_CAP (1u << 18)
__device__ __forceinline__ unsigned xb_ld(unsigned* p)              { return __hip_atomic_load(p, __ATOMIC_RELAXED, __HIP_MEMORY_SCOPE_AGENT); }
__device__ __forceinline__ unsigned xb_add(unsigned* p, unsigned v) { return __hip_atomic_fetch_add(p, v, __ATOMIC_RELAXED, __HIP_MEMORY_SCOPE_AGENT); }
__device__ __forceinline__ unsigned xb_xcc_id() { return (unsigned)__builtin_amdgcn_s_getreg((3 << 11) | 20) & 0xFu; }
#define XB_SPIN(cond, bar) do { unsigned _sp = 0; while (cond) { __builtin_amdgcn_s_sleep(1); \
    if ((++_sp & 255u) == 0u) { if (xb_ld(&(bar)[XB_TMO])) break; if (_sp > XB_SPIN_CAP) { atomicAdd(&(bar)[XB_TMO], 1u); break; } } } } while (0)
struct XcdBarrier { unsigned* bar; unsigned x; volatile LAS unsigned* st; };
__device__ __forceinline__ XcdBarrier xcd_barrier_post(unsigned* bar, volatile LAS unsigned* st, const int wv_) {
    XcdBarrier b; b.bar = bar; b.x = xb_xcc_id(); b.st = st;
    if (otid() == 0) (void)xb_add(&bar[XB_XCNT(b.x)], 1u);
    return b;
}
__device__ __forceinline__ void xcd_barrier_complete(unsigned* bar, unsigned x, unsigned& nloc, unsigned& nx) {
    const unsigned G = gridDim.x * gridDim.y * gridDim.z;
    unsigned sum, cnt, mine, sp = 0u;
    for (;;) {
        sum = 0u; cnt = 0u; mine = 0u;
#pragma unroll
        for (unsigned j = 0; j < 16; ++j) { const unsigned c = xb_ld(&bar[XB_XCNT(j)]); sum += c; cnt += (c > 0u) ? 1u : 0u; mine = (j == x) ? c : mine; }
        if (sum == G) break;
        __builtin_amdgcn_s_sleep(1);
        if ((++sp & 255u) == 0u) { if (xb_ld(&bar[XB_TMO])) break; if (sp > XB_SPIN_CAP) { atomicAdd(&bar[XB_TMO], 1u); break; } }
    }
    nloc = mine > 0u ? mine : 1u; nx = cnt > 0u ? cnt : 1u;
}
__device__ __forceinline__ void xcd_barrier(const XcdBarrier& b, const int wv_) {
    asm volatile("s_waitcnt vmcnt(0)" ::: "memory");
    __syncthreads();
    if (otid() == 0) {
        unsigned* bar = b.bar;
        __builtin_amdgcn_s_waitcnt(0);
        unsigned nloc = b.st[0], nx = b.st[1];
        if (nloc == 0u) { xcd_barrier_complete(bar, b.x, nloc, nx); b.st[0] = nloc; b.st[1] = nx; }
        const unsigned old = xb_add(&bar[XB_XSUB(b.x)], 1u);
        const unsigned gen = old / nloc;
        if (old + 1u == (gen + 1u) * nloc) {
            __builtin_amdgcn_fence(__ATOMIC_RELEASE, "agent");
            asm volatile("s_waitcnt vmcnt(0)" ::: "memory");
            const unsigned og = xb_add(&bar[XB_TOP], 1u);
            const unsigned tg = og / nx;
            if (og + 1u == (tg + 1u) * nx) xb_add(&bar[XB_TOPGEN], 1u);
            else XB_SPIN(xb_ld(&bar[XB_TOPGEN]) == tg, bar);
            __builtin_amdgcn_fence(__ATOMIC_ACQUIRE, "agent");
            xb_add(&bar[XB_XGEN(b.x)], 1u);
            asm volatile("s_waitcnt vmcnt(0)" ::: "memory");
        } else {
            XB_SPIN(xb_ld(&bar[XB_XGEN(b.x)]) == gen, bar);
            __builtin_amdgcn_fence(__ATOMIC_ACQUIRE, "agent");
            asm volatile("s_waitcnt vmcnt(0)" ::: "memory");
        }
    }
    __syncthreads();
}

constexpr int HTB = 128 * 64 * 2;
DI int lds_byte(int r, int c) { const int st = (r >> 4) * 2 + (c >> 5), rr = r & 15, cc = c & 31, ob = rr * 64 + cc * 2; return st * 1024 + (ob ^ (((ob >> 9) & 1) << 5)); }
DI void stage_rc(int b, int& R, int& C) { const int st = b / 1024, sb = b % 1024, swz = sb ^ (((sb >> 9) & 1) << 5); R = (st >> 1) * 16 + swz / 64; C = (st & 1) * 32 + (swz % 64) / 2; }

DI void stage_rc_t(int tz, int i, int& R, int& C) { stage_rc(tz * 16 + i * 8192, R, C); }
struct APlain {
    const char* base; int lda2;
    DI void park(LAS unsigned*) const {} DI void unpark(const LAS unsigned*) {} DI void take_uniform(const APlain&) {}
    DI const char* ptr(int tz, int h, int i, int kt) const { int R, C; stage_rc_t(tz, i, R, C); return base + (unsigned)((h * 128 + R) * lda2 + C * 2 + kt * 128); }
};
struct ASimple {
    const char* base; unsigned off[2][2]; unsigned kstride;
    DI void park(LAS unsigned* q) const { *(LAS u32x4*)q = (u32x4){off[0][0], off[0][1], off[1][0], off[1][1]}; }
    DI void unpark(const LAS unsigned* q) { const u32x4 v = *(const LAS u32x4*)q; off[0][0] = v.x; off[0][1] = v.y; off[1][0] = v.z; off[1][1] = v.w; }
    DI void take_uniform(const ASimple& o) { base = o.base; kstride = o.kstride; }
    DI const char* ptr(int tz, int h, int i, int kt) const { return base + (unsigned)(off[h][i] + (unsigned)kt * kstride); }
};
struct ASeg2 {
    const char* base0; const char* base1; unsigned off0[2][2]; unsigned off1[2][2]; unsigned ks0; int nt0;
    DI void park(LAS unsigned*) const {} DI void unpark(const LAS unsigned*) {} DI void take_uniform(const ASeg2&) {}
    DI const char* ptr(int tz, int h, int i, int kt) const { return kt < nt0 ? base0 + (unsigned)(off0[h][i] + (unsigned)kt * ks0) : base1 + (unsigned)(off1[h][i] + (unsigned)(kt - nt0) * 128u); }
};
DI int perm32(int rho) { const int n = rho >> 4, i = rho & 15; return 8 * (i >> 2) + 4 * n + (i & 3); }
struct BSimple {
    const char* base[2]; int ldb2;
    DI const char* ptr(int tz, int h, int i, int kt) const { int R, C; stage_rc_t(tz, i, R, C); const int Rb = (R & ~31) + perm32(R & 31); return base[h] + (unsigned)(Rb * ldb2 + C * 2 + kt * 128); }
};

struct BSeq16 {
    const char* base; int ldb2;
    DI const char* ptr(int tz, int h, int i, int kt) const { int R, C; stage_rc_t(tz, i, R, C); const int rho = R & 31;
        const int Rb = (R >> 5) * 64 + ((rho & 15) >> 2) * 16 + h * 8 + (rho >> 4) * 4 + (rho & 3); return base + (unsigned)(Rb * ldb2 + C * 2 + kt * 128); }
};

#define WAIT_V(n) asm volatile("s_waitcnt vmcnt(" #n ")" ::: "memory")
#define WAIT_L(n) asm volatile("s_waitcnt lgkmcnt(" #n ")" ::: "memory")
#define BAR_ __builtin_amdgcn_s_barrier()
#define SCHED_ __builtin_amdgcn_sched_barrier(0)

DI void zero_acc(f32x4 (&acc)[2][2][4][2]) {
#pragma unroll
    for (int a = 0; a < 2; ++a)
#pragma unroll
        for (int b = 0; b < 2; ++b)
#pragma unroll
            for (int m = 0; m < 4; ++m)
#pragma unroll
                for (int n = 0; n < 2; ++n) acc[a][b][m][n] = (f32x4){0.f, 0.f, 0.f, 0.f};
}
template <int MODE> struct FragT;
template <> struct FragT<0> {
    i32x4 lo, hi;
    DI void load(const LAS char* p0, const LAS char* p1) { lo = *(const LAS i32x4*)p0; hi = *(const LAS i32x4*)p1; }
    static DI f32x4 mma(const FragT& b, const FragT& a, f32x4 c) {
        c = __builtin_amdgcn_mfma_f32_16x16x32_bf16(__builtin_bit_cast(bf16x8, b.lo), __builtin_bit_cast(bf16x8, a.lo), c, 0, 0, 0);
        return __builtin_amdgcn_mfma_f32_16x16x32_bf16(__builtin_bit_cast(bf16x8, b.hi), __builtin_bit_cast(bf16x8, a.hi), c, 0, 0, 0); }
};
template <> struct FragT<1> {
    i32x4 lo, hi;
    DI void load(const LAS char* p0, const LAS char* p1) { lo = *(const LAS i32x4*)p0; hi = *(const LAS i32x4*)p1; }
    static DI long pk(int x, int y) { return (long)(((unsigned long long)(unsigned)y << 32) | (unsigned)x); }
    static DI f32x4 mma(const FragT& b, const FragT& a, f32x4 c) {
        c = __builtin_amdgcn_mfma_f32_16x16x32_fp8_fp8(pk(b.lo.x, b.lo.y), pk(a.lo.x, a.lo.y), c, 0, 0, 0);
        c = __builtin_amdgcn_mfma_f32_16x16x32_fp8_fp8(pk(b.lo.z, b.lo.w), pk(a.lo.z, a.lo.w), c, 0, 0, 0);
        c = __builtin_amdgcn_mfma_f32_16x16x32_fp8_fp8(pk(b.hi.x, b.hi.y), pk(a.hi.x, a.hi.y), c, 0, 0, 0);
        return __builtin_amdgcn_mfma_f32_16x16x32_fp8_fp8(pk(b.hi.z, b.hi.w), pk(a.hi.z, a.hi.w), c, 0, 0, 0); }
};
template <> struct FragT<2> {
    i32x8 v;
    DI void load(const LAS char* p0, const LAS char* p1) { const i32x4 lo = *(const LAS i32x4*)p0, hi = *(const LAS i32x4*)p1; v = __builtin_shufflevector(lo, hi, 0, 1, 2, 3, 4, 5, 6, 7); }
    static DI f32x4 mma(const FragT& b, const FragT& a, f32x4 c) {
        const int one = 0x7f7f7f7f;
        asm volatile("v_mfma_scale_f32_16x16x128_f8f6f4 %0, %1, %2, %0, %3, %3 op_sel_hi:[0,0,0]" : "+v"(c) : "v"(b.v), "v"(a.v), "v"(one));
        return c; }
};
template <class PV>
DI void gemm_stream(LAS char* shm, const PV& pv, const int wv_) {
    typedef typename PV::AS AS; typedef typename PV::BS BS;
    constexpr int nt = PV::NT;
    int u = pv.first();
    if (u < 0) return;
    const int tz = otid();
    const int wr = wv_ >> 2, wc = wv_ & 3, lane = tz & 63, fr = lane & 15, fq = lane >> 4;
    const int aoff = lds_byte(wr * 64 + fr, fq * 8), boff = lds_byte(wc * 32 + fr, fq * 8);
    const unsigned ldsw = (unsigned)wv_ * 1024u;
    f32x4 acc[2][2][4][2]; zero_acc(acc);
    typedef FragT<PV::FP8> Frag;
    Frag At[4], B0[2], B1[2];
    AS ca, na; BS cb, nb;
    pv.src(u, ca, cb, wv_); pv.fix(ca, true, wv_);
    constexpr bool F8 = PV::FP8 != 0;
    LAS unsigned* park = (LAS unsigned*)(shm + 131072) + tz * 4;
    const int aoff0 = aoff, aoff1 = aoff + 1024;
    const int boff0 = boff, boff1 = boff + 1024;
#define SA_(b, h) (((b) * 2 + (h)) * HTB)
#define SB_(b, h) ((4 + (b) * 2 + (h)) * HTB)
#define STG_(bufoff, S, h, kt) do { _Pragma("unroll") for (int i_ = 0; i_ < 2; ++i_) glds16((S).ptr(tz, h, i_, kt), shm + (bufoff) + ldsw + i_ * 8192); } while (0)
#define LDA_(dst, b, h) do { _Pragma("unroll") for (int m = 0; m < 4; ++m) dst[m].load(shm + SA_(b, h) + aoff0 + m * 2048, shm + SA_(b, h) + aoff1 + m * 2048); } while (0)
#define LDB_(dst, b, h) do { _Pragma("unroll") for (int n = 0; n < 2; ++n) dst[n].load(shm + SB_(b, h) + boff0 + n * 2048, shm + SB_(b, h) + boff1 + n * 2048); } while (0)
#define MMA2_(ai, A_, BA_, BB_) do { __builtin_amdgcn_s_setprio(1); \
        _Pragma("unroll") for (int m = 0; m < 4; ++m) _Pragma("unroll") for (int n = 0; n < 2; ++n) acc[ai][0][m][n] = Frag::mma(BA_[n], A_[m], acc[ai][0][m][n]); \
        _Pragma("unroll") for (int m = 0; m < 4; ++m) _Pragma("unroll") for (int n = 0; n < 2; ++n) acc[ai][1][m][n] = Frag::mma(BB_[n], A_[m], acc[ai][1][m][n]); \
        __builtin_amdgcn_s_setprio(0); } while (0)
#define CMEM_ asm volatile("" ::: "memory")
    STG_(SB_(0, 0), cb, 0, 0); STG_(SB_(0, 1), cb, 1, 0); STG_(SA_(0, 0), ca, 0, 0); STG_(SA_(0, 1), ca, 1, 0);
    WAIT_V(0);
    if (wr == 1) BAR_;
    BAR_; CMEM_;
#define ZQ_(ai, bj) do { _Pragma("unroll") for (int m_ = 0; m_ < 4; ++m_) _Pragma("unroll") for (int n_ = 0; n_ < 2; ++n_) acc[ai][bj][m_][n_] = (f32x4){0.f, 0.f, 0.f, 0.f}; } while (0)
    int un = -1; bool has_next = false;
    na = ca; nb = cb;
    for (;;) {
        typename PV::Aux aux;
#pragma clang loop unroll(disable)
        for (int t = 0; t < nt; t += 2) {
            const bool last = (t == nt - 2);
            if (last && has_next) pv.fix(na, false, wv_);
            AS a2 = last ? na : ca; const BS b2 = last ? nb : cb; const int k2 = last ? 0 : t + 2;
            STG_(SB_(1, 0), cb, 0, t + 1); STG_(SB_(1, 1), cb, 1, t + 1); STG_(SA_(1, 0), ca, 0, t + 1); SCHED_;
            LDB_(B0, 0, 0); LDB_(B1, 0, 1); SCHED_; LDA_(At, 0, 0); SCHED_;
            if (t == 0) { ZQ_(0, 0); ZQ_(0, 1); }
            WAIT_V(6); BAR_; WAIT_L(0); MMA2_(0, At, B0, B1); BAR_; SCHED_; CMEM_;
            if (t == 0) pv.top(u, aux, wv_);
            STG_(SA_(1, 1), ca, 1, t + 1); SCHED_;
            LDA_(At, 0, 1); SCHED_;
            if (t == 0) { ZQ_(1, 0); ZQ_(1, 1); }
            WAIT_V(2); BAR_; WAIT_L(0); if (t == 0) pv.mid(aux, wv_); MMA2_(1, At, B0, B1); BAR_; SCHED_; CMEM_;
            STG_(SB_(0, 0), b2, 0, k2); STG_(SB_(0, 1), b2, 1, k2); STG_(SA_(0, 0), a2, 0, k2); SCHED_;
            LDB_(B0, 1, 0); LDB_(B1, 1, 1); SCHED_; LDA_(At, 1, 0); SCHED_;
            WAIT_V(6); BAR_; WAIT_L(0); MMA2_(0, At, B0, B1); BAR_; SCHED_; CMEM_;
            STG_(SA_(0, 1), a2, 1, k2); SCHED_;
            LDA_(At, 1, 1); SCHED_;
            WAIT_V(2);
            if (t == 0) { un = pv.next(u); has_next = un >= 0; if (has_next) pv.src(un, na, nb, wv_); else { na = ca; nb = cb; } }
            BAR_; WAIT_L(0); MMA2_(1, At, B0, B1); BAR_; SCHED_; CMEM_;
        }
        if (PV::FP8 == 2) asm volatile("s_nop 15\n\ts_nop 15" ::: "memory");
        pv.epi(acc, u, wv_);
        if (!has_next) break;
        u = un; ca = na; cb = nb;
    }
#undef ZQ_
    WAIT_V(0);
    if (wr == 0) BAR_;
    BAR_;
#undef SA_
#undef SB_
#undef STG_
#undef LDA_
#undef LDB_
#undef MMA2_
#undef CMEM_
}
DI int lin_first(int shift, int count) { const int G = gridDim.x; const int u = (int)((blockIdx.x + G - (shift % G)) % G); return u < count ? u : -1; }
DI int lin_next(int u, int count) { const int un = u + (int)gridDim.x; return un < count ? un : -1; }
template <int MG, int NTL> struct XcdDeal {
    int MT;
    DI bool decode(int J, int& mt, int& nt) const { const int x = blockIdx.x & 7; const int grp = (J / (MG * NTL)) * 8 + x, w = J % (MG * NTL); mt = grp * MG + w / NTL; nt = w % NTL; return mt < MT; }
    DI int jmax() const { return ((MT + 8 * MG - 1) / (8 * MG)) * (MG * NTL); }
    DI int first() const { int J = blockIdx.x >> 3; const int per = gridDim.x >> 3, jm = jmax(); int mt, nt;
        while (J < jm && !decode(J, mt, nt)) J += per;
        return J < jm ? J : -1; }
    DI int next(int J) const { const int per = gridDim.x >> 3, jm = jmax(); int mt, nt; J += per;
        while (J < jm && !decode(J, mt, nt)) J += per;
        return J < jm ? J : -1; }
};
DI int first_unit(int shift) { const int G = gridDim.x; return (int)((blockIdx.x + G - (shift % G)) % G); }

DI void stage_coords(int (&R)[2], int (&C)[2], const int wv_) {
    const int t_ = otid();
#pragma unroll
    for (int i = 0; i < 2; ++i) stage_rc(t_ * 16 + i * 8192, R[i], C[i]);
}
DI APlain make_a_plain(const bf16_t* A, size_t row0, int lda, int col0) {
    APlain a; a.base = (const char*)(A + row0 * (size_t)lda + col0); a.lda2 = lda * 2; return a;
}
DI BSimple make_b(const bf16_t* Bt0, const bf16_t* Bt1, int ldb) {
    BSimple b; b.base[0] = (const char*)Bt0; b.base[1] = (const char*)Bt1; b.ldb2 = ldb * 2; return b;
}
#define EPI_FOR(acc, ...) do { const int _tz = otid(), _w = _tz >> 6, _l = _tz & 63, _wr = _w >> 2, _wc = _w & 3, _fr = _l & 15, _fq = _l >> 4; \
    _Pragma("unroll") for (int ai = 0; ai < 2; ++ai) _Pragma("unroll") for (int m = 0; m < 4; ++m) { const int lr = ai * 128 + _wr * 64 + m * 16 + _fr; \
    _Pragma("unroll") for (int bj = 0; bj < 2; ++bj) _Pragma("unroll") for (int n = 0; n < 2; ++n) { const int lc = bj * 128 + _wc * 32 + n * 16 + _fq * 4; const f32x4 v = acc[ai][bj][m][n]; __VA_ARGS__ } } } while (0)

DI void store_bf16x4(bf16_t* p, float a, float b, float c, float d) { u32x2 v; v.x = pk_bf16(a, b); v.y = pk_bf16(c, d); *(u32x2*)p = v; }
DI void store_bf16x8(bf16_t* p, const f32x4 a, const f32x4 b) { u32x4 v; v.x = pk_bf16(a[0], a[1]); v.y = pk_bf16(a[2], a[3]); v.z = pk_bf16(b[0], b[1]); v.w = pk_bf16(b[2], b[3]); *(u32x4*)p = v; }
#define EPI_FOR8(acc, ...) do { const int _tz = otid(), _w = _tz >> 6, _l = _tz & 63, _wr = _w >> 2, _wc = _w & 3, _fr = _l & 15, _fq = _l >> 4; \
    _Pragma("unroll") for (int ai = 0; ai < 2; ++ai) _Pragma("unroll") for (int m = 0; m < 4; ++m) { const int lr = ai * 128 + _wr * 64 + m * 16 + _fr; \
    _Pragma("unroll") for (int bj = 0; bj < 2; ++bj) { const int lc = bj * 128 + _wc * 32 + _fq * 8; const f32x4 v0 = acc[ai][bj][m][0], v1 = acc[ai][bj][m][1]; __VA_ARGS__ } } } while (0)

DI int mod_row(int r) { return r < TX ? (r >> 11) : 32; }
DI int crow_tok(int cr) { const int b = cr / NCH, j = cr - b * NCH; return j < 4 ? TX + b * CTXL + j * 64 : b * SEQ + (j - 4) * 64; }

DI void cvt_tile(LAS char* wl  , const float* src, int ld_src, int kvalid, int nvalid, const float* scale, bf16_t* dst, int ld_dst, const int wv_) {
    const int lane = otid() & 63;
    const int lr = lane >> 4, lc = (lane & 15) * 4;
    f32x4 v[16];
#pragma unroll
    for (int it = 0; it < 16; ++it) {
        const int k = it * 4 + lr;
        v[it] = (f32x4){0.f, 0.f, 0.f, 0.f};
        if (src != nullptr && k < kvalid && lc < nvalid) { v[it] = *(const f32x4*)(src + (size_t)k * ld_src + lc); if (scale) { const float s = scale[k]; v[it] *= s; } }
    }
#pragma unroll
    for (int it = 0; it < 16; ++it) {
        const int k = it * 4 + lr;
#pragma unroll
        for (int j = 0; j < 4; ++j) *(LAS bf16_t*)(wl + (lc + j) * 144 + k * 2) = f2bf(v[it][j]);
    }
    asm volatile("s_waitcnt lgkmcnt(0)" ::: "memory");
#pragma unroll
    for (int i = 0; i < 8; ++i) {
        const int q = i * 64 + lane, n = q >> 3, c = q & 7;
        const u32x4 w = *(const LAS u32x4*)(wl + n * 144 + c * 16);
        *(u32x4*)(dst + (size_t)n * ld_dst + c * 8) = w;
    }
    asm volatile("s_waitcnt lgkmcnt(0)" ::: "memory");
}
constexpr float SWI_A = 2.4554669595930156f;
DI void cvt_tile8(LAS char* wl  , const float* src, int ld_src, unsigned char* dst, int ld_dst, const float wscale, const int wv_) {
    const int lane = otid() & 63;
    const int lr = lane >> 4, lc = (lane & 15) * 4;
    f32x4 v[16];
#pragma unroll
    for (int it = 0; it < 16; ++it) v[it] = *(const f32x4*)(src + (size_t)(it * 4 + lr) * ld_src + lc);
#pragma unroll
    for (int it = 0; it < 16; ++it) {
        const int k = it * 4 + lr;
#pragma unroll
        for (int j = 0; j < 4; ++j) *(LAS unsigned char*)(wl + (lc + j) * 80 + k) = (unsigned char)f2fp8(v[it][j] * wscale);
    }
    asm volatile("s_waitcnt lgkmcnt(0)" ::: "memory");
#pragma unroll
    for (int i = 0; i < 4; ++i) {
        const int q = i * 64 + lane, n = q >> 2, c = q & 3;
        const u32x4 w = *(const LAS u32x4*)(wl + n * 80 + c * 16);
        *(u32x4*)(dst + (size_t)n * ld_dst + c * 16) = w;
    }
    asm volatile("s_waitcnt lgkmcnt(0)" ::: "memory");
}
constexpr int CVT_SMALL_TILES = 768 + 512 + 32 + 32 + 64 + 64 + 32;
constexpr int CVT_EXP_TILES = 32 * (32 * 16 + 16 * 16);
DI void cvt_small(const Params& p, LAS char* wl, int t, const int wv_) {
    char* ws = p.ws;
    if (t < 768) { const int l = t / 384, r = t % 384, nt = r / 16, kt = r % 16;
        cvt_tile(wl, p.w_mix_in + (size_t)l * 1024 * N_IN + (size_t)kt * 64 * N_IN + nt * 64, N_IN, 64, N_IN - nt * 64, nullptr,
                 (bf16_t*)(ws + WS_WMI) + ((size_t)l * 1536 + nt * 64) * 1024 + kt * 64, 1024, wv_); return; }
    t -= 768;
    if (t < 512) { const int l = t / 256, r = t % 256, nt = r / 16, kt = r % 16;
        cvt_tile(wl, p.w_mix_out + (size_t)l * 1024 * 1024 + (size_t)kt * 64 * 1024 + nt * 64, 1024, 64, 64, nullptr,
                 (bf16_t*)(ws + WS_WMO) + ((size_t)l * 1024 + nt * 64) * 1024 + kt * 64, 1024, wv_); return; }
    t -= 512;
    if (t < 32) { const int l = t / 16, r = t % 16, nt = r / 4, kt = r % 4;
        cvt_tile(wl, p.conv_pw + (size_t)l * 65536 + (size_t)kt * 64 * 256 + nt * 64, 256, 64, 64, nullptr,
                 (bf16_t*)(ws + WS_WPW) + ((size_t)l * 256 + nt * 64) * 256 + kt * 64, 256, wv_); return; }
    t -= 32;
    if (t < 32) { const int l = t / 16, r = t % 16, nt = r / 4, kt = r % 4;
        cvt_tile(wl, p.ssm_glu_w + (size_t)l * 65536 + (size_t)kt * 64 * 256 + nt * 64, 256, 64, 64, nullptr,
                 (bf16_t*)(ws + WS_WGLU) + ((size_t)l * 256 + nt * 64) * 256 + kt * 64, 256, wv_); return; }
    t -= 32;
    if (t < 64) { const int l = t / 32, r = t % 32, nt = r / 4, kt = r % 4;
        const bool any = (kt < 3) && (nt < 6);
        cvt_tile(wl, any ? p.mla_wq_b + (size_t)l * 192 * 384 + (size_t)kt * 64 * 384 + nt * 64 : nullptr, 384, 64, 64, p.mla_q_a_g + l * 192 + kt * 64,
                 (bf16_t*)(ws + WS_WQ) + ((size_t)l * 512 + nt * 64) * 256 + kt * 64, 256, wv_); return; }
    t -= 64;
    if (t < 64) { const int l = t / 32, r = t % 32, nt = r / 4, kt = r % 4;
        const bool any = (kt < 2);
        cvt_tile(wl, any ? p.mla_wkv_b + (size_t)l * 128 * 512 + (size_t)kt * 64 * 512 + nt * 64 : nullptr, 512, 64, 64, p.mla_kv_a_g + l * 128 + kt * 64,
                 (bf16_t*)(ws + WS_WKV) + ((size_t)l * 512 + nt * 64) * 256 + kt * 64, 256, wv_); return; }
    t -= 64;
    { const int l = t / 16, r = t % 16, nt = r / 4, kt = r % 4;
        cvt_tile(wl, nt == kt ? p.pool_w + ((size_t)l * 4 + nt) * 4096 : nullptr, 64, 64, 64, nullptr,
                 (bf16_t*)(ws + WS_WPOOL) + ((size_t)l * 256 + nt * 64) * 256 + kt * 64, 256, wv_); }
}
DI void cvt_expert(const Params& p, LAS char* wl, int l, int t, const int wv_) {
    char* ws = p.ws;
    const int e = t / 768, r = t % 768;
    if (r < 512) { const int nt = r / 16, kt = r % 16;
        cvt_tile8(wl, p.exp_w_in + ((size_t)(l * NE + e) * 1024 + kt * 64) * 2048 + nt * 64, 2048,
                  (unsigned char*)(ws + WS_W1) + ((size_t)(l * NE + e) * 2048 + nt * 64) * 1024 + kt * 64, 1024, nt < 16 ? 256.f * SWI_A : 256.f / SWI_A, wv_);
    } else { const int q = r - 512, nt = q / 16, kt = q % 16;
        cvt_tile8(wl, p.exp_w_out + ((size_t)(l * NE + e) * 1024 + kt * 64) * 1024 + nt * 64, 1024,
                  (unsigned char*)(ws + WS_W2) + ((size_t)(l * NE + e) * 1024 + nt * 64) * 1024 + kt * 64, 1024, 256.f, wv_);
    }
}

DI void ada_unit(const Params& p, LAS char* shm, int u, const int wv_) {
    const int tid = otid();
    const int l = u / 48, jc = u % 48;
    LAS float* sc = (LAS float*)shm;
    for (int i = tid; i < 33 * 1024; i += 512) { const int r = i >> 10, k = i & 1023; const float v = r < 32 ? p.c[r * 1024 + k] : p.c_ctx[k]; sc[i] = siluf_(v); }
    __syncthreads();
    const int col = tid & 127, kq = tid >> 7;
    float acc[33];
#pragma unroll
    for (int r = 0; r < 33; ++r) acc[r] = 0.f;
    const float* wp = p.ada_w + ((size_t)l * 1024 + kq * 256) * 6144 + jc * 128 + col;
    for (int k4 = 0; k4 < 256; k4 += 4) {
        float w[4];
#pragma unroll
        for (int i = 0; i < 4; ++i) w[i] = wp[(size_t)(k4 + i) * 6144];
#pragma unroll
        for (int r = 0; r < 33; ++r) { const f32x4 s = *(const LAS f32x4*)(sc + r * 1024 + kq * 256 + k4); acc[r] += s[0] * w[0] + s[1] * w[1] + s[2] * w[2] + s[3] * w[3]; }
    }
    __syncthreads();
    LAS float* red = (LAS float*)shm;
#pragma unroll
    for (int r = 0; r < 33; ++r) red[(kq * 33 + r) * 128 + col] = acc[r];
    __syncthreads();
    for (int i = tid; i < 33 * 128; i += 512) { const int r = i >> 7, cc = i & 127;
        const float s = red[(0 * 33 + r) * 128 + cc] + red[(1 * 33 + r) * 128 + cc] + red[(2 * 33 + r) * 128 + cc] + red[(3 * 33 + r) * 128 + cc];
        ((float*)(p.ws + WS_MOD))[((size_t)l * 33 + r) * 6144 + jc * 128 + cc] = s + p.ada_b[l * 6144 + jc * 128 + cc]; }
    __syncthreads();
}

DI void s5_load_bc(const Params& p, LAS float* bb, LAS float* cc, int l, int dir, int g, int tid) {
    const int pbase = ((l * 2 + dir) * 16 + g) * 64;
    const double dt = exp((double)p.ssm_log_dt[(l * 2 + dir) * 16 + g]);
    for (int i = tid; i < 64 * 16; i += 512) { const int q = i >> 4, ci = i & 15;
        const double are = fmin((double)p.ssm_a_re[pbase + q], -1e-4), aim = (double)p.ssm_a_im[pbase + q];
        const double mg = exp(are * dt), abr = mg * cos(aim * dt), abi = mg * sin(aim * dt), den = are * are + aim * aim;
        const double fre = ((abr - 1.0) * are + abi * aim) / den, fim = (abi * are - (abr - 1.0) * aim) / den;
        const double br = (double)p.ssm_b_re[(size_t)(pbase + q) * 16 + ci], bi = (double)p.ssm_b_im[(size_t)(pbase + q) * 16 + ci];
        bb[i * 2] = (float)(fre * br - fim * bi); bb[i * 2 + 1] = (float)(fre * bi + fim * br); }
    for (int i = tid; i < 16 * 64; i += 512) { const int co = i >> 6, q = i & 63;
        const size_t ix = ((size_t)((l * 2 + dir) * 16 + g) * 16 + co) * 64 + q;
        cc[i * 2] = p.ssm_c_re[ix]; cc[i * 2 + 1] = p.ssm_c_im[ix]; }
}
DI void s5pre_unit(const Params& p, LAS char* shm, int u, const int wv_) {
    const int tid = otid();
    const int l = u >> 5, g = (u >> 1) & 15, dir = u & 1;
    LAS float* pw = (LAS float*)shm;
    LAS float* bb = pw + 65 * 64 * 2;
    LAS float* cc = bb + 64 * 16 * 2;
    LAS float* kk = cc + 16 * 64 * 2;
    LAS float* k0o = kk + 64 * 256;
    bf16_t* TS = (bf16_t*)(p.ws + WS_TS5) + (size_t)(l * 16 + g) * 1024 * 1280;
    bf16_t* WS = (bf16_t*)(p.ws + WS_WS5) + (size_t)(l * 16 + g) * 256 * 1024;
    const int cocip = tid & 255, co_ = cocip >> 4, ci_ = cocip & 15;
    if (dir == 0) {
        s5_load_bc(p, bb, cc, l, 1, g, tid);
        __syncthreads();
        if (tid < 256) { float s_ = 0.f;
            for (int q = 0; q < 64; ++q) s_ += cc[(co_ * 64 + q) * 2] * bb[(q * 16 + ci_) * 2] - cc[(co_ * 64 + q) * 2 + 1] * bb[(q * 16 + ci_) * 2 + 1];
            k0o[tid] = s_; }
        __syncthreads();
    }
    {
        const int pbase = ((l * 2 + dir) * 16 + g) * 64;
        const double dt = exp((double)p.ssm_log_dt[(l * 2 + dir) * 16 + g]);
        for (int i = tid; i < 65 * 64; i += 512) { const int tau = i >> 6, q = i & 63;
            const double are = fmin((double)p.ssm_a_re[pbase + q], -1e-4), aim = (double)p.ssm_a_im[pbase + q];
            const double mg = exp(are * dt * tau), an = aim * dt * tau;
            pw[i * 2] = (float)(mg * cos(an)); pw[i * 2 + 1] = (float)(mg * sin(an)); }
        s5_load_bc(p, bb, cc, l, dir, g, tid);
        __syncthreads();
        if (tid < 64) { float* a64 = (float*)(p.ws + WS_A64) + (size_t)(((l * 2 + dir) * 16 + g) * 64 + tid) * 2; a64[0] = pw[(64 * 64 + tid) * 2]; a64[1] = pw[(64 * 64 + tid) * 2 + 1]; }
        { float gr[64], gi[64];
#pragma unroll
          for (int q = 0; q < 64; ++q) { const float cr = cc[(co_ * 64 + q) * 2], cim = cc[(co_ * 64 + q) * 2 + 1], br = bb[(q * 16 + ci_) * 2], bi = bb[(q * 16 + ci_) * 2 + 1];
              gr[q] = cr * br - cim * bi; gi[q] = cr * bi + cim * br; }
          for (int tau = (tid >> 8); tau < 64; tau += 2) {
              float s_ = 0.f;
#pragma unroll
              for (int q = 0; q < 64; ++q) s_ += gr[q] * pw[(tau * 64 + q) * 2] - gi[q] * pw[(tau * 64 + q) * 2 + 1];
              kk[tau * 256 + cocip] = s_;
          } }
        for (int i = tid; i < 128 * 512; i += 512) { const int row = i >> 9, kp = (i & 511) * 2, ri = row >> 6, q = row & 63, s_ = kp >> 4, ci = kp & 15;
            const int e = dir == 0 ? 63 - s_ : s_;
            const float pr = pw[(e * 64 + q) * 2], pi = pw[(e * 64 + q) * 2 + 1];
            float o[2];
#pragma unroll
            for (int j = 0; j < 2; ++j) { const float br = bb[(q * 16 + ci + j) * 2], bi = bb[(q * 16 + ci + j) * 2 + 1]; o[j] = ri == 0 ? pr * br - pi * bi : pr * bi + pi * br; }
            *(unsigned*)(WS + (size_t)(dir * 128 + row) * 1024 + kp) = pk_bf16(o[0], o[1]); }
        for (int i = tid; i < 1024 * 64; i += 512) { const int row = i >> 6, kp = (i & 63) * 2, t = row >> 4, co = row & 15, ri = kp >> 6, q = kp & 63;
            const int e = dir == 0 ? t + 1 : 64 - t;
            float o[2];
#pragma unroll
            for (int j = 0; j < 2; ++j) { const float pr = pw[(e * 64 + q + j) * 2], pi = pw[(e * 64 + q + j) * 2 + 1];
                const float cr = cc[(co * 64 + q + j) * 2], cim = cc[(co * 64 + q + j) * 2 + 1];
                o[j] = ri == 0 ? (cr * pr - cim * pi) : -(cr * pi + cim * pr); }
            *(unsigned*)(TS + (size_t)row * 1280 + 1024 + dir * 128 + kp) = pk_bf16(o[0], o[1]); }
        __syncthreads();
        for (int rr = tid; rr < 1024; rr += 512) { const int t = rr >> 4, co = rr & 15;
            const float dco = p.ssm_d[l * 256 + g * 16 + co];
            bf16_t* rowp = TS + (size_t)rr * 1280;
            const int s_lo = dir == 0 ? 0 : t + 1, s_hi = dir == 0 ? t : 63;
            for (int s_ = s_lo; s_ <= s_hi; ++s_) { const int tau = dir == 0 ? t - s_ : s_ - t;
                unsigned w[8];
#pragma unroll
                for (int j = 0; j < 8; ++j) { float a = kk[tau * 256 + co * 16 + 2 * j], b2 = kk[tau * 256 + co * 16 + 2 * j + 1];
                    if (s_ == t) { a += k0o[co * 16 + 2 * j]; b2 += k0o[co * 16 + 2 * j + 1]; if (2 * j == co) a += dco; if (2 * j + 1 == co) b2 += dco; }
                    w[j] = pk_bf16(a, b2); }
                *(u32x4*)(rowp + s_ * 16) = (u32x4){w[0], w[1], w[2], w[3]}; *(u32x4*)(rowp + s_ * 16 + 8) = (u32x4){w[4], w[5], w[6], w[7]}; }
        }
        __syncthreads();
    }
}

DI void phase_prologue(const Params& p, LAS char* shm, const int wv_) {
    const int tid = otid();
    __syncthreads();
    if (blockIdx.x == 0 && tid < 64) ((int*)(p.ws + WS_CNT))[tid] = 0;
    const int n_cvt = (CVT_SMALL_TILES + 2 * CVT_EXP_TILES + 7) / 8;
    for (int u = blockIdx.x; u < 160; u += gridDim.x) {
        if (u < 64) s5pre_unit(p, shm, u, wv_);
        else ada_unit(p, shm, u - 64, wv_);
    }
    int* wq = (int*)(p.ws + WS_CNT) + 192;
    volatile LAS int* slot = (volatile LAS int*)(shm + LDS_MISC + 32);
    __syncthreads();
    if (tid == 0) slot[0] = atomicAdd(wq, 1);
    __syncthreads();
    int cu = slot[0], par = 0;
    while (cu < n_cvt) {
        int nxt = 0;
        if (tid == 0) nxt = atomicAdd(wq, 1);
        const int t = cu * 8 + wv_;
        LAS char* wl = shm + wv_ * (64 * 144);
        if (t < CVT_SMALL_TILES) cvt_small(p, wl, t, wv_);
        else if (t < CVT_SMALL_TILES + 2 * CVT_EXP_TILES) { const int te = t - CVT_SMALL_TILES; cvt_expert(p, wl, te / CVT_EXP_TILES, te % CVT_EXP_TILES, wv_); }
        par ^= 1;
        if (tid == 0) slot[par] = nxt;
        __syncthreads();
        cu = slot[par];
    }
}

DI void norm_mod_store(const float (&v)[16], const float* g, const float* modrow  , bf16_t* hrow, const int wv_) {
    const int lane = otid() & 63;
    float ss = 0.f;
#pragma unroll
    for (int i = 0; i < 16; ++i) ss += v[i] * v[i];
    ss = wave_sum(ss);
    const float rn = rsqrtf(ss * (1.f / 1024.f) + EPS);
#pragma unroll
    for (int j = 0; j < 4; ++j) {
        const int col = j * 256 + lane * 4;
        const f32x4 gg = *(const f32x4*)(g + col), sh = *(const f32x4*)(modrow + col), sc = *(const f32x4*)(modrow + 1024 + col);
        float o[4];
#pragma unroll
        for (int i = 0; i < 4; ++i) o[i] = v[j * 4 + i] * rn * gg[i] * (1.f + sc[i]) + sh[i];
        store_bf16x4(hrow + col, o[0], o[1], o[2], o[3]);
    }
}
DI void phase_norm1_l0(const Params& p, const int wv_) {
    const int tid_ = otid(); const int wid = tid_ >> 6, lane = tid_ & 63;
    const float* MOD = (const float*)(p.ws + WS_MOD);
    bf16_t* H = (bf16_t*)(p.ws + WS_H);
    for (int r = blockIdx.x * 8 + wid; r < TT; r += gridDim.x * 8) {
        const float* src = r < TX ? p.x + (size_t)r * 1024 : p.ctx + (size_t)(r - TX) * 1024;
        float v[16];
#pragma unroll
        for (int j = 0; j < 4; ++j) { const f32x4 t = __builtin_nontemporal_load((const f32x4*)(src + j * 256 + lane * 4));       v[j * 4] = t[0]; v[j * 4 + 1] = t[1]; v[j * 4 + 2] = t[2]; v[j * 4 + 3] = t[3]; }
        norm_mod_store(v, p.norm1_g, MOD + (size_t)(0 * 33 + mod_row(r)) * 6144, H + (size_t)r * 1024, wv_);
    }
}

struct PvInproj {
    const Params& p; int l;
    PV_NOHOOKS
    static constexpr int NT = 16; static constexpr int FP8 = 0; static constexpr bool PARK = false; typedef APlain AS; typedef BSimple BS;
    XcdDeal<4, 6> deal;
    DI int first() const { return deal.first(); }
    DI int next(int u) const { return deal.next(u); }
    DI void src(int u, AS& a, BS& b, const int wv_) const {
        int mt, nt; deal.decode(u, mt, nt);
        const bf16_t* W = (const bf16_t*)(p.ws + WS_WMI) + (size_t)l * 1536 * 1024;
        a = make_a_plain((const bf16_t*)(p.ws + WS_H), (size_t)mt * 256, 1024, 0);
        b = nt < 2 ? make_b(W + (size_t)(nt * 128) * 1024, W + (size_t)(256 + nt * 128) * 1024, 1024)
                   : make_b(W + (size_t)(nt * 256) * 1024, W + (size_t)(nt * 256 + 128) * 1024, 1024);
    }
    DI void epi(f32x4 (&acc)[2][2][4][2], int u, const int wv_) const {
        int mt, nt; deal.decode(u, mt, nt);
        bf16_t* P = (bf16_t*)(p.ws + WS_P);
        if (nt < 2) {
            const int _tz = otid(), _w = _tz >> 6, _l = _tz & 63, _wr = _w >> 2, _wc = _w & 3, _fr = _l & 15, _fq = _l >> 4;
#pragma unroll
            for (int ai = 0; ai < 2; ++ai)
#pragma unroll
                for (int m = 0; m < 4; ++m) { const int lr = ai * 128 + _wr * 64 + m * 16 + _fr; const int lc = _wc * 32 + _fq * 8;
                    f32x4 o0, o1;
#pragma unroll
                    for (int r = 0; r < 4; ++r) { o0[r] = acc[ai][0][m][0][r] * sigmoidf_(acc[ai][1][m][0][r]); o1[r] = acc[ai][0][m][1][r] * sigmoidf_(acc[ai][1][m][1][r]); }
                    store_bf16x8(P + (size_t)(mt * 256 + lr) * NINP + nt * 128 + lc, o0, o1); }
        } else {
            EPI_FOR8(acc, { store_bf16x8(P + (size_t)(mt * 256 + lr) * NINP + nt * 256 + lc, v0, v1); });
        }
    }
};
DI void phase_inproj(const Params& p, LAS char* shm, int l, const int wv_) {
    PvInproj pv{p, l, {TT / 256}};
    gemm_stream(shm, pv, wv_);
}

template <int N> DI void wave_sum_n(float (&v)[N]) {
    const int l4 = olane();
#pragma unroll
    for (int o = 32; o > 0; o >>= 1) {
        float t_[N];
#pragma unroll
        for (int i = 0; i < N; ++i) t_[i] = __int_as_float(__builtin_amdgcn_ds_bpermute((l4 ^ o) << 2, __float_as_int(v[i])));
#pragma unroll
        for (int i = 0; i < N; ++i) v[i] += t_[i];
    }
}
template <int WIN, bool EDGE>
DI void pool_run(const LAS bf16_t* pin  , bf16_t* AP, int row0, int ts0, int L, int c, int half) {
    for (int blk = 0; blk < 2; ++blk) {
        const int t0 = half * 32 + blk * 16;
        float in[16 + WIN - 1];
#pragma unroll
        for (int i = 0; i < 16 + WIN - 1; ++i) in[i] = bf2f(pin[(t0 + i - WIN / 2 + 8) * 256 + c]);
        float sum = 0.f;
#pragma unroll
        for (int j = 0; j < WIN; ++j) sum += in[j];
#pragma unroll
        for (int o = 0; o < 16; ++o) {
            float inv = 1.f / (float)WIN;
            if (EDGE) { const int ts = ts0 + t0 + o; const int lo = max(ts - WIN / 2, 0), hi = min(ts + WIN - 1 - WIN / 2, L - 1); inv = 1.f / (float)(hi - lo + 1); }
            AP[(size_t)(row0 + t0 + o) * 256 + c] = f2bf(sum * inv - in[o + WIN / 2]);
            if (o < 15) sum += in[o + WIN] - in[o];
        }
    }
}
template <bool EDGE>
DI void pre_unit_t(const Params& p, LAS char* shm, int l, int row0, int ts0, int L, const float (&w)[31], const float bias, const int wv_) {
    const int tid = otid();
    const bf16_t* P = (const bf16_t*)(p.ws + WS_P);
    const int c = tid & 255, half = tid >> 8;
    LAS bf16_t* cin = (LAS bf16_t*)shm;
    LAS float* cv = (LAS float*)(shm + 49152);
    u32x4 creg[6], preg[5];
#pragma unroll
    for (int it = 0; it < 6; ++it) { const int q = it * 512 + tid, row = q >> 5, part = q & 31; const int ts = ts0 - 15 + row;
        creg[it] = (u32x4){0u, 0u, 0u, 0u};
        if (q < 94 * 32 && (!EDGE || (ts >= 0 && ts < L))) creg[it] = *(const u32x4*)(P + (size_t)(row0 - 15 + row) * NINP + part * 8); }
#pragma unroll
    for (int it = 0; it < 5; ++it) { const int q = it * 512 + tid, row = q >> 5, part = q & 31; const int ts = ts0 - 8 + row;
        preg[it] = (u32x4){0u, 0u, 0u, 0u};
        if (!EDGE || (ts >= 0 && ts < L)) preg[it] = *(const u32x4*)(P + (size_t)(row0 - 8 + row) * NINP + OFF_POOL + part * 8); }
#pragma unroll
    for (int it = 0; it < 6; ++it) { const int q = it * 512 + tid; if (q < 94 * 32) *(LAS u32x4*)(cin + q * 8) = creg[it]; }
    __syncthreads();
    {
        const int t0 = half * 32;
        float in[62];
#pragma unroll
        for (int i = 0; i < 62; ++i) in[i] = bf2f(cin[(t0 + i) * 256 + c]);
#pragma unroll
        for (int o = 0; o < 32; ++o) { float s_ = bias;
#pragma unroll
            for (int j = 0; j < 31; ++j) s_ += w[j] * in[o + j];
            cv[(t0 + o) * 257 + c] = s_; }
    }
    __syncthreads();
#pragma unroll
    for (int it = 0; it < 5; ++it) *(LAS u32x4*)(cin + (it * 512 + tid) * 8) = preg[it];
    {
        const int wid = tid >> 6, lane = tid & 63;
        bf16_t* AC = (bf16_t*)(p.ws + WS_ACONV);
        float lg[4], lb[4];
#pragma unroll
        for (int j = 0; j < 4; ++j) { lg[j] = p.conv_ln_g[l * 256 + lane + 64 * j]; lb[j] = p.conv_ln_b[l * 256 + lane + 64 * j]; }
        float x[8][4], s8[8];
#pragma unroll
        for (int i = 0; i < 8; ++i) { s8[i] = 0.f;
#pragma unroll
            for (int j = 0; j < 4; ++j) { x[i][j] = cv[(wid * 8 + i) * 257 + lane + 64 * j]; s8[i] += x[i][j]; } }
        wave_sum_n<8>(s8);
#pragma unroll
        for (int i = 0; i < 8; ++i) { const float mu = s8[i] * (1.f / 256.f); s8[i] = 0.f;
#pragma unroll
            for (int j = 0; j < 4; ++j) { x[i][j] -= mu; s8[i] += x[i][j] * x[i][j]; } }
        wave_sum_n<8>(s8);
#pragma unroll
        for (int i = 0; i < 8; ++i) { const float rs = rsqrtf(s8[i] * (1.f / 256.f) + EPS);
#pragma unroll
            for (int j = 0; j < 4; ++j) { const float y = x[i][j] * rs * lg[j] + lb[j]; AC[(size_t)(row0 + wid * 8 + i) * 256 + lane + 64 * j] = f2bf(siluf_(y)); } }
    }
    __syncthreads();
    {
        bf16_t* AP = (bf16_t*)(p.ws + WS_APOOL);
        const int g = __builtin_amdgcn_readfirstlane(c >> 6);
        if (g == 0) pool_run<2, EDGE>(cin, AP, row0, ts0, L, c, half);
        else if (g == 1) pool_run<4, EDGE>(cin, AP, row0, ts0, L, c, half);
        else if (g == 2) pool_run<8, EDGE>(cin, AP, row0, ts0, L, c, half);
        else pool_run<16, EDGE>(cin, AP, row0, ts0, L, c, half);
    }
    __syncthreads();
}
DI void pre_unit(const Params& p, LAS char* shm, int l, int tile, const float (&w)[31], const float bias, const int wv_) {
    int row0, ts0, L;
    if (tile < 1024) { row0 = tile * 64; ts0 = row0 & 2047; L = SEQ; } else { row0 = TX + (tile - 1024) * 64; ts0 = (row0 - TX) & 255; L = CTXL; }
    if (ts0 >= 16 && ts0 + 64 + 16 <= L) pre_unit_t<false>(p, shm, l, row0, ts0, L, w, bias, wv_);
    else pre_unit_t<true>(p, shm, l, row0, ts0, L, w, bias, wv_);
}
struct PvS5State {
    const Params& p; int l;
    PV_NOHOOKS
    static constexpr int NT = 16; static constexpr int FP8 = 0; static constexpr bool PARK = false; typedef ASimple AS; typedef BSimple BS;
    DI int first() const { return lin_first(0, 80); }
    DI int next(int u) const { return lin_next(u, 80); }
    DI void src(int u, AS& as, BS& bs, const int wv_) const {
        const int g = u / 5, mt = u % 5;
        int R[2], C[2]; stage_coords(R, C, wv_);
        as.base = (const char*)(p.ws + WS_P); as.kstride = 4 * NINP * 2;
#pragma unroll
        for (int h = 0; h < 2; ++h)
#pragma unroll
            for (int i = 0; i < 2; ++i) { const int cr = min(mt * 256 + h * 128 + R[i], NCROW - 1);
                as.off[h][i] = (unsigned)(((size_t)(crow_tok(cr) + (C[i] >> 4)) * NINP + OFF_SSM + g * 16 + (C[i] & 15)) * 2); }
        const bf16_t* W = (const bf16_t*)(p.ws + WS_WS5) + (size_t)(l * 16 + g) * 256 * 1024;
        bs = make_b(W, W + (size_t)128 * 1024, 1024);
    }
    DI void epi(f32x4 (&acc)[2][2][4][2], int u, const int wv_) const {
        const int g = u / 5, mt = u % 5;
        float* SST = (float*)(p.ws + WS_SST);
        EPI_FOR8(acc, { const int cr = mt * 256 + lr; if (cr < NCROW) { float* o_ = SST + ((size_t)cr * 16 + g) * 256 + lc; *(f32x4*)o_ = v0; *(f32x4*)(o_ + 4) = v1; } });
    }
};
struct PvQKV {
    const Params& p; int l;
    PV_NOHOOKS
    static constexpr int NT = 4; static constexpr int FP8 = 0; static constexpr bool PARK = false; typedef APlain AS; typedef BSimple BS;
    DI int first() const { return lin_first(80, 1152); }
    DI int next(int u) const { return lin_next(u, 1152); }
    DI void src(int u, AS& a, BS& b, const int wv_) const {
        const bool isq = u < 576; const int w_ = isq ? u : u - 576; const int mt = w_ >> 1, nt = w_ & 1;
        a = make_a_plain((const bf16_t*)(p.ws + WS_P), (size_t)mt * 256, NINP, isq ? OFF_Q : OFF_KV);
        const bf16_t* W = (const bf16_t*)(p.ws + (isq ? WS_WQ : WS_WKV)) + (size_t)l * 512 * 256 + (size_t)nt * 256 * 256;
        b = make_b(W, W + (size_t)128 * 256, 256);
    }
    DI void epi(f32x4 (&acc)[2][2][4][2], int u, const int wv_) const {
        const bool isq = u < 576; const int w_ = isq ? u : u - 576; const int mt = w_ >> 1, nt = w_ & 1;
        bf16_t* RAW = (bf16_t*)(p.ws + (isq ? WS_RAWQ : WS_RAWKV));
        EPI_FOR8(acc, { store_bf16x8(RAW + (size_t)(mt * 256 + lr) * 512 + nt * 256 + lc, v0, v1); });
    }
};
DI void phase_A(const Params& p, LAS char* shm, int l, const int wv_) {
    { PvS5State pv{p, l}; gemm_stream(shm, pv, wv_); }
    { PvQKV pv{p, l}; gemm_stream(shm, pv, wv_); }
    { const int c_ = otid() & 255;
      float w[31];
#pragma unroll
      for (int j = 0; j < 31; ++j) w[j] = p.conv_dw[((size_t)l * 31 + j) * 256 + c_];
      const float bias = p.conv_dw_b[l * 256 + c_];
      const int n_pre = l == 1 ? 1024 : 1152;
      for (int u = first_unit(80 + 1152); u < n_pre; u += gridDim.x) pre_unit(p, shm, l, u, w, bias, wv_); }
}

DI void qkvpost_unit(const Params& p, LAS char* shm, int l, int unit, const int wv_) {
    const int tid = otid(), wid = tid >> 6, lane = tid & 63;
    const bf16_t* P = (const bf16_t*)(p.ws + WS_P);
    const bf16_t* RAWQ = (const bf16_t*)(p.ws + WS_RAWQ);
    const bf16_t* RAWKV = (const bf16_t*)(p.ws + WS_RAWKV);
    bf16_t* Q = (bf16_t*)(p.ws + WS_Q);
    bf16_t* KB = (bf16_t*)(p.ws + WS_KB);
    bf16_t* VT = (bf16_t*)(p.ws + WS_VT);
    LAS bf16_t* vt = (LAS bf16_t*)shm;
    const int row0 = unit * 64;
    const bool lat = row0 < TX;
    const int b = lat ? (row0 >> 11) : ((row0 - TX) >> 8);
    const int key0 = lat ? (row0 & 2047) : 2048 + ((row0 - TX) & 255);
    const int head = lane >> 4, sub = lane & 15;
    const float lninv = -9.210340371976184f / 8.f;
    const float frq = __expf(lninv * (float)(sub & 7));
    float qg[6], kg[6];
#pragma unroll
    for (int j = 0; j < 6; ++j) { qg[j] = p.mla_q_g[l * 96 + sub + 16 * j] * 0.14724444674085666f; kg[j] = p.mla_k_g[l * 96 + sub + 16 * j]; }
    constexpr int NB = 4;
    for (int tk0 = wid * 8; tk0 < wid * 8 + 8; tk0 += NB) {
        float pq[NB][3], pkv[NB][2], qr[NB][6], kr[NB][6], vr[NB][4];
#pragma unroll
        for (int i = 0; i < NB; ++i) { const int r = row0 + tk0 + i; const bf16_t* pr = P + (size_t)r * NINP;
#pragma unroll
            for (int j = 0; j < 3; ++j) pq[i][j] = bf2f(pr[OFF_Q + lane + 64 * j]);
#pragma unroll
            for (int j = 0; j < 2; ++j) pkv[i][j] = bf2f(pr[OFF_KV + lane + 64 * j]);
#pragma unroll
            for (int j = 0; j < 6; ++j) qr[i][j] = bf2f(RAWQ[(size_t)r * 512 + head * 96 + sub + 16 * j]);
#pragma unroll
            for (int j = 0; j < 4; ++j) kr[i][j] = bf2f(RAWKV[(size_t)r * 512 + head * 128 + sub + 16 * j]);
#pragma unroll
            for (int j = 4; j < 6; ++j) kr[i][j] = bf2f(pr[OFF_KPE + sub + 16 * (j - 4)]);
#pragma unroll
            for (int j = 0; j < 4; ++j) vr[i][j] = bf2f(RAWKV[(size_t)r * 512 + head * 128 + 64 + sub + 16 * j]); }
        float red[2 * NB];
#pragma unroll
        for (int i = 0; i < NB; ++i) { red[2 * i] = pq[i][0] * pq[i][0] + pq[i][1] * pq[i][1] + pq[i][2] * pq[i][2]; red[2 * i + 1] = pkv[i][0] * pkv[i][0] + pkv[i][1] * pkv[i][1]; }
        wave_sum_n<2 * NB>(red);
        float ssq[2 * NB];
#pragma unroll
        for (int i = 0; i < NB; ++i) {
            const float rq = rsqrtf(red[2 * i] * (1.f / 192.f) + EPS), rkv = rsqrtf(red[2 * i + 1] * (1.f / 128.f) + EPS);
            float s0 = 0.f, s1 = 0.f;
#pragma unroll
            for (int j = 0; j < 6; ++j) { qr[i][j] *= rq; s0 += qr[i][j] * qr[i][j]; }
#pragma unroll
            for (int j = 0; j < 4; ++j) { kr[i][j] *= rkv; s1 += kr[i][j] * kr[i][j]; }
#pragma unroll
            for (int j = 4; j < 6; ++j) s1 += kr[i][j] * kr[i][j];
#pragma unroll
            for (int j = 0; j < 4; ++j) vr[i][j] *= rkv;
            ssq[2 * i] = s0; ssq[2 * i + 1] = s1;
        }
        { const int l4 = olane();
#pragma unroll
          for (int o = 8; o > 0; o >>= 1) { float t_[2 * NB];
#pragma unroll
              for (int i = 0; i < 2 * NB; ++i) t_[i] = __int_as_float(__builtin_amdgcn_ds_bpermute((l4 ^ o) << 2, __float_as_int(ssq[i])));
#pragma unroll
              for (int i = 0; i < 2 * NB; ++i) ssq[i] += t_[i]; } }
#pragma unroll
        for (int i = 0; i < NB; ++i) {
            const int tk = tk0 + i, r = row0 + tk;
            const float rnq = rsqrtf(ssq[2 * i] * (1.f / 96.f) + EPS), rnk = rsqrtf(ssq[2 * i + 1] * (1.f / 96.f) + EPS);
#pragma unroll
            for (int j = 0; j < 6; ++j) { qr[i][j] *= rnq * qg[j]; kr[i][j] *= rnk * kg[j]; }
            if (lat) {
                const int tseq = r & 2047; const float a0 = (float)(tseq >> 6) * frq, a1 = (float)(tseq & 63) * frq;
                const float cs0 = __cosf(a0), sn0 = __sinf(a0), cs1 = __cosf(a1), sn1 = __sinf(a1);
                const float oq4 = shx(qr[i][4], 8), oq5 = shx(qr[i][5], 8), ok4 = shx(kr[i][4], 8), ok5 = shx(kr[i][5], 8);
                const float sg = (sub < 8) ? -1.f : 1.f;
                qr[i][4] = qr[i][4] * cs0 + sg * oq4 * sn0; qr[i][5] = qr[i][5] * cs1 + sg * oq5 * sn1;
                kr[i][4] = kr[i][4] * cs0 + sg * ok4 * sn0; kr[i][5] = kr[i][5] * cs1 + sg * ok5 * sn1;
            }
            bf16_t* kro = KB + ((size_t)(b * 4 + head) * 2304 + key0 + tk) * 96;
#pragma unroll
            for (int j = 0; j < 6; ++j) { Q[(size_t)r * 384 + head * 96 + sub + 16 * j] = f2bf(qr[i][j]); kro[sub + 16 * j] = f2bf(kr[i][j]); }
#pragma unroll
            for (int j = 0; j < 4; ++j) vt[(head * 64 + sub + 16 * j) * 72 + tk] = f2bf(vr[i][j]);
        }
    }
    __syncthreads();
    { const int hv = tid >> 1, hf = tid & 1;
      bf16_t* dst = VT + ((size_t)(b * 4 + (hv >> 6)) * 64 + (hv & 63)) * 2304 + key0 + hf * 32;
#pragma unroll
      for (int i = 0; i < 4; ++i) *(u32x4*)(dst + i * 8) = *(const LAS u32x4*)(vt + hv * 72 + hf * 32 + i * 8); }
    __syncthreads();
}
DI void s5carry_unit(const Params& p, int l, int unit, const int wv_) {
    const int gid = unit * 512 + otid();
    const int q = gid & 63, dir = (gid >> 6) & 1, g = (gid >> 7) & 15, b = gid >> 11;
    const float* A64 = (const float*)(p.ws + WS_A64) + (size_t)(((l * 2 + dir) * 16 + g) * 64 + q) * 2;
    const float ar = A64[0], ai = A64[1];
    const float* SST = (const float*)(p.ws + WS_SST);
    bf16_t* HIN = (bf16_t*)(p.ws + WS_HIN);
    float sr[NCH], si[NCH];
#pragma unroll
    for (int s = 0; s < NCH; ++s) { const int j = dir == 0 ? s : (s < 4 ? 3 - s : 39 - s);
        const size_t base = ((size_t)(b * NCH + j) * 16 + g) * 256 + dir * 128 + q; sr[s] = SST[base]; si[s] = SST[base + 64]; }
    float hr = 0.f, hi = 0.f;
#pragma unroll
    for (int s = 0; s < NCH; ++s) {
        const int j = dir == 0 ? s : (s < 4 ? 3 - s : 39 - s);
        const size_t base = ((size_t)(b * NCH + j) * 16 + g) * 256 + dir * 128 + q;
        HIN[base] = f2bf(hr); HIN[base + 64] = f2bf(hi);
        const float nr = ar * hr - ai * hi + sr[s], ni = ar * hi + ai * hr + si[s];
        hr = nr; hi = ni;
    }
}
struct PvConvPool {
    const Params& p; int l;
    PV_NOHOOKS
    static constexpr int NT = 4; static constexpr int FP8 = 0; static constexpr bool PARK = false; typedef APlain AS; typedef BSimple BS;
    DI int nrt() const { return l == 1 ? 256 : 288; }
    DI int first() const { return lin_first(0, 2 * nrt()); }
    DI int next(int u) const { return lin_next(u, 2 * nrt()); }
    DI void src(int u, AS& a, BS& b, const int wv_) const {
        const bool isconv = u < nrt(); const int mt = isconv ? u : u - nrt();
        a = make_a_plain((const bf16_t*)(p.ws + (isconv ? WS_ACONV : WS_APOOL)), (size_t)mt * 256, 256, 0);
        const bf16_t* W = (const bf16_t*)(p.ws + (isconv ? WS_WPW : WS_WPOOL)) + (size_t)l * 65536;
        b = make_b(W, W + (size_t)128 * 256, 256);
    }
    DI void epi(f32x4 (&acc)[2][2][4][2], int u, const int wv_) const {
        const bool isconv = u < nrt(); const int mt = isconv ? u : u - nrt();
        bf16_t* CAT = (bf16_t*)(p.ws + WS_CAT);
        if (isconv) { EPI_FOR8(acc, { store_bf16x8(CAT + (size_t)(mt * 256 + lr) * 1024 + lc, v0, v1); }); }
        else { const int t_ = otid(), c0_ = ((t_ >> 6) & 3) * 32 + ((t_ & 63) >> 4) * 8; f32x4 sc_[2][2];
#pragma unroll
               for (int bj = 0; bj < 2; ++bj)
#pragma unroll
                   for (int n = 0; n < 2; ++n) sc_[bj][n] = *(const f32x4*)(p.pool_scale + l * 256 + bj * 128 + n * 4 + c0_);
               EPI_FOR8(acc, { store_bf16x8(CAT + (size_t)(mt * 256 + lr) * 1024 + 256 + lc, v0 * sc_[bj][0], v1 * sc_[bj][1]); }); }
    }
};
DI void phase_B(const Params& p, LAS char* shm, int l, const int wv_) {
    { PvConvPool pv{p, l}; gemm_stream(shm, pv, wv_); }
    const int n_post = TT / 64, n_carry = 128;
    for (int u = first_unit(l == 1 ? 512 : 576); u < n_post + n_carry; u += gridDim.x) {
        if (u < n_post) qkvpost_unit(p, shm, l, u, wv_);
        else s5carry_unit(p, l, u - n_post, wv_);
    }
}

template <bool NS> DI void attn_unit(const Params& p, LAS char* shm, int l, int b, int h, int qrow0, int nq, int key_lo, int nkeys, const float sh2, const int wv_) {
    const int tid = otid(), wid = tid >> 6, lane = tid & 63, l31 = lane & 31, hh = lane >> 5;
    const bf16_t* Q = (const bf16_t*)(p.ws + WS_Q);
    const bf16_t* KBp = (const bf16_t*)(p.ws + WS_KB) + (size_t)(b * 4 + h) * 2304 * 96;
    const bf16_t* VTp = (const bf16_t*)(p.ws + WS_VT) + (size_t)(b * 4 + h) * 64 * 2304;
    bf16_t* CAT = (bf16_t*)(p.ws + WS_CAT);
    LAS char* kl = shm;
    LAS char* vl = shm + 13312;
    const bool active = wid * 64 < nq;
    LAS char* const wq = shm + 2 * 13312 + 2 * 9216 + wid * 12288 + lane * 16;
    if (active) {
#pragma unroll
        for (int qb = 0; qb < 2; ++qb)
#pragma unroll
            for (int ks = 0; ks < 6; ++ks) *(LAS bf16x8*)(wq + (qb * 6 + ks) * 1024) = *(const bf16x8*)(Q + (size_t)(qrow0 + wid * 64 + qb * 32 + l31) * 384 + h * 96 + ks * 16 + hh * 8);
    }
    f32x16 O[2][2];
#pragma unroll
    for (int a = 0; a < 2; ++a)
#pragma unroll
        for (int c = 0; c < 2; ++c)
#pragma unroll
            for (int i = 0; i < 16; ++i) O[a][c][i] = 0.f;
    float lsum[2] = {0.f, 0.f};
    const int ntile = nkeys / 64;
    LAS char* const kb0 = shm;
    LAS char* const vb0 = shm + 2 * 13312;
    u32x4 kreg0, kreg1, vreg;
    const int k_kr0 = tid / 12, k_p0 = tid % 12, k_kr1 = (tid + 512) / 12, k_p1 = (tid + 512) % 12, v_vd = tid >> 3, v_p = tid & 7;
#define A_LOADK(T_) do { const int key_ = key_lo + (T_) * 64; kreg0 = *(const u32x4*)(KBp + (size_t)(key_ + k_kr0) * 96 + k_p0 * 8); \
        if (tid < 256) kreg1 = *(const u32x4*)(KBp + (size_t)(key_ + k_kr1) * 96 + k_p1 * 8); } while (0)
#define A_LOADV(T_) do { const int key_ = key_lo + (T_) * 64; vreg = *(const u32x4*)(VTp + (size_t)v_vd * 2304 + key_ + v_p * 8); } while (0)
#define A_WRITEK(buf_) do { LAS char* kl_ = kb0 + (buf_) * 13312; *(LAS u32x4*)(kl_ + k_kr0 * 208 + k_p0 * 16) = kreg0; if (tid < 256) *(LAS u32x4*)(kl_ + k_kr1 * 208 + k_p1 * 16) = kreg1; } while (0)
#define A_WRITEV(buf_) do { LAS char* vl_ = vb0 + (buf_) * 9216; *(LAS u32x4*)(vl_ + v_vd * 144 + v_p * 16) = vreg; } while (0)
#define A_QK(S_, kbuf_, half_) do { const LAS char* kl_ = kb0 + (kbuf_) * 13312 + ((half_) * 32 + l31) * 208 + hh * 16; \
        _Pragma("unroll") for (int ks = 0; ks < 6; ++ks) { const bf16x8 a_ = *(const LAS bf16x8*)(kl_ + ks * 32); \
            if (ks == 0) { _Pragma("unroll") for (int qb = 0; qb < 2; ++qb) { f32x16 z_; _Pragma("unroll") for (int i = 0; i < 16; ++i) z_[i] = 0.f; S_[qb] = __builtin_amdgcn_mfma_f32_32x32x16_bf16(a_, *(const LAS bf16x8*)(wq + (qb * 6) * 1024), z_, 0, 0, 0); } } \
            else { _Pragma("unroll") for (int qb = 0; qb < 2; ++qb) S_[qb] = __builtin_amdgcn_mfma_f32_32x32x16_bf16(a_, *(const LAS bf16x8*)(wq + (qb * 6 + ks) * 1024), S_[qb], 0, 0, 0); } } } while (0)
#define A_SOFTMAX(S_, P_) do { _Pragma("unroll") for (int qb = 0; qb < 2; ++qb) { float e_[16]; \
        _Pragma("unroll") for (int i = 0; i < 16; ++i) { e_[i] = __builtin_amdgcn_exp2f(NS ? S_[qb][i] : S_[qb][i] - sh2); lsum[qb] += e_[i]; } \
        _Pragma("unroll") for (int s_ = 0; s_ < 2; ++s_) { u32x4 w_; w_.x = pk_bf16(e_[8 * s_], e_[8 * s_ + 1]); w_.y = pk_bf16(e_[8 * s_ + 2], e_[8 * s_ + 3]); w_.z = pk_bf16(e_[8 * s_ + 4], e_[8 * s_ + 5]); w_.w = pk_bf16(e_[8 * s_ + 6], e_[8 * s_ + 7]); \
            P_[qb][s_] = __builtin_bit_cast(bf16x8, w_); } } } while (0)
#define A_PV(P_, vbuf_, half_) do { const LAS char* vl_ = vb0 + (vbuf_) * 9216 + l31 * 144 + hh * 8; \
        _Pragma("unroll") for (int s_ = 0; s_ < 2; ++s_) { const int kk_ = (half_) * 2 + s_; \
            _Pragma("unroll") for (int vb = 0; vb < 2; ++vb) { \
                const s16x4 lo_ = *(const LAS s16x4*)(vl_ + vb * 32 * 144 + kk_ * 32); const s16x4 hi_ = *(const LAS s16x4*)(vl_ + vb * 32 * 144 + kk_ * 32 + 16); \
                const bf16x8 va_ = __builtin_shufflevector(lo_, hi_, 0, 1, 2, 3, 4, 5, 6, 7); \
                _Pragma("unroll") for (int qb = 0; qb < 2; ++qb) O[vb][qb] = __builtin_amdgcn_mfma_f32_32x32x16_bf16(va_, P_[qb][s_], O[vb][qb], 0, 0, 0); } } } while (0)
#define A_LDF(p_) (*(const LAS bf16x8*)(p_))
#define A_LDV(p_) __builtin_shufflevector(*(const LAS s16x4*)(p_), *(const LAS s16x4*)((p_) + 16), 0, 1, 2, 3, 4, 5, 6, 7)
#define A_SOFT4(g_, Ss_) do { _Pragma("unroll") for (int j_ = 0; j_ < 2; ++j_) { const int ix_ = (g_) * 4 + j_ * 2, qb_ = ix_ >> 4, i_ = ix_ & 15; \
        const float e0_ = __builtin_amdgcn_exp2f(NS ? Ss_[qb_][i_] : Ss_[qb_][i_] - sh2), e1_ = __builtin_amdgcn_exp2f(NS ? Ss_[qb_][i_ + 1] : Ss_[qb_][i_ + 1] - sh2); lsum[qb_] += e0_ + e1_; pw_[ix_ >> 1] = pk_bf16(e0_, e1_); } } while (0)
#define A_STEP(Sq_, kbufq_, halfq_, Ss_, Ps_, Pp_, vbufp_, halfp_) do { \
        const LAS char* kl_ = kb0 + (kbufq_) * 13312 + ((halfq_) * 32 + l31) * 208 + hh * 16; \
        const LAS char* vl_ = vb0 + (vbufp_) * 9216 + l31 * 144 + hh * 8 + (halfp_) * 64; \
        bf16x8 fa_[2], fq_[2][2], fv_[2]; unsigned pw_[16]; \
        fa_[0] = A_LDF(kl_); fq_[0][0] = A_LDF(wq); fq_[0][1] = A_LDF(wq + 6 * 1024); \
        __builtin_amdgcn_sched_barrier(0); \
        _Pragma("unroll") for (int g_ = 0; g_ < 6; ++g_) { \
            if (g_ < 5) { fa_[(g_ + 1) & 1] = A_LDF(kl_ + (g_ + 1) * 32); fq_[(g_ + 1) & 1][0] = A_LDF(wq + (g_ + 1) * 1024); fq_[(g_ + 1) & 1][1] = A_LDF(wq + (6 + g_ + 1) * 1024); } \
            else fv_[0] = A_LDV(vl_); \
            if (g_ == 0) { _Pragma("unroll") for (int qb = 0; qb < 2; ++qb) { f32x16 z_; _Pragma("unroll") for (int i = 0; i < 16; ++i) z_[i] = 0.f; Sq_[qb] = __builtin_amdgcn_mfma_f32_32x32x16_bf16(fa_[0], fq_[0][qb], z_, 0, 0, 0); } } \
            else { _Pragma("unroll") for (int qb = 0; qb < 2; ++qb) Sq_[qb] = __builtin_amdgcn_mfma_f32_32x32x16_bf16(fa_[g_ & 1], fq_[g_ & 1][qb], Sq_[qb], 0, 0, 0); } \
            A_SOFT4(g_, Ss_); \
            __builtin_amdgcn_sched_barrier(0); } \
        _Pragma("unroll") for (int g_ = 0; g_ < 4; ++g_) { const int s_ = g_ >> 1, vb_ = g_ & 1; \
            if (g_ < 3) fv_[(g_ + 1) & 1] = A_LDV(vl_ + ((g_ + 1) & 1) * 32 * 144 + ((g_ + 1) >> 1) * 32); \
            _Pragma("unroll") for (int qb = 0; qb < 2; ++qb) O[vb_][qb] = __builtin_amdgcn_mfma_f32_32x32x16_bf16(fv_[g_ & 1], Pp_[qb][s_], O[vb_][qb], 0, 0, 0); \
            if (g_ < 2) A_SOFT4(6 + g_, Ss_); \
            __builtin_amdgcn_sched_barrier(0); } \
        _Pragma("unroll") for (int qb = 0; qb < 2; ++qb) _Pragma("unroll") for (int s_ = 0; s_ < 2; ++s_) { u32x4 w_; w_.x = pw_[qb * 8 + s_ * 4]; w_.y = pw_[qb * 8 + s_ * 4 + 1]; w_.z = pw_[qb * 8 + s_ * 4 + 2]; w_.w = pw_[qb * 8 + s_ * 4 + 3]; Ps_[qb][s_] = __builtin_bit_cast(bf16x8, w_); } \
    } while (0)
#define A_SCHED(n_) do { _Pragma("unroll") for (int g_ = 0; g_ < (n_); ++g_) { __builtin_amdgcn_sched_group_barrier(0x008, 1, 0); __builtin_amdgcn_sched_group_barrier(0x002, 5, 0); } } while (0)
    {
        u32x4 k1a = (u32x4){0u, 0u, 0u, 0u}, k1b = k1a;
        A_LOADK(0); A_LOADV(0);
        if (ntile > 1) { const int key_ = key_lo + 64; k1a = *(const u32x4*)(KBp + (size_t)(key_ + k_kr0) * 96 + k_p0 * 8); if (tid < 256) k1b = *(const u32x4*)(KBp + (size_t)(key_ + k_kr1) * 96 + k_p1 * 8); }
        A_WRITEK(0); A_WRITEV(0);
        kreg0 = k1a; kreg1 = k1b; A_WRITEK(1);
        if (ntile > 2) A_LOADK(2);
        if (ntile > 1) A_LOADV(1);
    }
    __syncthreads();
    f32x16 Sa[2], Sb[2]; bf16x8 Pa[2][2], Pb[2][2];
    if (active) { A_QK(Sa, 0, 0); A_QK(Sb, 0, 1); A_SOFTMAX(Sa, Pa); A_SCHED(12); }
    for (int T = 0; T < ntile; ++T) {
        const int kcur = T & 1, knxt = kcur ^ 1;
        __syncthreads();
        if (T + 2 < ntile) A_WRITEK(kcur);
        if (T + 1 < ntile) A_WRITEV(knxt);
        if (T + 3 < ntile) A_LOADK(T + 3);
        if (T + 2 < ntile) A_LOADV(T + 2);
        if (active) {
            if (T + 1 < ntile) {
                A_STEP(Sa, knxt, 0, Sb, Pb, Pa, kcur, 0);
                A_STEP(Sb, knxt, 1, Sa, Pa, Pb, kcur, 1);
            } else {
                A_SOFTMAX(Sb, Pb); A_PV(Pa, kcur, 0); A_SCHED(8);
                __builtin_amdgcn_sched_barrier(0);
                A_PV(Pb, kcur, 1);
            }
        }
    }
#undef A_LOADK
#undef A_LOADV
#undef A_WRITEK
#undef A_WRITEV
#undef A_QK
#undef A_SOFTMAX
#undef A_PV
#undef A_SCHED
#undef A_STEP
#undef A_SOFT4
#undef A_LDF
#undef A_LDV
    if (active) {
#pragma unroll
        for (int qb = 0; qb < 2; ++qb) {
            const float tot = lsum[qb] + shx(lsum[qb], 32);
            const float inv = 1.f / tot;
            bf16_t* orow = CAT + (size_t)(qrow0 + wid * 64 + qb * 32 + l31) * 1024 + 768 + h * 64;
#pragma unroll
            for (int vb = 0; vb < 2; ++vb)
#pragma unroll
                for (int i4 = 0; i4 < 4; ++i4)
                    store_bf16x4(orow + vb * 32 + 8 * i4 + 4 * hh, O[vb][qb][4 * i4] * inv, O[vb][qb][4 * i4 + 1] * inv, O[vb][qb][4 * i4 + 2] * inv, O[vb][qb][4 * i4 + 3] * inv);
        }
    }
    __syncthreads();
}
struct PvS5Out {
    const Params& p; int l;
    PV_NOHOOKS
    static constexpr int NT = 20; static constexpr int FP8 = 0; static constexpr bool PARK = false; typedef ASeg2 AS; typedef BSimple BS;
    DI int first() const { return lin_first(512, 320); }
    DI int next(int u) const { return lin_next(u, 320); }
    DI void src(int u, AS& as, BS& bs, const int wv_) const {
        const int ntile = u & 3, mt = (u >> 2) % 5, g = u / 20;
        int R[2], C[2]; stage_coords(R, C, wv_);
        as.base0 = (const char*)(p.ws + WS_P); as.base1 = (const char*)(p.ws + WS_HIN); as.ks0 = 4 * NINP * 2; as.nt0 = 16;
#pragma unroll
        for (int h = 0; h < 2; ++h)
#pragma unroll
            for (int i = 0; i < 2; ++i) { const int cr = min(mt * 256 + h * 128 + R[i], NCROW - 1);
                as.off0[h][i] = (unsigned)(((size_t)(crow_tok(cr) + (C[i] >> 4)) * NINP + OFF_SSM + g * 16 + (C[i] & 15)) * 2);
                as.off1[h][i] = (unsigned)((((size_t)cr * 16 + g) * 256 + C[i]) * 2); }
        const bf16_t* W = (const bf16_t*)(p.ws + WS_TS5) + ((size_t)(l * 16 + g) * 1024 + ntile * 256) * 1280;
        bs = make_b(W, W + (size_t)128 * 1280, 1280);
    }
    DI void epi(f32x4 (&acc)[2][2][4][2], int u, const int wv_) const {
        const int ntile = u & 3, mt = (u >> 2) % 5, g = u / 20;
        bf16_t* Z = (bf16_t*)(p.ws + WS_Z);
        EPI_FOR8(acc, { const int cr = mt * 256 + lr; if (cr < NCROW) { const int col = ntile * 256 + lc, t = col >> 4, co = col & 15;
            const f32x4 g0 = (f32x4){gelu_tanh(v0[0]), gelu_tanh(v0[1]), gelu_tanh(v0[2]), gelu_tanh(v0[3])}, g1_ = (f32x4){gelu_tanh(v1[0]), gelu_tanh(v1[1]), gelu_tanh(v1[2]), gelu_tanh(v1[3])};
            store_bf16x8(Z + (size_t)(crow_tok(cr) + t) * 256 + g * 16 + co, g0, g1_); } });
    }
};
DI void phase_C(const Params& p, LAS char* shm, int l, const int wv_) {
    float sh2;
    { const int lane = otid() & 63; float gq = 0.f, gk = 0.f;
      for (int i = lane; i < 96; i += 64) { gq = fmaxf(gq, fabsf(p.mla_q_g[l * 96 + i])); gk = fmaxf(gk, fabsf(p.mla_k_g[l * 96 + i])); }
      gq = wave_max(gq); gk = wave_max(gk);
      const float c2 = 9.797958971132712f * gq * gk * 1.4426950408889634f;
      sh2 = fmaxf(c2 - 64.f, 0.f); }
    const bool ns = __builtin_amdgcn_readfirstlane(__float_as_int(sh2)) == 0;
    for (int u = blockIdx.x; u < 512; u += gridDim.x) { const int qb = u & 3, h = (u >> 2) & 3, b = u >> 4;
        if (ns) attn_unit<true>(p, shm, l, b, h, b * SEQ + qb * 512, 512, 0, 2304, 0.f, wv_);
        else attn_unit<false>(p, shm, l, b, h, b * SEQ + qb * 512, 512, 0, 2304, sh2, wv_); }
    { PvS5Out pv{p, l}; gemm_stream(shm, pv, wv_); }
    if (l == 0) for (int u = first_unit(512 + 320); u < 128; u += gridDim.x) { const int h = u & 3, b = u >> 2;
        if (ns) attn_unit<true>(p, shm, l, b, h, TX + b * CTXL, 256, 2048, 256, 0.f, wv_);
        else attn_unit<false>(p, shm, l, b, h, TX + b * CTXL, 256, 2048, 256, sh2, wv_); }
}

struct PvGlu {
    const Params& p; int l;
    PV_NOHOOKS
    static constexpr int NT = 4; static constexpr int FP8 = 0; static constexpr bool PARK = false; typedef APlain AS; typedef BSimple BS;
    DI int first() const { return lin_first(0, l == 1 ? 256 : 288); }
    DI int next(int u) const { return lin_next(u, l == 1 ? 256 : 288); }
    DI void src(int u, AS& a, BS& b, const int wv_) const {
        a = make_a_plain((const bf16_t*)(p.ws + WS_Z), (size_t)u * 256, 256, 0);
        const bf16_t* W = (const bf16_t*)(p.ws + WS_WGLU) + (size_t)l * 65536;
        b = make_b(W, W + (size_t)128 * 256, 256);
    }
    DI void epi(f32x4 (&acc)[2][2][4][2], int u, const int wv_) const {
        const bf16_t* Z = (const bf16_t*)(p.ws + WS_Z); bf16_t* CAT = (bf16_t*)(p.ws + WS_CAT);
        const int _tz = otid(), _w = _tz >> 6, _l = _tz & 63, _wr = _w >> 2, _wc = _w & 3, _fr = _l & 15, _fq = _l >> 4;
        const int c0 = _wc * 32 + _fq * 8;
        f32x4 bsv[2][2];
#pragma unroll
        for (int bj = 0; bj < 2; ++bj)
#pragma unroll
            for (int n = 0; n < 2; ++n) bsv[bj][n] = *(const f32x4*)(p.ssm_glu_b + l * 256 + bj * 128 + n * 4 + c0);
#pragma unroll
        for (int ai = 0; ai < 2; ++ai) {
            u32x4 zz[4][2];
#pragma unroll
            for (int m = 0; m < 4; ++m)
#pragma unroll
                for (int bj = 0; bj < 2; ++bj) zz[m][bj] = *(const u32x4*)(Z + (size_t)(u * 256 + ai * 128 + _wr * 64 + m * 16 + _fr) * 256 + bj * 128 + c0);
#pragma unroll
            for (int m = 0; m < 4; ++m) { const size_t r = (size_t)(u * 256 + ai * 128 + _wr * 64 + m * 16 + _fr);
#pragma unroll
                for (int bj = 0; bj < 2; ++bj) { const f32x4 a0 = acc[ai][bj][m][0], a1 = acc[ai][bj][m][1]; const f32x4 b0 = bsv[bj][0], b1 = bsv[bj][1]; const u32x4 z_ = zz[m][bj];
                    const f32x4 o0 = (f32x4){bflo(z_.x) * sigmoidf_(a0[0] + b0[0]), bfhi(z_.x) * sigmoidf_(a0[1] + b0[1]), bflo(z_.y) * sigmoidf_(a0[2] + b0[2]), bfhi(z_.y) * sigmoidf_(a0[3] + b0[3])};
                    const f32x4 o1 = (f32x4){bflo(z_.z) * sigmoidf_(a1[0] + b1[0]), bfhi(z_.z) * sigmoidf_(a1[1] + b1[1]), bflo(z_.w) * sigmoidf_(a1[2] + b1[2]), bfhi(z_.w) * sigmoidf_(a1[3] + b1[3])};
                    store_bf16x8(CAT + r * 1024 + 512 + bj * 128 + c0, o0, o1); } }
        }
    }
};
DI void phase_D(const Params& p, LAS char* shm, int l, const int wv_) {
    PvGlu pv{p, l}; gemm_stream(shm, pv, wv_);
}

struct PvOutproj {
    const Params& p; int l;
    PV_NOHOOKS
    static constexpr int NT = 16; static constexpr int FP8 = 0; static constexpr bool PARK = false; typedef APlain AS; typedef BSimple BS;
    XcdDeal<4, 4> deal;
    DI int first() const { return deal.first(); }
    DI int next(int u) const { return deal.next(u); }
    DI void src(int u, AS& a, BS& b, const int wv_) const {
        int mt, nt; deal.decode(u, mt, nt);
        const bf16_t* W = (const bf16_t*)(p.ws + WS_WMO) + (size_t)l * 1024 * 1024;
        a = make_a_plain((const bf16_t*)(p.ws + WS_CAT), (size_t)mt * 256, 1024, 0);
        b = make_b(W + (size_t)(nt * 256) * 1024, W + (size_t)(nt * 256 + 128) * 1024, 1024);
    }
    DI void epi(f32x4 (&acc)[2][2][4][2], int u, const int wv_) const {
        int mt, nt; deal.decode(u, mt, nt);
        bf16_t* X = (bf16_t*)(p.ws + WS_X);
        const float* MOD = (const float*)(p.ws + WS_MOD) + (size_t)l * 33 * 6144;
        const int _tz = otid(), _w = _tz >> 6, _l = _tz & 63, _wr = _w >> 2, _wc = _w & 3, _fr = _l & 15, _fq = _l >> 4;
        const int c0 = nt * 256 + _wc * 32 + _fq * 8;
        const int row0 = mt * 256;
        const float* g1p = MOD + (size_t)mod_row(row0) * 6144 + 2048 + c0;
        f32x4 g1[2][2];
#pragma unroll
        for (int bj = 0; bj < 2; ++bj)
#pragma unroll
            for (int n = 0; n < 2; ++n) g1[bj][n] = *(const f32x4*)(g1p + bj * 128 + n * 4);
        bf16_t* obase = X + (size_t)row0 * 1024;
        if (l == 0) {
            const float* xbase = row0 < TX ? p.x + (size_t)row0 * 1024 : p.ctx + (size_t)(row0 - TX) * 1024;
#pragma unroll
            for (int ai = 0; ai < 2; ++ai)
#pragma unroll
                for (int mp = 0; mp < 2; ++mp) {
                    f32x4 xv[2][2][2];
#pragma unroll
                    for (int mm = 0; mm < 2; ++mm)
#pragma unroll
                        for (int bj = 0; bj < 2; ++bj)
#pragma unroll
                            for (int n = 0; n < 2; ++n) xv[mm][bj][n] = *(const f32x4*)(xbase + (size_t)(ai * 128 + _wr * 64 + (mp * 2 + mm) * 16 + _fr) * 1024 + c0 + bj * 128 + n * 4);
#pragma unroll
                    for (int mm = 0; mm < 2; ++mm)
#pragma unroll
                        for (int bj = 0; bj < 2; ++bj)
                            store_bf16x8(obase + (size_t)(ai * 128 + _wr * 64 + (mp * 2 + mm) * 16 + _fr) * 1024 + c0 + bj * 128,
                                         xv[mm][bj][0] + g1[bj][0] * acc[ai][bj][mp * 2 + mm][0], xv[mm][bj][1] + g1[bj][1] * acc[ai][bj][mp * 2 + mm][1]);
                }
        } else {
#pragma unroll
            for (int ai = 0; ai < 2; ++ai) {
                u32x4 xv[4][2];
#pragma unroll
                for (int m = 0; m < 4; ++m)
#pragma unroll
                    for (int bj = 0; bj < 2; ++bj) xv[m][bj] = *(const u32x4*)(obase + (size_t)(ai * 128 + _wr * 64 + m * 16 + _fr) * 1024 + c0 + bj * 128);
#pragma unroll
                for (int m = 0; m < 4; ++m)
#pragma unroll
                    for (int bj = 0; bj < 2; ++bj) { const u32x4 x_ = xv[m][bj];
                        const f32x4 x0 = (f32x4){bflo(x_.x), bfhi(x_.x), bflo(x_.y), bfhi(x_.y)}, x1 = (f32x4){bflo(x_.z), bfhi(x_.z), bflo(x_.w), bfhi(x_.w)};
                        store_bf16x8(obase + (size_t)(ai * 128 + _wr * 64 + m * 16 + _fr) * 1024 + c0 + bj * 128, x0 + g1[bj][0] * acc[ai][bj][m][0], x1 + g1[bj][1] * acc[ai][bj][m][1]); }
            }
        }
    }
};
DI void phase_E(const Params& p, LAS char* shm, int l, const int wv_) {
    PvOutproj pv{p, l, {(l == 1 ? TX : TT) / 256}}; gemm_stream(shm, pv, wv_);
}

template <int S> DI float row_rot_f(float v) { return __int_as_float(__builtin_amdgcn_update_dpp(0, __float_as_int(v), 0x120 | S, 0xf, 0xf, false)); }
template <int S> DI int row_rot_i(int v) { return __builtin_amdgcn_update_dpp(0, v, 0x120 | S, 0xf, 0xf, false); }
template <int S> struct RankAcc {
    static DI void run(float o0, float o1, int oe, float v0, float v1, int e0, int& r0, int& r1) {
        const float a0 = S ? row_rot_f<S>(o0) : o0, a1 = S ? row_rot_f<S>(o1) : o1; const int ae = S ? row_rot_i<S>(oe) : oe;
        r0 += (a0 > v0 || (a0 == v0 && ae < e0)) ? 1 : 0;
        r0 += (a1 > v0) ? 1 : 0;
        r1 += (a0 > v1 || a0 == v1) ? 1 : 0;
        r1 += (a1 > v1 || (a1 == v1 && ae < e0)) ? 1 : 0;
        RankAcc<S + 1>::run(o0, o1, oe, v0, v1, e0, r0, r1);
    }
};
template <> struct RankAcc<16> { static DI void run(float, float, int, float, float, int, int&, int&) {} };
DI float row_sum16(float v) { v += row_rot_f<8>(v); v += row_rot_f<4>(v); v += row_rot_f<2>(v); v += row_rot_f<1>(v); return v; }
DI float row_max16(float v) { v = fmaxf(v, row_rot_f<8>(v)); v = fmaxf(v, row_rot_f<4>(v)); v = fmaxf(v, row_rot_f<2>(v)); v = fmaxf(v, row_rot_f<1>(v)); return v; }

DI void phase_router(const Params& p, LAS char* shm, int l, const int wv_) {
    const int tid = otid(), wid = tid >> 6, lane = tid & 63;
    const int Tm = (l == 1) ? TX : TT;
    const bf16_t* X = (const bf16_t*)(p.ws + WS_X);
    const float* MOD = (const float*)(p.ws + WS_MOD) + (size_t)l * 33 * 6144;
    unsigned char* H8 = (unsigned char*)(p.ws + WS_H);
    const bool alt = p.ph_lo != 0;
    int* CNT = (int*)(p.ws + WS_CNT) + l * 32 + (alt ? 64 : 0);
    int* LIST = alt ? (int*)(p.ws + WS_RY) : (int*)(p.ws + WS_LIST);
    LAS char* wfr = shm;
    LAS bf16_t* gml = (LAS bf16_t*)(shm + 131072);
    LAS bf16_t* shl = gml + 1024;
    LAS float* cvec = (LAS float*)(shm + 131072 + 4096);
    LAS int* lcnt = (LAS int*)(cvec + 32);
    LAS int* lbase = lcnt + 32;
    LAS unsigned* lrec = (LAS unsigned*)(lbase + 32);
    LAS float* lwt = (LAS float*)(lrec + 1152);
    const int tpw = (Tm + gridDim.x - 1) / gridDim.x;
    const int tbeg = blockIdx.x * tpw, tend = min(tbeg + tpw, Tm);
    if (tid < 32) lcnt[tid] = 0;
    int seg_beg = tbeg;
    while (seg_beg < tend) {
        const int mrow = mod_row(seg_beg);
        int seg_end = tend;
        if (mrow < 32) seg_end = min(tend, (mrow + 1) * SEQ); else seg_end = tend;
        const float* mr = MOD + (size_t)mrow * 6144;
        __syncthreads();
        for (int k = tid; k < 1024; k += 512) { const float gmv = p.norm2_g[l * 1024 + k] * (1.f + mr[4096 + k]); gml[k] = f2bf(gmv); shl[k] = f2bf(mr[3072 + k]); }
#pragma unroll 8
        for (int i = tid; i < 1024 * 8; i += 512) {
            const int k = i >> 3, e4 = (i & 7) * 4;
            const float gmv = p.norm2_g[l * 1024 + k] * (1.f + mr[4096 + k]);
            const f32x4 w = *(const f32x4*)(p.router_w + (size_t)l * 32768 + k * 32 + e4);
            const int ks = k >> 5, kq = (k >> 3) & 3, j = k & 7;
#pragma unroll
            for (int c = 0; c < 4; ++c) { const int e = e4 + c, nb = e >> 4, ei = e & 15; const float wv = w[c] * gmv;
                const bf16_t hi = f2bf(wv); const bf16_t lo = f2bf(wv - bf2f(hi));
                LAS bf16_t* dst = (LAS bf16_t*)(wfr + ((size_t)((ks * 2 + nb) * 2) * 64 + (kq * 16 + ei)) * 16) + j;
                dst[0] = hi; dst[64 * 8] = lo; }
        }
        {
            float s4[4] = {0.f, 0.f, 0.f, 0.f};
#pragma unroll 8
            for (int k = lane; k < 1024; k += 64) { const float shv = mr[3072 + k]; const f32x4 w = *(const f32x4*)(p.router_w + (size_t)l * 32768 + k * 32 + wid * 4);
                s4[0] += shv * w[0]; s4[1] += shv * w[1]; s4[2] += shv * w[2]; s4[3] += shv * w[3]; }
#pragma unroll
            for (int c = 0; c < 4; ++c) { const float t_ = wave_sum(s4[c]); if (lane == 0) cvec[wid * 4 + c] = t_ + p.router_b[l * 32 + wid * 4 + c]; }
        }
        __syncthreads();
        const int ngroups = (seg_end - seg_beg) >> 4;
        for (int gi = wid; gi < ngroups; gi += 8) {
            const int t0 = seg_beg + gi * 16;
            const int tok = lane & 15, kq = lane >> 4;
            const bf16_t* xr = X + (size_t)(t0 + tok) * 1024 + kq * 8;
            f32x4 acc0 = {0.f, 0.f, 0.f, 0.f}, acc1 = {0.f, 0.f, 0.f, 0.f};
            float ss = 0.f;
            u32x4 xa[16], xb[16];
#pragma unroll
            for (int k2 = 0; k2 < 16; ++k2) xa[k2] = *(const u32x4*)(xr + k2 * 32);
#pragma unroll
            for (int k2 = 0; k2 < 16; ++k2) xb[k2] = *(const u32x4*)(xr + (16 + k2) * 32);
#pragma unroll
            for (int kc = 0; kc < 2; ++kc) {
#pragma unroll
            for (int k2 = 0; k2 < 16; ++k2) { const int ks = kc * 16 + k2;
                if ((k2 & 3) == 0) __builtin_amdgcn_sched_barrier(0);
                const u32x4 xh = kc == 0 ? xa[k2] : xb[k2];
                const float x0 = bflo(xh.x), x1 = bfhi(xh.x), x2 = bflo(xh.y), x3 = bfhi(xh.y), x4 = bflo(xh.z), x5 = bfhi(xh.z), x6 = bflo(xh.w), x7 = bfhi(xh.w);
                ss += x0 * x0 + x1 * x1 + x2 * x2 + x3 * x3 + x4 * x4 + x5 * x5 + x6 * x6 + x7 * x7;
                const bf16x8 ah = __builtin_bit_cast(bf16x8, xh);
                const LAS char* wb = wfr + (size_t)(ks * 4) * 1024 + lane * 16;
                const bf16x8 b0h = *(const LAS bf16x8*)(wb), b0l = *(const LAS bf16x8*)(wb + 1024), b1h = *(const LAS bf16x8*)(wb + 2048), b1l = *(const LAS bf16x8*)(wb + 3072);
                acc0 = __builtin_amdgcn_mfma_f32_16x16x32_bf16(ah, b0h, acc0, 0, 0, 0); acc0 = __builtin_amdgcn_mfma_f32_16x16x32_bf16(ah, b0l, acc0, 0, 0, 0);
                acc1 = __builtin_amdgcn_mfma_f32_16x16x32_bf16(ah, b1h, acc1, 0, 0, 0); acc1 = __builtin_amdgcn_mfma_f32_16x16x32_bf16(ah, b1l, acc1, 0, 0, 0);
            } }
            u32x4 xp[16];
#pragma unroll
            for (int k2 = 0; k2 < 16; ++k2) xp[k2] = *(const u32x4*)(xr + k2 * 32);
            ss += shx(ss, 16); ss += shx(ss, 32);
            const float rn = rsqrtf(ss * (1.f / 1024.f) + EPS);
            const int ei = lane & 15;
            const float c0v = cvec[ei], c1v = cvec[16 + ei];
#pragma unroll
            for (int r = 0; r < 4; ++r) {
                const int tl = (lane >> 4) * 4 + r;
                const float rnt = shi(rn, tl);
                float v0 = fminf(fmaxf(acc0[r] * rnt + c0v, -1e30f), 1e30f), v1 = fminf(fmaxf(acc1[r] * rnt + c1v, -1e30f), 1e30f);
                int r0 = 0, r1 = 0;
                RankAcc<0>::run(v0, v1, ei, v0, v1, ei, r0, r1);
                const float mx = row_max16(fmaxf(v0, v1));
                const bool s0 = r0 < 4, s1 = r1 < 4;
                const float e0 = s0 ? __expf(v0 - mx) : 0.f, e1 = s1 ? __expf(v1 - mx) : 0.f;
                const float inv = 1.f / row_sum16(e0 + e1);
                const int t = t0 + tl;
                if (s0) { const int pos = atomicAdd((int*)&lcnt[ei], 1); lrec[(t - tbeg) * 4 + r0] = (unsigned)ei | ((unsigned)pos << 8); lwt[(t - tbeg) * 4 + r0] = e0 * inv; }
                if (s1) { const int pos = atomicAdd((int*)&lcnt[16 + ei], 1); lrec[(t - tbeg) * 4 + r1] = (unsigned)(16 + ei) | ((unsigned)pos << 8); lwt[(t - tbeg) * 4 + r1] = e1 * inv; }
            }
            unsigned char* hr = H8 + (size_t)(t0 + tok) * 1024 + kq * 8;
#pragma unroll 1
            for (int kc = 0; kc < 2; ++kc) {
            u32x4 xv[16];
            if (kc == 0) {
#pragma unroll
                for (int k2 = 0; k2 < 16; ++k2) xv[k2] = xp[k2];
            } else {
#pragma unroll
                for (int k2 = 0; k2 < 16; ++k2) xv[k2] = *(const u32x4*)(xr + (16 + k2) * 32);
            }
#pragma unroll
            for (int k2 = 0; k2 < 16; ++k2) { const int ks = kc * 16 + k2;
                const u32x4 xh = xv[k2];
                const u32x4 gq = *(const LAS u32x4*)(gml + ks * 32 + kq * 8), sq = *(const LAS u32x4*)(shl + ks * 32 + kq * 8);
                float h[8];
                h[0] = bflo(xh.x) * rn * bflo(gq.x) + bflo(sq.x); h[1] = bfhi(xh.x) * rn * bfhi(gq.x) + bfhi(sq.x); h[2] = bflo(xh.y) * rn * bflo(gq.y) + bflo(sq.y); h[3] = bfhi(xh.y) * rn * bfhi(gq.y) + bfhi(sq.y);
                h[4] = bflo(xh.z) * rn * bflo(gq.z) + bflo(sq.z); h[5] = bfhi(xh.z) * rn * bfhi(gq.z) + bfhi(sq.z); h[6] = bflo(xh.w) * rn * bflo(gq.w) + bflo(sq.w); h[7] = bfhi(xh.w) * rn * bfhi(gq.w) + bfhi(sq.w);
#pragma unroll
                for (int i = 0; i < 8; ++i) h[i] = __builtin_amdgcn_fmed3f(h[i], -448.f, 448.f);
                u32x2 o; o.x = pk_fp8x4(h[0], h[1], h[2], h[3]); o.y = pk_fp8x4(h[4], h[5], h[6], h[7]);
                *(u32x2*)(hr + ks * 32) = o;
            } }
        }
        seg_beg = seg_end;
    }
    __syncthreads();
    if (tid < 32) lbase[tid] = atomicAdd(&CNT[tid], lcnt[tid]);
    __syncthreads();
    for (int i = tid; i < (tend - tbeg) * 4; i += 512) { const unsigned rec = lrec[i]; const int e = rec & 255, pos = rec >> 8;
        u32x2 ent; ent.x = (unsigned)(tbeg * 4 + i); ent.y = __float_as_uint(lwt[i]);
        *(u32x2*)(LIST + ((size_t)e * TT + lbase[e] + pos) * 2) = ent; }
    __syncthreads();
}

DI void moe_tiles(const Params& p, LAS int* tstart, int l, const int wv_) {
    const int* CNT = (const int*)(p.ws + WS_CNT) + l * 32;
    if (otid() == 0) { int s = 0; for (int e = 0; e < 32; ++e) { tstart[e] = s; s += (CNT[e] + 255) >> 8; } tstart[32] = s; }
    __syncthreads();
    LAS int* ttab = (LAS int*)((LAS char*)tstart - (LDS_MISC + 64) + LDS_TTAB);
    const int MT_ = tstart[32];
    for (int mt = otid(); mt < MT_; mt += 512) { int e = 0;
#pragma unroll
        for (int i = 1; i < 32; ++i) e += (mt >= tstart[i]) ? 1 : 0;
        ttab[mt] = e | ((mt - tstart[e]) << 8); }
    __syncthreads();
}
DI int moe_find(const LAS int* tstart, int mt) { const LAS int* ttab = (const LAS int*)((const LAS char*)tstart - (LDS_MISC + 64) + LDS_TTAB); return __builtin_amdgcn_readfirstlane(ttab[mt]); }
struct PvMoe1 {
    const Params& p; int l; const LAS int* tstart; LAS char* tbl;
    static constexpr int NT = 8; static constexpr int FP8 = 2; static constexpr bool PARK = false; typedef ASimple AS; typedef BSimple BS;
    XcdDeal<4, 8> deal;
    DI int first() const { return deal.first(); }
    DI int next(int u) const { return deal.next(u); }
    typedef u32x4 Aux;
    DI void top(int u, Aux& aux, const int wv_) const {
        int mt, n8; deal.decode(u, mt, n8);
        const int ev_ = moe_find(tstart, mt); const int e = ev_ & 255;
        const int t_ = otid() & 63;
        aux = aload128(p.exp_b_in + (size_t)(l * NE + e) * 2048 + (t_ < 32 ? n8 * 128 + t_ * 4 : 1024 + n8 * 128 + (t_ - 32) * 4));
    }
    DI void mid(Aux& aux, const int wv_) const { const int t_ = otid(); asm volatile("" : "+v"(aux)); if (t_ < 64) *(LAS u32x4*)(tbl + t_ * 16) = aux; }
    DI void fix(AS& as, bool wait, const int wv_) const {
        if (wait) asm volatile("s_waitcnt vmcnt(0)" ::: "memory");
        int R[2], C[2]; stage_coords(R, C, wv_);
#pragma unroll
        for (int h = 0; h < 2; ++h)
#pragma unroll
            for (int i = 0; i < 2; ++i) { unsigned sl = as.off[h][i]; asm volatile("" : "+v"(sl)); as.off[h][i] = (sl >> 2) * 1024u + (unsigned)(C[i] * 2); }
    }
    DI void src(int u, AS& as, BS& bs, const int wv_) const {
        int mt, n8; deal.decode(u, mt, n8);
        const int ev_ = moe_find(tstart, mt); const int e = ev_ & 255;
        const int r0 = (ev_ >> 8) * 256, cnt = ((const int*)(p.ws + WS_CNT))[l * 32 + e];
        const int* lst = (const int*)(p.ws + WS_LIST) + (size_t)e * TT * 2;
        int R[2], C[2]; stage_coords(R, C, wv_);
        as.base = (const char*)(p.ws + WS_H); as.kstride = 128;
#pragma unroll
        for (int h = 0; h < 2; ++h)
#pragma unroll
            for (int i = 0; i < 2; ++i) as.off[h][i] = aload32(lst + 2 * min(r0 + h * 128 + R[i], cnt - 1));
        const char* W = (const char*)(p.ws + WS_W1) + (size_t)(l * NE + e) * 2048 * 1024;
        bs.base[0] = W + (size_t)(n8 * 128) * 1024; bs.base[1] = W + (size_t)(1024 + n8 * 128) * 1024; bs.ldb2 = 1024;
    }
    DI void epi(f32x4 (&acc)[2][2][4][2], int u, const int wv_) const {
        int mt, n8; deal.decode(u, mt, n8);
        const int ev_ = moe_find(tstart, mt); const int e = ev_ & 255;
        unsigned char* ACT = (unsigned char*)(p.ws + WS_RA);
        const int _tz = otid(), _w = _tz >> 6, _l = _tz & 63, _wr = _w >> 2, _wc = _w & 3, _fr = _l & 15, _fq = _l >> 4;
        const LAS float* bin = (const LAS float*)tbl + _wc * 32 + _fq * 8;
        f32x4 bg[2], bu[2];
#pragma unroll
        for (int n = 0; n < 2; ++n) { bg[n] = *(const LAS f32x4*)(bin + n * 4) * SWI_A; bu[n] = (*(const LAS f32x4*)(bin + 128 + n * 4) + 1.f) * (1.f / SWI_A); }
        (void)e;
#pragma unroll
        for (int ai = 0; ai < 2; ++ai)
#pragma unroll
            for (int m = 0; m < 4; ++m) { const int lr = ai * 128 + _wr * 64 + m * 16 + _fr;
                unsigned char* orow = ACT + ((size_t)mt * 256 + lr) * 1024 + n8 * 128 + _wc * 32 + _fq * 8;
                u32x2 pk;
#pragma unroll
                for (int n = 0; n < 2; ++n) {
                    float o[4];
#pragma unroll
                    for (int h2 = 0; h2 < 2; ++h2) {
                        const f32v2_t ag = {acc[ai][0][m][n][2 * h2], acc[ai][0][m][n][2 * h2 + 1]}, au = {acc[ai][1][m][n][2 * h2], acc[ai][1][m][n][2 * h2 + 1]};
                        const f32v2_t bgv = {bg[n][2 * h2], bg[n][2 * h2 + 1]}, buv = {bu[n][2 * h2], bu[n][2 * h2 + 1]};
                        f32v2_t g2 = ag * (1.f / 256.f) + bgv, u2 = au * (1.f / 256.f) + buv;
                        g2[0] = fminf(g2[0], 7.f * SWI_A); g2[1] = fminf(g2[1], 7.f * SWI_A);
                        u2[0] = __builtin_amdgcn_fmed3f(u2[0], -6.f / SWI_A, 8.f / SWI_A); u2[1] = __builtin_amdgcn_fmed3f(u2[1], -6.f / SWI_A, 8.f / SWI_A);
                        f32v2_t e2; e2[0] = __builtin_amdgcn_exp2f(-g2[0]); e2[1] = __builtin_amdgcn_exp2f(-g2[1]);
                        const f32v2_t d2 = e2 + 1.f;
                        f32v2_t r2; r2[0] = __builtin_amdgcn_rcpf(d2[0]); r2[1] = __builtin_amdgcn_rcpf(d2[1]);
                        const f32v2_t o2 = u2 * g2 * r2;
                        o[2 * h2] = o2[0]; o[2 * h2 + 1] = o2[1]; }
                    if (n == 0) pk.x = pk_fp8x4(o[0], o[1], o[2], o[3]); else pk.y = pk_fp8x4(o[0], o[1], o[2], o[3]); }
                *(u32x2*)orow = pk; }
    }
};
DI void phase_moe1(const Params& p, LAS char* shm, int l, const int wv_) {
    LAS int* tstart = (LAS int*)(shm + LDS_MISC + 64);
    moe_tiles(p, tstart, l, wv_);
    PvMoe1 pv{p, l, tstart, shm + 131072, {tstart[32]}}; gemm_stream(shm, pv, wv_);
}
struct PvMoe2 {
    const Params& p; int l; const LAS int* tstart; LAS char* tbl;
    static constexpr int NT = 8; static constexpr int FP8 = 2; static constexpr bool PARK = false; typedef APlain AS; typedef BSeq16 BS;
    XcdDeal<4, 4> deal;
    DI int first() const { return deal.first(); }
    DI int next(int u) const { return deal.next(u); }
    template <class A_> DI void fix(A_&, bool, const int) const {}
    typedef u32x4 Aux;
    DI void top(int u, Aux& aux, const int wv_) const {
        int mt, n4; deal.decode(u, mt, n4);
        const int ev_ = moe_find(tstart, mt); const int e = ev_ & 255; const int r0 = (ev_ >> 8) * 256;
        const int t_ = otid();
        const char* src_ = t_ < 128 ? (const char*)((const int*)(p.ws + WS_LIST) + (size_t)e * TT * 2 + (size_t)(r0 + 2 * t_) * 2)
                                    : (const char*)(p.exp_b_out + (size_t)(l * NE + e) * 1024 + n4 * 256 + ((t_ - 128) & 63) * 4);
        aux = aload128(src_);
    }
    DI void mid(Aux& aux, const int wv_) const { const int t_ = otid(); asm volatile("" : "+v"(aux)); if (t_ < 192) *(LAS u32x4*)(tbl + t_ * 16) = aux; }
    DI void src(int u, AS& as, BS& bs, const int wv_) const {
        int mt, n4; deal.decode(u, mt, n4);
        const int ev_ = moe_find(tstart, mt); const int e = ev_ & 255;
        as.base = (const char*)(p.ws + WS_RA) + (size_t)mt * 256 * 1024; as.lda2 = 1024;
        const char* W = (const char*)(p.ws + WS_W2) + (size_t)(l * NE + e) * 1024 * 1024;
        bs.base = W + (size_t)(n4 * 256) * 1024; bs.ldb2 = 1024;
    }
    DI void epi(f32x4 (&acc)[2][2][4][2], int u, const int wv_) const {
        int mt, n4; deal.decode(u, mt, n4);
        const int ev_ = moe_find(tstart, mt); const int e = ev_ & 255;
        const int r0 = (ev_ >> 8) * 256, cnt = ((const int*)(p.ws + WS_CNT))[l * 32 + e];
        const int* lst = (const int*)(p.ws + WS_LIST) + (size_t)e * TT * 2;
        unsigned char* Y = (unsigned char*)(p.ws + WS_RY);
        const int _tz = otid(), _w = _tz >> 6, _l = _tz & 63, _wr = _w >> 2, _wc = _w & 3, _fr = _l & 15, _fq = _l >> 4;
        const LAS float* bo = (const LAS float*)(tbl + 2048) + _wc * 64 + _fq * 16;
        u32x2 ent[2][4]; f32x4 bv[2][2];
#pragma unroll
        for (int ai = 0; ai < 2; ++ai)
#pragma unroll
            for (int m = 0; m < 4; ++m) ent[ai][m] = *(const LAS u32x2*)(tbl + (ai * 128 + _wr * 64 + m * 16 + _fr) * 8);
#pragma unroll
        for (int bj = 0; bj < 2; ++bj)
#pragma unroll
            for (int n = 0; n < 2; ++n) bv[bj][n] = *(const LAS f32x4*)(bo + bj * 8 + n * 4);
        (void)lst;
#pragma unroll
        for (int ai = 0; ai < 2; ++ai)
#pragma unroll
            for (int m = 0; m < 4; ++m) { const int lr = r0 + ai * 128 + _wr * 64 + m * 16 + _fr;
                if (lr < cnt) { const float w = __uint_as_float(ent[ai][m].y) * YSCALE; unsigned char* orow = Y + (size_t)ent[ai][m].x * 1024 + n4 * 256 + _wc * 64 + _fq * 16;
                    const float sc_ = 1.f / 256.f;
                    u32x4 pk;
#pragma unroll
                    for (int bj = 0; bj < 2; ++bj)
#pragma unroll
                        for (int n = 0; n < 2; ++n) { const f32x4 v = (acc[ai][bj][m][n] * sc_ + bv[bj][n]) * w;
                            pk[bj * 2 + n] = pk_fp8x4(__builtin_amdgcn_fmed3f(v[0], -448.f, 448.f), __builtin_amdgcn_fmed3f(v[1], -448.f, 448.f), __builtin_amdgcn_fmed3f(v[2], -448.f, 448.f), __builtin_amdgcn_fmed3f(v[3], -448.f, 448.f)); }
                    *(u32x4*)orow = pk; } }
    }
};
DI void phase_moe2(const Params& p, LAS char* shm, int l, const int wv_) {
    LAS int* tstart = (LAS int*)(shm + LDS_MISC + 64);
    moe_tiles(p, tstart, l, wv_);
    PvMoe2 pv{p, l, tstart, shm + 131072, {tstart[32]}}; gemm_stream(shm, pv, wv_);
}

DI void phase_combine(const Params& p, LAS char* shm, int l, const int wv_) {
    const int tid = otid(), wid = tid >> 6, lane = tid & 63;
    const bool alt = p.ph_lo != 0;
    const bf16_t* X = (const bf16_t*)(p.ws + WS_X);
    bf16_t* XO = alt ? (bf16_t*)(p.ws + WS_RA) : (bf16_t*)(p.ws + WS_X);
    float* OUT = alt ? (float*)(p.ws + WS_RA) : p.out;
    const unsigned char* Y = (const unsigned char*)(p.ws + WS_RY);
    const float* MOD = (const float*)(p.ws + WS_MOD);
    bf16_t* H = alt ? (bf16_t*)(p.ws + WS_RA + (size_t)TT * 1024 * 4) : (bf16_t*)(p.ws + WS_H);
    const int Tm = (l == 1) ? TX : TT;
    for (int r = blockIdx.x * 8 + wid; r < Tm; r += gridDim.x * 8) {
        const float* g2 = MOD + (size_t)(l * 33 + mod_row(r)) * 6144 + 5120;
        float v[16];
#pragma unroll
        for (int j = 0; j < 4; ++j) {
            const int col = j * 256 + lane * 4;
            f32x4 s = (f32x4){0.f, 0.f, 0.f, 0.f};
#pragma unroll
            for (int k = 0; k < 4; ++k) { const int yy = __builtin_nontemporal_load((const int*)(Y + ((size_t)r * 4 + k) * 1024 + col));       const f32v2_t ya = __builtin_amdgcn_cvt_pk_f32_fp8(yy, false), yb = __builtin_amdgcn_cvt_pk_f32_fp8(yy, true);
                s[0] += ya[0]; s[1] += ya[1]; s[2] += yb[0]; s[3] += yb[1]; }
            s *= 1.f / YSCALE;
            const u32x2 xb_ = *(const u32x2*)(X + (size_t)r * 1024 + col); const f32x4 gg = *(const f32x4*)(g2 + col);
            const f32x4 xv = (f32x4){bflo(xb_.x), bfhi(xb_.x), bflo(xb_.y), bfhi(xb_.y)};
            const f32x4 o = xv + gg * s;
            if (l == 1) *(f32x4*)(OUT + (size_t)r * 1024 + col) = o; else store_bf16x4(XO + (size_t)r * 1024 + col, o[0], o[1], o[2], o[3]);
            v[j * 4] = o[0]; v[j * 4 + 1] = o[1]; v[j * 4 + 2] = o[2]; v[j * 4 + 3] = o[3];
        }
        if (l == 0) norm_mod_store(v, p.norm1_g + 1024, MOD + (size_t)(1 * 33 + mod_row(r)) * 6144, H + (size_t)r * 1024, wv_);
    }
}

constexpr int NPH_LAYER = 10;
constexpr int NPH = 2 + 2 * NPH_LAYER;

__global__ void __launch_bounds__(512, 2) mk_forward(Params p_unused) {
    extern __shared__ __attribute__((aligned(16))) char smem_raw[];
    LAS char* shm = (LAS char*)smem_raw;
    volatile LAS unsigned* xb_words = (volatile LAS unsigned*)(shm + LDS_MISC);
    const int wv_ = __builtin_amdgcn_readfirstlane((int)(threadIdx.x >> 6));
    if (wv_ == 0 && olane() < 4) xb_words[olane()] = 0u;
    __syncthreads();
    kaptr_t ka = (kaptr_t)__builtin_amdgcn_kernarg_segment_ptr();
    const int tok0 = ptoken();
    const int lo = (int)kld64<__builtin_offsetof(Params, ph_lo)>(ka, tok0), hi = (int)kld64<__builtin_offsetof(Params, ph_hi)>(ka, tok0);
    const bool multi = (hi - lo) > 1;
    unsigned* barw = (unsigned*)((__attribute__((address_space(1))) char*)kld64<__builtin_offsetof(Params, ws)>(ka, tok0) + WS_BAR);
    XcdBarrier bar; bar.bar = barw; bar.x = 0; bar.st = xb_words;
    if (multi) bar = xcd_barrier_post(barw, xb_words, wv_);
#ifndef ONLY_KIND
#define ONLY_KIND (-1)
#endif
#define PHASE(idx, kind, FN, ...) do { if ((ONLY_KIND < 0 || ONLY_KIND == (kind)) && (idx) >= lo && (idx) < hi) { const Params p = kparams(ka, ptoken()); int nrep_ = 1 + ((MK_REPEAT_MASK >> (kind)) & 1); asm volatile("" : "+s"(nrep_)); for (int rep_ = 0; rep_ < nrep_; ++rep_) { Params p2 = p; p2.ph_lo = rep_; FN(p2, ##__VA_ARGS__, wv_); } if ((idx) + 1 < hi) xcd_barrier(bar, wv_); } } while (0)
    PHASE(0, 0, phase_prologue, shm);
    PHASE(1, 1, phase_norm1_l0);
    for (int l = 0; l < 2; ++l) {
        const int b0 = 2 + l * NPH_LAYER;
        PHASE(b0 + 0, 2, phase_inproj, shm, l);
        PHASE(b0 + 1, 3, phase_A, shm, l);
        PHASE(b0 + 2, 4, phase_B, shm, l);
        PHASE(b0 + 3, 5, phase_C, shm, l);
        PHASE(b0 + 4, 6, phase_D, shm, l);
        PHASE(b0 + 5, 7, phase_E, shm, l);
        PHASE(b0 + 6, 8, phase_router, shm, l);
        PHASE(b0 + 7, 9, phase_moe1, shm, l);
        PHASE(b0 + 8, 10, phase_moe2, shm, l);
        PHASE(b0 + 9, 11, phase_combine, shm, l);
    }
#undef PHASE
}


extern "C" void kernel_launch(void* const* d_in, const int* in_sizes, int n_in, void* d_out, int out_size, void* d_ws, size_t ws_size, hipStream_t stream) {
    static int grid = 0;
    if (grid == 0) {
        if (n_in != 39 || ws_size < WS_END) { fprintf(stderr, "kernel_launch: unexpected n_in %d or ws_size %zu (< %zu)\n", n_in, ws_size, (size_t)WS_END); grid = -1; return; }
        int dev = 0, cus = 0;
        if (hipGetDevice(&dev) != hipSuccess || hipDeviceGetAttribute(&cus, hipDeviceAttributeMultiprocessorCount, dev) != hipSuccess) { grid = -1; return; }
        if (hipFuncSetAttribute((const void*)mk_forward, hipFuncAttributeMaxDynamicSharedMemorySize, LDS_BYTES) != hipSuccess) { fprintf(stderr, "kernel_launch: hipFuncSetAttribute failed\n"); grid = -1; return; }
        int per_cu = 0;
        if (hipOccupancyMaxActiveBlocksPerMultiprocessor(&per_cu, (const void*)mk_forward, 512, LDS_BYTES) != hipSuccess || per_cu < 1) fprintf(stderr, "kernel_launch: occupancy query says %d\n", per_cu);
        (void)hipGetLastError();
        grid = cus > 256 ? 256 : cus;
    }
    if (grid < 0) return;
    (void)hipMemsetAsync((char*)d_ws + WS_BAR, 0, 16384 + 1024, stream);
    Params p{};
    const float** pf = (const float**)&p;
    for (int i = 0; i < 39; ++i) pf[i] = (const float*)d_in[i];
    p.out = (float*)d_out; p.ws = (char*)d_ws;
#if MK_ONE_LAUNCH
    p.ph_lo = 0; p.ph_hi = NPH;
    hipLaunchKernelGGL(mk_forward, dim3(grid), dim3(512), LDS_BYTES, stream, p);
#else
#ifndef MK_LAST_PHASE
#define MK_LAST_PHASE NPH
#endif
    for (int ph = 0; ph < MK_LAST_PHASE; ++ph) { p.ph_lo = ph; p.ph_hi = ph + 1; hipLaunchKernelGGL(mk_forward, dim3(grid), dim3(512), LDS_BYTES, stream, p); }
#endif
}
```

```cpp
#include <hip/hip_runtime.h>
#include <stdint.h>
#include <stdio.h>

#ifndef MK_REPEAT_MASK
#define MK_REPEAT_MASK 0x0
#endif
#ifndef MK_ONE_LAUNCH
#define MK_ONE_LAUNCH 1
#endif

#define DI __device__ __forceinline__
#define LAS __attribute__((address_space(3)))
typedef unsigned short bf16_t;
typedef short bf16x8 __attribute__((ext_vector_type(8)));
typedef short s16x4 __attribute__((ext_vector_type(4)));
typedef float f32x4 __attribute__((ext_vector_type(4)));
typedef float f32x16 __attribute__((ext_vector_type(16)));
typedef unsigned u32x2 __attribute__((ext_vector_type(2)));
typedef unsigned u32x4 __attribute__((ext_vector_type(4)));
typedef int i32x4 __attribute__((ext_vector_type(4)));
typedef int i32x8 __attribute__((ext_vector_type(8)));

constexpr int D = 1024, NB = 32, SEQ = 2048, CTXL = 256;
constexpr int TX = NB * SEQ, TC = NB * CTXL, TT = TX + TC;
constexpr int NINP = 1536;
constexpr int OFF_POOL = 512, OFF_Q = 768, OFF_SSM = 960, OFF_KV = 1216, OFF_KPE = 1344, N_IN = 1376;
constexpr int NE = 32;
constexpr int NCH = 36;
constexpr int NCROW = NB * NCH;
constexpr float EPS = 1e-6f;

constexpr size_t WS_BAR = 0;
constexpr size_t WS_CNT = 16384;
constexpr size_t WS_MOD = WS_CNT + 1024;
constexpr size_t WS_A64 = WS_MOD + (size_t)2 * 33 * 6144 * 4;
constexpr size_t WS_WMI = WS_A64 + (size_t)2 * 2 * 16 * 64 * 2 * 4;
constexpr size_t WS_WMO = WS_WMI + (size_t)2 * 1536 * 1024 * 2;
constexpr size_t WS_WPW = WS_WMO + (size_t)2 * 1024 * 1024 * 2;
constexpr size_t WS_WGLU = WS_WPW + (size_t)2 * 256 * 256 * 2;
constexpr size_t WS_WPOOL = WS_WGLU + (size_t)2 * 256 * 256 * 2;
constexpr size_t WS_WQ = WS_WPOOL + (size_t)2 * 256 * 256 * 2;
constexpr size_t WS_WKV = WS_WQ + (size_t)2 * 512 * 256 * 2;
constexpr size_t WS_TS5 = WS_WKV + (size_t)2 * 512 * 256 * 2;
constexpr size_t WS_WS5 = WS_TS5 + (size_t)2 * 16 * 1024 * 1280 * 2;
constexpr size_t WS_W1 = WS_WS5 + (size_t)2 * 16 * 256 * 1024 * 2;
constexpr size_t WS_W2 = WS_W1 + (size_t)32 * 2048 * 1024 * 2;
constexpr size_t WS_X = WS_W2 + (size_t)32 * 1024 * 1024 * 2;
constexpr size_t WS_H = WS_X + (size_t)TT * 1024 * 4;
constexpr size_t WS_LIST = WS_H + (size_t)TT * 1024 * 2;
constexpr size_t WS_TOPW = WS_LIST + (size_t)32 * TT * 8;
constexpr size_t WS_RA = WS_TOPW + (size_t)TT * 4 * 4;
constexpr float YSCALE = 32.f;
constexpr size_t WS_RY = WS_RA + (size_t)TT * 4 * 1024 * 2;
constexpr size_t WS_END = WS_RY + (size_t)TT * 4 * 1024 * 2;
constexpr size_t WS_P = WS_RA;
constexpr size_t WS_ACONV = WS_P + (size_t)TT * NINP * 2;
constexpr size_t WS_APOOL = WS_ACONV + (size_t)TT * 256 * 2;
constexpr size_t WS_RAWQ = WS_APOOL + (size_t)TT * 256 * 2;
constexpr size_t WS_RAWKV = WS_RAWQ + (size_t)TT * 512 * 4;
constexpr size_t WS_Q = WS_RAWKV + (size_t)TT * 512 * 4;
constexpr size_t WS_KB = WS_Q + (size_t)TT * 384 * 2;
constexpr size_t WS_VT = WS_KB + (size_t)128 * 2304 * 96 * 2;
constexpr size_t WS_SST = WS_VT + (size_t)128 * 64 * 2304 * 2;
constexpr size_t WS_HIN = WS_SST + (size_t)NCROW * 16 * 256 * 4;
constexpr size_t WS_Z = WS_HIN + (size_t)NCROW * 16 * 256 * 2;
constexpr size_t WS_CAT = WS_Z + (size_t)TT * 256 * 2;
constexpr size_t WS_MIX_END = WS_CAT + (size_t)TT * 1024 * 2;
static_assert(WS_MIX_END <= WS_END, "mixer buffers must fit in the ACT/Y regions");
static_assert(WS_END <= (size_t)2147483648ull, "workspace budget");

constexpr int LDS_BYTES = 147456;
constexpr int LDS_TTAB = 131072 + 4096;
constexpr int LDS_MISC = 146432;

struct Params {
    const float *x, *c, *ctx, *c_ctx, *ada_w, *ada_b, *norm1_g, *norm2_g, *w_mix_in, *w_mix_out,
        *conv_dw, *conv_dw_b, *conv_ln_g, *conv_ln_b, *conv_pw, *pool_w, *pool_scale,
        *ssm_a_re, *ssm_a_im, *ssm_log_dt, *ssm_b_re, *ssm_b_im, *ssm_c_re, *ssm_c_im, *ssm_d, *ssm_glu_w, *ssm_glu_b,
        *mla_q_a_g, *mla_wq_b, *mla_kv_a_g, *mla_wkv_b, *mla_q_g, *mla_k_g,
        *router_w, *router_b, *exp_w_in, *exp_b_in, *exp_w_out, *exp_b_out;
    float* out;
    char* ws;
    long long ph_lo, ph_hi;
};

typedef const __attribute__((address_space(4))) char* kaptr_t;
template <int OFF> DI unsigned long long kld64(kaptr_t ka, int tok) {
    unsigned long long v;
    asm("s_load_dwordx2 %0, %1, %3\n\ts_waitcnt lgkmcnt(0)" : "=&s"(v) : "s"(ka), "s"(tok), "n"(OFF));
    return v;
}
DI int ptoken() { int t; asm volatile("s_mov_b32 %0, 0" : "=s"(t)); return t; }
DI Params kparams(kaptr_t ka, int tok) {
    Params p;
#define KL_(f) p.f = (decltype(p.f))((__attribute__((address_space(1))) char*)kld64<__builtin_offsetof(Params, f)>(ka, tok))
    KL_(x); KL_(c); KL_(ctx); KL_(c_ctx); KL_(ada_w); KL_(ada_b); KL_(norm1_g); KL_(norm2_g); KL_(w_mix_in); KL_(w_mix_out); KL_(conv_dw); KL_(conv_dw_b); KL_(conv_ln_g); KL_(conv_ln_b); KL_(conv_pw); KL_(pool_w); KL_(pool_scale); KL_(ssm_a_re); KL_(ssm_a_im); KL_(ssm_log_dt); KL_(ssm_b_re); KL_(ssm_b_im); KL_(ssm_c_re); KL_(ssm_c_im); KL_(ssm_d); KL_(ssm_glu_w); KL_(ssm_glu_b); KL_(mla_q_a_g); KL_(mla_wq_b); KL_(mla_kv_a_g); KL_(mla_wkv_b); KL_(mla_q_g); KL_(mla_k_g); KL_(router_w); KL_(router_b); KL_(exp_w_in); KL_(exp_b_in); KL_(exp_w_out); KL_(exp_b_out); KL_(out); KL_(ws);
#undef KL_
    p.ph_lo = 0; p.ph_hi = 0;
    return p;
}

typedef __bf16 bf16v2_t __attribute__((ext_vector_type(2)));
typedef float f32v2_t __attribute__((ext_vector_type(2)));
DI unsigned pk_bf16(float lo, float hi) { const f32v2_t f = {lo, hi}; const bf16v2_t b = __builtin_convertvector(f, bf16v2_t); return __builtin_bit_cast(unsigned, b); }
DI bf16_t f2bf(float x) { return (bf16_t)(pk_bf16(x, 0.f) & 0xffffu); }
DI float bf2f(bf16_t v) { return __uint_as_float(((unsigned)v) << 16); }
DI unsigned f2fp8(float x) { x = fminf(fmaxf(x, -448.f), 448.f); return (unsigned)__builtin_amdgcn_cvt_pk_fp8_f32(x, x, 0, false) & 0xffu; }
DI unsigned pk_fp8x4(float a, float b, float c, float d) { int v = __builtin_amdgcn_cvt_pk_fp8_f32(a, b, 0, false); v = __builtin_amdgcn_cvt_pk_fp8_f32(c, d, v, true); return (unsigned)v; }
DI float bflo(unsigned u) { return __uint_as_float(u << 16); }
DI float bfhi(unsigned u) { return __uint_as_float(u & 0xffff0000u); }
DI int olane() { int l = (int)__builtin_amdgcn_mbcnt_hi(~0u, __builtin_amdgcn_mbcnt_lo(~0u, 0u)); asm volatile("" : "+v"(l)); return l; }
DI float shx(float v, int o) { const int l = olane(); return __int_as_float(__builtin_amdgcn_ds_bpermute((l ^ o) << 2, __float_as_int(v))); }
DI float shi(float v, int src) { return __int_as_float(__builtin_amdgcn_ds_bpermute(src << 2, __float_as_int(v))); }
#define otid() otid_(wv_)
DI int otid_(int wv) { int t = (wv << 6) | olane(); asm volatile("" : "+v"(t)); return t; }
DI float wave_sum(float v) {
#pragma unroll
    for (int o = 32; o > 0; o >>= 1) v += shx(v, o);
    return v;
}
DI float wave_max(float v) {
#pragma unroll
    for (int o = 32; o > 0; o >>= 1) v = fmaxf(v, shx(v, o));
    return v;
}
DI float sigmoidf_(float x) { return __builtin_amdgcn_rcpf(1.f + __builtin_amdgcn_exp2f(-1.4426950408889634f * x)); }
DI float siluf_(float x) { return x * sigmoidf_(x); }
DI float gelu_tanh(float x) {
    const float u = 0.7978845608028654f * (x + 0.044715f * x * x * x);
    return x * __builtin_amdgcn_rcpf(1.f + __builtin_amdgcn_exp2f(-2.8853900817779268f * u));
}
DI unsigned aload32(const void* p_) { unsigned r; asm volatile("global_load_dword %0, %1, off" : "=v"(r) : "v"(p_) : "memory"); return r; }
DI u32x4 aload128(const void* p_) { u32x4 r; asm volatile("global_load_dwordx4 %0, %1, off" : "=v"(r) : "v"(p_) : "memory"); return r; }
#define PV_NOHOOKS typedef int Aux; DI void top(int, Aux&, const int) const {} DI void mid(Aux&, const int) const {} template <class A_> DI void fix(A_&, bool, const int) const {}
DI void glds16(const void* src, LAS char* dst) {
    __builtin_amdgcn_global_load_lds((const __attribute__((address_space(1))) void*)src, (LAS void*)dst, 16, 0, 0);
}

#define XB_TMO      128
#define XB_XCNT(j)  (256  + 64 * (j))
#define XB_XSUB(j)  (1280 + 64 * (j))
#define XB_XGEN(j)  (2304 + 64 * (j))
#define XB_TOP      3328
#define XB_TOPGEN   3392
#define XCD_BAR_WORDS 3456
#define XB_SPIN_CAP (1u << 18)
__device__ __forceinline__ unsigned xb_ld(unsigned* p)              { return __hip_atomic_load(p, __ATOMIC_RELAXED, __HIP_MEMORY_SCOPE_AGENT); }
__device__ __forceinline__ unsigned xb_add(unsigned* p, unsigned v) { return __hip_atomic_fetch_add(p, v, __ATOMIC_RELAXED, __HIP_MEMORY_SCOPE_AGENT); }
__device__ __forceinline__ unsigned xb_xcc_id() { return (unsigned)__builtin_amdgcn_s_getreg((3 << 11) | 20) & 0xFu; }
#define XB_SPIN(cond, bar) do { unsigned _sp = 0; while (cond) { __builtin_amdgcn_s_sleep(1); \
    if ((++_sp & 255u) == 0u) { if (xb_ld(&(bar)[XB_TMO])) break; if (_sp > XB_SPIN_CAP) { atomicAdd(&(bar)[XB_TMO], 1u); break; } } } } while (0)
struct XcdBarrier { unsigned* bar; unsigned x; volatile LAS unsigned* st; };
__device__ __forceinline__ XcdBarrier xcd_barrier_post(unsigned* bar, volatile LAS unsigned* st, const int wv_) {
    XcdBarrier b; b.bar = bar; b.x = xb_xcc_id(); b.st = st;
    if (otid() == 0) (void)xb_add(&bar[XB_XCNT(b.x)], 1u);
    return b;
}
__device__ __forceinline__ void xcd_barrier_complete(unsigned* bar, unsigned x, unsigned& nloc, unsigned& nx) {
    const unsigned G = gridDim.x * gridDim.y * gridDim.z;
    unsigned sum, cnt, mine, sp = 0u;
    for (;;) {
        sum = 0u; cnt = 0u; mine = 0u;
#pragma unroll
        for (unsigned j = 0; j < 16; ++j) { const unsigned c = xb_ld(&bar[XB_XCNT(j)]); sum += c; cnt += (c > 0u) ? 1u : 0u; mine = (j == x) ? c : mine; }
        if (sum == G) break;
        __builtin_amdgcn_s_sleep(1);
        if ((++sp & 255u) == 0u) { if (xb_ld(&bar[XB_TMO])) break; if (sp > XB_SPIN_CAP) { atomicAdd(&bar[XB_TMO], 1u); break; } }
    }
    nloc = mine > 0u ? mine : 1u; nx = cnt > 0u ? cnt : 1u;
}
__device__ __forceinline__ void xcd_barrier(const XcdBarrier& b, const int wv_) {
    asm volatile("s_waitcnt vmcnt(0)" ::: "memory");
    __syncthreads();
    if (otid() == 0) {
        unsigned* bar = b.bar;
        __builtin_amdgcn_s_waitcnt(0);
        unsigned nloc = b.st[0], nx = b.st[1];
        if (nloc == 0u) { xcd_barrier_complete(bar, b.x, nloc, nx); b.st[0] = nloc; b.st[1] = nx; }
        const unsigned old = xb_add(&bar[XB_XSUB(b.x)], 1u);
        const unsigned gen = old / nloc;
        if (old + 1u == (gen + 1u) * nloc) {
            __builtin_amdgcn_fence(__ATOMIC_RELEASE, "agent");
            asm volatile("s_waitcnt vmcnt(0)" ::: "memory");
            const unsigned og = xb_add(&bar[XB_TOP], 1u);
            const unsigned tg = og / nx;
            if (og + 1u == (tg + 1u) * nx) xb_add(&bar[XB_TOPGEN], 1u);
            else XB_SPIN(xb_ld(&bar[XB_TOPGEN]) == tg, bar);
            __builtin_amdgcn_fence(__ATOMIC_ACQUIRE, "agent");
            xb_add(&bar[XB_XGEN(b.x)], 1u);
            asm volatile("s_waitcnt vmcnt(0)" ::: "memory");
        } else {
            XB_SPIN(xb_ld(&bar[XB_XGEN(b.x)]) == gen, bar);
            __builtin_amdgcn_fence(__ATOMIC_ACQUIRE, "agent");
            asm volatile("s_waitcnt vmcnt(0)" ::: "memory");
        }
    }
    __syncthreads();
}

constexpr int HTB = 128 * 64 * 2;
DI int lds_byte(int r, int c) { const int st = (r >> 4) * 2 + (c >> 5), rr = r & 15, cc = c & 31, ob = rr * 64 + cc * 2; return st * 1024 + (ob ^ (((ob >> 9) & 1) << 5)); }
DI void stage_rc(int b, int& R, int& C) { const int st = b / 1024, sb = b % 1024, swz = sb ^ (((sb >> 9) & 1) << 5); R = (st >> 1) * 16 + swz / 64; C = (st & 1) * 32 + (swz % 64) / 2; }

DI void stage_rc_t(int tz, int i, int& R, int& C) { stage_rc(tz * 16 + i * 8192, R, C); }
struct APlain {
    const char* base; int lda2;
    DI void park(LAS unsigned*) const {} DI void unpark(const LAS unsigned*) {} DI void take_uniform(const APlain&) {}
    DI const char* ptr(int tz, int h, int i, int kt) const { int R, C; stage_rc_t(tz, i, R, C); return base + (unsigned)((h * 128 + R) * lda2 + C * 2 + kt * 128); }
};
struct ASimple {
    const char* base; unsigned off[2][2]; unsigned kstride;
    DI void park(LAS unsigned* q) const { *(LAS u32x4*)q = (u32x4){off[0][0], off[0][1], off[1][0], off[1][1]}; }
    DI void unpark(const LAS unsigned* q) { const u32x4 v = *(const LAS u32x4*)q; off[0][0] = v.x; off[0][1] = v.y; off[1][0] = v.z; off[1][1] = v.w; }
    DI void take_uniform(const ASimple& o) { base = o.base; kstride = o.kstride; }
    DI const char* ptr(int tz, int h, int i, int kt) const { return base + (unsigned)(off[h][i] + (unsigned)kt * kstride); }
};
struct ASeg2 {
    const char* base0; const char* base1; unsigned off0[2][2]; unsigned off1[2][2]; unsigned ks0; int nt0;
    DI void park(LAS unsigned*) const {} DI void unpark(const LAS unsigned*) {} DI void take_uniform(const ASeg2&) {}
    DI const char* ptr(int tz, int h, int i, int kt) const { return kt < nt0 ? base0 + (unsigned)(off0[h][i] + (unsigned)kt * ks0) : base1 + (unsigned)(off1[h][i] + (unsigned)(kt - nt0) * 128u); }
};
DI int perm32(int rho) { const int n = rho >> 4, i = rho & 15; return 8 * (i >> 2) + 4 * n + (i & 3); }
struct BSimple {
    const char* base[2]; int ldb2;
    DI const char* ptr(int tz, int h, int i, int kt) const { int R, C; stage_rc_t(tz, i, R, C); const int Rb = (R & ~31) + perm32(R & 31); return base[h] + (unsigned)(Rb * ldb2 + C * 2 + kt * 128); }
};

struct BSeq16 {
    const char* base; int ldb2;
    DI const char* ptr(int tz, int h, int i, int kt) const { int R, C; stage_rc_t(tz, i, R, C); const int rho = R & 31;
        const int Rb = (R >> 5) * 64 + ((rho & 15) >> 2) * 16 + h * 8 + (rho >> 4) * 4 + (rho & 3); return base + (unsigned)(Rb * ldb2 + C * 2 + kt * 128); }
};

#define WAIT_V(n) asm volatile("s_waitcnt vmcnt(" #n ")" ::: "memory")
#define WAIT_L(n) asm volatile("s_waitcnt lgkmcnt(" #n ")" ::: "memory")
#define BAR_ __builtin_amdgcn_s_barrier()
#define SCHED_ __builtin_amdgcn_sched_barrier(0)

DI void zero_acc(f32x4 (&acc)[2][2][4][2]) {
#pragma unroll
    for (int a = 0; a < 2; ++a)
#pragma unroll
        for (int b = 0; b < 2; ++b)
#pragma unroll
            for (int m = 0; m < 4; ++m)
#pragma unroll
                for (int n = 0; n < 2; ++n) acc[a][b][m][n] = (f32x4){0.f, 0.f, 0.f, 0.f};
}
template <int MODE> struct FragT;
template <> struct FragT<0> {
    i32x4 lo, hi;
    DI void load(const LAS char* p0, const LAS char* p1) { lo = *(const LAS i32x4*)p0; hi = *(const LAS i32x4*)p1; }
    static DI f32x4 mma(const FragT& b, const FragT& a, f32x4 c) {
        c = __builtin_amdgcn_mfma_f32_16x16x32_bf16(__builtin_bit_cast(bf16x8, b.lo), __builtin_bit_cast(bf16x8, a.lo), c, 0, 0, 0);
        return __builtin_amdgcn_mfma_f32_16x16x32_bf16(__builtin_bit_cast(bf16x8, b.hi), __builtin_bit_cast(bf16x8, a.hi), c, 0, 0, 0); }
};
template <> struct FragT<1> {
    i32x4 lo, hi;
    DI void load(const LAS char* p0, const LAS char* p1) { lo = *(const LAS i32x4*)p0; hi = *(const LAS i32x4*)p1; }
    static DI long pk(int x, int y) { return (long)(((unsigned long long)(unsigned)y << 32) | (unsigned)x); }
    static DI f32x4 mma(const FragT& b, const FragT& a, f32x4 c) {
        c = __builtin_amdgcn_mfma_f32_16x16x32_fp8_fp8(pk(b.lo.x, b.lo.y), pk(a.lo.x, a.lo.y), c, 0, 0, 0);
        c = __builtin_amdgcn_mfma_f32_16x16x32_fp8_fp8(pk(b.lo.z, b.lo.w), pk(a.lo.z, a.lo.w), c, 0, 0, 0);
        c = __builtin_amdgcn_mfma_f32_16x16x32_fp8_fp8(pk(b.hi.x, b.hi.y), pk(a.hi.x, a.hi.y), c, 0, 0, 0);
        return __builtin_amdgcn_mfma_f32_16x16x32_fp8_fp8(pk(b.hi.z, b.hi.w), pk(a.hi.z, a.hi.w), c, 0, 0, 0); }
};
template <> struct FragT<2> {
    i32x8 v;
    DI void load(const LAS char* p0, const LAS char* p1) { const i32x4 lo = *(const LAS i32x4*)p0, hi = *(const LAS i32x4*)p1; v = __builtin_shufflevector(lo, hi, 0, 1, 2, 3, 4, 5, 6, 7); }
    static DI f32x4 mma(const FragT& b, const FragT& a, f32x4 c) {
        const int one = 0x7f7f7f7f;
        asm volatile("v_mfma_scale_f32_16x16x128_f8f6f4 %0, %1, %2, %0, %3, %3 op_sel_hi:[0,0,0]" : "+v"(c) : "v"(b.v), "v"(a.v), "v"(one));
        return c; }
};
template <class PV>
DI void gemm_stream(LAS char* shm, const PV& pv, const int wv_) {
    typedef typename PV::AS AS; typedef typename PV::BS BS;
    constexpr int nt = PV::NT;
    int u = pv.first();
    if (u < 0) return;
    const int tz = otid();
    const int wr = wv_ >> 2, wc = wv_ & 3, lane = tz & 63, fr = lane & 15, fq = lane >> 4;
    const int aoff = lds_byte(wr * 64 + fr, fq * 8), boff = lds_byte(wc * 32 + fr, fq * 8);
    const unsigned ldsw = (unsigned)wv_ * 1024u;
    f32x4 acc[2][2][4][2]; zero_acc(acc);
    typedef FragT<PV::FP8> Frag;
    Frag At[4], B0[2], B1[2];
    AS ca, na; BS cb, nb;
    pv.src(u, ca, cb, wv_); pv.fix(ca, true, wv_);
    constexpr bool F8 = PV::FP8 != 0;
    LAS unsigned* park = (LAS unsigned*)(shm + 131072) + tz * 4;
    const int aoff0 = aoff, aoff1 = aoff + 1024;
    const int boff0 = boff, boff1 = boff + 1024;
#define SA_(b, h) (((b) * 2 + (h)) * HTB)
#define SB_(b, h) ((4 + (b) * 2 + (h)) * HTB)
#define STG_(bufoff, S, h, kt) do { _Pragma("unroll") for (int i_ = 0; i_ < 2; ++i_) glds16((S).ptr(tz, h, i_, kt), shm + (bufoff) + ldsw + i_ * 8192); } while (0)
#define LDA_(dst, b, h) do { _Pragma("unroll") for (int m = 0; m < 4; ++m) dst[m].load(shm + SA_(b, h) + aoff0 + m * 2048, shm + SA_(b, h) + aoff1 + m * 2048); } while (0)
#define LDB_(dst, b, h) do { _Pragma("unroll") for (int n = 0; n < 2; ++n) dst[n].load(shm + SB_(b, h) + boff0 + n * 2048, shm + SB_(b, h) + boff1 + n * 2048); } while (0)
#define MMA2_(ai, A_, BA_, BB_) do { __builtin_amdgcn_s_setprio(1); \
        _Pragma("unroll") for (int m = 0; m < 4; ++m) _Pragma("unroll") for (int n = 0; n < 2; ++n) acc[ai][0][m][n] = Frag::mma(BA_[n], A_[m], acc[ai][0][m][n]); \
        _Pragma("unroll") for (int m = 0; m < 4; ++m) _Pragma("unroll") for (int n = 0; n < 2; ++n) acc[ai][1][m][n] = Frag::mma(BB_[n], A_[m], acc[ai][1][m][n]); \
        __builtin_amdgcn_s_setprio(0); } while (0)
#define CMEM_ asm volatile("" ::: "memory")
    STG_(SB_(0, 0), cb, 0, 0); STG_(SB_(0, 1), cb, 1, 0); STG_(SA_(0, 0), ca, 0, 0); STG_(SA_(0, 1), ca, 1, 0);
    WAIT_V(0);
    if (wr == 1) BAR_;
    BAR_; CMEM_;
#define ZQ_(ai, bj) do { _Pragma("unroll") for (int m_ = 0; m_ < 4; ++m_) _Pragma("unroll") for (int n_ = 0; n_ < 2; ++n_) acc[ai][bj][m_][n_] = (f32x4){0.f, 0.f, 0.f, 0.f}; } while (0)
    int un = -1; bool has_next = false;
    na = ca; nb = cb;
    for (;;) {
        typename PV::Aux aux;
#pragma clang loop unroll(disable)
        for (int t = 0; t < nt; t += 2) {
            const bool last = (t == nt - 2);
            if (last && has_next) pv.fix(na, false, wv_);
            AS a2 = last ? na : ca; const BS b2 = last ? nb : cb; const int k2 = last ? 0 : t + 2;
            STG_(SB_(1, 0), cb, 0, t + 1); STG_(SB_(1, 1), cb, 1, t + 1); STG_(SA_(1, 0), ca, 0, t + 1); SCHED_;
            LDB_(B0, 0, 0); LDB_(B1, 0, 1); SCHED_; LDA_(At, 0, 0); SCHED_;
            if (t == 0) { ZQ_(0, 0); ZQ_(0, 1); }
            WAIT_V(6); BAR_; WAIT_L(0); MMA2_(0, At, B0, B1); BAR_; SCHED_; CMEM_;
            if (t == 0) pv.top(u, aux, wv_);
            STG_(SA_(1, 1), ca, 1, t + 1); SCHED_;
            LDA_(At, 0, 1); SCHED_;
            if (t == 0) { ZQ_(1, 0); ZQ_(1, 1); }
            WAIT_V(2); BAR_; WAIT_L(0); if (t == 0) pv.mid(aux, wv_); MMA2_(1, At, B0, B1); BAR_; SCHED_; CMEM_;
            STG_(SB_(0, 0), b2, 0, k2); STG_(SB_(0, 1), b2, 1, k2); STG_(SA_(0, 0), a2, 0, k2); SCHED_;
            LDB_(B0, 1, 0); LDB_(B1, 1, 1); SCHED_; LDA_(At, 1, 0); SCHED_;
            WAIT_V(6); BAR_; WAIT_L(0); MMA2_(0, At, B0, B1); BAR_; SCHED_; CMEM_;
            STG_(SA_(0, 1), a2, 1, k2); SCHED_;
            LDA_(At, 1, 1); SCHED_;
            WAIT_V(2);
            if (t == 0) { un = pv.next(u); has_next = un >= 0; if (has_next) pv.src(un, na, nb, wv_); else { na = ca; nb = cb; } }
            BAR_; WAIT_L(0); MMA2_(1, At, B0, B1); BAR_; SCHED_; CMEM_;
        }
        if (PV::FP8 == 2) asm volatile("s_nop 15\n\ts_nop 15" ::: "memory");
        pv.epi(acc, u, wv_);
        if (!has_next) break;
        u = un; ca = na; cb = nb;
    }
#undef ZQ_
    WAIT_V(0);
    if (wr == 0) BAR_;
    BAR_;
#undef SA_
#undef SB_
#undef STG_
#undef LDA_
#undef LDB_
#undef MMA2_
#undef CMEM_
}
DI int lin_first(int shift, int count) { const int G = gridDim.x; const int u = (int)((blockIdx.x + G - (shift % G)) % G); return u < count ? u : -1; }
DI int lin_next(int u, int count) { const int un = u + (int)gridDim.x; return un < count ? un : -1; }
template <int MG, int NTL> struct XcdDeal {
    int MT;
    DI bool decode(int J, int& mt, int& nt) const { const int x = blockIdx.x & 7; const int grp = (J / (MG * NTL)) * 8 + x, w = J % (MG * NTL); mt = grp * MG + w / NTL; nt = w % NTL; return mt < MT; }
    DI int jmax() const { return ((MT + 8 * MG - 1) / (8 * MG)) * (MG * NTL); }
    DI int first() const { int J = blockIdx.x >> 3; const int per = gridDim.x >> 3, jm = jmax(); int mt, nt;
        while (J < jm && !decode(J, mt, nt)) J += per;
        return J < jm ? J : -1; }
    DI int next(int J) const { const int per = gridDim.x >> 3, jm = jmax(); int mt, nt; J += per;
        while (J < jm && !decode(J, mt, nt)) J += per;
        return J < jm ? J : -1; }
};
DI int first_unit(int shift) { const int G = gridDim.x; return (int)((blockIdx.x + G - (shift % G)) % G); }

DI void stage_coords(int (&R)[2], int (&C)[2], const int wv_) {
    const int t_ = otid();
#pragma unroll
    for (int i = 0; i < 2; ++i) stage_rc(t_ * 16 + i * 8192, R[i], C[i]);
}
DI APlain make_a_plain(const bf16_t* A, size_t row0, int lda, int col0) {
    APlain a; a.base = (const char*)(A + row0 * (size_t)lda + col0); a.lda2 = lda * 2; return a;
}
DI BSimple make_b(const bf16_t* Bt0, const bf16_t* Bt1, int ldb) {
    BSimple b; b.base[0] = (const char*)Bt0; b.base[1] = (const char*)Bt1; b.ldb2 = ldb * 2; return b;
}
#define EPI_FOR(acc, ...) do { const int _tz = otid(), _w = _tz >> 6, _l = _tz & 63, _wr = _w >> 2, _wc = _w & 3, _fr = _l & 15, _fq = _l >> 4; \
    _Pragma("unroll") for (int ai = 0; ai < 2; ++ai) _Pragma("unroll") for (int m = 0; m < 4; ++m) { const int lr = ai * 128 + _wr * 64 + m * 16 + _fr; \
    _Pragma("unroll") for (int bj = 0; bj < 2; ++bj) _Pragma("unroll") for (int n = 0; n < 2; ++n) { const int lc = bj * 128 + _wc * 32 + n * 16 + _fq * 4; const f32x4 v = acc[ai][bj][m][n]; __VA_ARGS__ } } } while (0)

DI void store_bf16x4(bf16_t* p, float a, float b, float c, float d) { u32x2 v; v.x = pk_bf16(a, b); v.y = pk_bf16(c, d); *(u32x2*)p = v; }
DI void store_bf16x8(bf16_t* p, const f32x4 a, const f32x4 b) { u32x4 v; v.x = pk_bf16(a[0], a[1]); v.y = pk_bf16(a[2], a[3]); v.z = pk_bf16(b[0], b[1]); v.w = pk_bf16(b[2], b[3]); *(u32x4*)p = v; }
#define EPI_FOR8(acc, ...) do { const int _tz = otid(), _w = _tz >> 6, _l = _tz & 63, _wr = _w >> 2, _wc = _w & 3, _fr = _l & 15, _fq = _l >> 4; \
    _Pragma("unroll") for (int ai = 0; ai < 2; ++ai) _Pragma("unroll") for (int m = 0; m < 4; ++m) { const int lr = ai * 128 + _wr * 64 + m * 16 + _fr; \
    _Pragma("unroll") for (int bj = 0; bj < 2; ++bj) { const int lc = bj * 128 + _wc * 32 + _fq * 8; const f32x4 v0 = acc[ai][bj][m][0], v1 = acc[ai][bj][m][1]; __VA_ARGS__ } } } while (0)

DI int mod_row(int r) { return r < TX ? (r >> 11) : 32; }
DI int crow_tok(int cr) { const int b = cr / NCH, j = cr - b * NCH; return j < 4 ? TX + b * CTXL + j * 64 : b * SEQ + (j - 4) * 64; }

DI void cvt_tile(LAS char* wl  , const float* src, int ld_src, int kvalid, int nvalid, const float* scale, bf16_t* dst, int ld_dst, const int wv_) {
    const int lane = otid() & 63;
    const int lr = lane >> 4, lc = (lane & 15) * 4;
    f32x4 v[16];
#pragma unroll
    for (int it = 0; it < 16; ++it) {
        const int k = it * 4 + lr;
        v[it] = (f32x4){0.f, 0.f, 0.f, 0.f};
        if (src != nullptr && k < kvalid && lc < nvalid) { v[it] = *(const f32x4*)(src + (size_t)k * ld_src + lc); if (scale) { const float s = scale[k]; v[it] *= s; } }
    }
#pragma unroll
    for (int it = 0; it < 16; ++it) {
        const int k = it * 4 + lr;
#pragma unroll
        for (int j = 0; j < 4; ++j) *(LAS bf16_t*)(wl + (lc + j) * 144 + k * 2) = f2bf(v[it][j]);
    }
    asm volatile("s_waitcnt lgkmcnt(0)" ::: "memory");
#pragma unroll
    for (int i = 0; i < 8; ++i) {
        const int q = i * 64 + lane, n = q >> 3, c = q & 7;
        const u32x4 w = *(const LAS u32x4*)(wl + n * 144 + c * 16);
        *(u32x4*)(dst + (size_t)n * ld_dst + c * 8) = w;
    }
    asm volatile("s_waitcnt lgkmcnt(0)" ::: "memory");
}
constexpr float SWI_A = 2.4554669595930156f;
DI void cvt_tile8(LAS char* wl  , const float* src, int ld_src, unsigned char* dst, int ld_dst, const float wscale, const int wv_) {
    const int lane = otid() & 63;
    const int lr = lane >> 4, lc = (lane & 15) * 4;
    f32x4 v[16];
#pragma unroll
    for (int it = 0; it < 16; ++it) v[it] = *(const f32x4*)(src + (size_t)(it * 4 + lr) * ld_src + lc);
#pragma unroll
    for (int it = 0; it < 16; ++it) {
        const int k = it * 4 + lr;
#pragma unroll
        for (int j = 0; j < 4; ++j) *(LAS unsigned char*)(wl + (lc + j) * 80 + k) = (unsigned char)f2fp8(v[it][j] * wscale);
    }
    asm volatile("s_waitcnt lgkmcnt(0)" ::: "memory");
#pragma unroll
    for (int i = 0; i < 4; ++i) {
        const int q = i * 64 + lane, n = q >> 2, c = q & 3;
        const u32x4 w = *(const LAS u32x4*)(wl + n * 80 + c * 16);
        *(u32x4*)(dst + (size_t)n * ld_dst + c * 16) = w;
    }
    asm volatile("s_waitcnt lgkmcnt(0)" ::: "memory");
}
constexpr int CVT_SMALL_TILES = 768 + 512 + 32 + 32 + 64 + 64 + 32;
constexpr int CVT_EXP_TILES = 32 * (32 * 16 + 16 * 16);
DI void cvt_small(const Params& p, LAS char* wl, int t, const int wv_) {
    char* ws = p.ws;
    if (t < 768) { const int l = t / 384, r = t % 384, nt = r / 16, kt = r % 16;
        cvt_tile(wl, p.w_mix_in + (size_t)l * 1024 * N_IN + (size_t)kt * 64 * N_IN + nt * 64, N_IN, 64, N_IN - nt * 64, nullptr,
                 (bf16_t*)(ws + WS_WMI) + ((size_t)l * 1536 + nt * 64) * 1024 + kt * 64, 1024, wv_); return; }
    t -= 768;
    if (t < 512) { const int l = t / 256, r = t % 256, nt = r / 16, kt = r % 16;
        cvt_tile(wl, p.w_mix_out + (size_t)l * 1024 * 1024 + (size_t)kt * 64 * 1024 + nt * 64, 1024, 64, 64, nullptr,
                 (bf16_t*)(ws + WS_WMO) + ((size_t)l * 1024 + nt * 64) * 1024 + kt * 64, 1024, wv_); return; }
    t -= 512;
    if (t < 32) { const int l = t / 16, r = t % 16, nt = r / 4, kt = r % 4;
        cvt_tile(wl, p.conv_pw + (size_t)l * 65536 + (size_t)kt * 64 * 256 + nt * 64, 256, 64, 64, nullptr,
                 (bf16_t*)(ws + WS_WPW) + ((size_t)l * 256 + nt * 64) * 256 + kt * 64, 256, wv_); return; }
    t -= 32;
    if (t < 32) { const int l = t / 16, r = t % 16, nt = r / 4, kt = r % 4;
        cvt_tile(wl, p.ssm_glu_w + (size_t)l * 65536 + (size_t)kt * 64 * 256 + nt * 64, 256, 64, 64, nullptr,
                 (bf16_t*)(ws + WS_WGLU) + ((size_t)l * 256 + nt * 64) * 256 + kt * 64, 256, wv_); return; }
    t -= 32;
    if (t < 64) { const int l = t / 32, r = t % 32, nt = r / 4, kt = r % 4;
        const bool any = (kt < 3) && (nt < 6);
        cvt_tile(wl, any ? p.mla_wq_b + (size_t)l * 192 * 384 + (size_t)kt * 64 * 384 + nt * 64 : nullptr, 384, 64, 64, p.mla_q_a_g + l * 192 + kt * 64,
                 (bf16_t*)(ws + WS_WQ) + ((size_t)l * 512 + nt * 64) * 256 + kt * 64, 256, wv_); return; }
    t -= 64;
    if (t < 64) { const int l = t / 32, r = t % 32, nt = r / 4, kt = r % 4;
        const bool any = (kt < 2);
        cvt_tile(wl, any ? p.mla_wkv_b + (size_t)l * 128 * 512 + (size_t)kt * 64 * 512 + nt * 64 : nullptr, 512, 64, 64, p.mla_kv_a_g + l * 128 + kt * 64,
                 (bf16_t*)(ws + WS_WKV) + ((size_t)l * 512 + nt * 64) * 256 + kt * 64, 256, wv_); return; }
    t -= 64;
    { const int l = t / 16, r = t % 16, nt = r / 4, kt = r % 4;
        cvt_tile(wl, nt == kt ? p.pool_w + ((size_t)l * 4 + nt) * 4096 : nullptr, 64, 64, 64, nullptr,
                 (bf16_t*)(ws + WS_WPOOL) + ((size_t)l * 256 + nt * 64) * 256 + kt * 64, 256, wv_); }
}
DI void cvt_expert(const Params& p, LAS char* wl, int l, int t, const int wv_) {
    char* ws = p.ws;
    const int e = t / 768, r = t % 768;
    if (r < 512) { const int nt = r / 16, kt = r % 16;
        cvt_tile8(wl, p.exp_w_in + ((size_t)(l * NE + e) * 1024 + kt * 64) * 2048 + nt * 64, 2048,
                  (unsigned char*)(ws + WS_W1) + ((size_t)(l * NE + e) * 2048 + nt * 64) * 1024 + kt * 64, 1024, nt < 16 ? 256.f * SWI_A : 256.f / SWI_A, wv_);
    } else { const int q = r - 512, nt = q / 16, kt = q % 16;
        cvt_tile8(wl, p.exp_w_out + ((size_t)(l * NE + e) * 1024 + kt * 64) * 1024 + nt * 64, 1024,
                  (unsigned char*)(ws + WS_W2) + ((size_t)(l * NE + e) * 1024 + nt * 64) * 1024 + kt * 64, 1024, 256.f, wv_);
    }
}

DI void ada_unit(const Params& p, LAS char* shm, int u, const int wv_) {
    const int tid = otid();
    const int l = u / 48, jc = u % 48;
    LAS float* sc = (LAS float*)shm;
    for (int i = tid; i < 33 * 1024; i += 512) { const int r = i >> 10, k = i & 1023; const float v = r < 32 ? p.c[r * 1024 + k] : p.c_ctx[k]; sc[i] = siluf_(v); }
    __syncthreads();
    const int col = tid & 127, kq = tid >> 7;
    float acc[33];
#pragma unroll
    for (int r = 0; r < 33; ++r) acc[r] = 0.f;
    const float* wp = p.ada_w + ((size_t)l * 1024 + kq * 256) * 6144 + jc * 128 + col;
    for (int k4 = 0; k4 < 256; k4 += 4) {
        float w[4];
#pragma unroll
        for (int i = 0; i < 4; ++i) w[i] = wp[(size_t)(k4 + i) * 6144];
#pragma unroll
        for (int r = 0; r < 33; ++r) { const f32x4 s = *(const LAS f32x4*)(sc + r * 1024 + kq * 256 + k4); acc[r] += s[0] * w[0] + s[1] * w[1] + s[2] * w[2] + s[3] * w[3]; }
    }
    __syncthreads();
    LAS float* red = (LAS float*)shm;
#pragma unroll
    for (int r = 0; r < 33; ++r) red[(kq * 33 + r) * 128 + col] = acc[r];
    __syncthreads();
    for (int i = tid; i < 33 * 128; i += 512) { const int r = i >> 7, cc = i & 127;
        const float s = red[(0 * 33 + r) * 128 + cc] + red[(1 * 33 + r) * 128 + cc] + red[(2 * 33 + r) * 128 + cc] + red[(3 * 33 + r) * 128 + cc];
        ((float*)(p.ws + WS_MOD))[((size_t)l * 33 + r) * 6144 + jc * 128 + cc] = s + p.ada_b[l * 6144 + jc * 128 + cc]; }
    __syncthreads();
}

DI void s5_load_bc(const Params& p, LAS float* bb, LAS float* cc, int l, int dir, int g, int tid) {
    const int pbase = ((l * 2 + dir) * 16 + g) * 64;
    const double dt = exp((double)p.ssm_log_dt[(l * 2 + dir) * 16 + g]);
    for (int i = tid; i < 64 * 16; i += 512) { const int q = i >> 4, ci = i & 15;
        const double are = fmin((double)p.ssm_a_re[pbase + q], -1e-4), aim = (double)p.ssm_a_im[pbase + q];
        const double mg = exp(are * dt), abr = mg * cos(aim * dt), abi = mg * sin(aim * dt), den = are * are + aim * aim;
        const double fre = ((abr - 1.0) * are + abi * aim) / den, fim = (abi * are - (abr - 1.0) * aim) / den;
        const double br = (double)p.ssm_b_re[(size_t)(pbase + q) * 16 + ci], bi = (double)p.ssm_b_im[(size_t)(pbase + q) * 16 + ci];
        bb[i * 2] = (float)(fre * br - fim * bi); bb[i * 2 + 1] = (float)(fre * bi + fim * br); }
    for (int i = tid; i < 16 * 64; i += 512) { const int co = i >> 6, q = i & 63;
        const size_t ix = ((size_t)((l * 2 + dir) * 16 + g) * 16 + co) * 64 + q;
        cc[i * 2] = p.ssm_c_re[ix]; cc[i * 2 + 1] = p.ssm_c_im[ix]; }
}
DI void s5pre_unit(const Params& p, LAS char* shm, int u, const int wv_) {
    const int tid = otid();
    const int l = u >> 5, g = (u >> 1) & 15, dir = u & 1;
    LAS float* pw = (LAS float*)shm;
    LAS float* bb = pw + 65 * 64 * 2;
    LAS float* cc = bb + 64 * 16 * 2;
    LAS float* kk = cc + 16 * 64 * 2;
    LAS float* k0o = kk + 64 * 256;
    bf16_t* TS = (bf16_t*)(p.ws + WS_TS5) + (size_t)(l * 16 + g) * 1024 * 1280;
    bf16_t* WS = (bf16_t*)(p.ws + WS_WS5) + (size_t)(l * 16 + g) * 256 * 1024;
    const int cocip = tid & 255, co_ = cocip >> 4, ci_ = cocip & 15;
    if (dir == 0) {
        s5_load_bc(p, bb, cc, l, 1, g, tid);
        __syncthreads();
        if (tid < 256) { float s_ = 0.f;
            for (int q = 0; q < 64; ++q) s_ += cc[(co_ * 64 + q) * 2] * bb[(q * 16 + ci_) * 2] - cc[(co_ * 64 + q) * 2 + 1] * bb[(q * 16 + ci_) * 2 + 1];
            k0o[tid] = s_; }
        __syncthreads();
    }
    {
        const int pbase = ((l * 2 + dir) * 16 + g) * 64;
        const double dt = exp((double)p.ssm_log_dt[(l * 2 + dir) * 16 + g]);
        for (int i = tid; i < 65 * 64; i += 512) { const int tau = i >> 6, q = i & 63;
            const double are = fmin((double)p.ssm_a_re[pbase + q], -1e-4), aim = (double)p.ssm_a_im[pbase + q];
            const double mg = exp(are * dt * tau), an = aim * dt * tau;
            pw[i * 2] = (float)(mg * cos(an)); pw[i * 2 + 1] = (float)(mg * sin(an)); }
        s5_load_bc(p, bb, cc, l, dir, g, tid);
        __syncthreads();
        if (tid < 64) { float* a64 = (float*)(p.ws + WS_A64) + (size_t)(((l * 2 + dir) * 16 + g) * 64 + tid) * 2; a64[0] = pw[(64 * 64 + tid) * 2]; a64[1] = pw[(64 * 64 + tid) * 2 + 1]; }
        { float gr[64], gi[64];
#pragma unroll
          for (int q = 0; q < 64; ++q) { const float cr = cc[(co_ * 64 + q) * 2], cim = cc[(co_ * 64 + q) * 2 + 1], br = bb[(q * 16 + ci_) * 2], bi = bb[(q * 16 + ci_) * 2 + 1];
              gr[q] = cr * br - cim * bi; gi[q] = cr * bi + cim * br; }
          for (int tau = (tid >> 8); tau < 64; tau += 2) {
              float s_ = 0.f;
#pragma unroll
              for (int q = 0; q < 64; ++q) s_ += gr[q] * pw[(tau * 64 + q) * 2] - gi[q] * pw[(tau * 64 + q) * 2 + 1];
              kk[tau * 256 + cocip] = s_;
          } }
        for (int i = tid; i < 128 * 512; i += 512) { const int row = i >> 9, kp = (i & 511) * 2, ri = row >> 6, q = row & 63, s_ = kp >> 4, ci = kp & 15;
            const int e = dir == 0 ? 63 - s_ : s_;
            const float pr = pw[(e * 64 + q) * 2], pi = pw[(e * 64 + q) * 2 + 1];
            float o[2];
#pragma unroll
            for (int j = 0; j < 2; ++j) { const float br = bb[(q * 16 + ci + j) * 2], bi = bb[(q * 16 + ci + j) * 2 + 1]; o[j] = ri == 0 ? pr * br - pi * bi : pr * bi + pi * br; }
            *(unsigned*)(WS + (size_t)(dir * 128 + row) * 1024 + kp) = pk_bf16(o[0], o[1]); }
        for (int i = tid; i < 1024 * 64; i += 512) { const int row = i >> 6, kp = (i & 63) * 2, t = row >> 4, co = row & 15, ri = kp >> 6, q = kp & 63;
            const int e = dir == 0 ? t + 1 : 64 - t;
            float o[2];
#pragma unroll
            for (int j = 0; j < 2; ++j) { const float pr = pw[(e * 64 + q + j) * 2], pi = pw[(e * 64 + q + j) * 2 + 1];
                const float cr = cc[(co * 64 + q + j) * 2], cim = cc[(co * 64 + q + j) * 2 + 1];
                o[j] = ri == 0 ? (cr * pr - cim * pi) : -(cr * pi + cim * pr); }
            *(unsigned*)(TS + (size_t)row * 1280 + 1024 + dir * 128 + kp) = pk_bf16(o[0], o[1]); }
        __syncthreads();
        for (int rr = tid; rr < 1024; rr += 512) { const int t = rr >> 4, co = rr & 15;
            const float dco = p.ssm_d[l * 256 + g * 16 + co];
            bf16_t* rowp = TS + (size_t)rr * 1280;
            const int s_lo = dir == 0 ? 0 : t + 1, s_hi = dir == 0 ? t : 63;
            for (int s_ = s_lo; s_ <= s_hi; ++s_) { const int tau = dir == 0 ? t - s_ : s_ - t;
                unsigned w[8];
#pragma unroll
                for (int j = 0; j < 8; ++j) { float a = kk[tau * 256 + co * 16 + 2 * j], b2 = kk[tau * 256 + co * 16 + 2 * j + 1];
                    if (s_ == t) { a += k0o[co * 16 + 2 * j]; b2 += k0o[co * 16 + 2 * j + 1]; if (2 * j == co) a += dco; if (2 * j + 1 == co) b2 += dco; }
                    w[j] = pk_bf16(a, b2); }
                *(u32x4*)(rowp + s_ * 16) = (u32x4){w[0], w[1], w[2], w[3]}; *(u32x4*)(rowp + s_ * 16 + 8) = (u32x4){w[4], w[5], w[6], w[7]}; }
        }
        __syncthreads();
    }
}

DI void phase_prologue(const Params& p, LAS char* shm, const int wv_) {
    const int tid = otid();
    __syncthreads();
    if (blockIdx.x == 0 && tid < 64) ((int*)(p.ws + WS_CNT))[tid] = 0;
    const int n_cvt = (CVT_SMALL_TILES + 2 * CVT_EXP_TILES + 7) / 8;
    for (int u = blockIdx.x; u < 160; u += gridDim.x) {
        if (u < 64) s5pre_unit(p, shm, u, wv_);
        else ada_unit(p, shm, u - 64, wv_);
    }
    int* wq = (int*)(p.ws + WS_CNT) + 192;
    volatile LAS int* slot = (volatile LAS int*)(shm + LDS_MISC + 32);
    __syncthreads();
    if (tid == 0) slot[0] = atomicAdd(wq, 1);
    __syncthreads();
    int cu = slot[0], par = 0;
    while (cu < n_cvt) {
        int nxt = 0;
        if (tid == 0) nxt = atomicAdd(wq, 1);
        const int t = cu * 8 + wv_;
        LAS char* wl = shm + wv_ * (64 * 144);
        if (t < CVT_SMALL_TILES) cvt_small(p, wl, t, wv_);
        else if (t < CVT_SMALL_TILES + 2 * CVT_EXP_TILES) { const int te = t - CVT_SMALL_TILES; cvt_expert(p, wl, te / CVT_EXP_TILES, te % CVT_EXP_TILES, wv_); }
        par ^= 1;
        if (tid == 0) slot[par] = nxt;
        __syncthreads();
        cu = slot[par];
    }
}

DI void norm_mod_store(const float (&v)[16], const float* g, const float* modrow  , bf16_t* hrow, const int wv_) {
    const int lane = otid() & 63;
    float ss = 0.f;
#pragma unroll
    for (int i = 0; i < 16; ++i) ss += v[i] * v[i];
    ss = wave_sum(ss);
    const float rn = rsqrtf(ss * (1.f / 1024.f) + EPS);
#pragma unroll
    for (int jj = 0; jj < 2; ++jj) {
        const int col = jj * 512 + lane * 8;
        f32x4 o[2];
#pragma unroll
        for (int h = 0; h < 2; ++h) {
            const f32x4 gg = *(const f32x4*)(g + col + h * 4), sh = *(const f32x4*)(modrow + col + h * 4), sc = *(const f32x4*)(modrow + 1024 + col + h * 4);
#pragma unroll
            for (int i = 0; i < 4; ++i) o[h][i] = v[jj * 8 + h * 4 + i] * rn * gg[i] * (1.f + sc[i]) + sh[i];
        }
        store_bf16x8(hrow + col, o[0], o[1]);
    }
}
DI void phase_norm1_l0(const Params& p, const int wv_) {
    const int tid_ = otid(); const int wid = tid_ >> 6, lane = tid_ & 63;
    const float* MOD = (const float*)(p.ws + WS_MOD);
    bf16_t* H = (bf16_t*)(p.ws + WS_H);
    for (int r = blockIdx.x * 8 + wid; r < TT; r += gridDim.x * 8) {
        const float* src = r < TX ? p.x + (size_t)r * 1024 : p.ctx + (size_t)(r - TX) * 1024;
        float v[16];
#pragma unroll
        for (int jj = 0; jj < 2; ++jj)
#pragma unroll
            for (int h = 0; h < 2; ++h) { const f32x4 t = __builtin_nontemporal_load((const f32x4*)(src + jj * 512 + lane * 8 + h * 4));
                v[jj * 8 + h * 4] = t[0]; v[jj * 8 + h * 4 + 1] = t[1]; v[jj * 8 + h * 4 + 2] = t[2]; v[jj * 8 + h * 4 + 3] = t[3]; }
        norm_mod_store(v, p.norm1_g, MOD + (size_t)(0 * 33 + mod_row(r)) * 6144, H + (size_t)r * 1024, wv_);
    }
}

struct PvInproj {
    const Params& p; int l;
    PV_NOHOOKS
    static constexpr int NT = 16; static constexpr int FP8 = 0; static constexpr bool PARK = false; typedef APlain AS; typedef BSimple BS;
    XcdDeal<4, 6> deal;
    DI int first() const { return deal.first(); }
    DI int next(int u) const { return deal.next(u); }
    DI void src(int u, AS& a, BS& b, const int wv_) const {
        int mt, nt; deal.decode(u, mt, nt);
        const bf16_t* W = (const bf16_t*)(p.ws + WS_WMI) + (size_t)l * 1536 * 1024;
        a = make_a_plain((const bf16_t*)(p.ws + WS_H), (size_t)mt * 256, 1024, 0);
        b = nt < 2 ? make_b(W + (size_t)(nt * 128) * 1024, W + (size_t)(256 + nt * 128) * 1024, 1024)
                   : make_b(W + (size_t)(nt * 256) * 1024, W + (size_t)(nt * 256 + 128) * 1024, 1024);
    }
    DI void epi(f32x4 (&acc)[2][2][4][2], int u, const int wv_) const {
        int mt, nt; deal.decode(u, mt, nt);
        bf16_t* P = (bf16_t*)(p.ws + WS_P);
        if (nt < 2) {
            const int _tz = otid(), _w = _tz >> 6, _l = _tz & 63, _wr = _w >> 2, _wc = _w & 3, _fr = _l & 15, _fq = _l >> 4;
#pragma unroll
            for (int ai = 0; ai < 2; ++ai)
#pragma unroll
                for (int m = 0; m < 4; ++m) { const int lr = ai * 128 + _wr * 64 + m * 16 + _fr; const int lc = _wc * 32 + _fq * 8;
                    f32x4 o0, o1;
#pragma unroll
                    for (int r = 0; r < 4; ++r) { o0[r] = acc[ai][0][m][0][r] * sigmoidf_(acc[ai][1][m][0][r]); o1[r] = acc[ai][0][m][1][r] * sigmoidf_(acc[ai][1][m][1][r]); }
                    store_bf16x8(P + (size_t)(mt * 256 + lr) * NINP + nt * 128 + lc, o0, o1); }
        } else {
            EPI_FOR8(acc, { store_bf16x8(P + (size_t)(mt * 256 + lr) * NINP + nt * 256 + lc, v0, v1); });
        }
    }
};
DI void phase_inproj(const Params& p, LAS char* shm, int l, const int wv_) {
    PvInproj pv{p, l, {TT / 256}};
    gemm_stream(shm, pv, wv_);
}

template <int N> DI void wave_sum_n(float (&v)[N]) {
    const int l4 = olane();
#pragma unroll
    for (int o = 32; o > 0; o >>= 1) {
        float t_[N];
#pragma unroll
        for (int i = 0; i < N; ++i) t_[i] = __int_as_float(__builtin_amdgcn_ds_bpermute((l4 ^ o) << 2, __float_as_int(v[i])));
#pragma unroll
        for (int i = 0; i < N; ++i) v[i] += t_[i];
    }
}
template <int WIN, bool EDGE>
DI void pool_run(const LAS bf16_t* pin  , bf16_t* AP, int row0, int ts0, int L, int c, int half) {
    for (int blk = 0; blk < 2; ++blk) {
        const int t0 = half * 32 + blk * 16;
        float in[16 + WIN - 1];
#pragma unroll
        for (int i = 0; i < 16 + WIN - 1; ++i) in[i] = bf2f(pin[(t0 + i - WIN / 2 + 8) * 256 + c]);
        float sum = 0.f;
#pragma unroll
        for (int j = 0; j < WIN; ++j) sum += in[j];
#pragma unroll
        for (int o = 0; o < 16; ++o) {
            float inv = 1.f / (float)WIN;
            if (EDGE) { const int ts = ts0 + t0 + o; const int lo = max(ts - WIN / 2, 0), hi = min(ts + WIN - 1 - WIN / 2, L - 1); inv = 1.f / (float)(hi - lo + 1); }
            AP[(size_t)(row0 + t0 + o) * 256 + c] = f2bf(sum * inv - in[o + WIN / 2]);
            if (o < 15) sum += in[o + WIN] - in[o];
        }
    }
}
template <bool EDGE>
DI void pre_unit_t(const Params& p, LAS char* shm, int l, int row0, int ts0, int L, const float (&w)[31], const float bias, const int wv_) {
    const int tid = otid();
    const bf16_t* P = (const bf16_t*)(p.ws + WS_P);
    const int c = tid & 255, half = tid >> 8;
    LAS bf16_t* cin = (LAS bf16_t*)shm;
    LAS float* cv = (LAS float*)(shm + 49152);
    u32x4 creg[6], preg[5];
#pragma unroll
    for (int it = 0; it < 6; ++it) { const int q = it * 512 + tid, row = q >> 5, part = q & 31; const int ts = ts0 - 15 + row;
        creg[it] = (u32x4){0u, 0u, 0u, 0u};
        if (q < 94 * 32 && (!EDGE || (ts >= 0 && ts < L))) creg[it] = *(const u32x4*)(P + (size_t)(row0 - 15 + row) * NINP + part * 8); }
#pragma unroll
    for (int it = 0; it < 5; ++it) { const int q = it * 512 + tid, row = q >> 5, part = q & 31; const int ts = ts0 - 8 + row;
        preg[it] = (u32x4){0u, 0u, 0u, 0u};
        if (!EDGE || (ts >= 0 && ts < L)) preg[it] = *(const u32x4*)(P + (size_t)(row0 - 8 + row) * NINP + OFF_POOL + part * 8); }
#pragma unroll
    for (int it = 0; it < 6; ++it) { const int q = it * 512 + tid; if (q < 94 * 32) *(LAS u32x4*)(cin + q * 8) = creg[it]; }
    __syncthreads();
    {
        const int t0 = half * 32;
        float in[62];
#pragma unroll
        for (int i = 0; i < 62; ++i) in[i] = bf2f(cin[(t0 + i) * 256 + c]);
#pragma unroll
        for (int o = 0; o < 32; ++o) { float s_ = bias;
#pragma unroll
            for (int j = 0; j < 31; ++j) s_ += w[j] * in[o + j];
            cv[(t0 + o) * 257 + c] = s_; }
    }
    __syncthreads();
#pragma unroll
    for (int it = 0; it < 5; ++it) *(LAS u32x4*)(cin + (it * 512 + tid) * 8) = preg[it];
    {
        const int wid = tid >> 6, lane = tid & 63;
        bf16_t* AC = (bf16_t*)(p.ws + WS_ACONV);
        float lg[4], lb[4];
#pragma unroll
        for (int j = 0; j < 4; ++j) { lg[j] = p.conv_ln_g[l * 256 + lane + 64 * j]; lb[j] = p.conv_ln_b[l * 256 + lane + 64 * j]; }
        float x[8][4], s8[8];
#pragma unroll
        for (int i = 0; i < 8; ++i) { s8[i] = 0.f;
#pragma unroll
            for (int j = 0; j < 4; ++j) { x[i][j] = cv[(wid * 8 + i) * 257 + lane + 64 * j]; s8[i] += x[i][j]; } }
        wave_sum_n<8>(s8);
#pragma unroll
        for (int i = 0; i < 8; ++i) { const float mu = s8[i] * (1.f / 256.f); s8[i] = 0.f;
#pragma unroll
            for (int j = 0; j < 4; ++j) { x[i][j] -= mu; s8[i] += x[i][j] * x[i][j]; } }
        wave_sum_n<8>(s8);
#pragma unroll
        for (int i = 0; i < 8; ++i) { const float rs = rsqrtf(s8[i] * (1.f / 256.f) + EPS);
#pragma unroll
            for (int j = 0; j < 4; ++j) { const float y = x[i][j] * rs * lg[j] + lb[j]; AC[(size_t)(row0 + wid * 8 + i) * 256 + lane + 64 * j] = f2bf(siluf_(y)); } }
    }
    __syncthreads();
    {
        bf16_t* AP = (bf16_t*)(p.ws + WS_APOOL);
        const int g = __builtin_amdgcn_readfirstlane(c >> 6);
        if (g == 0) pool_run<2, EDGE>(cin, AP, row0, ts0, L, c, half);
        else if (g == 1) pool_run<4, EDGE>(cin, AP, row0, ts0, L, c, half);
        else if (g == 2) pool_run<8, EDGE>(cin, AP, row0, ts0, L, c, half);
        else pool_run<16, EDGE>(cin, AP, row0, ts0, L, c, half);
    }
    __syncthreads();
}
DI void pre_unit(const Params& p, LAS char* shm, int l, int tile, const float (&w)[31], const float bias, const int wv_) {
    int row0, ts0, L;
    if (tile < 1024) { row0 = tile * 64; ts0 = row0 & 2047; L = SEQ; } else { row0 = TX + (tile - 1024) * 64; ts0 = (row0 - TX) & 255; L = CTXL; }
    if (ts0 >= 16 && ts0 + 64 + 16 <= L) pre_unit_t<false>(p, shm, l, row0, ts0, L, w, bias, wv_);
    else pre_unit_t<true>(p, shm, l, row0, ts0, L, w, bias, wv_);
}
struct PvS5State {
    const Params& p; int l;
    PV_NOHOOKS
    static constexpr int NT = 16; static constexpr int FP8 = 0; static constexpr bool PARK = false; typedef ASimple AS; typedef BSimple BS;
    DI int first() const { return lin_first(0, 80); }
    DI int next(int u) const { return lin_next(u, 80); }
    DI void src(int u, AS& as, BS& bs, const int wv_) const {
        const int g = u / 5, mt = u % 5;
        int R[2], C[2]; stage_coords(R, C, wv_);
        as.base = (const char*)(p.ws + WS_P); as.kstride = 4 * NINP * 2;
#pragma unroll
        for (int h = 0; h < 2; ++h)
#pragma unroll
            for (int i = 0; i < 2; ++i) { const int cr = min(mt * 256 + h * 128 + R[i], NCROW - 1);
                as.off[h][i] = (unsigned)(((size_t)(crow_tok(cr) + (C[i] >> 4)) * NINP + OFF_SSM + g * 16 + (C[i] & 15)) * 2); }
        const bf16_t* W = (const bf16_t*)(p.ws + WS_WS5) + (size_t)(l * 16 + g) * 256 * 1024;
        bs = make_b(W, W + (size_t)128 * 1024, 1024);
    }
    DI void epi(f32x4 (&acc)[2][2][4][2], int u, const int wv_) const {
        const int g = u / 5, mt = u % 5;
        float* SST = (float*)(p.ws + WS_SST);
        EPI_FOR8(acc, { const int cr = mt * 256 + lr; if (cr < NCROW) { float* o_ = SST + ((size_t)cr * 16 + g) * 256 + lc; *(f32x4*)o_ = v0; *(f32x4*)(o_ + 4) = v1; } });
    }
};
struct PvQKV {
    const Params& p; int l;
    PV_NOHOOKS
    static constexpr int NT = 4; static constexpr int FP8 = 0; static constexpr bool PARK = false; typedef APlain AS; typedef BSimple BS;
    DI int first() const { return lin_first(80, 1152); }
    DI int next(int u) const { return lin_next(u, 1152); }
    DI void src(int u, AS& a, BS& b, const int wv_) const {
        const bool isq = u < 576; const int w_ = isq ? u : u - 576; const int mt = w_ >> 1, nt = w_ & 1;
        a = make_a_plain((const bf16_t*)(p.ws + WS_P), (size_t)mt * 256, NINP, isq ? OFF_Q : OFF_KV);
        const bf16_t* W = (const bf16_t*)(p.ws + (isq ? WS_WQ : WS_WKV)) + (size_t)l * 512 * 256 + (size_t)nt * 256 * 256;
        b = make_b(W, W + (size_t)128 * 256, 256);
    }
    DI void epi(f32x4 (&acc)[2][2][4][2], int u, const int wv_) const {
        const bool isq = u < 576; const int w_ = isq ? u : u - 576; const int mt = w_ >> 1, nt = w_ & 1;
        bf16_t* RAW = (bf16_t*)(p.ws + (isq ? WS_RAWQ : WS_RAWKV));
        EPI_FOR8(acc, { store_bf16x8(RAW + (size_t)(mt * 256 + lr) * 512 + nt * 256 + lc, v0, v1); });
    }
};
DI void phase_A(const Params& p, LAS char* shm, int l, const int wv_) {
    { PvS5State pv{p, l}; gemm_stream(shm, pv, wv_); }
    { PvQKV pv{p, l}; gemm_stream(shm, pv, wv_); }
    { const int c_ = otid() & 255;
      float w[31];
#pragma unroll
      for (int j = 0; j < 31; ++j) w[j] = p.conv_dw[((size_t)l * 31 + j) * 256 + c_];
      const float bias = p.conv_dw_b[l * 256 + c_];
      const int n_pre = l == 1 ? 1024 : 1152;
      for (int u = first_unit(80 + 1152); u < n_pre; u += gridDim.x) pre_unit(p, shm, l, u, w, bias, wv_); }
}

DI void qkvpost_unit(const Params& p, LAS char* shm, int l, int unit, const int wv_) {
    const int tid = otid(), wid = tid >> 6, lane = tid & 63;
    const bf16_t* P = (const bf16_t*)(p.ws + WS_P);
    const bf16_t* RAWQ = (const bf16_t*)(p.ws + WS_RAWQ);
    const bf16_t* RAWKV = (const bf16_t*)(p.ws + WS_RAWKV);
    bf16_t* Q = (bf16_t*)(p.ws + WS_Q);
    bf16_t* KB = (bf16_t*)(p.ws + WS_KB);
    bf16_t* VT = (bf16_t*)(p.ws + WS_VT);
    LAS bf16_t* vt = (LAS bf16_t*)shm;
    const int row0 = unit * 64;
    const bool lat = row0 < TX;
    const int b = lat ? (row0 >> 11) : ((row0 - TX) >> 8);
    const int key0 = lat ? (row0 & 2047) : 2048 + ((row0 - TX) & 255);
    const int head = lane >> 4, sub = lane & 15;
    const float lninv = -9.210340371976184f / 8.f;
    const float frq = __expf(lninv * (float)(sub & 7));
    float qg[6], kg[6];
#pragma unroll
    for (int j = 0; j < 6; ++j) { qg[j] = p.mla_q_g[l * 96 + sub + 16 * j] * 0.14724444674085666f; kg[j] = p.mla_k_g[l * 96 + sub + 16 * j]; }
    constexpr int NB = 4;
    for (int tk0 = wid * 8; tk0 < wid * 8 + 8; tk0 += NB) {
        float pq[NB][3], pkv[NB][2], qr[NB][6], kr[NB][6], vr[NB][4];
#pragma unroll
        for (int i = 0; i < NB; ++i) { const int r = row0 + tk0 + i; const bf16_t* pr = P + (size_t)r * NINP;
#pragma unroll
            for (int j = 0; j < 3; ++j) pq[i][j] = bf2f(pr[OFF_Q + lane + 64 * j]);
#pragma unroll
            for (int j = 0; j < 2; ++j) pkv[i][j] = bf2f(pr[OFF_KV + lane + 64 * j]);
#pragma unroll
            for (int j = 0; j < 6; ++j) qr[i][j] = bf2f(RAWQ[(size_t)r * 512 + head * 96 + sub + 16 * j]);
#pragma unroll
            for (int j = 0; j < 4; ++j) kr[i][j] = bf2f(RAWKV[(size_t)r * 512 + head * 128 + sub + 16 * j]);
#pragma unroll
            for (int j = 4; j < 6; ++j) kr[i][j] = bf2f(pr[OFF_KPE + sub + 16 * (j - 4)]);
#pragma unroll
            for (int j = 0; j < 4; ++j) vr[i][j] = bf2f(RAWKV[(size_t)r * 512 + head * 128 + 64 + sub + 16 * j]); }
        float red[2 * NB];
#pragma unroll
        for (int i = 0; i < NB; ++i) { red[2 * i] = pq[i][0] * pq[i][0] + pq[i][1] * pq[i][1] + pq[i][2] * pq[i][2]; red[2 * i + 1] = pkv[i][0] * pkv[i][0] + pkv[i][1] * pkv[i][1]; }
        wave_sum_n<2 * NB>(red);
        float ssq[2 * NB];
#pragma unroll
        for (int i = 0; i < NB; ++i) {
            const float rq = rsqrtf(red[2 * i] * (1.f / 192.f) + EPS), rkv = rsqrtf(red[2 * i + 1] * (1.f / 128.f) + EPS);
            float s0 = 0.f, s1 = 0.f;
#pragma unroll
            for (int j = 0; j < 6; ++j) { qr[i][j] *= rq; s0 += qr[i][j] * qr[i][j]; }
#pragma unroll
            for (int j = 0; j < 4; ++j) { kr[i][j] *= rkv; s1 += kr[i][j] * kr[i][j]; }
#pragma unroll
            for (int j = 4; j < 6; ++j) s1 += kr[i][j] * kr[i][j];
#pragma unroll
            for (int j = 0; j < 4; ++j) vr[i][j] *= rkv;
            ssq[2 * i] = s0; ssq[2 * i + 1] = s1;
        }
        { const int l4 = olane();
#pragma unroll
          for (int o = 8; o > 0; o >>= 1) { float t_[2 * NB];
#pragma unroll
              for (int i = 0; i < 2 * NB; ++i) t_[i] = __int_as_float(__builtin_amdgcn_ds_bpermute((l4 ^ o) << 2, __float_as_int(ssq[i])));
#pragma unroll
              for (int i = 0; i < 2 * NB; ++i) ssq[i] += t_[i]; } }
#pragma unroll
        for (int i = 0; i < NB; ++i) {
            const int tk = tk0 + i, r = row0 + tk;
            const float rnq = rsqrtf(ssq[2 * i] * (1.f / 96.f) + EPS), rnk = rsqrtf(ssq[2 * i + 1] * (1.f / 96.f) + EPS);
#pragma unroll
            for (int j = 0; j < 6; ++j) { qr[i][j] *= rnq * qg[j]; kr[i][j] *= rnk * kg[j]; }
            if (lat) {
                const int tseq = r & 2047; const float a0 = (float)(tseq >> 6) * frq, a1 = (float)(tseq & 63) * frq;
                const float cs0 = __cosf(a0), sn0 = __sinf(a0), cs1 = __cosf(a1), sn1 = __sinf(a1);
                const float oq4 = shx(qr[i][4], 8), oq5 = shx(qr[i][5], 8), ok4 = shx(kr[i][4], 8), ok5 = shx(kr[i][5], 8);
                const float sg = (sub < 8) ? -1.f : 1.f;
                qr[i][4] = qr[i][4] * cs0 + sg * oq4 * sn0; qr[i][5] = qr[i][5] * cs1 + sg * oq5 * sn1;
                kr[i][4] = kr[i][4] * cs0 + sg * ok4 * sn0; kr[i][5] = kr[i][5] * cs1 + sg * ok5 * sn1;
            }
            bf16_t* kro = KB + ((size_t)(b * 4 + head) * 2304 + key0 + tk) * 96;
#pragma unroll
            for (int j = 0; j < 6; ++j) { Q[(size_t)r * 384 + head * 96 + sub + 16 * j] = f2bf(qr[i][j]); kro[sub + 16 * j] = f2bf(kr[i][j]); }
#pragma unroll
            for (int j = 0; j < 4; ++j) vt[(head * 64 + sub + 16 * j) * 72 + tk] = f2bf(vr[i][j]);
        }
    }
    __syncthreads();
    { const int hv = tid >> 1, hf = tid & 1;
      bf16_t* dst = VT + ((size_t)(b * 4 + (hv >> 6)) * 64 + (hv & 63)) * 2304 + key0 + hf * 32;
#pragma unroll
      for (int i = 0; i < 4; ++i) *(u32x4*)(dst + i * 8) = *(const LAS u32x4*)(vt + hv * 72 + hf * 32 + i * 8); }
    __syncthreads();
}
DI void s5carry_unit(const Params& p, int l, int unit, const int wv_) {
    const int gid = unit * 512 + otid();
    const int q = gid & 63, dir = (gid >> 6) & 1, g = (gid >> 7) & 15, b = gid >> 11;
    const float* A64 = (const float*)(p.ws + WS_A64) + (size_t)(((l * 2 + dir) * 16 + g) * 64 + q) * 2;
    const float ar = A64[0], ai = A64[1];
    const float* SST = (const float*)(p.ws + WS_SST);
    bf16_t* HIN = (bf16_t*)(p.ws + WS_HIN);
    float sr[NCH], si[NCH];
#pragma unroll
    for (int s = 0; s < NCH; ++s) { const int j = dir == 0 ? s : (s < 4 ? 3 - s : 39 - s);
        const size_t base = ((size_t)(b * NCH + j) * 16 + g) * 256 + dir * 128 + q; sr[s] = SST[base]; si[s] = SST[base + 64]; }
    float hr = 0.f, hi = 0.f;
#pragma unroll
    for (int s = 0; s < NCH; ++s) {
        const int j = dir == 0 ? s : (s < 4 ? 3 - s : 39 - s);
        const size_t base = ((size_t)(b * NCH + j) * 16 + g) * 256 + dir * 128 + q;
        HIN[base] = f2bf(hr); HIN[base + 64] = f2bf(hi);
        const float nr = ar * hr - ai * hi + sr[s], ni = ar * hi + ai * hr + si[s];
        hr = nr; hi = ni;
    }
}
struct PvConvPool {
    const Params& p; int l;
    PV_NOHOOKS
    static constexpr int NT = 4; static constexpr int FP8 = 0; static constexpr bool PARK = false; typedef APlain AS; typedef BSimple BS;
    DI int nrt() const { return l == 1 ? 256 : 288; }
    DI int first() const { return lin_first(0, 2 * nrt()); }
    DI int next(int u) const { return lin_next(u, 2 * nrt()); }
    DI void src(int u, AS& a, BS& b, const int wv_) const {
        const bool isconv = u < nrt(); const int mt = isconv ? u : u - nrt();
        a = make_a_plain((const bf16_t*)(p.ws + (isconv ? WS_ACONV : WS_APOOL)), (size_t)mt * 256, 256, 0);
        const bf16_t* W = (const bf16_t*)(p.ws + (isconv ? WS_WPW : WS_WPOOL)) + (size_t)l * 65536;
        b = make_b(W, W + (size_t)128 * 256, 256);
    }
    DI void epi(f32x4 (&acc)[2][2][4][2], int u, const int wv_) const {
        const bool isconv = u < nrt(); const int mt = isconv ? u : u - nrt();
        bf16_t* CAT = (bf16_t*)(p.ws + WS_CAT);
        if (isconv) { EPI_FOR8(acc, { store_bf16x8(CAT + (size_t)(mt * 256 + lr) * 1024 + lc, v0, v1); }); }
        else { const int t_ = otid(), c0_ = ((t_ >> 6) & 3) * 32 + ((t_ & 63) >> 4) * 8; f32x4 sc_[2][2];
#pragma unroll
               for (int bj = 0; bj < 2; ++bj)
#pragma unroll
                   for (int n = 0; n < 2; ++n) sc_[bj][n] = *(const f32x4*)(p.pool_scale + l * 256 + bj * 128 + n * 4 + c0_);
               EPI_FOR8(acc, { store_bf16x8(CAT + (size_t)(mt * 256 + lr) * 1024 + 256 + lc, v0 * sc_[bj][0], v1 * sc_[bj][1]); }); }
    }
};
DI void phase_B(const Params& p, LAS char* shm, int l, const int wv_) {
    { PvConvPool pv{p, l}; gemm_stream(shm, pv, wv_); }
    const int n_post = TT / 64, n_carry = 128;
    for (int u = first_unit(l == 1 ? 512 : 576); u < n_post + n_carry; u += gridDim.x) {
        if (u < n_post) qkvpost_unit(p, shm, l, u, wv_);
        else s5carry_unit(p, l, u - n_post, wv_);
    }
}

template <bool NS> DI void attn_unit(const Params& p, LAS char* shm, int l, int b, int h, int qrow0, int nq, int key_lo, int nkeys, const float sh2, const int wv_) {
    const int tid = otid(), wid = tid >> 6, lane = tid & 63, l31 = lane & 31, hh = lane >> 5;
    const bf16_t* Q = (const bf16_t*)(p.ws + WS_Q);
    const bf16_t* KBp = (const bf16_t*)(p.ws + WS_KB) + (size_t)(b * 4 + h) * 2304 * 96;
    const bf16_t* VTp = (const bf16_t*)(p.ws + WS_VT) + (size_t)(b * 4 + h) * 64 * 2304;
    bf16_t* CAT = (bf16_t*)(p.ws + WS_CAT);
    LAS char* kl = shm;
    LAS char* vl = shm + 13312;
    const bool active = wid * 64 < nq;
    LAS char* const wq = shm + 2 * 13312 + 2 * 9216 + wid * 12288 + lane * 16;
    if (active) {
#pragma unroll
        for (int qb = 0; qb < 2; ++qb)
#pragma unroll
            for (int ks = 0; ks < 6; ++ks) *(LAS bf16x8*)(wq + (qb * 6 + ks) * 1024) = *(const bf16x8*)(Q + (size_t)(qrow0 + wid * 64 + qb * 32 + l31) * 384 + h * 96 + ks * 16 + hh * 8);
    }
    f32x16 O[2][2];
#pragma unroll
    for (int a = 0; a < 2; ++a)
#pragma unroll
        for (int c = 0; c < 2; ++c)
#pragma unroll
            for (int i = 0; i < 16; ++i) O[a][c][i] = 0.f;
    float lsum[2] = {0.f, 0.f};
    const int ntile = nkeys / 64;
    LAS char* const kb0 = shm;
    LAS char* const vb0 = shm + 2 * 13312;
    u32x4 kreg0, kreg1, vreg;
    const int k_kr0 = tid / 12, k_p0 = tid % 12, k_kr1 = (tid + 512) / 12, k_p1 = (tid + 512) % 12, v_vd = tid >> 3, v_p = tid & 7;
#define A_LOADK(T_) do { const int key_ = key_lo + (T_) * 64; kreg0 = *(const u32x4*)(KBp + (size_t)(key_ + k_kr0) * 96 + k_p0 * 8); \
        if (tid < 256) kreg1 = *(const u32x4*)(KBp + (size_t)(key_ + k_kr1) * 96 + k_p1 * 8); } while (0)
#define A_LOADV(T_) do { const int key_ = key_lo + (T_) * 64; vreg = *(const u32x4*)(VTp + (size_t)v_vd * 2304 + key_ + v_p * 8); } while (0)
#define A_WRITEK(buf_) do { LAS char* kl_ = kb0 + (buf_) * 13312; *(LAS u32x4*)(kl_ + k_kr0 * 208 + k_p0 * 16) = kreg0; if (tid < 256) *(LAS u32x4*)(kl_ + k_kr1 * 208 + k_p1 * 16) = kreg1; } while (0)
#define A_WRITEV(buf_) do { LAS char* vl_ = vb0 + (buf_) * 9216; *(LAS u32x4*)(vl_ + v_vd * 144 + v_p * 16) = vreg; } while (0)
#define A_QK(S_, kbuf_, half_) do { const LAS char* kl_ = kb0 + (kbuf_) * 13312 + ((half_) * 32 + l31) * 208 + hh * 16; \
        _Pragma("unroll") for (int ks = 0; ks < 6; ++ks) { const bf16x8 a_ = *(const LAS bf16x8*)(kl_ + ks * 32); \
            if (ks == 0) { _Pragma("unroll") for (int qb = 0; qb < 2; ++qb) { f32x16 z_; _Pragma("unroll") for (int i = 0; i < 16; ++i) z_[i] = 0.f; S_[qb] = __builtin_amdgcn_mfma_f32_32x32x16_bf16(a_, *(const LAS bf16x8*)(wq + (qb * 6) * 1024), z_, 0, 0, 0); } } \
            else { _Pragma("unroll") for (int qb = 0; qb < 2; ++qb) S_[qb] = __builtin_amdgcn_mfma_f32_32x32x16_bf16(a_, *(const LAS bf16x8*)(wq + (qb * 6 + ks) * 1024), S_[qb], 0, 0, 0); } } } while (0)
#define A_SOFTMAX(S_, P_) do { _Pragma("unroll") for (int qb = 0; qb < 2; ++qb) { float e_[16]; \
        _Pragma("unroll") for (int i = 0; i < 16; ++i) { e_[i] = __builtin_amdgcn_exp2f(NS ? S_[qb][i] : S_[qb][i] - sh2); lsum[qb] += e_[i]; } \
        _Pragma("unroll") for (int s_ = 0; s_ < 2; ++s_) { u32x4 w_; w_.x = pk_bf16(e_[8 * s_], e_[8 * s_ + 1]); w_.y = pk_bf16(e_[8 * s_ + 2], e_[8 * s_ + 3]); w_.z = pk_bf16(e_[8 * s_ + 4], e_[8 * s_ + 5]); w_.w = pk_bf16(e_[8 * s_ + 6], e_[8 * s_ + 7]); \
            P_[qb][s_] = __builtin_bit_cast(bf16x8, w_); } } } while (0)
#define A_PV(P_, vbuf_, half_) do { const LAS char* vl_ = vb0 + (vbuf_) * 9216 + l31 * 144 + hh * 8; \
        _Pragma("unroll") for (int s_ = 0; s_ < 2; ++s_) { const int kk_ = (half_) * 2 + s_; \
            _Pragma("unroll") for (int vb = 0; vb < 2; ++vb) { \
                const s16x4 lo_ = *(const LAS s16x4*)(vl_ + vb * 32 * 144 + kk_ * 32); const s16x4 hi_ = *(const LAS s16x4*)(vl_ + vb * 32 * 144 + kk_ * 32 + 16); \
                const bf16x8 va_ = __builtin_shufflevector(lo_, hi_, 0, 1, 2, 3, 4, 5, 6, 7); \
                _Pragma("unroll") for (int qb = 0; qb < 2; ++qb) O[vb][qb] = __builtin_amdgcn_mfma_f32_32x32x16_bf16(va_, P_[qb][s_], O[vb][qb], 0, 0, 0); } } } while (0)
#define A_LDF(p_) (*(const LAS bf16x8*)(p_))
#define A_LDV(p_) __builtin_shufflevector(*(const LAS s16x4*)(p_), *(const LAS s16x4*)((p_) + 16), 0, 1, 2, 3, 4, 5, 6, 7)
#define A_SOFT4(g_, Ss_) do { _Pragma("unroll") for (int j_ = 0; j_ < 2; ++j_) { const int ix_ = (g_) * 4 + j_ * 2, qb_ = ix_ >> 4, i_ = ix_ & 15; \
        const float e0_ = __builtin_amdgcn_exp2f(NS ? Ss_[qb_][i_] : Ss_[qb_][i_] - sh2), e1_ = __builtin_amdgcn_exp2f(NS ? Ss_[qb_][i_ + 1] : Ss_[qb_][i_ + 1] - sh2); lsum[qb_] += e0_ + e1_; pw_[ix_ >> 1] = pk_bf16(e0_, e1_); } } while (0)
#define A_STEP(Sq_, kbufq_, halfq_, Ss_, Ps_, Pp_, vbufp_, halfp_) do { \
        const LAS char* kl_ = kb0 + (kbufq_) * 13312 + ((halfq_) * 32 + l31) * 208 + hh * 16; \
        const LAS char* vl_ = vb0 + (vbufp_) * 9216 + l31 * 144 + hh * 8 + (halfp_) * 64; \
        bf16x8 fa_[2], fq_[2][2], fv_[2]; unsigned pw_[16]; \
        fa_[0] = A_LDF(kl_); fq_[0][0] = A_LDF(wq); fq_[0][1] = A_LDF(wq + 6 * 1024); \
        __builtin_amdgcn_sched_barrier(0); \
        _Pragma("unroll") for (int g_ = 0; g_ < 6; ++g_) { \
            if (g_ < 5) { fa_[(g_ + 1) & 1] = A_LDF(kl_ + (g_ + 1) * 32); fq_[(g_ + 1) & 1][0] = A_LDF(wq + (g_ + 1) * 1024); fq_[(g_ + 1) & 1][1] = A_LDF(wq + (6 + g_ + 1) * 1024); } \
            else fv_[0] = A_LDV(vl_); \
            if (g_ == 0) { _Pragma("unroll") for (int qb = 0; qb < 2; ++qb) { f32x16 z_; _Pragma("unroll") for (int i = 0; i < 16; ++i) z_[i] = 0.f; Sq_[qb] = __builtin_amdgcn_mfma_f32_32x32x16_bf16(fa_[0], fq_[0][qb], z_, 0, 0, 0); } } \
            else { _Pragma("unroll") for (int qb = 0; qb < 2; ++qb) Sq_[qb] = __builtin_amdgcn_mfma_f32_32x32x16_bf16(fa_[g_ & 1], fq_[g_ & 1][qb], Sq_[qb], 0, 0, 0); } \
            A_SOFT4(g_, Ss_); \
            __builtin_amdgcn_sched_barrier(0); } \
        _Pragma("unroll") for (int g_ = 0; g_ < 4; ++g_) { const int s_ = g_ >> 1, vb_ = g_ & 1; \
            if (g_ < 3) fv_[(g_ + 1) & 1] = A_LDV(vl_ + ((g_ + 1) & 1) * 32 * 144 + ((g_ + 1) >> 1) * 32); \
            _Pragma("unroll") for (int qb = 0; qb < 2; ++qb) O[vb_][qb] = __builtin_amdgcn_mfma_f32_32x32x16_bf16(fv_[g_ & 1], Pp_[qb][s_], O[vb_][qb], 0, 0, 0); \
            if (g_ < 2) A_SOFT4(6 + g_, Ss_); \
            __builtin_amdgcn_sched_barrier(0); } \
        _Pragma("unroll") for (int qb = 0; qb < 2; ++qb) _Pragma("unroll") for (int s_ = 0; s_ < 2; ++s_) { u32x4 w_; w_.x = pw_[qb * 8 + s_ * 4]; w_.y = pw_[qb * 8 + s_ * 4 + 1]; w_.z = pw_[qb * 8 + s_ * 4 + 2]; w_.w = pw_[qb * 8 + s_ * 4 + 3]; Ps_[qb][s_] = __builtin_bit_cast(bf16x8, w_); } \
    } while (0)
#define A_SCHED(n_) do { _Pragma("unroll") for (int g_ = 0; g_ < (n_); ++g_) { __builtin_amdgcn_sched_group_barrier(0x008, 1, 0); __builtin_amdgcn_sched_group_barrier(0x002, 5, 0); } } while (0)
    {
        u32x4 k1a = (u32x4){0u, 0u, 0u, 0u}, k1b = k1a;
        A_LOADK(0); A_LOADV(0);
        if (ntile > 1) { const int key_ = key_lo + 64; k1a = *(const u32x4*)(KBp + (size_t)(key_ + k_kr0) * 96 + k_p0 * 8); if (tid < 256) k1b = *(const u32x4*)(KBp + (size_t)(key_ + k_kr1) * 96 + k_p1 * 8); }
        A_WRITEK(0); A_WRITEV(0);
        kreg0 = k1a; kreg1 = k1b; A_WRITEK(1);
        if (ntile > 2) A_LOADK(2);
        if (ntile > 1) A_LOADV(1);
    }
    __syncthreads();
    f32x16 Sa[2], Sb[2]; bf16x8 Pa[2][2], Pb[2][2];
    if (active) { A_QK(Sa, 0, 0); A_QK(Sb, 0, 1); A_SOFTMAX(Sa, Pa); A_SCHED(12); }
    for (int T = 0; T < ntile; ++T) {
        const int kcur = T & 1, knxt = kcur ^ 1;
        __syncthreads();
        if (T + 2 < ntile) A_WRITEK(kcur);
        if (T + 1 < ntile) A_WRITEV(knxt);
        if (T + 3 < ntile) A_LOADK(T + 3);
        if (T + 2 < ntile) A_LOADV(T + 2);
        if (active) {
            if (T + 1 < ntile) {
                A_STEP(Sa, knxt, 0, Sb, Pb, Pa, kcur, 0);
                A_STEP(Sb, knxt, 1, Sa, Pa, Pb, kcur, 1);
            } else {
                A_SOFTMAX(Sb, Pb); A_PV(Pa, kcur, 0); A_SCHED(8);
                __builtin_amdgcn_sched_barrier(0);
                A_PV(Pb, kcur, 1);
            }
        }
    }
#undef A_LOADK
#undef A_LOADV
#undef A_WRITEK
#undef A_WRITEV
#undef A_QK
#undef A_SOFTMAX
#undef A_PV
#undef A_SCHED
#undef A_STEP
#undef A_SOFT4
#undef A_LDF
#undef A_LDV
    if (active) {
#pragma unroll
        for (int qb = 0; qb < 2; ++qb) {
            const float tot = lsum[qb] + shx(lsum[qb], 32);
            const float inv = 1.f / tot;
            bf16_t* orow = CAT + (size_t)(qrow0 + wid * 64 + qb * 32 + l31) * 1024 + 768 + h * 64;
#pragma unroll
            for (int vb = 0; vb < 2; ++vb)
#pragma unroll
                for (int i4 = 0; i4 < 4; ++i4)
                    store_bf16x4(orow + vb * 32 + 8 * i4 + 4 * hh, O[vb][qb][4 * i4] * inv, O[vb][qb][4 * i4 + 1] * inv, O[vb][qb][4 * i4 + 2] * inv, O[vb][qb][4 * i4 + 3] * inv);
        }
    }
    __syncthreads();
}
struct PvS5Out {
    const Params& p; int l;
    PV_NOHOOKS
    static constexpr int NT = 20; static constexpr int FP8 = 0; static constexpr bool PARK = false; typedef ASeg2 AS; typedef BSimple BS;
    DI int first() const { return lin_first(512, 320); }
    DI int next(int u) const { return lin_next(u, 320); }
    DI void src(int u, AS& as, BS& bs, const int wv_) const {
        const int ntile = u & 3, mt = (u >> 2) % 5, g = u / 20;
        int R[2], C[2]; stage_coords(R, C, wv_);
        as.base0 = (const char*)(p.ws + WS_P); as.base1 = (const char*)(p.ws + WS_HIN); as.ks0 = 4 * NINP * 2; as.nt0 = 16;
#pragma unroll
        for (int h = 0; h < 2; ++h)
#pragma unroll
            for (int i = 0; i < 2; ++i) { const int cr = min(mt * 256 + h * 128 + R[i], NCROW - 1);
                as.off0[h][i] = (unsigned)(((size_t)(crow_tok(cr) + (C[i] >> 4)) * NINP + OFF_SSM + g * 16 + (C[i] & 15)) * 2);
                as.off1[h][i] = (unsigned)((((size_t)cr * 16 + g) * 256 + C[i]) * 2); }
        const bf16_t* W = (const bf16_t*)(p.ws + WS_TS5) + ((size_t)(l * 16 + g) * 1024 + ntile * 256) * 1280;
        bs = make_b(W, W + (size_t)128 * 1280, 1280);
    }
    DI void epi(f32x4 (&acc)[2][2][4][2], int u, const int wv_) const {
        const int ntile = u & 3, mt = (u >> 2) % 5, g = u / 20;
        bf16_t* Z = (bf16_t*)(p.ws + WS_Z);
        EPI_FOR8(acc, { const int cr = mt * 256 + lr; if (cr < NCROW) { const int col = ntile * 256 + lc, t = col >> 4, co = col & 15;
            const f32x4 g0 = (f32x4){gelu_tanh(v0[0]), gelu_tanh(v0[1]), gelu_tanh(v0[2]), gelu_tanh(v0[3])}, g1_ = (f32x4){gelu_tanh(v1[0]), gelu_tanh(v1[1]), gelu_tanh(v1[2]), gelu_tanh(v1[3])};
            store_bf16x8(Z + (size_t)(crow_tok(cr) + t) * 256 + g * 16 + co, g0, g1_); } });
    }
};
DI void phase_C(const Params& p, LAS char* shm, int l, const int wv_) {
    float sh2;
    { const int lane = otid() & 63; float gq = 0.f, gk = 0.f;
      for (int i = lane; i < 96; i += 64) { gq = fmaxf(gq, fabsf(p.mla_q_g[l * 96 + i])); gk = fmaxf(gk, fabsf(p.mla_k_g[l * 96 + i])); }
      gq = wave_max(gq); gk = wave_max(gk);
      const float c2 = 9.797958971132712f * gq * gk * 1.4426950408889634f;
      sh2 = fmaxf(c2 - 64.f, 0.f); }
    const bool ns = __builtin_amdgcn_readfirstlane(__float_as_int(sh2)) == 0;
    for (int u = blockIdx.x; u < 512; u += gridDim.x) { const int qb = u & 3, h = (u >> 2) & 3, b = u >> 4;
        if (ns) attn_unit<true>(p, shm, l, b, h, b * SEQ + qb * 512, 512, 0, 2304, 0.f, wv_);
        else attn_unit<false>(p, shm, l, b, h, b * SEQ + qb * 512, 512, 0, 2304, sh2, wv_); }
    { PvS5Out pv{p, l}; gemm_stream(shm, pv, wv_); }
    if (l == 0) for (int u = first_unit(512 + 320); u < 128; u += gridDim.x) { const int h = u & 3, b = u >> 2;
        if (ns) attn_unit<true>(p, shm, l, b, h, TX + b * CTXL, 256, 2048, 256, 0.f, wv_);
        else attn_unit<false>(p, shm, l, b, h, TX + b * CTXL, 256, 2048, 256, sh2, wv_); }
}

struct PvGlu {
    const Params& p; int l;
    PV_NOHOOKS
    static constexpr int NT = 4; static constexpr int FP8 = 0; static constexpr bool PARK = false; typedef APlain AS; typedef BSimple BS;
    DI int first() const { return lin_first(0, l == 1 ? 256 : 288); }
    DI int next(int u) const { return lin_next(u, l == 1 ? 256 : 288); }
    DI void src(int u, AS& a, BS& b, const int wv_) const {
        a = make_a_plain((const bf16_t*)(p.ws + WS_Z), (size_t)u * 256, 256, 0);
        const bf16_t* W = (const bf16_t*)(p.ws + WS_WGLU) + (size_t)l * 65536;
        b = make_b(W, W + (size_t)128 * 256, 256);
    }
    DI void epi(f32x4 (&acc)[2][2][4][2], int u, const int wv_) const {
        const bf16_t* Z = (const bf16_t*)(p.ws + WS_Z); bf16_t* CAT = (bf16_t*)(p.ws + WS_CAT);
        const int _tz = otid(), _w = _tz >> 6, _l = _tz & 63, _wr = _w >> 2, _wc = _w & 3, _fr = _l & 15, _fq = _l >> 4;
        const int c0 = _wc * 32 + _fq * 8;
        f32x4 bsv[2][2];
#pragma unroll
        for (int bj = 0; bj < 2; ++bj)
#pragma unroll
            for (int n = 0; n < 2; ++n) bsv[bj][n] = *(const f32x4*)(p.ssm_glu_b + l * 256 + bj * 128 + n * 4 + c0);
#pragma unroll
        for (int ai = 0; ai < 2; ++ai) {
            u32x4 zz[4][2];
#pragma unroll
            for (int m = 0; m < 4; ++m)
#pragma unroll
                for (int bj = 0; bj < 2; ++bj) zz[m][bj] = *(const u32x4*)(Z + (size_t)(u * 256 + ai * 128 + _wr * 64 + m * 16 + _fr) * 256 + bj * 128 + c0);
#pragma unroll
            for (int m = 0; m < 4; ++m) { const size_t r = (size_t)(u * 256 + ai * 128 + _wr * 64 + m * 16 + _fr);
#pragma unroll
                for (int bj = 0; bj < 2; ++bj) { const f32x4 a0 = acc[ai][bj][m][0], a1 = acc[ai][bj][m][1]; const f32x4 b0 = bsv[bj][0], b1 = bsv[bj][1]; const u32x4 z_ = zz[m][bj];
                    const f32x4 o0 = (f32x4){bflo(z_.x) * sigmoidf_(a0[0] + b0[0]), bfhi(z_.x) * sigmoidf_(a0[1] + b0[1]), bflo(z_.y) * sigmoidf_(a0[2] + b0[2]), bfhi(z_.y) * sigmoidf_(a0[3] + b0[3])};
                    const f32x4 o1 = (f32x4){bflo(z_.z) * sigmoidf_(a1[0] + b1[0]), bfhi(z_.z) * sigmoidf_(a1[1] + b1[1]), bflo(z_.w) * sigmoidf_(a1[2] + b1[2]), bfhi(z_.w) * sigmoidf_(a1[3] + b1[3])};
                    store_bf16x8(CAT + r * 1024 + 512 + bj * 128 + c0, o0, o1); } }
        }
    }
};
DI void phase_D(const Params& p, LAS char* shm, int l, const int wv_) {
    PvGlu pv{p, l}; gemm_stream(shm, pv, wv_);
}

struct PvOutproj {
    const Params& p; int l;
    PV_NOHOOKS
    static constexpr int NT = 16; static constexpr int FP8 = 0; static constexpr bool PARK = false; typedef APlain AS; typedef BSimple BS;
    XcdDeal<4, 4> deal;
    DI int first() const { return deal.first(); }
    DI int next(int u) const { return deal.next(u); }
    DI void src(int u, AS& a, BS& b, const int wv_) const {
        int mt, nt; deal.decode(u, mt, nt);
        const bf16_t* W = (const bf16_t*)(p.ws + WS_WMO) + (size_t)l * 1024 * 1024;
        a = make_a_plain((const bf16_t*)(p.ws + WS_CAT), (size_t)mt * 256, 1024, 0);
        b = make_b(W + (size_t)(nt * 256) * 1024, W + (size_t)(nt * 256 + 128) * 1024, 1024);
    }
    DI void epi(f32x4 (&acc)[2][2][4][2], int u, const int wv_) const {
        int mt, nt; deal.decode(u, mt, nt);
        bf16_t* X = (bf16_t*)(p.ws + WS_X);
        const float* MOD = (const float*)(p.ws + WS_MOD) + (size_t)l * 33 * 6144;
        const int _tz = otid(), _w = _tz >> 6, _l = _tz & 63, _wr = _w >> 2, _wc = _w & 3, _fr = _l & 15, _fq = _l >> 4;
        const int c0 = nt * 256 + _wc * 32 + _fq * 8;
        const int row0 = mt * 256;
        const float* g1p = MOD + (size_t)mod_row(row0) * 6144 + 2048 + c0;
        f32x4 g1[2][2];
#pragma unroll
        for (int bj = 0; bj < 2; ++bj)
#pragma unroll
            for (int n = 0; n < 2; ++n) g1[bj][n] = *(const f32x4*)(g1p + bj * 128 + n * 4);
        bf16_t* obase = X + (size_t)row0 * 1024;
        if (l == 0) {
            const float* xbase = row0 < TX ? p.x + (size_t)row0 * 1024 : p.ctx + (size_t)(row0 - TX) * 1024;
#pragma unroll
            for (int ai = 0; ai < 2; ++ai)
#pragma unroll
                for (int mp = 0; mp < 2; ++mp) {
                    f32x4 xv[2][2][2];
#pragma unroll
                    for (int mm = 0; mm < 2; ++mm)
#pragma unroll
                        for (int bj = 0; bj < 2; ++bj)
#pragma unroll
                            for (int n = 0; n < 2; ++n) xv[mm][bj][n] = *(const f32x4*)(xbase + (size_t)(ai * 128 + _wr * 64 + (mp * 2 + mm) * 16 + _fr) * 1024 + c0 + bj * 128 + n * 4);
#pragma unroll
                    for (int mm = 0; mm < 2; ++mm)
#pragma unroll
                        for (int bj = 0; bj < 2; ++bj)
                            store_bf16x8(obase + (size_t)(ai * 128 + _wr * 64 + (mp * 2 + mm) * 16 + _fr) * 1024 + c0 + bj * 128,
                                         xv[mm][bj][0] + g1[bj][0] * acc[ai][bj][mp * 2 + mm][0], xv[mm][bj][1] + g1[bj][1] * acc[ai][bj][mp * 2 + mm][1]);
                }
        } else {
#pragma unroll
            for (int ai = 0; ai < 2; ++ai) {
                u32x4 xv[4][2];
#pragma unroll
                for (int m = 0; m < 4; ++m)
#pragma unroll
                    for (int bj = 0; bj < 2; ++bj) xv[m][bj] = *(const u32x4*)(obase + (size_t)(ai * 128 + _wr * 64 + m * 16 + _fr) * 1024 + c0 + bj * 128);
#pragma unroll
                for (int m = 0; m < 4; ++m)
#pragma unroll
                    for (int bj = 0; bj < 2; ++bj) { const u32x4 x_ = xv[m][bj];
                        const f32x4 x0 = (f32x4){bflo(x_.x), bfhi(x_.x), bflo(x_.y), bfhi(x_.y)}, x1 = (f32x4){bflo(x_.z), bfhi(x_.z), bflo(x_.w), bfhi(x_.w)};
                        store_bf16x8(obase + (size_t)(ai * 128 + _wr * 64 + m * 16 + _fr) * 1024 + c0 + bj * 128, x0 + g1[bj][0] * acc[ai][bj][m][0], x1 + g1[bj][1] * acc[ai][bj][m][1]); }
            }
        }
    }
};
DI void phase_E(const Params& p, LAS char* shm, int l, const int wv_) {
    PvOutproj pv{p, l, {(l == 1 ? TX : TT) / 256}}; gemm_stream(shm, pv, wv_);
}

template <int S> DI float row_rot_f(float v) { return __int_as_float(__builtin_amdgcn_update_dpp(0, __float_as_int(v), 0x120 | S, 0xf, 0xf, false)); }
template <int S> DI int row_rot_i(int v) { return __builtin_amdgcn_update_dpp(0, v, 0x120 | S, 0xf, 0xf, false); }
template <int S> struct RankAcc {
    static DI void run(float o0, float o1, int oe, float v0, float v1, int e0, int& r0, int& r1) {
        const float a0 = S ? row_rot_f<S>(o0) : o0, a1 = S ? row_rot_f<S>(o1) : o1; const int ae = S ? row_rot_i<S>(oe) : oe;
        r0 += (a0 > v0 || (a0 == v0 && ae < e0)) ? 1 : 0;
        r0 += (a1 > v0) ? 1 : 0;
        r1 += (a0 > v1 || a0 == v1) ? 1 : 0;
        r1 += (a1 > v1 || (a1 == v1 && ae < e0)) ? 1 : 0;
        RankAcc<S + 1>::run(o0, o1, oe, v0, v1, e0, r0, r1);
    }
};
template <> struct RankAcc<16> { static DI void run(float, float, int, float, float, int, int&, int&) {} };
DI float row_sum16(float v) { v += row_rot_f<8>(v); v += row_rot_f<4>(v); v += row_rot_f<2>(v); v += row_rot_f<1>(v); return v; }
DI float row_max16(float v) { v = fmaxf(v, row_rot_f<8>(v)); v = fmaxf(v, row_rot_f<4>(v)); v = fmaxf(v, row_rot_f<2>(v)); v = fmaxf(v, row_rot_f<1>(v)); return v; }

DI void phase_router(const Params& p, LAS char* shm, int l, const int wv_) {
    const int tid = otid(), wid = tid >> 6, lane = tid & 63;
    const int Tm = (l == 1) ? TX : TT;
    const bf16_t* X = (const bf16_t*)(p.ws + WS_X);
    const float* MOD = (const float*)(p.ws + WS_MOD) + (size_t)l * 33 * 6144;
    unsigned char* H8 = (unsigned char*)(p.ws + WS_H);
    const bool alt = p.ph_lo != 0;
    int* CNT = (int*)(p.ws + WS_CNT) + l * 32 + (alt ? 64 : 0);
    int* LIST = alt ? (int*)(p.ws + WS_RY) : (int*)(p.ws + WS_LIST);
    LAS char* wfr = shm;
    LAS bf16_t* gml = (LAS bf16_t*)(shm + 131072);
    LAS bf16_t* shl = gml + 1024;
    LAS float* cvec = (LAS float*)(shm + 131072 + 4096);
    LAS int* lcnt = (LAS int*)(cvec + 32);
    LAS int* lbase = lcnt + 32;
    LAS unsigned* lrec = (LAS unsigned*)(lbase + 32);
    LAS float* lwt = (LAS float*)(lrec + 1152);
    const int tpw = (Tm + gridDim.x - 1) / gridDim.x;
    const int tbeg = blockIdx.x * tpw, tend = min(tbeg + tpw, Tm);
    if (tid < 32) lcnt[tid] = 0;
    int seg_beg = tbeg;
    while (seg_beg < tend) {
        const int mrow = mod_row(seg_beg);
        int seg_end = tend;
        if (mrow < 32) seg_end = min(tend, (mrow + 1) * SEQ); else seg_end = tend;
        const float* mr = MOD + (size_t)mrow * 6144;
        __syncthreads();
        for (int k = tid; k < 1024; k += 512) { const float gmv = p.norm2_g[l * 1024 + k] * (1.f + mr[4096 + k]); gml[k] = f2bf(gmv); shl[k] = f2bf(mr[3072 + k]); }
#pragma unroll 8
        for (int i = tid; i < 1024 * 8; i += 512) {
            const int k = i >> 3, e4 = (i & 7) * 4;
            const float gmv = p.norm2_g[l * 1024 + k] * (1.f + mr[4096 + k]);
            const f32x4 w = *(const f32x4*)(p.router_w + (size_t)l * 32768 + k * 32 + e4);
            const int ks = k >> 5, kq = (k >> 3) & 3, j = k & 7;
#pragma unroll
            for (int c = 0; c < 4; ++c) { const int e = e4 + c, nb = e >> 4, ei = e & 15; const float wv = w[c] * gmv;
                const bf16_t hi = f2bf(wv); const bf16_t lo = f2bf(wv - bf2f(hi));
                LAS bf16_t* dst = (LAS bf16_t*)(wfr + ((size_t)((ks * 2 + nb) * 2) * 64 + (kq * 16 + ei)) * 16) + j;
                dst[0] = hi; dst[64 * 8] = lo; }
        }
        {
            float s4[4] = {0.f, 0.f, 0.f, 0.f};
#pragma unroll 8
            for (int k = lane; k < 1024; k += 64) { const float shv = mr[3072 + k]; const f32x4 w = *(const f32x4*)(p.router_w + (size_t)l * 32768 + k * 32 + wid * 4);
                s4[0] += shv * w[0]; s4[1] += shv * w[1]; s4[2] += shv * w[2]; s4[3] += shv * w[3]; }
#pragma unroll
            for (int c = 0; c < 4; ++c) { const float t_ = wave_sum(s4[c]); if (lane == 0) cvec[wid * 4 + c] = t_ + p.router_b[l * 32 + wid * 4 + c]; }
        }
        __syncthreads();
        const int ngroups = (seg_end - seg_beg) >> 4;
        for (int gi = wid; gi < ngroups; gi += 8) {
            const int t0 = seg_beg + gi * 16;
            const int tok = lane & 15, kq = lane >> 4;
            const bf16_t* xr = X + (size_t)(t0 + tok) * 1024 + kq * 8;
            f32x4 acc0 = {0.f, 0.f, 0.f, 0.f}, acc1 = {0.f, 0.f, 0.f, 0.f};
            float ss = 0.f;
            u32x4 xa[16], xb[16];
#pragma unroll
            for (int k2 = 0; k2 < 16; ++k2) xa[k2] = *(const u32x4*)(xr + k2 * 32);
#pragma unroll
            for (int k2 = 0; k2 < 16; ++k2) xb[k2] = *(const u32x4*)(xr + (16 + k2) * 32);
#pragma unroll
            for (int kc = 0; kc < 2; ++kc) {
#pragma unroll
            for (int k2 = 0; k2 < 16; ++k2) { const int ks = kc * 16 + k2;
                if ((k2 & 3) == 0) __builtin_amdgcn_sched_barrier(0);
                const u32x4 xh = kc == 0 ? xa[k2] : xb[k2];
                const float x0 = bflo(xh.x), x1 = bfhi(xh.x), x2 = bflo(xh.y), x3 = bfhi(xh.y), x4 = bflo(xh.z), x5 = bfhi(xh.z), x6 = bflo(xh.w), x7 = bfhi(xh.w);
                ss += x0 * x0 + x1 * x1 + x2 * x2 + x3 * x3 + x4 * x4 + x5 * x5 + x6 * x6 + x7 * x7;
                const bf16x8 ah = __builtin_bit_cast(bf16x8, xh);
                const LAS char* wb = wfr + (size_t)(ks * 4) * 1024 + lane * 16;
                const bf16x8 b0h = *(const LAS bf16x8*)(wb), b0l = *(const LAS bf16x8*)(wb + 1024), b1h = *(const LAS bf16x8*)(wb + 2048), b1l = *(const LAS bf16x8*)(wb + 3072);
                acc0 = __builtin_amdgcn_mfma_f32_16x16x32_bf16(ah, b0h, acc0, 0, 0, 0); acc0 = __builtin_amdgcn_mfma_f32_16x16x32_bf16(ah, b0l, acc0, 0, 0, 0);
                acc1 = __builtin_amdgcn_mfma_f32_16x16x32_bf16(ah, b1h, acc1, 0, 0, 0); acc1 = __builtin_amdgcn_mfma_f32_16x16x32_bf16(ah, b1l, acc1, 0, 0, 0);
            } }
            u32x4 xp[16];
#pragma unroll
            for (int k2 = 0; k2 < 16; ++k2) xp[k2] = *(const u32x4*)(xr + k2 * 32);
            ss += shx(ss, 16); ss += shx(ss, 32);
            const float rn = rsqrtf(ss * (1.f / 1024.f) + EPS);
            const int ei = lane & 15;
            const float c0v = cvec[ei], c1v = cvec[16 + ei];
#pragma unroll
            for (int r = 0; r < 4; ++r) {
                const int tl = (lane >> 4) * 4 + r;
                const float rnt = shi(rn, tl);
                float v0 = fminf(fmaxf(acc0[r] * rnt + c0v, -1e30f), 1e30f), v1 = fminf(fmaxf(acc1[r] * rnt + c1v, -1e30f), 1e30f);
                int r0 = 0, r1 = 0;
                RankAcc<0>::run(v0, v1, ei, v0, v1, ei, r0, r1);
                const float mx = row_max16(fmaxf(v0, v1));
                const bool s0 = r0 < 4, s1 = r1 < 4;
                const float e0 = s0 ? __expf(v0 - mx) : 0.f, e1 = s1 ? __expf(v1 - mx) : 0.f;
                const float inv = 1.f / row_sum16(e0 + e1);
                const int t = t0 + tl;
                if (s0) { const int pos = atomicAdd((int*)&lcnt[ei], 1); lrec[(t - tbeg) * 4 + r0] = (unsigned)ei | ((unsigned)pos << 8); lwt[(t - tbeg) * 4 + r0] = e0 * inv; }
                if (s1) { const int pos = atomicAdd((int*)&lcnt[16 + ei], 1); lrec[(t - tbeg) * 4 + r1] = (unsigned)(16 + ei) | ((unsigned)pos << 8); lwt[(t - tbeg) * 4 + r1] = e1 * inv; }
            }
            unsigned char* hr = H8 + (size_t)(t0 + tok) * 1024 + kq * 8;
#pragma unroll 1
            for (int kc = 0; kc < 2; ++kc) {
            u32x4 xv[16];
            if (kc == 0) {
#pragma unroll
                for (int k2 = 0; k2 < 16; ++k2) xv[k2] = xp[k2];
            } else {
#pragma unroll
                for (int k2 = 0; k2 < 16; ++k2) xv[k2] = *(const u32x4*)(xr + (16 + k2) * 32);
            }
#pragma unroll
            for (int k2 = 0; k2 < 16; ++k2) { const int ks = kc * 16 + k2;
                const u32x4 xh = xv[k2];
                const u32x4 gq = *(const LAS u32x4*)(gml + ks * 32 + kq * 8), sq = *(const LAS u32x4*)(shl + ks * 32 + kq * 8);
                float h[8];
                h[0] = bflo(xh.x) * rn * bflo(gq.x) + bflo(sq.x); h[1] = bfhi(xh.x) * rn * bfhi(gq.x) + bfhi(sq.x); h[2] = bflo(xh.y) * rn * bflo(gq.y) + bflo(sq.y); h[3] = bfhi(xh.y) * rn * bfhi(gq.y) + bfhi(sq.y);
                h[4] = bflo(xh.z) * rn * bflo(gq.z) + bflo(sq.z); h[5] = bfhi(xh.z) * rn * bfhi(gq.z) + bfhi(sq.z); h[6] = bflo(xh.w) * rn * bflo(gq.w) + bflo(sq.w); h[7] = bfhi(xh.w) * rn * bfhi(gq.w) + bfhi(sq.w);
#pragma unroll
                for (int i = 0; i < 8; ++i) h[i] = __builtin_amdgcn_fmed3f(h[i], -448.f, 448.f);
                u32x2 o; o.x = pk_fp8x4(h[0], h[1], h[2], h[3]); o.y = pk_fp8x4(h[4], h[5], h[6], h[7]);
                *(u32x2*)(hr + ks * 32) = o;
            } }
        }
        seg_beg = seg_end;
    }
    __syncthreads();
    if (tid < 32) lbase[tid] = atomicAdd(&CNT[tid], lcnt[tid]);
    __syncthreads();
    for (int i = tid; i < (tend - tbeg) * 4; i += 512) { const unsigned rec = lrec[i]; const int e = rec & 255, pos = rec >> 8;
        u32x2 ent; ent.x = (unsigned)(tbeg * 4 + i); ent.y = __float_as_uint(lwt[i]);
        *(u32x2*)(LIST + ((size_t)e * TT + lbase[e] + pos) * 2) = ent; }
    __syncthreads();
}

DI void moe_tiles(const Params& p, LAS int* tstart, int l, const int wv_) {
    const int* CNT = (const int*)(p.ws + WS_CNT) + l * 32;
    if (otid() == 0) { int s = 0; for (int e = 0; e < 32; ++e) { tstart[e] = s; s += (CNT[e] + 255) >> 8; } tstart[32] = s; }
    __syncthreads();
    LAS int* ttab = (LAS int*)((LAS char*)tstart - (LDS_MISC + 64) + LDS_TTAB);
    const int MT_ = tstart[32];
    for (int mt = otid(); mt < MT_; mt += 512) { int e = 0;
#pragma unroll
        for (int i = 1; i < 32; ++i) e += (mt >= tstart[i]) ? 1 : 0;
        ttab[mt] = e | ((mt - tstart[e]) << 8); }
    __syncthreads();
}
DI int moe_find(const LAS int* tstart, int mt) { const LAS int* ttab = (const LAS int*)((const LAS char*)tstart - (LDS_MISC + 64) + LDS_TTAB); return __builtin_amdgcn_readfirstlane(ttab[mt]); }
struct PvMoe1 {
    const Params& p; int l; const LAS int* tstart; LAS char* tbl;
    static constexpr int NT = 8; static constexpr int FP8 = 2; static constexpr bool PARK = false; typedef ASimple AS; typedef BSimple BS;
    XcdDeal<4, 8> deal;
    DI int first() const { return deal.first(); }
    DI int next(int u) const { return deal.next(u); }
    typedef u32x4 Aux;
    DI void top(int u, Aux& aux, const int wv_) const {
        int mt, n8; deal.decode(u, mt, n8);
        const int ev_ = moe_find(tstart, mt); const int e = ev_ & 255;
        const int t_ = otid() & 63;
        aux = aload128(p.exp_b_in + (size_t)(l * NE + e) * 2048 + (t_ < 32 ? n8 * 128 + t_ * 4 : 1024 + n8 * 128 + (t_ - 32) * 4));
    }
    DI void mid(Aux& aux, const int wv_) const { const int t_ = otid(); asm volatile("" : "+v"(aux)); if (t_ < 64) *(LAS u32x4*)(tbl + t_ * 16) = aux; }
    DI void fix(AS& as, bool wait, const int wv_) const {
        if (wait) asm volatile("s_waitcnt vmcnt(0)" ::: "memory");
        int R[2], C[2]; stage_coords(R, C, wv_);
#pragma unroll
        for (int h = 0; h < 2; ++h)
#pragma unroll
            for (int i = 0; i < 2; ++i) { unsigned sl = as.off[h][i]; asm volatile("" : "+v"(sl)); as.off[h][i] = (sl >> 2) * 1024u + (unsigned)(C[i] * 2); }
    }
    DI void src(int u, AS& as, BS& bs, const int wv_) const {
        int mt, n8; deal.decode(u, mt, n8);
        const int ev_ = moe_find(tstart, mt); const int e = ev_ & 255;
        const int r0 = (ev_ >> 8) * 256, cnt = ((const int*)(p.ws + WS_CNT))[l * 32 + e];
        const int* lst = (const int*)(p.ws + WS_LIST) + (size_t)e * TT * 2;
        int R[2], C[2]; stage_coords(R, C, wv_);
        as.base = (const char*)(p.ws + WS_H); as.kstride = 128;
#pragma unroll
        for (int h = 0; h < 2; ++h)
#pragma unroll
            for (int i = 0; i < 2; ++i) as.off[h][i] = aload32(lst + 2 * min(r0 + h * 128 + R[i], cnt - 1));
        const char* W = (const char*)(p.ws + WS_W1) + (size_t)(l * NE + e) * 2048 * 1024;
        bs.base[0] = W + (size_t)(n8 * 128) * 1024; bs.base[1] = W + (size_t)(1024 + n8 * 128) * 1024; bs.ldb2 = 1024;
    }
    DI void epi(f32x4 (&acc)[2][2][4][2], int u, const int wv_) const {
        int mt, n8; deal.decode(u, mt, n8);
        const int ev_ = moe_find(tstart, mt); const int e = ev_ & 255;
        unsigned char* ACT = (unsigned char*)(p.ws + WS_RA);
        const int _tz = otid(), _w = _tz >> 6, _l = _tz & 63, _wr = _w >> 2, _wc = _w & 3, _fr = _l & 15, _fq = _l >> 4;
        const LAS float* bin = (const LAS float*)tbl + _wc * 32 + _fq * 8;
        f32x4 bg[2], bu[2];
#pragma unroll
        for (int n = 0; n < 2; ++n) { bg[n] = *(const LAS f32x4*)(bin + n * 4) * SWI_A; bu[n] = (*(const LAS f32x4*)(bin + 128 + n * 4) + 1.f) * (1.f / SWI_A); }
        (void)e;
#pragma unroll
        for (int ai = 0; ai < 2; ++ai)
#pragma unroll
            for (int m = 0; m < 4; ++m) { const int lr = ai * 128 + _wr * 64 + m * 16 + _fr;
                unsigned char* orow = ACT + ((size_t)mt * 256 + lr) * 1024 + n8 * 128 + _wc * 32 + _fq * 8;
                u32x2 pk;
#pragma unroll
                for (int n = 0; n < 2; ++n) {
                    float o[4];
#pragma unroll
                    for (int h2 = 0; h2 < 2; ++h2) {
                        const f32v2_t ag = {acc[ai][0][m][n][2 * h2], acc[ai][0][m][n][2 * h2 + 1]}, au = {acc[ai][1][m][n][2 * h2], acc[ai][1][m][n][2 * h2 + 1]};
                        const f32v2_t bgv = {bg[n][2 * h2], bg[n][2 * h2 + 1]}, buv = {bu[n][2 * h2], bu[n][2 * h2 + 1]};
                        f32v2_t g2 = ag * (1.f / 256.f) + bgv, u2 = au * (1.f / 256.f) + buv;
                        g2[0] = fminf(g2[0], 7.f * SWI_A); g2[1] = fminf(g2[1], 7.f * SWI_A);
                        u2[0] = __builtin_amdgcn_fmed3f(u2[0], -6.f / SWI_A, 8.f / SWI_A); u2[1] = __builtin_amdgcn_fmed3f(u2[1], -6.f / SWI_A, 8.f / SWI_A);
                        f32v2_t e2; e2[0] = __builtin_amdgcn_exp2f(-g2[0]); e2[1] = __builtin_amdgcn_exp2f(-g2[1]);
                        const f32v2_t d2 = e2 + 1.f;
                        f32v2_t r2; r2[0] = __builtin_amdgcn_rcpf(d2[0]); r2[1] = __builtin_amdgcn_rcpf(d2[1]);
                        const f32v2_t o2 = u2 * g2 * r2;
                        o[2 * h2] = o2[0]; o[2 * h2 + 1] = o2[1]; }
                    if (n == 0) pk.x = pk_fp8x4(o[0], o[1], o[2], o[3]); else pk.y = pk_fp8x4(o[0], o[1], o[2], o[3]); }
                *(u32x2*)orow = pk; }
    }
};
DI void phase_moe1(const Params& p, LAS char* shm, int l, const int wv_) {
    LAS int* tstart = (LAS int*)(shm + LDS_MISC + 64);
    moe_tiles(p, tstart, l, wv_);
    PvMoe1 pv{p, l, tstart, shm + 131072, {tstart[32]}}; gemm_stream(shm, pv, wv_);
}
struct PvMoe2 {
    const Params& p; int l; const LAS int* tstart; LAS char* tbl;
    static constexpr int NT = 8; static constexpr int FP8 = 2; static constexpr bool PARK = false; typedef APlain AS; typedef BSeq16 BS;
    XcdDeal<4, 4> deal;
    DI int first() const { return deal.first(); }
    DI int next(int u) const { return deal.next(u); }
    template <class A_> DI void fix(A_&, bool, const int) const {}
    typedef u32x4 Aux;
    DI void top(int u, Aux& aux, const int wv_) const {
        int mt, n4; deal.decode(u, mt, n4);
        const int ev_ = moe_find(tstart, mt); const int e = ev_ & 255; const int r0 = (ev_ >> 8) * 256;
        const int t_ = otid();
        const char* src_ = t_ < 128 ? (const char*)((const int*)(p.ws + WS_LIST) + (size_t)e * TT * 2 + (size_t)(r0 + 2 * t_) * 2)
                                    : (const char*)(p.exp_b_out + (size_t)(l * NE + e) * 1024 + n4 * 256 + ((t_ - 128) & 63) * 4);
        aux = aload128(src_);
    }
    DI void mid(Aux& aux, const int wv_) const { const int t_ = otid(); asm volatile("" : "+v"(aux)); if (t_ < 192) *(LAS u32x4*)(tbl + t_ * 16) = aux; }
    DI void src(int u, AS& as, BS& bs, const int wv_) const {
        int mt, n4; deal.decode(u, mt, n4);
        const int ev_ = moe_find(tstart, mt); const int e = ev_ & 255;
        as.base = (const char*)(p.ws + WS_RA) + (size_t)mt * 256 * 1024; as.lda2 = 1024;
        const char* W = (const char*)(p.ws + WS_W2) + (size_t)(l * NE + e) * 1024 * 1024;
        bs.base = W + (size_t)(n4 * 256) * 1024; bs.ldb2 = 1024;
    }
    DI void epi(f32x4 (&acc)[2][2][4][2], int u, const int wv_) const {
        int mt, n4; deal.decode(u, mt, n4);
        const int ev_ = moe_find(tstart, mt); const int e = ev_ & 255;
        const int r0 = (ev_ >> 8) * 256, cnt = ((const int*)(p.ws + WS_CNT))[l * 32 + e];
        const int* lst = (const int*)(p.ws + WS_LIST) + (size_t)e * TT * 2;
        unsigned char* Y = (unsigned char*)(p.ws + WS_RY);
        const int _tz = otid(), _w = _tz >> 6, _l = _tz & 63, _wr = _w >> 2, _wc = _w & 3, _fr = _l & 15, _fq = _l >> 4;
        const LAS float* bo = (const LAS float*)(tbl + 2048) + _wc * 64 + _fq * 16;
        u32x2 ent[2][4]; f32x4 bv[2][2];
#pragma unroll
        for (int ai = 0; ai < 2; ++ai)
#pragma unroll
            for (int m = 0; m < 4; ++m) ent[ai][m] = *(const LAS u32x2*)(tbl + (ai * 128 + _wr * 64 + m * 16 + _fr) * 8);
#pragma unroll
        for (int bj = 0; bj < 2; ++bj)
#pragma unroll
            for (int n = 0; n < 2; ++n) bv[bj][n] = *(const LAS f32x4*)(bo + bj * 8 + n * 4);
        (void)lst;
#pragma unroll
        for (int ai = 0; ai < 2; ++ai)
#pragma unroll
            for (int m = 0; m < 4; ++m) { const int lr = r0 + ai * 128 + _wr * 64 + m * 16 + _fr;
                if (lr < cnt) { const float w = __uint_as_float(ent[ai][m].y) * YSCALE; unsigned char* orow = Y + (size_t)ent[ai][m].x * 1024 + n4 * 256 + _wc * 64 + _fq * 16;
                    const float sc_ = 1.f / 256.f;
                    u32x4 pk;
#pragma unroll
                    for (int bj = 0; bj < 2; ++bj)
#pragma unroll
                        for (int n = 0; n < 2; ++n) { const f32x4 v = (acc[ai][bj][m][n] * sc_ + bv[bj][n]) * w;
                            pk[bj * 2 + n] = pk_fp8x4(__builtin_amdgcn_fmed3f(v[0], -448.f, 448.f), __builtin_amdgcn_fmed3f(v[1], -448.f, 448.f), __builtin_amdgcn_fmed3f(v[2], -448.f, 448.f), __builtin_amdgcn_fmed3f(v[3], -448.f, 448.f)); }
                    *(u32x4*)orow = pk; } }
    }
};
DI void phase_moe2(const Params& p, LAS char* shm, int l, const int wv_) {
    LAS int* tstart = (LAS int*)(shm + LDS_MISC + 64);
    moe_tiles(p, tstart, l, wv_);
    PvMoe2 pv{p, l, tstart, shm + 131072, {tstart[32]}}; gemm_stream(shm, pv, wv_);
}

DI void phase_combine(const Params& p, LAS char* shm, int l, const int wv_) {
    const int tid = otid(), wid = tid >> 6, lane = tid & 63;
    const bool alt = p.ph_lo != 0;
    const bf16_t* X = (const bf16_t*)(p.ws + WS_X);
    bf16_t* XO = alt ? (bf16_t*)(p.ws + WS_RA) : (bf16_t*)(p.ws + WS_X);
    float* OUT = alt ? (float*)(p.ws + WS_RA) : p.out;
    const unsigned char* Y = (const unsigned char*)(p.ws + WS_RY);
    const float* MOD = (const float*)(p.ws + WS_MOD);
    bf16_t* H = alt ? (bf16_t*)(p.ws + WS_RA + (size_t)TT * 1024 * 4) : (bf16_t*)(p.ws + WS_H);
    const int Tm = (l == 1) ? TX : TT;
    for (int r = blockIdx.x * 8 + wid; r < Tm; r += gridDim.x * 8) {
        const float* g2 = MOD + (size_t)(l * 33 + mod_row(r)) * 6144 + 5120;
        float v[16];
#pragma unroll
        for (int jj = 0; jj < 2; ++jj) {
            const int col = jj * 512 + lane * 8;
            f32x4 s0 = (f32x4){0.f, 0.f, 0.f, 0.f}, s1 = s0;
#pragma unroll
            for (int k = 0; k < 4; ++k) { const u32x2 yy = __builtin_nontemporal_load((const u32x2*)(Y + ((size_t)r * 4 + k) * 1024 + col));
                const f32v2_t ya = __builtin_amdgcn_cvt_pk_f32_fp8((int)yy.x, false), yb = __builtin_amdgcn_cvt_pk_f32_fp8((int)yy.x, true), yc = __builtin_amdgcn_cvt_pk_f32_fp8((int)yy.y, false), yd = __builtin_amdgcn_cvt_pk_f32_fp8((int)yy.y, true);
                s0[0] += ya[0]; s0[1] += ya[1]; s0[2] += yb[0]; s0[3] += yb[1]; s1[0] += yc[0]; s1[1] += yc[1]; s1[2] += yd[0]; s1[3] += yd[1]; }
            s0 *= 1.f / YSCALE; s1 *= 1.f / YSCALE;
            const u32x4 xb_ = *(const u32x4*)(X + (size_t)r * 1024 + col); const f32x4 g0 = *(const f32x4*)(g2 + col), g1 = *(const f32x4*)(g2 + col + 4);
            const f32x4 x0 = (f32x4){bflo(xb_.x), bfhi(xb_.x), bflo(xb_.y), bfhi(xb_.y)}, x1 = (f32x4){bflo(xb_.z), bfhi(xb_.z), bflo(xb_.w), bfhi(xb_.w)};
            const f32x4 o0 = x0 + g0 * s0, o1 = x1 + g1 * s1;
            if (l == 1) { *(f32x4*)(OUT + (size_t)r * 1024 + col) = o0; *(f32x4*)(OUT + (size_t)r * 1024 + col + 4) = o1; } else store_bf16x8(XO + (size_t)r * 1024 + col, o0, o1);
#pragma unroll
            for (int i = 0; i < 4; ++i) { v[jj * 8 + i] = o0[i]; v[jj * 8 + 4 + i] = o1[i]; }
        }
        if (l == 0) norm_mod_store(v, p.norm1_g + 1024, MOD + (size_t)(1 * 33 + mod_row(r)) * 6144, H + (size_t)r * 1024, wv_);
    }
}

constexpr int NPH_LAYER = 10;
constexpr int NPH = 2 + 2 * NPH_LAYER;

__global__ void __launch_bounds__(512, 2) mk_forward(Params p_unused) {
    extern __shared__ __attribute__((aligned(16))) char smem_raw[];
    LAS char* shm = (LAS char*)smem_raw;
    volatile LAS unsigned* xb_words = (volatile LAS unsigned*)(shm + LDS_MISC);
    const int wv_ = __builtin_amdgcn_readfirstlane((int)(threadIdx.x >> 6));
    if (wv_ == 0 && olane() < 4) xb_words[olane()] = 0u;
    __syncthreads();
    kaptr_t ka = (kaptr_t)__builtin_amdgcn_kernarg_segment_ptr();
    const int tok0 = ptoken();
    const int lo = (int)kld64<__builtin_offsetof(Params, ph_lo)>(ka, tok0), hi = (int)kld64<__builtin_offsetof(Params, ph_hi)>(ka, tok0);
    const bool multi = (hi - lo) > 1;
    unsigned* barw = (unsigned*)((__attribute__((address_space(1))) char*)kld64<__builtin_offsetof(Params, ws)>(ka, tok0) + WS_BAR);
    XcdBarrier bar; bar.bar = barw; bar.x = 0; bar.st = xb_words;
    if (multi) bar = xcd_barrier_post(barw, xb_words, wv_);
#ifndef ONLY_KIND
#define ONLY_KIND (-1)
#endif
#define PHASE(idx, kind, FN, ...) do { if ((ONLY_KIND < 0 || ONLY_KIND == (kind)) && (idx) >= lo && (idx) < hi) { const Params p = kparams(ka, ptoken()); int nrep_ = 1 + ((MK_REPEAT_MASK >> (kind)) & 1); asm volatile("" : "+s"(nrep_)); for (int rep_ = 0; rep_ < nrep_; ++rep_) { Params p2 = p; p2.ph_lo = rep_; FN(p2, ##__VA_ARGS__, wv_); } if ((idx) + 1 < hi) xcd_barrier(bar, wv_); } } while (0)
    PHASE(0, 0, phase_prologue, shm);
    PHASE(1, 1, phase_norm1_l0);
    for (int l = 0; l < 2; ++l) {
        const int b0 = 2 + l * NPH_LAYER;
        PHASE(b0 + 0, 2, phase_inproj, shm, l);
        PHASE(b0 + 1, 3, phase_A, shm, l);
        PHASE(b0 + 2, 4, phase_B, shm, l);
        PHASE(b0 + 3, 5, phase_C, shm, l);
        PHASE(b0 + 4, 6, phase_D, shm, l);
        PHASE(b0 + 5, 7, phase_E, shm, l);
        PHASE(b0 + 6, 8, phase_router, shm, l);
        PHASE(b0 + 7, 9, phase_moe1, shm, l);
        PHASE(b0 + 8, 10, phase_moe2, shm, l);
        PHASE(b0 + 9, 11, phase_combine, shm, l);
    }
#undef PHASE
}


extern "C" void kernel_launch(void* const* d_in, const int* in_sizes, int n_in, void* d_out, int out_size, void* d_ws, size_t ws_size, hipStream_t stream) {
    static int grid = 0;
    if (grid == 0) {
        if (n_in != 39 || ws_size < WS_END) { fprintf(stderr, "kernel_launch: unexpected n_in %d or ws_size %zu (< %zu)\n", n_in, ws_size, (size_t)WS_END); grid = -1; return; }
        int dev = 0, cus = 0;
        if (hipGetDevice(&dev) != hipSuccess || hipDeviceGetAttribute(&cus, hipDeviceAttributeMultiprocessorCount, dev) != hipSuccess) { grid = -1; return; }
        if (hipFuncSetAttribute((const void*)mk_forward, hipFuncAttributeMaxDynamicSharedMemorySize, LDS_BYTES) != hipSuccess) { fprintf(stderr, "kernel_launch: hipFuncSetAttribute failed\n"); grid = -1; return; }
        int per_cu = 0;
        if (hipOccupancyMaxActiveBlocksPerMultiprocessor(&per_cu, (const void*)mk_forward, 512, LDS_BYTES) != hipSuccess || per_cu < 1) fprintf(stderr, "kernel_launch: occupancy query says %d\n", per_cu);
        (void)hipGetLastError();
        grid = cus > 256 ? 256 : cus;
    }
    if (grid < 0) return;
    (void)hipMemsetAsync((char*)d_ws + WS_BAR, 0, 16384 + 1024, stream);
    Params p{};
    const float** pf = (const float**)&p;
    for (int i = 0; i < 39; ++i) pf[i] = (const float*)d_in[i];
    p.out = (float*)d_out; p.ws = (char*)d_ws;
#if MK_ONE_LAUNCH
    p.ph_lo = 0; p.ph_hi = NPH;
    hipLaunchKernelGGL(mk_forward, dim3(grid), dim3(512), LDS_BYTES, stream, p);
#else
#ifndef MK_LAST_PHASE
#define MK_LAST_PHASE NPH
#endif
    for (int ph = 0; ph < MK_LAST_PHASE; ++ph) { p.ph_lo = ph; p.ph_hi = ph + 1; hipLaunchKernelGGL(mk_forward, dim3(grid), dim3(512), LDS_BYTES, stream, p); }
#endif
}
```
